# Optimizing an MI355X kernel written in HIP

```python
import math
import jax, jax.numpy as jnp
from jax import lax
import numpy as np

D_MODEL = 1024
BATCH = 4
SEQ = 4096
DEPTH = 1

N_MLSTM_HEADS = 4
MLSTM_HEAD_DIM = 128
D_MLSTM = N_MLSTM_HEADS * MLSTM_HEAD_DIM
MLSTM_CHUNK = 64
CONV_WIDTH = 3
N_MLA_HEADS = 8
MLA_NOPE_DIM = 64
MLA_ROPE_DIM = 32
MLA_QK_DIM = MLA_NOPE_DIM + MLA_ROPE_DIM
MLA_V_DIM = 64
D_MLA = N_MLA_HEADS * MLA_V_DIM
Q_LORA_RANK = 256
KV_LORA_RANK = 128
ROPE_THETA = 10000.0
Q_BLOCK = 128
D_MIX = D_MLSTM + D_MLA
N_GATE = 4 * N_MLSTM_HEADS
IN_SIZES = [D_MLSTM, D_MLSTM, D_MLSTM, D_MLSTM, N_GATE, Q_LORA_RANK, KV_LORA_RANK, MLA_ROPE_DIM]
IN_OFFSETS = np.cumsum(IN_SIZES)[:-1].tolist()
D_IN = int(sum(IN_SIZES))
N_MEM = 256
N_MEM_HEADS = 4
MEM_HEAD_DIM = 256
D_MEM_INNER = N_MEM_HEADS * MEM_HEAD_DIM
N_EXPERTS = 16
EC_CAPACITY_FACTOR = 2
D_FF_EXPERT = 2048
EPS = 1e-6

kernel_name = "hybrid_mlstm_mla_memxattn_ec_moe"


def rmsnorm(x, g):
    xf = x.astype(jnp.float32)
    y = xf * lax.rsqrt(jnp.mean(xf * xf, axis=-1, keepdims=True) + EPS)
    return (y * g).astype(x.dtype)


def head_rmsnorm(t, g):
    B, S, H, d = t.shape
    tf = t.astype(jnp.float32)
    y = tf * lax.rsqrt(jnp.mean(tf * tf, axis=-1, keepdims=True) + EPS)
    return (y.reshape(B, S, H * d) * g).astype(t.dtype)


def rope_tables(positions):
    inv_freq = ROPE_THETA ** (-jnp.arange(0, MLA_ROPE_DIM, 2, dtype=jnp.float32) / MLA_ROPE_DIM)
    ang = positions.astype(jnp.float32)[..., None] * inv_freq
    return jnp.cos(ang), jnp.sin(ang)


def apply_rope(t, cos, sin):
    tf = t.astype(jnp.float32)
    t1, t2 = jnp.split(tf, 2, axis=-1)
    return jnp.concatenate([t1 * cos - t2 * sin, t2 * cos + t1 * sin], axis=-1).astype(t.dtype)


def centred_conv(u, w):
    S = u.shape[1]
    pad = CONV_WIDTH // 2
    up = jnp.pad(u, ((0, 0), (pad, pad), (0, 0)))
    out = up[:, 0:S] * w[0]
    for j in range(1, CONV_WIDTH):
        out = out + up[:, j:j + S] * w[j]
    return out


def mlstm_chunkwise(q, k, v, log_i, log_f):
    B, H, S, d = q.shape
    T = MLSTM_CHUNK
    NC = S // T
    chunk = lambda t: jnp.moveaxis(t.reshape(B, H, NC, T, *t.shape[3:]), 2, 0)
    mask = jnp.tril(jnp.ones((T, T), dtype=bool))

    def step(carry, inp):
        C, n, m = carry
        qc, kc, vc, li, lf = inp
        b = jnp.cumsum(lf, axis=-1)
        g = b[..., -1]
        Dm = b[..., :, None] - b[..., None, :] + li[..., None, :]
        Dm = jnp.where(mask, Dm, -jnp.inf)
        inter = b + m[..., None]
        m_t = jnp.maximum(inter, jnp.max(Dm, axis=-1))
        Pw = jnp.exp(Dm - m_t[..., None]) * jnp.einsum('bhtd,bhsd->bhts', qc, kc)
        inter_w = jnp.exp(inter - m_t)
        num = inter_w[..., None] * jnp.einsum('bhtd,bhde->bhte', qc, C) + jnp.einsum('bhts,bhse->bhte', Pw, vc)
        den = inter_w * jnp.einsum('bhtd,bhd->bht', qc, n) + jnp.sum(Pw, axis=-1)
        h = num / jnp.maximum(jnp.abs(den), jnp.exp(-m_t))[..., None]
        w_s = g[..., None] - b + li
        m_new = jnp.maximum(g + m, jnp.max(w_s, axis=-1))
        decay = jnp.exp(g + m - m_new)
        ws = jnp.exp(w_s - m_new[..., None])
        C_new = decay[..., None, None] * C + jnp.einsum('bhs,bhsd,bhse->bhde', ws, kc, vc)
        n_new = decay[..., None] * n + jnp.einsum('bhs,bhsd->bhd', ws, kc)
        return (C_new, n_new, m_new), h

    init = (jnp.zeros((B, H, d, d), jnp.float32), jnp.zeros((B, H, d), jnp.float32), jnp.zeros((B, H), jnp.float32))
    _, hs = lax.scan(step, init, (chunk(q), chunk(k), chunk(v), chunk(log_i), chunk(log_f)))
    return jnp.moveaxis(hs, 0, 2).reshape(B, H, S, d)


def mla_attention(qn, qr, kn, kr, v):
    B, S, H, _ = qn.shape
    nb = S // Q_BLOCK
    scale = MLA_QK_DIM ** -0.5
    blk = lambda t: t.reshape(B, nb, Q_BLOCK, *t.shape[2:]).swapaxes(0, 1)

    def one(args):
        qn_b, qr_b = args
        s = jnp.einsum('bqhd,bkhd->bhqk', qn_b, kn) + jnp.einsum('bqhr,bkr->bhqk', qr_b, kr)
        p = jax.nn.softmax(s.astype(jnp.float32) * scale, axis=-1).astype(v.dtype)
        return jnp.einsum('bhqk,bkhd->bqhd', p, v)

    out = lax.map(one, (blk(qn), blk(qr)))
    return out.swapaxes(0, 1).reshape(B, S, H, MLA_V_DIM)


def hybrid_mixer(h, cos, sin, w_in, b_gates, conv_qk, g_q_a, w_q_b, g_kv_a, w_kv_b,
                 g_head_mlstm, g_head_mla, w_out):
    B, S, _ = h.shape
    proj = h @ w_in
    q_m, k_m, v_m, o_m, gates, c_q, c_kv, k_rope = jnp.split(proj, IN_OFFSETS, axis=-1)

    qk = jax.nn.silu(centred_conv(jnp.concatenate([q_m, k_m], axis=-1), conv_qk))
    q_m, k_m = jnp.split(qk, 2, axis=-1)
    to_heads = lambda t: t.reshape(B, S, N_MLSTM_HEADS, MLSTM_HEAD_DIM).transpose(0, 2, 1, 3).astype(jnp.float32)
    qh = to_heads(q_m)
    kh = to_heads(k_m) * (MLSTM_HEAD_DIM ** -0.5)
    vh = to_heads(v_m)
    gts = (gates + b_gates).astype(jnp.float32).reshape(B, S, 4, N_MLSTM_HEADS).transpose(2, 0, 3, 1)
    i_f, f_f, i_b, f_b = gts[0], gts[1], gts[2], gts[3]
    h_fwd = mlstm_chunkwise(qh, kh, vh, i_f, jax.nn.log_sigmoid(f_f))
    flip = lambda t: jnp.flip(t, axis=2)
    h_bwd = flip(mlstm_chunkwise(flip(qh), flip(kh), flip(vh), flip(i_b), flip(jax.nn.log_sigmoid(f_b))))
    h_m = (h_fwd + h_bwd).transpose(0, 2, 1, 3).astype(h.dtype)
    y_m = jax.nn.sigmoid(o_m) * head_rmsnorm(h_m, g_head_mlstm)

    q = (rmsnorm(c_q, g_q_a) @ w_q_b).reshape(B, S, N_MLA_HEADS, MLA_QK_DIM)
    qn, qr = q[..., :MLA_NOPE_DIM], q[..., MLA_NOPE_DIM:]
    qr = apply_rope(qr, cos[:, :, None], sin[:, :, None])
    kv = (rmsnorm(c_kv, g_kv_a) @ w_kv_b).reshape(B, S, N_MLA_HEADS, MLA_NOPE_DIM + MLA_V_DIM)
    kn, v = kv[..., :MLA_NOPE_DIM], kv[..., MLA_NOPE_DIM:]
    kr = apply_rope(k_rope, cos, sin)
    y_a = head_rmsnorm(mla_attention(qn, qr, kn, kr, v), g_head_mla)

    return jnp.concatenate([y_m, y_a], axis=-1) @ w_out


def memory_cross_attention(h, m, w_q, w_k, w_v, w_o):
    B, S, _ = h.shape
    M = m.shape[1]
    q = (h @ w_q).reshape(B, S, N_MEM_HEADS, MEM_HEAD_DIM)
    k = (m @ w_k).reshape(B, M, N_MEM_HEADS, MEM_HEAD_DIM)
    v = (m @ w_v).reshape(B, M, N_MEM_HEADS, MEM_HEAD_DIM)
    s = jnp.einsum('bqhd,bkhd->bhqk', q, k).astype(jnp.float32) * (MEM_HEAD_DIM ** -0.5)
    p = jax.nn.softmax(s, axis=-1).astype(v.dtype)
    o = jnp.einsum('bhqk,bkhd->bqhd', p, v).reshape(B, S, D_MEM_INNER)
    return o @ w_o


def expert_choice_ffn(h, w_router, w_gate, w_up, w_down):
    B, S, D = h.shape
    cap = EC_CAPACITY_FACTOR * S // N_EXPERTS
    aff = jax.nn.softmax((h @ w_router).astype(jnp.float32), axis=-1)
    gate_vals, idx = lax.top_k(aff.transpose(0, 2, 1), cap)
    xe = jax.vmap(lambda t, i: t[i])(h, idx)
    hid = jax.nn.silu(jnp.einsum('becd,edf->becf', xe, w_gate)) * jnp.einsum('becd,edf->becf', xe, w_up)
    ye = jnp.einsum('becf,efd->becd', hid, w_down) * gate_vals[..., None].astype(h.dtype)
    return jax.vmap(lambda y, i: jnp.zeros((S, D), y.dtype).at[i.reshape(-1)].add(y.reshape(-1, D)))(ye, idx)


def setup_inputs(seed: int = 0) -> dict:
    key = jax.random.key(seed)
    ks = jax.random.split(key, 32)
    f32 = jnp.float32

    def w(k, shape, fan_in):
        return jax.random.normal(k, (DEPTH,) + shape, f32) * (fan_in ** -0.5)

    def gain(k, n, depth=True):
        shape = (DEPTH, n) if depth else (n,)
        return 1.0 + 0.05 * jax.random.normal(k, shape, f32)

    x = jax.random.normal(ks[0], (BATCH, SEQ, D_MODEL), f32)
    mem = jax.random.normal(ks[1], (BATCH, N_MEM, D_MODEL), f32)
    offsets = jax.random.randint(ks[2], (BATCH, 1), 0, 1024, dtype=jnp.int32)
    positions = offsets + jnp.arange(SEQ, dtype=jnp.int32)[None, :]
    forget_bias = jnp.linspace(3.0, 6.0, N_MLSTM_HEADS, dtype=f32)
    zeros_h = jnp.zeros((N_MLSTM_HEADS,), f32)
    gate_base = jnp.concatenate([zeros_h, forget_bias, zeros_h, forget_bias])
    b_gates = gate_base[None] + 0.1 * jax.random.normal(ks[3], (DEPTH, N_GATE), f32)
    return {
        "x": x,
        "mem": mem,
        "positions": positions,
        "g_mix": gain(ks[4], D_MODEL),
        "w_in": w(ks[5], (D_MODEL, D_IN), D_MODEL),
        "b_gates": b_gates,
        "conv_qk": w(ks[6], (CONV_WIDTH, 2 * D_MLSTM), CONV_WIDTH),
        "g_q_a": gain(ks[7], Q_LORA_RANK),
        "w_q_b": w(ks[8], (Q_LORA_RANK, N_MLA_HEADS * MLA_QK_DIM), Q_LORA_RANK),
        "g_kv_a": gain(ks[9], KV_LORA_RANK),
        "w_kv_b": w(ks[10], (KV_LORA_RANK, N_MLA_HEADS * (MLA_NOPE_DIM + MLA_V_DIM)), KV_LORA_RANK),
        "g_head_mlstm": gain(ks[11], D_MLSTM),
        "g_head_mla": gain(ks[12], D_MLA),
        "w_out": w(ks[13], (D_MIX, D_MODEL), D_MIX),
        "g_mem_x": gain(ks[14], D_MODEL),
        "g_mem_kv": gain(ks[15], D_MODEL),
        "w_mem_q": w(ks[16], (D_MODEL, D_MEM_INNER), D_MODEL),
        "w_mem_k": w(ks[17], (D_MODEL, D_MEM_INNER), D_MODEL),
        "w_mem_v": w(ks[18], (D_MODEL, D_MEM_INNER), D_MODEL),
        "w_mem_o": w(ks[19], (D_MEM_INNER, D_MODEL), D_MEM_INNER),
        "g_ffn": gain(ks[20], D_MODEL),
        "w_router": w(ks[21], (D_MODEL, N_EXPERTS), D_MODEL),
        "w_exp_gate": w(ks[22], (N_EXPERTS, D_MODEL, D_FF_EXPERT), D_MODEL),
        "w_exp_up": w(ks[23], (N_EXPERTS, D_MODEL, D_FF_EXPERT), D_MODEL),
        "w_exp_down": w(ks[24], (N_EXPERTS, D_FF_EXPERT, D_MODEL), D_FF_EXPERT),
        "g_final": gain(ks[25], D_MODEL, depth=False),
    }


def reference(x, mem, positions, g_mix, w_in, b_gates, conv_qk, g_q_a, w_q_b, g_kv_a, w_kv_b,
              g_head_mlstm, g_head_mla, w_out, g_mem_x, g_mem_kv, w_mem_q, w_mem_k, w_mem_v, w_mem_o,
              g_ffn, w_router, w_exp_gate, w_exp_up, w_exp_down, g_final):
    cos, sin = rope_tables(positions)
    for l in range(DEPTH):
        x = x + hybrid_mixer(rmsnorm(x, g_mix[l]), cos, sin, w_in[l], b_gates[l], conv_qk[l],
                             g_q_a[l], w_q_b[l], g_kv_a[l], w_kv_b[l],
                             g_head_mlstm[l], g_head_mla[l], w_out[l])
        x = x + memory_cross_attention(rmsnorm(x, g_mem_x[l]), rmsnorm(mem, g_mem_kv[l]),
                                       w_mem_q[l], w_mem_k[l], w_mem_v[l], w_mem_o[l])
        x = x + expert_choice_ffn(rmsnorm(x, g_ffn[l]), w_router[l], w_exp_gate[l], w_exp_up[l], w_exp_down[l])
    return rmsnorm(x, g_final)
```

```cpp
#include <hip/hip_runtime.h>
#include <cstdint>
#include <cstdio>

constexpr int BATCH = 4, SEQ = 4096, DM = 1024, MTOK = BATCH * SEQ;
constexpr int D_IN = 2480;
constexpr int OFF_QM = 0, OFF_KM = 512, OFF_VM = 1024, OFF_OM = 1536, OFF_G = 2048, OFF_CQ = 2064, OFF_CKV = 2320, OFF_KR = 2448;
constexpr int NEXP = 16, CAP = 512, DFF = 2048, NMEM = 256;
constexpr size_t MiB = 1u << 20;
enum { I_X = 0, I_MEM, I_POS, I_GMIX, I_WIN, I_BG, I_CONV, I_GQA, I_WQB, I_GKVA, I_WKVB, I_GHM, I_GHA, I_WOUT, I_GMX, I_GMKV, I_WMQ, I_WMK, I_WMV, I_WMO, I_GFFN, I_WR, I_WEG, I_WEU, I_WED, I_GFIN };
namespace nv {
struct NG { const float* A; long lda; long sAz; const int* aidx; long aidx_z; const float* B; long ldb; long sBz; long M, N, K; };

struct EStore { float* C; long ldc; long sCz; __device__ void operator()(int z, int m, int n, float v) const { C[z * sCz + (long)m * ldc + n] = v; } };
struct EResid { const float* R; float* C; long ld; __device__ void operator()(int z, int m, int n, float v) const { C[(long)m * ld + n] = R[(long)m * ld + n] + v; } };
struct ESiluMul { float* C; long ldc; long sCz; __device__ void operator()(int z, int m, int n, float v) const { float* p = C + z * sCz + (long)m * ldc + n; float g = *p; *p = g / (1.f + __expf(-g)) * v; } };
struct EScatter { float* acc; const int* rowsel; const float* gsel; __device__ void operator()(int z, int m, int n, float v) const { int r = rowsel[z * 2048 + m]; atomicAdd(&acc[(long)r * 1024 + n], v * gsel[z * 2048 + m]); } };

template <class Epi> __global__ __launch_bounds__(256) void ngemm(NG g, Epi epi) {
  __shared__ float As[16][65];
  __shared__ float Bs[16][64];
  const int z = blockIdx.z, m0 = blockIdx.y * 64, n0 = blockIdx.x * 64, tid = threadIdx.x, tx = tid & 15, ty = tid >> 4;
  const float* A = g.A + z * g.sAz; const float* B = g.B + z * g.sBz;
  float acc[4][4];
#pragma unroll
  for (int i = 0; i < 4; ++i)
#pragma unroll
    for (int j = 0; j < 4; ++j) acc[i][j] = 0.f;
  const int ar = tid >> 2, ak = (tid & 3) * 4;
  const long arow = g.aidx ? (long)g.aidx[z * g.aidx_z + m0 + ar] : (long)(m0 + ar);
  const float* Ap = A + arow * g.lda + ak;
  const int bk = tid >> 4, bn = (tid & 15) * 4; const int NN = (int)g.N, KK = (int)g.K;
  for (int k0 = 0; k0 < KK; k0 += 16) {
    const float4 av = *(const float4*)(Ap + k0);
    float4 bv = make_float4(0.f, 0.f, 0.f, 0.f);
    if (n0 + bn < NN) bv = *(const float4*)(B + (long)(k0 + bk) * g.ldb + n0 + bn);
    As[ak + 0][ar] = av.x; As[ak + 1][ar] = av.y; As[ak + 2][ar] = av.z; As[ak + 3][ar] = av.w;
    *(float4*)&Bs[bk][bn] = bv;
    __syncthreads();
#pragma unroll
    for (int kk = 0; kk < 16; ++kk) {
      float a[4]; const float4 b = *(const float4*)&Bs[kk][tx * 4];
#pragma unroll
      for (int i = 0; i < 4; ++i) a[i] = As[kk][ty * 4 + i];
#pragma unroll
      for (int i = 0; i < 4; ++i) { acc[i][0] += a[i] * b.x; acc[i][1] += a[i] * b.y; acc[i][2] += a[i] * b.z; acc[i][3] += a[i] * b.w; }
    }
    __syncthreads();
  }
#pragma unroll
  for (int i = 0; i < 4; ++i)
#pragma unroll
    for (int j = 0; j < 4; ++j) { const int m = m0 + ty * 4 + i, n = n0 + tx * 4 + j; if (n < NN) epi(z, m, n, acc[i][j]); }
}
template <class Epi> void gemm(hipStream_t s, const float* A, int lda, const float* B, int ldb, int M, int N, int K, Epi e, int Z = 1, long sAz = 0, long sBz = 0, const int* aidx = nullptr, int aidx_z = 0) {
  NG g{A, lda, sAz, aidx, aidx_z, B, ldb, sBz, M, N, K};
  hipLaunchKernelGGL(ngemm<Epi>, dim3((N + 63) / 64, M / 64, Z), dim3(256), 0, s, g, e);
}

__global__ __launch_bounds__(256) void rmsnorm_rows(const float* in, long ldi, const float* g, float* out, long ldo, long M, long n_) {
  const int n = (int)n_;
  const int row = blockIdx.x * 4 + (threadIdx.x >> 6), lane = threadIdx.x & 63; if (row >= M) return;
  const float* p = in + (long)row * ldi; float s = 0.f;
  for (int i = lane; i < n; i += 64) s += p[i] * p[i];
  for (int o = 32; o > 0; o >>= 1) s += __shfl_xor(s, o);
  const float r = rsqrtf(s / n + 1e-6f);
  for (int i = lane; i < n; i += 64) out[(long)row * ldo + i] = p[i] * r * g[i];
}
__global__ __launch_bounds__(256) void headnorm_rows(const float* a, const float* b, long ld, long H_, long d_, const float* g, const float* gatein, long ldg, float* out, long ldo, long M) {
  const int H = (int)H_, d = (int)d_;
  const int w = blockIdx.x * 4 + (threadIdx.x >> 6), lane = threadIdx.x & 63; if (w >= M * H) return;
  const int row = w / H, h = w % H; float s = 0.f;
  for (int i = lane; i < d; i += 64) { float v = a[(long)row * ld + h * d + i]; if (b) v += b[(long)row * ld + h * d + i]; s += v * v; }
  for (int o = 32; o > 0; o >>= 1) s += __shfl_xor(s, o);
  const float r = rsqrtf(s / d + 1e-6f);
  for (int i = lane; i < d; i += 64) { float v = a[(long)row * ld + h * d + i]; if (b) v += b[(long)row * ld + h * d + i]; v = v * r * g[h * d + i];
    if (gatein) { const float o_ = gatein[(long)row * ldg + h * d + i]; v *= 1.f / (1.f + __expf(-o_)); } out[(long)row * ldo + h * d + i] = v; }
}
__global__ __launch_bounds__(256) void conv_silu(const float* proj, const float* cw, float* q, float* k) {
  const long i = blockIdx.x * 256L + threadIdx.x; if (i >= (long)MTOK * 1024) return;
  const int c = (int)(i % 1024); const long m = i / 1024; const int t = (int)(m % SEQ);
  float v = proj[m * D_IN + c] * cw[1024 + c];
  if (t > 0) v += proj[(m - 1) * D_IN + c] * cw[c];
  if (t < SEQ - 1) v += proj[(m + 1) * D_IN + c] * cw[2048 + c];
  v = v / (1.f + __expf(-v));
  if (c < 512) q[m * 512 + c] = v; else k[m * 512 + c - 512] = v * 0.08838834764831845f;
}
__global__ __launch_bounds__(256) void mlstm_naive(const float* q, const float* k, const float* proj, const float* bg, float* hf, float* hb) {
  __shared__ float sq[128], sk[128], red[4][64], dred[4], sden;
  const int sid = blockIdx.x >> 1, es = blockIdx.x & 1, dir = sid & 1, h = (sid >> 1) & 3, b = sid >> 3;
  const int tid = threadIdx.x, e = tid & 63, dq = tid >> 6, ecol = es * 64 + e;
  float C[32];
#pragma unroll
  for (int i = 0; i < 32; ++i) C[i] = 0.f;
  float nn = 0.f, m = 0.f;
  const int gi = (dir ? 8 : 0) + h, gf = (dir ? 12 : 4) + h;
  float* out = dir ? hb : hf;
  for (int st = 0; st < SEQ; ++st) {
    const int t = dir ? (SEQ - 1 - st) : st; const long row = (long)b * SEQ + t;
    if (tid < 128) { sq[tid] = q[row * 512 + h * 128 + tid]; sk[tid] = k[row * 512 + h * 128 + tid]; }
    const float v_e = proj[row * D_IN + OFF_VM + h * 128 + ecol];
    const float li = proj[row * D_IN + OFF_G + gi] + bg[gi];
    const float fr = proj[row * D_IN + OFF_G + gf] + bg[gf];
    const float lf = fminf(fr, 0.f) - log1pf(__expf(-fabsf(fr)));
    const float mn = fmaxf(lf + m, li), ip = __expf(li - mn), fp = __expf(lf + m - mn); m = mn;
    __syncthreads();
    float part = 0.f;
#pragma unroll
    for (int i = 0; i < 32; ++i) { C[i] = fp * C[i] + ip * sk[dq * 32 + i] * v_e; part += sq[dq * 32 + i] * C[i]; }
    red[dq][e] = part;
    if (tid < 128) { nn = fp * nn + ip * sk[tid]; float dp = sq[tid] * nn; for (int o = 32; o > 0; o >>= 1) dp += __shfl_xor(dp, o); if ((tid & 63) == 0) dred[tid >> 6] = dp; }
    __syncthreads();
    if (tid < 64) { const float num = red[0][tid] + red[1][tid] + red[2][tid] + red[3][tid]; const float den = dred[0] + dred[1];
      out[row * 512 + h * 128 + es * 64 + tid] = num / fmaxf(fabsf(den), __expf(-m)); }
  }
}
__global__ __launch_bounds__(256) void rope_naive(float* q, const float* proj, const int* pos, float* kr) {
  const long i = blockIdx.x * 256L + threadIdx.x; if (i >= (long)MTOK * 9 * 16) return;
  const int j = (int)(i % 16), hh = (int)((i / 16) % 9); const long m = i / (16 * 9);
  const float inv = powf(10000.f, -(float)j / 16.f); const float ang = (float)pos[m] * inv; const float c = cosf(ang), s = sinf(ang);
  if (hh < 8) { float* p = q + m * 768 + hh * 96 + 64; const float t1 = p[j], t2 = p[j + 16]; p[j] = t1 * c - t2 * s; p[j + 16] = t2 * c + t1 * s; }
  else { const float* p = proj + m * D_IN + OFF_KR; const float t1 = p[j], t2 = p[j + 16]; kr[m * 32 + j] = t1 * c - t2 * s; kr[m * 32 + j + 16] = t2 * c + t1 * s; }
}
__global__ __launch_bounds__(256) void mla_attn_naive(const float* q, const float* kv, const float* kr, float* o) {
  const int qt = blockIdx.x * 256 + threadIdx.x, h = blockIdx.y, b = blockIdx.z; const long row = (long)b * SEQ + qt;
  float qq[96], oo[64];
#pragma unroll
  for (int i = 0; i < 96; ++i) qq[i] = q[row * 768 + h * 96 + i] * 0.10206207261596575f;
#pragma unroll
  for (int i = 0; i < 64; ++i) oo[i] = 0.f;
  float mx = -1e30f, l = 0.f;
  for (int s = 0; s < SEQ; ++s) {
    const float* kp = kv + ((long)b * SEQ + s) * 1024 + h * 128; const float* rp = kr + ((long)b * SEQ + s) * 32; float sc = 0.f;
#pragma unroll
    for (int i = 0; i < 64; ++i) sc += qq[i] * kp[i];
#pragma unroll
    for (int i = 0; i < 32; ++i) sc += qq[64 + i] * rp[i];
    const float mn = fmaxf(mx, sc), al = __expf(mx - mn), p = __expf(sc - mn); mx = mn; l = l * al + p;
#pragma unroll
    for (int i = 0; i < 64; ++i) oo[i] = oo[i] * al + p * kp[64 + i];
  }
  const float rl = 1.f / l;
#pragma unroll
  for (int i = 0; i < 64; ++i) o[row * 512 + h * 64 + i] = oo[i] * rl;
}
__global__ __launch_bounds__(256) void memattn_naive(const float* qm, const float* km, const float* vm, float* o) {
  __shared__ float sq[1024], sp[4][256];
  const long row = blockIdx.x; const int b = (int)(row / SEQ), h = threadIdx.x >> 6, lane = threadIdx.x & 63;
  for (int i = threadIdx.x; i < 1024; i += 256) sq[i] = qm[row * 1024 + i];
  __syncthreads();
  float sc[4]; float mx = -1e30f;
#pragma unroll
  for (int jj = 0; jj < 4; ++jj) { const int j = lane + 64 * jj; const float* kp = km + ((long)b * 256 + j) * 1024 + h * 256; float d = 0.f;
    for (int i = 0; i < 256; ++i) d += sq[h * 256 + i] * kp[i]; sc[jj] = d * 0.0625f; mx = fmaxf(mx, sc[jj]); }
  for (int o_ = 32; o_ > 0; o_ >>= 1) mx = fmaxf(mx, __shfl_xor(mx, o_));
  float l = 0.f;
#pragma unroll
  for (int jj = 0; jj < 4; ++jj) { sc[jj] = __expf(sc[jj] - mx); l += sc[jj]; }
  for (int o_ = 32; o_ > 0; o_ >>= 1) l += __shfl_xor(l, o_);
#pragma unroll
  for (int jj = 0; jj < 4; ++jj) sp[h][lane + 64 * jj] = sc[jj] / l;
  __syncthreads();
#pragma unroll
  for (int dd = 0; dd < 4; ++dd) { const int d = lane + 64 * dd; float a = 0.f;
    for (int j = 0; j < 256; ++j) a += sp[h][j] * vm[((long)b * 256 + j) * 1024 + h * 256 + d];
    o[row * 1024 + h * 256 + d] = a; }
}
__global__ __launch_bounds__(256) void router_naive(const float* h2, const float* wr, float* aff) {
  const int row = blockIdx.x * 4 + (threadIdx.x >> 6), lane = threadIdx.x & 63;
  float acc[16];
#pragma unroll
  for (int e = 0; e < 16; ++e) acc[e] = 0.f;
  for (int i = lane; i < 1024; i += 64) { const float x = h2[(long)row * 1024 + i];
#pragma unroll
    for (int e = 0; e < 16; ++e) acc[e] += x * wr[i * 16 + e]; }
#pragma unroll
  for (int e = 0; e < 16; ++e) for (int o = 32; o > 0; o >>= 1) acc[e] += __shfl_xor(acc[e], o);
  float mx = acc[0];
#pragma unroll
  for (int e = 1; e < 16; ++e) mx = fmaxf(mx, acc[e]);
  float l = 0.f;
#pragma unroll
  for (int e = 0; e < 16; ++e) { acc[e] = __expf(acc[e] - mx); l += acc[e]; }
  if (lane < 16) { float v = 0.f;
#pragma unroll
    for (int e = 0; e < 16; ++e) if (e == lane) v = acc[e];
    aff[(long)row * 16 + lane] = v / l; }
}
__global__ __launch_bounds__(256) void topk_naive(const float* aff, int* rowsel, float* gsel) {
  __shared__ float sv[SEQ];
  const int b = blockIdx.x / 16, e = blockIdx.x % 16;
  for (int t = threadIdx.x; t < SEQ; t += 256) sv[t] = aff[((long)b * SEQ + t) * 16 + e];
  __syncthreads();
  for (int t = threadIdx.x; t < SEQ; t += 256) { const float v = sv[t]; int rank = 0;
    for (int u = 0; u < SEQ; ++u) { const float w = sv[u]; rank += (w > v || (w == v && u < t)) ? 1 : 0; }
    if (rank < CAP) { rowsel[e * 2048 + b * 512 + rank] = b * SEQ + t; gsel[e * 2048 + b * 512 + rank] = v; } }
}
__global__ __launch_bounds__(256) void add_rows(const float* a, const float* b, float* o, long n) { const long i = blockIdx.x * 256L + threadIdx.x; if (i < n) o[i] = a[i] + b[i]; }
}
extern "C" void kernel_launch(void* const* d_in, const int* in_sizes, int n_in, void* d_out, int out_size, void* d_ws, size_t ws_size, hipStream_t s) {
  using namespace nv;
  auto F = [&](int i) { return (const float*)d_in[i]; };
  char* ws = (char*)d_ws;
  auto W = [&](size_t mb) { return (float*)(ws + mb * MiB); };
  const float* x = F(I_X);
  float* out = (float*)d_out;
  const int M = MTOK;
  float* hn = W(160);
  hipLaunchKernelGGL(rmsnorm_rows, dim3(M / 4), dim3(256), 0, s, x, 1024, F(I_GMIX), hn, 1024, M, 1024);
  float* proj = W(0);
  gemm(s, hn, 1024, F(I_WIN), D_IN, M, D_IN, 1024, EStore{proj, D_IN, 0});
  float* q = W(224); float* k = W(256);
  hipLaunchKernelGGL(conv_silu, dim3((unsigned)(((long)M * 1024 + 255) / 256)), dim3(256), 0, s, proj, F(I_CONV), q, k);
  float* hf = W(288); float* hb = W(320);
  hipLaunchKernelGGL(mlstm_naive, dim3(64), dim3(256), 0, s, q, k, proj, F(I_BG), hf, hb);
  float* y = W(160);
  hipLaunchKernelGGL(headnorm_rows, dim3(M * 4 / 4), dim3(256), 0, s, hf, hb, 512, 4, 128, F(I_GHM), proj + OFF_OM, D_IN, y, 1024, M);
  float* cqn = W(352); float* ckvn = W(368); float* qmla = W(376); float* kvm = W(424); float* kr = W(488);
  hipLaunchKernelGGL(rmsnorm_rows, dim3(M / 4), dim3(256), 0, s, proj + OFF_CQ, D_IN, F(I_GQA), cqn, 256, M, 256);
  hipLaunchKernelGGL(rmsnorm_rows, dim3(M / 4), dim3(256), 0, s, proj + OFF_CKV, D_IN, F(I_GKVA), ckvn, 128, M, 128);
  gemm(s, cqn, 256, F(I_WQB), 768, M, 768, 256, EStore{qmla, 768, 0});
  gemm(s, ckvn, 128, F(I_WKVB), 1024, M, 1024, 128, EStore{kvm, 1024, 0});
  hipLaunchKernelGGL(rope_naive, dim3((unsigned)(((long)M * 144 + 255) / 256)), dim3(256), 0, s, qmla, proj, (const int*)d_in[I_POS], kr);
  float* att = W(224);
  hipLaunchKernelGGL(mla_attn_naive, dim3(SEQ / 256, 8, BATCH), dim3(256), 0, s, qmla, kvm, kr, att);
  hipLaunchKernelGGL(headnorm_rows, dim3(M * 8 / 4), dim3(256), 0, s, att, (const float*)nullptr, 512, 8, 64, F(I_GHA), (const float*)nullptr, 0, y + 512, 1024, M);
  float* x1 = W(256);
  gemm(s, y, 1024, F(I_WOUT), 1024, M, 1024, 1024, EResid{x, x1, 1024});
  float* h1 = W(0); float* qm = W(64); float* memn = W(128); float* km = W(132); float* vm = W(136);
  hipLaunchKernelGGL(rmsnorm_rows, dim3(M / 4), dim3(256), 0, s, x1, 1024, F(I_GMX), h1, 1024, M, 1024);
  gemm(s, h1, 1024, F(I_WMQ), 1024, M, 1024, 1024, EStore{qm, 1024, 0});
  hipLaunchKernelGGL(rmsnorm_rows, dim3(1024 / 4), dim3(256), 0, s, F(I_MEM), 1024, F(I_GMKV), memn, 1024, 1024, 1024);
  gemm(s, memn, 1024, F(I_WMK), 1024, 1024, 1024, 1024, EStore{km, 1024, 0});
  gemm(s, memn, 1024, F(I_WMV), 1024, 1024, 1024, 1024, EStore{vm, 1024, 0});
  float* mo = W(160);
  hipLaunchKernelGGL(memattn_naive, dim3(M), dim3(256), 0, s, qm, km, vm, mo);
  float* x2 = W(320);
  gemm(s, mo, 1024, F(I_WMO), 1024, M, 1024, 1024, EResid{x1, x2, 1024});
  float* h2 = W(0); float* aff = W(64); int* rowsel = (int*)W(65); float* gsel = W(66);
  hipLaunchKernelGGL(rmsnorm_rows, dim3(M / 4), dim3(256), 0, s, x2, 1024, F(I_GFFN), h2, 1024, M, 1024);
  hipLaunchKernelGGL(router_naive, dim3(M / 4), dim3(256), 0, s, h2, F(I_WR), aff);
  hipLaunchKernelGGL(topk_naive, dim3(64), dim3(256), 0, s, aff, rowsel, gsel);
  float* acc = W(160); float* hid = W(384);
  (void)hipMemsetAsync(acc, 0, (size_t)M * 1024 * 4, s);
  for (int g = 0; g < 4; ++g) {
    const long wo = (long)g * 4 * 1024 * 2048;
    gemm(s, h2, 1024, F(I_WEG) + wo, 2048, 2048, 2048, 1024, EStore{hid, 2048, 2048L * 2048}, 4, 0, 1024L * 2048, rowsel + g * 4 * 2048, 2048);
    gemm(s, h2, 1024, F(I_WEU) + wo, 2048, 2048, 2048, 1024, ESiluMul{hid, 2048, 2048L * 2048}, 4, 0, 1024L * 2048, rowsel + g * 4 * 2048, 2048);
    gemm(s, hid, 2048, F(I_WED) + wo, 1024, 2048, 1024, 2048, EScatter{acc, rowsel + g * 4 * 2048, gsel + g * 4 * 2048}, 4, 2048L * 2048, 2048L * 1024);
  }
  float* x3 = W(256);
  hipLaunchKernelGGL(add_rows, dim3((unsigned)(((long)M * 1024 + 255) / 256)), dim3(256), 0, s, x2, acc, x3, (long)M * 1024);
  hipLaunchKernelGGL(rmsnorm_rows, dim3(M / 4), dim3(256), 0, s, x3, 1024, F(I_GFIN), out, 1024, M, 1024);
}
```

```cpp
#include <hip/hip_runtime.h>
#include <cstdint>
#include <cstdio>
#include <cstring>

constexpr int BATCH = 4, SEQ = 4096, DM = 1024, MTOK = BATCH * SEQ;
constexpr int D_IN = 2480;
constexpr int OFF_QM = 0, OFF_KM = 512, OFF_VM = 1024, OFF_OM = 1536, OFF_G = 2048, OFF_CQ = 2064, OFF_CKV = 2320, OFF_KR = 2448;
constexpr int NEXP = 16, CAP = 512, DFF = 2048, NMEM = 256;
constexpr size_t MiB = 1u << 20;
enum { I_X = 0, I_MEM, I_POS, I_GMIX, I_WIN, I_BG, I_CONV, I_GQA, I_WQB, I_GKVA, I_WKVB, I_GHM, I_GHA, I_WOUT, I_GMX, I_GMKV, I_WMQ, I_WMK, I_WMV, I_WMO, I_GFFN, I_WR, I_WEG, I_WEU, I_WED, I_GFIN };
namespace nv {
struct NG { const float* A; long lda; long sAz; const int* aidx; long aidx_z; const float* B; long ldb; long sBz; long M, N, K; };

struct EStore { float* C; long ldc; long sCz; __device__ void operator()(int z, int m, int n, float v) const { C[z * sCz + (long)m * ldc + n] = v; } };
struct EResid { const float* R; float* C; long ld; __device__ void operator()(int z, int m, int n, float v) const { C[(long)m * ld + n] = R[(long)m * ld + n] + v; } };
struct ESiluMul { float* C; long ldc; long sCz; __device__ void operator()(int z, int m, int n, float v) const { float* p = C + z * sCz + (long)m * ldc + n; float g = *p; *p = g / (1.f + __expf(-g)) * v; } };
struct EScatter { float* acc; const int* rowsel; const float* gsel; __device__ void operator()(int z, int m, int n, float v) const { int r = rowsel[z * 512 + m]; atomicAdd(&acc[(long)r * 1024 + n], v * gsel[z * 512 + m]); } };

template <class Epi> __global__ __launch_bounds__(256) void ngemm(NG g, Epi epi) {
  __shared__ float As[16][65];
  __shared__ float Bs[16][64];
  const int z = blockIdx.z, m0 = blockIdx.y * 64, n0 = blockIdx.x * 64, tid = threadIdx.x, tx = tid & 15, ty = tid >> 4;
  const float* A = g.A + z * g.sAz; const float* B = g.B + z * g.sBz;
  float acc[4][4];
#pragma unroll
  for (int i = 0; i < 4; ++i)
#pragma unroll
    for (int j = 0; j < 4; ++j) acc[i][j] = 0.f;
  const int ar = tid >> 2, ak = (tid & 3) * 4;
  const long arow = g.aidx ? (long)g.aidx[z * g.aidx_z + m0 + ar] : (long)(m0 + ar);
  const float* Ap = A + arow * g.lda + ak;
  const int bk = tid >> 4, bn = (tid & 15) * 4; const int NN = (int)g.N, KK = (int)g.K;
  for (int k0 = 0; k0 < KK; k0 += 16) {
    const float4 av = *(const float4*)(Ap + k0);
    float4 bv = make_float4(0.f, 0.f, 0.f, 0.f);
    if (n0 + bn < NN) bv = *(const float4*)(B + (long)(k0 + bk) * g.ldb + n0 + bn);
    As[ak + 0][ar] = av.x; As[ak + 1][ar] = av.y; As[ak + 2][ar] = av.z; As[ak + 3][ar] = av.w;
    *(float4*)&Bs[bk][bn] = bv;
    __syncthreads();
#pragma unroll
    for (int kk = 0; kk < 16; ++kk) {
      float a[4]; const float4 b = *(const float4*)&Bs[kk][tx * 4];
#pragma unroll
      for (int i = 0; i < 4; ++i) a[i] = As[kk][ty * 4 + i];
#pragma unroll
      for (int i = 0; i < 4; ++i) { acc[i][0] += a[i] * b.x; acc[i][1] += a[i] * b.y; acc[i][2] += a[i] * b.z; acc[i][3] += a[i] * b.w; }
    }
    __syncthreads();
  }
#pragma unroll
  for (int i = 0; i < 4; ++i)
#pragma unroll
    for (int j = 0; j < 4; ++j) { const int m = m0 + ty * 4 + i, n = n0 + tx * 4 + j; if (n < NN) epi(z, m, n, acc[i][j]); }
}
template <class Epi> void gemm(hipStream_t s, const float* A, int lda, const float* B, int ldb, int M, int N, int K, Epi e, int Z = 1, long sAz = 0, long sBz = 0, const int* aidx = nullptr, int aidx_z = 0) {
  NG g{A, lda, sAz, aidx, aidx_z, B, ldb, sBz, M, N, K};
  hipLaunchKernelGGL(ngemm<Epi>, dim3((N + 63) / 64, M / 64, Z), dim3(256), 0, s, g, e);
}

__global__ __launch_bounds__(256) void rmsnorm_rows(const float* in, long ldi, const float* g, float* out, long ldo, long M, long n_) {
  const int n = (int)n_;
  const int row = blockIdx.x * 4 + (threadIdx.x >> 6), lane = threadIdx.x & 63; if (row >= M) return;
  const float* p = in + (long)row * ldi; float s = 0.f;
  for (int i = lane; i < n; i += 64) s += p[i] * p[i];
  for (int o = 32; o > 0; o >>= 1) s += __shfl_xor(s, o);
  const float r = rsqrtf(s / n + 1e-6f);
  for (int i = lane; i < n; i += 64) out[(long)row * ldo + i] = p[i] * r * g[i];
}
__global__ __launch_bounds__(256) void headnorm_rows(const float* a, const float* b, long ld, long H_, long d_, const float* g, const float* gatein, long ldg, float* out, long ldo, long M) {
  const int H = (int)H_, d = (int)d_;
  const int w = blockIdx.x * 4 + (threadIdx.x >> 6), lane = threadIdx.x & 63; if (w >= M * H) return;
  const int row = w / H, h = w % H; float s = 0.f;
  for (int i = lane; i < d; i += 64) { float v = a[(long)row * ld + h * d + i]; if (b) v += b[(long)row * ld + h * d + i]; s += v * v; }
  for (int o = 32; o > 0; o >>= 1) s += __shfl_xor(s, o);
  const float r = rsqrtf(s / d + 1e-6f);
  for (int i = lane; i < d; i += 64) { float v = a[(long)row * ld + h * d + i]; if (b) v += b[(long)row * ld + h * d + i]; v = v * r * g[h * d + i];
    if (gatein) { const float o_ = gatein[(long)row * ldg + h * d + i]; v *= 1.f / (1.f + __expf(-o_)); } out[(long)row * ldo + h * d + i] = v; }
}
__global__ __launch_bounds__(256) void conv_silu(const float* proj, const float* cw, float* q, float* k) {
  const long i = blockIdx.x * 256L + threadIdx.x; if (i >= (long)SEQ * 1024) return;
  const int c = (int)(i % 1024); const long m = i / 1024; const int t = (int)(m % SEQ);
  float v = proj[m * D_IN + c] * cw[1024 + c];
  if (t > 0) v += proj[(m - 1) * D_IN + c] * cw[c];
  if (t < SEQ - 1) v += proj[(m + 1) * D_IN + c] * cw[2048 + c];
  v = v / (1.f + __expf(-v));
  if (c < 512) q[m * 512 + c] = v; else k[m * 512 + c - 512] = v * 0.08838834764831845f;
}
__global__ __launch_bounds__(256) void mlstm_naive(const float* q, const float* k, const float* proj, const float* bg, float* hf, float* hb) {
  __shared__ float sq[128], sk[128], red[4][64], dred[4], sden;
  const int sid = blockIdx.x >> 1, es = blockIdx.x & 1, dir = sid & 1, h = (sid >> 1) & 3, b = 0;
  const int tid = threadIdx.x, e = tid & 63, dq = tid >> 6, ecol = es * 64 + e;
  float C[32];
#pragma unroll
  for (int i = 0; i < 32; ++i) C[i] = 0.f;
  float nn = 0.f, m = 0.f;
  const int gi = (dir ? 8 : 0) + h, gf = (dir ? 12 : 4) + h;
  float* out = dir ? hb : hf;
  for (int st = 0; st < SEQ; ++st) {
    const int t = dir ? (SEQ - 1 - st) : st; const long row = (long)b * SEQ + t;
    if (tid < 128) { sq[tid] = q[row * 512 + h * 128 + tid]; sk[tid] = k[row * 512 + h * 128 + tid]; }
    const float v_e = proj[row * D_IN + OFF_VM + h * 128 + ecol];
    const float li = proj[row * D_IN + OFF_G + gi] + bg[gi];
    const float fr = proj[row * D_IN + OFF_G + gf] + bg[gf];
    const float lf = fminf(fr, 0.f) - log1pf(__expf(-fabsf(fr)));
    const float mn = fmaxf(lf + m, li), ip = __expf(li - mn), fp = __expf(lf + m - mn); m = mn;
    __syncthreads();
    float part = 0.f;
#pragma unroll
    for (int i = 0; i < 32; ++i) { C[i] = fp * C[i] + ip * sk[dq * 32 + i] * v_e; part += sq[dq * 32 + i] * C[i]; }
    red[dq][e] = part;
    if (tid < 128) { nn = fp * nn + ip * sk[tid]; float dp = sq[tid] * nn; for (int o = 32; o > 0; o >>= 1) dp += __shfl_xor(dp, o); if ((tid & 63) == 0) dred[tid >> 6] = dp; }
    __syncthreads();
    if (tid < 64) { const float num = red[0][tid] + red[1][tid] + red[2][tid] + red[3][tid]; const float den = dred[0] + dred[1];
      out[row * 512 + h * 128 + es * 64 + tid] = num / fmaxf(fabsf(den), __expf(-m)); }
  }
}
__global__ __launch_bounds__(256) void rope_naive(float* q, const float* proj, const int* pos, float* kr) {
  const long i = blockIdx.x * 256L + threadIdx.x; if (i >= (long)SEQ * 9 * 16) return;
  const int j = (int)(i % 16), hh = (int)((i / 16) % 9); const long m = i / (16 * 9);
  const float inv = powf(10000.f, -(float)j / 16.f); const float ang = (float)pos[m] * inv; const float c = cosf(ang), s = sinf(ang);
  if (hh < 8) { float* p = q + m * 768 + hh * 96 + 64; const float t1 = p[j], t2 = p[j + 16]; p[j] = t1 * c - t2 * s; p[j + 16] = t2 * c + t1 * s; }
  else { const float* p = proj + m * D_IN + OFF_KR; const float t1 = p[j], t2 = p[j + 16]; kr[m * 32 + j] = t1 * c - t2 * s; kr[m * 32 + j + 16] = t2 * c + t1 * s; }
}
__global__ __launch_bounds__(256) void mla_attn_naive(const float* q, const float* kv, const float* kr, float* o) {
  const int qt = blockIdx.x * 256 + threadIdx.x, h = blockIdx.y, b = 0; const long row = (long)b * SEQ + qt;
  float qq[96], oo[64];
#pragma unroll
  for (int i = 0; i < 96; ++i) qq[i] = q[row * 768 + h * 96 + i] * 0.10206207261596575f;
#pragma unroll
  for (int i = 0; i < 64; ++i) oo[i] = 0.f;
  float mx = -1e30f, l = 0.f;
  for (int s = 0; s < SEQ; ++s) {
    const float* kp = kv + ((long)b * SEQ + s) * 1024 + h * 128; const float* rp = kr + ((long)b * SEQ + s) * 32; float sc = 0.f;
#pragma unroll
    for (int i = 0; i < 64; ++i) sc += qq[i] * kp[i];
#pragma unroll
    for (int i = 0; i < 32; ++i) sc += qq[64 + i] * rp[i];
    const float mn = fmaxf(mx, sc), al = __expf(mx - mn), p = __expf(sc - mn); mx = mn; l = l * al + p;
#pragma unroll
    for (int i = 0; i < 64; ++i) oo[i] = oo[i] * al + p * kp[64 + i];
  }
  const float rl = 1.f / l;
#pragma unroll
  for (int i = 0; i < 64; ++i) o[row * 512 + h * 64 + i] = oo[i] * rl;
}
__global__ __launch_bounds__(256) void memattn_naive(const float* qm, const float* km, const float* vm, float* o) {
  __shared__ float sq[1024], sp[4][256];
  const long row = blockIdx.x; const int b = 0, h = threadIdx.x >> 6, lane = threadIdx.x & 63;
  for (int i = threadIdx.x; i < 1024; i += 256) sq[i] = qm[row * 1024 + i];
  __syncthreads();
  float sc[4]; float mx = -1e30f;
#pragma unroll
  for (int jj = 0; jj < 4; ++jj) { const int j = lane + 64 * jj; const float* kp = km + ((long)b * 256 + j) * 1024 + h * 256; float d = 0.f;
    for (int i = 0; i < 256; ++i) d += sq[h * 256 + i] * kp[i]; sc[jj] = d * 0.0625f; mx = fmaxf(mx, sc[jj]); }
  for (int o_ = 32; o_ > 0; o_ >>= 1) mx = fmaxf(mx, __shfl_xor(mx, o_));
  float l = 0.f;
#pragma unroll
  for (int jj = 0; jj < 4; ++jj) { sc[jj] = __expf(sc[jj] - mx); l += sc[jj]; }
  for (int o_ = 32; o_ > 0; o_ >>= 1) l += __shfl_xor(l, o_);
#pragma unroll
  for (int jj = 0; jj < 4; ++jj) sp[h][lane + 64 * jj] = sc[jj] / l;
  __syncthreads();
#pragma unroll
  for (int dd = 0; dd < 4; ++dd) { const int d = lane + 64 * dd; float a = 0.f;
    for (int j = 0; j < 256; ++j) a += sp[h][j] * vm[((long)b * 256 + j) * 1024 + h * 256 + d];
    o[row * 1024 + h * 256 + d] = a; }
}
__global__ __launch_bounds__(256) void router_naive(const float* h2, const float* wr, float* aff) {
  const int row = blockIdx.x * 4 + (threadIdx.x >> 6), lane = threadIdx.x & 63;
  float acc[16];
#pragma unroll
  for (int e = 0; e < 16; ++e) acc[e] = 0.f;
  for (int i = lane; i < 1024; i += 64) { const float x = h2[(long)row * 1024 + i];
#pragma unroll
    for (int e = 0; e < 16; ++e) acc[e] += x * wr[i * 16 + e]; }
#pragma unroll
  for (int e = 0; e < 16; ++e) for (int o = 32; o > 0; o >>= 1) acc[e] += __shfl_xor(acc[e], o);
  float mx = acc[0];
#pragma unroll
  for (int e = 1; e < 16; ++e) mx = fmaxf(mx, acc[e]);
  float l = 0.f;
#pragma unroll
  for (int e = 0; e < 16; ++e) { acc[e] = __expf(acc[e] - mx); l += acc[e]; }
  if (lane < 16) { float v = 0.f;
#pragma unroll
    for (int e = 0; e < 16; ++e) if (e == lane) v = acc[e];
    aff[(long)row * 16 + lane] = v / l; }
}
__global__ __launch_bounds__(256) void topk_naive(const float* aff, int* rowsel, float* gsel) {
  __shared__ float sv[SEQ];
  const int e = blockIdx.x;
  for (int t = threadIdx.x; t < SEQ; t += 256) sv[t] = aff[(long)t * 16 + e];
  __syncthreads();
  for (int t = threadIdx.x; t < SEQ; t += 256) { const float v = sv[t]; int rank = 0;
    for (int u = 0; u < SEQ; ++u) { const float w = sv[u]; rank += (w > v || (w == v && u < t)) ? 1 : 0; }
    if (rank < CAP) { rowsel[e * 512 + rank] = t; gsel[e * 512 + rank] = v; } }
}
__global__ __launch_bounds__(256) void add_rows(const float* a, const float* b, float* o, long n) { const long i = blockIdx.x * 256L + threadIdx.x; if (i < n) o[i] = a[i] + b[i]; }
}
struct NB {
  float *hn, *proj, *q, *k, *hf, *hb, *y, *cqn, *ckvn, *qmla, *kvm, *kr, *att, *x1, *h1, *qm, *memn, *km, *vm, *mo, *x2, *aff, *gsel, *acc, *hid, *x3; int* rowsel;
  explicit NB(char* base) { auto W = [&](size_t mb) { return (float*)(base + mb * MiB); };
    hn = W(0); proj = W(16); q = W(56); k = W(64); hf = W(72); hb = W(80); y = W(88); cqn = W(104); ckvn = W(108); qmla = W(110); kvm = W(122); kr = W(138); att = W(139);
    x1 = W(147); h1 = W(163); qm = W(179); memn = W(195); km = W(196); vm = W(197); mo = W(198); x2 = W(214); aff = W(230); rowsel = (int*)W(231); gsel = (float*)((char*)W(231) + 65536);
    acc = W(179); hid = W(0); x3 = W(147); }
};
static void naive_run(hipStream_t s, int from, int b, void* const* d_in, float* out_all, const NB& n, const float* x1_ext = nullptr, const float* x2_ext = nullptr, bool skip_moe_gu = false, unsigned skip = 0u) {
  using namespace nv;
  auto F = [&](int i) { return (const float*)d_in[i]; };
  const int M = SEQ;
  const float* x = F(I_X) + (long)b * SEQ * 1024;
  float* out = out_all + (long)b * SEQ * 1024;
  const float* x1 = x1_ext ? x1_ext : n.x1; const float* x2 = x2_ext ? x2_ext : n.x2;
  if (from <= 1 && !(skip >> 1 & 1u)) hipLaunchKernelGGL(rmsnorm_rows, dim3(M / 4), dim3(256), 0, s, x, 1024L, F(I_GMIX), n.hn, 1024L, (long)M, 1024L);
  if (from <= 2 && !(skip >> 2 & 1u)) gemm(s, n.hn, 1024, F(I_WIN), D_IN, M, D_IN, 1024, EStore{n.proj, D_IN, 0});
  if (from <= 3 && !(skip >> 3 & 1u)) hipLaunchKernelGGL(conv_silu, dim3((unsigned)(((long)M * 1024 + 255) / 256)), dim3(256), 0, s, n.proj, F(I_CONV), n.q, n.k);
  if (from <= 4 && !(skip >> 4 & 1u)) hipLaunchKernelGGL(mlstm_naive, dim3(16), dim3(256), 0, s, n.q, n.k, n.proj, F(I_BG), n.hf, n.hb);
  if (from <= 5 && !(skip >> 5 & 1u)) hipLaunchKernelGGL(headnorm_rows, dim3(M * 4 / 4), dim3(256), 0, s, n.hf, n.hb, 512L, 4L, 128L, F(I_GHM), n.proj + OFF_OM, (long)D_IN, n.y, 1024L, (long)M);
  if (from <= 6 && !(skip >> 6 & 1u)) {
    hipLaunchKernelGGL(rmsnorm_rows, dim3(M / 4), dim3(256), 0, s, n.proj + OFF_CQ, (long)D_IN, F(I_GQA), n.cqn, 256L, (long)M, 256L);
    hipLaunchKernelGGL(rmsnorm_rows, dim3(M / 4), dim3(256), 0, s, n.proj + OFF_CKV, (long)D_IN, F(I_GKVA), n.ckvn, 128L, (long)M, 128L);
    gemm(s, n.cqn, 256, F(I_WQB), 768, M, 768, 256, EStore{n.qmla, 768, 0});
    gemm(s, n.ckvn, 128, F(I_WKVB), 1024, M, 1024, 128, EStore{n.kvm, 1024, 0});
    hipLaunchKernelGGL(rope_naive, dim3((unsigned)(((long)M * 144 + 255) / 256)), dim3(256), 0, s, n.qmla, n.proj, (const int*)d_in[I_POS] + (long)b * SEQ, n.kr);
  }
  if (from <= 7 && !(skip >> 7 & 1u)) hipLaunchKernelGGL(mla_attn_naive, dim3(SEQ / 256, 8, 1), dim3(256), 0, s, n.qmla, n.kvm, n.kr, n.att);
  if (from <= 8 && !(skip >> 8 & 1u)) hipLaunchKernelGGL(headnorm_rows, dim3(M * 8 / 4), dim3(256), 0, s, n.att, (const float*)nullptr, 512L, 8L, 64L, F(I_GHA), (const float*)nullptr, 0L, n.y + 512, 1024L, (long)M);
  if (from <= 9 && !(skip >> 9 & 1u)) gemm(s, n.y, 1024, F(I_WOUT), 1024, M, 1024, 1024, EResid{x, n.x1, 1024});
  if (from <= 10 && !(skip >> 10 & 1u)) {
    hipLaunchKernelGGL(rmsnorm_rows, dim3(M / 4), dim3(256), 0, s, x1, 1024L, F(I_GMX), n.h1, 1024L, (long)M, 1024L);
    gemm(s, n.h1, 1024, F(I_WMQ), 1024, M, 1024, 1024, EStore{n.qm, 1024, 0});
    hipLaunchKernelGGL(rmsnorm_rows, dim3(256 / 4), dim3(256), 0, s, F(I_MEM) + (long)b * 256 * 1024, 1024L, F(I_GMKV), n.memn, 1024L, 256L, 1024L);
    gemm(s, n.memn, 1024, F(I_WMK), 1024, 256, 1024, 1024, EStore{n.km, 1024, 0});
    gemm(s, n.memn, 1024, F(I_WMV), 1024, 256, 1024, 1024, EStore{n.vm, 1024, 0});
  }
  if (from <= 11 && !(skip >> 11 & 1u)) hipLaunchKernelGGL(memattn_naive, dim3(M), dim3(256), 0, s, n.qm, n.km, n.vm, n.mo);
  if (from <= 12 && !(skip >> 12 & 1u)) gemm(s, n.mo, 1024, F(I_WMO), 1024, M, 1024, 1024, EResid{x1, n.x2, 1024});
  if (from <= 13 && !(skip >> 13 & 1u)) {
    hipLaunchKernelGGL(rmsnorm_rows, dim3(M / 4), dim3(256), 0, s, x2, 1024L, F(I_GFFN), n.h1, 1024L, (long)M, 1024L);
    hipLaunchKernelGGL(router_naive, dim3(M / 4), dim3(256), 0, s, n.h1, F(I_WR), n.aff);
    hipLaunchKernelGGL(topk_naive, dim3(16), dim3(256), 0, s, n.aff, n.rowsel, n.gsel);
  }
  if (from <= 14) {
    (void)hipMemsetAsync(n.acc, 0, (size_t)M * 1024 * 4, s);
    if (!skip_moe_gu) {
      gemm(s, n.h1, 1024, F(I_WEG), 2048, 512, 2048, 1024, EStore{n.hid, 2048, 512L * 2048}, 16, 0, 1024L * 2048, n.rowsel, 512);
      gemm(s, n.h1, 1024, F(I_WEU), 2048, 512, 2048, 1024, ESiluMul{n.hid, 2048, 512L * 2048}, 16, 0, 1024L * 2048, n.rowsel, 512);
    }
    gemm(s, n.hid, 2048, F(I_WED), 1024, 512, 1024, 2048, EScatter{n.acc, n.rowsel, n.gsel}, 16, 512L * 2048, 2048L * 1024);
    hipLaunchKernelGGL(add_rows, dim3((unsigned)(((long)M * 1024 + 255) / 256)), dim3(256), 0, s, x2, n.acc, n.x3, (long)M * 1024);
    hipLaunchKernelGGL(rmsnorm_rows, dim3(M / 4), dim3(256), 0, s, n.x3, 1024L, F(I_GFIN), out, 1024L, (long)M, 1024L);
  } else if (from == 15) {
    hipLaunchKernelGGL(rmsnorm_rows, dim3(M / 4), dim3(256), 0, s, x2, 1024L, F(I_GFIN), out, 1024L, (long)M, 1024L);
  }
}
#define GAS __attribute__((address_space(1)))
#define LAS __attribute__((address_space(3)))
typedef unsigned short bf16;
typedef unsigned v4u __attribute__((ext_vector_type(4)));
typedef unsigned v2u __attribute__((ext_vector_type(2)));
typedef float f32x4 __attribute__((ext_vector_type(4)));
typedef float f32x16 __attribute__((ext_vector_type(16)));
typedef short bf16x8 __attribute__((ext_vector_type(8)));
typedef short s16x4 __attribute__((ext_vector_type(4)));
typedef GAS unsigned gu32;
#define RLX_AGENT __ATOMIC_RELAXED, __HIP_MEMORY_SCOPE_AGENT
#define LDS_WAIT() asm volatile("s_waitcnt lgkmcnt(0)" ::: "memory")
#define VM_WAIT() asm volatile("s_waitcnt vmcnt(0)" ::: "memory")
constexpr int NWAVES = 8, NTHR = 512;
__device__ __forceinline__ unsigned f2bf(float f) { unsigned u = __builtin_bit_cast(unsigned, f); return (u + 0x7fffu + ((u >> 16) & 1u)) >> 16; }
__device__ __forceinline__ unsigned pk2(float lo, float hi) { return f2bf(lo) | (f2bf(hi) << 16); }
__device__ __forceinline__ float bf2f(unsigned short h) { return __builtin_bit_cast(float, (unsigned)h << 16); }
__device__ __forceinline__ float bflo(unsigned w) { return __builtin_bit_cast(float, w << 16); }
__device__ __forceinline__ float bfhi(unsigned w) { return __builtin_bit_cast(float, w & 0xffff0000u); }
typedef float f32x2_t __attribute__((ext_vector_type(2))); typedef __bf16 bf16x2_t __attribute__((ext_vector_type(2)));
__device__ __forceinline__ unsigned cvt_pk_bf16(float lo, float hi) { f32x2_t v = {lo, hi}; bf16x2_t b = __builtin_convertvector(v, bf16x2_t); return __builtin_bit_cast(unsigned, b); }
__device__ __forceinline__ float wave_sum(float v) {
#pragma unroll
  for (int o = 1; o < 64; o <<= 1) v += __shfl_xor(v, o);
  return v;
}
__device__ __forceinline__ float sigmoidf_(float x) { return 1.f / (1.f + __expf(-x)); }

#define XB_TMO      128
#define XB_XCNT(j)  (256  + 64 * (j))
#define XB_XSUB(j)  (1280 + 64 * (j))
#define XB_XGEN(j)  (2304 + 64 * (j))
#define XB_TOP      3328
#define XB_TOPGEN   3392
#define XCD_BAR_WORDS 3456
#define XB_SPIN_CAP (1u << 22)
__device__ __forceinline__ unsigned xb_ld(unsigned* p)              { return __hip_atomic_load(p, __ATOMIC_RELAXED, __HIP_MEMORY_SCOPE_AGENT); }
__device__ __forceinline__ unsigned xb_add(unsigned* p, unsigned v) { return __hip_atomic_fetch_add(p, v, __ATOMIC_RELAXED, __HIP_MEMORY_SCOPE_AGENT); }
__device__ __forceinline__ unsigned xb_xcc_id() { return (unsigned)__builtin_amdgcn_s_getreg((3 << 11) | 20) & 0xFu; }
#define XB_SPIN(cond, bar) do { unsigned _sp = 0; while (cond) { __builtin_amdgcn_s_sleep(1); \
    if ((++_sp & 255u) == 0u) { if (xb_ld(&(bar)[XB_TMO])) break; if (_sp > XB_SPIN_CAP) { atomicAdd(&(bar)[XB_TMO], 1u); break; } } } } while (0)
struct XcdBarrier { unsigned* bar; unsigned x; volatile LAS unsigned* st; };
__device__ __forceinline__ XcdBarrier xcd_barrier_post(unsigned* bar, volatile LAS unsigned* st) {
  XcdBarrier b; b.bar = bar; b.x = xb_xcc_id(); b.st = st;
  if (threadIdx.x == 0) (void)xb_add(&bar[XB_XCNT(b.x)], 1u);
  return b;
}
__device__ __forceinline__ void xcd_barrier_complete(unsigned* bar, unsigned x, unsigned& nloc, unsigned& nx) {
  const unsigned G = gridDim.x * gridDim.y * gridDim.z;
  unsigned sum, cnt, mine, sp = 0u;
  for (;;) {
    sum = 0u; cnt = 0u; mine = 0u;
#pragma unroll
    for (unsigned j = 0; j < 16; ++j) { const unsigned c = xb_ld(&bar[XB_XCNT(j)]); sum += c; cnt += (c > 0u) ? 1u : 0u; mine = (j == x) ? c : mine; }
    if (sum == G) break;
    __builtin_amdgcn_s_sleep(1);
    if ((++sp & 255u) == 0u) { if (xb_ld(&bar[XB_TMO])) break; if (sp > XB_SPIN_CAP) { atomicAdd(&bar[XB_TMO], 1u); break; } }
  }
  nloc = mine > 0u ? mine : 1u; nx = cnt > 0u ? cnt : 1u;
}
__device__ __forceinline__ void xcd_barrier(const XcdBarrier& b) {
  asm volatile("s_waitcnt vmcnt(0)" ::: "memory");
  __syncthreads();
  if (threadIdx.x == 0) {
    unsigned* bar = b.bar;
    __builtin_amdgcn_s_waitcnt(0);
    unsigned nloc = b.st[0], nx = b.st[1];
    if (nloc == 0u) { xcd_barrier_complete(bar, b.x, nloc, nx); b.st[0] = nloc; b.st[1] = nx; }
    const unsigned old = xb_add(&bar[XB_XSUB(b.x)], 1u);
    const unsigned gen = old / nloc;
    if (old + 1u == (gen + 1u) * nloc) {
      __builtin_amdgcn_fence(__ATOMIC_RELEASE, "agent");
      asm volatile("s_waitcnt vmcnt(0)" ::: "memory");
      const unsigned og = xb_add(&bar[XB_TOP], 1u);
      const unsigned tg = og / nx;
      if (og + 1u == (tg + 1u) * nx) xb_add(&bar[XB_TOPGEN], 1u);
      else XB_SPIN(xb_ld(&bar[XB_TOPGEN]) == tg, bar);
      __builtin_amdgcn_fence(__ATOMIC_ACQUIRE, "agent");
      xb_add(&bar[XB_XGEN(b.x)], 1u);
      asm volatile("s_waitcnt vmcnt(0)" ::: "memory");
    } else {
      XB_SPIN(xb_ld(&bar[XB_XGEN(b.x)]) == gen, bar);
      __builtin_amdgcn_fence(__ATOMIC_ACQUIRE, "agent");
      asm volatile("s_waitcnt vmcnt(0)" ::: "memory");
    }
  }
  __syncthreads();
}

namespace pg8 {
constexpr int BM = 256, BK = 64, HALF = 128, HTB = HALF * BK * 2, STAGE_BYTES = 8 * HTB, NXCD = 8, WGM = 8;
__host__ __device__ __forceinline__ int lds_byte(int r, int c) { const int st = (r >> 4) * 2 + (c >> 5), rr = r & 15, cc = c & 31, ob = rr * 64 + cc * 2; return st * 1024 + (ob ^ (((ob >> 9) & 1) << 5)); }
__host__ __device__ __forceinline__ void stage_rc(int b, int& R, int& C) { const int st = b / 1024, sb = b % 1024, swz = sb ^ (((sb >> 9) & 1) << 5); R = (st >> 1) * 16 + swz / 64; C = (st & 1) * 32 + (swz % 64) / 2; }
__host__ __device__ __forceinline__ int perm32(int rho) { const int n = rho >> 4, i = rho & 15; return 8 * (i >> 2) + 4 * n + (i & 3); }

struct Unit { long aoff, boff; int pm, pn, g, ibase; };
struct Gemm { const bf16* A; const bf16* Bt; int lda, ldb, K; const int* gidx; };

struct StaticOrder {
  int nM, nN, nwg, G, c, lda, ldb;
  __device__ void init(int M, int N, int G_, int c_, int lda_, int ldb_) { nM = M / BM; nN = N / BM; nwg = nM * nN; G = G_; c = c_; lda = lda_; ldb = ldb_; }
  __device__ bool next(int i, Unit& u) const {
    const long L = (long)i * G + c; if (L >= nwg) return false;
    int wgid = (int)L; { const int q = nwg / NXCD, r = nwg % NXCD, xcd = wgid % NXCD, off = wgid / NXCD; wgid = (xcd < r ? xcd * (q + 1) : r * (q + 1) + (xcd - r) * q) + off; }
    const int nig = WGM * nN, gid = wgid / nig, fm = gid * WGM, gsz = (nM - fm) < WGM ? (nM - fm) : WGM;
    u.pm = fm + ((wgid % nig) % gsz); u.pn = (wgid % nig) / gsz; u.g = 0; u.ibase = 0;
    u.aoff = (long)u.pm * BM * lda; u.boff = (long)u.pn * BM * ldb; return true;
  }
};

template <class Epi, class Sched, bool GATHER>
__device__ __forceinline__ void gemm_phase(LAS unsigned char* lds, const Gemm g, const Sched& S, const Epi& E) {
  int tid = threadIdx.x; asm volatile("" : "+v"(tid));
  const int wid = __builtin_amdgcn_readfirstlane(tid >> 6), lane = tid & 63, wr = wid >> 2, wc = wid & 3, fr = lane & 15, fq = lane >> 4;
  const int K = g.K, nt = K / BK;
  int Rs[2], Cs[2]; unsigned voffB[2];
#pragma unroll
  for (int i = 0; i < 2; ++i) { int R, C; stage_rc(tid * 16 + i * 8192, R, C); Rs[i] = R; Cs[i] = C; const int Rb = (R & ~31) + perm32(R & 31); voffB[i] = (unsigned)(Rb * g.ldb + C) * 2u; }
  const size_t kstep = (size_t)(BK * 2);
  const size_t hstepB = (size_t)HALF * g.ldb * 2;
  const unsigned ldsw = (unsigned)wid * 1024u;
  const int aoff_l = lds_byte(wr * 64 + fr, fq * 8), boff_l = lds_byte(wc * 32 + fr, fq * 8);
#define PG8_SA(b, h) (((b) * 2 + (h)) * HTB)
#define PG8_SB(b, h) ((4 + (b) * 2 + (h)) * HTB)
#define PG8_STAGE(bufoff, gbase, voff) do { _Pragma("unroll") for (int _i = 0; _i < 2; ++_i) \
        __builtin_amdgcn_global_load_lds((const unsigned*)((const char*)(gbase) + (voff)[_i]), (LAS unsigned*)(lds + (bufoff) + ldsw + _i * 8192), 16, 0, 0); } while (0)
#define PG8_LDA(dst, b, h) do { _Pragma("unroll") for (int m = 0; m < 4; ++m) _Pragma("unroll") for (int k = 0; k < 2; ++k) dst[m][k] = *(const LAS bf16x8*)(lds + PG8_SA(b, h) + aoff_l + m * 2048 + k * 1024); } while (0)
#define PG8_LDB(dst, b, h) do { _Pragma("unroll") for (int n = 0; n < 2; ++n) _Pragma("unroll") for (int k = 0; k < 2; ++k) dst[n][k] = *(const LAS bf16x8*)(lds + PG8_SB(b, h) + boff_l + n * 2048 + k * 1024); } while (0)
#define PG8_MMA(ai, bj, At, Bt) do { __builtin_amdgcn_s_setprio(1); _Pragma("unroll") for (int m = 0; m < 4; ++m) _Pragma("unroll") for (int n = 0; n < 2; ++n) _Pragma("unroll") for (int k = 0; k < 2; ++k) \
        acc[ai][bj][m][n] = __builtin_amdgcn_mfma_f32_16x16x32_bf16(Bt[n][k], At[m][k], acc[ai][bj][m][n], 0, 0, 0); __builtin_amdgcn_s_setprio(0); } while (0)
#define PG8_WAIT_V(n) asm volatile("s_waitcnt vmcnt(" #n ")" ::: "memory")
#define PG8_WAIT_L(n) asm volatile("s_waitcnt lgkmcnt(" #n ")" ::: "memory")
#define PG8_BAR __builtin_amdgcn_s_barrier()
#define PG8_SCHED __builtin_amdgcn_sched_barrier(0)
  Unit cur, nxt; int ui = 0;
  if (!S.next(0, cur)) return;
  unsigned vA[2][2], nvA[2][2];
  auto load_va = [&](const Unit& u, unsigned (&v)[2][2]) {
#pragma unroll
    for (int h = 0; h < 2; ++h)
#pragma unroll
      for (int i = 0; i < 2; ++i) {
        if constexpr (GATHER) v[h][i] = (unsigned)((long)g.gidx[u.ibase + h * HALF + Rs[i]] * g.lda + Cs[i]) * 2u;
        else v[h][i] = (unsigned)((h * HALF + Rs[i]) * g.lda + Cs[i]) * 2u;
      }
  };
  load_va(cur, vA);
  f32x4 acc[2][2][4][2];
#pragma unroll
  for (int a = 0; a < 2; ++a)
#pragma unroll
    for (int b = 0; b < 2; ++b)
#pragma unroll
      for (int m = 0; m < 4; ++m)
#pragma unroll
        for (int n = 0; n < 2; ++n) acc[a][b][m][n] = (f32x4){0.f, 0.f, 0.f, 0.f};
  bf16x8 At[4][2], B0[2][2], B1[2][2];
  const char* cA = (const char*)g.A + (GATHER ? 0 : cur.aoff * 2); const char* cB = (const char*)g.Bt + cur.boff * 2;
  PG8_STAGE(PG8_SB(0, 0), cB, voffB); PG8_STAGE(PG8_SB(0, 1), cB + hstepB, voffB); PG8_STAGE(PG8_SA(0, 0), cA, vA[0]); PG8_STAGE(PG8_SA(0, 1), cA, vA[1]);
  if (wr == 1) PG8_BAR;
  PG8_WAIT_V(2); PG8_BAR;
  PG8_STAGE(PG8_SB(1, 0), cB + kstep, voffB); PG8_STAGE(PG8_SA(1, 0), cA + kstep, vA[0]); PG8_STAGE(PG8_SB(1, 1), cB + hstepB + kstep, voffB);
  PG8_WAIT_V(6); PG8_BAR;
  for (;;) {
    const bool has_next = S.next(ui + 1, nxt);
    const char* nA = has_next ? (const char*)g.A + (GATHER ? 0 : nxt.aoff * 2) : cA; const char* nB = has_next ? (const char*)g.Bt + nxt.boff * 2 : cB;
    if constexpr (GATHER) { if (has_next) load_va(nxt, nvA); else {
#pragma unroll
      for (int h = 0; h < 2; ++h)
#pragma unroll
        for (int i = 0; i < 2; ++i) nvA[h][i] = vA[h][i]; } }
#pragma unroll 1
    for (int t = 0; t < nt; t += 2) {
      const bool last = (t == nt - 2);
      const char* a1 = cA + (size_t)(t + 1) * kstep;
      const char* a2 = last ? nA : cA + (size_t)(t + 2) * kstep; const char* b2 = last ? nB : cB + (size_t)(t + 2) * kstep;
      const char* a3 = a2 + kstep; const char* b3 = b2 + kstep;
      unsigned w0[2], w1[2];
      if constexpr (GATHER) { w0[0] = last ? nvA[0][0] : vA[0][0]; w0[1] = last ? nvA[0][1] : vA[0][1]; w1[0] = last ? nvA[1][0] : vA[1][0]; w1[1] = last ? nvA[1][1] : vA[1][1]; }
      else { w0[0] = vA[0][0]; w0[1] = vA[0][1]; w1[0] = vA[1][0]; w1[1] = vA[1][1]; }
      PG8_LDB(B0, 0, 0); PG8_LDB(B1, 0, 1); PG8_SCHED; PG8_LDA(At, 0, 0); PG8_STAGE(PG8_SA(1, 1), a1, vA[1]);
      PG8_WAIT_V(8); PG8_WAIT_L(0); PG8_BAR; PG8_MMA(0, 0, At, B0); PG8_MMA(0, 1, At, B1); PG8_BAR; PG8_SCHED;
      PG8_LDA(At, 0, 1); PG8_STAGE(PG8_SB(0, 0), b2, voffB); PG8_STAGE(PG8_SB(0, 1), b2 + hstepB, voffB); PG8_STAGE(PG8_SA(0, 0), a2, w0);
      PG8_WAIT_V(8); PG8_WAIT_L(0); PG8_BAR; PG8_MMA(1, 0, At, B0); PG8_MMA(1, 1, At, B1); PG8_BAR; PG8_SCHED;
      PG8_LDB(B0, 1, 0); PG8_LDB(B1, 1, 1); PG8_SCHED; PG8_LDA(At, 1, 0); PG8_STAGE(PG8_SA(0, 1), a2, w1);
      PG8_WAIT_V(8); PG8_WAIT_L(0); PG8_BAR; PG8_MMA(0, 0, At, B0); PG8_MMA(0, 1, At, B1); PG8_BAR; PG8_SCHED;
      PG8_LDA(At, 1, 1); PG8_STAGE(PG8_SB(1, 0), b3, voffB); PG8_STAGE(PG8_SB(1, 1), b3 + hstepB, voffB); PG8_STAGE(PG8_SA(1, 0), a3, w0);
      PG8_WAIT_V(8); PG8_WAIT_L(0); PG8_BAR; PG8_MMA(1, 0, At, B0); PG8_MMA(1, 1, At, B1); PG8_BAR; PG8_SCHED;
    }
    if (wr == 0) PG8_BAR;
    if constexpr (Epi::TWO_PASS) {
#pragma unroll
      for (int ai = 0; ai < 2; ++ai)
#pragma unroll
        for (int m = 0; m < 4; ++m) {
          float v0[8], v1[8];
#pragma unroll
          for (int n = 0; n < 2; ++n)
#pragma unroll
            for (int j = 0; j < 4; ++j) { v0[n * 4 + j] = acc[ai][0][m][n][j]; v1[n * 4 + j] = acc[ai][1][m][n][j]; }
          E.pass1(cur, ai * HALF + wr * 64 + m * 16 + fr, wc, v0, v1, fq);
#pragma unroll
          for (int n = 0; n < 2; ++n)
#pragma unroll
            for (int j = 0; j < 4; ++j) { acc[ai][0][m][n][j] = v0[n * 4 + j]; acc[ai][1][m][n][j] = v1[n * 4 + j]; }
        }
      asm volatile("s_waitcnt lgkmcnt(0)" ::: "memory"); PG8_BAR; asm volatile("" ::: "memory");
    }
    {
#pragma unroll
      for (int ai = 0; ai < 2; ++ai)
#pragma unroll
        for (int m = 0; m < 4; ++m) {
          float v0[8], v1[8];
#pragma unroll
          for (int n = 0; n < 2; ++n)
#pragma unroll
            for (int j = 0; j < 4; ++j) { v0[n * 4 + j] = acc[ai][0][m][n][j]; v1[n * 4 + j] = acc[ai][1][m][n][j]; }
          E.row8(cur, ai * HALF + wr * 64 + m * 16 + fr, wc * 32 + 8 * fq, v0, v1, fq);
          asm volatile("" ::: "memory");
        }
    }
    if (!has_next) break;
#pragma unroll
    for (int a = 0; a < 2; ++a)
#pragma unroll
      for (int b = 0; b < 2; ++b)
#pragma unroll
        for (int m = 0; m < 4; ++m)
#pragma unroll
          for (int n = 0; n < 2; ++n) acc[a][b][m][n] = (f32x4){0.f, 0.f, 0.f, 0.f};
    cur = nxt; cA = nA; cB = nB; ++ui;
    if constexpr (GATHER) {
#pragma unroll
      for (int h = 0; h < 2; ++h)
#pragma unroll
        for (int i = 0; i < 2; ++i) vA[h][i] = nvA[h][i]; }
    if (wr == 1) PG8_BAR;
  }
  PG8_WAIT_V(0);
  PG8_BAR;
#undef PG8_SA
#undef PG8_SB
#undef PG8_STAGE
#undef PG8_LDA
#undef PG8_LDB
#undef PG8_MMA
#undef PG8_WAIT_V
#undef PG8_WAIT_L
#undef PG8_BAR
#undef PG8_SCHED
}
}
constexpr size_t WS_CTL = 0, CTL_ZERO_BYTES = 1 * MiB;
constexpr int CW_TMO = 0, CW_BAR = 4096, CW_Q = 8192;
constexpr size_t CTL_SSQ = 256 * 1024, CTL_SSKV = CTL_SSQ + 65536, CTL_SS1 = CTL_SSKV + 65536, CTL_SS2 = CTL_SS1 + 65536;
constexpr size_t WS_WIN = 1 * MiB, WS_WQB = 6 * MiB, WS_WKVB = 6 * MiB + 512 * 1024, WS_WOUT = 7 * MiB, WS_WMQ = 9 * MiB, WS_WMK = 11 * MiB, WS_WMV = 13 * MiB, WS_WMO = 15 * MiB;
constexpr size_t WS_ROPE = 17 * MiB, WS_MEMN = 19 * MiB, WS_KMEM = 21 * MiB, WS_VMEMT = 23 * MiB, WS_GSC = 25 * MiB, WS_DEC = 28 * MiB, WS_AFF = 29 * MiB, WS_SEL = 30 * MiB;
constexpr size_t WS_PROJ = 32 * MiB, WS_XN = 112 * MiB, WS_QC = 112 * MiB, WS_KC = 128 * MiB, WS_QM = 144 * MiB, WS_KM = 168 * MiB, WS_VM = 192 * MiB, WS_HF = 208 * MiB, WS_HB = 224 * MiB, WS_Y = 240 * MiB;
constexpr size_t WS_X1 = 112 * MiB, WS_X1B = 176 * MiB, WS_QMEM = 208 * MiB, WS_P = 240 * MiB, WS_MO = 176 * MiB, WS_X2 = 240 * MiB, WS_X2B = 208 * MiB, WS_HID = 32 * MiB;
constexpr size_t WS_WEGU = 320 * MiB, WS_WED = 448 * MiB, WS_END = 512 * MiB;
constexpr int PROJ_LD = 2560;
constexpr int PC_CQ = 2048, PC_CKV = 2304, PC_KR = 2432, PC_G = 2464;
constexpr int RING_BYTES = 131072, LDSCTL_OFF = RING_BYTES, LDS_BYTES = 147456;

struct Args { const void* in[26]; float* out; unsigned char* ws; int ph_lo, ph_hi, flags, pad; };

struct Frame {
  LAS unsigned char* lds; volatile LAS unsigned* MISC; gu32* ctl; unsigned char* ws;
  int tid, lane, wave, vcu, G;
};

__device__ __forceinline__ void p0_tr(const float* W, int ldw, int k0, int kvalid, int scol0, int ncols, const float* gs, bf16* WT, int ldt, int drow0, LAS float* scr, int lane) {
#pragma unroll 8
  for (int i = 0; i < 32; ++i) { const int kk = 2 * i + (lane >> 5), c = lane & 31; float v = 0.f;
    if (c < ncols && k0 + kk < kvalid) { v = W[(size_t)(k0 + kk) * ldw + scol0 + c]; if (gs) v *= gs[k0 + kk]; }
    scr[kk * 33 + c] = v; }
  LDS_WAIT(); asm volatile("" ::: "memory");
  const int c = lane & 7;
#pragma unroll
  for (int j = 0; j < 4; ++j) { const int n = (lane >> 3) + 8 * j; const LAS float* s = scr + (8 * c) * 33 + n;
    v4u o; o.x = pk2(s[0 * 33], s[1 * 33]); o.y = pk2(s[2 * 33], s[3 * 33]); o.z = pk2(s[4 * 33], s[5 * 33]); o.w = pk2(s[6 * 33], s[7 * 33]);
    *(GAS v4u*)(WT + (size_t)(drow0 + n) * ldt + k0 + 8 * c) = o; }
  LDS_WAIT(); asm volatile("" ::: "memory");
}
__device__ __forceinline__ void rms_row_to_bf16(const float* xrow, bf16* orow, int lane) {
  const GAS f32x4* xr = (const GAS f32x4*)xrow + lane;
  f32x4 v[4]; float s = 0.f;
#pragma unroll
  for (int j = 0; j < 4; ++j) { v[j] = xr[64 * j]; s += (v[j].x * v[j].x + v[j].y * v[j].y) + (v[j].z * v[j].z + v[j].w * v[j].w); }
  const float rstd = rsqrtf(wave_sum(s) * (1.f / 1024.f) + 1e-6f);
  GAS unsigned long long* o8 = (GAS unsigned long long*)orow + lane;
#pragma unroll
  for (int j = 0; j < 4; ++j) o8[64 * j] = (unsigned long long)pk2(v[j].x * rstd, v[j].y * rstd) | ((unsigned long long)pk2(v[j].z * rstd, v[j].w * rstd) << 32);
}

__device__ __forceinline__ void p0_prologue(Frame& F, const Args& a, bool do_dense, bool do_experts) {
  LAS float* scr = (LAS float*)(F.lds + F.wave * 16384);
  const int gw = F.vcu * NWAVES + F.wave, NGW = F.G * NWAVES;
  auto I = [&](int i) { return (const float*)a.in[i]; };
  unsigned char* ws = F.ws;
  if (do_dense) {
    constexpr int I_WIN_ = 16 * 80, I_WQB_ = 4 * 24, I_WKVB_ = 4 * 32, I_SQ = 16 * 32;
    constexpr int NIT = I_WIN_ + I_WQB_ + I_WKVB_ + 5 * I_SQ;
    for (int it = gw; it < NIT; it += NGW) {
      int r = it;
      if (r < I_WIN_) { const int kb = r / 80, nb = r % 80; int sc, nc = 32;
        if (nb < 64) sc = 32 * nb; else if (nb < 72) sc = OFF_CQ + 32 * (nb - 64); else if (nb < 76) sc = OFF_CKV + 32 * (nb - 72); else if (nb == 76) sc = OFF_KR; else if (nb == 77) { sc = OFF_G; nc = 16; } else { sc = 0; nc = 0; }
        p0_tr(I(I_WIN), D_IN, 64 * kb, 1024, sc, nc, I(I_GMIX), (bf16*)(ws + WS_WIN), 1024, 32 * nb, scr, F.lane); continue; } r -= I_WIN_;
      if (r < I_WQB_) { const int kb = r / 24, nb = r % 24; p0_tr(I(I_WQB), 768, 64 * kb, 256, 32 * nb, 32, I(I_GQA), (bf16*)(ws + WS_WQB), 256, 32 * nb, scr, F.lane); continue; } r -= I_WQB_;
      if (r < I_WKVB_) { const int kb = r / 32, nb = r % 32; const int h = (nb & 15) >> 1, d0 = (nb & 1) * 32; const int sc = h * 128 + (nb >= 16 ? 64 : 0) + d0;
        p0_tr(I(I_WKVB), 1024, 64 * kb, 128, sc, 32, I(I_GKVA), (bf16*)(ws + WS_WKVB), 256, 32 * nb, scr, F.lane); continue; } r -= I_WKVB_;
      const int which = r / I_SQ; r %= I_SQ; const int kb = r / 32, nb = r % 32;
      const float* src = which == 0 ? I(I_WOUT) : which == 1 ? I(I_WMQ) : which == 2 ? I(I_WMK) : which == 3 ? I(I_WMV) : I(I_WMO);
      const float* gs = which == 1 ? I(I_GMX) : (which == 2 || which == 3) ? I(I_GMKV) : nullptr;
      bf16* dst = (bf16*)(ws + (which == 0 ? WS_WOUT : which == 1 ? WS_WMQ : which == 2 ? WS_WMK : which == 3 ? WS_WMV : WS_WMO));
      p0_tr(src, 1024, 64 * kb, 1024, 32 * nb, 32, gs, dst, 1024, 32 * nb, scr, F.lane);
    }
    for (int m = gw; m < MTOK; m += NGW) rms_row_to_bf16(I(I_X) + (size_t)m * 1024, (bf16*)(ws + WS_XN) + (size_t)m * 1024, F.lane);
    for (int m = gw; m < BATCH * NMEM; m += NGW) rms_row_to_bf16(I(I_MEM) + (size_t)m * 1024, (bf16*)(ws + WS_MEMN) + (size_t)m * 1024, F.lane);
    { const int* pos = (const int*)a.in[I_POS]; float* rt = (float*)(ws + WS_ROPE);
      for (int i = (F.vcu * NTHR + F.tid); i < MTOK * 16; i += F.G * NTHR) { const int m = i >> 4, j = i & 15; const float inv = powf(10000.f, -(float)j / 16.f); const float ang = (float)pos[m] * inv;
        rt[m * 32 + j] = cosf(ang); rt[m * 32 + 16 + j] = sinf(ang); } }
  }
  if (do_experts) {
    constexpr int I_GU = 16 * 128, I_D = 32 * 32;
    for (int it = gw; it < NEXP * (I_GU + I_D); it += NGW) {
      const int e = it / (I_GU + I_D); int r = it % (I_GU + I_D);
      if (r < I_GU) { const int kb = r / 128, nb = r % 128, p = nb >> 3, j0 = (nb & 7) * 32; const bool up = j0 >= 128;
        p0_tr((up ? I(I_WEU) : I(I_WEG)) + (size_t)e * 1024 * 2048, 2048, 64 * kb, 1024, 128 * p + (up ? j0 - 128 : j0), 32, I(I_GFFN), (bf16*)(ws + WS_WEGU) + (size_t)e * 4096 * 1024, 1024, 32 * nb, scr, F.lane); }
      else { r -= I_GU; const int kb = r / 32, nb = r % 32;
        p0_tr(I(I_WED) + (size_t)e * 2048 * 1024, 1024, 64 * kb, 2048, 32 * nb, 32, nullptr, (bf16*)(ws + WS_WED) + (size_t)e * 1024 * 2048, 2048, 32 * nb, scr, F.lane); }
    }
  }
}

__device__ __forceinline__ v4u pack8(const float (&v)[8]) { v4u w; w.x = cvt_pk_bf16(v[0], v[1]); w.y = cvt_pk_bf16(v[2], v[3]); w.z = cvt_pk_bf16(v[4], v[5]); w.w = cvt_pk_bf16(v[6], v[7]); return w; }
__device__ __forceinline__ float sumsq8(const float (&v)[8]) { float s = 0.f;
#pragma unroll
  for (int i = 0; i < 8; ++i) s += v[i] * v[i];
  return s; }
struct EpiStore { static constexpr bool TWO_PASS = false; bf16* O; int ldc;
  __device__ __forceinline__ void row8(const pg8::Unit& u, int rloc, int cloc, const float (&v0)[8], const float (&v1)[8], int fq) const {
    bf16* p = O + (size_t)(u.pm * 256 + rloc) * ldc + u.pn * 256 + cloc; *(v4u*)p = pack8(v0); *(v4u*)(p + 128) = pack8(v1); } };
struct EpiProj { static constexpr bool TWO_PASS = false; bf16* P; float* ssq; float* sskv;
  __device__ __forceinline__ void row8(const pg8::Unit& u, int rloc, int cloc, const float (&v0)[8], const float (&v1)[8], int fq) const {
    const int row = u.pm * 256 + rloc; bf16* p = P + (size_t)row * PROJ_LD + u.pn * 256 + cloc; *(v4u*)p = pack8(v0); *(v4u*)(p + 128) = pack8(v1);
    if (u.pn == 8) { float s = sumsq8(v0) + sumsq8(v1); s += __shfl_xor(s, 16); s += __shfl_xor(s, 32); if (fq == 0) unsafeAtomicAdd(ssq + row, s); }
    if (u.pn == 9) { float s = sumsq8(v0); s += __shfl_xor(s, 16); s += __shfl_xor(s, 32); if (fq == 0) unsafeAtomicAdd(sskv + row, s); } } };
struct EpiQ { static constexpr bool TWO_PASS = false; bf16* Q; const float* ssq; const float* rope;
  __device__ __forceinline__ void rope8(float (&v)[8], int row, int fq) const {
    float pv[8];
#pragma unroll
    for (int i = 0; i < 8; ++i) pv[i] = __shfl_xor(v[i], 32);
    const float* cs = rope + (size_t)row * 32 + 8 * (fq & 1);
#pragma unroll
    for (int i = 0; i < 8; ++i) { const float c = cs[i], s = cs[16 + i]; v[i] = (fq < 2) ? (v[i] * c - pv[i] * s) : (v[i] * c + pv[i] * s); }
  }
  __device__ __forceinline__ void row8(const pg8::Unit& u, int rloc, int cloc, const float (&a0)[8], const float (&a1)[8], int fq) const {
    const int row = u.pm * 256 + rloc; const float r = rsqrtf(ssq[row] * (1.f / 256.f) + 1e-6f);
    float v0[8], v1[8];
#pragma unroll
    for (int i = 0; i < 8; ++i) { v0[i] = a0[i] * r; v1[i] = a1[i] * r; }
    const int g0 = u.pn * 8 + (cloc >> 5), g1 = g0 + 4;
    if (g0 % 3 == 2) rope8(v0, row, fq);
    if (g1 % 3 == 2) rope8(v1, row, fq);
    bf16* p = Q + (size_t)row * 768 + u.pn * 256 + cloc; *(v4u*)p = pack8(v0); *(v4u*)(p + 128) = pack8(v1); } };
struct EpiKV { static constexpr bool TWO_PASS = false; bf16* KMp; bf16* VMp; const float* sskv;
  __device__ __forceinline__ void put(int row, int c, const float (&v)[8], float r) const {
    float w[8];
#pragma unroll
    for (int i = 0; i < 8; ++i) w[i] = v[i] * r;
    if (c < 512) *(v4u*)(KMp + (size_t)row * 768 + (c >> 6) * 96 + (c & 63)) = pack8(w); else *(v4u*)(VMp + (size_t)row * 512 + (c - 512)) = pack8(w); }
  __device__ __forceinline__ void row8(const pg8::Unit& u, int rloc, int cloc, const float (&a0)[8], const float (&a1)[8], int fq) const {
    const int row = u.pm * 256 + rloc; const float r = rsqrtf(sskv[row] * (1.f / 128.f) + 1e-6f);
    put(row, u.pn * 256 + cloc, a0, r); put(row, u.pn * 256 + 128 + cloc, a1, r); } };

__device__ __forceinline__ void unpack8(v4u w, float (&f)[8]) { f[0] = bflo(w.x); f[1] = bfhi(w.x); f[2] = bflo(w.y); f[3] = bfhi(w.y); f[4] = bflo(w.z); f[5] = bfhi(w.z); f[6] = bflo(w.w); f[7] = bfhi(w.w); }
__device__ __forceinline__ float log_sigmoid(float x) { return fminf(x, 0.f) - log1pf(__expf(-fabsf(x))); }

__device__ __forceinline__ void p2_elementwise(Frame& F, const Args& a) {
  unsigned char* ws = F.ws;
  const bf16* P = (const bf16*)(ws + WS_PROJ);
  { const float* cw = (const float*)a.in[I_CONV]; bf16* QC = (bf16*)(ws + WS_QC); bf16* KC = (bf16*)(ws + WS_KC);
    for (int i = F.vcu * NTHR + F.tid; i < MTOK * 128; i += F.G * NTHR) { const int m = i >> 7, c = (i & 127) * 8, t = m & (SEQ - 1);
      float x1[8], x0[8], x2[8]; unpack8(*(const v4u*)(P + (size_t)m * PROJ_LD + c), x1);
      if (t > 0) unpack8(*(const v4u*)(P + (size_t)(m - 1) * PROJ_LD + c), x0); else {
#pragma unroll
        for (int j = 0; j < 8; ++j) x0[j] = 0.f; }
      if (t < SEQ - 1) unpack8(*(const v4u*)(P + (size_t)(m + 1) * PROJ_LD + c), x2); else {
#pragma unroll
        for (int j = 0; j < 8; ++j) x2[j] = 0.f; }
      float o[8];
#pragma unroll
      for (int j = 0; j < 8; ++j) { float v = x0[j] * cw[c + j] + x1[j] * cw[1024 + c + j] + x2[j] * cw[2048 + c + j]; v = v * sigmoidf_(v); o[j] = (c < 512) ? v : v * 0.08838834764831845f; }
      if (c < 512) *(v4u*)(QC + (size_t)m * 512 + c) = pack8(o); else *(v4u*)(KC + (size_t)m * 512 + c - 512) = pack8(o); } }
  { const float* rope = (const float*)(ws + WS_ROPE); bf16* KMp = (bf16*)(ws + WS_KM);
    for (int i = F.vcu * NTHR + F.tid; i < MTOK * 16; i += F.G * NTHR) { const int m = i >> 4, j = i & 15;
      const float t1 = bf2f(P[(size_t)m * PROJ_LD + PC_KR + j]), t2 = bf2f(P[(size_t)m * PROJ_LD + PC_KR + 16 + j]); const float c = rope[m * 32 + j], s = rope[m * 32 + 16 + j];
      const bf16 o1 = (bf16)f2bf(t1 * c - t2 * s), o2 = (bf16)f2bf(t2 * c + t1 * s);
#pragma unroll
      for (int h = 0; h < 8; ++h) { KMp[(size_t)m * 768 + h * 96 + 64 + j] = o1; KMp[(size_t)m * 768 + h * 96 + 80 + j] = o2; } } }
  { const float* bg = (const float*)a.in[I_BG]; float* GSC = (float*)(ws + WS_GSC); float* DEC = (float*)(ws + WS_DEC);
    const int gw = F.vcu * NWAVES + F.wave, NGW = F.G * NWAVES;
    for (int it = gw; it < 32 * 64; it += NGW) { const int seq = it >> 6, c = it & 63, dir = seq & 1, h = (seq >> 1) & 3, b = seq >> 3;
      const int p = c * 64 + F.lane, t = dir ? (SEQ - 1 - p) : p; const size_t row = (size_t)b * SEQ + t;
      const int gi = (dir ? 8 : 0) + h, gf = (dir ? 12 : 4) + h;
      const float li = bf2f(P[row * PROJ_LD + PC_G + gi]) + bg[gi]; const float lf = log_sigmoid(bf2f(P[row * PROJ_LD + PC_G + gf]) + bg[gf]);
      float bs = lf;
#pragma unroll
      for (int o = 1; o < 64; o <<= 1) { const float y = __shfl_up(bs, o); if (F.lane >= o) bs += y; }
      const float av = li - bs; float pm = av;
#pragma unroll
      for (int o = 1; o < 64; o <<= 1) { const float y = __shfl_up(pm, o); if (F.lane >= o) pm = fmaxf(pm, y); }
      float* gs = GSC + (size_t)seq * 3 * SEQ; gs[p] = bs; gs[SEQ + p] = av; gs[2 * SEQ + p] = pm;
      if (F.lane == 63) { DEC[seq * 128 + c] = bs; DEC[seq * 128 + 64 + c] = pm; } } }
}
namespace mla {
constexpr int DQK = 96, DV = 64, NW = 8, QBLK = 32, KVBLK = 64, LDQ = 768, LDK = 768, LDV = 512, LDO = 1024;
constexpr float SCALE = 0.10206207261596575f;
constexpr float THR = 8.f;
constexpr int SHM_V = 16384, SHM_K = 16384, SHM_ATTN = 2 * SHM_V + 2 * SHM_K + NW * 64 * 4;
#define KSWZ(row, colB) ((row) * 256 + ((colB) ^ (((row) & 7) << 4)))
#define SBAR() __builtin_amdgcn_sched_barrier(0)
__device__ __forceinline__ int crow(int r, int hi) { return (r & 3) + 8 * (r >> 2) + 4 * hi; }
__device__ __forceinline__ void partialSM(f32x16& p0, f32x16& p1, float& m_reg, float& mn, float& alpha) {
  constexpr float C = SCALE * 1.4426950408889634f;
  float pmax = p0[0];
#pragma unroll
  for (int r = 1; r < 16; ++r) pmax = fmaxf(pmax, p0[r]);
#pragma unroll
  for (int r = 0; r < 16; ++r) pmax = fmaxf(pmax, p1[r]);
  { auto rr = __builtin_amdgcn_permlane32_swap(__float_as_uint(pmax), __float_as_uint(pmax), false, false);
    pmax = fmaxf(__uint_as_float(rr[0]), __uint_as_float(rr[1])); }
  if (__builtin_expect(__all(pmax - m_reg <= THR / SCALE), 1)) { mn = m_reg; alpha = 1.f; }
  else { mn = fmaxf(m_reg, pmax); alpha = __builtin_amdgcn_exp2f((m_reg - mn) * C); m_reg = mn; }
  const float mnC = -mn * C;
#pragma unroll
  for (int r = 0; r < 16; ++r) p0[r] = fmaf(p0[r], C, mnC);
#pragma unroll
  for (int r = 0; r < 16; ++r) p1[r] = fmaf(p1[r], C, mnC);
#pragma unroll
  for (int r = 0; r < 16; ++r) p0[r] = __builtin_amdgcn_exp2f(p0[r]);
}
__device__ __forceinline__ void finishSM(f32x16& p0, f32x16& p1, float alpha, float& l_reg, bf16x8& pa0, bf16x8& pa1, bf16x8& pa2, bf16x8& pa3) {
#pragma unroll
  for (int r = 0; r < 16; ++r) p1[r] = __builtin_amdgcn_exp2f(p1[r]);
  float ps = 0;
#pragma unroll
  for (int r = 0; r < 16; ++r) ps += p0[r];
#pragma unroll
  for (int r = 0; r < 16; ++r) ps += p1[r];
  { auto rr = __builtin_amdgcn_permlane32_swap(__float_as_uint(ps), __float_as_uint(ps), false, false);
    ps = __uint_as_float(rr[0]) + __uint_as_float(rr[1]); }
  l_reg = l_reg * alpha + ps;
#define PK4(P, BASE, OUT) do { unsigned a0 = cvt_pk_bf16(P[BASE + 0], P[BASE + 1]), a1 = cvt_pk_bf16(P[BASE + 2], P[BASE + 3]);   \
    unsigned b0 = cvt_pk_bf16(P[BASE + 4], P[BASE + 5]), b1 = cvt_pk_bf16(P[BASE + 6], P[BASE + 7]);                              \
    auto r0 = __builtin_amdgcn_permlane32_swap(a0, b0, false, false); auto r1 = __builtin_amdgcn_permlane32_swap(a1, b1, false, false); \
    v4u w = {r0[0], r1[0], r0[1], r1[1]}; OUT = __builtin_bit_cast(bf16x8, w); } while (0)
  PK4(p0, 0, pa0); PK4(p0, 8, pa1); PK4(p1, 0, pa2); PK4(p1, 8, pa3);
#undef PK4
}
__device__ __forceinline__ void qkt(f32x16& p0, f32x16& p1, const char* Ks, const bf16x8* qr, int r32, int hi) {
  p0 = f32x16{}; p1 = f32x16{};
#pragma unroll
  for (int d0 = 0; d0 < DQK / 16; ++d0) { const int cb = (d0 * 16 + hi * 8) * 2;
    const bf16x8 b0 = *reinterpret_cast<const bf16x8*>(Ks + KSWZ(r32, cb));
    const bf16x8 b1 = *reinterpret_cast<const bf16x8*>(Ks + KSWZ(32 + r32, cb));
    p0 = __builtin_amdgcn_mfma_f32_32x32x16_bf16(b0, qr[d0], p0, 0, 0, 0);
    p1 = __builtin_amdgcn_mfma_f32_32x32x16_bf16(b1, qr[d0], p1, 0, 0, 0); }
}
__device__ __forceinline__ int v_st(int k, int c) { const int kk = (k & ~0xC) | ((k & 4) << 1) | ((k & 8) >> 1); return ((kk >> 3) * 4 + (c >> 5)) * 512 + ((kk & 7) * 32 + (c & 31)) * 2; }
__device__ __forceinline__ int v_rd_base(int lane) { return ((lane & 3) << 3) | (((lane >> 2) & 3) << 6) | (((lane >> 4) & 1) << 5) | (((lane >> 5) & 1) << 8); }
constexpr int v_rd_off(int d0, int ks, int half) { return d0 * 512 + ks * 4096 + half * 2048; }
template <int OFF> __device__ __forceinline__ s16x4 tr_read(int vb) {
  s16x4 r; asm volatile("ds_read_b64_tr_b16 %0, %1 offset:%2" : "=&v"(r) : "v"(vb), "i"(OFF) : "memory"); return r;
}
template <int D0> __device__ __forceinline__ void pv_one(f32x16& od, int vb, bf16x8 pa0, bf16x8 pa1, bf16x8 pa2, bf16x8 pa3) {
  const s16x4 l0 = tr_read<v_rd_off(D0, 0, 0)>(vb), h0 = tr_read<v_rd_off(D0, 0, 1)>(vb), l1 = tr_read<v_rd_off(D0, 1, 0)>(vb), h1 = tr_read<v_rd_off(D0, 1, 1)>(vb);
  const s16x4 l2 = tr_read<v_rd_off(D0, 2, 0)>(vb), h2 = tr_read<v_rd_off(D0, 2, 1)>(vb), l3 = tr_read<v_rd_off(D0, 3, 0)>(vb), h3 = tr_read<v_rd_off(D0, 3, 1)>(vb);
  asm volatile("s_waitcnt lgkmcnt(0)" ::: "memory"); SBAR();
#define PK(L, H) (bf16x8){L[0], L[1], L[2], L[3], H[0], H[1], H[2], H[3]}
  od = __builtin_amdgcn_mfma_f32_32x32x16_bf16(pa0, PK(l0, h0), od, 0, 0, 0);
  od = __builtin_amdgcn_mfma_f32_32x32x16_bf16(pa1, PK(l1, h1), od, 0, 0, 0);
  od = __builtin_amdgcn_mfma_f32_32x32x16_bf16(pa2, PK(l2, h2), od, 0, 0, 0);
  od = __builtin_amdgcn_mfma_f32_32x32x16_bf16(pa3, PK(l3, h3), od, 0, 0, 0);
#undef PK
}
__device__ __forceinline__ void pv_d0(f32x16* o, int vb, bf16x8 pa0, bf16x8 pa1, bf16x8 pa2, bf16x8 pa3) {
  pv_one<0>(o[0], vb, pa0, pa1, pa2, pa3); pv_one<1>(o[1], vb, pa0, pa1, pa2, pa3);
}
__device__ __forceinline__ void attn_unit(const bf16* __restrict__ Qb, const bf16* __restrict__ Kh, const bf16* __restrict__ Vh, bf16* __restrict__ Yb, const float* __restrict__ gh, int seq, char* lds) {
  int tid = threadIdx.x; asm volatile("" : "+v"(tid));
  const int wid = tid >> 6, lane = tid & 63, r32 = lane & 31, hi = lane >> 5;
  char* V_lds = lds; char* K_lds = lds + 2 * SHM_V;
  float* wsf = (float*)(lds + 2 * SHM_V + 2 * SHM_K) + wid * 64; float* li_l = wsf; float* al_l = wsf + 32;
  float m_reg = -1e30f, l_reg = 0; f32x16 o[2] = {}; bf16x8 qr[DQK / 16];
  const bf16* Qw = Qb + (long)(wid * QBLK + r32) * LDQ + hi * 8;
#pragma unroll
  for (int d0 = 0; d0 < DQK / 16; ++d0) qr[d0] = *reinterpret_cast<const bf16x8*>(Qw + d0 * 16);
  const int sr = tid >> 4, sc = (tid & 15) * 8, vst0 = v_st(sr, sc & 63), vst1 = v_st(32 + sr, sc & 63);
  const bool doK = sc < DQK, doV = sc < DV;
  const int vb0 = (int)(uintptr_t)V_lds + v_rd_base(lane);
  struct { bf16x8 vs0, vs1, ks0, ks1; } sr_[2];
#define SLOAD(i, k0) do { if (doV) { sr_[i].vs0 = *reinterpret_cast<const bf16x8*>(&Vh[(long)((k0) + sr) * LDV + sc]); sr_[i].vs1 = *reinterpret_cast<const bf16x8*>(&Vh[(long)((k0) + 32 + sr) * LDV + sc]); } \
    if (doK) { sr_[i].ks0 = *reinterpret_cast<const bf16x8*>(&Kh[(long)((k0) + sr) * LDK + sc]); sr_[i].ks1 = *reinterpret_cast<const bf16x8*>(&Kh[(long)((k0) + 32 + sr) * LDK + sc]); } } while (0)
#define SWRITE(b, i) do { if (doV) { *(bf16x8*)(V_lds + (b) * SHM_V + vst0) = sr_[i].vs0; *(bf16x8*)(V_lds + (b) * SHM_V + vst1) = sr_[i].vs1; } \
    if (doK) { const int kc = sc * 2; *(bf16x8*)(K_lds + (b) * SHM_K + KSWZ(sr, kc)) = sr_[i].ks0; *(bf16x8*)(K_lds + (b) * SHM_K + KSWZ(32 + sr, kc)) = sr_[i].ks1; } } while (0)
#define SWAIT() asm volatile("s_waitcnt vmcnt(4)" ::: "memory")
#define RESC(a) do { if (__any((a) < 1.f)) { if (hi == 0) al_l[r32] = (a); asm volatile("s_waitcnt lgkmcnt(0)" ::: "memory"); \
    _Pragma("unroll") for (int d = 0; d < 2; ++d) _Pragma("unroll") for (int r = 0; r < 16; ++r) o[d][r] *= al_l[crow(r, hi)]; } } while (0)
  f32x16 pA0, pA1, pB0, pB1; float mnA, mnB, alA, alB; bf16x8 pa0, pa1, pa2, pa3; const int NT = seq / KVBLK;
  constexpr int SE = 0, SO = 1;
  SLOAD(SE, 0); asm volatile("s_waitcnt vmcnt(0)" ::: "memory"); SWRITE(0, SE); __syncthreads();
  qkt(pA0, pA1, K_lds, qr, r32, hi); partialSM(pA0, pA1, m_reg, mnA, alA);
  SLOAD(SO, KVBLK); if (2 < NT) SLOAD(SE, 2 * KVBLK);
  SWAIT(); SWRITE(1, SO); __syncthreads();
  for (int j = 1; j + 1 < NT; j += 2) {
    SBAR(); qkt(pB0, pB1, K_lds + SHM_K, qr, r32, hi);
    finishSM(pA0, pA1, alA, l_reg, pa0, pa1, pa2, pa3); SBAR();
    SLOAD(SO, (j + 2) * KVBLK); SBAR();
    pv_d0(o, vb0, pa0, pa1, pa2, pa3); partialSM(pB0, pB1, m_reg, mnB, alB);
    __syncthreads(); SWAIT(); SWRITE(0, SE);
    RESC(alB); __syncthreads();
    SBAR(); qkt(pA0, pA1, K_lds, qr, r32, hi);
    finishSM(pB0, pB1, alB, l_reg, pa0, pa1, pa2, pa3); SBAR();
    if (j + 3 < NT) SLOAD(SE, (j + 3) * KVBLK); SBAR();
    pv_d0(o, vb0 + SHM_V, pa0, pa1, pa2, pa3); partialSM(pA0, pA1, m_reg, mnA, alA);
    __syncthreads(); SWAIT(); SWRITE(1, SO);
    RESC(alA); __syncthreads();
  }
  SBAR(); qkt(pB0, pB1, K_lds + SHM_K, qr, r32, hi);
  finishSM(pA0, pA1, alA, l_reg, pa0, pa1, pa2, pa3); SBAR();
  pv_d0(o, vb0, pa0, pa1, pa2, pa3); partialSM(pB0, pB1, m_reg, mnB, alB);
  __syncthreads(); RESC(alB);
  finishSM(pB0, pB1, alB, l_reg, pa0, pa1, pa2, pa3); SBAR();
  pv_d0(o, vb0 + SHM_V, pa0, pa1, pa2, pa3);
  __syncthreads();
  { float* st = (float*)lds + wid * (32 * 68);
#pragma unroll
    for (int r = 0; r < 16; ++r) { const int orow = crow(r, hi); st[orow * 68 + r32] = o[0][r]; st[orow * 68 + 32 + r32] = o[1][r]; }
    asm volatile("s_waitcnt lgkmcnt(0)" ::: "memory");
    float v[32]; float s = 0.f;
#pragma unroll
    for (int j = 0; j < 8; ++j) { const f32x4 t = *(const f32x4*)(st + r32 * 68 + hi * 32 + 4 * j); v[4 * j] = t.x; v[4 * j + 1] = t.y; v[4 * j + 2] = t.z; v[4 * j + 3] = t.w; s += (t.x * t.x + t.y * t.y) + (t.z * t.z + t.w * t.w); }
    { auto rr = __builtin_amdgcn_permlane32_swap(__float_as_uint(s), __float_as_uint(s), false, false); s = __uint_as_float(rr[0]) + __uint_as_float(rr[1]); }
    const float rl = 1.f / l_reg; const float fac = rl * rsqrtf(s * rl * rl * (1.f / 64.f) + 1e-6f);
    bf16* yp = Yb + (long)(wid * QBLK + r32) * LDO + hi * 32; const float* gp = gh + hi * 32;
#pragma unroll
    for (int j = 0; j < 4; ++j) { float w[8];
#pragma unroll
      for (int e = 0; e < 8; ++e) w[e] = v[8 * j + e] * fac * gp[8 * j + e];
      *(v4u*)(yp + 8 * j) = pack8(w); } }
  __syncthreads();
#undef SLOAD
#undef SWRITE
#undef SWAIT
#undef RESC
}
#undef KSWZ
#undef SBAR
}

__device__ __forceinline__ int queue_pull(Frame& F, gu32* heads, int nq, int nper, int myq) {
  volatile LAS int* slot = (volatile LAS int*)(F.lds + LDSCTL_OFF);
  if (F.tid == 0) { int got = -1;
    for (int k = 0; k < nq; ++k) { const int q = (myq + k) % nq;
      if (__hip_atomic_load(heads + 64 * q, RLX_AGENT) >= (unsigned)nper) continue;
      const unsigned i = __hip_atomic_fetch_add(heads + 64 * q, 1u, RLX_AGENT);
      if (i < (unsigned)nper) { got = q * nper + (int)i; break; } }
    *slot = got; }
  __syncthreads();
  const int r = *slot;
  __syncthreads();
  return r;
}
__device__ __forceinline__ void p3_attention(Frame& F, const Args& a, char* lds_generic, unsigned xcc) {
  unsigned char* ws = F.ws;
  const bf16* QMp = (const bf16*)(ws + WS_QM); const bf16* KMp = (const bf16*)(ws + WS_KM); const bf16* VMp = (const bf16*)(ws + WS_VM); bf16* Y = (bf16*)(ws + WS_Y);
  for (;;) {
    const int u = queue_pull(F, F.ctl + CW_Q, 8, 64, (int)(xcc & 7u));
    if (u < 0) break;
    const int bh = u >> 4, qb = u & 15, b = bh >> 3, h = bh & 7;
    mla::attn_unit(QMp + ((size_t)b * SEQ + qb * 256) * 768 + h * 96, KMp + (size_t)b * SEQ * 768 + h * 96, VMp + (size_t)b * SEQ * 512 + h * 64,
                   Y + ((size_t)b * SEQ + qb * 256) * 1024 + 512 + h * 64, (const float*)a.in[I_GHA] + h * 64, SEQ, lds_generic);
  }
}
namespace mls {
using mla::crow; using mla::v_st; using mla::v_rd_base;
#define KSWZ(row, colB) ((row) * 256 + ((colB) ^ (((row) & 7) << 4)))
constexpr int OFF_QS = 0, OFF_KS = 16384, OFF_KP = 32768, OFF_VV = 49152, OFF_CT = 65536, OFF_SC = 98304, OFF_NB = 99328, OFF_NP = 100352, OFF_CH = 104448, OFF_WS = 105472;
template <int OFF> __device__ __forceinline__ s16x4 trr(int vb) { s16x4 r; asm volatile("ds_read_b64_tr_b16 %0, %1 offset:%2" : "=&v"(r) : "v"(vb), "i"(OFF) : "memory"); return r; }
#define PKF(L, H) (bf16x8){L[0], L[1], L[2], L[3], H[0], H[1], H[2], H[3]}
__device__ __forceinline__ void vfrags(int img, int d0, int lane, bf16x8 (&f)[4]) {
  const int vb = img + v_rd_base(lane) + d0 * 512;
  const s16x4 l0 = trr<0>(vb), h0 = trr<2048>(vb), l1 = trr<4096>(vb), h1 = trr<4096 + 2048>(vb), l2 = trr<8192>(vb), h2 = trr<8192 + 2048>(vb), l3 = trr<12288>(vb), h3 = trr<12288 + 2048>(vb);
  asm volatile("s_waitcnt lgkmcnt(0)" ::: "memory"); __builtin_amdgcn_sched_barrier(0);
  f[0] = PKF(l0, h0); f[1] = PKF(l1, h1); f[2] = PKF(l2, h2); f[3] = PKF(l3, h3);
}
__device__ __forceinline__ void pack_p(const f32x16& p0, const f32x16& p1, bf16x8& pa0, bf16x8& pa1, bf16x8& pa2, bf16x8& pa3) {
#define PK4(P, BASE, OUT) do { unsigned a0 = cvt_pk_bf16(P[BASE + 0], P[BASE + 1]), a1 = cvt_pk_bf16(P[BASE + 2], P[BASE + 3]);   \
    unsigned b0 = cvt_pk_bf16(P[BASE + 4], P[BASE + 5]), b1 = cvt_pk_bf16(P[BASE + 6], P[BASE + 7]);                              \
    auto r0 = __builtin_amdgcn_permlane32_swap(a0, b0, false, false); auto r1 = __builtin_amdgcn_permlane32_swap(a1, b1, false, false); \
    v4u w = {r0[0], r1[0], r0[1], r1[1]}; OUT = __builtin_bit_cast(bf16x8, w); } while (0)
  PK4(p0, 0, pa0); PK4(p0, 8, pa1); PK4(p1, 0, pa2); PK4(p1, 8, pa3);
#undef PK4
}
__device__ __forceinline__ float swap_add(float v) { auto rr = __builtin_amdgcn_permlane32_swap(__float_as_uint(v), __float_as_uint(v), false, false); return __uint_as_float(rr[0]) + __uint_as_float(rr[1]); }

__device__ __forceinline__ void mlstm_seq(int seq, unsigned char* ws, char* lds) {
  int tid = threadIdx.x; asm volatile("" : "+v"(tid));
  const int wid = __builtin_amdgcn_readfirstlane(tid >> 6), lane = tid & 63, r32 = lane & 31, hi = lane >> 5, rb = wid >> 2, cb = wid & 3;
  const int dir = seq & 1, h = (seq >> 1) & 3, b = seq >> 3;
  const bf16* QC = (const bf16*)(ws + WS_QC); const bf16* KC = (const bf16*)(ws + WS_KC); const bf16* P = (const bf16*)(ws + WS_PROJ);
  const float* gs = (const float*)(ws + WS_GSC) + (size_t)seq * 3 * SEQ; const float* dec = (const float*)(ws + WS_DEC) + seq * 128;
  bf16* H = (bf16*)(ws + (dir ? WS_HB : WS_HF));
  float* sc_alpha = (float*)(lds + OFF_SC); float* sc_a = sc_alpha + 64; float* sc_iw = sc_alpha + 128; float* sc_en = sc_alpha + 192;
  float* nbuf = (float*)(lds + OFF_NB); float* npart = (float*)(lds + OFF_NP);
  float* ch_mprev = (float*)(lds + OFF_CH); float* ch_mnew = ch_mprev + 64; float* ch_dec = ch_mprev + 128; float* ch_g = ch_mprev + 192;
  float* wsf = (float*)(lds + OFF_WS) + wid * 32;
  const int ldsb = (int)(uintptr_t)lds;
  if (tid < 64) {
    if (tid == 0) { float m = 0.f; for (int c = 0; c < 64; ++c) { const float g = dec[c], wm = dec[64 + c]; const float mn = fmaxf(g + m, g + wm); ch_mprev[c] = m; ch_mnew[c] = mn; ch_dec[c] = __expf(g + m - mn); ch_g[c] = g; m = mn; } } }
  for (int i = tid; i < 32768 / 16; i += NTHR) ((v4u*)(lds + OFF_CT))[i] = (v4u){0u, 0u, 0u, 0u};
  if (tid < 128) nbuf[tid] = 0.f;
  f32x16 cacc[2]; cacc[0] = f32x16{}; cacc[1] = f32x16{};
  __syncthreads();
  const int sr = tid >> 4, sc = (tid & 15) * 8;
  v4u gq0, gq1, gk0, gk1, gv0, gv1; float ga0, ga1, sb = 0.f, sa = 0.f, spm = 0.f;
#define ROWOF(p) ((size_t)b * SEQ + (dir ? (SEQ - 1 - (p)) : (p)))
#define LOADC(c) do { const int p0_ = 64 * (c) + sr, p1_ = p0_ + 32; const size_t r0_ = ROWOF(p0_), r1_ = ROWOF(p1_); \
    gq0 = *(const v4u*)(QC + r0_ * 512 + h * 128 + sc); gq1 = *(const v4u*)(QC + r1_ * 512 + h * 128 + sc); \
    gk0 = *(const v4u*)(KC + r0_ * 512 + h * 128 + sc); gk1 = *(const v4u*)(KC + r1_ * 512 + h * 128 + sc); \
    gv0 = *(const v4u*)(P + r0_ * PROJ_LD + 1024 + h * 128 + sc); gv1 = *(const v4u*)(P + r1_ * PROJ_LD + 1024 + h * 128 + sc); \
    ga0 = gs[SEQ + p0_]; ga1 = gs[SEQ + p1_]; \
    if (tid < 64) { sb = gs[64 * (c) + tid]; sa = gs[SEQ + 64 * (c) + tid]; spm = gs[2 * SEQ + 64 * (c) + tid]; } } while (0)
#define WRITEC(c) do { \
    *(v4u*)(lds + OFF_QS + KSWZ(sr, sc * 2)) = gq0; *(v4u*)(lds + OFF_QS + KSWZ(32 + sr, sc * 2)) = gq1; \
    *(v4u*)(lds + OFF_KS + KSWZ(sr, sc * 2)) = gk0; *(v4u*)(lds + OFF_KS + KSWZ(32 + sr, sc * 2)) = gk1; \
    *(v4u*)(lds + OFF_VV + v_st(sr, sc)) = gv0; *(v4u*)(lds + OFF_VV + v_st(32 + sr, sc)) = gv1; \
    { const float gc_ = ch_g[c], mn_ = ch_mnew[c]; const float w0_ = __expf(gc_ + ga0 - mn_), w1_ = __expf(gc_ + ga1 - mn_); float f0_[8], f1_[8], cs_[8]; unpack8(gk0, f0_); unpack8(gk1, f1_); \
      _Pragma("unroll") for (int j = 0; j < 8; ++j) { f0_[j] *= w0_; f1_[j] *= w1_; cs_[j] = f0_[j] + f1_[j]; } \
      *(v4u*)(lds + OFF_KP + v_st(sr, sc)) = pack8(f0_); *(v4u*)(lds + OFF_KP + v_st(32 + sr, sc)) = pack8(f1_); \
      _Pragma("unroll") for (int j = 0; j < 8; ++j) { cs_[j] += __shfl_xor(cs_[j], 16); cs_[j] += __shfl_xor(cs_[j], 32); } \
      if ((lane >> 4) == 0) { _Pragma("unroll") for (int j = 0; j < 8; ++j) npart[wid * 128 + sc + j] = cs_[j]; } } \
    if (tid < 64) { const float m_ = ch_mprev[c]; const float mt_ = fmaxf(sb + m_, sb + spm); sc_alpha[tid] = sb - mt_; sc_a[tid] = sa; sc_iw[tid] = __expf(sb + m_ - mt_); sc_en[tid] = __expf(-mt_); } } while (0)
  LOADC(0); WRITEC(0);
  __syncthreads();
  for (int c = 0; c < 64; ++c) {
    if (c + 1 < 64) LOADC(c + 1);
    const float* nb = nbuf + (c & 1) * 128;
    if (tid < 128) { float s = 0.f;
#pragma unroll
      for (int w = 0; w < 8; ++w) s += npart[w * 128 + tid];
      nbuf[((c + 1) & 1) * 128 + tid] = ch_dec[c] * nb[tid] + s; }
    bf16x8 qr[8];
#pragma unroll
    for (int d0 = 0; d0 < 8; ++d0) qr[d0] = *(const bf16x8*)(lds + OFF_QS + KSWZ(32 * rb + r32, (16 * d0 + 8 * hi) * 2));
    f32x16 p0 = f32x16{}, p1 = f32x16{};
#pragma unroll
    for (int d0 = 0; d0 < 8; ++d0) { const bf16x8 k0 = *(const bf16x8*)(lds + OFF_KS + KSWZ(r32, (16 * d0 + 8 * hi) * 2)); p0 = __builtin_amdgcn_mfma_f32_32x32x16_bf16(k0, qr[d0], p0, 0, 0, 0); }
    if (rb == 1) {
#pragma unroll
      for (int d0 = 0; d0 < 8; ++d0) { const bf16x8 k1 = *(const bf16x8*)(lds + OFF_KS + KSWZ(32 + r32, (16 * d0 + 8 * hi) * 2)); p1 = __builtin_amdgcn_mfma_f32_32x32x16_bf16(k1, qr[d0], p1, 0, 0, 0); }
    }
    const float al = sc_alpha[32 * rb + r32];
    if (rb == 0) {
#pragma unroll
      for (int r = 0; r < 16; ++r) { const int sl = crow(r, hi); p0[r] = (sl <= r32) ? __expf(al + sc_a[sl]) * p0[r] : 0.f; }
    } else {
#pragma unroll
      for (int r = 0; r < 16; ++r) { const int sl = crow(r, hi); p0[r] = __expf(al + sc_a[sl]) * p0[r]; p1[r] = (sl <= r32) ? __expf(al + sc_a[32 + sl]) * p1[r] : 0.f; }
    }
    float ps = 0.f;
#pragma unroll
    for (int r = 0; r < 16; ++r) ps += p0[r] + p1[r];
    ps = swap_add(ps);
    bf16x8 pa0, pa1, pa2, pa3; pack_p(p0, p1, pa0, pa1, pa2, pa3);
    float qn = 0.f;
#pragma unroll
    for (int d0 = 0; d0 < 8; ++d0) { const f32x4 n0 = *(const f32x4*)(nb + 16 * d0 + 8 * hi), n1 = *(const f32x4*)(nb + 16 * d0 + 8 * hi + 4); const v4u qw = __builtin_bit_cast(v4u, qr[d0]);
      qn += bflo(qw.x) * n0.x + bfhi(qw.x) * n0.y + bflo(qw.y) * n0.z + bfhi(qw.y) * n0.w + bflo(qw.z) * n1.x + bfhi(qw.z) * n1.y + bflo(qw.w) * n1.z + bfhi(qw.w) * n1.w; }
    qn = swap_add(qn);
    { const float iwt = sc_iw[32 * rb + r32]; const float den = iwt * qn + ps; const float rd = 1.f / fmaxf(fabsf(den), sc_en[32 * rb + r32]); if (hi == 0) wsf[r32] = rd; }
    f32x16 o = f32x16{};
#pragma unroll
    for (int d0 = 0; d0 < 8; ++d0) { const bf16x8 cf = *(const bf16x8*)(lds + OFF_CT + KSWZ(32 * cb + r32, (16 * d0 + 8 * hi) * 2)); o = __builtin_amdgcn_mfma_f32_32x32x16_bf16(qr[d0], cf, o, 0, 0, 0); }
#pragma unroll
    for (int r = 0; r < 16; ++r) o[r] *= sc_iw[32 * rb + crow(r, hi)];
    bf16x8 vf[4]; vfrags(ldsb + OFF_VV, cb, lane, vf);
    o = __builtin_amdgcn_mfma_f32_32x32x16_bf16(pa0, vf[0], o, 0, 0, 0); o = __builtin_amdgcn_mfma_f32_32x32x16_bf16(pa1, vf[1], o, 0, 0, 0);
    if (rb == 1) { o = __builtin_amdgcn_mfma_f32_32x32x16_bf16(pa2, vf[2], o, 0, 0, 0); o = __builtin_amdgcn_mfma_f32_32x32x16_bf16(pa3, vf[3], o, 0, 0, 0); }
    asm volatile("s_waitcnt lgkmcnt(0)" ::: "memory");
#pragma unroll
    for (int r = 0; r < 16; ++r) { const int tl = crow(r, hi); const int p = 64 * c + 32 * rb + tl; H[ROWOF(p) * 512 + h * 128 + 32 * cb + r32] = (bf16)f2bf(o[r] * wsf[tl]); }
    { const float dc = ch_dec[c];
#pragma unroll
      for (int i = 0; i < 2; ++i) { bf16x8 kf[4]; vfrags(ldsb + OFF_KP, 2 * rb + i, lane, kf);
#pragma unroll
        for (int r = 0; r < 16; ++r) cacc[i][r] *= dc;
#pragma unroll
        for (int ks = 0; ks < 4; ++ks) cacc[i] = __builtin_amdgcn_mfma_f32_32x32x16_bf16(kf[ks], vf[ks], cacc[i], 0, 0, 0); } }
    __syncthreads();
#pragma unroll
    for (int i = 0; i < 2; ++i)
#pragma unroll
      for (int g = 0; g < 4; ++g) { const int d = 32 * (2 * rb + i) + 8 * g + 4 * hi, e = 32 * cb + r32;
        v2u w; w.x = cvt_pk_bf16(cacc[i][4 * g], cacc[i][4 * g + 1]); w.y = cvt_pk_bf16(cacc[i][4 * g + 2], cacc[i][4 * g + 3]);
        *(v2u*)(lds + OFF_CT + KSWZ(e, d * 2)) = w; }
    if (c + 1 < 64) WRITEC(c + 1);
    __syncthreads();
  }
#undef ROWOF
#undef LOADC
#undef WRITEC
}
#undef KSWZ
#undef PKF
}

__device__ __forceinline__ void p3_mixers(Frame& F, const Args& a, char* lds_generic, unsigned xcc) {
  for (;;) { const int it = queue_pull(F, F.ctl + CW_Q + 64 * 8, 8, 4, (int)(xcc & 7u)); if (it < 0) break; mls::mlstm_seq(it, F.ws, lds_generic); __syncthreads(); }
  p3_attention(F, a, lds_generic, xcc);
}
__device__ __forceinline__ void p4_combine(Frame& F, const Args& a) {
  unsigned char* ws = F.ws; const bf16* HF = (const bf16*)(ws + WS_HF); const bf16* HB = (const bf16*)(ws + WS_HB); const bf16* P = (const bf16*)(ws + WS_PROJ); bf16* Y = (bf16*)(ws + WS_Y);
  const float* g = (const float*)a.in[I_GHM];
  const int gw = F.vcu * NWAVES + F.wave, NGW = F.G * NWAVES, c = F.lane * 8;
  float gg[8];
#pragma unroll
  for (int j = 0; j < 8; ++j) gg[j] = g[c + j];
  for (int m = gw; m < MTOK; m += NGW) {
    float f[8], bb[8], oo[8]; unpack8(*(const v4u*)(HF + (size_t)m * 512 + c), f); unpack8(*(const v4u*)(HB + (size_t)m * 512 + c), bb); unpack8(*(const v4u*)(P + (size_t)m * PROJ_LD + 1536 + c), oo);
    float s = 0.f;
#pragma unroll
    for (int j = 0; j < 8; ++j) { f[j] += bb[j]; s += f[j] * f[j]; }
    s += __shfl_xor(s, 1); s += __shfl_xor(s, 2); s += __shfl_xor(s, 4); s += __shfl_xor(s, 8);
    const float r = rsqrtf(s * (1.f / 128.f) + 1e-6f);
#pragma unroll
    for (int j = 0; j < 8; ++j) f[j] = f[j] * r * gg[j] * sigmoidf_(oo[j]);
    *(v4u*)(Y + (size_t)m * 1024 + c) = pack8(f);
  }
}
struct EpiResid { static constexpr bool TWO_PASS = false; const float* base; float* out; bf16* outb; float* ss;
  __device__ __forceinline__ void row8(const pg8::Unit& u, int rloc, int cloc, const float (&a0)[8], const float (&a1)[8], int fq) const {
    const int row = u.pm * 256 + rloc; const size_t off = (size_t)row * 1024 + u.pn * 256 + cloc;
    const f32x4 b0 = *(const f32x4*)(base + off), b1 = *(const f32x4*)(base + off + 4), b2 = *(const f32x4*)(base + off + 128), b3 = *(const f32x4*)(base + off + 132);
    float v0[8], v1[8];
#pragma unroll
    for (int i = 0; i < 4; ++i) { v0[i] = a0[i] + b0[i]; v0[4 + i] = a0[4 + i] + b1[i]; v1[i] = a1[i] + b2[i]; v1[4 + i] = a1[4 + i] + b3[i]; }
    *(f32x4*)(out + off) = (f32x4){v0[0], v0[1], v0[2], v0[3]}; *(f32x4*)(out + off + 4) = (f32x4){v0[4], v0[5], v0[6], v0[7]};
    *(f32x4*)(out + off + 128) = (f32x4){v1[0], v1[1], v1[2], v1[3]}; *(f32x4*)(out + off + 132) = (f32x4){v1[4], v1[5], v1[6], v1[7]};
    *(v4u*)(outb + off) = pack8(v0); *(v4u*)(outb + off + 128) = pack8(v1);
    float s = sumsq8(v0) + sumsq8(v1); s += __shfl_xor(s, 16); s += __shfl_xor(s, 32); if (fq == 0) unsafeAtomicAdd(ss + row, s); } };
struct EpiScale { static constexpr bool TWO_PASS = false; bf16* O; const float* ss;
  __device__ __forceinline__ void row8(const pg8::Unit& u, int rloc, int cloc, const float (&a0)[8], const float (&a1)[8], int fq) const {
    const int row = u.pm * 256 + rloc; const float r = rsqrtf(ss[row] * (1.f / 1024.f) + 1e-6f); float v0[8], v1[8];
#pragma unroll
    for (int i = 0; i < 8; ++i) { v0[i] = a0[i] * r; v1[i] = a1[i] * r; }
    bf16* p = O + (size_t)row * 1024 + u.pn * 256 + cloc; *(v4u*)p = pack8(v0); *(v4u*)(p + 128) = pack8(v1); } };
struct EpiSoftmax { static constexpr bool TWO_PASS = true; bf16* O; float scale; LAS float* xch;
  __device__ __forceinline__ void pass1(const pg8::Unit& u, int rloc, int wc, float (&v0)[8], float (&v1)[8], int fq) const {
    float mx = -3.0e38f;
#pragma unroll
    for (int i = 0; i < 8; ++i) { v0[i] *= scale; v1[i] *= scale; mx = fmaxf(mx, fmaxf(v0[i], v1[i])); }
    mx = fmaxf(mx, __shfl_xor(mx, 16)); mx = fmaxf(mx, __shfl_xor(mx, 32));
    float l = 0.f;
#pragma unroll
    for (int i = 0; i < 8; ++i) { v0[i] = __expf(v0[i] - mx); v1[i] = __expf(v1[i] - mx); l += v0[i] + v1[i]; }
    l += __shfl_xor(l, 16); l += __shfl_xor(l, 32);
    if (fq == 0) { xch[(rloc * 4 + wc) * 2] = mx; xch[(rloc * 4 + wc) * 2 + 1] = l; } }
  __device__ __forceinline__ void row8(const pg8::Unit& u, int rloc, int cloc, const float (&a0)[8], const float (&a1)[8], int fq) const {
    const int wc = cloc >> 5; float m[4], l[4]; float M = -3.0e38f;
#pragma unroll
    for (int w = 0; w < 4; ++w) { m[w] = xch[(rloc * 4 + w) * 2]; l[w] = xch[(rloc * 4 + w) * 2 + 1]; M = fmaxf(M, m[w]); }
    float L = 0.f, mine = 0.f;
#pragma unroll
    for (int w = 0; w < 4; ++w) { const float e = __expf(m[w] - M); L += l[w] * e; if (w == wc) mine = e; }
    const float f = mine / L; float v0[8], v1[8];
#pragma unroll
    for (int i = 0; i < 8; ++i) { v0[i] = a0[i] * f; v1[i] = a1[i] * f; }
    bf16* p = O + (size_t)(u.pm * 256 + rloc) * 1024 + u.pn * 256 + cloc; *(v4u*)p = pack8(v0); *(v4u*)(p + 128) = pack8(v1); } };
struct MemOrder { int G, c, kind;
  __device__ bool next(int i, pg8::Unit& u) const { const int L = i * G + c; if (L >= 256) return false;
    const int bh = L >> 4, t = L & 15, b = bh >> 2, h = bh & 3;
    u.pm = b * 16 + t; u.pn = h; u.g = 0; u.ibase = 0; u.aoff = ((long)(b * SEQ + t * 256)) * 1024 + h * 256;
    u.boff = kind == 0 ? ((long)(b * NMEM)) * 1024 + h * 256 : ((long)(h * 256)) * 1024 + b * NMEM; return true; } };
constexpr size_t WS_ROWSEL = WS_SEL, WS_GSEL = WS_SEL + 131072, WS_INV = 31 * MiB, WS_YE = 160 * MiB;
__device__ __forceinline__ void p10_router(Frame& F, const Args& a) {
  unsigned char* ws = F.ws; const float* X2 = (const float*)(ws + WS_X2); const float* ss2 = (const float*)(ws + CTL_SS2); float* AFF = (float*)(ws + WS_AFF);
  const float* wr = (const float*)a.in[I_WR]; const float* gf = (const float*)a.in[I_GFFN];
  const int gw = F.vcu * NWAVES + F.wave, NGW = F.G * NWAVES;
  for (int m = gw; m < MTOK; m += NGW) {
    float acc[16];
#pragma unroll
    for (int e = 0; e < 16; ++e) acc[e] = 0.f;
#pragma unroll
    for (int j = 0; j < 4; ++j) { const int k0 = 256 * j + 4 * F.lane; const f32x4 xv = *(const f32x4*)(X2 + (size_t)m * 1024 + k0); const f32x4 gv = *(const f32x4*)(gf + k0);
#pragma unroll
      for (int i = 0; i < 4; ++i) { const float xg = xv[i] * gv[i]; const f32x4* w4 = (const f32x4*)(wr + (size_t)(k0 + i) * 16);
#pragma unroll
        for (int q = 0; q < 4; ++q) { const f32x4 w = w4[q]; acc[4 * q] += xg * w.x; acc[4 * q + 1] += xg * w.y; acc[4 * q + 2] += xg * w.z; acc[4 * q + 3] += xg * w.w; } } }
#pragma unroll
    for (int e = 0; e < 16; ++e) acc[e] = wave_sum(acc[e]);
    const float r = rsqrtf(ss2[m] * (1.f / 1024.f) + 1e-6f); float mx = -3.0e38f;
#pragma unroll
    for (int e = 0; e < 16; ++e) { acc[e] *= r; mx = fmaxf(mx, acc[e]); }
    float l = 0.f;
#pragma unroll
    for (int e = 0; e < 16; ++e) { acc[e] = __expf(acc[e] - mx); l += acc[e]; }
    const float rl = 1.f / l;
    if (F.lane < 16) { float v = 0.f;
#pragma unroll
      for (int e = 0; e < 16; ++e) if (e == F.lane) v = acc[e];
      AFF[(size_t)m * 16 + F.lane] = v * rl; }
  }
}
__device__ __forceinline__ void p11_topk(Frame& F, char* lds) {
  unsigned char* ws = F.ws; const float* AFF = (const float*)(ws + WS_AFF); int* ROWSEL = (int*)(ws + WS_ROWSEL); float* GSEL = (float*)(ws + WS_GSEL); int* INV = (int*)(ws + WS_INV);
  unsigned* hist = (unsigned*)lds; unsigned* ctl = hist + 256; unsigned* wsum = hist + 320;
  const int tid = F.tid, lane = F.lane, wid = F.wave;
  for (int it = (int)blockIdx.x; it < BATCH * NEXP; it += F.G) { const int b = it >> 4, e = it & 15;
    unsigned key[8];
#pragma unroll
    for (int j = 0; j < 8; ++j) key[j] = __float_as_uint(AFF[((size_t)b * SEQ + 8 * tid + j) * 16 + e]);
    unsigned prefix = 0u, mask = 0u, need = CAP;
    for (int shift = 24; shift >= 0; shift -= 8) {
      if (tid < 256) hist[tid] = 0u;
      __syncthreads();
#pragma unroll
      for (int j = 0; j < 8; ++j) if ((key[j] & mask) == prefix) atomicAdd(&hist[(key[j] >> shift) & 255u], 1u);
      __syncthreads();
      if (tid == 0) { unsigned above = 0u; int d = 255; for (; d > 0; --d) { const unsigned c = hist[d]; if (above + c >= need) break; above += c; } ctl[0] = (unsigned)d; ctl[1] = need - above; }
      __syncthreads();
      prefix |= ctl[0] << shift; mask |= 255u << shift; need = ctl[1];
      __syncthreads();
    }
    unsigned ngt = 0u, neq = 0u;
#pragma unroll
    for (int j = 0; j < 8; ++j) { ngt += key[j] > prefix ? 1u : 0u; neq += key[j] == prefix ? 1u : 0u; }
    unsigned sgt = ngt, seq_ = neq;
#pragma unroll
    for (int o = 1; o < 64; o <<= 1) { const unsigned y0 = __shfl_up(sgt, o), y1 = __shfl_up(seq_, o); if (lane >= o) { sgt += y0; seq_ += y1; } }
    if (lane == 63) { wsum[wid] = sgt; wsum[8 + wid] = seq_; }
    __syncthreads();
    unsigned bgt = 0u, beq = 0u, tgt = 0u;
#pragma unroll
    for (int w = 0; w < 8; ++w) { const unsigned g = wsum[w], q = wsum[8 + w]; if (w < wid) { bgt += g; beq += q; } tgt += g; }
    unsigned pgt = bgt + sgt - ngt, peq = beq + seq_ - neq;
#pragma unroll
    for (int j = 0; j < 8; ++j) { const int t = 8 * tid + j; int slot = -1;
      if (key[j] > prefix) slot = (int)pgt++; else if (key[j] == prefix) { if (peq < need) slot = (int)(tgt + peq); ++peq; }
      INV[((size_t)b * SEQ + t) * 16 + e] = slot;
      if (slot >= 0) { ROWSEL[e * 2048 + b * 512 + slot] = b * SEQ + t; GSEL[e * 2048 + b * 512 + slot] = __uint_as_float(key[j]); } }
    __syncthreads();
  }
}
struct MoeGUOrder { int G, c;
  __device__ bool next(int i, pg8::Unit& u) const { const int L = i * G + c; if (L >= 2048) return false;
    const int e = L >> 7, r = L & 127, pn = r >> 3, mt = r & 7;
    u.g = e; u.pm = mt; u.pn = pn; u.ibase = e * 2048 + mt * 256; u.aoff = 0; u.boff = ((long)e * 4096 + pn * 256) * 1024; return true; } };
struct MoeDownOrder { int G, c;
  __device__ bool next(int i, pg8::Unit& u) const { const int L = i * G + c; if (L >= 512) return false;
    const int e = L >> 5, r = L & 31, pn = r >> 3, mt = r & 7;
    u.g = e; u.pm = mt; u.pn = pn; u.ibase = e * 2048 + mt * 256; u.aoff = ((long)e * 2048 + mt * 256) * 2048; u.boff = ((long)e * 1024 + pn * 256) * 2048; return true; } };
struct EpiGU { static constexpr bool TWO_PASS = false; bf16* H; const float* ss2; const int* rowsel;
  __device__ __forceinline__ void row8(const pg8::Unit& u, int rloc, int cloc, const float (&a0)[8], const float (&a1)[8], int fq) const {
    const int tok = rowsel[u.ibase + rloc]; const float r = rsqrtf(ss2[tok] * (1.f / 1024.f) + 1e-6f); float h[8];
#pragma unroll
    for (int i = 0; i < 8; ++i) { const float g = a0[i] * r, up = a1[i] * r; h[i] = g * sigmoidf_(g) * up; }
    *(v4u*)(H + ((size_t)u.g * 2048 + u.pm * 256 + rloc) * 2048 + u.pn * 128 + cloc) = pack8(h); } };
struct EpiYE { static constexpr bool TWO_PASS = false; bf16* Yp; const float* gsel;
  __device__ __forceinline__ void row8(const pg8::Unit& u, int rloc, int cloc, const float (&a0)[8], const float (&a1)[8], int fq) const {
    const float gv = gsel[u.ibase + rloc]; float v0[8], v1[8];
#pragma unroll
    for (int i = 0; i < 8; ++i) { v0[i] = a0[i] * gv; v1[i] = a1[i] * gv; }
    bf16* p = Yp + ((size_t)u.g * 2048 + u.pm * 256 + rloc) * 1024 + u.pn * 256 + cloc; *(v4u*)p = pack8(v0); *(v4u*)(p + 128) = pack8(v1); } };
__device__ __forceinline__ void p14_final(Frame& F, const Args& a) {
  unsigned char* ws = F.ws; const float* X2 = (const float*)(ws + WS_X2); const int* INV = (const int*)(ws + WS_INV); const bf16* YE = (const bf16*)(ws + WS_YE);
  const float* gfin = (const float*)a.in[I_GFIN]; float* out = a.out;
  const int gw = F.vcu * NWAVES + F.wave, NGW = F.G * NWAVES;
  for (int m = gw; m < MTOK; m += NGW) { const int b = m >> 12;
    f32x4 v[4];
#pragma unroll
    for (int j = 0; j < 4; ++j) v[j] = *(const f32x4*)(X2 + (size_t)m * 1024 + 256 * j + 4 * F.lane);
    const int myinv = F.lane < 16 ? INV[(size_t)m * 16 + F.lane] : -1;
#pragma unroll
    for (int e = 0; e < 16; ++e) { const int slot = __shfl(myinv, e);
      if (slot >= 0) { const bf16* yr = YE + ((size_t)e * 2048 + b * 512 + slot) * 1024 + 4 * F.lane;
#pragma unroll
        for (int j = 0; j < 4; ++j) { const v2u w = *(const v2u*)(yr + 256 * j); v[j].x += bflo(w.x); v[j].y += bfhi(w.x); v[j].z += bflo(w.y); v[j].w += bfhi(w.y); } } }
    float s = 0.f;
#pragma unroll
    for (int j = 0; j < 4; ++j) s += (v[j].x * v[j].x + v[j].y * v[j].y) + (v[j].z * v[j].z + v[j].w * v[j].w);
    const float r = rsqrtf(wave_sum(s) * (1.f / 1024.f) + 1e-6f);
#pragma unroll
    for (int j = 0; j < 4; ++j) { const f32x4 g = *(const f32x4*)(gfin + 256 * j + 4 * F.lane); *(f32x4*)(out + (size_t)m * 1024 + 256 * j + 4 * F.lane) = v[j] * r * g; }
  }
}
__global__ void __launch_bounds__(NTHR, 2) mk(Args a) {
  extern __shared__ __attribute__((aligned(16))) unsigned char lds_raw[];
  Frame F;
  F.lds = (LAS unsigned char*)lds_raw; F.MISC = (volatile LAS unsigned*)(F.lds + LDSCTL_OFF + 320);
  F.tid = threadIdx.x; F.lane = F.tid & 63; F.wave = __builtin_amdgcn_readfirstlane(F.tid >> 6);
  F.G = gridDim.x; { const int bx = blockIdx.x; F.vcu = (F.G % 8 == 0) ? (bx % 8) * (F.G / 8) + bx / 8 : bx; }
  F.ws = a.ws; F.ctl = (gu32*)(a.ws + WS_CTL);
  unsigned char* ws = a.ws;
  for (int u = F.tid; u < (LDS_BYTES - LDSCTL_OFF) / 4; u += NTHR) ((LAS unsigned*)(F.lds + LDSCTL_OFF))[u] = 0u;
  __syncthreads();
  XcdBarrier bar = xcd_barrier_post((unsigned*)(F.ctl + CW_BAR), F.MISC + 8);
  const int lo = a.ph_lo, hi = a.ph_hi;
#define IN(k) (lo <= (k) && (k) < hi)
#define BOTH(k) (IN(k) && IN((k) + 1))
#define GRID_BAR() xcd_barrier(bar)
  float* ssq = (float*)(ws + CTL_SSQ); float* sskv = (float*)(ws + CTL_SSKV);

  if (IN(0)) { p0_prologue(F, a, true, (a.flags & 1) != 0); if (BOTH(0)) GRID_BAR(); }

  if (IN(1)) {
    { pg8::Gemm g{(const bf16*)(ws + WS_XN), (const bf16*)(ws + WS_WIN), 1024, 1024, 1024, nullptr}; pg8::StaticOrder S; S.init(MTOK, PROJ_LD, F.G, (int)blockIdx.x, 1024, 1024);
      EpiProj E{(bf16*)(ws + WS_PROJ), ssq, sskv};
      pg8::gemm_phase<EpiProj, pg8::StaticOrder, false>(F.lds, g, S, E); }
    { pg8::Gemm g{(const bf16*)(ws + WS_MEMN), (const bf16*)(ws + WS_WMK), 1024, 1024, 1024, nullptr}; pg8::StaticOrder S; S.init(1024, 1024, F.G, (int)((blockIdx.x + 128u) % (unsigned)F.G), 1024, 1024);
      EpiStore E{(bf16*)(ws + WS_KMEM), 1024};
      pg8::gemm_phase<EpiStore, pg8::StaticOrder, false>(F.lds, g, S, E); }
    { pg8::Gemm g{(const bf16*)(ws + WS_WMV), (const bf16*)(ws + WS_MEMN), 1024, 1024, 1024, nullptr}; pg8::StaticOrder S; S.init(1024, 1024, F.G, (int)((blockIdx.x + 112u) % (unsigned)F.G), 1024, 1024);
      EpiStore E{(bf16*)(ws + WS_VMEMT), 1024};
      pg8::gemm_phase<EpiStore, pg8::StaticOrder, false>(F.lds, g, S, E); }
    if (BOTH(1)) GRID_BAR();
  }

  if (IN(2)) {
    { pg8::Gemm g{(const bf16*)(ws + WS_PROJ) + PC_CQ, (const bf16*)(ws + WS_WQB), PROJ_LD, 256, 256, nullptr}; pg8::StaticOrder S; S.init(MTOK, 768, F.G, (int)blockIdx.x, PROJ_LD, 256);
      EpiQ E{(bf16*)(ws + WS_QM), ssq, (const float*)(ws + WS_ROPE)};
      pg8::gemm_phase<EpiQ, pg8::StaticOrder, false>(F.lds, g, S, E); }
    { pg8::Gemm g{(const bf16*)(ws + WS_PROJ) + PC_CKV, (const bf16*)(ws + WS_WKVB), PROJ_LD, 256, 256, nullptr}; pg8::StaticOrder S; S.init(MTOK, 1024, F.G, (int)((blockIdx.x + 64u) % (unsigned)F.G), PROJ_LD, 256);
      EpiKV E{(bf16*)(ws + WS_KM), (bf16*)(ws + WS_VM), sskv};
      pg8::gemm_phase<EpiKV, pg8::StaticOrder, false>(F.lds, g, S, E); }
    p2_elementwise(F, a);
    if (BOTH(2)) GRID_BAR();
  }
  if (IN(3)) {
    p3_mixers(F, a, (char*)lds_raw, bar.x);
    if (BOTH(3)) GRID_BAR();
  }
  if (IN(4)) { p4_combine(F, a); if (BOTH(4)) GRID_BAR(); }
  float* ss1 = (float*)(ws + CTL_SS1); float* ss2 = (float*)(ws + CTL_SS2);
  if (IN(5)) {
    pg8::Gemm g{(const bf16*)(ws + WS_Y), (const bf16*)(ws + WS_WOUT), 1024, 1024, 1024, nullptr}; pg8::StaticOrder S; S.init(MTOK, 1024, F.G, (int)blockIdx.x, 1024, 1024);
    EpiResid E{(const float*)a.in[I_X], (float*)(ws + WS_X1), (bf16*)(ws + WS_X1B), ss1};
    pg8::gemm_phase<EpiResid, pg8::StaticOrder, false>(F.lds, g, S, E);
    if (BOTH(5)) GRID_BAR();
  }
  if (IN(6)) {
    pg8::Gemm g{(const bf16*)(ws + WS_X1B), (const bf16*)(ws + WS_WMQ), 1024, 1024, 1024, nullptr}; pg8::StaticOrder S; S.init(MTOK, 1024, F.G, (int)blockIdx.x, 1024, 1024);
    EpiScale E{(bf16*)(ws + WS_QMEM), ss1};
    pg8::gemm_phase<EpiScale, pg8::StaticOrder, false>(F.lds, g, S, E);
    if (BOTH(6)) GRID_BAR();
  }
  if (IN(7)) {
    pg8::Gemm g{(const bf16*)(ws + WS_QMEM), (const bf16*)(ws + WS_KMEM), 1024, 1024, 256, nullptr}; MemOrder S{F.G, (int)blockIdx.x, 0};
    EpiSoftmax E{(bf16*)(ws + WS_P), 0.0625f, (LAS float*)(F.lds + LDSCTL_OFF + 1024)};
    pg8::gemm_phase<EpiSoftmax, MemOrder, false>(F.lds, g, S, E);
    if (BOTH(7)) GRID_BAR();
  }
  if (IN(8)) {
    pg8::Gemm g{(const bf16*)(ws + WS_P), (const bf16*)(ws + WS_VMEMT), 1024, 1024, 256, nullptr}; MemOrder S{F.G, (int)blockIdx.x, 1};
    EpiStore E{(bf16*)(ws + WS_MO), 1024};
    pg8::gemm_phase<EpiStore, MemOrder, false>(F.lds, g, S, E);
    if (BOTH(8)) GRID_BAR();
  }
  if (IN(9)) {
    pg8::Gemm g{(const bf16*)(ws + WS_MO), (const bf16*)(ws + WS_WMO), 1024, 1024, 1024, nullptr}; pg8::StaticOrder S; S.init(MTOK, 1024, F.G, (int)blockIdx.x, 1024, 1024);
    EpiResid E{(const float*)(ws + WS_X1), (float*)(ws + WS_X2), (bf16*)(ws + WS_X2B), ss2};
    pg8::gemm_phase<EpiResid, pg8::StaticOrder, false>(F.lds, g, S, E);
    if (BOTH(9)) GRID_BAR();
  }
  if (IN(10)) { p10_router(F, a); if (BOTH(10)) GRID_BAR(); }
  if (IN(11)) { p11_topk(F, (char*)lds_raw); if (BOTH(11)) GRID_BAR(); }
  if (IN(12)) {
    pg8::Gemm g{(const bf16*)(ws + WS_X2B), (const bf16*)(ws + WS_WEGU), 1024, 1024, 1024, (const int*)(ws + WS_ROWSEL)}; MoeGUOrder S{F.G, (int)blockIdx.x};
    EpiGU E{(bf16*)(ws + WS_HID), ss2, (const int*)(ws + WS_ROWSEL)};
    pg8::gemm_phase<EpiGU, MoeGUOrder, true>(F.lds, g, S, E);
    if (BOTH(12)) GRID_BAR();
  }
  if (IN(13)) {
    pg8::Gemm g{(const bf16*)(ws + WS_HID), (const bf16*)(ws + WS_WED), 2048, 2048, 2048, nullptr}; MoeDownOrder S{F.G, (int)blockIdx.x};
    EpiYE E{(bf16*)(ws + WS_YE), (const float*)(ws + WS_GSEL)};
    pg8::gemm_phase<EpiYE, MoeDownOrder, false>(F.lds, g, S, E);
    if (BOTH(13)) GRID_BAR();
  }
  if (IN(14)) { p14_final(F, a); }
#undef IN
#undef BOTH
#undef GRID_BAR
}

__global__ __launch_bounds__(256) void adapt_b2f(const bf16* src, long lds_, long scol, float* dst, long ldd, long dcol, long rows, long ncols) {
  const long i = blockIdx.x * 256L + threadIdx.x; if (i >= rows * ncols) return;
  const long r = i / ncols, c = i % ncols; dst[r * ldd + dcol + c] = bf2f(src[r * lds_ + scol + c]);
}
static void adapt(hipStream_t s, const void* src, long lds_, long scol, float* dst, long ldd, long dcol, long rows, long ncols) {
  hipLaunchKernelGGL(adapt_b2f, dim3((unsigned)((rows * ncols + 255) / 256)), dim3(256), 0, s, (const bf16*)src, lds_, scol, dst, ldd, dcol, rows, ncols);
}

static int mk_grid() {
  static int grid = 0;
  if (grid == 0) {
    int dev = 0, cus = 0, per_cu = 0;
    (void)hipGetDevice(&dev); (void)hipDeviceGetAttribute(&cus, hipDeviceAttributeMultiprocessorCount, dev);
    (void)hipFuncSetAttribute((const void*)mk, hipFuncAttributeMaxDynamicSharedMemorySize, LDS_BYTES);
    (void)hipOccupancyMaxActiveBlocksPerMultiprocessor(&per_cu, (const void*)mk, NTHR, LDS_BYTES);
    (void)hipGetLastError();
    grid = cus > 0 ? cus : 256;
  }
  return grid;
}
static void mk_launch(hipStream_t s, void* const* d_in, void* d_out, void* d_ws, int lo, int hi, int flags) {
  Args a; memset(&a, 0, sizeof(a));
  for (int i = 0; i < 26; ++i) a.in[i] = d_in[i];
  a.out = (float*)d_out; a.ws = (unsigned char*)d_ws; a.ph_lo = lo; a.ph_hi = hi; a.flags = flags; a.pad = 0;
  (void)hipMemsetAsync((char*)d_ws + WS_CTL + CW_BAR * 4, 0, XCD_BAR_WORDS * 4, s);
  hipLaunchKernelGGL(mk, dim3(mk_grid()), dim3(NTHR), LDS_BYTES, s, a);
}

extern "C" void kernel_launch(void* const* d_in, const int* in_sizes, int n_in, void* d_out, int out_size, void* d_ws, size_t ws_size, hipStream_t s) {
  (void)hipMemsetAsync((char*)d_ws + WS_CTL, 0, CTL_ZERO_BYTES, s);
  for (int p = 0; p < 15; ++p) mk_launch(s, d_in, d_out, d_ws, p, p + 1, 1);
}
```

```cpp
#include <hip/hip_runtime.h>
#include <cstdint>
#include <cstdio>
#include <cstring>

constexpr int BATCH = 4, SEQ = 4096, DM = 1024, MTOK = BATCH * SEQ;
constexpr int D_IN = 2480;
constexpr int OFF_QM = 0, OFF_KM = 512, OFF_VM = 1024, OFF_OM = 1536, OFF_G = 2048, OFF_CQ = 2064, OFF_CKV = 2320, OFF_KR = 2448;
constexpr int NEXP = 16, CAP = 512, DFF = 2048, NMEM = 256;
constexpr size_t MiB = 1u << 20;
enum { I_X = 0, I_MEM, I_POS, I_GMIX, I_WIN, I_BG, I_CONV, I_GQA, I_WQB, I_GKVA, I_WKVB, I_GHM, I_GHA, I_WOUT, I_GMX, I_GMKV, I_WMQ, I_WMK, I_WMV, I_WMO, I_GFFN, I_WR, I_WEG, I_WEU, I_WED, I_GFIN };
#define GAS __attribute__((address_space(1)))
#define LAS __attribute__((address_space(3)))
typedef unsigned short bf16;
typedef unsigned v4u __attribute__((ext_vector_type(4)));
typedef unsigned v2u __attribute__((ext_vector_type(2)));
typedef float f32x4 __attribute__((ext_vector_type(4)));
typedef float f32x16 __attribute__((ext_vector_type(16)));
typedef short bf16x8 __attribute__((ext_vector_type(8)));
typedef short s16x4 __attribute__((ext_vector_type(4)));
typedef GAS unsigned gu32;
#define RLX_AGENT __ATOMIC_RELAXED, __HIP_MEMORY_SCOPE_AGENT
#define LDS_WAIT() asm volatile("s_waitcnt lgkmcnt(0)" ::: "memory")
#define VM_WAIT() asm volatile("s_waitcnt vmcnt(0)" ::: "memory")
constexpr int NWAVES = 8, NTHR = 512;
__device__ __forceinline__ unsigned f2bf(float f) { unsigned u = __builtin_bit_cast(unsigned, f); return (u + 0x7fffu + ((u >> 16) & 1u)) >> 16; }
__device__ __forceinline__ unsigned pk2(float lo, float hi) { return f2bf(lo) | (f2bf(hi) << 16); }
__device__ __forceinline__ float bf2f(unsigned short h) { return __builtin_bit_cast(float, (unsigned)h << 16); }
__device__ __forceinline__ float bflo(unsigned w) { return __builtin_bit_cast(float, w << 16); }
__device__ __forceinline__ float bfhi(unsigned w) { return __builtin_bit_cast(float, w & 0xffff0000u); }
typedef float f32x2_t __attribute__((ext_vector_type(2))); typedef __bf16 bf16x2_t __attribute__((ext_vector_type(2)));
__device__ __forceinline__ unsigned cvt_pk_bf16(float lo, float hi) { f32x2_t v = {lo, hi}; bf16x2_t b = __builtin_convertvector(v, bf16x2_t); return __builtin_bit_cast(unsigned, b); }
__device__ __forceinline__ float wave_sum(float v) {
#pragma unroll
  for (int o = 1; o < 64; o <<= 1) v += __shfl_xor(v, o);
  return v;
}
__device__ __forceinline__ float sigmoidf_(float x) { return 1.f / (1.f + __expf(-x)); }

#define XB_TMO      128
#define XB_XCNT(j)  (256  + 64 * (j))
#define XB_XSUB(j)  (1280 + 64 * (j))
#define XB_XGEN(j)  (2304 + 64 * (j))
#define XB_TOP      3328
#define XB_TOPGEN   3392
#define XCD_BAR_WORDS 3456
#define XB_SPIN_CAP (1u << 22)
__device__ __forceinline__ unsigned xb_ld(unsigned* p)              { return __hip_atomic_load(p, __ATOMIC_RELAXED, __HIP_MEMORY_SCOPE_AGENT); }
__device__ __forceinline__ unsigned xb_add(unsigned* p, unsigned v) { return __hip_atomic_fetch_add(p, v, __ATOMIC_RELAXED, __HIP_MEMORY_SCOPE_AGENT); }
__device__ __forceinline__ unsigned xb_xcc_id() { return (unsigned)__builtin_amdgcn_s_getreg((3 << 11) | 20) & 0xFu; }
#define XB_SPIN(cond, bar) do { unsigned _sp = 0; while (cond) { __builtin_amdgcn_s_sleep(1); \
    if ((++_sp & 255u) == 0u) { if (xb_ld(&(bar)[XB_TMO])) break; if (_sp > XB_SPIN_CAP) { atomicAdd(&(bar)[XB_TMO], 1u); break; } } } } while (0)
struct XcdBarrier { unsigned* bar; unsigned x; volatile LAS unsigned* st; };
__device__ __forceinline__ XcdBarrier xcd_barrier_post(unsigned* bar, volatile LAS unsigned* st) {
  XcdBarrier b; b.bar = bar; b.x = xb_xcc_id(); b.st = st;
  if (threadIdx.x == 0) (void)xb_add(&bar[XB_XCNT(b.x)], 1u);
  return b;
}
__device__ __forceinline__ void xcd_barrier_complete(unsigned* bar, unsigned x, unsigned& nloc, unsigned& nx) {
  const unsigned G = gridDim.x * gridDim.y * gridDim.z;
  unsigned sum, cnt, mine, sp = 0u;
  for (;;) {
    sum = 0u; cnt = 0u; mine = 0u;
#pragma unroll
    for (unsigned j = 0; j < 16; ++j) { const unsigned c = xb_ld(&bar[XB_XCNT(j)]); sum += c; cnt += (c > 0u) ? 1u : 0u; mine = (j == x) ? c : mine; }
    if (sum == G) break;
    __builtin_amdgcn_s_sleep(1);
    if ((++sp & 255u) == 0u) { if (xb_ld(&bar[XB_TMO])) break; if (sp > XB_SPIN_CAP) { atomicAdd(&bar[XB_TMO], 1u); break; } }
  }
  nloc = mine > 0u ? mine : 1u; nx = cnt > 0u ? cnt : 1u;
}
__device__ __forceinline__ void xcd_barrier(const XcdBarrier& b) {
  asm volatile("s_waitcnt vmcnt(0)" ::: "memory");
  __syncthreads();
  if (threadIdx.x == 0) {
    unsigned* bar = b.bar;
    __builtin_amdgcn_s_waitcnt(0);
    unsigned nloc = b.st[0], nx = b.st[1];
    if (nloc == 0u) { xcd_barrier_complete(bar, b.x, nloc, nx); b.st[0] = nloc; b.st[1] = nx; }
    const unsigned old = xb_add(&bar[XB_XSUB(b.x)], 1u);
    const unsigned gen = old / nloc;
    if (old + 1u == (gen + 1u) * nloc) {
      __builtin_amdgcn_fence(__ATOMIC_RELEASE, "agent");
      asm volatile("s_waitcnt vmcnt(0)" ::: "memory");
      const unsigned og = xb_add(&bar[XB_TOP], 1u);
      const unsigned tg = og / nx;
      if (og + 1u == (tg + 1u) * nx) xb_add(&bar[XB_TOPGEN], 1u);
      else XB_SPIN(xb_ld(&bar[XB_TOPGEN]) == tg, bar);
      __builtin_amdgcn_fence(__ATOMIC_ACQUIRE, "agent");
      xb_add(&bar[XB_XGEN(b.x)], 1u);
      asm volatile("s_waitcnt vmcnt(0)" ::: "memory");
    } else {
      XB_SPIN(xb_ld(&bar[XB_XGEN(b.x)]) == gen, bar);
      __builtin_amdgcn_fence(__ATOMIC_ACQUIRE, "agent");
      asm volatile("s_waitcnt vmcnt(0)" ::: "memory");
    }
  }
  __syncthreads();
}

namespace pg8 {
constexpr int BM = 256, BK = 64, HALF = 128, HTB = HALF * BK * 2, STAGE_BYTES = 8 * HTB, NXCD = 8, WGM = 8;
__host__ __device__ __forceinline__ int lds_byte(int r, int c) { const int st = (r >> 4) * 2 + (c >> 5), rr = r & 15, cc = c & 31, ob = rr * 64 + cc * 2; return st * 1024 + (ob ^ (((ob >> 9) & 1) << 5)); }
__host__ __device__ __forceinline__ void stage_rc(int b, int& R, int& C) { const int st = b / 1024, sb = b % 1024, swz = sb ^ (((sb >> 9) & 1) << 5); R = (st >> 1) * 16 + swz / 64; C = (st & 1) * 32 + (swz % 64) / 2; }
__host__ __device__ __forceinline__ int perm32(int rho) { const int n = rho >> 4, i = rho & 15; return 8 * (i >> 2) + 4 * n + (i & 3); }

struct Unit { long aoff, boff; int pm, pn, g, ibase; };
struct Gemm { const bf16* A; const bf16* Bt; int lda, ldb, K; const int* gidx; };

struct StaticOrder {
  int nM, nN, nwg, G, c, lda, ldb;
  __device__ void init(int M, int N, int G_, int c_, int lda_, int ldb_) { nM = M / BM; nN = N / BM; nwg = nM * nN; G = G_; c = c_; lda = lda_; ldb = ldb_; }
  __device__ bool next(int i, Unit& u) const {
    const long L = (long)i * G + c; if (L >= nwg) return false;
    int wgid = (int)L; { const int q = nwg / NXCD, r = nwg % NXCD, xcd = wgid % NXCD, off = wgid / NXCD; wgid = (xcd < r ? xcd * (q + 1) : r * (q + 1) + (xcd - r) * q) + off; }
    const int nig = WGM * nN, gid = wgid / nig, fm = gid * WGM, gsz = (nM - fm) < WGM ? (nM - fm) : WGM;
    u.pm = fm + ((wgid % nig) % gsz); u.pn = (wgid % nig) / gsz; u.g = 0; u.ibase = 0;
    u.aoff = (long)u.pm * BM * lda; u.boff = (long)u.pn * BM * ldb; return true;
  }
};

template <class Epi, class Sched, bool GATHER>
__device__ __forceinline__ void gemm_phase(LAS unsigned char* lds, const Gemm g, const Sched& S, const Epi& E) {
  int tid = threadIdx.x; asm volatile("" : "+v"(tid));
  const int wid = __builtin_amdgcn_readfirstlane(tid >> 6), lane = tid & 63, wr = wid >> 2, wc = wid & 3, fr = lane & 15, fq = lane >> 4;
  const int K = g.K, nt = K / BK;
  int Rs[2], Cs[2]; unsigned voffB[2];
#pragma unroll
  for (int i = 0; i < 2; ++i) { int R, C; stage_rc(tid * 16 + i * 8192, R, C); Rs[i] = R; Cs[i] = C; const int Rb = (R & ~31) + perm32(R & 31); voffB[i] = (unsigned)(Rb * g.ldb + C) * 2u; }
  const size_t kstep = (size_t)(BK * 2);
  const size_t hstepB = (size_t)HALF * g.ldb * 2;
  const unsigned ldsw = (unsigned)wid * 1024u;
  const int aoff_l = lds_byte(wr * 64 + fr, fq * 8), boff_l = lds_byte(wc * 32 + fr, fq * 8);
#define PG8_SA(b, h) (((b) * 2 + (h)) * HTB)
#define PG8_SB(b, h) ((4 + (b) * 2 + (h)) * HTB)
#define PG8_STAGE(bufoff, gbase, voff) do { _Pragma("unroll") for (int _i = 0; _i < 2; ++_i) \
        __builtin_amdgcn_global_load_lds((const unsigned*)((const char*)(gbase) + (voff)[_i]), (LAS unsigned*)(lds + (bufoff) + ldsw + _i * 8192), 16, 0, 0); } while (0)
#define PG8_LDA(dst, b, h) do { _Pragma("unroll") for (int m = 0; m < 4; ++m) _Pragma("unroll") for (int k = 0; k < 2; ++k) dst[m][k] = *(const LAS bf16x8*)(lds + PG8_SA(b, h) + aoff_l + m * 2048 + k * 1024); } while (0)
#define PG8_LDB(dst, b, h) do { _Pragma("unroll") for (int n = 0; n < 2; ++n) _Pragma("unroll") for (int k = 0; k < 2; ++k) dst[n][k] = *(const LAS bf16x8*)(lds + PG8_SB(b, h) + boff_l + n * 2048 + k * 1024); } while (0)
#define PG8_MMA(ai, bj, At, Bt) do { __builtin_amdgcn_s_setprio(1); _Pragma("unroll") for (int m = 0; m < 4; ++m) _Pragma("unroll") for (int n = 0; n < 2; ++n) _Pragma("unroll") for (int k = 0; k < 2; ++k) \
        acc[ai][bj][m][n] = __builtin_amdgcn_mfma_f32_16x16x32_bf16(Bt[n][k], At[m][k], acc[ai][bj][m][n], 0, 0, 0); __builtin_amdgcn_s_setprio(0); } while (0)
#define PG8_WAIT_V(n) asm volatile("s_waitcnt vmcnt(" #n ")" ::: "memory")
#define PG8_WAIT_L(n) asm volatile("s_waitcnt lgkmcnt(" #n ")" ::: "memory")
#define PG8_BAR __builtin_amdgcn_s_barrier()
#define PG8_SCHED __builtin_amdgcn_sched_barrier(0)
  Unit cur, nxt; int ui = 0;
  if (!S.next(0, cur)) return;
  unsigned vA[2][2], nvA[2][2];
  auto load_va = [&](const Unit& u, unsigned (&v)[2][2]) {
#pragma unroll
    for (int h = 0; h < 2; ++h)
#pragma unroll
      for (int i = 0; i < 2; ++i) {
        if constexpr (GATHER) v[h][i] = (unsigned)((long)g.gidx[u.ibase + h * HALF + Rs[i]] * g.lda + Cs[i]) * 2u;
        else v[h][i] = (unsigned)((h * HALF + Rs[i]) * g.lda + Cs[i]) * 2u;
      }
  };
  load_va(cur, vA);
  f32x4 acc[2][2][4][2];
#pragma unroll
  for (int a = 0; a < 2; ++a)
#pragma unroll
    for (int b = 0; b < 2; ++b)
#pragma unroll
      for (int m = 0; m < 4; ++m)
#pragma unroll
        for (int n = 0; n < 2; ++n) acc[a][b][m][n] = (f32x4){0.f, 0.f, 0.f, 0.f};
  bf16x8 At[4][2], B0[2][2], B1[2][2];
  const char* cA = (const char*)g.A + (GATHER ? 0 : cur.aoff * 2); const char* cB = (const char*)g.Bt + cur.boff * 2;
  PG8_STAGE(PG8_SB(0, 0), cB, voffB); PG8_STAGE(PG8_SB(0, 1), cB + hstepB, voffB); PG8_STAGE(PG8_SA(0, 0), cA, vA[0]); PG8_STAGE(PG8_SA(0, 1), cA, vA[1]);
  if (wr == 1) PG8_BAR;
  PG8_WAIT_V(2); PG8_BAR;
  PG8_STAGE(PG8_SB(1, 0), cB + kstep, voffB); PG8_STAGE(PG8_SA(1, 0), cA + kstep, vA[0]); PG8_STAGE(PG8_SB(1, 1), cB + hstepB + kstep, voffB);
  PG8_WAIT_V(6); PG8_BAR;
  for (;;) {
    const bool has_next = S.next(ui + 1, nxt);
    const char* nA = has_next ? (const char*)g.A + (GATHER ? 0 : nxt.aoff * 2) : cA; const char* nB = has_next ? (const char*)g.Bt + nxt.boff * 2 : cB;
    if constexpr (GATHER) { if (has_next) load_va(nxt, nvA); else {
#pragma unroll
      for (int h = 0; h < 2; ++h)
#pragma unroll
        for (int i = 0; i < 2; ++i) nvA[h][i] = vA[h][i]; } }
#pragma unroll 1
    for (int t = 0; t < nt; t += 2) {
      const bool last = (t == nt - 2);
      const char* a1 = cA + (size_t)(t + 1) * kstep;
      const char* a2 = last ? nA : cA + (size_t)(t + 2) * kstep; const char* b2 = last ? nB : cB + (size_t)(t + 2) * kstep;
      const char* a3 = a2 + kstep; const char* b3 = b2 + kstep;
      unsigned w0[2], w1[2];
      if constexpr (GATHER) { w0[0] = last ? nvA[0][0] : vA[0][0]; w0[1] = last ? nvA[0][1] : vA[0][1]; w1[0] = last ? nvA[1][0] : vA[1][0]; w1[1] = last ? nvA[1][1] : vA[1][1]; }
      else { w0[0] = vA[0][0]; w0[1] = vA[0][1]; w1[0] = vA[1][0]; w1[1] = vA[1][1]; }
      PG8_LDB(B0, 0, 0); PG8_LDB(B1, 0, 1); PG8_SCHED; PG8_LDA(At, 0, 0); PG8_STAGE(PG8_SA(1, 1), a1, vA[1]);
      PG8_WAIT_V(8); PG8_WAIT_L(0); PG8_BAR; PG8_MMA(0, 0, At, B0); PG8_MMA(0, 1, At, B1); PG8_BAR; PG8_SCHED;
      PG8_LDA(At, 0, 1); PG8_STAGE(PG8_SB(0, 0), b2, voffB); PG8_STAGE(PG8_SB(0, 1), b2 + hstepB, voffB); PG8_STAGE(PG8_SA(0, 0), a2, w0);
      PG8_WAIT_V(8); PG8_WAIT_L(0); PG8_BAR; PG8_MMA(1, 0, At, B0); PG8_MMA(1, 1, At, B1); PG8_BAR; PG8_SCHED;
      PG8_LDB(B0, 1, 0); PG8_LDB(B1, 1, 1); PG8_SCHED; PG8_LDA(At, 1, 0); PG8_STAGE(PG8_SA(0, 1), a2, w1);
      PG8_WAIT_V(8); PG8_WAIT_L(0); PG8_BAR; PG8_MMA(0, 0, At, B0); PG8_MMA(0, 1, At, B1); PG8_BAR; PG8_SCHED;
      PG8_LDA(At, 1, 1); PG8_STAGE(PG8_SB(1, 0), b3, voffB); PG8_STAGE(PG8_SB(1, 1), b3 + hstepB, voffB); PG8_STAGE(PG8_SA(1, 0), a3, w0);
      PG8_WAIT_V(8); PG8_WAIT_L(0); PG8_BAR; PG8_MMA(1, 0, At, B0); PG8_MMA(1, 1, At, B1); PG8_BAR; PG8_SCHED;
    }
    if (wr == 0) PG8_BAR;
    if constexpr (Epi::TWO_PASS) {
#pragma unroll
      for (int ai = 0; ai < 2; ++ai)
#pragma unroll
        for (int m = 0; m < 4; ++m) {
          float v0[8], v1[8];
#pragma unroll
          for (int n = 0; n < 2; ++n)
#pragma unroll
            for (int j = 0; j < 4; ++j) { v0[n * 4 + j] = acc[ai][0][m][n][j]; v1[n * 4 + j] = acc[ai][1][m][n][j]; }
          E.pass1(cur, ai * HALF + wr * 64 + m * 16 + fr, wc, v0, v1, fq);
#pragma unroll
          for (int n = 0; n < 2; ++n)
#pragma unroll
            for (int j = 0; j < 4; ++j) { acc[ai][0][m][n][j] = v0[n * 4 + j]; acc[ai][1][m][n][j] = v1[n * 4 + j]; }
        }
      asm volatile("s_waitcnt lgkmcnt(0)" ::: "memory"); PG8_BAR; asm volatile("" ::: "memory");
    }
    {
#pragma unroll
      for (int ai = 0; ai < 2; ++ai)
#pragma unroll
        for (int m = 0; m < 4; ++m) {
          float v0[8], v1[8];
#pragma unroll
          for (int n = 0; n < 2; ++n)
#pragma unroll
            for (int j = 0; j < 4; ++j) { v0[n * 4 + j] = acc[ai][0][m][n][j]; v1[n * 4 + j] = acc[ai][1][m][n][j]; }
          E.row8(cur, ai * HALF + wr * 64 + m * 16 + fr, wc * 32 + 8 * fq, v0, v1, fq);
          asm volatile("" ::: "memory");
        }
    }
    if (!has_next) break;
#pragma unroll
    for (int a = 0; a < 2; ++a)
#pragma unroll
      for (int b = 0; b < 2; ++b)
#pragma unroll
        for (int m = 0; m < 4; ++m)
#pragma unroll
          for (int n = 0; n < 2; ++n) acc[a][b][m][n] = (f32x4){0.f, 0.f, 0.f, 0.f};
    cur = nxt; cA = nA; cB = nB; ++ui;
    if constexpr (GATHER) {
#pragma unroll
      for (int h = 0; h < 2; ++h)
#pragma unroll
        for (int i = 0; i < 2; ++i) vA[h][i] = nvA[h][i]; }
    if (wr == 1) PG8_BAR;
  }
  PG8_WAIT_V(0);
  PG8_BAR;
#undef PG8_SA
#undef PG8_SB
#undef PG8_STAGE
#undef PG8_LDA
#undef PG8_LDB
#undef PG8_MMA
#undef PG8_WAIT_V
#undef PG8_WAIT_L
#undef PG8_BAR
#undef PG8_SCHED
}
}
constexpr size_t WS_CTL = 0, CTL_ZERO_BYTES = 1 * MiB;
constexpr int CW_TMO = 0, CW_BAR = 4096, CW_Q = 8192;
constexpr size_t CTL_SSQ = 256 * 1024, CTL_SSKV = CTL_SSQ + 65536, CTL_SS1 = CTL_SSKV + 65536, CTL_SS2 = CTL_SS1 + 65536;
constexpr size_t WS_WIN = 1 * MiB, WS_WQB = 6 * MiB, WS_WKVB = 6 * MiB + 512 * 1024, WS_WOUT = 7 * MiB, WS_WMQ = 9 * MiB, WS_WMK = 11 * MiB, WS_WMV = 13 * MiB, WS_WMO = 15 * MiB;
constexpr size_t WS_ROPE = 17 * MiB, WS_MEMN = 19 * MiB, WS_KMEM = 21 * MiB, WS_VMEMT = 23 * MiB, WS_GSC = 25 * MiB, WS_DEC = 28 * MiB, WS_AFF = 29 * MiB, WS_SEL = 30 * MiB;
constexpr size_t WS_PROJ = 32 * MiB, WS_XN = 112 * MiB, WS_QC = 112 * MiB, WS_KC = 128 * MiB, WS_QM = 144 * MiB, WS_KM = 168 * MiB, WS_VM = 192 * MiB, WS_HF = 208 * MiB, WS_HB = 224 * MiB, WS_Y = 240 * MiB;
constexpr size_t WS_X1 = 112 * MiB, WS_X1B = 176 * MiB, WS_QMEM = 208 * MiB, WS_P = 240 * MiB, WS_MO = 176 * MiB, WS_X2 = 240 * MiB, WS_X2B = 208 * MiB, WS_HID = 32 * MiB;
constexpr size_t WS_WEGU = 320 * MiB, WS_WED = 448 * MiB, WS_END = 512 * MiB;
constexpr int PROJ_LD = 2560;
constexpr int PC_CQ = 2048, PC_CKV = 2304, PC_KR = 2432, PC_G = 2464;
constexpr int RING_BYTES = 131072, LDSCTL_OFF = RING_BYTES, LDS_BYTES = 147456;

struct Args { const void* in[26]; float* out; unsigned char* ws; int ph_lo, ph_hi, flags, pad; };

struct Frame {
  LAS unsigned char* lds; volatile LAS unsigned* MISC; gu32* ctl; unsigned char* ws;
  int tid, lane, wave, vcu, G;
};

__device__ __forceinline__ void p0_tr(const float* W, int ldw, int k0, int kvalid, int scol0, int ncols, const float* gs, bf16* WT, int ldt, int drow0, LAS float* scr, int lane) {
#pragma unroll 8
  for (int i = 0; i < 32; ++i) { const int kk = 2 * i + (lane >> 5), c = lane & 31; float v = 0.f;
    if (c < ncols && k0 + kk < kvalid) { v = W[(size_t)(k0 + kk) * ldw + scol0 + c]; if (gs) v *= gs[k0 + kk]; }
    scr[kk * 33 + c] = v; }
  LDS_WAIT(); asm volatile("" ::: "memory");
  const int c = lane & 7;
#pragma unroll
  for (int j = 0; j < 4; ++j) { const int n = (lane >> 3) + 8 * j; const LAS float* s = scr + (8 * c) * 33 + n;
    v4u o; o.x = pk2(s[0 * 33], s[1 * 33]); o.y = pk2(s[2 * 33], s[3 * 33]); o.z = pk2(s[4 * 33], s[5 * 33]); o.w = pk2(s[6 * 33], s[7 * 33]);
    *(GAS v4u*)(WT + (size_t)(drow0 + n) * ldt + k0 + 8 * c) = o; }
  LDS_WAIT(); asm volatile("" ::: "memory");
}
__device__ __forceinline__ void rms_row_to_bf16(const float* xrow, bf16* orow, int lane) {
  const GAS f32x4* xr = (const GAS f32x4*)xrow + lane;
  f32x4 v[4]; float s = 0.f;
#pragma unroll
  for (int j = 0; j < 4; ++j) { v[j] = xr[64 * j]; s += (v[j].x * v[j].x + v[j].y * v[j].y) + (v[j].z * v[j].z + v[j].w * v[j].w); }
  const float rstd = rsqrtf(wave_sum(s) * (1.f / 1024.f) + 1e-6f);
  GAS unsigned long long* o8 = (GAS unsigned long long*)orow + lane;
#pragma unroll
  for (int j = 0; j < 4; ++j) o8[64 * j] = (unsigned long long)pk2(v[j].x * rstd, v[j].y * rstd) | ((unsigned long long)pk2(v[j].z * rstd, v[j].w * rstd) << 32);
}

__device__ __forceinline__ void p0_prologue(Frame& F, const Args& a, bool do_dense, bool do_experts) {
  LAS float* scr = (LAS float*)(F.lds + F.wave * 16384);
  const int gw = F.vcu * NWAVES + F.wave, NGW = F.G * NWAVES;
  auto I = [&](int i) { return (const float*)a.in[i]; };
  unsigned char* ws = F.ws;
  if (do_dense) {
    constexpr int I_WIN_ = 16 * 80, I_WQB_ = 4 * 24, I_WKVB_ = 4 * 32, I_SQ = 16 * 32;
    constexpr int NIT = I_WIN_ + I_WQB_ + I_WKVB_ + 5 * I_SQ;
    for (int it = gw; it < NIT; it += NGW) {
      int r = it;
      if (r < I_WIN_) { const int kb = r / 80, nb = r % 80; int sc, nc = 32;
        if (nb < 64) sc = 32 * nb; else if (nb < 72) sc = OFF_CQ + 32 * (nb - 64); else if (nb < 76) sc = OFF_CKV + 32 * (nb - 72); else if (nb == 76) sc = OFF_KR; else if (nb == 77) { sc = OFF_G; nc = 16; } else { sc = 0; nc = 0; }
        p0_tr(I(I_WIN), D_IN, 64 * kb, 1024, sc, nc, I(I_GMIX), (bf16*)(ws + WS_WIN), 1024, 32 * nb, scr, F.lane); continue; } r -= I_WIN_;
      if (r < I_WQB_) { const int kb = r / 24, nb = r % 24; p0_tr(I(I_WQB), 768, 64 * kb, 256, 32 * nb, 32, I(I_GQA), (bf16*)(ws + WS_WQB), 256, 32 * nb, scr, F.lane); continue; } r -= I_WQB_;
      if (r < I_WKVB_) { const int kb = r / 32, nb = r % 32; const int h = (nb & 15) >> 1, d0 = (nb & 1) * 32; const int sc = h * 128 + (nb >= 16 ? 64 : 0) + d0;
        p0_tr(I(I_WKVB), 1024, 64 * kb, 128, sc, 32, I(I_GKVA), (bf16*)(ws + WS_WKVB), 256, 32 * nb, scr, F.lane); continue; } r -= I_WKVB_;
      const int which = r / I_SQ; r %= I_SQ; const int kb = r / 32, nb = r % 32;
      const float* src = which == 0 ? I(I_WOUT) : which == 1 ? I(I_WMQ) : which == 2 ? I(I_WMK) : which == 3 ? I(I_WMV) : I(I_WMO);
      const float* gs = which == 1 ? I(I_GMX) : (which == 2 || which == 3) ? I(I_GMKV) : nullptr;
      bf16* dst = (bf16*)(ws + (which == 0 ? WS_WOUT : which == 1 ? WS_WMQ : which == 2 ? WS_WMK : which == 3 ? WS_WMV : WS_WMO));
      p0_tr(src, 1024, 64 * kb, 1024, 32 * nb, 32, gs, dst, 1024, 32 * nb, scr, F.lane);
    }
    for (int m = gw; m < MTOK; m += NGW) rms_row_to_bf16(I(I_X) + (size_t)m * 1024, (bf16*)(ws + WS_XN) + (size_t)m * 1024, F.lane);
    for (int m = gw; m < BATCH * NMEM; m += NGW) rms_row_to_bf16(I(I_MEM) + (size_t)m * 1024, (bf16*)(ws + WS_MEMN) + (size_t)m * 1024, F.lane);
    { const int* pos = (const int*)a.in[I_POS]; float* rt = (float*)(ws + WS_ROPE);
      for (int i = (F.vcu * NTHR + F.tid); i < MTOK * 16; i += F.G * NTHR) { const int m = i >> 4, j = i & 15; const float inv = powf(10000.f, -(float)j / 16.f); const float ang = (float)pos[m] * inv;
        rt[m * 32 + j] = cosf(ang); rt[m * 32 + 16 + j] = sinf(ang); } }
  }
  if (do_experts) {
    constexpr int I_GU = 16 * 128, I_D = 32 * 32;
    for (int it = gw; it < NEXP * (I_GU + I_D); it += NGW) {
      const int e = it / (I_GU + I_D); int r = it % (I_GU + I_D);
      if (r < I_GU) { const int kb = r / 128, nb = r % 128, p = nb >> 3, j0 = (nb & 7) * 32; const bool up = j0 >= 128;
        p0_tr((up ? I(I_WEU) : I(I_WEG)) + (size_t)e * 1024 * 2048, 2048, 64 * kb, 1024, 128 * p + (up ? j0 - 128 : j0), 32, I(I_GFFN), (bf16*)(ws + WS_WEGU) + (size_t)e * 4096 * 1024, 1024, 32 * nb, scr, F.lane); }
      else { r -= I_GU; const int kb = r / 32, nb = r % 32;
        p0_tr(I(I_WED) + (size_t)e * 2048 * 1024, 1024, 64 * kb, 2048, 32 * nb, 32, nullptr, (bf16*)(ws + WS_WED) + (size_t)e * 1024 * 2048, 2048, 32 * nb, scr, F.lane); }
    }
  }
}

__device__ __forceinline__ v4u pack8(const float (&v)[8]) { v4u w; w.x = cvt_pk_bf16(v[0], v[1]); w.y = cvt_pk_bf16(v[2], v[3]); w.z = cvt_pk_bf16(v[4], v[5]); w.w = cvt_pk_bf16(v[6], v[7]); return w; }
__device__ __forceinline__ float sumsq8(const float (&v)[8]) { float s = 0.f;
#pragma unroll
  for (int i = 0; i < 8; ++i) s += v[i] * v[i];
  return s; }
struct EpiStore { static constexpr bool TWO_PASS = false; bf16* O; int ldc;
  __device__ __forceinline__ void row8(const pg8::Unit& u, int rloc, int cloc, const float (&v0)[8], const float (&v1)[8], int fq) const {
    bf16* p = O + (size_t)(u.pm * 256 + rloc) * ldc + u.pn * 256 + cloc; *(v4u*)p = pack8(v0); *(v4u*)(p + 128) = pack8(v1); } };
struct EpiProj { static constexpr bool TWO_PASS = false; bf16* P; float* ssq; float* sskv;
  __device__ __forceinline__ void row8(const pg8::Unit& u, int rloc, int cloc, const float (&v0)[8], const float (&v1)[8], int fq) const {
    const int row = u.pm * 256 + rloc; bf16* p = P + (size_t)row * PROJ_LD + u.pn * 256 + cloc; *(v4u*)p = pack8(v0); *(v4u*)(p + 128) = pack8(v1);
    if (u.pn == 8) { float s = sumsq8(v0) + sumsq8(v1); s += __shfl_xor(s, 16); s += __shfl_xor(s, 32); if (fq == 0) unsafeAtomicAdd(ssq + row, s); }
    if (u.pn == 9) { float s = sumsq8(v0); s += __shfl_xor(s, 16); s += __shfl_xor(s, 32); if (fq == 0) unsafeAtomicAdd(sskv + row, s); } } };
struct EpiQ { static constexpr bool TWO_PASS = false; bf16* Q; const float* ssq; const float* rope;
  __device__ __forceinline__ void rope8(float (&v)[8], int row, int fq) const {
    float pv[8];
#pragma unroll
    for (int i = 0; i < 8; ++i) pv[i] = __shfl_xor(v[i], 32);
    const float* cs = rope + (size_t)row * 32 + 8 * (fq & 1);
#pragma unroll
    for (int i = 0; i < 8; ++i) { const float c = cs[i], s = cs[16 + i]; v[i] = (fq < 2) ? (v[i] * c - pv[i] * s) : (v[i] * c + pv[i] * s); }
  }
  __device__ __forceinline__ void row8(const pg8::Unit& u, int rloc, int cloc, const float (&a0)[8], const float (&a1)[8], int fq) const {
    const int row = u.pm * 256 + rloc; const float r = rsqrtf(ssq[row] * (1.f / 256.f) + 1e-6f);
    float v0[8], v1[8];
#pragma unroll
    for (int i = 0; i < 8; ++i) { v0[i] = a0[i] * r; v1[i] = a1[i] * r; }
    const int g0 = u.pn * 8 + (cloc >> 5), g1 = g0 + 4;
    if (g0 % 3 == 2) rope8(v0, row, fq);
    if (g1 % 3 == 2) rope8(v1, row, fq);
    bf16* p = Q + (size_t)row * 768 + u.pn * 256 + cloc; *(v4u*)p = pack8(v0); *(v4u*)(p + 128) = pack8(v1); } };
struct EpiKV { static constexpr bool TWO_PASS = false; bf16* KMp; bf16* VMp; const float* sskv;
  __device__ __forceinline__ void put(int row, int c, const float (&v)[8], float r) const {
    float w[8];
#pragma unroll
    for (int i = 0; i < 8; ++i) w[i] = v[i] * r;
    if (c < 512) *(v4u*)(KMp + (size_t)row * 768 + (c >> 6) * 96 + (c & 63)) = pack8(w); else *(v4u*)(VMp + (size_t)row * 512 + (c - 512)) = pack8(w); }
  __device__ __forceinline__ void row8(const pg8::Unit& u, int rloc, int cloc, const float (&a0)[8], const float (&a1)[8], int fq) const {
    const int row = u.pm * 256 + rloc; const float r = rsqrtf(sskv[row] * (1.f / 128.f) + 1e-6f);
    put(row, u.pn * 256 + cloc, a0, r); put(row, u.pn * 256 + 128 + cloc, a1, r); } };

__device__ __forceinline__ void unpack8(v4u w, float (&f)[8]) { f[0] = bflo(w.x); f[1] = bfhi(w.x); f[2] = bflo(w.y); f[3] = bfhi(w.y); f[4] = bflo(w.z); f[5] = bfhi(w.z); f[6] = bflo(w.w); f[7] = bfhi(w.w); }
__device__ __forceinline__ float log_sigmoid(float x) { return fminf(x, 0.f) - log1pf(__expf(-fabsf(x))); }

__device__ __forceinline__ void p2_elementwise(Frame& F, const Args& a) {
  unsigned char* ws = F.ws;
  const bf16* P = (const bf16*)(ws + WS_PROJ);
  { const float* cw = (const float*)a.in[I_CONV]; bf16* QC = (bf16*)(ws + WS_QC); bf16* KC = (bf16*)(ws + WS_KC);
    for (int i = F.vcu * NTHR + F.tid; i < MTOK * 128; i += F.G * NTHR) { const int m = i >> 7, c = (i & 127) * 8, t = m & (SEQ - 1);
      float x1[8], x0[8], x2[8]; unpack8(*(const v4u*)(P + (size_t)m * PROJ_LD + c), x1);
      if (t > 0) unpack8(*(const v4u*)(P + (size_t)(m - 1) * PROJ_LD + c), x0); else {
#pragma unroll
        for (int j = 0; j < 8; ++j) x0[j] = 0.f; }
      if (t < SEQ - 1) unpack8(*(const v4u*)(P + (size_t)(m + 1) * PROJ_LD + c), x2); else {
#pragma unroll
        for (int j = 0; j < 8; ++j) x2[j] = 0.f; }
      float o[8];
#pragma unroll
      for (int j = 0; j < 8; ++j) { float v = x0[j] * cw[c + j] + x1[j] * cw[1024 + c + j] + x2[j] * cw[2048 + c + j]; v = v * sigmoidf_(v); o[j] = (c < 512) ? v : v * 0.08838834764831845f; }
      if (c < 512) *(v4u*)(QC + (size_t)m * 512 + c) = pack8(o); else *(v4u*)(KC + (size_t)m * 512 + c - 512) = pack8(o); } }
  { const float* rope = (const float*)(ws + WS_ROPE); bf16* KMp = (bf16*)(ws + WS_KM);
    for (int i = F.vcu * NTHR + F.tid; i < MTOK * 16; i += F.G * NTHR) { const int m = i >> 4, j = i & 15;
      const float t1 = bf2f(P[(size_t)m * PROJ_LD + PC_KR + j]), t2 = bf2f(P[(size_t)m * PROJ_LD + PC_KR + 16 + j]); const float c = rope[m * 32 + j], s = rope[m * 32 + 16 + j];
      const bf16 o1 = (bf16)f2bf(t1 * c - t2 * s), o2 = (bf16)f2bf(t2 * c + t1 * s);
#pragma unroll
      for (int h = 0; h < 8; ++h) { KMp[(size_t)m * 768 + h * 96 + 64 + j] = o1; KMp[(size_t)m * 768 + h * 96 + 80 + j] = o2; } } }
  { const float* bg = (const float*)a.in[I_BG]; float* GSC = (float*)(ws + WS_GSC); float* DEC = (float*)(ws + WS_DEC);
    const int gw = F.vcu * NWAVES + F.wave, NGW = F.G * NWAVES;
    for (int it = gw; it < 32 * 64; it += NGW) { const int seq = it >> 6, c = it & 63, dir = seq & 1, h = (seq >> 1) & 3, b = seq >> 3;
      const int p = c * 64 + F.lane, t = dir ? (SEQ - 1 - p) : p; const size_t row = (size_t)b * SEQ + t;
      const int gi = (dir ? 8 : 0) + h, gf = (dir ? 12 : 4) + h;
      const float li = bf2f(P[row * PROJ_LD + PC_G + gi]) + bg[gi]; const float lf = log_sigmoid(bf2f(P[row * PROJ_LD + PC_G + gf]) + bg[gf]);
      float bs = lf;
#pragma unroll
      for (int o = 1; o < 64; o <<= 1) { const float y = __shfl_up(bs, o); if (F.lane >= o) bs += y; }
      const float av = li - bs; float pm = av;
#pragma unroll
      for (int o = 1; o < 64; o <<= 1) { const float y = __shfl_up(pm, o); if (F.lane >= o) pm = fmaxf(pm, y); }
      float* gs = GSC + (size_t)seq * 3 * SEQ; gs[p] = bs; gs[SEQ + p] = av; gs[2 * SEQ + p] = pm;
      if (F.lane == 63) { DEC[seq * 128 + c] = bs; DEC[seq * 128 + 64 + c] = pm; } } }
}
namespace mla {
constexpr int DQK = 96, DV = 64, NW = 8, QBLK = 32, KVBLK = 64, LDQ = 768, LDK = 768, LDV = 512, LDO = 1024;
constexpr float SCALE = 0.10206207261596575f;
constexpr float THR = 8.f;
constexpr int SHM_V = 16384, SHM_K = 16384, SHM_ATTN = 2 * SHM_V + 2 * SHM_K + NW * 64 * 4;
#define KSWZ(row, colB) ((row) * 256 + ((colB) ^ (((row) & 7) << 4)))
#define SBAR() __builtin_amdgcn_sched_barrier(0)
__device__ __forceinline__ int crow(int r, int hi) { return (r & 3) + 8 * (r >> 2) + 4 * hi; }
__device__ __forceinline__ void partialSM(f32x16& p0, f32x16& p1, float& m_reg, float& mn, float& alpha) {
  constexpr float C = SCALE * 1.4426950408889634f;
  float pmax = p0[0];
#pragma unroll
  for (int r = 1; r < 16; ++r) pmax = fmaxf(pmax, p0[r]);
#pragma unroll
  for (int r = 0; r < 16; ++r) pmax = fmaxf(pmax, p1[r]);
  { auto rr = __builtin_amdgcn_permlane32_swap(__float_as_uint(pmax), __float_as_uint(pmax), false, false);
    pmax = fmaxf(__uint_as_float(rr[0]), __uint_as_float(rr[1])); }
  if (__builtin_expect(__all(pmax - m_reg <= THR / SCALE), 1)) { mn = m_reg; alpha = 1.f; }
  else { mn = fmaxf(m_reg, pmax); alpha = __builtin_amdgcn_exp2f((m_reg - mn) * C); m_reg = mn; }
  const float mnC = -mn * C;
#pragma unroll
  for (int r = 0; r < 16; ++r) p0[r] = fmaf(p0[r], C, mnC);
#pragma unroll
  for (int r = 0; r < 16; ++r) p1[r] = fmaf(p1[r], C, mnC);
#pragma unroll
  for (int r = 0; r < 16; ++r) p0[r] = __builtin_amdgcn_exp2f(p0[r]);
}
__device__ __forceinline__ void finishSM(f32x16& p0, f32x16& p1, float alpha, float& l_reg, bf16x8& pa0, bf16x8& pa1, bf16x8& pa2, bf16x8& pa3) {
#pragma unroll
  for (int r = 0; r < 16; ++r) p1[r] = __builtin_amdgcn_exp2f(p1[r]);
  float ps = 0;
#pragma unroll
  for (int r = 0; r < 16; ++r) ps += p0[r];
#pragma unroll
  for (int r = 0; r < 16; ++r) ps += p1[r];
  { auto rr = __builtin_amdgcn_permlane32_swap(__float_as_uint(ps), __float_as_uint(ps), false, false);
    ps = __uint_as_float(rr[0]) + __uint_as_float(rr[1]); }
  l_reg = l_reg * alpha + ps;
#define PK4(P, BASE, OUT) do { unsigned a0 = cvt_pk_bf16(P[BASE + 0], P[BASE + 1]), a1 = cvt_pk_bf16(P[BASE + 2], P[BASE + 3]);   \
    unsigned b0 = cvt_pk_bf16(P[BASE + 4], P[BASE + 5]), b1 = cvt_pk_bf16(P[BASE + 6], P[BASE + 7]);                              \
    auto r0 = __builtin_amdgcn_permlane32_swap(a0, b0, false, false); auto r1 = __builtin_amdgcn_permlane32_swap(a1, b1, false, false); \
    v4u w = {r0[0], r1[0], r0[1], r1[1]}; OUT = __builtin_bit_cast(bf16x8, w); } while (0)
  PK4(p0, 0, pa0); PK4(p0, 8, pa1); PK4(p1, 0, pa2); PK4(p1, 8, pa3);
#undef PK4
}
__device__ __forceinline__ void qkt(f32x16& p0, f32x16& p1, const char* Ks, const bf16x8* qr, int r32, int hi) {
  p0 = f32x16{}; p1 = f32x16{};
#pragma unroll
  for (int d0 = 0; d0 < DQK / 16; ++d0) { const int cb = (d0 * 16 + hi * 8) * 2;
    const bf16x8 b0 = *reinterpret_cast<const bf16x8*>(Ks + KSWZ(r32, cb));
    const bf16x8 b1 = *reinterpret_cast<const bf16x8*>(Ks + KSWZ(32 + r32, cb));
    p0 = __builtin_amdgcn_mfma_f32_32x32x16_bf16(b0, qr[d0], p0, 0, 0, 0);
    p1 = __builtin_amdgcn_mfma_f32_32x32x16_bf16(b1, qr[d0], p1, 0, 0, 0); }
}
__device__ __forceinline__ int v_st(int k, int c) { const int kk = (k & ~0xC) | ((k & 4) << 1) | ((k & 8) >> 1); return ((kk >> 3) * 4 + (c >> 5)) * 512 + ((kk & 7) * 32 + (c & 31)) * 2; }
__device__ __forceinline__ int v_rd_base(int lane) { return ((lane & 3) << 3) | (((lane >> 2) & 3) << 6) | (((lane >> 4) & 1) << 5) | (((lane >> 5) & 1) << 8); }
constexpr int v_rd_off(int d0, int ks, int half) { return d0 * 512 + ks * 4096 + half * 2048; }
template <int OFF> __device__ __forceinline__ s16x4 tr_read(int vb) {
  s16x4 r; asm volatile("ds_read_b64_tr_b16 %0, %1 offset:%2" : "=&v"(r) : "v"(vb), "i"(OFF) : "memory"); return r;
}
template <int D0> __device__ __forceinline__ void pv_one(f32x16& od, int vb, bf16x8 pa0, bf16x8 pa1, bf16x8 pa2, bf16x8 pa3) {
  const s16x4 l0 = tr_read<v_rd_off(D0, 0, 0)>(vb), h0 = tr_read<v_rd_off(D0, 0, 1)>(vb), l1 = tr_read<v_rd_off(D0, 1, 0)>(vb), h1 = tr_read<v_rd_off(D0, 1, 1)>(vb);
  const s16x4 l2 = tr_read<v_rd_off(D0, 2, 0)>(vb), h2 = tr_read<v_rd_off(D0, 2, 1)>(vb), l3 = tr_read<v_rd_off(D0, 3, 0)>(vb), h3 = tr_read<v_rd_off(D0, 3, 1)>(vb);
  asm volatile("s_waitcnt lgkmcnt(0)" ::: "memory"); SBAR();
#define PK(L, H) (bf16x8){L[0], L[1], L[2], L[3], H[0], H[1], H[2], H[3]}
  od = __builtin_amdgcn_mfma_f32_32x32x16_bf16(pa0, PK(l0, h0), od, 0, 0, 0);
  od = __builtin_amdgcn_mfma_f32_32x32x16_bf16(pa1, PK(l1, h1), od, 0, 0, 0);
  od = __builtin_amdgcn_mfma_f32_32x32x16_bf16(pa2, PK(l2, h2), od, 0, 0, 0);
  od = __builtin_amdgcn_mfma_f32_32x32x16_bf16(pa3, PK(l3, h3), od, 0, 0, 0);
#undef PK
}
__device__ __forceinline__ void pv_d0(f32x16* o, int vb, bf16x8 pa0, bf16x8 pa1, bf16x8 pa2, bf16x8 pa3) {
  pv_one<0>(o[0], vb, pa0, pa1, pa2, pa3); pv_one<1>(o[1], vb, pa0, pa1, pa2, pa3);
}
__device__ __forceinline__ void attn_unit(const bf16* __restrict__ Qb, const bf16* __restrict__ Kh, const bf16* __restrict__ Vh, bf16* __restrict__ Yb, const float* __restrict__ gh, int seq, char* lds) {
  int tid = threadIdx.x; asm volatile("" : "+v"(tid));
  const int wid = tid >> 6, lane = tid & 63, r32 = lane & 31, hi = lane >> 5;
  char* V_lds = lds; char* K_lds = lds + 2 * SHM_V;
  float* wsf = (float*)(lds + 2 * SHM_V + 2 * SHM_K) + wid * 64; float* li_l = wsf; float* al_l = wsf + 32;
  float m_reg = -1e30f, l_reg = 0; f32x16 o[2] = {}; bf16x8 qr[DQK / 16];
  const bf16* Qw = Qb + (long)(wid * QBLK + r32) * LDQ + hi * 8;
#pragma unroll
  for (int d0 = 0; d0 < DQK / 16; ++d0) qr[d0] = *reinterpret_cast<const bf16x8*>(Qw + d0 * 16);
  const int sr = tid >> 4, sc = (tid & 15) * 8, vst0 = v_st(sr, sc & 63), vst1 = v_st(32 + sr, sc & 63);
  const bool doK = sc < DQK, doV = sc < DV;
  const int vb0 = (int)(uintptr_t)V_lds + v_rd_base(lane);
  struct { bf16x8 vs0, vs1, ks0, ks1; } sr_[2];
#define SLOAD(i, k0) do { if (doV) { sr_[i].vs0 = *reinterpret_cast<const bf16x8*>(&Vh[(long)((k0) + sr) * LDV + sc]); sr_[i].vs1 = *reinterpret_cast<const bf16x8*>(&Vh[(long)((k0) + 32 + sr) * LDV + sc]); } \
    if (doK) { sr_[i].ks0 = *reinterpret_cast<const bf16x8*>(&Kh[(long)((k0) + sr) * LDK + sc]); sr_[i].ks1 = *reinterpret_cast<const bf16x8*>(&Kh[(long)((k0) + 32 + sr) * LDK + sc]); } } while (0)
#define SWRITE(b, i) do { if (doV) { *(bf16x8*)(V_lds + (b) * SHM_V + vst0) = sr_[i].vs0; *(bf16x8*)(V_lds + (b) * SHM_V + vst1) = sr_[i].vs1; } \
    if (doK) { const int kc = sc * 2; *(bf16x8*)(K_lds + (b) * SHM_K + KSWZ(sr, kc)) = sr_[i].ks0; *(bf16x8*)(K_lds + (b) * SHM_K + KSWZ(32 + sr, kc)) = sr_[i].ks1; } } while (0)
#define SWAIT() asm volatile("s_waitcnt vmcnt(4)" ::: "memory")
#define RESC(a) do { if (__any((a) < 1.f)) { if (hi == 0) al_l[r32] = (a); asm volatile("s_waitcnt lgkmcnt(0)" ::: "memory"); \
    _Pragma("unroll") for (int d = 0; d < 2; ++d) _Pragma("unroll") for (int r = 0; r < 16; ++r) o[d][r] *= al_l[crow(r, hi)]; } } while (0)
  f32x16 pA0, pA1, pB0, pB1; float mnA, mnB, alA, alB; bf16x8 pa0, pa1, pa2, pa3; const int NT = seq / KVBLK;
  constexpr int SE = 0, SO = 1;
  SLOAD(SE, 0); asm volatile("s_waitcnt vmcnt(0)" ::: "memory"); SWRITE(0, SE); __syncthreads();
  qkt(pA0, pA1, K_lds, qr, r32, hi); partialSM(pA0, pA1, m_reg, mnA, alA);
  SLOAD(SO, KVBLK); if (2 < NT) SLOAD(SE, 2 * KVBLK);
  SWAIT(); SWRITE(1, SO); __syncthreads();
  for (int j = 1; j + 1 < NT; j += 2) {
    SBAR(); qkt(pB0, pB1, K_lds + SHM_K, qr, r32, hi);
    finishSM(pA0, pA1, alA, l_reg, pa0, pa1, pa2, pa3); SBAR();
    SLOAD(SO, (j + 2) * KVBLK); SBAR();
    pv_d0(o, vb0, pa0, pa1, pa2, pa3); partialSM(pB0, pB1, m_reg, mnB, alB);
    __syncthreads(); SWAIT(); SWRITE(0, SE);
    RESC(alB); __syncthreads();
    SBAR(); qkt(pA0, pA1, K_lds, qr, r32, hi);
    finishSM(pB0, pB1, alB, l_reg, pa0, pa1, pa2, pa3); SBAR();
    if (j + 3 < NT) SLOAD(SE, (j + 3) * KVBLK); SBAR();
    pv_d0(o, vb0 + SHM_V, pa0, pa1, pa2, pa3); partialSM(pA0, pA1, m_reg, mnA, alA);
    __syncthreads(); SWAIT(); SWRITE(1, SO);
    RESC(alA); __syncthreads();
  }
  SBAR(); qkt(pB0, pB1, K_lds + SHM_K, qr, r32, hi);
  finishSM(pA0, pA1, alA, l_reg, pa0, pa1, pa2, pa3); SBAR();
  pv_d0(o, vb0, pa0, pa1, pa2, pa3); partialSM(pB0, pB1, m_reg, mnB, alB);
  __syncthreads(); RESC(alB);
  finishSM(pB0, pB1, alB, l_reg, pa0, pa1, pa2, pa3); SBAR();
  pv_d0(o, vb0 + SHM_V, pa0, pa1, pa2, pa3);
  __syncthreads();
  { float* st = (float*)lds + wid * (32 * 68);
#pragma unroll
    for (int r = 0; r < 16; ++r) { const int orow = crow(r, hi); st[orow * 68 + r32] = o[0][r]; st[orow * 68 + 32 + r32] = o[1][r]; }
    asm volatile("s_waitcnt lgkmcnt(0)" ::: "memory");
    float v[32]; float s = 0.f;
#pragma unroll
    for (int j = 0; j < 8; ++j) { const f32x4 t = *(const f32x4*)(st + r32 * 68 + hi * 32 + 4 * j); v[4 * j] = t.x; v[4 * j + 1] = t.y; v[4 * j + 2] = t.z; v[4 * j + 3] = t.w; s += (t.x * t.x + t.y * t.y) + (t.z * t.z + t.w * t.w); }
    { auto rr = __builtin_amdgcn_permlane32_swap(__float_as_uint(s), __float_as_uint(s), false, false); s = __uint_as_float(rr[0]) + __uint_as_float(rr[1]); }
    const float rl = 1.f / l_reg; const float fac = rl * rsqrtf(s * rl * rl * (1.f / 64.f) + 1e-6f);
    bf16* yp = Yb + (long)(wid * QBLK + r32) * LDO + hi * 32; const float* gp = gh + hi * 32;
#pragma unroll
    for (int j = 0; j < 4; ++j) { float w[8];
#pragma unroll
      for (int e = 0; e < 8; ++e) w[e] = v[8 * j + e] * fac * gp[8 * j + e];
      *(v4u*)(yp + 8 * j) = pack8(w); } }
  __syncthreads();
#undef SLOAD
#undef SWRITE
#undef SWAIT
#undef RESC
}
#undef KSWZ
#undef SBAR
}

__device__ __forceinline__ int queue_pull(Frame& F, gu32* heads, int nq, int nper, int myq) {
  volatile LAS int* slot = (volatile LAS int*)(F.lds + LDSCTL_OFF);
  if (F.tid == 0) { int got = -1;
    for (int k = 0; k < nq; ++k) { const int q = (myq + k) % nq;
      if (__hip_atomic_load(heads + 64 * q, RLX_AGENT) >= (unsigned)nper) continue;
      const unsigned i = __hip_atomic_fetch_add(heads + 64 * q, 1u, RLX_AGENT);
      if (i < (unsigned)nper) { got = q * nper + (int)i; break; } }
    *slot = got; }
  __syncthreads();
  const int r = *slot;
  __syncthreads();
  return r;
}
__device__ __forceinline__ void p3_attention(Frame& F, const Args& a, char* lds_generic, unsigned xcc) {
  unsigned char* ws = F.ws;
  const bf16* QMp = (const bf16*)(ws + WS_QM); const bf16* KMp = (const bf16*)(ws + WS_KM); const bf16* VMp = (const bf16*)(ws + WS_VM); bf16* Y = (bf16*)(ws + WS_Y);
  for (;;) {
    const int u = queue_pull(F, F.ctl + CW_Q, 8, 64, (int)(xcc & 7u));
    if (u < 0) break;
    const int bh = u >> 4, qb = u & 15, b = bh >> 3, h = bh & 7;
    mla::attn_unit(QMp + ((size_t)b * SEQ + qb * 256) * 768 + h * 96, KMp + (size_t)b * SEQ * 768 + h * 96, VMp + (size_t)b * SEQ * 512 + h * 64,
                   Y + ((size_t)b * SEQ + qb * 256) * 1024 + 512 + h * 64, (const float*)a.in[I_GHA] + h * 64, SEQ, lds_generic);
  }
}
namespace mls {
using mla::crow; using mla::v_st; using mla::v_rd_base;
#define KSWZ(row, colB) ((row) * 256 + ((colB) ^ (((row) & 7) << 4)))
constexpr int OFF_QS = 0, OFF_KS = 16384, OFF_KP = 32768, OFF_VV = 49152, OFF_CT = 65536, OFF_SC = 98304, OFF_NB = 99328, OFF_NP = 100352, OFF_CH = 104448, OFF_WS = 105472;
template <int OFF> __device__ __forceinline__ s16x4 trr(int vb) { s16x4 r; asm volatile("ds_read_b64_tr_b16 %0, %1 offset:%2" : "=&v"(r) : "v"(vb), "i"(OFF) : "memory"); return r; }
#define PKF(L, H) (bf16x8){L[0], L[1], L[2], L[3], H[0], H[1], H[2], H[3]}
__device__ __forceinline__ void vfrags(int img, int d0, int lane, bf16x8 (&f)[4]) {
  const int vb = img + v_rd_base(lane) + d0 * 512;
  const s16x4 l0 = trr<0>(vb), h0 = trr<2048>(vb), l1 = trr<4096>(vb), h1 = trr<4096 + 2048>(vb), l2 = trr<8192>(vb), h2 = trr<8192 + 2048>(vb), l3 = trr<12288>(vb), h3 = trr<12288 + 2048>(vb);
  asm volatile("s_waitcnt lgkmcnt(0)" ::: "memory"); __builtin_amdgcn_sched_barrier(0);
  f[0] = PKF(l0, h0); f[1] = PKF(l1, h1); f[2] = PKF(l2, h2); f[3] = PKF(l3, h3);
}
__device__ __forceinline__ void pack_p(const f32x16& p0, const f32x16& p1, bf16x8& pa0, bf16x8& pa1, bf16x8& pa2, bf16x8& pa3) {
#define PK4(P, BASE, OUT) do { unsigned a0 = cvt_pk_bf16(P[BASE + 0], P[BASE + 1]), a1 = cvt_pk_bf16(P[BASE + 2], P[BASE + 3]);   \
    unsigned b0 = cvt_pk_bf16(P[BASE + 4], P[BASE + 5]), b1 = cvt_pk_bf16(P[BASE + 6], P[BASE + 7]);                              \
    auto r0 = __builtin_amdgcn_permlane32_swap(a0, b0, false, false); auto r1 = __builtin_amdgcn_permlane32_swap(a1, b1, false, false); \
    v4u w = {r0[0], r1[0], r0[1], r1[1]}; OUT = __builtin_bit_cast(bf16x8, w); } while (0)
  PK4(p0, 0, pa0); PK4(p0, 8, pa1); PK4(p1, 0, pa2); PK4(p1, 8, pa3);
#undef PK4
}
__device__ __forceinline__ float swap_add(float v) { auto rr = __builtin_amdgcn_permlane32_swap(__float_as_uint(v), __float_as_uint(v), false, false); return __uint_as_float(rr[0]) + __uint_as_float(rr[1]); }

__device__ __forceinline__ void mlstm_seq(int seq, unsigned char* ws, char* lds) {
  int tid = threadIdx.x; asm volatile("" : "+v"(tid));
  const int wid = __builtin_amdgcn_readfirstlane(tid >> 6), lane = tid & 63, r32 = lane & 31, hi = lane >> 5, rb = wid >> 2, cb = wid & 3;
  const int dir = seq & 1, h = (seq >> 1) & 3, b = seq >> 3;
  const bf16* QC = (const bf16*)(ws + WS_QC); const bf16* KC = (const bf16*)(ws + WS_KC); const bf16* P = (const bf16*)(ws + WS_PROJ);
  const float* gs = (const float*)(ws + WS_GSC) + (size_t)seq * 3 * SEQ; const float* dec = (const float*)(ws + WS_DEC) + seq * 128;
  bf16* H = (bf16*)(ws + (dir ? WS_HB : WS_HF));
  float* sc_alpha = (float*)(lds + OFF_SC); float* sc_a = sc_alpha + 64; float* sc_iw = sc_alpha + 128; float* sc_en = sc_alpha + 192;
  float* nbuf = (float*)(lds + OFF_NB); float* npart = (float*)(lds + OFF_NP);
  float* ch_mprev = (float*)(lds + OFF_CH); float* ch_mnew = ch_mprev + 64; float* ch_dec = ch_mprev + 128; float* ch_g = ch_mprev + 192;
  float* wsf = (float*)(lds + OFF_WS) + wid * 32;
  const int ldsb = (int)(uintptr_t)lds;
  if (tid < 64) {
    if (tid == 0) { float m = 0.f; for (int c = 0; c < 64; ++c) { const float g = dec[c], wm = dec[64 + c]; const float mn = fmaxf(g + m, g + wm); ch_mprev[c] = m; ch_mnew[c] = mn; ch_dec[c] = __expf(g + m - mn); ch_g[c] = g; m = mn; } } }
  for (int i = tid; i < 32768 / 16; i += NTHR) ((v4u*)(lds + OFF_CT))[i] = (v4u){0u, 0u, 0u, 0u};
  if (tid < 128) nbuf[tid] = 0.f;
  f32x16 cacc[2]; cacc[0] = f32x16{}; cacc[1] = f32x16{};
  __syncthreads();
  const int sr = tid >> 4, sc = (tid & 15) * 8;
  v4u gq0, gq1, gk0, gk1, gv0, gv1; float ga0, ga1, sb = 0.f, sa = 0.f, spm = 0.f;
#define ROWOF(p) ((size_t)b * SEQ + (dir ? (SEQ - 1 - (p)) : (p)))
#define LOADC(c) do { const int p0_ = 64 * (c) + sr, p1_ = p0_ + 32; const size_t r0_ = ROWOF(p0_), r1_ = ROWOF(p1_); \
    gq0 = *(const v4u*)(QC + r0_ * 512 + h * 128 + sc); gq1 = *(const v4u*)(QC + r1_ * 512 + h * 128 + sc); \
    gk0 = *(const v4u*)(KC + r0_ * 512 + h * 128 + sc); gk1 = *(const v4u*)(KC + r1_ * 512 + h * 128 + sc); \
    gv0 = *(const v4u*)(P + r0_ * PROJ_LD + 1024 + h * 128 + sc); gv1 = *(const v4u*)(P + r1_ * PROJ_LD + 1024 + h * 128 + sc); \
    ga0 = gs[SEQ + p0_]; ga1 = gs[SEQ + p1_]; \
    if (tid < 64) { sb = gs[64 * (c) + tid]; sa = gs[SEQ + 64 * (c) + tid]; spm = gs[2 * SEQ + 64 * (c) + tid]; } } while (0)
#define WRITEC(c) do { \
    *(v4u*)(lds + OFF_QS + KSWZ(sr, sc * 2)) = gq0; *(v4u*)(lds + OFF_QS + KSWZ(32 + sr, sc * 2)) = gq1; \
    *(v4u*)(lds + OFF_KS + KSWZ(sr, sc * 2)) = gk0; *(v4u*)(lds + OFF_KS + KSWZ(32 + sr, sc * 2)) = gk1; \
    *(v4u*)(lds + OFF_VV + v_st(sr, sc)) = gv0; *(v4u*)(lds + OFF_VV + v_st(32 + sr, sc)) = gv1; \
    { const float gc_ = ch_g[c], mn_ = ch_mnew[c]; const float w0_ = __expf(gc_ + ga0 - mn_), w1_ = __expf(gc_ + ga1 - mn_); float f0_[8], f1_[8], cs_[8]; unpack8(gk0, f0_); unpack8(gk1, f1_); \
      _Pragma("unroll") for (int j = 0; j < 8; ++j) { f0_[j] *= w0_; f1_[j] *= w1_; cs_[j] = f0_[j] + f1_[j]; } \
      *(v4u*)(lds + OFF_KP + v_st(sr, sc)) = pack8(f0_); *(v4u*)(lds + OFF_KP + v_st(32 + sr, sc)) = pack8(f1_); \
      _Pragma("unroll") for (int j = 0; j < 8; ++j) { cs_[j] += __shfl_xor(cs_[j], 16); cs_[j] += __shfl_xor(cs_[j], 32); } \
      if ((lane >> 4) == 0) { _Pragma("unroll") for (int j = 0; j < 8; ++j) npart[wid * 128 + sc + j] = cs_[j]; } } \
    if (tid < 64) { const float m_ = ch_mprev[c]; const float mt_ = fmaxf(sb + m_, sb + spm); sc_alpha[tid] = sb - mt_; sc_a[tid] = sa; sc_iw[tid] = __expf(sb + m_ - mt_); sc_en[tid] = __expf(-mt_); } } while (0)
  LOADC(0); WRITEC(0);
  __syncthreads();
  for (int c = 0; c < 64; ++c) {
    if (c + 1 < 64) LOADC(c + 1);
    const float* nb = nbuf + (c & 1) * 128;
    if (tid < 128) { float s = 0.f;
#pragma unroll
      for (int w = 0; w < 8; ++w) s += npart[w * 128 + tid];
      nbuf[((c + 1) & 1) * 128 + tid] = ch_dec[c] * nb[tid] + s; }
    bf16x8 qr[8];
#pragma unroll
    for (int d0 = 0; d0 < 8; ++d0) qr[d0] = *(const bf16x8*)(lds + OFF_QS + KSWZ(32 * rb + r32, (16 * d0 + 8 * hi) * 2));
    f32x16 p0 = f32x16{}, p1 = f32x16{};
#pragma unroll
    for (int d0 = 0; d0 < 8; ++d0) { const bf16x8 k0 = *(const bf16x8*)(lds + OFF_KS + KSWZ(r32, (16 * d0 + 8 * hi) * 2)); p0 = __builtin_amdgcn_mfma_f32_32x32x16_bf16(k0, qr[d0], p0, 0, 0, 0); }
    if (rb == 1) {
#pragma unroll
      for (int d0 = 0; d0 < 8; ++d0) { const bf16x8 k1 = *(const bf16x8*)(lds + OFF_KS + KSWZ(32 + r32, (16 * d0 + 8 * hi) * 2)); p1 = __builtin_amdgcn_mfma_f32_32x32x16_bf16(k1, qr[d0], p1, 0, 0, 0); }
    }
    const float al = sc_alpha[32 * rb + r32];
    if (rb == 0) {
#pragma unroll
      for (int r = 0; r < 16; ++r) { const int sl = crow(r, hi); p0[r] = (sl <= r32) ? __expf(al + sc_a[sl]) * p0[r] : 0.f; }
    } else {
#pragma unroll
      for (int r = 0; r < 16; ++r) { const int sl = crow(r, hi); p0[r] = __expf(al + sc_a[sl]) * p0[r]; p1[r] = (sl <= r32) ? __expf(al + sc_a[32 + sl]) * p1[r] : 0.f; }
    }
    float ps = 0.f;
#pragma unroll
    for (int r = 0; r < 16; ++r) ps += p0[r] + p1[r];
    ps = swap_add(ps);
    bf16x8 pa0, pa1, pa2, pa3; pack_p(p0, p1, pa0, pa1, pa2, pa3);
    float qn = 0.f;
#pragma unroll
    for (int d0 = 0; d0 < 8; ++d0) { const f32x4 n0 = *(const f32x4*)(nb + 16 * d0 + 8 * hi), n1 = *(const f32x4*)(nb + 16 * d0 + 8 * hi + 4); const v4u qw = __builtin_bit_cast(v4u, qr[d0]);
      qn += bflo(qw.x) * n0.x + bfhi(qw.x) * n0.y + bflo(qw.y) * n0.z + bfhi(qw.y) * n0.w + bflo(qw.z) * n1.x + bfhi(qw.z) * n1.y + bflo(qw.w) * n1.z + bfhi(qw.w) * n1.w; }
    qn = swap_add(qn);
    { const float iwt = sc_iw[32 * rb + r32]; const float den = iwt * qn + ps; const float rd = 1.f / fmaxf(fabsf(den), sc_en[32 * rb + r32]); if (hi == 0) wsf[r32] = rd; }
    f32x16 o = f32x16{};
#pragma unroll
    for (int d0 = 0; d0 < 8; ++d0) { const bf16x8 cf = *(const bf16x8*)(lds + OFF_CT + KSWZ(32 * cb + r32, (16 * d0 + 8 * hi) * 2)); o = __builtin_amdgcn_mfma_f32_32x32x16_bf16(qr[d0], cf, o, 0, 0, 0); }
#pragma unroll
    for (int r = 0; r < 16; ++r) o[r] *= sc_iw[32 * rb + crow(r, hi)];
    bf16x8 vf[4]; vfrags(ldsb + OFF_VV, cb, lane, vf);
    o = __builtin_amdgcn_mfma_f32_32x32x16_bf16(pa0, vf[0], o, 0, 0, 0); o = __builtin_amdgcn_mfma_f32_32x32x16_bf16(pa1, vf[1], o, 0, 0, 0);
    if (rb == 1) { o = __builtin_amdgcn_mfma_f32_32x32x16_bf16(pa2, vf[2], o, 0, 0, 0); o = __builtin_amdgcn_mfma_f32_32x32x16_bf16(pa3, vf[3], o, 0, 0, 0); }
    asm volatile("s_waitcnt lgkmcnt(0)" ::: "memory");
#pragma unroll
    for (int r = 0; r < 16; ++r) { const int tl = crow(r, hi); const int p = 64 * c + 32 * rb + tl; H[ROWOF(p) * 512 + h * 128 + 32 * cb + r32] = (bf16)f2bf(o[r] * wsf[tl]); }
    { const float dc = ch_dec[c];
#pragma unroll
      for (int i = 0; i < 2; ++i) { bf16x8 kf[4]; vfrags(ldsb + OFF_KP, 2 * rb + i, lane, kf);
#pragma unroll
        for (int r = 0; r < 16; ++r) cacc[i][r] *= dc;
#pragma unroll
        for (int ks = 0; ks < 4; ++ks) cacc[i] = __builtin_amdgcn_mfma_f32_32x32x16_bf16(kf[ks], vf[ks], cacc[i], 0, 0, 0); } }
    __syncthreads();
#pragma unroll
    for (int i = 0; i < 2; ++i)
#pragma unroll
      for (int g = 0; g < 4; ++g) { const int d = 32 * (2 * rb + i) + 8 * g + 4 * hi, e = 32 * cb + r32;
        v2u w; w.x = cvt_pk_bf16(cacc[i][4 * g], cacc[i][4 * g + 1]); w.y = cvt_pk_bf16(cacc[i][4 * g + 2], cacc[i][4 * g + 3]);
        *(v2u*)(lds + OFF_CT + KSWZ(e, d * 2)) = w; }
    if (c + 1 < 64) WRITEC(c + 1);
    __syncthreads();
  }
#undef ROWOF
#undef LOADC
#undef WRITEC
}
#undef KSWZ
#undef PKF
}

__device__ __forceinline__ void p3_mixers(Frame& F, const Args& a, char* lds_generic, unsigned xcc) {
  for (;;) { const int it = queue_pull(F, F.ctl + CW_Q + 64 * 8, 8, 4, (int)(xcc & 7u)); if (it < 0) break; mls::mlstm_seq(it, F.ws, lds_generic); __syncthreads(); }
  p3_attention(F, a, lds_generic, xcc);
}
__device__ __forceinline__ void p4_combine(Frame& F, const Args& a) {
  unsigned char* ws = F.ws; const bf16* HF = (const bf16*)(ws + WS_HF); const bf16* HB = (const bf16*)(ws + WS_HB); const bf16* P = (const bf16*)(ws + WS_PROJ); bf16* Y = (bf16*)(ws + WS_Y);
  const float* g = (const float*)a.in[I_GHM];
  const int gw = F.vcu * NWAVES + F.wave, NGW = F.G * NWAVES, c = F.lane * 8;
  float gg[8];
#pragma unroll
  for (int j = 0; j < 8; ++j) gg[j] = g[c + j];
  for (int m = gw; m < MTOK; m += NGW) {
    float f[8], bb[8], oo[8]; unpack8(*(const v4u*)(HF + (size_t)m * 512 + c), f); unpack8(*(const v4u*)(HB + (size_t)m * 512 + c), bb); unpack8(*(const v4u*)(P + (size_t)m * PROJ_LD + 1536 + c), oo);
    float s = 0.f;
#pragma unroll
    for (int j = 0; j < 8; ++j) { f[j] += bb[j]; s += f[j] * f[j]; }
    s += __shfl_xor(s, 1); s += __shfl_xor(s, 2); s += __shfl_xor(s, 4); s += __shfl_xor(s, 8);
    const float r = rsqrtf(s * (1.f / 128.f) + 1e-6f);
#pragma unroll
    for (int j = 0; j < 8; ++j) f[j] = f[j] * r * gg[j] * sigmoidf_(oo[j]);
    *(v4u*)(Y + (size_t)m * 1024 + c) = pack8(f);
  }
}
struct EpiResid { static constexpr bool TWO_PASS = false; const float* base; float* out; bf16* outb; float* ss;
  __device__ __forceinline__ void row8(const pg8::Unit& u, int rloc, int cloc, const float (&a0)[8], const float (&a1)[8], int fq) const {
    const int row = u.pm * 256 + rloc; const size_t off = (size_t)row * 1024 + u.pn * 256 + cloc;
    const f32x4 b0 = *(const f32x4*)(base + off), b1 = *(const f32x4*)(base + off + 4), b2 = *(const f32x4*)(base + off + 128), b3 = *(const f32x4*)(base + off + 132);
    float v0[8], v1[8];
#pragma unroll
    for (int i = 0; i < 4; ++i) { v0[i] = a0[i] + b0[i]; v0[4 + i] = a0[4 + i] + b1[i]; v1[i] = a1[i] + b2[i]; v1[4 + i] = a1[4 + i] + b3[i]; }
    *(f32x4*)(out + off) = (f32x4){v0[0], v0[1], v0[2], v0[3]}; *(f32x4*)(out + off + 4) = (f32x4){v0[4], v0[5], v0[6], v0[7]};
    *(f32x4*)(out + off + 128) = (f32x4){v1[0], v1[1], v1[2], v1[3]}; *(f32x4*)(out + off + 132) = (f32x4){v1[4], v1[5], v1[6], v1[7]};
    *(v4u*)(outb + off) = pack8(v0); *(v4u*)(outb + off + 128) = pack8(v1);
    float s = sumsq8(v0) + sumsq8(v1); s += __shfl_xor(s, 16); s += __shfl_xor(s, 32); if (fq == 0) unsafeAtomicAdd(ss + row, s); } };
struct EpiScale { static constexpr bool TWO_PASS = false; bf16* O; const float* ss;
  __device__ __forceinline__ void row8(const pg8::Unit& u, int rloc, int cloc, const float (&a0)[8], const float (&a1)[8], int fq) const {
    const int row = u.pm * 256 + rloc; const float r = rsqrtf(ss[row] * (1.f / 1024.f) + 1e-6f); float v0[8], v1[8];
#pragma unroll
    for (int i = 0; i < 8; ++i) { v0[i] = a0[i] * r; v1[i] = a1[i] * r; }
    bf16* p = O + (size_t)row * 1024 + u.pn * 256 + cloc; *(v4u*)p = pack8(v0); *(v4u*)(p + 128) = pack8(v1); } };
struct EpiSoftmax { static constexpr bool TWO_PASS = true; bf16* O; float scale; LAS float* xch;
  __device__ __forceinline__ void pass1(const pg8::Unit& u, int rloc, int wc, float (&v0)[8], float (&v1)[8], int fq) const {
    float mx = -3.0e38f;
#pragma unroll
    for (int i = 0; i < 8; ++i) { v0[i] *= scale; v1[i] *= scale; mx = fmaxf(mx, fmaxf(v0[i], v1[i])); }
    mx = fmaxf(mx, __shfl_xor(mx, 16)); mx = fmaxf(mx, __shfl_xor(mx, 32));
    float l = 0.f;
#pragma unroll
    for (int i = 0; i < 8; ++i) { v0[i] = __expf(v0[i] - mx); v1[i] = __expf(v1[i] - mx); l += v0[i] + v1[i]; }
    l += __shfl_xor(l, 16); l += __shfl_xor(l, 32);
    if (fq == 0) { xch[(rloc * 4 + wc) * 2] = mx; xch[(rloc * 4 + wc) * 2 + 1] = l; } }
  __device__ __forceinline__ void row8(const pg8::Unit& u, int rloc, int cloc, const float (&a0)[8], const float (&a1)[8], int fq) const {
    const int wc = cloc >> 5; float m[4], l[4]; float M = -3.0e38f;
#pragma unroll
    for (int w = 0; w < 4; ++w) { m[w] = xch[(rloc * 4 + w) * 2]; l[w] = xch[(rloc * 4 + w) * 2 + 1]; M = fmaxf(M, m[w]); }
    float L = 0.f, mine = 0.f;
#pragma unroll
    for (int w = 0; w < 4; ++w) { const float e = __expf(m[w] - M); L += l[w] * e; if (w == wc) mine = e; }
    const float f = mine / L; float v0[8], v1[8];
#pragma unroll
    for (int i = 0; i < 8; ++i) { v0[i] = a0[i] * f; v1[i] = a1[i] * f; }
    bf16* p = O + (size_t)(u.pm * 256 + rloc) * 1024 + u.pn * 256 + cloc; *(v4u*)p = pack8(v0); *(v4u*)(p + 128) = pack8(v1); } };
struct MemOrder { int G, c, kind;
  __device__ bool next(int i, pg8::Unit& u) const { const int L = i * G + c; if (L >= 256) return false;
    const int bh = L >> 4, t = L & 15, b = bh >> 2, h = bh & 3;
    u.pm = b * 16 + t; u.pn = h; u.g = 0; u.ibase = 0; u.aoff = ((long)(b * SEQ + t * 256)) * 1024 + h * 256;
    u.boff = kind == 0 ? ((long)(b * NMEM)) * 1024 + h * 256 : ((long)(h * 256)) * 1024 + b * NMEM; return true; } };
constexpr size_t WS_ROWSEL = WS_SEL, WS_GSEL = WS_SEL + 131072, WS_INV = 31 * MiB, WS_YE = 160 * MiB;
__device__ __forceinline__ void p10_router(Frame& F, const Args& a) {
  unsigned char* ws = F.ws; const float* X2 = (const float*)(ws + WS_X2); const float* ss2 = (const float*)(ws + CTL_SS2); float* AFF = (float*)(ws + WS_AFF);
  const float* wr = (const float*)a.in[I_WR]; const float* gf = (const float*)a.in[I_GFFN];
  const int gw = F.vcu * NWAVES + F.wave, NGW = F.G * NWAVES;
  for (int m = gw; m < MTOK; m += NGW) {
    float acc[16];
#pragma unroll
    for (int e = 0; e < 16; ++e) acc[e] = 0.f;
#pragma unroll
    for (int j = 0; j < 4; ++j) { const int k0 = 256 * j + 4 * F.lane; const f32x4 xv = *(const f32x4*)(X2 + (size_t)m * 1024 + k0); const f32x4 gv = *(const f32x4*)(gf + k0);
#pragma unroll
      for (int i = 0; i < 4; ++i) { const float xg = xv[i] * gv[i]; const f32x4* w4 = (const f32x4*)(wr + (size_t)(k0 + i) * 16);
#pragma unroll
        for (int q = 0; q < 4; ++q) { const f32x4 w = w4[q]; acc[4 * q] += xg * w.x; acc[4 * q + 1] += xg * w.y; acc[4 * q + 2] += xg * w.z; acc[4 * q + 3] += xg * w.w; } } }
#pragma unroll
    for (int e = 0; e < 16; ++e) acc[e] = wave_sum(acc[e]);
    const float r = rsqrtf(ss2[m] * (1.f / 1024.f) + 1e-6f); float mx = -3.0e38f;
#pragma unroll
    for (int e = 0; e < 16; ++e) { acc[e] *= r; mx = fmaxf(mx, acc[e]); }
    float l = 0.f;
#pragma unroll
    for (int e = 0; e < 16; ++e) { acc[e] = __expf(acc[e] - mx); l += acc[e]; }
    const float rl = 1.f / l;
    if (F.lane < 16) { float v = 0.f;
#pragma unroll
      for (int e = 0; e < 16; ++e) if (e == F.lane) v = acc[e];
      AFF[(size_t)m * 16 + F.lane] = v * rl; }
  }
}
__device__ __forceinline__ void p11_topk(Frame& F, char* lds) {
  unsigned char* ws = F.ws; const float* AFF = (const float*)(ws + WS_AFF); int* ROWSEL = (int*)(ws + WS_ROWSEL); float* GSEL = (float*)(ws + WS_GSEL); int* INV = (int*)(ws + WS_INV);
  unsigned* hist = (unsigned*)lds; unsigned* ctl = hist + 256; unsigned* wsum = hist + 320;
  const int tid = F.tid, lane = F.lane, wid = F.wave;
  for (int it = (int)blockIdx.x; it < BATCH * NEXP; it += F.G) { const int b = it >> 4, e = it & 15;
    unsigned key[8];
#pragma unroll
    for (int j = 0; j < 8; ++j) key[j] = __float_as_uint(AFF[((size_t)b * SEQ + 8 * tid + j) * 16 + e]);
    unsigned prefix = 0u, mask = 0u, need = CAP;
    for (int shift = 24; shift >= 0; shift -= 8) {
      if (tid < 256) hist[tid] = 0u;
      __syncthreads();
#pragma unroll
      for (int j = 0; j < 8; ++j) if ((key[j] & mask) == prefix) atomicAdd(&hist[(key[j] >> shift) & 255u], 1u);
      __syncthreads();
      if (tid == 0) { unsigned above = 0u; int d = 255; for (; d > 0; --d) { const unsigned c = hist[d]; if (above + c >= need) break; above += c; } ctl[0] = (unsigned)d; ctl[1] = need - above; }
      __syncthreads();
      prefix |= ctl[0] << shift; mask |= 255u << shift; need = ctl[1];
      __syncthreads();
    }
    unsigned ngt = 0u, neq = 0u;
#pragma unroll
    for (int j = 0; j < 8; ++j) { ngt += key[j] > prefix ? 1u : 0u; neq += key[j] == prefix ? 1u : 0u; }
    unsigned sgt = ngt, seq_ = neq;
#pragma unroll
    for (int o = 1; o < 64; o <<= 1) { const unsigned y0 = __shfl_up(sgt, o), y1 = __shfl_up(seq_, o); if (lane >= o) { sgt += y0; seq_ += y1; } }
    if (lane == 63) { wsum[wid] = sgt; wsum[8 + wid] = seq_; }
    __syncthreads();
    unsigned bgt = 0u, beq = 0u, tgt = 0u;
#pragma unroll
    for (int w = 0; w < 8; ++w) { const unsigned g = wsum[w], q = wsum[8 + w]; if (w < wid) { bgt += g; beq += q; } tgt += g; }
    unsigned pgt = bgt + sgt - ngt, peq = beq + seq_ - neq;
#pragma unroll
    for (int j = 0; j < 8; ++j) { const int t = 8 * tid + j; int slot = -1;
      if (key[j] > prefix) slot = (int)pgt++; else if (key[j] == prefix) { if (peq < need) slot = (int)(tgt + peq); ++peq; }
      INV[((size_t)b * SEQ + t) * 16 + e] = slot;
      if (slot >= 0) { ROWSEL[e * 2048 + b * 512 + slot] = b * SEQ + t; GSEL[e * 2048 + b * 512 + slot] = __uint_as_float(key[j]); } }
    __syncthreads();
  }
}
struct MoeGUOrder { int G, c;
  __device__ bool next(int i, pg8::Unit& u) const { const int L = i * G + c; if (L >= 2048) return false;
    const int e = L >> 7, r = L & 127, pn = r >> 3, mt = r & 7;
    u.g = e; u.pm = mt; u.pn = pn; u.ibase = e * 2048 + mt * 256; u.aoff = 0; u.boff = ((long)e * 4096 + pn * 256) * 1024; return true; } };
struct MoeDownOrder { int G, c;
  __device__ bool next(int i, pg8::Unit& u) const { const int L = i * G + c; if (L >= 512) return false;
    const int e = L >> 5, r = L & 31, pn = r >> 3, mt = r & 7;
    u.g = e; u.pm = mt; u.pn = pn; u.ibase = e * 2048 + mt * 256; u.aoff = ((long)e * 2048 + mt * 256) * 2048; u.boff = ((long)e * 1024 + pn * 256) * 2048; return true; } };
struct EpiGU { static constexpr bool TWO_PASS = false; bf16* H; const float* ss2; const int* rowsel;
  __device__ __forceinline__ void row8(const pg8::Unit& u, int rloc, int cloc, const float (&a0)[8], const float (&a1)[8], int fq) const {
    const int tok = rowsel[u.ibase + rloc]; const float r = rsqrtf(ss2[tok] * (1.f / 1024.f) + 1e-6f); float h[8];
#pragma unroll
    for (int i = 0; i < 8; ++i) { const float g = a0[i] * r, up = a1[i] * r; h[i] = g * sigmoidf_(g) * up; }
    *(v4u*)(H + ((size_t)u.g * 2048 + u.pm * 256 + rloc) * 2048 + u.pn * 128 + cloc) = pack8(h); } };
struct EpiYE { static constexpr bool TWO_PASS = false; bf16* Yp; const float* gsel;
  __device__ __forceinline__ void row8(const pg8::Unit& u, int rloc, int cloc, const float (&a0)[8], const float (&a1)[8], int fq) const {
    const float gv = gsel[u.ibase + rloc]; float v0[8], v1[8];
#pragma unroll
    for (int i = 0; i < 8; ++i) { v0[i] = a0[i] * gv; v1[i] = a1[i] * gv; }
    bf16* p = Yp + ((size_t)u.g * 2048 + u.pm * 256 + rloc) * 1024 + u.pn * 256 + cloc; *(v4u*)p = pack8(v0); *(v4u*)(p + 128) = pack8(v1); } };
__device__ __forceinline__ void p14_final(Frame& F, const Args& a) {
  unsigned char* ws = F.ws; const float* X2 = (const float*)(ws + WS_X2); const int* INV = (const int*)(ws + WS_INV); const bf16* YE = (const bf16*)(ws + WS_YE);
  const float* gfin = (const float*)a.in[I_GFIN]; float* out = a.out;
  const int gw = F.vcu * NWAVES + F.wave, NGW = F.G * NWAVES;
  for (int m = gw; m < MTOK; m += NGW) { const int b = m >> 12;
    f32x4 v[4];
#pragma unroll
    for (int j = 0; j < 4; ++j) v[j] = *(const f32x4*)(X2 + (size_t)m * 1024 + 256 * j + 4 * F.lane);
    const int myinv = F.lane < 16 ? INV[(size_t)m * 16 + F.lane] : -1;
#pragma unroll
    for (int e = 0; e < 16; ++e) { const int slot = __shfl(myinv, e);
      if (slot >= 0) { const bf16* yr = YE + ((size_t)e * 2048 + b * 512 + slot) * 1024 + 4 * F.lane;
#pragma unroll
        for (int j = 0; j < 4; ++j) { const v2u w = *(const v2u*)(yr + 256 * j); v[j].x += bflo(w.x); v[j].y += bfhi(w.x); v[j].z += bflo(w.y); v[j].w += bfhi(w.y); } } }
    float s = 0.f;
#pragma unroll
    for (int j = 0; j < 4; ++j) s += (v[j].x * v[j].x + v[j].y * v[j].y) + (v[j].z * v[j].z + v[j].w * v[j].w);
    const float r = rsqrtf(wave_sum(s) * (1.f / 1024.f) + 1e-6f);
#pragma unroll
    for (int j = 0; j < 4; ++j) { const f32x4 g = *(const f32x4*)(gfin + 256 * j + 4 * F.lane); *(f32x4*)(out + (size_t)m * 1024 + 256 * j + 4 * F.lane) = v[j] * r * g; }
  }
}
__global__ void __launch_bounds__(NTHR, 2) mk(Args a) {
  extern __shared__ __attribute__((aligned(16))) unsigned char lds_raw[];
  Frame F;
  F.lds = (LAS unsigned char*)lds_raw; F.MISC = (volatile LAS unsigned*)(F.lds + LDSCTL_OFF + 320);
  F.tid = threadIdx.x; F.lane = F.tid & 63; F.wave = __builtin_amdgcn_readfirstlane(F.tid >> 6);
  F.G = gridDim.x; { const int bx = blockIdx.x; F.vcu = (F.G % 8 == 0) ? (bx % 8) * (F.G / 8) + bx / 8 : bx; }
  F.ws = a.ws; F.ctl = (gu32*)(a.ws + WS_CTL);
  unsigned char* ws = a.ws;
  for (int u = F.tid; u < (LDS_BYTES - LDSCTL_OFF) / 4; u += NTHR) ((LAS unsigned*)(F.lds + LDSCTL_OFF))[u] = 0u;
  __syncthreads();
  XcdBarrier bar = xcd_barrier_post((unsigned*)(F.ctl + CW_BAR), F.MISC + 8);
  const int lo = a.ph_lo, hi = a.ph_hi;
#define IN(k) (lo <= (k) && (k) < hi)
#define BOTH(k) (IN(k) && IN((k) + 1))
#define GRID_BAR() xcd_barrier(bar)
  float* ssq = (float*)(ws + CTL_SSQ); float* sskv = (float*)(ws + CTL_SSKV);

  if (IN(0)) { p0_prologue(F, a, true, (a.flags & 1) != 0); if (BOTH(0)) GRID_BAR(); }

  if (IN(1)) {
    { pg8::Gemm g{(const bf16*)(ws + WS_XN), (const bf16*)(ws + WS_WIN), 1024, 1024, 1024, nullptr}; pg8::StaticOrder S; S.init(MTOK, PROJ_LD, F.G, (int)blockIdx.x, 1024, 1024);
      EpiProj E{(bf16*)(ws + WS_PROJ), ssq, sskv};
      pg8::gemm_phase<EpiProj, pg8::StaticOrder, false>(F.lds, g, S, E); }
    { pg8::Gemm g{(const bf16*)(ws + WS_MEMN), (const bf16*)(ws + WS_WMK), 1024, 1024, 1024, nullptr}; pg8::StaticOrder S; S.init(1024, 1024, F.G, (int)((blockIdx.x + 128u) % (unsigned)F.G), 1024, 1024);
      EpiStore E{(bf16*)(ws + WS_KMEM), 1024};
      pg8::gemm_phase<EpiStore, pg8::StaticOrder, false>(F.lds, g, S, E); }
    { pg8::Gemm g{(const bf16*)(ws + WS_WMV), (const bf16*)(ws + WS_MEMN), 1024, 1024, 1024, nullptr}; pg8::StaticOrder S; S.init(1024, 1024, F.G, (int)((blockIdx.x + 112u) % (unsigned)F.G), 1024, 1024);
      EpiStore E{(bf16*)(ws + WS_VMEMT), 1024};
      pg8::gemm_phase<EpiStore, pg8::StaticOrder, false>(F.lds, g, S, E); }
    if (BOTH(1)) GRID_BAR();
  }

  if (IN(2)) {
    { pg8::Gemm g{(const bf16*)(ws + WS_PROJ) + PC_CQ, (const bf16*)(ws + WS_WQB), PROJ_LD, 256, 256, nullptr}; pg8::StaticOrder S; S.init(MTOK, 768, F.G, (int)blockIdx.x, PROJ_LD, 256);
      EpiQ E{(bf16*)(ws + WS_QM), ssq, (const float*)(ws + WS_ROPE)};
      pg8::gemm_phase<EpiQ, pg8::StaticOrder, false>(F.lds, g, S, E); }
    { pg8::Gemm g{(const bf16*)(ws + WS_PROJ) + PC_CKV, (const bf16*)(ws + WS_WKVB), PROJ_LD, 256, 256, nullptr}; pg8::StaticOrder S; S.init(MTOK, 1024, F.G, (int)((blockIdx.x + 64u) % (unsigned)F.G), PROJ_LD, 256);
      EpiKV E{(bf16*)(ws + WS_KM), (bf16*)(ws + WS_VM), sskv};
      pg8::gemm_phase<EpiKV, pg8::StaticOrder, false>(F.lds, g, S, E); }
    p2_elementwise(F, a);
    if (BOTH(2)) GRID_BAR();
  }
  if (IN(3)) {
    p3_mixers(F, a, (char*)lds_raw, bar.x);
    if (BOTH(3)) GRID_BAR();
  }
  if (IN(4)) { p4_combine(F, a); if (BOTH(4)) GRID_BAR(); }
  float* ss1 = (float*)(ws + CTL_SS1); float* ss2 = (float*)(ws + CTL_SS2);
  if (IN(5)) {
    pg8::Gemm g{(const bf16*)(ws + WS_Y), (const bf16*)(ws + WS_WOUT), 1024, 1024, 1024, nullptr}; pg8::StaticOrder S; S.init(MTOK, 1024, F.G, (int)blockIdx.x, 1024, 1024);
    EpiResid E{(const float*)a.in[I_X], (float*)(ws + WS_X1), (bf16*)(ws + WS_X1B), ss1};
    pg8::gemm_phase<EpiResid, pg8::StaticOrder, false>(F.lds, g, S, E);
    if (BOTH(5)) GRID_BAR();
  }
  if (IN(6)) {
    pg8::Gemm g{(const bf16*)(ws + WS_X1B), (const bf16*)(ws + WS_WMQ), 1024, 1024, 1024, nullptr}; pg8::StaticOrder S; S.init(MTOK, 1024, F.G, (int)blockIdx.x, 1024, 1024);
    EpiScale E{(bf16*)(ws + WS_QMEM), ss1};
    pg8::gemm_phase<EpiScale, pg8::StaticOrder, false>(F.lds, g, S, E);
    if (BOTH(6)) GRID_BAR();
  }
  if (IN(7)) {
    pg8::Gemm g{(const bf16*)(ws + WS_QMEM), (const bf16*)(ws + WS_KMEM), 1024, 1024, 256, nullptr}; MemOrder S{F.G, (int)blockIdx.x, 0};
    EpiSoftmax E{(bf16*)(ws + WS_P), 0.0625f, (LAS float*)(F.lds + LDSCTL_OFF + 1024)};
    pg8::gemm_phase<EpiSoftmax, MemOrder, false>(F.lds, g, S, E);
    if (BOTH(7)) GRID_BAR();
  }
  if (IN(8)) {
    pg8::Gemm g{(const bf16*)(ws + WS_P), (const bf16*)(ws + WS_VMEMT), 1024, 1024, 256, nullptr}; MemOrder S{F.G, (int)blockIdx.x, 1};
    EpiStore E{(bf16*)(ws + WS_MO), 1024};
    pg8::gemm_phase<EpiStore, MemOrder, false>(F.lds, g, S, E);
    if (BOTH(8)) GRID_BAR();
  }
  if (IN(9)) {
    pg8::Gemm g{(const bf16*)(ws + WS_MO), (const bf16*)(ws + WS_WMO), 1024, 1024, 1024, nullptr}; pg8::StaticOrder S; S.init(MTOK, 1024, F.G, (int)blockIdx.x, 1024, 1024);
    EpiResid E{(const float*)(ws + WS_X1), (float*)(ws + WS_X2), (bf16*)(ws + WS_X2B), ss2};
    pg8::gemm_phase<EpiResid, pg8::StaticOrder, false>(F.lds, g, S, E);
    if (BOTH(9)) GRID_BAR();
  }
  if (IN(10)) { p10_router(F, a); if (BOTH(10)) GRID_BAR(); }
  if (IN(11)) { p11_topk(F, (char*)lds_raw); if (BOTH(11)) GRID_BAR(); }
  if (IN(12)) {
    pg8::Gemm g{(const bf16*)(ws + WS_X2B), (const bf16*)(ws + WS_WEGU), 1024, 1024, 1024, (const int*)(ws + WS_ROWSEL)}; MoeGUOrder S{F.G, (int)blockIdx.x};
    EpiGU E{(bf16*)(ws + WS_HID), ss2, (const int*)(ws + WS_ROWSEL)};
    pg8::gemm_phase<EpiGU, MoeGUOrder, true>(F.lds, g, S, E);
    if (BOTH(12)) GRID_BAR();
  }
  if (IN(13)) {
    pg8::Gemm g{(const bf16*)(ws + WS_HID), (const bf16*)(ws + WS_WED), 2048, 2048, 2048, nullptr}; MoeDownOrder S{F.G, (int)blockIdx.x};
    EpiYE E{(bf16*)(ws + WS_YE), (const float*)(ws + WS_GSEL)};
    pg8::gemm_phase<EpiYE, MoeDownOrder, false>(F.lds, g, S, E);
    if (BOTH(13)) GRID_BAR();
  }
  if (IN(14)) { p14_final(F, a); }
#undef IN
#undef BOTH
#undef GRID_BAR
}

__global__ __launch_bounds__(256) void adapt_b2f(const bf16* src, long lds_, long scol, float* dst, long ldd, long dcol, long rows, long ncols) {
  const long i = blockIdx.x * 256L + threadIdx.x; if (i >= rows * ncols) return;
  const long r = i / ncols, c = i % ncols; dst[r * ldd + dcol + c] = bf2f(src[r * lds_ + scol + c]);
}
static void adapt(hipStream_t s, const void* src, long lds_, long scol, float* dst, long ldd, long dcol, long rows, long ncols) {
  hipLaunchKernelGGL(adapt_b2f, dim3((unsigned)((rows * ncols + 255) / 256)), dim3(256), 0, s, (const bf16*)src, lds_, scol, dst, ldd, dcol, rows, ncols);
}

static int mk_grid() {
  static int grid = 0;
  if (grid == 0) {
    int dev = 0, cus = 0, per_cu = 0;
    (void)hipGetDevice(&dev); (void)hipDeviceGetAttribute(&cus, hipDeviceAttributeMultiprocessorCount, dev);
    (void)hipFuncSetAttribute((const void*)mk, hipFuncAttributeMaxDynamicSharedMemorySize, LDS_BYTES);
    (void)hipOccupancyMaxActiveBlocksPerMultiprocessor(&per_cu, (const void*)mk, NTHR, LDS_BYTES);
    (void)hipGetLastError();
    grid = cus > 0 ? cus : 256;
  }
  return grid;
}
static void mk_launch(hipStream_t s, void* const* d_in, void* d_out, void* d_ws, int lo, int hi, int flags) {
  Args a; memset(&a, 0, sizeof(a));
  for (int i = 0; i < 26; ++i) a.in[i] = d_in[i];
  a.out = (float*)d_out; a.ws = (unsigned char*)d_ws; a.ph_lo = lo; a.ph_hi = hi; a.flags = flags; a.pad = 0;
  (void)hipMemsetAsync((char*)d_ws + WS_CTL + CW_BAR * 4, 0, XCD_BAR_WORDS * 4, s);
  hipLaunchKernelGGL(mk, dim3(mk_grid()), dim3(NTHR), LDS_BYTES, s, a);
}

extern "C" void kernel_launch(void* const* d_in, const int* in_sizes, int n_in, void* d_out, int out_size, void* d_ws, size_t ws_size, hipStream_t s) {
  (void)hipMemsetAsync((char*)d_ws + WS_CTL, 0, CTL_ZERO_BYTES, s);
  mk_launch(s, d_in, d_out, d_ws, 0, 15, 1);
}
```

```cpp
#include <hip/hip_runtime.h>
#include <cstdint>
#include <cstdio>
#include <cstring>

constexpr int BATCH = 4, SEQ = 4096, DM = 1024, MTOK = BATCH * SEQ;
constexpr int D_IN = 2480;
constexpr int OFF_QM = 0, OFF_KM = 512, OFF_VM = 1024, OFF_OM = 1536, OFF_G = 2048, OFF_CQ = 2064, OFF_CKV = 2320, OFF_KR = 2448;
constexpr int NEXP = 16, CAP = 512, DFF = 2048, NMEM = 256;
constexpr size_t MiB = 1u << 20;
enum { I_X = 0, I_MEM, I_POS, I_GMIX, I_WIN, I_BG, I_CONV, I_GQA, I_WQB, I_GKVA, I_WKVB, I_GHM, I_GHA, I_WOUT, I_GMX, I_GMKV, I_WMQ, I_WMK, I_WMV, I_WMO, I_GFFN, I_WR, I_WEG, I_WEU, I_WED, I_GFIN };
#define GAS __attribute__((address_space(1)))
#define LAS __attribute__((address_space(3)))
typedef unsigned short bf16;
typedef unsigned v4u __attribute__((ext_vector_type(4)));
typedef unsigned v2u __attribute__((ext_vector_type(2)));
typedef float f32x4 __attribute__((ext_vector_type(4)));
typedef float f32x16 __attribute__((ext_vector_type(16)));
typedef short bf16x8 __attribute__((ext_vector_type(8)));
typedef short s16x4 __attribute__((ext_vector_type(4)));
typedef GAS unsigned gu32;
#define RLX_AGENT __ATOMIC_RELAXED, __HIP_MEMORY_SCOPE_AGENT
#define LDS_WAIT() asm volatile("s_waitcnt lgkmcnt(0)" ::: "memory")
#define VM_WAIT() asm volatile("s_waitcnt vmcnt(0)" ::: "memory")
constexpr int NWAVES = 8, NTHR = 512;
__device__ __forceinline__ unsigned f2bf(float f) { unsigned u = __builtin_bit_cast(unsigned, f); return (u + 0x7fffu + ((u >> 16) & 1u)) >> 16; }
__device__ __forceinline__ unsigned pk2(float lo, float hi) { return f2bf(lo) | (f2bf(hi) << 16); }
__device__ __forceinline__ float bf2f(unsigned short h) { return __builtin_bit_cast(float, (unsigned)h << 16); }
__device__ __forceinline__ float bflo(unsigned w) { return __builtin_bit_cast(float, w << 16); }
__device__ __forceinline__ float bfhi(unsigned w) { return __builtin_bit_cast(float, w & 0xffff0000u); }
typedef float f32x2_t __attribute__((ext_vector_type(2))); typedef __bf16 bf16x2_t __attribute__((ext_vector_type(2)));
__device__ __forceinline__ unsigned cvt_pk_bf16(float lo, float hi) { f32x2_t v = {lo, hi}; bf16x2_t b = __builtin_convertvector(v, bf16x2_t); return __builtin_bit_cast(unsigned, b); }
__device__ __forceinline__ float wave_sum(float v) {
#pragma unroll
  for (int o = 1; o < 64; o <<= 1) v += __shfl_xor(v, o);
  return v;
}
__device__ __forceinline__ float sigmoidf_(float x) { return 1.f / (1.f + __expf(-x)); }

#define XB_TMO      128
#define XB_XCNT(j)  (256  + 64 * (j))
#define XB_XSUB(j)  (1280 + 64 * (j))
#define XB_XGEN(j)  (2304 + 64 * (j))
#define XB_TOP      3328
#define XB_TOPGEN   3392
#define XCD_BAR_WORDS 3456
#define XB_SPIN_CAP (1u << 22)
__device__ __forceinline__ unsigned xb_ld(unsigned* p)              { return __hip_atomic_load(p, __ATOMIC_RELAXED, __HIP_MEMORY_SCOPE_AGENT); }
__device__ __forceinline__ unsigned xb_add(unsigned* p, unsigned v) { return __hip_atomic_fetch_add(p, v, __ATOMIC_RELAXED, __HIP_MEMORY_SCOPE_AGENT); }
__device__ __forceinline__ unsigned xb_xcc_id() { return (unsigned)__builtin_amdgcn_s_getreg((3 << 11) | 20) & 0xFu; }
#define XB_SPIN(cond, bar) do { unsigned _sp = 0; while (cond) { __builtin_amdgcn_s_sleep(1); \
    if ((++_sp & 255u) == 0u) { if (xb_ld(&(bar)[XB_TMO])) break; if (_sp > XB_SPIN_CAP) { atomicAdd(&(bar)[XB_TMO], 1u); break; } } } } while (0)
struct XcdBarrier { unsigned* bar; unsigned x; volatile LAS unsigned* st; };
__device__ __forceinline__ XcdBarrier xcd_barrier_post(unsigned* bar, volatile LAS unsigned* st) {
  XcdBarrier b; b.bar = bar; b.x = xb_xcc_id(); b.st = st;
  if (threadIdx.x == 0) (void)xb_add(&bar[XB_XCNT(b.x)], 1u);
  return b;
}
__device__ __forceinline__ void xcd_barrier_complete(unsigned* bar, unsigned x, unsigned& nloc, unsigned& nx) {
  const unsigned G = gridDim.x * gridDim.y * gridDim.z;
  unsigned sum, cnt, mine, sp = 0u;
  for (;;) {
    sum = 0u; cnt = 0u; mine = 0u;
#pragma unroll
    for (unsigned j = 0; j < 16; ++j) { const unsigned c = xb_ld(&bar[XB_XCNT(j)]); sum += c; cnt += (c > 0u) ? 1u : 0u; mine = (j == x) ? c : mine; }
    if (sum == G) break;
    __builtin_amdgcn_s_sleep(1);
    if ((++sp & 255u) == 0u) { if (xb_ld(&bar[XB_TMO])) break; if (sp > XB_SPIN_CAP) { atomicAdd(&bar[XB_TMO], 1u); break; } }
  }
  nloc = mine > 0u ? mine : 1u; nx = cnt > 0u ? cnt : 1u;
}
__device__ __forceinline__ void xcd_barrier(const XcdBarrier& b) {
  asm volatile("s_waitcnt vmcnt(0)" ::: "memory");
  __syncthreads();
  if (threadIdx.x == 0) {
    unsigned* bar = b.bar;
    __builtin_amdgcn_s_waitcnt(0);
    unsigned nloc = b.st[0], nx = b.st[1];
    if (nloc == 0u) { xcd_barrier_complete(bar, b.x, nloc, nx); b.st[0] = nloc; b.st[1] = nx; }
    const unsigned old = xb_add(&bar[XB_XSUB(b.x)], 1u);
    const unsigned gen = old / nloc;
    if (old + 1u == (gen + 1u) * nloc) {
      __builtin_amdgcn_fence(__ATOMIC_RELEASE, "agent");
      asm volatile("s_waitcnt vmcnt(0)" ::: "memory");
      const unsigned og = xb_add(&bar[XB_TOP], 1u);
      const unsigned tg = og / nx;
      if (og + 1u == (tg + 1u) * nx) xb_add(&bar[XB_TOPGEN], 1u);
      else XB_SPIN(xb_ld(&bar[XB_TOPGEN]) == tg, bar);
      __builtin_amdgcn_fence(__ATOMIC_ACQUIRE, "agent");
      xb_add(&bar[XB_XGEN(b.x)], 1u);
      asm volatile("s_waitcnt vmcnt(0)" ::: "memory");
    } else {
      XB_SPIN(xb_ld(&bar[XB_XGEN(b.x)]) == gen, bar);
      __builtin_amdgcn_fence(__ATOMIC_ACQUIRE, "agent");
      asm volatile("s_waitcnt vmcnt(0)" ::: "memory");
    }
  }
  __syncthreads();
}

namespace pg8 {
constexpr int BM = 256, BK = 64, HALF = 128, HTB = HALF * BK * 2, STAGE_BYTES = 8 * HTB, NXCD = 8, WGM = 8;
__host__ __device__ __forceinline__ int lds_byte(int r, int c) { const int st = (r >> 4) * 2 + (c >> 5), rr = r & 15, cc = c & 31, ob = rr * 64 + cc * 2; return st * 1024 + (ob ^ (((ob >> 9) & 1) << 5)); }
__host__ __device__ __forceinline__ void stage_rc(int b, int& R, int& C) { const int st = b / 1024, sb = b % 1024, swz = sb ^ (((sb >> 9) & 1) << 5); R = (st >> 1) * 16 + swz / 64; C = (st & 1) * 32 + (swz % 64) / 2; }
__host__ __device__ __forceinline__ int perm32(int rho) { const int n = rho >> 4, i = rho & 15; return 8 * (i >> 2) + 4 * n + (i & 3); }

struct Unit { long aoff, boff; int pm, pn, g, ibase; };
struct Gemm { const bf16* A; const bf16* Bt; int lda, ldb, K; const int* gidx; };

struct StaticOrder {
  int nM, nN, nwg, G, c, lda, ldb;
  __device__ void init(int M, int N, int G_, int c_, int lda_, int ldb_) { nM = M / BM; nN = N / BM; nwg = nM * nN; G = G_; c = c_; lda = lda_; ldb = ldb_; }
  __device__ bool next(int i, Unit& u) const {
    const long L = (long)i * G + c; if (L >= nwg) return false;
    int wgid = (int)L; { const int q = nwg / NXCD, r = nwg % NXCD, xcd = wgid % NXCD, off = wgid / NXCD; wgid = (xcd < r ? xcd * (q + 1) : r * (q + 1) + (xcd - r) * q) + off; }
    const int nig = WGM * nN, gid = wgid / nig, fm = gid * WGM, gsz = (nM - fm) < WGM ? (nM - fm) : WGM;
    u.pm = fm + ((wgid % nig) % gsz); u.pn = (wgid % nig) / gsz; u.g = 0; u.ibase = 0;
    u.aoff = (long)u.pm * BM * lda; u.boff = (long)u.pn * BM * ldb; return true;
  }
};

template <class Epi, class Sched, bool GATHER>
__device__ __forceinline__ void gemm_phase(LAS unsigned char* lds, const Gemm g, const Sched& S, const Epi& E) {
  int tid = threadIdx.x; asm volatile("" : "+v"(tid));
  const int wid = __builtin_amdgcn_readfirstlane(tid >> 6), lane = tid & 63, wr = wid >> 2, wc = wid & 3, fr = lane & 15, fq = lane >> 4;
  const int K = g.K, nt = K / BK;
  int Rs[2], Cs[2]; unsigned voffB[2];
#pragma unroll
  for (int i = 0; i < 2; ++i) { int R, C; stage_rc(tid * 16 + i * 8192, R, C); Rs[i] = R; Cs[i] = C; const int Rb = (R & ~31) + perm32(R & 31); voffB[i] = (unsigned)(Rb * g.ldb + C) * 2u; }
  const size_t kstep = (size_t)(BK * 2);
  const size_t hstepB = (size_t)HALF * g.ldb * 2;
  const unsigned ldsw = (unsigned)wid * 1024u;
  const int aoff_l = lds_byte(wr * 64 + fr, fq * 8), boff_l = lds_byte(wc * 32 + fr, fq * 8);
#define PG8_SA(b, h) (((b) * 2 + (h)) * HTB)
#define PG8_SB(b, h) ((4 + (b) * 2 + (h)) * HTB)
#define PG8_STAGE(bufoff, gbase, voff) do { _Pragma("unroll") for (int _i = 0; _i < 2; ++_i) \
        __builtin_amdgcn_global_load_lds((const unsigned*)((const char*)(gbase) + (voff)[_i]), (LAS unsigned*)(lds + (bufoff) + ldsw + _i * 8192), 16, 0, 0); } while (0)
#define PG8_LDA(dst, b, h) do { _Pragma("unroll") for (int m = 0; m < 4; ++m) _Pragma("unroll") for (int k = 0; k < 2; ++k) dst[m][k] = *(const LAS bf16x8*)(lds + PG8_SA(b, h) + aoff_l + m * 2048 + k * 1024); } while (0)
#define PG8_LDB(dst, b, h) do { _Pragma("unroll") for (int n = 0; n < 2; ++n) _Pragma("unroll") for (int k = 0; k < 2; ++k) dst[n][k] = *(const LAS bf16x8*)(lds + PG8_SB(b, h) + boff_l + n * 2048 + k * 1024); } while (0)
#define PG8_MMA(ai, bj, At, Bt) do { __builtin_amdgcn_s_setprio(1); _Pragma("unroll") for (int m = 0; m < 4; ++m) _Pragma("unroll") for (int n = 0; n < 2; ++n) _Pragma("unroll") for (int k = 0; k < 2; ++k) \
        acc[ai][bj][m][n] = __builtin_amdgcn_mfma_f32_16x16x32_bf16(Bt[n][k], At[m][k], acc[ai][bj][m][n], 0, 0, 0); __builtin_amdgcn_s_setprio(0); } while (0)
#define PG8_WAIT_V(n) asm volatile("s_waitcnt vmcnt(" #n ")" ::: "memory")
#define PG8_WAIT_L(n) asm volatile("s_waitcnt lgkmcnt(" #n ")" ::: "memory")
#define PG8_BAR __builtin_amdgcn_s_barrier()
#define PG8_SCHED __builtin_amdgcn_sched_barrier(0)
  Unit cur, nxt; int ui = 0;
  if (!S.next(0, cur)) return;
  unsigned vA[2][2], nvA[2][2];
  auto load_va = [&](const Unit& u, unsigned (&v)[2][2]) {
#pragma unroll
    for (int h = 0; h < 2; ++h)
#pragma unroll
      for (int i = 0; i < 2; ++i) {
        if constexpr (GATHER) v[h][i] = (unsigned)((long)g.gidx[u.ibase + h * HALF + Rs[i]] * g.lda + Cs[i]) * 2u;
        else v[h][i] = (unsigned)((h * HALF + Rs[i]) * g.lda + Cs[i]) * 2u;
      }
  };
  load_va(cur, vA);
  f32x4 acc[2][2][4][2];
#pragma unroll
  for (int a = 0; a < 2; ++a)
#pragma unroll
    for (int b = 0; b < 2; ++b)
#pragma unroll
      for (int m = 0; m < 4; ++m)
#pragma unroll
        for (int n = 0; n < 2; ++n) acc[a][b][m][n] = (f32x4){0.f, 0.f, 0.f, 0.f};
  bf16x8 At[4][2], B0[2][2], B1[2][2];
  const char* cA = (const char*)g.A + (GATHER ? 0 : cur.aoff * 2); const char* cB = (const char*)g.Bt + cur.boff * 2;
  PG8_STAGE(PG8_SB(0, 0), cB, voffB); PG8_STAGE(PG8_SB(0, 1), cB + hstepB, voffB); PG8_STAGE(PG8_SA(0, 0), cA, vA[0]); PG8_STAGE(PG8_SA(0, 1), cA, vA[1]);
  if (wr == 1) PG8_BAR;
  PG8_WAIT_V(2); PG8_BAR;
  PG8_STAGE(PG8_SB(1, 0), cB + kstep, voffB); PG8_STAGE(PG8_SA(1, 0), cA + kstep, vA[0]); PG8_STAGE(PG8_SB(1, 1), cB + hstepB + kstep, voffB);
  PG8_WAIT_V(6); PG8_BAR;
  for (;;) {
    const bool has_next = S.next(ui + 1, nxt);
    const char* nA = has_next ? (const char*)g.A + (GATHER ? 0 : nxt.aoff * 2) : cA; const char* nB = has_next ? (const char*)g.Bt + nxt.boff * 2 : cB;
    if constexpr (GATHER) { if (has_next) load_va(nxt, nvA); else {
#pragma unroll
      for (int h = 0; h < 2; ++h)
#pragma unroll
        for (int i = 0; i < 2; ++i) nvA[h][i] = vA[h][i]; } }
#pragma unroll 1
    for (int t = 0; t < nt; t += 2) {
      const bool last = (t == nt - 2);
      const char* a1 = cA + (size_t)(t + 1) * kstep;
      const char* a2 = last ? nA : cA + (size_t)(t + 2) * kstep; const char* b2 = last ? nB : cB + (size_t)(t + 2) * kstep;
      const char* a3 = a2 + kstep; const char* b3 = b2 + kstep;
      unsigned w0[2], w1[2];
      if constexpr (GATHER) { w0[0] = last ? nvA[0][0] : vA[0][0]; w0[1] = last ? nvA[0][1] : vA[0][1]; w1[0] = last ? nvA[1][0] : vA[1][0]; w1[1] = last ? nvA[1][1] : vA[1][1]; }
      else { w0[0] = vA[0][0]; w0[1] = vA[0][1]; w1[0] = vA[1][0]; w1[1] = vA[1][1]; }
      PG8_LDB(B0, 0, 0); PG8_LDB(B1, 0, 1); PG8_SCHED; PG8_LDA(At, 0, 0); PG8_STAGE(PG8_SA(1, 1), a1, vA[1]);
      PG8_WAIT_V(8); PG8_WAIT_L(0); PG8_BAR; PG8_MMA(0, 0, At, B0); PG8_MMA(0, 1, At, B1); PG8_BAR; PG8_SCHED;
      PG8_LDA(At, 0, 1); PG8_STAGE(PG8_SB(0, 0), b2, voffB); PG8_STAGE(PG8_SB(0, 1), b2 + hstepB, voffB); PG8_STAGE(PG8_SA(0, 0), a2, w0);
      PG8_WAIT_V(8); PG8_WAIT_L(0); PG8_BAR; PG8_MMA(1, 0, At, B0); PG8_MMA(1, 1, At, B1); PG8_BAR; PG8_SCHED;
      PG8_LDB(B0, 1, 0); PG8_LDB(B1, 1, 1); PG8_SCHED; PG8_LDA(At, 1, 0); PG8_STAGE(PG8_SA(0, 1), a2, w1);
      PG8_WAIT_V(8); PG8_WAIT_L(0); PG8_BAR; PG8_MMA(0, 0, At, B0); PG8_MMA(0, 1, At, B1); PG8_BAR; PG8_SCHED;
      PG8_LDA(At, 1, 1); PG8_STAGE(PG8_SB(1, 0), b3, voffB); PG8_STAGE(PG8_SB(1, 1), b3 + hstepB, voffB); PG8_STAGE(PG8_SA(1, 0), a3, w0);
      PG8_WAIT_V(8); PG8_WAIT_L(0); PG8_BAR; PG8_MMA(1, 0, At, B0); PG8_MMA(1, 1, At, B1); PG8_BAR; PG8_SCHED;
    }
    if (wr == 0) PG8_BAR;
    if constexpr (Epi::TWO_PASS) {
#pragma unroll
      for (int ai = 0; ai < 2; ++ai)
#pragma unroll
        for (int m = 0; m < 4; ++m) {
          float v0[8], v1[8];
#pragma unroll
          for (int n = 0; n < 2; ++n)
#pragma unroll
            for (int j = 0; j < 4; ++j) { v0[n * 4 + j] = acc[ai][0][m][n][j]; v1[n * 4 + j] = acc[ai][1][m][n][j]; }
          E.pass1(cur, ai * HALF + wr * 64 + m * 16 + fr, wc, v0, v1, fq);
#pragma unroll
          for (int n = 0; n < 2; ++n)
#pragma unroll
            for (int j = 0; j < 4; ++j) { acc[ai][0][m][n][j] = v0[n * 4 + j]; acc[ai][1][m][n][j] = v1[n * 4 + j]; }
        }
      asm volatile("s_waitcnt lgkmcnt(0)" ::: "memory"); PG8_BAR; asm volatile("" ::: "memory");
    }
    {
#pragma unroll
      for (int ai = 0; ai < 2; ++ai)
#pragma unroll
        for (int m = 0; m < 4; ++m) {
          float v0[8], v1[8];
#pragma unroll
          for (int n = 0; n < 2; ++n)
#pragma unroll
            for (int j = 0; j < 4; ++j) { v0[n * 4 + j] = acc[ai][0][m][n][j]; v1[n * 4 + j] = acc[ai][1][m][n][j]; }
          E.row8(cur, ai * HALF + wr * 64 + m * 16 + fr, wc * 32 + 8 * fq, v0, v1, fq);
          asm volatile("" ::: "memory");
        }
    }
    if (!has_next) break;
#pragma unroll
    for (int a = 0; a < 2; ++a)
#pragma unroll
      for (int b = 0; b < 2; ++b)
#pragma unroll
        for (int m = 0; m < 4; ++m)
#pragma unroll
          for (int n = 0; n < 2; ++n) acc[a][b][m][n] = (f32x4){0.f, 0.f, 0.f, 0.f};
    cur = nxt; cA = nA; cB = nB; ++ui;
    if constexpr (GATHER) {
#pragma unroll
      for (int h = 0; h < 2; ++h)
#pragma unroll
        for (int i = 0; i < 2; ++i) vA[h][i] = nvA[h][i]; }
    if (wr == 1) PG8_BAR;
  }
  PG8_WAIT_V(0);
  PG8_BAR;
#undef PG8_SA
#undef PG8_SB
#undef PG8_STAGE
#undef PG8_LDA
#undef PG8_LDB
#undef PG8_MMA
#undef PG8_WAIT_V
#undef PG8_WAIT_L
#undef PG8_BAR
#undef PG8_SCHED
}
}
constexpr size_t WS_CTL = 0, CTL_ZERO_BYTES = 1 * MiB;
constexpr int CW_TMO = 0, CW_BAR = 4096, CW_Q = 8192;
constexpr size_t CTL_SSQ = 256 * 1024, CTL_SSKV = CTL_SSQ + 65536, CTL_SS1 = CTL_SSKV + 65536, CTL_SS2 = CTL_SS1 + 65536;
constexpr size_t WS_WIN = 1 * MiB, WS_WQB = 6 * MiB, WS_WKVB = 6 * MiB + 512 * 1024, WS_WOUT = 7 * MiB, WS_WMQ = 9 * MiB, WS_WMK = 11 * MiB, WS_WMV = 13 * MiB, WS_WMO = 15 * MiB;
constexpr size_t WS_ROPE = 17 * MiB, WS_MEMN = 19 * MiB, WS_KMEM = 21 * MiB, WS_VMEMT = 23 * MiB, WS_GSC = 25 * MiB, WS_DEC = 28 * MiB, WS_AFF = 29 * MiB, WS_SEL = 30 * MiB;
constexpr size_t WS_PROJ = 32 * MiB, WS_XN = 112 * MiB, WS_QC = 112 * MiB, WS_KC = 128 * MiB, WS_QM = 144 * MiB, WS_KM = 168 * MiB, WS_VM = 192 * MiB, WS_HF = 208 * MiB, WS_HB = 224 * MiB, WS_Y = 240 * MiB;
constexpr size_t WS_X1 = 112 * MiB, WS_X1B = 176 * MiB, WS_QMEM = 208 * MiB, WS_P = 240 * MiB, WS_MO = 176 * MiB, WS_X2 = 240 * MiB, WS_X2B = 208 * MiB, WS_HID = 32 * MiB;
constexpr size_t WS_DUMMY = 304 * MiB;
constexpr size_t WS_WEGU = 320 * MiB, WS_WED = 448 * MiB, WS_END = 512 * MiB;
constexpr int PROJ_LD = 2560;
constexpr int PC_CQ = 2048, PC_CKV = 2304, PC_KR = 2432, PC_G = 2464;
constexpr int RING_BYTES = 131072, LDSCTL_OFF = 133120, LDS_BYTES = 147456;

struct Args { const void* in[26]; float* out; unsigned char* ws; int ph_lo, ph_hi, flags, pad; };

struct Frame {
  LAS unsigned char* lds; volatile LAS unsigned* MISC; gu32* ctl; unsigned char* ws;
  int tid, lane, wave, vcu, G;
};

__device__ __forceinline__ void p0_tr(const float* W, int ldw, int k0, int kvalid, int scol0, int ncols, const float* gs, bf16* WT, int ldt, int drow0, LAS float* scr, int lane) {
  const int c4 = (lane & 15) * 4, kr = lane >> 4;
  f32x4 v[16];
#pragma unroll
  for (int i = 0; i < 16; ++i) { const int kk = 4 * i + kr; v[i] = (f32x4){0.f, 0.f, 0.f, 0.f};
    if (c4 < ncols && k0 + kk < kvalid) { v[i] = *(const f32x4*)(W + (size_t)(k0 + kk) * ldw + scol0 + c4); if (gs) v[i] = v[i] * gs[k0 + kk]; } }
#pragma unroll
  for (int i = 0; i < 16; ++i) { const int kk = 4 * i + kr; LAS float* d = scr + kk * 65 + c4; d[0] = v[i].x; d[1] = v[i].y; d[2] = v[i].z; d[3] = v[i].w; }
  LDS_WAIT(); asm volatile("" ::: "memory");
  const int c = lane & 7;
#pragma unroll
  for (int j = 0; j < 8; ++j) { const int n = (lane >> 3) + 8 * j; const LAS float* s = scr + (8 * c) * 65 + n;
    v4u o; o.x = pk2(s[0 * 65], s[1 * 65]); o.y = pk2(s[2 * 65], s[3 * 65]); o.z = pk2(s[4 * 65], s[5 * 65]); o.w = pk2(s[6 * 65], s[7 * 65]);
    *(GAS v4u*)(WT + (size_t)(drow0 + n) * ldt + k0 + 8 * c) = o; }
  LDS_WAIT(); asm volatile("" ::: "memory");
}
__device__ __forceinline__ void p0_tr32(const float* W, int ldw, int k0, int scol0, int ncols, const float* gs, bf16* WT, int ldt, int drow0, LAS float* scr, int lane) {
#pragma unroll 8
  for (int i = 0; i < 32; ++i) { const int kk = 2 * i + (lane >> 5), c = lane & 31; float v = 0.f;
    if (c < ncols) { v = W[(size_t)(k0 + kk) * ldw + scol0 + c]; if (gs) v *= gs[k0 + kk]; }
    scr[kk * 65 + c] = v; }
  LDS_WAIT(); asm volatile("" ::: "memory");
  const int c = lane & 7;
#pragma unroll
  for (int j = 0; j < 4; ++j) { const int n = (lane >> 3) + 8 * j; const LAS float* s = scr + (8 * c) * 65 + n;
    v4u o; o.x = pk2(s[0 * 65], s[1 * 65]); o.y = pk2(s[2 * 65], s[3 * 65]); o.z = pk2(s[4 * 65], s[5 * 65]); o.w = pk2(s[6 * 65], s[7 * 65]);
    *(GAS v4u*)(WT + (size_t)(drow0 + n) * ldt + k0 + 8 * c) = o; }
  LDS_WAIT(); asm volatile("" ::: "memory");
}
__device__ __forceinline__ void rms_row_to_bf16(const float* xrow, bf16* orow, int lane) {
  const GAS f32x4* xr = (const GAS f32x4*)xrow + lane;
  f32x4 v[4]; float s = 0.f;
#pragma unroll
  for (int j = 0; j < 4; ++j) { v[j] = xr[64 * j]; s += (v[j].x * v[j].x + v[j].y * v[j].y) + (v[j].z * v[j].z + v[j].w * v[j].w); }
  const float rstd = rsqrtf(wave_sum(s) * (1.f / 1024.f) + 1e-6f);
  GAS unsigned long long* o8 = (GAS unsigned long long*)orow + lane;
#pragma unroll
  for (int j = 0; j < 4; ++j) o8[64 * j] = (unsigned long long)pk2(v[j].x * rstd, v[j].y * rstd) | ((unsigned long long)pk2(v[j].z * rstd, v[j].w * rstd) << 32);
}

__device__ __forceinline__ void p0_prologue(Frame& F, const Args& a, bool do_dense, bool do_experts) {
  LAS float* scr = (LAS float*)(F.lds + F.wave * 16640);
  const int gw = F.vcu * NWAVES + F.wave, NGW = F.G * NWAVES;
  auto I = [&](int i) { return (const float*)a.in[i]; };
  unsigned char* ws = F.ws;
  if (do_dense) {
    constexpr int I_WIN_ = 16 * 40, I_WQB_ = 4 * 12, I_WKVB_ = 4 * 16, I_SQ = 16 * 16;
    constexpr int NIT = I_WIN_ + I_WQB_ + I_WKVB_ + 5 * I_SQ;
    for (int it = gw; it < NIT; it += NGW) {
      int r = it;
      if (r < I_WIN_) { const int kb = r / 40, nb = r % 40; int sc, nc = 64;
        if (nb < 32) sc = 64 * nb; else if (nb < 36) sc = OFF_CQ + 64 * (nb - 32); else if (nb < 38) sc = OFF_CKV + 64 * (nb - 36); else if (nb == 38) { sc = OFF_KR; nc = 32; } else { sc = 0; nc = 0; }
        p0_tr(I(I_WIN), D_IN, 64 * kb, 1024, sc, nc, I(I_GMIX), (bf16*)(ws + WS_WIN), 1024, 64 * nb, scr, F.lane);
        if (nb == 38) p0_tr32(I(I_WIN), D_IN, 64 * kb, OFF_G, 16, I(I_GMIX), (bf16*)(ws + WS_WIN), 1024, PC_G, scr, F.lane);
        continue; } r -= I_WIN_;
      if (r < I_WQB_) { const int kb = r / 12, nb = r % 12; p0_tr(I(I_WQB), 768, 64 * kb, 256, 64 * nb, 64, I(I_GQA), (bf16*)(ws + WS_WQB), 256, 64 * nb, scr, F.lane); continue; } r -= I_WQB_;
      if (r < I_WKVB_) { const int kb = r / 16, nb = r % 16; const int h = nb & 7; const int sc = h * 128 + (nb >= 8 ? 64 : 0);
        p0_tr(I(I_WKVB), 1024, 64 * kb, 128, sc, 64, I(I_GKVA), (bf16*)(ws + WS_WKVB), 256, 64 * nb, scr, F.lane); continue; } r -= I_WKVB_;
      const int which = r / I_SQ; r %= I_SQ; const int kb = r / 16, nb = r % 16;
      const float* src = which == 0 ? I(I_WOUT) : which == 1 ? I(I_WMQ) : which == 2 ? I(I_WMK) : which == 3 ? I(I_WMV) : I(I_WMO);
      const float* gs = which == 1 ? I(I_GMX) : (which == 2 || which == 3) ? I(I_GMKV) : nullptr;
      bf16* dst = (bf16*)(ws + (which == 0 ? WS_WOUT : which == 1 ? WS_WMQ : which == 2 ? WS_WMK : which == 3 ? WS_WMV : WS_WMO));
      p0_tr(src, 1024, 64 * kb, 1024, 64 * nb, 64, gs, dst, 1024, 64 * nb, scr, F.lane);
    }
    for (int m = gw; m < MTOK; m += NGW) rms_row_to_bf16(I(I_X) + (size_t)m * 1024, (bf16*)(ws + WS_XN) + (size_t)m * 1024, F.lane);
    for (int m = gw; m < BATCH * NMEM; m += NGW) rms_row_to_bf16(I(I_MEM) + (size_t)m * 1024, (bf16*)(ws + WS_MEMN) + (size_t)m * 1024, F.lane);
    { const int* pos = (const int*)a.in[I_POS]; float* rt = (float*)(ws + WS_ROPE);
      for (int i = (F.vcu * NTHR + F.tid); i < MTOK * 16; i += F.G * NTHR) { const int m = i >> 4, j = i & 15; const float inv = powf(10000.f, -(float)j / 16.f); const float ang = (float)pos[m] * inv;
        rt[m * 32 + j] = cosf(ang); rt[m * 32 + 16 + j] = sinf(ang); } }
  }
  if (do_experts) {
    constexpr int I_GU = 16 * 64, I_D = 32 * 16;
    for (int it = gw; it < NEXP * (I_GU + I_D); it += NGW) {
      const int e = it / (I_GU + I_D); int r = it % (I_GU + I_D);
      if (r < I_GU) { const int kb = r / 64, nb = r % 64, p = nb >> 2, j0 = (nb & 3) * 64; const bool up = j0 >= 128;
        p0_tr((up ? I(I_WEU) : I(I_WEG)) + (size_t)e * 1024 * 2048, 2048, 64 * kb, 1024, 128 * p + (up ? j0 - 128 : j0), 64, I(I_GFFN), (bf16*)(ws + WS_WEGU) + (size_t)e * 4096 * 1024, 1024, 64 * nb, scr, F.lane); }
      else { r -= I_GU; const int kb = r / 16, nb = r % 16;
        p0_tr(I(I_WED) + (size_t)e * 2048 * 1024, 1024, 64 * kb, 2048, 64 * nb, 64, nullptr, (bf16*)(ws + WS_WED) + (size_t)e * 1024 * 2048, 2048, 64 * nb, scr, F.lane); }
    }
  }
}

__device__ __forceinline__ v4u pack8(const float (&v)[8]) { v4u w; w.x = cvt_pk_bf16(v[0], v[1]); w.y = cvt_pk_bf16(v[2], v[3]); w.z = cvt_pk_bf16(v[4], v[5]); w.w = cvt_pk_bf16(v[6], v[7]); return w; }
__device__ __forceinline__ float sumsq8(const float (&v)[8]) { float s = 0.f;
#pragma unroll
  for (int i = 0; i < 8; ++i) s += v[i] * v[i];
  return s; }
struct EpiStore { static constexpr bool TWO_PASS = false; bf16* O; int ldc;
  __device__ __forceinline__ void row8(const pg8::Unit& u, int rloc, int cloc, const float (&v0)[8], const float (&v1)[8], int fq) const {
    bf16* p = O + (size_t)(u.pm * 256 + rloc) * ldc + u.pn * 256 + cloc; *(v4u*)p = pack8(v0); *(v4u*)(p + 128) = pack8(v1); } };
struct EpiProj { static constexpr bool TWO_PASS = false; bf16* P; float* ssq; float* sskv;
  __device__ __forceinline__ void row8(const pg8::Unit& u, int rloc, int cloc, const float (&v0)[8], const float (&v1)[8], int fq) const {
    const int row = u.pm * 256 + rloc; bf16* p = P + (size_t)row * PROJ_LD + u.pn * 256 + cloc; *(v4u*)p = pack8(v0); *(v4u*)(p + 128) = pack8(v1);
    if (u.pn == 8) { float s = sumsq8(v0) + sumsq8(v1); s += __shfl_xor(s, 16); s += __shfl_xor(s, 32); if (fq == 0) unsafeAtomicAdd(ssq + row, s); }
    if (u.pn == 9) { float s = sumsq8(v0); s += __shfl_xor(s, 16); s += __shfl_xor(s, 32); if (fq == 0) unsafeAtomicAdd(sskv + row, s); } } };
struct EpiQ { static constexpr bool TWO_PASS = false; bf16* Q; const float* ssq; const float* rope;
  __device__ __forceinline__ void rope8(float (&v)[8], int row, int fq) const {
    float pv[8];
#pragma unroll
    for (int i = 0; i < 8; ++i) pv[i] = __shfl_xor(v[i], 32);
    const float* cs = rope + (size_t)row * 32 + 8 * (fq & 1);
#pragma unroll
    for (int i = 0; i < 8; ++i) { const float c = cs[i], s = cs[16 + i]; v[i] = (fq < 2) ? (v[i] * c - pv[i] * s) : (v[i] * c + pv[i] * s); }
  }
  __device__ __forceinline__ void row8(const pg8::Unit& u, int rloc, int cloc, const float (&a0)[8], const float (&a1)[8], int fq) const {
    const int row = u.pm * 256 + rloc; const float r = rsqrtf(ssq[row] * (1.f / 256.f) + 1e-6f);
    float v0[8], v1[8];
#pragma unroll
    for (int i = 0; i < 8; ++i) { v0[i] = a0[i] * r; v1[i] = a1[i] * r; }
    const int g0 = u.pn * 8 + (cloc >> 5), g1 = g0 + 4;
    if (g0 % 3 == 2) rope8(v0, row, fq);
    if (g1 % 3 == 2) rope8(v1, row, fq);
    bf16* p = Q + (size_t)row * 768 + u.pn * 256 + cloc; *(v4u*)p = pack8(v0); *(v4u*)(p + 128) = pack8(v1); } };
struct EpiKV { static constexpr bool TWO_PASS = false; bf16* KMp; bf16* VMp; const float* sskv;
  __device__ __forceinline__ void put(int row, int c, const float (&v)[8], float r) const {
    float w[8];
#pragma unroll
    for (int i = 0; i < 8; ++i) w[i] = v[i] * r;
    if (c < 512) *(v4u*)(KMp + (size_t)row * 768 + (c >> 6) * 96 + (c & 63)) = pack8(w); else *(v4u*)(VMp + (size_t)row * 512 + (c - 512)) = pack8(w); }
  __device__ __forceinline__ void row8(const pg8::Unit& u, int rloc, int cloc, const float (&a0)[8], const float (&a1)[8], int fq) const {
    const int row = u.pm * 256 + rloc; const float r = rsqrtf(sskv[row] * (1.f / 128.f) + 1e-6f);
    put(row, u.pn * 256 + cloc, a0, r); put(row, u.pn * 256 + 128 + cloc, a1, r); } };

__device__ __forceinline__ void unpack8(v4u w, float (&f)[8]) { f[0] = bflo(w.x); f[1] = bfhi(w.x); f[2] = bflo(w.y); f[3] = bfhi(w.y); f[4] = bflo(w.z); f[5] = bfhi(w.z); f[6] = bflo(w.w); f[7] = bfhi(w.w); }
__device__ __forceinline__ float log_sigmoid(float x) { return fminf(x, 0.f) - log1pf(__expf(-fabsf(x))); }

__device__ __forceinline__ void p2_elementwise(Frame& F, const Args& a) {
  unsigned char* ws = F.ws;
  const bf16* P = (const bf16*)(ws + WS_PROJ);
  { const float* cw = (const float*)a.in[I_CONV]; bf16* QC = (bf16*)(ws + WS_QC); bf16* KC = (bf16*)(ws + WS_KC);
    for (int i = F.vcu * NTHR + F.tid; i < MTOK * 128; i += F.G * NTHR) { const int m = i >> 7, c = (i & 127) * 8, t = m & (SEQ - 1);
      float x1[8], x0[8], x2[8]; unpack8(*(const v4u*)(P + (size_t)m * PROJ_LD + c), x1);
      if (t > 0) unpack8(*(const v4u*)(P + (size_t)(m - 1) * PROJ_LD + c), x0); else {
#pragma unroll
        for (int j = 0; j < 8; ++j) x0[j] = 0.f; }
      if (t < SEQ - 1) unpack8(*(const v4u*)(P + (size_t)(m + 1) * PROJ_LD + c), x2); else {
#pragma unroll
        for (int j = 0; j < 8; ++j) x2[j] = 0.f; }
      float o[8];
#pragma unroll
      for (int j = 0; j < 8; ++j) { float v = x0[j] * cw[c + j] + x1[j] * cw[1024 + c + j] + x2[j] * cw[2048 + c + j]; v = v * sigmoidf_(v); o[j] = (c < 512) ? v : v * 0.08838834764831845f; }
      if (c < 512) *(v4u*)(QC + (size_t)m * 512 + c) = pack8(o); else *(v4u*)(KC + (size_t)m * 512 + c - 512) = pack8(o); } }
  { const float* rope = (const float*)(ws + WS_ROPE); bf16* KMp = (bf16*)(ws + WS_KM);
    for (int i = F.vcu * NTHR + F.tid; i < MTOK * 16; i += F.G * NTHR) { const int m = i >> 4, j = i & 15;
      const float t1 = bf2f(P[(size_t)m * PROJ_LD + PC_KR + j]), t2 = bf2f(P[(size_t)m * PROJ_LD + PC_KR + 16 + j]); const float c = rope[m * 32 + j], s = rope[m * 32 + 16 + j];
      const bf16 o1 = (bf16)f2bf(t1 * c - t2 * s), o2 = (bf16)f2bf(t2 * c + t1 * s);
#pragma unroll
      for (int h = 0; h < 8; ++h) { KMp[(size_t)m * 768 + h * 96 + 64 + j] = o1; KMp[(size_t)m * 768 + h * 96 + 80 + j] = o2; } } }
  { const float* bg = (const float*)a.in[I_BG]; float* GSC = (float*)(ws + WS_GSC); float* DEC = (float*)(ws + WS_DEC);
    const int gw = F.vcu * NWAVES + F.wave, NGW = F.G * NWAVES;
    for (int it = gw; it < 32 * 64; it += NGW) { const int seq = it >> 6, c = it & 63, dir = seq & 1, h = (seq >> 1) & 3, b = seq >> 3;
      const int p = c * 64 + F.lane, t = dir ? (SEQ - 1 - p) : p; const size_t row = (size_t)b * SEQ + t;
      const int gi = (dir ? 8 : 0) + h, gf = (dir ? 12 : 4) + h;
      const float li = bf2f(P[row * PROJ_LD + PC_G + gi]) + bg[gi]; const float lf = log_sigmoid(bf2f(P[row * PROJ_LD + PC_G + gf]) + bg[gf]);
      float bs = lf;
#pragma unroll
      for (int o = 1; o < 64; o <<= 1) { const float y = __shfl_up(bs, o); if (F.lane >= o) bs += y; }
      const float av = li - bs; float pm = av;
#pragma unroll
      for (int o = 1; o < 64; o <<= 1) { const float y = __shfl_up(pm, o); if (F.lane >= o) pm = fmaxf(pm, y); }
      float* gs = GSC + (size_t)seq * 3 * SEQ; gs[p] = bs; gs[SEQ + p] = av; gs[2 * SEQ + p] = pm;
      if (F.lane == 63) { DEC[seq * 128 + c] = bs; DEC[seq * 128 + 64 + c] = pm; } } }
}
namespace mla {
constexpr int DQK = 96, DV = 64, NW = 8, QBLK = 32, KVBLK = 64, LDQ = 768, LDK = 768, LDV = 512, LDO = 1024;
constexpr float SCALE = 0.10206207261596575f;
constexpr float THR = 8.f;
constexpr int SHM_V = 16384, SHM_K = 16384, SHM_ATTN = 2 * SHM_V + 2 * SHM_K + NW * 64 * 4;
#define KSWZ(row, colB) ((row) * 256 + ((colB) ^ (((row) & 7) << 4)))
#define SBAR() __builtin_amdgcn_sched_barrier(0)
__device__ __forceinline__ int crow(int r, int hi) { return (r & 3) + 8 * (r >> 2) + 4 * hi; }
__device__ __forceinline__ void partialSM(f32x16& p0, f32x16& p1, float& m_reg, float& mn, float& alpha) {
  constexpr float C = SCALE * 1.4426950408889634f;
  float pmax = p0[0];
#pragma unroll
  for (int r = 1; r < 16; ++r) pmax = fmaxf(pmax, p0[r]);
#pragma unroll
  for (int r = 0; r < 16; ++r) pmax = fmaxf(pmax, p1[r]);
  { auto rr = __builtin_amdgcn_permlane32_swap(__float_as_uint(pmax), __float_as_uint(pmax), false, false);
    pmax = fmaxf(__uint_as_float(rr[0]), __uint_as_float(rr[1])); }
  if (__builtin_expect(__all(pmax - m_reg <= THR / SCALE), 1)) { mn = m_reg; alpha = 1.f; }
  else { mn = fmaxf(m_reg, pmax); alpha = __builtin_amdgcn_exp2f((m_reg - mn) * C); m_reg = mn; }
  const float mnC = -mn * C;
#pragma unroll
  for (int r = 0; r < 16; ++r) p0[r] = fmaf(p0[r], C, mnC);
#pragma unroll
  for (int r = 0; r < 16; ++r) p1[r] = fmaf(p1[r], C, mnC);
#pragma unroll
  for (int r = 0; r < 16; ++r) p0[r] = __builtin_amdgcn_exp2f(p0[r]);
}
__device__ __forceinline__ void finishSM(f32x16& p0, f32x16& p1, float alpha, float& l_reg, bf16x8& pa0, bf16x8& pa1, bf16x8& pa2, bf16x8& pa3) {
#pragma unroll
  for (int r = 0; r < 16; ++r) p1[r] = __builtin_amdgcn_exp2f(p1[r]);
  float ps = 0;
#pragma unroll
  for (int r = 0; r < 16; ++r) ps += p0[r];
#pragma unroll
  for (int r = 0; r < 16; ++r) ps += p1[r];
  { auto rr = __builtin_amdgcn_permlane32_swap(__float_as_uint(ps), __float_as_uint(ps), false, false);
    ps = __uint_as_float(rr[0]) + __uint_as_float(rr[1]); }
  l_reg = l_reg * alpha + ps;
#define PK4(P, BASE, OUT) do { unsigned a0 = cvt_pk_bf16(P[BASE + 0], P[BASE + 1]), a1 = cvt_pk_bf16(P[BASE + 2], P[BASE + 3]);   \
    unsigned b0 = cvt_pk_bf16(P[BASE + 4], P[BASE + 5]), b1 = cvt_pk_bf16(P[BASE + 6], P[BASE + 7]);                              \
    auto r0 = __builtin_amdgcn_permlane32_swap(a0, b0, false, false); auto r1 = __builtin_amdgcn_permlane32_swap(a1, b1, false, false); \
    v4u w = {r0[0], r1[0], r0[1], r1[1]}; OUT = __builtin_bit_cast(bf16x8, w); } while (0)
  PK4(p0, 0, pa0); PK4(p0, 8, pa1); PK4(p1, 0, pa2); PK4(p1, 8, pa3);
#undef PK4
}
__device__ __forceinline__ void qkt(f32x16& p0, f32x16& p1, const char* Ks, const bf16x8* qr, int r32, int hi) {
  p0 = f32x16{}; p1 = f32x16{};
#pragma unroll
  for (int d0 = 0; d0 < DQK / 16; ++d0) { const int cb = (d0 * 16 + hi * 8) * 2;
    const bf16x8 b0 = *reinterpret_cast<const bf16x8*>(Ks + KSWZ(r32, cb));
    const bf16x8 b1 = *reinterpret_cast<const bf16x8*>(Ks + KSWZ(32 + r32, cb));
    p0 = __builtin_amdgcn_mfma_f32_32x32x16_bf16(b0, qr[d0], p0, 0, 0, 0);
    p1 = __builtin_amdgcn_mfma_f32_32x32x16_bf16(b1, qr[d0], p1, 0, 0, 0); }
}
__device__ __forceinline__ int v_st(int k, int c) { const int kk = (k & ~0xC) | ((k & 4) << 1) | ((k & 8) >> 1); return ((kk >> 3) * 4 + (c >> 5)) * 512 + ((kk & 7) * 32 + (c & 31)) * 2; }
__device__ __forceinline__ int v_rd_base(int lane) { return ((lane & 3) << 3) | (((lane >> 2) & 3) << 6) | (((lane >> 4) & 1) << 5) | (((lane >> 5) & 1) << 8); }
constexpr int v_rd_off(int d0, int ks, int half) { return d0 * 512 + ks * 4096 + half * 2048; }
template <int OFF> __device__ __forceinline__ s16x4 tr_read(int vb) {
  s16x4 r; asm volatile("ds_read_b64_tr_b16 %0, %1 offset:%2" : "=&v"(r) : "v"(vb), "i"(OFF) : "memory"); return r;
}
template <int D0> __device__ __forceinline__ void pv_one(f32x16& od, int vb, bf16x8 pa0, bf16x8 pa1, bf16x8 pa2, bf16x8 pa3) {
  const s16x4 l0 = tr_read<v_rd_off(D0, 0, 0)>(vb), h0 = tr_read<v_rd_off(D0, 0, 1)>(vb), l1 = tr_read<v_rd_off(D0, 1, 0)>(vb), h1 = tr_read<v_rd_off(D0, 1, 1)>(vb);
  const s16x4 l2 = tr_read<v_rd_off(D0, 2, 0)>(vb), h2 = tr_read<v_rd_off(D0, 2, 1)>(vb), l3 = tr_read<v_rd_off(D0, 3, 0)>(vb), h3 = tr_read<v_rd_off(D0, 3, 1)>(vb);
  asm volatile("s_waitcnt lgkmcnt(0)" ::: "memory"); SBAR();
#define PK(L, H) (bf16x8){L[0], L[1], L[2], L[3], H[0], H[1], H[2], H[3]}
  od = __builtin_amdgcn_mfma_f32_32x32x16_bf16(pa0, PK(l0, h0), od, 0, 0, 0);
  od = __builtin_amdgcn_mfma_f32_32x32x16_bf16(pa1, PK(l1, h1), od, 0, 0, 0);
  od = __builtin_amdgcn_mfma_f32_32x32x16_bf16(pa2, PK(l2, h2), od, 0, 0, 0);
  od = __builtin_amdgcn_mfma_f32_32x32x16_bf16(pa3, PK(l3, h3), od, 0, 0, 0);
#undef PK
}
__device__ __forceinline__ void pv_d0(f32x16* o, int vb, bf16x8 pa0, bf16x8 pa1, bf16x8 pa2, bf16x8 pa3) {
  pv_one<0>(o[0], vb, pa0, pa1, pa2, pa3); pv_one<1>(o[1], vb, pa0, pa1, pa2, pa3);
}
__device__ __forceinline__ void attn_unit(const bf16* __restrict__ Qb, const bf16* __restrict__ Kh, const bf16* __restrict__ Vh, bf16* __restrict__ Yb, const float* __restrict__ gh, int seq, char* lds) {
  int tid = threadIdx.x; asm volatile("" : "+v"(tid));
  const int wid = tid >> 6, lane = tid & 63, r32 = lane & 31, hi = lane >> 5;
  char* V_lds = lds; char* K_lds = lds + 2 * SHM_V;
  float* wsf = (float*)(lds + 2 * SHM_V + 2 * SHM_K) + wid * 64; float* li_l = wsf; float* al_l = wsf + 32;
  float m_reg = -1e30f, l_reg = 0; f32x16 o[2] = {}; bf16x8 qr[DQK / 16];
  const bf16* Qw = Qb + (long)(wid * QBLK + r32) * LDQ + hi * 8;
#pragma unroll
  for (int d0 = 0; d0 < DQK / 16; ++d0) qr[d0] = *reinterpret_cast<const bf16x8*>(Qw + d0 * 16);
  const int sr = tid >> 4, sc = (tid & 15) * 8, vst0 = v_st(sr, sc & 63), vst1 = v_st(32 + sr, sc & 63);
  const bool doK = sc < DQK, doV = sc < DV;
  const int vb0 = (int)(uintptr_t)V_lds + v_rd_base(lane);
  struct { bf16x8 vs0, vs1, ks0, ks1; } sr_[2];
#define SLOAD(i, k0) do { if (doV) { sr_[i].vs0 = *reinterpret_cast<const bf16x8*>(&Vh[(long)((k0) + sr) * LDV + sc]); sr_[i].vs1 = *reinterpret_cast<const bf16x8*>(&Vh[(long)((k0) + 32 + sr) * LDV + sc]); } \
    if (doK) { sr_[i].ks0 = *reinterpret_cast<const bf16x8*>(&Kh[(long)((k0) + sr) * LDK + sc]); sr_[i].ks1 = *reinterpret_cast<const bf16x8*>(&Kh[(long)((k0) + 32 + sr) * LDK + sc]); } } while (0)
#define SWRITE(b, i) do { if (doV) { *(bf16x8*)(V_lds + (b) * SHM_V + vst0) = sr_[i].vs0; *(bf16x8*)(V_lds + (b) * SHM_V + vst1) = sr_[i].vs1; } \
    if (doK) { const int kc = sc * 2; *(bf16x8*)(K_lds + (b) * SHM_K + KSWZ(sr, kc)) = sr_[i].ks0; *(bf16x8*)(K_lds + (b) * SHM_K + KSWZ(32 + sr, kc)) = sr_[i].ks1; } } while (0)
#define SWAIT() asm volatile("s_waitcnt vmcnt(4)" ::: "memory")
#define RESC(a) do { if (__any((a) < 1.f)) { if (hi == 0) al_l[r32] = (a); asm volatile("s_waitcnt lgkmcnt(0)" ::: "memory"); \
    _Pragma("unroll") for (int d = 0; d < 2; ++d) _Pragma("unroll") for (int r = 0; r < 16; ++r) o[d][r] *= al_l[crow(r, hi)]; } } while (0)
  f32x16 pA0, pA1, pB0, pB1; float mnA, mnB, alA, alB; bf16x8 pa0, pa1, pa2, pa3; const int NT = seq / KVBLK;
  constexpr int SE = 0, SO = 1;
  SLOAD(SE, 0); asm volatile("s_waitcnt vmcnt(0)" ::: "memory"); SWRITE(0, SE); __syncthreads();
  qkt(pA0, pA1, K_lds, qr, r32, hi); partialSM(pA0, pA1, m_reg, mnA, alA);
  SLOAD(SO, KVBLK); if (2 < NT) SLOAD(SE, 2 * KVBLK);
  SWAIT(); SWRITE(1, SO); __syncthreads();
  for (int j = 1; j + 1 < NT; j += 2) {
    SBAR(); qkt(pB0, pB1, K_lds + SHM_K, qr, r32, hi);
    finishSM(pA0, pA1, alA, l_reg, pa0, pa1, pa2, pa3); SBAR();
    SLOAD(SO, (j + 2) * KVBLK); SBAR();
    pv_d0(o, vb0, pa0, pa1, pa2, pa3); partialSM(pB0, pB1, m_reg, mnB, alB);
    __syncthreads(); SWAIT(); SWRITE(0, SE);
    RESC(alB); __syncthreads();
    SBAR(); qkt(pA0, pA1, K_lds, qr, r32, hi);
    finishSM(pB0, pB1, alB, l_reg, pa0, pa1, pa2, pa3); SBAR();
    if (j + 3 < NT) SLOAD(SE, (j + 3) * KVBLK); SBAR();
    pv_d0(o, vb0 + SHM_V, pa0, pa1, pa2, pa3); partialSM(pA0, pA1, m_reg, mnA, alA);
    __syncthreads(); SWAIT(); SWRITE(1, SO);
    RESC(alA); __syncthreads();
  }
  SBAR(); qkt(pB0, pB1, K_lds + SHM_K, qr, r32, hi);
  finishSM(pA0, pA1, alA, l_reg, pa0, pa1, pa2, pa3); SBAR();
  pv_d0(o, vb0, pa0, pa1, pa2, pa3); partialSM(pB0, pB1, m_reg, mnB, alB);
  __syncthreads(); RESC(alB);
  finishSM(pB0, pB1, alB, l_reg, pa0, pa1, pa2, pa3); SBAR();
  pv_d0(o, vb0 + SHM_V, pa0, pa1, pa2, pa3);
  __syncthreads();
  { float* st = (float*)lds + wid * (32 * 68);
#pragma unroll
    for (int r = 0; r < 16; ++r) { const int orow = crow(r, hi); st[orow * 68 + r32] = o[0][r]; st[orow * 68 + 32 + r32] = o[1][r]; }
    asm volatile("s_waitcnt lgkmcnt(0)" ::: "memory");
    float v[32]; float s = 0.f;
#pragma unroll
    for (int j = 0; j < 8; ++j) { const f32x4 t = *(const f32x4*)(st + r32 * 68 + hi * 32 + 4 * j); v[4 * j] = t.x; v[4 * j + 1] = t.y; v[4 * j + 2] = t.z; v[4 * j + 3] = t.w; s += (t.x * t.x + t.y * t.y) + (t.z * t.z + t.w * t.w); }
    { auto rr = __builtin_amdgcn_permlane32_swap(__float_as_uint(s), __float_as_uint(s), false, false); s = __uint_as_float(rr[0]) + __uint_as_float(rr[1]); }
    const float rl = 1.f / l_reg; const float fac = rl * rsqrtf(s * rl * rl * (1.f / 64.f) + 1e-6f);
    bf16* yp = Yb + (long)(wid * QBLK + r32) * LDO + hi * 32; const float* gp = gh + hi * 32;
#pragma unroll
    for (int j = 0; j < 4; ++j) { float w[8];
#pragma unroll
      for (int e = 0; e < 8; ++e) w[e] = v[8 * j + e] * fac * gp[8 * j + e];
      *(v4u*)(yp + 8 * j) = pack8(w); } }
  __syncthreads();
#undef SLOAD
#undef SWRITE
#undef SWAIT
#undef RESC
}
#undef KSWZ
#undef SBAR
}

__device__ __forceinline__ int queue_pull(Frame& F, gu32* heads, int nq, int nper, int myq) {
  volatile LAS int* slot = (volatile LAS int*)(F.lds + LDSCTL_OFF);
  if (F.tid == 0) { int got = -1;
    for (int k = 0; k < nq; ++k) { const int q = (myq + k) % nq;
      if (__hip_atomic_load(heads + 64 * q, RLX_AGENT) >= (unsigned)nper) continue;
      const unsigned i = __hip_atomic_fetch_add(heads + 64 * q, 1u, RLX_AGENT);
      if (i < (unsigned)nper) { got = q * nper + (int)i; break; } }
    *slot = got; }
  __syncthreads();
  const int r = *slot;
  __syncthreads();
  return r;
}
__device__ __forceinline__ void p3_attention(Frame& F, const Args& a, char* lds_generic, unsigned xcc, int qoff) {
  unsigned char* ws = F.ws;
  const bf16* QMp = (const bf16*)(ws + WS_QM); const bf16* KMp = (const bf16*)(ws + WS_KM); const bf16* VMp = (const bf16*)(ws + WS_VM); bf16* Y = (bf16*)(ws + WS_Y);
  for (;;) {
    const int u = queue_pull(F, F.ctl + CW_Q + qoff, 8, 64, (int)(xcc & 7u));
    if (u < 0) break;
    const int bh = u >> 4, qb = u & 15, b = bh >> 3, h = bh & 7;
    mla::attn_unit(QMp + ((size_t)b * SEQ + qb * 256) * 768 + h * 96, KMp + (size_t)b * SEQ * 768 + h * 96, VMp + (size_t)b * SEQ * 512 + h * 64,
                   Y + ((size_t)b * SEQ + qb * 256) * 1024 + 512 + h * 64, (const float*)a.in[I_GHA] + h * 64, SEQ, lds_generic);
  }
}
namespace mls {
using mla::crow; using mla::v_st; using mla::v_rd_base;
#define KSWZ(row, colB) ((row) * 256 + ((colB) ^ (((row) & 7) << 4)))
constexpr int OFF_QS = 0, OFF_KS = 16384, OFF_KP = 32768, OFF_VV = 49152, OFF_CT = 65536, OFF_SC = 98304, OFF_NB = 99328, OFF_NP = 100352, OFF_CH = 104448, OFF_WS = 105472;
template <int OFF> __device__ __forceinline__ s16x4 trr(int vb) { s16x4 r; asm volatile("ds_read_b64_tr_b16 %0, %1 offset:%2" : "=&v"(r) : "v"(vb), "i"(OFF) : "memory"); return r; }
#define PKF(L, H) (bf16x8){L[0], L[1], L[2], L[3], H[0], H[1], H[2], H[3]}
__device__ __forceinline__ void vfrags(int img, int d0, int lane, bf16x8 (&f)[4]) {
  const int vb = img + v_rd_base(lane) + d0 * 512;
  const s16x4 l0 = trr<0>(vb), h0 = trr<2048>(vb), l1 = trr<4096>(vb), h1 = trr<4096 + 2048>(vb), l2 = trr<8192>(vb), h2 = trr<8192 + 2048>(vb), l3 = trr<12288>(vb), h3 = trr<12288 + 2048>(vb);
  asm volatile("s_waitcnt lgkmcnt(0)" ::: "memory"); __builtin_amdgcn_sched_barrier(0);
  f[0] = PKF(l0, h0); f[1] = PKF(l1, h1); f[2] = PKF(l2, h2); f[3] = PKF(l3, h3);
}
__device__ __forceinline__ void pack_p(const f32x16& p0, const f32x16& p1, bf16x8& pa0, bf16x8& pa1, bf16x8& pa2, bf16x8& pa3) {
#define PK4(P, BASE, OUT) do { unsigned a0 = cvt_pk_bf16(P[BASE + 0], P[BASE + 1]), a1 = cvt_pk_bf16(P[BASE + 2], P[BASE + 3]);   \
    unsigned b0 = cvt_pk_bf16(P[BASE + 4], P[BASE + 5]), b1 = cvt_pk_bf16(P[BASE + 6], P[BASE + 7]);                              \
    auto r0 = __builtin_amdgcn_permlane32_swap(a0, b0, false, false); auto r1 = __builtin_amdgcn_permlane32_swap(a1, b1, false, false); \
    v4u w = {r0[0], r1[0], r0[1], r1[1]}; OUT = __builtin_bit_cast(bf16x8, w); } while (0)
  PK4(p0, 0, pa0); PK4(p0, 8, pa1); PK4(p1, 0, pa2); PK4(p1, 8, pa3);
#undef PK4
}
__device__ __forceinline__ float swap_add(float v) { auto rr = __builtin_amdgcn_permlane32_swap(__float_as_uint(v), __float_as_uint(v), false, false); return __uint_as_float(rr[0]) + __uint_as_float(rr[1]); }

__device__ __forceinline__ void mlstm_seq(int seq, unsigned char* ws, char* lds) {
  int tid = threadIdx.x; asm volatile("" : "+v"(tid));
  const int wid = __builtin_amdgcn_readfirstlane(tid >> 6), lane = tid & 63, r32 = lane & 31, hi = lane >> 5, rb = wid >> 2, cb = wid & 3;
  const int dir = seq & 1, h = (seq >> 1) & 3, b = seq >> 3;
  const bf16* QC = (const bf16*)(ws + WS_QC); const bf16* KC = (const bf16*)(ws + WS_KC); const bf16* P = (const bf16*)(ws + WS_PROJ);
  const float* gs = (const float*)(ws + WS_GSC) + (size_t)seq * 3 * SEQ; const float* dec = (const float*)(ws + WS_DEC) + seq * 128;
  bf16* H = (bf16*)(ws + (dir ? WS_HB : WS_HF));
  float* sc_alpha = (float*)(lds + OFF_SC); float* sc_a = sc_alpha + 64; float* sc_iw = sc_alpha + 128; float* sc_en = sc_alpha + 192;
  float* nbuf = (float*)(lds + OFF_NB); float* npart = (float*)(lds + OFF_NP);
  float* ch_mprev = (float*)(lds + OFF_CH); float* ch_mnew = ch_mprev + 64; float* ch_dec = ch_mprev + 128; float* ch_g = ch_mprev + 192;
  float* wsf = (float*)(lds + OFF_WS) + wid * 32;
  const int ldsb = (int)(uintptr_t)lds;
  if (tid < 64) {
    if (tid == 0) { float m = 0.f; for (int c = 0; c < 64; ++c) { const float g = dec[c], wm = dec[64 + c]; const float mn = fmaxf(g + m, g + wm); ch_mprev[c] = m; ch_mnew[c] = mn; ch_dec[c] = __expf(g + m - mn); ch_g[c] = g; m = mn; } } }
  for (int i = tid; i < 32768 / 16; i += NTHR) ((v4u*)(lds + OFF_CT))[i] = (v4u){0u, 0u, 0u, 0u};
  if (tid < 128) nbuf[tid] = 0.f;
  f32x16 cacc[2]; cacc[0] = f32x16{}; cacc[1] = f32x16{};
  __syncthreads();
  const int sr = tid >> 4, sc = (tid & 15) * 8;
  v4u gq0, gq1, gk0, gk1, gv0, gv1; float ga0, ga1, sb = 0.f, sa = 0.f, spm = 0.f;
#define ROWOF(p) ((size_t)b * SEQ + (dir ? (SEQ - 1 - (p)) : (p)))
#define LOADC(c) do { const int p0_ = 64 * (c) + sr, p1_ = p0_ + 32; const size_t r0_ = ROWOF(p0_), r1_ = ROWOF(p1_); \
    gq0 = *(const v4u*)(QC + r0_ * 512 + h * 128 + sc); gq1 = *(const v4u*)(QC + r1_ * 512 + h * 128 + sc); \
    gk0 = *(const v4u*)(KC + r0_ * 512 + h * 128 + sc); gk1 = *(const v4u*)(KC + r1_ * 512 + h * 128 + sc); \
    gv0 = *(const v4u*)(P + r0_ * PROJ_LD + 1024 + h * 128 + sc); gv1 = *(const v4u*)(P + r1_ * PROJ_LD + 1024 + h * 128 + sc); \
    ga0 = gs[SEQ + p0_]; ga1 = gs[SEQ + p1_]; \
    if (tid < 64) { sb = gs[64 * (c) + tid]; sa = gs[SEQ + 64 * (c) + tid]; spm = gs[2 * SEQ + 64 * (c) + tid]; } } while (0)
#define WRITEC(c) do { \
    *(v4u*)(lds + OFF_QS + KSWZ(sr, sc * 2)) = gq0; *(v4u*)(lds + OFF_QS + KSWZ(32 + sr, sc * 2)) = gq1; \
    *(v4u*)(lds + OFF_KS + KSWZ(sr, sc * 2)) = gk0; *(v4u*)(lds + OFF_KS + KSWZ(32 + sr, sc * 2)) = gk1; \
    *(v4u*)(lds + OFF_VV + v_st(sr, sc)) = gv0; *(v4u*)(lds + OFF_VV + v_st(32 + sr, sc)) = gv1; \
    { const float gc_ = ch_g[c], mn_ = ch_mnew[c]; const float w0_ = __expf(gc_ + ga0 - mn_), w1_ = __expf(gc_ + ga1 - mn_); float f0_[8], f1_[8], cs_[8]; unpack8(gk0, f0_); unpack8(gk1, f1_); \
      _Pragma("unroll") for (int j = 0; j < 8; ++j) { f0_[j] *= w0_; f1_[j] *= w1_; cs_[j] = f0_[j] + f1_[j]; } \
      *(v4u*)(lds + OFF_KP + v_st(sr, sc)) = pack8(f0_); *(v4u*)(lds + OFF_KP + v_st(32 + sr, sc)) = pack8(f1_); \
      _Pragma("unroll") for (int j = 0; j < 8; ++j) { cs_[j] += __shfl_xor(cs_[j], 16); cs_[j] += __shfl_xor(cs_[j], 32); } \
      if ((lane >> 4) == 0) { _Pragma("unroll") for (int j = 0; j < 8; ++j) npart[wid * 128 + sc + j] = cs_[j]; } } \
    if (tid < 64) { const float m_ = ch_mprev[c]; const float mt_ = fmaxf(sb + m_, sb + spm); sc_alpha[tid] = sb - mt_; sc_a[tid] = sa; sc_iw[tid] = __expf(sb + m_ - mt_); sc_en[tid] = __expf(-mt_); } } while (0)
  LOADC(0); WRITEC(0);
  __syncthreads();
  for (int c = 0; c < 64; ++c) {
    if (c + 1 < 64) LOADC(c + 1);
    const float* nb = nbuf + (c & 1) * 128;
    if (tid < 128) { float s = 0.f;
#pragma unroll
      for (int w = 0; w < 8; ++w) s += npart[w * 128 + tid];
      nbuf[((c + 1) & 1) * 128 + tid] = ch_dec[c] * nb[tid] + s; }
    bf16x8 qr[8];
#pragma unroll
    for (int d0 = 0; d0 < 8; ++d0) qr[d0] = *(const bf16x8*)(lds + OFF_QS + KSWZ(32 * rb + r32, (16 * d0 + 8 * hi) * 2));
    f32x16 p0 = f32x16{}, p1 = f32x16{};
#pragma unroll
    for (int d0 = 0; d0 < 8; ++d0) { const bf16x8 k0 = *(const bf16x8*)(lds + OFF_KS + KSWZ(r32, (16 * d0 + 8 * hi) * 2)); p0 = __builtin_amdgcn_mfma_f32_32x32x16_bf16(k0, qr[d0], p0, 0, 0, 0); }
    if (rb == 1) {
#pragma unroll
      for (int d0 = 0; d0 < 8; ++d0) { const bf16x8 k1 = *(const bf16x8*)(lds + OFF_KS + KSWZ(32 + r32, (16 * d0 + 8 * hi) * 2)); p1 = __builtin_amdgcn_mfma_f32_32x32x16_bf16(k1, qr[d0], p1, 0, 0, 0); }
    }
    const float al = sc_alpha[32 * rb + r32];
    if (rb == 0) {
#pragma unroll
      for (int r = 0; r < 16; ++r) { const int sl = crow(r, hi); p0[r] = (sl <= r32) ? __expf(al + sc_a[sl]) * p0[r] : 0.f; }
    } else {
#pragma unroll
      for (int r = 0; r < 16; ++r) { const int sl = crow(r, hi); p0[r] = __expf(al + sc_a[sl]) * p0[r]; p1[r] = (sl <= r32) ? __expf(al + sc_a[32 + sl]) * p1[r] : 0.f; }
    }
    float ps = 0.f;
#pragma unroll
    for (int r = 0; r < 16; ++r) ps += p0[r] + p1[r];
    ps = swap_add(ps);
    bf16x8 pa0, pa1, pa2, pa3; pack_p(p0, p1, pa0, pa1, pa2, pa3);
    float qn = 0.f;
#pragma unroll
    for (int d0 = 0; d0 < 8; ++d0) { const f32x4 n0 = *(const f32x4*)(nb + 16 * d0 + 8 * hi), n1 = *(const f32x4*)(nb + 16 * d0 + 8 * hi + 4); const v4u qw = __builtin_bit_cast(v4u, qr[d0]);
      qn += bflo(qw.x) * n0.x + bfhi(qw.x) * n0.y + bflo(qw.y) * n0.z + bfhi(qw.y) * n0.w + bflo(qw.z) * n1.x + bfhi(qw.z) * n1.y + bflo(qw.w) * n1.z + bfhi(qw.w) * n1.w; }
    qn = swap_add(qn);
    { const float iwt = sc_iw[32 * rb + r32]; const float den = iwt * qn + ps; const float rd = 1.f / fmaxf(fabsf(den), sc_en[32 * rb + r32]); if (hi == 0) wsf[r32] = rd; }
    f32x16 o = f32x16{};
#pragma unroll
    for (int d0 = 0; d0 < 8; ++d0) { const bf16x8 cf = *(const bf16x8*)(lds + OFF_CT + KSWZ(32 * cb + r32, (16 * d0 + 8 * hi) * 2)); o = __builtin_amdgcn_mfma_f32_32x32x16_bf16(qr[d0], cf, o, 0, 0, 0); }
#pragma unroll
    for (int r = 0; r < 16; ++r) o[r] *= sc_iw[32 * rb + crow(r, hi)];
    bf16x8 vf[4]; vfrags(ldsb + OFF_VV, cb, lane, vf);
    o = __builtin_amdgcn_mfma_f32_32x32x16_bf16(pa0, vf[0], o, 0, 0, 0); o = __builtin_amdgcn_mfma_f32_32x32x16_bf16(pa1, vf[1], o, 0, 0, 0);
    if (rb == 1) { o = __builtin_amdgcn_mfma_f32_32x32x16_bf16(pa2, vf[2], o, 0, 0, 0); o = __builtin_amdgcn_mfma_f32_32x32x16_bf16(pa3, vf[3], o, 0, 0, 0); }
    asm volatile("s_waitcnt lgkmcnt(0)" ::: "memory");
#pragma unroll
    for (int r = 0; r < 16; ++r) { const int tl = crow(r, hi); const int p = 64 * c + 32 * rb + tl; H[ROWOF(p) * 512 + h * 128 + 32 * cb + r32] = (bf16)f2bf(o[r] * wsf[tl]); }
    { const float dc = ch_dec[c];
#pragma unroll
      for (int i = 0; i < 2; ++i) { bf16x8 kf[4]; vfrags(ldsb + OFF_KP, 2 * rb + i, lane, kf);
#pragma unroll
        for (int r = 0; r < 16; ++r) cacc[i][r] *= dc;
#pragma unroll
        for (int ks = 0; ks < 4; ++ks) cacc[i] = __builtin_amdgcn_mfma_f32_32x32x16_bf16(kf[ks], vf[ks], cacc[i], 0, 0, 0); } }
    __syncthreads();
#pragma unroll
    for (int i = 0; i < 2; ++i)
#pragma unroll
      for (int g = 0; g < 4; ++g) { const int d = 32 * (2 * rb + i) + 8 * g + 4 * hi, e = 32 * cb + r32;
        v2u w; w.x = cvt_pk_bf16(cacc[i][4 * g], cacc[i][4 * g + 1]); w.y = cvt_pk_bf16(cacc[i][4 * g + 2], cacc[i][4 * g + 3]);
        *(v2u*)(lds + OFF_CT + KSWZ(e, d * 2)) = w; }
    if (c + 1 < 64) WRITEC(c + 1);
    __syncthreads();
  }
#undef ROWOF
#undef LOADC
#undef WRITEC
}
#undef KSWZ
#undef PKF
}

__device__ __forceinline__ void p3_mixers(Frame& F, const Args& a, char* lds_generic, unsigned xcc, int qoff) {
#ifndef DRY_MODE
#define DRY_MODE 0
#endif
  if (!(qoff && DRY_MODE == 2))
  for (;;) { const int it = queue_pull(F, F.ctl + CW_Q + qoff + 64 * 8, 8, 4, (int)(xcc & 7u)); if (it < 0) break; mls::mlstm_seq(it, F.ws, lds_generic); __syncthreads(); }
  if (!(qoff && DRY_MODE == 1))
  p3_attention(F, a, lds_generic, xcc, qoff);
}
__device__ __forceinline__ void p4_combine(Frame& F, const Args& a) {
  unsigned char* ws = F.ws; const bf16* HF = (const bf16*)(ws + WS_HF); const bf16* HB = (const bf16*)(ws + WS_HB); const bf16* P = (const bf16*)(ws + WS_PROJ); bf16* Y = (bf16*)(ws + WS_Y);
  const float* g = (const float*)a.in[I_GHM];
  const int gw = F.vcu * NWAVES + F.wave, NGW = F.G * NWAVES, c = F.lane * 8;
  float gg[8];
#pragma unroll
  for (int j = 0; j < 8; ++j) gg[j] = g[c + j];
  for (int m = gw; m < MTOK; m += NGW) {
    float f[8], bb[8], oo[8]; unpack8(*(const v4u*)(HF + (size_t)m * 512 + c), f); unpack8(*(const v4u*)(HB + (size_t)m * 512 + c), bb); unpack8(*(const v4u*)(P + (size_t)m * PROJ_LD + 1536 + c), oo);
    float s = 0.f;
#pragma unroll
    for (int j = 0; j < 8; ++j) { f[j] += bb[j]; s += f[j] * f[j]; }
    s += __shfl_xor(s, 1); s += __shfl_xor(s, 2); s += __shfl_xor(s, 4); s += __shfl_xor(s, 8);
    const float r = rsqrtf(s * (1.f / 128.f) + 1e-6f);
#pragma unroll
    for (int j = 0; j < 8; ++j) f[j] = f[j] * r * gg[j] * sigmoidf_(oo[j]);
    *(v4u*)(Y + (size_t)m * 1024 + c) = pack8(f);
  }
}
struct EpiResid { static constexpr bool TWO_PASS = false; const float* base; float* out; bf16* outb; float* ss;
  __device__ __forceinline__ void row8(const pg8::Unit& u, int rloc, int cloc, const float (&a0)[8], const float (&a1)[8], int fq) const {
    const int row = u.pm * 256 + rloc; const size_t off = (size_t)row * 1024 + u.pn * 256 + cloc;
    const f32x4 b0 = *(const f32x4*)(base + off), b1 = *(const f32x4*)(base + off + 4), b2 = *(const f32x4*)(base + off + 128), b3 = *(const f32x4*)(base + off + 132);
    float v0[8], v1[8];
#pragma unroll
    for (int i = 0; i < 4; ++i) { v0[i] = a0[i] + b0[i]; v0[4 + i] = a0[4 + i] + b1[i]; v1[i] = a1[i] + b2[i]; v1[4 + i] = a1[4 + i] + b3[i]; }
    *(f32x4*)(out + off) = (f32x4){v0[0], v0[1], v0[2], v0[3]}; *(f32x4*)(out + off + 4) = (f32x4){v0[4], v0[5], v0[6], v0[7]};
    *(f32x4*)(out + off + 128) = (f32x4){v1[0], v1[1], v1[2], v1[3]}; *(f32x4*)(out + off + 132) = (f32x4){v1[4], v1[5], v1[6], v1[7]};
    *(v4u*)(outb + off) = pack8(v0); *(v4u*)(outb + off + 128) = pack8(v1);
    float s = sumsq8(v0) + sumsq8(v1); s += __shfl_xor(s, 16); s += __shfl_xor(s, 32); if (fq == 0) unsafeAtomicAdd(ss + row, s); } };
struct EpiScale { static constexpr bool TWO_PASS = false; bf16* O; const float* ss;
  __device__ __forceinline__ void row8(const pg8::Unit& u, int rloc, int cloc, const float (&a0)[8], const float (&a1)[8], int fq) const {
    const int row = u.pm * 256 + rloc; const float r = rsqrtf(ss[row] * (1.f / 1024.f) + 1e-6f); float v0[8], v1[8];
#pragma unroll
    for (int i = 0; i < 8; ++i) { v0[i] = a0[i] * r; v1[i] = a1[i] * r; }
    bf16* p = O + (size_t)row * 1024 + u.pn * 256 + cloc; *(v4u*)p = pack8(v0); *(v4u*)(p + 128) = pack8(v1); } };
struct EpiSoftmax { static constexpr bool TWO_PASS = true; bf16* O; float scale; LAS float* xch;
  __device__ __forceinline__ void pass1(const pg8::Unit& u, int rloc, int wc, float (&v0)[8], float (&v1)[8], int fq) const {
    float mx = -3.0e38f;
#pragma unroll
    for (int i = 0; i < 8; ++i) { v0[i] *= scale; v1[i] *= scale; mx = fmaxf(mx, fmaxf(v0[i], v1[i])); }
    mx = fmaxf(mx, __shfl_xor(mx, 16)); mx = fmaxf(mx, __shfl_xor(mx, 32));
    float l = 0.f;
#pragma unroll
    for (int i = 0; i < 8; ++i) { v0[i] = __expf(v0[i] - mx); v1[i] = __expf(v1[i] - mx); l += v0[i] + v1[i]; }
    l += __shfl_xor(l, 16); l += __shfl_xor(l, 32);
    if (fq == 0) { xch[(rloc * 4 + wc) * 2] = mx; xch[(rloc * 4 + wc) * 2 + 1] = l; } }
  __device__ __forceinline__ void row8(const pg8::Unit& u, int rloc, int cloc, const float (&a0)[8], const float (&a1)[8], int fq) const {
    const int wc = cloc >> 5; float m[4], l[4]; float M = -3.0e38f;
#pragma unroll
    for (int w = 0; w < 4; ++w) { m[w] = xch[(rloc * 4 + w) * 2]; l[w] = xch[(rloc * 4 + w) * 2 + 1]; M = fmaxf(M, m[w]); }
    float L = 0.f, mine = 0.f;
#pragma unroll
    for (int w = 0; w < 4; ++w) { const float e = __expf(m[w] - M); L += l[w] * e; if (w == wc) mine = e; }
    const float f = mine / L; float v0[8], v1[8];
#pragma unroll
    for (int i = 0; i < 8; ++i) { v0[i] = a0[i] * f; v1[i] = a1[i] * f; }
    bf16* p = O + (size_t)(u.pm * 256 + rloc) * 1024 + u.pn * 256 + cloc; *(v4u*)p = pack8(v0); *(v4u*)(p + 128) = pack8(v1); } };
struct MemOrder { int G, c, kind;
  __device__ bool next(int i, pg8::Unit& u) const { const int L = i * G + c; if (L >= 256) return false;
    const int bh = L >> 4, t = L & 15, b = bh >> 2, h = bh & 3;
    u.pm = b * 16 + t; u.pn = h; u.g = 0; u.ibase = 0; u.aoff = ((long)(b * SEQ + t * 256)) * 1024 + h * 256;
    u.boff = kind == 0 ? ((long)(b * NMEM)) * 1024 + h * 256 : ((long)(h * 256)) * 1024 + b * NMEM; return true; } };
constexpr size_t WS_ROWSEL = WS_SEL, WS_GSEL = WS_SEL + 131072, WS_INV = 31 * MiB, WS_YE = 160 * MiB;
__device__ __forceinline__ void p10_router(Frame& F, const Args& a) {
  unsigned char* ws = F.ws; const float* X2 = (const float*)(ws + WS_X2); const float* ss2 = (const float*)(ws + CTL_SS2); float* AFF = (float*)(ws + WS_AFF);
  const float* wr = (const float*)a.in[I_WR]; const float* gf = (const float*)a.in[I_GFFN];
  const int gw = F.vcu * NWAVES + F.wave, NGW = F.G * NWAVES;
  for (int m = gw; m < MTOK; m += NGW) {
    float acc[16];
#pragma unroll
    for (int e = 0; e < 16; ++e) acc[e] = 0.f;
#pragma unroll
    for (int j = 0; j < 4; ++j) { const int k0 = 256 * j + 4 * F.lane; const f32x4 xv = *(const f32x4*)(X2 + (size_t)m * 1024 + k0); const f32x4 gv = *(const f32x4*)(gf + k0);
#pragma unroll
      for (int i = 0; i < 4; ++i) { const float xg = xv[i] * gv[i]; const f32x4* w4 = (const f32x4*)(wr + (size_t)(k0 + i) * 16);
#pragma unroll
        for (int q = 0; q < 4; ++q) { const f32x4 w = w4[q]; acc[4 * q] += xg * w.x; acc[4 * q + 1] += xg * w.y; acc[4 * q + 2] += xg * w.z; acc[4 * q + 3] += xg * w.w; } } }
#pragma unroll
    for (int e = 0; e < 16; ++e) acc[e] = wave_sum(acc[e]);
    const float r = rsqrtf(ss2[m] * (1.f / 1024.f) + 1e-6f); float mx = -3.0e38f;
#pragma unroll
    for (int e = 0; e < 16; ++e) { acc[e] *= r; mx = fmaxf(mx, acc[e]); }
    float l = 0.f;
#pragma unroll
    for (int e = 0; e < 16; ++e) { acc[e] = __expf(acc[e] - mx); l += acc[e]; }
    const float rl = 1.f / l;
    if (F.lane < 16) { float v = 0.f;
#pragma unroll
      for (int e = 0; e < 16; ++e) if (e == F.lane) v = acc[e];
      AFF[(size_t)m * 16 + F.lane] = v * rl; }
  }
}
__device__ __forceinline__ void p11_topk(Frame& F, char* lds) {
  unsigned char* ws = F.ws; const float* AFF = (const float*)(ws + WS_AFF); int* ROWSEL = (int*)(ws + WS_ROWSEL); float* GSEL = (float*)(ws + WS_GSEL); int* INV = (int*)(ws + WS_INV);
  unsigned* hist = (unsigned*)lds; unsigned* ctl = hist + 256; unsigned* wsum = hist + 320;
  const int tid = F.tid, lane = F.lane, wid = F.wave;
  for (int it = (int)blockIdx.x; it < BATCH * NEXP; it += F.G) { const int b = it >> 4, e = it & 15;
    unsigned key[8];
#pragma unroll
    for (int j = 0; j < 8; ++j) key[j] = __float_as_uint(AFF[((size_t)b * SEQ + 8 * tid + j) * 16 + e]);
    unsigned prefix = 0u, mask = 0u, need = CAP;
    for (int shift = 24; shift >= 0; shift -= 8) {
      if (tid < 256) hist[tid] = 0u;
      __syncthreads();
#pragma unroll
      for (int j = 0; j < 8; ++j) if ((key[j] & mask) == prefix) atomicAdd(&hist[(key[j] >> shift) & 255u], 1u);
      __syncthreads();
      if (tid == 0) { unsigned above = 0u; int d = 255; for (; d > 0; --d) { const unsigned c = hist[d]; if (above + c >= need) break; above += c; } ctl[0] = (unsigned)d; ctl[1] = need - above; }
      __syncthreads();
      prefix |= ctl[0] << shift; mask |= 255u << shift; need = ctl[1];
      __syncthreads();
    }
    unsigned ngt = 0u, neq = 0u;
#pragma unroll
    for (int j = 0; j < 8; ++j) { ngt += key[j] > prefix ? 1u : 0u; neq += key[j] == prefix ? 1u : 0u; }
    unsigned sgt = ngt, seq_ = neq;
#pragma unroll
    for (int o = 1; o < 64; o <<= 1) { const unsigned y0 = __shfl_up(sgt, o), y1 = __shfl_up(seq_, o); if (lane >= o) { sgt += y0; seq_ += y1; } }
    if (lane == 63) { wsum[wid] = sgt; wsum[8 + wid] = seq_; }
    __syncthreads();
    unsigned bgt = 0u, beq = 0u, tgt = 0u;
#pragma unroll
    for (int w = 0; w < 8; ++w) { const unsigned g = wsum[w], q = wsum[8 + w]; if (w < wid) { bgt += g; beq += q; } tgt += g; }
    unsigned pgt = bgt + sgt - ngt, peq = beq + seq_ - neq;
#pragma unroll
    for (int j = 0; j < 8; ++j) { const int t = 8 * tid + j; int slot = -1;
      if (key[j] > prefix) slot = (int)pgt++; else if (key[j] == prefix) { if (peq < need) slot = (int)(tgt + peq); ++peq; }
      INV[((size_t)b * SEQ + t) * 16 + e] = slot;
      if (slot >= 0) { ROWSEL[e * 2048 + b * 512 + slot] = b * SEQ + t; GSEL[e * 2048 + b * 512 + slot] = __uint_as_float(key[j]); } }
    __syncthreads();
  }
}
struct MoeGUOrder { int G, c;
  __device__ bool next(int i, pg8::Unit& u) const { const int L = i * G + c; if (L >= 2048) return false;
    const int e = L >> 7, r = L & 127, pn = r >> 3, mt = r & 7;
    u.g = e; u.pm = mt; u.pn = pn; u.ibase = e * 2048 + mt * 256; u.aoff = 0; u.boff = ((long)e * 4096 + pn * 256) * 1024; return true; } };
struct MoeDownOrder { int G, c;
  __device__ bool next(int i, pg8::Unit& u) const { const int L = i * G + c; if (L >= 512) return false;
    const int e = L >> 5, r = L & 31, pn = r >> 3, mt = r & 7;
    u.g = e; u.pm = mt; u.pn = pn; u.ibase = e * 2048 + mt * 256; u.aoff = ((long)e * 2048 + mt * 256) * 2048; u.boff = ((long)e * 1024 + pn * 256) * 2048; return true; } };
struct EpiGU { static constexpr bool TWO_PASS = false; bf16* H; const float* ss2; const int* rowsel;
  __device__ __forceinline__ void row8(const pg8::Unit& u, int rloc, int cloc, const float (&a0)[8], const float (&a1)[8], int fq) const {
    const int tok = rowsel[u.ibase + rloc]; const float r = rsqrtf(ss2[tok] * (1.f / 1024.f) + 1e-6f); float h[8];
#pragma unroll
    for (int i = 0; i < 8; ++i) { const float g = a0[i] * r, up = a1[i] * r; h[i] = g * sigmoidf_(g) * up; }
    *(v4u*)(H + ((size_t)u.g * 2048 + u.pm * 256 + rloc) * 2048 + u.pn * 128 + cloc) = pack8(h); } };
struct EpiYE { static constexpr bool TWO_PASS = false; bf16* Yp; const float* gsel;
  __device__ __forceinline__ void row8(const pg8::Unit& u, int rloc, int cloc, const float (&a0)[8], const float (&a1)[8], int fq) const {
    const float gv = gsel[u.ibase + rloc]; float v0[8], v1[8];
#pragma unroll
    for (int i = 0; i < 8; ++i) { v0[i] = a0[i] * gv; v1[i] = a1[i] * gv; }
    bf16* p = Yp + ((size_t)u.g * 2048 + u.pm * 256 + rloc) * 1024 + u.pn * 256 + cloc; *(v4u*)p = pack8(v0); *(v4u*)(p + 128) = pack8(v1); } };
__device__ __forceinline__ void p14_final(Frame& F, const Args& a) {
  unsigned char* ws = F.ws; const float* X2 = (const float*)(ws + WS_X2); const int* INV = (const int*)(ws + WS_INV); const bf16* YE = (const bf16*)(ws + WS_YE);
  const float* gfin = (const float*)a.in[I_GFIN]; float* out = a.out;
  const int gw = F.vcu * NWAVES + F.wave, NGW = F.G * NWAVES;
  for (int m = gw; m < MTOK; m += NGW) { const int b = m >> 12;
    f32x4 v[4];
#pragma unroll
    for (int j = 0; j < 4; ++j) v[j] = *(const f32x4*)(X2 + (size_t)m * 1024 + 256 * j + 4 * F.lane);
    const int myinv = F.lane < 16 ? INV[(size_t)m * 16 + F.lane] : -1;
#pragma unroll
    for (int e = 0; e < 16; ++e) { const int slot = __shfl(myinv, e);
      if (slot >= 0) { const bf16* yr = YE + ((size_t)e * 2048 + b * 512 + slot) * 1024 + 4 * F.lane;
#pragma unroll
        for (int j = 0; j < 4; ++j) { const v2u w = *(const v2u*)(yr + 256 * j); v[j].x += bflo(w.x); v[j].y += bfhi(w.x); v[j].z += bflo(w.y); v[j].w += bfhi(w.y); } } }
    float s = 0.f;
#pragma unroll
    for (int j = 0; j < 4; ++j) s += (v[j].x * v[j].x + v[j].y * v[j].y) + (v[j].z * v[j].z + v[j].w * v[j].w);
    const float r = rsqrtf(wave_sum(s) * (1.f / 1024.f) + 1e-6f);
#pragma unroll
    for (int j = 0; j < 4; ++j) { const f32x4 g = *(const f32x4*)(gfin + 256 * j + 4 * F.lane); *(f32x4*)(out + (size_t)m * 1024 + 256 * j + 4 * F.lane) = v[j] * r * g; }
  }
}
__global__ void __launch_bounds__(NTHR, 2) mk(Args a) {
  extern __shared__ __attribute__((aligned(16))) unsigned char lds_raw[];
  Frame F;
  F.lds = (LAS unsigned char*)lds_raw; F.MISC = (volatile LAS unsigned*)(F.lds + LDSCTL_OFF + 320);
  F.tid = threadIdx.x; F.lane = F.tid & 63; F.wave = __builtin_amdgcn_readfirstlane(F.tid >> 6);
  F.G = gridDim.x; { const int bx = blockIdx.x; F.vcu = (F.G % 8 == 0) ? (bx % 8) * (F.G / 8) + bx / 8 : bx; }
  F.ws = a.ws; F.ctl = (gu32*)(a.ws + WS_CTL);
  unsigned char* ws = a.ws;
  for (int u = F.tid; u < (LDS_BYTES - LDSCTL_OFF) / 4; u += NTHR) ((LAS unsigned*)(F.lds + LDSCTL_OFF))[u] = 0u;
  __syncthreads();
  XcdBarrier bar = xcd_barrier_post((unsigned*)(F.ctl + CW_BAR), F.MISC + 8);
  const int lo = a.ph_lo, hi = a.ph_hi;
#define IN(k) (lo <= (k) && (k) < hi)
#define BOTH(k) (IN(k) && IN((k) + 1))
#define GRID_BAR() xcd_barrier(bar)
  float* ssq = (float*)(ws + CTL_SSQ); float* sskv = (float*)(ws + CTL_SSKV);

#ifndef REP_MASK
#define REP_MASK 0
#endif
#define NREP(k) ((((REP_MASK) >> (k)) & 1) ? 2 : 1)
#define PH_BEGIN(k) if (IN(k)) { for (int rep_ = 0; rep_ < NREP(k); ++rep_) { const bool dry = rep_ + 1 < NREP(k); (void)dry;
#define PH_END(k) if (dry) GRID_BAR(); } if (BOTH(k)) GRID_BAR(); }
  float* dummy = (float*)(ws + WS_DUMMY);
  float* ss1 = (float*)(ws + CTL_SS1); float* ss2 = (float*)(ws + CTL_SS2);
  PH_BEGIN(0) p0_prologue(F, a, true, (a.flags & 1) != 0); PH_END(0)
  PH_BEGIN(1)
    { pg8::Gemm g{(const bf16*)(ws + WS_XN), (const bf16*)(ws + WS_WIN), 1024, 1024, 1024, nullptr}; pg8::StaticOrder S; S.init(MTOK, PROJ_LD, F.G, (int)blockIdx.x, 1024, 1024);
      EpiProj E{(bf16*)(ws + WS_PROJ), dry ? dummy : ssq, dry ? dummy + 16384 : sskv};
      pg8::gemm_phase<EpiProj, pg8::StaticOrder, false>(F.lds, g, S, E); }
    { pg8::Gemm g{(const bf16*)(ws + WS_MEMN), (const bf16*)(ws + WS_WMK), 1024, 1024, 1024, nullptr}; pg8::StaticOrder S; S.init(1024, 1024, F.G, (int)((blockIdx.x + 128u) % (unsigned)F.G), 1024, 1024);
      EpiStore E{(bf16*)(ws + WS_KMEM), 1024};
      pg8::gemm_phase<EpiStore, pg8::StaticOrder, false>(F.lds, g, S, E); }
    { pg8::Gemm g{(const bf16*)(ws + WS_WMV), (const bf16*)(ws + WS_MEMN), 1024, 1024, 1024, nullptr}; pg8::StaticOrder S; S.init(1024, 1024, F.G, (int)((blockIdx.x + 112u) % (unsigned)F.G), 1024, 1024);
      EpiStore E{(bf16*)(ws + WS_VMEMT), 1024};
      pg8::gemm_phase<EpiStore, pg8::StaticOrder, false>(F.lds, g, S, E); }
  PH_END(1)
  PH_BEGIN(2)
    { pg8::Gemm g{(const bf16*)(ws + WS_PROJ) + PC_CQ, (const bf16*)(ws + WS_WQB), PROJ_LD, 256, 256, nullptr}; pg8::StaticOrder S; S.init(MTOK, 768, F.G, (int)blockIdx.x, PROJ_LD, 256);
      EpiQ E{(bf16*)(ws + WS_QM), ssq, (const float*)(ws + WS_ROPE)};
      pg8::gemm_phase<EpiQ, pg8::StaticOrder, false>(F.lds, g, S, E); }
    { pg8::Gemm g{(const bf16*)(ws + WS_PROJ) + PC_CKV, (const bf16*)(ws + WS_WKVB), PROJ_LD, 256, 256, nullptr}; pg8::StaticOrder S; S.init(MTOK, 1024, F.G, (int)((blockIdx.x + 64u) % (unsigned)F.G), PROJ_LD, 256);
      EpiKV E{(bf16*)(ws + WS_KM), (bf16*)(ws + WS_VM), sskv};
      pg8::gemm_phase<EpiKV, pg8::StaticOrder, false>(F.lds, g, S, E); }
    p2_elementwise(F, a);
  PH_END(2)
  PH_BEGIN(3) p3_mixers(F, a, (char*)lds_raw, bar.x, dry ? 64 * 16 : 0); PH_END(3)
  PH_BEGIN(4) p4_combine(F, a); PH_END(4)
  PH_BEGIN(5)
    pg8::Gemm g{(const bf16*)(ws + WS_Y), (const bf16*)(ws + WS_WOUT), 1024, 1024, 1024, nullptr}; pg8::StaticOrder S; S.init(MTOK, 1024, F.G, (int)blockIdx.x, 1024, 1024);
    EpiResid E{(const float*)a.in[I_X], (float*)(ws + WS_X1), (bf16*)(ws + WS_X1B), dry ? dummy : ss1};
    pg8::gemm_phase<EpiResid, pg8::StaticOrder, false>(F.lds, g, S, E);
  PH_END(5)
  PH_BEGIN(6)
    pg8::Gemm g{(const bf16*)(ws + WS_X1B), (const bf16*)(ws + WS_WMQ), 1024, 1024, 1024, nullptr}; pg8::StaticOrder S; S.init(MTOK, 1024, F.G, (int)blockIdx.x, 1024, 1024);
    EpiScale E{(bf16*)(ws + WS_QMEM), ss1};
    pg8::gemm_phase<EpiScale, pg8::StaticOrder, false>(F.lds, g, S, E);
  PH_END(6)
  PH_BEGIN(7)
    pg8::Gemm g{(const bf16*)(ws + WS_QMEM), (const bf16*)(ws + WS_KMEM), 1024, 1024, 256, nullptr}; MemOrder S{F.G, (int)blockIdx.x, 0};
    EpiSoftmax E{(bf16*)(ws + WS_P), 0.0625f, (LAS float*)(F.lds + LDSCTL_OFF + 1024)};
    pg8::gemm_phase<EpiSoftmax, MemOrder, false>(F.lds, g, S, E);
  PH_END(7)
  PH_BEGIN(8)
    pg8::Gemm g{(const bf16*)(ws + WS_P), (const bf16*)(ws + WS_VMEMT), 1024, 1024, 256, nullptr}; MemOrder S{F.G, (int)blockIdx.x, 1};
    EpiStore E{(bf16*)(ws + WS_MO), 1024};
    pg8::gemm_phase<EpiStore, MemOrder, false>(F.lds, g, S, E);
  PH_END(8)
  PH_BEGIN(9)
    pg8::Gemm g{(const bf16*)(ws + WS_MO), (const bf16*)(ws + WS_WMO), 1024, 1024, 1024, nullptr}; pg8::StaticOrder S; S.init(MTOK, 1024, F.G, (int)blockIdx.x, 1024, 1024);
    EpiResid E{(const float*)(ws + WS_X1), (float*)(ws + WS_X2), (bf16*)(ws + WS_X2B), dry ? dummy : ss2};
    pg8::gemm_phase<EpiResid, pg8::StaticOrder, false>(F.lds, g, S, E);
  PH_END(9)
  PH_BEGIN(10) p10_router(F, a); PH_END(10)
  PH_BEGIN(11) p11_topk(F, (char*)lds_raw); PH_END(11)
  PH_BEGIN(12)
    pg8::Gemm g{(const bf16*)(ws + WS_X2B), (const bf16*)(ws + WS_WEGU), 1024, 1024, 1024, (const int*)(ws + WS_ROWSEL)}; MoeGUOrder S{F.G, (int)blockIdx.x};
    EpiGU E{(bf16*)(ws + WS_HID), ss2, (const int*)(ws + WS_ROWSEL)};
    pg8::gemm_phase<EpiGU, MoeGUOrder, true>(F.lds, g, S, E);
  PH_END(12)
  PH_BEGIN(13)
    pg8::Gemm g{(const bf16*)(ws + WS_HID), (const bf16*)(ws + WS_WED), 2048, 2048, 2048, nullptr}; MoeDownOrder S{F.G, (int)blockIdx.x};
    EpiYE E{(bf16*)(ws + WS_YE), (const float*)(ws + WS_GSEL)};
    pg8::gemm_phase<EpiYE, MoeDownOrder, false>(F.lds, g, S, E);
  PH_END(13)
  PH_BEGIN(14) p14_final(F, a); PH_END(14)
#undef IN
#undef BOTH
#undef GRID_BAR
}

__global__ __launch_bounds__(256) void adapt_b2f(const bf16* src, long lds_, long scol, float* dst, long ldd, long dcol, long rows, long ncols) {
  const long i = blockIdx.x * 256L + threadIdx.x; if (i >= rows * ncols) return;
  const long r = i / ncols, c = i % ncols; dst[r * ldd + dcol + c] = bf2f(src[r * lds_ + scol + c]);
}
static void adapt(hipStream_t s, const void* src, long lds_, long scol, float* dst, long ldd, long dcol, long rows, long ncols) {
  hipLaunchKernelGGL(adapt_b2f, dim3((unsigned)((rows * ncols + 255) / 256)), dim3(256), 0, s, (const bf16*)src, lds_, scol, dst, ldd, dcol, rows, ncols);
}

static int mk_grid() {
  static int grid = 0;
  if (grid == 0) {
    int dev = 0, cus = 0, per_cu = 0;
    (void)hipGetDevice(&dev); (void)hipDeviceGetAttribute(&cus, hipDeviceAttributeMultiprocessorCount, dev);
    (void)hipFuncSetAttribute((const void*)mk, hipFuncAttributeMaxDynamicSharedMemorySize, LDS_BYTES);
    (void)hipOccupancyMaxActiveBlocksPerMultiprocessor(&per_cu, (const void*)mk, NTHR, LDS_BYTES);
    (void)hipGetLastError();
    grid = cus > 0 ? cus : 256;
  }
  return grid;
}
static void mk_launch(hipStream_t s, void* const* d_in, void* d_out, void* d_ws, int lo, int hi, int flags) {
  Args a; memset(&a, 0, sizeof(a));
  for (int i = 0; i < 26; ++i) a.in[i] = d_in[i];
  a.out = (float*)d_out; a.ws = (unsigned char*)d_ws; a.ph_lo = lo; a.ph_hi = hi; a.flags = flags; a.pad = 0;
  (void)hipMemsetAsync((char*)d_ws + WS_CTL + CW_BAR * 4, 0, XCD_BAR_WORDS * 4, s);
  hipLaunchKernelGGL(mk, dim3(mk_grid()), dim3(NTHR), LDS_BYTES, s, a);
}

extern "C" void kernel_launch(void* const* d_in, const int* in_sizes, int n_in, void* d_out, int out_size, void* d_ws, size_t ws_size, hipStream_t s) {
  (void)hipMemsetAsync((char*)d_ws + WS_CTL, 0, CTL_ZERO_BYTES, s);
  mk_launch(s, d_in, d_out, d_ws, 0, 15, 1);
}
```

```cpp
#include <hip/hip_runtime.h>
#include <cstdint>
#include <cstdio>
#include <cstring>

constexpr int BATCH = 4, SEQ = 4096, DM = 1024, MTOK = BATCH * SEQ;
constexpr int D_IN = 2480;
constexpr int OFF_QM = 0, OFF_KM = 512, OFF_VM = 1024, OFF_OM = 1536, OFF_G = 2048, OFF_CQ = 2064, OFF_CKV = 2320, OFF_KR = 2448;
constexpr int NEXP = 16, CAP = 512, DFF = 2048, NMEM = 256;
constexpr size_t MiB = 1u << 20;
enum { I_X = 0, I_MEM, I_POS, I_GMIX, I_WIN, I_BG, I_CONV, I_GQA, I_WQB, I_GKVA, I_WKVB, I_GHM, I_GHA, I_WOUT, I_GMX, I_GMKV, I_WMQ, I_WMK, I_WMV, I_WMO, I_GFFN, I_WR, I_WEG, I_WEU, I_WED, I_GFIN };
#define GAS __attribute__((address_space(1)))
#define LAS __attribute__((address_space(3)))
typedef unsigned short bf16;
typedef unsigned v4u __attribute__((ext_vector_type(4)));
typedef unsigned v2u __attribute__((ext_vector_type(2)));
typedef float f32x4 __attribute__((ext_vector_type(4)));
typedef float f32x16 __attribute__((ext_vector_type(16)));
typedef short bf16x8 __attribute__((ext_vector_type(8)));
typedef short s16x4 __attribute__((ext_vector_type(4)));
typedef GAS unsigned gu32;
#define RLX_AGENT __ATOMIC_RELAXED, __HIP_MEMORY_SCOPE_AGENT
#define LDS_WAIT() asm volatile("s_waitcnt lgkmcnt(0)" ::: "memory")
#define VM_WAIT() asm volatile("s_waitcnt vmcnt(0)" ::: "memory")
constexpr int NWAVES = 8, NTHR = 512;
__device__ __forceinline__ unsigned f2bf(float f) { unsigned u = __builtin_bit_cast(unsigned, f); return (u + 0x7fffu + ((u >> 16) & 1u)) >> 16; }
__device__ __forceinline__ unsigned pk2(float lo, float hi) { return f2bf(lo) | (f2bf(hi) << 16); }
__device__ __forceinline__ float bf2f(unsigned short h) { return __builtin_bit_cast(float, (unsigned)h << 16); }
__device__ __forceinline__ float bflo(unsigned w) { return __builtin_bit_cast(float, w << 16); }
__device__ __forceinline__ float bfhi(unsigned w) { return __builtin_bit_cast(float, w & 0xffff0000u); }
typedef float f32x2_t __attribute__((ext_vector_type(2))); typedef __bf16 bf16x2_t __attribute__((ext_vector_type(2)));
__device__ __forceinline__ unsigned cvt_pk_bf16(float lo, float hi) { f32x2_t v = {lo, hi}; bf16x2_t b = __builtin_convertvector(v, bf16x2_t); return __builtin_bit_cast(unsigned, b); }
__device__ __forceinline__ float wave_sum(float v) {
#pragma unroll
  for (int o = 1; o < 64; o <<= 1) v += __shfl_xor(v, o);
  return v;
}
__device__ __forceinline__ float sigmoidf_(float x) { return 1.f / (1.f + __expf(-x)); }

#define XB_TMO      128
#define XB_XCNT(j)  (256  + 64 * (j))
#define XB_XSUB(j)  (1280 + 64 * (j))
#define XB_XGEN(j)  (2304 + 64 * (j))
#define XB_TOP      3328
#define XB_TOPGEN   3392
#define XCD_BAR_WORDS 3456
#define XB_SPIN_CAP (1u << 22)
__device__ __forceinline__ unsigned xb_ld(unsigned* p)              { return __hip_atomic_load(p, __ATOMIC_RELAXED, __HIP_MEMORY_SCOPE_AGENT); }
__device__ __forceinline__ unsigned xb_add(unsigned* p, unsigned v) { return __hip_atomic_fetch_add(p, v, __ATOMIC_RELAXED, __HIP_MEMORY_SCOPE_AGENT); }
__device__ __forceinline__ unsigned xb_xcc_id() { return (unsigned)__builtin_amdgcn_s_getreg((3 << 11) | 20) & 0xFu; }
#define XB_SPIN(cond, bar) do { unsigned _sp = 0; while (cond) { __builtin_amdgcn_s_sleep(1); \
    if ((++_sp & 255u) == 0u) { if (xb_ld(&(bar)[XB_TMO])) break; if (_sp > XB_SPIN_CAP) { atomicAdd(&(bar)[XB_TMO], 1u); break; } } } } while (0)
struct XcdBarrier { unsigned* bar; unsigned x; volatile LAS unsigned* st; };
__device__ __forceinline__ XcdBarrier xcd_barrier_post(unsigned* bar, volatile LAS unsigned* st) {
  XcdBarrier b; b.bar = bar; b.x = xb_xcc_id(); b.st = st;
  if (threadIdx.x == 0) (void)xb_add(&bar[XB_XCNT(b.x)], 1u);
  return b;
}
__device__ __forceinline__ void xcd_barrier_complete(unsigned* bar, unsigned x, unsigned& nloc, unsigned& nx) {
  const unsigned G = gridDim.x * gridDim.y * gridDim.z;
  unsigned sum, cnt, mine, sp = 0u;
  for (;;) {
    sum = 0u; cnt = 0u; mine = 0u;
#pragma unroll
    for (unsigned j = 0; j < 16; ++j) { const unsigned c = xb_ld(&bar[XB_XCNT(j)]); sum += c; cnt += (c > 0u) ? 1u : 0u; mine = (j == x) ? c : mine; }
    if (sum == G) break;
    __builtin_amdgcn_s_sleep(1);
    if ((++sp & 255u) == 0u) { if (xb_ld(&bar[XB_TMO])) break; if (sp > XB_SPIN_CAP) { atomicAdd(&bar[XB_TMO], 1u); break; } }
  }
  nloc = mine > 0u ? mine : 1u; nx = cnt > 0u ? cnt : 1u;
}
__device__ __forceinline__ void xcd_barrier(const XcdBarrier& b) {
  asm volatile("s_waitcnt vmcnt(0)" ::: "memory");
  __syncthreads();
  if (threadIdx.x == 0) {
    unsigned* bar = b.bar;
    __builtin_amdgcn_s_waitcnt(0);
    unsigned nloc = b.st[0], nx = b.st[1];
    if (nloc == 0u) { xcd_barrier_complete(bar, b.x, nloc, nx); b.st[0] = nloc; b.st[1] = nx; }
    const unsigned old = xb_add(&bar[XB_XSUB(b.x)], 1u);
    const unsigned gen = old / nloc;
    if (old + 1u == (gen + 1u) * nloc) {
      __builtin_amdgcn_fence(__ATOMIC_RELEASE, "agent");
      asm volatile("s_waitcnt vmcnt(0)" ::: "memory");
      const unsigned og = xb_add(&bar[XB_TOP], 1u);
      const unsigned tg = og / nx;
      if (og + 1u == (tg + 1u) * nx) xb_add(&bar[XB_TOPGEN], 1u);
      else XB_SPIN(xb_ld(&bar[XB_TOPGEN]) == tg, bar);
      __builtin_amdgcn_fence(__ATOMIC_ACQUIRE, "agent");
      xb_add(&bar[XB_XGEN(b.x)], 1u);
      asm volatile("s_waitcnt vmcnt(0)" ::: "memory");
    } else {
      XB_SPIN(xb_ld(&bar[XB_XGEN(b.x)]) == gen, bar);
      __builtin_amdgcn_fence(__ATOMIC_ACQUIRE, "agent");
      asm volatile("s_waitcnt vmcnt(0)" ::: "memory");
    }
  }
  __syncthreads();
}

namespace pg8 {
constexpr int BM = 256, BK = 64, HALF = 128, HTB = HALF * BK * 2, STAGE_BYTES = 8 * HTB, NXCD = 8, WGM = 8;
__host__ __device__ __forceinline__ int lds_byte(int r, int c) { const int st = (r >> 4) * 2 + (c >> 5), rr = r & 15, cc = c & 31, ob = rr * 64 + cc * 2; return st * 1024 + (ob ^ (((ob >> 9) & 1) << 5)); }
__host__ __device__ __forceinline__ void stage_rc(int b, int& R, int& C) { const int st = b / 1024, sb = b % 1024, swz = sb ^ (((sb >> 9) & 1) << 5); R = (st >> 1) * 16 + swz / 64; C = (st & 1) * 32 + (swz % 64) / 2; }
__host__ __device__ __forceinline__ int perm32(int rho) { const int n = rho >> 4, i = rho & 15; return 8 * (i >> 2) + 4 * n + (i & 3); }

struct Unit { long aoff, boff; int pm, pn, g, ibase; };
struct Gemm { const bf16* A; const bf16* Bt; int lda, ldb, K; const int* gidx; };

struct StaticOrder {
  int nM, nN, nwg, G, c, lda, ldb;
  __device__ void init(int M, int N, int G_, int c_, int lda_, int ldb_) { nM = M / BM; nN = N / BM; nwg = nM * nN; G = G_; c = c_; lda = lda_; ldb = ldb_; }
  __device__ bool next(int i, Unit& u) const {
    const long L = (long)i * G + c; if (L >= nwg) return false;
    int wgid = (int)L; { const int q = nwg / NXCD, r = nwg % NXCD, xcd = wgid % NXCD, off = wgid / NXCD; wgid = (xcd < r ? xcd * (q + 1) : r * (q + 1) + (xcd - r) * q) + off; }
    const int nig = WGM * nN, gid = wgid / nig, fm = gid * WGM, gsz = (nM - fm) < WGM ? (nM - fm) : WGM;
    u.pm = fm + ((wgid % nig) % gsz); u.pn = (wgid % nig) / gsz; u.g = 0; u.ibase = 0;
    u.aoff = (long)u.pm * BM * lda; u.boff = (long)u.pn * BM * ldb; return true;
  }
};

template <class Epi, class Sched, bool GATHER>
__device__ __forceinline__ void gemm_phase(LAS unsigned char* lds, const Gemm g, const Sched& S, const Epi& E) {
  int tid = threadIdx.x; asm volatile("" : "+v"(tid));
  const int wid = __builtin_amdgcn_readfirstlane(tid >> 6), lane = tid & 63, wr = wid >> 2, wc = wid & 3, fr = lane & 15, fq = lane >> 4;
  const int K = g.K, nt = K / BK;
  int Rs[2], Cs[2]; unsigned voffB[2];
#pragma unroll
  for (int i = 0; i < 2; ++i) { int R, C; stage_rc(tid * 16 + i * 8192, R, C); Rs[i] = R; Cs[i] = C; const int Rb = (R & ~31) + perm32(R & 31); voffB[i] = (unsigned)(Rb * g.ldb + C) * 2u; }
  const size_t kstep = (size_t)(BK * 2);
  const size_t hstepB = (size_t)HALF * g.ldb * 2;
  const unsigned ldsw = (unsigned)wid * 1024u;
  const int aoff_l = lds_byte(wr * 64 + fr, fq * 8), boff_l = lds_byte(wc * 32 + fr, fq * 8);
#define PG8_SA(b, h) (((b) * 2 + (h)) * HTB)
#define PG8_SB(b, h) ((4 + (b) * 2 + (h)) * HTB)
#define PG8_STAGE(bufoff, gbase, voff) do { _Pragma("unroll") for (int _i = 0; _i < 2; ++_i) \
        __builtin_amdgcn_global_load_lds((const unsigned*)((const char*)(gbase) + (voff)[_i]), (LAS unsigned*)(lds + (bufoff) + ldsw + _i * 8192), 16, 0, 0); } while (0)
#define PG8_LDA(dst, b, h) do { _Pragma("unroll") for (int m = 0; m < 4; ++m) _Pragma("unroll") for (int k = 0; k < 2; ++k) dst[m][k] = *(const LAS bf16x8*)(lds + PG8_SA(b, h) + aoff_l + m * 2048 + k * 1024); } while (0)
#define PG8_LDB(dst, b, h) do { _Pragma("unroll") for (int n = 0; n < 2; ++n) _Pragma("unroll") for (int k = 0; k < 2; ++k) dst[n][k] = *(const LAS bf16x8*)(lds + PG8_SB(b, h) + boff_l + n * 2048 + k * 1024); } while (0)
#define PG8_MMA(ai, bj, At, Bt) do { __builtin_amdgcn_s_setprio(1); _Pragma("unroll") for (int m = 0; m < 4; ++m) _Pragma("unroll") for (int n = 0; n < 2; ++n) _Pragma("unroll") for (int k = 0; k < 2; ++k) \
        acc[ai][bj][m][n] = __builtin_amdgcn_mfma_f32_16x16x32_bf16(Bt[n][k], At[m][k], acc[ai][bj][m][n], 0, 0, 0); __builtin_amdgcn_s_setprio(0); } while (0)
#define PG8_WAIT_V(n) asm volatile("s_waitcnt vmcnt(" #n ")" ::: "memory")
#define PG8_WAIT_L(n) asm volatile("s_waitcnt lgkmcnt(" #n ")" ::: "memory")
#define PG8_BAR __builtin_amdgcn_s_barrier()
#define PG8_SCHED __builtin_amdgcn_sched_barrier(0)
  Unit cur, nxt; int ui = 0;
  if (!S.next(0, cur)) return;
  unsigned vA[2][2], nvA[2][2];
  auto load_va = [&](const Unit& u, unsigned (&v)[2][2]) {
#pragma unroll
    for (int h = 0; h < 2; ++h)
#pragma unroll
      for (int i = 0; i < 2; ++i) {
        if constexpr (GATHER) v[h][i] = (unsigned)((long)g.gidx[u.ibase + h * HALF + Rs[i]] * g.lda + Cs[i]) * 2u;
        else v[h][i] = (unsigned)((h * HALF + Rs[i]) * g.lda + Cs[i]) * 2u;
      }
  };
  load_va(cur, vA);
  f32x4 acc[2][2][4][2];
#pragma unroll
  for (int a = 0; a < 2; ++a)
#pragma unroll
    for (int b = 0; b < 2; ++b)
#pragma unroll
      for (int m = 0; m < 4; ++m)
#pragma unroll
        for (int n = 0; n < 2; ++n) acc[a][b][m][n] = (f32x4){0.f, 0.f, 0.f, 0.f};
  bf16x8 At[4][2], B0[2][2], B1[2][2];
  const char* cA = (const char*)g.A + (GATHER ? 0 : cur.aoff * 2); const char* cB = (const char*)g.Bt + cur.boff * 2;
  PG8_STAGE(PG8_SB(0, 0), cB, voffB); PG8_STAGE(PG8_SB(0, 1), cB + hstepB, voffB); PG8_STAGE(PG8_SA(0, 0), cA, vA[0]); PG8_STAGE(PG8_SA(0, 1), cA, vA[1]);
  if (wr == 1) PG8_BAR;
  PG8_WAIT_V(2); PG8_BAR;
  PG8_STAGE(PG8_SB(1, 0), cB + kstep, voffB); PG8_STAGE(PG8_SA(1, 0), cA + kstep, vA[0]); PG8_STAGE(PG8_SB(1, 1), cB + hstepB + kstep, voffB);
  PG8_WAIT_V(6); PG8_BAR;
  for (;;) {
    const bool has_next = S.next(ui + 1, nxt);
    const char* nA = has_next ? (const char*)g.A + (GATHER ? 0 : nxt.aoff * 2) : cA; const char* nB = has_next ? (const char*)g.Bt + nxt.boff * 2 : cB;
    if constexpr (GATHER) { if (has_next) load_va(nxt, nvA); else {
#pragma unroll
      for (int h = 0; h < 2; ++h)
#pragma unroll
        for (int i = 0; i < 2; ++i) nvA[h][i] = vA[h][i]; } }
#pragma unroll 1
    for (int t = 0; t < nt; t += 2) {
      const bool last = (t == nt - 2);
      const char* a1 = cA + (size_t)(t + 1) * kstep;
      const char* a2 = last ? nA : cA + (size_t)(t + 2) * kstep; const char* b2 = last ? nB : cB + (size_t)(t + 2) * kstep;
      const char* a3 = a2 + kstep; const char* b3 = b2 + kstep;
      unsigned w0[2], w1[2];
      if constexpr (GATHER) { w0[0] = last ? nvA[0][0] : vA[0][0]; w0[1] = last ? nvA[0][1] : vA[0][1]; w1[0] = last ? nvA[1][0] : vA[1][0]; w1[1] = last ? nvA[1][1] : vA[1][1]; }
      else { w0[0] = vA[0][0]; w0[1] = vA[0][1]; w1[0] = vA[1][0]; w1[1] = vA[1][1]; }
      PG8_LDB(B0, 0, 0); PG8_LDB(B1, 0, 1); PG8_SCHED; PG8_LDA(At, 0, 0); PG8_STAGE(PG8_SA(1, 1), a1, vA[1]);
      PG8_WAIT_V(8); PG8_WAIT_L(0); PG8_BAR; PG8_MMA(0, 0, At, B0); PG8_MMA(0, 1, At, B1); PG8_BAR; PG8_SCHED;
      PG8_LDA(At, 0, 1); PG8_STAGE(PG8_SB(0, 0), b2, voffB); PG8_STAGE(PG8_SB(0, 1), b2 + hstepB, voffB); PG8_STAGE(PG8_SA(0, 0), a2, w0);
      PG8_WAIT_V(8); PG8_WAIT_L(0); PG8_BAR; PG8_MMA(1, 0, At, B0); PG8_MMA(1, 1, At, B1); PG8_BAR; PG8_SCHED;
      PG8_LDB(B0, 1, 0); PG8_LDB(B1, 1, 1); PG8_SCHED; PG8_LDA(At, 1, 0); PG8_STAGE(PG8_SA(0, 1), a2, w1);
      PG8_WAIT_V(8); PG8_WAIT_L(0); PG8_BAR; PG8_MMA(0, 0, At, B0); PG8_MMA(0, 1, At, B1); PG8_BAR; PG8_SCHED;
      PG8_LDA(At, 1, 1); PG8_STAGE(PG8_SB(1, 0), b3, voffB); PG8_STAGE(PG8_SB(1, 1), b3 + hstepB, voffB); PG8_STAGE(PG8_SA(1, 0), a3, w0);
      PG8_WAIT_V(8); PG8_WAIT_L(0); PG8_BAR; PG8_MMA(1, 0, At, B0); PG8_MMA(1, 1, At, B1); PG8_BAR; PG8_SCHED;
    }
    if (wr == 0) PG8_BAR;
    if constexpr (Epi::TWO_PASS) {
#pragma unroll
      for (int ai = 0; ai < 2; ++ai)
#pragma unroll
        for (int m = 0; m < 4; ++m) {
          float v0[8], v1[8];
#pragma unroll
          for (int n = 0; n < 2; ++n)
#pragma unroll
            for (int j = 0; j < 4; ++j) { v0[n * 4 + j] = acc[ai][0][m][n][j]; v1[n * 4 + j] = acc[ai][1][m][n][j]; }
          E.pass1(cur, ai * HALF + wr * 64 + m * 16 + fr, wc, v0, v1, fq);
#pragma unroll
          for (int n = 0; n < 2; ++n)
#pragma unroll
            for (int j = 0; j < 4; ++j) { acc[ai][0][m][n][j] = v0[n * 4 + j]; acc[ai][1][m][n][j] = v1[n * 4 + j]; }
        }
      asm volatile("s_waitcnt lgkmcnt(0)" ::: "memory"); PG8_BAR; asm volatile("" ::: "memory");
    }
    {
#pragma unroll
      for (int ai = 0; ai < 2; ++ai)
#pragma unroll
        for (int m = 0; m < 4; ++m) {
          float v0[8], v1[8];
#pragma unroll
          for (int n = 0; n < 2; ++n)
#pragma unroll
            for (int j = 0; j < 4; ++j) { v0[n * 4 + j] = acc[ai][0][m][n][j]; v1[n * 4 + j] = acc[ai][1][m][n][j]; }
          E.row8(cur, ai * HALF + wr * 64 + m * 16 + fr, wc * 32 + 8 * fq, v0, v1, fq);
          asm volatile("" ::: "memory");
        }
    }
    if (!has_next) break;
#pragma unroll
    for (int a = 0; a < 2; ++a)
#pragma unroll
      for (int b = 0; b < 2; ++b)
#pragma unroll
        for (int m = 0; m < 4; ++m)
#pragma unroll
          for (int n = 0; n < 2; ++n) acc[a][b][m][n] = (f32x4){0.f, 0.f, 0.f, 0.f};
    cur = nxt; cA = nA; cB = nB; ++ui;
    if constexpr (GATHER) {
#pragma unroll
      for (int h = 0; h < 2; ++h)
#pragma unroll
        for (int i = 0; i < 2; ++i) vA[h][i] = nvA[h][i]; }
    if (wr == 1) PG8_BAR;
  }
  PG8_WAIT_V(0);
  PG8_BAR;
#undef PG8_SA
#undef PG8_SB
#undef PG8_STAGE
#undef PG8_LDA
#undef PG8_LDB
#undef PG8_MMA
#undef PG8_WAIT_V
#undef PG8_WAIT_L
#undef PG8_BAR
#undef PG8_SCHED
}
}
constexpr size_t WS_CTL = 0, CTL_ZERO_BYTES = 1 * MiB;
constexpr int CW_TMO = 0, CW_BAR = 4096, CW_Q = 8192;
constexpr size_t CTL_SSQ = 256 * 1024, CTL_SSKV = CTL_SSQ + 65536, CTL_SS1 = CTL_SSKV + 65536, CTL_SS2 = CTL_SS1 + 65536;
constexpr size_t WS_WIN = 1 * MiB, WS_WQB = 6 * MiB, WS_WKVB = 6 * MiB + 512 * 1024, WS_WOUT = 7 * MiB, WS_WMQ = 9 * MiB, WS_WMK = 11 * MiB, WS_WMV = 13 * MiB, WS_WMO = 15 * MiB;
constexpr size_t WS_ROPE = 17 * MiB, WS_MEMN = 19 * MiB, WS_KMEM = 21 * MiB, WS_VMEMT = 23 * MiB, WS_GSC = 25 * MiB, WS_DEC = 28 * MiB, WS_AFF = 29 * MiB, WS_SEL = 30 * MiB;
constexpr size_t WS_PROJ = 32 * MiB, WS_XN = 112 * MiB, WS_QC = 112 * MiB, WS_KC = 128 * MiB, WS_QM = 144 * MiB, WS_KM = 168 * MiB, WS_VM = 192 * MiB, WS_HF = 208 * MiB, WS_HB = 224 * MiB, WS_Y = 240 * MiB;
constexpr size_t WS_X1 = 112 * MiB, WS_X1B = 176 * MiB, WS_QMEM = 208 * MiB, WS_P = 240 * MiB, WS_MO = 176 * MiB, WS_X2 = 240 * MiB, WS_X2B = 208 * MiB, WS_HID = 32 * MiB;
constexpr size_t WS_DUMMY = 304 * MiB;
constexpr size_t WS_WEGU = 320 * MiB, WS_WED = 448 * MiB, WS_END = 512 * MiB;
constexpr int PROJ_LD = 2560;
constexpr int PC_CQ = 2048, PC_CKV = 2304, PC_KR = 2432, PC_G = 2464;
constexpr int RING_BYTES = 131072, LDSCTL_OFF = 133120, LDS_BYTES = 147456;

struct Args { const void* in[26]; float* out; unsigned char* ws; int ph_lo, ph_hi, flags, pad; };

struct Frame {
  LAS unsigned char* lds; volatile LAS unsigned* MISC; gu32* ctl; unsigned char* ws;
  int tid, lane, wave, vcu, G;
};

__device__ __forceinline__ void p0_tr(const float* W, int ldw, int k0, int kvalid, int scol0, int ncols, const float* gs, bf16* WT, int ldt, int drow0, LAS float* scr, int lane) {
  const int c4 = (lane & 15) * 4, kr = lane >> 4;
  f32x4 v[16];
#pragma unroll
  for (int i = 0; i < 16; ++i) { const int kk = 4 * i + kr; v[i] = (f32x4){0.f, 0.f, 0.f, 0.f};
    if (c4 < ncols && k0 + kk < kvalid) { v[i] = *(const f32x4*)(W + (size_t)(k0 + kk) * ldw + scol0 + c4); if (gs) v[i] = v[i] * gs[k0 + kk]; } }
#pragma unroll
  for (int i = 0; i < 16; ++i) { const int kk = 4 * i + kr; LAS float* d = scr + kk * 65 + c4; d[0] = v[i].x; d[1] = v[i].y; d[2] = v[i].z; d[3] = v[i].w; }
  LDS_WAIT(); asm volatile("" ::: "memory");
  const int c = lane & 7;
#pragma unroll
  for (int j = 0; j < 8; ++j) { const int n = (lane >> 3) + 8 * j; const LAS float* s = scr + (8 * c) * 65 + n;
    v4u o; o.x = pk2(s[0 * 65], s[1 * 65]); o.y = pk2(s[2 * 65], s[3 * 65]); o.z = pk2(s[4 * 65], s[5 * 65]); o.w = pk2(s[6 * 65], s[7 * 65]);
    *(GAS v4u*)(WT + (size_t)(drow0 + n) * ldt + k0 + 8 * c) = o; }
  LDS_WAIT(); asm volatile("" ::: "memory");
}
__device__ __forceinline__ void p0_tr32(const float* W, int ldw, int k0, int scol0, int ncols, const float* gs, bf16* WT, int ldt, int drow0, LAS float* scr, int lane) {
#pragma unroll 8
  for (int i = 0; i < 32; ++i) { const int kk = 2 * i + (lane >> 5), c = lane & 31; float v = 0.f;
    if (c < ncols) { v = W[(size_t)(k0 + kk) * ldw + scol0 + c]; if (gs) v *= gs[k0 + kk]; }
    scr[kk * 65 + c] = v; }
  LDS_WAIT(); asm volatile("" ::: "memory");
  const int c = lane & 7;
#pragma unroll
  for (int j = 0; j < 4; ++j) { const int n = (lane >> 3) + 8 * j; const LAS float* s = scr + (8 * c) * 65 + n;
    v4u o; o.x = pk2(s[0 * 65], s[1 * 65]); o.y = pk2(s[2 * 65], s[3 * 65]); o.z = pk2(s[4 * 65], s[5 * 65]); o.w = pk2(s[6 * 65], s[7 * 65]);
    *(GAS v4u*)(WT + (size_t)(drow0 + n) * ldt + k0 + 8 * c) = o; }
  LDS_WAIT(); asm volatile("" ::: "memory");
}
__device__ __forceinline__ void rms_row_to_bf16(const float* xrow, bf16* orow, int lane) {
  const GAS f32x4* xr = (const GAS f32x4*)xrow + lane;
  f32x4 v[4]; float s = 0.f;
#pragma unroll
  for (int j = 0; j < 4; ++j) { v[j] = xr[64 * j]; s += (v[j].x * v[j].x + v[j].y * v[j].y) + (v[j].z * v[j].z + v[j].w * v[j].w); }
  const float rstd = rsqrtf(wave_sum(s) * (1.f / 1024.f) + 1e-6f);
  GAS unsigned long long* o8 = (GAS unsigned long long*)orow + lane;
#pragma unroll
  for (int j = 0; j < 4; ++j) o8[64 * j] = (unsigned long long)pk2(v[j].x * rstd, v[j].y * rstd) | ((unsigned long long)pk2(v[j].z * rstd, v[j].w * rstd) << 32);
}

constexpr int CW_CONV = 8192 + 64 * 40, CW_MDONE = 8192 + 64 * 41, CW_TDONE = 8192 + 64 * 42;
constexpr int CONV_IGU = 16 * 64, CONV_ID = 32 * 16, CONV_ITEMS = NEXP * (CONV_IGU + CONV_ID), CONV_CHUNKS = CONV_ITEMS / 8;
__device__ __forceinline__ void conv_item(Frame& F, const Args& a, int it) {
  LAS float* scr = (LAS float*)(F.lds + F.wave * 16640);
  auto I = [&](int i) { return (const float*)a.in[i]; };
  unsigned char* ws = F.ws;
  const int e = it / (CONV_IGU + CONV_ID); int r = it % (CONV_IGU + CONV_ID);
  if (r < CONV_IGU) { const int kb = r / 64, nb = r % 64, p = nb >> 2, j0 = (nb & 3) * 64; const bool up = j0 >= 128;
    p0_tr((up ? I(I_WEU) : I(I_WEG)) + (size_t)e * 1024 * 2048, 2048, 64 * kb, 1024, 128 * p + (up ? j0 - 128 : j0), 64, I(I_GFFN), (bf16*)(ws + WS_WEGU) + (size_t)e * 4096 * 1024, 1024, 64 * nb, scr, F.lane); }
  else { r -= CONV_IGU; const int kb = r / 16, nb = r % 16;
    p0_tr(I(I_WED) + (size_t)e * 2048 * 1024, 1024, 64 * kb, 2048, 64 * nb, 64, nullptr, (bf16*)(ws + WS_WED) + (size_t)e * 1024 * 2048, 2048, 64 * nb, scr, F.lane); }
}
__device__ __forceinline__ void conv_fill(Frame& F, const Args& a, int maxchunks) {
  volatile LAS int* slot = (volatile LAS int*)(F.lds + LDSCTL_OFF + 16);
  for (int n = 0; n < maxchunks; ++n) {
    if (F.tid == 0) { int got = -1;
      if (__hip_atomic_load(F.ctl + CW_CONV, RLX_AGENT) < (unsigned)CONV_CHUNKS) { const unsigned c = __hip_atomic_fetch_add(F.ctl + CW_CONV, 1u, RLX_AGENT); if (c < (unsigned)CONV_CHUNKS) got = (int)c; }
      *slot = got; }
    __syncthreads();
    const int c = __builtin_amdgcn_readfirstlane(*slot);
    __syncthreads();
    if (c < 0) break;
    conv_item(F, a, c * 8 + F.wave);
  }
}
__device__ __forceinline__ void p0_prologue(Frame& F, const Args& a, bool do_dense, bool do_experts) {
  LAS float* scr = (LAS float*)(F.lds + F.wave * 16640);
  const int gw = F.vcu * NWAVES + F.wave, NGW = F.G * NWAVES;
  auto I = [&](int i) { return (const float*)a.in[i]; };
  unsigned char* ws = F.ws;
  if (do_dense) {
    constexpr int I_WIN_ = 16 * 40, I_WQB_ = 4 * 12, I_WKVB_ = 4 * 16, I_SQ = 16 * 16;
    constexpr int NIT = I_WIN_ + I_WQB_ + I_WKVB_ + 5 * I_SQ;
    for (int it = gw; it < NIT; it += NGW) {
      int r = it;
      if (r < I_WIN_) { const int kb = r / 40, nb = r % 40; int sc, nc = 64;
        if (nb < 32) sc = 64 * nb; else if (nb < 36) sc = OFF_CQ + 64 * (nb - 32); else if (nb < 38) sc = OFF_CKV + 64 * (nb - 36); else if (nb == 38) { sc = OFF_KR; nc = 32; } else { sc = 0; nc = 0; }
        p0_tr(I(I_WIN), D_IN, 64 * kb, 1024, sc, nc, I(I_GMIX), (bf16*)(ws + WS_WIN), 1024, 64 * nb, scr, F.lane);
        if (nb == 38) p0_tr32(I(I_WIN), D_IN, 64 * kb, OFF_G, 16, I(I_GMIX), (bf16*)(ws + WS_WIN), 1024, PC_G, scr, F.lane);
        continue; } r -= I_WIN_;
      if (r < I_WQB_) { const int kb = r / 12, nb = r % 12; p0_tr(I(I_WQB), 768, 64 * kb, 256, 64 * nb, 64, I(I_GQA), (bf16*)(ws + WS_WQB), 256, 64 * nb, scr, F.lane); continue; } r -= I_WQB_;
      if (r < I_WKVB_) { const int kb = r / 16, nb = r % 16; const int h = nb & 7; const int sc = h * 128 + (nb >= 8 ? 64 : 0);
        p0_tr(I(I_WKVB), 1024, 64 * kb, 128, sc, 64, I(I_GKVA), (bf16*)(ws + WS_WKVB), 256, 64 * nb, scr, F.lane); continue; } r -= I_WKVB_;
      const int which = r / I_SQ; r %= I_SQ; const int kb = r / 16, nb = r % 16;
      const float* src = which == 0 ? I(I_WOUT) : which == 1 ? I(I_WMQ) : which == 2 ? I(I_WMK) : which == 3 ? I(I_WMV) : I(I_WMO);
      const float* gs = which == 1 ? I(I_GMX) : (which == 2 || which == 3) ? I(I_GMKV) : nullptr;
      bf16* dst = (bf16*)(ws + (which == 0 ? WS_WOUT : which == 1 ? WS_WMQ : which == 2 ? WS_WMK : which == 3 ? WS_WMV : WS_WMO));
      p0_tr(src, 1024, 64 * kb, 1024, 64 * nb, 64, gs, dst, 1024, 64 * nb, scr, F.lane);
    }
    for (int m = gw; m < MTOK; m += NGW) rms_row_to_bf16(I(I_X) + (size_t)m * 1024, (bf16*)(ws + WS_XN) + (size_t)m * 1024, F.lane);
    for (int m = gw; m < BATCH * NMEM; m += NGW) rms_row_to_bf16(I(I_MEM) + (size_t)m * 1024, (bf16*)(ws + WS_MEMN) + (size_t)m * 1024, F.lane);
    { const float* wr = I(I_WR); const float* gf = I(I_GFFN); float* wrg = (float*)(ws + WS_DEC + 65536);
      for (int i = (F.vcu * NTHR + F.tid); i < 1024 * 16; i += F.G * NTHR) wrg[i] = wr[i] * gf[i >> 4]; }
    { const int* pos = (const int*)a.in[I_POS]; float* rt = (float*)(ws + WS_ROPE);
      for (int i = (F.vcu * NTHR + F.tid); i < MTOK * 16; i += F.G * NTHR) { const int m = i >> 4, j = i & 15; const float inv = powf(10000.f, -(float)j / 16.f); const float ang = (float)pos[m] * inv;
        rt[m * 32 + j] = cosf(ang); rt[m * 32 + 16 + j] = sinf(ang); } }
  }
  if (do_experts) conv_fill(F, a, 1 << 30);
}

__device__ __forceinline__ v4u pack8(const float (&v)[8]) { v4u w; w.x = cvt_pk_bf16(v[0], v[1]); w.y = cvt_pk_bf16(v[2], v[3]); w.z = cvt_pk_bf16(v[4], v[5]); w.w = cvt_pk_bf16(v[6], v[7]); return w; }
__device__ __forceinline__ float sumsq8(const float (&v)[8]) { float s = 0.f;
#pragma unroll
  for (int i = 0; i < 8; ++i) s += v[i] * v[i];
  return s; }
struct EpiStore { static constexpr bool TWO_PASS = false; bf16* O; int ldc;
  __device__ __forceinline__ void row8(const pg8::Unit& u, int rloc, int cloc, const float (&v0)[8], const float (&v1)[8], int fq) const {
    bf16* p = O + (size_t)(u.pm * 256 + rloc) * ldc + u.pn * 256 + cloc; *(v4u*)p = pack8(v0); *(v4u*)(p + 128) = pack8(v1); } };
struct EpiProj { static constexpr bool TWO_PASS = false; bf16* P; float* ssq; float* sskv;
  __device__ __forceinline__ void row8(const pg8::Unit& u, int rloc, int cloc, const float (&v0)[8], const float (&v1)[8], int fq) const {
    const int row = u.pm * 256 + rloc; bf16* p = P + (size_t)row * PROJ_LD + u.pn * 256 + cloc; *(v4u*)p = pack8(v0); *(v4u*)(p + 128) = pack8(v1);
    if (u.pn == 8) { float s = sumsq8(v0) + sumsq8(v1); s += __shfl_xor(s, 16); s += __shfl_xor(s, 32); if (fq == 0) unsafeAtomicAdd(ssq + row, s); }
    if (u.pn == 9) { float s = sumsq8(v0); s += __shfl_xor(s, 16); s += __shfl_xor(s, 32); if (fq == 0) unsafeAtomicAdd(sskv + row, s); } } };
struct EpiQ { static constexpr bool TWO_PASS = false; bf16* Q; const float* ssq; const float* rope;
  __device__ __forceinline__ void rope8(float (&v)[8], int row, int fq) const {
    float pv[8];
#pragma unroll
    for (int i = 0; i < 8; ++i) pv[i] = __shfl_xor(v[i], 32);
    const float* cs = rope + (size_t)row * 32 + 8 * (fq & 1);
#pragma unroll
    for (int i = 0; i < 8; ++i) { const float c = cs[i], s = cs[16 + i]; v[i] = (fq < 2) ? (v[i] * c - pv[i] * s) : (v[i] * c + pv[i] * s); }
  }
  __device__ __forceinline__ void row8(const pg8::Unit& u, int rloc, int cloc, const float (&a0)[8], const float (&a1)[8], int fq) const {
    const int row = u.pm * 256 + rloc; const float r = rsqrtf(ssq[row] * (1.f / 256.f) + 1e-6f);
    float v0[8], v1[8];
#pragma unroll
    for (int i = 0; i < 8; ++i) { v0[i] = a0[i] * r; v1[i] = a1[i] * r; }
    const int g0 = u.pn * 8 + (cloc >> 5), g1 = g0 + 4;
    if (g0 % 3 == 2) rope8(v0, row, fq);
    if (g1 % 3 == 2) rope8(v1, row, fq);
    bf16* p = Q + (size_t)row * 768 + u.pn * 256 + cloc; *(v4u*)p = pack8(v0); *(v4u*)(p + 128) = pack8(v1); } };
struct EpiKV { static constexpr bool TWO_PASS = false; bf16* KMp; bf16* VMp; const float* sskv;
  __device__ __forceinline__ void put(int row, int c, const float (&v)[8], float r) const {
    float w[8];
#pragma unroll
    for (int i = 0; i < 8; ++i) w[i] = v[i] * r;
    if (c < 512) *(v4u*)(KMp + (size_t)row * 768 + (c >> 6) * 96 + (c & 63)) = pack8(w); else *(v4u*)(VMp + (size_t)row * 512 + (c - 512)) = pack8(w); }
  __device__ __forceinline__ void row8(const pg8::Unit& u, int rloc, int cloc, const float (&a0)[8], const float (&a1)[8], int fq) const {
    const int row = u.pm * 256 + rloc; const float r = rsqrtf(sskv[row] * (1.f / 128.f) + 1e-6f);
    put(row, u.pn * 256 + cloc, a0, r); put(row, u.pn * 256 + 128 + cloc, a1, r); } };

__device__ __forceinline__ void unpack8(v4u w, float (&f)[8]) { f[0] = bflo(w.x); f[1] = bfhi(w.x); f[2] = bflo(w.y); f[3] = bfhi(w.y); f[4] = bflo(w.z); f[5] = bfhi(w.z); f[6] = bflo(w.w); f[7] = bfhi(w.w); }
__device__ __forceinline__ float log_sigmoid(float x) { return fminf(x, 0.f) - log1pf(__expf(-fabsf(x))); }

__device__ __forceinline__ void p2_elementwise(Frame& F, const Args& a) {
  unsigned char* ws = F.ws;
  const bf16* P = (const bf16*)(ws + WS_PROJ);
  { const float* cw = (const float*)a.in[I_CONV]; bf16* QC = (bf16*)(ws + WS_QC); bf16* KC = (bf16*)(ws + WS_KC);
    for (int i = F.vcu * NTHR + F.tid; i < MTOK * 128; i += F.G * NTHR) { const int m = i >> 7, c = (i & 127) * 8, t = m & (SEQ - 1);
      float x1[8], x0[8], x2[8]; unpack8(*(const v4u*)(P + (size_t)m * PROJ_LD + c), x1);
      if (t > 0) unpack8(*(const v4u*)(P + (size_t)(m - 1) * PROJ_LD + c), x0); else {
#pragma unroll
        for (int j = 0; j < 8; ++j) x0[j] = 0.f; }
      if (t < SEQ - 1) unpack8(*(const v4u*)(P + (size_t)(m + 1) * PROJ_LD + c), x2); else {
#pragma unroll
        for (int j = 0; j < 8; ++j) x2[j] = 0.f; }
      float o[8];
#pragma unroll
      for (int j = 0; j < 8; ++j) { float v = x0[j] * cw[c + j] + x1[j] * cw[1024 + c + j] + x2[j] * cw[2048 + c + j]; v = v * sigmoidf_(v); o[j] = (c < 512) ? v : v * 0.08838834764831845f; }
      if (c < 512) *(v4u*)(QC + (size_t)m * 512 + c) = pack8(o); else *(v4u*)(KC + (size_t)m * 512 + c - 512) = pack8(o); } }
  { const float* rope = (const float*)(ws + WS_ROPE); bf16* KMp = (bf16*)(ws + WS_KM);
    for (int i = F.vcu * NTHR + F.tid; i < MTOK * 16; i += F.G * NTHR) { const int m = i >> 4, j = i & 15;
      const float t1 = bf2f(P[(size_t)m * PROJ_LD + PC_KR + j]), t2 = bf2f(P[(size_t)m * PROJ_LD + PC_KR + 16 + j]); const float c = rope[m * 32 + j], s = rope[m * 32 + 16 + j];
      const bf16 o1 = (bf16)f2bf(t1 * c - t2 * s), o2 = (bf16)f2bf(t2 * c + t1 * s);
#pragma unroll
      for (int h = 0; h < 8; ++h) { KMp[(size_t)m * 768 + h * 96 + 64 + j] = o1; KMp[(size_t)m * 768 + h * 96 + 80 + j] = o2; } } }
  { const float* bg = (const float*)a.in[I_BG]; float* GSC = (float*)(ws + WS_GSC); float* DEC = (float*)(ws + WS_DEC);
    const int gw = F.vcu * NWAVES + F.wave, NGW = F.G * NWAVES;
    for (int it = gw; it < 32 * 64; it += NGW) { const int seq = it >> 6, c = it & 63, dir = seq & 1, h = (seq >> 1) & 3, b = seq >> 3;
      const int p = c * 64 + F.lane, t = dir ? (SEQ - 1 - p) : p; const size_t row = (size_t)b * SEQ + t;
      const int gi = (dir ? 8 : 0) + h, gf = (dir ? 12 : 4) + h;
      const float li = bf2f(P[row * PROJ_LD + PC_G + gi]) + bg[gi]; const float lf = log_sigmoid(bf2f(P[row * PROJ_LD + PC_G + gf]) + bg[gf]);
      float bs = lf;
#pragma unroll
      for (int o = 1; o < 64; o <<= 1) { const float y = __shfl_up(bs, o); if (F.lane >= o) bs += y; }
      const float av = li - bs; float pm = av;
#pragma unroll
      for (int o = 1; o < 64; o <<= 1) { const float y = __shfl_up(pm, o); if (F.lane >= o) pm = fmaxf(pm, y); }
      float* gs = GSC + (size_t)seq * 3 * SEQ; gs[p] = bs; gs[SEQ + p] = av; gs[2 * SEQ + p] = pm;
      if (F.lane == 63) { DEC[seq * 128 + c] = bs; DEC[seq * 128 + 64 + c] = pm; } } }
}
namespace mla {
constexpr int DQK = 96, DV = 64, NW = 8, QBLK = 32, KVBLK = 64, LDQ = 768, LDK = 768, LDV = 512, LDO = 1024;
constexpr float SCALE = 0.10206207261596575f;
constexpr float THR = 8.f;
constexpr int SHM_V = 16384, SHM_K = 16384, SHM_ATTN = 2 * SHM_V + 2 * SHM_K + NW * 64 * 4;
#define KSWZ(row, colB) ((row) * 256 + ((colB) ^ (((row) & 7) << 4)))
#define SBAR() __builtin_amdgcn_sched_barrier(0)
__device__ __forceinline__ int crow(int r, int hi) { return (r & 3) + 8 * (r >> 2) + 4 * hi; }
__device__ __forceinline__ void partialSM(f32x16& p0, f32x16& p1, float& m_reg, float& mn, float& alpha) {
  constexpr float C = SCALE * 1.4426950408889634f;
  float pmax = p0[0];
#pragma unroll
  for (int r = 1; r < 16; ++r) pmax = fmaxf(pmax, p0[r]);
#pragma unroll
  for (int r = 0; r < 16; ++r) pmax = fmaxf(pmax, p1[r]);
  { auto rr = __builtin_amdgcn_permlane32_swap(__float_as_uint(pmax), __float_as_uint(pmax), false, false);
    pmax = fmaxf(__uint_as_float(rr[0]), __uint_as_float(rr[1])); }
  if (__builtin_expect(__all(pmax - m_reg <= THR / SCALE), 1)) { mn = m_reg; alpha = 1.f; }
  else { mn = fmaxf(m_reg, pmax); alpha = __builtin_amdgcn_exp2f((m_reg - mn) * C); m_reg = mn; }
  const float mnC = -mn * C;
#pragma unroll
  for (int r = 0; r < 16; ++r) p0[r] = fmaf(p0[r], C, mnC);
#pragma unroll
  for (int r = 0; r < 16; ++r) p1[r] = fmaf(p1[r], C, mnC);
#pragma unroll
  for (int r = 0; r < 16; ++r) p0[r] = __builtin_amdgcn_exp2f(p0[r]);
}
__device__ __forceinline__ void finishSM(f32x16& p0, f32x16& p1, float alpha, float& l_reg, bf16x8& pa0, bf16x8& pa1, bf16x8& pa2, bf16x8& pa3) {
#pragma unroll
  for (int r = 0; r < 16; ++r) p1[r] = __builtin_amdgcn_exp2f(p1[r]);
  float ps = 0;
#pragma unroll
  for (int r = 0; r < 16; ++r) ps += p0[r];
#pragma unroll
  for (int r = 0; r < 16; ++r) ps += p1[r];
  { auto rr = __builtin_amdgcn_permlane32_swap(__float_as_uint(ps), __float_as_uint(ps), false, false);
    ps = __uint_as_float(rr[0]) + __uint_as_float(rr[1]); }
  l_reg = l_reg * alpha + ps;
#define PK4(P, BASE, OUT) do { unsigned a0 = cvt_pk_bf16(P[BASE + 0], P[BASE + 1]), a1 = cvt_pk_bf16(P[BASE + 2], P[BASE + 3]);   \
    unsigned b0 = cvt_pk_bf16(P[BASE + 4], P[BASE + 5]), b1 = cvt_pk_bf16(P[BASE + 6], P[BASE + 7]);                              \
    auto r0 = __builtin_amdgcn_permlane32_swap(a0, b0, false, false); auto r1 = __builtin_amdgcn_permlane32_swap(a1, b1, false, false); \
    v4u w = {r0[0], r1[0], r0[1], r1[1]}; OUT = __builtin_bit_cast(bf16x8, w); } while (0)
  PK4(p0, 0, pa0); PK4(p0, 8, pa1); PK4(p1, 0, pa2); PK4(p1, 8, pa3);
#undef PK4
}
__device__ __forceinline__ void qkt(f32x16& p0, f32x16& p1, const char* Ks, const bf16x8* qr, int r32, int hi) {
  p0 = f32x16{}; p1 = f32x16{};
#pragma unroll
  for (int d0 = 0; d0 < DQK / 16; ++d0) { const int cb = (d0 * 16 + hi * 8) * 2;
    const bf16x8 b0 = *reinterpret_cast<const bf16x8*>(Ks + KSWZ(r32, cb));
    const bf16x8 b1 = *reinterpret_cast<const bf16x8*>(Ks + KSWZ(32 + r32, cb));
    p0 = __builtin_amdgcn_mfma_f32_32x32x16_bf16(b0, qr[d0], p0, 0, 0, 0);
    p1 = __builtin_amdgcn_mfma_f32_32x32x16_bf16(b1, qr[d0], p1, 0, 0, 0); }
}
__device__ __forceinline__ int v_st(int k, int c) { const int kk = (k & ~0xC) | ((k & 4) << 1) | ((k & 8) >> 1); return ((kk >> 3) * 4 + (c >> 5)) * 512 + ((kk & 7) * 32 + (c & 31)) * 2; }
__device__ __forceinline__ int v_rd_base(int lane) { return ((lane & 3) << 3) | (((lane >> 2) & 3) << 6) | (((lane >> 4) & 1) << 5) | (((lane >> 5) & 1) << 8); }
constexpr int v_rd_off(int d0, int ks, int half) { return d0 * 512 + ks * 4096 + half * 2048; }
template <int OFF> __device__ __forceinline__ s16x4 tr_read(int vb) {
  s16x4 r; asm volatile("ds_read_b64_tr_b16 %0, %1 offset:%2" : "=&v"(r) : "v"(vb), "i"(OFF) : "memory"); return r;
}
template <int D0> __device__ __forceinline__ void pv_one(f32x16& od, int vb, bf16x8 pa0, bf16x8 pa1, bf16x8 pa2, bf16x8 pa3) {
  const s16x4 l0 = tr_read<v_rd_off(D0, 0, 0)>(vb), h0 = tr_read<v_rd_off(D0, 0, 1)>(vb), l1 = tr_read<v_rd_off(D0, 1, 0)>(vb), h1 = tr_read<v_rd_off(D0, 1, 1)>(vb);
  const s16x4 l2 = tr_read<v_rd_off(D0, 2, 0)>(vb), h2 = tr_read<v_rd_off(D0, 2, 1)>(vb), l3 = tr_read<v_rd_off(D0, 3, 0)>(vb), h3 = tr_read<v_rd_off(D0, 3, 1)>(vb);
  asm volatile("s_waitcnt lgkmcnt(0)" ::: "memory"); SBAR();
#define PK(L, H) (bf16x8){L[0], L[1], L[2], L[3], H[0], H[1], H[2], H[3]}
  od = __builtin_amdgcn_mfma_f32_32x32x16_bf16(pa0, PK(l0, h0), od, 0, 0, 0);
  od = __builtin_amdgcn_mfma_f32_32x32x16_bf16(pa1, PK(l1, h1), od, 0, 0, 0);
  od = __builtin_amdgcn_mfma_f32_32x32x16_bf16(pa2, PK(l2, h2), od, 0, 0, 0);
  od = __builtin_amdgcn_mfma_f32_32x32x16_bf16(pa3, PK(l3, h3), od, 0, 0, 0);
#undef PK
}
__device__ __forceinline__ void pv_d0(f32x16* o, int vb, bf16x8 pa0, bf16x8 pa1, bf16x8 pa2, bf16x8 pa3) {
  pv_one<0>(o[0], vb, pa0, pa1, pa2, pa3); pv_one<1>(o[1], vb, pa0, pa1, pa2, pa3);
}
__device__ __forceinline__ void attn_unit(const bf16* __restrict__ Qb, const bf16* __restrict__ Kh, const bf16* __restrict__ Vh, bf16* __restrict__ Yb, const float* __restrict__ gh, int seq, char* lds) {
  int tid = threadIdx.x; asm volatile("" : "+v"(tid));
  const int wid = tid >> 6, lane = tid & 63, r32 = lane & 31, hi = lane >> 5;
  char* V_lds = lds; char* K_lds = lds + 2 * SHM_V;
  float* wsf = (float*)(lds + 2 * SHM_V + 2 * SHM_K) + wid * 64; float* li_l = wsf; float* al_l = wsf + 32;
  float m_reg = -1e30f, l_reg = 0; f32x16 o[2] = {}; bf16x8 qr[DQK / 16];
  const bf16* Qw = Qb + (long)(wid * QBLK + r32) * LDQ + hi * 8;
#pragma unroll
  for (int d0 = 0; d0 < DQK / 16; ++d0) qr[d0] = *reinterpret_cast<const bf16x8*>(Qw + d0 * 16);
  const int sr = tid >> 4, sc = (tid & 15) * 8, vst0 = v_st(sr, sc & 63), vst1 = v_st(32 + sr, sc & 63);
  const bool doK = sc < DQK, doV = sc < DV;
  const int vb0 = (int)(uintptr_t)V_lds + v_rd_base(lane);
  struct { bf16x8 vs0, vs1, ks0, ks1; } sr_[2];
#define SLOAD(i, k0) do { if (doV) { sr_[i].vs0 = *reinterpret_cast<const bf16x8*>(&Vh[(long)((k0) + sr) * LDV + sc]); sr_[i].vs1 = *reinterpret_cast<const bf16x8*>(&Vh[(long)((k0) + 32 + sr) * LDV + sc]); } \
    if (doK) { sr_[i].ks0 = *reinterpret_cast<const bf16x8*>(&Kh[(long)((k0) + sr) * LDK + sc]); sr_[i].ks1 = *reinterpret_cast<const bf16x8*>(&Kh[(long)((k0) + 32 + sr) * LDK + sc]); } } while (0)
#define SWRITE(b, i) do { if (doV) { *(bf16x8*)(V_lds + (b) * SHM_V + vst0) = sr_[i].vs0; *(bf16x8*)(V_lds + (b) * SHM_V + vst1) = sr_[i].vs1; } \
    if (doK) { const int kc = sc * 2; *(bf16x8*)(K_lds + (b) * SHM_K + KSWZ(sr, kc)) = sr_[i].ks0; *(bf16x8*)(K_lds + (b) * SHM_K + KSWZ(32 + sr, kc)) = sr_[i].ks1; } } while (0)
#define SWAIT() asm volatile("s_waitcnt vmcnt(4)" ::: "memory")
#define RESC(a) do { if (__any((a) < 1.f)) { if (hi == 0) al_l[r32] = (a); asm volatile("s_waitcnt lgkmcnt(0)" ::: "memory"); \
    _Pragma("unroll") for (int d = 0; d < 2; ++d) _Pragma("unroll") for (int r = 0; r < 16; ++r) o[d][r] *= al_l[crow(r, hi)]; } } while (0)
  f32x16 pA0, pA1, pB0, pB1; float mnA, mnB, alA, alB; bf16x8 pa0, pa1, pa2, pa3; const int NT = seq / KVBLK;
  constexpr int SE = 0, SO = 1;
  SLOAD(SE, 0); asm volatile("s_waitcnt vmcnt(0)" ::: "memory"); SWRITE(0, SE); __syncthreads();
  qkt(pA0, pA1, K_lds, qr, r32, hi); partialSM(pA0, pA1, m_reg, mnA, alA);
  SLOAD(SO, KVBLK); if (2 < NT) SLOAD(SE, 2 * KVBLK);
  SWAIT(); SWRITE(1, SO); __syncthreads();
  for (int j = 1; j + 1 < NT; j += 2) {
    SBAR(); qkt(pB0, pB1, K_lds + SHM_K, qr, r32, hi);
    finishSM(pA0, pA1, alA, l_reg, pa0, pa1, pa2, pa3); SBAR();
    SLOAD(SO, (j + 2) * KVBLK); SBAR();
    pv_d0(o, vb0, pa0, pa1, pa2, pa3); partialSM(pB0, pB1, m_reg, mnB, alB);
    __syncthreads(); SWAIT(); SWRITE(0, SE);
    RESC(alB); __syncthreads();
    SBAR(); qkt(pA0, pA1, K_lds, qr, r32, hi);
    finishSM(pB0, pB1, alB, l_reg, pa0, pa1, pa2, pa3); SBAR();
    if (j + 3 < NT) SLOAD(SE, (j + 3) * KVBLK); SBAR();
    pv_d0(o, vb0 + SHM_V, pa0, pa1, pa2, pa3); partialSM(pA0, pA1, m_reg, mnA, alA);
    __syncthreads(); SWAIT(); SWRITE(1, SO);
    RESC(alA); __syncthreads();
  }
  SBAR(); qkt(pB0, pB1, K_lds + SHM_K, qr, r32, hi);
  finishSM(pA0, pA1, alA, l_reg, pa0, pa1, pa2, pa3); SBAR();
  pv_d0(o, vb0, pa0, pa1, pa2, pa3); partialSM(pB0, pB1, m_reg, mnB, alB);
  __syncthreads(); RESC(alB);
  finishSM(pB0, pB1, alB, l_reg, pa0, pa1, pa2, pa3); SBAR();
  pv_d0(o, vb0 + SHM_V, pa0, pa1, pa2, pa3);
  __syncthreads();
  { float* st = (float*)lds + wid * (32 * 68);
#pragma unroll
    for (int r = 0; r < 16; ++r) { const int orow = crow(r, hi); st[orow * 68 + r32] = o[0][r]; st[orow * 68 + 32 + r32] = o[1][r]; }
    asm volatile("s_waitcnt lgkmcnt(0)" ::: "memory");
    float v[32]; float s = 0.f;
#pragma unroll
    for (int j = 0; j < 8; ++j) { const f32x4 t = *(const f32x4*)(st + r32 * 68 + hi * 32 + 4 * j); v[4 * j] = t.x; v[4 * j + 1] = t.y; v[4 * j + 2] = t.z; v[4 * j + 3] = t.w; s += (t.x * t.x + t.y * t.y) + (t.z * t.z + t.w * t.w); }
    { auto rr = __builtin_amdgcn_permlane32_swap(__float_as_uint(s), __float_as_uint(s), false, false); s = __uint_as_float(rr[0]) + __uint_as_float(rr[1]); }
    const float rl = 1.f / l_reg; const float fac = rl * rsqrtf(s * rl * rl * (1.f / 64.f) + 1e-6f);
    bf16* yp = Yb + (long)(wid * QBLK + r32) * LDO + hi * 32; const float* gp = gh + hi * 32;
#pragma unroll
    for (int j = 0; j < 4; ++j) { float w[8];
#pragma unroll
      for (int e = 0; e < 8; ++e) w[e] = v[8 * j + e] * fac * gp[8 * j + e];
      *(v4u*)(yp + 8 * j) = pack8(w); } }
  __syncthreads();
#undef SLOAD
#undef SWRITE
#undef SWAIT
#undef RESC
}
#undef KSWZ
#undef SBAR
}

__device__ __forceinline__ int queue_pull(Frame& F, gu32* heads, int nq, int nper, int myq) {
  volatile LAS int* slot = (volatile LAS int*)(F.lds + LDSCTL_OFF);
  if (F.tid == 0) { int got = -1;
    for (int k = 0; k < nq; ++k) { const int q = (myq + k) % nq;
      if (__hip_atomic_load(heads + 64 * q, RLX_AGENT) >= (unsigned)nper) continue;
      const unsigned i = __hip_atomic_fetch_add(heads + 64 * q, 1u, RLX_AGENT);
      if (i < (unsigned)nper) { got = q * nper + (int)i; break; } }
    *slot = got; }
  __syncthreads();
  const int r = __builtin_amdgcn_readfirstlane(*slot);
  __syncthreads();
  return r;
}
__device__ __forceinline__ void p3_attention(Frame& F, const Args& a, char* lds_generic, unsigned xcc, int qoff) {
  unsigned char* ws = F.ws;
  const bf16* QMp = (const bf16*)(ws + WS_QM); const bf16* KMp = (const bf16*)(ws + WS_KM); const bf16* VMp = (const bf16*)(ws + WS_VM); bf16* Y = (bf16*)(ws + WS_Y);
  for (;;) {
    const int u = queue_pull(F, F.ctl + CW_Q + qoff, 8, 64, (int)(xcc & 7u));
    if (u < 0) break;
    const int bh = u >> 4, qb = u & 15, b = bh >> 3, h = bh & 7;
    mla::attn_unit(QMp + ((size_t)b * SEQ + qb * 256) * 768 + h * 96, KMp + (size_t)b * SEQ * 768 + h * 96, VMp + (size_t)b * SEQ * 512 + h * 64,
                   Y + ((size_t)b * SEQ + qb * 256) * 1024 + 512 + h * 64, (const float*)a.in[I_GHA] + h * 64, SEQ, lds_generic);
  }
}
namespace mls {
using mla::crow; using mla::v_st; using mla::v_rd_base;
#define KSWZ(row, colB) ((row) * 256 + ((colB) ^ (((row) & 7) << 4)))
constexpr int OFF_QS = 0, OFF_KS = 16384, OFF_KP = 32768, OFF_VV = 49152, OFF_CT = 65536, OFF_SC = 98304, OFF_NB = 99328, OFF_NP = 100352, OFF_CH = 104448, OFF_WS = 105472;
template <int OFF> __device__ __forceinline__ s16x4 trr(int vb) { s16x4 r; asm volatile("ds_read_b64_tr_b16 %0, %1 offset:%2" : "=&v"(r) : "v"(vb), "i"(OFF) : "memory"); return r; }
#define PKF(L, H) (bf16x8){L[0], L[1], L[2], L[3], H[0], H[1], H[2], H[3]}
__device__ __forceinline__ void vfrags(int img, int d0, int lane, bf16x8 (&f)[4]) {
  const int vb = img + v_rd_base(lane) + d0 * 512;
  const s16x4 l0 = trr<0>(vb), h0 = trr<2048>(vb), l1 = trr<4096>(vb), h1 = trr<4096 + 2048>(vb), l2 = trr<8192>(vb), h2 = trr<8192 + 2048>(vb), l3 = trr<12288>(vb), h3 = trr<12288 + 2048>(vb);
  asm volatile("s_waitcnt lgkmcnt(0)" ::: "memory"); __builtin_amdgcn_sched_barrier(0);
  f[0] = PKF(l0, h0); f[1] = PKF(l1, h1); f[2] = PKF(l2, h2); f[3] = PKF(l3, h3);
}
__device__ __forceinline__ void pack_p(const f32x16& p0, const f32x16& p1, bf16x8& pa0, bf16x8& pa1, bf16x8& pa2, bf16x8& pa3) {
#define PK4(P, BASE, OUT) do { unsigned a0 = cvt_pk_bf16(P[BASE + 0], P[BASE + 1]), a1 = cvt_pk_bf16(P[BASE + 2], P[BASE + 3]);   \
    unsigned b0 = cvt_pk_bf16(P[BASE + 4], P[BASE + 5]), b1 = cvt_pk_bf16(P[BASE + 6], P[BASE + 7]);                              \
    auto r0 = __builtin_amdgcn_permlane32_swap(a0, b0, false, false); auto r1 = __builtin_amdgcn_permlane32_swap(a1, b1, false, false); \
    v4u w = {r0[0], r1[0], r0[1], r1[1]}; OUT = __builtin_bit_cast(bf16x8, w); } while (0)
  PK4(p0, 0, pa0); PK4(p0, 8, pa1); PK4(p1, 0, pa2); PK4(p1, 8, pa3);
#undef PK4
}
__device__ __forceinline__ float swap_add(float v) { auto rr = __builtin_amdgcn_permlane32_swap(__float_as_uint(v), __float_as_uint(v), false, false); return __uint_as_float(rr[0]) + __uint_as_float(rr[1]); }

__device__ __forceinline__ void mlstm_seq(int seq, unsigned char* ws, char* lds) {
  int tid = threadIdx.x; asm volatile("" : "+v"(tid));
  const int wid = __builtin_amdgcn_readfirstlane(tid >> 6), lane = tid & 63, r32 = lane & 31, hi = lane >> 5, rb = wid >> 2, cb = wid & 3;
  const int dir = seq & 1, h = (seq >> 1) & 3, b = seq >> 3;
  const bf16* QC = (const bf16*)(ws + WS_QC); const bf16* KC = (const bf16*)(ws + WS_KC); const bf16* P = (const bf16*)(ws + WS_PROJ);
  const float* gs = (const float*)(ws + WS_GSC) + (size_t)seq * 3 * SEQ; const float* dec = (const float*)(ws + WS_DEC) + seq * 128;
  bf16* H = (bf16*)(ws + (dir ? WS_HB : WS_HF));
  float* sc_alpha = (float*)(lds + OFF_SC); float* sc_a = sc_alpha + 64; float* sc_iw = sc_alpha + 128; float* sc_en = sc_alpha + 192;
  float* nbuf = (float*)(lds + OFF_NB); float* npart = (float*)(lds + OFF_NP);
  float* ch_mprev = (float*)(lds + OFF_CH); float* ch_mnew = ch_mprev + 64; float* ch_dec = ch_mprev + 128; float* ch_g = ch_mprev + 192;
  float* wsf = (float*)(lds + OFF_WS) + wid * 32;
  const int ldsb = (int)(uintptr_t)lds;
  if (tid < 64) {
    if (tid == 0) { float m = 0.f; for (int c = 0; c < 64; ++c) { const float g = dec[c], wm = dec[64 + c]; const float mn = fmaxf(g + m, g + wm); ch_mprev[c] = m; ch_mnew[c] = mn; ch_dec[c] = __expf(g + m - mn); ch_g[c] = g; m = mn; } } }
  for (int i = tid; i < 32768 / 16; i += NTHR) ((v4u*)(lds + OFF_CT))[i] = (v4u){0u, 0u, 0u, 0u};
  if (tid < 128) nbuf[tid] = 0.f;
  f32x16 cacc[2]; cacc[0] = f32x16{}; cacc[1] = f32x16{};
  __syncthreads();
  const int sr = tid >> 4, sc = (tid & 15) * 8;
  v4u gq0, gq1, gk0, gk1, gv0, gv1; float ga0, ga1, sb = 0.f, sa = 0.f, spm = 0.f;
#define ROWOF(p) ((size_t)b * SEQ + (dir ? (SEQ - 1 - (p)) : (p)))
#define LOADC(c) do { const int p0_ = 64 * (c) + sr, p1_ = p0_ + 32; const size_t r0_ = ROWOF(p0_), r1_ = ROWOF(p1_); \
    gq0 = *(const v4u*)(QC + r0_ * 512 + h * 128 + sc); gq1 = *(const v4u*)(QC + r1_ * 512 + h * 128 + sc); \
    gk0 = *(const v4u*)(KC + r0_ * 512 + h * 128 + sc); gk1 = *(const v4u*)(KC + r1_ * 512 + h * 128 + sc); \
    gv0 = *(const v4u*)(P + r0_ * PROJ_LD + 1024 + h * 128 + sc); gv1 = *(const v4u*)(P + r1_ * PROJ_LD + 1024 + h * 128 + sc); \
    ga0 = gs[SEQ + p0_]; ga1 = gs[SEQ + p1_]; \
    if (tid < 64) { sb = gs[64 * (c) + tid]; sa = gs[SEQ + 64 * (c) + tid]; spm = gs[2 * SEQ + 64 * (c) + tid]; } } while (0)
#define WRITEC(c) do { \
    *(v4u*)(lds + OFF_QS + KSWZ(sr, sc * 2)) = gq0; *(v4u*)(lds + OFF_QS + KSWZ(32 + sr, sc * 2)) = gq1; \
    *(v4u*)(lds + OFF_KS + KSWZ(sr, sc * 2)) = gk0; *(v4u*)(lds + OFF_KS + KSWZ(32 + sr, sc * 2)) = gk1; \
    *(v4u*)(lds + OFF_VV + v_st(sr, sc)) = gv0; *(v4u*)(lds + OFF_VV + v_st(32 + sr, sc)) = gv1; \
    { const float gc_ = ch_g[c], mn_ = ch_mnew[c]; const float w0_ = __expf(gc_ + ga0 - mn_), w1_ = __expf(gc_ + ga1 - mn_); float f0_[8], f1_[8], cs_[8]; unpack8(gk0, f0_); unpack8(gk1, f1_); \
      _Pragma("unroll") for (int j = 0; j < 8; ++j) { f0_[j] *= w0_; f1_[j] *= w1_; cs_[j] = f0_[j] + f1_[j]; } \
      *(v4u*)(lds + OFF_KP + v_st(sr, sc)) = pack8(f0_); *(v4u*)(lds + OFF_KP + v_st(32 + sr, sc)) = pack8(f1_); \
      _Pragma("unroll") for (int j = 0; j < 8; ++j) { cs_[j] += __shfl_xor(cs_[j], 16); cs_[j] += __shfl_xor(cs_[j], 32); } \
      if ((lane >> 4) == 0) { _Pragma("unroll") for (int j = 0; j < 8; ++j) npart[wid * 128 + sc + j] = cs_[j]; } } \
    if (tid < 64) { const float m_ = ch_mprev[c]; const float mt_ = fmaxf(sb + m_, sb + spm); sc_alpha[tid] = sb - mt_; sc_a[tid] = sa; sc_iw[tid] = __expf(sb + m_ - mt_); sc_en[tid] = __expf(-mt_); } } while (0)
  LOADC(0); WRITEC(0);
  __syncthreads();
  for (int c = 0; c < 64; ++c) {
    if (c + 1 < 64) LOADC(c + 1);
    const float* nb = nbuf + (c & 1) * 128;
    if (tid < 128) { float s = 0.f;
#pragma unroll
      for (int w = 0; w < 8; ++w) s += npart[w * 128 + tid];
      nbuf[((c + 1) & 1) * 128 + tid] = ch_dec[c] * nb[tid] + s; }
    bf16x8 qr[8];
#pragma unroll
    for (int d0 = 0; d0 < 8; ++d0) qr[d0] = *(const bf16x8*)(lds + OFF_QS + KSWZ(32 * rb + r32, (16 * d0 + 8 * hi) * 2));
    f32x16 p0 = f32x16{}, p1 = f32x16{};
#pragma unroll
    for (int d0 = 0; d0 < 8; ++d0) { const bf16x8 k0 = *(const bf16x8*)(lds + OFF_KS + KSWZ(r32, (16 * d0 + 8 * hi) * 2)); p0 = __builtin_amdgcn_mfma_f32_32x32x16_bf16(k0, qr[d0], p0, 0, 0, 0); }
    if (rb == 1) {
#pragma unroll
      for (int d0 = 0; d0 < 8; ++d0) { const bf16x8 k1 = *(const bf16x8*)(lds + OFF_KS + KSWZ(32 + r32, (16 * d0 + 8 * hi) * 2)); p1 = __builtin_amdgcn_mfma_f32_32x32x16_bf16(k1, qr[d0], p1, 0, 0, 0); }
    }
    const float al = sc_alpha[32 * rb + r32];
    if (rb == 0) {
#pragma unroll
      for (int r = 0; r < 16; ++r) { const int sl = crow(r, hi); p0[r] = (sl <= r32) ? __expf(al + sc_a[sl]) * p0[r] : 0.f; }
    } else {
#pragma unroll
      for (int r = 0; r < 16; ++r) { const int sl = crow(r, hi); p0[r] = __expf(al + sc_a[sl]) * p0[r]; p1[r] = (sl <= r32) ? __expf(al + sc_a[32 + sl]) * p1[r] : 0.f; }
    }
    float ps = 0.f;
#pragma unroll
    for (int r = 0; r < 16; ++r) ps += p0[r] + p1[r];
    ps = swap_add(ps);
    bf16x8 pa0, pa1, pa2, pa3; pack_p(p0, p1, pa0, pa1, pa2, pa3);
    float qn = 0.f;
#pragma unroll
    for (int d0 = 0; d0 < 8; ++d0) { const f32x4 n0 = *(const f32x4*)(nb + 16 * d0 + 8 * hi), n1 = *(const f32x4*)(nb + 16 * d0 + 8 * hi + 4); const v4u qw = __builtin_bit_cast(v4u, qr[d0]);
      qn += bflo(qw.x) * n0.x + bfhi(qw.x) * n0.y + bflo(qw.y) * n0.z + bfhi(qw.y) * n0.w + bflo(qw.z) * n1.x + bfhi(qw.z) * n1.y + bflo(qw.w) * n1.z + bfhi(qw.w) * n1.w; }
    qn = swap_add(qn);
    { const float iwt = sc_iw[32 * rb + r32]; const float den = iwt * qn + ps; const float rd = 1.f / fmaxf(fabsf(den), sc_en[32 * rb + r32]); if (hi == 0) wsf[r32] = rd; }
    f32x16 o = f32x16{};
#pragma unroll
    for (int d0 = 0; d0 < 8; ++d0) { const bf16x8 cf = *(const bf16x8*)(lds + OFF_CT + KSWZ(32 * cb + r32, (16 * d0 + 8 * hi) * 2)); o = __builtin_amdgcn_mfma_f32_32x32x16_bf16(qr[d0], cf, o, 0, 0, 0); }
#pragma unroll
    for (int r = 0; r < 16; ++r) o[r] *= sc_iw[32 * rb + crow(r, hi)];
    bf16x8 vf[4]; vfrags(ldsb + OFF_VV, cb, lane, vf);
    o = __builtin_amdgcn_mfma_f32_32x32x16_bf16(pa0, vf[0], o, 0, 0, 0); o = __builtin_amdgcn_mfma_f32_32x32x16_bf16(pa1, vf[1], o, 0, 0, 0);
    if (rb == 1) { o = __builtin_amdgcn_mfma_f32_32x32x16_bf16(pa2, vf[2], o, 0, 0, 0); o = __builtin_amdgcn_mfma_f32_32x32x16_bf16(pa3, vf[3], o, 0, 0, 0); }
    asm volatile("s_waitcnt lgkmcnt(0)" ::: "memory");
#pragma unroll
    for (int r = 0; r < 16; ++r) { const int tl = crow(r, hi); const int p = 64 * c + 32 * rb + tl; H[ROWOF(p) * 512 + h * 128 + 32 * cb + r32] = (bf16)f2bf(o[r] * wsf[tl]); }
    { const float dc = ch_dec[c];
#pragma unroll
      for (int i = 0; i < 2; ++i) { bf16x8 kf[4]; vfrags(ldsb + OFF_KP, 2 * rb + i, lane, kf);
#pragma unroll
        for (int r = 0; r < 16; ++r) cacc[i][r] *= dc;
#pragma unroll
        for (int ks = 0; ks < 4; ++ks) cacc[i] = __builtin_amdgcn_mfma_f32_32x32x16_bf16(kf[ks], vf[ks], cacc[i], 0, 0, 0); } }
    __syncthreads();
#pragma unroll
    for (int i = 0; i < 2; ++i)
#pragma unroll
      for (int g = 0; g < 4; ++g) { const int d = 32 * (2 * rb + i) + 8 * g + 4 * hi, e = 32 * cb + r32;
        v2u w; w.x = cvt_pk_bf16(cacc[i][4 * g], cacc[i][4 * g + 1]); w.y = cvt_pk_bf16(cacc[i][4 * g + 2], cacc[i][4 * g + 3]);
        *(v2u*)(lds + OFF_CT + KSWZ(e, d * 2)) = w; }
    if (c + 1 < 64) WRITEC(c + 1);
    __syncthreads();
  }
#undef ROWOF
#undef LOADC
#undef WRITEC
}
#undef KSWZ
#undef PKF
}

__device__ __forceinline__ void p3_mixers(Frame& F, const Args& a, char* lds_generic, unsigned xcc, int qoff) {
#ifndef DRY_MODE
#define DRY_MODE 0
#endif
  bool did_mlstm = false;
  if (!(qoff && DRY_MODE == 2))
  for (;;) { const int it = queue_pull(F, F.ctl + CW_Q + qoff + 64 * 8, 8, 4, (int)(xcc & 7u)); if (it < 0) break; mls::mlstm_seq(it, F.ws, lds_generic); __syncthreads();  }
  if (!(qoff && DRY_MODE == 1))
  p3_attention(F, a, lds_generic, xcc, qoff);
#ifndef P3_FILL_CHUNKS
#define P3_FILL_CHUNKS 14
#endif
  if (!qoff && !did_mlstm) conv_fill(F, a, P3_FILL_CHUNKS);
}
__device__ __forceinline__ void p4_combine(Frame& F, const Args& a) {
  unsigned char* ws = F.ws; const bf16* HF = (const bf16*)(ws + WS_HF); const bf16* HB = (const bf16*)(ws + WS_HB); const bf16* P = (const bf16*)(ws + WS_PROJ); bf16* Y = (bf16*)(ws + WS_Y);
  const float* g = (const float*)a.in[I_GHM];
  const int gw = F.vcu * NWAVES + F.wave, NGW = F.G * NWAVES, c = F.lane * 8;
  float gg[8];
#pragma unroll
  for (int j = 0; j < 8; ++j) gg[j] = g[c + j];
  for (int m = gw; m < MTOK; m += NGW) {
    float f[8], bb[8], oo[8]; unpack8(*(const v4u*)(HF + (size_t)m * 512 + c), f); unpack8(*(const v4u*)(HB + (size_t)m * 512 + c), bb); unpack8(*(const v4u*)(P + (size_t)m * PROJ_LD + 1536 + c), oo);
    float s = 0.f;
#pragma unroll
    for (int j = 0; j < 8; ++j) { f[j] += bb[j]; s += f[j] * f[j]; }
    s += __shfl_xor(s, 1); s += __shfl_xor(s, 2); s += __shfl_xor(s, 4); s += __shfl_xor(s, 8);
    const float r = rsqrtf(s * (1.f / 128.f) + 1e-6f);
#pragma unroll
    for (int j = 0; j < 8; ++j) f[j] = f[j] * r * gg[j] * sigmoidf_(oo[j]);
    *(v4u*)(Y + (size_t)m * 1024 + c) = pack8(f);
  }
}
struct EpiResid { static constexpr bool TWO_PASS = false; const float* base; float* out; bf16* outb; float* ss;
  __device__ __forceinline__ void row8(const pg8::Unit& u, int rloc, int cloc, const float (&a0)[8], const float (&a1)[8], int fq) const {
    const int row = u.pm * 256 + rloc; const size_t off = (size_t)row * 1024 + u.pn * 256 + cloc;
    const f32x4 b0 = *(const f32x4*)(base + off), b1 = *(const f32x4*)(base + off + 4), b2 = *(const f32x4*)(base + off + 128), b3 = *(const f32x4*)(base + off + 132);
    float v0[8], v1[8];
#pragma unroll
    for (int i = 0; i < 4; ++i) { v0[i] = a0[i] + b0[i]; v0[4 + i] = a0[4 + i] + b1[i]; v1[i] = a1[i] + b2[i]; v1[4 + i] = a1[4 + i] + b3[i]; }
    *(f32x4*)(out + off) = (f32x4){v0[0], v0[1], v0[2], v0[3]}; *(f32x4*)(out + off + 4) = (f32x4){v0[4], v0[5], v0[6], v0[7]};
    *(f32x4*)(out + off + 128) = (f32x4){v1[0], v1[1], v1[2], v1[3]}; *(f32x4*)(out + off + 132) = (f32x4){v1[4], v1[5], v1[6], v1[7]};
    *(v4u*)(outb + off) = pack8(v0); *(v4u*)(outb + off + 128) = pack8(v1);
    float s = sumsq8(v0) + sumsq8(v1); s += __shfl_xor(s, 16); s += __shfl_xor(s, 32); if (fq == 0) unsafeAtomicAdd(ss + row, s); } };
struct EpiScale { static constexpr bool TWO_PASS = false; bf16* O; const float* ss;
  __device__ __forceinline__ void row8(const pg8::Unit& u, int rloc, int cloc, const float (&a0)[8], const float (&a1)[8], int fq) const {
    const int row = u.pm * 256 + rloc; const float r = rsqrtf(ss[row] * (1.f / 1024.f) + 1e-6f); float v0[8], v1[8];
#pragma unroll
    for (int i = 0; i < 8; ++i) { v0[i] = a0[i] * r; v1[i] = a1[i] * r; }
    bf16* p = O + (size_t)row * 1024 + u.pn * 256 + cloc; *(v4u*)p = pack8(v0); *(v4u*)(p + 128) = pack8(v1); } };
struct EpiSoftmax { static constexpr bool TWO_PASS = true; bf16* O; float scale; LAS float* xch;
  __device__ __forceinline__ void pass1(const pg8::Unit& u, int rloc, int wc, float (&v0)[8], float (&v1)[8], int fq) const {
    float mx = -3.0e38f;
#pragma unroll
    for (int i = 0; i < 8; ++i) { v0[i] *= scale; v1[i] *= scale; mx = fmaxf(mx, fmaxf(v0[i], v1[i])); }
    mx = fmaxf(mx, __shfl_xor(mx, 16)); mx = fmaxf(mx, __shfl_xor(mx, 32));
    float l = 0.f;
#pragma unroll
    for (int i = 0; i < 8; ++i) { v0[i] = __expf(v0[i] - mx); v1[i] = __expf(v1[i] - mx); l += v0[i] + v1[i]; }
    l += __shfl_xor(l, 16); l += __shfl_xor(l, 32);
    if (fq == 0) { xch[(rloc * 4 + wc) * 2] = mx; xch[(rloc * 4 + wc) * 2 + 1] = l; } }
  __device__ __forceinline__ void row8(const pg8::Unit& u, int rloc, int cloc, const float (&a0)[8], const float (&a1)[8], int fq) const {
    const int wc = cloc >> 5; float m[4], l[4]; float M = -3.0e38f;
#pragma unroll
    for (int w = 0; w < 4; ++w) { m[w] = xch[(rloc * 4 + w) * 2]; l[w] = xch[(rloc * 4 + w) * 2 + 1]; M = fmaxf(M, m[w]); }
    float L = 0.f, mine = 0.f;
#pragma unroll
    for (int w = 0; w < 4; ++w) { const float e = __expf(m[w] - M); L += l[w] * e; if (w == wc) mine = e; }
    const float f = mine / L; float v0[8], v1[8];
#pragma unroll
    for (int i = 0; i < 8; ++i) { v0[i] = a0[i] * f; v1[i] = a1[i] * f; }
    bf16* p = O + (size_t)(u.pm * 256 + rloc) * 1024 + u.pn * 256 + cloc; *(v4u*)p = pack8(v0); *(v4u*)(p + 128) = pack8(v1); } };
struct MemOrder { int G, c, kind;
  __device__ bool next(int i, pg8::Unit& u) const { const int L = i * G + c; if (L >= 256) return false;
    const int bh = L >> 4, t = L & 15, b = bh >> 2, h = bh & 3;
    u.pm = b * 16 + t; u.pn = h; u.g = 0; u.ibase = 0; u.aoff = ((long)(b * SEQ + t * 256)) * 1024 + h * 256;
    u.boff = kind == 0 ? ((long)(b * NMEM)) * 1024 + h * 256 : ((long)(h * 256)) * 1024 + b * NMEM; return true; } };
constexpr size_t WS_WRG = WS_DEC + 65536;
constexpr size_t WS_ROWSEL = WS_SEL, WS_GSEL = WS_SEL + 131072, WS_INV = 31 * MiB, WS_YE = 160 * MiB;
typedef float f32x4m __attribute__((ext_vector_type(4)));
__device__ __forceinline__ void p10_router(Frame& F, const Args& a) {
  unsigned char* ws = F.ws; const float* X2 = (const float*)(ws + WS_X2); const float* ss2 = (const float*)(ws + CTL_SS2); float* AFF = (float*)(ws + WS_AFF); const float* WRG = (const float*)(ws + WS_WRG);
  const int gw = F.vcu * NWAVES + F.wave, NGW = F.G * NWAVES, r = F.lane & 15, kq = F.lane >> 4;
  LAS float* wl = (LAS float*)F.lds;
  for (int i = F.tid; i < 4096; i += NTHR) ((LAS f32x4*)wl)[i] = ((const f32x4*)WRG)[i];
  __syncthreads();
  for (int it = gw; it < MTOK / 16; it += NGW) { const int m0 = it * 16;
    const float* xp = X2 + (size_t)(m0 + r) * 1024 + 4 * kq; const LAS float* wp = wl + (4 * kq) * 16 + r;
    f32x4m acc0 = {0.f, 0.f, 0.f, 0.f}, acc1 = {0.f, 0.f, 0.f, 0.f};
#pragma unroll 1
    for (int hf = 0; hf < 2; ++hf) {
      f32x4 xv[32];
#pragma unroll
      for (int j = 0; j < 32; ++j) xv[j] = *(const f32x4*)(xp + 16 * (32 * hf + j));
#pragma unroll
      for (int j = 0; j < 32; j += 2) { const LAS float* w0 = wp + (16 * (32 * hf + j)) * 16; const LAS float* w1 = w0 + 256;
        acc0 = __builtin_amdgcn_mfma_f32_16x16x4f32(xv[j].x, w0[0], acc0, 0, 0, 0); acc1 = __builtin_amdgcn_mfma_f32_16x16x4f32(xv[j + 1].x, w1[0], acc1, 0, 0, 0);
        acc0 = __builtin_amdgcn_mfma_f32_16x16x4f32(xv[j].y, w0[16], acc0, 0, 0, 0); acc1 = __builtin_amdgcn_mfma_f32_16x16x4f32(xv[j + 1].y, w1[16], acc1, 0, 0, 0);
        acc0 = __builtin_amdgcn_mfma_f32_16x16x4f32(xv[j].z, w0[32], acc0, 0, 0, 0); acc1 = __builtin_amdgcn_mfma_f32_16x16x4f32(xv[j + 1].z, w1[32], acc1, 0, 0, 0);
        acc0 = __builtin_amdgcn_mfma_f32_16x16x4f32(xv[j].w, w0[48], acc0, 0, 0, 0); acc1 = __builtin_amdgcn_mfma_f32_16x16x4f32(xv[j + 1].w, w1[48], acc1, 0, 0, 0); }
    }
#pragma unroll
    for (int i = 0; i < 4; ++i) { const int row = m0 + 4 * kq + i; const float lg = (acc0[i] + acc1[i]) * rsqrtf(ss2[row] * (1.f / 1024.f) + 1e-6f);
      float mx = lg; mx = fmaxf(mx, __shfl_xor(mx, 1)); mx = fmaxf(mx, __shfl_xor(mx, 2)); mx = fmaxf(mx, __shfl_xor(mx, 4)); mx = fmaxf(mx, __shfl_xor(mx, 8));
      const float ex = __expf(lg - mx); float l = ex; l += __shfl_xor(l, 1); l += __shfl_xor(l, 2); l += __shfl_xor(l, 4); l += __shfl_xor(l, 8);
      AFF[(size_t)row * 16 + r] = ex / l; }
  }
  __syncthreads();
}
__device__ __forceinline__ void p11_topk(Frame& F, char* lds) {
  unsigned char* ws = F.ws; const float* AFF = (const float*)(ws + WS_AFF); int* ROWSEL = (int*)(ws + WS_ROWSEL); float* GSEL = (float*)(ws + WS_GSEL); int* INV = (int*)(ws + WS_INV);
  unsigned* hist = (unsigned*)lds; unsigned* ctl = hist + 256; unsigned* wsum = hist + 320;
  const int tid = F.tid, lane = F.lane, wid = F.wave;
  for (int it = (int)blockIdx.x; it < BATCH * NEXP; it += F.G) { const int b = it >> 4, e = it & 15;
    unsigned key[8];
#pragma unroll
    for (int j = 0; j < 8; ++j) key[j] = __float_as_uint(AFF[((size_t)b * SEQ + 8 * tid + j) * 16 + e]);
    unsigned prefix = 0u, mask = 0u, need = CAP;
    for (int shift = 24; shift >= 0; shift -= 8) {
      if (tid < 256) hist[tid] = 0u;
      __syncthreads();
#pragma unroll
      for (int j = 0; j < 8; ++j) if ((key[j] & mask) == prefix) atomicAdd(&hist[(key[j] >> shift) & 255u], 1u);
      __syncthreads();
      if (tid == 0) { unsigned above = 0u; int d = 255; for (; d > 0; --d) { const unsigned c = hist[d]; if (above + c >= need) break; above += c; } ctl[0] = (unsigned)d; ctl[1] = need - above; }
      __syncthreads();
      prefix |= ctl[0] << shift; mask |= 255u << shift; need = ctl[1];
      __syncthreads();
    }
    unsigned ngt = 0u, neq = 0u;
#pragma unroll
    for (int j = 0; j < 8; ++j) { ngt += key[j] > prefix ? 1u : 0u; neq += key[j] == prefix ? 1u : 0u; }
    unsigned sgt = ngt, seq_ = neq;
#pragma unroll
    for (int o = 1; o < 64; o <<= 1) { const unsigned y0 = __shfl_up(sgt, o), y1 = __shfl_up(seq_, o); if (lane >= o) { sgt += y0; seq_ += y1; } }
    if (lane == 63) { wsum[wid] = sgt; wsum[8 + wid] = seq_; }
    __syncthreads();
    unsigned bgt = 0u, beq = 0u, tgt = 0u;
#pragma unroll
    for (int w = 0; w < 8; ++w) { const unsigned g = wsum[w], q = wsum[8 + w]; if (w < wid) { bgt += g; beq += q; } tgt += g; }
    unsigned pgt = bgt + sgt - ngt, peq = beq + seq_ - neq;
#pragma unroll
    for (int j = 0; j < 8; ++j) { const int t = 8 * tid + j; int slot = -1;
      if (key[j] > prefix) slot = (int)pgt++; else if (key[j] == prefix) { if (peq < need) slot = (int)(tgt + peq); ++peq; }
      INV[((size_t)b * SEQ + t) * 16 + e] = slot;
      if (slot >= 0) { ROWSEL[e * 2048 + b * 512 + slot] = b * SEQ + t; GSEL[e * 2048 + b * 512 + slot] = __uint_as_float(key[j]); } }
    __syncthreads();
  }
}
#ifndef GU_ORDER
#define GU_ORDER 1
#endif
#ifndef DN_ORDER
#define DN_ORDER 1
#endif
struct MoeGUOrder { int G, c;
  __device__ bool next(int i, pg8::Unit& u) const { const int L = i * G + c; if (L >= 2048) return false;
#if GU_ORDER == 0
    const int e = L >> 7, r = L & 127, pn = r >> 3, mt = r & 7;
#elif GU_ORDER == 1
    const int e = L >> 7, r = L & 127, mt = r >> 4, pn = r & 15;
#else
    const int x = c & 7, j = c >> 3, e = (i >> 2) * 8 + x, r = (i & 3) * 32 + j, mt = r >> 4, pn = r & 15;
#endif
    u.g = e; u.pm = mt; u.pn = pn; u.ibase = e * 2048 + mt * 256; u.aoff = 0; u.boff = ((long)e * 4096 + pn * 256) * 1024; return true; } };
struct MoeDownOrder { int G, c;
  __device__ bool next(int i, pg8::Unit& u) const { const int L = i * G + c; if (L >= 512) return false;
#if DN_ORDER == 0
    const int e = L >> 5, r = L & 31, pn = r >> 3, mt = r & 7;
#else
    const int x = c & 7, j = c >> 3, e = i * 8 + x, pn = j >> 3, mt = j & 7;
#endif
    u.g = e; u.pm = mt; u.pn = pn; u.ibase = e * 2048 + mt * 256; u.aoff = ((long)e * 2048 + mt * 256) * 2048; u.boff = ((long)e * 1024 + pn * 256) * 2048; return true; } };
struct EpiGU { static constexpr bool TWO_PASS = false; bf16* H; const float* ss2; const int* rowsel;
  __device__ __forceinline__ void row8(const pg8::Unit& u, int rloc, int cloc, const float (&a0)[8], const float (&a1)[8], int fq) const {
    const int tok = rowsel[u.ibase + rloc]; const float r = rsqrtf(ss2[tok] * (1.f / 1024.f) + 1e-6f); float h[8];
#pragma unroll
    for (int i = 0; i < 8; ++i) { const float g = a0[i] * r, up = a1[i] * r; h[i] = g * sigmoidf_(g) * up; }
    *(v4u*)(H + ((size_t)u.g * 2048 + u.pm * 256 + rloc) * 2048 + u.pn * 128 + cloc) = pack8(h); } };
struct EpiYE { static constexpr bool TWO_PASS = false; bf16* Yp; const float* gsel;
  __device__ __forceinline__ void row8(const pg8::Unit& u, int rloc, int cloc, const float (&a0)[8], const float (&a1)[8], int fq) const {
    const float gv = gsel[u.ibase + rloc]; float v0[8], v1[8];
#pragma unroll
    for (int i = 0; i < 8; ++i) { v0[i] = a0[i] * gv; v1[i] = a1[i] * gv; }
    bf16* p = Yp + ((size_t)u.g * 2048 + u.pm * 256 + rloc) * 1024 + u.pn * 256 + cloc; *(v4u*)p = pack8(v0); *(v4u*)(p + 128) = pack8(v1); } };
__device__ __forceinline__ void p14_final(Frame& F, const Args& a) {
  unsigned char* ws = F.ws; const float* X2 = (const float*)(ws + WS_X2); const int* INV = (const int*)(ws + WS_INV); const bf16* YE = (const bf16*)(ws + WS_YE);
  const float* gfin = (const float*)a.in[I_GFIN]; float* out = a.out;
  const int gw = F.vcu * NWAVES + F.wave, NGW = F.G * NWAVES;
  for (int m = gw; m < MTOK; m += NGW) { const int b = m >> 12;
    f32x4 v[4];
#pragma unroll
    for (int j = 0; j < 4; ++j) v[j] = *(const f32x4*)(X2 + (size_t)m * 1024 + 256 * j + 4 * F.lane);
    const int myinv = F.lane < 16 ? INV[(size_t)m * 16 + F.lane] : -1;
#pragma unroll
    for (int e = 0; e < 16; ++e) { const int slot = __shfl(myinv, e);
      if (slot >= 0) { const bf16* yr = YE + ((size_t)e * 2048 + b * 512 + slot) * 1024 + 4 * F.lane;
#pragma unroll
        for (int j = 0; j < 4; ++j) { const v2u w = *(const v2u*)(yr + 256 * j); v[j].x += bflo(w.x); v[j].y += bfhi(w.x); v[j].z += bflo(w.y); v[j].w += bfhi(w.y); } } }
    float s = 0.f;
#pragma unroll
    for (int j = 0; j < 4; ++j) s += (v[j].x * v[j].x + v[j].y * v[j].y) + (v[j].z * v[j].z + v[j].w * v[j].w);
    const float r = rsqrtf(wave_sum(s) * (1.f / 1024.f) + 1e-6f);
#pragma unroll
    for (int j = 0; j < 4; ++j) { const f32x4 g = *(const f32x4*)(gfin + 256 * j + 4 * F.lane); *(f32x4*)(out + (size_t)m * 1024 + 256 * j + 4 * F.lane) = v[j] * r * g; }
  }
}
__global__ void __launch_bounds__(NTHR, 2) mk(Args a) {
  extern __shared__ __attribute__((aligned(16))) unsigned char lds_raw[];
  Frame F;
  F.lds = (LAS unsigned char*)lds_raw; F.MISC = (volatile LAS unsigned*)(F.lds + LDSCTL_OFF + 320);
  F.tid = threadIdx.x; F.lane = F.tid & 63; F.wave = __builtin_amdgcn_readfirstlane(F.tid >> 6);
  F.G = gridDim.x; { const int bx = blockIdx.x; F.vcu = (F.G % 8 == 0) ? (bx % 8) * (F.G / 8) + bx / 8 : bx; }
  F.ws = a.ws; F.ctl = (gu32*)(a.ws + WS_CTL);
  unsigned char* ws = a.ws;
  for (int u = F.tid; u < (LDS_BYTES - LDSCTL_OFF) / 4; u += NTHR) ((LAS unsigned*)(F.lds + LDSCTL_OFF))[u] = 0u;
  __syncthreads();
  XcdBarrier bar = xcd_barrier_post((unsigned*)(F.ctl + CW_BAR), F.MISC + 8);
  const int lo = a.ph_lo, hi = a.ph_hi;
#define IN(k) (lo <= (k) && (k) < hi)
#define BOTH(k) (IN(k) && IN((k) + 1))
#define GRID_BAR() xcd_barrier(bar)
  float* ssq = (float*)(ws + CTL_SSQ); float* sskv = (float*)(ws + CTL_SSKV);

#ifndef REP_MASK
#define REP_MASK 0
#endif
#define NREP(k) ((((REP_MASK) >> (k)) & 1) ? 2 : 1)
#define PH_BEGIN(k) if (IN(k)) { for (int rep_ = 0; rep_ < NREP(k); ++rep_) { const bool dry = rep_ + 1 < NREP(k); (void)dry;
#define PH_END(k) if (dry) GRID_BAR(); } if (BOTH(k)) GRID_BAR(); }
  float* dummy = (float*)(ws + WS_DUMMY);
  float* ss1 = (float*)(ws + CTL_SS1); float* ss2 = (float*)(ws + CTL_SS2);
#ifndef FILLMODE
#define FILLMODE 2
#endif
  PH_BEGIN(0) p0_prologue(F, a, true, FILLMODE == 0); PH_END(0)
  PH_BEGIN(1)
    { pg8::Gemm g{(const bf16*)(ws + WS_XN), (const bf16*)(ws + WS_WIN), 1024, 1024, 1024, nullptr}; pg8::StaticOrder S; S.init(MTOK, PROJ_LD, F.G, (int)blockIdx.x, 1024, 1024);
      EpiProj E{(bf16*)(ws + WS_PROJ), dry ? dummy : ssq, dry ? dummy + 16384 : sskv};
      pg8::gemm_phase<EpiProj, pg8::StaticOrder, false>(F.lds, g, S, E); }
    { pg8::Gemm g{(const bf16*)(ws + WS_MEMN), (const bf16*)(ws + WS_WMK), 1024, 1024, 1024, nullptr}; pg8::StaticOrder S; S.init(1024, 1024, F.G, (int)((blockIdx.x + 128u) % (unsigned)F.G), 1024, 1024);
      EpiStore E{(bf16*)(ws + WS_KMEM), 1024};
      pg8::gemm_phase<EpiStore, pg8::StaticOrder, false>(F.lds, g, S, E); }
    { pg8::Gemm g{(const bf16*)(ws + WS_WMV), (const bf16*)(ws + WS_MEMN), 1024, 1024, 1024, nullptr}; pg8::StaticOrder S; S.init(1024, 1024, F.G, (int)((blockIdx.x + 112u) % (unsigned)F.G), 1024, 1024);
      EpiStore E{(bf16*)(ws + WS_VMEMT), 1024};
      pg8::gemm_phase<EpiStore, pg8::StaticOrder, false>(F.lds, g, S, E); }
  PH_END(1)
  PH_BEGIN(2)
    { pg8::Gemm g{(const bf16*)(ws + WS_PROJ) + PC_CQ, (const bf16*)(ws + WS_WQB), PROJ_LD, 256, 256, nullptr}; pg8::StaticOrder S; S.init(MTOK, 768, F.G, (int)blockIdx.x, PROJ_LD, 256);
      EpiQ E{(bf16*)(ws + WS_QM), ssq, (const float*)(ws + WS_ROPE)};
      pg8::gemm_phase<EpiQ, pg8::StaticOrder, false>(F.lds, g, S, E); }
    { pg8::Gemm g{(const bf16*)(ws + WS_PROJ) + PC_CKV, (const bf16*)(ws + WS_WKVB), PROJ_LD, 256, 256, nullptr}; pg8::StaticOrder S; S.init(MTOK, 1024, F.G, (int)((blockIdx.x + 64u) % (unsigned)F.G), PROJ_LD, 256);
      EpiKV E{(bf16*)(ws + WS_KM), (bf16*)(ws + WS_VM), sskv};
      pg8::gemm_phase<EpiKV, pg8::StaticOrder, false>(F.lds, g, S, E); }
    p2_elementwise(F, a);
  PH_END(2)
  PH_BEGIN(3) p3_mixers(F, a, (char*)lds_raw, bar.x, dry ? 64 * 16 : 0); PH_END(3)
  PH_BEGIN(4) p4_combine(F, a); PH_END(4)
  PH_BEGIN(5)
    pg8::Gemm g{(const bf16*)(ws + WS_Y), (const bf16*)(ws + WS_WOUT), 1024, 1024, 1024, nullptr}; pg8::StaticOrder S; S.init(MTOK, 1024, F.G, (int)blockIdx.x, 1024, 1024);
    EpiResid E{(const float*)a.in[I_X], (float*)(ws + WS_X1), (bf16*)(ws + WS_X1B), dry ? dummy : ss1};
    pg8::gemm_phase<EpiResid, pg8::StaticOrder, false>(F.lds, g, S, E);
  PH_END(5)
  PH_BEGIN(6)
    pg8::Gemm g{(const bf16*)(ws + WS_X1B), (const bf16*)(ws + WS_WMQ), 1024, 1024, 1024, nullptr}; pg8::StaticOrder S; S.init(MTOK, 1024, F.G, (int)blockIdx.x, 1024, 1024);
    EpiScale E{(bf16*)(ws + WS_QMEM), ss1};
    pg8::gemm_phase<EpiScale, pg8::StaticOrder, false>(F.lds, g, S, E);
  PH_END(6)
  PH_BEGIN(7)
    pg8::Gemm g{(const bf16*)(ws + WS_QMEM), (const bf16*)(ws + WS_KMEM), 1024, 1024, 256, nullptr}; MemOrder S{F.G, (int)blockIdx.x, 0};
    EpiSoftmax E{(bf16*)(ws + WS_P), 0.0625f, (LAS float*)(F.lds + LDSCTL_OFF + 1024)};
    pg8::gemm_phase<EpiSoftmax, MemOrder, false>(F.lds, g, S, E);
  PH_END(7)
  PH_BEGIN(8)
    pg8::Gemm g{(const bf16*)(ws + WS_P), (const bf16*)(ws + WS_VMEMT), 1024, 1024, 256, nullptr}; MemOrder S{F.G, (int)blockIdx.x, 1};
    EpiStore E{(bf16*)(ws + WS_MO), 1024};
    pg8::gemm_phase<EpiStore, MemOrder, false>(F.lds, g, S, E);
  PH_END(8)
  PH_BEGIN(9)
    pg8::Gemm g{(const bf16*)(ws + WS_MO), (const bf16*)(ws + WS_WMO), 1024, 1024, 1024, nullptr}; pg8::StaticOrder S; S.init(MTOK, 1024, F.G, (int)blockIdx.x, 1024, 1024);
    EpiResid E{(const float*)(ws + WS_X1), (float*)(ws + WS_X2), (bf16*)(ws + WS_X2B), dry ? dummy : ss2};
    pg8::gemm_phase<EpiResid, pg8::StaticOrder, false>(F.lds, g, S, E);
  PH_END(9)
  PH_BEGIN(10) p10_router(F, a); PH_END(10)
  PH_BEGIN(11) p11_topk(F, (char*)lds_raw);
    if (!dry && FILLMODE != 0) conv_fill(F, a, 1 << 30);
  PH_END(11)
  PH_BEGIN(12)
    pg8::Gemm g{(const bf16*)(ws + WS_X2B), (const bf16*)(ws + WS_WEGU), 1024, 1024, 1024, (const int*)(ws + WS_ROWSEL)}; MoeGUOrder S{F.G, (int)blockIdx.x};
    EpiGU E{(bf16*)(ws + WS_HID), ss2, (const int*)(ws + WS_ROWSEL)};
    pg8::gemm_phase<EpiGU, MoeGUOrder, true>(F.lds, g, S, E);
  PH_END(12)
  PH_BEGIN(13)
    pg8::Gemm g{(const bf16*)(ws + WS_HID), (const bf16*)(ws + WS_WED), 2048, 2048, 2048, nullptr}; MoeDownOrder S{F.G, (int)blockIdx.x};
    EpiYE E{(bf16*)(ws + WS_YE), (const float*)(ws + WS_GSEL)};
    pg8::gemm_phase<EpiYE, MoeDownOrder, false>(F.lds, g, S, E);
  PH_END(13)
  PH_BEGIN(14) p14_final(F, a); PH_END(14)
#undef IN
#undef BOTH
#undef GRID_BAR
}

__global__ __launch_bounds__(256) void adapt_b2f(const bf16* src, long lds_, long scol, float* dst, long ldd, long dcol, long rows, long ncols) {
  const long i = blockIdx.x * 256L + threadIdx.x; if (i >= rows * ncols) return;
  const long r = i / ncols, c = i % ncols; dst[r * ldd + dcol + c] = bf2f(src[r * lds_ + scol + c]);
}
static void adapt(hipStream_t s, const void* src, long lds_, long scol, float* dst, long ldd, long dcol, long rows, long ncols) {
  hipLaunchKernelGGL(adapt_b2f, dim3((unsigned)((rows * ncols + 255) / 256)), dim3(256), 0, s, (const bf16*)src, lds_, scol, dst, ldd, dcol, rows, ncols);
}

static int mk_grid() {
  static int grid = 0;
  if (grid == 0) {
    int dev = 0, cus = 0, per_cu = 0;
    (void)hipGetDevice(&dev); (void)hipDeviceGetAttribute(&cus, hipDeviceAttributeMultiprocessorCount, dev);
    (void)hipFuncSetAttribute((const void*)mk, hipFuncAttributeMaxDynamicSharedMemorySize, LDS_BYTES);
    (void)hipOccupancyMaxActiveBlocksPerMultiprocessor(&per_cu, (const void*)mk, NTHR, LDS_BYTES);
    (void)hipGetLastError();
    grid = cus > 0 ? cus : 256;
  }
  return grid;
}
static void mk_launch(hipStream_t s, void* const* d_in, void* d_out, void* d_ws, int lo, int hi, int flags) {
  Args a; memset(&a, 0, sizeof(a));
  for (int i = 0; i < 26; ++i) a.in[i] = d_in[i];
  a.out = (float*)d_out; a.ws = (unsigned char*)d_ws; a.ph_lo = lo; a.ph_hi = hi; a.flags = flags; a.pad = 0;
  (void)hipMemsetAsync((char*)d_ws + WS_CTL + CW_BAR * 4, 0, XCD_BAR_WORDS * 4, s);
  hipLaunchKernelGGL(mk, dim3(mk_grid()), dim3(NTHR), LDS_BYTES, s, a);
}

extern "C" void kernel_launch(void* const* d_in, const int* in_sizes, int n_in, void* d_out, int out_size, void* d_ws, size_t ws_size, hipStream_t s) {
  (void)hipMemsetAsync((char*)d_ws + WS_CTL, 0, CTL_ZERO_BYTES, s);
  mk_launch(s, d_in, d_out, d_ws, 0, 15, 1);
}
```

```cpp
#include <hip/hip_runtime.h>
#include <cstdint>
#include <cstdio>
#include <cstring>

constexpr int BATCH = 4, SEQ = 4096, DM = 1024, MTOK = BATCH * SEQ;
constexpr int D_IN = 2480;
constexpr int OFF_QM = 0, OFF_KM = 512, OFF_VM = 1024, OFF_OM = 1536, OFF_G = 2048, OFF_CQ = 2064, OFF_CKV = 2320, OFF_KR = 2448;
constexpr int NEXP = 16, CAP = 512, DFF = 2048, NMEM = 256;
constexpr size_t MiB = 1u << 20;
enum { I_X = 0, I_MEM, I_POS, I_GMIX, I_WIN, I_BG, I_CONV, I_GQA, I_WQB, I_GKVA, I_WKVB, I_GHM, I_GHA, I_WOUT, I_GMX, I_GMKV, I_WMQ, I_WMK, I_WMV, I_WMO, I_GFFN, I_WR, I_WEG, I_WEU, I_WED, I_GFIN };
#define GAS __attribute__((address_space(1)))
#define LAS __attribute__((address_space(3)))
typedef unsigned short bf16;
typedef unsigned v4u __attribute__((ext_vector_type(4)));
typedef unsigned v2u __attribute__((ext_vector_type(2)));
typedef float f32x4 __attribute__((ext_vector_type(4)));
typedef float f32x16 __attribute__((ext_vector_type(16)));
typedef short bf16x8 __attribute__((ext_vector_type(8)));
typedef short s16x4 __attribute__((ext_vector_type(4)));
typedef GAS unsigned gu32;
#define RLX_AGENT __ATOMIC_RELAXED, __HIP_MEMORY_SCOPE_AGENT
#define LDS_WAIT() asm volatile("s_waitcnt lgkmcnt(0)" ::: "memory")
#define VM_WAIT() asm volatile("s_waitcnt vmcnt(0)" ::: "memory")
constexpr int NWAVES = 8, NTHR = 512;
__device__ __forceinline__ unsigned f2bf(float f) { unsigned u = __builtin_bit_cast(unsigned, f); return (u + 0x7fffu + ((u >> 16) & 1u)) >> 16; }
__device__ __forceinline__ unsigned pk2(float lo, float hi) { return f2bf(lo) | (f2bf(hi) << 16); }
__device__ __forceinline__ float bf2f(unsigned short h) { return __builtin_bit_cast(float, (unsigned)h << 16); }
__device__ __forceinline__ float bflo(unsigned w) { return __builtin_bit_cast(float, w << 16); }
__device__ __forceinline__ float bfhi(unsigned w) { return __builtin_bit_cast(float, w & 0xffff0000u); }
typedef float f32x2_t __attribute__((ext_vector_type(2))); typedef __bf16 bf16x2_t __attribute__((ext_vector_type(2)));
__device__ __forceinline__ unsigned cvt_pk_bf16(float lo, float hi) { f32x2_t v = {lo, hi}; bf16x2_t b = __builtin_convertvector(v, bf16x2_t); return __builtin_bit_cast(unsigned, b); }
__device__ __forceinline__ v2u pack8_fp8(const float (&v)[8], float sc) { float c[8];
#pragma unroll
  for (int i = 0; i < 8; ++i) c[i] = __builtin_amdgcn_fmed3f(v[i] * sc, -448.f, 448.f);
  int a = 0, b = 0; a = __builtin_amdgcn_cvt_pk_fp8_f32(c[0], c[1], a, false); a = __builtin_amdgcn_cvt_pk_fp8_f32(c[2], c[3], a, true);
  b = __builtin_amdgcn_cvt_pk_fp8_f32(c[4], c[5], b, false); b = __builtin_amdgcn_cvt_pk_fp8_f32(c[6], c[7], b, true); v2u r; r.x = (unsigned)a; r.y = (unsigned)b; return r; }
__device__ __forceinline__ float q8(float x, float sc) { const int p = __builtin_amdgcn_cvt_pk_fp8_f32(x * sc, 0.f, 0, false); return __builtin_amdgcn_cvt_f32_fp8(p, 0) * (1.f / sc); }
__device__ __forceinline__ float wave_sum(float v) {
#pragma unroll
  for (int o = 1; o < 64; o <<= 1) v += __shfl_xor(v, o);
  return v;
}
__device__ __forceinline__ float sigmoidf_(float x) { return 1.f / (1.f + __expf(-x)); }

#define XB_TMO      128
#define XB_XCNT(j)  (256  + 64 * (j))
#define XB_XSUB(j)  (1280 + 64 * (j))
#define XB_XGEN(j)  (2304 + 64 * (j))
#define XB_TOP      3328
#define XB_TOPGEN   3392
#define XCD_BAR_WORDS 3456
#define XB_SPIN_CAP (1u << 22)
__device__ __forceinline__ unsigned xb_ld(unsigned* p)              { return __hip_atomic_load(p, __ATOMIC_RELAXED, __HIP_MEMORY_SCOPE_AGENT); }
__device__ __forceinline__ unsigned xb_add(unsigned* p, unsigned v) { return __hip_atomic_fetch_add(p, v, __ATOMIC_RELAXED, __HIP_MEMORY_SCOPE_AGENT); }
__device__ __forceinline__ unsigned xb_xcc_id() { return (unsigned)__builtin_amdgcn_s_getreg((3 << 11) | 20) & 0xFu; }
#define XB_SPIN(cond, bar) do { unsigned _sp = 0; while (cond) { __builtin_amdgcn_s_sleep(1); \
    if ((++_sp & 255u) == 0u) { if (xb_ld(&(bar)[XB_TMO])) break; if (_sp > XB_SPIN_CAP) { atomicAdd(&(bar)[XB_TMO], 1u); break; } } } } while (0)
struct XcdBarrier { unsigned* bar; unsigned x; volatile LAS unsigned* st; };
__device__ __forceinline__ XcdBarrier xcd_barrier_post(unsigned* bar, volatile LAS unsigned* st) {
  XcdBarrier b; b.bar = bar; b.x = xb_xcc_id(); b.st = st;
  if (threadIdx.x == 0) (void)xb_add(&bar[XB_XCNT(b.x)], 1u);
  return b;
}
__device__ __forceinline__ void xcd_barrier_complete(unsigned* bar, unsigned x, unsigned& nloc, unsigned& nx) {
  const unsigned G = gridDim.x * gridDim.y * gridDim.z;
  unsigned sum, cnt, mine, sp = 0u;
  for (;;) {
    sum = 0u; cnt = 0u; mine = 0u;
#pragma unroll
    for (unsigned j = 0; j < 16; ++j) { const unsigned c = xb_ld(&bar[XB_XCNT(j)]); sum += c; cnt += (c > 0u) ? 1u : 0u; mine = (j == x) ? c : mine; }
    if (sum == G) break;
    __builtin_amdgcn_s_sleep(1);
    if ((++sp & 255u) == 0u) { if (xb_ld(&bar[XB_TMO])) break; if (sp > XB_SPIN_CAP) { atomicAdd(&bar[XB_TMO], 1u); break; } }
  }
  nloc = mine > 0u ? mine : 1u; nx = cnt > 0u ? cnt : 1u;
}
__device__ __forceinline__ void xcd_barrier(const XcdBarrier& b) {
  asm volatile("s_waitcnt vmcnt(0)" ::: "memory");
  __syncthreads();
  if (threadIdx.x == 0) {
    unsigned* bar = b.bar;
    __builtin_amdgcn_s_waitcnt(0);
    unsigned nloc = b.st[0], nx = b.st[1];
    if (nloc == 0u) { xcd_barrier_complete(bar, b.x, nloc, nx); b.st[0] = nloc; b.st[1] = nx; }
    const unsigned old = xb_add(&bar[XB_XSUB(b.x)], 1u);
    const unsigned gen = old / nloc;
    if (old + 1u == (gen + 1u) * nloc) {
      __builtin_amdgcn_fence(__ATOMIC_RELEASE, "agent");
      asm volatile("s_waitcnt vmcnt(0)" ::: "memory");
      const unsigned og = xb_add(&bar[XB_TOP], 1u);
      const unsigned tg = og / nx;
      if (og + 1u == (tg + 1u) * nx) xb_add(&bar[XB_TOPGEN], 1u);
      else XB_SPIN(xb_ld(&bar[XB_TOPGEN]) == tg, bar);
      __builtin_amdgcn_fence(__ATOMIC_ACQUIRE, "agent");
      xb_add(&bar[XB_XGEN(b.x)], 1u);
      asm volatile("s_waitcnt vmcnt(0)" ::: "memory");
    } else {
      XB_SPIN(xb_ld(&bar[XB_XGEN(b.x)]) == gen, bar);
      __builtin_amdgcn_fence(__ATOMIC_ACQUIRE, "agent");
      asm volatile("s_waitcnt vmcnt(0)" ::: "memory");
    }
  }
  __syncthreads();
}

namespace pg8 {
constexpr int BM = 256, BK = 64, HALF = 128, HTB = HALF * BK * 2, STAGE_BYTES = 8 * HTB, NXCD = 8, WGM = 8;
__host__ __device__ __forceinline__ int lds_byte(int r, int c) { const int st = (r >> 4) * 2 + (c >> 5), rr = r & 15, cc = c & 31, ob = rr * 64 + cc * 2; return st * 1024 + (ob ^ (((ob >> 9) & 1) << 5)); }
__host__ __device__ __forceinline__ void stage_rc(int b, int& R, int& C) { const int st = b / 1024, sb = b % 1024, swz = sb ^ (((sb >> 9) & 1) << 5); R = (st >> 1) * 16 + swz / 64; C = (st & 1) * 32 + (swz % 64) / 2; }
__host__ __device__ __forceinline__ int perm32(int rho) { const int n = rho >> 4, i = rho & 15; return 8 * (i >> 2) + 4 * n + (i & 3); }

struct Unit { long aoff, boff; int pm, pn, g, ibase; };
struct Gemm { const bf16* A; const bf16* Bt; int lda, ldb, K; const int* gidx; int sa, sb; };
typedef int v8i_t __attribute__((ext_vector_type(8))); typedef int v4i_t __attribute__((ext_vector_type(4)));
__device__ __forceinline__ v8i_t cat8(bf16x8 lo, bf16x8 hi) { const v4i_t a = __builtin_bit_cast(v4i_t, lo), b = __builtin_bit_cast(v4i_t, hi); return __builtin_shufflevector(a, b, 0, 1, 2, 3, 4, 5, 6, 7); }

struct StaticOrder {
  int nM, nN, nwg, G, c, lda, ldb;
  __device__ void init(int M, int N, int G_, int c_, int lda_, int ldb_) { nM = M / BM; nN = N / BM; nwg = nM * nN; G = G_; c = c_; lda = lda_; ldb = ldb_; }
  __device__ bool next(int i, Unit& u) const {
    const long L = (long)i * G + c; if (L >= nwg) return false;
    int wgid = (int)L; { const int q = nwg / NXCD, r = nwg % NXCD, xcd = wgid % NXCD, off = wgid / NXCD; wgid = (xcd < r ? xcd * (q + 1) : r * (q + 1) + (xcd - r) * q) + off; }
    const int nig = WGM * nN, gid = wgid / nig, fm = gid * WGM, gsz = (nM - fm) < WGM ? (nM - fm) : WGM;
    u.pm = fm + ((wgid % nig) % gsz); u.pn = (wgid % nig) / gsz; u.g = 0; u.ibase = 0;
    u.aoff = (long)u.pm * BM * lda; u.boff = (long)u.pn * BM * ldb; return true;
  }
};

template <class Epi, class Sched, bool GATHER, int FP8 = 0>
__device__ __forceinline__ void gemm_phase(LAS unsigned char* lds, const Gemm g, const Sched& S, const Epi& E) {
  int tid = threadIdx.x; asm volatile("" : "+v"(tid));
  const int wid = __builtin_amdgcn_readfirstlane(tid >> 6), lane = tid & 63, wr = wid >> 2, wc = wid & 3, fr = lane & 15, fq = lane >> 4;
  const int K = g.K, nt = K / BK;
  int Rs[2], Cs[2]; unsigned voffB[2];
#pragma unroll
  for (int i = 0; i < 2; ++i) { int R, C; stage_rc(tid * 16 + i * 8192, R, C); Rs[i] = R; Cs[i] = C; const int Rb = (R & ~31) + perm32(R & 31); voffB[i] = (unsigned)(Rb * g.ldb + C) * 2u; }
  const size_t kstep = (size_t)(BK * 2);
  const size_t hstepB = (size_t)HALF * g.ldb * 2;
  const unsigned ldsw = (unsigned)wid * 1024u;
  const int aoff_l = lds_byte(wr * 64 + fr, FP8 ? fq * 16 : fq * 8), boff_l = lds_byte(wc * 32 + fr, FP8 ? fq * 16 : fq * 8);
  constexpr int aoff_k = FP8 ? 16 : 1024, boff_k = FP8 ? 16 : 1024;
#define PG8_SA(b, h) (((b) * 2 + (h)) * HTB)
#define PG8_SB(b, h) ((4 + (b) * 2 + (h)) * HTB)
#define PG8_STAGE(bufoff, gbase, voff) do { _Pragma("unroll") for (int _i = 0; _i < 2; ++_i) \
        __builtin_amdgcn_global_load_lds((const unsigned*)((const char*)(gbase) + (voff)[_i]), (LAS unsigned*)(lds + (bufoff) + ldsw + _i * 8192), 16, 0, 0); } while (0)
#define PG8_LDA(dst, b, h) do { _Pragma("unroll") for (int m = 0; m < 4; ++m) { if constexpr (FP8) { const v4i_t lo_ = *(const LAS v4i_t*)(lds + PG8_SA(b, h) + aoff_l + m * 2048), hi_ = *(const LAS v4i_t*)(lds + PG8_SA(b, h) + aoff_l + m * 2048 + aoff_k); dst##8[m] = __builtin_shufflevector(lo_, hi_, 0, 1, 2, 3, 4, 5, 6, 7); } \
        else { _Pragma("unroll") for (int k = 0; k < 2; ++k) dst[m][k] = *(const LAS bf16x8*)(lds + PG8_SA(b, h) + aoff_l + m * 2048 + k * aoff_k); } } } while (0)
#define PG8_LDB(dst, b, h) do { _Pragma("unroll") for (int n = 0; n < 2; ++n) { if constexpr (FP8) { const v4i_t lo_ = *(const LAS v4i_t*)(lds + PG8_SB(b, h) + boff_l + n * 2048), hi_ = *(const LAS v4i_t*)(lds + PG8_SB(b, h) + boff_l + n * 2048 + boff_k); dst##8[n] = __builtin_shufflevector(lo_, hi_, 0, 1, 2, 3, 4, 5, 6, 7); } \
        else { _Pragma("unroll") for (int k = 0; k < 2; ++k) dst[n][k] = *(const LAS bf16x8*)(lds + PG8_SB(b, h) + boff_l + n * 2048 + k * boff_k); } } } while (0)
#define PG8_MMA(ai, bj, At, Bt) do { __builtin_amdgcn_s_setprio(1); _Pragma("unroll") for (int m = 0; m < 4; ++m) _Pragma("unroll") for (int n = 0; n < 2; ++n) { \
        if constexpr (FP8) asm volatile("v_mfma_scale_f32_16x16x128_f8f6f4 %0, %1, %2, %0, %3, %4 op_sel_hi:[0,0,0]" : "+v"(acc[ai][bj][m][n]) : "v"(Bt##8[n]), "v"(At##8[m]), "v"(vsb), "v"(vsa)); \
        else { _Pragma("unroll") for (int k = 0; k < 2; ++k) acc[ai][bj][m][n] = __builtin_amdgcn_mfma_f32_16x16x32_bf16(Bt[n][k], At[m][k], acc[ai][bj][m][n], 0, 0, 0); } } \
        __builtin_amdgcn_s_setprio(0); } while (0)
#define PG8_WAIT_V(n) asm volatile("s_waitcnt vmcnt(" #n ")" ::: "memory")
#define PG8_WAIT_L(n) asm volatile("s_waitcnt lgkmcnt(" #n ")" ::: "memory")
#define PG8_BAR __builtin_amdgcn_s_barrier()
#define PG8_SCHED __builtin_amdgcn_sched_barrier(0)
  Unit cur, nxt; int ui = 0;
  if (!S.next(0, cur)) return;
  unsigned vA[2][2], nvA[2][2];
  auto load_va = [&](const Unit& u, unsigned (&v)[2][2]) {
#pragma unroll
    for (int h = 0; h < 2; ++h)
#pragma unroll
      for (int i = 0; i < 2; ++i) {
        if constexpr (GATHER) v[h][i] = (unsigned)((long)g.gidx[u.ibase + h * HALF + Rs[i]] * g.lda + Cs[i]) * 2u;
        else v[h][i] = (unsigned)((h * HALF + Rs[i]) * g.lda + Cs[i]) * 2u;
      }
  };
  load_va(cur, vA);
  f32x4 acc[2][2][4][2];
#pragma unroll
  for (int a = 0; a < 2; ++a)
#pragma unroll
    for (int b = 0; b < 2; ++b)
#pragma unroll
      for (int m = 0; m < 4; ++m)
#pragma unroll
        for (int n = 0; n < 2; ++n) acc[a][b][m][n] = (f32x4){0.f, 0.f, 0.f, 0.f};
  int vsa = g.sa, vsb = g.sb; (void)vsa; (void)vsb;
  bf16x8 At[4][2], B0[2][2], B1[2][2]; v8i_t At8[4], B08[2], B18[2];
  const char* cA = (const char*)g.A + (GATHER ? 0 : cur.aoff * 2); const char* cB = (const char*)g.Bt + cur.boff * 2;
  PG8_STAGE(PG8_SB(0, 0), cB, voffB); PG8_STAGE(PG8_SB(0, 1), cB + hstepB, voffB); PG8_STAGE(PG8_SA(0, 0), cA, vA[0]); PG8_STAGE(PG8_SA(0, 1), cA, vA[1]);
  if (wr == 1) PG8_BAR;
  PG8_WAIT_V(2); PG8_BAR;
  PG8_STAGE(PG8_SB(1, 0), cB + kstep, voffB); PG8_STAGE(PG8_SA(1, 0), cA + kstep, vA[0]); PG8_STAGE(PG8_SB(1, 1), cB + hstepB + kstep, voffB);
  PG8_WAIT_V(6); PG8_BAR;
  for (;;) {
    const bool has_next = S.next(ui + 1, nxt);
    const char* nA = has_next ? (const char*)g.A + (GATHER ? 0 : nxt.aoff * 2) : cA; const char* nB = has_next ? (const char*)g.Bt + nxt.boff * 2 : cB;
    if constexpr (GATHER) { if (has_next) load_va(nxt, nvA); else {
#pragma unroll
      for (int h = 0; h < 2; ++h)
#pragma unroll
        for (int i = 0; i < 2; ++i) nvA[h][i] = vA[h][i]; } }
#pragma unroll 1
    for (int t = 0; t < nt; t += 2) {
      const bool last = (t == nt - 2);
      const char* a1 = cA + (size_t)(t + 1) * kstep;
      const char* a2 = last ? nA : cA + (size_t)(t + 2) * kstep; const char* b2 = last ? nB : cB + (size_t)(t + 2) * kstep;
      const char* a3 = a2 + kstep; const char* b3 = b2 + kstep;
      unsigned w0[2], w1[2];
      if constexpr (GATHER) { w0[0] = last ? nvA[0][0] : vA[0][0]; w0[1] = last ? nvA[0][1] : vA[0][1]; w1[0] = last ? nvA[1][0] : vA[1][0]; w1[1] = last ? nvA[1][1] : vA[1][1]; }
      else { w0[0] = vA[0][0]; w0[1] = vA[0][1]; w1[0] = vA[1][0]; w1[1] = vA[1][1]; }
      PG8_LDB(B0, 0, 0); PG8_LDB(B1, 0, 1); PG8_SCHED; PG8_LDA(At, 0, 0); PG8_STAGE(PG8_SA(1, 1), a1, vA[1]);
      PG8_WAIT_V(8); PG8_WAIT_L(0); PG8_BAR; PG8_MMA(0, 0, At, B0); PG8_MMA(0, 1, At, B1); PG8_BAR; PG8_SCHED;
      PG8_LDA(At, 0, 1); PG8_STAGE(PG8_SB(0, 0), b2, voffB); PG8_STAGE(PG8_SB(0, 1), b2 + hstepB, voffB); PG8_STAGE(PG8_SA(0, 0), a2, w0);
      PG8_WAIT_V(8); PG8_WAIT_L(0); PG8_BAR; PG8_MMA(1, 0, At, B0); PG8_MMA(1, 1, At, B1); PG8_BAR; PG8_SCHED;
      PG8_LDB(B0, 1, 0); PG8_LDB(B1, 1, 1); PG8_SCHED; PG8_LDA(At, 1, 0); PG8_STAGE(PG8_SA(0, 1), a2, w1);
      PG8_WAIT_V(8); PG8_WAIT_L(0); PG8_BAR; PG8_MMA(0, 0, At, B0); PG8_MMA(0, 1, At, B1); PG8_BAR; PG8_SCHED;
      PG8_LDA(At, 1, 1); PG8_STAGE(PG8_SB(1, 0), b3, voffB); PG8_STAGE(PG8_SB(1, 1), b3 + hstepB, voffB); PG8_STAGE(PG8_SA(1, 0), a3, w0);
      PG8_WAIT_V(8); PG8_WAIT_L(0); PG8_BAR; PG8_MMA(1, 0, At, B0); PG8_MMA(1, 1, At, B1); PG8_BAR; PG8_SCHED;
    }
    if constexpr (FP8) { asm volatile("s_nop 15\n\ts_nop 15" ::: "memory"); __builtin_amdgcn_sched_barrier(0); }
    if (wr == 0) PG8_BAR;
    int fr_o = fr, fq_o = fq; asm volatile("" : "+v"(fr_o), "+v"(fq_o));
    if constexpr (Epi::TWO_PASS) {
#pragma unroll
      for (int ai = 0; ai < 2; ++ai)
#pragma unroll
        for (int m = 0; m < 4; ++m) {
          float v0[8], v1[8];
#pragma unroll
          for (int n = 0; n < 2; ++n)
#pragma unroll
            for (int j = 0; j < 4; ++j) { v0[n * 4 + j] = acc[ai][0][m][n][j]; v1[n * 4 + j] = acc[ai][1][m][n][j]; }
          E.pass1(cur, ai * HALF + wr * 64 + m * 16 + fr_o, wc, v0, v1, fq_o);
#pragma unroll
          for (int n = 0; n < 2; ++n)
#pragma unroll
            for (int j = 0; j < 4; ++j) { acc[ai][0][m][n][j] = v0[n * 4 + j]; acc[ai][1][m][n][j] = v1[n * 4 + j]; }
        }
      asm volatile("s_waitcnt lgkmcnt(0)" ::: "memory"); PG8_BAR; asm volatile("" ::: "memory");
    }
    {
#pragma unroll
      for (int ai = 0; ai < 2; ++ai)
#pragma unroll
        for (int m = 0; m < 4; ++m) {
          float v0[8], v1[8];
#pragma unroll
          for (int n = 0; n < 2; ++n)
#pragma unroll
            for (int j = 0; j < 4; ++j) { v0[n * 4 + j] = acc[ai][0][m][n][j]; v1[n * 4 + j] = acc[ai][1][m][n][j]; }
          E.row8(cur, ai * HALF + wr * 64 + m * 16 + fr_o, wc * 32 + 8 * fq_o, v0, v1, fq_o);
          asm volatile("" ::: "memory");
        }
    }
    if (!has_next) break;
#pragma unroll
    for (int a = 0; a < 2; ++a)
#pragma unroll
      for (int b = 0; b < 2; ++b)
#pragma unroll
        for (int m = 0; m < 4; ++m)
#pragma unroll
          for (int n = 0; n < 2; ++n) acc[a][b][m][n] = (f32x4){0.f, 0.f, 0.f, 0.f};
    cur = nxt; cA = nA; cB = nB; ++ui;
    if constexpr (GATHER) {
#pragma unroll
      for (int h = 0; h < 2; ++h)
#pragma unroll
        for (int i = 0; i < 2; ++i) vA[h][i] = nvA[h][i]; }
    if (wr == 1) PG8_BAR;
  }
  PG8_WAIT_V(0);
  PG8_BAR;
#undef PG8_SA
#undef PG8_SB
#undef PG8_STAGE
#undef PG8_LDA
#undef PG8_LDB
#undef PG8_MMA
#undef PG8_WAIT_V
#undef PG8_WAIT_L
#undef PG8_BAR
#undef PG8_SCHED
}
}
constexpr size_t WS_CTL = 0, CTL_ZERO_BYTES = 1 * MiB;
constexpr int CW_TMO = 0, CW_BAR = 4096, CW_Q = 8192;
constexpr size_t CTL_SSQ = 256 * 1024, CTL_SSKV = CTL_SSQ + 65536, CTL_SS1 = CTL_SSKV + 65536, CTL_SS2 = CTL_SS1 + 65536;
constexpr size_t WS_WIN = 1 * MiB, WS_WQB = 6 * MiB, WS_WKVB = 6 * MiB + 512 * 1024, WS_WOUT = 7 * MiB, WS_WMQ = 9 * MiB, WS_WMK = 11 * MiB, WS_WMV = 13 * MiB, WS_WMO = 15 * MiB;
constexpr size_t WS_ROPE = 17 * MiB, WS_MEMN = 19 * MiB, WS_KMEM = 21 * MiB, WS_VMEMT = 23 * MiB, WS_GSC = 25 * MiB, WS_DEC = 28 * MiB, WS_AFF = 29 * MiB, WS_SEL = 30 * MiB;
constexpr size_t WS_PROJ = 32 * MiB, WS_XN = 112 * MiB, WS_QC = 112 * MiB, WS_KC = 128 * MiB, WS_QM = 144 * MiB, WS_KM = 168 * MiB, WS_VM = 192 * MiB, WS_HF = 208 * MiB, WS_HB = 224 * MiB, WS_Y = 240 * MiB;
constexpr size_t WS_X1 = 112 * MiB, WS_X1B = 176 * MiB, WS_QMEM = 208 * MiB, WS_P = 240 * MiB, WS_MO = 176 * MiB, WS_X2 = 240 * MiB, WS_X2B = 208 * MiB, WS_HID = 32 * MiB;
constexpr size_t WS_DUMMY = 304 * MiB;
constexpr size_t WS_WEGU = 320 * MiB, WS_WED = 448 * MiB, WS_END = 512 * MiB;
constexpr int PROJ_LD = 2560;
constexpr int PC_CQ = 2048, PC_CKV = 2304, PC_KR = 2432, PC_G = 2464;
constexpr int RING_BYTES = 131072, LDSCTL_OFF = 133120, LDS_BYTES = 147456;

struct Args { const void* in[26]; float* out; unsigned char* ws; int ph_lo, ph_hi, flags, pad; };

struct Frame {
  LAS unsigned char* lds; volatile LAS unsigned* MISC; gu32* ctl; unsigned char* ws;
  int tid, lane, wave, vcu, G;
};

__device__ __forceinline__ void p0_tr(const float* W, int ldw, int k0, int kvalid, int scol0, int ncols, const float* gs, bf16* WT, int ldt, int drow0, LAS float* scr, int lane, bool doq = false) {
  const int c4 = (lane & 15) * 4, kr = lane >> 4;
  f32x4 v[16];
#pragma unroll
  for (int i = 0; i < 16; ++i) { const int kk = 4 * i + kr; v[i] = (f32x4){0.f, 0.f, 0.f, 0.f};
    if (c4 < ncols && k0 + kk < kvalid) { v[i] = *(const f32x4*)(W + (size_t)(k0 + kk) * ldw + scol0 + c4); if (gs) v[i] = v[i] * gs[k0 + kk];
      if (doq) { v[i].x = q8(v[i].x, 64.f); v[i].y = q8(v[i].y, 64.f); v[i].z = q8(v[i].z, 64.f); v[i].w = q8(v[i].w, 64.f); } } }
#pragma unroll
  for (int i = 0; i < 16; ++i) { const int kk = 4 * i + kr; LAS float* d = scr + kk * 65 + c4; d[0] = v[i].x; d[1] = v[i].y; d[2] = v[i].z; d[3] = v[i].w; }
  LDS_WAIT(); asm volatile("" ::: "memory");
  const int c = lane & 7;
#pragma unroll
  for (int j = 0; j < 8; ++j) { const int n = (lane >> 3) + 8 * j; const LAS float* s = scr + (8 * c) * 65 + n;
    v4u o; o.x = pk2(s[0 * 65], s[1 * 65]); o.y = pk2(s[2 * 65], s[3 * 65]); o.z = pk2(s[4 * 65], s[5 * 65]); o.w = pk2(s[6 * 65], s[7 * 65]);
    *(GAS v4u*)(WT + (size_t)(drow0 + n) * ldt + k0 + 8 * c) = o; }
  LDS_WAIT(); asm volatile("" ::: "memory");
}
__device__ __forceinline__ void p0_tr8(const float* W, int ldw, int k0, int scol0, const float* gs, float sc, unsigned char* WT8, int ldt, int drow0, LAS float* scr, int lane) {
  const int c4 = (lane & 15) * 4, kr = lane >> 4;
  f32x4 v[16];
#pragma unroll
  for (int i = 0; i < 16; ++i) { const int kk = 4 * i + kr; v[i] = *(const f32x4*)(W + (size_t)(k0 + kk) * ldw + scol0 + c4); if (gs) v[i] = v[i] * gs[k0 + kk]; }
#pragma unroll
  for (int i = 0; i < 16; ++i) { const int kk = 4 * i + kr; LAS float* d = scr + kk * 65 + c4; d[0] = v[i].x; d[1] = v[i].y; d[2] = v[i].z; d[3] = v[i].w; }
  LDS_WAIT(); asm volatile("" ::: "memory");
  const int c = lane & 7;
#pragma unroll
  for (int j = 0; j < 8; ++j) { const int n = (lane >> 3) + 8 * j; const LAS float* s = scr + (8 * c) * 65 + n;
    float f[8];
#pragma unroll
    for (int q = 0; q < 8; ++q) f[q] = s[q * 65];
    *(GAS v2u*)(WT8 + (size_t)(drow0 + n) * ldt + k0 + 8 * c) = pack8_fp8(f, sc); }
  LDS_WAIT(); asm volatile("" ::: "memory");
}
__device__ __forceinline__ void p0_tr32(const float* W, int ldw, int k0, int scol0, int ncols, const float* gs, bf16* WT, int ldt, int drow0, LAS float* scr, int lane) {
#pragma unroll 8
  for (int i = 0; i < 32; ++i) { const int kk = 2 * i + (lane >> 5), c = lane & 31; float v = 0.f;
    if (c < ncols) { v = W[(size_t)(k0 + kk) * ldw + scol0 + c]; if (gs) v *= gs[k0 + kk]; }
    scr[kk * 65 + c] = v; }
  LDS_WAIT(); asm volatile("" ::: "memory");
  const int c = lane & 7;
#pragma unroll
  for (int j = 0; j < 4; ++j) { const int n = (lane >> 3) + 8 * j; const LAS float* s = scr + (8 * c) * 65 + n;
    v4u o; o.x = pk2(s[0 * 65], s[1 * 65]); o.y = pk2(s[2 * 65], s[3 * 65]); o.z = pk2(s[4 * 65], s[5 * 65]); o.w = pk2(s[6 * 65], s[7 * 65]);
    *(GAS v4u*)(WT + (size_t)(drow0 + n) * ldt + k0 + 8 * c) = o; }
  LDS_WAIT(); asm volatile("" ::: "memory");
}
__device__ __forceinline__ void rms_row_to_bf16(const float* xrow, bf16* orow, int lane) {
  const GAS f32x4* xr = (const GAS f32x4*)xrow + lane;
  f32x4 v[4]; float s = 0.f;
#pragma unroll
  for (int j = 0; j < 4; ++j) { v[j] = xr[64 * j]; s += (v[j].x * v[j].x + v[j].y * v[j].y) + (v[j].z * v[j].z + v[j].w * v[j].w); }
  const float rstd = rsqrtf(wave_sum(s) * (1.f / 1024.f) + 1e-6f);
  GAS unsigned long long* o8 = (GAS unsigned long long*)orow + lane;
#pragma unroll
  for (int j = 0; j < 4; ++j) o8[64 * j] = (unsigned long long)pk2(v[j].x * rstd, v[j].y * rstd) | ((unsigned long long)pk2(v[j].z * rstd, v[j].w * rstd) << 32);
}

#ifndef FP8EMU
#define FP8EMU 0
#endif
#ifndef MOE_FP8
#define MOE_FP8 1
#endif
#ifndef MOE_FP8_DOWN
#define MOE_FP8_DOWN MOE_FP8
#endif
constexpr size_t WS_XG = 96 * MiB;
constexpr size_t WS_X2Q = 208 * MiB, WS_WEGU8 = 320 * MiB, WS_WED8 = 448 * MiB, WS_HID8 = 32 * MiB;
constexpr int CW_CONV = 8192 + 64 * 40, CW_MDONE = 8192 + 64 * 41, CW_TDONE = 8192 + 64 * 42;
constexpr int CONV_IGU = 16 * 64, CONV_ID = 32 * 16, CONV_ITEMS = NEXP * (CONV_IGU + CONV_ID), CONV_CHUNKS = CONV_ITEMS / 8;
__device__ __forceinline__ void conv_item(Frame& F, const Args& a, int it) {
  LAS float* scr = (LAS float*)(F.lds + F.wave * 16640);
  auto I = [&](int i) { return (const float*)a.in[i]; };
  unsigned char* ws = F.ws;
  const int e = it / (CONV_IGU + CONV_ID); int r = it % (CONV_IGU + CONV_ID);
  if (r < CONV_IGU) { const int kb = r / 64, nb = r % 64, p = nb >> 2, j0 = (nb & 3) * 64; const bool up = j0 >= 128;
#if MOE_FP8
    p0_tr8((up ? I(I_WEU) : I(I_WEG)) + (size_t)e * 1024 * 2048, 2048, 64 * kb, 128 * p + (up ? j0 - 128 : j0), I(I_GFFN), 64.f, ws + WS_WEGU8 + (size_t)e * 4096 * 1024, 1024, 64 * nb, scr, F.lane);
#else
    p0_tr((up ? I(I_WEU) : I(I_WEG)) + (size_t)e * 1024 * 2048, 2048, 64 * kb, 1024, 128 * p + (up ? j0 - 128 : j0), 64, I(I_GFFN), (bf16*)(ws + WS_WEGU) + (size_t)e * 4096 * 1024, 1024, 64 * nb, scr, F.lane, FP8EMU != 0);
#endif
  } else { r -= CONV_IGU; const int kb = r / 16, nb = r % 16;
#if MOE_FP8_DOWN
    p0_tr8(I(I_WED) + (size_t)e * 2048 * 1024, 1024, 64 * kb, 64 * nb, nullptr, 64.f, ws + WS_WED8 + (size_t)e * 1024 * 2048, 2048, 64 * nb, scr, F.lane);
#else
    p0_tr(I(I_WED) + (size_t)e * 2048 * 1024, 1024, 64 * kb, 2048, 64 * nb, 64, nullptr, (bf16*)(ws + WS_WED) + (size_t)e * 1024 * 2048, 2048, 64 * nb, scr, F.lane, FP8EMU != 0);
#endif
  }
}
__device__ __forceinline__ void conv_fill(Frame& F, const Args& a, int maxchunks) {
  volatile LAS int* slot = (volatile LAS int*)(F.lds + LDSCTL_OFF + 16);
  for (int n = 0; n < maxchunks; ++n) {
    if (F.tid == 0) { int got = -1;
      if (__hip_atomic_load(F.ctl + CW_CONV, RLX_AGENT) < (unsigned)CONV_CHUNKS) { const unsigned c = __hip_atomic_fetch_add(F.ctl + CW_CONV, 1u, RLX_AGENT); if (c < (unsigned)CONV_CHUNKS) got = (int)c; }
      *slot = got; }
    __syncthreads();
    const int c = __builtin_amdgcn_readfirstlane(*slot);
    __syncthreads();
    if (c < 0) break;
    conv_item(F, a, c * 8 + F.wave);
  }
}
__device__ __forceinline__ void p0_prologue(Frame& F, const Args& a, bool do_dense, bool do_experts) {
  LAS float* scr = (LAS float*)(F.lds + F.wave * 16640);
  const int gw = F.vcu * NWAVES + F.wave, NGW = F.G * NWAVES;
  auto I = [&](int i) { return (const float*)a.in[i]; };
  unsigned char* ws = F.ws;
  if (do_dense) {
    constexpr int I_WIN_ = 16 * 40, I_WQB_ = 4 * 12, I_WKVB_ = 4 * 16, I_SQ = 16 * 16;
    constexpr int NIT = I_WIN_ + I_WQB_ + I_WKVB_ + 5 * I_SQ;
    for (int it = gw; it < NIT; it += NGW) {
      int r = it;
      if (r < I_WIN_) { const int kb = r / 40, nb = r % 40; int sc, nc = 64;
        if (nb < 32) sc = 64 * nb; else if (nb < 36) sc = OFF_CQ + 64 * (nb - 32); else if (nb < 38) sc = OFF_CKV + 64 * (nb - 36); else if (nb == 38) { sc = OFF_KR; nc = 32; } else { sc = 0; nc = 0; }
        p0_tr(I(I_WIN), D_IN, 64 * kb, 1024, sc, nc, I(I_GMIX), (bf16*)(ws + WS_WIN), 1024, 64 * nb, scr, F.lane);
        if (nb == 38) p0_tr32(I(I_WIN), D_IN, 64 * kb, OFF_G, 16, I(I_GMIX), (bf16*)(ws + WS_WIN), 1024, PC_G, scr, F.lane);
        continue; } r -= I_WIN_;
      if (r < I_WQB_) { const int kb = r / 12, nb = r % 12; p0_tr(I(I_WQB), 768, 64 * kb, 256, 64 * nb, 64, I(I_GQA), (bf16*)(ws + WS_WQB), 256, 64 * nb, scr, F.lane); continue; } r -= I_WQB_;
      if (r < I_WKVB_) { const int kb = r / 16, nb = r % 16; const int h = nb & 7; const int sc = h * 128 + (nb >= 8 ? 64 : 0);
        p0_tr(I(I_WKVB), 1024, 64 * kb, 128, sc, 64, I(I_GKVA), (bf16*)(ws + WS_WKVB), 256, 64 * nb, scr, F.lane); continue; } r -= I_WKVB_;
      const int which = r / I_SQ; r %= I_SQ; const int kb = r / 16, nb = r % 16;
      const float* src = which == 0 ? I(I_WOUT) : which == 1 ? I(I_WMQ) : which == 2 ? I(I_WMK) : which == 3 ? I(I_WMV) : I(I_WMO);
      const float* gs = which == 1 ? I(I_GMX) : (which == 2 || which == 3) ? I(I_GMKV) : nullptr;
      bf16* dst = (bf16*)(ws + (which == 0 ? WS_WOUT : which == 1 ? WS_WMQ : which == 2 ? WS_WMK : which == 3 ? WS_WMV : WS_WMO));
      p0_tr(src, 1024, 64 * kb, 1024, 64 * nb, 64, gs, dst, 1024, 64 * nb, scr, F.lane);
    }
    for (int m = gw; m < MTOK; m += NGW) rms_row_to_bf16(I(I_X) + (size_t)m * 1024, (bf16*)(ws + WS_XN) + (size_t)m * 1024, F.lane);
    for (int m = gw; m < BATCH * NMEM; m += NGW) rms_row_to_bf16(I(I_MEM) + (size_t)m * 1024, (bf16*)(ws + WS_MEMN) + (size_t)m * 1024, F.lane);
    { const float* wr = I(I_WR); const float* gf = I(I_GFFN); float* wrg = (float*)(ws + WS_DEC + 65536);
      for (int i = (F.vcu * NTHR + F.tid); i < 1024 * 16; i += F.G * NTHR) wrg[i] = wr[i] * gf[i >> 4]; }
    { const int* pos = (const int*)a.in[I_POS]; float* rt = (float*)(ws + WS_ROPE);
      for (int i = (F.vcu * NTHR + F.tid); i < MTOK * 16; i += F.G * NTHR) { const int m = i >> 4, j = i & 15; const float inv = powf(10000.f, -(float)j / 16.f); const float ang = (float)pos[m] * inv;
        rt[m * 32 + j] = cosf(ang); rt[m * 32 + 16 + j] = sinf(ang); } }
  }
  if (do_experts) conv_fill(F, a, 1 << 30);
}

__device__ __forceinline__ v4u pack8(const float (&v)[8]) { v4u w; w.x = cvt_pk_bf16(v[0], v[1]); w.y = cvt_pk_bf16(v[2], v[3]); w.z = cvt_pk_bf16(v[4], v[5]); w.w = cvt_pk_bf16(v[6], v[7]); return w; }
__device__ __forceinline__ float sumsq8(const float (&v)[8]) { float s = 0.f;
#pragma unroll
  for (int i = 0; i < 8; ++i) s += v[i] * v[i];
  return s; }
struct EpiStore { static constexpr bool TWO_PASS = false; bf16* O; int ldc;
  __device__ __forceinline__ void row8(const pg8::Unit& u, int rloc, int cloc, const float (&v0)[8], const float (&v1)[8], int fq) const {
    bf16* p = O + (size_t)(u.pm * 256 + rloc) * ldc + u.pn * 256 + cloc; *(v4u*)p = pack8(v0); *(v4u*)(p + 128) = pack8(v1); } };
struct EpiProj { static constexpr bool TWO_PASS = false; bf16* P; float* ssq; float* sskv;
  __device__ __forceinline__ void row8(const pg8::Unit& u, int rloc, int cloc, const float (&v0)[8], const float (&v1)[8], int fq) const {
    const int row = u.pm * 256 + rloc; bf16* p = P + (size_t)row * PROJ_LD + u.pn * 256 + cloc; *(v4u*)p = pack8(v0); *(v4u*)(p + 128) = pack8(v1);
    if (u.pn == 8) { float s = sumsq8(v0) + sumsq8(v1); s += __shfl_xor(s, 16); s += __shfl_xor(s, 32); if (fq == 0) unsafeAtomicAdd(ssq + row, s); }
    if (u.pn == 9) { float s = sumsq8(v0); s += __shfl_xor(s, 16); s += __shfl_xor(s, 32); if (fq == 0) unsafeAtomicAdd(sskv + row, s); } } };
struct EpiQ { static constexpr bool TWO_PASS = false; bf16* Q; const float* ssq; const float* rope;
  __device__ __forceinline__ void rope8(float (&v)[8], int row, int fq) const {
    float pv[8];
#pragma unroll
    for (int i = 0; i < 8; ++i) pv[i] = __shfl_xor(v[i], 32);
    const float* cs = rope + (size_t)row * 32 + 8 * (fq & 1);
#pragma unroll
    for (int i = 0; i < 8; ++i) { const float c = cs[i], s = cs[16 + i]; v[i] = (fq < 2) ? (v[i] * c - pv[i] * s) : (v[i] * c + pv[i] * s); }
  }
  __device__ __forceinline__ void row8(const pg8::Unit& u, int rloc, int cloc, const float (&a0)[8], const float (&a1)[8], int fq) const {
    const int row = u.pm * 256 + rloc; const float r = rsqrtf(ssq[row] * (1.f / 256.f) + 1e-6f);
    float v0[8], v1[8];
#pragma unroll
    for (int i = 0; i < 8; ++i) { v0[i] = a0[i] * r; v1[i] = a1[i] * r; }
    const int g0 = u.pn * 8 + (cloc >> 5), g1 = g0 + 4;
    if (g0 % 3 == 2) rope8(v0, row, fq);
    if (g1 % 3 == 2) rope8(v1, row, fq);
    bf16* p = Q + (size_t)row * 768 + u.pn * 256 + cloc; *(v4u*)p = pack8(v0); *(v4u*)(p + 128) = pack8(v1); } };
struct EpiKV { static constexpr bool TWO_PASS = false; bf16* KMp; bf16* VMp; const float* sskv;
  __device__ __forceinline__ void put(int row, int c, const float (&v)[8], float r) const {
    float w[8];
#pragma unroll
    for (int i = 0; i < 8; ++i) w[i] = v[i] * r;
    if (c < 512) *(v4u*)(KMp + (size_t)row * 768 + (c >> 6) * 96 + (c & 63)) = pack8(w); else *(v4u*)(VMp + (size_t)row * 512 + (c - 512)) = pack8(w); }
  __device__ __forceinline__ void row8(const pg8::Unit& u, int rloc, int cloc, const float (&a0)[8], const float (&a1)[8], int fq) const {
    const int row = u.pm * 256 + rloc; const float r = rsqrtf(sskv[row] * (1.f / 128.f) + 1e-6f);
    put(row, u.pn * 256 + cloc, a0, r); put(row, u.pn * 256 + 128 + cloc, a1, r); } };

__device__ __forceinline__ void unpack8(v4u w, float (&f)[8]) { f[0] = bflo(w.x); f[1] = bfhi(w.x); f[2] = bflo(w.y); f[3] = bfhi(w.y); f[4] = bflo(w.z); f[5] = bfhi(w.z); f[6] = bflo(w.w); f[7] = bfhi(w.w); }
__device__ __forceinline__ float log_sigmoid(float x) { return fminf(x, 0.f) - log1pf(__expf(-fabsf(x))); }

__device__ __forceinline__ void p2_elementwise(Frame& F, const Args& a) {
  unsigned char* ws = F.ws;
  const bf16* P = (const bf16*)(ws + WS_PROJ);
  { const float* cw = (const float*)a.in[I_CONV]; bf16* QC = (bf16*)(ws + WS_QC); bf16* KC = (bf16*)(ws + WS_KC);
    for (int i = F.vcu * NTHR + F.tid; i < MTOK * 128; i += F.G * NTHR) { const int m = i >> 7, c = (i & 127) * 8, t = m & (SEQ - 1);
      float x1[8], x0[8], x2[8]; unpack8(*(const v4u*)(P + (size_t)m * PROJ_LD + c), x1);
      if (t > 0) unpack8(*(const v4u*)(P + (size_t)(m - 1) * PROJ_LD + c), x0); else {
#pragma unroll
        for (int j = 0; j < 8; ++j) x0[j] = 0.f; }
      if (t < SEQ - 1) unpack8(*(const v4u*)(P + (size_t)(m + 1) * PROJ_LD + c), x2); else {
#pragma unroll
        for (int j = 0; j < 8; ++j) x2[j] = 0.f; }
      float o[8];
#pragma unroll
      for (int j = 0; j < 8; ++j) { float v = x0[j] * cw[c + j] + x1[j] * cw[1024 + c + j] + x2[j] * cw[2048 + c + j]; v = v * sigmoidf_(v); o[j] = (c < 512) ? v : v * 0.08838834764831845f; }
      if (c < 512) *(v4u*)(QC + (size_t)m * 512 + c) = pack8(o); else *(v4u*)(KC + (size_t)m * 512 + c - 512) = pack8(o); } }
  { const float* rope = (const float*)(ws + WS_ROPE); bf16* KMp = (bf16*)(ws + WS_KM);
    for (int i = F.vcu * NTHR + F.tid; i < MTOK * 16; i += F.G * NTHR) { const int m = i >> 4, j = i & 15;
      const float t1 = bf2f(P[(size_t)m * PROJ_LD + PC_KR + j]), t2 = bf2f(P[(size_t)m * PROJ_LD + PC_KR + 16 + j]); const float c = rope[m * 32 + j], s = rope[m * 32 + 16 + j];
      const bf16 o1 = (bf16)f2bf(t1 * c - t2 * s), o2 = (bf16)f2bf(t2 * c + t1 * s);
#pragma unroll
      for (int h = 0; h < 8; ++h) { KMp[(size_t)m * 768 + h * 96 + 64 + j] = o1; KMp[(size_t)m * 768 + h * 96 + 80 + j] = o2; } } }
  { const float* bg = (const float*)a.in[I_BG]; float* GSC = (float*)(ws + WS_GSC); float* DEC = (float*)(ws + WS_DEC);
    const int gw = F.vcu * NWAVES + F.wave, NGW = F.G * NWAVES;
    for (int it = gw; it < 32 * 64; it += NGW) { const int seq = it >> 6, c = it & 63, dir = seq & 1, h = (seq >> 1) & 3, b = seq >> 3;
      const int p = c * 64 + F.lane, t = dir ? (SEQ - 1 - p) : p; const size_t row = (size_t)b * SEQ + t;
      const int gi = (dir ? 8 : 0) + h, gf = (dir ? 12 : 4) + h;
      const float li = bf2f(P[row * PROJ_LD + PC_G + gi]) + bg[gi]; const float lf = log_sigmoid(bf2f(P[row * PROJ_LD + PC_G + gf]) + bg[gf]);
      float bs = lf;
#pragma unroll
      for (int o = 1; o < 64; o <<= 1) { const float y = __shfl_up(bs, o); if (F.lane >= o) bs += y; }
      const float av = li - bs; float pm = av;
#pragma unroll
      for (int o = 1; o < 64; o <<= 1) { const float y = __shfl_up(pm, o); if (F.lane >= o) pm = fmaxf(pm, y); }
      float* gs = GSC + (size_t)seq * 3 * SEQ; gs[p] = bs; gs[SEQ + p] = av; gs[2 * SEQ + p] = pm;
      if (F.lane == 63) { DEC[seq * 128 + c] = bs; DEC[seq * 128 + 64 + c] = pm; } } }
}
namespace mla {
constexpr int DQK = 96, DV = 64, NW = 8, QBLK = 32, KVBLK = 64, LDQ = 768, LDK = 768, LDV = 512, LDO = 1024;
constexpr float SCALE = 0.10206207261596575f;
constexpr float THR = 8.f;
constexpr int SHM_V = 16384, SHM_K = 16384, SHM_ATTN = 2 * SHM_V + 2 * SHM_K + NW * 64 * 4;
#define KSWZ(row, colB) ((row) * 256 + ((colB) ^ (((row) & 7) << 4)))
#define SBAR() __builtin_amdgcn_sched_barrier(0)
__device__ __forceinline__ int crow(int r, int hi) { return (r & 3) + 8 * (r >> 2) + 4 * hi; }
__device__ __forceinline__ void partialSM(f32x16& p0, f32x16& p1, float& m_reg, float& mn, float& alpha) {
  constexpr float C = SCALE * 1.4426950408889634f;
  float pmax = p0[0];
#pragma unroll
  for (int r = 1; r < 16; ++r) pmax = fmaxf(pmax, p0[r]);
#pragma unroll
  for (int r = 0; r < 16; ++r) pmax = fmaxf(pmax, p1[r]);
  { auto rr = __builtin_amdgcn_permlane32_swap(__float_as_uint(pmax), __float_as_uint(pmax), false, false);
    pmax = fmaxf(__uint_as_float(rr[0]), __uint_as_float(rr[1])); }
  if (__builtin_expect(__all(pmax - m_reg <= THR / SCALE), 1)) { mn = m_reg; alpha = 1.f; }
  else { mn = fmaxf(m_reg, pmax); alpha = __builtin_amdgcn_exp2f((m_reg - mn) * C); m_reg = mn; }
  const float mnC = -mn * C;
#pragma unroll
  for (int r = 0; r < 16; ++r) p0[r] = fmaf(p0[r], C, mnC);
#pragma unroll
  for (int r = 0; r < 16; ++r) p1[r] = fmaf(p1[r], C, mnC);
#pragma unroll
  for (int r = 0; r < 16; ++r) p0[r] = __builtin_amdgcn_exp2f(p0[r]);
}
__device__ __forceinline__ void finishSM(f32x16& p0, f32x16& p1, float alpha, float& l_reg, bf16x8& pa0, bf16x8& pa1, bf16x8& pa2, bf16x8& pa3) {
#pragma unroll
  for (int r = 0; r < 16; ++r) p1[r] = __builtin_amdgcn_exp2f(p1[r]);
  float ps = 0;
#pragma unroll
  for (int r = 0; r < 16; ++r) ps += p0[r];
#pragma unroll
  for (int r = 0; r < 16; ++r) ps += p1[r];
  { auto rr = __builtin_amdgcn_permlane32_swap(__float_as_uint(ps), __float_as_uint(ps), false, false);
    ps = __uint_as_float(rr[0]) + __uint_as_float(rr[1]); }
  l_reg = l_reg * alpha + ps;
#define PK4(P, BASE, OUT) do { unsigned a0 = cvt_pk_bf16(P[BASE + 0], P[BASE + 1]), a1 = cvt_pk_bf16(P[BASE + 2], P[BASE + 3]);   \
    unsigned b0 = cvt_pk_bf16(P[BASE + 4], P[BASE + 5]), b1 = cvt_pk_bf16(P[BASE + 6], P[BASE + 7]);                              \
    auto r0 = __builtin_amdgcn_permlane32_swap(a0, b0, false, false); auto r1 = __builtin_amdgcn_permlane32_swap(a1, b1, false, false); \
    v4u w = {r0[0], r1[0], r0[1], r1[1]}; OUT = __builtin_bit_cast(bf16x8, w); } while (0)
  PK4(p0, 0, pa0); PK4(p0, 8, pa1); PK4(p1, 0, pa2); PK4(p1, 8, pa3);
#undef PK4
}
__device__ __forceinline__ void qkt(f32x16& p0, f32x16& p1, const char* Ks, const bf16x8* qr, int r32, int hi) {
  p0 = f32x16{}; p1 = f32x16{};
#pragma unroll
  for (int d0 = 0; d0 < DQK / 16; ++d0) { const int cb = (d0 * 16 + hi * 8) * 2;
    const bf16x8 b0 = *reinterpret_cast<const bf16x8*>(Ks + KSWZ(r32, cb));
    const bf16x8 b1 = *reinterpret_cast<const bf16x8*>(Ks + KSWZ(32 + r32, cb));
    p0 = __builtin_amdgcn_mfma_f32_32x32x16_bf16(b0, qr[d0], p0, 0, 0, 0);
    p1 = __builtin_amdgcn_mfma_f32_32x32x16_bf16(b1, qr[d0], p1, 0, 0, 0); }
}
__device__ __forceinline__ int v_st(int k, int c) { const int kk = (k & ~0xC) | ((k & 4) << 1) | ((k & 8) >> 1); return ((kk >> 3) * 4 + (c >> 5)) * 512 + ((kk & 7) * 32 + (c & 31)) * 2; }
__device__ __forceinline__ int v_rd_base(int lane) { return ((lane & 3) << 3) | (((lane >> 2) & 3) << 6) | (((lane >> 4) & 1) << 5) | (((lane >> 5) & 1) << 8); }
constexpr int v_rd_off(int d0, int ks, int half) { return d0 * 512 + ks * 4096 + half * 2048; }
template <int OFF> __device__ __forceinline__ s16x4 tr_read(int vb) {
  s16x4 r; asm volatile("ds_read_b64_tr_b16 %0, %1 offset:%2" : "=&v"(r) : "v"(vb), "i"(OFF) : "memory"); return r;
}
template <int D0> __device__ __forceinline__ void pv_one(f32x16& od, int vb, bf16x8 pa0, bf16x8 pa1, bf16x8 pa2, bf16x8 pa3) {
  const s16x4 l0 = tr_read<v_rd_off(D0, 0, 0)>(vb), h0 = tr_read<v_rd_off(D0, 0, 1)>(vb), l1 = tr_read<v_rd_off(D0, 1, 0)>(vb), h1 = tr_read<v_rd_off(D0, 1, 1)>(vb);
  const s16x4 l2 = tr_read<v_rd_off(D0, 2, 0)>(vb), h2 = tr_read<v_rd_off(D0, 2, 1)>(vb), l3 = tr_read<v_rd_off(D0, 3, 0)>(vb), h3 = tr_read<v_rd_off(D0, 3, 1)>(vb);
  asm volatile("s_waitcnt lgkmcnt(0)" ::: "memory"); SBAR();
#define PK(L, H) (bf16x8){L[0], L[1], L[2], L[3], H[0], H[1], H[2], H[3]}
  od = __builtin_amdgcn_mfma_f32_32x32x16_bf16(pa0, PK(l0, h0), od, 0, 0, 0);
  od = __builtin_amdgcn_mfma_f32_32x32x16_bf16(pa1, PK(l1, h1), od, 0, 0, 0);
  od = __builtin_amdgcn_mfma_f32_32x32x16_bf16(pa2, PK(l2, h2), od, 0, 0, 0);
  od = __builtin_amdgcn_mfma_f32_32x32x16_bf16(pa3, PK(l3, h3), od, 0, 0, 0);
#undef PK
}
__device__ __forceinline__ void pv_d0(f32x16* o, int vb, bf16x8 pa0, bf16x8 pa1, bf16x8 pa2, bf16x8 pa3) {
  pv_one<0>(o[0], vb, pa0, pa1, pa2, pa3); pv_one<1>(o[1], vb, pa0, pa1, pa2, pa3);
}
__device__ __forceinline__ void attn_unit(const bf16* __restrict__ Qb, const bf16* __restrict__ Kh, const bf16* __restrict__ Vh, bf16* __restrict__ Yb, const float* __restrict__ gh, int seq, char* lds) {
  int tid = threadIdx.x; asm volatile("" : "+v"(tid));
  const int wid = tid >> 6, lane = tid & 63, r32 = lane & 31, hi = lane >> 5;
  char* V_lds = lds; char* K_lds = lds + 2 * SHM_V;
  float* wsf = (float*)(lds + 2 * SHM_V + 2 * SHM_K) + wid * 64; float* li_l = wsf; float* al_l = wsf + 32;
  float m_reg = -1e30f, l_reg = 0; f32x16 o[2] = {}; bf16x8 qr[DQK / 16];
  const bf16* Qw = Qb + (long)(wid * QBLK + r32) * LDQ + hi * 8;
#pragma unroll
  for (int d0 = 0; d0 < DQK / 16; ++d0) qr[d0] = *reinterpret_cast<const bf16x8*>(Qw + d0 * 16);
  const int sr = tid >> 4, sc = (tid & 15) * 8, vst0 = v_st(sr, sc & 63), vst1 = v_st(32 + sr, sc & 63);
  const bool doK = sc < DQK, doV = sc < DV;
  const int vb0 = (int)(uintptr_t)V_lds + v_rd_base(lane);
  struct { bf16x8 vs0, vs1, ks0, ks1; } sr_[2];
#define SLOAD(i, k0) do { if (doV) { sr_[i].vs0 = *reinterpret_cast<const bf16x8*>(&Vh[(long)((k0) + sr) * LDV + sc]); sr_[i].vs1 = *reinterpret_cast<const bf16x8*>(&Vh[(long)((k0) + 32 + sr) * LDV + sc]); } \
    if (doK) { sr_[i].ks0 = *reinterpret_cast<const bf16x8*>(&Kh[(long)((k0) + sr) * LDK + sc]); sr_[i].ks1 = *reinterpret_cast<const bf16x8*>(&Kh[(long)((k0) + 32 + sr) * LDK + sc]); } } while (0)
#define SWRITE(b, i) do { if (doV) { *(bf16x8*)(V_lds + (b) * SHM_V + vst0) = sr_[i].vs0; *(bf16x8*)(V_lds + (b) * SHM_V + vst1) = sr_[i].vs1; } \
    if (doK) { const int kc = sc * 2; *(bf16x8*)(K_lds + (b) * SHM_K + KSWZ(sr, kc)) = sr_[i].ks0; *(bf16x8*)(K_lds + (b) * SHM_K + KSWZ(32 + sr, kc)) = sr_[i].ks1; } } while (0)
#define SWAIT() asm volatile("s_waitcnt vmcnt(4)" ::: "memory")
#define RESC(a) do { if (__any((a) < 1.f)) { if (hi == 0) al_l[r32] = (a); asm volatile("s_waitcnt lgkmcnt(0)" ::: "memory"); \
    _Pragma("unroll") for (int d = 0; d < 2; ++d) _Pragma("unroll") for (int r = 0; r < 16; ++r) o[d][r] *= al_l[crow(r, hi)]; } } while (0)
  f32x16 pA0, pA1, pB0, pB1; float mnA, mnB, alA, alB; bf16x8 pa0, pa1, pa2, pa3; const int NT = seq / KVBLK;
  constexpr int SE = 0, SO = 1;
  SLOAD(SE, 0); asm volatile("s_waitcnt vmcnt(0)" ::: "memory"); SWRITE(0, SE); __syncthreads();
  qkt(pA0, pA1, K_lds, qr, r32, hi); partialSM(pA0, pA1, m_reg, mnA, alA);
  SLOAD(SO, KVBLK); if (2 < NT) SLOAD(SE, 2 * KVBLK);
  SWAIT(); SWRITE(1, SO); __syncthreads();
  for (int j = 1; j + 1 < NT; j += 2) {
    SBAR(); qkt(pB0, pB1, K_lds + SHM_K, qr, r32, hi);
    finishSM(pA0, pA1, alA, l_reg, pa0, pa1, pa2, pa3); SBAR();
    SLOAD(SO, (j + 2) * KVBLK); SBAR();
    pv_d0(o, vb0, pa0, pa1, pa2, pa3); partialSM(pB0, pB1, m_reg, mnB, alB);
    __syncthreads(); SWAIT(); SWRITE(0, SE);
    RESC(alB); __syncthreads();
    SBAR(); qkt(pA0, pA1, K_lds, qr, r32, hi);
    finishSM(pB0, pB1, alB, l_reg, pa0, pa1, pa2, pa3); SBAR();
    if (j + 3 < NT) SLOAD(SE, (j + 3) * KVBLK); SBAR();
    pv_d0(o, vb0 + SHM_V, pa0, pa1, pa2, pa3); partialSM(pA0, pA1, m_reg, mnA, alA);
    __syncthreads(); SWAIT(); SWRITE(1, SO);
    RESC(alA); __syncthreads();
  }
  SBAR(); qkt(pB0, pB1, K_lds + SHM_K, qr, r32, hi);
  finishSM(pA0, pA1, alA, l_reg, pa0, pa1, pa2, pa3); SBAR();
  pv_d0(o, vb0, pa0, pa1, pa2, pa3); partialSM(pB0, pB1, m_reg, mnB, alB);
  __syncthreads(); RESC(alB);
  finishSM(pB0, pB1, alB, l_reg, pa0, pa1, pa2, pa3); SBAR();
  pv_d0(o, vb0 + SHM_V, pa0, pa1, pa2, pa3);
  __syncthreads();
  { float* st = (float*)lds + wid * (32 * 68);
#pragma unroll
    for (int r = 0; r < 16; ++r) { const int orow = crow(r, hi); st[orow * 68 + r32] = o[0][r]; st[orow * 68 + 32 + r32] = o[1][r]; }
    asm volatile("s_waitcnt lgkmcnt(0)" ::: "memory");
    float v[32]; float s = 0.f;
#pragma unroll
    for (int j = 0; j < 8; ++j) { const f32x4 t = *(const f32x4*)(st + r32 * 68 + hi * 32 + 4 * j); v[4 * j] = t.x; v[4 * j + 1] = t.y; v[4 * j + 2] = t.z; v[4 * j + 3] = t.w; s += (t.x * t.x + t.y * t.y) + (t.z * t.z + t.w * t.w); }
    { auto rr = __builtin_amdgcn_permlane32_swap(__float_as_uint(s), __float_as_uint(s), false, false); s = __uint_as_float(rr[0]) + __uint_as_float(rr[1]); }
    const float rl = 1.f / l_reg; const float fac = rl * rsqrtf(s * rl * rl * (1.f / 64.f) + 1e-6f);
    bf16* yp = Yb + (long)(wid * QBLK + r32) * LDO + hi * 32; const float* gp = gh + hi * 32;
#pragma unroll
    for (int j = 0; j < 4; ++j) { float w[8];
#pragma unroll
      for (int e = 0; e < 8; ++e) w[e] = v[8 * j + e] * fac * gp[8 * j + e];
      *(v4u*)(yp + 8 * j) = pack8(w); } }
  __syncthreads();
#undef SLOAD
#undef SWRITE
#undef SWAIT
#undef RESC
}
#undef KSWZ
#undef SBAR
}

__device__ __forceinline__ int queue_pull(Frame& F, gu32* heads, int nq, int nper, int myq) {
  volatile LAS int* slot = (volatile LAS int*)(F.lds + LDSCTL_OFF);
  if (F.tid == 0) { int got = -1;
    for (int k = 0; k < nq; ++k) { const int q = (myq + k) % nq;
      if (__hip_atomic_load(heads + 64 * q, RLX_AGENT) >= (unsigned)nper) continue;
      const unsigned i = __hip_atomic_fetch_add(heads + 64 * q, 1u, RLX_AGENT);
      if (i < (unsigned)nper) { got = q * nper + (int)i; break; } }
    *slot = got; }
  __syncthreads();
  const int r = __builtin_amdgcn_readfirstlane(*slot);
  __syncthreads();
  return r;
}
__device__ __forceinline__ void p3_attention(Frame& F, const Args& a, char* lds_generic, unsigned xcc, int qoff) {
  unsigned char* ws = F.ws;
  const bf16* QMp = (const bf16*)(ws + WS_QM); const bf16* KMp = (const bf16*)(ws + WS_KM); const bf16* VMp = (const bf16*)(ws + WS_VM); bf16* Y = (bf16*)(ws + WS_Y);
  for (;;) {
    const int u = queue_pull(F, F.ctl + CW_Q + qoff, 8, 64, (int)(xcc & 7u));
    if (u < 0) break;
    const int bh = u >> 4, qb = u & 15, b = bh >> 3, h = bh & 7;
    mla::attn_unit(QMp + ((size_t)b * SEQ + qb * 256) * 768 + h * 96, KMp + (size_t)b * SEQ * 768 + h * 96, VMp + (size_t)b * SEQ * 512 + h * 64,
                   Y + ((size_t)b * SEQ + qb * 256) * 1024 + 512 + h * 64, (const float*)a.in[I_GHA] + h * 64, SEQ, lds_generic);
  }
}
namespace mls {
using mla::crow; using mla::v_st; using mla::v_rd_base;
#define KSWZ(row, colB) ((row) * 256 + ((colB) ^ (((row) & 7) << 4)))
constexpr int OFF_QS = 0, OFF_KS = 16384, OFF_KP = 32768, OFF_VV = 49152, OFF_CT = 65536, OFF_SC = 98304, OFF_NB = 99328, OFF_NP = 100352, OFF_CH = 104448, OFF_WS = 105472;
template <int OFF> __device__ __forceinline__ s16x4 trr(int vb) { s16x4 r; asm volatile("ds_read_b64_tr_b16 %0, %1 offset:%2" : "=&v"(r) : "v"(vb), "i"(OFF) : "memory"); return r; }
#define PKF(L, H) (bf16x8){L[0], L[1], L[2], L[3], H[0], H[1], H[2], H[3]}
__device__ __forceinline__ void vfrags(int img, int d0, int lane, bf16x8 (&f)[4]) {
  const int vb = img + v_rd_base(lane) + d0 * 512;
  const s16x4 l0 = trr<0>(vb), h0 = trr<2048>(vb), l1 = trr<4096>(vb), h1 = trr<4096 + 2048>(vb), l2 = trr<8192>(vb), h2 = trr<8192 + 2048>(vb), l3 = trr<12288>(vb), h3 = trr<12288 + 2048>(vb);
  asm volatile("s_waitcnt lgkmcnt(0)" ::: "memory"); __builtin_amdgcn_sched_barrier(0);
  f[0] = PKF(l0, h0); f[1] = PKF(l1, h1); f[2] = PKF(l2, h2); f[3] = PKF(l3, h3);
}
__device__ __forceinline__ void pack_p(const f32x16& p0, const f32x16& p1, bf16x8& pa0, bf16x8& pa1, bf16x8& pa2, bf16x8& pa3) {
#define PK4(P, BASE, OUT) do { unsigned a0 = cvt_pk_bf16(P[BASE + 0], P[BASE + 1]), a1 = cvt_pk_bf16(P[BASE + 2], P[BASE + 3]);   \
    unsigned b0 = cvt_pk_bf16(P[BASE + 4], P[BASE + 5]), b1 = cvt_pk_bf16(P[BASE + 6], P[BASE + 7]);                              \
    auto r0 = __builtin_amdgcn_permlane32_swap(a0, b0, false, false); auto r1 = __builtin_amdgcn_permlane32_swap(a1, b1, false, false); \
    v4u w = {r0[0], r1[0], r0[1], r1[1]}; OUT = __builtin_bit_cast(bf16x8, w); } while (0)
  PK4(p0, 0, pa0); PK4(p0, 8, pa1); PK4(p1, 0, pa2); PK4(p1, 8, pa3);
#undef PK4
}
__device__ __forceinline__ float swap_add(float v) { auto rr = __builtin_amdgcn_permlane32_swap(__float_as_uint(v), __float_as_uint(v), false, false); return __uint_as_float(rr[0]) + __uint_as_float(rr[1]); }

__device__ __forceinline__ void mlstm_seq(int seq, unsigned char* ws, char* lds) {
  int tid = threadIdx.x; asm volatile("" : "+v"(tid));
  const int wid = __builtin_amdgcn_readfirstlane(tid >> 6), lane = tid & 63, r32 = lane & 31, hi = lane >> 5, rb = wid >> 2, cb = wid & 3;
  const int dir = seq & 1, h = (seq >> 1) & 3, b = seq >> 3;
  const bf16* QC = (const bf16*)(ws + WS_QC); const bf16* KC = (const bf16*)(ws + WS_KC); const bf16* P = (const bf16*)(ws + WS_PROJ);
  const float* gs = (const float*)(ws + WS_GSC) + (size_t)seq * 3 * SEQ; const float* dec = (const float*)(ws + WS_DEC) + seq * 128;
  bf16* H = (bf16*)(ws + (dir ? WS_HB : WS_HF));
  float* sc_alpha = (float*)(lds + OFF_SC); float* sc_a = sc_alpha + 64; float* sc_iw = sc_alpha + 128; float* sc_en = sc_alpha + 192;
  float* nbuf = (float*)(lds + OFF_NB); float* npart = (float*)(lds + OFF_NP);
  float* ch_mprev = (float*)(lds + OFF_CH); float* ch_mnew = ch_mprev + 64; float* ch_dec = ch_mprev + 128; float* ch_g = ch_mprev + 192;
  float* wsf = (float*)(lds + OFF_WS) + wid * 32;
  const int ldsb = (int)(uintptr_t)lds;
  if (tid < 64) {
    if (tid == 0) { float m = 0.f; for (int c = 0; c < 64; ++c) { const float g = dec[c], wm = dec[64 + c]; const float mn = fmaxf(g + m, g + wm); ch_mprev[c] = m; ch_mnew[c] = mn; ch_dec[c] = __expf(g + m - mn); ch_g[c] = g; m = mn; } } }
  for (int i = tid; i < 32768 / 16; i += NTHR) ((v4u*)(lds + OFF_CT))[i] = (v4u){0u, 0u, 0u, 0u};
  if (tid < 128) nbuf[tid] = 0.f;
  f32x16 cacc[2]; cacc[0] = f32x16{}; cacc[1] = f32x16{};
  __syncthreads();
  const int sr = tid >> 4, sc = (tid & 15) * 8;
  v4u gq0, gq1, gk0, gk1, gv0, gv1; float ga0, ga1, sb = 0.f, sa = 0.f, spm = 0.f;
#define ROWOF(p) ((size_t)b * SEQ + (dir ? (SEQ - 1 - (p)) : (p)))
#define LOADC(c) do { const int p0_ = 64 * (c) + sr, p1_ = p0_ + 32; const size_t r0_ = ROWOF(p0_), r1_ = ROWOF(p1_); \
    gq0 = *(const v4u*)(QC + r0_ * 512 + h * 128 + sc); gq1 = *(const v4u*)(QC + r1_ * 512 + h * 128 + sc); \
    gk0 = *(const v4u*)(KC + r0_ * 512 + h * 128 + sc); gk1 = *(const v4u*)(KC + r1_ * 512 + h * 128 + sc); \
    gv0 = *(const v4u*)(P + r0_ * PROJ_LD + 1024 + h * 128 + sc); gv1 = *(const v4u*)(P + r1_ * PROJ_LD + 1024 + h * 128 + sc); \
    ga0 = gs[SEQ + p0_]; ga1 = gs[SEQ + p1_]; \
    if (tid < 64) { sb = gs[64 * (c) + tid]; sa = gs[SEQ + 64 * (c) + tid]; spm = gs[2 * SEQ + 64 * (c) + tid]; } } while (0)
#define WRITEC(c) do { \
    *(v4u*)(lds + OFF_QS + KSWZ(sr, sc * 2)) = gq0; *(v4u*)(lds + OFF_QS + KSWZ(32 + sr, sc * 2)) = gq1; \
    *(v4u*)(lds + OFF_KS + KSWZ(sr, sc * 2)) = gk0; *(v4u*)(lds + OFF_KS + KSWZ(32 + sr, sc * 2)) = gk1; \
    *(v4u*)(lds + OFF_VV + v_st(sr, sc)) = gv0; *(v4u*)(lds + OFF_VV + v_st(32 + sr, sc)) = gv1; \
    { const float gc_ = ch_g[c], mn_ = ch_mnew[c]; const float w0_ = __expf(gc_ + ga0 - mn_), w1_ = __expf(gc_ + ga1 - mn_); float f0_[8], f1_[8], cs_[8]; unpack8(gk0, f0_); unpack8(gk1, f1_); \
      _Pragma("unroll") for (int j = 0; j < 8; ++j) { f0_[j] *= w0_; f1_[j] *= w1_; cs_[j] = f0_[j] + f1_[j]; } \
      *(v4u*)(lds + OFF_KP + v_st(sr, sc)) = pack8(f0_); *(v4u*)(lds + OFF_KP + v_st(32 + sr, sc)) = pack8(f1_); \
      _Pragma("unroll") for (int j = 0; j < 8; ++j) { cs_[j] += __shfl_xor(cs_[j], 16); cs_[j] += __shfl_xor(cs_[j], 32); } \
      if ((lane >> 4) == 0) { _Pragma("unroll") for (int j = 0; j < 8; ++j) npart[wid * 128 + sc + j] = cs_[j]; } } \
    if (tid < 64) { const float m_ = ch_mprev[c]; const float mt_ = fmaxf(sb + m_, sb + spm); sc_alpha[tid] = sb - mt_; sc_a[tid] = sa; sc_iw[tid] = __expf(sb + m_ - mt_); sc_en[tid] = __expf(-mt_); } } while (0)
  LOADC(0); WRITEC(0);
  __syncthreads();
  for (int c = 0; c < 64; ++c) {
    if (c + 1 < 64) LOADC(c + 1);
    const float* nb = nbuf + (c & 1) * 128;
    if (tid < 128) { float s = 0.f;
#pragma unroll
      for (int w = 0; w < 8; ++w) s += npart[w * 128 + tid];
      nbuf[((c + 1) & 1) * 128 + tid] = ch_dec[c] * nb[tid] + s; }
    bf16x8 qr[8];
#pragma unroll
    for (int d0 = 0; d0 < 8; ++d0) qr[d0] = *(const bf16x8*)(lds + OFF_QS + KSWZ(32 * rb + r32, (16 * d0 + 8 * hi) * 2));
    f32x16 p0 = f32x16{}, p1 = f32x16{};
#pragma unroll
    for (int d0 = 0; d0 < 8; ++d0) { const bf16x8 k0 = *(const bf16x8*)(lds + OFF_KS + KSWZ(r32, (16 * d0 + 8 * hi) * 2)); p0 = __builtin_amdgcn_mfma_f32_32x32x16_bf16(k0, qr[d0], p0, 0, 0, 0); }
    if (rb == 1) {
#pragma unroll
      for (int d0 = 0; d0 < 8; ++d0) { const bf16x8 k1 = *(const bf16x8*)(lds + OFF_KS + KSWZ(32 + r32, (16 * d0 + 8 * hi) * 2)); p1 = __builtin_amdgcn_mfma_f32_32x32x16_bf16(k1, qr[d0], p1, 0, 0, 0); }
    }
    const float al = sc_alpha[32 * rb + r32];
    if (rb == 0) {
#pragma unroll
      for (int r = 0; r < 16; ++r) { const int sl = crow(r, hi); p0[r] = (sl <= r32) ? __expf(al + sc_a[sl]) * p0[r] : 0.f; }
    } else {
#pragma unroll
      for (int r = 0; r < 16; ++r) { const int sl = crow(r, hi); p0[r] = __expf(al + sc_a[sl]) * p0[r]; p1[r] = (sl <= r32) ? __expf(al + sc_a[32 + sl]) * p1[r] : 0.f; }
    }
    float ps = 0.f;
#pragma unroll
    for (int r = 0; r < 16; ++r) ps += p0[r] + p1[r];
    ps = swap_add(ps);
    bf16x8 pa0, pa1, pa2, pa3; pack_p(p0, p1, pa0, pa1, pa2, pa3);
    float qn = 0.f;
#pragma unroll
    for (int d0 = 0; d0 < 8; ++d0) { const f32x4 n0 = *(const f32x4*)(nb + 16 * d0 + 8 * hi), n1 = *(const f32x4*)(nb + 16 * d0 + 8 * hi + 4); const v4u qw = __builtin_bit_cast(v4u, qr[d0]);
      qn += bflo(qw.x) * n0.x + bfhi(qw.x) * n0.y + bflo(qw.y) * n0.z + bfhi(qw.y) * n0.w + bflo(qw.z) * n1.x + bfhi(qw.z) * n1.y + bflo(qw.w) * n1.z + bfhi(qw.w) * n1.w; }
    qn = swap_add(qn);
    { const float iwt = sc_iw[32 * rb + r32]; const float den = iwt * qn + ps; const float rd = 1.f / fmaxf(fabsf(den), sc_en[32 * rb + r32]); if (hi == 0) wsf[r32] = rd; }
    f32x16 o = f32x16{};
#pragma unroll
    for (int d0 = 0; d0 < 8; ++d0) { const bf16x8 cf = *(const bf16x8*)(lds + OFF_CT + KSWZ(32 * cb + r32, (16 * d0 + 8 * hi) * 2)); o = __builtin_amdgcn_mfma_f32_32x32x16_bf16(qr[d0], cf, o, 0, 0, 0); }
#pragma unroll
    for (int r = 0; r < 16; ++r) o[r] *= sc_iw[32 * rb + crow(r, hi)];
    bf16x8 vf[4]; vfrags(ldsb + OFF_VV, cb, lane, vf);
    o = __builtin_amdgcn_mfma_f32_32x32x16_bf16(pa0, vf[0], o, 0, 0, 0); o = __builtin_amdgcn_mfma_f32_32x32x16_bf16(pa1, vf[1], o, 0, 0, 0);
    if (rb == 1) { o = __builtin_amdgcn_mfma_f32_32x32x16_bf16(pa2, vf[2], o, 0, 0, 0); o = __builtin_amdgcn_mfma_f32_32x32x16_bf16(pa3, vf[3], o, 0, 0, 0); }
    asm volatile("s_waitcnt lgkmcnt(0)" ::: "memory");
#pragma unroll
    for (int r = 0; r < 16; ++r) { const int tl = crow(r, hi); const int p = 64 * c + 32 * rb + tl; H[ROWOF(p) * 512 + h * 128 + 32 * cb + r32] = (bf16)f2bf(o[r] * wsf[tl]); }
    { const float dc = ch_dec[c];
#pragma unroll
      for (int i = 0; i < 2; ++i) { bf16x8 kf[4]; vfrags(ldsb + OFF_KP, 2 * rb + i, lane, kf);
#pragma unroll
        for (int r = 0; r < 16; ++r) cacc[i][r] *= dc;
#pragma unroll
        for (int ks = 0; ks < 4; ++ks) cacc[i] = __builtin_amdgcn_mfma_f32_32x32x16_bf16(kf[ks], vf[ks], cacc[i], 0, 0, 0); } }
    __syncthreads();
#pragma unroll
    for (int i = 0; i < 2; ++i)
#pragma unroll
      for (int g = 0; g < 4; ++g) { const int d = 32 * (2 * rb + i) + 8 * g + 4 * hi, e = 32 * cb + r32;
        v2u w; w.x = cvt_pk_bf16(cacc[i][4 * g], cacc[i][4 * g + 1]); w.y = cvt_pk_bf16(cacc[i][4 * g + 2], cacc[i][4 * g + 3]);
        *(v2u*)(lds + OFF_CT + KSWZ(e, d * 2)) = w; }
    if (c + 1 < 64) WRITEC(c + 1);
    __syncthreads();
  }
#undef ROWOF
#undef LOADC
#undef WRITEC
}
#undef KSWZ
#undef PKF
}

__device__ __forceinline__ void p3_mixers(Frame& F, const Args& a, char* lds_generic, unsigned xcc, int qoff) {
#ifndef DRY_MODE
#define DRY_MODE 0
#endif
  bool did_mlstm = false;
  if (!(qoff && DRY_MODE == 2))
  for (;;) { const int it = queue_pull(F, F.ctl + CW_Q + qoff + 64 * 8, 8, 4, (int)(xcc & 7u)); if (it < 0) break; mls::mlstm_seq(it, F.ws, lds_generic); __syncthreads();  }
  if (!(qoff && DRY_MODE == 1))
  p3_attention(F, a, lds_generic, xcc, qoff);
#ifndef P3_FILL_CHUNKS
#define P3_FILL_CHUNKS 14
#endif
  if (!qoff && !did_mlstm) conv_fill(F, a, P3_FILL_CHUNKS);
}
__device__ __forceinline__ void p4_combine(Frame& F, const Args& a) {
  unsigned char* ws = F.ws; const bf16* HF = (const bf16*)(ws + WS_HF); const bf16* HB = (const bf16*)(ws + WS_HB); const bf16* P = (const bf16*)(ws + WS_PROJ); bf16* Y = (bf16*)(ws + WS_Y);
  const float* g = (const float*)a.in[I_GHM];
  const int gw = F.vcu * NWAVES + F.wave, NGW = F.G * NWAVES, c = F.lane * 8;
  float gg[8];
#pragma unroll
  for (int j = 0; j < 8; ++j) gg[j] = g[c + j];
  for (int m = gw; m < MTOK; m += NGW) {
    float f[8], bb[8], oo[8]; unpack8(*(const v4u*)(HF + (size_t)m * 512 + c), f); unpack8(*(const v4u*)(HB + (size_t)m * 512 + c), bb); unpack8(*(const v4u*)(P + (size_t)m * PROJ_LD + 1536 + c), oo);
    float s = 0.f;
#pragma unroll
    for (int j = 0; j < 8; ++j) { f[j] += bb[j]; s += f[j] * f[j]; }
    s += __shfl_xor(s, 1); s += __shfl_xor(s, 2); s += __shfl_xor(s, 4); s += __shfl_xor(s, 8);
    const float r = rsqrtf(s * (1.f / 128.f) + 1e-6f);
#pragma unroll
    for (int j = 0; j < 8; ++j) f[j] = f[j] * r * gg[j] * sigmoidf_(oo[j]);
    *(v4u*)(Y + (size_t)m * 1024 + c) = pack8(f);
  }
}
struct EpiResid { static constexpr bool TWO_PASS = false; const float* base; float* out; bf16* outb; float* ss; int doq; unsigned char* outq;
  __device__ __forceinline__ void row8(const pg8::Unit& u, int rloc, int cloc, const float (&a0)[8], const float (&a1)[8], int fq) const {
    const int row = u.pm * 256 + rloc; const size_t off = (size_t)row * 1024 + u.pn * 256 + cloc;
    const f32x4 b0 = *(const f32x4*)(base + off), b1 = *(const f32x4*)(base + off + 4), b2 = *(const f32x4*)(base + off + 128), b3 = *(const f32x4*)(base + off + 132);
    float v0[8], v1[8];
#pragma unroll
    for (int i = 0; i < 4; ++i) { v0[i] = a0[i] + b0[i]; v0[4 + i] = a0[4 + i] + b1[i]; v1[i] = a1[i] + b2[i]; v1[4 + i] = a1[4 + i] + b3[i]; }
    *(f32x4*)(out + off) = (f32x4){v0[0], v0[1], v0[2], v0[3]}; *(f32x4*)(out + off + 4) = (f32x4){v0[4], v0[5], v0[6], v0[7]};
    *(f32x4*)(out + off + 128) = (f32x4){v1[0], v1[1], v1[2], v1[3]}; *(f32x4*)(out + off + 132) = (f32x4){v1[4], v1[5], v1[6], v1[7]};
    float s = sumsq8(v0) + sumsq8(v1);
    if (doq) {
#pragma unroll
      for (int i = 0; i < 8; ++i) { v0[i] = q8(v0[i], 1.f); v1[i] = q8(v1[i], 1.f); } }
    *(v4u*)(outb + off) = pack8(v0); *(v4u*)(outb + off + 128) = pack8(v1); s += __shfl_xor(s, 16); s += __shfl_xor(s, 32); if (fq == 0) unsafeAtomicAdd(ss + row, s); } };
struct EpiScale { static constexpr bool TWO_PASS = false; bf16* O; const float* ss;
  __device__ __forceinline__ void row8(const pg8::Unit& u, int rloc, int cloc, const float (&a0)[8], const float (&a1)[8], int fq) const {
    const int row = u.pm * 256 + rloc; const float r = rsqrtf(ss[row] * (1.f / 1024.f) + 1e-6f); float v0[8], v1[8];
#pragma unroll
    for (int i = 0; i < 8; ++i) { v0[i] = a0[i] * r; v1[i] = a1[i] * r; }
    bf16* p = O + (size_t)row * 1024 + u.pn * 256 + cloc; *(v4u*)p = pack8(v0); *(v4u*)(p + 128) = pack8(v1); } };
struct EpiSoftmax { static constexpr bool TWO_PASS = true; bf16* O; float scale; LAS float* xch;
  __device__ __forceinline__ void pass1(const pg8::Unit& u, int rloc, int wc, float (&v0)[8], float (&v1)[8], int fq) const {
    float mx = -3.0e38f;
#pragma unroll
    for (int i = 0; i < 8; ++i) { v0[i] *= scale; v1[i] *= scale; mx = fmaxf(mx, fmaxf(v0[i], v1[i])); }
    mx = fmaxf(mx, __shfl_xor(mx, 16)); mx = fmaxf(mx, __shfl_xor(mx, 32));
    float l = 0.f;
#pragma unroll
    for (int i = 0; i < 8; ++i) { v0[i] = __expf(v0[i] - mx); v1[i] = __expf(v1[i] - mx); l += v0[i] + v1[i]; }
    l += __shfl_xor(l, 16); l += __shfl_xor(l, 32);
    if (fq == 0) { xch[(rloc * 4 + wc) * 2] = mx; xch[(rloc * 4 + wc) * 2 + 1] = l; } }
  __device__ __forceinline__ void row8(const pg8::Unit& u, int rloc, int cloc, const float (&a0)[8], const float (&a1)[8], int fq) const {
    const int wc = cloc >> 5; float m[4], l[4]; float M = -3.0e38f;
#pragma unroll
    for (int w = 0; w < 4; ++w) { m[w] = xch[(rloc * 4 + w) * 2]; l[w] = xch[(rloc * 4 + w) * 2 + 1]; M = fmaxf(M, m[w]); }
    float L = 0.f, mine = 0.f;
#pragma unroll
    for (int w = 0; w < 4; ++w) { const float e = __expf(m[w] - M); L += l[w] * e; if (w == wc) mine = e; }
    const float f = mine / L; float v0[8], v1[8];
#pragma unroll
    for (int i = 0; i < 8; ++i) { v0[i] = a0[i] * f; v1[i] = a1[i] * f; }
    bf16* p = O + (size_t)(u.pm * 256 + rloc) * 1024 + u.pn * 256 + cloc; *(v4u*)p = pack8(v0); *(v4u*)(p + 128) = pack8(v1); } };
struct MemOrder { int G, c, kind;
  __device__ bool next(int i, pg8::Unit& u) const { const int L = i * G + c; if (L >= 256) return false;
    const int bh = L >> 4, t = L & 15, b = bh >> 2, h = bh & 3;
    u.pm = b * 16 + t; u.pn = h; u.g = 0; u.ibase = 0; u.aoff = ((long)(b * SEQ + t * 256)) * 1024 + h * 256;
    u.boff = kind == 0 ? ((long)(b * NMEM)) * 1024 + h * 256 : ((long)(h * 256)) * 1024 + b * NMEM; return true; } };
constexpr size_t WS_WRG = WS_DEC + 65536;
constexpr size_t WS_ROWSEL = WS_SEL, WS_GSEL = WS_SEL + 131072, WS_INV = 31 * MiB, WS_YE = 160 * MiB;
typedef float f32x4m __attribute__((ext_vector_type(4)));
__device__ __forceinline__ void p10_router(Frame& F, const Args& a) {
  unsigned char* ws = F.ws; const float* X2 = (const float*)(ws + WS_X2); const float* ss2 = (const float*)(ws + CTL_SS2); float* AFF = (float*)(ws + WS_AFF); const float* WRG = (const float*)(ws + WS_WRG);
  const int gw = F.vcu * NWAVES + F.wave, NGW = F.G * NWAVES, r = F.lane & 15, kq = F.lane >> 4;
  LAS float* wl = (LAS float*)F.lds;
  for (int i = F.tid; i < 4096; i += NTHR) ((LAS f32x4*)wl)[i] = ((const f32x4*)WRG)[i];
  __syncthreads();
  for (int it = gw; it < MTOK / 16; it += NGW) { const int m0 = it * 16;
    const float* xp = X2 + (size_t)(m0 + r) * 1024 + 4 * kq; const LAS float* wp = wl + (4 * kq) * 16 + r;
    f32x4m acc0 = {0.f, 0.f, 0.f, 0.f}, acc1 = {0.f, 0.f, 0.f, 0.f};
#pragma unroll 1
    for (int hf = 0; hf < 2; ++hf) {
      f32x4 xv[32];
#pragma unroll
      for (int j = 0; j < 32; ++j) xv[j] = *(const f32x4*)(xp + 16 * (32 * hf + j));
#pragma unroll
      for (int j = 0; j < 32; j += 2) { const LAS float* w0 = wp + (16 * (32 * hf + j)) * 16; const LAS float* w1 = w0 + 256;
        acc0 = __builtin_amdgcn_mfma_f32_16x16x4f32(xv[j].x, w0[0], acc0, 0, 0, 0); acc1 = __builtin_amdgcn_mfma_f32_16x16x4f32(xv[j + 1].x, w1[0], acc1, 0, 0, 0);
        acc0 = __builtin_amdgcn_mfma_f32_16x16x4f32(xv[j].y, w0[16], acc0, 0, 0, 0); acc1 = __builtin_amdgcn_mfma_f32_16x16x4f32(xv[j + 1].y, w1[16], acc1, 0, 0, 0);
        acc0 = __builtin_amdgcn_mfma_f32_16x16x4f32(xv[j].z, w0[32], acc0, 0, 0, 0); acc1 = __builtin_amdgcn_mfma_f32_16x16x4f32(xv[j + 1].z, w1[32], acc1, 0, 0, 0);
        acc0 = __builtin_amdgcn_mfma_f32_16x16x4f32(xv[j].w, w0[48], acc0, 0, 0, 0); acc1 = __builtin_amdgcn_mfma_f32_16x16x4f32(xv[j + 1].w, w1[48], acc1, 0, 0, 0); }
    }
#pragma unroll
    for (int i = 0; i < 4; ++i) { const int row = m0 + 4 * kq + i; const float lg = (acc0[i] + acc1[i]) * rsqrtf(ss2[row] * (1.f / 1024.f) + 1e-6f);
      float mx = lg; mx = fmaxf(mx, __shfl_xor(mx, 1)); mx = fmaxf(mx, __shfl_xor(mx, 2)); mx = fmaxf(mx, __shfl_xor(mx, 4)); mx = fmaxf(mx, __shfl_xor(mx, 8));
      const float ex = __expf(lg - mx); float l = ex; l += __shfl_xor(l, 1); l += __shfl_xor(l, 2); l += __shfl_xor(l, 4); l += __shfl_xor(l, 8);
      AFF[(size_t)row * 16 + r] = ex / l; }
  }
  __syncthreads();
}
__device__ __forceinline__ void p11_topk(Frame& F, char* lds) {
  unsigned char* ws = F.ws; const float* AFF = (const float*)(ws + WS_AFF); int* ROWSEL = (int*)(ws + WS_ROWSEL); float* GSEL = (float*)(ws + WS_GSEL); int* INV = (int*)(ws + WS_INV);
  unsigned* hist = (unsigned*)lds; unsigned* ctl = hist + 256; unsigned* wsum = hist + 320;
  const int tid = F.tid, lane = F.lane, wid = F.wave;
  for (int it = (int)blockIdx.x; it < BATCH * NEXP; it += F.G) { const int b = it >> 4, e = it & 15;
    unsigned key[8];
#pragma unroll
    for (int j = 0; j < 8; ++j) key[j] = __float_as_uint(AFF[((size_t)b * SEQ + 8 * tid + j) * 16 + e]);
    unsigned prefix = 0u, mask = 0u, need = CAP;
    for (int shift = 24; shift >= 0; shift -= 8) {
      if (tid < 256) hist[tid] = 0u;
      __syncthreads();
#pragma unroll
      for (int j = 0; j < 8; ++j) if ((key[j] & mask) == prefix) atomicAdd(&hist[(key[j] >> shift) & 255u], 1u);
      __syncthreads();
      if (tid == 0) { unsigned above = 0u; int d = 255; for (; d > 0; --d) { const unsigned c = hist[d]; if (above + c >= need) break; above += c; } ctl[0] = (unsigned)d; ctl[1] = need - above; }
      __syncthreads();
      prefix |= ctl[0] << shift; mask |= 255u << shift; need = ctl[1];
      __syncthreads();
    }
    unsigned ngt = 0u, neq = 0u;
#pragma unroll
    for (int j = 0; j < 8; ++j) { ngt += key[j] > prefix ? 1u : 0u; neq += key[j] == prefix ? 1u : 0u; }
    unsigned sgt = ngt, seq_ = neq;
#pragma unroll
    for (int o = 1; o < 64; o <<= 1) { const unsigned y0 = __shfl_up(sgt, o), y1 = __shfl_up(seq_, o); if (lane >= o) { sgt += y0; seq_ += y1; } }
    if (lane == 63) { wsum[wid] = sgt; wsum[8 + wid] = seq_; }
    __syncthreads();
    unsigned bgt = 0u, beq = 0u, tgt = 0u;
#pragma unroll
    for (int w = 0; w < 8; ++w) { const unsigned g = wsum[w], q = wsum[8 + w]; if (w < wid) { bgt += g; beq += q; } tgt += g; }
    unsigned pgt = bgt + sgt - ngt, peq = beq + seq_ - neq;
#pragma unroll
    for (int j = 0; j < 8; ++j) { const int t = 8 * tid + j; int slot = -1;
      if (key[j] > prefix) slot = (int)pgt++; else if (key[j] == prefix) { if (peq < need) slot = (int)(tgt + peq); ++peq; }
      INV[((size_t)b * SEQ + t) * 16 + e] = slot;
      if (slot >= 0) { ROWSEL[e * 2048 + b * 512 + slot] = b * SEQ + t; GSEL[e * 2048 + b * 512 + slot] = __uint_as_float(key[j]); } }
    __syncthreads();
  }
}
#ifndef GU_ORDER
#define GU_ORDER 1
#endif
#ifndef DN_ORDER
#define DN_ORDER 1
#endif
struct MoeGUOrder { int G, c;
  __device__ bool next(int i, pg8::Unit& u) const { const int L = i * G + c; if (L >= 2048) return false;
#if GU_ORDER == 0
    const int e = L >> 7, r = L & 127, pn = r >> 3, mt = r & 7;
#elif GU_ORDER == 1
    const int e = L >> 7, r = L & 127, mt = r >> 4, pn = r & 15;
#else
    const int x = c & 7, j = c >> 3, e = (i >> 2) * 8 + x, r = (i & 3) * 32 + j, mt = r >> 4, pn = r & 15;
#endif
    u.g = e; u.pm = mt; u.pn = pn; u.ibase = e * 2048 + mt * 256; u.aoff = MOE_FP8 ? ((long)e * 2048 + mt * 256) * 512 : 0; u.boff = ((long)e * 4096 + pn * 256) * (MOE_FP8 ? 512 : 1024); return true; } };
struct MoeDownOrder { int G, c;
  __device__ bool next(int i, pg8::Unit& u) const { const int L = i * G + c; if (L >= 512) return false;
#if DN_ORDER == 0
    const int e = L >> 5, r = L & 31, pn = r >> 3, mt = r & 7;
#else
    const int x = c & 7, j = c >> 3, e = i * 8 + x, pn = j >> 3, mt = j & 7;
#endif
    u.g = e; u.pm = mt; u.pn = pn; u.ibase = e * 2048 + mt * 256; u.aoff = ((long)e * 2048 + mt * 256) * (MOE_FP8_DOWN ? 1024 : 2048); u.boff = ((long)e * 1024 + pn * 256) * (MOE_FP8_DOWN ? 1024 : 2048); return true; } };
struct EpiGU { static constexpr bool TWO_PASS = false; bf16* H; const float* ss2; const int* rowsel;
  __device__ __forceinline__ void row8(const pg8::Unit& u, int rloc, int cloc, const float (&a0)[8], const float (&a1)[8], int fq) const {
    const int tok = rowsel[u.ibase + rloc]; const float r = rsqrtf(ss2[tok] * (1.f / 1024.f) + 1e-6f); float h[8];
#pragma unroll
    for (int i = 0; i < 8; ++i) { const float g = a0[i] * r, up = a1[i] * r; h[i] = g * sigmoidf_(g) * up; if (FP8EMU) h[i] = q8(h[i], 8.f); }
#if MOE_FP8_DOWN
    *(v2u*)((unsigned char*)H + ((size_t)u.g * 2048 + u.pm * 256 + rloc) * 2048 + u.pn * 128 + cloc) = pack8_fp8(h, 8.f); } };
#else
    *(v4u*)(H + ((size_t)u.g * 2048 + u.pm * 256 + rloc) * 2048 + u.pn * 128 + cloc) = pack8(h); } };
#endif
struct EpiGU8 { static constexpr bool TWO_PASS = false; unsigned char* H8; const float* ss2; const int* rowsel;
  __device__ __forceinline__ void row8(const pg8::Unit& u, int rloc, int cloc, const float (&a0)[8], const float (&a1)[8], int fq) const {
    const int tok = rowsel[u.ibase + rloc]; const float r = rsqrtf(ss2[tok] * (1.f / 1024.f) + 1e-6f); float h[8];
#pragma unroll
    for (int i = 0; i < 8; ++i) { const float g = a0[i] * r, up = a1[i] * r; h[i] = g * sigmoidf_(g) * up; }
#if MOE_FP8_DOWN
    *(v2u*)(H8 + ((size_t)u.g * 2048 + u.pm * 256 + rloc) * 2048 + u.pn * 128 + cloc) = pack8_fp8(h, 8.f); } };
#else
    *(v4u*)((bf16*)H8 + ((size_t)u.g * 2048 + u.pm * 256 + rloc) * 2048 + u.pn * 128 + cloc) = pack8(h); } };
#endif
struct EpiYE { static constexpr bool TWO_PASS = false; bf16* Yp; const float* gsel;
  __device__ __forceinline__ void row8(const pg8::Unit& u, int rloc, int cloc, const float (&a0)[8], const float (&a1)[8], int fq) const {
    const float gv = gsel[u.ibase + rloc]; float v0[8], v1[8];
#pragma unroll
    for (int i = 0; i < 8; ++i) { v0[i] = a0[i] * gv; v1[i] = a1[i] * gv; }
    bf16* p = Yp + ((size_t)u.g * 2048 + u.pm * 256 + rloc) * 1024 + u.pn * 256 + cloc; *(v4u*)p = pack8(v0); *(v4u*)(p + 128) = pack8(v1); } };
__device__ __forceinline__ void p14_final(Frame& F, const Args& a) {
  unsigned char* ws = F.ws; const float* X2 = (const float*)(ws + WS_X2); const int* INV = (const int*)(ws + WS_INV); const bf16* YE = (const bf16*)(ws + WS_YE);
  const float* gfin = (const float*)a.in[I_GFIN]; float* out = a.out;
  const int gw = F.vcu * NWAVES + F.wave, NGW = F.G * NWAVES;
  for (int m = gw; m < MTOK; m += NGW) { const int b = m >> 12;
    f32x4 v[4];
#pragma unroll
    for (int j = 0; j < 4; ++j) v[j] = *(const f32x4*)(X2 + (size_t)m * 1024 + 256 * j + 4 * F.lane);
    const int myinv = F.lane < 16 ? INV[(size_t)m * 16 + F.lane] : -1;
#pragma unroll
    for (int e = 0; e < 16; ++e) { const int slot = __shfl(myinv, e);
      if (slot >= 0) { const bf16* yr = YE + ((size_t)e * 2048 + b * 512 + slot) * 1024 + 4 * F.lane;
#pragma unroll
        for (int j = 0; j < 4; ++j) { const v2u w = *(const v2u*)(yr + 256 * j); v[j].x += bflo(w.x); v[j].y += bfhi(w.x); v[j].z += bflo(w.y); v[j].w += bfhi(w.y); } } }
    float s = 0.f;
#pragma unroll
    for (int j = 0; j < 4; ++j) s += (v[j].x * v[j].x + v[j].y * v[j].y) + (v[j].z * v[j].z + v[j].w * v[j].w);
    const float r = rsqrtf(wave_sum(s) * (1.f / 1024.f) + 1e-6f);
#pragma unroll
    for (int j = 0; j < 4; ++j) { const f32x4 g = *(const f32x4*)(gfin + 256 * j + 4 * F.lane); *(f32x4*)(out + (size_t)m * 1024 + 256 * j + 4 * F.lane) = v[j] * r * g; }
  }
}
__global__ void __launch_bounds__(NTHR, 2) mk(Args a) {
  extern __shared__ __attribute__((aligned(16))) unsigned char lds_raw[];
  Frame F;
  F.lds = (LAS unsigned char*)lds_raw; F.MISC = (volatile LAS unsigned*)(F.lds + LDSCTL_OFF + 320);
  F.tid = threadIdx.x; F.lane = F.tid & 63; F.wave = __builtin_amdgcn_readfirstlane(F.tid >> 6);
  F.G = gridDim.x; { const int bx = blockIdx.x; F.vcu = (F.G % 8 == 0) ? (bx % 8) * (F.G / 8) + bx / 8 : bx; }
  F.ws = a.ws; F.ctl = (gu32*)(a.ws + WS_CTL);
  unsigned char* ws = a.ws;
  for (int u = F.tid; u < (LDS_BYTES - LDSCTL_OFF) / 4; u += NTHR) ((LAS unsigned*)(F.lds + LDSCTL_OFF))[u] = 0u;
  __syncthreads();
  XcdBarrier bar = xcd_barrier_post((unsigned*)(F.ctl + CW_BAR), F.MISC + 8);
  const int lo = a.ph_lo, hi = a.ph_hi;
#define IN(k) (lo <= (k) && (k) < hi)
#define BOTH(k) (IN(k) && IN((k) + 1))
#define GRID_BAR() xcd_barrier(bar)
  float* ssq = (float*)(ws + CTL_SSQ); float* sskv = (float*)(ws + CTL_SSKV);

#ifndef REP_MASK
#define REP_MASK 0
#endif
#define NREP(k) ((((REP_MASK) >> (k)) & 1) ? 2 : 1)
#define PH_BEGIN(k) if (IN(k)) { for (int rep_ = 0; rep_ < NREP(k); ++rep_) { const bool dry = rep_ + 1 < NREP(k); (void)dry;
#define PH_END(k) if (dry) GRID_BAR(); } if (BOTH(k)) GRID_BAR(); }
  float* dummy = (float*)(ws + WS_DUMMY);
  float* ss1 = (float*)(ws + CTL_SS1); float* ss2 = (float*)(ws + CTL_SS2);
#ifndef FILLMODE
#define FILLMODE 2
#endif
  PH_BEGIN(0) p0_prologue(F, a, true, FILLMODE == 0); PH_END(0)
  PH_BEGIN(1)
    { pg8::Gemm g{(const bf16*)(ws + WS_XN), (const bf16*)(ws + WS_WIN), 1024, 1024, 1024, nullptr, 127, 127}; pg8::StaticOrder S; S.init(MTOK, PROJ_LD, F.G, (int)blockIdx.x, 1024, 1024);
      EpiProj E{(bf16*)(ws + WS_PROJ), dry ? dummy : ssq, dry ? dummy + 16384 : sskv};
      pg8::gemm_phase<EpiProj, pg8::StaticOrder, false>(F.lds, g, S, E); }
    { pg8::Gemm g{(const bf16*)(ws + WS_MEMN), (const bf16*)(ws + WS_WMK), 1024, 1024, 1024, nullptr, 127, 127}; pg8::StaticOrder S; S.init(1024, 1024, F.G, (int)((blockIdx.x + 128u) % (unsigned)F.G), 1024, 1024);
      EpiStore E{(bf16*)(ws + WS_KMEM), 1024};
      pg8::gemm_phase<EpiStore, pg8::StaticOrder, false>(F.lds, g, S, E); }
    { pg8::Gemm g{(const bf16*)(ws + WS_WMV), (const bf16*)(ws + WS_MEMN), 1024, 1024, 1024, nullptr, 127, 127}; pg8::StaticOrder S; S.init(1024, 1024, F.G, (int)((blockIdx.x + 112u) % (unsigned)F.G), 1024, 1024);
      EpiStore E{(bf16*)(ws + WS_VMEMT), 1024};
      pg8::gemm_phase<EpiStore, pg8::StaticOrder, false>(F.lds, g, S, E); }
  PH_END(1)
  PH_BEGIN(2)
    { pg8::Gemm g{(const bf16*)(ws + WS_PROJ) + PC_CQ, (const bf16*)(ws + WS_WQB), PROJ_LD, 256, 256, nullptr, 127, 127}; pg8::StaticOrder S; S.init(MTOK, 768, F.G, (int)blockIdx.x, PROJ_LD, 256);
      EpiQ E{(bf16*)(ws + WS_QM), ssq, (const float*)(ws + WS_ROPE)};
      pg8::gemm_phase<EpiQ, pg8::StaticOrder, false>(F.lds, g, S, E); }
    { pg8::Gemm g{(const bf16*)(ws + WS_PROJ) + PC_CKV, (const bf16*)(ws + WS_WKVB), PROJ_LD, 256, 256, nullptr, 127, 127}; pg8::StaticOrder S; S.init(MTOK, 1024, F.G, (int)((blockIdx.x + 64u) % (unsigned)F.G), PROJ_LD, 256);
      EpiKV E{(bf16*)(ws + WS_KM), (bf16*)(ws + WS_VM), sskv};
      pg8::gemm_phase<EpiKV, pg8::StaticOrder, false>(F.lds, g, S, E); }
    p2_elementwise(F, a);
  PH_END(2)
  PH_BEGIN(3) p3_mixers(F, a, (char*)lds_raw, bar.x, dry ? 64 * 16 : 0); PH_END(3)
  PH_BEGIN(4) p4_combine(F, a); PH_END(4)
  PH_BEGIN(5)
    pg8::Gemm g{(const bf16*)(ws + WS_Y), (const bf16*)(ws + WS_WOUT), 1024, 1024, 1024, nullptr, 127, 127}; pg8::StaticOrder S; S.init(MTOK, 1024, F.G, (int)blockIdx.x, 1024, 1024);
    EpiResid E{(const float*)a.in[I_X], (float*)(ws + WS_X1), (bf16*)(ws + WS_X1B), dry ? dummy : ss1, 0, nullptr};
    pg8::gemm_phase<EpiResid, pg8::StaticOrder, false>(F.lds, g, S, E);
  PH_END(5)
  PH_BEGIN(6)
    pg8::Gemm g{(const bf16*)(ws + WS_X1B), (const bf16*)(ws + WS_WMQ), 1024, 1024, 1024, nullptr, 127, 127}; pg8::StaticOrder S; S.init(MTOK, 1024, F.G, (int)blockIdx.x, 1024, 1024);
    EpiScale E{(bf16*)(ws + WS_QMEM), ss1};
    pg8::gemm_phase<EpiScale, pg8::StaticOrder, false>(F.lds, g, S, E);
  PH_END(6)
  PH_BEGIN(7)
    pg8::Gemm g{(const bf16*)(ws + WS_QMEM), (const bf16*)(ws + WS_KMEM), 1024, 1024, 256, nullptr, 127, 127}; MemOrder S{F.G, (int)blockIdx.x, 0};
    EpiSoftmax E{(bf16*)(ws + WS_P), 0.0625f, (LAS float*)(F.lds + LDSCTL_OFF + 1024)};
    pg8::gemm_phase<EpiSoftmax, MemOrder, false>(F.lds, g, S, E);
  PH_END(7)
  PH_BEGIN(8)
    pg8::Gemm g{(const bf16*)(ws + WS_P), (const bf16*)(ws + WS_VMEMT), 1024, 1024, 256, nullptr, 127, 127}; MemOrder S{F.G, (int)blockIdx.x, 1};
    EpiStore E{(bf16*)(ws + WS_MO), 1024};
    pg8::gemm_phase<EpiStore, MemOrder, false>(F.lds, g, S, E);
  PH_END(8)
  PH_BEGIN(9)
    pg8::Gemm g{(const bf16*)(ws + WS_MO), (const bf16*)(ws + WS_WMO), 1024, 1024, 1024, nullptr, 127, 127}; pg8::StaticOrder S; S.init(MTOK, 1024, F.G, (int)blockIdx.x, 1024, 1024);
    EpiResid E{(const float*)(ws + WS_X1), (float*)(ws + WS_X2), (bf16*)(ws + WS_X2B), dry ? dummy : ss2, FP8EMU, nullptr};
    pg8::gemm_phase<EpiResid, pg8::StaticOrder, false>(F.lds, g, S, E);
  PH_END(9)
  PH_BEGIN(10) p10_router(F, a); PH_END(10)
  PH_BEGIN(11) p11_topk(F, (char*)lds_raw);
    if (!dry && FILLMODE != 0) conv_fill(F, a, 1 << 30);
  PH_END(11)
  PH_BEGIN(12)
#if MOE_FP8
    {
      const int gw = F.vcu * NWAVES + F.wave, NGW = F.G * NWAVES; const int* rs = (const int*)(ws + WS_ROWSEL);
      for (int r = gw; r < NEXP * 2048; r += NGW) { const int tok = rs[r]; const float* xr = (const float*)(ws + WS_X2) + (size_t)tok * 1024 + F.lane * 16;
        const f32x4 q0 = *(const f32x4*)xr, q1 = *(const f32x4*)(xr + 4), q2 = *(const f32x4*)(xr + 8), q3 = *(const f32x4*)(xr + 12);
        const float lo[8] = {q0.x, q0.y, q0.z, q0.w, q1.x, q1.y, q1.z, q1.w}, hi[8] = {q2.x, q2.y, q2.z, q2.w, q3.x, q3.y, q3.z, q3.w};
        const v2u a8 = pack8_fp8(lo, 1.f), b8 = pack8_fp8(hi, 1.f); v4u o; o.x = a8.x; o.y = a8.y; o.z = b8.x; o.w = b8.y;
        *(v4u*)(ws + WS_XG + (size_t)r * 1024 + F.lane * 16) = o; }
      GRID_BAR(); }
    pg8::Gemm g{(const bf16*)(ws + WS_XG), (const bf16*)(ws + WS_WEGU8), 512, 512, 512, nullptr, 127, 121}; MoeGUOrder S{F.G, (int)blockIdx.x};
    EpiGU8 E{(unsigned char*)(ws + WS_HID8), ss2, (const int*)(ws + WS_ROWSEL)};
    pg8::gemm_phase<EpiGU8, MoeGUOrder, false, 1>(F.lds, g, S, E);
#else
    pg8::Gemm g{(const bf16*)(ws + WS_X2B), (const bf16*)(ws + WS_WEGU), 1024, 1024, 1024, (const int*)(ws + WS_ROWSEL), 127, 127}; MoeGUOrder S{F.G, (int)blockIdx.x};
    EpiGU E{(bf16*)(ws + WS_HID), ss2, (const int*)(ws + WS_ROWSEL)};
    pg8::gemm_phase<EpiGU, MoeGUOrder, true>(F.lds, g, S, E);
#endif
  PH_END(12)
  PH_BEGIN(13)
#if MOE_FP8_DOWN
    pg8::Gemm g{(const bf16*)(ws + WS_HID8), (const bf16*)(ws + WS_WED8), 1024, 1024, 1024, nullptr, 124, 121}; MoeDownOrder S{F.G, (int)blockIdx.x};
    EpiYE E{(bf16*)(ws + WS_YE), (const float*)(ws + WS_GSEL)};
    pg8::gemm_phase<EpiYE, MoeDownOrder, false, 1>(F.lds, g, S, E);
#else
    pg8::Gemm g{(const bf16*)(ws + WS_HID), (const bf16*)(ws + WS_WED), 2048, 2048, 2048, nullptr, 127, 127}; MoeDownOrder S{F.G, (int)blockIdx.x};
    EpiYE E{(bf16*)(ws + WS_YE), (const float*)(ws + WS_GSEL)};
    pg8::gemm_phase<EpiYE, MoeDownOrder, false>(F.lds, g, S, E);
#endif
  PH_END(13)
  PH_BEGIN(14) p14_final(F, a); PH_END(14)
#undef IN
#undef BOTH
#undef GRID_BAR
}

__global__ __launch_bounds__(256) void adapt_b2f(const bf16* src, long lds_, long scol, float* dst, long ldd, long dcol, long rows, long ncols) {
  const long i = blockIdx.x * 256L + threadIdx.x; if (i >= rows * ncols) return;
  const long r = i / ncols, c = i % ncols; dst[r * ldd + dcol + c] = bf2f(src[r * lds_ + scol + c]);
}
static void adapt(hipStream_t s, const void* src, long lds_, long scol, float* dst, long ldd, long dcol, long rows, long ncols) {
  hipLaunchKernelGGL(adapt_b2f, dim3((unsigned)((rows * ncols + 255) / 256)), dim3(256), 0, s, (const bf16*)src, lds_, scol, dst, ldd, dcol, rows, ncols);
}

static int mk_grid() {
  static int grid = 0;
  if (grid == 0) {
    int dev = 0, cus = 0, per_cu = 0;
    (void)hipGetDevice(&dev); (void)hipDeviceGetAttribute(&cus, hipDeviceAttributeMultiprocessorCount, dev);
    (void)hipFuncSetAttribute((const void*)mk, hipFuncAttributeMaxDynamicSharedMemorySize, LDS_BYTES);
    (void)hipOccupancyMaxActiveBlocksPerMultiprocessor(&per_cu, (const void*)mk, NTHR, LDS_BYTES);
    (void)hipGetLastError();
    grid = cus > 0 ? cus : 256;
  }
  return grid;
}
static void mk_launch(hipStream_t s, void* const* d_in, void* d_out, void* d_ws, int lo, int hi, int flags) {
  Args a; memset(&a, 0, sizeof(a));
  for (int i = 0; i < 26; ++i) a.in[i] = d_in[i];
  a.out = (float*)d_out; a.ws = (unsigned char*)d_ws; a.ph_lo = lo; a.ph_hi = hi; a.flags = flags; a.pad = 0;
  (void)hipMemsetAsync((char*)d_ws + WS_CTL + CW_BAR * 4, 0, XCD_BAR_WORDS * 4, s);
  hipLaunchKernelGGL(mk, dim3(mk_grid()), dim3(NTHR), LDS_BYTES, s, a);
}

extern "C" void kernel_launch(void* const* d_in, const int* in_sizes, int n_in, void* d_out, int out_size, void* d_ws, size_t ws_size, hipStream_t s) {
  (void)hipMemsetAsync((char*)d_ws + WS_CTL, 0, CTL_ZERO_BYTES, s);
  mk_launch(s, d_in, d_out, d_ws, 0, 15, 1);
}
```

```cpp
#include <hip/hip_runtime.h>
#include <cstdint>
#include <cstdio>
#include <cstring>

constexpr int BATCH = 4, SEQ = 4096, DM = 1024, MTOK = BATCH * SEQ;
constexpr int D_IN = 2480;
constexpr int OFF_QM = 0, OFF_KM = 512, OFF_VM = 1024, OFF_OM = 1536, OFF_G = 2048, OFF_CQ = 2064, OFF_CKV = 2320, OFF_KR = 2448;
constexpr int NEXP = 16, CAP = 512, DFF = 2048, NMEM = 256;
constexpr size_t MiB = 1u << 20;
enum { I_X = 0, I_MEM, I_POS, I_GMIX, I_WIN, I_BG, I_CONV, I_GQA, I_WQB, I_GKVA, I_WKVB, I_GHM, I_GHA, I_WOUT, I_GMX, I_GMKV, I_WMQ, I_WMK, I_WMV, I_WMO, I_GFFN, I_WR, I_WEG, I_WEU, I_WED, I_GFIN };
#define GAS __attribute__((address_space(1)))
#define LAS __attribute__((address_space(3)))
typedef unsigned short bf16;
typedef unsigned v4u __attribute__((ext_vector_type(4)));
typedef unsigned v2u __attribute__((ext_vector_type(2)));
typedef float f32x4 __attribute__((ext_vector_type(4)));
typedef float f32x16 __attribute__((ext_vector_type(16)));
typedef short bf16x8 __attribute__((ext_vector_type(8)));
typedef short s16x4 __attribute__((ext_vector_type(4)));
typedef GAS unsigned gu32;
#define RLX_AGENT __ATOMIC_RELAXED, __HIP_MEMORY_SCOPE_AGENT
#define LDS_WAIT() asm volatile("s_waitcnt lgkmcnt(0)" ::: "memory")
#define VM_WAIT() asm volatile("s_waitcnt vmcnt(0)" ::: "memory")
constexpr int NWAVES = 8, NTHR = 512;
__device__ __forceinline__ unsigned f2bf(float f) { unsigned u = __builtin_bit_cast(unsigned, f); return (u + 0x7fffu + ((u >> 16) & 1u)) >> 16; }
__device__ __forceinline__ unsigned pk2(float lo, float hi) { return f2bf(lo) | (f2bf(hi) << 16); }
__device__ __forceinline__ float bf2f(unsigned short h) { return __builtin_bit_cast(float, (unsigned)h << 16); }
__device__ __forceinline__ float bflo(unsigned w) { return __builtin_bit_cast(float, w << 16); }
__device__ __forceinline__ float bfhi(unsigned w) { return __builtin_bit_cast(float, w & 0xffff0000u); }
typedef float f32x2_t __attribute__((ext_vector_type(2))); typedef __bf16 bf16x2_t __attribute__((ext_vector_type(2)));
__device__ __forceinline__ unsigned cvt_pk_bf16(float lo, float hi) { f32x2_t v = {lo, hi}; bf16x2_t b = __builtin_convertvector(v, bf16x2_t); return __builtin_bit_cast(unsigned, b); }
__device__ __forceinline__ v2u pack8_fp8(const float (&v)[8], float sc) { float c[8];
#pragma unroll
  for (int i = 0; i < 8; ++i) c[i] = __builtin_amdgcn_fmed3f(v[i] * sc, -448.f, 448.f);
  int a = 0, b = 0; a = __builtin_amdgcn_cvt_pk_fp8_f32(c[0], c[1], a, false); a = __builtin_amdgcn_cvt_pk_fp8_f32(c[2], c[3], a, true);
  b = __builtin_amdgcn_cvt_pk_fp8_f32(c[4], c[5], b, false); b = __builtin_amdgcn_cvt_pk_fp8_f32(c[6], c[7], b, true); v2u r; r.x = (unsigned)a; r.y = (unsigned)b; return r; }
__device__ __forceinline__ float q8(float x, float sc) { const int p = __builtin_amdgcn_cvt_pk_fp8_f32(x * sc, 0.f, 0, false); return __builtin_amdgcn_cvt_f32_fp8(p, 0) * (1.f / sc); }
__device__ __forceinline__ float wave_sum(float v) {
#pragma unroll
  for (int o = 1; o < 64; o <<= 1) v += __shfl_xor(v, o);
  return v;
}
__device__ __forceinline__ float sigmoidf_(float x) { return 1.f / (1.f + __expf(-x)); }

#define XB_TMO      128
#define XB_XCNT(j)  (256  + 64 * (j))
#define XB_XSUB(j)  (1280 + 64 * (j))
#define XB_XGEN(j)  (2304 + 64 * (j))
#define XB_TOP      3328
#define XB_TOPGEN   3392
#define XCD_BAR_WORDS 3456
#define XB_SPIN_CAP (1u << 22)
__device__ __forceinline__ unsigned xb_ld(unsigned* p)              { return __hip_atomic_load(p, __ATOMIC_RELAXED, __HIP_MEMORY_SCOPE_AGENT); }
__device__ __forceinline__ unsigned xb_add(unsigned* p, unsigned v) { return __hip_atomic_fetch_add(p, v, __ATOMIC_RELAXED, __HIP_MEMORY_SCOPE_AGENT); }
__device__ __forceinline__ unsigned xb_xcc_id() { return (unsigned)__builtin_amdgcn_s_getreg((3 << 11) | 20) & 0xFu; }
#define XB_SPIN(cond, bar) do { unsigned _sp = 0; while (cond) { __builtin_amdgcn_s_sleep(1); \
    if ((++_sp & 255u) == 0u) { if (xb_ld(&(bar)[XB_TMO])) break; if (_sp > XB_SPIN_CAP) { atomicAdd(&(bar)[XB_TMO], 1u); break; } } } } while (0)
struct XcdBarrier { unsigned* bar; unsigned x; volatile LAS unsigned* st; };
__device__ __forceinline__ XcdBarrier xcd_barrier_post(unsigned* bar, volatile LAS unsigned* st) {
  XcdBarrier b; b.bar = bar; b.x = xb_xcc_id(); b.st = st;
  if (threadIdx.x == 0) (void)xb_add(&bar[XB_XCNT(b.x)], 1u);
  return b;
}
__device__ __forceinline__ void xcd_barrier_complete(unsigned* bar, unsigned x, unsigned& nloc, unsigned& nx) {
  const unsigned G = gridDim.x * gridDim.y * gridDim.z;
  unsigned sum, cnt, mine, sp = 0u;
  for (;;) {
    sum = 0u; cnt = 0u; mine = 0u;
#pragma unroll
    for (unsigned j = 0; j < 16; ++j) { const unsigned c = xb_ld(&bar[XB_XCNT(j)]); sum += c; cnt += (c > 0u) ? 1u : 0u; mine = (j == x) ? c : mine; }
    if (sum == G) break;
    __builtin_amdgcn_s_sleep(1);
    if ((++sp & 255u) == 0u) { if (xb_ld(&bar[XB_TMO])) break; if (sp > XB_SPIN_CAP) { atomicAdd(&bar[XB_TMO], 1u); break; } }
  }
  nloc = mine > 0u ? mine : 1u; nx = cnt > 0u ? cnt : 1u;
}
__device__ __forceinline__ void xcd_barrier(const XcdBarrier& b) {
  asm volatile("s_waitcnt vmcnt(0)" ::: "memory");
  __syncthreads();
  if (threadIdx.x == 0) {
    unsigned* bar = b.bar;
    __builtin_amdgcn_s_waitcnt(0);
    unsigned nloc = b.st[0], nx = b.st[1];
    if (nloc == 0u) { xcd_barrier_complete(bar, b.x, nloc, nx); b.st[0] = nloc; b.st[1] = nx; }
    const unsigned old = xb_add(&bar[XB_XSUB(b.x)], 1u);
    const unsigned gen = old / nloc;
    if (old + 1u == (gen + 1u) * nloc) {
      __builtin_amdgcn_fence(__ATOMIC_RELEASE, "agent");
      asm volatile("s_waitcnt vmcnt(0)" ::: "memory");
      const unsigned og = xb_add(&bar[XB_TOP], 1u);
      const unsigned tg = og / nx;
      if (og + 1u == (tg + 1u) * nx) xb_add(&bar[XB_TOPGEN], 1u);
      else XB_SPIN(xb_ld(&bar[XB_TOPGEN]) == tg, bar);
      __builtin_amdgcn_fence(__ATOMIC_ACQUIRE, "agent");
      xb_add(&bar[XB_XGEN(b.x)], 1u);
      asm volatile("s_waitcnt vmcnt(0)" ::: "memory");
    } else {
      XB_SPIN(xb_ld(&bar[XB_XGEN(b.x)]) == gen, bar);
      __builtin_amdgcn_fence(__ATOMIC_ACQUIRE, "agent");
      asm volatile("s_waitcnt vmcnt(0)" ::: "memory");
    }
  }
  __syncthreads();
}

namespace pg8 {
constexpr int BM = 256, BK = 64, HALF = 128, HTB = HALF * BK * 2, STAGE_BYTES = 8 * HTB, NXCD = 8, WGM = 8;
__host__ __device__ __forceinline__ int lds_byte(int r, int c) { const int st = (r >> 4) * 2 + (c >> 5), rr = r & 15, cc = c & 31, ob = rr * 64 + cc * 2; return st * 1024 + (ob ^ (((ob >> 9) & 1) << 5)); }
__host__ __device__ __forceinline__ void stage_rc(int b, int& R, int& C) { const int st = b / 1024, sb = b % 1024, swz = sb ^ (((sb >> 9) & 1) << 5); R = (st >> 1) * 16 + swz / 64; C = (st & 1) * 32 + (swz % 64) / 2; }
__host__ __device__ __forceinline__ int perm32(int rho) { const int n = rho >> 4, i = rho & 15; return 8 * (i >> 2) + 4 * n + (i & 3); }

struct Unit { long aoff, boff; int pm, pn, g, ibase; };
struct Gemm { const bf16* A; const bf16* Bt; int lda, ldb, K; const int* gidx; int sa, sb; };
typedef int v8i_t __attribute__((ext_vector_type(8))); typedef int v4i_t __attribute__((ext_vector_type(4)));
__device__ __forceinline__ v8i_t cat8(bf16x8 lo, bf16x8 hi) { const v4i_t a = __builtin_bit_cast(v4i_t, lo), b = __builtin_bit_cast(v4i_t, hi); return __builtin_shufflevector(a, b, 0, 1, 2, 3, 4, 5, 6, 7); }

struct StaticOrder {
  int nM, nN, nwg, G, c, lda, ldb;
  __device__ void init(int M, int N, int G_, int c_, int lda_, int ldb_) { nM = M / BM; nN = N / BM; nwg = nM * nN; G = G_; c = c_; lda = lda_; ldb = ldb_; }
  __device__ bool next(int i, Unit& u) const {
    const long L = (long)i * G + c; if (L >= nwg) return false;
    int wgid = (int)L; { const int q = nwg / NXCD, r = nwg % NXCD, xcd = wgid % NXCD, off = wgid / NXCD; wgid = (xcd < r ? xcd * (q + 1) : r * (q + 1) + (xcd - r) * q) + off; }
    const int nig = WGM * nN, gid = wgid / nig, fm = gid * WGM, gsz = (nM - fm) < WGM ? (nM - fm) : WGM;
    u.pm = fm + ((wgid % nig) % gsz); u.pn = (wgid % nig) / gsz; u.g = 0; u.ibase = 0;
    u.aoff = (long)u.pm * BM * lda; u.boff = (long)u.pn * BM * ldb; return true;
  }
};

template <class Epi, class Sched, bool GATHER, int FP8 = 0>
__device__ __forceinline__ void gemm_phase(LAS unsigned char* lds, const Gemm g, const Sched& S, const Epi& E) {
  int tid = threadIdx.x; asm volatile("" : "+v"(tid));
  const int wid = __builtin_amdgcn_readfirstlane(tid >> 6), lane = tid & 63, wr = wid >> 2, wc = wid & 3, fr = lane & 15, fq = lane >> 4;
  const int K = g.K, nt = K / BK;
  int Rs[2], Cs[2]; unsigned voffB[2];
#pragma unroll
  for (int i = 0; i < 2; ++i) { int R, C; stage_rc(tid * 16 + i * 8192, R, C); Rs[i] = R; Cs[i] = C; const int Rb = (R & ~31) + perm32(R & 31); voffB[i] = (unsigned)(Rb * g.ldb + C) * 2u; }
  const size_t kstep = (size_t)(BK * 2);
  const size_t hstepB = (size_t)HALF * g.ldb * 2;
  const unsigned ldsw = (unsigned)wid * 1024u;
  const int aoff_l = lds_byte(wr * 64 + fr, FP8 ? fq * 16 : fq * 8), boff_l = lds_byte(wc * 32 + fr, FP8 ? fq * 16 : fq * 8);
  constexpr int aoff_k = FP8 ? 16 : 1024, boff_k = FP8 ? 16 : 1024;
#define PG8_SA(b, h) (((b) * 2 + (h)) * HTB)
#define PG8_SB(b, h) ((4 + (b) * 2 + (h)) * HTB)
#define PG8_STAGE(bufoff, gbase, voff) do { _Pragma("unroll") for (int _i = 0; _i < 2; ++_i) \
        __builtin_amdgcn_global_load_lds((const unsigned*)((const char*)(gbase) + (voff)[_i]), (LAS unsigned*)(lds + (bufoff) + ldsw + _i * 8192), 16, 0, 0); } while (0)
#define PG8_LDA(dst, b, h) do { _Pragma("unroll") for (int m = 0; m < 4; ++m) { if constexpr (FP8) { const v4i_t lo_ = *(const LAS v4i_t*)(lds + PG8_SA(b, h) + aoff_l + m * 2048), hi_ = *(const LAS v4i_t*)(lds + PG8_SA(b, h) + aoff_l + m * 2048 + aoff_k); dst##8[m] = __builtin_shufflevector(lo_, hi_, 0, 1, 2, 3, 4, 5, 6, 7); } \
        else { _Pragma("unroll") for (int k = 0; k < 2; ++k) dst[m][k] = *(const LAS bf16x8*)(lds + PG8_SA(b, h) + aoff_l + m * 2048 + k * aoff_k); } } } while (0)
#define PG8_LDB(dst, b, h) do { _Pragma("unroll") for (int n = 0; n < 2; ++n) { if constexpr (FP8) { const v4i_t lo_ = *(const LAS v4i_t*)(lds + PG8_SB(b, h) + boff_l + n * 2048), hi_ = *(const LAS v4i_t*)(lds + PG8_SB(b, h) + boff_l + n * 2048 + boff_k); dst##8[n] = __builtin_shufflevector(lo_, hi_, 0, 1, 2, 3, 4, 5, 6, 7); } \
        else { _Pragma("unroll") for (int k = 0; k < 2; ++k) dst[n][k] = *(const LAS bf16x8*)(lds + PG8_SB(b, h) + boff_l + n * 2048 + k * boff_k); } } } while (0)
#define PG8_MMA(ai, bj, At, Bt) do { __builtin_amdgcn_s_setprio(1); _Pragma("unroll") for (int m = 0; m < 4; ++m) _Pragma("unroll") for (int n = 0; n < 2; ++n) { \
        if constexpr (FP8) asm volatile("v_mfma_scale_f32_16x16x128_f8f6f4 %0, %1, %2, %0, %3, %4 op_sel_hi:[0,0,0]" : "+v"(acc[ai][bj][m][n]) : "v"(Bt##8[n]), "v"(At##8[m]), "v"(vsb), "v"(vsa)); \
        else { _Pragma("unroll") for (int k = 0; k < 2; ++k) acc[ai][bj][m][n] = __builtin_amdgcn_mfma_f32_16x16x32_bf16(Bt[n][k], At[m][k], acc[ai][bj][m][n], 0, 0, 0); } } \
        __builtin_amdgcn_s_setprio(0); } while (0)
#define PG8_WAIT_V(n) asm volatile("s_waitcnt vmcnt(" #n ")" ::: "memory")
#define PG8_WAIT_L(n) asm volatile("s_waitcnt lgkmcnt(" #n ")" ::: "memory")
#define PG8_BAR __builtin_amdgcn_s_barrier()
#define PG8_SCHED __builtin_amdgcn_sched_barrier(0)
  Unit cur, nxt; int ui = 0;
  if (!S.next(0, cur)) return;
  unsigned vA[2][2], nvA[2][2];
  auto load_va = [&](const Unit& u, unsigned (&v)[2][2]) {
#pragma unroll
    for (int h = 0; h < 2; ++h)
#pragma unroll
      for (int i = 0; i < 2; ++i) {
        if constexpr (GATHER) v[h][i] = (unsigned)((long)g.gidx[u.ibase + h * HALF + Rs[i]] * g.lda + Cs[i]) * 2u;
        else v[h][i] = (unsigned)((h * HALF + Rs[i]) * g.lda + Cs[i]) * 2u;
      }
  };
  load_va(cur, vA);
  f32x4 acc[2][2][4][2];
#pragma unroll
  for (int a = 0; a < 2; ++a)
#pragma unroll
    for (int b = 0; b < 2; ++b)
#pragma unroll
      for (int m = 0; m < 4; ++m)
#pragma unroll
        for (int n = 0; n < 2; ++n) acc[a][b][m][n] = (f32x4){0.f, 0.f, 0.f, 0.f};
  int vsa = g.sa, vsb = g.sb; (void)vsa; (void)vsb;
  bf16x8 At[4][2], B0[2][2], B1[2][2]; v8i_t At8[4], B08[2], B18[2];
  const char* cA = (const char*)g.A + (GATHER ? 0 : cur.aoff * 2); const char* cB = (const char*)g.Bt + cur.boff * 2;
  PG8_STAGE(PG8_SB(0, 0), cB, voffB); PG8_STAGE(PG8_SB(0, 1), cB + hstepB, voffB); PG8_STAGE(PG8_SA(0, 0), cA, vA[0]); PG8_STAGE(PG8_SA(0, 1), cA, vA[1]);
  if (wr == 1) PG8_BAR;
  PG8_WAIT_V(2); PG8_BAR;
  PG8_STAGE(PG8_SB(1, 0), cB + kstep, voffB); PG8_STAGE(PG8_SA(1, 0), cA + kstep, vA[0]); PG8_STAGE(PG8_SB(1, 1), cB + hstepB + kstep, voffB);
  PG8_WAIT_V(6); PG8_BAR;
  for (;;) {
    const bool has_next = S.next(ui + 1, nxt);
    const char* nA = has_next ? (const char*)g.A + (GATHER ? 0 : nxt.aoff * 2) : cA; const char* nB = has_next ? (const char*)g.Bt + nxt.boff * 2 : cB;
    if constexpr (GATHER) { if (has_next) load_va(nxt, nvA); else {
#pragma unroll
      for (int h = 0; h < 2; ++h)
#pragma unroll
        for (int i = 0; i < 2; ++i) nvA[h][i] = vA[h][i]; } }
#pragma unroll 1
    for (int t = 0; t < nt; t += 2) {
      const bool last = (t == nt - 2);
      const char* a1 = cA + (size_t)(t + 1) * kstep;
      const char* a2 = last ? nA : cA + (size_t)(t + 2) * kstep; const char* b2 = last ? nB : cB + (size_t)(t + 2) * kstep;
      const char* a3 = a2 + kstep; const char* b3 = b2 + kstep;
      unsigned w0[2], w1[2];
      if constexpr (GATHER) { w0[0] = last ? nvA[0][0] : vA[0][0]; w0[1] = last ? nvA[0][1] : vA[0][1]; w1[0] = last ? nvA[1][0] : vA[1][0]; w1[1] = last ? nvA[1][1] : vA[1][1]; }
      else { w0[0] = vA[0][0]; w0[1] = vA[0][1]; w1[0] = vA[1][0]; w1[1] = vA[1][1]; }
      PG8_LDB(B0, 0, 0); PG8_LDB(B1, 0, 1); PG8_SCHED; PG8_LDA(At, 0, 0); PG8_STAGE(PG8_SA(1, 1), a1, vA[1]);
      PG8_WAIT_V(8); PG8_WAIT_L(0); PG8_BAR; PG8_MMA(0, 0, At, B0); PG8_MMA(0, 1, At, B1); PG8_BAR; PG8_SCHED;
      PG8_LDA(At, 0, 1); PG8_STAGE(PG8_SB(0, 0), b2, voffB); PG8_STAGE(PG8_SB(0, 1), b2 + hstepB, voffB); PG8_STAGE(PG8_SA(0, 0), a2, w0);
      PG8_WAIT_V(8); PG8_WAIT_L(0); PG8_BAR; PG8_MMA(1, 0, At, B0); PG8_MMA(1, 1, At, B1); PG8_BAR; PG8_SCHED;
      PG8_LDB(B0, 1, 0); PG8_LDB(B1, 1, 1); PG8_SCHED; PG8_LDA(At, 1, 0); PG8_STAGE(PG8_SA(0, 1), a2, w1);
      PG8_WAIT_V(8); PG8_WAIT_L(0); PG8_BAR; PG8_MMA(0, 0, At, B0); PG8_MMA(0, 1, At, B1); PG8_BAR; PG8_SCHED;
      PG8_LDA(At, 1, 1); PG8_STAGE(PG8_SB(1, 0), b3, voffB); PG8_STAGE(PG8_SB(1, 1), b3 + hstepB, voffB); PG8_STAGE(PG8_SA(1, 0), a3, w0);
      PG8_WAIT_V(8); PG8_WAIT_L(0); PG8_BAR; PG8_MMA(1, 0, At, B0); PG8_MMA(1, 1, At, B1); PG8_BAR; PG8_SCHED;
    }
    if constexpr (FP8) { asm volatile("s_nop 15\n\ts_nop 15" ::: "memory"); __builtin_amdgcn_sched_barrier(0); }
    if (wr == 0) PG8_BAR;
    int fr_o = fr, fq_o = fq; asm volatile("" : "+v"(fr_o), "+v"(fq_o));
    if constexpr (Epi::TWO_PASS) {
#pragma unroll
      for (int ai = 0; ai < 2; ++ai)
#pragma unroll
        for (int m = 0; m < 4; ++m) {
          float v0[8], v1[8];
#pragma unroll
          for (int n = 0; n < 2; ++n)
#pragma unroll
            for (int j = 0; j < 4; ++j) { v0[n * 4 + j] = acc[ai][0][m][n][j]; v1[n * 4 + j] = acc[ai][1][m][n][j]; }
          E.pass1(cur, ai * HALF + wr * 64 + m * 16 + fr_o, wc, v0, v1, fq_o);
#pragma unroll
          for (int n = 0; n < 2; ++n)
#pragma unroll
            for (int j = 0; j < 4; ++j) { acc[ai][0][m][n][j] = v0[n * 4 + j]; acc[ai][1][m][n][j] = v1[n * 4 + j]; }
        }
      asm volatile("s_waitcnt lgkmcnt(0)" ::: "memory"); PG8_BAR; asm volatile("" ::: "memory");
    }
    {
#pragma unroll
      for (int ai = 0; ai < 2; ++ai)
#pragma unroll
        for (int m = 0; m < 4; ++m) {
          float v0[8], v1[8];
#pragma unroll
          for (int n = 0; n < 2; ++n)
#pragma unroll
            for (int j = 0; j < 4; ++j) { v0[n * 4 + j] = acc[ai][0][m][n][j]; v1[n * 4 + j] = acc[ai][1][m][n][j]; }
          E.row8(cur, ai * HALF + wr * 64 + m * 16 + fr_o, wc * 32 + 8 * fq_o, v0, v1, fq_o);
          asm volatile("" ::: "memory");
        }
    }
    if (!has_next) break;
#pragma unroll
    for (int a = 0; a < 2; ++a)
#pragma unroll
      for (int b = 0; b < 2; ++b)
#pragma unroll
        for (int m = 0; m < 4; ++m)
#pragma unroll
          for (int n = 0; n < 2; ++n) acc[a][b][m][n] = (f32x4){0.f, 0.f, 0.f, 0.f};
    cur = nxt; cA = nA; cB = nB; ++ui;
    if constexpr (GATHER) {
#pragma unroll
      for (int h = 0; h < 2; ++h)
#pragma unroll
        for (int i = 0; i < 2; ++i) vA[h][i] = nvA[h][i]; }
    if (wr == 1) PG8_BAR;
  }
  PG8_WAIT_V(0);
  PG8_BAR;
#undef PG8_SA
#undef PG8_SB
#undef PG8_STAGE
#undef PG8_LDA
#undef PG8_LDB
#undef PG8_MMA
#undef PG8_WAIT_V
#undef PG8_WAIT_L
#undef PG8_BAR
#undef PG8_SCHED
}
}
constexpr size_t WS_CTL = 0, CTL_ZERO_BYTES = 1 * MiB;
constexpr int CW_TMO = 0, CW_BAR = 4096, CW_Q = 8192;
constexpr size_t CTL_SSQ = 256 * 1024, CTL_SSKV = CTL_SSQ + 65536, CTL_SS1 = CTL_SSKV + 65536, CTL_SS2 = CTL_SS1 + 65536;
constexpr size_t WS_WIN = 1 * MiB, WS_WQB = 6 * MiB, WS_WKVB = 6 * MiB + 512 * 1024, WS_WOUT = 7 * MiB, WS_WMQ = 9 * MiB, WS_WMK = 11 * MiB, WS_WMV = 13 * MiB, WS_WMO = 15 * MiB;
constexpr size_t WS_ROPE = 17 * MiB, WS_MEMN = 19 * MiB, WS_KMEM = 21 * MiB, WS_VMEMT = 23 * MiB, WS_GSC = 25 * MiB, WS_DEC = 28 * MiB, WS_AFF = 29 * MiB, WS_SEL = 30 * MiB;
constexpr size_t WS_PROJ = 32 * MiB, WS_XN = 112 * MiB, WS_QC = 112 * MiB, WS_KC = 128 * MiB, WS_QM = 144 * MiB, WS_KM = 168 * MiB, WS_VM = 192 * MiB, WS_HF = 208 * MiB, WS_HB = 224 * MiB, WS_Y = 240 * MiB;
constexpr size_t WS_X1 = 112 * MiB, WS_X1B = 176 * MiB, WS_QMEM = 208 * MiB, WS_P = 240 * MiB, WS_MO = 176 * MiB, WS_X2 = 240 * MiB, WS_X2B = 208 * MiB, WS_HID = 32 * MiB;
constexpr size_t WS_DUMMY = 304 * MiB;
constexpr size_t WS_WEGU = 320 * MiB, WS_WED = 448 * MiB, WS_END = 512 * MiB;
constexpr int PROJ_LD = 2560;
constexpr int PC_CQ = 2048, PC_CKV = 2304, PC_KR = 2432, PC_G = 2464;
constexpr int RING_BYTES = 131072, LDSCTL_OFF = 133120, LDS_BYTES = 147456;

struct Args { const void* in[26]; float* out; unsigned char* ws; int ph_lo, ph_hi, flags, pad; };

struct Frame {
  LAS unsigned char* lds; volatile LAS unsigned* MISC; gu32* ctl; unsigned char* ws;
  int tid, lane, wave, vcu, G;
};

__device__ __forceinline__ void p0_tr(const float* W, int ldw, int k0, int kvalid, int scol0, int ncols, const float* gs, bf16* WT, int ldt, int drow0, LAS float* scr, int lane, bool doq = false) {
  const int c4 = (lane & 15) * 4, kr = lane >> 4;
  f32x4 v[16];
#pragma unroll
  for (int i = 0; i < 16; ++i) { const int kk = 4 * i + kr; v[i] = (f32x4){0.f, 0.f, 0.f, 0.f};
    if (c4 < ncols && k0 + kk < kvalid) { v[i] = *(const f32x4*)(W + (size_t)(k0 + kk) * ldw + scol0 + c4); if (gs) v[i] = v[i] * gs[k0 + kk];
      if (doq) { v[i].x = q8(v[i].x, 64.f); v[i].y = q8(v[i].y, 64.f); v[i].z = q8(v[i].z, 64.f); v[i].w = q8(v[i].w, 64.f); } } }
#pragma unroll
  for (int i = 0; i < 16; ++i) { const int kk = 4 * i + kr; LAS float* d = scr + kk * 65 + c4; d[0] = v[i].x; d[1] = v[i].y; d[2] = v[i].z; d[3] = v[i].w; }
  LDS_WAIT(); asm volatile("" ::: "memory");
  const int c = lane & 7;
#pragma unroll
  for (int j = 0; j < 8; ++j) { const int n = (lane >> 3) + 8 * j; const LAS float* s = scr + (8 * c) * 65 + n;
    v4u o; o.x = pk2(s[0 * 65], s[1 * 65]); o.y = pk2(s[2 * 65], s[3 * 65]); o.z = pk2(s[4 * 65], s[5 * 65]); o.w = pk2(s[6 * 65], s[7 * 65]);
    *(GAS v4u*)(WT + (size_t)(drow0 + n) * ldt + k0 + 8 * c) = o; }
  LDS_WAIT(); asm volatile("" ::: "memory");
}
__device__ __forceinline__ void p0_tr8(const float* W, int ldw, int k0, int scol0, const float* gs, float sc, unsigned char* WT8, int ldt, int drow0, LAS float* scr, int lane) {
  const int c4 = (lane & 15) * 4, kr = lane >> 4;
  f32x4 v[16];
#pragma unroll
  for (int i = 0; i < 16; ++i) { const int kk = 4 * i + kr; v[i] = *(const f32x4*)(W + (size_t)(k0 + kk) * ldw + scol0 + c4); if (gs) v[i] = v[i] * gs[k0 + kk]; }
#pragma unroll
  for (int i = 0; i < 16; ++i) { const int kk = 4 * i + kr; LAS float* d = scr + kk * 65 + c4; d[0] = v[i].x; d[1] = v[i].y; d[2] = v[i].z; d[3] = v[i].w; }
  LDS_WAIT(); asm volatile("" ::: "memory");
  const int c = lane & 7;
#pragma unroll
  for (int j = 0; j < 8; ++j) { const int n = (lane >> 3) + 8 * j; const LAS float* s = scr + (8 * c) * 65 + n;
    float f[8];
#pragma unroll
    for (int q = 0; q < 8; ++q) f[q] = s[q * 65];
    *(GAS v2u*)(WT8 + (size_t)(drow0 + n) * ldt + k0 + 8 * c) = pack8_fp8(f, sc); }
  LDS_WAIT(); asm volatile("" ::: "memory");
}
__device__ __forceinline__ void p0_tr32(const float* W, int ldw, int k0, int scol0, int ncols, const float* gs, bf16* WT, int ldt, int drow0, LAS float* scr, int lane) {
#pragma unroll 8
  for (int i = 0; i < 32; ++i) { const int kk = 2 * i + (lane >> 5), c = lane & 31; float v = 0.f;
    if (c < ncols) { v = W[(size_t)(k0 + kk) * ldw + scol0 + c]; if (gs) v *= gs[k0 + kk]; }
    scr[kk * 65 + c] = v; }
  LDS_WAIT(); asm volatile("" ::: "memory");
  const int c = lane & 7;
#pragma unroll
  for (int j = 0; j < 4; ++j) { const int n = (lane >> 3) + 8 * j; const LAS float* s = scr + (8 * c) * 65 + n;
    v4u o; o.x = pk2(s[0 * 65], s[1 * 65]); o.y = pk2(s[2 * 65], s[3 * 65]); o.z = pk2(s[4 * 65], s[5 * 65]); o.w = pk2(s[6 * 65], s[7 * 65]);
    *(GAS v4u*)(WT + (size_t)(drow0 + n) * ldt + k0 + 8 * c) = o; }
  LDS_WAIT(); asm volatile("" ::: "memory");
}
__device__ __forceinline__ void rms_row_to_bf16(const float* xrow, bf16* orow, int lane) {
  const GAS f32x4* xr = (const GAS f32x4*)xrow + lane;
  f32x4 v[4]; float s = 0.f;
#pragma unroll
  for (int j = 0; j < 4; ++j) { v[j] = xr[64 * j]; s += (v[j].x * v[j].x + v[j].y * v[j].y) + (v[j].z * v[j].z + v[j].w * v[j].w); }
  const float rstd = rsqrtf(wave_sum(s) * (1.f / 1024.f) + 1e-6f);
  GAS unsigned long long* o8 = (GAS unsigned long long*)orow + lane;
#pragma unroll
  for (int j = 0; j < 4; ++j) o8[64 * j] = (unsigned long long)pk2(v[j].x * rstd, v[j].y * rstd) | ((unsigned long long)pk2(v[j].z * rstd, v[j].w * rstd) << 32);
}

#ifndef FP8EMU
#define FP8EMU 0
#endif
#ifndef MOE_FP8
#define MOE_FP8 1
#endif
#ifndef MOE_FP8_DOWN
#define MOE_FP8_DOWN MOE_FP8
#endif
constexpr size_t WS_XG = 96 * MiB;
constexpr size_t WS_X2Q = 208 * MiB, WS_WEGU8 = 320 * MiB, WS_WED8 = 448 * MiB, WS_HID8 = 32 * MiB;
constexpr int CW_CONV = 8192 + 64 * 40, CW_MDONE = 8192 + 64 * 41, CW_TDONE = 8192 + 64 * 42;
constexpr int CONV_IGU = 16 * 64, CONV_ID = 32 * 16, CONV_ITEMS = NEXP * (CONV_IGU + CONV_ID), CONV_CHUNKS = CONV_ITEMS / 8;
__device__ __forceinline__ void conv_item(Frame& F, const Args& a, int it) {
  LAS float* scr = (LAS float*)(F.lds + F.wave * 16640);
  auto I = [&](int i) { return (const float*)a.in[i]; };
  unsigned char* ws = F.ws;
  const int e = it / (CONV_IGU + CONV_ID); int r = it % (CONV_IGU + CONV_ID);
  if (r < CONV_IGU) { const int kb = r / 64, nb = r % 64, p = nb >> 2, j0 = (nb & 3) * 64; const bool up = j0 >= 128;
#if MOE_FP8
    p0_tr8((up ? I(I_WEU) : I(I_WEG)) + (size_t)e * 1024 * 2048, 2048, 64 * kb, 128 * p + (up ? j0 - 128 : j0), I(I_GFFN), 64.f, ws + WS_WEGU8 + (size_t)e * 4096 * 1024, 1024, 64 * nb, scr, F.lane);
#else
    p0_tr((up ? I(I_WEU) : I(I_WEG)) + (size_t)e * 1024 * 2048, 2048, 64 * kb, 1024, 128 * p + (up ? j0 - 128 : j0), 64, I(I_GFFN), (bf16*)(ws + WS_WEGU) + (size_t)e * 4096 * 1024, 1024, 64 * nb, scr, F.lane, FP8EMU != 0);
#endif
  } else { r -= CONV_IGU; const int kb = r / 16, nb = r % 16;
#if MOE_FP8_DOWN
    p0_tr8(I(I_WED) + (size_t)e * 2048 * 1024, 1024, 64 * kb, 64 * nb, nullptr, 64.f, ws + WS_WED8 + (size_t)e * 1024 * 2048, 2048, 64 * nb, scr, F.lane);
#else
    p0_tr(I(I_WED) + (size_t)e * 2048 * 1024, 1024, 64 * kb, 2048, 64 * nb, 64, nullptr, (bf16*)(ws + WS_WED) + (size_t)e * 1024 * 2048, 2048, 64 * nb, scr, F.lane, FP8EMU != 0);
#endif
  }
}
__device__ __forceinline__ void conv_fill(Frame& F, const Args& a, int maxchunks) {
  volatile LAS int* slot = (volatile LAS int*)(F.lds + LDSCTL_OFF + 16);
  for (int n = 0; n < maxchunks; ++n) {
    if (F.tid == 0) { int got = -1;
      if (__hip_atomic_load(F.ctl + CW_CONV, RLX_AGENT) < (unsigned)CONV_CHUNKS) { const unsigned c = __hip_atomic_fetch_add(F.ctl + CW_CONV, 1u, RLX_AGENT); if (c < (unsigned)CONV_CHUNKS) got = (int)c; }
      *slot = got; }
    __syncthreads();
    const int c = __builtin_amdgcn_readfirstlane(*slot);
    __syncthreads();
    if (c < 0) break;
    conv_item(F, a, c * 8 + F.wave);
  }
}
__device__ __forceinline__ void p0_prologue(Frame& F, const Args& a, bool do_dense, bool do_experts) {
  LAS float* scr = (LAS float*)(F.lds + F.wave * 16640);
  const int gw = F.vcu * NWAVES + F.wave, NGW = F.G * NWAVES;
  auto I = [&](int i) { return (const float*)a.in[i]; };
  unsigned char* ws = F.ws;
  if (do_dense) {
    constexpr int I_WIN_ = 16 * 40, I_WQB_ = 4 * 12, I_WKVB_ = 4 * 16, I_SQ = 16 * 16;
    constexpr int NIT = I_WIN_ + I_WQB_ + I_WKVB_ + 5 * I_SQ;
    for (int it = gw; it < NIT; it += NGW) {
      int r = it;
      if (r < I_WIN_) { const int kb = r / 40, nb = r % 40; int sc, nc = 64;
        if (nb < 32) sc = 64 * nb; else if (nb < 36) sc = OFF_CQ + 64 * (nb - 32); else if (nb < 38) sc = OFF_CKV + 64 * (nb - 36); else if (nb == 38) { sc = OFF_KR; nc = 32; } else { sc = 0; nc = 0; }
        p0_tr(I(I_WIN), D_IN, 64 * kb, 1024, sc, nc, I(I_GMIX), (bf16*)(ws + WS_WIN), 1024, 64 * nb, scr, F.lane);
        if (nb == 38) p0_tr32(I(I_WIN), D_IN, 64 * kb, OFF_G, 16, I(I_GMIX), (bf16*)(ws + WS_WIN), 1024, PC_G, scr, F.lane);
        continue; } r -= I_WIN_;
      if (r < I_WQB_) { const int kb = r / 12, nb = r % 12; p0_tr(I(I_WQB), 768, 64 * kb, 256, 64 * nb, 64, I(I_GQA), (bf16*)(ws + WS_WQB), 256, 64 * nb, scr, F.lane); continue; } r -= I_WQB_;
      if (r < I_WKVB_) { const int kb = r / 16, nb = r % 16; const int h = nb & 7; const int sc = h * 128 + (nb >= 8 ? 64 : 0);
        p0_tr(I(I_WKVB), 1024, 64 * kb, 128, sc, 64, I(I_GKVA), (bf16*)(ws + WS_WKVB), 256, 64 * nb, scr, F.lane); continue; } r -= I_WKVB_;
      const int which = r / I_SQ; r %= I_SQ; const int kb = r / 16, nb = r % 16;
      const float* src = which == 0 ? I(I_WOUT) : which == 1 ? I(I_WMQ) : which == 2 ? I(I_WMK) : which == 3 ? I(I_WMV) : I(I_WMO);
      const float* gs = which == 1 ? I(I_GMX) : (which == 2 || which == 3) ? I(I_GMKV) : nullptr;
      bf16* dst = (bf16*)(ws + (which == 0 ? WS_WOUT : which == 1 ? WS_WMQ : which == 2 ? WS_WMK : which == 3 ? WS_WMV : WS_WMO));
      p0_tr(src, 1024, 64 * kb, 1024, 64 * nb, 64, gs, dst, 1024, 64 * nb, scr, F.lane);
    }
    for (int m = gw; m < MTOK; m += NGW) rms_row_to_bf16(I(I_X) + (size_t)m * 1024, (bf16*)(ws + WS_XN) + (size_t)m * 1024, F.lane);
    for (int m = gw; m < BATCH * NMEM; m += NGW) rms_row_to_bf16(I(I_MEM) + (size_t)m * 1024, (bf16*)(ws + WS_MEMN) + (size_t)m * 1024, F.lane);
    { const float* wr = I(I_WR); const float* gf = I(I_GFFN); float* wrg = (float*)(ws + WS_DEC + 65536);
      for (int i = (F.vcu * NTHR + F.tid); i < 1024 * 16; i += F.G * NTHR) wrg[i] = wr[i] * gf[i >> 4]; }
    { const int* pos = (const int*)a.in[I_POS]; float* rt = (float*)(ws + WS_ROPE);
      for (int i = (F.vcu * NTHR + F.tid); i < MTOK * 16; i += F.G * NTHR) { const int m = i >> 4, j = i & 15; const float inv = powf(10000.f, -(float)j / 16.f); const float ang = (float)pos[m] * inv;
        rt[m * 32 + j] = cosf(ang); rt[m * 32 + 16 + j] = sinf(ang); } }
  }
  if (do_experts) conv_fill(F, a, 1 << 30);
}

__device__ __forceinline__ v4u pack8(const float (&v)[8]) { v4u w; w.x = cvt_pk_bf16(v[0], v[1]); w.y = cvt_pk_bf16(v[2], v[3]); w.z = cvt_pk_bf16(v[4], v[5]); w.w = cvt_pk_bf16(v[6], v[7]); return w; }
__device__ __forceinline__ float sumsq8(const float (&v)[8]) { float s = 0.f;
#pragma unroll
  for (int i = 0; i < 8; ++i) s += v[i] * v[i];
  return s; }
struct EpiStore { static constexpr bool TWO_PASS = false; bf16* O; int ldc;
  __device__ __forceinline__ void row8(const pg8::Unit& u, int rloc, int cloc, const float (&v0)[8], const float (&v1)[8], int fq) const {
    bf16* p = O + (size_t)(u.pm * 256 + rloc) * ldc + u.pn * 256 + cloc; *(v4u*)p = pack8(v0); *(v4u*)(p + 128) = pack8(v1); } };
struct EpiProj { static constexpr bool TWO_PASS = false; bf16* P; float* ssq; float* sskv;
  __device__ __forceinline__ void row8(const pg8::Unit& u, int rloc, int cloc, const float (&v0)[8], const float (&v1)[8], int fq) const {
    const int row = u.pm * 256 + rloc; bf16* p = P + (size_t)row * PROJ_LD + u.pn * 256 + cloc; *(v4u*)p = pack8(v0); *(v4u*)(p + 128) = pack8(v1);
    if (u.pn == 8) { float s = sumsq8(v0) + sumsq8(v1); s += __shfl_xor(s, 16); s += __shfl_xor(s, 32); if (fq == 0) unsafeAtomicAdd(ssq + row, s); }
    if (u.pn == 9) { float s = sumsq8(v0); s += __shfl_xor(s, 16); s += __shfl_xor(s, 32); if (fq == 0) unsafeAtomicAdd(sskv + row, s); } } };
struct EpiQ { static constexpr bool TWO_PASS = false; bf16* Q; const float* ssq; const float* rope;
  __device__ __forceinline__ void rope8(float (&v)[8], int row, int fq) const {
    float pv[8];
#pragma unroll
    for (int i = 0; i < 8; ++i) pv[i] = __shfl_xor(v[i], 32);
    const float* cs = rope + (size_t)row * 32 + 8 * (fq & 1);
#pragma unroll
    for (int i = 0; i < 8; ++i) { const float c = cs[i], s = cs[16 + i]; v[i] = (fq < 2) ? (v[i] * c - pv[i] * s) : (v[i] * c + pv[i] * s); }
  }
  __device__ __forceinline__ void row8(const pg8::Unit& u, int rloc, int cloc, const float (&a0)[8], const float (&a1)[8], int fq) const {
    const int row = u.pm * 256 + rloc; const float r = rsqrtf(ssq[row] * (1.f / 256.f) + 1e-6f);
    float v0[8], v1[8];
#pragma unroll
    for (int i = 0; i < 8; ++i) { v0[i] = a0[i] * r; v1[i] = a1[i] * r; }
    const int g0 = u.pn * 8 + (cloc >> 5), g1 = g0 + 4;
    if (g0 % 3 == 2) rope8(v0, row, fq);
    if (g1 % 3 == 2) rope8(v1, row, fq);
    bf16* p = Q + (size_t)row * 768 + u.pn * 256 + cloc; *(v4u*)p = pack8(v0); *(v4u*)(p + 128) = pack8(v1); } };
struct EpiKV { static constexpr bool TWO_PASS = false; bf16* KMp; bf16* VMp; const float* sskv;
  __device__ __forceinline__ void put(int row, int c, const float (&v)[8], float r) const {
    float w[8];
#pragma unroll
    for (int i = 0; i < 8; ++i) w[i] = v[i] * r;
    if (c < 512) *(v4u*)(KMp + (size_t)row * 768 + (c >> 6) * 96 + (c & 63)) = pack8(w); else *(v4u*)(VMp + (size_t)row * 512 + (c - 512)) = pack8(w); }
  __device__ __forceinline__ void row8(const pg8::Unit& u, int rloc, int cloc, const float (&a0)[8], const float (&a1)[8], int fq) const {
    const int row = u.pm * 256 + rloc; const float r = rsqrtf(sskv[row] * (1.f / 128.f) + 1e-6f);
    put(row, u.pn * 256 + cloc, a0, r); put(row, u.pn * 256 + 128 + cloc, a1, r); } };

__device__ __forceinline__ void unpack8(v4u w, float (&f)[8]) { f[0] = bflo(w.x); f[1] = bfhi(w.x); f[2] = bflo(w.y); f[3] = bfhi(w.y); f[4] = bflo(w.z); f[5] = bfhi(w.z); f[6] = bflo(w.w); f[7] = bfhi(w.w); }
__device__ __forceinline__ float log_sigmoid(float x) { return fminf(x, 0.f) - log1pf(__expf(-fabsf(x))); }

__device__ __forceinline__ void p2_elementwise(Frame& F, const Args& a) {
  unsigned char* ws = F.ws;
  const bf16* P = (const bf16*)(ws + WS_PROJ);
  { const float* cw = (const float*)a.in[I_CONV]; bf16* QC = (bf16*)(ws + WS_QC); bf16* KC = (bf16*)(ws + WS_KC);
    for (int i = F.vcu * NTHR + F.tid; i < MTOK * 128; i += F.G * NTHR) { const int m = i >> 7, c = (i & 127) * 8, t = m & (SEQ - 1);
      float x1[8], x0[8], x2[8]; unpack8(*(const v4u*)(P + (size_t)m * PROJ_LD + c), x1);
      if (t > 0) unpack8(*(const v4u*)(P + (size_t)(m - 1) * PROJ_LD + c), x0); else {
#pragma unroll
        for (int j = 0; j < 8; ++j) x0[j] = 0.f; }
      if (t < SEQ - 1) unpack8(*(const v4u*)(P + (size_t)(m + 1) * PROJ_LD + c), x2); else {
#pragma unroll
        for (int j = 0; j < 8; ++j) x2[j] = 0.f; }
      float o[8];
#pragma unroll
      for (int j = 0; j < 8; ++j) { float v = x0[j] * cw[c + j] + x1[j] * cw[1024 + c + j] + x2[j] * cw[2048 + c + j]; v = v * sigmoidf_(v); o[j] = (c < 512) ? v : v * 0.08838834764831845f; }
      if (c < 512) *(v4u*)(QC + (size_t)m * 512 + c) = pack8(o); else *(v4u*)(KC + (size_t)m * 512 + c - 512) = pack8(o); } }
  { const float* rope = (const float*)(ws + WS_ROPE); bf16* KMp = (bf16*)(ws + WS_KM);
    for (int i = F.vcu * NTHR + F.tid; i < MTOK * 16; i += F.G * NTHR) { const int m = i >> 4, j = i & 15;
      const float t1 = bf2f(P[(size_t)m * PROJ_LD + PC_KR + j]), t2 = bf2f(P[(size_t)m * PROJ_LD + PC_KR + 16 + j]); const float c = rope[m * 32 + j], s = rope[m * 32 + 16 + j];
      const bf16 o1 = (bf16)f2bf(t1 * c - t2 * s), o2 = (bf16)f2bf(t2 * c + t1 * s);
#pragma unroll
      for (int h = 0; h < 8; ++h) { KMp[(size_t)m * 768 + h * 96 + 64 + j] = o1; KMp[(size_t)m * 768 + h * 96 + 80 + j] = o2; } } }
  { const float* bg = (const float*)a.in[I_BG]; float* GSC = (float*)(ws + WS_GSC); float* DEC = (float*)(ws + WS_DEC);
    const int gw = F.vcu * NWAVES + F.wave, NGW = F.G * NWAVES;
    for (int it = gw; it < 32 * 64; it += NGW) { const int seq = it >> 6, c = it & 63, dir = seq & 1, h = (seq >> 1) & 3, b = seq >> 3;
      const int p = c * 64 + F.lane, t = dir ? (SEQ - 1 - p) : p; const size_t row = (size_t)b * SEQ + t;
      const int gi = (dir ? 8 : 0) + h, gf = (dir ? 12 : 4) + h;
      const float li = bf2f(P[row * PROJ_LD + PC_G + gi]) + bg[gi]; const float lf = log_sigmoid(bf2f(P[row * PROJ_LD + PC_G + gf]) + bg[gf]);
      float bs = lf;
#pragma unroll
      for (int o = 1; o < 64; o <<= 1) { const float y = __shfl_up(bs, o); if (F.lane >= o) bs += y; }
      const float av = li - bs; float pm = av;
#pragma unroll
      for (int o = 1; o < 64; o <<= 1) { const float y = __shfl_up(pm, o); if (F.lane >= o) pm = fmaxf(pm, y); }
      float* gs = GSC + (size_t)seq * 3 * SEQ; gs[p] = bs; gs[SEQ + p] = av; gs[2 * SEQ + p] = pm;
      if (F.lane == 63) { DEC[seq * 128 + c] = bs; DEC[seq * 128 + 64 + c] = pm; } } }
}
namespace mla {
constexpr int DQK = 96, DV = 64, NW = 8, QBLK = 32, KVBLK = 64, LDQ = 768, LDK = 768, LDV = 512, LDO = 1024;
constexpr float SCALE = 0.10206207261596575f;
constexpr float THR = 8.f;
constexpr int SHM_V = 16384, SHM_K = 16384, SHM_ATTN = 2 * SHM_V + 2 * SHM_K + NW * 64 * 4;
#define KSWZ(row, colB) ((row) * 256 + ((colB) ^ (((row) & 7) << 4)))
#define SBAR() __builtin_amdgcn_sched_barrier(0)
__device__ __forceinline__ int crow(int r, int hi) { return (r & 3) + 8 * (r >> 2) + 4 * hi; }
__device__ __forceinline__ void partialSM(f32x16& p0, f32x16& p1, float& m_reg, float& mn, float& alpha) {
  constexpr float C = SCALE * 1.4426950408889634f;
  float pmax = p0[0];
#pragma unroll
  for (int r = 1; r < 16; ++r) pmax = fmaxf(pmax, p0[r]);
#pragma unroll
  for (int r = 0; r < 16; ++r) pmax = fmaxf(pmax, p1[r]);
  { auto rr = __builtin_amdgcn_permlane32_swap(__float_as_uint(pmax), __float_as_uint(pmax), false, false);
    pmax = fmaxf(__uint_as_float(rr[0]), __uint_as_float(rr[1])); }
  if (__builtin_expect(__all(pmax - m_reg <= THR / SCALE), 1)) { mn = m_reg; alpha = 1.f; }
  else { mn = fmaxf(m_reg, pmax); alpha = __builtin_amdgcn_exp2f((m_reg - mn) * C); m_reg = mn; }
  const float mnC = -mn * C;
#pragma unroll
  for (int r = 0; r < 16; ++r) p0[r] = fmaf(p0[r], C, mnC);
#pragma unroll
  for (int r = 0; r < 16; ++r) p1[r] = fmaf(p1[r], C, mnC);
#pragma unroll
  for (int r = 0; r < 16; ++r) p0[r] = __builtin_amdgcn_exp2f(p0[r]);
}
__device__ __forceinline__ void finishSM(f32x16& p0, f32x16& p1, float alpha, float& l_reg, bf16x8& pa0, bf16x8& pa1, bf16x8& pa2, bf16x8& pa3) {
#pragma unroll
  for (int r = 0; r < 16; ++r) p1[r] = __builtin_amdgcn_exp2f(p1[r]);
  float ps = 0;
#pragma unroll
  for (int r = 0; r < 16; ++r) ps += p0[r];
#pragma unroll
  for (int r = 0; r < 16; ++r) ps += p1[r];
  { auto rr = __builtin_amdgcn_permlane32_swap(__float_as_uint(ps), __float_as_uint(ps), false, false);
    ps = __uint_as_float(rr[0]) + __uint_as_float(rr[1]); }
  l_reg = l_reg * alpha + ps;
#define PK4(P, BASE, OUT) do { unsigned a0 = cvt_pk_bf16(P[BASE + 0], P[BASE + 1]), a1 = cvt_pk_bf16(P[BASE + 2], P[BASE + 3]);   \
    unsigned b0 = cvt_pk_bf16(P[BASE + 4], P[BASE + 5]), b1 = cvt_pk_bf16(P[BASE + 6], P[BASE + 7]);                              \
    auto r0 = __builtin_amdgcn_permlane32_swap(a0, b0, false, false); auto r1 = __builtin_amdgcn_permlane32_swap(a1, b1, false, false); \
    v4u w = {r0[0], r1[0], r0[1], r1[1]}; OUT = __builtin_bit_cast(bf16x8, w); } while (0)
  PK4(p0, 0, pa0); PK4(p0, 8, pa1); PK4(p1, 0, pa2); PK4(p1, 8, pa3);
#undef PK4
}
__device__ __forceinline__ void qkt(f32x16& p0, f32x16& p1, const char* Ks, const bf16x8* qr, int r32, int hi) {
  p0 = f32x16{}; p1 = f32x16{};
#pragma unroll
  for (int d0 = 0; d0 < DQK / 16; ++d0) { const int cb = (d0 * 16 + hi * 8) * 2;
    const bf16x8 b0 = *reinterpret_cast<const bf16x8*>(Ks + KSWZ(r32, cb));
    const bf16x8 b1 = *reinterpret_cast<const bf16x8*>(Ks + KSWZ(32 + r32, cb));
    p0 = __builtin_amdgcn_mfma_f32_32x32x16_bf16(b0, qr[d0], p0, 0, 0, 0);
    p1 = __builtin_amdgcn_mfma_f32_32x32x16_bf16(b1, qr[d0], p1, 0, 0, 0); }
}
__device__ __forceinline__ int v_st(int k, int c) { const int kk = (k & ~0xC) | ((k & 4) << 1) | ((k & 8) >> 1); return ((kk >> 3) * 4 + (c >> 5)) * 512 + ((kk & 7) * 32 + (c & 31)) * 2; }
__device__ __forceinline__ int v_rd_base(int lane) { return ((lane & 3) << 3) | (((lane >> 2) & 3) << 6) | (((lane >> 4) & 1) << 5) | (((lane >> 5) & 1) << 8); }
constexpr int v_rd_off(int d0, int ks, int half) { return d0 * 512 + ks * 4096 + half * 2048; }
template <int OFF> __device__ __forceinline__ s16x4 tr_read(int vb) {
  s16x4 r; asm volatile("ds_read_b64_tr_b16 %0, %1 offset:%2" : "=&v"(r) : "v"(vb), "i"(OFF) : "memory"); return r;
}
template <int D0> __device__ __forceinline__ void pv_one(f32x16& od, int vb, bf16x8 pa0, bf16x8 pa1, bf16x8 pa2, bf16x8 pa3) {
  const s16x4 l0 = tr_read<v_rd_off(D0, 0, 0)>(vb), h0 = tr_read<v_rd_off(D0, 0, 1)>(vb), l1 = tr_read<v_rd_off(D0, 1, 0)>(vb), h1 = tr_read<v_rd_off(D0, 1, 1)>(vb);
  const s16x4 l2 = tr_read<v_rd_off(D0, 2, 0)>(vb), h2 = tr_read<v_rd_off(D0, 2, 1)>(vb), l3 = tr_read<v_rd_off(D0, 3, 0)>(vb), h3 = tr_read<v_rd_off(D0, 3, 1)>(vb);
  asm volatile("s_waitcnt lgkmcnt(0)" ::: "memory"); SBAR();
#define PK(L, H) (bf16x8){L[0], L[1], L[2], L[3], H[0], H[1], H[2], H[3]}
  od = __builtin_amdgcn_mfma_f32_32x32x16_bf16(pa0, PK(l0, h0), od, 0, 0, 0);
  od = __builtin_amdgcn_mfma_f32_32x32x16_bf16(pa1, PK(l1, h1), od, 0, 0, 0);
  od = __builtin_amdgcn_mfma_f32_32x32x16_bf16(pa2, PK(l2, h2), od, 0, 0, 0);
  od = __builtin_amdgcn_mfma_f32_32x32x16_bf16(pa3, PK(l3, h3), od, 0, 0, 0);
#undef PK
}
__device__ __forceinline__ void pv_d0(f32x16* o, int vb, bf16x8 pa0, bf16x8 pa1, bf16x8 pa2, bf16x8 pa3) {
  pv_one<0>(o[0], vb, pa0, pa1, pa2, pa3); pv_one<1>(o[1], vb, pa0, pa1, pa2, pa3);
}
__device__ __forceinline__ void attn_unit(const bf16* __restrict__ Qb, const bf16* __restrict__ Kh, const bf16* __restrict__ Vh, bf16* __restrict__ Yb, const float* __restrict__ gh, int seq, char* lds) {
  int tid = threadIdx.x; asm volatile("" : "+v"(tid));
  const int wid = tid >> 6, lane = tid & 63, r32 = lane & 31, hi = lane >> 5;
  char* V_lds = lds; char* K_lds = lds + 2 * SHM_V;
  float* wsf = (float*)(lds + 2 * SHM_V + 2 * SHM_K) + wid * 64; float* li_l = wsf; float* al_l = wsf + 32;
  float m_reg = -1e30f, l_reg = 0; f32x16 o[2] = {}; bf16x8 qr[DQK / 16];
  const bf16* Qw = Qb + (long)(wid * QBLK + r32) * LDQ + hi * 8;
#pragma unroll
  for (int d0 = 0; d0 < DQK / 16; ++d0) qr[d0] = *reinterpret_cast<const bf16x8*>(Qw + d0 * 16);
  const int sr = tid >> 4, sc = (tid & 15) * 8, vst0 = v_st(sr, sc & 63), vst1 = v_st(32 + sr, sc & 63);
  const bool doK = sc < DQK, doV = sc < DV;
  const int vb0 = (int)(uintptr_t)V_lds + v_rd_base(lane);
  struct { bf16x8 vs0, vs1, ks0, ks1; } sr_[2];
#define SLOAD(i, k0) do { if (doV) { sr_[i].vs0 = *reinterpret_cast<const bf16x8*>(&Vh[(long)((k0) + sr) * LDV + sc]); sr_[i].vs1 = *reinterpret_cast<const bf16x8*>(&Vh[(long)((k0) + 32 + sr) * LDV + sc]); } \
    if (doK) { sr_[i].ks0 = *reinterpret_cast<const bf16x8*>(&Kh[(long)((k0) + sr) * LDK + sc]); sr_[i].ks1 = *reinterpret_cast<const bf16x8*>(&Kh[(long)((k0) + 32 + sr) * LDK + sc]); } } while (0)
#define SWRITE(b, i) do { if (doV) { *(bf16x8*)(V_lds + (b) * SHM_V + vst0) = sr_[i].vs0; *(bf16x8*)(V_lds + (b) * SHM_V + vst1) = sr_[i].vs1; } \
    if (doK) { const int kc = sc * 2; *(bf16x8*)(K_lds + (b) * SHM_K + KSWZ(sr, kc)) = sr_[i].ks0; *(bf16x8*)(K_lds + (b) * SHM_K + KSWZ(32 + sr, kc)) = sr_[i].ks1; } } while (0)
#define SWAIT() asm volatile("s_waitcnt vmcnt(4)" ::: "memory")
#define RESC(a) do { if (__any((a) < 1.f)) { if (hi == 0) al_l[r32] = (a); asm volatile("s_waitcnt lgkmcnt(0)" ::: "memory"); \
    _Pragma("unroll") for (int d = 0; d < 2; ++d) _Pragma("unroll") for (int r = 0; r < 16; ++r) o[d][r] *= al_l[crow(r, hi)]; } } while (0)
  f32x16 pA0, pA1, pB0, pB1; float mnA, mnB, alA, alB; bf16x8 pa0, pa1, pa2, pa3; const int NT = seq / KVBLK;
  constexpr int SE = 0, SO = 1;
  SLOAD(SE, 0); asm volatile("s_waitcnt vmcnt(0)" ::: "memory"); SWRITE(0, SE); __syncthreads();
  qkt(pA0, pA1, K_lds, qr, r32, hi); partialSM(pA0, pA1, m_reg, mnA, alA);
  SLOAD(SO, KVBLK); if (2 < NT) SLOAD(SE, 2 * KVBLK);
  SWAIT(); SWRITE(1, SO); __syncthreads();
  for (int j = 1; j + 1 < NT; j += 2) {
    SBAR(); qkt(pB0, pB1, K_lds + SHM_K, qr, r32, hi);
    finishSM(pA0, pA1, alA, l_reg, pa0, pa1, pa2, pa3); SBAR();
    SLOAD(SO, (j + 2) * KVBLK); SBAR();
    pv_d0(o, vb0, pa0, pa1, pa2, pa3); partialSM(pB0, pB1, m_reg, mnB, alB);
    __syncthreads(); SWAIT(); SWRITE(0, SE);
    RESC(alB); __syncthreads();
    SBAR(); qkt(pA0, pA1, K_lds, qr, r32, hi);
    finishSM(pB0, pB1, alB, l_reg, pa0, pa1, pa2, pa3); SBAR();
    if (j + 3 < NT) SLOAD(SE, (j + 3) * KVBLK); SBAR();
    pv_d0(o, vb0 + SHM_V, pa0, pa1, pa2, pa3); partialSM(pA0, pA1, m_reg, mnA, alA);
    __syncthreads(); SWAIT(); SWRITE(1, SO);
    RESC(alA); __syncthreads();
  }
  SBAR(); qkt(pB0, pB1, K_lds + SHM_K, qr, r32, hi);
  finishSM(pA0, pA1, alA, l_reg, pa0, pa1, pa2, pa3); SBAR();
  pv_d0(o, vb0, pa0, pa1, pa2, pa3); partialSM(pB0, pB1, m_reg, mnB, alB);
  __syncthreads(); RESC(alB);
  finishSM(pB0, pB1, alB, l_reg, pa0, pa1, pa2, pa3); SBAR();
  pv_d0(o, vb0 + SHM_V, pa0, pa1, pa2, pa3);
  __syncthreads();
  { float* st = (float*)lds + wid * (32 * 68);
#pragma unroll
    for (int r = 0; r < 16; ++r) { const int orow = crow(r, hi); st[orow * 68 + r32] = o[0][r]; st[orow * 68 + 32 + r32] = o[1][r]; }
    asm volatile("s_waitcnt lgkmcnt(0)" ::: "memory");
    float v[32]; float s = 0.f;
#pragma unroll
    for (int j = 0; j < 8; ++j) { const f32x4 t = *(const f32x4*)(st + r32 * 68 + hi * 32 + 4 * j); v[4 * j] = t.x; v[4 * j + 1] = t.y; v[4 * j + 2] = t.z; v[4 * j + 3] = t.w; s += (t.x * t.x + t.y * t.y) + (t.z * t.z + t.w * t.w); }
    { auto rr = __builtin_amdgcn_permlane32_swap(__float_as_uint(s), __float_as_uint(s), false, false); s = __uint_as_float(rr[0]) + __uint_as_float(rr[1]); }
    const float rl = 1.f / l_reg; const float fac = rl * rsqrtf(s * rl * rl * (1.f / 64.f) + 1e-6f);
    bf16* yp = Yb + (long)(wid * QBLK + r32) * LDO + hi * 32; const float* gp = gh + hi * 32;
#pragma unroll
    for (int j = 0; j < 4; ++j) { float w[8];
#pragma unroll
      for (int e = 0; e < 8; ++e) w[e] = v[8 * j + e] * fac * gp[8 * j + e];
      *(v4u*)(yp + 8 * j) = pack8(w); } }
  __syncthreads();
#undef SLOAD
#undef SWRITE
#undef SWAIT
#undef RESC
}
#undef KSWZ
#undef SBAR
}

__device__ __forceinline__ int queue_pull(Frame& F, gu32* heads, int nq, int nper, int myq) {
  volatile LAS int* slot = (volatile LAS int*)(F.lds + LDSCTL_OFF);
  if (F.tid == 0) { int got = -1;
    for (int k = 0; k < nq; ++k) { const int q = (myq + k) % nq;
      if (__hip_atomic_load(heads + 64 * q, RLX_AGENT) >= (unsigned)nper) continue;
      const unsigned i = __hip_atomic_fetch_add(heads + 64 * q, 1u, RLX_AGENT);
      if (i < (unsigned)nper) { got = q * nper + (int)i; break; } }
    *slot = got; }
  __syncthreads();
  const int r = __builtin_amdgcn_readfirstlane(*slot);
  __syncthreads();
  return r;
}
__device__ __forceinline__ void p3_attention(Frame& F, const Args& a, char* lds_generic, unsigned xcc, int qoff) {
  unsigned char* ws = F.ws;
  const bf16* QMp = (const bf16*)(ws + WS_QM); const bf16* KMp = (const bf16*)(ws + WS_KM); const bf16* VMp = (const bf16*)(ws + WS_VM); bf16* Y = (bf16*)(ws + WS_Y);
  for (;;) {
    const int u = queue_pull(F, F.ctl + CW_Q + qoff, 8, 64, (int)(xcc & 7u));
    if (u < 0) break;
    const int bh = u >> 4, qb = u & 15, b = bh >> 3, h = bh & 7;
    mla::attn_unit(QMp + ((size_t)b * SEQ + qb * 256) * 768 + h * 96, KMp + (size_t)b * SEQ * 768 + h * 96, VMp + (size_t)b * SEQ * 512 + h * 64,
                   Y + ((size_t)b * SEQ + qb * 256) * 1024 + 512 + h * 64, (const float*)a.in[I_GHA] + h * 64, SEQ, lds_generic);
  }
}
namespace mls {
using mla::crow; using mla::v_st; using mla::v_rd_base;
#define KSWZ(row, colB) ((row) * 256 + ((colB) ^ (((row) & 7) << 4)))
constexpr int OFF_QS = 0, OFF_KS = 16384, OFF_KP = 32768, OFF_VV = 49152, OFF_CT = 65536, OFF_SC = 98304, OFF_NB = 99328, OFF_NP = 100352, OFF_CH = 104448, OFF_WS = 105472;
template <int OFF> __device__ __forceinline__ s16x4 trr(int vb) { s16x4 r; asm volatile("ds_read_b64_tr_b16 %0, %1 offset:%2" : "=&v"(r) : "v"(vb), "i"(OFF) : "memory"); return r; }
#define PKF(L, H) (bf16x8){L[0], L[1], L[2], L[3], H[0], H[1], H[2], H[3]}
__device__ __forceinline__ void vfrags(int img, int d0, int lane, bf16x8 (&f)[4]) {
  const int vb = img + v_rd_base(lane) + d0 * 512;
  const s16x4 l0 = trr<0>(vb), h0 = trr<2048>(vb), l1 = trr<4096>(vb), h1 = trr<4096 + 2048>(vb), l2 = trr<8192>(vb), h2 = trr<8192 + 2048>(vb), l3 = trr<12288>(vb), h3 = trr<12288 + 2048>(vb);
  asm volatile("s_waitcnt lgkmcnt(0)" ::: "memory"); __builtin_amdgcn_sched_barrier(0);
  f[0] = PKF(l0, h0); f[1] = PKF(l1, h1); f[2] = PKF(l2, h2); f[3] = PKF(l3, h3);
}
__device__ __forceinline__ void pack_p(const f32x16& p0, const f32x16& p1, bf16x8& pa0, bf16x8& pa1, bf16x8& pa2, bf16x8& pa3) {
#define PK4(P, BASE, OUT) do { unsigned a0 = cvt_pk_bf16(P[BASE + 0], P[BASE + 1]), a1 = cvt_pk_bf16(P[BASE + 2], P[BASE + 3]);   \
    unsigned b0 = cvt_pk_bf16(P[BASE + 4], P[BASE + 5]), b1 = cvt_pk_bf16(P[BASE + 6], P[BASE + 7]);                              \
    auto r0 = __builtin_amdgcn_permlane32_swap(a0, b0, false, false); auto r1 = __builtin_amdgcn_permlane32_swap(a1, b1, false, false); \
    v4u w = {r0[0], r1[0], r0[1], r1[1]}; OUT = __builtin_bit_cast(bf16x8, w); } while (0)
  PK4(p0, 0, pa0); PK4(p0, 8, pa1); PK4(p1, 0, pa2); PK4(p1, 8, pa3);
#undef PK4
}
__device__ __forceinline__ float swap_add(float v) { auto rr = __builtin_amdgcn_permlane32_swap(__float_as_uint(v), __float_as_uint(v), false, false); return __uint_as_float(rr[0]) + __uint_as_float(rr[1]); }

__device__ __forceinline__ void mlstm_seq(int seq, unsigned char* ws, char* lds) {
  int tid = threadIdx.x; asm volatile("" : "+v"(tid));
  const int wid = __builtin_amdgcn_readfirstlane(tid >> 6), lane = tid & 63, r32 = lane & 31, hi = lane >> 5, rb = wid >> 2, cb = wid & 3;
  const int dir = seq & 1, h = (seq >> 1) & 3, b = seq >> 3;
  const bf16* QC = (const bf16*)(ws + WS_QC); const bf16* KC = (const bf16*)(ws + WS_KC); const bf16* P = (const bf16*)(ws + WS_PROJ);
  const float* gs = (const float*)(ws + WS_GSC) + (size_t)seq * 3 * SEQ; const float* dec = (const float*)(ws + WS_DEC) + seq * 128;
  bf16* H = (bf16*)(ws + (dir ? WS_HB : WS_HF));
  float* sc_alpha = (float*)(lds + OFF_SC); float* sc_a = sc_alpha + 64; float* sc_iw = sc_alpha + 128; float* sc_en = sc_alpha + 192;
  float* nbuf = (float*)(lds + OFF_NB); float* npart = (float*)(lds + OFF_NP);
  float* ch_mprev = (float*)(lds + OFF_CH); float* ch_mnew = ch_mprev + 64; float* ch_dec = ch_mprev + 128; float* ch_g = ch_mprev + 192;
  float* wsf = (float*)(lds + OFF_WS) + wid * 32;
  const int ldsb = (int)(uintptr_t)lds;
  if (tid < 64) {
    if (tid == 0) { float m = 0.f; for (int c = 0; c < 64; ++c) { const float g = dec[c], wm = dec[64 + c]; const float mn = fmaxf(g + m, g + wm); ch_mprev[c] = m; ch_mnew[c] = mn; ch_dec[c] = __expf(g + m - mn); ch_g[c] = g; m = mn; } } }
  for (int i = tid; i < 32768 / 16; i += NTHR) ((v4u*)(lds + OFF_CT))[i] = (v4u){0u, 0u, 0u, 0u};
  if (tid < 128) nbuf[tid] = 0.f;
  f32x16 cacc[2]; cacc[0] = f32x16{}; cacc[1] = f32x16{};
  __syncthreads();
  const int sr = tid >> 4, sc = (tid & 15) * 8;
  v4u gq0, gq1, gk0, gk1, gv0, gv1; float ga0, ga1, sb = 0.f, sa = 0.f, spm = 0.f;
#define ROWOF(p) ((size_t)b * SEQ + (dir ? (SEQ - 1 - (p)) : (p)))
#define LOADC(c) do { const int p0_ = 64 * (c) + sr, p1_ = p0_ + 32; const size_t r0_ = ROWOF(p0_), r1_ = ROWOF(p1_); \
    gq0 = *(const v4u*)(QC + r0_ * 512 + h * 128 + sc); gq1 = *(const v4u*)(QC + r1_ * 512 + h * 128 + sc); \
    gk0 = *(const v4u*)(KC + r0_ * 512 + h * 128 + sc); gk1 = *(const v4u*)(KC + r1_ * 512 + h * 128 + sc); \
    gv0 = *(const v4u*)(P + r0_ * PROJ_LD + 1024 + h * 128 + sc); gv1 = *(const v4u*)(P + r1_ * PROJ_LD + 1024 + h * 128 + sc); \
    ga0 = gs[SEQ + p0_]; ga1 = gs[SEQ + p1_]; \
    if (tid < 64) { sb = gs[64 * (c) + tid]; sa = gs[SEQ + 64 * (c) + tid]; spm = gs[2 * SEQ + 64 * (c) + tid]; } } while (0)
#define WRITEC(c) do { \
    *(v4u*)(lds + OFF_QS + KSWZ(sr, sc * 2)) = gq0; *(v4u*)(lds + OFF_QS + KSWZ(32 + sr, sc * 2)) = gq1; \
    *(v4u*)(lds + OFF_KS + KSWZ(sr, sc * 2)) = gk0; *(v4u*)(lds + OFF_KS + KSWZ(32 + sr, sc * 2)) = gk1; \
    *(v4u*)(lds + OFF_VV + v_st(sr, sc)) = gv0; *(v4u*)(lds + OFF_VV + v_st(32 + sr, sc)) = gv1; \
    { const float gc_ = ch_g[c], mn_ = ch_mnew[c]; const float w0_ = __expf(gc_ + ga0 - mn_), w1_ = __expf(gc_ + ga1 - mn_); float f0_[8], f1_[8], cs_[8]; unpack8(gk0, f0_); unpack8(gk1, f1_); \
      _Pragma("unroll") for (int j = 0; j < 8; ++j) { f0_[j] *= w0_; f1_[j] *= w1_; cs_[j] = f0_[j] + f1_[j]; } \
      *(v4u*)(lds + OFF_KP + v_st(sr, sc)) = pack8(f0_); *(v4u*)(lds + OFF_KP + v_st(32 + sr, sc)) = pack8(f1_); \
      _Pragma("unroll") for (int j = 0; j < 8; ++j) { cs_[j] += __shfl_xor(cs_[j], 16); cs_[j] += __shfl_xor(cs_[j], 32); } \
      if ((lane >> 4) == 0) { _Pragma("unroll") for (int j = 0; j < 8; ++j) npart[wid * 128 + sc + j] = cs_[j]; } } \
    if (tid < 64) { const float m_ = ch_mprev[c]; const float mt_ = fmaxf(sb + m_, sb + spm); sc_alpha[tid] = sb - mt_; sc_a[tid] = sa; sc_iw[tid] = __expf(sb + m_ - mt_); sc_en[tid] = __expf(-mt_); } } while (0)
  LOADC(0); WRITEC(0);
  __syncthreads();
  for (int c = 0; c < 64; ++c) {
    if (c + 1 < 64) LOADC(c + 1);
    const float* nb = nbuf + (c & 1) * 128;
    if (tid < 128) { float s = 0.f;
#pragma unroll
      for (int w = 0; w < 8; ++w) s += npart[w * 128 + tid];
      nbuf[((c + 1) & 1) * 128 + tid] = ch_dec[c] * nb[tid] + s; }
    bf16x8 qr[8];
#pragma unroll
    for (int d0 = 0; d0 < 8; ++d0) qr[d0] = *(const bf16x8*)(lds + OFF_QS + KSWZ(32 * rb + r32, (16 * d0 + 8 * hi) * 2));
    f32x16 p0 = f32x16{}, p1 = f32x16{};
#pragma unroll
    for (int d0 = 0; d0 < 8; ++d0) { const bf16x8 k0 = *(const bf16x8*)(lds + OFF_KS + KSWZ(r32, (16 * d0 + 8 * hi) * 2)); p0 = __builtin_amdgcn_mfma_f32_32x32x16_bf16(k0, qr[d0], p0, 0, 0, 0); }
    if (rb == 1) {
#pragma unroll
      for (int d0 = 0; d0 < 8; ++d0) { const bf16x8 k1 = *(const bf16x8*)(lds + OFF_KS + KSWZ(32 + r32, (16 * d0 + 8 * hi) * 2)); p1 = __builtin_amdgcn_mfma_f32_32x32x16_bf16(k1, qr[d0], p1, 0, 0, 0); }
    }
    const float al = sc_alpha[32 * rb + r32];
    if (rb == 0) {
#pragma unroll
      for (int r = 0; r < 16; ++r) { const int sl = crow(r, hi); p0[r] = (sl <= r32) ? __expf(al + sc_a[sl]) * p0[r] : 0.f; }
    } else {
#pragma unroll
      for (int r = 0; r < 16; ++r) { const int sl = crow(r, hi); p0[r] = __expf(al + sc_a[sl]) * p0[r]; p1[r] = (sl <= r32) ? __expf(al + sc_a[32 + sl]) * p1[r] : 0.f; }
    }
    float ps = 0.f;
#pragma unroll
    for (int r = 0; r < 16; ++r) ps += p0[r] + p1[r];
    ps = swap_add(ps);
    bf16x8 pa0, pa1, pa2, pa3; pack_p(p0, p1, pa0, pa1, pa2, pa3);
    float qn = 0.f;
#pragma unroll
    for (int d0 = 0; d0 < 8; ++d0) { const f32x4 n0 = *(const f32x4*)(nb + 16 * d0 + 8 * hi), n1 = *(const f32x4*)(nb + 16 * d0 + 8 * hi + 4); const v4u qw = __builtin_bit_cast(v4u, qr[d0]);
      qn += bflo(qw.x) * n0.x + bfhi(qw.x) * n0.y + bflo(qw.y) * n0.z + bfhi(qw.y) * n0.w + bflo(qw.z) * n1.x + bfhi(qw.z) * n1.y + bflo(qw.w) * n1.z + bfhi(qw.w) * n1.w; }
    qn = swap_add(qn);
    { const float iwt = sc_iw[32 * rb + r32]; const float den = iwt * qn + ps; const float rd = 1.f / fmaxf(fabsf(den), sc_en[32 * rb + r32]); if (hi == 0) wsf[r32] = rd; }
    f32x16 o = f32x16{};
#pragma unroll
    for (int d0 = 0; d0 < 8; ++d0) { const bf16x8 cf = *(const bf16x8*)(lds + OFF_CT + KSWZ(32 * cb + r32, (16 * d0 + 8 * hi) * 2)); o = __builtin_amdgcn_mfma_f32_32x32x16_bf16(qr[d0], cf, o, 0, 0, 0); }
#pragma unroll
    for (int r = 0; r < 16; ++r) o[r] *= sc_iw[32 * rb + crow(r, hi)];
    bf16x8 vf[4]; vfrags(ldsb + OFF_VV, cb, lane, vf);
    o = __builtin_amdgcn_mfma_f32_32x32x16_bf16(pa0, vf[0], o, 0, 0, 0); o = __builtin_amdgcn_mfma_f32_32x32x16_bf16(pa1, vf[1], o, 0, 0, 0);
    if (rb == 1) { o = __builtin_amdgcn_mfma_f32_32x32x16_bf16(pa2, vf[2], o, 0, 0, 0); o = __builtin_amdgcn_mfma_f32_32x32x16_bf16(pa3, vf[3], o, 0, 0, 0); }
    asm volatile("s_waitcnt lgkmcnt(0)" ::: "memory");
#pragma unroll
    for (int r = 0; r < 16; ++r) { const int tl = crow(r, hi); const int p = 64 * c + 32 * rb + tl; H[ROWOF(p) * 512 + h * 128 + 32 * cb + r32] = (bf16)f2bf(o[r] * wsf[tl]); }
    { const float dc = ch_dec[c];
#pragma unroll
      for (int i = 0; i < 2; ++i) { bf16x8 kf[4]; vfrags(ldsb + OFF_KP, 2 * rb + i, lane, kf);
#pragma unroll
        for (int r = 0; r < 16; ++r) cacc[i][r] *= dc;
#pragma unroll
        for (int ks = 0; ks < 4; ++ks) cacc[i] = __builtin_amdgcn_mfma_f32_32x32x16_bf16(kf[ks], vf[ks], cacc[i], 0, 0, 0); } }
    __syncthreads();
#pragma unroll
    for (int i = 0; i < 2; ++i)
#pragma unroll
      for (int g = 0; g < 4; ++g) { const int d = 32 * (2 * rb + i) + 8 * g + 4 * hi, e = 32 * cb + r32;
        v2u w; w.x = cvt_pk_bf16(cacc[i][4 * g], cacc[i][4 * g + 1]); w.y = cvt_pk_bf16(cacc[i][4 * g + 2], cacc[i][4 * g + 3]);
        *(v2u*)(lds + OFF_CT + KSWZ(e, d * 2)) = w; }
    if (c + 1 < 64) WRITEC(c + 1);
    __syncthreads();
  }
#undef ROWOF
#undef LOADC
#undef WRITEC
}
#undef KSWZ
#undef PKF
}

__device__ __forceinline__ void p3_mixers(Frame& F, const Args& a, char* lds_generic, unsigned xcc, int qoff) {
#ifndef DRY_MODE
#define DRY_MODE 0
#endif
  bool did_mlstm = false;
  if (!(qoff && DRY_MODE == 2))
  for (;;) { const int it = queue_pull(F, F.ctl + CW_Q + qoff + 64 * 8, 8, 4, (int)(xcc & 7u)); if (it < 0) break; mls::mlstm_seq(it, F.ws, lds_generic); __syncthreads();  }
  if (!(qoff && DRY_MODE == 1))
  p3_attention(F, a, lds_generic, xcc, qoff);
#ifndef P3_FILL_CHUNKS
#define P3_FILL_CHUNKS 9
#endif
  if (!qoff && !did_mlstm) conv_fill(F, a, P3_FILL_CHUNKS);
}
__device__ __forceinline__ void p4_combine(Frame& F, const Args& a) {
  unsigned char* ws = F.ws; const bf16* HF = (const bf16*)(ws + WS_HF); const bf16* HB = (const bf16*)(ws + WS_HB); const bf16* P = (const bf16*)(ws + WS_PROJ); bf16* Y = (bf16*)(ws + WS_Y);
  const float* g = (const float*)a.in[I_GHM];
  const int gw = F.vcu * NWAVES + F.wave, NGW = F.G * NWAVES, c = F.lane * 8;
  float gg[8];
#pragma unroll
  for (int j = 0; j < 8; ++j) gg[j] = g[c + j];
  for (int m = gw; m < MTOK; m += NGW) {
    float f[8], bb[8], oo[8]; unpack8(*(const v4u*)(HF + (size_t)m * 512 + c), f); unpack8(*(const v4u*)(HB + (size_t)m * 512 + c), bb); unpack8(*(const v4u*)(P + (size_t)m * PROJ_LD + 1536 + c), oo);
    float s = 0.f;
#pragma unroll
    for (int j = 0; j < 8; ++j) { f[j] += bb[j]; s += f[j] * f[j]; }
    s += __shfl_xor(s, 1); s += __shfl_xor(s, 2); s += __shfl_xor(s, 4); s += __shfl_xor(s, 8);
    const float r = rsqrtf(s * (1.f / 128.f) + 1e-6f);
#pragma unroll
    for (int j = 0; j < 8; ++j) f[j] = f[j] * r * gg[j] * sigmoidf_(oo[j]);
    *(v4u*)(Y + (size_t)m * 1024 + c) = pack8(f);
  }
}
struct EpiResid { static constexpr bool TWO_PASS = false; const float* base; float* out; bf16* outb; float* ss; int doq; unsigned char* outq;
  __device__ __forceinline__ void row8(const pg8::Unit& u, int rloc, int cloc, const float (&a0)[8], const float (&a1)[8], int fq) const {
    const int row = u.pm * 256 + rloc; const size_t off = (size_t)row * 1024 + u.pn * 256 + cloc;
    const f32x4 b0 = *(const f32x4*)(base + off), b1 = *(const f32x4*)(base + off + 4), b2 = *(const f32x4*)(base + off + 128), b3 = *(const f32x4*)(base + off + 132);
    float v0[8], v1[8];
#pragma unroll
    for (int i = 0; i < 4; ++i) { v0[i] = a0[i] + b0[i]; v0[4 + i] = a0[4 + i] + b1[i]; v1[i] = a1[i] + b2[i]; v1[4 + i] = a1[4 + i] + b3[i]; }
    *(f32x4*)(out + off) = (f32x4){v0[0], v0[1], v0[2], v0[3]}; *(f32x4*)(out + off + 4) = (f32x4){v0[4], v0[5], v0[6], v0[7]};
    *(f32x4*)(out + off + 128) = (f32x4){v1[0], v1[1], v1[2], v1[3]}; *(f32x4*)(out + off + 132) = (f32x4){v1[4], v1[5], v1[6], v1[7]};
    float s = sumsq8(v0) + sumsq8(v1);
    if (doq) {
#pragma unroll
      for (int i = 0; i < 8; ++i) { v0[i] = q8(v0[i], 1.f); v1[i] = q8(v1[i], 1.f); } }
    *(v4u*)(outb + off) = pack8(v0); *(v4u*)(outb + off + 128) = pack8(v1); s += __shfl_xor(s, 16); s += __shfl_xor(s, 32); if (fq == 0) unsafeAtomicAdd(ss + row, s); } };
struct EpiScale { static constexpr bool TWO_PASS = false; bf16* O; const float* ss;
  __device__ __forceinline__ void row8(const pg8::Unit& u, int rloc, int cloc, const float (&a0)[8], const float (&a1)[8], int fq) const {
    const int row = u.pm * 256 + rloc; const float r = rsqrtf(ss[row] * (1.f / 1024.f) + 1e-6f); float v0[8], v1[8];
#pragma unroll
    for (int i = 0; i < 8; ++i) { v0[i] = a0[i] * r; v1[i] = a1[i] * r; }
    bf16* p = O + (size_t)row * 1024 + u.pn * 256 + cloc; *(v4u*)p = pack8(v0); *(v4u*)(p + 128) = pack8(v1); } };
struct EpiSoftmax { static constexpr bool TWO_PASS = true; bf16* O; float scale; LAS float* xch;
  __device__ __forceinline__ void pass1(const pg8::Unit& u, int rloc, int wc, float (&v0)[8], float (&v1)[8], int fq) const {
    float mx = -3.0e38f;
#pragma unroll
    for (int i = 0; i < 8; ++i) { v0[i] *= scale; v1[i] *= scale; mx = fmaxf(mx, fmaxf(v0[i], v1[i])); }
    mx = fmaxf(mx, __shfl_xor(mx, 16)); mx = fmaxf(mx, __shfl_xor(mx, 32));
    float l = 0.f;
#pragma unroll
    for (int i = 0; i < 8; ++i) { v0[i] = __expf(v0[i] - mx); v1[i] = __expf(v1[i] - mx); l += v0[i] + v1[i]; }
    l += __shfl_xor(l, 16); l += __shfl_xor(l, 32);
    if (fq == 0) { xch[(rloc * 4 + wc) * 2] = mx; xch[(rloc * 4 + wc) * 2 + 1] = l; } }
  __device__ __forceinline__ void row8(const pg8::Unit& u, int rloc, int cloc, const float (&a0)[8], const float (&a1)[8], int fq) const {
    const int wc = cloc >> 5; float m[4], l[4]; float M = -3.0e38f;
#pragma unroll
    for (int w = 0; w < 4; ++w) { m[w] = xch[(rloc * 4 + w) * 2]; l[w] = xch[(rloc * 4 + w) * 2 + 1]; M = fmaxf(M, m[w]); }
    float L = 0.f, mine = 0.f;
#pragma unroll
    for (int w = 0; w < 4; ++w) { const float e = __expf(m[w] - M); L += l[w] * e; if (w == wc) mine = e; }
    const float f = mine / L; float v0[8], v1[8];
#pragma unroll
    for (int i = 0; i < 8; ++i) { v0[i] = a0[i] * f; v1[i] = a1[i] * f; }
    bf16* p = O + (size_t)(u.pm * 256 + rloc) * 1024 + u.pn * 256 + cloc; *(v4u*)p = pack8(v0); *(v4u*)(p + 128) = pack8(v1); } };
struct MemOrder { int G, c, kind;
  __device__ bool next(int i, pg8::Unit& u) const { const int L = i * G + c; if (L >= 256) return false;
    const int bh = L >> 4, t = L & 15, b = bh >> 2, h = bh & 3;
    u.pm = b * 16 + t; u.pn = h; u.g = 0; u.ibase = 0; u.aoff = ((long)(b * SEQ + t * 256)) * 1024 + h * 256;
    u.boff = kind == 0 ? ((long)(b * NMEM)) * 1024 + h * 256 : ((long)(h * 256)) * 1024 + b * NMEM; return true; } };
constexpr size_t WS_WRG = WS_DEC + 65536;
constexpr size_t WS_ROWSEL = WS_SEL, WS_GSEL = WS_SEL + 131072, WS_INV = 31 * MiB, WS_YE = 160 * MiB;
typedef float f32x4m __attribute__((ext_vector_type(4)));
__device__ __forceinline__ void p10_router(Frame& F, const Args& a) {
  unsigned char* ws = F.ws; const float* X2 = (const float*)(ws + WS_X2); const float* ss2 = (const float*)(ws + CTL_SS2); float* AFF = (float*)(ws + WS_AFF); const float* WRG = (const float*)(ws + WS_WRG);
  const int gw = F.vcu * NWAVES + F.wave, NGW = F.G * NWAVES, r = F.lane & 15, kq = F.lane >> 4;
  LAS float* wl = (LAS float*)F.lds;
  for (int i = F.tid; i < 4096; i += NTHR) ((LAS f32x4*)wl)[i] = ((const f32x4*)WRG)[i];
  __syncthreads();
  for (int it = gw; it < MTOK / 16; it += NGW) { const int m0 = it * 16;
    const float* xp = X2 + (size_t)(m0 + r) * 1024 + 4 * kq; const LAS float* wp = wl + (4 * kq) * 16 + r;
    f32x4m acc0 = {0.f, 0.f, 0.f, 0.f}, acc1 = {0.f, 0.f, 0.f, 0.f};
#pragma unroll 1
    for (int hf = 0; hf < 2; ++hf) {
      f32x4 xv[32];
#pragma unroll
      for (int j = 0; j < 32; ++j) xv[j] = *(const f32x4*)(xp + 16 * (32 * hf + j));
#pragma unroll
      for (int j = 0; j < 32; j += 2) { const LAS float* w0 = wp + (16 * (32 * hf + j)) * 16; const LAS float* w1 = w0 + 256;
        acc0 = __builtin_amdgcn_mfma_f32_16x16x4f32(xv[j].x, w0[0], acc0, 0, 0, 0); acc1 = __builtin_amdgcn_mfma_f32_16x16x4f32(xv[j + 1].x, w1[0], acc1, 0, 0, 0);
        acc0 = __builtin_amdgcn_mfma_f32_16x16x4f32(xv[j].y, w0[16], acc0, 0, 0, 0); acc1 = __builtin_amdgcn_mfma_f32_16x16x4f32(xv[j + 1].y, w1[16], acc1, 0, 0, 0);
        acc0 = __builtin_amdgcn_mfma_f32_16x16x4f32(xv[j].z, w0[32], acc0, 0, 0, 0); acc1 = __builtin_amdgcn_mfma_f32_16x16x4f32(xv[j + 1].z, w1[32], acc1, 0, 0, 0);
        acc0 = __builtin_amdgcn_mfma_f32_16x16x4f32(xv[j].w, w0[48], acc0, 0, 0, 0); acc1 = __builtin_amdgcn_mfma_f32_16x16x4f32(xv[j + 1].w, w1[48], acc1, 0, 0, 0); }
    }
#pragma unroll
    for (int i = 0; i < 4; ++i) { const int row = m0 + 4 * kq + i; const float lg = (acc0[i] + acc1[i]) * rsqrtf(ss2[row] * (1.f / 1024.f) + 1e-6f);
      float mx = lg; mx = fmaxf(mx, __shfl_xor(mx, 1)); mx = fmaxf(mx, __shfl_xor(mx, 2)); mx = fmaxf(mx, __shfl_xor(mx, 4)); mx = fmaxf(mx, __shfl_xor(mx, 8));
      const float ex = __expf(lg - mx); float l = ex; l += __shfl_xor(l, 1); l += __shfl_xor(l, 2); l += __shfl_xor(l, 4); l += __shfl_xor(l, 8);
      AFF[(size_t)row * 16 + r] = ex / l; }
  }
  __syncthreads();
}
__device__ __forceinline__ void p11_topk(Frame& F, char* lds) {
  unsigned char* ws = F.ws; const float* AFF = (const float*)(ws + WS_AFF); int* ROWSEL = (int*)(ws + WS_ROWSEL); float* GSEL = (float*)(ws + WS_GSEL); int* INV = (int*)(ws + WS_INV);
  unsigned* hist = (unsigned*)lds; unsigned* ctl = hist + 256; unsigned* wsum = hist + 320;
  const int tid = F.tid, lane = F.lane, wid = F.wave;
  for (int it = (int)blockIdx.x; it < BATCH * NEXP; it += F.G) { const int b = it >> 4, e = it & 15;
    unsigned key[8];
#pragma unroll
    for (int j = 0; j < 8; ++j) key[j] = __float_as_uint(AFF[((size_t)b * SEQ + 8 * tid + j) * 16 + e]);
    unsigned prefix = 0u, mask = 0u, need = CAP;
    for (int shift = 24; shift >= 0; shift -= 8) {
      if (tid < 256) hist[tid] = 0u;
      __syncthreads();
#pragma unroll
      for (int j = 0; j < 8; ++j) if ((key[j] & mask) == prefix) atomicAdd(&hist[(key[j] >> shift) & 255u], 1u);
      __syncthreads();
      if (tid == 0) { unsigned above = 0u; int d = 255; for (; d > 0; --d) { const unsigned c = hist[d]; if (above + c >= need) break; above += c; } ctl[0] = (unsigned)d; ctl[1] = need - above; }
      __syncthreads();
      prefix |= ctl[0] << shift; mask |= 255u << shift; need = ctl[1];
      __syncthreads();
    }
    unsigned ngt = 0u, neq = 0u;
#pragma unroll
    for (int j = 0; j < 8; ++j) { ngt += key[j] > prefix ? 1u : 0u; neq += key[j] == prefix ? 1u : 0u; }
    unsigned sgt = ngt, seq_ = neq;
#pragma unroll
    for (int o = 1; o < 64; o <<= 1) { const unsigned y0 = __shfl_up(sgt, o), y1 = __shfl_up(seq_, o); if (lane >= o) { sgt += y0; seq_ += y1; } }
    if (lane == 63) { wsum[wid] = sgt; wsum[8 + wid] = seq_; }
    __syncthreads();
    unsigned bgt = 0u, beq = 0u, tgt = 0u;
#pragma unroll
    for (int w = 0; w < 8; ++w) { const unsigned g = wsum[w], q = wsum[8 + w]; if (w < wid) { bgt += g; beq += q; } tgt += g; }
    unsigned pgt = bgt + sgt - ngt, peq = beq + seq_ - neq;
#pragma unroll
    for (int j = 0; j < 8; ++j) { const int t = 8 * tid + j; int slot = -1;
      if (key[j] > prefix) slot = (int)pgt++; else if (key[j] == prefix) { if (peq < need) slot = (int)(tgt + peq); ++peq; }
      INV[((size_t)b * SEQ + t) * 16 + e] = slot;
      if (slot >= 0) { ROWSEL[e * 2048 + b * 512 + slot] = b * SEQ + t; GSEL[e * 2048 + b * 512 + slot] = __uint_as_float(key[j]); } }
    __syncthreads();
  }
}
#ifndef GU_ORDER
#define GU_ORDER 1
#endif
#ifndef DN_ORDER
#define DN_ORDER 1
#endif
struct MoeGUOrder { int G, c;
  __device__ bool next(int i, pg8::Unit& u) const { const int L = i * G + c; if (L >= 2048) return false;
#if GU_ORDER == 0
    const int e = L >> 7, r = L & 127, pn = r >> 3, mt = r & 7;
#elif GU_ORDER == 1
    const int e = L >> 7, r = L & 127, mt = r >> 4, pn = r & 15;
#else
    const int x = c & 7, j = c >> 3, e = (i >> 2) * 8 + x, r = (i & 3) * 32 + j, mt = r >> 4, pn = r & 15;
#endif
    u.g = e; u.pm = mt; u.pn = pn; u.ibase = e * 2048 + mt * 256; u.aoff = MOE_FP8 ? ((long)e * 2048 + mt * 256) * 512 : 0; u.boff = ((long)e * 4096 + pn * 256) * (MOE_FP8 ? 512 : 1024); return true; } };
struct MoeDownOrder { int G, c;
  __device__ bool next(int i, pg8::Unit& u) const { const int L = i * G + c; if (L >= 512) return false;
#if DN_ORDER == 0
    const int e = L >> 5, r = L & 31, pn = r >> 3, mt = r & 7;
#else
    const int x = c & 7, j = c >> 3, e = i * 8 + x, pn = j >> 3, mt = j & 7;
#endif
    u.g = e; u.pm = mt; u.pn = pn; u.ibase = e * 2048 + mt * 256; u.aoff = ((long)e * 2048 + mt * 256) * (MOE_FP8_DOWN ? 1024 : 2048); u.boff = ((long)e * 1024 + pn * 256) * (MOE_FP8_DOWN ? 1024 : 2048); return true; } };
struct EpiGU { static constexpr bool TWO_PASS = false; bf16* H; const float* ss2; const int* rowsel;
  __device__ __forceinline__ void row8(const pg8::Unit& u, int rloc, int cloc, const float (&a0)[8], const float (&a1)[8], int fq) const {
    const int tok = rowsel[u.ibase + rloc]; const float r = rsqrtf(ss2[tok] * (1.f / 1024.f) + 1e-6f); float h[8];
#pragma unroll
    for (int i = 0; i < 8; ++i) { const float g = a0[i] * r, up = a1[i] * r; h[i] = g * sigmoidf_(g) * up; if (FP8EMU) h[i] = q8(h[i], 8.f); }
#if MOE_FP8_DOWN
    *(v2u*)((unsigned char*)H + ((size_t)u.g * 2048 + u.pm * 256 + rloc) * 2048 + u.pn * 128 + cloc) = pack8_fp8(h, 8.f); } };
#else
    *(v4u*)(H + ((size_t)u.g * 2048 + u.pm * 256 + rloc) * 2048 + u.pn * 128 + cloc) = pack8(h); } };
#endif
struct EpiGU8 { static constexpr bool TWO_PASS = false; unsigned char* H8; const float* ss2; const int* rowsel;
  __device__ __forceinline__ void row8(const pg8::Unit& u, int rloc, int cloc, const float (&a0)[8], const float (&a1)[8], int fq) const {
    float h[8];
#pragma unroll
    for (int i = 0; i < 8; ++i) { const float g = a0[i], up = a1[i]; h[i] = g * sigmoidf_(g) * up; }
#if MOE_FP8_DOWN
    *(v2u*)(H8 + ((size_t)u.g * 2048 + u.pm * 256 + rloc) * 2048 + u.pn * 128 + cloc) = pack8_fp8(h, 8.f); } };
#else
    *(v4u*)((bf16*)H8 + ((size_t)u.g * 2048 + u.pm * 256 + rloc) * 2048 + u.pn * 128 + cloc) = pack8(h); } };
#endif
struct EpiYE { static constexpr bool TWO_PASS = false; bf16* Yp; const float* gsel;
  __device__ __forceinline__ void row8(const pg8::Unit& u, int rloc, int cloc, const float (&a0)[8], const float (&a1)[8], int fq) const {
    const float gv = gsel[u.ibase + rloc]; float v0[8], v1[8];
#pragma unroll
    for (int i = 0; i < 8; ++i) { v0[i] = a0[i] * gv; v1[i] = a1[i] * gv; }
    bf16* p = Yp + ((size_t)u.g * 2048 + u.pm * 256 + rloc) * 1024 + u.pn * 256 + cloc; *(v4u*)p = pack8(v0); *(v4u*)(p + 128) = pack8(v1); } };
__device__ __forceinline__ void p14_final(Frame& F, const Args& a) {
  unsigned char* ws = F.ws; const float* X2 = (const float*)(ws + WS_X2); const int* INV = (const int*)(ws + WS_INV); const bf16* YE = (const bf16*)(ws + WS_YE);
  const float* gfin = (const float*)a.in[I_GFIN]; float* out = a.out;
  const int gw = F.vcu * NWAVES + F.wave, NGW = F.G * NWAVES;
  for (int m = gw; m < MTOK; m += NGW) { const int b = m >> 12;
    f32x4 v[4];
#pragma unroll
    for (int j = 0; j < 4; ++j) v[j] = *(const f32x4*)(X2 + (size_t)m * 1024 + 256 * j + 4 * F.lane);
    const int myinv = F.lane < 16 ? INV[(size_t)m * 16 + F.lane] : -1;
#pragma unroll
    for (int e = 0; e < 16; ++e) { const int slot = __shfl(myinv, e);
      if (slot >= 0) { const bf16* yr = YE + ((size_t)e * 2048 + b * 512 + slot) * 1024 + 4 * F.lane;
#pragma unroll
        for (int j = 0; j < 4; ++j) { const v2u w = *(const v2u*)(yr + 256 * j); v[j].x += bflo(w.x); v[j].y += bfhi(w.x); v[j].z += bflo(w.y); v[j].w += bfhi(w.y); } } }
    float s = 0.f;
#pragma unroll
    for (int j = 0; j < 4; ++j) s += (v[j].x * v[j].x + v[j].y * v[j].y) + (v[j].z * v[j].z + v[j].w * v[j].w);
    const float r = rsqrtf(wave_sum(s) * (1.f / 1024.f) + 1e-6f);
#pragma unroll
    for (int j = 0; j < 4; ++j) { const f32x4 g = *(const f32x4*)(gfin + 256 * j + 4 * F.lane); *(f32x4*)(out + (size_t)m * 1024 + 256 * j + 4 * F.lane) = v[j] * r * g; }
  }
}
__global__ void __launch_bounds__(NTHR, 2) mk(Args a) {
  extern __shared__ __attribute__((aligned(16))) unsigned char lds_raw[];
  Frame F;
  F.lds = (LAS unsigned char*)lds_raw; F.MISC = (volatile LAS unsigned*)(F.lds + LDSCTL_OFF + 320);
  F.tid = threadIdx.x; F.lane = F.tid & 63; F.wave = __builtin_amdgcn_readfirstlane(F.tid >> 6);
  F.G = gridDim.x; { const int bx = blockIdx.x; F.vcu = (F.G % 8 == 0) ? (bx % 8) * (F.G / 8) + bx / 8 : bx; }
  F.ws = a.ws; F.ctl = (gu32*)(a.ws + WS_CTL);
  unsigned char* ws = a.ws;
  for (int u = F.tid; u < (LDS_BYTES - LDSCTL_OFF) / 4; u += NTHR) ((LAS unsigned*)(F.lds + LDSCTL_OFF))[u] = 0u;
  __syncthreads();
  XcdBarrier bar = xcd_barrier_post((unsigned*)(F.ctl + CW_BAR), F.MISC + 8);
  const int lo = a.ph_lo, hi = a.ph_hi;
#define IN(k) (lo <= (k) && (k) < hi)
#define BOTH(k) (IN(k) && IN((k) + 1))
#define GRID_BAR() xcd_barrier(bar)
  float* ssq = (float*)(ws + CTL_SSQ); float* sskv = (float*)(ws + CTL_SSKV);

#ifndef REP_MASK
#define REP_MASK 0
#endif
#define NREP(k) ((((REP_MASK) >> (k)) & 1) ? 2 : 1)
#define PH_BEGIN(k) if (IN(k)) { for (int rep_ = 0; rep_ < NREP(k); ++rep_) { const bool dry = rep_ + 1 < NREP(k); (void)dry;
#define PH_END(k) if (dry) GRID_BAR(); } if (BOTH(k)) GRID_BAR(); }
  float* dummy = (float*)(ws + WS_DUMMY);
  float* ss1 = (float*)(ws + CTL_SS1); float* ss2 = (float*)(ws + CTL_SS2);
#ifndef FILLMODE
#define FILLMODE 2
#endif
  PH_BEGIN(0) p0_prologue(F, a, true, FILLMODE == 0); PH_END(0)
  PH_BEGIN(1)
    { pg8::Gemm g{(const bf16*)(ws + WS_XN), (const bf16*)(ws + WS_WIN), 1024, 1024, 1024, nullptr, 127, 127}; pg8::StaticOrder S; S.init(MTOK, PROJ_LD, F.G, (int)blockIdx.x, 1024, 1024);
      EpiProj E{(bf16*)(ws + WS_PROJ), dry ? dummy : ssq, dry ? dummy + 16384 : sskv};
      pg8::gemm_phase<EpiProj, pg8::StaticOrder, false>(F.lds, g, S, E); }
    { pg8::Gemm g{(const bf16*)(ws + WS_MEMN), (const bf16*)(ws + WS_WMK), 1024, 1024, 1024, nullptr, 127, 127}; pg8::StaticOrder S; S.init(1024, 1024, F.G, (int)((blockIdx.x + 128u) % (unsigned)F.G), 1024, 1024);
      EpiStore E{(bf16*)(ws + WS_KMEM), 1024};
      pg8::gemm_phase<EpiStore, pg8::StaticOrder, false>(F.lds, g, S, E); }
    { pg8::Gemm g{(const bf16*)(ws + WS_WMV), (const bf16*)(ws + WS_MEMN), 1024, 1024, 1024, nullptr, 127, 127}; pg8::StaticOrder S; S.init(1024, 1024, F.G, (int)((blockIdx.x + 112u) % (unsigned)F.G), 1024, 1024);
      EpiStore E{(bf16*)(ws + WS_VMEMT), 1024};
      pg8::gemm_phase<EpiStore, pg8::StaticOrder, false>(F.lds, g, S, E); }
  PH_END(1)
  PH_BEGIN(2)
    { pg8::Gemm g{(const bf16*)(ws + WS_PROJ) + PC_CQ, (const bf16*)(ws + WS_WQB), PROJ_LD, 256, 256, nullptr, 127, 127}; pg8::StaticOrder S; S.init(MTOK, 768, F.G, (int)blockIdx.x, PROJ_LD, 256);
      EpiQ E{(bf16*)(ws + WS_QM), ssq, (const float*)(ws + WS_ROPE)};
      pg8::gemm_phase<EpiQ, pg8::StaticOrder, false>(F.lds, g, S, E); }
    { pg8::Gemm g{(const bf16*)(ws + WS_PROJ) + PC_CKV, (const bf16*)(ws + WS_WKVB), PROJ_LD, 256, 256, nullptr, 127, 127}; pg8::StaticOrder S; S.init(MTOK, 1024, F.G, (int)((blockIdx.x + 64u) % (unsigned)F.G), PROJ_LD, 256);
      EpiKV E{(bf16*)(ws + WS_KM), (bf16*)(ws + WS_VM), sskv};
      pg8::gemm_phase<EpiKV, pg8::StaticOrder, false>(F.lds, g, S, E); }
    p2_elementwise(F, a);
  PH_END(2)
  PH_BEGIN(3) p3_mixers(F, a, (char*)lds_raw, bar.x, dry ? 64 * 16 : 0); PH_END(3)
  PH_BEGIN(4) p4_combine(F, a); PH_END(4)
  PH_BEGIN(5)
    pg8::Gemm g{(const bf16*)(ws + WS_Y), (const bf16*)(ws + WS_WOUT), 1024, 1024, 1024, nullptr, 127, 127}; pg8::StaticOrder S; S.init(MTOK, 1024, F.G, (int)blockIdx.x, 1024, 1024);
    EpiResid E{(const float*)a.in[I_X], (float*)(ws + WS_X1), (bf16*)(ws + WS_X1B), dry ? dummy : ss1, 0, nullptr};
    pg8::gemm_phase<EpiResid, pg8::StaticOrder, false>(F.lds, g, S, E);
  PH_END(5)
  PH_BEGIN(6)
    pg8::Gemm g{(const bf16*)(ws + WS_X1B), (const bf16*)(ws + WS_WMQ), 1024, 1024, 1024, nullptr, 127, 127}; pg8::StaticOrder S; S.init(MTOK, 1024, F.G, (int)blockIdx.x, 1024, 1024);
    EpiScale E{(bf16*)(ws + WS_QMEM), ss1};
    pg8::gemm_phase<EpiScale, pg8::StaticOrder, false>(F.lds, g, S, E);
  PH_END(6)
  PH_BEGIN(7)
    pg8::Gemm g{(const bf16*)(ws + WS_QMEM), (const bf16*)(ws + WS_KMEM), 1024, 1024, 256, nullptr, 127, 127}; MemOrder S{F.G, (int)blockIdx.x, 0};
    EpiSoftmax E{(bf16*)(ws + WS_P), 0.0625f, (LAS float*)(F.lds + LDSCTL_OFF + 1024)};
    pg8::gemm_phase<EpiSoftmax, MemOrder, false>(F.lds, g, S, E);
  PH_END(7)
  PH_BEGIN(8)
    pg8::Gemm g{(const bf16*)(ws + WS_P), (const bf16*)(ws + WS_VMEMT), 1024, 1024, 256, nullptr, 127, 127}; MemOrder S{F.G, (int)blockIdx.x, 1};
    EpiStore E{(bf16*)(ws + WS_MO), 1024};
    pg8::gemm_phase<EpiStore, MemOrder, false>(F.lds, g, S, E);
  PH_END(8)
  PH_BEGIN(9)
    pg8::Gemm g{(const bf16*)(ws + WS_MO), (const bf16*)(ws + WS_WMO), 1024, 1024, 1024, nullptr, 127, 127}; pg8::StaticOrder S; S.init(MTOK, 1024, F.G, (int)blockIdx.x, 1024, 1024);
    EpiResid E{(const float*)(ws + WS_X1), (float*)(ws + WS_X2), (bf16*)(ws + WS_X2B), dry ? dummy : ss2, FP8EMU, nullptr};
    pg8::gemm_phase<EpiResid, pg8::StaticOrder, false>(F.lds, g, S, E);
  PH_END(9)
  PH_BEGIN(10) p10_router(F, a); PH_END(10)
  PH_BEGIN(11) p11_topk(F, (char*)lds_raw);
    if (!dry && FILLMODE != 0) conv_fill(F, a, 1 << 30);
  PH_END(11)
  PH_BEGIN(12)
#if MOE_FP8
    {
      const int gw = F.vcu * NWAVES + F.wave, NGW = F.G * NWAVES; const int* rs = (const int*)(ws + WS_ROWSEL);
      for (int r0 = gw; r0 < NEXP * 2048; r0 += 4 * NGW) {
        int tok[4]; float rn[4]; f32x4 q[4][4];
#pragma unroll
        for (int u = 0; u < 4; ++u) { const int r = r0 + u * NGW; tok[u] = r < NEXP * 2048 ? rs[r] : 0; }
#pragma unroll
        for (int u = 0; u < 4; ++u) { const float* xr = (const float*)(ws + WS_X2) + (size_t)tok[u] * 1024 + F.lane * 16; rn[u] = ss2[tok[u]];
#pragma unroll
          for (int j = 0; j < 4; ++j) q[u][j] = *(const f32x4*)(xr + 4 * j); }
#pragma unroll
        for (int u = 0; u < 4; ++u) { const int r = r0 + u * NGW; const float s = rsqrtf(rn[u] * (1.f / 1024.f) + 1e-6f);
          const f32x4 a0 = q[u][0] * s, a1 = q[u][1] * s, a2 = q[u][2] * s, a3 = q[u][3] * s;
          const float lo[8] = {a0.x, a0.y, a0.z, a0.w, a1.x, a1.y, a1.z, a1.w}, hi[8] = {a2.x, a2.y, a2.z, a2.w, a3.x, a3.y, a3.z, a3.w};
          const v2u a8 = pack8_fp8(lo, 1.f), b8 = pack8_fp8(hi, 1.f); v4u o; o.x = a8.x; o.y = a8.y; o.z = b8.x; o.w = b8.y;
          if (r < NEXP * 2048) *(v4u*)(ws + WS_XG + (size_t)r * 1024 + F.lane * 16) = o; } }
      GRID_BAR(); }
    pg8::Gemm g{(const bf16*)(ws + WS_XG), (const bf16*)(ws + WS_WEGU8), 512, 512, 512, nullptr, 127, 121}; MoeGUOrder S{F.G, (int)blockIdx.x};
    EpiGU8 E{(unsigned char*)(ws + WS_HID8), ss2, (const int*)(ws + WS_ROWSEL)};
    pg8::gemm_phase<EpiGU8, MoeGUOrder, false, 1>(F.lds, g, S, E);
#else
    pg8::Gemm g{(const bf16*)(ws + WS_X2B), (const bf16*)(ws + WS_WEGU), 1024, 1024, 1024, (const int*)(ws + WS_ROWSEL), 127, 127}; MoeGUOrder S{F.G, (int)blockIdx.x};
    EpiGU E{(bf16*)(ws + WS_HID), ss2, (const int*)(ws + WS_ROWSEL)};
    pg8::gemm_phase<EpiGU, MoeGUOrder, true>(F.lds, g, S, E);
#endif
  PH_END(12)
  PH_BEGIN(13)
#if MOE_FP8_DOWN
    pg8::Gemm g{(const bf16*)(ws + WS_HID8), (const bf16*)(ws + WS_WED8), 1024, 1024, 1024, nullptr, 124, 121}; MoeDownOrder S{F.G, (int)blockIdx.x};
    EpiYE E{(bf16*)(ws + WS_YE), (const float*)(ws + WS_GSEL)};
    pg8::gemm_phase<EpiYE, MoeDownOrder, false, 1>(F.lds, g, S, E);
#else
    pg8::Gemm g{(const bf16*)(ws + WS_HID), (const bf16*)(ws + WS_WED), 2048, 2048, 2048, nullptr, 127, 127}; MoeDownOrder S{F.G, (int)blockIdx.x};
    EpiYE E{(bf16*)(ws + WS_YE), (const float*)(ws + WS_GSEL)};
    pg8::gemm_phase<EpiYE, MoeDownOrder, false>(F.lds, g, S, E);
#endif
  PH_END(13)
  PH_BEGIN(14) p14_final(F, a); PH_END(14)
#undef IN
#undef BOTH
#undef GRID_BAR
}

__global__ __launch_bounds__(256) void adapt_b2f(const bf16* src, long lds_, long scol, float* dst, long ldd, long dcol, long rows, long ncols) {
  const long i = blockIdx.x * 256L + threadIdx.x; if (i >= rows * ncols) return;
  const long r = i / ncols, c = i % ncols; dst[r * ldd + dcol + c] = bf2f(src[r * lds_ + scol + c]);
}
static void adapt(hipStream_t s, const void* src, long lds_, long scol, float* dst, long ldd, long dcol, long rows, long ncols) {
  hipLaunchKernelGGL(adapt_b2f, dim3((unsigned)((rows * ncols + 255) / 256)), dim3(256), 0, s, (const bf16*)src, lds_, scol, dst, ldd, dcol, rows, ncols);
}

static int mk_grid() {
  static int grid = 0;
  if (grid == 0) {
    int dev = 0, cus = 0, per_cu = 0;
    (void)hipGetDevice(&dev); (void)hipDeviceGetAttribute(&cus, hipDeviceAttributeMultiprocessorCount, dev);
    (void)hipFuncSetAttribute((const void*)mk, hipFuncAttributeMaxDynamicSharedMemorySize, LDS_BYTES);
    (void)hipOccupancyMaxActiveBlocksPerMultiprocessor(&per_cu, (const void*)mk, NTHR, LDS_BYTES);
    (void)hipGetLastError();
    grid = cus > 0 ? cus : 256;
  }
  return grid;
}
static void mk_launch(hipStream_t s, void* const* d_in, void* d_out, void* d_ws, int lo, int hi, int flags) {
  Args a; memset(&a, 0, sizeof(a));
  for (int i = 0; i < 26; ++i) a.in[i] = d_in[i];
  a.out = (float*)d_out; a.ws = (unsigned char*)d_ws; a.ph_lo = lo; a.ph_hi = hi; a.flags = flags; a.pad = 0;
  (void)hipMemsetAsync((char*)d_ws + WS_CTL + CW_BAR * 4, 0, XCD_BAR_WORDS * 4, s);
  hipLaunchKernelGGL(mk, dim3(mk_grid()), dim3(NTHR), LDS_BYTES, s, a);
}

extern "C" void kernel_launch(void* const* d_in, const int* in_sizes, int n_in, void* d_out, int out_size, void* d_ws, size_t ws_size, hipStream_t s) {
  (void)hipMemsetAsync((char*)d_ws + WS_CTL, 0, CTL_ZERO_BYTES, s);
  mk_launch(s, d_in, d_out, d_ws, 0, 15, 1);
}
```

```cpp
#include <hip/hip_runtime.h>
#include <cstdint>
#include <cstdio>
#include <cstring>

constexpr int BATCH = 4, SEQ = 4096, DM = 1024, MTOK = BATCH * SEQ;
constexpr int D_IN = 2480;
constexpr int OFF_QM = 0, OFF_KM = 512, OFF_VM = 1024, OFF_OM = 1536, OFF_G = 2048, OFF_CQ = 2064, OFF_CKV = 2320, OFF_KR = 2448;
constexpr int NEXP = 16, CAP = 512, DFF = 2048, NMEM = 256;
constexpr size_t MiB = 1u << 20;
enum { I_X = 0, I_MEM, I_POS, I_GMIX, I_WIN, I_BG, I_CONV, I_GQA, I_WQB, I_GKVA, I_WKVB, I_GHM, I_GHA, I_WOUT, I_GMX, I_GMKV, I_WMQ, I_WMK, I_WMV, I_WMO, I_GFFN, I_WR, I_WEG, I_WEU, I_WED, I_GFIN };
#define GAS __attribute__((address_space(1)))
#define LAS __attribute__((address_space(3)))
typedef unsigned short bf16;
typedef unsigned v4u __attribute__((ext_vector_type(4)));
typedef unsigned v2u __attribute__((ext_vector_type(2)));
typedef float f32x4 __attribute__((ext_vector_type(4)));
typedef float f32x16 __attribute__((ext_vector_type(16)));
typedef short bf16x8 __attribute__((ext_vector_type(8)));
typedef short s16x4 __attribute__((ext_vector_type(4)));
typedef GAS unsigned gu32;
#define RLX_AGENT __ATOMIC_RELAXED, __HIP_MEMORY_SCOPE_AGENT
#define LDS_WAIT() asm volatile("s_waitcnt lgkmcnt(0)" ::: "memory")
#define VM_WAIT() asm volatile("s_waitcnt vmcnt(0)" ::: "memory")
constexpr int NWAVES = 8, NTHR = 512;
__device__ __forceinline__ unsigned f2bf(float f) { unsigned u = __builtin_bit_cast(unsigned, f); return (u + 0x7fffu + ((u >> 16) & 1u)) >> 16; }
__device__ __forceinline__ unsigned pk2(float lo, float hi) { return f2bf(lo) | (f2bf(hi) << 16); }
__device__ __forceinline__ float bf2f(unsigned short h) { return __builtin_bit_cast(float, (unsigned)h << 16); }
__device__ __forceinline__ float bflo(unsigned w) { return __builtin_bit_cast(float, w << 16); }
__device__ __forceinline__ float bfhi(unsigned w) { return __builtin_bit_cast(float, w & 0xffff0000u); }
typedef float f32x2_t __attribute__((ext_vector_type(2))); typedef __bf16 bf16x2_t __attribute__((ext_vector_type(2)));
__device__ __forceinline__ unsigned cvt_pk_bf16(float lo, float hi) { f32x2_t v = {lo, hi}; bf16x2_t b = __builtin_convertvector(v, bf16x2_t); return __builtin_bit_cast(unsigned, b); }
__device__ __forceinline__ v2u pack8_fp8(const float (&v)[8], float sc) { float c[8];
#pragma unroll
  for (int i = 0; i < 8; ++i) c[i] = __builtin_amdgcn_fmed3f(v[i] * sc, -448.f, 448.f);
  int a = 0, b = 0; a = __builtin_amdgcn_cvt_pk_fp8_f32(c[0], c[1], a, false); a = __builtin_amdgcn_cvt_pk_fp8_f32(c[2], c[3], a, true);
  b = __builtin_amdgcn_cvt_pk_fp8_f32(c[4], c[5], b, false); b = __builtin_amdgcn_cvt_pk_fp8_f32(c[6], c[7], b, true); v2u r; r.x = (unsigned)a; r.y = (unsigned)b; return r; }
__device__ __forceinline__ float q8(float x, float sc) { const int p = __builtin_amdgcn_cvt_pk_fp8_f32(x * sc, 0.f, 0, false); return __builtin_amdgcn_cvt_f32_fp8(p, 0) * (1.f / sc); }
__device__ __forceinline__ float wave_sum(float v) {
#pragma unroll
  for (int o = 1; o < 64; o <<= 1) v += __shfl_xor(v, o);
  return v;
}
__device__ __forceinline__ float sigmoidf_(float x) { return 1.f / (1.f + __expf(-x)); }

#define XB_TMO      128
#define XB_XCNT(j)  (256  + 64 * (j))
#define XB_XSUB(j)  (1280 + 64 * (j))
#define XB_XGEN(j)  (2304 + 64 * (j))
#define XB_TOP      3328
#define XB_TOPGEN   3392
#define XCD_BAR_WORDS 3456
#define XB_SPIN_CAP (1u << 22)
__device__ __forceinline__ unsigned xb_ld(unsigned* p)              { return __hip_atomic_load(p, __ATOMIC_RELAXED, __HIP_MEMORY_SCOPE_AGENT); }
__device__ __forceinline__ unsigned xb_add(unsigned* p, unsigned v) { return __hip_atomic_fetch_add(p, v, __ATOMIC_RELAXED, __HIP_MEMORY_SCOPE_AGENT); }
__device__ __forceinline__ unsigned xb_xcc_id() { return (unsigned)__builtin_amdgcn_s_getreg((3 << 11) | 20) & 0xFu; }
#define XB_SPIN(cond, bar) do { unsigned _sp = 0; while (cond) { __builtin_amdgcn_s_sleep(1); \
    if ((++_sp & 255u) == 0u) { if (xb_ld(&(bar)[XB_TMO])) break; if (_sp > XB_SPIN_CAP) { atomicAdd(&(bar)[XB_TMO], 1u); break; } } } } while (0)
struct XcdBarrier { unsigned* bar; unsigned x; volatile LAS unsigned* st; };
__device__ __forceinline__ XcdBarrier xcd_barrier_post(unsigned* bar, volatile LAS unsigned* st) {
  XcdBarrier b; b.bar = bar; b.x = xb_xcc_id(); b.st = st;
  if (threadIdx.x == 0) (void)xb_add(&bar[XB_XCNT(b.x)], 1u);
  return b;
}
__device__ __forceinline__ void xcd_barrier_complete(unsigned* bar, unsigned x, unsigned& nloc, unsigned& nx) {
  const unsigned G = gridDim.x * gridDim.y * gridDim.z;
  unsigned sum, cnt, mine, sp = 0u;
  for (;;) {
    sum = 0u; cnt = 0u; mine = 0u;
#pragma unroll
    for (unsigned j = 0; j < 16; ++j) { const unsigned c = xb_ld(&bar[XB_XCNT(j)]); sum += c; cnt += (c > 0u) ? 1u : 0u; mine = (j == x) ? c : mine; }
    if (sum == G) break;
    __builtin_amdgcn_s_sleep(1);
    if ((++sp & 255u) == 0u) { if (xb_ld(&bar[XB_TMO])) break; if (sp > XB_SPIN_CAP) { atomicAdd(&bar[XB_TMO], 1u); break; } }
  }
  nloc = mine > 0u ? mine : 1u; nx = cnt > 0u ? cnt : 1u;
}
__device__ __forceinline__ void xcd_barrier(const XcdBarrier& b) {
  asm volatile("s_waitcnt vmcnt(0)" ::: "memory");
  __syncthreads();
  if (threadIdx.x == 0) {
    unsigned* bar = b.bar;
    __builtin_amdgcn_s_waitcnt(0);
    unsigned nloc = b.st[0], nx = b.st[1];
    if (nloc == 0u) { xcd_barrier_complete(bar, b.x, nloc, nx); b.st[0] = nloc; b.st[1] = nx; }
    const unsigned old = xb_add(&bar[XB_XSUB(b.x)], 1u);
    const unsigned gen = old / nloc;
    if (old + 1u == (gen + 1u) * nloc) {
      __builtin_amdgcn_fence(__ATOMIC_RELEASE, "agent");
      asm volatile("s_waitcnt vmcnt(0)" ::: "memory");
      const unsigned og = xb_add(&bar[XB_TOP], 1u);
      const unsigned tg = og / nx;
      if (og + 1u == (tg + 1u) * nx) xb_add(&bar[XB_TOPGEN], 1u);
      else XB_SPIN(xb_ld(&bar[XB_TOPGEN]) == tg, bar);
      __builtin_amdgcn_fence(__ATOMIC_ACQUIRE, "agent");
      xb_add(&bar[XB_XGEN(b.x)], 1u);
      asm volatile("s_waitcnt vmcnt(0)" ::: "memory");
    } else {
      XB_SPIN(xb_ld(&bar[XB_XGEN(b.x)]) == gen, bar);
      __builtin_amdgcn_fence(__ATOMIC_ACQUIRE, "agent");
      asm volatile("s_waitcnt vmcnt(0)" ::: "memory");
    }
  }
  __syncthreads();
}

namespace pg8 {
constexpr int BM = 256, BK = 64, HALF = 128, HTB = HALF * BK * 2, STAGE_BYTES = 8 * HTB, NXCD = 8, WGM = 8;
__host__ __device__ __forceinline__ int lds_byte(int r, int c) { const int st = (r >> 4) * 2 + (c >> 5), rr = r & 15, cc = c & 31, ob = rr * 64 + cc * 2; return st * 1024 + (ob ^ (((ob >> 9) & 1) << 5)); }
__host__ __device__ __forceinline__ void stage_rc(int b, int& R, int& C) { const int st = b / 1024, sb = b % 1024, swz = sb ^ (((sb >> 9) & 1) << 5); R = (st >> 1) * 16 + swz / 64; C = (st & 1) * 32 + (swz % 64) / 2; }
__host__ __device__ __forceinline__ int perm32(int rho) { const int n = rho >> 4, i = rho & 15; return 8 * (i >> 2) + 4 * n + (i & 3); }

struct Unit { long aoff, boff; int pm, pn, g, ibase; };
struct Gemm { const bf16* A; const bf16* Bt; int lda, ldb, K; const int* gidx; int sa, sb; };
typedef int v8i_t __attribute__((ext_vector_type(8))); typedef int v4i_t __attribute__((ext_vector_type(4)));
__device__ __forceinline__ v8i_t cat8(bf16x8 lo, bf16x8 hi) { const v4i_t a = __builtin_bit_cast(v4i_t, lo), b = __builtin_bit_cast(v4i_t, hi); return __builtin_shufflevector(a, b, 0, 1, 2, 3, 4, 5, 6, 7); }

struct StaticOrder {
  int nM, nN, nwg, G, c, lda, ldb;
  __device__ void init(int M, int N, int G_, int c_, int lda_, int ldb_) { nM = M / BM; nN = N / BM; nwg = nM * nN; G = G_; c = c_; lda = lda_; ldb = ldb_; }
  __device__ bool next(int i, Unit& u) const {
    const long L = (long)i * G + c; if (L >= nwg) return false;
    int wgid = (int)L; { const int q = nwg / NXCD, r = nwg % NXCD, xcd = wgid % NXCD, off = wgid / NXCD; wgid = (xcd < r ? xcd * (q + 1) : r * (q + 1) + (xcd - r) * q) + off; }
    const int nig = WGM * nN, gid = wgid / nig, fm = gid * WGM, gsz = (nM - fm) < WGM ? (nM - fm) : WGM;
    u.pm = fm + ((wgid % nig) % gsz); u.pn = (wgid % nig) / gsz; u.g = 0; u.ibase = 0;
    u.aoff = (long)u.pm * BM * lda; u.boff = (long)u.pn * BM * ldb; return true;
  }
};

template <class Epi, class Sched, bool GATHER, int FP8 = 0>
__device__ __forceinline__ void gemm_phase(LAS unsigned char* lds, const Gemm g, const Sched& S, const Epi& E) {
  int tid = threadIdx.x; asm volatile("" : "+v"(tid));
  const int wid = __builtin_amdgcn_readfirstlane(tid >> 6), lane = tid & 63, wr = wid >> 2, wc = wid & 3, fr = lane & 15, fq = lane >> 4;
  const int K = g.K, nt = K / BK;
  int Rs[2], Cs[2]; unsigned voffB[2];
#pragma unroll
  for (int i = 0; i < 2; ++i) { int R, C; stage_rc(tid * 16 + i * 8192, R, C); Rs[i] = R; Cs[i] = C; const int Rb = (R & ~31) + perm32(R & 31); voffB[i] = (unsigned)(Rb * g.ldb + C) * 2u; }
  const size_t kstep = (size_t)(BK * 2);
  const size_t hstepB = (size_t)HALF * g.ldb * 2;
  const unsigned ldsw = (unsigned)wid * 1024u;
  const int aoff_l = lds_byte(wr * 64 + fr, FP8 ? fq * 16 : fq * 8), boff_l = lds_byte(wc * 32 + fr, FP8 ? fq * 16 : fq * 8);
  constexpr int aoff_k = FP8 ? 16 : 1024, boff_k = FP8 ? 16 : 1024;
#define PG8_SA(b, h) (((b) * 2 + (h)) * HTB)
#define PG8_SB(b, h) ((4 + (b) * 2 + (h)) * HTB)
#define PG8_STAGE(bufoff, gbase, voff) do { _Pragma("unroll") for (int _i = 0; _i < 2; ++_i) \
        __builtin_amdgcn_global_load_lds((const unsigned*)((const char*)(gbase) + (voff)[_i]), (LAS unsigned*)(lds + (bufoff) + ldsw + _i * 8192), 16, 0, 0); } while (0)
#define PG8_LDA(dst, b, h) do { _Pragma("unroll") for (int m = 0; m < 4; ++m) { if constexpr (FP8) { const v4i_t lo_ = *(const LAS v4i_t*)(lds + PG8_SA(b, h) + aoff_l + m * 2048), hi_ = *(const LAS v4i_t*)(lds + PG8_SA(b, h) + aoff_l + m * 2048 + aoff_k); dst##8[m] = __builtin_shufflevector(lo_, hi_, 0, 1, 2, 3, 4, 5, 6, 7); } \
        else { _Pragma("unroll") for (int k = 0; k < 2; ++k) dst[m][k] = *(const LAS bf16x8*)(lds + PG8_SA(b, h) + aoff_l + m * 2048 + k * aoff_k); } } } while (0)
#define PG8_LDB(dst, b, h) do { _Pragma("unroll") for (int n = 0; n < 2; ++n) { if constexpr (FP8) { const v4i_t lo_ = *(const LAS v4i_t*)(lds + PG8_SB(b, h) + boff_l + n * 2048), hi_ = *(const LAS v4i_t*)(lds + PG8_SB(b, h) + boff_l + n * 2048 + boff_k); dst##8[n] = __builtin_shufflevector(lo_, hi_, 0, 1, 2, 3, 4, 5, 6, 7); } \
        else { _Pragma("unroll") for (int k = 0; k < 2; ++k) dst[n][k] = *(const LAS bf16x8*)(lds + PG8_SB(b, h) + boff_l + n * 2048 + k * boff_k); } } } while (0)
#define PG8_MMA(ai, bj, At, Bt) do { __builtin_amdgcn_s_setprio(1); _Pragma("unroll") for (int m = 0; m < 4; ++m) _Pragma("unroll") for (int n = 0; n < 2; ++n) { \
        if constexpr (FP8) asm volatile("v_mfma_scale_f32_16x16x128_f8f6f4 %0, %1, %2, %0, %3, %4 op_sel_hi:[0,0,0]" : "+v"(acc[ai][bj][m][n]) : "v"(Bt##8[n]), "v"(At##8[m]), "v"(vsb), "v"(vsa)); \
        else { _Pragma("unroll") for (int k = 0; k < 2; ++k) acc[ai][bj][m][n] = __builtin_amdgcn_mfma_f32_16x16x32_bf16(Bt[n][k], At[m][k], acc[ai][bj][m][n], 0, 0, 0); } } \
        __builtin_amdgcn_s_setprio(0); } while (0)
#define PG8_WAIT_V(n) asm volatile("s_waitcnt vmcnt(" #n ")" ::: "memory")
#define PG8_WAIT_L(n) asm volatile("s_waitcnt lgkmcnt(" #n ")" ::: "memory")
#define PG8_BAR __builtin_amdgcn_s_barrier()
#define PG8_SCHED __builtin_amdgcn_sched_barrier(0)
  Unit cur, nxt; int ui = 0;
  if (!S.next(0, cur)) return;
  unsigned vA[2][2], nvA[2][2];
  auto load_va = [&](const Unit& u, unsigned (&v)[2][2]) {
#pragma unroll
    for (int h = 0; h < 2; ++h)
#pragma unroll
      for (int i = 0; i < 2; ++i) {
        if constexpr (GATHER) v[h][i] = (unsigned)((long)g.gidx[u.ibase + h * HALF + Rs[i]] * g.lda + Cs[i]) * 2u;
        else v[h][i] = (unsigned)((h * HALF + Rs[i]) * g.lda + Cs[i]) * 2u;
      }
  };
  load_va(cur, vA);
  f32x4 acc[2][2][4][2];
#pragma unroll
  for (int a = 0; a < 2; ++a)
#pragma unroll
    for (int b = 0; b < 2; ++b)
#pragma unroll
      for (int m = 0; m < 4; ++m)
#pragma unroll
        for (int n = 0; n < 2; ++n) acc[a][b][m][n] = (f32x4){0.f, 0.f, 0.f, 0.f};
  int vsa = g.sa, vsb = g.sb; (void)vsa; (void)vsb;
  bf16x8 At[4][2], B0[2][2], B1[2][2]; v8i_t At8[4], B08[2], B18[2];
  const char* cA = (const char*)g.A + (GATHER ? 0 : cur.aoff * 2); const char* cB = (const char*)g.Bt + cur.boff * 2;
  PG8_STAGE(PG8_SB(0, 0), cB, voffB); PG8_STAGE(PG8_SB(0, 1), cB + hstepB, voffB); PG8_STAGE(PG8_SA(0, 0), cA, vA[0]); PG8_STAGE(PG8_SA(0, 1), cA, vA[1]);
  if (wr == 1) PG8_BAR;
  PG8_WAIT_V(2); PG8_BAR;
  PG8_STAGE(PG8_SB(1, 0), cB + kstep, voffB); PG8_STAGE(PG8_SA(1, 0), cA + kstep, vA[0]); PG8_STAGE(PG8_SB(1, 1), cB + hstepB + kstep, voffB);
  PG8_WAIT_V(6); PG8_BAR;
  for (;;) {
    const bool has_next = S.next(ui + 1, nxt);
    const char* nA = has_next ? (const char*)g.A + (GATHER ? 0 : nxt.aoff * 2) : cA; const char* nB = has_next ? (const char*)g.Bt + nxt.boff * 2 : cB;
    if constexpr (GATHER) { if (has_next) load_va(nxt, nvA); else {
#pragma unroll
      for (int h = 0; h < 2; ++h)
#pragma unroll
        for (int i = 0; i < 2; ++i) nvA[h][i] = vA[h][i]; } }
#pragma unroll 1
    for (int t = 0; t < nt; t += 2) {
      const bool last = (t == nt - 2);
      const char* a1 = cA + (size_t)(t + 1) * kstep;
      const char* a2 = last ? nA : cA + (size_t)(t + 2) * kstep; const char* b2 = last ? nB : cB + (size_t)(t + 2) * kstep;
      const char* a3 = a2 + kstep; const char* b3 = b2 + kstep;
      unsigned w0[2], w1[2];
      if constexpr (GATHER) { w0[0] = last ? nvA[0][0] : vA[0][0]; w0[1] = last ? nvA[0][1] : vA[0][1]; w1[0] = last ? nvA[1][0] : vA[1][0]; w1[1] = last ? nvA[1][1] : vA[1][1]; }
      else { w0[0] = vA[0][0]; w0[1] = vA[0][1]; w1[0] = vA[1][0]; w1[1] = vA[1][1]; }
      PG8_LDB(B0, 0, 0); PG8_LDB(B1, 0, 1); PG8_SCHED; PG8_LDA(At, 0, 0); PG8_STAGE(PG8_SA(1, 1), a1, vA[1]);
      PG8_WAIT_V(8); PG8_WAIT_L(0); PG8_BAR; PG8_MMA(0, 0, At, B0); PG8_MMA(0, 1, At, B1); PG8_BAR; PG8_SCHED;
      PG8_LDA(At, 0, 1); PG8_STAGE(PG8_SB(0, 0), b2, voffB); PG8_STAGE(PG8_SB(0, 1), b2 + hstepB, voffB); PG8_STAGE(PG8_SA(0, 0), a2, w0);
      PG8_WAIT_V(8); PG8_WAIT_L(0); PG8_BAR; PG8_MMA(1, 0, At, B0); PG8_MMA(1, 1, At, B1); PG8_BAR; PG8_SCHED;
      PG8_LDB(B0, 1, 0); PG8_LDB(B1, 1, 1); PG8_SCHED; PG8_LDA(At, 1, 0); PG8_STAGE(PG8_SA(0, 1), a2, w1);
      PG8_WAIT_V(8); PG8_WAIT_L(0); PG8_BAR; PG8_MMA(0, 0, At, B0); PG8_MMA(0, 1, At, B1); PG8_BAR; PG8_SCHED;
      PG8_LDA(At, 1, 1); PG8_STAGE(PG8_SB(1, 0), b3, voffB); PG8_STAGE(PG8_SB(1, 1), b3 + hstepB, voffB); PG8_STAGE(PG8_SA(1, 0), a3, w0);
      PG8_WAIT_V(8); PG8_WAIT_L(0); PG8_BAR; PG8_MMA(1, 0, At, B0); PG8_MMA(1, 1, At, B1); PG8_BAR; PG8_SCHED;
    }
    if constexpr (FP8) { asm volatile("s_nop 15\n\ts_nop 15" ::: "memory"); __builtin_amdgcn_sched_barrier(0); }
    if (wr == 0) PG8_BAR;
    int fr_o = fr, fq_o = fq; asm volatile("" : "+v"(fr_o), "+v"(fq_o));
    if constexpr (Epi::TWO_PASS) {
#pragma unroll
      for (int ai = 0; ai < 2; ++ai)
#pragma unroll
        for (int m = 0; m < 4; ++m) {
          float v0[8], v1[8];
#pragma unroll
          for (int n = 0; n < 2; ++n)
#pragma unroll
            for (int j = 0; j < 4; ++j) { v0[n * 4 + j] = acc[ai][0][m][n][j]; v1[n * 4 + j] = acc[ai][1][m][n][j]; }
          E.pass1(cur, ai * HALF + wr * 64 + m * 16 + fr_o, wc, v0, v1, fq_o);
#pragma unroll
          for (int n = 0; n < 2; ++n)
#pragma unroll
            for (int j = 0; j < 4; ++j) { acc[ai][0][m][n][j] = v0[n * 4 + j]; acc[ai][1][m][n][j] = v1[n * 4 + j]; }
        }
      asm volatile("s_waitcnt lgkmcnt(0)" ::: "memory"); PG8_BAR; asm volatile("" ::: "memory");
    }
    {
#pragma unroll
      for (int ai = 0; ai < 2; ++ai)
#pragma unroll
        for (int m = 0; m < 4; ++m) {
          float v0[8], v1[8];
#pragma unroll
          for (int n = 0; n < 2; ++n)
#pragma unroll
            for (int j = 0; j < 4; ++j) { v0[n * 4 + j] = acc[ai][0][m][n][j]; v1[n * 4 + j] = acc[ai][1][m][n][j]; }
          E.row8(cur, ai * HALF + wr * 64 + m * 16 + fr_o, wc * 32 + 8 * fq_o, v0, v1, fq_o);
          asm volatile("" ::: "memory");
        }
    }
    if (!has_next) break;
#pragma unroll
    for (int a = 0; a < 2; ++a)
#pragma unroll
      for (int b = 0; b < 2; ++b)
#pragma unroll
        for (int m = 0; m < 4; ++m)
#pragma unroll
          for (int n = 0; n < 2; ++n) acc[a][b][m][n] = (f32x4){0.f, 0.f, 0.f, 0.f};
    cur = nxt; cA = nA; cB = nB; ++ui;
    if constexpr (GATHER) {
#pragma unroll
      for (int h = 0; h < 2; ++h)
#pragma unroll
        for (int i = 0; i < 2; ++i) vA[h][i] = nvA[h][i]; }
    if (wr == 1) PG8_BAR;
  }
  PG8_WAIT_V(0);
  PG8_BAR;
#undef PG8_SA
#undef PG8_SB
#undef PG8_STAGE
#undef PG8_LDA
#undef PG8_LDB
#undef PG8_MMA
#undef PG8_WAIT_V
#undef PG8_WAIT_L
#undef PG8_BAR
#undef PG8_SCHED
}
}
constexpr size_t WS_CTL = 0, CTL_ZERO_BYTES = 1 * MiB;
constexpr int CW_TMO = 0, CW_BAR = 4096, CW_Q = 8192;
constexpr size_t CTL_SSQ = 256 * 1024, CTL_SSKV = CTL_SSQ + 65536, CTL_SS1 = CTL_SSKV + 65536, CTL_SS2 = CTL_SS1 + 65536;
constexpr size_t WS_WIN = 1 * MiB, WS_WQB = 6 * MiB, WS_WKVB = 6 * MiB + 512 * 1024, WS_WOUT = 7 * MiB, WS_WMQ = 9 * MiB, WS_WMK = 11 * MiB, WS_WMV = 13 * MiB, WS_WMO = 15 * MiB;
constexpr size_t WS_ROPE = 17 * MiB, WS_MEMN = 19 * MiB, WS_KMEM = 21 * MiB, WS_VMEMT = 23 * MiB, WS_GSC = 25 * MiB, WS_DEC = 28 * MiB, WS_AFF = 29 * MiB, WS_SEL = 30 * MiB;
constexpr size_t WS_PROJ = 32 * MiB, WS_XN = 112 * MiB, WS_QC = 112 * MiB, WS_KC = 128 * MiB, WS_QM = 144 * MiB, WS_KM = 168 * MiB, WS_VM = 192 * MiB, WS_HF = 208 * MiB, WS_HB = 224 * MiB, WS_Y = 240 * MiB;
constexpr size_t WS_X1 = 112 * MiB, WS_X1B = 176 * MiB, WS_QMEM = 208 * MiB, WS_P = 240 * MiB, WS_MO = 176 * MiB, WS_X2 = 240 * MiB, WS_X2B = 208 * MiB, WS_HID = 32 * MiB;
constexpr size_t WS_DUMMY = 304 * MiB;
constexpr size_t WS_WEGU = 320 * MiB, WS_WED = 448 * MiB, WS_END = 512 * MiB;
constexpr int PROJ_LD = 2560;
constexpr int PC_CQ = 2048, PC_CKV = 2304, PC_KR = 2432, PC_G = 2464;
constexpr int RING_BYTES = 131072, LDSCTL_OFF = 133120, LDS_BYTES = 147456;

struct Args { const void* in[26]; float* out; unsigned char* ws; int ph_lo, ph_hi, flags, pad; };

struct Frame {
  LAS unsigned char* lds; volatile LAS unsigned* MISC; gu32* ctl; unsigned char* ws;
  int tid, lane, wave, vcu, G;
};

__device__ __forceinline__ void p0_tr(const float* W, int ldw, int k0, int kvalid, int scol0, int ncols, const float* gs, bf16* WT, int ldt, int drow0, LAS float* scr, int lane, bool doq = false) {
  const int c4 = (lane & 15) * 4, kr = lane >> 4;
  f32x4 v[16];
#pragma unroll
  for (int i = 0; i < 16; ++i) { const int kk = 4 * i + kr; v[i] = (f32x4){0.f, 0.f, 0.f, 0.f};
    if (c4 < ncols && k0 + kk < kvalid) { v[i] = *(const f32x4*)(W + (size_t)(k0 + kk) * ldw + scol0 + c4); if (gs) v[i] = v[i] * gs[k0 + kk];
      if (doq) { v[i].x = q8(v[i].x, 64.f); v[i].y = q8(v[i].y, 64.f); v[i].z = q8(v[i].z, 64.f); v[i].w = q8(v[i].w, 64.f); } } }
#pragma unroll
  for (int i = 0; i < 16; ++i) { const int kk = 4 * i + kr; LAS float* d = scr + kk * 65 + c4; d[0] = v[i].x; d[1] = v[i].y; d[2] = v[i].z; d[3] = v[i].w; }
  LDS_WAIT(); asm volatile("" ::: "memory");
  const int c = lane & 7;
#pragma unroll
  for (int j = 0; j < 8; ++j) { const int n = (lane >> 3) + 8 * j; const LAS float* s = scr + (8 * c) * 65 + n;
    v4u o; o.x = pk2(s[0 * 65], s[1 * 65]); o.y = pk2(s[2 * 65], s[3 * 65]); o.z = pk2(s[4 * 65], s[5 * 65]); o.w = pk2(s[6 * 65], s[7 * 65]);
    *(GAS v4u*)(WT + (size_t)(drow0 + n) * ldt + k0 + 8 * c) = o; }
  LDS_WAIT(); asm volatile("" ::: "memory");
}
struct ConvDesc { const float* W; const float* gs; unsigned char* WT8; int ldw, k0, scol0, ldt, drow0; };
__device__ __forceinline__ void p0_tr8_load(const ConvDesc& d, f32x4 (&v)[16], int lane) {
  const int c4 = (lane & 15) * 4, kr = lane >> 4;
#pragma unroll
  for (int i = 0; i < 16; ++i) { const int kk = 4 * i + kr; v[i] = *(const f32x4*)(d.W + (size_t)(d.k0 + kk) * d.ldw + d.scol0 + c4); }
}
__device__ __forceinline__ void p0_tr8_finish(const ConvDesc& d, f32x4 (&v)[16], float sc, LAS float* scr, int lane) {
  const int c4 = (lane & 15) * 4, kr = lane >> 4;
#pragma unroll
  for (int i = 0; i < 16; ++i) { const int kk = 4 * i + kr; f32x4 x = v[i]; if (d.gs) x = x * d.gs[d.k0 + kk]; LAS float* p = scr + kk * 65 + c4; p[0] = x.x; p[1] = x.y; p[2] = x.z; p[3] = x.w; }
  LDS_WAIT(); asm volatile("" ::: "memory");
  const int c = lane & 7;
#pragma unroll
  for (int j = 0; j < 8; ++j) { const int n = (lane >> 3) + 8 * j; const LAS float* s = scr + (8 * c) * 65 + n;
    float f[8];
#pragma unroll
    for (int q = 0; q < 8; ++q) f[q] = s[q * 65];
    *(GAS v2u*)(d.WT8 + (size_t)(d.drow0 + n) * d.ldt + d.k0 + 8 * c) = pack8_fp8(f, sc); }
  LDS_WAIT(); asm volatile("" ::: "memory");
}
__device__ __forceinline__ void p0_tr32(const float* W, int ldw, int k0, int scol0, int ncols, const float* gs, bf16* WT, int ldt, int drow0, LAS float* scr, int lane) {
#pragma unroll 8
  for (int i = 0; i < 32; ++i) { const int kk = 2 * i + (lane >> 5), c = lane & 31; float v = 0.f;
    if (c < ncols) { v = W[(size_t)(k0 + kk) * ldw + scol0 + c]; if (gs) v *= gs[k0 + kk]; }
    scr[kk * 65 + c] = v; }
  LDS_WAIT(); asm volatile("" ::: "memory");
  const int c = lane & 7;
#pragma unroll
  for (int j = 0; j < 4; ++j) { const int n = (lane >> 3) + 8 * j; const LAS float* s = scr + (8 * c) * 65 + n;
    v4u o; o.x = pk2(s[0 * 65], s[1 * 65]); o.y = pk2(s[2 * 65], s[3 * 65]); o.z = pk2(s[4 * 65], s[5 * 65]); o.w = pk2(s[6 * 65], s[7 * 65]);
    *(GAS v4u*)(WT + (size_t)(drow0 + n) * ldt + k0 + 8 * c) = o; }
  LDS_WAIT(); asm volatile("" ::: "memory");
}
__device__ __forceinline__ void rms_row_to_bf16(const float* xrow, bf16* orow, int lane) {
  const GAS f32x4* xr = (const GAS f32x4*)xrow + lane;
  f32x4 v[4]; float s = 0.f;
#pragma unroll
  for (int j = 0; j < 4; ++j) { v[j] = xr[64 * j]; s += (v[j].x * v[j].x + v[j].y * v[j].y) + (v[j].z * v[j].z + v[j].w * v[j].w); }
  const float rstd = rsqrtf(wave_sum(s) * (1.f / 1024.f) + 1e-6f);
  GAS unsigned long long* o8 = (GAS unsigned long long*)orow + lane;
#pragma unroll
  for (int j = 0; j < 4; ++j) o8[64 * j] = (unsigned long long)pk2(v[j].x * rstd, v[j].y * rstd) | ((unsigned long long)pk2(v[j].z * rstd, v[j].w * rstd) << 32);
}

#ifndef FP8EMU
#define FP8EMU 0
#endif
#ifndef MOE_FP8
#define MOE_FP8 1
#endif
#ifndef CONV_NT
#define CONV_NT 0
#endif
#ifndef MOE_FP8_DOWN
#define MOE_FP8_DOWN MOE_FP8
#endif
constexpr size_t WS_XG = 96 * MiB;
constexpr size_t WS_X2Q = 208 * MiB, WS_WEGU8 = 320 * MiB, WS_WED8 = 448 * MiB, WS_HID8 = 32 * MiB;
constexpr int CW_CONV = 8192 + 64 * 40, CW_MDONE = 8192 + 64 * 41, CW_TDONE = 8192 + 64 * 42;
constexpr int CONV_IGU = 16 * 64, CONV_ID = 32 * 16, CONV_ITEMS = NEXP * (CONV_IGU + CONV_ID), CONV_CHUNKS = CONV_ITEMS / 8;
__device__ __forceinline__ ConvDesc conv_desc(Frame& F, const Args& a, int it) {
  auto I = [&](int i) { return (const float*)a.in[i]; };
  unsigned char* ws = F.ws; ConvDesc d;
  const int e = it / (CONV_IGU + CONV_ID); int r = it % (CONV_IGU + CONV_ID);
  if (r < CONV_IGU) { const int kb = r / 64, nb = r % 64, p = nb >> 2, j0 = (nb & 3) * 64; const bool up = j0 >= 128;
    d.W = (up ? I(I_WEU) : I(I_WEG)) + (size_t)e * 1024 * 2048; d.ldw = 2048; d.k0 = 64 * kb; d.scol0 = 128 * p + (up ? j0 - 128 : j0); d.gs = I(I_GFFN); d.WT8 = ws + WS_WEGU8 + (size_t)e * 4096 * 1024; d.ldt = 1024; d.drow0 = 64 * nb; }
  else { r -= CONV_IGU; const int kb = r / 16, nb = r % 16;
    d.W = I(I_WED) + (size_t)e * 2048 * 1024; d.ldw = 1024; d.k0 = 64 * kb; d.scol0 = 64 * nb; d.gs = nullptr; d.WT8 = ws + WS_WED8 + (size_t)e * 1024 * 2048; d.ldt = 2048; d.drow0 = 64 * nb; }
  return d;
}
__device__ __forceinline__ void conv_fill(Frame& F, const Args& a, int maxpairs) {
  static_assert(MOE_FP8 && MOE_FP8_DOWN, "the conversion filler writes fp8 expert weights");
  volatile LAS int* slot = (volatile LAS int*)(F.lds + LDSCTL_OFF + 16);
  LAS float* scr = (LAS float*)(F.lds + F.wave * 16640);
  for (int n = 0; n < maxpairs; ++n) {
    if (F.tid == 0) { int got = -1;
      if (__hip_atomic_load(F.ctl + CW_CONV, RLX_AGENT) < (unsigned)CONV_CHUNKS) { const unsigned c = __hip_atomic_fetch_add(F.ctl + CW_CONV, 2u, RLX_AGENT); if (c < (unsigned)CONV_CHUNKS) got = (int)c; }
      *slot = got; }
    __syncthreads();
    const int c = __builtin_amdgcn_readfirstlane(*slot);
    __syncthreads();
    if (c < 0) break;
    const ConvDesc d0 = conv_desc(F, a, c * 8 + F.wave), d1 = conv_desc(F, a, (c + 1) * 8 + F.wave);
    f32x4 v0[16], v1[16];
    p0_tr8_load(d0, v0, F.lane); p0_tr8_load(d1, v1, F.lane);
    p0_tr8_finish(d0, v0, 64.f, scr, F.lane); p0_tr8_finish(d1, v1, 64.f, scr, F.lane);
  }
}
__device__ __forceinline__ void p0_prologue(Frame& F, const Args& a, bool do_dense, bool do_experts) {
  LAS float* scr = (LAS float*)(F.lds + F.wave * 16640);
  const int gw = F.vcu * NWAVES + F.wave, NGW = F.G * NWAVES;
  auto I = [&](int i) { return (const float*)a.in[i]; };
  unsigned char* ws = F.ws;
  if (do_dense) {
    constexpr int I_WIN_ = 16 * 40, I_WQB_ = 4 * 12, I_WKVB_ = 4 * 16, I_SQ = 16 * 16;
    constexpr int NIT = I_WIN_ + I_WQB_ + I_WKVB_ + 5 * I_SQ;
    for (int it = gw; it < NIT; it += NGW) {
      int r = it;
      if (r < I_WIN_) { const int kb = r / 40, nb = r % 40; int sc, nc = 64;
        if (nb < 32) sc = 64 * nb; else if (nb < 36) sc = OFF_CQ + 64 * (nb - 32); else if (nb < 38) sc = OFF_CKV + 64 * (nb - 36); else if (nb == 38) { sc = OFF_KR; nc = 32; } else { sc = 0; nc = 0; }
        p0_tr(I(I_WIN), D_IN, 64 * kb, 1024, sc, nc, I(I_GMIX), (bf16*)(ws + WS_WIN), 1024, 64 * nb, scr, F.lane);
        if (nb == 38) p0_tr32(I(I_WIN), D_IN, 64 * kb, OFF_G, 16, I(I_GMIX), (bf16*)(ws + WS_WIN), 1024, PC_G, scr, F.lane);
        continue; } r -= I_WIN_;
      if (r < I_WQB_) { const int kb = r / 12, nb = r % 12; p0_tr(I(I_WQB), 768, 64 * kb, 256, 64 * nb, 64, I(I_GQA), (bf16*)(ws + WS_WQB), 256, 64 * nb, scr, F.lane); continue; } r -= I_WQB_;
      if (r < I_WKVB_) { const int kb = r / 16, nb = r % 16; const int h = nb & 7; const int sc = h * 128 + (nb >= 8 ? 64 : 0);
        p0_tr(I(I_WKVB), 1024, 64 * kb, 128, sc, 64, I(I_GKVA), (bf16*)(ws + WS_WKVB), 256, 64 * nb, scr, F.lane); continue; } r -= I_WKVB_;
      const int which = r / I_SQ; r %= I_SQ; const int kb = r / 16, nb = r % 16;
      const float* src = which == 0 ? I(I_WOUT) : which == 1 ? I(I_WMQ) : which == 2 ? I(I_WMK) : which == 3 ? I(I_WMV) : I(I_WMO);
      const float* gs = which == 1 ? I(I_GMX) : (which == 2 || which == 3) ? I(I_GMKV) : nullptr;
      bf16* dst = (bf16*)(ws + (which == 0 ? WS_WOUT : which == 1 ? WS_WMQ : which == 2 ? WS_WMK : which == 3 ? WS_WMV : WS_WMO));
      p0_tr(src, 1024, 64 * kb, 1024, 64 * nb, 64, gs, dst, 1024, 64 * nb, scr, F.lane);
    }
    for (int m = gw; m < MTOK; m += NGW) rms_row_to_bf16(I(I_X) + (size_t)m * 1024, (bf16*)(ws + WS_XN) + (size_t)m * 1024, F.lane);
    for (int m = gw; m < BATCH * NMEM; m += NGW) rms_row_to_bf16(I(I_MEM) + (size_t)m * 1024, (bf16*)(ws + WS_MEMN) + (size_t)m * 1024, F.lane);
    { const float* wr = I(I_WR); const float* gf = I(I_GFFN); float* wrg = (float*)(ws + WS_DEC + 65536);
      for (int i = (F.vcu * NTHR + F.tid); i < 1024 * 16; i += F.G * NTHR) wrg[i] = wr[i] * gf[i >> 4]; }
    { const int* pos = (const int*)a.in[I_POS]; float* rt = (float*)(ws + WS_ROPE);
      for (int i = (F.vcu * NTHR + F.tid); i < MTOK * 16; i += F.G * NTHR) { const int m = i >> 4, j = i & 15; const float inv = powf(10000.f, -(float)j / 16.f); const float ang = (float)pos[m] * inv;
        rt[m * 32 + j] = cosf(ang); rt[m * 32 + 16 + j] = sinf(ang); } }
  }
  if (do_experts) conv_fill(F, a, 1 << 30);
}

__device__ __forceinline__ v4u pack8(const float (&v)[8]) { v4u w; w.x = cvt_pk_bf16(v[0], v[1]); w.y = cvt_pk_bf16(v[2], v[3]); w.z = cvt_pk_bf16(v[4], v[5]); w.w = cvt_pk_bf16(v[6], v[7]); return w; }
__device__ __forceinline__ float sumsq8(const float (&v)[8]) { float s = 0.f;
#pragma unroll
  for (int i = 0; i < 8; ++i) s += v[i] * v[i];
  return s; }
struct EpiStore { static constexpr bool TWO_PASS = false; bf16* O; int ldc;
  __device__ __forceinline__ void row8(const pg8::Unit& u, int rloc, int cloc, const float (&v0)[8], const float (&v1)[8], int fq) const {
    bf16* p = O + (size_t)(u.pm * 256 + rloc) * ldc + u.pn * 256 + cloc; *(v4u*)p = pack8(v0); *(v4u*)(p + 128) = pack8(v1); } };
struct EpiProj { static constexpr bool TWO_PASS = false; bf16* P; float* ssq; float* sskv;
  __device__ __forceinline__ void row8(const pg8::Unit& u, int rloc, int cloc, const float (&v0)[8], const float (&v1)[8], int fq) const {
    const int row = u.pm * 256 + rloc; bf16* p = P + (size_t)row * PROJ_LD + u.pn * 256 + cloc; *(v4u*)p = pack8(v0); *(v4u*)(p + 128) = pack8(v1);
    if (u.pn == 8) { float s = sumsq8(v0) + sumsq8(v1); s += __shfl_xor(s, 16); s += __shfl_xor(s, 32); if (fq == 0) unsafeAtomicAdd(ssq + row, s); }
    if (u.pn == 9) { float s = sumsq8(v0); s += __shfl_xor(s, 16); s += __shfl_xor(s, 32); if (fq == 0) unsafeAtomicAdd(sskv + row, s); } } };
struct EpiQ { static constexpr bool TWO_PASS = false; bf16* Q; const float* ssq; const float* rope;
  __device__ __forceinline__ void rope8(float (&v)[8], int row, int fq) const {
    float pv[8];
#pragma unroll
    for (int i = 0; i < 8; ++i) pv[i] = __shfl_xor(v[i], 32);
    const float* cs = rope + (size_t)row * 32 + 8 * (fq & 1);
#pragma unroll
    for (int i = 0; i < 8; ++i) { const float c = cs[i], s = cs[16 + i]; v[i] = (fq < 2) ? (v[i] * c - pv[i] * s) : (v[i] * c + pv[i] * s); }
  }
  __device__ __forceinline__ void row8(const pg8::Unit& u, int rloc, int cloc, const float (&a0)[8], const float (&a1)[8], int fq) const {
    const int row = u.pm * 256 + rloc; const float r = rsqrtf(ssq[row] * (1.f / 256.f) + 1e-6f);
    float v0[8], v1[8];
#pragma unroll
    for (int i = 0; i < 8; ++i) { v0[i] = a0[i] * r; v1[i] = a1[i] * r; }
    const int g0 = u.pn * 8 + (cloc >> 5), g1 = g0 + 4;
    if (g0 % 3 == 2) rope8(v0, row, fq);
    if (g1 % 3 == 2) rope8(v1, row, fq);
    bf16* p = Q + (size_t)row * 768 + u.pn * 256 + cloc; *(v4u*)p = pack8(v0); *(v4u*)(p + 128) = pack8(v1); } };
struct EpiKV { static constexpr bool TWO_PASS = false; bf16* KMp; bf16* VMp; const float* sskv;
  __device__ __forceinline__ void put(int row, int c, const float (&v)[8], float r) const {
    float w[8];
#pragma unroll
    for (int i = 0; i < 8; ++i) w[i] = v[i] * r;
    if (c < 512) *(v4u*)(KMp + (size_t)row * 768 + (c >> 6) * 96 + (c & 63)) = pack8(w); else *(v4u*)(VMp + (size_t)row * 512 + (c - 512)) = pack8(w); }
  __device__ __forceinline__ void row8(const pg8::Unit& u, int rloc, int cloc, const float (&a0)[8], const float (&a1)[8], int fq) const {
    const int row = u.pm * 256 + rloc; const float r = rsqrtf(sskv[row] * (1.f / 128.f) + 1e-6f);
    put(row, u.pn * 256 + cloc, a0, r); put(row, u.pn * 256 + 128 + cloc, a1, r); } };

__device__ __forceinline__ void unpack8(v4u w, float (&f)[8]) { f[0] = bflo(w.x); f[1] = bfhi(w.x); f[2] = bflo(w.y); f[3] = bfhi(w.y); f[4] = bflo(w.z); f[5] = bfhi(w.z); f[6] = bflo(w.w); f[7] = bfhi(w.w); }
__device__ __forceinline__ float log_sigmoid(float x) { return fminf(x, 0.f) - log1pf(__expf(-fabsf(x))); }

__device__ __forceinline__ void p2_elementwise(Frame& F, const Args& a) {
  unsigned char* ws = F.ws;
  const bf16* P = (const bf16*)(ws + WS_PROJ);
  { const float* cw = (const float*)a.in[I_CONV]; bf16* QC = (bf16*)(ws + WS_QC); bf16* KC = (bf16*)(ws + WS_KC);
    for (int i = F.vcu * NTHR + F.tid; i < MTOK * 128; i += F.G * NTHR) { const int m = i >> 7, c = (i & 127) * 8, t = m & (SEQ - 1);
      float x1[8], x0[8], x2[8]; unpack8(*(const v4u*)(P + (size_t)m * PROJ_LD + c), x1);
      if (t > 0) unpack8(*(const v4u*)(P + (size_t)(m - 1) * PROJ_LD + c), x0); else {
#pragma unroll
        for (int j = 0; j < 8; ++j) x0[j] = 0.f; }
      if (t < SEQ - 1) unpack8(*(const v4u*)(P + (size_t)(m + 1) * PROJ_LD + c), x2); else {
#pragma unroll
        for (int j = 0; j < 8; ++j) x2[j] = 0.f; }
      float o[8];
#pragma unroll
      for (int j = 0; j < 8; ++j) { float v = x0[j] * cw[c + j] + x1[j] * cw[1024 + c + j] + x2[j] * cw[2048 + c + j]; v = v * sigmoidf_(v); o[j] = (c < 512) ? v : v * 0.08838834764831845f; }
      if (c < 512) *(v4u*)(QC + (size_t)m * 512 + c) = pack8(o); else *(v4u*)(KC + (size_t)m * 512 + c - 512) = pack8(o); } }
  { const float* rope = (const float*)(ws + WS_ROPE); bf16* KMp = (bf16*)(ws + WS_KM);
    for (int i = F.vcu * NTHR + F.tid; i < MTOK * 16; i += F.G * NTHR) { const int m = i >> 4, j = i & 15;
      const float t1 = bf2f(P[(size_t)m * PROJ_LD + PC_KR + j]), t2 = bf2f(P[(size_t)m * PROJ_LD + PC_KR + 16 + j]); const float c = rope[m * 32 + j], s = rope[m * 32 + 16 + j];
      const bf16 o1 = (bf16)f2bf(t1 * c - t2 * s), o2 = (bf16)f2bf(t2 * c + t1 * s);
#pragma unroll
      for (int h = 0; h < 8; ++h) { KMp[(size_t)m * 768 + h * 96 + 64 + j] = o1; KMp[(size_t)m * 768 + h * 96 + 80 + j] = o2; } } }
  { const float* bg = (const float*)a.in[I_BG]; float* GSC = (float*)(ws + WS_GSC); float* DEC = (float*)(ws + WS_DEC);
    const int gw = F.vcu * NWAVES + F.wave, NGW = F.G * NWAVES;
    for (int it = gw; it < 32 * 64; it += NGW) { const int seq = it >> 6, c = it & 63, dir = seq & 1, h = (seq >> 1) & 3, b = seq >> 3;
      const int p = c * 64 + F.lane, t = dir ? (SEQ - 1 - p) : p; const size_t row = (size_t)b * SEQ + t;
      const int gi = (dir ? 8 : 0) + h, gf = (dir ? 12 : 4) + h;
      const float li = bf2f(P[row * PROJ_LD + PC_G + gi]) + bg[gi]; const float lf = log_sigmoid(bf2f(P[row * PROJ_LD + PC_G + gf]) + bg[gf]);
      float bs = lf;
#pragma unroll
      for (int o = 1; o < 64; o <<= 1) { const float y = __shfl_up(bs, o); if (F.lane >= o) bs += y; }
      const float av = li - bs; float pm = av;
#pragma unroll
      for (int o = 1; o < 64; o <<= 1) { const float y = __shfl_up(pm, o); if (F.lane >= o) pm = fmaxf(pm, y); }
      float* gs = GSC + (size_t)seq * 3 * SEQ; gs[p] = bs; gs[SEQ + p] = av; gs[2 * SEQ + p] = pm;
      if (F.lane == 63) { DEC[seq * 128 + c] = bs; DEC[seq * 128 + 64 + c] = pm; } } }
}
namespace mla {
constexpr int DQK = 96, DV = 64, NW = 8, QBLK = 32, KVBLK = 64, LDQ = 768, LDK = 768, LDV = 512, LDO = 1024;
constexpr float SCALE = 0.10206207261596575f;
constexpr float THR = 8.f;
constexpr int SHM_V = 16384, SHM_K = 16384, SHM_ATTN = 2 * SHM_V + 2 * SHM_K + NW * 64 * 4;
#define KSWZ(row, colB) ((row) * 256 + ((colB) ^ (((row) & 7) << 4)))
#define SBAR() __builtin_amdgcn_sched_barrier(0)
__device__ __forceinline__ int crow(int r, int hi) { return (r & 3) + 8 * (r >> 2) + 4 * hi; }
__device__ __forceinline__ void partialSM(f32x16& p0, f32x16& p1, float& m_reg, float& mn, float& alpha) {
  constexpr float C = SCALE * 1.4426950408889634f;
  float pmax = p0[0];
#pragma unroll
  for (int r = 1; r < 16; ++r) pmax = fmaxf(pmax, p0[r]);
#pragma unroll
  for (int r = 0; r < 16; ++r) pmax = fmaxf(pmax, p1[r]);
  { auto rr = __builtin_amdgcn_permlane32_swap(__float_as_uint(pmax), __float_as_uint(pmax), false, false);
    pmax = fmaxf(__uint_as_float(rr[0]), __uint_as_float(rr[1])); }
  if (__builtin_expect(__all(pmax - m_reg <= THR / SCALE), 1)) { mn = m_reg; alpha = 1.f; }
  else { mn = fmaxf(m_reg, pmax); alpha = __builtin_amdgcn_exp2f((m_reg - mn) * C); m_reg = mn; }
  const float mnC = -mn * C;
#pragma unroll
  for (int r = 0; r < 16; ++r) p0[r] = fmaf(p0[r], C, mnC);
#pragma unroll
  for (int r = 0; r < 16; ++r) p1[r] = fmaf(p1[r], C, mnC);
#pragma unroll
  for (int r = 0; r < 16; ++r) p0[r] = __builtin_amdgcn_exp2f(p0[r]);
}
__device__ __forceinline__ void finishSM(f32x16& p0, f32x16& p1, float alpha, float& l_reg, bf16x8& pa0, bf16x8& pa1, bf16x8& pa2, bf16x8& pa3) {
#pragma unroll
  for (int r = 0; r < 16; ++r) p1[r] = __builtin_amdgcn_exp2f(p1[r]);
  float ps = 0;
#pragma unroll
  for (int r = 0; r < 16; ++r) ps += p0[r];
#pragma unroll
  for (int r = 0; r < 16; ++r) ps += p1[r];
  { auto rr = __builtin_amdgcn_permlane32_swap(__float_as_uint(ps), __float_as_uint(ps), false, false);
    ps = __uint_as_float(rr[0]) + __uint_as_float(rr[1]); }
  l_reg = l_reg * alpha + ps;
#define PK4(P, BASE, OUT) do { unsigned a0 = cvt_pk_bf16(P[BASE + 0], P[BASE + 1]), a1 = cvt_pk_bf16(P[BASE + 2], P[BASE + 3]);   \
    unsigned b0 = cvt_pk_bf16(P[BASE + 4], P[BASE + 5]), b1 = cvt_pk_bf16(P[BASE + 6], P[BASE + 7]);                              \
    auto r0 = __builtin_amdgcn_permlane32_swap(a0, b0, false, false); auto r1 = __builtin_amdgcn_permlane32_swap(a1, b1, false, false); \
    v4u w = {r0[0], r1[0], r0[1], r1[1]}; OUT = __builtin_bit_cast(bf16x8, w); } while (0)
  PK4(p0, 0, pa0); PK4(p0, 8, pa1); PK4(p1, 0, pa2); PK4(p1, 8, pa3);
#undef PK4
}
__device__ __forceinline__ void qkt(f32x16& p0, f32x16& p1, const char* Ks, const bf16x8* qr, int r32, int hi) {
  p0 = f32x16{}; p1 = f32x16{};
#pragma unroll
  for (int d0 = 0; d0 < DQK / 16; ++d0) { const int cb = (d0 * 16 + hi * 8) * 2;
    const bf16x8 b0 = *reinterpret_cast<const bf16x8*>(Ks + KSWZ(r32, cb));
    const bf16x8 b1 = *reinterpret_cast<const bf16x8*>(Ks + KSWZ(32 + r32, cb));
    p0 = __builtin_amdgcn_mfma_f32_32x32x16_bf16(b0, qr[d0], p0, 0, 0, 0);
    p1 = __builtin_amdgcn_mfma_f32_32x32x16_bf16(b1, qr[d0], p1, 0, 0, 0); }
}
__device__ __forceinline__ int v_st(int k, int c) { const int kk = (k & ~0xC) | ((k & 4) << 1) | ((k & 8) >> 1); return ((kk >> 3) * 4 + (c >> 5)) * 512 + ((kk & 7) * 32 + (c & 31)) * 2; }
__device__ __forceinline__ int v_rd_base(int lane) { return ((lane & 3) << 3) | (((lane >> 2) & 3) << 6) | (((lane >> 4) & 1) << 5) | (((lane >> 5) & 1) << 8); }
constexpr int v_rd_off(int d0, int ks, int half) { return d0 * 512 + ks * 4096 + half * 2048; }
template <int OFF> __device__ __forceinline__ s16x4 tr_read(int vb) {
  s16x4 r; asm volatile("ds_read_b64_tr_b16 %0, %1 offset:%2" : "=&v"(r) : "v"(vb), "i"(OFF) : "memory"); return r;
}
template <int D0> __device__ __forceinline__ void pv_one(f32x16& od, int vb, bf16x8 pa0, bf16x8 pa1, bf16x8 pa2, bf16x8 pa3) {
  const s16x4 l0 = tr_read<v_rd_off(D0, 0, 0)>(vb), h0 = tr_read<v_rd_off(D0, 0, 1)>(vb), l1 = tr_read<v_rd_off(D0, 1, 0)>(vb), h1 = tr_read<v_rd_off(D0, 1, 1)>(vb);
  const s16x4 l2 = tr_read<v_rd_off(D0, 2, 0)>(vb), h2 = tr_read<v_rd_off(D0, 2, 1)>(vb), l3 = tr_read<v_rd_off(D0, 3, 0)>(vb), h3 = tr_read<v_rd_off(D0, 3, 1)>(vb);
  asm volatile("s_waitcnt lgkmcnt(0)" ::: "memory"); SBAR();
#define PK(L, H) (bf16x8){L[0], L[1], L[2], L[3], H[0], H[1], H[2], H[3]}
  od = __builtin_amdgcn_mfma_f32_32x32x16_bf16(pa0, PK(l0, h0), od, 0, 0, 0);
  od = __builtin_amdgcn_mfma_f32_32x32x16_bf16(pa1, PK(l1, h1), od, 0, 0, 0);
  od = __builtin_amdgcn_mfma_f32_32x32x16_bf16(pa2, PK(l2, h2), od, 0, 0, 0);
  od = __builtin_amdgcn_mfma_f32_32x32x16_bf16(pa3, PK(l3, h3), od, 0, 0, 0);
#undef PK
}
__device__ __forceinline__ void pv_d0(f32x16* o, int vb, bf16x8 pa0, bf16x8 pa1, bf16x8 pa2, bf16x8 pa3) {
  pv_one<0>(o[0], vb, pa0, pa1, pa2, pa3); pv_one<1>(o[1], vb, pa0, pa1, pa2, pa3);
}
__device__ __forceinline__ void attn_unit(const bf16* __restrict__ Qb, const bf16* __restrict__ Kh, const bf16* __restrict__ Vh, bf16* __restrict__ Yb, const float* __restrict__ gh, int seq, char* lds) {
  int tid = threadIdx.x; asm volatile("" : "+v"(tid));
  const int wid = tid >> 6, lane = tid & 63, r32 = lane & 31, hi = lane >> 5;
  char* V_lds = lds; char* K_lds = lds + 2 * SHM_V;
  float* wsf = (float*)(lds + 2 * SHM_V + 2 * SHM_K) + wid * 64; float* li_l = wsf; float* al_l = wsf + 32;
  float m_reg = -1e30f, l_reg = 0; f32x16 o[2] = {}; bf16x8 qr[DQK / 16];
  const bf16* Qw = Qb + (long)(wid * QBLK + r32) * LDQ + hi * 8;
#pragma unroll
  for (int d0 = 0; d0 < DQK / 16; ++d0) qr[d0] = *reinterpret_cast<const bf16x8*>(Qw + d0 * 16);
  const int sr = tid >> 4, sc = (tid & 15) * 8, vst0 = v_st(sr, sc & 63), vst1 = v_st(32 + sr, sc & 63);
  const bool doK = sc < DQK, doV = sc < DV;
  const int vb0 = (int)(uintptr_t)V_lds + v_rd_base(lane);
  struct { bf16x8 vs0, vs1, ks0, ks1; } sr_[2];
#define SLOAD(i, k0) do { if (doV) { sr_[i].vs0 = *reinterpret_cast<const bf16x8*>(&Vh[(long)((k0) + sr) * LDV + sc]); sr_[i].vs1 = *reinterpret_cast<const bf16x8*>(&Vh[(long)((k0) + 32 + sr) * LDV + sc]); } \
    if (doK) { sr_[i].ks0 = *reinterpret_cast<const bf16x8*>(&Kh[(long)((k0) + sr) * LDK + sc]); sr_[i].ks1 = *reinterpret_cast<const bf16x8*>(&Kh[(long)((k0) + 32 + sr) * LDK + sc]); } } while (0)
#define SWRITE(b, i) do { if (doV) { *(bf16x8*)(V_lds + (b) * SHM_V + vst0) = sr_[i].vs0; *(bf16x8*)(V_lds + (b) * SHM_V + vst1) = sr_[i].vs1; } \
    if (doK) { const int kc = sc * 2; *(bf16x8*)(K_lds + (b) * SHM_K + KSWZ(sr, kc)) = sr_[i].ks0; *(bf16x8*)(K_lds + (b) * SHM_K + KSWZ(32 + sr, kc)) = sr_[i].ks1; } } while (0)
#define SWAIT() asm volatile("s_waitcnt vmcnt(4)" ::: "memory")
#define RESC(a) do { if (__any((a) < 1.f)) { if (hi == 0) al_l[r32] = (a); asm volatile("s_waitcnt lgkmcnt(0)" ::: "memory"); \
    _Pragma("unroll") for (int d = 0; d < 2; ++d) _Pragma("unroll") for (int r = 0; r < 16; ++r) o[d][r] *= al_l[crow(r, hi)]; } } while (0)
  f32x16 pA0, pA1, pB0, pB1; float mnA, mnB, alA, alB; bf16x8 pa0, pa1, pa2, pa3; const int NT = seq / KVBLK;
  constexpr int SE = 0, SO = 1;
  SLOAD(SE, 0); asm volatile("s_waitcnt vmcnt(0)" ::: "memory"); SWRITE(0, SE); __syncthreads();
  qkt(pA0, pA1, K_lds, qr, r32, hi); partialSM(pA0, pA1, m_reg, mnA, alA);
  SLOAD(SO, KVBLK); if (2 < NT) SLOAD(SE, 2 * KVBLK);
  SWAIT(); SWRITE(1, SO); __syncthreads();
  for (int j = 1; j + 1 < NT; j += 2) {
    SBAR(); qkt(pB0, pB1, K_lds + SHM_K, qr, r32, hi);
    finishSM(pA0, pA1, alA, l_reg, pa0, pa1, pa2, pa3); SBAR();
    SLOAD(SO, (j + 2) * KVBLK); SBAR();
    pv_d0(o, vb0, pa0, pa1, pa2, pa3); partialSM(pB0, pB1, m_reg, mnB, alB);
    __syncthreads(); SWAIT(); SWRITE(0, SE);
    RESC(alB); __syncthreads();
    SBAR(); qkt(pA0, pA1, K_lds, qr, r32, hi);
    finishSM(pB0, pB1, alB, l_reg, pa0, pa1, pa2, pa3); SBAR();
    if (j + 3 < NT) SLOAD(SE, (j + 3) * KVBLK); SBAR();
    pv_d0(o, vb0 + SHM_V, pa0, pa1, pa2, pa3); partialSM(pA0, pA1, m_reg, mnA, alA);
    __syncthreads(); SWAIT(); SWRITE(1, SO);
    RESC(alA); __syncthreads();
  }
  SBAR(); qkt(pB0, pB1, K_lds + SHM_K, qr, r32, hi);
  finishSM(pA0, pA1, alA, l_reg, pa0, pa1, pa2, pa3); SBAR();
  pv_d0(o, vb0, pa0, pa1, pa2, pa3); partialSM(pB0, pB1, m_reg, mnB, alB);
  __syncthreads(); RESC(alB);
  finishSM(pB0, pB1, alB, l_reg, pa0, pa1, pa2, pa3); SBAR();
  pv_d0(o, vb0 + SHM_V, pa0, pa1, pa2, pa3);
  __syncthreads();
  { float* st = (float*)lds + wid * (32 * 68);
#pragma unroll
    for (int r = 0; r < 16; ++r) { const int orow = crow(r, hi); st[orow * 68 + r32] = o[0][r]; st[orow * 68 + 32 + r32] = o[1][r]; }
    asm volatile("s_waitcnt lgkmcnt(0)" ::: "memory");
    float v[32]; float s = 0.f;
#pragma unroll
    for (int j = 0; j < 8; ++j) { const f32x4 t = *(const f32x4*)(st + r32 * 68 + hi * 32 + 4 * j); v[4 * j] = t.x; v[4 * j + 1] = t.y; v[4 * j + 2] = t.z; v[4 * j + 3] = t.w; s += (t.x * t.x + t.y * t.y) + (t.z * t.z + t.w * t.w); }
    { auto rr = __builtin_amdgcn_permlane32_swap(__float_as_uint(s), __float_as_uint(s), false, false); s = __uint_as_float(rr[0]) + __uint_as_float(rr[1]); }
    const float rl = 1.f / l_reg; const float fac = rl * rsqrtf(s * rl * rl * (1.f / 64.f) + 1e-6f);
    bf16* yp = Yb + (long)(wid * QBLK + r32) * LDO + hi * 32; const float* gp = gh + hi * 32;
#pragma unroll
    for (int j = 0; j < 4; ++j) { float w[8];
#pragma unroll
      for (int e = 0; e < 8; ++e) w[e] = v[8 * j + e] * fac * gp[8 * j + e];
      *(v4u*)(yp + 8 * j) = pack8(w); } }
  __syncthreads();
#undef SLOAD
#undef SWRITE
#undef SWAIT
#undef RESC
}
#undef KSWZ
#undef SBAR
}

__device__ __forceinline__ int queue_pull(Frame& F, gu32* heads, int nq, int nper, int myq) {
  volatile LAS int* slot = (volatile LAS int*)(F.lds + LDSCTL_OFF);
  if (F.tid == 0) { int got = -1;
    for (int k = 0; k < nq; ++k) { const int q = (myq + k) % nq;
      if (__hip_atomic_load(heads + 64 * q, RLX_AGENT) >= (unsigned)nper) continue;
      const unsigned i = __hip_atomic_fetch_add(heads + 64 * q, 1u, RLX_AGENT);
      if (i < (unsigned)nper) { got = q * nper + (int)i; break; } }
    *slot = got; }
  __syncthreads();
  const int r = __builtin_amdgcn_readfirstlane(*slot);
  __syncthreads();
  return r;
}
__device__ __forceinline__ void p3_attention(Frame& F, const Args& a, char* lds_generic, unsigned xcc, int qoff) {
  unsigned char* ws = F.ws;
  const bf16* QMp = (const bf16*)(ws + WS_QM); const bf16* KMp = (const bf16*)(ws + WS_KM); const bf16* VMp = (const bf16*)(ws + WS_VM); bf16* Y = (bf16*)(ws + WS_Y);
  for (;;) {
    const int u = queue_pull(F, F.ctl + CW_Q + qoff, 8, 64, (int)(xcc & 7u));
    if (u < 0) break;
    const int bh = u >> 4, qb = u & 15, b = bh >> 3, h = bh & 7;
    mla::attn_unit(QMp + ((size_t)b * SEQ + qb * 256) * 768 + h * 96, KMp + (size_t)b * SEQ * 768 + h * 96, VMp + (size_t)b * SEQ * 512 + h * 64,
                   Y + ((size_t)b * SEQ + qb * 256) * 1024 + 512 + h * 64, (const float*)a.in[I_GHA] + h * 64, SEQ, lds_generic);
  }
}
namespace mls {
using mla::crow; using mla::v_st; using mla::v_rd_base;
#define KSWZ(row, colB) ((row) * 256 + ((colB) ^ (((row) & 7) << 4)))
constexpr int OFF_QS = 0, OFF_KS = 16384, OFF_KP = 32768, OFF_VV = 49152, OFF_CT = 65536, OFF_SC = 98304, OFF_NB = 99328, OFF_NP = 100352, OFF_CH = 104448, OFF_WS = 105472;
template <int OFF> __device__ __forceinline__ s16x4 trr(int vb) { s16x4 r; asm volatile("ds_read_b64_tr_b16 %0, %1 offset:%2" : "=&v"(r) : "v"(vb), "i"(OFF) : "memory"); return r; }
#define PKF(L, H) (bf16x8){L[0], L[1], L[2], L[3], H[0], H[1], H[2], H[3]}
__device__ __forceinline__ void vfrags(int img, int d0, int lane, bf16x8 (&f)[4]) {
  const int vb = img + v_rd_base(lane) + d0 * 512;
  const s16x4 l0 = trr<0>(vb), h0 = trr<2048>(vb), l1 = trr<4096>(vb), h1 = trr<4096 + 2048>(vb), l2 = trr<8192>(vb), h2 = trr<8192 + 2048>(vb), l3 = trr<12288>(vb), h3 = trr<12288 + 2048>(vb);
  asm volatile("s_waitcnt lgkmcnt(0)" ::: "memory"); __builtin_amdgcn_sched_barrier(0);
  f[0] = PKF(l0, h0); f[1] = PKF(l1, h1); f[2] = PKF(l2, h2); f[3] = PKF(l3, h3);
}
__device__ __forceinline__ void pack_p(const f32x16& p0, const f32x16& p1, bf16x8& pa0, bf16x8& pa1, bf16x8& pa2, bf16x8& pa3) {
#define PK4(P, BASE, OUT) do { unsigned a0 = cvt_pk_bf16(P[BASE + 0], P[BASE + 1]), a1 = cvt_pk_bf16(P[BASE + 2], P[BASE + 3]);   \
    unsigned b0 = cvt_pk_bf16(P[BASE + 4], P[BASE + 5]), b1 = cvt_pk_bf16(P[BASE + 6], P[BASE + 7]);                              \
    auto r0 = __builtin_amdgcn_permlane32_swap(a0, b0, false, false); auto r1 = __builtin_amdgcn_permlane32_swap(a1, b1, false, false); \
    v4u w = {r0[0], r1[0], r0[1], r1[1]}; OUT = __builtin_bit_cast(bf16x8, w); } while (0)
  PK4(p0, 0, pa0); PK4(p0, 8, pa1); PK4(p1, 0, pa2); PK4(p1, 8, pa3);
#undef PK4
}
__device__ __forceinline__ float swap_add(float v) { auto rr = __builtin_amdgcn_permlane32_swap(__float_as_uint(v), __float_as_uint(v), false, false); return __uint_as_float(rr[0]) + __uint_as_float(rr[1]); }

__device__ __forceinline__ void mlstm_seq(int seq, unsigned char* ws, char* lds) {
  int tid = threadIdx.x; asm volatile("" : "+v"(tid));
  const int wid = __builtin_amdgcn_readfirstlane(tid >> 6), lane = tid & 63, r32 = lane & 31, hi = lane >> 5, rb = wid >> 2, cb = wid & 3;
  const int dir = seq & 1, h = (seq >> 1) & 3, b = seq >> 3;
  const bf16* QC = (const bf16*)(ws + WS_QC); const bf16* KC = (const bf16*)(ws + WS_KC); const bf16* P = (const bf16*)(ws + WS_PROJ);
  const float* gs = (const float*)(ws + WS_GSC) + (size_t)seq * 3 * SEQ; const float* dec = (const float*)(ws + WS_DEC) + seq * 128;
  bf16* H = (bf16*)(ws + (dir ? WS_HB : WS_HF));
  float* sc_alpha = (float*)(lds + OFF_SC); float* sc_a = sc_alpha + 64; float* sc_iw = sc_alpha + 128; float* sc_en = sc_alpha + 192;
  float* nbuf = (float*)(lds + OFF_NB); float* npart = (float*)(lds + OFF_NP);
  float* ch_mprev = (float*)(lds + OFF_CH); float* ch_mnew = ch_mprev + 64; float* ch_dec = ch_mprev + 128; float* ch_g = ch_mprev + 192;
  float* wsf = (float*)(lds + OFF_WS) + wid * 32;
  const int ldsb = (int)(uintptr_t)lds;
  if (tid < 64) {
    if (tid == 0) { float m = 0.f; for (int c = 0; c < 64; ++c) { const float g = dec[c], wm = dec[64 + c]; const float mn = fmaxf(g + m, g + wm); ch_mprev[c] = m; ch_mnew[c] = mn; ch_dec[c] = __expf(g + m - mn); ch_g[c] = g; m = mn; } } }
  for (int i = tid; i < 32768 / 16; i += NTHR) ((v4u*)(lds + OFF_CT))[i] = (v4u){0u, 0u, 0u, 0u};
  if (tid < 128) nbuf[tid] = 0.f;
  f32x16 cacc[2]; cacc[0] = f32x16{}; cacc[1] = f32x16{};
  __syncthreads();
  const int sr = tid >> 4, sc = (tid & 15) * 8;
  v4u gq0, gq1, gk0, gk1, gv0, gv1; float ga0, ga1, sb = 0.f, sa = 0.f, spm = 0.f;
#define ROWOF(p) ((size_t)b * SEQ + (dir ? (SEQ - 1 - (p)) : (p)))
#define LOADC(c) do { const int p0_ = 64 * (c) + sr, p1_ = p0_ + 32; const size_t r0_ = ROWOF(p0_), r1_ = ROWOF(p1_); \
    gq0 = *(const v4u*)(QC + r0_ * 512 + h * 128 + sc); gq1 = *(const v4u*)(QC + r1_ * 512 + h * 128 + sc); \
    gk0 = *(const v4u*)(KC + r0_ * 512 + h * 128 + sc); gk1 = *(const v4u*)(KC + r1_ * 512 + h * 128 + sc); \
    gv0 = *(const v4u*)(P + r0_ * PROJ_LD + 1024 + h * 128 + sc); gv1 = *(const v4u*)(P + r1_ * PROJ_LD + 1024 + h * 128 + sc); \
    ga0 = gs[SEQ + p0_]; ga1 = gs[SEQ + p1_]; \
    if (tid < 64) { sb = gs[64 * (c) + tid]; sa = gs[SEQ + 64 * (c) + tid]; spm = gs[2 * SEQ + 64 * (c) + tid]; } } while (0)
#define WRITEC(c) do { \
    *(v4u*)(lds + OFF_QS + KSWZ(sr, sc * 2)) = gq0; *(v4u*)(lds + OFF_QS + KSWZ(32 + sr, sc * 2)) = gq1; \
    *(v4u*)(lds + OFF_KS + KSWZ(sr, sc * 2)) = gk0; *(v4u*)(lds + OFF_KS + KSWZ(32 + sr, sc * 2)) = gk1; \
    *(v4u*)(lds + OFF_VV + v_st(sr, sc)) = gv0; *(v4u*)(lds + OFF_VV + v_st(32 + sr, sc)) = gv1; \
    { const float gc_ = ch_g[c], mn_ = ch_mnew[c]; const float w0_ = __expf(gc_ + ga0 - mn_), w1_ = __expf(gc_ + ga1 - mn_); float f0_[8], f1_[8], cs_[8]; unpack8(gk0, f0_); unpack8(gk1, f1_); \
      _Pragma("unroll") for (int j = 0; j < 8; ++j) { f0_[j] *= w0_; f1_[j] *= w1_; cs_[j] = f0_[j] + f1_[j]; } \
      *(v4u*)(lds + OFF_KP + v_st(sr, sc)) = pack8(f0_); *(v4u*)(lds + OFF_KP + v_st(32 + sr, sc)) = pack8(f1_); \
      _Pragma("unroll") for (int j = 0; j < 8; ++j) { cs_[j] += __shfl_xor(cs_[j], 16); cs_[j] += __shfl_xor(cs_[j], 32); } \
      if ((lane >> 4) == 0) { _Pragma("unroll") for (int j = 0; j < 8; ++j) npart[wid * 128 + sc + j] = cs_[j]; } } \
    if (tid < 64) { const float m_ = ch_mprev[c]; const float mt_ = fmaxf(sb + m_, sb + spm); sc_alpha[tid] = sb - mt_; sc_a[tid] = sa; sc_iw[tid] = __expf(sb + m_ - mt_); sc_en[tid] = __expf(-mt_); } } while (0)
  LOADC(0); WRITEC(0);
  __syncthreads();
  for (int c = 0; c < 64; ++c) {
    if (c + 1 < 64) LOADC(c + 1);
    const float* nb = nbuf + (c & 1) * 128;
    if (tid < 128) { float s = 0.f;
#pragma unroll
      for (int w = 0; w < 8; ++w) s += npart[w * 128 + tid];
      nbuf[((c + 1) & 1) * 128 + tid] = ch_dec[c] * nb[tid] + s; }
    bf16x8 qr[8];
#pragma unroll
    for (int d0 = 0; d0 < 8; ++d0) qr[d0] = *(const bf16x8*)(lds + OFF_QS + KSWZ(32 * rb + r32, (16 * d0 + 8 * hi) * 2));
    f32x16 p0 = f32x16{}, p1 = f32x16{};
#pragma unroll
    for (int d0 = 0; d0 < 8; ++d0) { const bf16x8 k0 = *(const bf16x8*)(lds + OFF_KS + KSWZ(r32, (16 * d0 + 8 * hi) * 2)); p0 = __builtin_amdgcn_mfma_f32_32x32x16_bf16(k0, qr[d0], p0, 0, 0, 0); }
    if (rb == 1) {
#pragma unroll
      for (int d0 = 0; d0 < 8; ++d0) { const bf16x8 k1 = *(const bf16x8*)(lds + OFF_KS + KSWZ(32 + r32, (16 * d0 + 8 * hi) * 2)); p1 = __builtin_amdgcn_mfma_f32_32x32x16_bf16(k1, qr[d0], p1, 0, 0, 0); }
    }
    const float al = sc_alpha[32 * rb + r32];
    if (rb == 0) {
#pragma unroll
      for (int r = 0; r < 16; ++r) { const int sl = crow(r, hi); p0[r] = (sl <= r32) ? __expf(al + sc_a[sl]) * p0[r] : 0.f; }
    } else {
#pragma unroll
      for (int r = 0; r < 16; ++r) { const int sl = crow(r, hi); p0[r] = __expf(al + sc_a[sl]) * p0[r]; p1[r] = (sl <= r32) ? __expf(al + sc_a[32 + sl]) * p1[r] : 0.f; }
    }
    float ps = 0.f;
#pragma unroll
    for (int r = 0; r < 16; ++r) ps += p0[r] + p1[r];
    ps = swap_add(ps);
    bf16x8 pa0, pa1, pa2, pa3; pack_p(p0, p1, pa0, pa1, pa2, pa3);
    float qn = 0.f;
#pragma unroll
    for (int d0 = 0; d0 < 8; ++d0) { const f32x4 n0 = *(const f32x4*)(nb + 16 * d0 + 8 * hi), n1 = *(const f32x4*)(nb + 16 * d0 + 8 * hi + 4); const v4u qw = __builtin_bit_cast(v4u, qr[d0]);
      qn += bflo(qw.x) * n0.x + bfhi(qw.x) * n0.y + bflo(qw.y) * n0.z + bfhi(qw.y) * n0.w + bflo(qw.z) * n1.x + bfhi(qw.z) * n1.y + bflo(qw.w) * n1.z + bfhi(qw.w) * n1.w; }
    qn = swap_add(qn);
    { const float iwt = sc_iw[32 * rb + r32]; const float den = iwt * qn + ps; const float rd = 1.f / fmaxf(fabsf(den), sc_en[32 * rb + r32]); if (hi == 0) wsf[r32] = rd; }
    f32x16 o = f32x16{};
#pragma unroll
    for (int d0 = 0; d0 < 8; ++d0) { const bf16x8 cf = *(const bf16x8*)(lds + OFF_CT + KSWZ(32 * cb + r32, (16 * d0 + 8 * hi) * 2)); o = __builtin_amdgcn_mfma_f32_32x32x16_bf16(qr[d0], cf, o, 0, 0, 0); }
#pragma unroll
    for (int r = 0; r < 16; ++r) o[r] *= sc_iw[32 * rb + crow(r, hi)];
    bf16x8 vf[4]; vfrags(ldsb + OFF_VV, cb, lane, vf);
    o = __builtin_amdgcn_mfma_f32_32x32x16_bf16(pa0, vf[0], o, 0, 0, 0); o = __builtin_amdgcn_mfma_f32_32x32x16_bf16(pa1, vf[1], o, 0, 0, 0);
    if (rb == 1) { o = __builtin_amdgcn_mfma_f32_32x32x16_bf16(pa2, vf[2], o, 0, 0, 0); o = __builtin_amdgcn_mfma_f32_32x32x16_bf16(pa3, vf[3], o, 0, 0, 0); }
    asm volatile("s_waitcnt lgkmcnt(0)" ::: "memory");
#pragma unroll
    for (int r = 0; r < 16; ++r) { const int tl = crow(r, hi); const int p = 64 * c + 32 * rb + tl; H[ROWOF(p) * 512 + h * 128 + 32 * cb + r32] = (bf16)f2bf(o[r] * wsf[tl]); }
    { const float dc = ch_dec[c];
#pragma unroll
      for (int i = 0; i < 2; ++i) { bf16x8 kf[4]; vfrags(ldsb + OFF_KP, 2 * rb + i, lane, kf);
#pragma unroll
        for (int r = 0; r < 16; ++r) cacc[i][r] *= dc;
#pragma unroll
        for (int ks = 0; ks < 4; ++ks) cacc[i] = __builtin_amdgcn_mfma_f32_32x32x16_bf16(kf[ks], vf[ks], cacc[i], 0, 0, 0); } }
    __syncthreads();
#pragma unroll
    for (int i = 0; i < 2; ++i)
#pragma unroll
      for (int g = 0; g < 4; ++g) { const int d = 32 * (2 * rb + i) + 8 * g + 4 * hi, e = 32 * cb + r32;
        v2u w; w.x = cvt_pk_bf16(cacc[i][4 * g], cacc[i][4 * g + 1]); w.y = cvt_pk_bf16(cacc[i][4 * g + 2], cacc[i][4 * g + 3]);
        *(v2u*)(lds + OFF_CT + KSWZ(e, d * 2)) = w; }
    if (c + 1 < 64) WRITEC(c + 1);
    __syncthreads();
  }
#undef ROWOF
#undef LOADC
#undef WRITEC
}
#undef KSWZ
#undef PKF
}

__device__ __forceinline__ void p3_mixers(Frame& F, const Args& a, char* lds_generic, unsigned xcc, int qoff) {
#ifndef DRY_MODE
#define DRY_MODE 0
#endif
  bool did_mlstm = false;
  if (!(qoff && DRY_MODE == 2))
  for (;;) { const int it = queue_pull(F, F.ctl + CW_Q + qoff + 64 * 8, 8, 4, (int)(xcc & 7u)); if (it < 0) break; mls::mlstm_seq(it, F.ws, lds_generic); __syncthreads();  }
  if (!(qoff && DRY_MODE == 1))
  p3_attention(F, a, lds_generic, xcc, qoff);
#ifndef P3_FILL_CHUNKS
#define P3_FILL_CHUNKS 3
#endif
  if (!qoff && !did_mlstm) conv_fill(F, a, P3_FILL_CHUNKS);
}
__device__ __forceinline__ void p4_combine(Frame& F, const Args& a) {
  unsigned char* ws = F.ws; const bf16* HF = (const bf16*)(ws + WS_HF); const bf16* HB = (const bf16*)(ws + WS_HB); const bf16* P = (const bf16*)(ws + WS_PROJ); bf16* Y = (bf16*)(ws + WS_Y);
  const float* g = (const float*)a.in[I_GHM];
  const int gw = F.vcu * NWAVES + F.wave, NGW = F.G * NWAVES, c = F.lane * 8;
  float gg[8];
#pragma unroll
  for (int j = 0; j < 8; ++j) gg[j] = g[c + j];
  for (int m0 = gw; m0 < MTOK; m0 += 2 * NGW) {
    v4u wf[2], wb[2], wo[2];
#pragma unroll
    for (int u = 0; u < 2; ++u) { const size_t m = (size_t)(m0 + u * NGW); wf[u] = *(const v4u*)(HF + m * 512 + c); wb[u] = *(const v4u*)(HB + m * 512 + c); wo[u] = *(const v4u*)(P + m * PROJ_LD + 1536 + c); }
#pragma unroll
    for (int u = 0; u < 2; ++u) { const size_t m = (size_t)(m0 + u * NGW);
      float f[8], bb[8], oo[8]; unpack8(wf[u], f); unpack8(wb[u], bb); unpack8(wo[u], oo);
      float s = 0.f;
#pragma unroll
      for (int j = 0; j < 8; ++j) { f[j] += bb[j]; s += f[j] * f[j]; }
      s += __shfl_xor(s, 1); s += __shfl_xor(s, 2); s += __shfl_xor(s, 4); s += __shfl_xor(s, 8);
      const float r = rsqrtf(s * (1.f / 128.f) + 1e-6f);
#pragma unroll
      for (int j = 0; j < 8; ++j) f[j] = f[j] * r * gg[j] * sigmoidf_(oo[j]);
      *(v4u*)(Y + m * 1024 + c) = pack8(f); }
  }
}
struct EpiResid { static constexpr bool TWO_PASS = false; const float* base; float* out; bf16* outb; float* ss; int doq; unsigned char* outq;
  __device__ __forceinline__ void row8(const pg8::Unit& u, int rloc, int cloc, const float (&a0)[8], const float (&a1)[8], int fq) const {
    const int row = u.pm * 256 + rloc; const size_t off = (size_t)row * 1024 + u.pn * 256 + cloc;
    const f32x4 b0 = *(const f32x4*)(base + off), b1 = *(const f32x4*)(base + off + 4), b2 = *(const f32x4*)(base + off + 128), b3 = *(const f32x4*)(base + off + 132);
    float v0[8], v1[8];
#pragma unroll
    for (int i = 0; i < 4; ++i) { v0[i] = a0[i] + b0[i]; v0[4 + i] = a0[4 + i] + b1[i]; v1[i] = a1[i] + b2[i]; v1[4 + i] = a1[4 + i] + b3[i]; }
    *(f32x4*)(out + off) = (f32x4){v0[0], v0[1], v0[2], v0[3]}; *(f32x4*)(out + off + 4) = (f32x4){v0[4], v0[5], v0[6], v0[7]};
    *(f32x4*)(out + off + 128) = (f32x4){v1[0], v1[1], v1[2], v1[3]}; *(f32x4*)(out + off + 132) = (f32x4){v1[4], v1[5], v1[6], v1[7]};
    float s = sumsq8(v0) + sumsq8(v1);
    if (doq) {
#pragma unroll
      for (int i = 0; i < 8; ++i) { v0[i] = q8(v0[i], 1.f); v1[i] = q8(v1[i], 1.f); } }
    *(v4u*)(outb + off) = pack8(v0); *(v4u*)(outb + off + 128) = pack8(v1); s += __shfl_xor(s, 16); s += __shfl_xor(s, 32); if (fq == 0) unsafeAtomicAdd(ss + row, s); } };
struct EpiScale { static constexpr bool TWO_PASS = false; bf16* O; const float* ss;
  __device__ __forceinline__ void row8(const pg8::Unit& u, int rloc, int cloc, const float (&a0)[8], const float (&a1)[8], int fq) const {
    const int row = u.pm * 256 + rloc; const float r = rsqrtf(ss[row] * (1.f / 1024.f) + 1e-6f); float v0[8], v1[8];
#pragma unroll
    for (int i = 0; i < 8; ++i) { v0[i] = a0[i] * r; v1[i] = a1[i] * r; }
    bf16* p = O + (size_t)row * 1024 + u.pn * 256 + cloc; *(v4u*)p = pack8(v0); *(v4u*)(p + 128) = pack8(v1); } };
struct EpiSoftmax { static constexpr bool TWO_PASS = true; bf16* O; float scale; LAS float* xch;
  __device__ __forceinline__ void pass1(const pg8::Unit& u, int rloc, int wc, float (&v0)[8], float (&v1)[8], int fq) const {
    float mx = -3.0e38f;
#pragma unroll
    for (int i = 0; i < 8; ++i) { v0[i] *= scale; v1[i] *= scale; mx = fmaxf(mx, fmaxf(v0[i], v1[i])); }
    mx = fmaxf(mx, __shfl_xor(mx, 16)); mx = fmaxf(mx, __shfl_xor(mx, 32));
    float l = 0.f;
#pragma unroll
    for (int i = 0; i < 8; ++i) { v0[i] = __expf(v0[i] - mx); v1[i] = __expf(v1[i] - mx); l += v0[i] + v1[i]; }
    l += __shfl_xor(l, 16); l += __shfl_xor(l, 32);
    if (fq == 0) { xch[(rloc * 4 + wc) * 2] = mx; xch[(rloc * 4 + wc) * 2 + 1] = l; } }
  __device__ __forceinline__ void row8(const pg8::Unit& u, int rloc, int cloc, const float (&a0)[8], const float (&a1)[8], int fq) const {
    const int wc = cloc >> 5; float m[4], l[4]; float M = -3.0e38f;
#pragma unroll
    for (int w = 0; w < 4; ++w) { m[w] = xch[(rloc * 4 + w) * 2]; l[w] = xch[(rloc * 4 + w) * 2 + 1]; M = fmaxf(M, m[w]); }
    float L = 0.f, mine = 0.f;
#pragma unroll
    for (int w = 0; w < 4; ++w) { const float e = __expf(m[w] - M); L += l[w] * e; if (w == wc) mine = e; }
    const float f = mine / L; float v0[8], v1[8];
#pragma unroll
    for (int i = 0; i < 8; ++i) { v0[i] = a0[i] * f; v1[i] = a1[i] * f; }
    bf16* p = O + (size_t)(u.pm * 256 + rloc) * 1024 + u.pn * 256 + cloc; *(v4u*)p = pack8(v0); *(v4u*)(p + 128) = pack8(v1); } };
struct MemOrder { int G, c, kind;
  __device__ bool next(int i, pg8::Unit& u) const { const int L = i * G + c; if (L >= 256) return false;
    const int bh = L >> 4, t = L & 15, b = bh >> 2, h = bh & 3;
    u.pm = b * 16 + t; u.pn = h; u.g = 0; u.ibase = 0; u.aoff = ((long)(b * SEQ + t * 256)) * 1024 + h * 256;
    u.boff = kind == 0 ? ((long)(b * NMEM)) * 1024 + h * 256 : ((long)(h * 256)) * 1024 + b * NMEM; return true; } };
constexpr size_t WS_WRG = WS_DEC + 65536;
constexpr size_t WS_ROWSEL = WS_SEL, WS_GSEL = WS_SEL + 131072, WS_INV = 31 * MiB, WS_YE = 160 * MiB;
typedef float f32x4m __attribute__((ext_vector_type(4)));
__device__ __forceinline__ void p10_router(Frame& F, const Args& a) {
  unsigned char* ws = F.ws; const float* X2 = (const float*)(ws + WS_X2); const float* ss2 = (const float*)(ws + CTL_SS2); float* AFF = (float*)(ws + WS_AFF); const float* WRG = (const float*)(ws + WS_WRG);
  const int gw = F.vcu * NWAVES + F.wave, NGW = F.G * NWAVES, r = F.lane & 15, kq = F.lane >> 4;
  LAS float* wl = (LAS float*)F.lds;
  for (int i = F.tid; i < 4096; i += NTHR) ((LAS f32x4*)wl)[i] = ((const f32x4*)WRG)[i];
  __syncthreads();
  for (int it = gw; it < MTOK / 16; it += NGW) { const int m0 = it * 16;
    const float* xp = X2 + (size_t)(m0 + r) * 1024 + 4 * kq; const LAS float* wp = wl + (4 * kq) * 16 + r;
    f32x4m acc0 = {0.f, 0.f, 0.f, 0.f}, acc1 = {0.f, 0.f, 0.f, 0.f};
#pragma unroll 1
    for (int hf = 0; hf < 2; ++hf) {
      f32x4 xv[32];
#pragma unroll
      for (int j = 0; j < 32; ++j) xv[j] = *(const f32x4*)(xp + 16 * (32 * hf + j));
#pragma unroll
      for (int j = 0; j < 32; j += 2) { const LAS float* w0 = wp + (16 * (32 * hf + j)) * 16; const LAS float* w1 = w0 + 256;
        acc0 = __builtin_amdgcn_mfma_f32_16x16x4f32(xv[j].x, w0[0], acc0, 0, 0, 0); acc1 = __builtin_amdgcn_mfma_f32_16x16x4f32(xv[j + 1].x, w1[0], acc1, 0, 0, 0);
        acc0 = __builtin_amdgcn_mfma_f32_16x16x4f32(xv[j].y, w0[16], acc0, 0, 0, 0); acc1 = __builtin_amdgcn_mfma_f32_16x16x4f32(xv[j + 1].y, w1[16], acc1, 0, 0, 0);
        acc0 = __builtin_amdgcn_mfma_f32_16x16x4f32(xv[j].z, w0[32], acc0, 0, 0, 0); acc1 = __builtin_amdgcn_mfma_f32_16x16x4f32(xv[j + 1].z, w1[32], acc1, 0, 0, 0);
        acc0 = __builtin_amdgcn_mfma_f32_16x16x4f32(xv[j].w, w0[48], acc0, 0, 0, 0); acc1 = __builtin_amdgcn_mfma_f32_16x16x4f32(xv[j + 1].w, w1[48], acc1, 0, 0, 0); }
    }
#pragma unroll
    for (int i = 0; i < 4; ++i) { const int row = m0 + 4 * kq + i; const float lg = (acc0[i] + acc1[i]) * rsqrtf(ss2[row] * (1.f / 1024.f) + 1e-6f);
      float mx = lg; mx = fmaxf(mx, __shfl_xor(mx, 1)); mx = fmaxf(mx, __shfl_xor(mx, 2)); mx = fmaxf(mx, __shfl_xor(mx, 4)); mx = fmaxf(mx, __shfl_xor(mx, 8));
      const float ex = __expf(lg - mx); float l = ex; l += __shfl_xor(l, 1); l += __shfl_xor(l, 2); l += __shfl_xor(l, 4); l += __shfl_xor(l, 8);
      AFF[(size_t)row * 16 + r] = ex / l; }
  }
  __syncthreads();
}
__device__ __forceinline__ void p11_topk(Frame& F, char* lds) {
  unsigned char* ws = F.ws; const float* AFF = (const float*)(ws + WS_AFF); int* ROWSEL = (int*)(ws + WS_ROWSEL); float* GSEL = (float*)(ws + WS_GSEL); int* INV = (int*)(ws + WS_INV);
  unsigned* hist = (unsigned*)lds; unsigned* ctl = hist + 256; unsigned* wsum = hist + 320;
  const int tid = F.tid, lane = F.lane, wid = F.wave;
  for (int it = (int)blockIdx.x; it < BATCH * NEXP; it += F.G) { const int b = it >> 4, e = it & 15;
    unsigned key[8];
#pragma unroll
    for (int j = 0; j < 8; ++j) key[j] = __float_as_uint(AFF[((size_t)b * SEQ + 8 * tid + j) * 16 + e]);
    unsigned prefix = 0u, mask = 0u, need = CAP;
    for (int shift = 24; shift >= 0; shift -= 8) {
      if (tid < 256) hist[tid] = 0u;
      __syncthreads();
#pragma unroll
      for (int j = 0; j < 8; ++j) if ((key[j] & mask) == prefix) atomicAdd(&hist[(key[j] >> shift) & 255u], 1u);
      __syncthreads();
      if (tid == 0) { unsigned above = 0u; int d = 255; for (; d > 0; --d) { const unsigned c = hist[d]; if (above + c >= need) break; above += c; } ctl[0] = (unsigned)d; ctl[1] = need - above; }
      __syncthreads();
      prefix |= ctl[0] << shift; mask |= 255u << shift; need = ctl[1];
      __syncthreads();
    }
    unsigned ngt = 0u, neq = 0u;
#pragma unroll
    for (int j = 0; j < 8; ++j) { ngt += key[j] > prefix ? 1u : 0u; neq += key[j] == prefix ? 1u : 0u; }
    unsigned sgt = ngt, seq_ = neq;
#pragma unroll
    for (int o = 1; o < 64; o <<= 1) { const unsigned y0 = __shfl_up(sgt, o), y1 = __shfl_up(seq_, o); if (lane >= o) { sgt += y0; seq_ += y1; } }
    if (lane == 63) { wsum[wid] = sgt; wsum[8 + wid] = seq_; }
    __syncthreads();
    unsigned bgt = 0u, beq = 0u, tgt = 0u;
#pragma unroll
    for (int w = 0; w < 8; ++w) { const unsigned g = wsum[w], q = wsum[8 + w]; if (w < wid) { bgt += g; beq += q; } tgt += g; }
    unsigned pgt = bgt + sgt - ngt, peq = beq + seq_ - neq;
#pragma unroll
    for (int j = 0; j < 8; ++j) { const int t = 8 * tid + j; int slot = -1;
      if (key[j] > prefix) slot = (int)pgt++; else if (key[j] == prefix) { if (peq < need) slot = (int)(tgt + peq); ++peq; }
      INV[((size_t)b * SEQ + t) * 16 + e] = slot;
      if (slot >= 0) { ROWSEL[e * 2048 + b * 512 + slot] = b * SEQ + t; GSEL[e * 2048 + b * 512 + slot] = __uint_as_float(key[j]); } }
    __syncthreads();
  }
}
#ifndef GU_ORDER
#define GU_ORDER 1
#endif
#ifndef DN_ORDER
#define DN_ORDER 1
#endif
struct MoeGUOrder { int G, c;
  __device__ bool next(int i, pg8::Unit& u) const { const int L = i * G + c; if (L >= 2048) return false;
#if GU_ORDER == 0
    const int e = L >> 7, r = L & 127, pn = r >> 3, mt = r & 7;
#elif GU_ORDER == 1
    const int e = L >> 7, r = L & 127, mt = r >> 4, pn = r & 15;
#else
    const int x = c & 7, j = c >> 3, e = (i >> 2) * 8 + x, r = (i & 3) * 32 + j, mt = r >> 4, pn = r & 15;
#endif
    u.g = e; u.pm = mt; u.pn = pn; u.ibase = e * 2048 + mt * 256; u.aoff = MOE_FP8 ? ((long)e * 2048 + mt * 256) * 512 : 0; u.boff = ((long)e * 4096 + pn * 256) * (MOE_FP8 ? 512 : 1024); return true; } };
struct MoeDownOrder { int G, c;
  __device__ bool next(int i, pg8::Unit& u) const { const int L = i * G + c; if (L >= 512) return false;
#if DN_ORDER == 0
    const int e = L >> 5, r = L & 31, pn = r >> 3, mt = r & 7;
#else
    const int x = c & 7, j = c >> 3, e = i * 8 + x, pn = j >> 3, mt = j & 7;
#endif
    u.g = e; u.pm = mt; u.pn = pn; u.ibase = e * 2048 + mt * 256; u.aoff = ((long)e * 2048 + mt * 256) * (MOE_FP8_DOWN ? 1024 : 2048); u.boff = ((long)e * 1024 + pn * 256) * (MOE_FP8_DOWN ? 1024 : 2048); return true; } };
struct EpiGU { static constexpr bool TWO_PASS = false; bf16* H; const float* ss2; const int* rowsel;
  __device__ __forceinline__ void row8(const pg8::Unit& u, int rloc, int cloc, const float (&a0)[8], const float (&a1)[8], int fq) const {
    const int tok = rowsel[u.ibase + rloc]; const float r = rsqrtf(ss2[tok] * (1.f / 1024.f) + 1e-6f); float h[8];
#pragma unroll
    for (int i = 0; i < 8; ++i) { const float g = a0[i] * r, up = a1[i] * r; h[i] = g * sigmoidf_(g) * up; if (FP8EMU) h[i] = q8(h[i], 8.f); }
#if MOE_FP8_DOWN
    *(v2u*)((unsigned char*)H + ((size_t)u.g * 2048 + u.pm * 256 + rloc) * 2048 + u.pn * 128 + cloc) = pack8_fp8(h, 8.f); } };
#else
    *(v4u*)(H + ((size_t)u.g * 2048 + u.pm * 256 + rloc) * 2048 + u.pn * 128 + cloc) = pack8(h); } };
#endif
struct EpiGU8 { static constexpr bool TWO_PASS = false; unsigned char* H8; const float* ss2; const int* rowsel;
  __device__ __forceinline__ void row8(const pg8::Unit& u, int rloc, int cloc, const float (&a0)[8], const float (&a1)[8], int fq) const {
    float h[8];
#pragma unroll
    for (int i = 0; i < 8; ++i) { const float g = a0[i], up = a1[i]; h[i] = g * sigmoidf_(g) * up; }
#if MOE_FP8_DOWN
    *(v2u*)(H8 + ((size_t)u.g * 2048 + u.pm * 256 + rloc) * 2048 + u.pn * 128 + cloc) = pack8_fp8(h, 8.f); } };
#else
    *(v4u*)((bf16*)H8 + ((size_t)u.g * 2048 + u.pm * 256 + rloc) * 2048 + u.pn * 128 + cloc) = pack8(h); } };
#endif
struct EpiYE { static constexpr bool TWO_PASS = false; bf16* Yp; const float* gsel;
  __device__ __forceinline__ void row8(const pg8::Unit& u, int rloc, int cloc, const float (&a0)[8], const float (&a1)[8], int fq) const {
    const float gv = gsel[u.ibase + rloc]; float v0[8], v1[8];
#pragma unroll
    for (int i = 0; i < 8; ++i) { v0[i] = a0[i] * gv; v1[i] = a1[i] * gv; }
    bf16* p = Yp + ((size_t)u.g * 2048 + u.pm * 256 + rloc) * 1024 + u.pn * 256 + cloc; *(v4u*)p = pack8(v0); *(v4u*)(p + 128) = pack8(v1); } };
__device__ __forceinline__ void p14_final(Frame& F, const Args& a) {
  unsigned char* ws = F.ws; const float* X2 = (const float*)(ws + WS_X2); const int* INV = (const int*)(ws + WS_INV); const bf16* YE = (const bf16*)(ws + WS_YE);
  const float* gfin = (const float*)a.in[I_GFIN]; float* out = a.out;
  const int gw = F.vcu * NWAVES + F.wave, NGW = F.G * NWAVES;
  f32x4 g[4];
#pragma unroll
  for (int j = 0; j < 4; ++j) g[j] = *(const f32x4*)(gfin + 256 * j + 4 * F.lane);
  for (int m0 = gw; m0 < MTOK; m0 += 2 * NGW) {
    f32x4 v[2][4]; int inv[2];
#pragma unroll
    for (int u = 0; u < 2; ++u) { const int m = m0 + u * NGW;
#pragma unroll
      for (int j = 0; j < 4; ++j) v[u][j] = *(const f32x4*)(X2 + (size_t)m * 1024 + 256 * j + 4 * F.lane);
      inv[u] = F.lane < 16 ? INV[(size_t)m * 16 + F.lane] : -1; }
#pragma unroll
    for (int u = 0; u < 2; ++u) { const int m = m0 + u * NGW, b = m >> 12;
      unsigned long long sel = __ballot(inv[u] >= 0);
      while (sel) { const int e = __builtin_ctzll(sel); sel &= sel - 1; const int slot = __shfl(inv[u], e);
        const bf16* yr = YE + ((size_t)e * 2048 + b * 512 + slot) * 1024 + 4 * F.lane;
#pragma unroll
        for (int j = 0; j < 4; ++j) { const v2u w = *(const v2u*)(yr + 256 * j); v[u][j].x += bflo(w.x); v[u][j].y += bfhi(w.x); v[u][j].z += bflo(w.y); v[u][j].w += bfhi(w.y); } }
      float s = 0.f;
#pragma unroll
      for (int j = 0; j < 4; ++j) s += (v[u][j].x * v[u][j].x + v[u][j].y * v[u][j].y) + (v[u][j].z * v[u][j].z + v[u][j].w * v[u][j].w);
      const float r = rsqrtf(wave_sum(s) * (1.f / 1024.f) + 1e-6f);
#pragma unroll
      for (int j = 0; j < 4; ++j) *(f32x4*)(out + (size_t)m * 1024 + 256 * j + 4 * F.lane) = v[u][j] * r * g[j]; }
  }
}
__global__ void __launch_bounds__(NTHR, 2) mk(Args a) {
  extern __shared__ __attribute__((aligned(16))) unsigned char lds_raw[];
  Frame F;
  F.lds = (LAS unsigned char*)lds_raw; F.MISC = (volatile LAS unsigned*)(F.lds + LDSCTL_OFF + 320);
  F.tid = threadIdx.x; F.lane = F.tid & 63; F.wave = __builtin_amdgcn_readfirstlane(F.tid >> 6);
  F.G = gridDim.x; { const int bx = blockIdx.x; F.vcu = (F.G % 8 == 0) ? (bx % 8) * (F.G / 8) + bx / 8 : bx; }
  F.ws = a.ws; F.ctl = (gu32*)(a.ws + WS_CTL);
  unsigned char* ws = a.ws;
  for (int u = F.tid; u < (LDS_BYTES - LDSCTL_OFF) / 4; u += NTHR) ((LAS unsigned*)(F.lds + LDSCTL_OFF))[u] = 0u;
  __syncthreads();
  XcdBarrier bar = xcd_barrier_post((unsigned*)(F.ctl + CW_BAR), F.MISC + 8);
  const int lo = a.ph_lo, hi = a.ph_hi;
#define IN(k) (lo <= (k) && (k) < hi)
#define BOTH(k) (IN(k) && IN((k) + 1))
#define GRID_BAR() xcd_barrier(bar)
  float* ssq = (float*)(ws + CTL_SSQ); float* sskv = (float*)(ws + CTL_SSKV);

#ifndef REP_MASK
#define REP_MASK 0
#endif
#define NREP(k) ((((REP_MASK) >> (k)) & 1) ? 2 : 1)
#define PH_BEGIN(k) if (IN(k)) { for (int rep_ = 0; rep_ < NREP(k); ++rep_) { const bool dry = rep_ + 1 < NREP(k); (void)dry;
#define PH_END(k) if (dry) GRID_BAR(); } if (BOTH(k)) GRID_BAR(); }
  float* dummy = (float*)(ws + WS_DUMMY);
  float* ss1 = (float*)(ws + CTL_SS1); float* ss2 = (float*)(ws + CTL_SS2);
#ifndef FILLMODE
#define FILLMODE 2
#endif
  PH_BEGIN(0) p0_prologue(F, a, true, FILLMODE == 0); PH_END(0)
  PH_BEGIN(1)
    { pg8::Gemm g{(const bf16*)(ws + WS_XN), (const bf16*)(ws + WS_WIN), 1024, 1024, 1024, nullptr, 127, 127}; pg8::StaticOrder S; S.init(MTOK, PROJ_LD, F.G, (int)blockIdx.x, 1024, 1024);
      EpiProj E{(bf16*)(ws + WS_PROJ), dry ? dummy : ssq, dry ? dummy + 16384 : sskv};
      pg8::gemm_phase<EpiProj, pg8::StaticOrder, false>(F.lds, g, S, E); }
    { pg8::Gemm g{(const bf16*)(ws + WS_MEMN), (const bf16*)(ws + WS_WMK), 1024, 1024, 1024, nullptr, 127, 127}; pg8::StaticOrder S; S.init(1024, 1024, F.G, (int)((blockIdx.x + 128u) % (unsigned)F.G), 1024, 1024);
      EpiStore E{(bf16*)(ws + WS_KMEM), 1024};
      pg8::gemm_phase<EpiStore, pg8::StaticOrder, false>(F.lds, g, S, E); }
    { pg8::Gemm g{(const bf16*)(ws + WS_WMV), (const bf16*)(ws + WS_MEMN), 1024, 1024, 1024, nullptr, 127, 127}; pg8::StaticOrder S; S.init(1024, 1024, F.G, (int)((blockIdx.x + 112u) % (unsigned)F.G), 1024, 1024);
      EpiStore E{(bf16*)(ws + WS_VMEMT), 1024};
      pg8::gemm_phase<EpiStore, pg8::StaticOrder, false>(F.lds, g, S, E); }
  PH_END(1)
  PH_BEGIN(2)
    { pg8::Gemm g{(const bf16*)(ws + WS_PROJ) + PC_CQ, (const bf16*)(ws + WS_WQB), PROJ_LD, 256, 256, nullptr, 127, 127}; pg8::StaticOrder S; S.init(MTOK, 768, F.G, (int)blockIdx.x, PROJ_LD, 256);
      EpiQ E{(bf16*)(ws + WS_QM), ssq, (const float*)(ws + WS_ROPE)};
      pg8::gemm_phase<EpiQ, pg8::StaticOrder, false>(F.lds, g, S, E); }
    { pg8::Gemm g{(const bf16*)(ws + WS_PROJ) + PC_CKV, (const bf16*)(ws + WS_WKVB), PROJ_LD, 256, 256, nullptr, 127, 127}; pg8::StaticOrder S; S.init(MTOK, 1024, F.G, (int)((blockIdx.x + 64u) % (unsigned)F.G), PROJ_LD, 256);
      EpiKV E{(bf16*)(ws + WS_KM), (bf16*)(ws + WS_VM), sskv};
      pg8::gemm_phase<EpiKV, pg8::StaticOrder, false>(F.lds, g, S, E); }
    p2_elementwise(F, a);
  PH_END(2)
  PH_BEGIN(3) p3_mixers(F, a, (char*)lds_raw, bar.x, dry ? 64 * 16 : 0); PH_END(3)
  PH_BEGIN(4) p4_combine(F, a); PH_END(4)
  PH_BEGIN(5)
    pg8::Gemm g{(const bf16*)(ws + WS_Y), (const bf16*)(ws + WS_WOUT), 1024, 1024, 1024, nullptr, 127, 127}; pg8::StaticOrder S; S.init(MTOK, 1024, F.G, (int)blockIdx.x, 1024, 1024);
    EpiResid E{(const float*)a.in[I_X], (float*)(ws + WS_X1), (bf16*)(ws + WS_X1B), dry ? dummy : ss1, 0, nullptr};
    pg8::gemm_phase<EpiResid, pg8::StaticOrder, false>(F.lds, g, S, E);
  PH_END(5)
  PH_BEGIN(6)
    pg8::Gemm g{(const bf16*)(ws + WS_X1B), (const bf16*)(ws + WS_WMQ), 1024, 1024, 1024, nullptr, 127, 127}; pg8::StaticOrder S; S.init(MTOK, 1024, F.G, (int)blockIdx.x, 1024, 1024);
    EpiScale E{(bf16*)(ws + WS_QMEM), ss1};
    pg8::gemm_phase<EpiScale, pg8::StaticOrder, false>(F.lds, g, S, E);
  PH_END(6)
  PH_BEGIN(7)
    pg8::Gemm g{(const bf16*)(ws + WS_QMEM), (const bf16*)(ws + WS_KMEM), 1024, 1024, 256, nullptr, 127, 127}; MemOrder S{F.G, (int)blockIdx.x, 0};
    EpiSoftmax E{(bf16*)(ws + WS_P), 0.0625f, (LAS float*)(F.lds + LDSCTL_OFF + 1024)};
    pg8::gemm_phase<EpiSoftmax, MemOrder, false>(F.lds, g, S, E);
  PH_END(7)
  PH_BEGIN(8)
    pg8::Gemm g{(const bf16*)(ws + WS_P), (const bf16*)(ws + WS_VMEMT), 1024, 1024, 256, nullptr, 127, 127}; MemOrder S{F.G, (int)blockIdx.x, 1};
    EpiStore E{(bf16*)(ws + WS_MO), 1024};
    pg8::gemm_phase<EpiStore, MemOrder, false>(F.lds, g, S, E);
  PH_END(8)
  PH_BEGIN(9)
    pg8::Gemm g{(const bf16*)(ws + WS_MO), (const bf16*)(ws + WS_WMO), 1024, 1024, 1024, nullptr, 127, 127}; pg8::StaticOrder S; S.init(MTOK, 1024, F.G, (int)blockIdx.x, 1024, 1024);
    EpiResid E{(const float*)(ws + WS_X1), (float*)(ws + WS_X2), (bf16*)(ws + WS_X2B), dry ? dummy : ss2, FP8EMU, nullptr};
    pg8::gemm_phase<EpiResid, pg8::StaticOrder, false>(F.lds, g, S, E);
  PH_END(9)
  PH_BEGIN(10) p10_router(F, a); PH_END(10)
  PH_BEGIN(11) p11_topk(F, (char*)lds_raw);
    if (!dry && FILLMODE != 0) conv_fill(F, a, 1 << 30);
  PH_END(11)
  PH_BEGIN(12)
#if MOE_FP8
    {
      const int gw = F.vcu * NWAVES + F.wave, NGW = F.G * NWAVES; const int* rs = (const int*)(ws + WS_ROWSEL);
      for (int r0 = gw; r0 < NEXP * 2048; r0 += 4 * NGW) {
        int tok[4]; float rn[4]; f32x4 q[4][4];
#pragma unroll
        for (int u = 0; u < 4; ++u) { const int r = r0 + u * NGW; tok[u] = r < NEXP * 2048 ? rs[r] : 0; }
#pragma unroll
        for (int u = 0; u < 4; ++u) { const float* xr = (const float*)(ws + WS_X2) + (size_t)tok[u] * 1024 + F.lane * 16; rn[u] = ss2[tok[u]];
#pragma unroll
          for (int j = 0; j < 4; ++j) q[u][j] = *(const f32x4*)(xr + 4 * j); }
#pragma unroll
        for (int u = 0; u < 4; ++u) { const int r = r0 + u * NGW; const float s = rsqrtf(rn[u] * (1.f / 1024.f) + 1e-6f);
          const f32x4 a0 = q[u][0] * s, a1 = q[u][1] * s, a2 = q[u][2] * s, a3 = q[u][3] * s;
          const float lo[8] = {a0.x, a0.y, a0.z, a0.w, a1.x, a1.y, a1.z, a1.w}, hi[8] = {a2.x, a2.y, a2.z, a2.w, a3.x, a3.y, a3.z, a3.w};
          const v2u a8 = pack8_fp8(lo, 1.f), b8 = pack8_fp8(hi, 1.f); v4u o; o.x = a8.x; o.y = a8.y; o.z = b8.x; o.w = b8.y;
          if (r < NEXP * 2048) *(v4u*)(ws + WS_XG + (size_t)r * 1024 + F.lane * 16) = o; } }
      GRID_BAR(); }
    pg8::Gemm g{(const bf16*)(ws + WS_XG), (const bf16*)(ws + WS_WEGU8), 512, 512, 512, nullptr, 127, 121}; MoeGUOrder S{F.G, (int)blockIdx.x};
    EpiGU8 E{(unsigned char*)(ws + WS_HID8), ss2, (const int*)(ws + WS_ROWSEL)};
    pg8::gemm_phase<EpiGU8, MoeGUOrder, false, 1>(F.lds, g, S, E);
#else
    pg8::Gemm g{(const bf16*)(ws + WS_X2B), (const bf16*)(ws + WS_WEGU), 1024, 1024, 1024, (const int*)(ws + WS_ROWSEL), 127, 127}; MoeGUOrder S{F.G, (int)blockIdx.x};
    EpiGU E{(bf16*)(ws + WS_HID), ss2, (const int*)(ws + WS_ROWSEL)};
    pg8::gemm_phase<EpiGU, MoeGUOrder, true>(F.lds, g, S, E);
#endif
  PH_END(12)
  PH_BEGIN(13)
#if MOE_FP8_DOWN
    pg8::Gemm g{(const bf16*)(ws + WS_HID8), (const bf16*)(ws + WS_WED8), 1024, 1024, 1024, nullptr, 124, 121}; MoeDownOrder S{F.G, (int)blockIdx.x};
    EpiYE E{(bf16*)(ws + WS_YE), (const float*)(ws + WS_GSEL)};
    pg8::gemm_phase<EpiYE, MoeDownOrder, false, 1>(F.lds, g, S, E);
#else
    pg8::Gemm g{(const bf16*)(ws + WS_HID), (const bf16*)(ws + WS_WED), 2048, 2048, 2048, nullptr, 127, 127}; MoeDownOrder S{F.G, (int)blockIdx.x};
    EpiYE E{(bf16*)(ws + WS_YE), (const float*)(ws + WS_GSEL)};
    pg8::gemm_phase<EpiYE, MoeDownOrder, false>(F.lds, g, S, E);
#endif
  PH_END(13)
  PH_BEGIN(14) p14_final(F, a); PH_END(14)
#undef IN
#undef BOTH
#undef GRID_BAR
}

__global__ __launch_bounds__(256) void adapt_b2f(const bf16* src, long lds_, long scol, float* dst, long ldd, long dcol, long rows, long ncols) {
  const long i = blockIdx.x * 256L + threadIdx.x; if (i >= rows * ncols) return;
  const long r = i / ncols, c = i % ncols; dst[r * ldd + dcol + c] = bf2f(src[r * lds_ + scol + c]);
}
static void adapt(hipStream_t s, const void* src, long lds_, long scol, float* dst, long ldd, long dcol, long rows, long ncols) {
  hipLaunchKernelGGL(adapt_b2f, dim3((unsigned)((rows * ncols + 255) / 256)), dim3(256), 0, s, (const bf16*)src, lds_, scol, dst, ldd, dcol, rows, ncols);
}

static int mk_grid() {
  static int grid = 0;
  if (grid == 0) {
    int dev = 0, cus = 0, per_cu = 0;
    (void)hipGetDevice(&dev); (void)hipDeviceGetAttribute(&cus, hipDeviceAttributeMultiprocessorCount, dev);
    (void)hipFuncSetAttribute((const void*)mk, hipFuncAttributeMaxDynamicSharedMemorySize, LDS_BYTES);
    (void)hipOccupancyMaxActiveBlocksPerMultiprocessor(&per_cu, (const void*)mk, NTHR, LDS_BYTES);
    (void)hipGetLastError();
    grid = cus > 0 ? cus : 256;
  }
  return grid;
}
static void mk_launch(hipStream_t s, void* const* d_in, void* d_out, void* d_ws, int lo, int hi, int flags) {
  Args a; memset(&a, 0, sizeof(a));
  for (int i = 0; i < 26; ++i) a.in[i] = d_in[i];
  a.out = (float*)d_out; a.ws = (unsigned char*)d_ws; a.ph_lo = lo; a.ph_hi = hi; a.flags = flags; a.pad = 0;
  (void)hipMemsetAsync((char*)d_ws + WS_CTL + CW_BAR * 4, 0, XCD_BAR_WORDS * 4, s);
  hipLaunchKernelGGL(mk, dim3(mk_grid()), dim3(NTHR), LDS_BYTES, s, a);
}

extern "C" void kernel_launch(void* const* d_in, const int* in_sizes, int n_in, void* d_out, int out_size, void* d_ws, size_t ws_size, hipStream_t s) {
  (void)hipMemsetAsync((char*)d_ws + WS_CTL, 0, CTL_ZERO_BYTES, s);
  mk_launch(s, d_in, d_out, d_ws, 0, 15, 1);
}
```

```cpp
#include <hip/hip_runtime.h>
#include <cstdint>
#include <cstdio>
#include <cstring>

constexpr int BATCH = 4, SEQ = 4096, DM = 1024, MTOK = BATCH * SEQ;
constexpr int D_IN = 2480;
constexpr int OFF_QM = 0, OFF_KM = 512, OFF_VM = 1024, OFF_OM = 1536, OFF_G = 2048, OFF_CQ = 2064, OFF_CKV = 2320, OFF_KR = 2448;
constexpr int NEXP = 16, CAP = 512, DFF = 2048, NMEM = 256;
constexpr size_t MiB = 1u << 20;
enum { I_X = 0, I_MEM, I_POS, I_GMIX, I_WIN, I_BG, I_CONV, I_GQA, I_WQB, I_GKVA, I_WKVB, I_GHM, I_GHA, I_WOUT, I_GMX, I_GMKV, I_WMQ, I_WMK, I_WMV, I_WMO, I_GFFN, I_WR, I_WEG, I_WEU, I_WED, I_GFIN };
#define GAS __attribute__((address_space(1)))
#define LAS __attribute__((address_space(3)))
typedef unsigned short bf16;
typedef unsigned v4u __attribute__((ext_vector_type(4)));
typedef unsigned v2u __attribute__((ext_vector_type(2)));
typedef float f32x4 __attribute__((ext_vector_type(4)));
typedef float f32x16 __attribute__((ext_vector_type(16)));
typedef short bf16x8 __attribute__((ext_vector_type(8)));
typedef short s16x4 __attribute__((ext_vector_type(4)));
typedef GAS unsigned gu32;
#define RLX_AGENT __ATOMIC_RELAXED, __HIP_MEMORY_SCOPE_AGENT
#define LDS_WAIT() asm volatile("s_waitcnt lgkmcnt(0)" ::: "memory")
#define VM_WAIT() asm volatile("s_waitcnt vmcnt(0)" ::: "memory")
constexpr int NWAVES = 8, NTHR = 512;
__device__ __forceinline__ unsigned f2bf(float f) { unsigned u = __builtin_bit_cast(unsigned, f); return (u + 0x7fffu + ((u >> 16) & 1u)) >> 16; }
__device__ __forceinline__ unsigned pk2(float lo, float hi) { return f2bf(lo) | (f2bf(hi) << 16); }
__device__ __forceinline__ float bf2f(unsigned short h) { return __builtin_bit_cast(float, (unsigned)h << 16); }
__device__ __forceinline__ float bflo(unsigned w) { return __builtin_bit_cast(float, w << 16); }
__device__ __forceinline__ float bfhi(unsigned w) { return __builtin_bit_cast(float, w & 0xffff0000u); }
typedef float f32x2_t __attribute__((ext_vector_type(2))); typedef __bf16 bf16x2_t __attribute__((ext_vector_type(2)));
__device__ __forceinline__ unsigned cvt_pk_bf16(float lo, float hi) { f32x2_t v = {lo, hi}; bf16x2_t b = __builtin_convertvector(v, bf16x2_t); return __builtin_bit_cast(unsigned, b); }
__device__ __forceinline__ v2u pack8_fp8(const float (&v)[8], float sc) { float c[8];
#pragma unroll
  for (int i = 0; i < 8; ++i) c[i] = __builtin_amdgcn_fmed3f(v[i] * sc, -448.f, 448.f);
  int a = 0, b = 0; a = __builtin_amdgcn_cvt_pk_fp8_f32(c[0], c[1], a, false); a = __builtin_amdgcn_cvt_pk_fp8_f32(c[2], c[3], a, true);
  b = __builtin_amdgcn_cvt_pk_fp8_f32(c[4], c[5], b, false); b = __builtin_amdgcn_cvt_pk_fp8_f32(c[6], c[7], b, true); v2u r; r.x = (unsigned)a; r.y = (unsigned)b; return r; }
__device__ __forceinline__ float q8(float x, float sc) { const int p = __builtin_amdgcn_cvt_pk_fp8_f32(x * sc, 0.f, 0, false); return __builtin_amdgcn_cvt_f32_fp8(p, 0) * (1.f / sc); }
__device__ __forceinline__ float wave_sum(float v) {
#pragma unroll
  for (int o = 1; o < 64; o <<= 1) v += __shfl_xor(v, o);
  return v;
}
__device__ __forceinline__ float sigmoidf_(float x) { return 1.f / (1.f + __expf(-x)); }

#define XB_TMO      128
#define XB_XCNT(j)  (256  + 64 * (j))
#define XB_XSUB(j)  (1280 + 64 * (j))
#define XB_XGEN(j)  (2304 + 64 * (j))
#define XB_TOP      3328
#define XB_TOPGEN   3392
#define XCD_BAR_WORDS 3456
#define XB_SPIN_CAP (1u << 22)
__device__ __forceinline__ unsigned xb_ld(unsigned* p)              { return __hip_atomic_load(p, __ATOMIC_RELAXED, __HIP_MEMORY_SCOPE_AGENT); }
__device__ __forceinline__ unsigned xb_add(unsigned* p, unsigned v) { return __hip_atomic_fetch_add(p, v, __ATOMIC_RELAXED, __HIP_MEMORY_SCOPE_AGENT); }
__device__ __forceinline__ unsigned xb_xcc_id() { return (unsigned)__builtin_amdgcn_s_getreg((3 << 11) | 20) & 0xFu; }
#define XB_SPIN(cond, bar) do { unsigned _sp = 0; while (cond) { __builtin_amdgcn_s_sleep(1); \
    if ((++_sp & 255u) == 0u) { if (xb_ld(&(bar)[XB_TMO])) break; if (_sp > XB_SPIN_CAP) { atomicAdd(&(bar)[XB_TMO], 1u); break; } } } } while (0)
struct XcdBarrier { unsigned* bar; unsigned x; volatile LAS unsigned* st; };
__device__ __forceinline__ XcdBarrier xcd_barrier_post(unsigned* bar, volatile LAS unsigned* st) {
  XcdBarrier b; b.bar = bar; b.x = xb_xcc_id(); b.st = st;
  if (threadIdx.x == 0) (void)xb_add(&bar[XB_XCNT(b.x)], 1u);
  return b;
}
__device__ __forceinline__ void xcd_barrier_complete(unsigned* bar, unsigned x, unsigned& nloc, unsigned& nx) {
  const unsigned G = gridDim.x * gridDim.y * gridDim.z;
  unsigned sum, cnt, mine, sp = 0u;
  for (;;) {
    sum = 0u; cnt = 0u; mine = 0u;
#pragma unroll
    for (unsigned j = 0; j < 16; ++j) { const unsigned c = xb_ld(&bar[XB_XCNT(j)]); sum += c; cnt += (c > 0u) ? 1u : 0u; mine = (j == x) ? c : mine; }
    if (sum == G) break;
    __builtin_amdgcn_s_sleep(1);
    if ((++sp & 255u) == 0u) { if (xb_ld(&bar[XB_TMO])) break; if (sp > XB_SPIN_CAP) { atomicAdd(&bar[XB_TMO], 1u); break; } }
  }
  nloc = mine > 0u ? mine : 1u; nx = cnt > 0u ? cnt : 1u;
}
__device__ __forceinline__ void xcd_barrier(const XcdBarrier& b) {
  asm volatile("s_waitcnt vmcnt(0)" ::: "memory");
  __syncthreads();
  if (threadIdx.x == 0) {
    unsigned* bar = b.bar;
    __builtin_amdgcn_s_waitcnt(0);
    unsigned nloc = b.st[0], nx = b.st[1];
    if (nloc == 0u) { xcd_barrier_complete(bar, b.x, nloc, nx); b.st[0] = nloc; b.st[1] = nx; }
    const unsigned old = xb_add(&bar[XB_XSUB(b.x)], 1u);
    const unsigned gen = old / nloc;
    if (old + 1u == (gen + 1u) * nloc) {
      __builtin_amdgcn_fence(__ATOMIC_RELEASE, "agent");
      asm volatile("s_waitcnt vmcnt(0)" ::: "memory");
      const unsigned og = xb_add(&bar[XB_TOP], 1u);
      const unsigned tg = og / nx;
      if (og + 1u == (tg + 1u) * nx) xb_add(&bar[XB_TOPGEN], 1u);
      else XB_SPIN(xb_ld(&bar[XB_TOPGEN]) == tg, bar);
      __builtin_amdgcn_fence(__ATOMIC_ACQUIRE, "agent");
      xb_add(&bar[XB_XGEN(b.x)], 1u);
      asm volatile("s_waitcnt vmcnt(0)" ::: "memory");
    } else {
      XB_SPIN(xb_ld(&bar[XB_XGEN(b.x)]) == gen, bar);
      __builtin_amdgcn_fence(__ATOMIC_ACQUIRE, "agent");
      asm volatile("s_waitcnt vmcnt(0)" ::: "memory");
    }
  }
  __syncthreads();
}

namespace pg8 {
constexpr int BM = 256, BK = 64, HALF = 128, HTB = HALF * BK * 2, STAGE_BYTES = 8 * HTB, NXCD = 8, WGM = 8;
__host__ __device__ __forceinline__ int lds_byte(int r, int c) { const int st = (r >> 4) * 2 + (c >> 5), rr = r & 15, cc = c & 31, ob = rr * 64 + cc * 2; return st * 1024 + (ob ^ (((ob >> 9) & 1) << 5)); }
__host__ __device__ __forceinline__ void stage_rc(int b, int& R, int& C) { const int st = b / 1024, sb = b % 1024, swz = sb ^ (((sb >> 9) & 1) << 5); R = (st >> 1) * 16 + swz / 64; C = (st & 1) * 32 + (swz % 64) / 2; }
__host__ __device__ __forceinline__ int perm32(int rho) { const int n = rho >> 4, i = rho & 15; return 8 * (i >> 2) + 4 * n + (i & 3); }

struct Unit { long aoff, boff; int pm, pn, g, ibase; };
struct Gemm { const bf16* A; const bf16* Bt; int lda, ldb, K; const int* gidx; int sa, sb; };
typedef int v8i_t __attribute__((ext_vector_type(8))); typedef int v4i_t __attribute__((ext_vector_type(4)));
__device__ __forceinline__ v8i_t cat8(bf16x8 lo, bf16x8 hi) { const v4i_t a = __builtin_bit_cast(v4i_t, lo), b = __builtin_bit_cast(v4i_t, hi); return __builtin_shufflevector(a, b, 0, 1, 2, 3, 4, 5, 6, 7); }

struct StaticOrder {
  int nM, nN, nwg, G, c, lda, ldb;
  __device__ void init(int M, int N, int G_, int c_, int lda_, int ldb_) { nM = M / BM; nN = N / BM; nwg = nM * nN; G = G_; c = c_; lda = lda_; ldb = ldb_; }
  __device__ bool next(int i, Unit& u) const {
    const long L = (long)i * G + c; if (L >= nwg) return false;
    int wgid = (int)L; { const int q = nwg / NXCD, r = nwg % NXCD, xcd = wgid % NXCD, off = wgid / NXCD; wgid = (xcd < r ? xcd * (q + 1) : r * (q + 1) + (xcd - r) * q) + off; }
    const int nig = WGM * nN, gid = wgid / nig, fm = gid * WGM, gsz = (nM - fm) < WGM ? (nM - fm) : WGM;
    u.pm = fm + ((wgid % nig) % gsz); u.pn = (wgid % nig) / gsz; u.g = 0; u.ibase = 0;
    u.aoff = (long)u.pm * BM * lda; u.boff = (long)u.pn * BM * ldb; return true;
  }
};

template <class Epi, class Sched, bool GATHER, int FP8 = 0>
__device__ __forceinline__ void gemm_phase(LAS unsigned char* lds, const Gemm g, const Sched& S, const Epi& E) {
  int tid = threadIdx.x; asm volatile("" : "+v"(tid));
  const int wid = __builtin_amdgcn_readfirstlane(tid >> 6), lane = tid & 63, wr = wid >> 2, wc = wid & 3, fr = lane & 15, fq = lane >> 4;
  const int K = g.K, nt = K / BK;
  int Rs[2], Cs[2]; unsigned voffB[2];
#pragma unroll
  for (int i = 0; i < 2; ++i) { int R, C; stage_rc(tid * 16 + i * 8192, R, C); Rs[i] = R; Cs[i] = C; const int Rb = (R & ~31) + perm32(R & 31); voffB[i] = (unsigned)(Rb * g.ldb + C) * 2u; }
  const size_t kstep = (size_t)(BK * 2);
  const size_t hstepB = (size_t)HALF * g.ldb * 2;
  const unsigned ldsw = (unsigned)wid * 1024u;
  const int aoff_l = lds_byte(wr * 64 + fr, FP8 ? fq * 16 : fq * 8), boff_l = lds_byte(wc * 32 + fr, FP8 ? fq * 16 : fq * 8);
  constexpr int aoff_k = FP8 ? 16 : 1024, boff_k = FP8 ? 16 : 1024;
#define PG8_SA(b, h) (((b) * 2 + (h)) * HTB)
#define PG8_SB(b, h) ((4 + (b) * 2 + (h)) * HTB)
#define PG8_STAGE(bufoff, gbase, voff) do { _Pragma("unroll") for (int _i = 0; _i < 2; ++_i) \
        __builtin_amdgcn_global_load_lds((const unsigned*)((const char*)(gbase) + (voff)[_i]), (LAS unsigned*)(lds + (bufoff) + ldsw + _i * 8192), 16, 0, 0); } while (0)
#define PG8_LDA(dst, b, h) do { _Pragma("unroll") for (int m = 0; m < 4; ++m) { if constexpr (FP8) { const v4i_t lo_ = *(const LAS v4i_t*)(lds + PG8_SA(b, h) + aoff_l + m * 2048), hi_ = *(const LAS v4i_t*)(lds + PG8_SA(b, h) + aoff_l + m * 2048 + aoff_k); dst##8[m] = __builtin_shufflevector(lo_, hi_, 0, 1, 2, 3, 4, 5, 6, 7); } \
        else { _Pragma("unroll") for (int k = 0; k < 2; ++k) dst[m][k] = *(const LAS bf16x8*)(lds + PG8_SA(b, h) + aoff_l + m * 2048 + k * aoff_k); } } } while (0)
#define PG8_LDB(dst, b, h) do { _Pragma("unroll") for (int n = 0; n < 2; ++n) { if constexpr (FP8) { const v4i_t lo_ = *(const LAS v4i_t*)(lds + PG8_SB(b, h) + boff_l + n * 2048), hi_ = *(const LAS v4i_t*)(lds + PG8_SB(b, h) + boff_l + n * 2048 + boff_k); dst##8[n] = __builtin_shufflevector(lo_, hi_, 0, 1, 2, 3, 4, 5, 6, 7); } \
        else { _Pragma("unroll") for (int k = 0; k < 2; ++k) dst[n][k] = *(const LAS bf16x8*)(lds + PG8_SB(b, h) + boff_l + n * 2048 + k * boff_k); } } } while (0)
#define PG8_MMA(ai, bj, At, Bt) do { __builtin_amdgcn_s_setprio(1); _Pragma("unroll") for (int m = 0; m < 4; ++m) _Pragma("unroll") for (int n = 0; n < 2; ++n) { \
        if constexpr (FP8) asm volatile("v_mfma_scale_f32_16x16x128_f8f6f4 %0, %1, %2, %0, %3, %4 op_sel_hi:[0,0,0]" : "+v"(acc[ai][bj][m][n]) : "v"(Bt##8[n]), "v"(At##8[m]), "v"(vsb), "v"(vsa)); \
        else { _Pragma("unroll") for (int k = 0; k < 2; ++k) acc[ai][bj][m][n] = __builtin_amdgcn_mfma_f32_16x16x32_bf16(Bt[n][k], At[m][k], acc[ai][bj][m][n], 0, 0, 0); } } \
        __builtin_amdgcn_s_setprio(0); } while (0)
#define PG8_WAIT_V(n) asm volatile("s_waitcnt vmcnt(" #n ")" ::: "memory")
#define PG8_WAIT_L(n) asm volatile("s_waitcnt lgkmcnt(" #n ")" ::: "memory")
#define PG8_BAR __builtin_amdgcn_s_barrier()
#define PG8_SCHED __builtin_amdgcn_sched_barrier(0)
  Unit cur, nxt; int ui = 0;
  if (!S.next(0, cur)) return;
  unsigned vA[2][2], nvA[2][2];
  auto load_va = [&](const Unit& u, unsigned (&v)[2][2]) {
#pragma unroll
    for (int h = 0; h < 2; ++h)
#pragma unroll
      for (int i = 0; i < 2; ++i) {
        if constexpr (GATHER) v[h][i] = (unsigned)((long)g.gidx[u.ibase + h * HALF + Rs[i]] * g.lda + Cs[i]) * 2u;
        else v[h][i] = (unsigned)((h * HALF + Rs[i]) * g.lda + Cs[i]) * 2u;
      }
  };
  load_va(cur, vA);
  f32x4 acc[2][2][4][2];
#pragma unroll
  for (int a = 0; a < 2; ++a)
#pragma unroll
    for (int b = 0; b < 2; ++b)
#pragma unroll
      for (int m = 0; m < 4; ++m)
#pragma unroll
        for (int n = 0; n < 2; ++n) acc[a][b][m][n] = (f32x4){0.f, 0.f, 0.f, 0.f};
  int vsa = g.sa, vsb = g.sb; (void)vsa; (void)vsb;
  bf16x8 At[4][2], B0[2][2], B1[2][2]; v8i_t At8[4], B08[2], B18[2];
  const char* cA = (const char*)g.A + (GATHER ? 0 : cur.aoff * 2); const char* cB = (const char*)g.Bt + cur.boff * 2;
  PG8_STAGE(PG8_SB(0, 0), cB, voffB); PG8_STAGE(PG8_SB(0, 1), cB + hstepB, voffB); PG8_STAGE(PG8_SA(0, 0), cA, vA[0]); PG8_STAGE(PG8_SA(0, 1), cA, vA[1]);
  if (wr == 1) PG8_BAR;
  PG8_WAIT_V(2); PG8_BAR;
  PG8_STAGE(PG8_SB(1, 0), cB + kstep, voffB); PG8_STAGE(PG8_SA(1, 0), cA + kstep, vA[0]); PG8_STAGE(PG8_SB(1, 1), cB + hstepB + kstep, voffB);
  PG8_WAIT_V(6); PG8_BAR;
  for (;;) {
    const bool has_next = S.next(ui + 1, nxt);
    const char* nA = has_next ? (const char*)g.A + (GATHER ? 0 : nxt.aoff * 2) : cA; const char* nB = has_next ? (const char*)g.Bt + nxt.boff * 2 : cB;
    if constexpr (GATHER) { if (has_next) load_va(nxt, nvA); else {
#pragma unroll
      for (int h = 0; h < 2; ++h)
#pragma unroll
        for (int i = 0; i < 2; ++i) nvA[h][i] = vA[h][i]; } }
#pragma unroll 1
    for (int t = 0; t < nt; t += 2) {
      const bool last = (t == nt - 2);
      const char* a1 = cA + (size_t)(t + 1) * kstep;
      const char* a2 = last ? nA : cA + (size_t)(t + 2) * kstep; const char* b2 = last ? nB : cB + (size_t)(t + 2) * kstep;
      const char* a3 = a2 + kstep; const char* b3 = b2 + kstep;
      unsigned w0[2], w1[2];
      if constexpr (GATHER) { w0[0] = last ? nvA[0][0] : vA[0][0]; w0[1] = last ? nvA[0][1] : vA[0][1]; w1[0] = last ? nvA[1][0] : vA[1][0]; w1[1] = last ? nvA[1][1] : vA[1][1]; }
      else { w0[0] = vA[0][0]; w0[1] = vA[0][1]; w1[0] = vA[1][0]; w1[1] = vA[1][1]; }
      PG8_LDB(B0, 0, 0); PG8_LDB(B1, 0, 1); PG8_SCHED; PG8_LDA(At, 0, 0); PG8_STAGE(PG8_SA(1, 1), a1, vA[1]);
      PG8_WAIT_V(8); PG8_WAIT_L(0); PG8_BAR; PG8_MMA(0, 0, At, B0); PG8_MMA(0, 1, At, B1); PG8_BAR; PG8_SCHED;
      PG8_LDA(At, 0, 1); PG8_STAGE(PG8_SB(0, 0), b2, voffB); PG8_STAGE(PG8_SB(0, 1), b2 + hstepB, voffB); PG8_STAGE(PG8_SA(0, 0), a2, w0);
      PG8_WAIT_V(8); PG8_WAIT_L(0); PG8_BAR; PG8_MMA(1, 0, At, B0); PG8_MMA(1, 1, At, B1); PG8_BAR; PG8_SCHED;
      PG8_LDB(B0, 1, 0); PG8_LDB(B1, 1, 1); PG8_SCHED; PG8_LDA(At, 1, 0); PG8_STAGE(PG8_SA(0, 1), a2, w1);
      PG8_WAIT_V(8); PG8_WAIT_L(0); PG8_BAR; PG8_MMA(0, 0, At, B0); PG8_MMA(0, 1, At, B1); PG8_BAR; PG8_SCHED;
      PG8_LDA(At, 1, 1); PG8_STAGE(PG8_SB(1, 0), b3, voffB); PG8_STAGE(PG8_SB(1, 1), b3 + hstepB, voffB); PG8_STAGE(PG8_SA(1, 0), a3, w0);
      PG8_WAIT_V(8); PG8_WAIT_L(0); PG8_BAR; PG8_MMA(1, 0, At, B0); PG8_MMA(1, 1, At, B1); PG8_BAR; PG8_SCHED;
    }
    if constexpr (FP8) { asm volatile("s_nop 15\n\ts_nop 15" ::: "memory"); __builtin_amdgcn_sched_barrier(0); }
    if (wr == 0) PG8_BAR;
    int fr_o = fr, fq_o = fq; asm volatile("" : "+v"(fr_o), "+v"(fq_o));
    if constexpr (Epi::TWO_PASS) {
#pragma unroll
      for (int ai = 0; ai < 2; ++ai)
#pragma unroll
        for (int m = 0; m < 4; ++m) {
          float v0[8], v1[8];
#pragma unroll
          for (int n = 0; n < 2; ++n)
#pragma unroll
            for (int j = 0; j < 4; ++j) { v0[n * 4 + j] = acc[ai][0][m][n][j]; v1[n * 4 + j] = acc[ai][1][m][n][j]; }
          E.pass1(cur, ai * HALF + wr * 64 + m * 16 + fr_o, wc, v0, v1, fq_o);
#pragma unroll
          for (int n = 0; n < 2; ++n)
#pragma unroll
            for (int j = 0; j < 4; ++j) { acc[ai][0][m][n][j] = v0[n * 4 + j]; acc[ai][1][m][n][j] = v1[n * 4 + j]; }
        }
      asm volatile("s_waitcnt lgkmcnt(0)" ::: "memory"); PG8_BAR; asm volatile("" ::: "memory");
    }
    {
#pragma unroll
      for (int ai = 0; ai < 2; ++ai)
#pragma unroll
        for (int m = 0; m < 4; ++m) {
          float v0[8], v1[8];
#pragma unroll
          for (int n = 0; n < 2; ++n)
#pragma unroll
            for (int j = 0; j < 4; ++j) { v0[n * 4 + j] = acc[ai][0][m][n][j]; v1[n * 4 + j] = acc[ai][1][m][n][j]; }
          E.row8(cur, ai * HALF + wr * 64 + m * 16 + fr_o, wc * 32 + 8 * fq_o, v0, v1, fq_o);
          asm volatile("" ::: "memory");
        }
    }
    if (!has_next) break;
#pragma unroll
    for (int a = 0; a < 2; ++a)
#pragma unroll
      for (int b = 0; b < 2; ++b)
#pragma unroll
        for (int m = 0; m < 4; ++m)
#pragma unroll
          for (int n = 0; n < 2; ++n) acc[a][b][m][n] = (f32x4){0.f, 0.f, 0.f, 0.f};
    cur = nxt; cA = nA; cB = nB; ++ui;
    if constexpr (GATHER) {
#pragma unroll
      for (int h = 0; h < 2; ++h)
#pragma unroll
        for (int i = 0; i < 2; ++i) vA[h][i] = nvA[h][i]; }
    if (wr == 1) PG8_BAR;
  }
  PG8_WAIT_V(0);
  PG8_BAR;
#undef PG8_SA
#undef PG8_SB
#undef PG8_STAGE
#undef PG8_LDA
#undef PG8_LDB
#undef PG8_MMA
#undef PG8_WAIT_V
#undef PG8_WAIT_L
#undef PG8_BAR
#undef PG8_SCHED
}
}
constexpr size_t WS_CTL = 0, CTL_ZERO_BYTES = 1 * MiB;
constexpr int CW_TMO = 0, CW_BAR = 4096, CW_Q = 8192;
constexpr size_t CTL_SSQ = 256 * 1024, CTL_SSKV = CTL_SSQ + 65536, CTL_SS1 = CTL_SSKV + 65536, CTL_SS2 = CTL_SS1 + 65536;
constexpr size_t WS_WIN = 1 * MiB, WS_WQB = 6 * MiB, WS_WKVB = 6 * MiB + 512 * 1024, WS_WOUT = 7 * MiB, WS_WMQ = 9 * MiB, WS_WMK = 11 * MiB, WS_WMV = 13 * MiB, WS_WMO = 15 * MiB;
constexpr size_t WS_ROPE = 17 * MiB, WS_MEMN = 19 * MiB, WS_KMEM = 21 * MiB, WS_VMEMT = 23 * MiB, WS_GSC = 25 * MiB, WS_DEC = 28 * MiB, WS_AFF = 29 * MiB, WS_SEL = 30 * MiB;
constexpr size_t WS_PROJ = 32 * MiB, WS_XN = 112 * MiB, WS_QC = 112 * MiB, WS_KC = 128 * MiB, WS_QM = 144 * MiB, WS_KM = 168 * MiB, WS_VM = 192 * MiB, WS_HF = 208 * MiB, WS_HB = 224 * MiB, WS_Y = 240 * MiB;
constexpr size_t WS_X1 = 112 * MiB, WS_X1B = 176 * MiB, WS_QMEM = 208 * MiB, WS_P = 240 * MiB, WS_MO = 176 * MiB, WS_X2 = 240 * MiB, WS_X2B = 208 * MiB, WS_HID = 32 * MiB;
constexpr size_t WS_DUMMY = 304 * MiB;
constexpr size_t WS_WEGU = 320 * MiB, WS_WED = 448 * MiB, WS_END = 512 * MiB;
constexpr int PROJ_LD = 2560;
constexpr int PC_CQ = 2048, PC_CKV = 2304, PC_KR = 2432, PC_G = 2464;
constexpr int RING_BYTES = 131072, LDSCTL_OFF = 133120, LDS_BYTES = 147456;

struct Args { const void* in[26]; float* out; unsigned char* ws; int ph_lo, ph_hi, flags, pad; };

struct Frame {
  LAS unsigned char* lds; volatile LAS unsigned* MISC; gu32* ctl; unsigned char* ws;
  int tid, lane, wave, vcu, G;
};

__device__ __forceinline__ void p0_tr(const float* W, int ldw, int k0, int kvalid, int scol0, int ncols, const float* gs, bf16* WT, int ldt, int drow0, LAS float* scr, int lane, bool doq = false) {
  const int c4 = (lane & 15) * 4, kr = lane >> 4;
  f32x4 v[16];
#pragma unroll
  for (int i = 0; i < 16; ++i) { const int kk = 4 * i + kr; v[i] = (f32x4){0.f, 0.f, 0.f, 0.f};
    if (c4 < ncols && k0 + kk < kvalid) { v[i] = *(const f32x4*)(W + (size_t)(k0 + kk) * ldw + scol0 + c4); if (gs) v[i] = v[i] * gs[k0 + kk];
      if (doq) { v[i].x = q8(v[i].x, 64.f); v[i].y = q8(v[i].y, 64.f); v[i].z = q8(v[i].z, 64.f); v[i].w = q8(v[i].w, 64.f); } } }
#pragma unroll
  for (int i = 0; i < 16; ++i) { const int kk = 4 * i + kr; LAS float* d = scr + kk * 65 + c4; d[0] = v[i].x; d[1] = v[i].y; d[2] = v[i].z; d[3] = v[i].w; }
  LDS_WAIT(); asm volatile("" ::: "memory");
  const int c = lane & 7;
#pragma unroll
  for (int j = 0; j < 8; ++j) { const int n = (lane >> 3) + 8 * j; const LAS float* s = scr + (8 * c) * 65 + n;
    v4u o; o.x = pk2(s[0 * 65], s[1 * 65]); o.y = pk2(s[2 * 65], s[3 * 65]); o.z = pk2(s[4 * 65], s[5 * 65]); o.w = pk2(s[6 * 65], s[7 * 65]);
    *(GAS v4u*)(WT + (size_t)(drow0 + n) * ldt + k0 + 8 * c) = o; }
  LDS_WAIT(); asm volatile("" ::: "memory");
}
struct ConvDesc { const float* W; const float* gs; unsigned char* WT8; int ldw, k0, scol0, ldt, drow0; };
__device__ __forceinline__ void p0_tr8_load(const ConvDesc& d, f32x4 (&v)[16], int lane) {
  const int c4 = (lane & 15) * 4, kr = lane >> 4;
#pragma unroll
  for (int i = 0; i < 16; ++i) { const int kk = 4 * i + kr; v[i] = *(const f32x4*)(d.W + (size_t)(d.k0 + kk) * d.ldw + d.scol0 + c4); }
}
__device__ __forceinline__ void p0_tr8_finish(const ConvDesc& d, f32x4 (&v)[16], float sc, LAS float* scr, int lane) {
  const int c4 = (lane & 15) * 4, kr = lane >> 4;
#pragma unroll
  for (int i = 0; i < 16; ++i) { const int kk = 4 * i + kr; f32x4 x = v[i]; if (d.gs) x = x * d.gs[d.k0 + kk]; LAS float* p = scr + kk * 65 + c4; p[0] = x.x; p[1] = x.y; p[2] = x.z; p[3] = x.w; }
  LDS_WAIT(); asm volatile("" ::: "memory");
  const int c = lane & 7;
#pragma unroll
  for (int j = 0; j < 8; ++j) { const int n = (lane >> 3) + 8 * j; const LAS float* s = scr + (8 * c) * 65 + n;
    float f[8];
#pragma unroll
    for (int q = 0; q < 8; ++q) f[q] = s[q * 65];
    *(GAS v2u*)(d.WT8 + (size_t)(d.drow0 + n) * d.ldt + d.k0 + 8 * c) = pack8_fp8(f, sc); }
  LDS_WAIT(); asm volatile("" ::: "memory");
}
__device__ __forceinline__ void p0_tr32(const float* W, int ldw, int k0, int scol0, int ncols, const float* gs, bf16* WT, int ldt, int drow0, LAS float* scr, int lane) {
#pragma unroll 8
  for (int i = 0; i < 32; ++i) { const int kk = 2 * i + (lane >> 5), c = lane & 31; float v = 0.f;
    if (c < ncols) { v = W[(size_t)(k0 + kk) * ldw + scol0 + c]; if (gs) v *= gs[k0 + kk]; }
    scr[kk * 65 + c] = v; }
  LDS_WAIT(); asm volatile("" ::: "memory");
  const int c = lane & 7;
#pragma unroll
  for (int j = 0; j < 4; ++j) { const int n = (lane >> 3) + 8 * j; const LAS float* s = scr + (8 * c) * 65 + n;
    v4u o; o.x = pk2(s[0 * 65], s[1 * 65]); o.y = pk2(s[2 * 65], s[3 * 65]); o.z = pk2(s[4 * 65], s[5 * 65]); o.w = pk2(s[6 * 65], s[7 * 65]);
    *(GAS v4u*)(WT + (size_t)(drow0 + n) * ldt + k0 + 8 * c) = o; }
  LDS_WAIT(); asm volatile("" ::: "memory");
}
__device__ __forceinline__ void rms_row_to_bf16(const float* xrow, bf16* orow, int lane) {
  const GAS f32x4* xr = (const GAS f32x4*)xrow + lane;
  f32x4 v[4]; float s = 0.f;
#pragma unroll
  for (int j = 0; j < 4; ++j) { v[j] = xr[64 * j]; s += (v[j].x * v[j].x + v[j].y * v[j].y) + (v[j].z * v[j].z + v[j].w * v[j].w); }
  const float rstd = rsqrtf(wave_sum(s) * (1.f / 1024.f) + 1e-6f);
  GAS unsigned long long* o8 = (GAS unsigned long long*)orow + lane;
#pragma unroll
  for (int j = 0; j < 4; ++j) o8[64 * j] = (unsigned long long)pk2(v[j].x * rstd, v[j].y * rstd) | ((unsigned long long)pk2(v[j].z * rstd, v[j].w * rstd) << 32);
}

#ifndef FP8EMU
#define FP8EMU 0
#endif
#ifndef MOE_FP8
#define MOE_FP8 1
#endif
#ifndef CONV_NT
#define CONV_NT 0
#endif
#ifndef MOE_FP8_DOWN
#define MOE_FP8_DOWN MOE_FP8
#endif
constexpr size_t WS_PO = 384 * MiB, WS_PML = 272 * MiB;
constexpr size_t WS_XG = 96 * MiB;
constexpr size_t WS_X2Q = 208 * MiB, WS_WEGU8 = 320 * MiB, WS_WED8 = 448 * MiB, WS_HID8 = 32 * MiB;
constexpr int CW_RDY = 8192 + 64 * 44;
constexpr int CW_CONV = 8192 + 64 * 40, CW_MDONE = 8192 + 64 * 41, CW_TDONE = 8192 + 64 * 42;
constexpr int CONV_IGU = 16 * 64, CONV_ID = 32 * 16, CONV_ITEMS = NEXP * (CONV_IGU + CONV_ID), CONV_CHUNKS = CONV_ITEMS / 8;
__device__ __forceinline__ ConvDesc conv_desc(Frame& F, const Args& a, int it) {
  auto I = [&](int i) { return (const float*)a.in[i]; };
  unsigned char* ws = F.ws; ConvDesc d;
  const int e = it / (CONV_IGU + CONV_ID); int r = it % (CONV_IGU + CONV_ID);
  if (r < CONV_IGU) { const int kb = r / 64, nb = r % 64, p = nb >> 2, j0 = (nb & 3) * 64; const bool up = j0 >= 128;
    d.W = (up ? I(I_WEU) : I(I_WEG)) + (size_t)e * 1024 * 2048; d.ldw = 2048; d.k0 = 64 * kb; d.scol0 = 128 * p + (up ? j0 - 128 : j0); d.gs = I(I_GFFN); d.WT8 = ws + WS_WEGU8 + (size_t)e * 4096 * 1024; d.ldt = 1024; d.drow0 = 64 * nb; }
  else { r -= CONV_IGU; const int kb = r / 16, nb = r % 16;
    d.W = I(I_WED) + (size_t)e * 2048 * 1024; d.ldw = 1024; d.k0 = 64 * kb; d.scol0 = 64 * nb; d.gs = nullptr; d.WT8 = ws + WS_WED8 + (size_t)e * 1024 * 2048; d.ldt = 2048; d.drow0 = 64 * nb; }
  return d;
}
__device__ __forceinline__ void conv_fill(Frame& F, const Args& a, int maxpairs) {
  static_assert(MOE_FP8 && MOE_FP8_DOWN, "the conversion filler writes fp8 expert weights");
  volatile LAS int* slot = (volatile LAS int*)(F.lds + LDSCTL_OFF + 16);
  LAS float* scr = (LAS float*)(F.lds + F.wave * 16640);
  for (int n = 0; n < maxpairs; ++n) {
    if (F.tid == 0) { int got = -1;
      if (__hip_atomic_load(F.ctl + CW_CONV, RLX_AGENT) < (unsigned)CONV_CHUNKS) { const unsigned c = __hip_atomic_fetch_add(F.ctl + CW_CONV, 2u, RLX_AGENT); if (c < (unsigned)CONV_CHUNKS) got = (int)c; }
      *slot = got; }
    __syncthreads();
    const int c = __builtin_amdgcn_readfirstlane(*slot);
    __syncthreads();
    if (c < 0) break;
    const ConvDesc d0 = conv_desc(F, a, c * 8 + F.wave), d1 = conv_desc(F, a, (c + 1) * 8 + F.wave);
    f32x4 v0[16], v1[16];
    p0_tr8_load(d0, v0, F.lane); p0_tr8_load(d1, v1, F.lane);
    p0_tr8_finish(d0, v0, 64.f, scr, F.lane); p0_tr8_finish(d1, v1, 64.f, scr, F.lane);
  }
}
__device__ __forceinline__ void p0_prologue(Frame& F, const Args& a, bool do_dense, bool do_experts) {
  LAS float* scr = (LAS float*)(F.lds + F.wave * 16640);
  const int gw = F.vcu * NWAVES + F.wave, NGW = F.G * NWAVES;
  auto I = [&](int i) { return (const float*)a.in[i]; };
  unsigned char* ws = F.ws;
  if (do_dense) {
    constexpr int I_WIN_ = 16 * 40, I_WQB_ = 4 * 12, I_WKVB_ = 4 * 16, I_SQ = 16 * 16;
    constexpr int NIT = I_WIN_ + I_WQB_ + I_WKVB_ + 5 * I_SQ;
    for (int it = gw; it < NIT; it += NGW) {
      int r = it;
      if (r < I_WIN_) { const int kb = r / 40, nb = r % 40; int sc, nc = 64;
        if (nb < 32) sc = 64 * nb; else if (nb < 36) sc = OFF_CQ + 64 * (nb - 32); else if (nb < 38) sc = OFF_CKV + 64 * (nb - 36); else if (nb == 38) { sc = OFF_KR; nc = 32; } else { sc = 0; nc = 0; }
        p0_tr(I(I_WIN), D_IN, 64 * kb, 1024, sc, nc, I(I_GMIX), (bf16*)(ws + WS_WIN), 1024, 64 * nb, scr, F.lane);
        if (nb == 38) p0_tr32(I(I_WIN), D_IN, 64 * kb, OFF_G, 16, I(I_GMIX), (bf16*)(ws + WS_WIN), 1024, PC_G, scr, F.lane);
        continue; } r -= I_WIN_;
      if (r < I_WQB_) { const int kb = r / 12, nb = r % 12; p0_tr(I(I_WQB), 768, 64 * kb, 256, 64 * nb, 64, I(I_GQA), (bf16*)(ws + WS_WQB), 256, 64 * nb, scr, F.lane); continue; } r -= I_WQB_;
      if (r < I_WKVB_) { const int kb = r / 16, nb = r % 16; const int h = nb & 7; const int sc = h * 128 + (nb >= 8 ? 64 : 0);
        p0_tr(I(I_WKVB), 1024, 64 * kb, 128, sc, 64, I(I_GKVA), (bf16*)(ws + WS_WKVB), 256, 64 * nb, scr, F.lane); continue; } r -= I_WKVB_;
      const int which = r / I_SQ; r %= I_SQ; const int kb = r / 16, nb = r % 16;
      const float* src = which == 0 ? I(I_WOUT) : which == 1 ? I(I_WMQ) : which == 2 ? I(I_WMK) : which == 3 ? I(I_WMV) : I(I_WMO);
      const float* gs = which == 1 ? I(I_GMX) : (which == 2 || which == 3) ? I(I_GMKV) : nullptr;
      bf16* dst = (bf16*)(ws + (which == 0 ? WS_WOUT : which == 1 ? WS_WMQ : which == 2 ? WS_WMK : which == 3 ? WS_WMV : WS_WMO));
      p0_tr(src, 1024, 64 * kb, 1024, 64 * nb, 64, gs, dst, 1024, 64 * nb, scr, F.lane);
    }
    for (int m = gw; m < MTOK; m += NGW) rms_row_to_bf16(I(I_X) + (size_t)m * 1024, (bf16*)(ws + WS_XN) + (size_t)m * 1024, F.lane);
    for (int m = gw; m < BATCH * NMEM; m += NGW) rms_row_to_bf16(I(I_MEM) + (size_t)m * 1024, (bf16*)(ws + WS_MEMN) + (size_t)m * 1024, F.lane);
    { const float* wr = I(I_WR); const float* gf = I(I_GFFN); float* wrg = (float*)(ws + WS_DEC + 65536);
      for (int i = (F.vcu * NTHR + F.tid); i < 1024 * 16; i += F.G * NTHR) wrg[i] = wr[i] * gf[i >> 4]; }
    { const int* pos = (const int*)a.in[I_POS]; float* rt = (float*)(ws + WS_ROPE);
      for (int i = (F.vcu * NTHR + F.tid); i < MTOK * 16; i += F.G * NTHR) { const int m = i >> 4, j = i & 15; const float inv = powf(10000.f, -(float)j / 16.f); const float ang = (float)pos[m] * inv;
        rt[m * 32 + j] = cosf(ang); rt[m * 32 + 16 + j] = sinf(ang); } }
  }
  if (do_experts) conv_fill(F, a, 1 << 30);
}

__device__ __forceinline__ v4u pack8(const float (&v)[8]) { v4u w; w.x = cvt_pk_bf16(v[0], v[1]); w.y = cvt_pk_bf16(v[2], v[3]); w.z = cvt_pk_bf16(v[4], v[5]); w.w = cvt_pk_bf16(v[6], v[7]); return w; }
__device__ __forceinline__ float sumsq8(const float (&v)[8]) { float s = 0.f;
#pragma unroll
  for (int i = 0; i < 8; ++i) s += v[i] * v[i];
  return s; }
struct EpiStore { static constexpr bool TWO_PASS = false; bf16* O; int ldc;
  __device__ __forceinline__ void row8(const pg8::Unit& u, int rloc, int cloc, const float (&v0)[8], const float (&v1)[8], int fq) const {
    bf16* p = O + (size_t)(u.pm * 256 + rloc) * ldc + u.pn * 256 + cloc; *(v4u*)p = pack8(v0); *(v4u*)(p + 128) = pack8(v1); } };
struct EpiProj { static constexpr bool TWO_PASS = false; bf16* P; float* ssq; float* sskv;
  __device__ __forceinline__ void row8(const pg8::Unit& u, int rloc, int cloc, const float (&v0)[8], const float (&v1)[8], int fq) const {
    const int row = u.pm * 256 + rloc; bf16* p = P + (size_t)row * PROJ_LD + u.pn * 256 + cloc; *(v4u*)p = pack8(v0); *(v4u*)(p + 128) = pack8(v1);
    if (u.pn == 8) { float s = sumsq8(v0) + sumsq8(v1); s += __shfl_xor(s, 16); s += __shfl_xor(s, 32); if (fq == 0) unsafeAtomicAdd(ssq + row, s); }
    if (u.pn == 9) { float s = sumsq8(v0); s += __shfl_xor(s, 16); s += __shfl_xor(s, 32); if (fq == 0) unsafeAtomicAdd(sskv + row, s); } } };
struct EpiQ { static constexpr bool TWO_PASS = false; bf16* Q; const float* ssq; const float* rope;
  __device__ __forceinline__ void rope8(float (&v)[8], int row, int fq) const {
    float pv[8];
#pragma unroll
    for (int i = 0; i < 8; ++i) pv[i] = __shfl_xor(v[i], 32);
    const float* cs = rope + (size_t)row * 32 + 8 * (fq & 1);
#pragma unroll
    for (int i = 0; i < 8; ++i) { const float c = cs[i], s = cs[16 + i]; v[i] = (fq < 2) ? (v[i] * c - pv[i] * s) : (v[i] * c + pv[i] * s); }
  }
  __device__ __forceinline__ void row8(const pg8::Unit& u, int rloc, int cloc, const float (&a0)[8], const float (&a1)[8], int fq) const {
    const int row = u.pm * 256 + rloc; const float r = rsqrtf(ssq[row] * (1.f / 256.f) + 1e-6f);
    float v0[8], v1[8];
#pragma unroll
    for (int i = 0; i < 8; ++i) { v0[i] = a0[i] * r; v1[i] = a1[i] * r; }
    const int g0 = u.pn * 8 + (cloc >> 5), g1 = g0 + 4;
    if (g0 % 3 == 2) rope8(v0, row, fq);
    if (g1 % 3 == 2) rope8(v1, row, fq);
    bf16* p = Q + (size_t)row * 768 + u.pn * 256 + cloc; *(v4u*)p = pack8(v0); *(v4u*)(p + 128) = pack8(v1); } };
struct EpiKV { static constexpr bool TWO_PASS = false; bf16* KMp; bf16* VMp; const float* sskv;
  __device__ __forceinline__ void put(int row, int c, const float (&v)[8], float r) const {
    float w[8];
#pragma unroll
    for (int i = 0; i < 8; ++i) w[i] = v[i] * r;
    if (c < 512) *(v4u*)(KMp + (size_t)row * 768 + (c >> 6) * 96 + (c & 63)) = pack8(w); else *(v4u*)(VMp + (size_t)row * 512 + (c - 512)) = pack8(w); }
  __device__ __forceinline__ void row8(const pg8::Unit& u, int rloc, int cloc, const float (&a0)[8], const float (&a1)[8], int fq) const {
    const int row = u.pm * 256 + rloc; const float r = rsqrtf(sskv[row] * (1.f / 128.f) + 1e-6f);
    put(row, u.pn * 256 + cloc, a0, r); put(row, u.pn * 256 + 128 + cloc, a1, r); } };

__device__ __forceinline__ void unpack8(v4u w, float (&f)[8]) { f[0] = bflo(w.x); f[1] = bfhi(w.x); f[2] = bflo(w.y); f[3] = bfhi(w.y); f[4] = bflo(w.z); f[5] = bfhi(w.z); f[6] = bflo(w.w); f[7] = bfhi(w.w); }
__device__ __forceinline__ float log_sigmoid(float x) { return fminf(x, 0.f) - log1pf(__expf(-fabsf(x))); }

__device__ __forceinline__ void p2_elementwise(Frame& F, const Args& a) {
  unsigned char* ws = F.ws;
  const bf16* P = (const bf16*)(ws + WS_PROJ);
  { const float* cw = (const float*)a.in[I_CONV]; bf16* QC = (bf16*)(ws + WS_QC); bf16* KC = (bf16*)(ws + WS_KC);
    for (int i = F.vcu * NTHR + F.tid; i < MTOK * 128; i += F.G * NTHR) { const int m = i >> 7, c = (i & 127) * 8, t = m & (SEQ - 1);
      float x1[8], x0[8], x2[8]; unpack8(*(const v4u*)(P + (size_t)m * PROJ_LD + c), x1);
      if (t > 0) unpack8(*(const v4u*)(P + (size_t)(m - 1) * PROJ_LD + c), x0); else {
#pragma unroll
        for (int j = 0; j < 8; ++j) x0[j] = 0.f; }
      if (t < SEQ - 1) unpack8(*(const v4u*)(P + (size_t)(m + 1) * PROJ_LD + c), x2); else {
#pragma unroll
        for (int j = 0; j < 8; ++j) x2[j] = 0.f; }
      float o[8];
#pragma unroll
      for (int j = 0; j < 8; ++j) { float v = x0[j] * cw[c + j] + x1[j] * cw[1024 + c + j] + x2[j] * cw[2048 + c + j]; v = v * sigmoidf_(v); o[j] = (c < 512) ? v : v * 0.08838834764831845f; }
      if (c < 512) *(v4u*)(QC + (size_t)m * 512 + c) = pack8(o); else *(v4u*)(KC + (size_t)m * 512 + c - 512) = pack8(o); } }
  { const float* rope = (const float*)(ws + WS_ROPE); bf16* KMp = (bf16*)(ws + WS_KM);
    for (int i = F.vcu * NTHR + F.tid; i < MTOK * 16; i += F.G * NTHR) { const int m = i >> 4, j = i & 15;
      const float t1 = bf2f(P[(size_t)m * PROJ_LD + PC_KR + j]), t2 = bf2f(P[(size_t)m * PROJ_LD + PC_KR + 16 + j]); const float c = rope[m * 32 + j], s = rope[m * 32 + 16 + j];
      const bf16 o1 = (bf16)f2bf(t1 * c - t2 * s), o2 = (bf16)f2bf(t2 * c + t1 * s);
#pragma unroll
      for (int h = 0; h < 8; ++h) { KMp[(size_t)m * 768 + h * 96 + 64 + j] = o1; KMp[(size_t)m * 768 + h * 96 + 80 + j] = o2; } } }
  { const float* bg = (const float*)a.in[I_BG]; float* GSC = (float*)(ws + WS_GSC); float* DEC = (float*)(ws + WS_DEC);
    const int gw = F.vcu * NWAVES + F.wave, NGW = F.G * NWAVES;
    for (int it = gw; it < 32 * 64; it += NGW) { const int seq = it >> 6, c = it & 63, dir = seq & 1, h = (seq >> 1) & 3, b = seq >> 3;
      const int p = c * 64 + F.lane, t = dir ? (SEQ - 1 - p) : p; const size_t row = (size_t)b * SEQ + t;
      const int gi = (dir ? 8 : 0) + h, gf = (dir ? 12 : 4) + h;
      const float li = bf2f(P[row * PROJ_LD + PC_G + gi]) + bg[gi]; const float lf = log_sigmoid(bf2f(P[row * PROJ_LD + PC_G + gf]) + bg[gf]);
      float bs = lf;
#pragma unroll
      for (int o = 1; o < 64; o <<= 1) { const float y = __shfl_up(bs, o); if (F.lane >= o) bs += y; }
      const float av = li - bs; float pm = av;
#pragma unroll
      for (int o = 1; o < 64; o <<= 1) { const float y = __shfl_up(pm, o); if (F.lane >= o) pm = fmaxf(pm, y); }
      float* gs = GSC + (size_t)seq * 3 * SEQ; gs[p] = bs; gs[SEQ + p] = av; gs[2 * SEQ + p] = pm;
      if (F.lane == 63) { DEC[seq * 128 + c] = bs; DEC[seq * 128 + 64 + c] = pm; } } }
}
namespace mla {
constexpr int DQK = 96, DV = 64, NW = 8, QBLK = 32, KVBLK = 64, LDQ = 768, LDK = 768, LDV = 512, LDO = 1024;
constexpr float SCALE = 0.10206207261596575f;
constexpr float THR = 8.f;
constexpr int SHM_V = 16384, SHM_K = 16384, SHM_ATTN = 2 * SHM_V + 2 * SHM_K + NW * 64 * 4;
#define KSWZ(row, colB) ((row) * 256 + ((colB) ^ (((row) & 7) << 4)))
#define SBAR() __builtin_amdgcn_sched_barrier(0)
__device__ __forceinline__ int crow(int r, int hi) { return (r & 3) + 8 * (r >> 2) + 4 * hi; }
__device__ __forceinline__ void partialSM(f32x16& p0, f32x16& p1, float& m_reg, float& mn, float& alpha) {
  constexpr float C = SCALE * 1.4426950408889634f;
  float pmax = p0[0];
#pragma unroll
  for (int r = 1; r < 16; ++r) pmax = fmaxf(pmax, p0[r]);
#pragma unroll
  for (int r = 0; r < 16; ++r) pmax = fmaxf(pmax, p1[r]);
  { auto rr = __builtin_amdgcn_permlane32_swap(__float_as_uint(pmax), __float_as_uint(pmax), false, false);
    pmax = fmaxf(__uint_as_float(rr[0]), __uint_as_float(rr[1])); }
  if (__builtin_expect(__all(pmax - m_reg <= THR / SCALE), 1)) { mn = m_reg; alpha = 1.f; }
  else { mn = fmaxf(m_reg, pmax); alpha = __builtin_amdgcn_exp2f((m_reg - mn) * C); m_reg = mn; }
  const float mnC = -mn * C;
#pragma unroll
  for (int r = 0; r < 16; ++r) p0[r] = fmaf(p0[r], C, mnC);
#pragma unroll
  for (int r = 0; r < 16; ++r) p1[r] = fmaf(p1[r], C, mnC);
#pragma unroll
  for (int r = 0; r < 16; ++r) p0[r] = __builtin_amdgcn_exp2f(p0[r]);
}
__device__ __forceinline__ void finishSM(f32x16& p0, f32x16& p1, float alpha, float& l_reg, bf16x8& pa0, bf16x8& pa1, bf16x8& pa2, bf16x8& pa3) {
#pragma unroll
  for (int r = 0; r < 16; ++r) p1[r] = __builtin_amdgcn_exp2f(p1[r]);
  float ps = 0;
#pragma unroll
  for (int r = 0; r < 16; ++r) ps += p0[r];
#pragma unroll
  for (int r = 0; r < 16; ++r) ps += p1[r];
  { auto rr = __builtin_amdgcn_permlane32_swap(__float_as_uint(ps), __float_as_uint(ps), false, false);
    ps = __uint_as_float(rr[0]) + __uint_as_float(rr[1]); }
  l_reg = l_reg * alpha + ps;
#define PK4(P, BASE, OUT) do { unsigned a0 = cvt_pk_bf16(P[BASE + 0], P[BASE + 1]), a1 = cvt_pk_bf16(P[BASE + 2], P[BASE + 3]);   \
    unsigned b0 = cvt_pk_bf16(P[BASE + 4], P[BASE + 5]), b1 = cvt_pk_bf16(P[BASE + 6], P[BASE + 7]);                              \
    auto r0 = __builtin_amdgcn_permlane32_swap(a0, b0, false, false); auto r1 = __builtin_amdgcn_permlane32_swap(a1, b1, false, false); \
    v4u w = {r0[0], r1[0], r0[1], r1[1]}; OUT = __builtin_bit_cast(bf16x8, w); } while (0)
  PK4(p0, 0, pa0); PK4(p0, 8, pa1); PK4(p1, 0, pa2); PK4(p1, 8, pa3);
#undef PK4
}
__device__ __forceinline__ void qkt(f32x16& p0, f32x16& p1, const char* Ks, const bf16x8* qr, int r32, int hi) {
  p0 = f32x16{}; p1 = f32x16{};
#pragma unroll
  for (int d0 = 0; d0 < DQK / 16; ++d0) { const int cb = (d0 * 16 + hi * 8) * 2;
    const bf16x8 b0 = *reinterpret_cast<const bf16x8*>(Ks + KSWZ(r32, cb));
    const bf16x8 b1 = *reinterpret_cast<const bf16x8*>(Ks + KSWZ(32 + r32, cb));
    p0 = __builtin_amdgcn_mfma_f32_32x32x16_bf16(b0, qr[d0], p0, 0, 0, 0);
    p1 = __builtin_amdgcn_mfma_f32_32x32x16_bf16(b1, qr[d0], p1, 0, 0, 0); }
}
__device__ __forceinline__ int v_st(int k, int c) { const int kk = (k & ~0xC) | ((k & 4) << 1) | ((k & 8) >> 1); return ((kk >> 3) * 4 + (c >> 5)) * 512 + ((kk & 7) * 32 + (c & 31)) * 2; }
__device__ __forceinline__ int v_rd_base(int lane) { return ((lane & 3) << 3) | (((lane >> 2) & 3) << 6) | (((lane >> 4) & 1) << 5) | (((lane >> 5) & 1) << 8); }
constexpr int v_rd_off(int d0, int ks, int half) { return d0 * 512 + ks * 4096 + half * 2048; }
template <int OFF> __device__ __forceinline__ s16x4 tr_read(int vb) {
  s16x4 r; asm volatile("ds_read_b64_tr_b16 %0, %1 offset:%2" : "=&v"(r) : "v"(vb), "i"(OFF) : "memory"); return r;
}
template <int D0> __device__ __forceinline__ void pv_one(f32x16& od, int vb, bf16x8 pa0, bf16x8 pa1, bf16x8 pa2, bf16x8 pa3) {
  const s16x4 l0 = tr_read<v_rd_off(D0, 0, 0)>(vb), h0 = tr_read<v_rd_off(D0, 0, 1)>(vb), l1 = tr_read<v_rd_off(D0, 1, 0)>(vb), h1 = tr_read<v_rd_off(D0, 1, 1)>(vb);
  const s16x4 l2 = tr_read<v_rd_off(D0, 2, 0)>(vb), h2 = tr_read<v_rd_off(D0, 2, 1)>(vb), l3 = tr_read<v_rd_off(D0, 3, 0)>(vb), h3 = tr_read<v_rd_off(D0, 3, 1)>(vb);
  asm volatile("s_waitcnt lgkmcnt(0)" ::: "memory"); SBAR();
#define PK(L, H) (bf16x8){L[0], L[1], L[2], L[3], H[0], H[1], H[2], H[3]}
  od = __builtin_amdgcn_mfma_f32_32x32x16_bf16(pa0, PK(l0, h0), od, 0, 0, 0);
  od = __builtin_amdgcn_mfma_f32_32x32x16_bf16(pa1, PK(l1, h1), od, 0, 0, 0);
  od = __builtin_amdgcn_mfma_f32_32x32x16_bf16(pa2, PK(l2, h2), od, 0, 0, 0);
  od = __builtin_amdgcn_mfma_f32_32x32x16_bf16(pa3, PK(l3, h3), od, 0, 0, 0);
#undef PK
}
__device__ __forceinline__ void pv_d0(f32x16* o, int vb, bf16x8 pa0, bf16x8 pa1, bf16x8 pa2, bf16x8 pa3) {
  pv_one<0>(o[0], vb, pa0, pa1, pa2, pa3); pv_one<1>(o[1], vb, pa0, pa1, pa2, pa3);
}
constexpr int LDP = 8 * 64, LDML = 8 * 2;
__device__ __forceinline__ void attn_unit(const bf16* __restrict__ Qb, const bf16* __restrict__ Kh, const bf16* __restrict__ Vh, float* __restrict__ Op, float* __restrict__ MLp, int seq, char* lds) {
  int tid = threadIdx.x; asm volatile("" : "+v"(tid));
  const int wid = tid >> 6, lane = tid & 63, r32 = lane & 31, hi = lane >> 5;
  char* V_lds = lds; char* K_lds = lds + 2 * SHM_V;
  float* wsf = (float*)(lds + 2 * SHM_V + 2 * SHM_K) + wid * 64; float* li_l = wsf; float* al_l = wsf + 32;
  float m_reg = -1e30f, l_reg = 0; f32x16 o[2] = {}; bf16x8 qr[DQK / 16];
  const bf16* Qw = Qb + (long)(wid * QBLK + r32) * LDQ + hi * 8;
#pragma unroll
  for (int d0 = 0; d0 < DQK / 16; ++d0) qr[d0] = *reinterpret_cast<const bf16x8*>(Qw + d0 * 16);
  const int sr = tid >> 4, sc = (tid & 15) * 8, vst0 = v_st(sr, sc & 63), vst1 = v_st(32 + sr, sc & 63);
  const bool doK = sc < DQK, doV = sc < DV;
  const int vb0 = (int)(uintptr_t)V_lds + v_rd_base(lane);
  struct { bf16x8 vs0, vs1, ks0, ks1; } sr_[2];
#define SLOAD(i, k0) do { if (doV) { sr_[i].vs0 = *reinterpret_cast<const bf16x8*>(&Vh[(long)((k0) + sr) * LDV + sc]); sr_[i].vs1 = *reinterpret_cast<const bf16x8*>(&Vh[(long)((k0) + 32 + sr) * LDV + sc]); } \
    if (doK) { sr_[i].ks0 = *reinterpret_cast<const bf16x8*>(&Kh[(long)((k0) + sr) * LDK + sc]); sr_[i].ks1 = *reinterpret_cast<const bf16x8*>(&Kh[(long)((k0) + 32 + sr) * LDK + sc]); } } while (0)
#define SWRITE(b, i) do { if (doV) { *(bf16x8*)(V_lds + (b) * SHM_V + vst0) = sr_[i].vs0; *(bf16x8*)(V_lds + (b) * SHM_V + vst1) = sr_[i].vs1; } \
    if (doK) { const int kc = sc * 2; *(bf16x8*)(K_lds + (b) * SHM_K + KSWZ(sr, kc)) = sr_[i].ks0; *(bf16x8*)(K_lds + (b) * SHM_K + KSWZ(32 + sr, kc)) = sr_[i].ks1; } } while (0)
#define SWAIT() asm volatile("s_waitcnt vmcnt(4)" ::: "memory")
#define RESC(a) do { if (__any((a) < 1.f)) { if (hi == 0) al_l[r32] = (a); asm volatile("s_waitcnt lgkmcnt(0)" ::: "memory"); \
    _Pragma("unroll") for (int d = 0; d < 2; ++d) _Pragma("unroll") for (int r = 0; r < 16; ++r) o[d][r] *= al_l[crow(r, hi)]; } } while (0)
  f32x16 pA0, pA1, pB0, pB1; float mnA, mnB, alA, alB; bf16x8 pa0, pa1, pa2, pa3; const int NT = seq / KVBLK;
  constexpr int SE = 0, SO = 1;
  SLOAD(SE, 0); asm volatile("s_waitcnt vmcnt(0)" ::: "memory"); SWRITE(0, SE); __syncthreads();
  qkt(pA0, pA1, K_lds, qr, r32, hi); partialSM(pA0, pA1, m_reg, mnA, alA);
  SLOAD(SO, KVBLK); if (2 < NT) SLOAD(SE, 2 * KVBLK);
  SWAIT(); SWRITE(1, SO); __syncthreads();
  for (int j = 1; j + 1 < NT; j += 2) {
    SBAR(); qkt(pB0, pB1, K_lds + SHM_K, qr, r32, hi);
    finishSM(pA0, pA1, alA, l_reg, pa0, pa1, pa2, pa3); SBAR();
    SLOAD(SO, (j + 2) * KVBLK); SBAR();
    pv_d0(o, vb0, pa0, pa1, pa2, pa3); partialSM(pB0, pB1, m_reg, mnB, alB);
    __syncthreads(); SWAIT(); SWRITE(0, SE);
    RESC(alB); __syncthreads();
    SBAR(); qkt(pA0, pA1, K_lds, qr, r32, hi);
    finishSM(pB0, pB1, alB, l_reg, pa0, pa1, pa2, pa3); SBAR();
    if (j + 3 < NT) SLOAD(SE, (j + 3) * KVBLK); SBAR();
    pv_d0(o, vb0 + SHM_V, pa0, pa1, pa2, pa3); partialSM(pA0, pA1, m_reg, mnA, alA);
    __syncthreads(); SWAIT(); SWRITE(1, SO);
    RESC(alA); __syncthreads();
  }
  SBAR(); qkt(pB0, pB1, K_lds + SHM_K, qr, r32, hi);
  finishSM(pA0, pA1, alA, l_reg, pa0, pa1, pa2, pa3); SBAR();
  pv_d0(o, vb0, pa0, pa1, pa2, pa3); partialSM(pB0, pB1, m_reg, mnB, alB);
  __syncthreads(); RESC(alB);
  finishSM(pB0, pB1, alB, l_reg, pa0, pa1, pa2, pa3); SBAR();
  pv_d0(o, vb0 + SHM_V, pa0, pa1, pa2, pa3);
  __syncthreads();
  { float* st = (float*)lds + wid * (32 * 68);
#pragma unroll
    for (int r = 0; r < 16; ++r) { const int orow = crow(r, hi); st[orow * 68 + r32] = o[0][r]; st[orow * 68 + 32 + r32] = o[1][r]; }
    asm volatile("s_waitcnt lgkmcnt(0)" ::: "memory");
    float* op = Op + (long)(wid * QBLK + r32) * LDP + hi * 32;
#pragma unroll
    for (int j = 0; j < 8; ++j) *(f32x4*)(op + 4 * j) = *(const f32x4*)(st + r32 * 68 + hi * 32 + 4 * j);
    if (hi == 0) { float* mp = MLp + (long)(wid * QBLK + r32) * LDML; mp[0] = m_reg; mp[1] = l_reg; } }
  __syncthreads();
#undef SLOAD
#undef SWRITE
#undef SWAIT
#undef RESC
}
#undef KSWZ
#undef SBAR
}

__device__ __forceinline__ int queue_pull(Frame& F, gu32* heads, int nq, int nper, int myq) {
  volatile LAS int* slot = (volatile LAS int*)(F.lds + LDSCTL_OFF);
  if (F.tid == 0) { int got = -1;
    for (int k = 0; k < nq; ++k) { const int q = (myq + k) % nq;
      if (__hip_atomic_load(heads + 64 * q, RLX_AGENT) >= (unsigned)nper) continue;
      const unsigned i = __hip_atomic_fetch_add(heads + 64 * q, 1u, RLX_AGENT);
      if (i < (unsigned)nper) { got = q * nper + (int)i; break; } }
    *slot = got; }
  __syncthreads();
  const int r = __builtin_amdgcn_readfirstlane(*slot);
  __syncthreads();
  return r;
}
__device__ __forceinline__ void p3_attention(Frame& F, const Args& a, char* lds_generic, unsigned xcc, int qoff) {
  unsigned char* ws = F.ws;
  const bf16* QMp = (const bf16*)(ws + WS_QM); const bf16* KMp = (const bf16*)(ws + WS_KM); const bf16* VMp = (const bf16*)(ws + WS_VM); float* PO = (float*)(ws + WS_PO); float* PML = (float*)(ws + WS_PML);
#ifndef WAIT_MODE
#define WAIT_MODE 1
#endif
  bool waited = false; (void)waited;
  for (;;) {
    const int u = queue_pull(F, F.ctl + CW_Q + qoff, 8, 128, (int)(xcc & 7u));
    if (u < 0) break;
    const int bh = u >> 5, qb = (u >> 1) & 15, kh = u & 1, b = bh >> 3, h = bh & 7;
#if WAIT_MODE == 0
    if (F.tid == 0) { unsigned sp = 0;
      while (__hip_atomic_load(F.ctl + CW_RDY + 64 * b, RLX_AGENT) < 112u) { __builtin_amdgcn_s_sleep(2); if (++sp > (1u << 24)) break; }
      __builtin_amdgcn_fence(__ATOMIC_ACQUIRE, "agent"); }
    asm volatile("s_waitcnt vmcnt(0)" ::: "memory"); __syncthreads();
#else
    if (!waited) { waited = true;
      if (F.tid == 0) { unsigned sp = 0;
        for (int bb = 0; bb < 4; ++bb) while (__hip_atomic_load(F.ctl + CW_RDY + 64 * bb, RLX_AGENT) < 112u) { __builtin_amdgcn_s_sleep(2); if (++sp > (1u << 24)) break; }
        __builtin_amdgcn_fence(__ATOMIC_ACQUIRE, "agent"); }
      asm volatile("s_waitcnt vmcnt(0)" ::: "memory"); __syncthreads(); }
#endif
    const size_t row0 = (size_t)b * SEQ + qb * 256, key0 = (size_t)b * SEQ + kh * (SEQ / 2);
    mla::attn_unit(QMp + row0 * 768 + h * 96, KMp + key0 * 768 + h * 96, VMp + key0 * 512 + h * 64,
                   PO + ((size_t)kh * MTOK + row0) * 512 + h * 64, PML + ((size_t)kh * MTOK + row0) * 16 + h * 2, SEQ / 2, lds_generic);
  }
}
namespace mls {
using mla::crow; using mla::v_st; using mla::v_rd_base;
#define KSWZ(row, colB) ((row) * 256 + ((colB) ^ (((row) & 7) << 4)))
constexpr int OFF_QS = 0, OFF_KS = 16384, OFF_KP = 32768, OFF_VV = 49152, OFF_CT = 65536, OFF_SC = 98304, OFF_NB = 99328, OFF_NP = 100352, OFF_CH = 104448, OFF_WS = 105472;
template <int OFF> __device__ __forceinline__ s16x4 trr(int vb) { s16x4 r; asm volatile("ds_read_b64_tr_b16 %0, %1 offset:%2" : "=&v"(r) : "v"(vb), "i"(OFF) : "memory"); return r; }
#define PKF(L, H) (bf16x8){L[0], L[1], L[2], L[3], H[0], H[1], H[2], H[3]}
__device__ __forceinline__ void vfrags(int img, int d0, int lane, bf16x8 (&f)[4]) {
  const int vb = img + v_rd_base(lane) + d0 * 512;
  const s16x4 l0 = trr<0>(vb), h0 = trr<2048>(vb), l1 = trr<4096>(vb), h1 = trr<4096 + 2048>(vb), l2 = trr<8192>(vb), h2 = trr<8192 + 2048>(vb), l3 = trr<12288>(vb), h3 = trr<12288 + 2048>(vb);
  asm volatile("s_waitcnt lgkmcnt(0)" ::: "memory"); __builtin_amdgcn_sched_barrier(0);
  f[0] = PKF(l0, h0); f[1] = PKF(l1, h1); f[2] = PKF(l2, h2); f[3] = PKF(l3, h3);
}
__device__ __forceinline__ void pack_p(const f32x16& p0, const f32x16& p1, bf16x8& pa0, bf16x8& pa1, bf16x8& pa2, bf16x8& pa3) {
#define PK4(P, BASE, OUT) do { unsigned a0 = cvt_pk_bf16(P[BASE + 0], P[BASE + 1]), a1 = cvt_pk_bf16(P[BASE + 2], P[BASE + 3]);   \
    unsigned b0 = cvt_pk_bf16(P[BASE + 4], P[BASE + 5]), b1 = cvt_pk_bf16(P[BASE + 6], P[BASE + 7]);                              \
    auto r0 = __builtin_amdgcn_permlane32_swap(a0, b0, false, false); auto r1 = __builtin_amdgcn_permlane32_swap(a1, b1, false, false); \
    v4u w = {r0[0], r1[0], r0[1], r1[1]}; OUT = __builtin_bit_cast(bf16x8, w); } while (0)
  PK4(p0, 0, pa0); PK4(p0, 8, pa1); PK4(p1, 0, pa2); PK4(p1, 8, pa3);
#undef PK4
}
__device__ __forceinline__ float swap_add(float v) { auto rr = __builtin_amdgcn_permlane32_swap(__float_as_uint(v), __float_as_uint(v), false, false); return __uint_as_float(rr[0]) + __uint_as_float(rr[1]); }

__device__ __forceinline__ void mlstm_seq(int seq, unsigned char* ws, char* lds) {
  int tid = threadIdx.x; asm volatile("" : "+v"(tid));
  const int wid = __builtin_amdgcn_readfirstlane(tid >> 6), lane = tid & 63, r32 = lane & 31, hi = lane >> 5, rb = wid >> 2, cb = wid & 3;
  const int dir = seq & 1, h = (seq >> 1) & 3, b = seq >> 3;
  const bf16* QC = (const bf16*)(ws + WS_QC); const bf16* KC = (const bf16*)(ws + WS_KC); const bf16* P = (const bf16*)(ws + WS_PROJ);
  const float* gs = (const float*)(ws + WS_GSC) + (size_t)seq * 3 * SEQ; const float* dec = (const float*)(ws + WS_DEC) + seq * 128;
  bf16* H = (bf16*)(ws + (dir ? WS_HB : WS_HF));
  float* sc_alpha = (float*)(lds + OFF_SC); float* sc_a = sc_alpha + 64; float* sc_iw = sc_alpha + 128; float* sc_en = sc_alpha + 192;
  float* nbuf = (float*)(lds + OFF_NB); float* npart = (float*)(lds + OFF_NP);
  float* ch_mprev = (float*)(lds + OFF_CH); float* ch_mnew = ch_mprev + 64; float* ch_dec = ch_mprev + 128; float* ch_g = ch_mprev + 192;
  float* wsf = (float*)(lds + OFF_WS) + wid * 32;
  const int ldsb = (int)(uintptr_t)lds;
  if (tid < 64) {
    if (tid == 0) { float m = 0.f; for (int c = 0; c < 64; ++c) { const float g = dec[c], wm = dec[64 + c]; const float mn = fmaxf(g + m, g + wm); ch_mprev[c] = m; ch_mnew[c] = mn; ch_dec[c] = __expf(g + m - mn); ch_g[c] = g; m = mn; } } }
  for (int i = tid; i < 32768 / 16; i += NTHR) ((v4u*)(lds + OFF_CT))[i] = (v4u){0u, 0u, 0u, 0u};
  if (tid < 128) nbuf[tid] = 0.f;
  f32x16 cacc[3]; cacc[0] = f32x16{}; cacc[1] = f32x16{}; cacc[2] = f32x16{};
  const int nown = rb ? 1 : 3;
  __syncthreads();
  const int sr = tid >> 4, sc = (tid & 15) * 8;
  v4u gq0, gq1, gk0, gk1, gv0, gv1; float ga0, ga1, sb = 0.f, sa = 0.f, spm = 0.f;
#define ROWOF(p) ((size_t)b * SEQ + (dir ? (SEQ - 1 - (p)) : (p)))
#define LOADC(c) do { const int p0_ = 64 * (c) + sr, p1_ = p0_ + 32; const size_t r0_ = ROWOF(p0_), r1_ = ROWOF(p1_); \
    gq0 = *(const v4u*)(QC + r0_ * 512 + h * 128 + sc); gq1 = *(const v4u*)(QC + r1_ * 512 + h * 128 + sc); \
    gk0 = *(const v4u*)(KC + r0_ * 512 + h * 128 + sc); gk1 = *(const v4u*)(KC + r1_ * 512 + h * 128 + sc); \
    gv0 = *(const v4u*)(P + r0_ * PROJ_LD + 1024 + h * 128 + sc); gv1 = *(const v4u*)(P + r1_ * PROJ_LD + 1024 + h * 128 + sc); \
    ga0 = gs[SEQ + p0_]; ga1 = gs[SEQ + p1_]; \
    if (tid < 64) { sb = gs[64 * (c) + tid]; sa = gs[SEQ + 64 * (c) + tid]; spm = gs[2 * SEQ + 64 * (c) + tid]; } } while (0)
#define WRITEC(c) do { \
    *(v4u*)(lds + OFF_QS + KSWZ(sr, sc * 2)) = gq0; *(v4u*)(lds + OFF_QS + KSWZ(32 + sr, sc * 2)) = gq1; \
    *(v4u*)(lds + OFF_KS + KSWZ(sr, sc * 2)) = gk0; *(v4u*)(lds + OFF_KS + KSWZ(32 + sr, sc * 2)) = gk1; \
    *(v4u*)(lds + OFF_VV + v_st(sr, sc)) = gv0; *(v4u*)(lds + OFF_VV + v_st(32 + sr, sc)) = gv1; \
    { const float gc_ = ch_g[c], mn_ = ch_mnew[c]; const float w0_ = __expf(gc_ + ga0 - mn_), w1_ = __expf(gc_ + ga1 - mn_); float f0_[8], f1_[8], cs_[8]; unpack8(gk0, f0_); unpack8(gk1, f1_); \
      _Pragma("unroll") for (int j = 0; j < 8; ++j) { f0_[j] *= w0_; f1_[j] *= w1_; cs_[j] = f0_[j] + f1_[j]; } \
      *(v4u*)(lds + OFF_KP + v_st(sr, sc)) = pack8(f0_); *(v4u*)(lds + OFF_KP + v_st(32 + sr, sc)) = pack8(f1_); \
      _Pragma("unroll") for (int j = 0; j < 8; ++j) { cs_[j] += __shfl_xor(cs_[j], 16); cs_[j] += __shfl_xor(cs_[j], 32); } \
      if ((lane >> 4) == 0) { _Pragma("unroll") for (int j = 0; j < 8; ++j) npart[wid * 128 + sc + j] = cs_[j]; } } \
    if (tid < 64) { const float m_ = ch_mprev[c]; const float mt_ = fmaxf(sb + m_, sb + spm); sc_alpha[tid] = sb - mt_; sc_a[tid] = sa; sc_iw[tid] = __expf(sb + m_ - mt_); sc_en[tid] = __expf(-mt_); } } while (0)
  LOADC(0); WRITEC(0);
  __syncthreads();
  for (int c = 0; c < 64; ++c) {
    if (c + 1 < 64) LOADC(c + 1);
    const float* nb = nbuf + (c & 1) * 128;
    if (tid < 128) { float s = 0.f;
#pragma unroll
      for (int w = 0; w < 8; ++w) s += npart[w * 128 + tid];
      nbuf[((c + 1) & 1) * 128 + tid] = ch_dec[c] * nb[tid] + s; }
    bf16x8 qr[8];
#pragma unroll
    for (int d0 = 0; d0 < 8; ++d0) qr[d0] = *(const bf16x8*)(lds + OFF_QS + KSWZ(32 * rb + r32, (16 * d0 + 8 * hi) * 2));
    f32x16 p0 = f32x16{}, p1 = f32x16{};
#pragma unroll
    for (int d0 = 0; d0 < 8; ++d0) { const bf16x8 k0 = *(const bf16x8*)(lds + OFF_KS + KSWZ(r32, (16 * d0 + 8 * hi) * 2)); p0 = __builtin_amdgcn_mfma_f32_32x32x16_bf16(k0, qr[d0], p0, 0, 0, 0); }
    if (rb == 1) {
#pragma unroll
      for (int d0 = 0; d0 < 8; ++d0) { const bf16x8 k1 = *(const bf16x8*)(lds + OFF_KS + KSWZ(32 + r32, (16 * d0 + 8 * hi) * 2)); p1 = __builtin_amdgcn_mfma_f32_32x32x16_bf16(k1, qr[d0], p1, 0, 0, 0); }
    }
    const float al = sc_alpha[32 * rb + r32];
    if (rb == 0) {
#pragma unroll
      for (int r = 0; r < 16; ++r) { const int sl = crow(r, hi); p0[r] = (sl <= r32) ? __expf(al + sc_a[sl]) * p0[r] : 0.f; }
    } else {
#pragma unroll
      for (int r = 0; r < 16; ++r) { const int sl = crow(r, hi); p0[r] = __expf(al + sc_a[sl]) * p0[r]; p1[r] = (sl <= r32) ? __expf(al + sc_a[32 + sl]) * p1[r] : 0.f; }
    }
    float ps = 0.f;
#pragma unroll
    for (int r = 0; r < 16; ++r) ps += p0[r] + p1[r];
    ps = swap_add(ps);
    bf16x8 pa0, pa1, pa2, pa3; pack_p(p0, p1, pa0, pa1, pa2, pa3);
    float qn = 0.f;
#pragma unroll
    for (int d0 = 0; d0 < 8; ++d0) { const f32x4 n0 = *(const f32x4*)(nb + 16 * d0 + 8 * hi), n1 = *(const f32x4*)(nb + 16 * d0 + 8 * hi + 4); const v4u qw = __builtin_bit_cast(v4u, qr[d0]);
      qn += bflo(qw.x) * n0.x + bfhi(qw.x) * n0.y + bflo(qw.y) * n0.z + bfhi(qw.y) * n0.w + bflo(qw.z) * n1.x + bfhi(qw.z) * n1.y + bflo(qw.w) * n1.z + bfhi(qw.w) * n1.w; }
    qn = swap_add(qn);
    { const float iwt = sc_iw[32 * rb + r32]; const float den = iwt * qn + ps; const float rd = 1.f / fmaxf(fabsf(den), sc_en[32 * rb + r32]); if (hi == 0) wsf[r32] = rd; }
    f32x16 o = f32x16{};
#pragma unroll
    for (int d0 = 0; d0 < 8; ++d0) { const bf16x8 cf = *(const bf16x8*)(lds + OFF_CT + KSWZ(32 * cb + r32, (16 * d0 + 8 * hi) * 2)); o = __builtin_amdgcn_mfma_f32_32x32x16_bf16(qr[d0], cf, o, 0, 0, 0); }
#pragma unroll
    for (int r = 0; r < 16; ++r) o[r] *= sc_iw[32 * rb + crow(r, hi)];
    bf16x8 vf[4]; vfrags(ldsb + OFF_VV, cb, lane, vf);
    o = __builtin_amdgcn_mfma_f32_32x32x16_bf16(pa0, vf[0], o, 0, 0, 0); o = __builtin_amdgcn_mfma_f32_32x32x16_bf16(pa1, vf[1], o, 0, 0, 0);
    if (rb == 1) { o = __builtin_amdgcn_mfma_f32_32x32x16_bf16(pa2, vf[2], o, 0, 0, 0); o = __builtin_amdgcn_mfma_f32_32x32x16_bf16(pa3, vf[3], o, 0, 0, 0); }
    asm volatile("s_waitcnt lgkmcnt(0)" ::: "memory");
#pragma unroll
    for (int r = 0; r < 16; ++r) { const int tl = crow(r, hi); const int p = 64 * c + 32 * rb + tl; H[ROWOF(p) * 512 + h * 128 + 32 * cb + r32] = (bf16)f2bf(o[r] * wsf[tl]); }
    { const float dc = ch_dec[c];
#pragma unroll
      for (int i = 0; i < 3; ++i) if (i < nown) { const int db = rb ? 3 : i; bf16x8 kf[4]; vfrags(ldsb + OFF_KP, db, lane, kf);
#pragma unroll
        for (int r = 0; r < 16; ++r) cacc[i][r] *= dc;
#pragma unroll
        for (int ks = 0; ks < 4; ++ks) cacc[i] = __builtin_amdgcn_mfma_f32_32x32x16_bf16(kf[ks], vf[ks], cacc[i], 0, 0, 0); } }
    __syncthreads();
#pragma unroll
    for (int i = 0; i < 3; ++i) if (i < nown) {
#pragma unroll
      for (int g = 0; g < 4; ++g) { const int d = 32 * (rb ? 3 : i) + 8 * g + 4 * hi, e = 32 * cb + r32;
        v2u w; w.x = cvt_pk_bf16(cacc[i][4 * g], cacc[i][4 * g + 1]); w.y = cvt_pk_bf16(cacc[i][4 * g + 2], cacc[i][4 * g + 3]);
        *(v2u*)(lds + OFF_CT + KSWZ(e, d * 2)) = w; } }
    if (c + 1 < 64) WRITEC(c + 1);
    __syncthreads();
  }
#undef ROWOF
#undef LOADC
#undef WRITEC
}
#undef KSWZ
#undef PKF
}

struct ListOrder { int n, L0, L1, nN, lda, ldb;
  __device__ bool next(int i, pg8::Unit& u) const { if (i >= n) return false; const int L = i ? L1 : L0; u.pm = L / nN; u.pn = L % nN; u.g = 0; u.ibase = 0;
    u.aoff = (long)u.pm * 256 * lda; u.boff = (long)u.pn * 256 * ldb; return true; } };
__device__ __forceinline__ void publish_units(Frame& F, const ListOrder& S) {
  if (F.tid == 0) { __builtin_amdgcn_fence(__ATOMIC_RELEASE, "agent"); asm volatile("s_waitcnt vmcnt(0)" ::: "memory");
    for (int i = 0; i < S.n; ++i) { const int L = i ? S.L1 : S.L0; __hip_atomic_fetch_add(F.ctl + CW_RDY + 64 * ((L / S.nN) >> 4), 1u, RLX_AGENT); } }
}
#ifndef P3_FILL_CHUNKS
#define P3_FILL_CHUNKS 3
#endif
__device__ __forceinline__ void p3_mixers(Frame& F, const Args& a, char* lds_generic, unsigned xcc, float* ssq, float* sskv, int qoff) {
  unsigned char* ws = F.ws; const int bx = (int)blockIdx.x;
#ifndef MLSTM_REPS
#define MLSTM_REPS 1
#endif
  if (bx < 32) { for (int rp = 0; rp < MLSTM_REPS; ++rp) { mls::mlstm_seq(bx, F.ws, lds_generic); __syncthreads(); } }
  else { const int c = bx - 32;
    { ListOrder S{c < 192 ? 1 : 0, c, 0, 3, PROJ_LD, 256};
      pg8::Gemm g{(const bf16*)(ws + WS_PROJ) + PC_CQ, (const bf16*)(ws + WS_WQB), PROJ_LD, 256, 256, nullptr, 127, 127};
      EpiQ E{(bf16*)(ws + WS_QM), ssq, (const float*)(ws + WS_ROPE)};
      pg8::gemm_phase<EpiQ, ListOrder, false>(F.lds, g, S, E); publish_units(F, S); }
    { ListOrder S{c >= 192 ? 2 : 1, c >= 192 ? c - 192 : c + 32, c + 32, 4, PROJ_LD, 256};
      pg8::Gemm g{(const bf16*)(ws + WS_PROJ) + PC_CKV, (const bf16*)(ws + WS_WKVB), PROJ_LD, 256, 256, nullptr, 127, 127};
      EpiKV E{(bf16*)(ws + WS_KM), (bf16*)(ws + WS_VM), sskv};
      pg8::gemm_phase<EpiKV, ListOrder, false>(F.lds, g, S, E); publish_units(F, S); }
  }
  p3_attention(F, a, lds_generic, xcc, qoff);
  if (bx >= 32 && !qoff) conv_fill(F, a, P3_FILL_CHUNKS);
}
__device__ __forceinline__ void p4_combine(Frame& F, const Args& a) {
  unsigned char* ws = F.ws; const bf16* HF = (const bf16*)(ws + WS_HF); const bf16* HB = (const bf16*)(ws + WS_HB); const bf16* P = (const bf16*)(ws + WS_PROJ); bf16* Y = (bf16*)(ws + WS_Y);
  const float* g = (const float*)a.in[I_GHM];
  const int gw = F.vcu * NWAVES + F.wave, NGW = F.G * NWAVES, c = F.lane * 8;
  float gg[8];
#pragma unroll
  for (int j = 0; j < 8; ++j) gg[j] = g[c + j];
  for (int m0 = gw; m0 < MTOK; m0 += 2 * NGW) {
    v4u wf[2], wb[2], wo[2];
#pragma unroll
    for (int u = 0; u < 2; ++u) { const size_t m = (size_t)(m0 + u * NGW); wf[u] = *(const v4u*)(HF + m * 512 + c); wb[u] = *(const v4u*)(HB + m * 512 + c); wo[u] = *(const v4u*)(P + m * PROJ_LD + 1536 + c); }
#pragma unroll
    for (int u = 0; u < 2; ++u) { const size_t m = (size_t)(m0 + u * NGW);
      float f[8], bb[8], oo[8]; unpack8(wf[u], f); unpack8(wb[u], bb); unpack8(wo[u], oo);
      float s = 0.f;
#pragma unroll
      for (int j = 0; j < 8; ++j) { f[j] += bb[j]; s += f[j] * f[j]; }
      s += __shfl_xor(s, 1); s += __shfl_xor(s, 2); s += __shfl_xor(s, 4); s += __shfl_xor(s, 8);
      const float r = rsqrtf(s * (1.f / 128.f) + 1e-6f);
#pragma unroll
      for (int j = 0; j < 8; ++j) f[j] = f[j] * r * gg[j] * sigmoidf_(oo[j]);
      *(v4u*)(Y + m * 1024 + c) = pack8(f); }
  }
  { const float* PO = (const float*)(ws + WS_PO); const float* PML = (const float*)(ws + WS_PML); const float* ga = (const float*)a.in[I_GHA];
    constexpr float C = 0.10206207261596575f * 1.4426950408889634f; const int hh = F.lane >> 3;
    float g8[8];
#pragma unroll
    for (int j = 0; j < 8; ++j) g8[j] = ga[c + j];
    for (int m = gw; m < MTOK; m += NGW) {
      const float* p0 = PO + (size_t)m * 512 + c; const float* p1 = p0 + (size_t)MTOK * 512;
      const f32x4 a0 = *(const f32x4*)p0, a1 = *(const f32x4*)(p0 + 4), b0 = *(const f32x4*)p1, b1 = *(const f32x4*)(p1 + 4);
      const float m0 = PML[(size_t)m * 16 + hh * 2], l0 = PML[(size_t)m * 16 + hh * 2 + 1], m1 = PML[((size_t)MTOK + m) * 16 + hh * 2], l1 = PML[((size_t)MTOK + m) * 16 + hh * 2 + 1];
      const float M = fmaxf(m0, m1), e0 = __builtin_amdgcn_exp2f((m0 - M) * C), e1 = __builtin_amdgcn_exp2f((m1 - M) * C); const float rl = 1.f / (l0 * e0 + l1 * e1);
      float f[8] = {a0.x * e0 + b0.x * e1, a0.y * e0 + b0.y * e1, a0.z * e0 + b0.z * e1, a0.w * e0 + b0.w * e1, a1.x * e0 + b1.x * e1, a1.y * e0 + b1.y * e1, a1.z * e0 + b1.z * e1, a1.w * e0 + b1.w * e1};
      float s = 0.f;
#pragma unroll
      for (int j = 0; j < 8; ++j) { f[j] *= rl; s += f[j] * f[j]; }
      s += __shfl_xor(s, 1); s += __shfl_xor(s, 2); s += __shfl_xor(s, 4);
      const float r = rsqrtf(s * (1.f / 64.f) + 1e-6f);
#pragma unroll
      for (int j = 0; j < 8; ++j) f[j] = f[j] * r * g8[j];
      *(v4u*)(Y + (size_t)m * 1024 + 512 + c) = pack8(f); } }
}
struct EpiResid { static constexpr bool TWO_PASS = false; const float* base; float* out; bf16* outb; float* ss; int doq; unsigned char* outq;
  __device__ __forceinline__ void row8(const pg8::Unit& u, int rloc, int cloc, const float (&a0)[8], const float (&a1)[8], int fq) const {
    const int row = u.pm * 256 + rloc; const size_t off = (size_t)row * 1024 + u.pn * 256 + cloc;
    const f32x4 b0 = *(const f32x4*)(base + off), b1 = *(const f32x4*)(base + off + 4), b2 = *(const f32x4*)(base + off + 128), b3 = *(const f32x4*)(base + off + 132);
    float v0[8], v1[8];
#pragma unroll
    for (int i = 0; i < 4; ++i) { v0[i] = a0[i] + b0[i]; v0[4 + i] = a0[4 + i] + b1[i]; v1[i] = a1[i] + b2[i]; v1[4 + i] = a1[4 + i] + b3[i]; }
    *(f32x4*)(out + off) = (f32x4){v0[0], v0[1], v0[2], v0[3]}; *(f32x4*)(out + off + 4) = (f32x4){v0[4], v0[5], v0[6], v0[7]};
    *(f32x4*)(out + off + 128) = (f32x4){v1[0], v1[1], v1[2], v1[3]}; *(f32x4*)(out + off + 132) = (f32x4){v1[4], v1[5], v1[6], v1[7]};
    float s = sumsq8(v0) + sumsq8(v1);
    if (doq) {
#pragma unroll
      for (int i = 0; i < 8; ++i) { v0[i] = q8(v0[i], 1.f); v1[i] = q8(v1[i], 1.f); } }
    *(v4u*)(outb + off) = pack8(v0); *(v4u*)(outb + off + 128) = pack8(v1); s += __shfl_xor(s, 16); s += __shfl_xor(s, 32); if (fq == 0) unsafeAtomicAdd(ss + row, s); } };
struct EpiScale { static constexpr bool TWO_PASS = false; bf16* O; const float* ss;
  __device__ __forceinline__ void row8(const pg8::Unit& u, int rloc, int cloc, const float (&a0)[8], const float (&a1)[8], int fq) const {
    const int row = u.pm * 256 + rloc; const float r = rsqrtf(ss[row] * (1.f / 1024.f) + 1e-6f); float v0[8], v1[8];
#pragma unroll
    for (int i = 0; i < 8; ++i) { v0[i] = a0[i] * r; v1[i] = a1[i] * r; }
    bf16* p = O + (size_t)row * 1024 + u.pn * 256 + cloc; *(v4u*)p = pack8(v0); *(v4u*)(p + 128) = pack8(v1); } };
struct EpiSoftmax { static constexpr bool TWO_PASS = true; bf16* O; float scale; LAS float* xch;
  __device__ __forceinline__ void pass1(const pg8::Unit& u, int rloc, int wc, float (&v0)[8], float (&v1)[8], int fq) const {
    float mx = -3.0e38f;
#pragma unroll
    for (int i = 0; i < 8; ++i) { v0[i] *= scale; v1[i] *= scale; mx = fmaxf(mx, fmaxf(v0[i], v1[i])); }
    mx = fmaxf(mx, __shfl_xor(mx, 16)); mx = fmaxf(mx, __shfl_xor(mx, 32));
    float l = 0.f;
#pragma unroll
    for (int i = 0; i < 8; ++i) { v0[i] = __expf(v0[i] - mx); v1[i] = __expf(v1[i] - mx); l += v0[i] + v1[i]; }
    l += __shfl_xor(l, 16); l += __shfl_xor(l, 32);
    if (fq == 0) { xch[(rloc * 4 + wc) * 2] = mx; xch[(rloc * 4 + wc) * 2 + 1] = l; } }
  __device__ __forceinline__ void row8(const pg8::Unit& u, int rloc, int cloc, const float (&a0)[8], const float (&a1)[8], int fq) const {
    const int wc = cloc >> 5; float m[4], l[4]; float M = -3.0e38f;
#pragma unroll
    for (int w = 0; w < 4; ++w) { m[w] = xch[(rloc * 4 + w) * 2]; l[w] = xch[(rloc * 4 + w) * 2 + 1]; M = fmaxf(M, m[w]); }
    float L = 0.f, mine = 0.f;
#pragma unroll
    for (int w = 0; w < 4; ++w) { const float e = __expf(m[w] - M); L += l[w] * e; if (w == wc) mine = e; }
    const float f = mine / L; float v0[8], v1[8];
#pragma unroll
    for (int i = 0; i < 8; ++i) { v0[i] = a0[i] * f; v1[i] = a1[i] * f; }
    bf16* p = O + (size_t)(u.pm * 256 + rloc) * 1024 + u.pn * 256 + cloc; *(v4u*)p = pack8(v0); *(v4u*)(p + 128) = pack8(v1); } };
struct MemOrder { int G, c, kind;
  __device__ bool next(int i, pg8::Unit& u) const { const int L = i * G + c; if (L >= 256) return false;
    const int bh = L >> 4, t = L & 15, b = bh >> 2, h = bh & 3;
    u.pm = b * 16 + t; u.pn = h; u.g = 0; u.ibase = 0; u.aoff = ((long)(b * SEQ + t * 256)) * 1024 + h * 256;
    u.boff = kind == 0 ? ((long)(b * NMEM)) * 1024 + h * 256 : ((long)(h * 256)) * 1024 + b * NMEM; return true; } };
constexpr size_t WS_WRG = WS_DEC + 65536;
constexpr size_t WS_ROWSEL = WS_SEL, WS_GSEL = WS_SEL + 131072, WS_INV = 31 * MiB, WS_YE = 160 * MiB;
typedef float f32x4m __attribute__((ext_vector_type(4)));
__device__ __forceinline__ void p10_router(Frame& F, const Args& a) {
  unsigned char* ws = F.ws; const float* X2 = (const float*)(ws + WS_X2); const float* ss2 = (const float*)(ws + CTL_SS2); float* AFF = (float*)(ws + WS_AFF); const float* WRG = (const float*)(ws + WS_WRG);
  const int gw = F.vcu * NWAVES + F.wave, NGW = F.G * NWAVES, r = F.lane & 15, kq = F.lane >> 4;
  LAS float* wl = (LAS float*)F.lds;
  for (int i = F.tid; i < 4096; i += NTHR) ((LAS f32x4*)wl)[i] = ((const f32x4*)WRG)[i];
  __syncthreads();
  for (int it = gw; it < MTOK / 16; it += NGW) { const int m0 = it * 16;
    const float* xp = X2 + (size_t)(m0 + r) * 1024 + 4 * kq; const LAS float* wp = wl + (4 * kq) * 16 + r;
    f32x4m acc0 = {0.f, 0.f, 0.f, 0.f}, acc1 = {0.f, 0.f, 0.f, 0.f};
#pragma unroll 1
    for (int hf = 0; hf < 2; ++hf) {
      f32x4 xv[32];
#pragma unroll
      for (int j = 0; j < 32; ++j) xv[j] = *(const f32x4*)(xp + 16 * (32 * hf + j));
#pragma unroll
      for (int j = 0; j < 32; j += 2) { const LAS float* w0 = wp + (16 * (32 * hf + j)) * 16; const LAS float* w1 = w0 + 256;
        acc0 = __builtin_amdgcn_mfma_f32_16x16x4f32(xv[j].x, w0[0], acc0, 0, 0, 0); acc1 = __builtin_amdgcn_mfma_f32_16x16x4f32(xv[j + 1].x, w1[0], acc1, 0, 0, 0);
        acc0 = __builtin_amdgcn_mfma_f32_16x16x4f32(xv[j].y, w0[16], acc0, 0, 0, 0); acc1 = __builtin_amdgcn_mfma_f32_16x16x4f32(xv[j + 1].y, w1[16], acc1, 0, 0, 0);
        acc0 = __builtin_amdgcn_mfma_f32_16x16x4f32(xv[j].z, w0[32], acc0, 0, 0, 0); acc1 = __builtin_amdgcn_mfma_f32_16x16x4f32(xv[j + 1].z, w1[32], acc1, 0, 0, 0);
        acc0 = __builtin_amdgcn_mfma_f32_16x16x4f32(xv[j].w, w0[48], acc0, 0, 0, 0); acc1 = __builtin_amdgcn_mfma_f32_16x16x4f32(xv[j + 1].w, w1[48], acc1, 0, 0, 0); }
    }
#pragma unroll
    for (int i = 0; i < 4; ++i) { const int row = m0 + 4 * kq + i; const float lg = (acc0[i] + acc1[i]) * rsqrtf(ss2[row] * (1.f / 1024.f) + 1e-6f);
      float mx = lg; mx = fmaxf(mx, __shfl_xor(mx, 1)); mx = fmaxf(mx, __shfl_xor(mx, 2)); mx = fmaxf(mx, __shfl_xor(mx, 4)); mx = fmaxf(mx, __shfl_xor(mx, 8));
      const float ex = __expf(lg - mx); float l = ex; l += __shfl_xor(l, 1); l += __shfl_xor(l, 2); l += __shfl_xor(l, 4); l += __shfl_xor(l, 8);
      AFF[(size_t)row * 16 + r] = ex / l; }
  }
  __syncthreads();
}
__device__ __forceinline__ void p11_topk(Frame& F, char* lds) {
  unsigned char* ws = F.ws; const float* AFF = (const float*)(ws + WS_AFF); int* ROWSEL = (int*)(ws + WS_ROWSEL); float* GSEL = (float*)(ws + WS_GSEL); int* INV = (int*)(ws + WS_INV);
  unsigned* hist = (unsigned*)lds; unsigned* ctl = hist + 256; unsigned* wsum = hist + 320;
  const int tid = F.tid, lane = F.lane, wid = F.wave;
  for (int it = (int)blockIdx.x; it < BATCH * NEXP; it += F.G) { const int b = it >> 4, e = it & 15;
    unsigned key[8];
#pragma unroll
    for (int j = 0; j < 8; ++j) key[j] = __float_as_uint(AFF[((size_t)b * SEQ + 8 * tid + j) * 16 + e]);
    unsigned prefix = 0u, mask = 0u, need = CAP;
    for (int shift = 24; shift >= 0; shift -= 8) {
      if (tid < 256) hist[tid] = 0u;
      __syncthreads();
#pragma unroll
      for (int j = 0; j < 8; ++j) if ((key[j] & mask) == prefix) atomicAdd(&hist[(key[j] >> shift) & 255u], 1u);
      __syncthreads();
      if (tid == 0) { unsigned above = 0u; int d = 255; for (; d > 0; --d) { const unsigned c = hist[d]; if (above + c >= need) break; above += c; } ctl[0] = (unsigned)d; ctl[1] = need - above; }
      __syncthreads();
      prefix |= ctl[0] << shift; mask |= 255u << shift; need = ctl[1];
      __syncthreads();
    }
    unsigned ngt = 0u, neq = 0u;
#pragma unroll
    for (int j = 0; j < 8; ++j) { ngt += key[j] > prefix ? 1u : 0u; neq += key[j] == prefix ? 1u : 0u; }
    unsigned sgt = ngt, seq_ = neq;
#pragma unroll
    for (int o = 1; o < 64; o <<= 1) { const unsigned y0 = __shfl_up(sgt, o), y1 = __shfl_up(seq_, o); if (lane >= o) { sgt += y0; seq_ += y1; } }
    if (lane == 63) { wsum[wid] = sgt; wsum[8 + wid] = seq_; }
    __syncthreads();
    unsigned bgt = 0u, beq = 0u, tgt = 0u;
#pragma unroll
    for (int w = 0; w < 8; ++w) { const unsigned g = wsum[w], q = wsum[8 + w]; if (w < wid) { bgt += g; beq += q; } tgt += g; }
    unsigned pgt = bgt + sgt - ngt, peq = beq + seq_ - neq;
#pragma unroll
    for (int j = 0; j < 8; ++j) { const int t = 8 * tid + j; int slot = -1;
      if (key[j] > prefix) slot = (int)pgt++; else if (key[j] == prefix) { if (peq < need) slot = (int)(tgt + peq); ++peq; }
      INV[((size_t)b * SEQ + t) * 16 + e] = slot;
      if (slot >= 0) { ROWSEL[e * 2048 + b * 512 + slot] = b * SEQ + t; GSEL[e * 2048 + b * 512 + slot] = __uint_as_float(key[j]); } }
    __syncthreads();
  }
}
#ifndef GU_ORDER
#define GU_ORDER 1
#endif
#ifndef DN_ORDER
#define DN_ORDER 1
#endif
struct MoeGUOrder { int G, c;
  __device__ bool next(int i, pg8::Unit& u) const { const int L = i * G + c; if (L >= 2048) return false;
#if GU_ORDER == 0
    const int e = L >> 7, r = L & 127, pn = r >> 3, mt = r & 7;
#elif GU_ORDER == 1
    const int e = L >> 7, r = L & 127, mt = r >> 4, pn = r & 15;
#else
    const int x = c & 7, j = c >> 3, e = (i >> 2) * 8 + x, r = (i & 3) * 32 + j, mt = r >> 4, pn = r & 15;
#endif
    u.g = e; u.pm = mt; u.pn = pn; u.ibase = e * 2048 + mt * 256; u.aoff = MOE_FP8 ? ((long)e * 2048 + mt * 256) * 512 : 0; u.boff = ((long)e * 4096 + pn * 256) * (MOE_FP8 ? 512 : 1024); return true; } };
struct MoeDownOrder { int G, c;
  __device__ bool next(int i, pg8::Unit& u) const { const int L = i * G + c; if (L >= 512) return false;
#if DN_ORDER == 0
    const int e = L >> 5, r = L & 31, pn = r >> 3, mt = r & 7;
#else
    const int x = c & 7, j = c >> 3, e = i * 8 + x, pn = j >> 3, mt = j & 7;
#endif
    u.g = e; u.pm = mt; u.pn = pn; u.ibase = e * 2048 + mt * 256; u.aoff = ((long)e * 2048 + mt * 256) * (MOE_FP8_DOWN ? 1024 : 2048); u.boff = ((long)e * 1024 + pn * 256) * (MOE_FP8_DOWN ? 1024 : 2048); return true; } };
struct EpiGU { static constexpr bool TWO_PASS = false; bf16* H; const float* ss2; const int* rowsel;
  __device__ __forceinline__ void row8(const pg8::Unit& u, int rloc, int cloc, const float (&a0)[8], const float (&a1)[8], int fq) const {
    const int tok = rowsel[u.ibase + rloc]; const float r = rsqrtf(ss2[tok] * (1.f / 1024.f) + 1e-6f); float h[8];
#pragma unroll
    for (int i = 0; i < 8; ++i) { const float g = a0[i] * r, up = a1[i] * r; h[i] = g * sigmoidf_(g) * up; if (FP8EMU) h[i] = q8(h[i], 8.f); }
#if MOE_FP8_DOWN
    *(v2u*)((unsigned char*)H + ((size_t)u.g * 2048 + u.pm * 256 + rloc) * 2048 + u.pn * 128 + cloc) = pack8_fp8(h, 8.f); } };
#else
    *(v4u*)(H + ((size_t)u.g * 2048 + u.pm * 256 + rloc) * 2048 + u.pn * 128 + cloc) = pack8(h); } };
#endif
struct EpiGU8 { static constexpr bool TWO_PASS = false; unsigned char* H8; const float* ss2; const int* rowsel;
  __device__ __forceinline__ void row8(const pg8::Unit& u, int rloc, int cloc, const float (&a0)[8], const float (&a1)[8], int fq) const {
    float h[8];
#pragma unroll
    for (int i = 0; i < 8; ++i) { const float g = a0[i], up = a1[i]; h[i] = g * sigmoidf_(g) * up; }
#if MOE_FP8_DOWN
    *(v2u*)(H8 + ((size_t)u.g * 2048 + u.pm * 256 + rloc) * 2048 + u.pn * 128 + cloc) = pack8_fp8(h, 8.f); } };
#else
    *(v4u*)((bf16*)H8 + ((size_t)u.g * 2048 + u.pm * 256 + rloc) * 2048 + u.pn * 128 + cloc) = pack8(h); } };
#endif
struct EpiYE { static constexpr bool TWO_PASS = false; bf16* Yp; const float* gsel;
  __device__ __forceinline__ void row8(const pg8::Unit& u, int rloc, int cloc, const float (&a0)[8], const float (&a1)[8], int fq) const {
    const float gv = gsel[u.ibase + rloc]; float v0[8], v1[8];
#pragma unroll
    for (int i = 0; i < 8; ++i) { v0[i] = a0[i] * gv; v1[i] = a1[i] * gv; }
    bf16* p = Yp + ((size_t)u.g * 2048 + u.pm * 256 + rloc) * 1024 + u.pn * 256 + cloc; *(v4u*)p = pack8(v0); *(v4u*)(p + 128) = pack8(v1); } };
__device__ __forceinline__ void p14_final(Frame& F, const Args& a) {
  unsigned char* ws = F.ws; const float* X2 = (const float*)(ws + WS_X2); const int* INV = (const int*)(ws + WS_INV); const bf16* YE = (const bf16*)(ws + WS_YE);
  const float* gfin = (const float*)a.in[I_GFIN]; float* out = a.out;
  const int gw = F.vcu * NWAVES + F.wave, NGW = F.G * NWAVES;
  f32x4 g[4];
#pragma unroll
  for (int j = 0; j < 4; ++j) g[j] = *(const f32x4*)(gfin + 256 * j + 4 * F.lane);
  for (int m0 = gw; m0 < MTOK; m0 += 2 * NGW) {
    f32x4 v[2][4]; int inv[2];
#pragma unroll
    for (int u = 0; u < 2; ++u) { const int m = m0 + u * NGW;
#pragma unroll
      for (int j = 0; j < 4; ++j) v[u][j] = *(const f32x4*)(X2 + (size_t)m * 1024 + 256 * j + 4 * F.lane);
      inv[u] = F.lane < 16 ? INV[(size_t)m * 16 + F.lane] : -1; }
#pragma unroll
    for (int u = 0; u < 2; ++u) { const int m = m0 + u * NGW, b = m >> 12;
      unsigned long long sel = __ballot(inv[u] >= 0);
      while (sel) { const int e = __builtin_ctzll(sel); sel &= sel - 1; const int slot = __shfl(inv[u], e);
        const bf16* yr = YE + ((size_t)e * 2048 + b * 512 + slot) * 1024 + 4 * F.lane;
#pragma unroll
        for (int j = 0; j < 4; ++j) { const v2u w = *(const v2u*)(yr + 256 * j); v[u][j].x += bflo(w.x); v[u][j].y += bfhi(w.x); v[u][j].z += bflo(w.y); v[u][j].w += bfhi(w.y); } }
      float s = 0.f;
#pragma unroll
      for (int j = 0; j < 4; ++j) s += (v[u][j].x * v[u][j].x + v[u][j].y * v[u][j].y) + (v[u][j].z * v[u][j].z + v[u][j].w * v[u][j].w);
      const float r = rsqrtf(wave_sum(s) * (1.f / 1024.f) + 1e-6f);
#pragma unroll
      for (int j = 0; j < 4; ++j) *(f32x4*)(out + (size_t)m * 1024 + 256 * j + 4 * F.lane) = v[u][j] * r * g[j]; }
  }
}
__global__ void __launch_bounds__(NTHR, 2) mk(Args a) {
  extern __shared__ __attribute__((aligned(16))) unsigned char lds_raw[];
  Frame F;
  F.lds = (LAS unsigned char*)lds_raw; F.MISC = (volatile LAS unsigned*)(F.lds + LDSCTL_OFF + 320);
  F.tid = threadIdx.x; F.lane = F.tid & 63; F.wave = __builtin_amdgcn_readfirstlane(F.tid >> 6);
  F.G = gridDim.x; { const int bx = blockIdx.x; F.vcu = (F.G % 8 == 0) ? (bx % 8) * (F.G / 8) + bx / 8 : bx; }
  F.ws = a.ws; F.ctl = (gu32*)(a.ws + WS_CTL);
  unsigned char* ws = a.ws;
  for (int u = F.tid; u < (LDS_BYTES - LDSCTL_OFF) / 4; u += NTHR) ((LAS unsigned*)(F.lds + LDSCTL_OFF))[u] = 0u;
  __syncthreads();
  XcdBarrier bar = xcd_barrier_post((unsigned*)(F.ctl + CW_BAR), F.MISC + 8);
  const int lo = a.ph_lo, hi = a.ph_hi;
#define IN(k) (lo <= (k) && (k) < hi)
#define BOTH(k) (IN(k) && IN((k) + 1))
#define GRID_BAR() xcd_barrier(bar)
  float* ssq = (float*)(ws + CTL_SSQ); float* sskv = (float*)(ws + CTL_SSKV);

#ifndef REP_MASK
#define REP_MASK 0
#endif
#define NREP(k) ((((REP_MASK) >> (k)) & 1) ? 2 : 1)
#define PH_BEGIN(k) if (IN(k)) { for (int rep_ = 0; rep_ < NREP(k); ++rep_) { const bool dry = rep_ + 1 < NREP(k); (void)dry;
#define PH_END(k) if (dry) GRID_BAR(); } if (BOTH(k)) GRID_BAR(); }
  float* dummy = (float*)(ws + WS_DUMMY);
  float* ss1 = (float*)(ws + CTL_SS1); float* ss2 = (float*)(ws + CTL_SS2);
#ifndef FILLMODE
#define FILLMODE 2
#endif
  PH_BEGIN(0) p0_prologue(F, a, true, FILLMODE == 0); PH_END(0)
  PH_BEGIN(1)
    { pg8::Gemm g{(const bf16*)(ws + WS_XN), (const bf16*)(ws + WS_WIN), 1024, 1024, 1024, nullptr, 127, 127}; pg8::StaticOrder S; S.init(MTOK, PROJ_LD, F.G, (int)blockIdx.x, 1024, 1024);
      EpiProj E{(bf16*)(ws + WS_PROJ), dry ? dummy : ssq, dry ? dummy + 16384 : sskv};
      pg8::gemm_phase<EpiProj, pg8::StaticOrder, false>(F.lds, g, S, E); }
    { pg8::Gemm g{(const bf16*)(ws + WS_MEMN), (const bf16*)(ws + WS_WMK), 1024, 1024, 1024, nullptr, 127, 127}; pg8::StaticOrder S; S.init(1024, 1024, F.G, (int)((blockIdx.x + 128u) % (unsigned)F.G), 1024, 1024);
      EpiStore E{(bf16*)(ws + WS_KMEM), 1024};
      pg8::gemm_phase<EpiStore, pg8::StaticOrder, false>(F.lds, g, S, E); }
    { pg8::Gemm g{(const bf16*)(ws + WS_WMV), (const bf16*)(ws + WS_MEMN), 1024, 1024, 1024, nullptr, 127, 127}; pg8::StaticOrder S; S.init(1024, 1024, F.G, (int)((blockIdx.x + 112u) % (unsigned)F.G), 1024, 1024);
      EpiStore E{(bf16*)(ws + WS_VMEMT), 1024};
      pg8::gemm_phase<EpiStore, pg8::StaticOrder, false>(F.lds, g, S, E); }
  PH_END(1)
  PH_BEGIN(2) p2_elementwise(F, a); PH_END(2)
  PH_BEGIN(3) p3_mixers(F, a, (char*)lds_raw, bar.x, ssq, sskv, dry ? 64 * 16 : 0); PH_END(3)
  PH_BEGIN(4) p4_combine(F, a); PH_END(4)
  PH_BEGIN(5)
    pg8::Gemm g{(const bf16*)(ws + WS_Y), (const bf16*)(ws + WS_WOUT), 1024, 1024, 1024, nullptr, 127, 127}; pg8::StaticOrder S; S.init(MTOK, 1024, F.G, (int)blockIdx.x, 1024, 1024);
    EpiResid E{(const float*)a.in[I_X], (float*)(ws + WS_X1), (bf16*)(ws + WS_X1B), dry ? dummy : ss1, 0, nullptr};
    pg8::gemm_phase<EpiResid, pg8::StaticOrder, false>(F.lds, g, S, E);
  PH_END(5)
  PH_BEGIN(6)
    pg8::Gemm g{(const bf16*)(ws + WS_X1B), (const bf16*)(ws + WS_WMQ), 1024, 1024, 1024, nullptr, 127, 127}; pg8::StaticOrder S; S.init(MTOK, 1024, F.G, (int)blockIdx.x, 1024, 1024);
    EpiScale E{(bf16*)(ws + WS_QMEM), ss1};
    pg8::gemm_phase<EpiScale, pg8::StaticOrder, false>(F.lds, g, S, E);
  PH_END(6)
  PH_BEGIN(7)
    pg8::Gemm g{(const bf16*)(ws + WS_QMEM), (const bf16*)(ws + WS_KMEM), 1024, 1024, 256, nullptr, 127, 127}; MemOrder S{F.G, (int)blockIdx.x, 0};
    EpiSoftmax E{(bf16*)(ws + WS_P), 0.0625f, (LAS float*)(F.lds + LDSCTL_OFF + 1024)};
    pg8::gemm_phase<EpiSoftmax, MemOrder, false>(F.lds, g, S, E);
  PH_END(7)
  PH_BEGIN(8)
    pg8::Gemm g{(const bf16*)(ws + WS_P), (const bf16*)(ws + WS_VMEMT), 1024, 1024, 256, nullptr, 127, 127}; MemOrder S{F.G, (int)blockIdx.x, 1};
    EpiStore E{(bf16*)(ws + WS_MO), 1024};
    pg8::gemm_phase<EpiStore, MemOrder, false>(F.lds, g, S, E);
  PH_END(8)
  PH_BEGIN(9)
    pg8::Gemm g{(const bf16*)(ws + WS_MO), (const bf16*)(ws + WS_WMO), 1024, 1024, 1024, nullptr, 127, 127}; pg8::StaticOrder S; S.init(MTOK, 1024, F.G, (int)blockIdx.x, 1024, 1024);
    EpiResid E{(const float*)(ws + WS_X1), (float*)(ws + WS_X2), (bf16*)(ws + WS_X2B), dry ? dummy : ss2, FP8EMU, nullptr};
    pg8::gemm_phase<EpiResid, pg8::StaticOrder, false>(F.lds, g, S, E);
  PH_END(9)
  PH_BEGIN(10) p10_router(F, a); PH_END(10)
  PH_BEGIN(11) p11_topk(F, (char*)lds_raw);
    if (!dry && FILLMODE != 0) conv_fill(F, a, 1 << 30);
  PH_END(11)
  PH_BEGIN(12)
#if MOE_FP8
    {
      const int gw = F.vcu * NWAVES + F.wave, NGW = F.G * NWAVES; const int* rs = (const int*)(ws + WS_ROWSEL);
      for (int r0 = gw; r0 < NEXP * 2048; r0 += 4 * NGW) {
        int tok[4]; float rn[4]; f32x4 q[4][4];
#pragma unroll
        for (int u = 0; u < 4; ++u) { const int r = r0 + u * NGW; tok[u] = r < NEXP * 2048 ? rs[r] : 0; }
#pragma unroll
        for (int u = 0; u < 4; ++u) { const float* xr = (const float*)(ws + WS_X2) + (size_t)tok[u] * 1024 + F.lane * 16; rn[u] = ss2[tok[u]];
#pragma unroll
          for (int j = 0; j < 4; ++j) q[u][j] = *(const f32x4*)(xr + 4 * j); }
#pragma unroll
        for (int u = 0; u < 4; ++u) { const int r = r0 + u * NGW; const float s = rsqrtf(rn[u] * (1.f / 1024.f) + 1e-6f);
          const f32x4 a0 = q[u][0] * s, a1 = q[u][1] * s, a2 = q[u][2] * s, a3 = q[u][3] * s;
          const float lo[8] = {a0.x, a0.y, a0.z, a0.w, a1.x, a1.y, a1.z, a1.w}, hi[8] = {a2.x, a2.y, a2.z, a2.w, a3.x, a3.y, a3.z, a3.w};
          const v2u a8 = pack8_fp8(lo, 1.f), b8 = pack8_fp8(hi, 1.f); v4u o; o.x = a8.x; o.y = a8.y; o.z = b8.x; o.w = b8.y;
          if (r < NEXP * 2048) *(v4u*)(ws + WS_XG + (size_t)r * 1024 + F.lane * 16) = o; } }
      GRID_BAR(); }
    pg8::Gemm g{(const bf16*)(ws + WS_XG), (const bf16*)(ws + WS_WEGU8), 512, 512, 512, nullptr, 127, 121}; MoeGUOrder S{F.G, (int)blockIdx.x};
    EpiGU8 E{(unsigned char*)(ws + WS_HID8), ss2, (const int*)(ws + WS_ROWSEL)};
    pg8::gemm_phase<EpiGU8, MoeGUOrder, false, 1>(F.lds, g, S, E);
#else
    pg8::Gemm g{(const bf16*)(ws + WS_X2B), (const bf16*)(ws + WS_WEGU), 1024, 1024, 1024, (const int*)(ws + WS_ROWSEL), 127, 127}; MoeGUOrder S{F.G, (int)blockIdx.x};
    EpiGU E{(bf16*)(ws + WS_HID), ss2, (const int*)(ws + WS_ROWSEL)};
    pg8::gemm_phase<EpiGU, MoeGUOrder, true>(F.lds, g, S, E);
#endif
  PH_END(12)
  PH_BEGIN(13)
#if MOE_FP8_DOWN
    pg8::Gemm g{(const bf16*)(ws + WS_HID8), (const bf16*)(ws + WS_WED8), 1024, 1024, 1024, nullptr, 124, 121}; MoeDownOrder S{F.G, (int)blockIdx.x};
    EpiYE E{(bf16*)(ws + WS_YE), (const float*)(ws + WS_GSEL)};
    pg8::gemm_phase<EpiYE, MoeDownOrder, false, 1>(F.lds, g, S, E);
#else
    pg8::Gemm g{(const bf16*)(ws + WS_HID), (const bf16*)(ws + WS_WED), 2048, 2048, 2048, nullptr, 127, 127}; MoeDownOrder S{F.G, (int)blockIdx.x};
    EpiYE E{(bf16*)(ws + WS_YE), (const float*)(ws + WS_GSEL)};
    pg8::gemm_phase<EpiYE, MoeDownOrder, false>(F.lds, g, S, E);
#endif
  PH_END(13)
  PH_BEGIN(14) p14_final(F, a); PH_END(14)
#undef IN
#undef BOTH
#undef GRID_BAR
}

__global__ __launch_bounds__(256) void adapt_b2f(const bf16* src, long lds_, long scol, float* dst, long ldd, long dcol, long rows, long ncols) {
  const long i = blockIdx.x * 256L + threadIdx.x; if (i >= rows * ncols) return;
  const long r = i / ncols, c = i % ncols; dst[r * ldd + dcol + c] = bf2f(src[r * lds_ + scol + c]);
}
static void adapt(hipStream_t s, const void* src, long lds_, long scol, float* dst, long ldd, long dcol, long rows, long ncols) {
  hipLaunchKernelGGL(adapt_b2f, dim3((unsigned)((rows * ncols + 255) / 256)), dim3(256), 0, s, (const bf16*)src, lds_, scol, dst, ldd, dcol, rows, ncols);
}

static int mk_grid() {
  static int grid = 0;
  if (grid == 0) {
    int dev = 0, cus = 0, per_cu = 0;
    (void)hipGetDevice(&dev); (void)hipDeviceGetAttribute(&cus, hipDeviceAttributeMultiprocessorCount, dev);
    (void)hipFuncSetAttribute((const void*)mk, hipFuncAttributeMaxDynamicSharedMemorySize, LDS_BYTES);
    (void)hipOccupancyMaxActiveBlocksPerMultiprocessor(&per_cu, (const void*)mk, NTHR, LDS_BYTES);
    (void)hipGetLastError();
    grid = cus > 0 ? cus : 256;
  }
  return grid;
}
static void mk_launch(hipStream_t s, void* const* d_in, void* d_out, void* d_ws, int lo, int hi, int flags) {
  Args a; memset(&a, 0, sizeof(a));
  for (int i = 0; i < 26; ++i) a.in[i] = d_in[i];
  a.out = (float*)d_out; a.ws = (unsigned char*)d_ws; a.ph_lo = lo; a.ph_hi = hi; a.flags = flags; a.pad = 0;
  (void)hipMemsetAsync((char*)d_ws + WS_CTL + CW_BAR * 4, 0, XCD_BAR_WORDS * 4, s);
  hipLaunchKernelGGL(mk, dim3(mk_grid()), dim3(NTHR), LDS_BYTES, s, a);
}

extern "C" void kernel_launch(void* const* d_in, const int* in_sizes, int n_in, void* d_out, int out_size, void* d_ws, size_t ws_size, hipStream_t s) {
  (void)hipMemsetAsync((char*)d_ws + WS_CTL, 0, CTL_ZERO_BYTES, s);
  mk_launch(s, d_in, d_out, d_ws, 0, 15, 1);
}
```

```cpp
#include <hip/hip_runtime.h>
#include <cstdint>
#include <cstdio>
#include <cstring>

constexpr int BATCH = 4, SEQ = 4096, DM = 1024, MTOK = BATCH * SEQ;
constexpr int D_IN = 2480;
constexpr int OFF_QM = 0, OFF_KM = 512, OFF_VM = 1024, OFF_OM = 1536, OFF_G = 2048, OFF_CQ = 2064, OFF_CKV = 2320, OFF_KR = 2448;
constexpr int NEXP = 16, CAP = 512, DFF = 2048, NMEM = 256;
constexpr size_t MiB = 1u << 20;
enum { I_X = 0, I_MEM, I_POS, I_GMIX, I_WIN, I_BG, I_CONV, I_GQA, I_WQB, I_GKVA, I_WKVB, I_GHM, I_GHA, I_WOUT, I_GMX, I_GMKV, I_WMQ, I_WMK, I_WMV, I_WMO, I_GFFN, I_WR, I_WEG, I_WEU, I_WED, I_GFIN };
#define GAS __attribute__((address_space(1)))
#define LAS __attribute__((address_space(3)))
typedef unsigned short bf16;
typedef unsigned v4u __attribute__((ext_vector_type(4)));
typedef unsigned v2u __attribute__((ext_vector_type(2)));
typedef float f32x4 __attribute__((ext_vector_type(4)));
typedef float f32x16 __attribute__((ext_vector_type(16)));
typedef short bf16x8 __attribute__((ext_vector_type(8)));
typedef short s16x4 __attribute__((ext_vector_type(4)));
typedef GAS unsigned gu32;
#define RLX_AGENT __ATOMIC_RELAXED, __HIP_MEMORY_SCOPE_AGENT
#define LDS_WAIT() asm volatile("s_waitcnt lgkmcnt(0)" ::: "memory")
#define VM_WAIT() asm volatile("s_waitcnt vmcnt(0)" ::: "memory")
constexpr int NWAVES = 8, NTHR = 512;
__device__ __forceinline__ unsigned f2bf(float f) { unsigned u = __builtin_bit_cast(unsigned, f); return (u + 0x7fffu + ((u >> 16) & 1u)) >> 16; }
__device__ __forceinline__ unsigned pk2(float lo, float hi) { return f2bf(lo) | (f2bf(hi) << 16); }
__device__ __forceinline__ float bf2f(unsigned short h) { return __builtin_bit_cast(float, (unsigned)h << 16); }
__device__ __forceinline__ float bflo(unsigned w) { return __builtin_bit_cast(float, w << 16); }
__device__ __forceinline__ float bfhi(unsigned w) { return __builtin_bit_cast(float, w & 0xffff0000u); }
typedef float f32x2_t __attribute__((ext_vector_type(2))); typedef __bf16 bf16x2_t __attribute__((ext_vector_type(2)));
__device__ __forceinline__ unsigned cvt_pk_bf16(float lo, float hi) { f32x2_t v = {lo, hi}; bf16x2_t b = __builtin_convertvector(v, bf16x2_t); return __builtin_bit_cast(unsigned, b); }
__device__ __forceinline__ v2u pack8_fp8(const float (&v)[8], float sc) { float c[8];
#pragma unroll
  for (int i = 0; i < 8; ++i) c[i] = __builtin_amdgcn_fmed3f(v[i] * sc, -448.f, 448.f);
  int a = 0, b = 0; a = __builtin_amdgcn_cvt_pk_fp8_f32(c[0], c[1], a, false); a = __builtin_amdgcn_cvt_pk_fp8_f32(c[2], c[3], a, true);
  b = __builtin_amdgcn_cvt_pk_fp8_f32(c[4], c[5], b, false); b = __builtin_amdgcn_cvt_pk_fp8_f32(c[6], c[7], b, true); v2u r; r.x = (unsigned)a; r.y = (unsigned)b; return r; }
__device__ __forceinline__ float q8(float x, float sc) { const int p = __builtin_amdgcn_cvt_pk_fp8_f32(x * sc, 0.f, 0, false); return __builtin_amdgcn_cvt_f32_fp8(p, 0) * (1.f / sc); }
__device__ __forceinline__ float wave_sum(float v) {
#pragma unroll
  for (int o = 1; o < 64; o <<= 1) v += __shfl_xor(v, o);
  return v;
}
__device__ __forceinline__ float sigmoidf_(float x) { return 1.f / (1.f + __expf(-x)); }

#define XB_TMO      128
#define XB_XCNT(j)  (256  + 64 * (j))
#define XB_XSUB(j)  (1280 + 64 * (j))
#define XB_XGEN(j)  (2304 + 64 * (j))
#define XB_TOP      3328
#define XB_TOPGEN   3392
#define XCD_BAR_WORDS 3456
#define XB_SPIN_CAP (1u << 22)
__device__ __forceinline__ unsigned xb_ld(unsigned* p)              { return __hip_atomic_load(p, __ATOMIC_RELAXED, __HIP_MEMORY_SCOPE_AGENT); }
__device__ __forceinline__ unsigned xb_add(unsigned* p, unsigned v) { return __hip_atomic_fetch_add(p, v, __ATOMIC_RELAXED, __HIP_MEMORY_SCOPE_AGENT); }
__device__ __forceinline__ unsigned xb_xcc_id() { return (unsigned)__builtin_amdgcn_s_getreg((3 << 11) | 20) & 0xFu; }
#define XB_SPIN(cond, bar) do { unsigned _sp = 0; while (cond) { __builtin_amdgcn_s_sleep(1); \
    if ((++_sp & 255u) == 0u) { if (xb_ld(&(bar)[XB_TMO])) break; if (_sp > XB_SPIN_CAP) { atomicAdd(&(bar)[XB_TMO], 1u); break; } } } } while (0)
struct XcdBarrier { unsigned* bar; unsigned x; volatile LAS unsigned* st; };
__device__ __forceinline__ XcdBarrier xcd_barrier_post(unsigned* bar, volatile LAS unsigned* st) {
  XcdBarrier b; b.bar = bar; b.x = xb_xcc_id(); b.st = st;
  if (threadIdx.x == 0) (void)xb_add(&bar[XB_XCNT(b.x)], 1u);
  return b;
}
__device__ __forceinline__ void xcd_barrier_complete(unsigned* bar, unsigned x, unsigned& nloc, unsigned& nx) {
  const unsigned G = gridDim.x * gridDim.y * gridDim.z;
  unsigned sum, cnt, mine, sp = 0u;
  for (;;) {
    sum = 0u; cnt = 0u; mine = 0u;
#pragma unroll
    for (unsigned j = 0; j < 16; ++j) { const unsigned c = xb_ld(&bar[XB_XCNT(j)]); sum += c; cnt += (c > 0u) ? 1u : 0u; mine = (j == x) ? c : mine; }
    if (sum == G) break;
    __builtin_amdgcn_s_sleep(1);
    if ((++sp & 255u) == 0u) { if (xb_ld(&bar[XB_TMO])) break; if (sp > XB_SPIN_CAP) { atomicAdd(&bar[XB_TMO], 1u); break; } }
  }
  nloc = mine > 0u ? mine : 1u; nx = cnt > 0u ? cnt : 1u;
}
__device__ __forceinline__ void xcd_barrier(const XcdBarrier& b) {
  asm volatile("s_waitcnt vmcnt(0)" ::: "memory");
  __syncthreads();
  if (threadIdx.x == 0) {
    unsigned* bar = b.bar;
    __builtin_amdgcn_s_waitcnt(0);
    unsigned nloc = b.st[0], nx = b.st[1];
    if (nloc == 0u) { xcd_barrier_complete(bar, b.x, nloc, nx); b.st[0] = nloc; b.st[1] = nx; }
    const unsigned old = xb_add(&bar[XB_XSUB(b.x)], 1u);
    const unsigned gen = old / nloc;
    if (old + 1u == (gen + 1u) * nloc) {
      __builtin_amdgcn_fence(__ATOMIC_RELEASE, "agent");
      asm volatile("s_waitcnt vmcnt(0)" ::: "memory");
      const unsigned og = xb_add(&bar[XB_TOP], 1u);
      const unsigned tg = og / nx;
      if (og + 1u == (tg + 1u) * nx) xb_add(&bar[XB_TOPGEN], 1u);
      else XB_SPIN(xb_ld(&bar[XB_TOPGEN]) == tg, bar);
      __builtin_amdgcn_fence(__ATOMIC_ACQUIRE, "agent");
      xb_add(&bar[XB_XGEN(b.x)], 1u);
      asm volatile("s_waitcnt vmcnt(0)" ::: "memory");
    } else {
      XB_SPIN(xb_ld(&bar[XB_XGEN(b.x)]) == gen, bar);
      __builtin_amdgcn_fence(__ATOMIC_ACQUIRE, "agent");
      asm volatile("s_waitcnt vmcnt(0)" ::: "memory");
    }
  }
  __syncthreads();
}

namespace pg8 {
constexpr int BM = 256, BK = 64, HALF = 128, HTB = HALF * BK * 2, STAGE_BYTES = 8 * HTB, NXCD = 8, WGM = 8;
__host__ __device__ __forceinline__ int lds_byte(int r, int c) { const int st = (r >> 4) * 2 + (c >> 5), rr = r & 15, cc = c & 31, ob = rr * 64 + cc * 2; return st * 1024 + (ob ^ (((ob >> 9) & 1) << 5)); }
__host__ __device__ __forceinline__ void stage_rc(int b, int& R, int& C) { const int st = b / 1024, sb = b % 1024, swz = sb ^ (((sb >> 9) & 1) << 5); R = (st >> 1) * 16 + swz / 64; C = (st & 1) * 32 + (swz % 64) / 2; }
__host__ __device__ __forceinline__ int perm32(int rho) { const int n = rho >> 4, i = rho & 15; return 8 * (i >> 2) + 4 * n + (i & 3); }

struct Unit { long aoff, boff; int pm, pn, g, ibase; };
struct Gemm { const bf16* A; const bf16* Bt; int lda, ldb, K; const int* gidx; int sa, sb; };
typedef int v8i_t __attribute__((ext_vector_type(8))); typedef int v4i_t __attribute__((ext_vector_type(4)));
__device__ __forceinline__ v8i_t cat8(bf16x8 lo, bf16x8 hi) { const v4i_t a = __builtin_bit_cast(v4i_t, lo), b = __builtin_bit_cast(v4i_t, hi); return __builtin_shufflevector(a, b, 0, 1, 2, 3, 4, 5, 6, 7); }

struct StaticOrder {
  int nM, nN, nwg, G, c, lda, ldb;
  __device__ void init(int M, int N, int G_, int c_, int lda_, int ldb_) { nM = M / BM; nN = N / BM; nwg = nM * nN; G = G_; c = c_; lda = lda_; ldb = ldb_; }
  __device__ bool next(int i, Unit& u) const {
    const long L = (long)i * G + c; if (L >= nwg) return false;
    int wgid = (int)L; { const int q = nwg / NXCD, r = nwg % NXCD, xcd = wgid % NXCD, off = wgid / NXCD; wgid = (xcd < r ? xcd * (q + 1) : r * (q + 1) + (xcd - r) * q) + off; }
    const int nig = WGM * nN, gid = wgid / nig, fm = gid * WGM, gsz = (nM - fm) < WGM ? (nM - fm) : WGM;
    u.pm = fm + ((wgid % nig) % gsz); u.pn = (wgid % nig) / gsz; u.g = 0; u.ibase = 0;
    u.aoff = (long)u.pm * BM * lda; u.boff = (long)u.pn * BM * ldb; return true;
  }
};

template <class Epi, class Sched, bool GATHER, int FP8 = 0>
__device__ __forceinline__ void gemm_phase(LAS unsigned char* lds, const Gemm g, const Sched& S, const Epi& E) {
  int tid = threadIdx.x; asm volatile("" : "+v"(tid));
  const int wid = __builtin_amdgcn_readfirstlane(tid >> 6), lane = tid & 63, wr = wid >> 2, wc = wid & 3, fr = lane & 15, fq = lane >> 4;
  const int K = g.K, nt = K / BK;
  int Rs[2], Cs[2]; unsigned voffB[2];
#pragma unroll
  for (int i = 0; i < 2; ++i) { int R, C; stage_rc(tid * 16 + i * 8192, R, C); Rs[i] = R; Cs[i] = C; const int Rb = (R & ~31) + perm32(R & 31); voffB[i] = (unsigned)(Rb * g.ldb + C) * 2u; }
  const size_t kstep = (size_t)(BK * 2);
  const size_t hstepB = (size_t)HALF * g.ldb * 2;
  const unsigned ldsw = (unsigned)wid * 1024u;
  const int aoff_l = lds_byte(wr * 64 + fr, FP8 ? fq * 16 : fq * 8), boff_l = lds_byte(wc * 32 + fr, FP8 ? fq * 16 : fq * 8);
  constexpr int aoff_k = FP8 ? 16 : 1024, boff_k = FP8 ? 16 : 1024;
#define PG8_SA(b, h) (((b) * 2 + (h)) * HTB)
#define PG8_SB(b, h) ((4 + (b) * 2 + (h)) * HTB)
#define PG8_STAGE(bufoff, gbase, voff) do { _Pragma("unroll") for (int _i = 0; _i < 2; ++_i) \
        __builtin_amdgcn_global_load_lds((const unsigned*)((const char*)(gbase) + (voff)[_i]), (LAS unsigned*)(lds + (bufoff) + ldsw + _i * 8192), 16, 0, 0); } while (0)
#define PG8_LDA(dst, b, h) do { _Pragma("unroll") for (int m = 0; m < 4; ++m) { if constexpr (FP8) { const v4i_t lo_ = *(const LAS v4i_t*)(lds + PG8_SA(b, h) + aoff_l + m * 2048), hi_ = *(const LAS v4i_t*)(lds + PG8_SA(b, h) + aoff_l + m * 2048 + aoff_k); dst##8[m] = __builtin_shufflevector(lo_, hi_, 0, 1, 2, 3, 4, 5, 6, 7); } \
        else { _Pragma("unroll") for (int k = 0; k < 2; ++k) dst[m][k] = *(const LAS bf16x8*)(lds + PG8_SA(b, h) + aoff_l + m * 2048 + k * aoff_k); } } } while (0)
#define PG8_LDB(dst, b, h) do { _Pragma("unroll") for (int n = 0; n < 2; ++n) { if constexpr (FP8) { const v4i_t lo_ = *(const LAS v4i_t*)(lds + PG8_SB(b, h) + boff_l + n * 2048), hi_ = *(const LAS v4i_t*)(lds + PG8_SB(b, h) + boff_l + n * 2048 + boff_k); dst##8[n] = __builtin_shufflevector(lo_, hi_, 0, 1, 2, 3, 4, 5, 6, 7); } \
        else { _Pragma("unroll") for (int k = 0; k < 2; ++k) dst[n][k] = *(const LAS bf16x8*)(lds + PG8_SB(b, h) + boff_l + n * 2048 + k * boff_k); } } } while (0)
#define PG8_MMA(ai, bj, At, Bt) do { __builtin_amdgcn_s_setprio(1); _Pragma("unroll") for (int m = 0; m < 4; ++m) _Pragma("unroll") for (int n = 0; n < 2; ++n) { \
        if constexpr (FP8) asm volatile("v_mfma_scale_f32_16x16x128_f8f6f4 %0, %1, %2, %0, %3, %4 op_sel_hi:[0,0,0]" : "+v"(acc[ai][bj][m][n]) : "v"(Bt##8[n]), "v"(At##8[m]), "v"(vsb), "v"(vsa)); \
        else { _Pragma("unroll") for (int k = 0; k < 2; ++k) acc[ai][bj][m][n] = __builtin_amdgcn_mfma_f32_16x16x32_bf16(Bt[n][k], At[m][k], acc[ai][bj][m][n], 0, 0, 0); } } \
        __builtin_amdgcn_s_setprio(0); } while (0)
#define PG8_WAIT_V(n) asm volatile("s_waitcnt vmcnt(" #n ")" ::: "memory")
#define PG8_WAIT_L(n) asm volatile("s_waitcnt lgkmcnt(" #n ")" ::: "memory")
#define PG8_BAR __builtin_amdgcn_s_barrier()
#define PG8_SCHED __builtin_amdgcn_sched_barrier(0)
  Unit cur, nxt; int ui = 0;
  if (!S.next(0, cur)) return;
  unsigned vA[2][2], nvA[2][2];
  auto load_va = [&](const Unit& u, unsigned (&v)[2][2]) {
#pragma unroll
    for (int h = 0; h < 2; ++h)
#pragma unroll
      for (int i = 0; i < 2; ++i) {
        if constexpr (GATHER) v[h][i] = (unsigned)((long)g.gidx[u.ibase + h * HALF + Rs[i]] * g.lda + Cs[i]) * 2u;
        else v[h][i] = (unsigned)((h * HALF + Rs[i]) * g.lda + Cs[i]) * 2u;
      }
  };
  load_va(cur, vA);
  f32x4 acc[2][2][4][2];
#pragma unroll
  for (int a = 0; a < 2; ++a)
#pragma unroll
    for (int b = 0; b < 2; ++b)
#pragma unroll
      for (int m = 0; m < 4; ++m)
#pragma unroll
        for (int n = 0; n < 2; ++n) acc[a][b][m][n] = (f32x4){0.f, 0.f, 0.f, 0.f};
  int vsa = g.sa, vsb = g.sb; (void)vsa; (void)vsb;
  bf16x8 At[4][2], B0[2][2], B1[2][2]; v8i_t At8[4], B08[2], B18[2];
  const char* cA = (const char*)g.A + (GATHER ? 0 : cur.aoff * 2); const char* cB = (const char*)g.Bt + cur.boff * 2;
  PG8_STAGE(PG8_SB(0, 0), cB, voffB); PG8_STAGE(PG8_SB(0, 1), cB + hstepB, voffB); PG8_STAGE(PG8_SA(0, 0), cA, vA[0]); PG8_STAGE(PG8_SA(0, 1), cA, vA[1]);
  if (wr == 1) PG8_BAR;
  PG8_WAIT_V(2); PG8_BAR;
  PG8_STAGE(PG8_SB(1, 0), cB + kstep, voffB); PG8_STAGE(PG8_SA(1, 0), cA + kstep, vA[0]); PG8_STAGE(PG8_SB(1, 1), cB + hstepB + kstep, voffB);
  PG8_WAIT_V(6); PG8_BAR;
  for (;;) {
    const bool has_next = S.next(ui + 1, nxt);
    const char* nA = has_next ? (const char*)g.A + (GATHER ? 0 : nxt.aoff * 2) : cA; const char* nB = has_next ? (const char*)g.Bt + nxt.boff * 2 : cB;
    if constexpr (GATHER) { if (has_next) load_va(nxt, nvA); else {
#pragma unroll
      for (int h = 0; h < 2; ++h)
#pragma unroll
        for (int i = 0; i < 2; ++i) nvA[h][i] = vA[h][i]; } }
#pragma unroll 1
    for (int t = 0; t < nt; t += 2) {
      const bool last = (t == nt - 2);
      const char* a1 = cA + (size_t)(t + 1) * kstep;
      const char* a2 = last ? nA : cA + (size_t)(t + 2) * kstep; const char* b2 = last ? nB : cB + (size_t)(t + 2) * kstep;
      const char* a3 = a2 + kstep; const char* b3 = b2 + kstep;
      unsigned w0[2], w1[2];
      if constexpr (GATHER) { w0[0] = last ? nvA[0][0] : vA[0][0]; w0[1] = last ? nvA[0][1] : vA[0][1]; w1[0] = last ? nvA[1][0] : vA[1][0]; w1[1] = last ? nvA[1][1] : vA[1][1]; }
      else { w0[0] = vA[0][0]; w0[1] = vA[0][1]; w1[0] = vA[1][0]; w1[1] = vA[1][1]; }
      PG8_LDB(B0, 0, 0); PG8_LDB(B1, 0, 1); PG8_SCHED; PG8_LDA(At, 0, 0); PG8_STAGE(PG8_SA(1, 1), a1, vA[1]);
      PG8_WAIT_V(8); PG8_WAIT_L(0); PG8_BAR; PG8_MMA(0, 0, At, B0); PG8_MMA(0, 1, At, B1); PG8_BAR; PG8_SCHED;
      PG8_LDA(At, 0, 1); PG8_STAGE(PG8_SB(0, 0), b2, voffB); PG8_STAGE(PG8_SB(0, 1), b2 + hstepB, voffB); PG8_STAGE(PG8_SA(0, 0), a2, w0);
      PG8_WAIT_V(8); PG8_WAIT_L(0); PG8_BAR; PG8_MMA(1, 0, At, B0); PG8_MMA(1, 1, At, B1); PG8_BAR; PG8_SCHED;
      PG8_LDB(B0, 1, 0); PG8_LDB(B1, 1, 1); PG8_SCHED; PG8_LDA(At, 1, 0); PG8_STAGE(PG8_SA(0, 1), a2, w1);
      PG8_WAIT_V(8); PG8_WAIT_L(0); PG8_BAR; PG8_MMA(0, 0, At, B0); PG8_MMA(0, 1, At, B1); PG8_BAR; PG8_SCHED;
      PG8_LDA(At, 1, 1); PG8_STAGE(PG8_SB(1, 0), b3, voffB); PG8_STAGE(PG8_SB(1, 1), b3 + hstepB, voffB); PG8_STAGE(PG8_SA(1, 0), a3, w0);
      PG8_WAIT_V(8); PG8_WAIT_L(0); PG8_BAR; PG8_MMA(1, 0, At, B0); PG8_MMA(1, 1, At, B1); PG8_BAR; PG8_SCHED;
    }
    if constexpr (FP8) { asm volatile("s_nop 15\n\ts_nop 15" ::: "memory"); __builtin_amdgcn_sched_barrier(0); }
    if (wr == 0) PG8_BAR;
    int fr_o = fr, fq_o = fq; asm volatile("" : "+v"(fr_o), "+v"(fq_o));
    if constexpr (Epi::TWO_PASS) {
#pragma unroll
      for (int ai = 0; ai < 2; ++ai)
#pragma unroll
        for (int m = 0; m < 4; ++m) {
          float v0[8], v1[8];
#pragma unroll
          for (int n = 0; n < 2; ++n)
#pragma unroll
            for (int j = 0; j < 4; ++j) { v0[n * 4 + j] = acc[ai][0][m][n][j]; v1[n * 4 + j] = acc[ai][1][m][n][j]; }
          E.pass1(cur, ai * HALF + wr * 64 + m * 16 + fr_o, wc, v0, v1, fq_o);
#pragma unroll
          for (int n = 0; n < 2; ++n)
#pragma unroll
            for (int j = 0; j < 4; ++j) { acc[ai][0][m][n][j] = v0[n * 4 + j]; acc[ai][1][m][n][j] = v1[n * 4 + j]; }
        }
      asm volatile("s_waitcnt lgkmcnt(0)" ::: "memory"); PG8_BAR; asm volatile("" ::: "memory");
    }
    {
#pragma unroll
      for (int ai = 0; ai < 2; ++ai)
#pragma unroll
        for (int m = 0; m < 4; ++m) {
          float v0[8], v1[8];
#pragma unroll
          for (int n = 0; n < 2; ++n)
#pragma unroll
            for (int j = 0; j < 4; ++j) { v0[n * 4 + j] = acc[ai][0][m][n][j]; v1[n * 4 + j] = acc[ai][1][m][n][j]; }
          E.row8(cur, ai * HALF + wr * 64 + m * 16 + fr_o, wc * 32 + 8 * fq_o, v0, v1, fq_o);
          asm volatile("" ::: "memory");
        }
    }
    if (!has_next) break;
#pragma unroll
    for (int a = 0; a < 2; ++a)
#pragma unroll
      for (int b = 0; b < 2; ++b)
#pragma unroll
        for (int m = 0; m < 4; ++m)
#pragma unroll
          for (int n = 0; n < 2; ++n) acc[a][b][m][n] = (f32x4){0.f, 0.f, 0.f, 0.f};
    cur = nxt; cA = nA; cB = nB; ++ui;
    if constexpr (GATHER) {
#pragma unroll
      for (int h = 0; h < 2; ++h)
#pragma unroll
        for (int i = 0; i < 2; ++i) vA[h][i] = nvA[h][i]; }
    if (wr == 1) PG8_BAR;
  }
  PG8_WAIT_V(0);
  PG8_BAR;
#undef PG8_SA
#undef PG8_SB
#undef PG8_STAGE
#undef PG8_LDA
#undef PG8_LDB
#undef PG8_MMA
#undef PG8_WAIT_V
#undef PG8_WAIT_L
#undef PG8_BAR
#undef PG8_SCHED
}
}
constexpr size_t WS_CTL = 0, CTL_ZERO_BYTES = 1 * MiB;
constexpr int CW_TMO = 0, CW_BAR = 4096, CW_Q = 8192;
constexpr size_t CTL_SSQ = 256 * 1024, CTL_SSKV = CTL_SSQ + 65536, CTL_SS1 = CTL_SSKV + 65536, CTL_SS2 = CTL_SS1 + 65536;
constexpr size_t WS_WIN = 1 * MiB, WS_WQB = 6 * MiB, WS_WKVB = 6 * MiB + 512 * 1024, WS_WOUT = 7 * MiB, WS_WMQ = 9 * MiB, WS_WMK = 11 * MiB, WS_WMV = 13 * MiB, WS_WMO = 15 * MiB;
constexpr size_t WS_ROPE = 17 * MiB, WS_MEMN = 19 * MiB, WS_KMEM = 21 * MiB, WS_VMEMT = 23 * MiB, WS_GSC = 25 * MiB, WS_DEC = 28 * MiB, WS_AFF = 29 * MiB, WS_SEL = 30 * MiB;
constexpr size_t WS_PROJ = 32 * MiB, WS_XN = 112 * MiB, WS_QC = 112 * MiB, WS_KC = 128 * MiB, WS_QM = 144 * MiB, WS_KM = 168 * MiB, WS_VM = 192 * MiB, WS_HF = 208 * MiB, WS_HB = 224 * MiB, WS_Y = 240 * MiB;
constexpr size_t WS_X1 = 112 * MiB, WS_X1B = 176 * MiB, WS_QMEM = 208 * MiB, WS_P = 240 * MiB, WS_MO = 176 * MiB, WS_X2 = 240 * MiB, WS_X2B = 208 * MiB, WS_HID = 32 * MiB;
constexpr size_t WS_DUMMY = 304 * MiB;
constexpr size_t WS_WEGU = 320 * MiB, WS_WED = 448 * MiB, WS_END = 512 * MiB;
constexpr int PROJ_LD = 2560;
constexpr int PC_CQ = 2048, PC_CKV = 2304, PC_KR = 2432, PC_G = 2464;
constexpr int RING_BYTES = 131072, LDSCTL_OFF = 133120, LDS_BYTES = 147456;

struct Args { const void* in[26]; float* out; unsigned char* ws; int ph_lo, ph_hi, flags, pad; };

struct Frame {
  LAS unsigned char* lds; volatile LAS unsigned* MISC; gu32* ctl; unsigned char* ws;
  int tid, lane, wave, vcu, G;
};

__device__ __forceinline__ void p0_tr(const float* W, int ldw, int k0, int kvalid, int scol0, int ncols, const float* gs, bf16* WT, int ldt, int drow0, LAS float* scr, int lane, bool doq = false) {
  const int c4 = (lane & 15) * 4, kr = lane >> 4;
  f32x4 v[16];
#pragma unroll
  for (int i = 0; i < 16; ++i) { const int kk = 4 * i + kr; v[i] = (f32x4){0.f, 0.f, 0.f, 0.f};
    if (c4 < ncols && k0 + kk < kvalid) { v[i] = *(const f32x4*)(W + (size_t)(k0 + kk) * ldw + scol0 + c4); if (gs) v[i] = v[i] * gs[k0 + kk];
      if (doq) { v[i].x = q8(v[i].x, 64.f); v[i].y = q8(v[i].y, 64.f); v[i].z = q8(v[i].z, 64.f); v[i].w = q8(v[i].w, 64.f); } } }
#pragma unroll
  for (int i = 0; i < 16; ++i) { const int kk = 4 * i + kr; LAS float* d = scr + kk * 65 + c4; d[0] = v[i].x; d[1] = v[i].y; d[2] = v[i].z; d[3] = v[i].w; }
  LDS_WAIT(); asm volatile("" ::: "memory");
  const int c = lane & 7;
#pragma unroll
  for (int j = 0; j < 8; ++j) { const int n = (lane >> 3) + 8 * j; const LAS float* s = scr + (8 * c) * 65 + n;
    v4u o; o.x = pk2(s[0 * 65], s[1 * 65]); o.y = pk2(s[2 * 65], s[3 * 65]); o.z = pk2(s[4 * 65], s[5 * 65]); o.w = pk2(s[6 * 65], s[7 * 65]);
    *(GAS v4u*)(WT + (size_t)(drow0 + n) * ldt + k0 + 8 * c) = o; }
  LDS_WAIT(); asm volatile("" ::: "memory");
}
struct ConvDesc { const float* W; const float* gs; unsigned char* WT8; int ldw, k0, scol0, ldt, drow0; };
__device__ __forceinline__ void p0_tr8_load(const ConvDesc& d, f32x4 (&v)[16], int lane) {
  const int c4 = (lane & 15) * 4, kr = lane >> 4;
#pragma unroll
  for (int i = 0; i < 16; ++i) { const int kk = 4 * i + kr; v[i] = *(const f32x4*)(d.W + (size_t)(d.k0 + kk) * d.ldw + d.scol0 + c4); }
}
__device__ __forceinline__ void p0_tr8_finish(const ConvDesc& d, f32x4 (&v)[16], float sc, LAS float* scr, int lane) {
  const int c4 = (lane & 15) * 4, kr = lane >> 4;
#pragma unroll
  for (int i = 0; i < 16; ++i) { const int kk = 4 * i + kr; f32x4 x = v[i]; if (d.gs) x = x * d.gs[d.k0 + kk]; LAS float* p = scr + kk * 65 + c4; p[0] = x.x; p[1] = x.y; p[2] = x.z; p[3] = x.w; }
  LDS_WAIT(); asm volatile("" ::: "memory");
  const int c = lane & 7;
#pragma unroll
  for (int j = 0; j < 8; ++j) { const int n = (lane >> 3) + 8 * j; const LAS float* s = scr + (8 * c) * 65 + n;
    float f[8];
#pragma unroll
    for (int q = 0; q < 8; ++q) f[q] = s[q * 65];
    *(GAS v2u*)(d.WT8 + (size_t)(d.drow0 + n) * d.ldt + d.k0 + 8 * c) = pack8_fp8(f, sc); }
  LDS_WAIT(); asm volatile("" ::: "memory");
}
__device__ __forceinline__ void p0_tr32(const float* W, int ldw, int k0, int scol0, int ncols, const float* gs, bf16* WT, int ldt, int drow0, LAS float* scr, int lane) {
#pragma unroll 8
  for (int i = 0; i < 32; ++i) { const int kk = 2 * i + (lane >> 5), c = lane & 31; float v = 0.f;
    if (c < ncols) { v = W[(size_t)(k0 + kk) * ldw + scol0 + c]; if (gs) v *= gs[k0 + kk]; }
    scr[kk * 65 + c] = v; }
  LDS_WAIT(); asm volatile("" ::: "memory");
  const int c = lane & 7;
#pragma unroll
  for (int j = 0; j < 4; ++j) { const int n = (lane >> 3) + 8 * j; const LAS float* s = scr + (8 * c) * 65 + n;
    v4u o; o.x = pk2(s[0 * 65], s[1 * 65]); o.y = pk2(s[2 * 65], s[3 * 65]); o.z = pk2(s[4 * 65], s[5 * 65]); o.w = pk2(s[6 * 65], s[7 * 65]);
    *(GAS v4u*)(WT + (size_t)(drow0 + n) * ldt + k0 + 8 * c) = o; }
  LDS_WAIT(); asm volatile("" ::: "memory");
}
__device__ __forceinline__ void rms_row_to_bf16(const float* xrow, bf16* orow, int lane) {
  const GAS f32x4* xr = (const GAS f32x4*)xrow + lane;
  f32x4 v[4]; float s = 0.f;
#pragma unroll
  for (int j = 0; j < 4; ++j) { v[j] = xr[64 * j]; s += (v[j].x * v[j].x + v[j].y * v[j].y) + (v[j].z * v[j].z + v[j].w * v[j].w); }
  const float rstd = rsqrtf(wave_sum(s) * (1.f / 1024.f) + 1e-6f);
  GAS unsigned long long* o8 = (GAS unsigned long long*)orow + lane;
#pragma unroll
  for (int j = 0; j < 4; ++j) o8[64 * j] = (unsigned long long)pk2(v[j].x * rstd, v[j].y * rstd) | ((unsigned long long)pk2(v[j].z * rstd, v[j].w * rstd) << 32);
}

#ifndef FP8EMU
#define FP8EMU 0
#endif
#ifndef MOE_FP8
#define MOE_FP8 1
#endif
#ifndef CONV_NT
#define CONV_NT 0
#endif
#ifndef MOE_FP8_DOWN
#define MOE_FP8_DOWN MOE_FP8
#endif
constexpr size_t WS_PO = 384 * MiB, WS_PML = 272 * MiB;
constexpr size_t WS_XG = 96 * MiB;
constexpr size_t WS_X2Q = 208 * MiB, WS_WEGU8 = 320 * MiB, WS_WED8 = 448 * MiB, WS_HID8 = 32 * MiB;
constexpr int CW_RDY = 8192 + 64 * 44;
constexpr int CW_CONV = 8192 + 64 * 40, CW_MDONE = 8192 + 64 * 41, CW_TDONE = 8192 + 64 * 42;
constexpr int CONV_IGU = 16 * 64, CONV_ID = 32 * 16, CONV_ITEMS = NEXP * (CONV_IGU + CONV_ID), CONV_CHUNKS = CONV_ITEMS / 8;
__device__ __forceinline__ ConvDesc conv_desc(Frame& F, const Args& a, int it) {
  auto I = [&](int i) { return (const float*)a.in[i]; };
  unsigned char* ws = F.ws; ConvDesc d;
  const int e = it / (CONV_IGU + CONV_ID); int r = it % (CONV_IGU + CONV_ID);
  if (r < CONV_IGU) { const int kb = r / 64, nb = r % 64, p = nb >> 2, j0 = (nb & 3) * 64; const bool up = j0 >= 128;
    d.W = (up ? I(I_WEU) : I(I_WEG)) + (size_t)e * 1024 * 2048; d.ldw = 2048; d.k0 = 64 * kb; d.scol0 = 128 * p + (up ? j0 - 128 : j0); d.gs = I(I_GFFN); d.WT8 = ws + WS_WEGU8 + (size_t)e * 4096 * 1024; d.ldt = 1024; d.drow0 = 64 * nb; }
  else { r -= CONV_IGU; const int kb = r / 16, nb = r % 16;
    d.W = I(I_WED) + (size_t)e * 2048 * 1024; d.ldw = 1024; d.k0 = 64 * kb; d.scol0 = 64 * nb; d.gs = nullptr; d.WT8 = ws + WS_WED8 + (size_t)e * 1024 * 2048; d.ldt = 2048; d.drow0 = 64 * nb; }
  return d;
}
__device__ __forceinline__ void conv_fill(Frame& F, const Args& a, int maxpairs) {
  static_assert(MOE_FP8 && MOE_FP8_DOWN, "the conversion filler writes fp8 expert weights");
  volatile LAS int* slot = (volatile LAS int*)(F.lds + LDSCTL_OFF + 16);
  LAS float* scr = (LAS float*)(F.lds + F.wave * 16640);
  for (int n = 0; n < maxpairs; ++n) {
    if (F.tid == 0) { int got = -1;
      if (__hip_atomic_load(F.ctl + CW_CONV, RLX_AGENT) < (unsigned)CONV_CHUNKS) { const unsigned c = __hip_atomic_fetch_add(F.ctl + CW_CONV, 2u, RLX_AGENT); if (c < (unsigned)CONV_CHUNKS) got = (int)c; }
      *slot = got; }
    __syncthreads();
    const int c = __builtin_amdgcn_readfirstlane(*slot);
    __syncthreads();
    if (c < 0) break;
    const ConvDesc d0 = conv_desc(F, a, c * 8 + F.wave), d1 = conv_desc(F, a, (c + 1) * 8 + F.wave);
    f32x4 v0[16], v1[16];
    p0_tr8_load(d0, v0, F.lane); p0_tr8_load(d1, v1, F.lane);
    p0_tr8_finish(d0, v0, 64.f, scr, F.lane); p0_tr8_finish(d1, v1, 64.f, scr, F.lane);
  }
}
__device__ __forceinline__ void p0_prologue(Frame& F, const Args& a, bool do_dense, bool do_experts) {
  LAS float* scr = (LAS float*)(F.lds + F.wave * 16640);
  const int gw = F.vcu * NWAVES + F.wave, NGW = F.G * NWAVES;
  auto I = [&](int i) { return (const float*)a.in[i]; };
  unsigned char* ws = F.ws;
  if (do_dense) {
    constexpr int I_WIN_ = 16 * 40, I_WQB_ = 4 * 12, I_WKVB_ = 4 * 16, I_SQ = 16 * 16;
    constexpr int NIT = I_WIN_ + I_WQB_ + I_WKVB_ + 5 * I_SQ;
    for (int it = gw; it < NIT; it += NGW) {
      int r = it;
      if (r < I_WIN_) { const int kb = r / 40, nb = r % 40; int sc, nc = 64;
        if (nb < 32) sc = 64 * nb; else if (nb < 36) sc = OFF_CQ + 64 * (nb - 32); else if (nb < 38) sc = OFF_CKV + 64 * (nb - 36); else if (nb == 38) { sc = OFF_KR; nc = 32; } else { sc = 0; nc = 0; }
        p0_tr(I(I_WIN), D_IN, 64 * kb, 1024, sc, nc, I(I_GMIX), (bf16*)(ws + WS_WIN), 1024, 64 * nb, scr, F.lane);
        if (nb == 38) p0_tr32(I(I_WIN), D_IN, 64 * kb, OFF_G, 16, I(I_GMIX), (bf16*)(ws + WS_WIN), 1024, PC_G, scr, F.lane);
        continue; } r -= I_WIN_;
      if (r < I_WQB_) { const int kb = r / 12, nb = r % 12; p0_tr(I(I_WQB), 768, 64 * kb, 256, 64 * nb, 64, I(I_GQA), (bf16*)(ws + WS_WQB), 256, 64 * nb, scr, F.lane); continue; } r -= I_WQB_;
      if (r < I_WKVB_) { const int kb = r / 16, nb = r % 16; const int h = nb & 7; const int sc = h * 128 + (nb >= 8 ? 64 : 0);
        p0_tr(I(I_WKVB), 1024, 64 * kb, 128, sc, 64, I(I_GKVA), (bf16*)(ws + WS_WKVB), 256, 64 * nb, scr, F.lane); continue; } r -= I_WKVB_;
      const int which = r / I_SQ; r %= I_SQ; const int kb = r / 16, nb = r % 16;
      const float* src = which == 0 ? I(I_WOUT) : which == 1 ? I(I_WMQ) : which == 2 ? I(I_WMK) : which == 3 ? I(I_WMV) : I(I_WMO);
      const float* gs = which == 1 ? I(I_GMX) : (which == 2 || which == 3) ? I(I_GMKV) : nullptr;
      bf16* dst = (bf16*)(ws + (which == 0 ? WS_WOUT : which == 1 ? WS_WMQ : which == 2 ? WS_WMK : which == 3 ? WS_WMV : WS_WMO));
      p0_tr(src, 1024, 64 * kb, 1024, 64 * nb, 64, gs, dst, 1024, 64 * nb, scr, F.lane);
    }
    for (int m = gw; m < MTOK; m += NGW) rms_row_to_bf16(I(I_X) + (size_t)m * 1024, (bf16*)(ws + WS_XN) + (size_t)m * 1024, F.lane);
    for (int m = gw; m < BATCH * NMEM; m += NGW) rms_row_to_bf16(I(I_MEM) + (size_t)m * 1024, (bf16*)(ws + WS_MEMN) + (size_t)m * 1024, F.lane);
    { const float* wr = I(I_WR); const float* gf = I(I_GFFN); float* wrg = (float*)(ws + WS_DEC + 65536);
      for (int i = (F.vcu * NTHR + F.tid); i < 1024 * 16; i += F.G * NTHR) wrg[i] = wr[i] * gf[i >> 4]; }
    { const int* pos = (const int*)a.in[I_POS]; float* rt = (float*)(ws + WS_ROPE);
      for (int i = (F.vcu * NTHR + F.tid); i < MTOK * 16; i += F.G * NTHR) { const int m = i >> 4, j = i & 15; const float inv = powf(10000.f, -(float)j / 16.f); const float ang = (float)pos[m] * inv;
        rt[m * 32 + j] = cosf(ang); rt[m * 32 + 16 + j] = sinf(ang); } }
  }
  if (do_experts) conv_fill(F, a, 1 << 30);
}

__device__ __forceinline__ v4u pack8(const float (&v)[8]) { v4u w; w.x = cvt_pk_bf16(v[0], v[1]); w.y = cvt_pk_bf16(v[2], v[3]); w.z = cvt_pk_bf16(v[4], v[5]); w.w = cvt_pk_bf16(v[6], v[7]); return w; }
__device__ __forceinline__ float sumsq8(const float (&v)[8]) { float s = 0.f;
#pragma unroll
  for (int i = 0; i < 8; ++i) s += v[i] * v[i];
  return s; }
struct EpiStore { static constexpr bool TWO_PASS = false; bf16* O; int ldc;
  __device__ __forceinline__ void row8(const pg8::Unit& u, int rloc, int cloc, const float (&v0)[8], const float (&v1)[8], int fq) const {
    bf16* p = O + (size_t)(u.pm * 256 + rloc) * ldc + u.pn * 256 + cloc; *(v4u*)p = pack8(v0); *(v4u*)(p + 128) = pack8(v1); } };
struct EpiProj { static constexpr bool TWO_PASS = false; bf16* P; float* ssq; float* sskv;
  __device__ __forceinline__ void row8(const pg8::Unit& u, int rloc, int cloc, const float (&v0)[8], const float (&v1)[8], int fq) const {
    const int row = u.pm * 256 + rloc; bf16* p = P + (size_t)row * PROJ_LD + u.pn * 256 + cloc; *(v4u*)p = pack8(v0); *(v4u*)(p + 128) = pack8(v1);
    if (u.pn == 8) { float s = sumsq8(v0) + sumsq8(v1); s += __shfl_xor(s, 16); s += __shfl_xor(s, 32); if (fq == 0) unsafeAtomicAdd(ssq + row, s); }
    if (u.pn == 9) { float s = sumsq8(v0); s += __shfl_xor(s, 16); s += __shfl_xor(s, 32); if (fq == 0) unsafeAtomicAdd(sskv + row, s); } } };
struct EpiQ { static constexpr bool TWO_PASS = false; bf16* Q; const float* ssq; const float* rope;
  __device__ __forceinline__ void rope8(float (&v)[8], int row, int fq) const {
    float pv[8];
#pragma unroll
    for (int i = 0; i < 8; ++i) pv[i] = __shfl_xor(v[i], 32);
    const float* cs = rope + (size_t)row * 32 + 8 * (fq & 1);
#pragma unroll
    for (int i = 0; i < 8; ++i) { const float c = cs[i], s = cs[16 + i]; v[i] = (fq < 2) ? (v[i] * c - pv[i] * s) : (v[i] * c + pv[i] * s); }
  }
  __device__ __forceinline__ void row8(const pg8::Unit& u, int rloc, int cloc, const float (&a0)[8], const float (&a1)[8], int fq) const {
    const int row = u.pm * 256 + rloc; const float r = rsqrtf(ssq[row] * (1.f / 256.f) + 1e-6f);
    float v0[8], v1[8];
#pragma unroll
    for (int i = 0; i < 8; ++i) { v0[i] = a0[i] * r; v1[i] = a1[i] * r; }
    const int g0 = u.pn * 8 + (cloc >> 5), g1 = g0 + 4;
    if (g0 % 3 == 2) rope8(v0, row, fq);
    if (g1 % 3 == 2) rope8(v1, row, fq);
    bf16* p = Q + (size_t)row * 768 + u.pn * 256 + cloc; *(v4u*)p = pack8(v0); *(v4u*)(p + 128) = pack8(v1); } };
struct EpiKV { static constexpr bool TWO_PASS = false; bf16* KMp; bf16* VMp; const float* sskv;
  __device__ __forceinline__ void put(int row, int c, const float (&v)[8], float r) const {
    float w[8];
#pragma unroll
    for (int i = 0; i < 8; ++i) w[i] = v[i] * r;
    if (c < 512) *(v4u*)(KMp + (size_t)row * 768 + (c >> 6) * 96 + (c & 63)) = pack8(w); else *(v4u*)(VMp + (size_t)row * 512 + (c - 512)) = pack8(w); }
  __device__ __forceinline__ void row8(const pg8::Unit& u, int rloc, int cloc, const float (&a0)[8], const float (&a1)[8], int fq) const {
    const int row = u.pm * 256 + rloc; const float r = rsqrtf(sskv[row] * (1.f / 128.f) + 1e-6f);
    put(row, u.pn * 256 + cloc, a0, r); put(row, u.pn * 256 + 128 + cloc, a1, r); } };

__device__ __forceinline__ void unpack8(v4u w, float (&f)[8]) { f[0] = bflo(w.x); f[1] = bfhi(w.x); f[2] = bflo(w.y); f[3] = bfhi(w.y); f[4] = bflo(w.z); f[5] = bfhi(w.z); f[6] = bflo(w.w); f[7] = bfhi(w.w); }
__device__ __forceinline__ float log_sigmoid(float x) { return fminf(x, 0.f) - log1pf(__expf(-fabsf(x))); }

__device__ __forceinline__ void p2_elementwise(Frame& F, const Args& a) {
  unsigned char* ws = F.ws;
  const bf16* P = (const bf16*)(ws + WS_PROJ);
  { const float* cw = (const float*)a.in[I_CONV]; bf16* QC = (bf16*)(ws + WS_QC); bf16* KC = (bf16*)(ws + WS_KC);
    for (int i = F.vcu * NTHR + F.tid; i < MTOK * 128; i += F.G * NTHR) { const int m = i >> 7, c = (i & 127) * 8, t = m & (SEQ - 1);
      float x1[8], x0[8], x2[8]; unpack8(*(const v4u*)(P + (size_t)m * PROJ_LD + c), x1);
      if (t > 0) unpack8(*(const v4u*)(P + (size_t)(m - 1) * PROJ_LD + c), x0); else {
#pragma unroll
        for (int j = 0; j < 8; ++j) x0[j] = 0.f; }
      if (t < SEQ - 1) unpack8(*(const v4u*)(P + (size_t)(m + 1) * PROJ_LD + c), x2); else {
#pragma unroll
        for (int j = 0; j < 8; ++j) x2[j] = 0.f; }
      float o[8];
#pragma unroll
      for (int j = 0; j < 8; ++j) { float v = x0[j] * cw[c + j] + x1[j] * cw[1024 + c + j] + x2[j] * cw[2048 + c + j]; v = v * sigmoidf_(v); o[j] = (c < 512) ? v : v * 0.08838834764831845f; }
      if (c < 512) *(v4u*)(QC + (size_t)m * 512 + c) = pack8(o); else *(v4u*)(KC + (size_t)m * 512 + c - 512) = pack8(o); } }
  { const float* rope = (const float*)(ws + WS_ROPE); bf16* KMp = (bf16*)(ws + WS_KM);
    for (int i = F.vcu * NTHR + F.tid; i < MTOK * 16; i += F.G * NTHR) { const int m = i >> 4, j = i & 15;
      const float t1 = bf2f(P[(size_t)m * PROJ_LD + PC_KR + j]), t2 = bf2f(P[(size_t)m * PROJ_LD + PC_KR + 16 + j]); const float c = rope[m * 32 + j], s = rope[m * 32 + 16 + j];
      const bf16 o1 = (bf16)f2bf(t1 * c - t2 * s), o2 = (bf16)f2bf(t2 * c + t1 * s);
#pragma unroll
      for (int h = 0; h < 8; ++h) { KMp[(size_t)m * 768 + h * 96 + 64 + j] = o1; KMp[(size_t)m * 768 + h * 96 + 80 + j] = o2; } } }
  { const float* bg = (const float*)a.in[I_BG]; float* GSC = (float*)(ws + WS_GSC); float* DEC = (float*)(ws + WS_DEC);
    const int gw = F.vcu * NWAVES + F.wave, NGW = F.G * NWAVES;
    for (int it = gw; it < 32 * 64; it += NGW) { const int seq = it >> 6, c = it & 63, dir = seq & 1, h = (seq >> 1) & 3, b = seq >> 3;
      const int p = c * 64 + F.lane, t = dir ? (SEQ - 1 - p) : p; const size_t row = (size_t)b * SEQ + t;
      const int gi = (dir ? 8 : 0) + h, gf = (dir ? 12 : 4) + h;
      const float li = bf2f(P[row * PROJ_LD + PC_G + gi]) + bg[gi]; const float lf = log_sigmoid(bf2f(P[row * PROJ_LD + PC_G + gf]) + bg[gf]);
      float bs = lf;
#pragma unroll
      for (int o = 1; o < 64; o <<= 1) { const float y = __shfl_up(bs, o); if (F.lane >= o) bs += y; }
      const float av = li - bs; float pm = av;
#pragma unroll
      for (int o = 1; o < 64; o <<= 1) { const float y = __shfl_up(pm, o); if (F.lane >= o) pm = fmaxf(pm, y); }
      float* gs = GSC + (size_t)seq * 3 * SEQ; gs[p] = bs; gs[SEQ + p] = av; gs[2 * SEQ + p] = pm;
      if (F.lane == 63) { DEC[seq * 128 + c] = bs; DEC[seq * 128 + 64 + c] = pm; } } }
}
namespace mla {
constexpr int DQK = 96, DV = 64, NW = 8, QBLK = 32, KVBLK = 64, LDQ = 768, LDK = 768, LDV = 512, LDO = 1024;
constexpr float SCALE = 0.10206207261596575f;
constexpr float THR = 8.f;
constexpr int SHM_V = 16384, SHM_K = 16384, SHM_ATTN = 2 * SHM_V + 2 * SHM_K + NW * 64 * 4;
#define KSWZ(row, colB) ((row) * 256 + ((colB) ^ (((row) & 7) << 4)))
#define SBAR() __builtin_amdgcn_sched_barrier(0)
__device__ __forceinline__ int crow(int r, int hi) { return (r & 3) + 8 * (r >> 2) + 4 * hi; }
__device__ __forceinline__ void partialSM(f32x16& p0, f32x16& p1, float& m_reg, float& mn, float& alpha) {
  constexpr float C = SCALE * 1.4426950408889634f;
  float pmax = p0[0];
#pragma unroll
  for (int r = 1; r < 16; ++r) pmax = fmaxf(pmax, p0[r]);
#pragma unroll
  for (int r = 0; r < 16; ++r) pmax = fmaxf(pmax, p1[r]);
  { auto rr = __builtin_amdgcn_permlane32_swap(__float_as_uint(pmax), __float_as_uint(pmax), false, false);
    pmax = fmaxf(__uint_as_float(rr[0]), __uint_as_float(rr[1])); }
  if (__builtin_expect(__all(pmax - m_reg <= THR / SCALE), 1)) { mn = m_reg; alpha = 1.f; }
  else { mn = fmaxf(m_reg, pmax); alpha = __builtin_amdgcn_exp2f((m_reg - mn) * C); m_reg = mn; }
  const float mnC = -mn * C;
#pragma unroll
  for (int r = 0; r < 16; ++r) p0[r] = fmaf(p0[r], C, mnC);
#pragma unroll
  for (int r = 0; r < 16; ++r) p1[r] = fmaf(p1[r], C, mnC);
#pragma unroll
  for (int r = 0; r < 16; ++r) p0[r] = __builtin_amdgcn_exp2f(p0[r]);
}
__device__ __forceinline__ void finishSM(f32x16& p0, f32x16& p1, float alpha, float& l_reg, bf16x8& pa0, bf16x8& pa1, bf16x8& pa2, bf16x8& pa3) {
#pragma unroll
  for (int r = 0; r < 16; ++r) p1[r] = __builtin_amdgcn_exp2f(p1[r]);
  float ps = 0;
#pragma unroll
  for (int r = 0; r < 16; ++r) ps += p0[r];
#pragma unroll
  for (int r = 0; r < 16; ++r) ps += p1[r];
  { auto rr = __builtin_amdgcn_permlane32_swap(__float_as_uint(ps), __float_as_uint(ps), false, false);
    ps = __uint_as_float(rr[0]) + __uint_as_float(rr[1]); }
  l_reg = l_reg * alpha + ps;
#define PK4(P, BASE, OUT) do { unsigned a0 = cvt_pk_bf16(P[BASE + 0], P[BASE + 1]), a1 = cvt_pk_bf16(P[BASE + 2], P[BASE + 3]);   \
    unsigned b0 = cvt_pk_bf16(P[BASE + 4], P[BASE + 5]), b1 = cvt_pk_bf16(P[BASE + 6], P[BASE + 7]);                              \
    auto r0 = __builtin_amdgcn_permlane32_swap(a0, b0, false, false); auto r1 = __builtin_amdgcn_permlane32_swap(a1, b1, false, false); \
    v4u w = {r0[0], r1[0], r0[1], r1[1]}; OUT = __builtin_bit_cast(bf16x8, w); } while (0)
  PK4(p0, 0, pa0); PK4(p0, 8, pa1); PK4(p1, 0, pa2); PK4(p1, 8, pa3);
#undef PK4
}
__device__ __forceinline__ void qkt(f32x16& p0, f32x16& p1, const char* Ks, const bf16x8* qr, int r32, int hi) {
  p0 = f32x16{}; p1 = f32x16{};
#pragma unroll
  for (int d0 = 0; d0 < DQK / 16; ++d0) { const int cb = (d0 * 16 + hi * 8) * 2;
    const bf16x8 b0 = *reinterpret_cast<const bf16x8*>(Ks + KSWZ(r32, cb));
    const bf16x8 b1 = *reinterpret_cast<const bf16x8*>(Ks + KSWZ(32 + r32, cb));
    p0 = __builtin_amdgcn_mfma_f32_32x32x16_bf16(b0, qr[d0], p0, 0, 0, 0);
    p1 = __builtin_amdgcn_mfma_f32_32x32x16_bf16(b1, qr[d0], p1, 0, 0, 0); }
}
__device__ __forceinline__ int v_st(int k, int c) { const int kk = (k & ~0xC) | ((k & 4) << 1) | ((k & 8) >> 1); return ((kk >> 3) * 4 + (c >> 5)) * 512 + ((kk & 7) * 32 + (c & 31)) * 2; }
__device__ __forceinline__ int v_rd_base(int lane) { return ((lane & 3) << 3) | (((lane >> 2) & 3) << 6) | (((lane >> 4) & 1) << 5) | (((lane >> 5) & 1) << 8); }
constexpr int v_rd_off(int d0, int ks, int half) { return d0 * 512 + ks * 4096 + half * 2048; }
template <int OFF> __device__ __forceinline__ s16x4 tr_read(int vb) {
  s16x4 r; asm volatile("ds_read_b64_tr_b16 %0, %1 offset:%2" : "=&v"(r) : "v"(vb), "i"(OFF) : "memory"); return r;
}
template <int D0> __device__ __forceinline__ void pv_one(f32x16& od, int vb, bf16x8 pa0, bf16x8 pa1, bf16x8 pa2, bf16x8 pa3) {
  const s16x4 l0 = tr_read<v_rd_off(D0, 0, 0)>(vb), h0 = tr_read<v_rd_off(D0, 0, 1)>(vb), l1 = tr_read<v_rd_off(D0, 1, 0)>(vb), h1 = tr_read<v_rd_off(D0, 1, 1)>(vb);
  const s16x4 l2 = tr_read<v_rd_off(D0, 2, 0)>(vb), h2 = tr_read<v_rd_off(D0, 2, 1)>(vb), l3 = tr_read<v_rd_off(D0, 3, 0)>(vb), h3 = tr_read<v_rd_off(D0, 3, 1)>(vb);
  asm volatile("s_waitcnt lgkmcnt(0)" ::: "memory"); SBAR();
#define PK(L, H) (bf16x8){L[0], L[1], L[2], L[3], H[0], H[1], H[2], H[3]}
  od = __builtin_amdgcn_mfma_f32_32x32x16_bf16(pa0, PK(l0, h0), od, 0, 0, 0);
  od = __builtin_amdgcn_mfma_f32_32x32x16_bf16(pa1, PK(l1, h1), od, 0, 0, 0);
  od = __builtin_amdgcn_mfma_f32_32x32x16_bf16(pa2, PK(l2, h2), od, 0, 0, 0);
  od = __builtin_amdgcn_mfma_f32_32x32x16_bf16(pa3, PK(l3, h3), od, 0, 0, 0);
#undef PK
}
__device__ __forceinline__ void pv_d0(f32x16* o, int vb, bf16x8 pa0, bf16x8 pa1, bf16x8 pa2, bf16x8 pa3) {
  pv_one<0>(o[0], vb, pa0, pa1, pa2, pa3); pv_one<1>(o[1], vb, pa0, pa1, pa2, pa3);
}
constexpr int LDP = 8 * 64, LDML = 8 * 2;
__device__ __forceinline__ void attn_unit(const bf16* __restrict__ Qb, const bf16* __restrict__ Kh, const bf16* __restrict__ Vh, float* __restrict__ Op, float* __restrict__ MLp, int seq, char* lds) {
  int tid = threadIdx.x; asm volatile("" : "+v"(tid));
  const int wid = tid >> 6, lane = tid & 63, r32 = lane & 31, hi = lane >> 5;
  char* V_lds = lds; char* K_lds = lds + 2 * SHM_V;
  float* wsf = (float*)(lds + 2 * SHM_V + 2 * SHM_K) + wid * 64; float* li_l = wsf; float* al_l = wsf + 32;
  float m_reg = -1e30f, l_reg = 0; f32x16 o[2] = {}; bf16x8 qr[DQK / 16];
  const bf16* Qw = Qb + (long)(wid * QBLK + r32) * LDQ + hi * 8;
#pragma unroll
  for (int d0 = 0; d0 < DQK / 16; ++d0) qr[d0] = *reinterpret_cast<const bf16x8*>(Qw + d0 * 16);
  const int sr = tid >> 4, sc = (tid & 15) * 8, vst0 = v_st(sr, sc & 63), vst1 = v_st(32 + sr, sc & 63);
  const bool doK = sc < DQK, doV = sc < DV;
  const int vb0 = (int)(uintptr_t)V_lds + v_rd_base(lane);
  struct { bf16x8 vs0, vs1, ks0, ks1; } sr_[2];
#define SLOAD(i, k0) do { if (doV) { sr_[i].vs0 = *reinterpret_cast<const bf16x8*>(&Vh[(long)((k0) + sr) * LDV + sc]); sr_[i].vs1 = *reinterpret_cast<const bf16x8*>(&Vh[(long)((k0) + 32 + sr) * LDV + sc]); } \
    if (doK) { sr_[i].ks0 = *reinterpret_cast<const bf16x8*>(&Kh[(long)((k0) + sr) * LDK + sc]); sr_[i].ks1 = *reinterpret_cast<const bf16x8*>(&Kh[(long)((k0) + 32 + sr) * LDK + sc]); } } while (0)
#define SWRITE(b, i) do { if (doV) { *(bf16x8*)(V_lds + (b) * SHM_V + vst0) = sr_[i].vs0; *(bf16x8*)(V_lds + (b) * SHM_V + vst1) = sr_[i].vs1; } \
    if (doK) { const int kc = sc * 2; *(bf16x8*)(K_lds + (b) * SHM_K + KSWZ(sr, kc)) = sr_[i].ks0; *(bf16x8*)(K_lds + (b) * SHM_K + KSWZ(32 + sr, kc)) = sr_[i].ks1; } } while (0)
#define SWAIT() asm volatile("s_waitcnt vmcnt(4)" ::: "memory")
#define RESC(a) do { if (__any((a) < 1.f)) { if (hi == 0) al_l[r32] = (a); asm volatile("s_waitcnt lgkmcnt(0)" ::: "memory"); \
    _Pragma("unroll") for (int d = 0; d < 2; ++d) _Pragma("unroll") for (int r = 0; r < 16; ++r) o[d][r] *= al_l[crow(r, hi)]; } } while (0)
  f32x16 pA0, pA1, pB0, pB1; float mnA, mnB, alA, alB; bf16x8 pa0, pa1, pa2, pa3; const int NT = seq / KVBLK;
  constexpr int SE = 0, SO = 1;
  SLOAD(SE, 0); asm volatile("s_waitcnt vmcnt(0)" ::: "memory"); SWRITE(0, SE); __syncthreads();
  qkt(pA0, pA1, K_lds, qr, r32, hi); partialSM(pA0, pA1, m_reg, mnA, alA);
  SLOAD(SO, KVBLK); if (2 < NT) SLOAD(SE, 2 * KVBLK);
  SWAIT(); SWRITE(1, SO); __syncthreads();
  for (int j = 1; j + 1 < NT; j += 2) {
    SBAR(); qkt(pB0, pB1, K_lds + SHM_K, qr, r32, hi);
    finishSM(pA0, pA1, alA, l_reg, pa0, pa1, pa2, pa3); SBAR();
    SLOAD(SO, (j + 2) * KVBLK); SBAR();
    pv_d0(o, vb0, pa0, pa1, pa2, pa3); partialSM(pB0, pB1, m_reg, mnB, alB);
    __syncthreads(); SWAIT(); SWRITE(0, SE);
    RESC(alB); __syncthreads();
    SBAR(); qkt(pA0, pA1, K_lds, qr, r32, hi);
    finishSM(pB0, pB1, alB, l_reg, pa0, pa1, pa2, pa3); SBAR();
    if (j + 3 < NT) SLOAD(SE, (j + 3) * KVBLK); SBAR();
    pv_d0(o, vb0 + SHM_V, pa0, pa1, pa2, pa3); partialSM(pA0, pA1, m_reg, mnA, alA);
    __syncthreads(); SWAIT(); SWRITE(1, SO);
    RESC(alA); __syncthreads();
  }
  SBAR(); qkt(pB0, pB1, K_lds + SHM_K, qr, r32, hi);
  finishSM(pA0, pA1, alA, l_reg, pa0, pa1, pa2, pa3); SBAR();
  pv_d0(o, vb0, pa0, pa1, pa2, pa3); partialSM(pB0, pB1, m_reg, mnB, alB);
  __syncthreads(); RESC(alB);
  finishSM(pB0, pB1, alB, l_reg, pa0, pa1, pa2, pa3); SBAR();
  pv_d0(o, vb0 + SHM_V, pa0, pa1, pa2, pa3);
  __syncthreads();
  { float* st = (float*)lds + wid * (32 * 68);
#pragma unroll
    for (int r = 0; r < 16; ++r) { const int orow = crow(r, hi); st[orow * 68 + r32] = o[0][r]; st[orow * 68 + 32 + r32] = o[1][r]; }
    asm volatile("s_waitcnt lgkmcnt(0)" ::: "memory");
    float* op = Op + (long)(wid * QBLK + r32) * LDP + hi * 32;
#pragma unroll
    for (int j = 0; j < 8; ++j) *(f32x4*)(op + 4 * j) = *(const f32x4*)(st + r32 * 68 + hi * 32 + 4 * j);
    if (hi == 0) { float* mp = MLp + (long)(wid * QBLK + r32) * LDML; mp[0] = m_reg; mp[1] = l_reg; } }
  __syncthreads();
#undef SLOAD
#undef SWRITE
#undef SWAIT
#undef RESC
}
#undef KSWZ
#undef SBAR
}

__device__ __forceinline__ int queue_pull(Frame& F, gu32* heads, int nq, int nper, int myq) {
  volatile LAS int* slot = (volatile LAS int*)(F.lds + LDSCTL_OFF);
  if (F.tid == 0) { int got = -1;
    for (int k = 0; k < nq; ++k) { const int q = (myq + k) % nq;
      if (__hip_atomic_load(heads + 64 * q, RLX_AGENT) >= (unsigned)nper) continue;
      const unsigned i = __hip_atomic_fetch_add(heads + 64 * q, 1u, RLX_AGENT);
      if (i < (unsigned)nper) { got = q * nper + (int)i; break; } }
    *slot = got; }
  __syncthreads();
  const int r = __builtin_amdgcn_readfirstlane(*slot);
  __syncthreads();
  return r;
}
__device__ __forceinline__ void p3_attention(Frame& F, const Args& a, char* lds_generic, unsigned xcc, int qoff) {
  unsigned char* ws = F.ws;
  const bf16* QMp = (const bf16*)(ws + WS_QM); const bf16* KMp = (const bf16*)(ws + WS_KM); const bf16* VMp = (const bf16*)(ws + WS_VM); float* PO = (float*)(ws + WS_PO); float* PML = (float*)(ws + WS_PML);
#ifndef WAIT_MODE
#define WAIT_MODE 1
#endif
  bool waited = false; (void)waited;
  for (;;) {
    const int u = queue_pull(F, F.ctl + CW_Q + qoff, 8, 128, (int)(xcc & 7u));
    if (u < 0) break;
    const int bh = u >> 5, qb = (u >> 1) & 15, kh = u & 1, b = bh >> 3, h = bh & 7;
#if WAIT_MODE == 0
    if (F.tid == 0) { unsigned sp = 0;
      while (__hip_atomic_load(F.ctl + CW_RDY + 64 * b, RLX_AGENT) < 112u) { __builtin_amdgcn_s_sleep(2); if (++sp > (1u << 24)) break; }
      __builtin_amdgcn_fence(__ATOMIC_ACQUIRE, "agent"); }
    asm volatile("s_waitcnt vmcnt(0)" ::: "memory"); __syncthreads();
#else
    if (!waited) { waited = true;
      if (F.tid == 0) { unsigned sp = 0;
        for (int bb = 0; bb < 4; ++bb) while (__hip_atomic_load(F.ctl + CW_RDY + 64 * bb, RLX_AGENT) < 112u) { __builtin_amdgcn_s_sleep(2); if (++sp > (1u << 24)) break; }
        __builtin_amdgcn_fence(__ATOMIC_ACQUIRE, "agent"); }
      asm volatile("s_waitcnt vmcnt(0)" ::: "memory"); __syncthreads(); }
#endif
    const size_t row0 = (size_t)b * SEQ + qb * 256, key0 = (size_t)b * SEQ + kh * (SEQ / 2);
    mla::attn_unit(QMp + row0 * 768 + h * 96, KMp + key0 * 768 + h * 96, VMp + key0 * 512 + h * 64,
                   PO + ((size_t)kh * MTOK + row0) * 512 + h * 64, PML + ((size_t)kh * MTOK + row0) * 16 + h * 2, SEQ / 2, lds_generic);
  }
}
namespace mls {
using mla::crow; using mla::v_st; using mla::v_rd_base;
#define KSWZ(row, colB) ((row) * 256 + ((colB) ^ (((row) & 7) << 4)))
constexpr int OFF_QS = 0, OFF_KS = 16384, OFF_KP = 32768, OFF_VV = 49152, OFF_CT = 65536, OFF_SC = 98304, OFF_NB = 99328, OFF_NP = 100352, OFF_CH = 104448, OFF_WS = 105472;
template <int OFF> __device__ __forceinline__ s16x4 trr(int vb) { s16x4 r; asm volatile("ds_read_b64_tr_b16 %0, %1 offset:%2" : "=&v"(r) : "v"(vb), "i"(OFF) : "memory"); return r; }
#define PKF(L, H) (bf16x8){L[0], L[1], L[2], L[3], H[0], H[1], H[2], H[3]}
__device__ __forceinline__ void vfrags(int img, int d0, int lane, bf16x8 (&f)[4]) {
  const int vb = img + v_rd_base(lane) + d0 * 512;
  const s16x4 l0 = trr<0>(vb), h0 = trr<2048>(vb), l1 = trr<4096>(vb), h1 = trr<4096 + 2048>(vb), l2 = trr<8192>(vb), h2 = trr<8192 + 2048>(vb), l3 = trr<12288>(vb), h3 = trr<12288 + 2048>(vb);
  asm volatile("s_waitcnt lgkmcnt(0)" ::: "memory"); __builtin_amdgcn_sched_barrier(0);
  f[0] = PKF(l0, h0); f[1] = PKF(l1, h1); f[2] = PKF(l2, h2); f[3] = PKF(l3, h3);
}
__device__ __forceinline__ void pack_p(const f32x16& p0, const f32x16& p1, bf16x8& pa0, bf16x8& pa1, bf16x8& pa2, bf16x8& pa3) {
#define PK4(P, BASE, OUT) do { unsigned a0 = cvt_pk_bf16(P[BASE + 0], P[BASE + 1]), a1 = cvt_pk_bf16(P[BASE + 2], P[BASE + 3]);   \
    unsigned b0 = cvt_pk_bf16(P[BASE + 4], P[BASE + 5]), b1 = cvt_pk_bf16(P[BASE + 6], P[BASE + 7]);                              \
    auto r0 = __builtin_amdgcn_permlane32_swap(a0, b0, false, false); auto r1 = __builtin_amdgcn_permlane32_swap(a1, b1, false, false); \
    v4u w = {r0[0], r1[0], r0[1], r1[1]}; OUT = __builtin_bit_cast(bf16x8, w); } while (0)
  PK4(p0, 0, pa0); PK4(p0, 8, pa1); PK4(p1, 0, pa2); PK4(p1, 8, pa3);
#undef PK4
}
__device__ __forceinline__ float swap_add(float v) { auto rr = __builtin_amdgcn_permlane32_swap(__float_as_uint(v), __float_as_uint(v), false, false); return __uint_as_float(rr[0]) + __uint_as_float(rr[1]); }

__device__ __forceinline__ void mlstm_seq(int seq, unsigned char* ws, char* lds) {
  int tid = threadIdx.x; asm volatile("" : "+v"(tid));
  const int wid = __builtin_amdgcn_readfirstlane(tid >> 6), lane = tid & 63, r32 = lane & 31, hi = lane >> 5, rb = wid >> 2, cb = wid & 3;
  const int dir = seq & 1, h = (seq >> 1) & 3, b = seq >> 3;
  const bf16* QC = (const bf16*)(ws + WS_QC); const bf16* KC = (const bf16*)(ws + WS_KC); const bf16* P = (const bf16*)(ws + WS_PROJ);
  const float* gs = (const float*)(ws + WS_GSC) + (size_t)seq * 3 * SEQ; const float* dec = (const float*)(ws + WS_DEC) + seq * 128;
  bf16* H = (bf16*)(ws + (dir ? WS_HB : WS_HF));
  float* sc_alpha = (float*)(lds + OFF_SC); float* sc_a = sc_alpha + 64; float* sc_iw = sc_alpha + 128; float* sc_en = sc_alpha + 192;
  float* nbuf = (float*)(lds + OFF_NB); float* npart = (float*)(lds + OFF_NP);
  float* ch_mprev = (float*)(lds + OFF_CH); float* ch_mnew = ch_mprev + 64; float* ch_dec = ch_mprev + 128; float* ch_g = ch_mprev + 192;
  float* wsf = (float*)(lds + OFF_WS) + wid * 32;
  const int ldsb = (int)(uintptr_t)lds;
  if (tid < 64) {
    if (tid == 0) { float m = 0.f; for (int c = 0; c < 64; ++c) { const float g = dec[c], wm = dec[64 + c]; const float mn = fmaxf(g + m, g + wm); ch_mprev[c] = m; ch_mnew[c] = mn; ch_dec[c] = __expf(g + m - mn); ch_g[c] = g; m = mn; } } }
  for (int i = tid; i < 32768 / 16; i += NTHR) ((v4u*)(lds + OFF_CT))[i] = (v4u){0u, 0u, 0u, 0u};
  if (tid < 128) nbuf[tid] = 0.f;
  f32x16 cacc[3]; cacc[0] = f32x16{}; cacc[1] = f32x16{}; cacc[2] = f32x16{};
  const int nown = rb ? 1 : 3;
  __syncthreads();
  const int sr = tid >> 4, sc = (tid & 15) * 8;
  v4u gq0, gq1, gk0, gk1, gv0, gv1; float ga0, ga1, sb = 0.f, sa = 0.f, spm = 0.f;
#define ROWOF(p) ((size_t)b * SEQ + (dir ? (SEQ - 1 - (p)) : (p)))
#define LOADC(c) do { const int p0_ = 64 * (c) + sr, p1_ = p0_ + 32; const size_t r0_ = ROWOF(p0_), r1_ = ROWOF(p1_); \
    gq0 = *(const v4u*)(QC + r0_ * 512 + h * 128 + sc); gq1 = *(const v4u*)(QC + r1_ * 512 + h * 128 + sc); \
    gk0 = *(const v4u*)(KC + r0_ * 512 + h * 128 + sc); gk1 = *(const v4u*)(KC + r1_ * 512 + h * 128 + sc); \
    gv0 = *(const v4u*)(P + r0_ * PROJ_LD + 1024 + h * 128 + sc); gv1 = *(const v4u*)(P + r1_ * PROJ_LD + 1024 + h * 128 + sc); \
    ga0 = gs[SEQ + p0_]; ga1 = gs[SEQ + p1_]; \
    if (tid < 64) { sb = gs[64 * (c) + tid]; sa = gs[SEQ + 64 * (c) + tid]; spm = gs[2 * SEQ + 64 * (c) + tid]; } } while (0)
#define WRITEC(c) do { \
    *(v4u*)(lds + OFF_QS + KSWZ(sr, sc * 2)) = gq0; *(v4u*)(lds + OFF_QS + KSWZ(32 + sr, sc * 2)) = gq1; \
    *(v4u*)(lds + OFF_KS + KSWZ(sr, sc * 2)) = gk0; *(v4u*)(lds + OFF_KS + KSWZ(32 + sr, sc * 2)) = gk1; \
    *(v4u*)(lds + OFF_VV + v_st(sr, sc)) = gv0; *(v4u*)(lds + OFF_VV + v_st(32 + sr, sc)) = gv1; \
    { const float gc_ = ch_g[c], mn_ = ch_mnew[c]; const float w0_ = __expf(gc_ + ga0 - mn_), w1_ = __expf(gc_ + ga1 - mn_); float f0_[8], f1_[8], cs_[8]; unpack8(gk0, f0_); unpack8(gk1, f1_); \
      _Pragma("unroll") for (int j = 0; j < 8; ++j) { f0_[j] *= w0_; f1_[j] *= w1_; cs_[j] = f0_[j] + f1_[j]; } \
      *(v4u*)(lds + OFF_KP + v_st(sr, sc)) = pack8(f0_); *(v4u*)(lds + OFF_KP + v_st(32 + sr, sc)) = pack8(f1_); \
      _Pragma("unroll") for (int j = 0; j < 8; ++j) { cs_[j] += __shfl_xor(cs_[j], 16); cs_[j] += __shfl_xor(cs_[j], 32); } \
      if ((lane >> 4) == 0) { _Pragma("unroll") for (int j = 0; j < 8; ++j) npart[wid * 128 + sc + j] = cs_[j]; } } \
    if (tid < 64) { const float m_ = ch_mprev[c]; const float mt_ = fmaxf(sb + m_, sb + spm); sc_alpha[tid] = sb - mt_; sc_a[tid] = sa; sc_iw[tid] = __expf(sb + m_ - mt_); sc_en[tid] = __expf(-mt_); } } while (0)
  LOADC(0); WRITEC(0);
  __syncthreads();
  for (int c = 0; c < 64; ++c) {
    if (c + 1 < 64) LOADC(c + 1);
    const float* nb = nbuf + (c & 1) * 128;
    if (tid < 128) { float s = 0.f;
#pragma unroll
      for (int w = 0; w < 8; ++w) s += npart[w * 128 + tid];
      nbuf[((c + 1) & 1) * 128 + tid] = ch_dec[c] * nb[tid] + s; }
    bf16x8 qr[8];
#pragma unroll
    for (int d0 = 0; d0 < 8; ++d0) qr[d0] = *(const bf16x8*)(lds + OFF_QS + KSWZ(32 * rb + r32, (16 * d0 + 8 * hi) * 2));
    f32x16 p0 = f32x16{}, p1 = f32x16{};
#pragma unroll
    for (int d0 = 0; d0 < 8; ++d0) { const bf16x8 k0 = *(const bf16x8*)(lds + OFF_KS + KSWZ(r32, (16 * d0 + 8 * hi) * 2)); p0 = __builtin_amdgcn_mfma_f32_32x32x16_bf16(k0, qr[d0], p0, 0, 0, 0); }
    if (rb == 1) {
#pragma unroll
      for (int d0 = 0; d0 < 8; ++d0) { const bf16x8 k1 = *(const bf16x8*)(lds + OFF_KS + KSWZ(32 + r32, (16 * d0 + 8 * hi) * 2)); p1 = __builtin_amdgcn_mfma_f32_32x32x16_bf16(k1, qr[d0], p1, 0, 0, 0); }
    }
    const float al = sc_alpha[32 * rb + r32];
    if (rb == 0) {
#pragma unroll
      for (int r = 0; r < 16; ++r) { const int sl = crow(r, hi); p0[r] = (sl <= r32) ? __expf(al + sc_a[sl]) * p0[r] : 0.f; }
    } else {
#pragma unroll
      for (int r = 0; r < 16; ++r) { const int sl = crow(r, hi); p0[r] = __expf(al + sc_a[sl]) * p0[r]; p1[r] = (sl <= r32) ? __expf(al + sc_a[32 + sl]) * p1[r] : 0.f; }
    }
    float ps = 0.f;
#pragma unroll
    for (int r = 0; r < 16; ++r) ps += p0[r] + p1[r];
    ps = swap_add(ps);
    bf16x8 pa0, pa1, pa2, pa3; pack_p(p0, p1, pa0, pa1, pa2, pa3);
    float qn = 0.f;
#pragma unroll
    for (int d0 = 0; d0 < 8; ++d0) { const f32x4 n0 = *(const f32x4*)(nb + 16 * d0 + 8 * hi), n1 = *(const f32x4*)(nb + 16 * d0 + 8 * hi + 4); const v4u qw = __builtin_bit_cast(v4u, qr[d0]);
      qn += bflo(qw.x) * n0.x + bfhi(qw.x) * n0.y + bflo(qw.y) * n0.z + bfhi(qw.y) * n0.w + bflo(qw.z) * n1.x + bfhi(qw.z) * n1.y + bflo(qw.w) * n1.z + bfhi(qw.w) * n1.w; }
    qn = swap_add(qn);
    { const float iwt = sc_iw[32 * rb + r32]; const float den = iwt * qn + ps; const float rd = 1.f / fmaxf(fabsf(den), sc_en[32 * rb + r32]); if (hi == 0) wsf[r32] = rd; }
    f32x16 o = f32x16{};
#pragma unroll
    for (int d0 = 0; d0 < 8; ++d0) { const bf16x8 cf = *(const bf16x8*)(lds + OFF_CT + KSWZ(32 * cb + r32, (16 * d0 + 8 * hi) * 2)); o = __builtin_amdgcn_mfma_f32_32x32x16_bf16(qr[d0], cf, o, 0, 0, 0); }
#pragma unroll
    for (int r = 0; r < 16; ++r) o[r] *= sc_iw[32 * rb + crow(r, hi)];
    bf16x8 vf[4]; vfrags(ldsb + OFF_VV, cb, lane, vf);
    o = __builtin_amdgcn_mfma_f32_32x32x16_bf16(pa0, vf[0], o, 0, 0, 0); o = __builtin_amdgcn_mfma_f32_32x32x16_bf16(pa1, vf[1], o, 0, 0, 0);
    if (rb == 1) { o = __builtin_amdgcn_mfma_f32_32x32x16_bf16(pa2, vf[2], o, 0, 0, 0); o = __builtin_amdgcn_mfma_f32_32x32x16_bf16(pa3, vf[3], o, 0, 0, 0); }
    asm volatile("s_waitcnt lgkmcnt(0)" ::: "memory");
#pragma unroll
    for (int r = 0; r < 16; ++r) { const int tl = crow(r, hi); const int p = 64 * c + 32 * rb + tl; H[ROWOF(p) * 512 + h * 128 + 32 * cb + r32] = (bf16)f2bf(o[r] * wsf[tl]); }
    { const float dc = ch_dec[c];
#pragma unroll
      for (int i = 0; i < 3; ++i) if (i < nown) { const int db = rb ? 3 : i; bf16x8 kf[4]; vfrags(ldsb + OFF_KP, db, lane, kf);
#pragma unroll
        for (int r = 0; r < 16; ++r) cacc[i][r] *= dc;
#pragma unroll
        for (int ks = 0; ks < 4; ++ks) cacc[i] = __builtin_amdgcn_mfma_f32_32x32x16_bf16(kf[ks], vf[ks], cacc[i], 0, 0, 0); } }
    __syncthreads();
#pragma unroll
    for (int i = 0; i < 3; ++i) if (i < nown) {
#pragma unroll
      for (int g = 0; g < 4; ++g) { const int d = 32 * (rb ? 3 : i) + 8 * g + 4 * hi, e = 32 * cb + r32;
        v2u w; w.x = cvt_pk_bf16(cacc[i][4 * g], cacc[i][4 * g + 1]); w.y = cvt_pk_bf16(cacc[i][4 * g + 2], cacc[i][4 * g + 3]);
        *(v2u*)(lds + OFF_CT + KSWZ(e, d * 2)) = w; } }
    if (c + 1 < 64) WRITEC(c + 1);
    __syncthreads();
  }
#undef ROWOF
#undef LOADC
#undef WRITEC
}
#undef KSWZ
#undef PKF
}

struct ListOrder { int n, L0, L1, nN, lda, ldb;
  __device__ bool next(int i, pg8::Unit& u) const { if (i >= n) return false; const int L = i ? L1 : L0; u.pm = L / nN; u.pn = L % nN; u.g = 0; u.ibase = 0;
    u.aoff = (long)u.pm * 256 * lda; u.boff = (long)u.pn * 256 * ldb; return true; } };
__device__ __forceinline__ void publish_units(Frame& F, const ListOrder& S) {
  if (F.tid == 0) { __builtin_amdgcn_fence(__ATOMIC_RELEASE, "agent"); asm volatile("s_waitcnt vmcnt(0)" ::: "memory");
    for (int i = 0; i < S.n; ++i) { const int L = i ? S.L1 : S.L0; __hip_atomic_fetch_add(F.ctl + CW_RDY + 64 * ((L / S.nN) >> 4), 1u, RLX_AGENT); } }
}
#ifndef P3_FILL_CHUNKS
#define P3_FILL_CHUNKS 3
#endif
__device__ __forceinline__ void p3_mixers(Frame& F, const Args& a, char* lds_generic, unsigned xcc, float* ssq, float* sskv, int qoff) {
  unsigned char* ws = F.ws; const int bx = (int)blockIdx.x;
#ifndef MLSTM_REPS
#define MLSTM_REPS 1
#endif
  if (bx < 32) { for (int rp = 0; rp < MLSTM_REPS; ++rp) { mls::mlstm_seq(bx, F.ws, lds_generic); __syncthreads(); } }
  else { const int c = bx - 32;
    { ListOrder S{c < 192 ? 1 : 0, c, 0, 3, PROJ_LD, 256};
      pg8::Gemm g{(const bf16*)(ws + WS_PROJ) + PC_CQ, (const bf16*)(ws + WS_WQB), PROJ_LD, 256, 256, nullptr, 127, 127};
      EpiQ E{(bf16*)(ws + WS_QM), ssq, (const float*)(ws + WS_ROPE)};
      pg8::gemm_phase<EpiQ, ListOrder, false>(F.lds, g, S, E); publish_units(F, S); }
    { ListOrder S{c >= 192 ? 2 : 1, c >= 192 ? c - 192 : c + 32, c + 32, 4, PROJ_LD, 256};
      pg8::Gemm g{(const bf16*)(ws + WS_PROJ) + PC_CKV, (const bf16*)(ws + WS_WKVB), PROJ_LD, 256, 256, nullptr, 127, 127};
      EpiKV E{(bf16*)(ws + WS_KM), (bf16*)(ws + WS_VM), sskv};
      pg8::gemm_phase<EpiKV, ListOrder, false>(F.lds, g, S, E); publish_units(F, S); }
  }
  p3_attention(F, a, lds_generic, xcc, qoff);
  if (bx >= 32 && !qoff) conv_fill(F, a, P3_FILL_CHUNKS);
}
__device__ __forceinline__ void p4_combine(Frame& F, const Args& a) {
  unsigned char* ws = F.ws; const bf16* HF = (const bf16*)(ws + WS_HF); const bf16* HB = (const bf16*)(ws + WS_HB); const bf16* P = (const bf16*)(ws + WS_PROJ); bf16* Y = (bf16*)(ws + WS_Y);
  const float* g = (const float*)a.in[I_GHM];
  const int gw = F.vcu * NWAVES + F.wave, NGW = F.G * NWAVES, c = F.lane * 8;
  float gg[8];
#pragma unroll
  for (int j = 0; j < 8; ++j) gg[j] = g[c + j];
  for (int m0 = gw; m0 < MTOK; m0 += 2 * NGW) {
    v4u wf[2], wb[2], wo[2];
#pragma unroll
    for (int u = 0; u < 2; ++u) { const size_t m = (size_t)(m0 + u * NGW); wf[u] = *(const v4u*)(HF + m * 512 + c); wb[u] = *(const v4u*)(HB + m * 512 + c); wo[u] = *(const v4u*)(P + m * PROJ_LD + 1536 + c); }
#pragma unroll
    for (int u = 0; u < 2; ++u) { const size_t m = (size_t)(m0 + u * NGW);
      float f[8], bb[8], oo[8]; unpack8(wf[u], f); unpack8(wb[u], bb); unpack8(wo[u], oo);
      float s = 0.f;
#pragma unroll
      for (int j = 0; j < 8; ++j) { f[j] += bb[j]; s += f[j] * f[j]; }
      s += __shfl_xor(s, 1); s += __shfl_xor(s, 2); s += __shfl_xor(s, 4); s += __shfl_xor(s, 8);
      const float r = rsqrtf(s * (1.f / 128.f) + 1e-6f);
#pragma unroll
      for (int j = 0; j < 8; ++j) f[j] = f[j] * r * gg[j] * sigmoidf_(oo[j]);
      *(v4u*)(Y + m * 1024 + c) = pack8(f); }
  }
  { const float* PO = (const float*)(ws + WS_PO); const float* PML = (const float*)(ws + WS_PML); const float* ga = (const float*)a.in[I_GHA];
    constexpr float C = 0.10206207261596575f * 1.4426950408889634f; const int hh = F.lane >> 3;
    float g8[8];
#pragma unroll
    for (int j = 0; j < 8; ++j) g8[j] = ga[c + j];
    for (int m = gw; m < MTOK; m += NGW) {
      const float* p0 = PO + (size_t)m * 512 + c; const float* p1 = p0 + (size_t)MTOK * 512;
      const f32x4 a0 = *(const f32x4*)p0, a1 = *(const f32x4*)(p0 + 4), b0 = *(const f32x4*)p1, b1 = *(const f32x4*)(p1 + 4);
      const float m0 = PML[(size_t)m * 16 + hh * 2], l0 = PML[(size_t)m * 16 + hh * 2 + 1], m1 = PML[((size_t)MTOK + m) * 16 + hh * 2], l1 = PML[((size_t)MTOK + m) * 16 + hh * 2 + 1];
      const float M = fmaxf(m0, m1), e0 = __builtin_amdgcn_exp2f((m0 - M) * C), e1 = __builtin_amdgcn_exp2f((m1 - M) * C); const float rl = 1.f / (l0 * e0 + l1 * e1);
      float f[8] = {a0.x * e0 + b0.x * e1, a0.y * e0 + b0.y * e1, a0.z * e0 + b0.z * e1, a0.w * e0 + b0.w * e1, a1.x * e0 + b1.x * e1, a1.y * e0 + b1.y * e1, a1.z * e0 + b1.z * e1, a1.w * e0 + b1.w * e1};
      float s = 0.f;
#pragma unroll
      for (int j = 0; j < 8; ++j) { f[j] *= rl; s += f[j] * f[j]; }
      s += __shfl_xor(s, 1); s += __shfl_xor(s, 2); s += __shfl_xor(s, 4);
      const float r = rsqrtf(s * (1.f / 64.f) + 1e-6f);
#pragma unroll
      for (int j = 0; j < 8; ++j) f[j] = f[j] * r * g8[j];
      *(v4u*)(Y + (size_t)m * 1024 + 512 + c) = pack8(f); } }
}
struct EpiResid { static constexpr bool TWO_PASS = false; const float* base; float* out; bf16* outb; float* ss; int doq; unsigned char* outq;
  __device__ __forceinline__ void row8(const pg8::Unit& u, int rloc, int cloc, const float (&a0)[8], const float (&a1)[8], int fq) const {
    const int row = u.pm * 256 + rloc; const size_t off = (size_t)row * 1024 + u.pn * 256 + cloc;
    const f32x4 b0 = *(const f32x4*)(base + off), b1 = *(const f32x4*)(base + off + 4), b2 = *(const f32x4*)(base + off + 128), b3 = *(const f32x4*)(base + off + 132);
    float v0[8], v1[8];
#pragma unroll
    for (int i = 0; i < 4; ++i) { v0[i] = a0[i] + b0[i]; v0[4 + i] = a0[4 + i] + b1[i]; v1[i] = a1[i] + b2[i]; v1[4 + i] = a1[4 + i] + b3[i]; }
    *(f32x4*)(out + off) = (f32x4){v0[0], v0[1], v0[2], v0[3]}; *(f32x4*)(out + off + 4) = (f32x4){v0[4], v0[5], v0[6], v0[7]};
    *(f32x4*)(out + off + 128) = (f32x4){v1[0], v1[1], v1[2], v1[3]}; *(f32x4*)(out + off + 132) = (f32x4){v1[4], v1[5], v1[6], v1[7]};
    float s = sumsq8(v0) + sumsq8(v1);
    if (doq) {
#pragma unroll
      for (int i = 0; i < 8; ++i) { v0[i] = q8(v0[i], 1.f); v1[i] = q8(v1[i], 1.f); } }
    *(v4u*)(outb + off) = pack8(v0); *(v4u*)(outb + off + 128) = pack8(v1); s += __shfl_xor(s, 16); s += __shfl_xor(s, 32); if (fq == 0) unsafeAtomicAdd(ss + row, s); } };
struct EpiScale { static constexpr bool TWO_PASS = false; bf16* O; const float* ss;
  __device__ __forceinline__ void row8(const pg8::Unit& u, int rloc, int cloc, const float (&a0)[8], const float (&a1)[8], int fq) const {
    const int row = u.pm * 256 + rloc; const float r = rsqrtf(ss[row] * (1.f / 1024.f) + 1e-6f); float v0[8], v1[8];
#pragma unroll
    for (int i = 0; i < 8; ++i) { v0[i] = a0[i] * r; v1[i] = a1[i] * r; }
    bf16* p = O + (size_t)row * 1024 + u.pn * 256 + cloc; *(v4u*)p = pack8(v0); *(v4u*)(p + 128) = pack8(v1); } };
struct EpiSoftmax { static constexpr bool TWO_PASS = true; bf16* O; float scale; LAS float* xch;
  __device__ __forceinline__ void pass1(const pg8::Unit& u, int rloc, int wc, float (&v0)[8], float (&v1)[8], int fq) const {
    float mx = -3.0e38f;
#pragma unroll
    for (int i = 0; i < 8; ++i) { v0[i] *= scale; v1[i] *= scale; mx = fmaxf(mx, fmaxf(v0[i], v1[i])); }
    mx = fmaxf(mx, __shfl_xor(mx, 16)); mx = fmaxf(mx, __shfl_xor(mx, 32));
    float l = 0.f;
#pragma unroll
    for (int i = 0; i < 8; ++i) { v0[i] = __expf(v0[i] - mx); v1[i] = __expf(v1[i] - mx); l += v0[i] + v1[i]; }
    l += __shfl_xor(l, 16); l += __shfl_xor(l, 32);
    if (fq == 0) { xch[(rloc * 4 + wc) * 2] = mx; xch[(rloc * 4 + wc) * 2 + 1] = l; } }
  __device__ __forceinline__ void row8(const pg8::Unit& u, int rloc, int cloc, const float (&a0)[8], const float (&a1)[8], int fq) const {
    const int wc = cloc >> 5; float m[4], l[4]; float M = -3.0e38f;
#pragma unroll
    for (int w = 0; w < 4; ++w) { m[w] = xch[(rloc * 4 + w) * 2]; l[w] = xch[(rloc * 4 + w) * 2 + 1]; M = fmaxf(M, m[w]); }
    float L = 0.f, mine = 0.f;
#pragma unroll
    for (int w = 0; w < 4; ++w) { const float e = __expf(m[w] - M); L += l[w] * e; if (w == wc) mine = e; }
    const float f = mine / L; float v0[8], v1[8];
#pragma unroll
    for (int i = 0; i < 8; ++i) { v0[i] = a0[i] * f; v1[i] = a1[i] * f; }
    bf16* p = O + (size_t)(u.pm * 256 + rloc) * 1024 + u.pn * 256 + cloc; *(v4u*)p = pack8(v0); *(v4u*)(p + 128) = pack8(v1); } };
struct MemOrder { int G, c, kind;
  __device__ bool next(int i, pg8::Unit& u) const { const int L = i * G + c; if (L >= 256) return false;
    const int bh = L >> 4, t = L & 15, b = bh >> 2, h = bh & 3;
    u.pm = b * 16 + t; u.pn = h; u.g = 0; u.ibase = 0; u.aoff = ((long)(b * SEQ + t * 256)) * 1024 + (kind == 2 ? 0 : h * 256);
    u.boff = kind == 0 ? ((long)(b * NMEM)) * 1024 + h * 256 : kind == 1 ? ((long)(h * 256)) * 1024 + b * NMEM : ((long)(h * 256)) * 1024; return true; } };
constexpr size_t WS_WRG = WS_DEC + 65536;
constexpr size_t WS_ROWSEL = WS_SEL, WS_GSEL = WS_SEL + 131072, WS_INV = 31 * MiB, WS_YE = 160 * MiB;
typedef float f32x4m __attribute__((ext_vector_type(4)));
__device__ __forceinline__ void p10_router(Frame& F, const Args& a) {
  unsigned char* ws = F.ws; const float* X2 = (const float*)(ws + WS_X2); const float* ss2 = (const float*)(ws + CTL_SS2); float* AFF = (float*)(ws + WS_AFF); const float* WRG = (const float*)(ws + WS_WRG);
  const int gw = F.vcu * NWAVES + F.wave, NGW = F.G * NWAVES, r = F.lane & 15, kq = F.lane >> 4;
  LAS float* wl = (LAS float*)F.lds;
  for (int i = F.tid; i < 4096; i += NTHR) ((LAS f32x4*)wl)[i] = ((const f32x4*)WRG)[i];
  __syncthreads();
  for (int it = gw; it < MTOK / 16; it += NGW) { const int m0 = it * 16;
    const float* xp = X2 + (size_t)(m0 + r) * 1024 + 4 * kq; const LAS float* wp = wl + (4 * kq) * 16 + r;
    f32x4m acc0 = {0.f, 0.f, 0.f, 0.f}, acc1 = {0.f, 0.f, 0.f, 0.f};
#pragma unroll 1
    for (int hf = 0; hf < 2; ++hf) {
      f32x4 xv[32];
#pragma unroll
      for (int j = 0; j < 32; ++j) xv[j] = *(const f32x4*)(xp + 16 * (32 * hf + j));
#pragma unroll
      for (int j = 0; j < 32; j += 2) { const LAS float* w0 = wp + (16 * (32 * hf + j)) * 16; const LAS float* w1 = w0 + 256;
        acc0 = __builtin_amdgcn_mfma_f32_16x16x4f32(xv[j].x, w0[0], acc0, 0, 0, 0); acc1 = __builtin_amdgcn_mfma_f32_16x16x4f32(xv[j + 1].x, w1[0], acc1, 0, 0, 0);
        acc0 = __builtin_amdgcn_mfma_f32_16x16x4f32(xv[j].y, w0[16], acc0, 0, 0, 0); acc1 = __builtin_amdgcn_mfma_f32_16x16x4f32(xv[j + 1].y, w1[16], acc1, 0, 0, 0);
        acc0 = __builtin_amdgcn_mfma_f32_16x16x4f32(xv[j].z, w0[32], acc0, 0, 0, 0); acc1 = __builtin_amdgcn_mfma_f32_16x16x4f32(xv[j + 1].z, w1[32], acc1, 0, 0, 0);
        acc0 = __builtin_amdgcn_mfma_f32_16x16x4f32(xv[j].w, w0[48], acc0, 0, 0, 0); acc1 = __builtin_amdgcn_mfma_f32_16x16x4f32(xv[j + 1].w, w1[48], acc1, 0, 0, 0); }
    }
#pragma unroll
    for (int i = 0; i < 4; ++i) { const int row = m0 + 4 * kq + i; const float lg = (acc0[i] + acc1[i]) * rsqrtf(ss2[row] * (1.f / 1024.f) + 1e-6f);
      float mx = lg; mx = fmaxf(mx, __shfl_xor(mx, 1)); mx = fmaxf(mx, __shfl_xor(mx, 2)); mx = fmaxf(mx, __shfl_xor(mx, 4)); mx = fmaxf(mx, __shfl_xor(mx, 8));
      const float ex = __expf(lg - mx); float l = ex; l += __shfl_xor(l, 1); l += __shfl_xor(l, 2); l += __shfl_xor(l, 4); l += __shfl_xor(l, 8);
      AFF[(size_t)row * 16 + r] = ex / l; }
  }
  __syncthreads();
}
__device__ __forceinline__ void p11_topk(Frame& F, char* lds) {
  unsigned char* ws = F.ws; const float* AFF = (const float*)(ws + WS_AFF); int* ROWSEL = (int*)(ws + WS_ROWSEL); float* GSEL = (float*)(ws + WS_GSEL); int* INV = (int*)(ws + WS_INV);
  unsigned* hist = (unsigned*)lds; unsigned* ctl = hist + 256; unsigned* wsum = hist + 320;
  const int tid = F.tid, lane = F.lane, wid = F.wave;
  for (int it = (int)blockIdx.x; it < BATCH * NEXP; it += F.G) { const int b = it >> 4, e = it & 15;
    unsigned key[8];
#pragma unroll
    for (int j = 0; j < 8; ++j) key[j] = __float_as_uint(AFF[((size_t)b * SEQ + 8 * tid + j) * 16 + e]);
    unsigned prefix = 0u, mask = 0u, need = CAP;
    for (int shift = 24; shift >= 0; shift -= 8) {
      if (tid < 256) hist[tid] = 0u;
      __syncthreads();
#pragma unroll
      for (int j = 0; j < 8; ++j) if ((key[j] & mask) == prefix) atomicAdd(&hist[(key[j] >> shift) & 255u], 1u);
      __syncthreads();
      if (tid == 0) { unsigned above = 0u; int d = 255; for (; d > 0; --d) { const unsigned c = hist[d]; if (above + c >= need) break; above += c; } ctl[0] = (unsigned)d; ctl[1] = need - above; }
      __syncthreads();
      prefix |= ctl[0] << shift; mask |= 255u << shift; need = ctl[1];
      __syncthreads();
    }
    unsigned ngt = 0u, neq = 0u;
#pragma unroll
    for (int j = 0; j < 8; ++j) { ngt += key[j] > prefix ? 1u : 0u; neq += key[j] == prefix ? 1u : 0u; }
    unsigned sgt = ngt, seq_ = neq;
#pragma unroll
    for (int o = 1; o < 64; o <<= 1) { const unsigned y0 = __shfl_up(sgt, o), y1 = __shfl_up(seq_, o); if (lane >= o) { sgt += y0; seq_ += y1; } }
    if (lane == 63) { wsum[wid] = sgt; wsum[8 + wid] = seq_; }
    __syncthreads();
    unsigned bgt = 0u, beq = 0u, tgt = 0u;
#pragma unroll
    for (int w = 0; w < 8; ++w) { const unsigned g = wsum[w], q = wsum[8 + w]; if (w < wid) { bgt += g; beq += q; } tgt += g; }
    unsigned pgt = bgt + sgt - ngt, peq = beq + seq_ - neq;
#pragma unroll
    for (int j = 0; j < 8; ++j) { const int t = 8 * tid + j; int slot = -1;
      if (key[j] > prefix) slot = (int)pgt++; else if (key[j] == prefix) { if (peq < need) slot = (int)(tgt + peq); ++peq; }
      INV[((size_t)b * SEQ + t) * 16 + e] = slot;
      if (slot >= 0) { ROWSEL[e * 2048 + b * 512 + slot] = b * SEQ + t; GSEL[e * 2048 + b * 512 + slot] = __uint_as_float(key[j]); } }
    __syncthreads();
  }
}
#ifndef GU_ORDER
#define GU_ORDER 1
#endif
#ifndef DN_ORDER
#define DN_ORDER 1
#endif
struct MoeGUOrder { int G, c;
  __device__ bool next(int i, pg8::Unit& u) const { const int L = i * G + c; if (L >= 2048) return false;
#if GU_ORDER == 0
    const int e = L >> 7, r = L & 127, pn = r >> 3, mt = r & 7;
#elif GU_ORDER == 1
    const int e = L >> 7, r = L & 127, mt = r >> 4, pn = r & 15;
#else
    const int x = c & 7, j = c >> 3, e = (i >> 2) * 8 + x, r = (i & 3) * 32 + j, mt = r >> 4, pn = r & 15;
#endif
    u.g = e; u.pm = mt; u.pn = pn; u.ibase = e * 2048 + mt * 256; u.aoff = MOE_FP8 ? ((long)e * 2048 + mt * 256) * 512 : 0; u.boff = ((long)e * 4096 + pn * 256) * (MOE_FP8 ? 512 : 1024); return true; } };
struct MoeDownOrder { int G, c;
  __device__ bool next(int i, pg8::Unit& u) const { const int L = i * G + c; if (L >= 512) return false;
#if DN_ORDER == 0
    const int e = L >> 5, r = L & 31, pn = r >> 3, mt = r & 7;
#else
    const int x = c & 7, j = c >> 3, e = i * 8 + x, pn = j >> 3, mt = j & 7;
#endif
    u.g = e; u.pm = mt; u.pn = pn; u.ibase = e * 2048 + mt * 256; u.aoff = ((long)e * 2048 + mt * 256) * (MOE_FP8_DOWN ? 1024 : 2048); u.boff = ((long)e * 1024 + pn * 256) * (MOE_FP8_DOWN ? 1024 : 2048); return true; } };
struct EpiGU { static constexpr bool TWO_PASS = false; bf16* H; const float* ss2; const int* rowsel;
  __device__ __forceinline__ void row8(const pg8::Unit& u, int rloc, int cloc, const float (&a0)[8], const float (&a1)[8], int fq) const {
    const int tok = rowsel[u.ibase + rloc]; const float r = rsqrtf(ss2[tok] * (1.f / 1024.f) + 1e-6f); float h[8];
#pragma unroll
    for (int i = 0; i < 8; ++i) { const float g = a0[i] * r, up = a1[i] * r; h[i] = g * sigmoidf_(g) * up; if (FP8EMU) h[i] = q8(h[i], 8.f); }
#if MOE_FP8_DOWN
    *(v2u*)((unsigned char*)H + ((size_t)u.g * 2048 + u.pm * 256 + rloc) * 2048 + u.pn * 128 + cloc) = pack8_fp8(h, 8.f); } };
#else
    *(v4u*)(H + ((size_t)u.g * 2048 + u.pm * 256 + rloc) * 2048 + u.pn * 128 + cloc) = pack8(h); } };
#endif
struct EpiGU8 { static constexpr bool TWO_PASS = false; unsigned char* H8; const float* ss2; const int* rowsel;
  __device__ __forceinline__ void row8(const pg8::Unit& u, int rloc, int cloc, const float (&a0)[8], const float (&a1)[8], int fq) const {
    float h[8];
#pragma unroll
    for (int i = 0; i < 8; ++i) { const float g = a0[i], up = a1[i]; h[i] = g * sigmoidf_(g) * up; }
#if MOE_FP8_DOWN
    *(v2u*)(H8 + ((size_t)u.g * 2048 + u.pm * 256 + rloc) * 2048 + u.pn * 128 + cloc) = pack8_fp8(h, 8.f); } };
#else
    *(v4u*)((bf16*)H8 + ((size_t)u.g * 2048 + u.pm * 256 + rloc) * 2048 + u.pn * 128 + cloc) = pack8(h); } };
#endif
struct EpiYE { static constexpr bool TWO_PASS = false; bf16* Yp; const float* gsel;
  __device__ __forceinline__ void row8(const pg8::Unit& u, int rloc, int cloc, const float (&a0)[8], const float (&a1)[8], int fq) const {
    const float gv = gsel[u.ibase + rloc]; float v0[8], v1[8];
#pragma unroll
    for (int i = 0; i < 8; ++i) { v0[i] = a0[i] * gv; v1[i] = a1[i] * gv; }
    bf16* p = Yp + ((size_t)u.g * 2048 + u.pm * 256 + rloc) * 1024 + u.pn * 256 + cloc; *(v4u*)p = pack8(v0); *(v4u*)(p + 128) = pack8(v1); } };
__device__ __forceinline__ void p14_final(Frame& F, const Args& a) {
  unsigned char* ws = F.ws; const float* X2 = (const float*)(ws + WS_X2); const int* INV = (const int*)(ws + WS_INV); const bf16* YE = (const bf16*)(ws + WS_YE);
  const float* gfin = (const float*)a.in[I_GFIN]; float* out = a.out;
  const int gw = F.vcu * NWAVES + F.wave, NGW = F.G * NWAVES;
  f32x4 g[4];
#pragma unroll
  for (int j = 0; j < 4; ++j) g[j] = *(const f32x4*)(gfin + 256 * j + 4 * F.lane);
  for (int m0 = gw; m0 < MTOK; m0 += 2 * NGW) {
    f32x4 v[2][4]; int inv[2];
#pragma unroll
    for (int u = 0; u < 2; ++u) { const int m = m0 + u * NGW;
#pragma unroll
      for (int j = 0; j < 4; ++j) v[u][j] = *(const f32x4*)(X2 + (size_t)m * 1024 + 256 * j + 4 * F.lane);
      inv[u] = F.lane < 16 ? INV[(size_t)m * 16 + F.lane] : -1; }
#pragma unroll
    for (int u = 0; u < 2; ++u) { const int m = m0 + u * NGW, b = m >> 12;
      unsigned long long sel = __ballot(inv[u] >= 0);
      while (sel) { const int e = __builtin_ctzll(sel); sel &= sel - 1; const int slot = __shfl(inv[u], e);
        const bf16* yr = YE + ((size_t)e * 2048 + b * 512 + slot) * 1024 + 4 * F.lane;
#pragma unroll
        for (int j = 0; j < 4; ++j) { const v2u w = *(const v2u*)(yr + 256 * j); v[u][j].x += bflo(w.x); v[u][j].y += bfhi(w.x); v[u][j].z += bflo(w.y); v[u][j].w += bfhi(w.y); } }
      float s = 0.f;
#pragma unroll
      for (int j = 0; j < 4; ++j) s += (v[u][j].x * v[u][j].x + v[u][j].y * v[u][j].y) + (v[u][j].z * v[u][j].z + v[u][j].w * v[u][j].w);
      const float r = rsqrtf(wave_sum(s) * (1.f / 1024.f) + 1e-6f);
#pragma unroll
      for (int j = 0; j < 4; ++j) *(f32x4*)(out + (size_t)m * 1024 + 256 * j + 4 * F.lane) = v[u][j] * r * g[j]; }
  }
}
__global__ void __launch_bounds__(NTHR, 2) mk(Args a) {
  extern __shared__ __attribute__((aligned(16))) unsigned char lds_raw[];
  Frame F;
  F.lds = (LAS unsigned char*)lds_raw; F.MISC = (volatile LAS unsigned*)(F.lds + LDSCTL_OFF + 320);
  F.tid = threadIdx.x; F.lane = F.tid & 63; F.wave = __builtin_amdgcn_readfirstlane(F.tid >> 6);
  F.G = gridDim.x; { const int bx = blockIdx.x; F.vcu = (F.G % 8 == 0) ? (bx % 8) * (F.G / 8) + bx / 8 : bx; }
  F.ws = a.ws; F.ctl = (gu32*)(a.ws + WS_CTL);
  unsigned char* ws = a.ws;
  for (int u = F.tid; u < (LDS_BYTES - LDSCTL_OFF) / 4; u += NTHR) ((LAS unsigned*)(F.lds + LDSCTL_OFF))[u] = 0u;
  __syncthreads();
  XcdBarrier bar = xcd_barrier_post((unsigned*)(F.ctl + CW_BAR), F.MISC + 8);
  const int lo = a.ph_lo, hi = a.ph_hi;
#define IN(k) (lo <= (k) && (k) < hi)
#define BOTH(k) (IN(k) && IN((k) + 1))
#define GRID_BAR() xcd_barrier(bar)
  float* ssq = (float*)(ws + CTL_SSQ); float* sskv = (float*)(ws + CTL_SSKV);

#ifndef REP_MASK
#define REP_MASK 0
#endif
#define NREP(k) ((((REP_MASK) >> (k)) & 1) ? 2 : 1)
#define PH_BEGIN(k) if (IN(k)) { for (int rep_ = 0; rep_ < NREP(k); ++rep_) { const bool dry = rep_ + 1 < NREP(k); (void)dry;
#define PH_END(k) if (dry) GRID_BAR(); } if (BOTH(k)) GRID_BAR(); }
  float* dummy = (float*)(ws + WS_DUMMY);
  float* ss1 = (float*)(ws + CTL_SS1); float* ss2 = (float*)(ws + CTL_SS2);
#ifndef FILLMODE
#define FILLMODE 2
#endif
  PH_BEGIN(0) p0_prologue(F, a, true, FILLMODE == 0); PH_END(0)
  PH_BEGIN(1)
    { pg8::Gemm g{(const bf16*)(ws + WS_XN), (const bf16*)(ws + WS_WIN), 1024, 1024, 1024, nullptr, 127, 127}; pg8::StaticOrder S; S.init(MTOK, PROJ_LD, F.G, (int)blockIdx.x, 1024, 1024);
      EpiProj E{(bf16*)(ws + WS_PROJ), dry ? dummy : ssq, dry ? dummy + 16384 : sskv};
      pg8::gemm_phase<EpiProj, pg8::StaticOrder, false>(F.lds, g, S, E); }
    { pg8::Gemm g{(const bf16*)(ws + WS_MEMN), (const bf16*)(ws + WS_WMK), 1024, 1024, 1024, nullptr, 127, 127}; pg8::StaticOrder S; S.init(1024, 1024, F.G, (int)((blockIdx.x + 128u) % (unsigned)F.G), 1024, 1024);
      EpiStore E{(bf16*)(ws + WS_KMEM), 1024};
      pg8::gemm_phase<EpiStore, pg8::StaticOrder, false>(F.lds, g, S, E); }
    { pg8::Gemm g{(const bf16*)(ws + WS_WMV), (const bf16*)(ws + WS_MEMN), 1024, 1024, 1024, nullptr, 127, 127}; pg8::StaticOrder S; S.init(1024, 1024, F.G, (int)((blockIdx.x + 112u) % (unsigned)F.G), 1024, 1024);
      EpiStore E{(bf16*)(ws + WS_VMEMT), 1024};
      pg8::gemm_phase<EpiStore, pg8::StaticOrder, false>(F.lds, g, S, E); }
  PH_END(1)
  PH_BEGIN(2) p2_elementwise(F, a); PH_END(2)
  PH_BEGIN(3) p3_mixers(F, a, (char*)lds_raw, bar.x, ssq, sskv, dry ? 64 * 16 : 0); PH_END(3)
  PH_BEGIN(4) p4_combine(F, a); PH_END(4)
  PH_BEGIN(5)
    pg8::Gemm g{(const bf16*)(ws + WS_Y), (const bf16*)(ws + WS_WOUT), 1024, 1024, 1024, nullptr, 127, 127}; pg8::StaticOrder S; S.init(MTOK, 1024, F.G, (int)blockIdx.x, 1024, 1024);
    EpiResid E{(const float*)a.in[I_X], (float*)(ws + WS_X1), (bf16*)(ws + WS_X1B), dry ? dummy : ss1, 0, nullptr};
    pg8::gemm_phase<EpiResid, pg8::StaticOrder, false>(F.lds, g, S, E);
  PH_END(5)
  PH_BEGIN(6)
    { pg8::Gemm g{(const bf16*)(ws + WS_X1B), (const bf16*)(ws + WS_WMQ), 1024, 1024, 1024, nullptr, 127, 127}; MemOrder S{F.G, (int)blockIdx.x, 2};
      EpiScale E{(bf16*)(ws + WS_QMEM), ss1};
      pg8::gemm_phase<EpiScale, MemOrder, false>(F.lds, g, S, E); }
    if (F.tid == 0) __builtin_amdgcn_fence(__ATOMIC_ACQUIRE, "agent");
    asm volatile("s_waitcnt vmcnt(0)" ::: "memory"); __syncthreads();
    { pg8::Gemm g{(const bf16*)(ws + WS_QMEM), (const bf16*)(ws + WS_KMEM), 1024, 1024, 256, nullptr, 127, 127}; MemOrder S{F.G, (int)blockIdx.x, 0};
      EpiSoftmax E{(bf16*)(ws + WS_P), 0.0625f, (LAS float*)(F.lds + LDSCTL_OFF + 1024)};
      pg8::gemm_phase<EpiSoftmax, MemOrder, false>(F.lds, g, S, E); }
    if (F.tid == 0) __builtin_amdgcn_fence(__ATOMIC_ACQUIRE, "agent");
    asm volatile("s_waitcnt vmcnt(0)" ::: "memory"); __syncthreads();
    { pg8::Gemm g{(const bf16*)(ws + WS_P), (const bf16*)(ws + WS_VMEMT), 1024, 1024, 256, nullptr, 127, 127}; MemOrder S{F.G, (int)blockIdx.x, 1};
      EpiStore E{(bf16*)(ws + WS_MO), 1024};
      pg8::gemm_phase<EpiStore, MemOrder, false>(F.lds, g, S, E); }
  PH_END(6)
  PH_BEGIN(9)
    pg8::Gemm g{(const bf16*)(ws + WS_MO), (const bf16*)(ws + WS_WMO), 1024, 1024, 1024, nullptr, 127, 127}; pg8::StaticOrder S; S.init(MTOK, 1024, F.G, (int)blockIdx.x, 1024, 1024);
    EpiResid E{(const float*)(ws + WS_X1), (float*)(ws + WS_X2), (bf16*)(ws + WS_X2B), dry ? dummy : ss2, FP8EMU, nullptr};
    pg8::gemm_phase<EpiResid, pg8::StaticOrder, false>(F.lds, g, S, E);
  PH_END(9)
  PH_BEGIN(10) p10_router(F, a); PH_END(10)
  PH_BEGIN(11) p11_topk(F, (char*)lds_raw);
    if (!dry && FILLMODE != 0) conv_fill(F, a, 1 << 30);
  PH_END(11)
  PH_BEGIN(12)
#if MOE_FP8
    {
      const int gw = F.vcu * NWAVES + F.wave, NGW = F.G * NWAVES; const int* rs = (const int*)(ws + WS_ROWSEL);
      for (int r0 = gw; r0 < NEXP * 2048; r0 += 4 * NGW) {
        int tok[4]; float rn[4]; f32x4 q[4][4];
#pragma unroll
        for (int u = 0; u < 4; ++u) { const int r = r0 + u * NGW; tok[u] = r < NEXP * 2048 ? rs[r] : 0; }
#pragma unroll
        for (int u = 0; u < 4; ++u) { const float* xr = (const float*)(ws + WS_X2) + (size_t)tok[u] * 1024 + F.lane * 16; rn[u] = ss2[tok[u]];
#pragma unroll
          for (int j = 0; j < 4; ++j) q[u][j] = *(const f32x4*)(xr + 4 * j); }
#pragma unroll
        for (int u = 0; u < 4; ++u) { const int r = r0 + u * NGW; const float s = rsqrtf(rn[u] * (1.f / 1024.f) + 1e-6f);
          const f32x4 a0 = q[u][0] * s, a1 = q[u][1] * s, a2 = q[u][2] * s, a3 = q[u][3] * s;
          const float lo[8] = {a0.x, a0.y, a0.z, a0.w, a1.x, a1.y, a1.z, a1.w}, hi[8] = {a2.x, a2.y, a2.z, a2.w, a3.x, a3.y, a3.z, a3.w};
          const v2u a8 = pack8_fp8(lo, 1.f), b8 = pack8_fp8(hi, 1.f); v4u o; o.x = a8.x; o.y = a8.y; o.z = b8.x; o.w = b8.y;
          if (r < NEXP * 2048) *(v4u*)(ws + WS_XG + (size_t)r * 1024 + F.lane * 16) = o; } }
      GRID_BAR(); }
    pg8::Gemm g{(const bf16*)(ws + WS_XG), (const bf16*)(ws + WS_WEGU8), 512, 512, 512, nullptr, 127, 121}; MoeGUOrder S{F.G, (int)blockIdx.x};
    EpiGU8 E{(unsigned char*)(ws + WS_HID8), ss2, (const int*)(ws + WS_ROWSEL)};
    pg8::gemm_phase<EpiGU8, MoeGUOrder, false, 1>(F.lds, g, S, E);
#else
    pg8::Gemm g{(const bf16*)(ws + WS_X2B), (const bf16*)(ws + WS_WEGU), 1024, 1024, 1024, (const int*)(ws + WS_ROWSEL), 127, 127}; MoeGUOrder S{F.G, (int)blockIdx.x};
    EpiGU E{(bf16*)(ws + WS_HID), ss2, (const int*)(ws + WS_ROWSEL)};
    pg8::gemm_phase<EpiGU, MoeGUOrder, true>(F.lds, g, S, E);
#endif
  PH_END(12)
  PH_BEGIN(13)
#if MOE_FP8_DOWN
    pg8::Gemm g{(const bf16*)(ws + WS_HID8), (const bf16*)(ws + WS_WED8), 1024, 1024, 1024, nullptr, 124, 121}; MoeDownOrder S{F.G, (int)blockIdx.x};
    EpiYE E{(bf16*)(ws + WS_YE), (const float*)(ws + WS_GSEL)};
    pg8::gemm_phase<EpiYE, MoeDownOrder, false, 1>(F.lds, g, S, E);
#else
    pg8::Gemm g{(const bf16*)(ws + WS_HID), (const bf16*)(ws + WS_WED), 2048, 2048, 2048, nullptr, 127, 127}; MoeDownOrder S{F.G, (int)blockIdx.x};
    EpiYE E{(bf16*)(ws + WS_YE), (const float*)(ws + WS_GSEL)};
    pg8::gemm_phase<EpiYE, MoeDownOrder, false>(F.lds, g, S, E);
#endif
  PH_END(13)
  PH_BEGIN(14) p14_final(F, a); PH_END(14)
#undef IN
#undef BOTH
#undef GRID_BAR
}

__global__ __launch_bounds__(256) void adapt_b2f(const bf16* src, long lds_, long scol, float* dst, long ldd, long dcol, long rows, long ncols) {
  const long i = blockIdx.x * 256L + threadIdx.x; if (i >= rows * ncols) return;
  const long r = i / ncols, c = i % ncols; dst[r * ldd + dcol + c] = bf2f(src[r * lds_ + scol + c]);
}
static void adapt(hipStream_t s, const void* src, long lds_, long scol, float* dst, long ldd, long dcol, long rows, long ncols) {
  hipLaunchKernelGGL(adapt_b2f, dim3((unsigned)((rows * ncols + 255) / 256)), dim3(256), 0, s, (const bf16*)src, lds_, scol, dst, ldd, dcol, rows, ncols);
}

static int mk_grid() {
  static int grid = 0;
  if (grid == 0) {
    int dev = 0, cus = 0, per_cu = 0;
    (void)hipGetDevice(&dev); (void)hipDeviceGetAttribute(&cus, hipDeviceAttributeMultiprocessorCount, dev);
    (void)hipFuncSetAttribute((const void*)mk, hipFuncAttributeMaxDynamicSharedMemorySize, LDS_BYTES);
    (void)hipOccupancyMaxActiveBlocksPerMultiprocessor(&per_cu, (const void*)mk, NTHR, LDS_BYTES);
    (void)hipGetLastError();
    grid = cus > 0 ? cus : 256;
  }
  return grid;
}
static void mk_launch(hipStream_t s, void* const* d_in, void* d_out, void* d_ws, int lo, int hi, int flags) {
  Args a; memset(&a, 0, sizeof(a));
  for (int i = 0; i < 26; ++i) a.in[i] = d_in[i];
  a.out = (float*)d_out; a.ws = (unsigned char*)d_ws; a.ph_lo = lo; a.ph_hi = hi; a.flags = flags; a.pad = 0;
  (void)hipMemsetAsync((char*)d_ws + WS_CTL + CW_BAR * 4, 0, XCD_BAR_WORDS * 4, s);
  hipLaunchKernelGGL(mk, dim3(mk_grid()), dim3(NTHR), LDS_BYTES, s, a);
}

extern "C" void kernel_launch(void* const* d_in, const int* in_sizes, int n_in, void* d_out, int out_size, void* d_ws, size_t ws_size, hipStream_t s) {
  (void)hipMemsetAsync((char*)d_ws + WS_CTL, 0, CTL_ZERO_BYTES, s);
  mk_launch(s, d_in, d_out, d_ws, 0, 15, 1);
}
```

```cpp
#include <hip/hip_runtime.h>
#include <cstdint>
#include <cstdio>
#include <cstring>

constexpr int BATCH = 4, SEQ = 4096, DM = 1024, MTOK = BATCH * SEQ;
constexpr int D_IN = 2480;
constexpr int OFF_QM = 0, OFF_KM = 512, OFF_VM = 1024, OFF_OM = 1536, OFF_G = 2048, OFF_CQ = 2064, OFF_CKV = 2320, OFF_KR = 2448;
constexpr int NEXP = 16, CAP = 512, DFF = 2048, NMEM = 256;
constexpr size_t MiB = 1u << 20;
enum { I_X = 0, I_MEM, I_POS, I_GMIX, I_WIN, I_BG, I_CONV, I_GQA, I_WQB, I_GKVA, I_WKVB, I_GHM, I_GHA, I_WOUT, I_GMX, I_GMKV, I_WMQ, I_WMK, I_WMV, I_WMO, I_GFFN, I_WR, I_WEG, I_WEU, I_WED, I_GFIN };
#define GAS __attribute__((address_space(1)))
#define LAS __attribute__((address_space(3)))
typedef unsigned short bf16;
typedef unsigned v4u __attribute__((ext_vector_type(4)));
typedef unsigned v2u __attribute__((ext_vector_type(2)));
typedef float f32x4 __attribute__((ext_vector_type(4)));
typedef float f32x16 __attribute__((ext_vector_type(16)));
typedef short bf16x8 __attribute__((ext_vector_type(8)));
typedef short s16x4 __attribute__((ext_vector_type(4)));
typedef GAS unsigned gu32;
#define RLX_AGENT __ATOMIC_RELAXED, __HIP_MEMORY_SCOPE_AGENT
#define LDS_WAIT() asm volatile("s_waitcnt lgkmcnt(0)" ::: "memory")
#define VM_WAIT() asm volatile("s_waitcnt vmcnt(0)" ::: "memory")
constexpr int NWAVES = 8, NTHR = 512;
__device__ __forceinline__ unsigned f2bf(float f) { unsigned u = __builtin_bit_cast(unsigned, f); return (u + 0x7fffu + ((u >> 16) & 1u)) >> 16; }
__device__ __forceinline__ unsigned pk2(float lo, float hi) { return f2bf(lo) | (f2bf(hi) << 16); }
__device__ __forceinline__ float bf2f(unsigned short h) { return __builtin_bit_cast(float, (unsigned)h << 16); }
__device__ __forceinline__ float bflo(unsigned w) { return __builtin_bit_cast(float, w << 16); }
__device__ __forceinline__ float bfhi(unsigned w) { return __builtin_bit_cast(float, w & 0xffff0000u); }
typedef float f32x2_t __attribute__((ext_vector_type(2))); typedef __bf16 bf16x2_t __attribute__((ext_vector_type(2)));
__device__ __forceinline__ unsigned cvt_pk_bf16(float lo, float hi) { f32x2_t v = {lo, hi}; bf16x2_t b = __builtin_convertvector(v, bf16x2_t); return __builtin_bit_cast(unsigned, b); }
__device__ __forceinline__ v2u pack8_fp8(const float (&v)[8], float sc) { float c[8];
#pragma unroll
  for (int i = 0; i < 8; ++i) c[i] = __builtin_amdgcn_fmed3f(v[i] * sc, -448.f, 448.f);
  int a = 0, b = 0; a = __builtin_amdgcn_cvt_pk_fp8_f32(c[0], c[1], a, false); a = __builtin_amdgcn_cvt_pk_fp8_f32(c[2], c[3], a, true);
  b = __builtin_amdgcn_cvt_pk_fp8_f32(c[4], c[5], b, false); b = __builtin_amdgcn_cvt_pk_fp8_f32(c[6], c[7], b, true); v2u r; r.x = (unsigned)a; r.y = (unsigned)b; return r; }
__device__ __forceinline__ float q8(float x, float sc) { const int p = __builtin_amdgcn_cvt_pk_fp8_f32(x * sc, 0.f, 0, false); return __builtin_amdgcn_cvt_f32_fp8(p, 0) * (1.f / sc); }
__device__ __forceinline__ float wave_sum(float v) {
#pragma unroll
  for (int o = 1; o < 64; o <<= 1) v += __shfl_xor(v, o);
  return v;
}
__device__ __forceinline__ float sigmoidf_(float x) { return 1.f / (1.f + __expf(-x)); }

#define XB_TMO      128
#define XB_XCNT(j)  (256  + 64 * (j))
#define XB_XSUB(j)  (1280 + 64 * (j))
#define XB_XGEN(j)  (2304 + 64 * (j))
#define XB_TOP      3328
#define XB_TOPGEN   3392
#define XCD_BAR_WORDS 3456
#define XB_SPIN_CAP (1u << 22)
__device__ __forceinline__ unsigned xb_ld(unsigned* p)              { return __hip_atomic_load(p, __ATOMIC_RELAXED, __HIP_MEMORY_SCOPE_AGENT); }
__device__ __forceinline__ unsigned xb_add(unsigned* p, unsigned v) { return __hip_atomic_fetch_add(p, v, __ATOMIC_RELAXED, __HIP_MEMORY_SCOPE_AGENT); }
__device__ __forceinline__ unsigned xb_xcc_id() { return (unsigned)__builtin_amdgcn_s_getreg((3 << 11) | 20) & 0xFu; }
#define XB_SPIN(cond, bar) do { unsigned _sp = 0; while (cond) { __builtin_amdgcn_s_sleep(1); \
    if ((++_sp & 255u) == 0u) { if (xb_ld(&(bar)[XB_TMO])) break; if (_sp > XB_SPIN_CAP) { atomicAdd(&(bar)[XB_TMO], 1u); break; } } } } while (0)
struct XcdBarrier { unsigned* bar; unsigned x; volatile LAS unsigned* st; };
__device__ __forceinline__ XcdBarrier xcd_barrier_post(unsigned* bar, volatile LAS unsigned* st) {
  XcdBarrier b; b.bar = bar; b.x = xb_xcc_id(); b.st = st;
  if (threadIdx.x == 0) (void)xb_add(&bar[XB_XCNT(b.x)], 1u);
  return b;
}
__device__ __forceinline__ void xcd_barrier_complete(unsigned* bar, unsigned x, unsigned& nloc, unsigned& nx) {
  const unsigned G = gridDim.x * gridDim.y * gridDim.z;
  unsigned sum, cnt, mine, sp = 0u;
  for (;;) {
    sum = 0u; cnt = 0u; mine = 0u;
#pragma unroll
    for (unsigned j = 0; j < 16; ++j) { const unsigned c = xb_ld(&bar[XB_XCNT(j)]); sum += c; cnt += (c > 0u) ? 1u : 0u; mine = (j == x) ? c : mine; }
    if (sum == G) break;
    __builtin_amdgcn_s_sleep(1);
    if ((++sp & 255u) == 0u) { if (xb_ld(&bar[XB_TMO])) break; if (sp > XB_SPIN_CAP) { atomicAdd(&bar[XB_TMO], 1u); break; } }
  }
  nloc = mine > 0u ? mine : 1u; nx = cnt > 0u ? cnt : 1u;
}
__device__ __forceinline__ void xcd_barrier(const XcdBarrier& b) {
  asm volatile("s_waitcnt vmcnt(0)" ::: "memory");
  __syncthreads();
  if (threadIdx.x == 0) {
    unsigned* bar = b.bar;
    __builtin_amdgcn_s_waitcnt(0);
    unsigned nloc = b.st[0], nx = b.st[1];
    if (nloc == 0u) { xcd_barrier_complete(bar, b.x, nloc, nx); b.st[0] = nloc; b.st[1] = nx; }
    const unsigned old = xb_add(&bar[XB_XSUB(b.x)], 1u);
    const unsigned gen = old / nloc;
    if (old + 1u == (gen + 1u) * nloc) {
      __builtin_amdgcn_fence(__ATOMIC_RELEASE, "agent");
      asm volatile("s_waitcnt vmcnt(0)" ::: "memory");
      const unsigned og = xb_add(&bar[XB_TOP], 1u);
      const unsigned tg = og / nx;
      if (og + 1u == (tg + 1u) * nx) xb_add(&bar[XB_TOPGEN], 1u);
      else XB_SPIN(xb_ld(&bar[XB_TOPGEN]) == tg, bar);
      __builtin_amdgcn_fence(__ATOMIC_ACQUIRE, "agent");
      xb_add(&bar[XB_XGEN(b.x)], 1u);
      asm volatile("s_waitcnt vmcnt(0)" ::: "memory");
    } else {
      XB_SPIN(xb_ld(&bar[XB_XGEN(b.x)]) == gen, bar);
      __builtin_amdgcn_fence(__ATOMIC_ACQUIRE, "agent");
      asm volatile("s_waitcnt vmcnt(0)" ::: "memory");
    }
  }
  __syncthreads();
}

namespace pg8 {
constexpr int BM = 256, BK = 64, HALF = 128, HTB = HALF * BK * 2, STAGE_BYTES = 8 * HTB, NXCD = 8, WGM = 8;
__host__ __device__ __forceinline__ int lds_byte(int r, int c) { const int st = (r >> 4) * 2 + (c >> 5), rr = r & 15, cc = c & 31, ob = rr * 64 + cc * 2; return st * 1024 + (ob ^ (((ob >> 9) & 1) << 5)); }
__host__ __device__ __forceinline__ void stage_rc(int b, int& R, int& C) { const int st = b / 1024, sb = b % 1024, swz = sb ^ (((sb >> 9) & 1) << 5); R = (st >> 1) * 16 + swz / 64; C = (st & 1) * 32 + (swz % 64) / 2; }
__host__ __device__ __forceinline__ int perm32(int rho) { const int n = rho >> 4, i = rho & 15; return 8 * (i >> 2) + 4 * n + (i & 3); }

struct Unit { long aoff, boff; int pm, pn, g, ibase; };
struct Gemm { const bf16* A; const bf16* Bt; int lda, ldb, K; const int* gidx; int sa, sb; };
typedef int v8i_t __attribute__((ext_vector_type(8))); typedef int v4i_t __attribute__((ext_vector_type(4)));
__device__ __forceinline__ v8i_t cat8(bf16x8 lo, bf16x8 hi) { const v4i_t a = __builtin_bit_cast(v4i_t, lo), b = __builtin_bit_cast(v4i_t, hi); return __builtin_shufflevector(a, b, 0, 1, 2, 3, 4, 5, 6, 7); }

struct StaticOrder {
  int nM, nN, nwg, G, c, lda, ldb;
  __device__ void init(int M, int N, int G_, int c_, int lda_, int ldb_) { nM = M / BM; nN = N / BM; nwg = nM * nN; G = G_; c = c_; lda = lda_; ldb = ldb_; }
  __device__ bool next(int i, Unit& u) const {
    const long L = (long)i * G + c; if (L >= nwg) return false;
    int wgid = (int)L; { const int q = nwg / NXCD, r = nwg % NXCD, xcd = wgid % NXCD, off = wgid / NXCD; wgid = (xcd < r ? xcd * (q + 1) : r * (q + 1) + (xcd - r) * q) + off; }
    const int nig = WGM * nN, gid = wgid / nig, fm = gid * WGM, gsz = (nM - fm) < WGM ? (nM - fm) : WGM;
    u.pm = fm + ((wgid % nig) % gsz); u.pn = (wgid % nig) / gsz; u.g = 0; u.ibase = 0;
    u.aoff = (long)u.pm * BM * lda; u.boff = (long)u.pn * BM * ldb; return true;
  }
};

template <class Epi, class Sched, bool GATHER, int FP8 = 0>
__device__ __forceinline__ void gemm_phase(LAS unsigned char* lds, const Gemm g, const Sched& S, const Epi& E) {
  int tid = threadIdx.x; asm volatile("" : "+v"(tid));
  const int wid = __builtin_amdgcn_readfirstlane(tid >> 6), lane = tid & 63, wr = wid >> 2, wc = wid & 3, fr = lane & 15, fq = lane >> 4;
  const int K = g.K, nt = K / BK;
  int Rs[2], Cs[2]; unsigned voffB[2];
#pragma unroll
  for (int i = 0; i < 2; ++i) { int R, C; stage_rc(tid * 16 + i * 8192, R, C); Rs[i] = R; Cs[i] = C; const int Rb = (R & ~31) + perm32(R & 31); voffB[i] = (unsigned)(Rb * g.ldb + C) * 2u; }
  const size_t kstep = (size_t)(BK * 2);
  const size_t hstepB = (size_t)HALF * g.ldb * 2;
  const unsigned ldsw = (unsigned)wid * 1024u;
  const int aoff_l = lds_byte(wr * 64 + fr, FP8 ? fq * 16 : fq * 8), boff_l = lds_byte(wc * 32 + fr, FP8 ? fq * 16 : fq * 8);
  constexpr int aoff_k = FP8 ? 16 : 1024, boff_k = FP8 ? 16 : 1024;
#define PG8_SA(b, h) (((b) * 2 + (h)) * HTB)
#define PG8_SB(b, h) ((4 + (b) * 2 + (h)) * HTB)
#define PG8_STAGE(bufoff, gbase, voff) do { _Pragma("unroll") for (int _i = 0; _i < 2; ++_i) \
        __builtin_amdgcn_global_load_lds((const unsigned*)((const char*)(gbase) + (voff)[_i]), (LAS unsigned*)(lds + (bufoff) + ldsw + _i * 8192), 16, 0, 0); } while (0)
#define PG8_LDA(dst, b, h) do { _Pragma("unroll") for (int m = 0; m < 4; ++m) { if constexpr (FP8) { const v4i_t lo_ = *(const LAS v4i_t*)(lds + PG8_SA(b, h) + aoff_l + m * 2048), hi_ = *(const LAS v4i_t*)(lds + PG8_SA(b, h) + aoff_l + m * 2048 + aoff_k); dst##8[m] = __builtin_shufflevector(lo_, hi_, 0, 1, 2, 3, 4, 5, 6, 7); } \
        else { _Pragma("unroll") for (int k = 0; k < 2; ++k) dst[m][k] = *(const LAS bf16x8*)(lds + PG8_SA(b, h) + aoff_l + m * 2048 + k * aoff_k); } } } while (0)
#define PG8_LDB(dst, b, h) do { _Pragma("unroll") for (int n = 0; n < 2; ++n) { if constexpr (FP8) { const v4i_t lo_ = *(const LAS v4i_t*)(lds + PG8_SB(b, h) + boff_l + n * 2048), hi_ = *(const LAS v4i_t*)(lds + PG8_SB(b, h) + boff_l + n * 2048 + boff_k); dst##8[n] = __builtin_shufflevector(lo_, hi_, 0, 1, 2, 3, 4, 5, 6, 7); } \
        else { _Pragma("unroll") for (int k = 0; k < 2; ++k) dst[n][k] = *(const LAS bf16x8*)(lds + PG8_SB(b, h) + boff_l + n * 2048 + k * boff_k); } } } while (0)
#define PG8_MMA(ai, bj, At, Bt) do { __builtin_amdgcn_s_setprio(1); _Pragma("unroll") for (int m = 0; m < 4; ++m) _Pragma("unroll") for (int n = 0; n < 2; ++n) { \
        if constexpr (FP8) asm volatile("v_mfma_scale_f32_16x16x128_f8f6f4 %0, %1, %2, %0, %3, %4 op_sel_hi:[0,0,0]" : "+v"(acc[ai][bj][m][n]) : "v"(Bt##8[n]), "v"(At##8[m]), "v"(vsb), "v"(vsa)); \
        else { _Pragma("unroll") for (int k = 0; k < 2; ++k) acc[ai][bj][m][n] = __builtin_amdgcn_mfma_f32_16x16x32_bf16(Bt[n][k], At[m][k], acc[ai][bj][m][n], 0, 0, 0); } } \
        __builtin_amdgcn_s_setprio(0); } while (0)
#define PG8_WAIT_V(n) asm volatile("s_waitcnt vmcnt(" #n ")" ::: "memory")
#define PG8_WAIT_L(n) asm volatile("s_waitcnt lgkmcnt(" #n ")" ::: "memory")
#define PG8_BAR __builtin_amdgcn_s_barrier()
#define PG8_SCHED __builtin_amdgcn_sched_barrier(0)
  Unit cur, nxt; int ui = 0;
  if (!S.next(0, cur)) return;
  unsigned vA[2][2], nvA[2][2];
  auto load_va = [&](const Unit& u, unsigned (&v)[2][2]) {
#pragma unroll
    for (int h = 0; h < 2; ++h)
#pragma unroll
      for (int i = 0; i < 2; ++i) {
        if constexpr (GATHER) v[h][i] = (unsigned)((long)g.gidx[u.ibase + h * HALF + Rs[i]] * g.lda + Cs[i]) * 2u;
        else v[h][i] = (unsigned)((h * HALF + Rs[i]) * g.lda + Cs[i]) * 2u;
      }
  };
  load_va(cur, vA);
  f32x4 acc[2][2][4][2];
#pragma unroll
  for (int a = 0; a < 2; ++a)
#pragma unroll
    for (int b = 0; b < 2; ++b)
#pragma unroll
      for (int m = 0; m < 4; ++m)
#pragma unroll
        for (int n = 0; n < 2; ++n) acc[a][b][m][n] = (f32x4){0.f, 0.f, 0.f, 0.f};
  int vsa = g.sa, vsb = g.sb; (void)vsa; (void)vsb;
  bf16x8 At[4][2], B0[2][2], B1[2][2]; v8i_t At8[4], B08[2], B18[2];
  const char* cA = (const char*)g.A + (GATHER ? 0 : cur.aoff * 2); const char* cB = (const char*)g.Bt + cur.boff * 2;
  PG8_STAGE(PG8_SB(0, 0), cB, voffB); PG8_STAGE(PG8_SB(0, 1), cB + hstepB, voffB); PG8_STAGE(PG8_SA(0, 0), cA, vA[0]); PG8_STAGE(PG8_SA(0, 1), cA, vA[1]);
  if (wr == 1) PG8_BAR;
  PG8_WAIT_V(2); PG8_BAR;
  PG8_STAGE(PG8_SB(1, 0), cB + kstep, voffB); PG8_STAGE(PG8_SA(1, 0), cA + kstep, vA[0]); PG8_STAGE(PG8_SB(1, 1), cB + hstepB + kstep, voffB);
  PG8_WAIT_V(6); PG8_BAR;
  for (;;) {
    const bool has_next = S.next(ui + 1, nxt);
    const char* nA = has_next ? (const char*)g.A + (GATHER ? 0 : nxt.aoff * 2) : cA; const char* nB = has_next ? (const char*)g.Bt + nxt.boff * 2 : cB;
    if constexpr (GATHER) { if (has_next) load_va(nxt, nvA); else {
#pragma unroll
      for (int h = 0; h < 2; ++h)
#pragma unroll
        for (int i = 0; i < 2; ++i) nvA[h][i] = vA[h][i]; } }
#pragma unroll 1
    for (int t = 0; t < nt; t += 2) {
      const bool last = (t == nt - 2);
      const char* a1 = cA + (size_t)(t + 1) * kstep;
      const char* a2 = last ? nA : cA + (size_t)(t + 2) * kstep; const char* b2 = last ? nB : cB + (size_t)(t + 2) * kstep;
      const char* a3 = a2 + kstep; const char* b3 = b2 + kstep;
      unsigned w0[2], w1[2];
      if constexpr (GATHER) { w0[0] = last ? nvA[0][0] : vA[0][0]; w0[1] = last ? nvA[0][1] : vA[0][1]; w1[0] = last ? nvA[1][0] : vA[1][0]; w1[1] = last ? nvA[1][1] : vA[1][1]; }
      else { w0[0] = vA[0][0]; w0[1] = vA[0][1]; w1[0] = vA[1][0]; w1[1] = vA[1][1]; }
      PG8_LDB(B0, 0, 0); PG8_LDB(B1, 0, 1); PG8_SCHED; PG8_LDA(At, 0, 0); PG8_STAGE(PG8_SA(1, 1), a1, vA[1]);
      PG8_WAIT_V(8); PG8_WAIT_L(0); PG8_BAR; PG8_MMA(0, 0, At, B0); PG8_MMA(0, 1, At, B1); PG8_BAR; PG8_SCHED;
      PG8_LDA(At, 0, 1); PG8_STAGE(PG8_SB(0, 0), b2, voffB); PG8_STAGE(PG8_SB(0, 1), b2 + hstepB, voffB); PG8_STAGE(PG8_SA(0, 0), a2, w0);
      PG8_WAIT_V(8); PG8_WAIT_L(0); PG8_BAR; PG8_MMA(1, 0, At, B0); PG8_MMA(1, 1, At, B1); PG8_BAR; PG8_SCHED;
      PG8_LDB(B0, 1, 0); PG8_LDB(B1, 1, 1); PG8_SCHED; PG8_LDA(At, 1, 0); PG8_STAGE(PG8_SA(0, 1), a2, w1);
      PG8_WAIT_V(8); PG8_WAIT_L(0); PG8_BAR; PG8_MMA(0, 0, At, B0); PG8_MMA(0, 1, At, B1); PG8_BAR; PG8_SCHED;
      PG8_LDA(At, 1, 1); PG8_STAGE(PG8_SB(1, 0), b3, voffB); PG8_STAGE(PG8_SB(1, 1), b3 + hstepB, voffB); PG8_STAGE(PG8_SA(1, 0), a3, w0);
      PG8_WAIT_V(8); PG8_WAIT_L(0); PG8_BAR; PG8_MMA(1, 0, At, B0); PG8_MMA(1, 1, At, B1); PG8_BAR; PG8_SCHED;
    }
    if constexpr (FP8) { asm volatile("s_nop 15\n\ts_nop 15" ::: "memory"); __builtin_amdgcn_sched_barrier(0); }
    if (wr == 0) PG8_BAR;
    int fr_o = fr, fq_o = fq; asm volatile("" : "+v"(fr_o), "+v"(fq_o));
    if constexpr (Epi::TWO_PASS) {
#pragma unroll
      for (int ai = 0; ai < 2; ++ai)
#pragma unroll
        for (int m = 0; m < 4; ++m) {
          float v0[8], v1[8];
#pragma unroll
          for (int n = 0; n < 2; ++n)
#pragma unroll
            for (int j = 0; j < 4; ++j) { v0[n * 4 + j] = acc[ai][0][m][n][j]; v1[n * 4 + j] = acc[ai][1][m][n][j]; }
          E.pass1(cur, ai * HALF + wr * 64 + m * 16 + fr_o, wc, v0, v1, fq_o);
#pragma unroll
          for (int n = 0; n < 2; ++n)
#pragma unroll
            for (int j = 0; j < 4; ++j) { acc[ai][0][m][n][j] = v0[n * 4 + j]; acc[ai][1][m][n][j] = v1[n * 4 + j]; }
        }
      asm volatile("s_waitcnt lgkmcnt(0)" ::: "memory"); PG8_BAR; asm volatile("" ::: "memory");
    }
    {
#pragma unroll
      for (int ai = 0; ai < 2; ++ai)
#pragma unroll
        for (int m = 0; m < 4; ++m) {
          float v0[8], v1[8];
#pragma unroll
          for (int n = 0; n < 2; ++n)
#pragma unroll
            for (int j = 0; j < 4; ++j) { v0[n * 4 + j] = acc[ai][0][m][n][j]; v1[n * 4 + j] = acc[ai][1][m][n][j]; }
          E.row8(cur, ai * HALF + wr * 64 + m * 16 + fr_o, wc * 32 + 8 * fq_o, v0, v1, fq_o);
          asm volatile("" ::: "memory");
        }
    }
    if (!has_next) break;
#pragma unroll
    for (int a = 0; a < 2; ++a)
#pragma unroll
      for (int b = 0; b < 2; ++b)
#pragma unroll
        for (int m = 0; m < 4; ++m)
#pragma unroll
          for (int n = 0; n < 2; ++n) acc[a][b][m][n] = (f32x4){0.f, 0.f, 0.f, 0.f};
    cur = nxt; cA = nA; cB = nB; ++ui;
    if constexpr (GATHER) {
#pragma unroll
      for (int h = 0; h < 2; ++h)
#pragma unroll
        for (int i = 0; i < 2; ++i) vA[h][i] = nvA[h][i]; }
    if (wr == 1) PG8_BAR;
  }
  PG8_WAIT_V(0);
  PG8_BAR;
#undef PG8_SA
#undef PG8_SB
#undef PG8_STAGE
#undef PG8_LDA
#undef PG8_LDB
#undef PG8_MMA
#undef PG8_WAIT_V
#undef PG8_WAIT_L
#undef PG8_BAR
#undef PG8_SCHED
}
}
constexpr size_t WS_CTL = 0, CTL_ZERO_BYTES = 1 * MiB;
constexpr int CW_TMO = 0, CW_BAR = 4096, CW_Q = 8192;
constexpr size_t CTL_SSQ = 256 * 1024, CTL_SSKV = CTL_SSQ + 65536, CTL_SS1 = CTL_SSKV + 65536, CTL_SS2 = CTL_SS1 + 65536;
constexpr size_t WS_WIN = 1 * MiB, WS_WQB = 6 * MiB, WS_WKVB = 6 * MiB + 512 * 1024, WS_WOUT = 7 * MiB, WS_WMQ = 9 * MiB, WS_WMK = 11 * MiB, WS_WMV = 13 * MiB, WS_WMO = 15 * MiB;
constexpr size_t WS_ROPE = 17 * MiB, WS_MEMN = 19 * MiB, WS_KMEM = 21 * MiB, WS_VMEMT = 23 * MiB, WS_GSC = 25 * MiB, WS_DEC = 28 * MiB, WS_AFF = 29 * MiB, WS_SEL = 30 * MiB;
constexpr size_t WS_PROJ = 32 * MiB, WS_XN = 112 * MiB, WS_QC = 112 * MiB, WS_KC = 128 * MiB, WS_QM = 144 * MiB, WS_KM = 168 * MiB, WS_VM = 192 * MiB, WS_HF = 208 * MiB, WS_HB = 224 * MiB, WS_Y = 240 * MiB;
constexpr size_t WS_X1 = 112 * MiB, WS_X1B = 176 * MiB, WS_QMEM = 208 * MiB, WS_P = 240 * MiB, WS_MO = 112 * MiB, WS_X2 = 240 * MiB, WS_X2B = 208 * MiB, WS_HID = 32 * MiB;
constexpr size_t WS_DUMMY = 304 * MiB;
constexpr size_t WS_WEGU = 320 * MiB, WS_WED = 448 * MiB, WS_END = 512 * MiB;
constexpr int PROJ_LD = 2560;
constexpr int PC_CQ = 2048, PC_CKV = 2304, PC_KR = 2432, PC_G = 2464;
constexpr int RING_BYTES = 131072, LDSCTL_OFF = 133120, LDS_BYTES = 147456;

struct Args { const void* in[26]; float* out; unsigned char* ws; int ph_lo, ph_hi, flags, pad; };

struct Frame {
  LAS unsigned char* lds; volatile LAS unsigned* MISC; gu32* ctl; unsigned char* ws;
  int tid, lane, wave, vcu, G;
};

__device__ __forceinline__ void p0_tr(const float* W, int ldw, int k0, int kvalid, int scol0, int ncols, const float* gs, bf16* WT, int ldt, int drow0, LAS float* scr, int lane, bool doq = false) {
  const int c4 = (lane & 15) * 4, kr = lane >> 4;
  f32x4 v[16];
#pragma unroll
  for (int i = 0; i < 16; ++i) { const int kk = 4 * i + kr; v[i] = (f32x4){0.f, 0.f, 0.f, 0.f};
    if (c4 < ncols && k0 + kk < kvalid) { v[i] = *(const f32x4*)(W + (size_t)(k0 + kk) * ldw + scol0 + c4); if (gs) v[i] = v[i] * gs[k0 + kk];
      if (doq) { v[i].x = q8(v[i].x, 64.f); v[i].y = q8(v[i].y, 64.f); v[i].z = q8(v[i].z, 64.f); v[i].w = q8(v[i].w, 64.f); } } }
#pragma unroll
  for (int i = 0; i < 16; ++i) { const int kk = 4 * i + kr; LAS float* d = scr + kk * 65 + c4; d[0] = v[i].x; d[1] = v[i].y; d[2] = v[i].z; d[3] = v[i].w; }
  LDS_WAIT(); asm volatile("" ::: "memory");
  const int c = lane & 7;
#pragma unroll
  for (int j = 0; j < 8; ++j) { const int n = (lane >> 3) + 8 * j; const LAS float* s = scr + (8 * c) * 65 + n;
    v4u o; o.x = pk2(s[0 * 65], s[1 * 65]); o.y = pk2(s[2 * 65], s[3 * 65]); o.z = pk2(s[4 * 65], s[5 * 65]); o.w = pk2(s[6 * 65], s[7 * 65]);
    *(GAS v4u*)(WT + (size_t)(drow0 + n) * ldt + k0 + 8 * c) = o; }
  LDS_WAIT(); asm volatile("" ::: "memory");
}
struct ConvDesc { const float* W; const float* gs; unsigned char* WT8; int ldw, k0, scol0, ldt, drow0; };
__device__ __forceinline__ void p0_tr8_load(const ConvDesc& d, f32x4 (&v)[16], int lane) {
  const int c4 = (lane & 15) * 4, kr = lane >> 4;
#pragma unroll
  for (int i = 0; i < 16; ++i) { const int kk = 4 * i + kr; v[i] = *(const f32x4*)(d.W + (size_t)(d.k0 + kk) * d.ldw + d.scol0 + c4); }
}
__device__ __forceinline__ void p0_tr8_finish(const ConvDesc& d, f32x4 (&v)[16], float sc, LAS float* scr, int lane) {
  const int c4 = (lane & 15) * 4, kr = lane >> 4;
#pragma unroll
  for (int i = 0; i < 16; ++i) { const int kk = 4 * i + kr; f32x4 x = v[i]; if (d.gs) x = x * d.gs[d.k0 + kk]; LAS float* p = scr + kk * 65 + c4; p[0] = x.x; p[1] = x.y; p[2] = x.z; p[3] = x.w; }
  LDS_WAIT(); asm volatile("" ::: "memory");
  const int c = lane & 7;
#pragma unroll
  for (int j = 0; j < 8; ++j) { const int n = (lane >> 3) + 8 * j; const LAS float* s = scr + (8 * c) * 65 + n;
    float f[8];
#pragma unroll
    for (int q = 0; q < 8; ++q) f[q] = s[q * 65];
    *(GAS v2u*)(d.WT8 + (size_t)(d.drow0 + n) * d.ldt + d.k0 + 8 * c) = pack8_fp8(f, sc); }
  LDS_WAIT(); asm volatile("" ::: "memory");
}
__device__ __forceinline__ void p0_tr32(const float* W, int ldw, int k0, int scol0, int ncols, const float* gs, bf16* WT, int ldt, int drow0, LAS float* scr, int lane) {
#pragma unroll 8
  for (int i = 0; i < 32; ++i) { const int kk = 2 * i + (lane >> 5), c = lane & 31; float v = 0.f;
    if (c < ncols) { v = W[(size_t)(k0 + kk) * ldw + scol0 + c]; if (gs) v *= gs[k0 + kk]; }
    scr[kk * 65 + c] = v; }
  LDS_WAIT(); asm volatile("" ::: "memory");
  const int c = lane & 7;
#pragma unroll
  for (int j = 0; j < 4; ++j) { const int n = (lane >> 3) + 8 * j; const LAS float* s = scr + (8 * c) * 65 + n;
    v4u o; o.x = pk2(s[0 * 65], s[1 * 65]); o.y = pk2(s[2 * 65], s[3 * 65]); o.z = pk2(s[4 * 65], s[5 * 65]); o.w = pk2(s[6 * 65], s[7 * 65]);
    *(GAS v4u*)(WT + (size_t)(drow0 + n) * ldt + k0 + 8 * c) = o; }
  LDS_WAIT(); asm volatile("" ::: "memory");
}
__device__ __forceinline__ void rms_row_to_bf16(const float* xrow, bf16* orow, int lane) {
  const GAS f32x4* xr = (const GAS f32x4*)xrow + lane;
  f32x4 v[4]; float s = 0.f;
#pragma unroll
  for (int j = 0; j < 4; ++j) { v[j] = xr[64 * j]; s += (v[j].x * v[j].x + v[j].y * v[j].y) + (v[j].z * v[j].z + v[j].w * v[j].w); }
  const float rstd = rsqrtf(wave_sum(s) * (1.f / 1024.f) + 1e-6f);
  GAS unsigned long long* o8 = (GAS unsigned long long*)orow + lane;
#pragma unroll
  for (int j = 0; j < 4; ++j) o8[64 * j] = (unsigned long long)pk2(v[j].x * rstd, v[j].y * rstd) | ((unsigned long long)pk2(v[j].z * rstd, v[j].w * rstd) << 32);
}

#ifndef FP8EMU
#define FP8EMU 0
#endif
#ifndef MOE_FP8
#define MOE_FP8 1
#endif
#ifndef CONV_NT
#define CONV_NT 0
#endif
#ifndef MOE_FP8_DOWN
#define MOE_FP8_DOWN MOE_FP8
#endif
constexpr size_t WS_PO = 384 * MiB, WS_PML = 272 * MiB;
constexpr size_t WS_XG = 96 * MiB;
constexpr size_t WS_X2Q = 208 * MiB, WS_WEGU8 = 320 * MiB, WS_WED8 = 448 * MiB, WS_HID8 = 32 * MiB;
constexpr int CW_RDY = 8192 + 64 * 44;
constexpr int CW_CONV = 8192 + 64 * 40, CW_MDONE = 8192 + 64 * 41, CW_TDONE = 8192 + 64 * 42;
constexpr int CONV_IGU = 16 * 64, CONV_ID = 32 * 16, CONV_ITEMS = NEXP * (CONV_IGU + CONV_ID), CONV_CHUNKS = CONV_ITEMS / 8;
__device__ __forceinline__ ConvDesc conv_desc(Frame& F, const Args& a, int it) {
  auto I = [&](int i) { return (const float*)a.in[i]; };
  unsigned char* ws = F.ws; ConvDesc d;
  const int e = it / (CONV_IGU + CONV_ID); int r = it % (CONV_IGU + CONV_ID);
  if (r < CONV_IGU) { const int kb = r / 64, nb = r % 64, p = nb >> 2, j0 = (nb & 3) * 64; const bool up = j0 >= 128;
    d.W = (up ? I(I_WEU) : I(I_WEG)) + (size_t)e * 1024 * 2048; d.ldw = 2048; d.k0 = 64 * kb; d.scol0 = 128 * p + (up ? j0 - 128 : j0); d.gs = I(I_GFFN); d.WT8 = ws + WS_WEGU8 + (size_t)e * 4096 * 1024; d.ldt = 1024; d.drow0 = 64 * nb; }
  else { r -= CONV_IGU; const int kb = r / 16, nb = r % 16;
    d.W = I(I_WED) + (size_t)e * 2048 * 1024; d.ldw = 1024; d.k0 = 64 * kb; d.scol0 = 64 * nb; d.gs = nullptr; d.WT8 = ws + WS_WED8 + (size_t)e * 1024 * 2048; d.ldt = 2048; d.drow0 = 64 * nb; }
  return d;
}
__device__ __forceinline__ void conv_fill(Frame& F, const Args& a, int maxpairs) {
  static_assert(MOE_FP8 && MOE_FP8_DOWN, "the conversion filler writes fp8 expert weights");
  volatile LAS int* slot = (volatile LAS int*)(F.lds + LDSCTL_OFF + 16);
  LAS float* scr = (LAS float*)(F.lds + F.wave * 16640);
  for (int n = 0; n < maxpairs; ++n) {
    if (F.tid == 0) { int got = -1;
      if (__hip_atomic_load(F.ctl + CW_CONV, RLX_AGENT) < (unsigned)CONV_CHUNKS) { const unsigned c = __hip_atomic_fetch_add(F.ctl + CW_CONV, 2u, RLX_AGENT); if (c < (unsigned)CONV_CHUNKS) got = (int)c; }
      *slot = got; }
    __syncthreads();
    const int c = __builtin_amdgcn_readfirstlane(*slot);
    __syncthreads();
    if (c < 0) break;
    const ConvDesc d0 = conv_desc(F, a, c * 8 + F.wave), d1 = conv_desc(F, a, (c + 1) * 8 + F.wave);
    f32x4 v0[16], v1[16];
    p0_tr8_load(d0, v0, F.lane); p0_tr8_load(d1, v1, F.lane);
    p0_tr8_finish(d0, v0, 64.f, scr, F.lane); p0_tr8_finish(d1, v1, 64.f, scr, F.lane);
  }
}
__device__ __forceinline__ void p0_prologue(Frame& F, const Args& a, bool do_dense, bool do_experts) {
  LAS float* scr = (LAS float*)(F.lds + F.wave * 16640);
  const int gw = F.vcu * NWAVES + F.wave, NGW = F.G * NWAVES;
  auto I = [&](int i) { return (const float*)a.in[i]; };
  unsigned char* ws = F.ws;
  if (do_dense) {
    constexpr int I_WIN_ = 16 * 40, I_WQB_ = 4 * 12, I_WKVB_ = 4 * 16, I_SQ = 16 * 16;
    constexpr int NIT = I_WIN_ + I_WQB_ + I_WKVB_ + 5 * I_SQ;
    for (int it = gw; it < NIT; it += NGW) {
      int r = it;
      if (r < I_WIN_) { const int kb = r / 40, nb = r % 40; int sc, nc = 64;
        if (nb < 32) sc = 64 * nb; else if (nb < 36) sc = OFF_CQ + 64 * (nb - 32); else if (nb < 38) sc = OFF_CKV + 64 * (nb - 36); else if (nb == 38) { sc = OFF_KR; nc = 32; } else { sc = 0; nc = 0; }
        p0_tr(I(I_WIN), D_IN, 64 * kb, 1024, sc, nc, I(I_GMIX), (bf16*)(ws + WS_WIN), 1024, 64 * nb, scr, F.lane);
        if (nb == 38) p0_tr32(I(I_WIN), D_IN, 64 * kb, OFF_G, 16, I(I_GMIX), (bf16*)(ws + WS_WIN), 1024, PC_G, scr, F.lane);
        continue; } r -= I_WIN_;
      if (r < I_WQB_) { const int kb = r / 12, nb = r % 12; p0_tr(I(I_WQB), 768, 64 * kb, 256, 64 * nb, 64, I(I_GQA), (bf16*)(ws + WS_WQB), 256, 64 * nb, scr, F.lane); continue; } r -= I_WQB_;
      if (r < I_WKVB_) { const int kb = r / 16, nb = r % 16; const int h = nb & 7; const int sc = h * 128 + (nb >= 8 ? 64 : 0);
        p0_tr(I(I_WKVB), 1024, 64 * kb, 128, sc, 64, I(I_GKVA), (bf16*)(ws + WS_WKVB), 256, 64 * nb, scr, F.lane); continue; } r -= I_WKVB_;
      const int which = r / I_SQ; r %= I_SQ; const int kb = r / 16, nb = r % 16;
      const float* src = which == 0 ? I(I_WOUT) : which == 1 ? I(I_WMQ) : which == 2 ? I(I_WMK) : which == 3 ? I(I_WMV) : I(I_WMO);
      const float* gs = which == 1 ? I(I_GMX) : (which == 2 || which == 3) ? I(I_GMKV) : nullptr;
      bf16* dst = (bf16*)(ws + (which == 0 ? WS_WOUT : which == 1 ? WS_WMQ : which == 2 ? WS_WMK : which == 3 ? WS_WMV : WS_WMO));
      p0_tr(src, 1024, 64 * kb, 1024, 64 * nb, 64, gs, dst, 1024, 64 * nb, scr, F.lane);
    }
    for (int m = gw; m < MTOK; m += NGW) rms_row_to_bf16(I(I_X) + (size_t)m * 1024, (bf16*)(ws + WS_XN) + (size_t)m * 1024, F.lane);
    for (int m = gw; m < BATCH * NMEM; m += NGW) rms_row_to_bf16(I(I_MEM) + (size_t)m * 1024, (bf16*)(ws + WS_MEMN) + (size_t)m * 1024, F.lane);
    { const float* wr = I(I_WR); const float* gf = I(I_GFFN); float* wrg = (float*)(ws + WS_DEC + 65536);
      for (int i = (F.vcu * NTHR + F.tid); i < 1024 * 16; i += F.G * NTHR) wrg[i] = wr[i] * gf[i >> 4]; }
    { const int* pos = (const int*)a.in[I_POS]; float* rt = (float*)(ws + WS_ROPE);
      for (int i = (F.vcu * NTHR + F.tid); i < MTOK * 16; i += F.G * NTHR) { const int m = i >> 4, j = i & 15; const float inv = powf(10000.f, -(float)j / 16.f); const float ang = (float)pos[m] * inv;
        rt[m * 32 + j] = cosf(ang); rt[m * 32 + 16 + j] = sinf(ang); } }
  }
  if (do_experts) conv_fill(F, a, 1 << 30);
}

__device__ __forceinline__ v4u pack8(const float (&v)[8]) { v4u w; w.x = cvt_pk_bf16(v[0], v[1]); w.y = cvt_pk_bf16(v[2], v[3]); w.z = cvt_pk_bf16(v[4], v[5]); w.w = cvt_pk_bf16(v[6], v[7]); return w; }
__device__ __forceinline__ float sumsq8(const float (&v)[8]) { float s = 0.f;
#pragma unroll
  for (int i = 0; i < 8; ++i) s += v[i] * v[i];
  return s; }
struct EpiStore { static constexpr bool TWO_PASS = false; bf16* O; int ldc;
  __device__ __forceinline__ void row8(const pg8::Unit& u, int rloc, int cloc, const float (&v0)[8], const float (&v1)[8], int fq) const {
    bf16* p = O + (size_t)(u.pm * 256 + rloc) * ldc + u.pn * 256 + cloc; *(v4u*)p = pack8(v0); *(v4u*)(p + 128) = pack8(v1); } };
struct EpiProj { static constexpr bool TWO_PASS = false; bf16* P; float* ssq; float* sskv;
  __device__ __forceinline__ void row8(const pg8::Unit& u, int rloc, int cloc, const float (&v0)[8], const float (&v1)[8], int fq) const {
    const int row = u.pm * 256 + rloc; bf16* p = P + (size_t)row * PROJ_LD + u.pn * 256 + cloc; *(v4u*)p = pack8(v0); *(v4u*)(p + 128) = pack8(v1);
    if (u.pn == 8) { float s = sumsq8(v0) + sumsq8(v1); s += __shfl_xor(s, 16); s += __shfl_xor(s, 32); if (fq == 0) unsafeAtomicAdd(ssq + row, s); }
    if (u.pn == 9) { float s = sumsq8(v0); s += __shfl_xor(s, 16); s += __shfl_xor(s, 32); if (fq == 0) unsafeAtomicAdd(sskv + row, s); } } };
struct EpiQ { static constexpr bool TWO_PASS = false; bf16* Q; const float* ssq; const float* rope;
  __device__ __forceinline__ void rope8(float (&v)[8], int row, int fq) const {
    float pv[8];
#pragma unroll
    for (int i = 0; i < 8; ++i) pv[i] = __shfl_xor(v[i], 32);
    const float* cs = rope + (size_t)row * 32 + 8 * (fq & 1);
#pragma unroll
    for (int i = 0; i < 8; ++i) { const float c = cs[i], s = cs[16 + i]; v[i] = (fq < 2) ? (v[i] * c - pv[i] * s) : (v[i] * c + pv[i] * s); }
  }
  __device__ __forceinline__ void row8(const pg8::Unit& u, int rloc, int cloc, const float (&a0)[8], const float (&a1)[8], int fq) const {
    const int row = u.pm * 256 + rloc; const float r = rsqrtf(ssq[row] * (1.f / 256.f) + 1e-6f);
    float v0[8], v1[8];
#pragma unroll
    for (int i = 0; i < 8; ++i) { v0[i] = a0[i] * r; v1[i] = a1[i] * r; }
    const int g0 = u.pn * 8 + (cloc >> 5), g1 = g0 + 4;
    if (g0 % 3 == 2) rope8(v0, row, fq);
    if (g1 % 3 == 2) rope8(v1, row, fq);
    bf16* p = Q + (size_t)row * 768 + u.pn * 256 + cloc; *(v4u*)p = pack8(v0); *(v4u*)(p + 128) = pack8(v1); } };
struct EpiKV { static constexpr bool TWO_PASS = false; bf16* KMp; bf16* VMp; const float* sskv;
  __device__ __forceinline__ void put(int row, int c, const float (&v)[8], float r) const {
    float w[8];
#pragma unroll
    for (int i = 0; i < 8; ++i) w[i] = v[i] * r;
    if (c < 512) *(v4u*)(KMp + (size_t)row * 768 + (c >> 6) * 96 + (c & 63)) = pack8(w); else *(v4u*)(VMp + (size_t)row * 512 + (c - 512)) = pack8(w); }
  __device__ __forceinline__ void row8(const pg8::Unit& u, int rloc, int cloc, const float (&a0)[8], const float (&a1)[8], int fq) const {
    const int row = u.pm * 256 + rloc; const float r = rsqrtf(sskv[row] * (1.f / 128.f) + 1e-6f);
    put(row, u.pn * 256 + cloc, a0, r); put(row, u.pn * 256 + 128 + cloc, a1, r); } };

__device__ __forceinline__ void unpack8(v4u w, float (&f)[8]) { f[0] = bflo(w.x); f[1] = bfhi(w.x); f[2] = bflo(w.y); f[3] = bfhi(w.y); f[4] = bflo(w.z); f[5] = bfhi(w.z); f[6] = bflo(w.w); f[7] = bfhi(w.w); }
__device__ __forceinline__ float log_sigmoid(float x) { return fminf(x, 0.f) - log1pf(__expf(-fabsf(x))); }

__device__ __forceinline__ void p2_elementwise(Frame& F, const Args& a) {
  unsigned char* ws = F.ws;
  const bf16* P = (const bf16*)(ws + WS_PROJ);
  { const float* cw = (const float*)a.in[I_CONV]; bf16* QC = (bf16*)(ws + WS_QC); bf16* KC = (bf16*)(ws + WS_KC);
    for (int i = F.vcu * NTHR + F.tid; i < MTOK * 128; i += F.G * NTHR) { const int m = i >> 7, c = (i & 127) * 8, t = m & (SEQ - 1);
      float x1[8], x0[8], x2[8]; unpack8(*(const v4u*)(P + (size_t)m * PROJ_LD + c), x1);
      if (t > 0) unpack8(*(const v4u*)(P + (size_t)(m - 1) * PROJ_LD + c), x0); else {
#pragma unroll
        for (int j = 0; j < 8; ++j) x0[j] = 0.f; }
      if (t < SEQ - 1) unpack8(*(const v4u*)(P + (size_t)(m + 1) * PROJ_LD + c), x2); else {
#pragma unroll
        for (int j = 0; j < 8; ++j) x2[j] = 0.f; }
      float o[8];
#pragma unroll
      for (int j = 0; j < 8; ++j) { float v = x0[j] * cw[c + j] + x1[j] * cw[1024 + c + j] + x2[j] * cw[2048 + c + j]; v = v * sigmoidf_(v); o[j] = (c < 512) ? v : v * 0.08838834764831845f; }
      if (c < 512) *(v4u*)(QC + (size_t)m * 512 + c) = pack8(o); else *(v4u*)(KC + (size_t)m * 512 + c - 512) = pack8(o); } }
  { const float* rope = (const float*)(ws + WS_ROPE); bf16* KMp = (bf16*)(ws + WS_KM);
    for (int i = F.vcu * NTHR + F.tid; i < MTOK * 16; i += F.G * NTHR) { const int m = i >> 4, j = i & 15;
      const float t1 = bf2f(P[(size_t)m * PROJ_LD + PC_KR + j]), t2 = bf2f(P[(size_t)m * PROJ_LD + PC_KR + 16 + j]); const float c = rope[m * 32 + j], s = rope[m * 32 + 16 + j];
      const bf16 o1 = (bf16)f2bf(t1 * c - t2 * s), o2 = (bf16)f2bf(t2 * c + t1 * s);
#pragma unroll
      for (int h = 0; h < 8; ++h) { KMp[(size_t)m * 768 + h * 96 + 64 + j] = o1; KMp[(size_t)m * 768 + h * 96 + 80 + j] = o2; } } }
  { const float* bg = (const float*)a.in[I_BG]; float* GSC = (float*)(ws + WS_GSC); float* DEC = (float*)(ws + WS_DEC);
    const int gw = F.vcu * NWAVES + F.wave, NGW = F.G * NWAVES;
    for (int it = gw; it < 32 * 64; it += NGW) { const int seq = it >> 6, c = it & 63, dir = seq & 1, h = (seq >> 1) & 3, b = seq >> 3;
      const int p = c * 64 + F.lane, t = dir ? (SEQ - 1 - p) : p; const size_t row = (size_t)b * SEQ + t;
      const int gi = (dir ? 8 : 0) + h, gf = (dir ? 12 : 4) + h;
      const float li = bf2f(P[row * PROJ_LD + PC_G + gi]) + bg[gi]; const float lf = log_sigmoid(bf2f(P[row * PROJ_LD + PC_G + gf]) + bg[gf]);
      float bs = lf;
#pragma unroll
      for (int o = 1; o < 64; o <<= 1) { const float y = __shfl_up(bs, o); if (F.lane >= o) bs += y; }
      const float av = li - bs; float pm = av;
#pragma unroll
      for (int o = 1; o < 64; o <<= 1) { const float y = __shfl_up(pm, o); if (F.lane >= o) pm = fmaxf(pm, y); }
      float* gs = GSC + (size_t)seq * 3 * SEQ; gs[p] = bs; gs[SEQ + p] = av; gs[2 * SEQ + p] = pm;
      if (F.lane == 63) { DEC[seq * 128 + c] = bs; DEC[seq * 128 + 64 + c] = pm; } } }
}
namespace mla {
constexpr int DQK = 96, DV = 64, NW = 8, QBLK = 32, KVBLK = 64, LDQ = 768, LDK = 768, LDV = 512, LDO = 1024;
constexpr float SCALE = 0.10206207261596575f;
constexpr float THR = 8.f;
constexpr int SHM_V = 16384, SHM_K = 16384, SHM_ATTN = 2 * SHM_V + 2 * SHM_K + NW * 64 * 4;
#define KSWZ(row, colB) ((row) * 256 + ((colB) ^ (((row) & 7) << 4)))
#define SBAR() __builtin_amdgcn_sched_barrier(0)
__device__ __forceinline__ int crow(int r, int hi) { return (r & 3) + 8 * (r >> 2) + 4 * hi; }
__device__ __forceinline__ void partialSM(f32x16& p0, f32x16& p1, float& m_reg, float& mn, float& alpha) {
  constexpr float C = SCALE * 1.4426950408889634f;
  float pmax = p0[0];
#pragma unroll
  for (int r = 1; r < 16; ++r) pmax = fmaxf(pmax, p0[r]);
#pragma unroll
  for (int r = 0; r < 16; ++r) pmax = fmaxf(pmax, p1[r]);
  { auto rr = __builtin_amdgcn_permlane32_swap(__float_as_uint(pmax), __float_as_uint(pmax), false, false);
    pmax = fmaxf(__uint_as_float(rr[0]), __uint_as_float(rr[1])); }
  if (__builtin_expect(__all(pmax - m_reg <= THR / SCALE), 1)) { mn = m_reg; alpha = 1.f; }
  else { mn = fmaxf(m_reg, pmax); alpha = __builtin_amdgcn_exp2f((m_reg - mn) * C); m_reg = mn; }
  const float mnC = -mn * C;
#pragma unroll
  for (int r = 0; r < 16; ++r) p0[r] = fmaf(p0[r], C, mnC);
#pragma unroll
  for (int r = 0; r < 16; ++r) p1[r] = fmaf(p1[r], C, mnC);
#pragma unroll
  for (int r = 0; r < 16; ++r) p0[r] = __builtin_amdgcn_exp2f(p0[r]);
}
__device__ __forceinline__ void finishSM(f32x16& p0, f32x16& p1, float alpha, float& l_reg, bf16x8& pa0, bf16x8& pa1, bf16x8& pa2, bf16x8& pa3) {
#pragma unroll
  for (int r = 0; r < 16; ++r) p1[r] = __builtin_amdgcn_exp2f(p1[r]);
  float ps = 0;
#pragma unroll
  for (int r = 0; r < 16; ++r) ps += p0[r];
#pragma unroll
  for (int r = 0; r < 16; ++r) ps += p1[r];
  { auto rr = __builtin_amdgcn_permlane32_swap(__float_as_uint(ps), __float_as_uint(ps), false, false);
    ps = __uint_as_float(rr[0]) + __uint_as_float(rr[1]); }
  l_reg = l_reg * alpha + ps;
#define PK4(P, BASE, OUT) do { unsigned a0 = cvt_pk_bf16(P[BASE + 0], P[BASE + 1]), a1 = cvt_pk_bf16(P[BASE + 2], P[BASE + 3]);   \
    unsigned b0 = cvt_pk_bf16(P[BASE + 4], P[BASE + 5]), b1 = cvt_pk_bf16(P[BASE + 6], P[BASE + 7]);                              \
    auto r0 = __builtin_amdgcn_permlane32_swap(a0, b0, false, false); auto r1 = __builtin_amdgcn_permlane32_swap(a1, b1, false, false); \
    v4u w = {r0[0], r1[0], r0[1], r1[1]}; OUT = __builtin_bit_cast(bf16x8, w); } while (0)
  PK4(p0, 0, pa0); PK4(p0, 8, pa1); PK4(p1, 0, pa2); PK4(p1, 8, pa3);
#undef PK4
}
__device__ __forceinline__ void qkt(f32x16& p0, f32x16& p1, const char* Ks, const bf16x8* qr, int r32, int hi) {
  p0 = f32x16{}; p1 = f32x16{};
#pragma unroll
  for (int d0 = 0; d0 < DQK / 16; ++d0) { const int cb = (d0 * 16 + hi * 8) * 2;
    const bf16x8 b0 = *reinterpret_cast<const bf16x8*>(Ks + KSWZ(r32, cb));
    const bf16x8 b1 = *reinterpret_cast<const bf16x8*>(Ks + KSWZ(32 + r32, cb));
    p0 = __builtin_amdgcn_mfma_f32_32x32x16_bf16(b0, qr[d0], p0, 0, 0, 0);
    p1 = __builtin_amdgcn_mfma_f32_32x32x16_bf16(b1, qr[d0], p1, 0, 0, 0); }
}
__device__ __forceinline__ int v_st(int k, int c) { const int kk = (k & ~0xC) | ((k & 4) << 1) | ((k & 8) >> 1); return ((kk >> 3) * 4 + (c >> 5)) * 512 + ((kk & 7) * 32 + (c & 31)) * 2; }
__device__ __forceinline__ int v_rd_base(int lane) { return ((lane & 3) << 3) | (((lane >> 2) & 3) << 6) | (((lane >> 4) & 1) << 5) | (((lane >> 5) & 1) << 8); }
constexpr int v_rd_off(int d0, int ks, int half) { return d0 * 512 + ks * 4096 + half * 2048; }
template <int OFF> __device__ __forceinline__ s16x4 tr_read(int vb) {
  s16x4 r; asm volatile("ds_read_b64_tr_b16 %0, %1 offset:%2" : "=&v"(r) : "v"(vb), "i"(OFF) : "memory"); return r;
}
template <int D0> __device__ __forceinline__ void pv_one(f32x16& od, int vb, bf16x8 pa0, bf16x8 pa1, bf16x8 pa2, bf16x8 pa3) {
  const s16x4 l0 = tr_read<v_rd_off(D0, 0, 0)>(vb), h0 = tr_read<v_rd_off(D0, 0, 1)>(vb), l1 = tr_read<v_rd_off(D0, 1, 0)>(vb), h1 = tr_read<v_rd_off(D0, 1, 1)>(vb);
  const s16x4 l2 = tr_read<v_rd_off(D0, 2, 0)>(vb), h2 = tr_read<v_rd_off(D0, 2, 1)>(vb), l3 = tr_read<v_rd_off(D0, 3, 0)>(vb), h3 = tr_read<v_rd_off(D0, 3, 1)>(vb);
  asm volatile("s_waitcnt lgkmcnt(0)" ::: "memory"); SBAR();
#define PK(L, H) (bf16x8){L[0], L[1], L[2], L[3], H[0], H[1], H[2], H[3]}
  od = __builtin_amdgcn_mfma_f32_32x32x16_bf16(pa0, PK(l0, h0), od, 0, 0, 0);
  od = __builtin_amdgcn_mfma_f32_32x32x16_bf16(pa1, PK(l1, h1), od, 0, 0, 0);
  od = __builtin_amdgcn_mfma_f32_32x32x16_bf16(pa2, PK(l2, h2), od, 0, 0, 0);
  od = __builtin_amdgcn_mfma_f32_32x32x16_bf16(pa3, PK(l3, h3), od, 0, 0, 0);
#undef PK
}
__device__ __forceinline__ void pv_d0(f32x16* o, int vb, bf16x8 pa0, bf16x8 pa1, bf16x8 pa2, bf16x8 pa3) {
  pv_one<0>(o[0], vb, pa0, pa1, pa2, pa3); pv_one<1>(o[1], vb, pa0, pa1, pa2, pa3);
}
constexpr int LDP = 8 * 64, LDML = 8 * 2;
__device__ __forceinline__ void attn_unit(const bf16* __restrict__ Qb, const bf16* __restrict__ Kh, const bf16* __restrict__ Vh, float* __restrict__ Op, float* __restrict__ MLp, int seq, char* lds) {
  int tid = threadIdx.x; asm volatile("" : "+v"(tid));
  const int wid = tid >> 6, lane = tid & 63, r32 = lane & 31, hi = lane >> 5;
  char* V_lds = lds; char* K_lds = lds + 2 * SHM_V;
  float* wsf = (float*)(lds + 2 * SHM_V + 2 * SHM_K) + wid * 64; float* li_l = wsf; float* al_l = wsf + 32;
  float m_reg = -1e30f, l_reg = 0; f32x16 o[2] = {}; bf16x8 qr[DQK / 16];
  const bf16* Qw = Qb + (long)(wid * QBLK + r32) * LDQ + hi * 8;
#pragma unroll
  for (int d0 = 0; d0 < DQK / 16; ++d0) qr[d0] = *reinterpret_cast<const bf16x8*>(Qw + d0 * 16);
  const int sr = tid >> 4, sc = (tid & 15) * 8, vst0 = v_st(sr, sc & 63), vst1 = v_st(32 + sr, sc & 63);
  const bool doK = sc < DQK, doV = sc < DV;
  const int vb0 = (int)(uintptr_t)V_lds + v_rd_base(lane);
  struct { bf16x8 vs0, vs1, ks0, ks1; } sr_[2];
#define SLOAD(i, k0) do { if (doV) { sr_[i].vs0 = *reinterpret_cast<const bf16x8*>(&Vh[(long)((k0) + sr) * LDV + sc]); sr_[i].vs1 = *reinterpret_cast<const bf16x8*>(&Vh[(long)((k0) + 32 + sr) * LDV + sc]); } \
    if (doK) { sr_[i].ks0 = *reinterpret_cast<const bf16x8*>(&Kh[(long)((k0) + sr) * LDK + sc]); sr_[i].ks1 = *reinterpret_cast<const bf16x8*>(&Kh[(long)((k0) + 32 + sr) * LDK + sc]); } } while (0)
#define SWRITE(b, i) do { if (doV) { *(bf16x8*)(V_lds + (b) * SHM_V + vst0) = sr_[i].vs0; *(bf16x8*)(V_lds + (b) * SHM_V + vst1) = sr_[i].vs1; } \
    if (doK) { const int kc = sc * 2; *(bf16x8*)(K_lds + (b) * SHM_K + KSWZ(sr, kc)) = sr_[i].ks0; *(bf16x8*)(K_lds + (b) * SHM_K + KSWZ(32 + sr, kc)) = sr_[i].ks1; } } while (0)
#define SWAIT() asm volatile("s_waitcnt vmcnt(4)" ::: "memory")
#define RESC(a) do { if (__any((a) < 1.f)) { if (hi == 0) al_l[r32] = (a); asm volatile("s_waitcnt lgkmcnt(0)" ::: "memory"); \
    _Pragma("unroll") for (int d = 0; d < 2; ++d) _Pragma("unroll") for (int r = 0; r < 16; ++r) o[d][r] *= al_l[crow(r, hi)]; } } while (0)
  f32x16 pA0, pA1, pB0, pB1; float mnA, mnB, alA, alB; bf16x8 pa0, pa1, pa2, pa3; const int NT = seq / KVBLK;
  constexpr int SE = 0, SO = 1;
  SLOAD(SE, 0); asm volatile("s_waitcnt vmcnt(0)" ::: "memory"); SWRITE(0, SE); __syncthreads();
  qkt(pA0, pA1, K_lds, qr, r32, hi); partialSM(pA0, pA1, m_reg, mnA, alA);
  SLOAD(SO, KVBLK); if (2 < NT) SLOAD(SE, 2 * KVBLK);
  SWAIT(); SWRITE(1, SO); __syncthreads();
  for (int j = 1; j + 1 < NT; j += 2) {
    SBAR(); qkt(pB0, pB1, K_lds + SHM_K, qr, r32, hi);
    finishSM(pA0, pA1, alA, l_reg, pa0, pa1, pa2, pa3); SBAR();
    SLOAD(SO, (j + 2) * KVBLK); SBAR();
    pv_d0(o, vb0, pa0, pa1, pa2, pa3); partialSM(pB0, pB1, m_reg, mnB, alB);
    __syncthreads(); SWAIT(); SWRITE(0, SE);
    RESC(alB); __syncthreads();
    SBAR(); qkt(pA0, pA1, K_lds, qr, r32, hi);
    finishSM(pB0, pB1, alB, l_reg, pa0, pa1, pa2, pa3); SBAR();
    if (j + 3 < NT) SLOAD(SE, (j + 3) * KVBLK); SBAR();
    pv_d0(o, vb0 + SHM_V, pa0, pa1, pa2, pa3); partialSM(pA0, pA1, m_reg, mnA, alA);
    __syncthreads(); SWAIT(); SWRITE(1, SO);
    RESC(alA); __syncthreads();
  }
  SBAR(); qkt(pB0, pB1, K_lds + SHM_K, qr, r32, hi);
  finishSM(pA0, pA1, alA, l_reg, pa0, pa1, pa2, pa3); SBAR();
  pv_d0(o, vb0, pa0, pa1, pa2, pa3); partialSM(pB0, pB1, m_reg, mnB, alB);
  __syncthreads(); RESC(alB);
  finishSM(pB0, pB1, alB, l_reg, pa0, pa1, pa2, pa3); SBAR();
  pv_d0(o, vb0 + SHM_V, pa0, pa1, pa2, pa3);
  __syncthreads();
  { float* st = (float*)lds + wid * (32 * 68);
#pragma unroll
    for (int r = 0; r < 16; ++r) { const int orow = crow(r, hi); st[orow * 68 + r32] = o[0][r]; st[orow * 68 + 32 + r32] = o[1][r]; }
    asm volatile("s_waitcnt lgkmcnt(0)" ::: "memory");
    float* op = Op + (long)(wid * QBLK + r32) * LDP + hi * 32;
#pragma unroll
    for (int j = 0; j < 8; ++j) *(f32x4*)(op + 4 * j) = *(const f32x4*)(st + r32 * 68 + hi * 32 + 4 * j);
    if (hi == 0) { float* mp = MLp + (long)(wid * QBLK + r32) * LDML; mp[0] = m_reg; mp[1] = l_reg; } }
  __syncthreads();
#undef SLOAD
#undef SWRITE
#undef SWAIT
#undef RESC
}
#undef KSWZ
#undef SBAR
}

__device__ __forceinline__ int queue_pull(Frame& F, gu32* heads, int nq, int nper, int myq) {
  volatile LAS int* slot = (volatile LAS int*)(F.lds + LDSCTL_OFF);
  if (F.tid == 0) { int got = -1;
    for (int k = 0; k < nq; ++k) { const int q = (myq + k) % nq;
      if (__hip_atomic_load(heads + 64 * q, RLX_AGENT) >= (unsigned)nper) continue;
      const unsigned i = __hip_atomic_fetch_add(heads + 64 * q, 1u, RLX_AGENT);
      if (i < (unsigned)nper) { got = q * nper + (int)i; break; } }
    *slot = got; }
  __syncthreads();
  const int r = __builtin_amdgcn_readfirstlane(*slot);
  __syncthreads();
  return r;
}
__device__ __forceinline__ void p3_attention(Frame& F, const Args& a, char* lds_generic, unsigned xcc, int qoff) {
  unsigned char* ws = F.ws;
  const bf16* QMp = (const bf16*)(ws + WS_QM); const bf16* KMp = (const bf16*)(ws + WS_KM); const bf16* VMp = (const bf16*)(ws + WS_VM); float* PO = (float*)(ws + WS_PO); float* PML = (float*)(ws + WS_PML);
#ifndef WAIT_MODE
#define WAIT_MODE 1
#endif
  bool waited = false; (void)waited;
  for (;;) {
    const int u = queue_pull(F, F.ctl + CW_Q + qoff, 8, 128, (int)(xcc & 7u));
    if (u < 0) break;
    const int bh = u >> 5, qb = (u >> 1) & 15, kh = u & 1, b = bh >> 3, h = bh & 7;
#if WAIT_MODE == 0
    if (F.tid == 0) { unsigned sp = 0;
      while (__hip_atomic_load(F.ctl + CW_RDY + 64 * b, RLX_AGENT) < 112u) { __builtin_amdgcn_s_sleep(2); if (++sp > (1u << 24)) break; }
      __builtin_amdgcn_fence(__ATOMIC_ACQUIRE, "agent"); }
    asm volatile("s_waitcnt vmcnt(0)" ::: "memory"); __syncthreads();
#else
    if (!waited) { waited = true;
      if (F.tid == 0) { unsigned sp = 0;
        for (int bb = 0; bb < 4; ++bb) while (__hip_atomic_load(F.ctl + CW_RDY + 64 * bb, RLX_AGENT) < 112u) { __builtin_amdgcn_s_sleep(2); if (++sp > (1u << 24)) break; }
        __builtin_amdgcn_fence(__ATOMIC_ACQUIRE, "agent"); }
      asm volatile("s_waitcnt vmcnt(0)" ::: "memory"); __syncthreads(); }
#endif
    const size_t row0 = (size_t)b * SEQ + qb * 256, key0 = (size_t)b * SEQ + kh * (SEQ / 2);
    mla::attn_unit(QMp + row0 * 768 + h * 96, KMp + key0 * 768 + h * 96, VMp + key0 * 512 + h * 64,
                   PO + ((size_t)kh * MTOK + row0) * 512 + h * 64, PML + ((size_t)kh * MTOK + row0) * 16 + h * 2, SEQ / 2, lds_generic);
  }
}
namespace mls {
using mla::crow; using mla::v_st; using mla::v_rd_base;
#define KSWZ(row, colB) ((row) * 256 + ((colB) ^ (((row) & 7) << 4)))
constexpr int OFF_QS = 0, OFF_KS = 16384, OFF_KP = 32768, OFF_VV = 49152, OFF_CT = 65536, OFF_SC = 98304, OFF_NB = 99328, OFF_NP = 100352, OFF_CH = 104448, OFF_WS = 105472;
template <int OFF> __device__ __forceinline__ s16x4 trr(int vb) { s16x4 r; asm volatile("ds_read_b64_tr_b16 %0, %1 offset:%2" : "=&v"(r) : "v"(vb), "i"(OFF) : "memory"); return r; }
#define PKF(L, H) (bf16x8){L[0], L[1], L[2], L[3], H[0], H[1], H[2], H[3]}
__device__ __forceinline__ void vfrags(int img, int d0, int lane, bf16x8 (&f)[4]) {
  const int vb = img + v_rd_base(lane) + d0 * 512;
  const s16x4 l0 = trr<0>(vb), h0 = trr<2048>(vb), l1 = trr<4096>(vb), h1 = trr<4096 + 2048>(vb), l2 = trr<8192>(vb), h2 = trr<8192 + 2048>(vb), l3 = trr<12288>(vb), h3 = trr<12288 + 2048>(vb);
  asm volatile("s_waitcnt lgkmcnt(0)" ::: "memory"); __builtin_amdgcn_sched_barrier(0);
  f[0] = PKF(l0, h0); f[1] = PKF(l1, h1); f[2] = PKF(l2, h2); f[3] = PKF(l3, h3);
}
__device__ __forceinline__ void pack_p(const f32x16& p0, const f32x16& p1, bf16x8& pa0, bf16x8& pa1, bf16x8& pa2, bf16x8& pa3) {
#define PK4(P, BASE, OUT) do { unsigned a0 = cvt_pk_bf16(P[BASE + 0], P[BASE + 1]), a1 = cvt_pk_bf16(P[BASE + 2], P[BASE + 3]);   \
    unsigned b0 = cvt_pk_bf16(P[BASE + 4], P[BASE + 5]), b1 = cvt_pk_bf16(P[BASE + 6], P[BASE + 7]);                              \
    auto r0 = __builtin_amdgcn_permlane32_swap(a0, b0, false, false); auto r1 = __builtin_amdgcn_permlane32_swap(a1, b1, false, false); \
    v4u w = {r0[0], r1[0], r0[1], r1[1]}; OUT = __builtin_bit_cast(bf16x8, w); } while (0)
  PK4(p0, 0, pa0); PK4(p0, 8, pa1); PK4(p1, 0, pa2); PK4(p1, 8, pa3);
#undef PK4
}
__device__ __forceinline__ float swap_add(float v) { auto rr = __builtin_amdgcn_permlane32_swap(__float_as_uint(v), __float_as_uint(v), false, false); return __uint_as_float(rr[0]) + __uint_as_float(rr[1]); }

__device__ __forceinline__ void mlstm_seq(int seq, unsigned char* ws, char* lds) {
  int tid = threadIdx.x; asm volatile("" : "+v"(tid));
  const int wid = __builtin_amdgcn_readfirstlane(tid >> 6), lane = tid & 63, r32 = lane & 31, hi = lane >> 5, rb = wid >> 2, cb = wid & 3;
  const int dir = seq & 1, h = (seq >> 1) & 3, b = seq >> 3;
  const bf16* QC = (const bf16*)(ws + WS_QC); const bf16* KC = (const bf16*)(ws + WS_KC); const bf16* P = (const bf16*)(ws + WS_PROJ);
  const float* gs = (const float*)(ws + WS_GSC) + (size_t)seq * 3 * SEQ; const float* dec = (const float*)(ws + WS_DEC) + seq * 128;
  bf16* H = (bf16*)(ws + (dir ? WS_HB : WS_HF));
  float* sc_alpha = (float*)(lds + OFF_SC); float* sc_a = sc_alpha + 64; float* sc_iw = sc_alpha + 128; float* sc_en = sc_alpha + 192;
  float* nbuf = (float*)(lds + OFF_NB); float* npart = (float*)(lds + OFF_NP);
  float* ch_mprev = (float*)(lds + OFF_CH); float* ch_mnew = ch_mprev + 64; float* ch_dec = ch_mprev + 128; float* ch_g = ch_mprev + 192;
  float* wsf = (float*)(lds + OFF_WS) + wid * 32;
  const int ldsb = (int)(uintptr_t)lds;
  if (tid < 64) {
    if (tid == 0) { float m = 0.f; for (int c = 0; c < 64; ++c) { const float g = dec[c], wm = dec[64 + c]; const float mn = fmaxf(g + m, g + wm); ch_mprev[c] = m; ch_mnew[c] = mn; ch_dec[c] = __expf(g + m - mn); ch_g[c] = g; m = mn; } } }
  for (int i = tid; i < 32768 / 16; i += NTHR) ((v4u*)(lds + OFF_CT))[i] = (v4u){0u, 0u, 0u, 0u};
  if (tid < 128) nbuf[tid] = 0.f;
  f32x16 cacc[3]; cacc[0] = f32x16{}; cacc[1] = f32x16{}; cacc[2] = f32x16{};
  const int nown = rb ? 1 : 3;
  __syncthreads();
  const int sr = tid >> 4, sc = (tid & 15) * 8;
  v4u gq0, gq1, gk0, gk1, gv0, gv1; float ga0, ga1, sb = 0.f, sa = 0.f, spm = 0.f;
#define ROWOF(p) ((size_t)b * SEQ + (dir ? (SEQ - 1 - (p)) : (p)))
#define LOADC(c) do { const int p0_ = 64 * (c) + sr, p1_ = p0_ + 32; const size_t r0_ = ROWOF(p0_), r1_ = ROWOF(p1_); \
    gq0 = *(const v4u*)(QC + r0_ * 512 + h * 128 + sc); gq1 = *(const v4u*)(QC + r1_ * 512 + h * 128 + sc); \
    gk0 = *(const v4u*)(KC + r0_ * 512 + h * 128 + sc); gk1 = *(const v4u*)(KC + r1_ * 512 + h * 128 + sc); \
    gv0 = *(const v4u*)(P + r0_ * PROJ_LD + 1024 + h * 128 + sc); gv1 = *(const v4u*)(P + r1_ * PROJ_LD + 1024 + h * 128 + sc); \
    ga0 = gs[SEQ + p0_]; ga1 = gs[SEQ + p1_]; \
    if (tid < 64) { sb = gs[64 * (c) + tid]; sa = gs[SEQ + 64 * (c) + tid]; spm = gs[2 * SEQ + 64 * (c) + tid]; } } while (0)
#define WRITEC(c) do { \
    *(v4u*)(lds + OFF_QS + KSWZ(sr, sc * 2)) = gq0; *(v4u*)(lds + OFF_QS + KSWZ(32 + sr, sc * 2)) = gq1; \
    *(v4u*)(lds + OFF_KS + KSWZ(sr, sc * 2)) = gk0; *(v4u*)(lds + OFF_KS + KSWZ(32 + sr, sc * 2)) = gk1; \
    *(v4u*)(lds + OFF_VV + v_st(sr, sc)) = gv0; *(v4u*)(lds + OFF_VV + v_st(32 + sr, sc)) = gv1; \
    { const float gc_ = ch_g[c], mn_ = ch_mnew[c]; const float w0_ = __expf(gc_ + ga0 - mn_), w1_ = __expf(gc_ + ga1 - mn_); float f0_[8], f1_[8], cs_[8]; unpack8(gk0, f0_); unpack8(gk1, f1_); \
      _Pragma("unroll") for (int j = 0; j < 8; ++j) { f0_[j] *= w0_; f1_[j] *= w1_; cs_[j] = f0_[j] + f1_[j]; } \
      *(v4u*)(lds + OFF_KP + v_st(sr, sc)) = pack8(f0_); *(v4u*)(lds + OFF_KP + v_st(32 + sr, sc)) = pack8(f1_); \
      _Pragma("unroll") for (int j = 0; j < 8; ++j) { cs_[j] += __shfl_xor(cs_[j], 16); cs_[j] += __shfl_xor(cs_[j], 32); } \
      if ((lane >> 4) == 0) { _Pragma("unroll") for (int j = 0; j < 8; ++j) npart[wid * 128 + sc + j] = cs_[j]; } } \
    if (tid < 64) { const float m_ = ch_mprev[c]; const float mt_ = fmaxf(sb + m_, sb + spm); sc_alpha[tid] = sb - mt_; sc_a[tid] = sa; sc_iw[tid] = __expf(sb + m_ - mt_); sc_en[tid] = __expf(-mt_); } } while (0)
  LOADC(0); WRITEC(0);
  __syncthreads();
  for (int c = 0; c < 64; ++c) {
    if (c + 1 < 64) LOADC(c + 1);
    const float* nb = nbuf + (c & 1) * 128;
    if (tid < 128) { float s = 0.f;
#pragma unroll
      for (int w = 0; w < 8; ++w) s += npart[w * 128 + tid];
      nbuf[((c + 1) & 1) * 128 + tid] = ch_dec[c] * nb[tid] + s; }
    bf16x8 qr[8];
#pragma unroll
    for (int d0 = 0; d0 < 8; ++d0) qr[d0] = *(const bf16x8*)(lds + OFF_QS + KSWZ(32 * rb + r32, (16 * d0 + 8 * hi) * 2));
    f32x16 p0 = f32x16{}, p1 = f32x16{};
#pragma unroll
    for (int d0 = 0; d0 < 8; ++d0) { const bf16x8 k0 = *(const bf16x8*)(lds + OFF_KS + KSWZ(r32, (16 * d0 + 8 * hi) * 2)); p0 = __builtin_amdgcn_mfma_f32_32x32x16_bf16(k0, qr[d0], p0, 0, 0, 0); }
    if (rb == 1) {
#pragma unroll
      for (int d0 = 0; d0 < 8; ++d0) { const bf16x8 k1 = *(const bf16x8*)(lds + OFF_KS + KSWZ(32 + r32, (16 * d0 + 8 * hi) * 2)); p1 = __builtin_amdgcn_mfma_f32_32x32x16_bf16(k1, qr[d0], p1, 0, 0, 0); }
    }
    const float al = sc_alpha[32 * rb + r32];
    if (rb == 0) {
#pragma unroll
      for (int r = 0; r < 16; ++r) { const int sl = crow(r, hi); p0[r] = (sl <= r32) ? __expf(al + sc_a[sl]) * p0[r] : 0.f; }
    } else {
#pragma unroll
      for (int r = 0; r < 16; ++r) { const int sl = crow(r, hi); p0[r] = __expf(al + sc_a[sl]) * p0[r]; p1[r] = (sl <= r32) ? __expf(al + sc_a[32 + sl]) * p1[r] : 0.f; }
    }
    float ps = 0.f;
#pragma unroll
    for (int r = 0; r < 16; ++r) ps += p0[r] + p1[r];
    ps = swap_add(ps);
    bf16x8 pa0, pa1, pa2, pa3; pack_p(p0, p1, pa0, pa1, pa2, pa3);
    float qn = 0.f;
#pragma unroll
    for (int d0 = 0; d0 < 8; ++d0) { const f32x4 n0 = *(const f32x4*)(nb + 16 * d0 + 8 * hi), n1 = *(const f32x4*)(nb + 16 * d0 + 8 * hi + 4); const v4u qw = __builtin_bit_cast(v4u, qr[d0]);
      qn += bflo(qw.x) * n0.x + bfhi(qw.x) * n0.y + bflo(qw.y) * n0.z + bfhi(qw.y) * n0.w + bflo(qw.z) * n1.x + bfhi(qw.z) * n1.y + bflo(qw.w) * n1.z + bfhi(qw.w) * n1.w; }
    qn = swap_add(qn);
    { const float iwt = sc_iw[32 * rb + r32]; const float den = iwt * qn + ps; const float rd = 1.f / fmaxf(fabsf(den), sc_en[32 * rb + r32]); if (hi == 0) wsf[r32] = rd; }
    f32x16 o = f32x16{};
#pragma unroll
    for (int d0 = 0; d0 < 8; ++d0) { const bf16x8 cf = *(const bf16x8*)(lds + OFF_CT + KSWZ(32 * cb + r32, (16 * d0 + 8 * hi) * 2)); o = __builtin_amdgcn_mfma_f32_32x32x16_bf16(qr[d0], cf, o, 0, 0, 0); }
#pragma unroll
    for (int r = 0; r < 16; ++r) o[r] *= sc_iw[32 * rb + crow(r, hi)];
    bf16x8 vf[4]; vfrags(ldsb + OFF_VV, cb, lane, vf);
    o = __builtin_amdgcn_mfma_f32_32x32x16_bf16(pa0, vf[0], o, 0, 0, 0); o = __builtin_amdgcn_mfma_f32_32x32x16_bf16(pa1, vf[1], o, 0, 0, 0);
    if (rb == 1) { o = __builtin_amdgcn_mfma_f32_32x32x16_bf16(pa2, vf[2], o, 0, 0, 0); o = __builtin_amdgcn_mfma_f32_32x32x16_bf16(pa3, vf[3], o, 0, 0, 0); }
    asm volatile("s_waitcnt lgkmcnt(0)" ::: "memory");
#pragma unroll
    for (int r = 0; r < 16; ++r) { const int tl = crow(r, hi); const int p = 64 * c + 32 * rb + tl; H[ROWOF(p) * 512 + h * 128 + 32 * cb + r32] = (bf16)f2bf(o[r] * wsf[tl]); }
    { const float dc = ch_dec[c];
#pragma unroll
      for (int i = 0; i < 3; ++i) if (i < nown) { const int db = rb ? 3 : i; bf16x8 kf[4]; vfrags(ldsb + OFF_KP, db, lane, kf);
#pragma unroll
        for (int r = 0; r < 16; ++r) cacc[i][r] *= dc;
#pragma unroll
        for (int ks = 0; ks < 4; ++ks) cacc[i] = __builtin_amdgcn_mfma_f32_32x32x16_bf16(kf[ks], vf[ks], cacc[i], 0, 0, 0); } }
    __syncthreads();
#pragma unroll
    for (int i = 0; i < 3; ++i) if (i < nown) {
#pragma unroll
      for (int g = 0; g < 4; ++g) { const int d = 32 * (rb ? 3 : i) + 8 * g + 4 * hi, e = 32 * cb + r32;
        v2u w; w.x = cvt_pk_bf16(cacc[i][4 * g], cacc[i][4 * g + 1]); w.y = cvt_pk_bf16(cacc[i][4 * g + 2], cacc[i][4 * g + 3]);
        *(v2u*)(lds + OFF_CT + KSWZ(e, d * 2)) = w; } }
    if (c + 1 < 64) WRITEC(c + 1);
    __syncthreads();
  }
#undef ROWOF
#undef LOADC
#undef WRITEC
}
#undef KSWZ
#undef PKF
}

struct ListOrder { int n, L0, L1, nN, lda, ldb;
  __device__ bool next(int i, pg8::Unit& u) const { if (i >= n) return false; const int L = i ? L1 : L0; u.pm = L / nN; u.pn = L % nN; u.g = 0; u.ibase = 0;
    u.aoff = (long)u.pm * 256 * lda; u.boff = (long)u.pn * 256 * ldb; return true; } };
__device__ __forceinline__ void publish_units(Frame& F, const ListOrder& S) {
  if (F.tid == 0) { __builtin_amdgcn_fence(__ATOMIC_RELEASE, "agent"); asm volatile("s_waitcnt vmcnt(0)" ::: "memory");
    for (int i = 0; i < S.n; ++i) { const int L = i ? S.L1 : S.L0; __hip_atomic_fetch_add(F.ctl + CW_RDY + 64 * ((L / S.nN) >> 4), 1u, RLX_AGENT); } }
}
#ifndef P3_FILL_CHUNKS
#define P3_FILL_CHUNKS 3
#endif
__device__ __forceinline__ void p3_mixers(Frame& F, const Args& a, char* lds_generic, unsigned xcc, float* ssq, float* sskv, int qoff) {
  unsigned char* ws = F.ws; const int bx = (int)blockIdx.x;
#ifndef MLSTM_REPS
#define MLSTM_REPS 1
#endif
  if (bx < 32) { for (int rp = 0; rp < MLSTM_REPS; ++rp) { mls::mlstm_seq(bx, F.ws, lds_generic); __syncthreads(); } }
  else { const int c = bx - 32;
    { ListOrder S{c < 192 ? 1 : 0, c, 0, 3, PROJ_LD, 256};
      pg8::Gemm g{(const bf16*)(ws + WS_PROJ) + PC_CQ, (const bf16*)(ws + WS_WQB), PROJ_LD, 256, 256, nullptr, 127, 127};
      EpiQ E{(bf16*)(ws + WS_QM), ssq, (const float*)(ws + WS_ROPE)};
      pg8::gemm_phase<EpiQ, ListOrder, false>(F.lds, g, S, E); publish_units(F, S); }
    { ListOrder S{c >= 192 ? 2 : 1, c >= 192 ? c - 192 : c + 32, c + 32, 4, PROJ_LD, 256};
      pg8::Gemm g{(const bf16*)(ws + WS_PROJ) + PC_CKV, (const bf16*)(ws + WS_WKVB), PROJ_LD, 256, 256, nullptr, 127, 127};
      EpiKV E{(bf16*)(ws + WS_KM), (bf16*)(ws + WS_VM), sskv};
      pg8::gemm_phase<EpiKV, ListOrder, false>(F.lds, g, S, E); publish_units(F, S); }
  }
  p3_attention(F, a, lds_generic, xcc, qoff);
  if (bx >= 32 && !qoff) conv_fill(F, a, P3_FILL_CHUNKS);
}
__device__ __forceinline__ void p4_combine(Frame& F, const Args& a) {
  unsigned char* ws = F.ws; const bf16* HF = (const bf16*)(ws + WS_HF); const bf16* HB = (const bf16*)(ws + WS_HB); const bf16* P = (const bf16*)(ws + WS_PROJ); bf16* Y = (bf16*)(ws + WS_Y);
  const float* g = (const float*)a.in[I_GHM];
  const int gw = F.vcu * NWAVES + F.wave, NGW = F.G * NWAVES, c = F.lane * 8;
  float gg[8];
#pragma unroll
  for (int j = 0; j < 8; ++j) gg[j] = g[c + j];
  for (int m0 = gw; m0 < MTOK; m0 += 2 * NGW) {
    v4u wf[2], wb[2], wo[2];
#pragma unroll
    for (int u = 0; u < 2; ++u) { const size_t m = (size_t)(m0 + u * NGW); wf[u] = *(const v4u*)(HF + m * 512 + c); wb[u] = *(const v4u*)(HB + m * 512 + c); wo[u] = *(const v4u*)(P + m * PROJ_LD + 1536 + c); }
#pragma unroll
    for (int u = 0; u < 2; ++u) { const size_t m = (size_t)(m0 + u * NGW);
      float f[8], bb[8], oo[8]; unpack8(wf[u], f); unpack8(wb[u], bb); unpack8(wo[u], oo);
      float s = 0.f;
#pragma unroll
      for (int j = 0; j < 8; ++j) { f[j] += bb[j]; s += f[j] * f[j]; }
      s += __shfl_xor(s, 1); s += __shfl_xor(s, 2); s += __shfl_xor(s, 4); s += __shfl_xor(s, 8);
      const float r = rsqrtf(s * (1.f / 128.f) + 1e-6f);
#pragma unroll
      for (int j = 0; j < 8; ++j) f[j] = f[j] * r * gg[j] * sigmoidf_(oo[j]);
      *(v4u*)(Y + m * 1024 + c) = pack8(f); }
  }
  { const float* PO = (const float*)(ws + WS_PO); const float* PML = (const float*)(ws + WS_PML); const float* ga = (const float*)a.in[I_GHA];
    constexpr float C = 0.10206207261596575f * 1.4426950408889634f; const int hh = F.lane >> 3;
    float g8[8];
#pragma unroll
    for (int j = 0; j < 8; ++j) g8[j] = ga[c + j];
    for (int m = gw; m < MTOK; m += NGW) {
      const float* p0 = PO + (size_t)m * 512 + c; const float* p1 = p0 + (size_t)MTOK * 512;
      const f32x4 a0 = *(const f32x4*)p0, a1 = *(const f32x4*)(p0 + 4), b0 = *(const f32x4*)p1, b1 = *(const f32x4*)(p1 + 4);
      const float m0 = PML[(size_t)m * 16 + hh * 2], l0 = PML[(size_t)m * 16 + hh * 2 + 1], m1 = PML[((size_t)MTOK + m) * 16 + hh * 2], l1 = PML[((size_t)MTOK + m) * 16 + hh * 2 + 1];
      const float M = fmaxf(m0, m1), e0 = __builtin_amdgcn_exp2f((m0 - M) * C), e1 = __builtin_amdgcn_exp2f((m1 - M) * C); const float rl = 1.f / (l0 * e0 + l1 * e1);
      float f[8] = {a0.x * e0 + b0.x * e1, a0.y * e0 + b0.y * e1, a0.z * e0 + b0.z * e1, a0.w * e0 + b0.w * e1, a1.x * e0 + b1.x * e1, a1.y * e0 + b1.y * e1, a1.z * e0 + b1.z * e1, a1.w * e0 + b1.w * e1};
      float s = 0.f;
#pragma unroll
      for (int j = 0; j < 8; ++j) { f[j] *= rl; s += f[j] * f[j]; }
      s += __shfl_xor(s, 1); s += __shfl_xor(s, 2); s += __shfl_xor(s, 4);
      const float r = rsqrtf(s * (1.f / 64.f) + 1e-6f);
#pragma unroll
      for (int j = 0; j < 8; ++j) f[j] = f[j] * r * g8[j];
      *(v4u*)(Y + (size_t)m * 1024 + 512 + c) = pack8(f); } }
}
template <int MODE> struct EpiResid { static constexpr bool TWO_PASS = false; const float* basef; const bf16* baseb; float* out; bf16* outb; float* ss;
  __device__ __forceinline__ void row8(const pg8::Unit& u, int rloc, int cloc, const float (&a0)[8], const float (&a1)[8], int fq) const {
    const int row = u.pm * 256 + rloc; const size_t off = (size_t)row * 1024 + u.pn * 256 + cloc;
    float v0[8], v1[8];
    if constexpr (MODE == 0) {
      const f32x4 b0 = *(const f32x4*)(basef + off), b1 = *(const f32x4*)(basef + off + 4), b2 = *(const f32x4*)(basef + off + 128), b3 = *(const f32x4*)(basef + off + 132);
#pragma unroll
      for (int i = 0; i < 4; ++i) { v0[i] = a0[i] + b0[i]; v0[4 + i] = a0[4 + i] + b1[i]; v1[i] = a1[i] + b2[i]; v1[4 + i] = a1[4 + i] + b3[i]; }
      *(v4u*)(outb + off) = pack8(v0); *(v4u*)(outb + off + 128) = pack8(v1);
    } else {
      float r0[8], r1[8]; unpack8(*(const v4u*)(baseb + off), r0); unpack8(*(const v4u*)(baseb + off + 128), r1);
#pragma unroll
      for (int i = 0; i < 8; ++i) { v0[i] = a0[i] + r0[i]; v1[i] = a1[i] + r1[i]; }
      *(f32x4*)(out + off) = (f32x4){v0[0], v0[1], v0[2], v0[3]}; *(f32x4*)(out + off + 4) = (f32x4){v0[4], v0[5], v0[6], v0[7]};
      *(f32x4*)(out + off + 128) = (f32x4){v1[0], v1[1], v1[2], v1[3]}; *(f32x4*)(out + off + 132) = (f32x4){v1[4], v1[5], v1[6], v1[7]};
    }
    float s = sumsq8(v0) + sumsq8(v1); s += __shfl_xor(s, 16); s += __shfl_xor(s, 32); if (fq == 0) unsafeAtomicAdd(ss + row, s); } };
struct EpiScale { static constexpr bool TWO_PASS = false; bf16* O; const float* ss;
  __device__ __forceinline__ void row8(const pg8::Unit& u, int rloc, int cloc, const float (&a0)[8], const float (&a1)[8], int fq) const {
    const int row = u.pm * 256 + rloc; const float r = rsqrtf(ss[row] * (1.f / 1024.f) + 1e-6f); float v0[8], v1[8];
#pragma unroll
    for (int i = 0; i < 8; ++i) { v0[i] = a0[i] * r; v1[i] = a1[i] * r; }
    bf16* p = O + (size_t)row * 1024 + u.pn * 256 + cloc; *(v4u*)p = pack8(v0); *(v4u*)(p + 128) = pack8(v1); } };
struct EpiSoftmax { static constexpr bool TWO_PASS = true; bf16* O; float scale; LAS float* xch;
  __device__ __forceinline__ void pass1(const pg8::Unit& u, int rloc, int wc, float (&v0)[8], float (&v1)[8], int fq) const {
    float mx = -3.0e38f;
#pragma unroll
    for (int i = 0; i < 8; ++i) { v0[i] *= scale; v1[i] *= scale; mx = fmaxf(mx, fmaxf(v0[i], v1[i])); }
    mx = fmaxf(mx, __shfl_xor(mx, 16)); mx = fmaxf(mx, __shfl_xor(mx, 32));
    float l = 0.f;
#pragma unroll
    for (int i = 0; i < 8; ++i) { v0[i] = __expf(v0[i] - mx); v1[i] = __expf(v1[i] - mx); l += v0[i] + v1[i]; }
    l += __shfl_xor(l, 16); l += __shfl_xor(l, 32);
    if (fq == 0) { xch[(rloc * 4 + wc) * 2] = mx; xch[(rloc * 4 + wc) * 2 + 1] = l; } }
  __device__ __forceinline__ void row8(const pg8::Unit& u, int rloc, int cloc, const float (&a0)[8], const float (&a1)[8], int fq) const {
    const int wc = cloc >> 5; float m[4], l[4]; float M = -3.0e38f;
#pragma unroll
    for (int w = 0; w < 4; ++w) { m[w] = xch[(rloc * 4 + w) * 2]; l[w] = xch[(rloc * 4 + w) * 2 + 1]; M = fmaxf(M, m[w]); }
    float L = 0.f, mine = 0.f;
#pragma unroll
    for (int w = 0; w < 4; ++w) { const float e = __expf(m[w] - M); L += l[w] * e; if (w == wc) mine = e; }
    const float f = mine / L; float v0[8], v1[8];
#pragma unroll
    for (int i = 0; i < 8; ++i) { v0[i] = a0[i] * f; v1[i] = a1[i] * f; }
    bf16* p = O + (size_t)(u.pm * 256 + rloc) * 1024 + u.pn * 256 + cloc; *(v4u*)p = pack8(v0); *(v4u*)(p + 128) = pack8(v1); } };
struct MemOrder { int G, c, kind;
  __device__ bool next(int i, pg8::Unit& u) const { const int L = i * G + c; if (L >= 256) return false;
    const int bh = L >> 4, t = L & 15, b = bh >> 2, h = bh & 3;
    u.pm = b * 16 + t; u.pn = h; u.g = 0; u.ibase = 0; u.aoff = ((long)(b * SEQ + t * 256)) * 1024 + (kind == 2 ? 0 : h * 256);
    u.boff = kind == 0 ? ((long)(b * NMEM)) * 1024 + h * 256 : kind == 1 ? ((long)(h * 256)) * 1024 + b * NMEM : ((long)(h * 256)) * 1024; return true; } };
constexpr size_t WS_WRG = WS_DEC + 65536;
constexpr size_t WS_ROWSEL = WS_SEL, WS_GSEL = WS_SEL + 131072, WS_INV = 31 * MiB, WS_YE = 160 * MiB;
typedef float f32x4m __attribute__((ext_vector_type(4)));
__device__ __forceinline__ void p10_router(Frame& F, const Args& a) {
  unsigned char* ws = F.ws; const float* X2 = (const float*)(ws + WS_X2); const float* ss2 = (const float*)(ws + CTL_SS2); float* AFF = (float*)(ws + WS_AFF); const float* WRG = (const float*)(ws + WS_WRG);
  const int gw = F.vcu * NWAVES + F.wave, NGW = F.G * NWAVES, r = F.lane & 15, kq = F.lane >> 4;
  LAS float* wl = (LAS float*)F.lds;
  for (int i = F.tid; i < 4096; i += NTHR) ((LAS f32x4*)wl)[i] = ((const f32x4*)WRG)[i];
  __syncthreads();
  for (int it = gw; it < MTOK / 16; it += NGW) { const int m0 = it * 16;
    const float* xp = X2 + (size_t)(m0 + r) * 1024 + 4 * kq; const LAS float* wp = wl + (4 * kq) * 16 + r;
    f32x4m acc0 = {0.f, 0.f, 0.f, 0.f}, acc1 = {0.f, 0.f, 0.f, 0.f};
#pragma unroll 1
    for (int hf = 0; hf < 2; ++hf) {
      f32x4 xv[32];
#pragma unroll
      for (int j = 0; j < 32; ++j) xv[j] = *(const f32x4*)(xp + 16 * (32 * hf + j));
#pragma unroll
      for (int j = 0; j < 32; j += 2) { const LAS float* w0 = wp + (16 * (32 * hf + j)) * 16; const LAS float* w1 = w0 + 256;
        acc0 = __builtin_amdgcn_mfma_f32_16x16x4f32(xv[j].x, w0[0], acc0, 0, 0, 0); acc1 = __builtin_amdgcn_mfma_f32_16x16x4f32(xv[j + 1].x, w1[0], acc1, 0, 0, 0);
        acc0 = __builtin_amdgcn_mfma_f32_16x16x4f32(xv[j].y, w0[16], acc0, 0, 0, 0); acc1 = __builtin_amdgcn_mfma_f32_16x16x4f32(xv[j + 1].y, w1[16], acc1, 0, 0, 0);
        acc0 = __builtin_amdgcn_mfma_f32_16x16x4f32(xv[j].z, w0[32], acc0, 0, 0, 0); acc1 = __builtin_amdgcn_mfma_f32_16x16x4f32(xv[j + 1].z, w1[32], acc1, 0, 0, 0);
        acc0 = __builtin_amdgcn_mfma_f32_16x16x4f32(xv[j].w, w0[48], acc0, 0, 0, 0); acc1 = __builtin_amdgcn_mfma_f32_16x16x4f32(xv[j + 1].w, w1[48], acc1, 0, 0, 0); }
    }
#pragma unroll
    for (int i = 0; i < 4; ++i) { const int row = m0 + 4 * kq + i; const float lg = (acc0[i] + acc1[i]) * rsqrtf(ss2[row] * (1.f / 1024.f) + 1e-6f);
      float mx = lg; mx = fmaxf(mx, __shfl_xor(mx, 1)); mx = fmaxf(mx, __shfl_xor(mx, 2)); mx = fmaxf(mx, __shfl_xor(mx, 4)); mx = fmaxf(mx, __shfl_xor(mx, 8));
      const float ex = __expf(lg - mx); float l = ex; l += __shfl_xor(l, 1); l += __shfl_xor(l, 2); l += __shfl_xor(l, 4); l += __shfl_xor(l, 8);
      AFF[(size_t)row * 16 + r] = ex / l; }
  }
  __syncthreads();
}
__device__ __forceinline__ void p11_topk(Frame& F, char* lds) {
  unsigned char* ws = F.ws; const float* AFF = (const float*)(ws + WS_AFF); int* ROWSEL = (int*)(ws + WS_ROWSEL); float* GSEL = (float*)(ws + WS_GSEL); int* INV = (int*)(ws + WS_INV);
  unsigned* hist = (unsigned*)lds; unsigned* ctl = hist + 256; unsigned* wsum = hist + 320;
  const int tid = F.tid, lane = F.lane, wid = F.wave;
  for (int it = (int)blockIdx.x; it < BATCH * NEXP; it += F.G) { const int b = it >> 4, e = it & 15;
    unsigned key[8];
#pragma unroll
    for (int j = 0; j < 8; ++j) key[j] = __float_as_uint(AFF[((size_t)b * SEQ + 8 * tid + j) * 16 + e]);
    unsigned prefix = 0u, mask = 0u, need = CAP;
    for (int shift = 24; shift >= 0; shift -= 8) {
      if (tid < 256) hist[tid] = 0u;
      __syncthreads();
#pragma unroll
      for (int j = 0; j < 8; ++j) if ((key[j] & mask) == prefix) atomicAdd(&hist[(key[j] >> shift) & 255u], 1u);
      __syncthreads();
      if (tid == 0) { unsigned above = 0u; int d = 255; for (; d > 0; --d) { const unsigned c = hist[d]; if (above + c >= need) break; above += c; } ctl[0] = (unsigned)d; ctl[1] = need - above; }
      __syncthreads();
      prefix |= ctl[0] << shift; mask |= 255u << shift; need = ctl[1];
      __syncthreads();
    }
    unsigned ngt = 0u, neq = 0u;
#pragma unroll
    for (int j = 0; j < 8; ++j) { ngt += key[j] > prefix ? 1u : 0u; neq += key[j] == prefix ? 1u : 0u; }
    unsigned sgt = ngt, seq_ = neq;
#pragma unroll
    for (int o = 1; o < 64; o <<= 1) { const unsigned y0 = __shfl_up(sgt, o), y1 = __shfl_up(seq_, o); if (lane >= o) { sgt += y0; seq_ += y1; } }
    if (lane == 63) { wsum[wid] = sgt; wsum[8 + wid] = seq_; }
    __syncthreads();
    unsigned bgt = 0u, beq = 0u, tgt = 0u;
#pragma unroll
    for (int w = 0; w < 8; ++w) { const unsigned g = wsum[w], q = wsum[8 + w]; if (w < wid) { bgt += g; beq += q; } tgt += g; }
    unsigned pgt = bgt + sgt - ngt, peq = beq + seq_ - neq;
#pragma unroll
    for (int j = 0; j < 8; ++j) { const int t = 8 * tid + j; int slot = -1;
      if (key[j] > prefix) slot = (int)pgt++; else if (key[j] == prefix) { if (peq < need) slot = (int)(tgt + peq); ++peq; }
      INV[((size_t)b * SEQ + t) * 16 + e] = slot;
      if (slot >= 0) { ROWSEL[e * 2048 + b * 512 + slot] = b * SEQ + t; GSEL[e * 2048 + b * 512 + slot] = __uint_as_float(key[j]); } }
    __syncthreads();
  }
}
#ifndef GU_ORDER
#define GU_ORDER 1
#endif
#ifndef DN_ORDER
#define DN_ORDER 1
#endif
struct MoeGUOrder { int G, c;
  __device__ bool next(int i, pg8::Unit& u) const { const int L = i * G + c; if (L >= 2048) return false;
#if GU_ORDER == 0
    const int e = L >> 7, r = L & 127, pn = r >> 3, mt = r & 7;
#elif GU_ORDER == 1
    const int e = L >> 7, r = L & 127, mt = r >> 4, pn = r & 15;
#else
    const int x = c & 7, j = c >> 3, e = (i >> 2) * 8 + x, r = (i & 3) * 32 + j, mt = r >> 4, pn = r & 15;
#endif
    u.g = e; u.pm = mt; u.pn = pn; u.ibase = e * 2048 + mt * 256; u.aoff = MOE_FP8 ? ((long)e * 2048 + mt * 256) * 512 : 0; u.boff = ((long)e * 4096 + pn * 256) * (MOE_FP8 ? 512 : 1024); return true; } };
struct MoeDownOrder { int G, c;
  __device__ bool next(int i, pg8::Unit& u) const { const int L = i * G + c; if (L >= 512) return false;
#if DN_ORDER == 0
    const int e = L >> 5, r = L & 31, pn = r >> 3, mt = r & 7;
#else
    const int x = c & 7, j = c >> 3, e = i * 8 + x, pn = j >> 3, mt = j & 7;
#endif
    u.g = e; u.pm = mt; u.pn = pn; u.ibase = e * 2048 + mt * 256; u.aoff = ((long)e * 2048 + mt * 256) * (MOE_FP8_DOWN ? 1024 : 2048); u.boff = ((long)e * 1024 + pn * 256) * (MOE_FP8_DOWN ? 1024 : 2048); return true; } };
struct EpiGU { static constexpr bool TWO_PASS = false; bf16* H; const float* ss2; const int* rowsel;
  __device__ __forceinline__ void row8(const pg8::Unit& u, int rloc, int cloc, const float (&a0)[8], const float (&a1)[8], int fq) const {
    const int tok = rowsel[u.ibase + rloc]; const float r = rsqrtf(ss2[tok] * (1.f / 1024.f) + 1e-6f); float h[8];
#pragma unroll
    for (int i = 0; i < 8; ++i) { const float g = a0[i] * r, up = a1[i] * r; h[i] = g * sigmoidf_(g) * up; if (FP8EMU) h[i] = q8(h[i], 8.f); }
#if MOE_FP8_DOWN
    *(v2u*)((unsigned char*)H + ((size_t)u.g * 2048 + u.pm * 256 + rloc) * 2048 + u.pn * 128 + cloc) = pack8_fp8(h, 8.f); } };
#else
    *(v4u*)(H + ((size_t)u.g * 2048 + u.pm * 256 + rloc) * 2048 + u.pn * 128 + cloc) = pack8(h); } };
#endif
struct EpiGU8 { static constexpr bool TWO_PASS = false; unsigned char* H8; const float* ss2; const int* rowsel;
  __device__ __forceinline__ void row8(const pg8::Unit& u, int rloc, int cloc, const float (&a0)[8], const float (&a1)[8], int fq) const {
    float h[8];
#pragma unroll
    for (int i = 0; i < 8; ++i) { const float g = a0[i], up = a1[i]; h[i] = g * sigmoidf_(g) * up; }
#if MOE_FP8_DOWN
    *(v2u*)(H8 + ((size_t)u.g * 2048 + u.pm * 256 + rloc) * 2048 + u.pn * 128 + cloc) = pack8_fp8(h, 8.f); } };
#else
    *(v4u*)((bf16*)H8 + ((size_t)u.g * 2048 + u.pm * 256 + rloc) * 2048 + u.pn * 128 + cloc) = pack8(h); } };
#endif
struct EpiYE { static constexpr bool TWO_PASS = false; bf16* Yp; const float* gsel;
  __device__ __forceinline__ void row8(const pg8::Unit& u, int rloc, int cloc, const float (&a0)[8], const float (&a1)[8], int fq) const {
    const float gv = gsel[u.ibase + rloc]; float v0[8], v1[8];
#pragma unroll
    for (int i = 0; i < 8; ++i) { v0[i] = a0[i] * gv; v1[i] = a1[i] * gv; }
    bf16* p = Yp + ((size_t)u.g * 2048 + u.pm * 256 + rloc) * 1024 + u.pn * 256 + cloc; *(v4u*)p = pack8(v0); *(v4u*)(p + 128) = pack8(v1); } };
__device__ __forceinline__ void p14_final(Frame& F, const Args& a) {
  unsigned char* ws = F.ws; const float* X2 = (const float*)(ws + WS_X2); const int* INV = (const int*)(ws + WS_INV); const bf16* YE = (const bf16*)(ws + WS_YE);
  const float* gfin = (const float*)a.in[I_GFIN]; float* out = a.out;
  const int gw = F.vcu * NWAVES + F.wave, NGW = F.G * NWAVES;
  f32x4 g[4];
#pragma unroll
  for (int j = 0; j < 4; ++j) g[j] = *(const f32x4*)(gfin + 256 * j + 4 * F.lane);
  for (int m0 = gw; m0 < MTOK; m0 += 2 * NGW) {
    f32x4 v[2][4]; int inv[2];
#pragma unroll
    for (int u = 0; u < 2; ++u) { const int m = m0 + u * NGW;
#pragma unroll
      for (int j = 0; j < 4; ++j) v[u][j] = *(const f32x4*)(X2 + (size_t)m * 1024 + 256 * j + 4 * F.lane);
      inv[u] = F.lane < 16 ? INV[(size_t)m * 16 + F.lane] : -1; }
#pragma unroll
    for (int u = 0; u < 2; ++u) { const int m = m0 + u * NGW, b = m >> 12;
      unsigned long long sel = __ballot(inv[u] >= 0);
      while (sel) { const int e = __builtin_ctzll(sel); sel &= sel - 1; const int slot = __shfl(inv[u], e);
        const bf16* yr = YE + ((size_t)e * 2048 + b * 512 + slot) * 1024 + 4 * F.lane;
#pragma unroll
        for (int j = 0; j < 4; ++j) { const v2u w = *(const v2u*)(yr + 256 * j); v[u][j].x += bflo(w.x); v[u][j].y += bfhi(w.x); v[u][j].z += bflo(w.y); v[u][j].w += bfhi(w.y); } }
      float s = 0.f;
#pragma unroll
      for (int j = 0; j < 4; ++j) s += (v[u][j].x * v[u][j].x + v[u][j].y * v[u][j].y) + (v[u][j].z * v[u][j].z + v[u][j].w * v[u][j].w);
      const float r = rsqrtf(wave_sum(s) * (1.f / 1024.f) + 1e-6f);
#pragma unroll
      for (int j = 0; j < 4; ++j) *(f32x4*)(out + (size_t)m * 1024 + 256 * j + 4 * F.lane) = v[u][j] * r * g[j]; }
  }
}
__global__ void __launch_bounds__(NTHR, 2) mk(Args a) {
  extern __shared__ __attribute__((aligned(16))) unsigned char lds_raw[];
  Frame F;
  F.lds = (LAS unsigned char*)lds_raw; F.MISC = (volatile LAS unsigned*)(F.lds + LDSCTL_OFF + 320);
  F.tid = threadIdx.x; F.lane = F.tid & 63; F.wave = __builtin_amdgcn_readfirstlane(F.tid >> 6);
  F.G = gridDim.x; { const int bx = blockIdx.x; F.vcu = (F.G % 8 == 0) ? (bx % 8) * (F.G / 8) + bx / 8 : bx; }
  F.ws = a.ws; F.ctl = (gu32*)(a.ws + WS_CTL);
  unsigned char* ws = a.ws;
  for (int u = F.tid; u < (LDS_BYTES - LDSCTL_OFF) / 4; u += NTHR) ((LAS unsigned*)(F.lds + LDSCTL_OFF))[u] = 0u;
  __syncthreads();
  XcdBarrier bar = xcd_barrier_post((unsigned*)(F.ctl + CW_BAR), F.MISC + 8);
  const int lo = a.ph_lo, hi = a.ph_hi;
#define IN(k) (lo <= (k) && (k) < hi)
#define BOTH(k) (IN(k) && IN((k) + 1))
#define GRID_BAR() xcd_barrier(bar)
  float* ssq = (float*)(ws + CTL_SSQ); float* sskv = (float*)(ws + CTL_SSKV);

#ifndef REP_MASK
#define REP_MASK 0
#endif
#define NREP(k) ((((REP_MASK) >> (k)) & 1) ? 2 : 1)
#define PH_BEGIN(k) if (IN(k)) { for (int rep_ = 0; rep_ < NREP(k); ++rep_) { const bool dry = rep_ + 1 < NREP(k); (void)dry;
#define PH_END(k) if (dry) GRID_BAR(); } if (BOTH(k)) GRID_BAR(); }
  float* dummy = (float*)(ws + WS_DUMMY);
  float* ss1 = (float*)(ws + CTL_SS1); float* ss2 = (float*)(ws + CTL_SS2);
#ifndef FILLMODE
#define FILLMODE 2
#endif
  PH_BEGIN(0) p0_prologue(F, a, true, FILLMODE == 0); PH_END(0)
  PH_BEGIN(1)
    { pg8::Gemm g{(const bf16*)(ws + WS_XN), (const bf16*)(ws + WS_WIN), 1024, 1024, 1024, nullptr, 127, 127}; pg8::StaticOrder S; S.init(MTOK, PROJ_LD, F.G, (int)blockIdx.x, 1024, 1024);
      EpiProj E{(bf16*)(ws + WS_PROJ), dry ? dummy : ssq, dry ? dummy + 16384 : sskv};
      pg8::gemm_phase<EpiProj, pg8::StaticOrder, false>(F.lds, g, S, E); }
    { pg8::Gemm g{(const bf16*)(ws + WS_MEMN), (const bf16*)(ws + WS_WMK), 1024, 1024, 1024, nullptr, 127, 127}; pg8::StaticOrder S; S.init(1024, 1024, F.G, (int)((blockIdx.x + 128u) % (unsigned)F.G), 1024, 1024);
      EpiStore E{(bf16*)(ws + WS_KMEM), 1024};
      pg8::gemm_phase<EpiStore, pg8::StaticOrder, false>(F.lds, g, S, E); }
    { pg8::Gemm g{(const bf16*)(ws + WS_WMV), (const bf16*)(ws + WS_MEMN), 1024, 1024, 1024, nullptr, 127, 127}; pg8::StaticOrder S; S.init(1024, 1024, F.G, (int)((blockIdx.x + 112u) % (unsigned)F.G), 1024, 1024);
      EpiStore E{(bf16*)(ws + WS_VMEMT), 1024};
      pg8::gemm_phase<EpiStore, pg8::StaticOrder, false>(F.lds, g, S, E); }
  PH_END(1)
  PH_BEGIN(2) p2_elementwise(F, a); PH_END(2)
  PH_BEGIN(3) p3_mixers(F, a, (char*)lds_raw, bar.x, ssq, sskv, dry ? 64 * 16 : 0); PH_END(3)
  PH_BEGIN(4) p4_combine(F, a); PH_END(4)
  PH_BEGIN(5)
    pg8::Gemm g{(const bf16*)(ws + WS_Y), (const bf16*)(ws + WS_WOUT), 1024, 1024, 1024, nullptr, 127, 127}; pg8::StaticOrder S; S.init(MTOK, 1024, F.G, (int)blockIdx.x, 1024, 1024);
    EpiResid<0> E{(const float*)a.in[I_X], nullptr, nullptr, (bf16*)(ws + WS_X1B), dry ? dummy : ss1};
    pg8::gemm_phase<EpiResid<0>, pg8::StaticOrder, false>(F.lds, g, S, E);
  PH_END(5)
  PH_BEGIN(6)
    { pg8::Gemm g{(const bf16*)(ws + WS_X1B), (const bf16*)(ws + WS_WMQ), 1024, 1024, 1024, nullptr, 127, 127}; MemOrder S{F.G, (int)blockIdx.x, 2};
      EpiScale E{(bf16*)(ws + WS_QMEM), ss1};
      pg8::gemm_phase<EpiScale, MemOrder, false>(F.lds, g, S, E); }
    if (F.tid == 0) __builtin_amdgcn_fence(__ATOMIC_ACQUIRE, "agent");
    asm volatile("s_waitcnt vmcnt(0)" ::: "memory"); __syncthreads();
    { pg8::Gemm g{(const bf16*)(ws + WS_QMEM), (const bf16*)(ws + WS_KMEM), 1024, 1024, 256, nullptr, 127, 127}; MemOrder S{F.G, (int)blockIdx.x, 0};
      EpiSoftmax E{(bf16*)(ws + WS_P), 0.0625f, (LAS float*)(F.lds + LDSCTL_OFF + 1024)};
      pg8::gemm_phase<EpiSoftmax, MemOrder, false>(F.lds, g, S, E); }
    if (F.tid == 0) __builtin_amdgcn_fence(__ATOMIC_ACQUIRE, "agent");
    asm volatile("s_waitcnt vmcnt(0)" ::: "memory"); __syncthreads();
    { pg8::Gemm g{(const bf16*)(ws + WS_P), (const bf16*)(ws + WS_VMEMT), 1024, 1024, 256, nullptr, 127, 127}; MemOrder S{F.G, (int)blockIdx.x, 1};
      EpiStore E{(bf16*)(ws + WS_MO), 1024};
      pg8::gemm_phase<EpiStore, MemOrder, false>(F.lds, g, S, E); }
  PH_END(6)
  PH_BEGIN(9)
    pg8::Gemm g{(const bf16*)(ws + WS_MO), (const bf16*)(ws + WS_WMO), 1024, 1024, 1024, nullptr, 127, 127}; pg8::StaticOrder S; S.init(MTOK, 1024, F.G, (int)blockIdx.x, 1024, 1024);
    EpiResid<1> E{nullptr, (const bf16*)(ws + WS_X1B), (float*)(ws + WS_X2), nullptr, dry ? dummy : ss2};
    pg8::gemm_phase<EpiResid<1>, pg8::StaticOrder, false>(F.lds, g, S, E);
  PH_END(9)
  PH_BEGIN(10) p10_router(F, a); PH_END(10)
  PH_BEGIN(11) p11_topk(F, (char*)lds_raw);
    if (!dry && FILLMODE != 0) conv_fill(F, a, 1 << 30);
  PH_END(11)
  PH_BEGIN(12)
#if MOE_FP8
    {
      const int gw = F.vcu * NWAVES + F.wave, NGW = F.G * NWAVES; const int* rs = (const int*)(ws + WS_ROWSEL);
      for (int r0 = gw; r0 < NEXP * 2048; r0 += 4 * NGW) {
        int tok[4]; float rn[4]; f32x4 q[4][4];
#pragma unroll
        for (int u = 0; u < 4; ++u) { const int r = r0 + u * NGW; tok[u] = r < NEXP * 2048 ? rs[r] : 0; }
#pragma unroll
        for (int u = 0; u < 4; ++u) { const float* xr = (const float*)(ws + WS_X2) + (size_t)tok[u] * 1024 + F.lane * 16; rn[u] = ss2[tok[u]];
#pragma unroll
          for (int j = 0; j < 4; ++j) q[u][j] = *(const f32x4*)(xr + 4 * j); }
#pragma unroll
        for (int u = 0; u < 4; ++u) { const int r = r0 + u * NGW; const float s = rsqrtf(rn[u] * (1.f / 1024.f) + 1e-6f);
          const f32x4 a0 = q[u][0] * s, a1 = q[u][1] * s, a2 = q[u][2] * s, a3 = q[u][3] * s;
          const float lo[8] = {a0.x, a0.y, a0.z, a0.w, a1.x, a1.y, a1.z, a1.w}, hi[8] = {a2.x, a2.y, a2.z, a2.w, a3.x, a3.y, a3.z, a3.w};
          const v2u a8 = pack8_fp8(lo, 1.f), b8 = pack8_fp8(hi, 1.f); v4u o; o.x = a8.x; o.y = a8.y; o.z = b8.x; o.w = b8.y;
          if (r < NEXP * 2048) *(v4u*)(ws + WS_XG + (size_t)r * 1024 + F.lane * 16) = o; } }
      GRID_BAR(); }
    pg8::Gemm g{(const bf16*)(ws + WS_XG), (const bf16*)(ws + WS_WEGU8), 512, 512, 512, nullptr, 127, 121}; MoeGUOrder S{F.G, (int)blockIdx.x};
    EpiGU8 E{(unsigned char*)(ws + WS_HID8), ss2, (const int*)(ws + WS_ROWSEL)};
    pg8::gemm_phase<EpiGU8, MoeGUOrder, false, 1>(F.lds, g, S, E);
#else
    pg8::Gemm g{(const bf16*)(ws + WS_X2B), (const bf16*)(ws + WS_WEGU), 1024, 1024, 1024, (const int*)(ws + WS_ROWSEL), 127, 127}; MoeGUOrder S{F.G, (int)blockIdx.x};
    EpiGU E{(bf16*)(ws + WS_HID), ss2, (const int*)(ws + WS_ROWSEL)};
    pg8::gemm_phase<EpiGU, MoeGUOrder, true>(F.lds, g, S, E);
#endif
  PH_END(12)
  PH_BEGIN(13)
#if MOE_FP8_DOWN
    pg8::Gemm g{(const bf16*)(ws + WS_HID8), (const bf16*)(ws + WS_WED8), 1024, 1024, 1024, nullptr, 124, 121}; MoeDownOrder S{F.G, (int)blockIdx.x};
    EpiYE E{(bf16*)(ws + WS_YE), (const float*)(ws + WS_GSEL)};
    pg8::gemm_phase<EpiYE, MoeDownOrder, false, 1>(F.lds, g, S, E);
#else
    pg8::Gemm g{(const bf16*)(ws + WS_HID), (const bf16*)(ws + WS_WED), 2048, 2048, 2048, nullptr, 127, 127}; MoeDownOrder S{F.G, (int)blockIdx.x};
    EpiYE E{(bf16*)(ws + WS_YE), (const float*)(ws + WS_GSEL)};
    pg8::gemm_phase<EpiYE, MoeDownOrder, false>(F.lds, g, S, E);
#endif
  PH_END(13)
  PH_BEGIN(14) p14_final(F, a); PH_END(14)
#undef IN
#undef BOTH
#undef GRID_BAR
}

__global__ __launch_bounds__(256) void adapt_b2f(const bf16* src, long lds_, long scol, float* dst, long ldd, long dcol, long rows, long ncols) {
  const long i = blockIdx.x * 256L + threadIdx.x; if (i >= rows * ncols) return;
  const long r = i / ncols, c = i % ncols; dst[r * ldd + dcol + c] = bf2f(src[r * lds_ + scol + c]);
}
static void adapt(hipStream_t s, const void* src, long lds_, long scol, float* dst, long ldd, long dcol, long rows, long ncols) {
  hipLaunchKernelGGL(adapt_b2f, dim3((unsigned)((rows * ncols + 255) / 256)), dim3(256), 0, s, (const bf16*)src, lds_, scol, dst, ldd, dcol, rows, ncols);
}

static int mk_grid() {
  static int grid = 0;
  if (grid == 0) {
    int dev = 0, cus = 0, per_cu = 0;
    (void)hipGetDevice(&dev); (void)hipDeviceGetAttribute(&cus, hipDeviceAttributeMultiprocessorCount, dev);
    (void)hipFuncSetAttribute((const void*)mk, hipFuncAttributeMaxDynamicSharedMemorySize, LDS_BYTES);
    (void)hipOccupancyMaxActiveBlocksPerMultiprocessor(&per_cu, (const void*)mk, NTHR, LDS_BYTES);
    (void)hipGetLastError();
    grid = cus > 0 ? cus : 256;
  }
  return grid;
}
static void mk_launch(hipStream_t s, void* const* d_in, void* d_out, void* d_ws, int lo, int hi, int flags) {
  Args a; memset(&a, 0, sizeof(a));
  for (int i = 0; i < 26; ++i) a.in[i] = d_in[i];
  a.out = (float*)d_out; a.ws = (unsigned char*)d_ws; a.ph_lo = lo; a.ph_hi = hi; a.flags = flags; a.pad = 0;
  (void)hipMemsetAsync((char*)d_ws + WS_CTL + CW_BAR * 4, 0, XCD_BAR_WORDS * 4, s);
  hipLaunchKernelGGL(mk, dim3(mk_grid()), dim3(NTHR), LDS_BYTES, s, a);
}

extern "C" void kernel_launch(void* const* d_in, const int* in_sizes, int n_in, void* d_out, int out_size, void* d_ws, size_t ws_size, hipStream_t s) {
  (void)hipMemsetAsync((char*)d_ws + WS_CTL, 0, CTL_ZERO_BYTES, s);
  mk_launch(s, d_in, d_out, d_ws, 0, 15, 1);
}
```

```cpp
#include <hip/hip_runtime.h>
#include <cstdint>
#include <cstdio>
#include <cstring>

constexpr int BATCH = 4, SEQ = 4096, DM = 1024, MTOK = BATCH * SEQ;
constexpr int D_IN = 2480;
constexpr int OFF_QM = 0, OFF_KM = 512, OFF_VM = 1024, OFF_OM = 1536, OFF_G = 2048, OFF_CQ = 2064, OFF_CKV = 2320, OFF_KR = 2448;
constexpr int NEXP = 16, CAP = 512, DFF = 2048, NMEM = 256;
constexpr size_t MiB = 1u << 20;
enum { I_X = 0, I_MEM, I_POS, I_GMIX, I_WIN, I_BG, I_CONV, I_GQA, I_WQB, I_GKVA, I_WKVB, I_GHM, I_GHA, I_WOUT, I_GMX, I_GMKV, I_WMQ, I_WMK, I_WMV, I_WMO, I_GFFN, I_WR, I_WEG, I_WEU, I_WED, I_GFIN };
#define GAS __attribute__((address_space(1)))
#define LAS __attribute__((address_space(3)))
typedef unsigned short bf16;
typedef unsigned v4u __attribute__((ext_vector_type(4)));
typedef unsigned v2u __attribute__((ext_vector_type(2)));
typedef float f32x4 __attribute__((ext_vector_type(4)));
typedef float f32x16 __attribute__((ext_vector_type(16)));
typedef short bf16x8 __attribute__((ext_vector_type(8)));
typedef short s16x4 __attribute__((ext_vector_type(4)));
typedef GAS unsigned gu32;
#define RLX_AGENT __ATOMIC_RELAXED, __HIP_MEMORY_SCOPE_AGENT
#define LDS_WAIT() asm volatile("s_waitcnt lgkmcnt(0)" ::: "memory")
#define VM_WAIT() asm volatile("s_waitcnt vmcnt(0)" ::: "memory")
constexpr int NWAVES = 8, NTHR = 512;
__device__ __forceinline__ unsigned f2bf(float f) { unsigned u = __builtin_bit_cast(unsigned, f); return (u + 0x7fffu + ((u >> 16) & 1u)) >> 16; }
__device__ __forceinline__ unsigned pk2(float lo, float hi) { return f2bf(lo) | (f2bf(hi) << 16); }
__device__ __forceinline__ float bf2f(unsigned short h) { return __builtin_bit_cast(float, (unsigned)h << 16); }
__device__ __forceinline__ float bflo(unsigned w) { return __builtin_bit_cast(float, w << 16); }
__device__ __forceinline__ float bfhi(unsigned w) { return __builtin_bit_cast(float, w & 0xffff0000u); }
typedef float f32x2_t __attribute__((ext_vector_type(2))); typedef __bf16 bf16x2_t __attribute__((ext_vector_type(2)));
__device__ __forceinline__ unsigned cvt_pk_bf16(float lo, float hi) { f32x2_t v = {lo, hi}; bf16x2_t b = __builtin_convertvector(v, bf16x2_t); return __builtin_bit_cast(unsigned, b); }
__device__ __forceinline__ v2u pack8_fp8(const float (&v)[8], float sc) { float c[8];
#pragma unroll
  for (int i = 0; i < 8; ++i) c[i] = __builtin_amdgcn_fmed3f(v[i] * sc, -448.f, 448.f);
  int a = 0, b = 0; a = __builtin_amdgcn_cvt_pk_fp8_f32(c[0], c[1], a, false); a = __builtin_amdgcn_cvt_pk_fp8_f32(c[2], c[3], a, true);
  b = __builtin_amdgcn_cvt_pk_fp8_f32(c[4], c[5], b, false); b = __builtin_amdgcn_cvt_pk_fp8_f32(c[6], c[7], b, true); v2u r; r.x = (unsigned)a; r.y = (unsigned)b; return r; }
__device__ __forceinline__ float q8(float x, float sc) { const int p = __builtin_amdgcn_cvt_pk_fp8_f32(x * sc, 0.f, 0, false); return __builtin_amdgcn_cvt_f32_fp8(p, 0) * (1.f / sc); }
__device__ __forceinline__ float wave_sum(float v) {
#pragma unroll
  for (int o = 1; o < 64; o <<= 1) v += __shfl_xor(v, o);
  return v;
}
__device__ __forceinline__ float sigmoidf_(float x) { return 1.f / (1.f + __expf(-x)); }

#define XB_TMO      128
#define XB_XCNT(j)  (256  + 64 * (j))
#define XB_XSUB(j)  (1280 + 64 * (j))
#define XB_XGEN(j)  (2304 + 64 * (j))
#define XB_TOP      3328
#define XB_TOPGEN   3392
#define XCD_BAR_WORDS 3456
#define XB_SPIN_CAP (1u << 22)
__device__ __forceinline__ unsigned xb_ld(unsigned* p)              { return __hip_atomic_load(p, __ATOMIC_RELAXED, __HIP_MEMORY_SCOPE_AGENT); }
__device__ __forceinline__ unsigned xb_add(unsigned* p, unsigned v) { return __hip_atomic_fetch_add(p, v, __ATOMIC_RELAXED, __HIP_MEMORY_SCOPE_AGENT); }
__device__ __forceinline__ unsigned xb_xcc_id() { return (unsigned)__builtin_amdgcn_s_getreg((3 << 11) | 20) & 0xFu; }
#define XB_SPIN(cond, bar) do { unsigned _sp = 0; while (cond) { __builtin_amdgcn_s_sleep(1); \
    if ((++_sp & 255u) == 0u) { if (xb_ld(&(bar)[XB_TMO])) break; if (_sp > XB_SPIN_CAP) { atomicAdd(&(bar)[XB_TMO], 1u); break; } } } } while (0)
struct XcdBarrier { unsigned* bar; unsigned x; volatile LAS unsigned* st; };
__device__ __forceinline__ XcdBarrier xcd_barrier_post(unsigned* bar, volatile LAS unsigned* st) {
  XcdBarrier b; b.bar = bar; b.x = xb_xcc_id(); b.st = st;
  if (threadIdx.x == 0) (void)xb_add(&bar[XB_XCNT(b.x)], 1u);
  return b;
}
__device__ __forceinline__ void xcd_barrier_complete(unsigned* bar, unsigned x, unsigned& nloc, unsigned& nx) {
  const unsigned G = gridDim.x * gridDim.y * gridDim.z;
  unsigned sum, cnt, mine, sp = 0u;
  for (;;) {
    sum = 0u; cnt = 0u; mine = 0u;
#pragma unroll
    for (unsigned j = 0; j < 16; ++j) { const unsigned c = xb_ld(&bar[XB_XCNT(j)]); sum += c; cnt += (c > 0u) ? 1u : 0u; mine = (j == x) ? c : mine; }
    if (sum == G) break;
    __builtin_amdgcn_s_sleep(1);
    if ((++sp & 255u) == 0u) { if (xb_ld(&bar[XB_TMO])) break; if (sp > XB_SPIN_CAP) { atomicAdd(&bar[XB_TMO], 1u); break; } }
  }
  nloc = mine > 0u ? mine : 1u; nx = cnt > 0u ? cnt : 1u;
}
__device__ __forceinline__ void xcd_barrier(const XcdBarrier& b) {
  asm volatile("s_waitcnt vmcnt(0)" ::: "memory");
  __syncthreads();
  if (threadIdx.x == 0) {
    unsigned* bar = b.bar;
    __builtin_amdgcn_s_waitcnt(0);
    unsigned nloc = b.st[0], nx = b.st[1];
    if (nloc == 0u) { xcd_barrier_complete(bar, b.x, nloc, nx); b.st[0] = nloc; b.st[1] = nx; }
    const unsigned old = xb_add(&bar[XB_XSUB(b.x)], 1u);
    const unsigned gen = old / nloc;
    if (old + 1u == (gen + 1u) * nloc) {
      __builtin_amdgcn_fence(__ATOMIC_RELEASE, "agent");
      asm volatile("s_waitcnt vmcnt(0)" ::: "memory");
      const unsigned og = xb_add(&bar[XB_TOP], 1u);
      const unsigned tg = og / nx;
      if (og + 1u == (tg + 1u) * nx) xb_add(&bar[XB_TOPGEN], 1u);
      else XB_SPIN(xb_ld(&bar[XB_TOPGEN]) == tg, bar);
      __builtin_amdgcn_fence(__ATOMIC_ACQUIRE, "agent");
      xb_add(&bar[XB_XGEN(b.x)], 1u);
      asm volatile("s_waitcnt vmcnt(0)" ::: "memory");
    } else {
      XB_SPIN(xb_ld(&bar[XB_XGEN(b.x)]) == gen, bar);
      __builtin_amdgcn_fence(__ATOMIC_ACQUIRE, "agent");
      asm volatile("s_waitcnt vmcnt(0)" ::: "memory");
    }
  }
  __syncthreads();
}

namespace pg8 {
constexpr int BM = 256, BK = 64, HALF = 128, HTB = HALF * BK * 2, STAGE_BYTES = 8 * HTB, NXCD = 8, WGM = 8;
__host__ __device__ __forceinline__ int lds_byte(int r, int c) { const int st = (r >> 4) * 2 + (c >> 5), rr = r & 15, cc = c & 31, ob = rr * 64 + cc * 2; return st * 1024 + (ob ^ (((ob >> 9) & 1) << 5)); }
__host__ __device__ __forceinline__ void stage_rc(int b, int& R, int& C) { const int st = b / 1024, sb = b % 1024, swz = sb ^ (((sb >> 9) & 1) << 5); R = (st >> 1) * 16 + swz / 64; C = (st & 1) * 32 + (swz % 64) / 2; }
__host__ __device__ __forceinline__ int perm32(int rho) { const int n = rho >> 4, i = rho & 15; return 8 * (i >> 2) + 4 * n + (i & 3); }

struct Unit { long aoff, boff; int pm, pn, g, ibase; };
struct Gemm { const bf16* A; const bf16* Bt; int lda, ldb, K; const int* gidx; int sa, sb; };
typedef int v8i_t __attribute__((ext_vector_type(8))); typedef int v4i_t __attribute__((ext_vector_type(4)));
__device__ __forceinline__ v8i_t cat8(bf16x8 lo, bf16x8 hi) { const v4i_t a = __builtin_bit_cast(v4i_t, lo), b = __builtin_bit_cast(v4i_t, hi); return __builtin_shufflevector(a, b, 0, 1, 2, 3, 4, 5, 6, 7); }

struct StaticOrder {
  int nM, nN, nwg, G, c, lda, ldb;
  __device__ void init(int M, int N, int G_, int c_, int lda_, int ldb_) { nM = M / BM; nN = N / BM; nwg = nM * nN; G = G_; c = c_; lda = lda_; ldb = ldb_; }
  __device__ bool next(int i, Unit& u) const {
    const long L = (long)i * G + c; if (L >= nwg) return false;
    int wgid = (int)L; { const int q = nwg / NXCD, r = nwg % NXCD, xcd = wgid % NXCD, off = wgid / NXCD; wgid = (xcd < r ? xcd * (q + 1) : r * (q + 1) + (xcd - r) * q) + off; }
    const int nig = WGM * nN, gid = wgid / nig, fm = gid * WGM, gsz = (nM - fm) < WGM ? (nM - fm) : WGM;
    u.pm = fm + ((wgid % nig) % gsz); u.pn = (wgid % nig) / gsz; u.g = 0; u.ibase = 0;
    u.aoff = (long)u.pm * BM * lda; u.boff = (long)u.pn * BM * ldb; return true;
  }
};

template <class Epi, class Sched, bool GATHER, int FP8 = 0>
__device__ __forceinline__ void gemm_phase(LAS unsigned char* lds, const Gemm g, const Sched& S, const Epi& E) {
  int tid = threadIdx.x; asm volatile("" : "+v"(tid));
  const int wid = __builtin_amdgcn_readfirstlane(tid >> 6), lane = tid & 63, wr = wid >> 2, wc = wid & 3, fr = lane & 15, fq = lane >> 4;
  const int K = g.K, nt = K / BK;
  int Rs[2], Cs[2]; unsigned voffB[2];
#pragma unroll
  for (int i = 0; i < 2; ++i) { int R, C; stage_rc(tid * 16 + i * 8192, R, C); Rs[i] = R; Cs[i] = C; const int Rb = (R & ~31) + perm32(R & 31); voffB[i] = (unsigned)(Rb * g.ldb + C) * 2u; }
  const size_t kstep = (size_t)(BK * 2);
  const size_t hstepB = (size_t)HALF * g.ldb * 2;
  const unsigned ldsw = (unsigned)wid * 1024u;
  const int aoff_l = lds_byte(wr * 64 + fr, FP8 ? fq * 16 : fq * 8), boff_l = lds_byte(wc * 32 + fr, FP8 ? fq * 16 : fq * 8);
  constexpr int aoff_k = FP8 ? 16 : 1024, boff_k = FP8 ? 16 : 1024;
#define PG8_SA(b, h) (((b) * 2 + (h)) * HTB)
#define PG8_SB(b, h) ((4 + (b) * 2 + (h)) * HTB)
#define PG8_STAGE(bufoff, gbase, voff) do { _Pragma("unroll") for (int _i = 0; _i < 2; ++_i) \
        __builtin_amdgcn_global_load_lds((const unsigned*)((const char*)(gbase) + (voff)[_i]), (LAS unsigned*)(lds + (bufoff) + ldsw + _i * 8192), 16, 0, 0); } while (0)
#define PG8_LDA(dst, b, h) do { _Pragma("unroll") for (int m = 0; m < 4; ++m) { if constexpr (FP8) { const v4i_t lo_ = *(const LAS v4i_t*)(lds + PG8_SA(b, h) + aoff_l + m * 2048), hi_ = *(const LAS v4i_t*)(lds + PG8_SA(b, h) + aoff_l + m * 2048 + aoff_k); dst##8[m] = __builtin_shufflevector(lo_, hi_, 0, 1, 2, 3, 4, 5, 6, 7); } \
        else { _Pragma("unroll") for (int k = 0; k < 2; ++k) dst[m][k] = *(const LAS bf16x8*)(lds + PG8_SA(b, h) + aoff_l + m * 2048 + k * aoff_k); } } } while (0)
#define PG8_LDB(dst, b, h) do { _Pragma("unroll") for (int n = 0; n < 2; ++n) { if constexpr (FP8) { const v4i_t lo_ = *(const LAS v4i_t*)(lds + PG8_SB(b, h) + boff_l + n * 2048), hi_ = *(const LAS v4i_t*)(lds + PG8_SB(b, h) + boff_l + n * 2048 + boff_k); dst##8[n] = __builtin_shufflevector(lo_, hi_, 0, 1, 2, 3, 4, 5, 6, 7); } \
        else { _Pragma("unroll") for (int k = 0; k < 2; ++k) dst[n][k] = *(const LAS bf16x8*)(lds + PG8_SB(b, h) + boff_l + n * 2048 + k * boff_k); } } } while (0)
#define PG8_MMA(ai, bj, At, Bt) do { __builtin_amdgcn_s_setprio(1); _Pragma("unroll") for (int m = 0; m < 4; ++m) _Pragma("unroll") for (int n = 0; n < 2; ++n) { \
        if constexpr (FP8) asm volatile("v_mfma_scale_f32_16x16x128_f8f6f4 %0, %1, %2, %0, %3, %4 op_sel_hi:[0,0,0]" : "+v"(acc[ai][bj][m][n]) : "v"(Bt##8[n]), "v"(At##8[m]), "v"(vsb), "v"(vsa)); \
        else { _Pragma("unroll") for (int k = 0; k < 2; ++k) acc[ai][bj][m][n] = __builtin_amdgcn_mfma_f32_16x16x32_bf16(Bt[n][k], At[m][k], acc[ai][bj][m][n], 0, 0, 0); } } \
        __builtin_amdgcn_s_setprio(0); } while (0)
#define PG8_WAIT_V(n) asm volatile("s_waitcnt vmcnt(" #n ")" ::: "memory")
#define PG8_WAIT_L(n) asm volatile("s_waitcnt lgkmcnt(" #n ")" ::: "memory")
#define PG8_BAR __builtin_amdgcn_s_barrier()
#define PG8_SCHED __builtin_amdgcn_sched_barrier(0)
  Unit cur, nxt; int ui = 0;
  if (!S.next(0, cur)) return;
  unsigned vA[2][2], nvA[2][2];
  auto load_va = [&](const Unit& u, unsigned (&v)[2][2]) {
#pragma unroll
    for (int h = 0; h < 2; ++h)
#pragma unroll
      for (int i = 0; i < 2; ++i) {
        if constexpr (GATHER) v[h][i] = (unsigned)((long)g.gidx[u.ibase + h * HALF + Rs[i]] * g.lda + Cs[i]) * 2u;
        else v[h][i] = (unsigned)((h * HALF + Rs[i]) * g.lda + Cs[i]) * 2u;
      }
  };
  load_va(cur, vA);
  f32x4 acc[2][2][4][2];
#pragma unroll
  for (int a = 0; a < 2; ++a)
#pragma unroll
    for (int b = 0; b < 2; ++b)
#pragma unroll
      for (int m = 0; m < 4; ++m)
#pragma unroll
        for (int n = 0; n < 2; ++n) acc[a][b][m][n] = (f32x4){0.f, 0.f, 0.f, 0.f};
  int vsa = g.sa, vsb = g.sb; (void)vsa; (void)vsb;
  bf16x8 At[4][2], B0[2][2], B1[2][2]; v8i_t At8[4], B08[2], B18[2];
  const char* cA = (const char*)g.A + (GATHER ? 0 : cur.aoff * 2); const char* cB = (const char*)g.Bt + cur.boff * 2;
  PG8_STAGE(PG8_SB(0, 0), cB, voffB); PG8_STAGE(PG8_SB(0, 1), cB + hstepB, voffB); PG8_STAGE(PG8_SA(0, 0), cA, vA[0]); PG8_STAGE(PG8_SA(0, 1), cA, vA[1]);
  if (wr == 1) PG8_BAR;
  PG8_WAIT_V(2); PG8_BAR;
  PG8_STAGE(PG8_SB(1, 0), cB + kstep, voffB); PG8_STAGE(PG8_SA(1, 0), cA + kstep, vA[0]); PG8_STAGE(PG8_SB(1, 1), cB + hstepB + kstep, voffB);
  PG8_WAIT_V(6); PG8_BAR;
  for (;;) {
    const bool has_next = S.next(ui + 1, nxt);
    const char* nA = has_next ? (const char*)g.A + (GATHER ? 0 : nxt.aoff * 2) : cA; const char* nB = has_next ? (const char*)g.Bt + nxt.boff * 2 : cB;
    if constexpr (GATHER) { if (has_next) load_va(nxt, nvA); else {
#pragma unroll
      for (int h = 0; h < 2; ++h)
#pragma unroll
        for (int i = 0; i < 2; ++i) nvA[h][i] = vA[h][i]; } }
#pragma unroll 1
    for (int t = 0; t < nt; t += 2) {
      const bool last = (t == nt - 2);
      const char* a1 = cA + (size_t)(t + 1) * kstep;
      const char* a2 = last ? nA : cA + (size_t)(t + 2) * kstep; const char* b2 = last ? nB : cB + (size_t)(t + 2) * kstep;
      const char* a3 = a2 + kstep; const char* b3 = b2 + kstep;
      unsigned w0[2], w1[2];
      if constexpr (GATHER) { w0[0] = last ? nvA[0][0] : vA[0][0]; w0[1] = last ? nvA[0][1] : vA[0][1]; w1[0] = last ? nvA[1][0] : vA[1][0]; w1[1] = last ? nvA[1][1] : vA[1][1]; }
      else { w0[0] = vA[0][0]; w0[1] = vA[0][1]; w1[0] = vA[1][0]; w1[1] = vA[1][1]; }
      PG8_LDB(B0, 0, 0); PG8_LDB(B1, 0, 1); PG8_SCHED; PG8_LDA(At, 0, 0); PG8_STAGE(PG8_SA(1, 1), a1, vA[1]);
      PG8_WAIT_V(8); PG8_WAIT_L(0); PG8_BAR; PG8_MMA(0, 0, At, B0); PG8_MMA(0, 1, At, B1); PG8_BAR; PG8_SCHED;
      PG8_LDA(At, 0, 1); PG8_STAGE(PG8_SB(0, 0), b2, voffB); PG8_STAGE(PG8_SB(0, 1), b2 + hstepB, voffB); PG8_STAGE(PG8_SA(0, 0), a2, w0);
      PG8_WAIT_V(8); PG8_WAIT_L(0); PG8_BAR; PG8_MMA(1, 0, At, B0); PG8_MMA(1, 1, At, B1); PG8_BAR; PG8_SCHED;
      PG8_LDB(B0, 1, 0); PG8_LDB(B1, 1, 1); PG8_SCHED; PG8_LDA(At, 1, 0); PG8_STAGE(PG8_SA(0, 1), a2, w1);
      PG8_WAIT_V(8); PG8_WAIT_L(0); PG8_BAR; PG8_MMA(0, 0, At, B0); PG8_MMA(0, 1, At, B1); PG8_BAR; PG8_SCHED;
      PG8_LDA(At, 1, 1); PG8_STAGE(PG8_SB(1, 0), b3, voffB); PG8_STAGE(PG8_SB(1, 1), b3 + hstepB, voffB); PG8_STAGE(PG8_SA(1, 0), a3, w0);
      PG8_WAIT_V(8); PG8_WAIT_L(0); PG8_BAR; PG8_MMA(1, 0, At, B0); PG8_MMA(1, 1, At, B1); PG8_BAR; PG8_SCHED;
    }
    if constexpr (FP8) { asm volatile("s_nop 15\n\ts_nop 15" ::: "memory"); __builtin_amdgcn_sched_barrier(0); }
    if (wr == 0) PG8_BAR;
    int fr_o = fr, fq_o = fq; asm volatile("" : "+v"(fr_o), "+v"(fq_o));
    if constexpr (Epi::TWO_PASS) {
#pragma unroll
      for (int ai = 0; ai < 2; ++ai)
#pragma unroll
        for (int m = 0; m < 4; ++m) {
          float v0[8], v1[8];
#pragma unroll
          for (int n = 0; n < 2; ++n)
#pragma unroll
            for (int j = 0; j < 4; ++j) { v0[n * 4 + j] = acc[ai][0][m][n][j]; v1[n * 4 + j] = acc[ai][1][m][n][j]; }
          E.pass1(cur, ai * HALF + wr * 64 + m * 16 + fr_o, wc, v0, v1, fq_o);
#pragma unroll
          for (int n = 0; n < 2; ++n)
#pragma unroll
            for (int j = 0; j < 4; ++j) { acc[ai][0][m][n][j] = v0[n * 4 + j]; acc[ai][1][m][n][j] = v1[n * 4 + j]; }
        }
      asm volatile("s_waitcnt lgkmcnt(0)" ::: "memory"); PG8_BAR; asm volatile("" ::: "memory");
    }
    {
#pragma unroll
      for (int ai = 0; ai < 2; ++ai)
#pragma unroll
        for (int m = 0; m < 4; ++m) {
          float v0[8], v1[8];
#pragma unroll
          for (int n = 0; n < 2; ++n)
#pragma unroll
            for (int j = 0; j < 4; ++j) { v0[n * 4 + j] = acc[ai][0][m][n][j]; v1[n * 4 + j] = acc[ai][1][m][n][j]; }
          E.row8(cur, ai * HALF + wr * 64 + m * 16 + fr_o, wc * 32 + 8 * fq_o, v0, v1, fq_o);
          asm volatile("" ::: "memory");
        }
    }
    if (!has_next) break;
#pragma unroll
    for (int a = 0; a < 2; ++a)
#pragma unroll
      for (int b = 0; b < 2; ++b)
#pragma unroll
        for (int m = 0; m < 4; ++m)
#pragma unroll
          for (int n = 0; n < 2; ++n) acc[a][b][m][n] = (f32x4){0.f, 0.f, 0.f, 0.f};
    cur = nxt; cA = nA; cB = nB; ++ui;
    if constexpr (GATHER) {
#pragma unroll
      for (int h = 0; h < 2; ++h)
#pragma unroll
        for (int i = 0; i < 2; ++i) vA[h][i] = nvA[h][i]; }
    if (wr == 1) PG8_BAR;
  }
  PG8_WAIT_V(0);
  PG8_BAR;
#undef PG8_SA
#undef PG8_SB
#undef PG8_STAGE
#undef PG8_LDA
#undef PG8_LDB
#undef PG8_MMA
#undef PG8_WAIT_V
#undef PG8_WAIT_L
#undef PG8_BAR
#undef PG8_SCHED
}
}
constexpr size_t WS_CTL = 0, CTL_ZERO_BYTES = 1 * MiB;
constexpr int CW_TMO = 0, CW_BAR = 4096, CW_Q = 8192;
constexpr size_t CTL_SSQ = 256 * 1024, CTL_SSKV = CTL_SSQ + 65536, CTL_SS1 = CTL_SSKV + 65536, CTL_SS2 = CTL_SS1 + 65536;
constexpr size_t WS_WIN = 1 * MiB, WS_WQB = 6 * MiB, WS_WKVB = 6 * MiB + 512 * 1024, WS_WOUT = 7 * MiB, WS_WMQ = 9 * MiB, WS_WMK = 11 * MiB, WS_WMV = 13 * MiB, WS_WMO = 15 * MiB;
constexpr size_t WS_ROPE = 17 * MiB, WS_MEMN = 19 * MiB, WS_KMEM = 21 * MiB, WS_VMEMT = 23 * MiB, WS_GSC = 25 * MiB, WS_DEC = 28 * MiB, WS_AFF = 29 * MiB, WS_SEL = 30 * MiB;
constexpr size_t WS_PROJ = 32 * MiB, WS_XN = 112 * MiB, WS_QC = 112 * MiB, WS_KC = 128 * MiB, WS_QM = 144 * MiB, WS_KM = 168 * MiB, WS_VM = 192 * MiB, WS_HF = 208 * MiB, WS_HB = 224 * MiB, WS_Y = 240 * MiB;
constexpr size_t WS_X1 = 112 * MiB, WS_X1B = 176 * MiB, WS_QMEM = 208 * MiB, WS_P = 240 * MiB, WS_MO = 112 * MiB, WS_X2 = 208 * MiB, WS_X2B = 208 * MiB, WS_HID = 32 * MiB;
constexpr size_t WS_DUMMY = 304 * MiB;
#ifndef X2MODE
#define X2MODE 2
#endif
constexpr size_t WS_X2F = 256 * MiB;
constexpr size_t WS_WEGU = 320 * MiB, WS_WED = 448 * MiB, WS_END = 512 * MiB;
constexpr int PROJ_LD = 2560;
constexpr int PC_CQ = 2048, PC_CKV = 2304, PC_KR = 2432, PC_G = 2464;
constexpr int RING_BYTES = 131072, LDSCTL_OFF = 133120, LDS_BYTES = 147456;

struct Args { const void* in[26]; float* out; unsigned char* ws; int ph_lo, ph_hi, flags, pad; };

struct Frame {
  LAS unsigned char* lds; volatile LAS unsigned* MISC; gu32* ctl; unsigned char* ws;
  int tid, lane, wave, vcu, G;
};

__device__ __forceinline__ void p0_tr(const float* W, int ldw, int k0, int kvalid, int scol0, int ncols, const float* gs, bf16* WT, int ldt, int drow0, LAS float* scr, int lane, bool doq = false) {
  const int c4 = (lane & 15) * 4, kr = lane >> 4;
  f32x4 v[16];
#pragma unroll
  for (int i = 0; i < 16; ++i) { const int kk = 4 * i + kr; v[i] = (f32x4){0.f, 0.f, 0.f, 0.f};
    if (c4 < ncols && k0 + kk < kvalid) { v[i] = *(const f32x4*)(W + (size_t)(k0 + kk) * ldw + scol0 + c4); if (gs) v[i] = v[i] * gs[k0 + kk];
      if (doq) { v[i].x = q8(v[i].x, 64.f); v[i].y = q8(v[i].y, 64.f); v[i].z = q8(v[i].z, 64.f); v[i].w = q8(v[i].w, 64.f); } } }
#pragma unroll
  for (int i = 0; i < 16; ++i) { const int kk = 4 * i + kr; LAS float* d = scr + kk * 65 + c4; d[0] = v[i].x; d[1] = v[i].y; d[2] = v[i].z; d[3] = v[i].w; }
  LDS_WAIT(); asm volatile("" ::: "memory");
  const int c = lane & 7;
#pragma unroll
  for (int j = 0; j < 8; ++j) { const int n = (lane >> 3) + 8 * j; const LAS float* s = scr + (8 * c) * 65 + n;
    v4u o; o.x = pk2(s[0 * 65], s[1 * 65]); o.y = pk2(s[2 * 65], s[3 * 65]); o.z = pk2(s[4 * 65], s[5 * 65]); o.w = pk2(s[6 * 65], s[7 * 65]);
    *(GAS v4u*)(WT + (size_t)(drow0 + n) * ldt + k0 + 8 * c) = o; }
  LDS_WAIT(); asm volatile("" ::: "memory");
}
struct ConvDesc { const float* W; const float* gs; unsigned char* WT8; int ldw, k0, scol0, ldt, drow0; };
__device__ __forceinline__ void p0_tr8_load(const ConvDesc& d, f32x4 (&v)[16], int lane) {
  const int c4 = (lane & 15) * 4, kr = lane >> 4;
#pragma unroll
  for (int i = 0; i < 16; ++i) { const int kk = 4 * i + kr; v[i] = *(const f32x4*)(d.W + (size_t)(d.k0 + kk) * d.ldw + d.scol0 + c4); }
}
__device__ __forceinline__ void p0_tr8_finish(const ConvDesc& d, f32x4 (&v)[16], float sc, LAS float* scr, int lane) {
  const int c4 = (lane & 15) * 4, kr = lane >> 4;
#pragma unroll
  for (int i = 0; i < 16; ++i) { const int kk = 4 * i + kr; f32x4 x = v[i]; if (d.gs) x = x * d.gs[d.k0 + kk]; LAS float* p = scr + kk * 65 + c4; p[0] = x.x; p[1] = x.y; p[2] = x.z; p[3] = x.w; }
  LDS_WAIT(); asm volatile("" ::: "memory");
  const int c = lane & 7;
#pragma unroll
  for (int j = 0; j < 8; ++j) { const int n = (lane >> 3) + 8 * j; const LAS float* s = scr + (8 * c) * 65 + n;
    float f[8];
#pragma unroll
    for (int q = 0; q < 8; ++q) f[q] = s[q * 65];
    *(GAS v2u*)(d.WT8 + (size_t)(d.drow0 + n) * d.ldt + d.k0 + 8 * c) = pack8_fp8(f, sc); }
  LDS_WAIT(); asm volatile("" ::: "memory");
}
__device__ __forceinline__ void p0_tr32(const float* W, int ldw, int k0, int scol0, int ncols, const float* gs, bf16* WT, int ldt, int drow0, LAS float* scr, int lane) {
#pragma unroll 8
  for (int i = 0; i < 32; ++i) { const int kk = 2 * i + (lane >> 5), c = lane & 31; float v = 0.f;
    if (c < ncols) { v = W[(size_t)(k0 + kk) * ldw + scol0 + c]; if (gs) v *= gs[k0 + kk]; }
    scr[kk * 65 + c] = v; }
  LDS_WAIT(); asm volatile("" ::: "memory");
  const int c = lane & 7;
#pragma unroll
  for (int j = 0; j < 4; ++j) { const int n = (lane >> 3) + 8 * j; const LAS float* s = scr + (8 * c) * 65 + n;
    v4u o; o.x = pk2(s[0 * 65], s[1 * 65]); o.y = pk2(s[2 * 65], s[3 * 65]); o.z = pk2(s[4 * 65], s[5 * 65]); o.w = pk2(s[6 * 65], s[7 * 65]);
    *(GAS v4u*)(WT + (size_t)(drow0 + n) * ldt + k0 + 8 * c) = o; }
  LDS_WAIT(); asm volatile("" ::: "memory");
}
__device__ __forceinline__ void rms_row_to_bf16(const float* xrow, bf16* orow, int lane) {
  const GAS f32x4* xr = (const GAS f32x4*)xrow + lane;
  f32x4 v[4]; float s = 0.f;
#pragma unroll
  for (int j = 0; j < 4; ++j) { v[j] = xr[64 * j]; s += (v[j].x * v[j].x + v[j].y * v[j].y) + (v[j].z * v[j].z + v[j].w * v[j].w); }
  const float rstd = rsqrtf(wave_sum(s) * (1.f / 1024.f) + 1e-6f);
  GAS unsigned long long* o8 = (GAS unsigned long long*)orow + lane;
#pragma unroll
  for (int j = 0; j < 4; ++j) o8[64 * j] = (unsigned long long)pk2(v[j].x * rstd, v[j].y * rstd) | ((unsigned long long)pk2(v[j].z * rstd, v[j].w * rstd) << 32);
}

#ifndef FP8EMU
#define FP8EMU 0
#endif
#ifndef MOE_FP8
#define MOE_FP8 1
#endif
#ifndef CONV_NT
#define CONV_NT 0
#endif
#ifndef MOE_FP8_DOWN
#define MOE_FP8_DOWN MOE_FP8
#endif
constexpr size_t WS_PO = 384 * MiB, WS_PML = 272 * MiB;
constexpr size_t WS_XG = 96 * MiB;
constexpr size_t WS_X2Q = 208 * MiB, WS_WEGU8 = 320 * MiB, WS_WED8 = 448 * MiB, WS_HID8 = 32 * MiB;
constexpr int CW_RDY = 8192 + 64 * 44;
constexpr int CW_CONV = 8192 + 64 * 40, CW_MDONE = 8192 + 64 * 41, CW_TDONE = 8192 + 64 * 42;
constexpr int CONV_IGU = 16 * 64, CONV_ID = 32 * 16, CONV_ITEMS = NEXP * (CONV_IGU + CONV_ID), CONV_CHUNKS = CONV_ITEMS / 8;
__device__ __forceinline__ ConvDesc conv_desc(Frame& F, const Args& a, int it) {
  auto I = [&](int i) { return (const float*)a.in[i]; };
  unsigned char* ws = F.ws; ConvDesc d;
  const int e = it / (CONV_IGU + CONV_ID); int r = it % (CONV_IGU + CONV_ID);
  if (r < CONV_IGU) { const int kb = r / 64, nb = r % 64, p = nb >> 2, j0 = (nb & 3) * 64; const bool up = j0 >= 128;
    d.W = (up ? I(I_WEU) : I(I_WEG)) + (size_t)e * 1024 * 2048; d.ldw = 2048; d.k0 = 64 * kb; d.scol0 = 128 * p + (up ? j0 - 128 : j0); d.gs = I(I_GFFN); d.WT8 = ws + WS_WEGU8 + (size_t)e * 4096 * 1024; d.ldt = 1024; d.drow0 = 64 * nb; }
  else { r -= CONV_IGU; const int kb = r / 16, nb = r % 16;
    d.W = I(I_WED) + (size_t)e * 2048 * 1024; d.ldw = 1024; d.k0 = 64 * kb; d.scol0 = 64 * nb; d.gs = nullptr; d.WT8 = ws + WS_WED8 + (size_t)e * 1024 * 2048; d.ldt = 2048; d.drow0 = 64 * nb; }
  return d;
}
__device__ __forceinline__ void conv_fill(Frame& F, const Args& a, int maxpairs) {
  static_assert(MOE_FP8 && MOE_FP8_DOWN, "the conversion filler writes fp8 expert weights");
  volatile LAS int* slot = (volatile LAS int*)(F.lds + LDSCTL_OFF + 16);
  LAS float* scr = (LAS float*)(F.lds + F.wave * 16640);
  for (int n = 0; n < maxpairs; ++n) {
    if (F.tid == 0) { int got = -1;
      if (__hip_atomic_load(F.ctl + CW_CONV, RLX_AGENT) < (unsigned)CONV_CHUNKS) { const unsigned c = __hip_atomic_fetch_add(F.ctl + CW_CONV, 2u, RLX_AGENT); if (c < (unsigned)CONV_CHUNKS) got = (int)c; }
      *slot = got; }
    __syncthreads();
    const int c = __builtin_amdgcn_readfirstlane(*slot);
    __syncthreads();
    if (c < 0) break;
    const ConvDesc d0 = conv_desc(F, a, c * 8 + F.wave), d1 = conv_desc(F, a, (c + 1) * 8 + F.wave);
    f32x4 v0[16], v1[16];
    p0_tr8_load(d0, v0, F.lane); p0_tr8_load(d1, v1, F.lane);
    p0_tr8_finish(d0, v0, 64.f, scr, F.lane); p0_tr8_finish(d1, v1, 64.f, scr, F.lane);
  }
}
__device__ __forceinline__ void p0_prologue(Frame& F, const Args& a, bool do_dense, bool do_experts) {
  LAS float* scr = (LAS float*)(F.lds + F.wave * 16640);
  const int gw = F.vcu * NWAVES + F.wave, NGW = F.G * NWAVES;
  auto I = [&](int i) { return (const float*)a.in[i]; };
  unsigned char* ws = F.ws;
  if (do_dense) {
    constexpr int I_WIN_ = 16 * 40, I_WQB_ = 4 * 12, I_WKVB_ = 4 * 16, I_SQ = 16 * 16;
    constexpr int NIT = I_WIN_ + I_WQB_ + I_WKVB_ + 5 * I_SQ;
    for (int it = gw; it < NIT; it += NGW) {
      int r = it;
      if (r < I_WIN_) { const int kb = r / 40, nb = r % 40; int sc, nc = 64;
        if (nb < 32) sc = 64 * nb; else if (nb < 36) sc = OFF_CQ + 64 * (nb - 32); else if (nb < 38) sc = OFF_CKV + 64 * (nb - 36); else if (nb == 38) { sc = OFF_KR; nc = 32; } else { sc = 0; nc = 0; }
        p0_tr(I(I_WIN), D_IN, 64 * kb, 1024, sc, nc, I(I_GMIX), (bf16*)(ws + WS_WIN), 1024, 64 * nb, scr, F.lane);
        if (nb == 38) p0_tr32(I(I_WIN), D_IN, 64 * kb, OFF_G, 16, I(I_GMIX), (bf16*)(ws + WS_WIN), 1024, PC_G, scr, F.lane);
        continue; } r -= I_WIN_;
      if (r < I_WQB_) { const int kb = r / 12, nb = r % 12; p0_tr(I(I_WQB), 768, 64 * kb, 256, 64 * nb, 64, I(I_GQA), (bf16*)(ws + WS_WQB), 256, 64 * nb, scr, F.lane); continue; } r -= I_WQB_;
      if (r < I_WKVB_) { const int kb = r / 16, nb = r % 16; const int h = nb & 7; const int sc = h * 128 + (nb >= 8 ? 64 : 0);
        p0_tr(I(I_WKVB), 1024, 64 * kb, 128, sc, 64, I(I_GKVA), (bf16*)(ws + WS_WKVB), 256, 64 * nb, scr, F.lane); continue; } r -= I_WKVB_;
      const int which = r / I_SQ; r %= I_SQ; const int kb = r / 16, nb = r % 16;
      const float* src = which == 0 ? I(I_WOUT) : which == 1 ? I(I_WMQ) : which == 2 ? I(I_WMK) : which == 3 ? I(I_WMV) : I(I_WMO);
      const float* gs = which == 1 ? I(I_GMX) : (which == 2 || which == 3) ? I(I_GMKV) : nullptr;
      bf16* dst = (bf16*)(ws + (which == 0 ? WS_WOUT : which == 1 ? WS_WMQ : which == 2 ? WS_WMK : which == 3 ? WS_WMV : WS_WMO));
      p0_tr(src, 1024, 64 * kb, 1024, 64 * nb, 64, gs, dst, 1024, 64 * nb, scr, F.lane);
    }
    for (int m = gw; m < MTOK; m += NGW) rms_row_to_bf16(I(I_X) + (size_t)m * 1024, (bf16*)(ws + WS_XN) + (size_t)m * 1024, F.lane);
    for (int m = gw; m < BATCH * NMEM; m += NGW) rms_row_to_bf16(I(I_MEM) + (size_t)m * 1024, (bf16*)(ws + WS_MEMN) + (size_t)m * 1024, F.lane);
    { const float* wr = I(I_WR); const float* gf = I(I_GFFN); float* wrg = (float*)(ws + WS_DEC + 65536);
      for (int i = (F.vcu * NTHR + F.tid); i < 1024 * 16; i += F.G * NTHR) wrg[i] = wr[i] * gf[i >> 4]; }
    { const int* pos = (const int*)a.in[I_POS]; float* rt = (float*)(ws + WS_ROPE);
      for (int i = (F.vcu * NTHR + F.tid); i < MTOK * 16; i += F.G * NTHR) { const int m = i >> 4, j = i & 15; const float inv = powf(10000.f, -(float)j / 16.f); const float ang = (float)pos[m] * inv;
        rt[m * 32 + j] = cosf(ang); rt[m * 32 + 16 + j] = sinf(ang); } }
  }
  if (do_experts) conv_fill(F, a, 1 << 30);
}

__device__ __forceinline__ v4u pack8(const float (&v)[8]) { v4u w; w.x = cvt_pk_bf16(v[0], v[1]); w.y = cvt_pk_bf16(v[2], v[3]); w.z = cvt_pk_bf16(v[4], v[5]); w.w = cvt_pk_bf16(v[6], v[7]); return w; }
__device__ __forceinline__ float sumsq8(const float (&v)[8]) { float s = 0.f;
#pragma unroll
  for (int i = 0; i < 8; ++i) s += v[i] * v[i];
  return s; }
struct EpiStore { static constexpr bool TWO_PASS = false; bf16* O; int ldc;
  __device__ __forceinline__ void row8(const pg8::Unit& u, int rloc, int cloc, const float (&v0)[8], const float (&v1)[8], int fq) const {
    bf16* p = O + (size_t)(u.pm * 256 + rloc) * ldc + u.pn * 256 + cloc; *(v4u*)p = pack8(v0); *(v4u*)(p + 128) = pack8(v1); } };
struct EpiProj { static constexpr bool TWO_PASS = false; bf16* P; float* ssq; float* sskv;
  __device__ __forceinline__ void row8(const pg8::Unit& u, int rloc, int cloc, const float (&v0)[8], const float (&v1)[8], int fq) const {
    const int row = u.pm * 256 + rloc; bf16* p = P + (size_t)row * PROJ_LD + u.pn * 256 + cloc; *(v4u*)p = pack8(v0); *(v4u*)(p + 128) = pack8(v1);
    if (u.pn == 8) { float s = sumsq8(v0) + sumsq8(v1); s += __shfl_xor(s, 16); s += __shfl_xor(s, 32); if (fq == 0) unsafeAtomicAdd(ssq + row, s); }
    if (u.pn == 9) { float s = sumsq8(v0); s += __shfl_xor(s, 16); s += __shfl_xor(s, 32); if (fq == 0) unsafeAtomicAdd(sskv + row, s); } } };
struct EpiQ { static constexpr bool TWO_PASS = false; bf16* Q; const float* ssq; const float* rope;
  __device__ __forceinline__ void rope8(float (&v)[8], int row, int fq) const {
    float pv[8];
#pragma unroll
    for (int i = 0; i < 8; ++i) pv[i] = __shfl_xor(v[i], 32);
    const float* cs = rope + (size_t)row * 32 + 8 * (fq & 1);
#pragma unroll
    for (int i = 0; i < 8; ++i) { const float c = cs[i], s = cs[16 + i]; v[i] = (fq < 2) ? (v[i] * c - pv[i] * s) : (v[i] * c + pv[i] * s); }
  }
  __device__ __forceinline__ void row8(const pg8::Unit& u, int rloc, int cloc, const float (&a0)[8], const float (&a1)[8], int fq) const {
    const int row = u.pm * 256 + rloc; const float r = rsqrtf(ssq[row] * (1.f / 256.f) + 1e-6f);
    float v0[8], v1[8];
#pragma unroll
    for (int i = 0; i < 8; ++i) { v0[i] = a0[i] * r; v1[i] = a1[i] * r; }
    const int g0 = u.pn * 8 + (cloc >> 5), g1 = g0 + 4;
    if (g0 % 3 == 2) rope8(v0, row, fq);
    if (g1 % 3 == 2) rope8(v1, row, fq);
    bf16* p = Q + (size_t)row * 768 + u.pn * 256 + cloc; *(v4u*)p = pack8(v0); *(v4u*)(p + 128) = pack8(v1); } };
struct EpiKV { static constexpr bool TWO_PASS = false; bf16* KMp; bf16* VMp; const float* sskv;
  __device__ __forceinline__ void put(int row, int c, const float (&v)[8], float r) const {
    float w[8];
#pragma unroll
    for (int i = 0; i < 8; ++i) w[i] = v[i] * r;
    if (c < 512) *(v4u*)(KMp + (size_t)row * 768 + (c >> 6) * 96 + (c & 63)) = pack8(w); else *(v4u*)(VMp + (size_t)row * 512 + (c - 512)) = pack8(w); }
  __device__ __forceinline__ void row8(const pg8::Unit& u, int rloc, int cloc, const float (&a0)[8], const float (&a1)[8], int fq) const {
    const int row = u.pm * 256 + rloc; const float r = rsqrtf(sskv[row] * (1.f / 128.f) + 1e-6f);
    put(row, u.pn * 256 + cloc, a0, r); put(row, u.pn * 256 + 128 + cloc, a1, r); } };

__device__ __forceinline__ void unpack8(v4u w, float (&f)[8]) { f[0] = bflo(w.x); f[1] = bfhi(w.x); f[2] = bflo(w.y); f[3] = bfhi(w.y); f[4] = bflo(w.z); f[5] = bfhi(w.z); f[6] = bflo(w.w); f[7] = bfhi(w.w); }
__device__ __forceinline__ float log_sigmoid(float x) { return fminf(x, 0.f) - log1pf(__expf(-fabsf(x))); }

__device__ __forceinline__ void p2_elementwise(Frame& F, const Args& a) {
  unsigned char* ws = F.ws;
  const bf16* P = (const bf16*)(ws + WS_PROJ);
  { const float* cw = (const float*)a.in[I_CONV]; bf16* QC = (bf16*)(ws + WS_QC); bf16* KC = (bf16*)(ws + WS_KC);
    for (int i = F.vcu * NTHR + F.tid; i < MTOK * 128; i += F.G * NTHR) { const int m = i >> 7, c = (i & 127) * 8, t = m & (SEQ - 1);
      float x1[8], x0[8], x2[8]; unpack8(*(const v4u*)(P + (size_t)m * PROJ_LD + c), x1);
      if (t > 0) unpack8(*(const v4u*)(P + (size_t)(m - 1) * PROJ_LD + c), x0); else {
#pragma unroll
        for (int j = 0; j < 8; ++j) x0[j] = 0.f; }
      if (t < SEQ - 1) unpack8(*(const v4u*)(P + (size_t)(m + 1) * PROJ_LD + c), x2); else {
#pragma unroll
        for (int j = 0; j < 8; ++j) x2[j] = 0.f; }
      float o[8];
#pragma unroll
      for (int j = 0; j < 8; ++j) { float v = x0[j] * cw[c + j] + x1[j] * cw[1024 + c + j] + x2[j] * cw[2048 + c + j]; v = v * sigmoidf_(v); o[j] = (c < 512) ? v : v * 0.08838834764831845f; }
      if (c < 512) *(v4u*)(QC + (size_t)m * 512 + c) = pack8(o); else *(v4u*)(KC + (size_t)m * 512 + c - 512) = pack8(o); } }
  { const float* rope = (const float*)(ws + WS_ROPE); bf16* KMp = (bf16*)(ws + WS_KM);
    for (int i = F.vcu * NTHR + F.tid; i < MTOK * 16; i += F.G * NTHR) { const int m = i >> 4, j = i & 15;
      const float t1 = bf2f(P[(size_t)m * PROJ_LD + PC_KR + j]), t2 = bf2f(P[(size_t)m * PROJ_LD + PC_KR + 16 + j]); const float c = rope[m * 32 + j], s = rope[m * 32 + 16 + j];
      const bf16 o1 = (bf16)f2bf(t1 * c - t2 * s), o2 = (bf16)f2bf(t2 * c + t1 * s);
#pragma unroll
      for (int h = 0; h < 8; ++h) { KMp[(size_t)m * 768 + h * 96 + 64 + j] = o1; KMp[(size_t)m * 768 + h * 96 + 80 + j] = o2; } } }
  { const float* bg = (const float*)a.in[I_BG]; float* GSC = (float*)(ws + WS_GSC); float* DEC = (float*)(ws + WS_DEC);
    const int gw = F.vcu * NWAVES + F.wave, NGW = F.G * NWAVES;
    for (int it = gw; it < 32 * 64; it += NGW) { const int seq = it >> 6, c = it & 63, dir = seq & 1, h = (seq >> 1) & 3, b = seq >> 3;
      const int p = c * 64 + F.lane, t = dir ? (SEQ - 1 - p) : p; const size_t row = (size_t)b * SEQ + t;
      const int gi = (dir ? 8 : 0) + h, gf = (dir ? 12 : 4) + h;
      const float li = bf2f(P[row * PROJ_LD + PC_G + gi]) + bg[gi]; const float lf = log_sigmoid(bf2f(P[row * PROJ_LD + PC_G + gf]) + bg[gf]);
      float bs = lf;
#pragma unroll
      for (int o = 1; o < 64; o <<= 1) { const float y = __shfl_up(bs, o); if (F.lane >= o) bs += y; }
      const float av = li - bs; float pm = av;
#pragma unroll
      for (int o = 1; o < 64; o <<= 1) { const float y = __shfl_up(pm, o); if (F.lane >= o) pm = fmaxf(pm, y); }
      float* gs = GSC + (size_t)seq * 3 * SEQ; gs[p] = bs; gs[SEQ + p] = av; gs[2 * SEQ + p] = pm;
      if (F.lane == 63) { DEC[seq * 128 + c] = bs; DEC[seq * 128 + 64 + c] = pm; } } }
}
namespace mla {
constexpr int DQK = 96, DV = 64, NW = 8, QBLK = 32, KVBLK = 64, LDQ = 768, LDK = 768, LDV = 512, LDO = 1024;
constexpr float SCALE = 0.10206207261596575f;
constexpr float THR = 8.f;
constexpr int SHM_V = 16384, SHM_K = 16384, SHM_ATTN = 2 * SHM_V + 2 * SHM_K + NW * 64 * 4;
#define KSWZ(row, colB) ((row) * 256 + ((colB) ^ (((row) & 7) << 4)))
#define SBAR() __builtin_amdgcn_sched_barrier(0)
__device__ __forceinline__ int crow(int r, int hi) { return (r & 3) + 8 * (r >> 2) + 4 * hi; }
__device__ __forceinline__ void partialSM(f32x16& p0, f32x16& p1, float& m_reg, float& mn, float& alpha) {
  constexpr float C = SCALE * 1.4426950408889634f;
  float pmax = p0[0];
#pragma unroll
  for (int r = 1; r < 16; ++r) pmax = fmaxf(pmax, p0[r]);
#pragma unroll
  for (int r = 0; r < 16; ++r) pmax = fmaxf(pmax, p1[r]);
  { auto rr = __builtin_amdgcn_permlane32_swap(__float_as_uint(pmax), __float_as_uint(pmax), false, false);
    pmax = fmaxf(__uint_as_float(rr[0]), __uint_as_float(rr[1])); }
  if (__builtin_expect(__all(pmax - m_reg <= THR / SCALE), 1)) { mn = m_reg; alpha = 1.f; }
  else { mn = fmaxf(m_reg, pmax); alpha = __builtin_amdgcn_exp2f((m_reg - mn) * C); m_reg = mn; }
  const float mnC = -mn * C;
#pragma unroll
  for (int r = 0; r < 16; ++r) p0[r] = fmaf(p0[r], C, mnC);
#pragma unroll
  for (int r = 0; r < 16; ++r) p1[r] = fmaf(p1[r], C, mnC);
#pragma unroll
  for (int r = 0; r < 16; ++r) p0[r] = __builtin_amdgcn_exp2f(p0[r]);
}
__device__ __forceinline__ void finishSM(f32x16& p0, f32x16& p1, float alpha, float& l_reg, bf16x8& pa0, bf16x8& pa1, bf16x8& pa2, bf16x8& pa3) {
#pragma unroll
  for (int r = 0; r < 16; ++r) p1[r] = __builtin_amdgcn_exp2f(p1[r]);
  float ps = 0;
#pragma unroll
  for (int r = 0; r < 16; ++r) ps += p0[r];
#pragma unroll
  for (int r = 0; r < 16; ++r) ps += p1[r];
  { auto rr = __builtin_amdgcn_permlane32_swap(__float_as_uint(ps), __float_as_uint(ps), false, false);
    ps = __uint_as_float(rr[0]) + __uint_as_float(rr[1]); }
  l_reg = l_reg * alpha + ps;
#define PK4(P, BASE, OUT) do { unsigned a0 = cvt_pk_bf16(P[BASE + 0], P[BASE + 1]), a1 = cvt_pk_bf16(P[BASE + 2], P[BASE + 3]);   \
    unsigned b0 = cvt_pk_bf16(P[BASE + 4], P[BASE + 5]), b1 = cvt_pk_bf16(P[BASE + 6], P[BASE + 7]);                              \
    auto r0 = __builtin_amdgcn_permlane32_swap(a0, b0, false, false); auto r1 = __builtin_amdgcn_permlane32_swap(a1, b1, false, false); \
    v4u w = {r0[0], r1[0], r0[1], r1[1]}; OUT = __builtin_bit_cast(bf16x8, w); } while (0)
  PK4(p0, 0, pa0); PK4(p0, 8, pa1); PK4(p1, 0, pa2); PK4(p1, 8, pa3);
#undef PK4
}
__device__ __forceinline__ void qkt(f32x16& p0, f32x16& p1, const char* Ks, const bf16x8* qr, int r32, int hi) {
  p0 = f32x16{}; p1 = f32x16{};
#pragma unroll
  for (int d0 = 0; d0 < DQK / 16; ++d0) { const int cb = (d0 * 16 + hi * 8) * 2;
    const bf16x8 b0 = *reinterpret_cast<const bf16x8*>(Ks + KSWZ(r32, cb));
    const bf16x8 b1 = *reinterpret_cast<const bf16x8*>(Ks + KSWZ(32 + r32, cb));
    p0 = __builtin_amdgcn_mfma_f32_32x32x16_bf16(b0, qr[d0], p0, 0, 0, 0);
    p1 = __builtin_amdgcn_mfma_f32_32x32x16_bf16(b1, qr[d0], p1, 0, 0, 0); }
}
__device__ __forceinline__ int v_st(int k, int c) { const int kk = (k & ~0xC) | ((k & 4) << 1) | ((k & 8) >> 1); return ((kk >> 3) * 4 + (c >> 5)) * 512 + ((kk & 7) * 32 + (c & 31)) * 2; }
__device__ __forceinline__ int v_rd_base(int lane) { return ((lane & 3) << 3) | (((lane >> 2) & 3) << 6) | (((lane >> 4) & 1) << 5) | (((lane >> 5) & 1) << 8); }
constexpr int v_rd_off(int d0, int ks, int half) { return d0 * 512 + ks * 4096 + half * 2048; }
template <int OFF> __device__ __forceinline__ s16x4 tr_read(int vb) {
  s16x4 r; asm volatile("ds_read_b64_tr_b16 %0, %1 offset:%2" : "=&v"(r) : "v"(vb), "i"(OFF) : "memory"); return r;
}
template <int D0> __device__ __forceinline__ void pv_one(f32x16& od, int vb, bf16x8 pa0, bf16x8 pa1, bf16x8 pa2, bf16x8 pa3) {
  const s16x4 l0 = tr_read<v_rd_off(D0, 0, 0)>(vb), h0 = tr_read<v_rd_off(D0, 0, 1)>(vb), l1 = tr_read<v_rd_off(D0, 1, 0)>(vb), h1 = tr_read<v_rd_off(D0, 1, 1)>(vb);
  const s16x4 l2 = tr_read<v_rd_off(D0, 2, 0)>(vb), h2 = tr_read<v_rd_off(D0, 2, 1)>(vb), l3 = tr_read<v_rd_off(D0, 3, 0)>(vb), h3 = tr_read<v_rd_off(D0, 3, 1)>(vb);
  asm volatile("s_waitcnt lgkmcnt(0)" ::: "memory"); SBAR();
#define PK(L, H) (bf16x8){L[0], L[1], L[2], L[3], H[0], H[1], H[2], H[3]}
  od = __builtin_amdgcn_mfma_f32_32x32x16_bf16(pa0, PK(l0, h0), od, 0, 0, 0);
  od = __builtin_amdgcn_mfma_f32_32x32x16_bf16(pa1, PK(l1, h1), od, 0, 0, 0);
  od = __builtin_amdgcn_mfma_f32_32x32x16_bf16(pa2, PK(l2, h2), od, 0, 0, 0);
  od = __builtin_amdgcn_mfma_f32_32x32x16_bf16(pa3, PK(l3, h3), od, 0, 0, 0);
#undef PK
}
__device__ __forceinline__ void pv_d0(f32x16* o, int vb, bf16x8 pa0, bf16x8 pa1, bf16x8 pa2, bf16x8 pa3) {
  pv_one<0>(o[0], vb, pa0, pa1, pa2, pa3); pv_one<1>(o[1], vb, pa0, pa1, pa2, pa3);
}
constexpr int LDP = 8 * 64, LDML = 8 * 2;
__device__ __forceinline__ void attn_unit(const bf16* __restrict__ Qb, const bf16* __restrict__ Kh, const bf16* __restrict__ Vh, bf16* __restrict__ Op, float* __restrict__ MLp, int seq, char* lds) {
  int tid = threadIdx.x; asm volatile("" : "+v"(tid));
  const int wid = tid >> 6, lane = tid & 63, r32 = lane & 31, hi = lane >> 5;
  char* V_lds = lds; char* K_lds = lds + 2 * SHM_V;
  float* wsf = (float*)(lds + 2 * SHM_V + 2 * SHM_K) + wid * 64; float* li_l = wsf; float* al_l = wsf + 32;
  float m_reg = -1e30f, l_reg = 0; f32x16 o[2] = {}; bf16x8 qr[DQK / 16];
  const bf16* Qw = Qb + (long)(wid * QBLK + r32) * LDQ + hi * 8;
#pragma unroll
  for (int d0 = 0; d0 < DQK / 16; ++d0) qr[d0] = *reinterpret_cast<const bf16x8*>(Qw + d0 * 16);
  const int sr = tid >> 4, sc = (tid & 15) * 8, vst0 = v_st(sr, sc & 63), vst1 = v_st(32 + sr, sc & 63);
  const bool doK = sc < DQK, doV = sc < DV;
  const int vb0 = (int)(uintptr_t)V_lds + v_rd_base(lane);
  struct { bf16x8 vs0, vs1, ks0, ks1; } sr_[2];
#define SLOAD(i, k0) do { if (doV) { sr_[i].vs0 = *reinterpret_cast<const bf16x8*>(&Vh[(long)((k0) + sr) * LDV + sc]); sr_[i].vs1 = *reinterpret_cast<const bf16x8*>(&Vh[(long)((k0) + 32 + sr) * LDV + sc]); } \
    if (doK) { sr_[i].ks0 = *reinterpret_cast<const bf16x8*>(&Kh[(long)((k0) + sr) * LDK + sc]); sr_[i].ks1 = *reinterpret_cast<const bf16x8*>(&Kh[(long)((k0) + 32 + sr) * LDK + sc]); } } while (0)
#define SWRITE(b, i) do { if (doV) { *(bf16x8*)(V_lds + (b) * SHM_V + vst0) = sr_[i].vs0; *(bf16x8*)(V_lds + (b) * SHM_V + vst1) = sr_[i].vs1; } \
    if (doK) { const int kc = sc * 2; *(bf16x8*)(K_lds + (b) * SHM_K + KSWZ(sr, kc)) = sr_[i].ks0; *(bf16x8*)(K_lds + (b) * SHM_K + KSWZ(32 + sr, kc)) = sr_[i].ks1; } } while (0)
#define SWAIT() asm volatile("s_waitcnt vmcnt(4)" ::: "memory")
#define RESC(a) do { if (__any((a) < 1.f)) { if (hi == 0) al_l[r32] = (a); asm volatile("s_waitcnt lgkmcnt(0)" ::: "memory"); \
    _Pragma("unroll") for (int d = 0; d < 2; ++d) _Pragma("unroll") for (int r = 0; r < 16; ++r) o[d][r] *= al_l[crow(r, hi)]; } } while (0)
  f32x16 pA0, pA1, pB0, pB1; float mnA, mnB, alA, alB; bf16x8 pa0, pa1, pa2, pa3; const int NT = seq / KVBLK;
  constexpr int SE = 0, SO = 1;
  SLOAD(SE, 0); asm volatile("s_waitcnt vmcnt(0)" ::: "memory"); SWRITE(0, SE); __syncthreads();
  qkt(pA0, pA1, K_lds, qr, r32, hi); partialSM(pA0, pA1, m_reg, mnA, alA);
  SLOAD(SO, KVBLK); if (2 < NT) SLOAD(SE, 2 * KVBLK);
  SWAIT(); SWRITE(1, SO); __syncthreads();
  for (int j = 1; j + 1 < NT; j += 2) {
    SBAR(); qkt(pB0, pB1, K_lds + SHM_K, qr, r32, hi);
    finishSM(pA0, pA1, alA, l_reg, pa0, pa1, pa2, pa3); SBAR();
    SLOAD(SO, (j + 2) * KVBLK); SBAR();
    pv_d0(o, vb0, pa0, pa1, pa2, pa3); partialSM(pB0, pB1, m_reg, mnB, alB);
    __syncthreads(); SWAIT(); SWRITE(0, SE);
    RESC(alB); __syncthreads();
    SBAR(); qkt(pA0, pA1, K_lds, qr, r32, hi);
    finishSM(pB0, pB1, alB, l_reg, pa0, pa1, pa2, pa3); SBAR();
    if (j + 3 < NT) SLOAD(SE, (j + 3) * KVBLK); SBAR();
    pv_d0(o, vb0 + SHM_V, pa0, pa1, pa2, pa3); partialSM(pA0, pA1, m_reg, mnA, alA);
    __syncthreads(); SWAIT(); SWRITE(1, SO);
    RESC(alA); __syncthreads();
  }
  SBAR(); qkt(pB0, pB1, K_lds + SHM_K, qr, r32, hi);
  finishSM(pA0, pA1, alA, l_reg, pa0, pa1, pa2, pa3); SBAR();
  pv_d0(o, vb0, pa0, pa1, pa2, pa3); partialSM(pB0, pB1, m_reg, mnB, alB);
  __syncthreads(); RESC(alB);
  finishSM(pB0, pB1, alB, l_reg, pa0, pa1, pa2, pa3); SBAR();
  pv_d0(o, vb0 + SHM_V, pa0, pa1, pa2, pa3);
  __syncthreads();
  { float* st = (float*)lds + wid * (32 * 68);
#pragma unroll
    for (int r = 0; r < 16; ++r) { const int orow = crow(r, hi); st[orow * 68 + r32] = o[0][r]; st[orow * 68 + 32 + r32] = o[1][r]; }
    asm volatile("s_waitcnt lgkmcnt(0)" ::: "memory");
    bf16* op = Op + (long)(wid * QBLK + r32) * LDP + hi * 32;
#pragma unroll
    for (int j = 0; j < 4; ++j) { const f32x4 x0 = *(const f32x4*)(st + r32 * 68 + hi * 32 + 8 * j), x1 = *(const f32x4*)(st + r32 * 68 + hi * 32 + 8 * j + 4);
      const float w[8] = {x0.x, x0.y, x0.z, x0.w, x1.x, x1.y, x1.z, x1.w}; *(v4u*)(op + 8 * j) = pack8(w); }
    if (hi == 0) { float* mp = MLp + (long)(wid * QBLK + r32) * LDML; mp[0] = m_reg; mp[1] = l_reg; } }
  __syncthreads();
#undef SLOAD
#undef SWRITE
#undef SWAIT
#undef RESC
}
#undef KSWZ
#undef SBAR
}

__device__ __forceinline__ int queue_pull(Frame& F, gu32* heads, int nq, int nper, int myq) {
  volatile LAS int* slot = (volatile LAS int*)(F.lds + LDSCTL_OFF);
  if (F.tid == 0) { int got = -1;
    for (int k = 0; k < nq; ++k) { const int q = (myq + k) % nq;
      if (__hip_atomic_load(heads + 64 * q, RLX_AGENT) >= (unsigned)nper) continue;
      const unsigned i = __hip_atomic_fetch_add(heads + 64 * q, 1u, RLX_AGENT);
      if (i < (unsigned)nper) { got = q * nper + (int)i; break; } }
    *slot = got; }
  __syncthreads();
  const int r = __builtin_amdgcn_readfirstlane(*slot);
  __syncthreads();
  return r;
}
__device__ __forceinline__ void p3_attention(Frame& F, const Args& a, char* lds_generic, unsigned xcc, int qoff) {
  unsigned char* ws = F.ws;
  const bf16* QMp = (const bf16*)(ws + WS_QM); const bf16* KMp = (const bf16*)(ws + WS_KM); const bf16* VMp = (const bf16*)(ws + WS_VM); bf16* PO = (bf16*)(ws + WS_PO); float* PML = (float*)(ws + WS_PML);
#ifndef WAIT_MODE
#define WAIT_MODE 1
#endif
  bool waited = false; (void)waited;
  for (;;) {
    const int u = queue_pull(F, F.ctl + CW_Q + qoff, 8, 128, (int)(xcc & 7u));
    if (u < 0) break;
    const int bh = u >> 5, qb = (u >> 1) & 15, kh = u & 1, b = bh >> 3, h = bh & 7;
#if WAIT_MODE == 0
    if (F.tid == 0) { unsigned sp = 0;
      while (__hip_atomic_load(F.ctl + CW_RDY + 64 * b, RLX_AGENT) < 112u) { __builtin_amdgcn_s_sleep(2); if (++sp > (1u << 24)) break; }
      __builtin_amdgcn_fence(__ATOMIC_ACQUIRE, "agent"); }
    asm volatile("s_waitcnt vmcnt(0)" ::: "memory"); __syncthreads();
#else
    if (!waited) { waited = true;
      if (F.tid == 0) { unsigned sp = 0;
        for (int bb = 0; bb < 4; ++bb) while (__hip_atomic_load(F.ctl + CW_RDY + 64 * bb, RLX_AGENT) < 112u) { __builtin_amdgcn_s_sleep(2); if (++sp > (1u << 24)) break; }
        __builtin_amdgcn_fence(__ATOMIC_ACQUIRE, "agent"); }
      asm volatile("s_waitcnt vmcnt(0)" ::: "memory"); __syncthreads(); }
#endif
    const size_t row0 = (size_t)b * SEQ + qb * 256, key0 = (size_t)b * SEQ + kh * (SEQ / 2);
    mla::attn_unit(QMp + row0 * 768 + h * 96, KMp + key0 * 768 + h * 96, VMp + key0 * 512 + h * 64,
                   PO + ((size_t)kh * MTOK + row0) * 512 + h * 64, PML + ((size_t)kh * MTOK + row0) * 16 + h * 2, SEQ / 2, lds_generic);
  }
}
namespace mls {
using mla::crow; using mla::v_st; using mla::v_rd_base;
#define KSWZ(row, colB) ((row) * 256 + ((colB) ^ (((row) & 7) << 4)))
constexpr int OFF_QS = 0, OFF_KS = 16384, OFF_KP = 32768, OFF_VV = 49152, OFF_CT = 65536, OFF_SC = 98304, OFF_NB = 99328, OFF_NP = 100352, OFF_CH = 104448, OFF_WS = 105472;
template <int OFF> __device__ __forceinline__ s16x4 trr(int vb) { s16x4 r; asm volatile("ds_read_b64_tr_b16 %0, %1 offset:%2" : "=&v"(r) : "v"(vb), "i"(OFF) : "memory"); return r; }
#define PKF(L, H) (bf16x8){L[0], L[1], L[2], L[3], H[0], H[1], H[2], H[3]}
__device__ __forceinline__ void vfrags(int img, int d0, int lane, bf16x8 (&f)[4]) {
  const int vb = img + v_rd_base(lane) + d0 * 512;
  const s16x4 l0 = trr<0>(vb), h0 = trr<2048>(vb), l1 = trr<4096>(vb), h1 = trr<4096 + 2048>(vb), l2 = trr<8192>(vb), h2 = trr<8192 + 2048>(vb), l3 = trr<12288>(vb), h3 = trr<12288 + 2048>(vb);
  asm volatile("s_waitcnt lgkmcnt(0)" ::: "memory"); __builtin_amdgcn_sched_barrier(0);
  f[0] = PKF(l0, h0); f[1] = PKF(l1, h1); f[2] = PKF(l2, h2); f[3] = PKF(l3, h3);
}
__device__ __forceinline__ void pack_p(const f32x16& p0, const f32x16& p1, bf16x8& pa0, bf16x8& pa1, bf16x8& pa2, bf16x8& pa3) {
#define PK4(P, BASE, OUT) do { unsigned a0 = cvt_pk_bf16(P[BASE + 0], P[BASE + 1]), a1 = cvt_pk_bf16(P[BASE + 2], P[BASE + 3]);   \
    unsigned b0 = cvt_pk_bf16(P[BASE + 4], P[BASE + 5]), b1 = cvt_pk_bf16(P[BASE + 6], P[BASE + 7]);                              \
    auto r0 = __builtin_amdgcn_permlane32_swap(a0, b0, false, false); auto r1 = __builtin_amdgcn_permlane32_swap(a1, b1, false, false); \
    v4u w = {r0[0], r1[0], r0[1], r1[1]}; OUT = __builtin_bit_cast(bf16x8, w); } while (0)
  PK4(p0, 0, pa0); PK4(p0, 8, pa1); PK4(p1, 0, pa2); PK4(p1, 8, pa3);
#undef PK4
}
__device__ __forceinline__ float swap_add(float v) { auto rr = __builtin_amdgcn_permlane32_swap(__float_as_uint(v), __float_as_uint(v), false, false); return __uint_as_float(rr[0]) + __uint_as_float(rr[1]); }

__device__ __forceinline__ void mlstm_seq(int seq, unsigned char* ws, char* lds) {
  int tid = threadIdx.x; asm volatile("" : "+v"(tid));
  const int wid = __builtin_amdgcn_readfirstlane(tid >> 6), lane = tid & 63, r32 = lane & 31, hi = lane >> 5, rb = wid >> 2, cb = wid & 3;
  const int dir = seq & 1, h = (seq >> 1) & 3, b = seq >> 3;
  const bf16* QC = (const bf16*)(ws + WS_QC); const bf16* KC = (const bf16*)(ws + WS_KC); const bf16* P = (const bf16*)(ws + WS_PROJ);
  const float* gs = (const float*)(ws + WS_GSC) + (size_t)seq * 3 * SEQ; const float* dec = (const float*)(ws + WS_DEC) + seq * 128;
  bf16* H = (bf16*)(ws + (dir ? WS_HB : WS_HF));
  float* sc_alpha = (float*)(lds + OFF_SC); float* sc_a = sc_alpha + 64; float* sc_iw = sc_alpha + 128; float* sc_en = sc_alpha + 192;
  float* nbuf = (float*)(lds + OFF_NB); float* npart = (float*)(lds + OFF_NP);
  float* ch_mprev = (float*)(lds + OFF_CH); float* ch_mnew = ch_mprev + 64; float* ch_dec = ch_mprev + 128; float* ch_g = ch_mprev + 192;
  float* wsf = (float*)(lds + OFF_WS) + wid * 32;
  const int ldsb = (int)(uintptr_t)lds;
  if (tid < 64) {
    if (tid == 0) { float m = 0.f; for (int c = 0; c < 64; ++c) { const float g = dec[c], wm = dec[64 + c]; const float mn = fmaxf(g + m, g + wm); ch_mprev[c] = m; ch_mnew[c] = mn; ch_dec[c] = __expf(g + m - mn); ch_g[c] = g; m = mn; } } }
  for (int i = tid; i < 32768 / 16; i += NTHR) ((v4u*)(lds + OFF_CT))[i] = (v4u){0u, 0u, 0u, 0u};
  if (tid < 128) nbuf[tid] = 0.f;
  f32x16 cacc[3]; cacc[0] = f32x16{}; cacc[1] = f32x16{}; cacc[2] = f32x16{};
  const int nown = rb ? 1 : 3;
  __syncthreads();
  const int sr = tid >> 4, sc = (tid & 15) * 8;
  v4u gq0, gq1, gk0, gk1, gv0, gv1; float ga0, ga1, sb = 0.f, sa = 0.f, spm = 0.f;
#define ROWOF(p) ((size_t)b * SEQ + (dir ? (SEQ - 1 - (p)) : (p)))
#define LOADC(c) do { const int p0_ = 64 * (c) + sr, p1_ = p0_ + 32; const size_t r0_ = ROWOF(p0_), r1_ = ROWOF(p1_); \
    gq0 = *(const v4u*)(QC + r0_ * 512 + h * 128 + sc); gq1 = *(const v4u*)(QC + r1_ * 512 + h * 128 + sc); \
    gk0 = *(const v4u*)(KC + r0_ * 512 + h * 128 + sc); gk1 = *(const v4u*)(KC + r1_ * 512 + h * 128 + sc); \
    gv0 = *(const v4u*)(P + r0_ * PROJ_LD + 1024 + h * 128 + sc); gv1 = *(const v4u*)(P + r1_ * PROJ_LD + 1024 + h * 128 + sc); \
    ga0 = gs[SEQ + p0_]; ga1 = gs[SEQ + p1_]; \
    if (tid < 64) { sb = gs[64 * (c) + tid]; sa = gs[SEQ + 64 * (c) + tid]; spm = gs[2 * SEQ + 64 * (c) + tid]; } } while (0)
#define WRITEC(c) do { \
    *(v4u*)(lds + OFF_QS + KSWZ(sr, sc * 2)) = gq0; *(v4u*)(lds + OFF_QS + KSWZ(32 + sr, sc * 2)) = gq1; \
    *(v4u*)(lds + OFF_KS + KSWZ(sr, sc * 2)) = gk0; *(v4u*)(lds + OFF_KS + KSWZ(32 + sr, sc * 2)) = gk1; \
    *(v4u*)(lds + OFF_VV + v_st(sr, sc)) = gv0; *(v4u*)(lds + OFF_VV + v_st(32 + sr, sc)) = gv1; \
    { const float gc_ = ch_g[c], mn_ = ch_mnew[c]; const float w0_ = __expf(gc_ + ga0 - mn_), w1_ = __expf(gc_ + ga1 - mn_); float f0_[8], f1_[8], cs_[8]; unpack8(gk0, f0_); unpack8(gk1, f1_); \
      _Pragma("unroll") for (int j = 0; j < 8; ++j) { f0_[j] *= w0_; f1_[j] *= w1_; cs_[j] = f0_[j] + f1_[j]; } \
      *(v4u*)(lds + OFF_KP + v_st(sr, sc)) = pack8(f0_); *(v4u*)(lds + OFF_KP + v_st(32 + sr, sc)) = pack8(f1_); \
      _Pragma("unroll") for (int j = 0; j < 8; ++j) { cs_[j] += __shfl_xor(cs_[j], 16); cs_[j] += __shfl_xor(cs_[j], 32); } \
      if ((lane >> 4) == 0) { _Pragma("unroll") for (int j = 0; j < 8; ++j) npart[wid * 128 + sc + j] = cs_[j]; } } \
    if (tid < 64) { const float m_ = ch_mprev[c]; const float mt_ = fmaxf(sb + m_, sb + spm); sc_alpha[tid] = sb - mt_; sc_a[tid] = sa; sc_iw[tid] = __expf(sb + m_ - mt_); sc_en[tid] = __expf(-mt_); } } while (0)
  LOADC(0); WRITEC(0);
  __syncthreads();
  for (int c = 0; c < 64; ++c) {
    if (c + 1 < 64) LOADC(c + 1);
    const float* nb = nbuf + (c & 1) * 128;
    if (tid < 128) { float s = 0.f;
#pragma unroll
      for (int w = 0; w < 8; ++w) s += npart[w * 128 + tid];
      nbuf[((c + 1) & 1) * 128 + tid] = ch_dec[c] * nb[tid] + s; }
    bf16x8 qr[8];
#pragma unroll
    for (int d0 = 0; d0 < 8; ++d0) qr[d0] = *(const bf16x8*)(lds + OFF_QS + KSWZ(32 * rb + r32, (16 * d0 + 8 * hi) * 2));
    f32x16 p0 = f32x16{}, p1 = f32x16{};
#pragma unroll
    for (int d0 = 0; d0 < 8; ++d0) { const bf16x8 k0 = *(const bf16x8*)(lds + OFF_KS + KSWZ(r32, (16 * d0 + 8 * hi) * 2)); p0 = __builtin_amdgcn_mfma_f32_32x32x16_bf16(k0, qr[d0], p0, 0, 0, 0); }
    if (rb == 1) {
#pragma unroll
      for (int d0 = 0; d0 < 8; ++d0) { const bf16x8 k1 = *(const bf16x8*)(lds + OFF_KS + KSWZ(32 + r32, (16 * d0 + 8 * hi) * 2)); p1 = __builtin_amdgcn_mfma_f32_32x32x16_bf16(k1, qr[d0], p1, 0, 0, 0); }
    }
    const float al = sc_alpha[32 * rb + r32];
    if (rb == 0) {
#pragma unroll
      for (int r = 0; r < 16; ++r) { const int sl = crow(r, hi); p0[r] = (sl <= r32) ? __expf(al + sc_a[sl]) * p0[r] : 0.f; }
    } else {
#pragma unroll
      for (int r = 0; r < 16; ++r) { const int sl = crow(r, hi); p0[r] = __expf(al + sc_a[sl]) * p0[r]; p1[r] = (sl <= r32) ? __expf(al + sc_a[32 + sl]) * p1[r] : 0.f; }
    }
    float ps = 0.f;
#pragma unroll
    for (int r = 0; r < 16; ++r) ps += p0[r] + p1[r];
    ps = swap_add(ps);
    bf16x8 pa0, pa1, pa2, pa3; pack_p(p0, p1, pa0, pa1, pa2, pa3);
    float qn = 0.f;
#pragma unroll
    for (int d0 = 0; d0 < 8; ++d0) { const f32x4 n0 = *(const f32x4*)(nb + 16 * d0 + 8 * hi), n1 = *(const f32x4*)(nb + 16 * d0 + 8 * hi + 4); const v4u qw = __builtin_bit_cast(v4u, qr[d0]);
      qn += bflo(qw.x) * n0.x + bfhi(qw.x) * n0.y + bflo(qw.y) * n0.z + bfhi(qw.y) * n0.w + bflo(qw.z) * n1.x + bfhi(qw.z) * n1.y + bflo(qw.w) * n1.z + bfhi(qw.w) * n1.w; }
    qn = swap_add(qn);
    { const float iwt = sc_iw[32 * rb + r32]; const float den = iwt * qn + ps; const float rd = 1.f / fmaxf(fabsf(den), sc_en[32 * rb + r32]); if (hi == 0) wsf[r32] = rd; }
    f32x16 o = f32x16{};
#pragma unroll
    for (int d0 = 0; d0 < 8; ++d0) { const bf16x8 cf = *(const bf16x8*)(lds + OFF_CT + KSWZ(32 * cb + r32, (16 * d0 + 8 * hi) * 2)); o = __builtin_amdgcn_mfma_f32_32x32x16_bf16(qr[d0], cf, o, 0, 0, 0); }
#pragma unroll
    for (int r = 0; r < 16; ++r) o[r] *= sc_iw[32 * rb + crow(r, hi)];
    bf16x8 vf[4]; vfrags(ldsb + OFF_VV, cb, lane, vf);
    o = __builtin_amdgcn_mfma_f32_32x32x16_bf16(pa0, vf[0], o, 0, 0, 0); o = __builtin_amdgcn_mfma_f32_32x32x16_bf16(pa1, vf[1], o, 0, 0, 0);
    if (rb == 1) { o = __builtin_amdgcn_mfma_f32_32x32x16_bf16(pa2, vf[2], o, 0, 0, 0); o = __builtin_amdgcn_mfma_f32_32x32x16_bf16(pa3, vf[3], o, 0, 0, 0); }
    asm volatile("s_waitcnt lgkmcnt(0)" ::: "memory");
#pragma unroll
    for (int r = 0; r < 16; ++r) { const int tl = crow(r, hi); const int p = 64 * c + 32 * rb + tl; H[ROWOF(p) * 512 + h * 128 + 32 * cb + r32] = (bf16)f2bf(o[r] * wsf[tl]); }
    { const float dc = ch_dec[c];
#pragma unroll
      for (int i = 0; i < 3; ++i) if (i < nown) { const int db = rb ? 3 : i; bf16x8 kf[4]; vfrags(ldsb + OFF_KP, db, lane, kf);
#pragma unroll
        for (int r = 0; r < 16; ++r) cacc[i][r] *= dc;
#pragma unroll
        for (int ks = 0; ks < 4; ++ks) cacc[i] = __builtin_amdgcn_mfma_f32_32x32x16_bf16(kf[ks], vf[ks], cacc[i], 0, 0, 0); } }
    __syncthreads();
#pragma unroll
    for (int i = 0; i < 3; ++i) if (i < nown) {
#pragma unroll
      for (int g = 0; g < 4; ++g) { const int d = 32 * (rb ? 3 : i) + 8 * g + 4 * hi, e = 32 * cb + r32;
        v2u w; w.x = cvt_pk_bf16(cacc[i][4 * g], cacc[i][4 * g + 1]); w.y = cvt_pk_bf16(cacc[i][4 * g + 2], cacc[i][4 * g + 3]);
        *(v2u*)(lds + OFF_CT + KSWZ(e, d * 2)) = w; } }
    if (c + 1 < 64) WRITEC(c + 1);
    __syncthreads();
  }
#undef ROWOF
#undef LOADC
#undef WRITEC
}
#undef KSWZ
#undef PKF
}

struct ListOrder { int n, L0, L1, nN, lda, ldb;
  __device__ bool next(int i, pg8::Unit& u) const { if (i >= n) return false; const int L = i ? L1 : L0; u.pm = L / nN; u.pn = L % nN; u.g = 0; u.ibase = 0;
    u.aoff = (long)u.pm * 256 * lda; u.boff = (long)u.pn * 256 * ldb; return true; } };
__device__ __forceinline__ void publish_units(Frame& F, const ListOrder& S) {
  if (F.tid == 0) { __builtin_amdgcn_fence(__ATOMIC_RELEASE, "agent"); asm volatile("s_waitcnt vmcnt(0)" ::: "memory");
    for (int i = 0; i < S.n; ++i) { const int L = i ? S.L1 : S.L0; __hip_atomic_fetch_add(F.ctl + CW_RDY + 64 * ((L / S.nN) >> 4), 1u, RLX_AGENT); } }
}
#ifndef P3_FILL_CHUNKS
#define P3_FILL_CHUNKS 3
#endif
__device__ __forceinline__ void p3_mixers(Frame& F, const Args& a, char* lds_generic, unsigned xcc, float* ssq, float* sskv, int qoff) {
  unsigned char* ws = F.ws; const int bx = (int)blockIdx.x;
#ifndef MLSTM_REPS
#define MLSTM_REPS 1
#endif
  if (bx < 32) { for (int rp = 0; rp < MLSTM_REPS; ++rp) { mls::mlstm_seq(bx, F.ws, lds_generic); __syncthreads(); } }
  else { const int c = bx - 32;
    { ListOrder S{c < 192 ? 1 : 0, c, 0, 3, PROJ_LD, 256};
      pg8::Gemm g{(const bf16*)(ws + WS_PROJ) + PC_CQ, (const bf16*)(ws + WS_WQB), PROJ_LD, 256, 256, nullptr, 127, 127};
      EpiQ E{(bf16*)(ws + WS_QM), ssq, (const float*)(ws + WS_ROPE)};
      pg8::gemm_phase<EpiQ, ListOrder, false>(F.lds, g, S, E); publish_units(F, S); }
    { ListOrder S{c >= 192 ? 2 : 1, c >= 192 ? c - 192 : c + 32, c + 32, 4, PROJ_LD, 256};
      pg8::Gemm g{(const bf16*)(ws + WS_PROJ) + PC_CKV, (const bf16*)(ws + WS_WKVB), PROJ_LD, 256, 256, nullptr, 127, 127};
      EpiKV E{(bf16*)(ws + WS_KM), (bf16*)(ws + WS_VM), sskv};
      pg8::gemm_phase<EpiKV, ListOrder, false>(F.lds, g, S, E); publish_units(F, S); }
  }
  p3_attention(F, a, lds_generic, xcc, qoff);
  if (bx >= 32 && !qoff) conv_fill(F, a, P3_FILL_CHUNKS);
}
__device__ __forceinline__ void p4_combine(Frame& F, const Args& a) {
  unsigned char* ws = F.ws; const bf16* HF = (const bf16*)(ws + WS_HF); const bf16* HB = (const bf16*)(ws + WS_HB); const bf16* P = (const bf16*)(ws + WS_PROJ); bf16* Y = (bf16*)(ws + WS_Y);
  const float* g = (const float*)a.in[I_GHM];
  const int gw = F.vcu * NWAVES + F.wave, NGW = F.G * NWAVES, c = F.lane * 8;
  float gg[8];
#pragma unroll
  for (int j = 0; j < 8; ++j) gg[j] = g[c + j];
  for (int m0 = gw; m0 < MTOK; m0 += 2 * NGW) {
    v4u wf[2], wb[2], wo[2];
#pragma unroll
    for (int u = 0; u < 2; ++u) { const size_t m = (size_t)(m0 + u * NGW); wf[u] = *(const v4u*)(HF + m * 512 + c); wb[u] = *(const v4u*)(HB + m * 512 + c); wo[u] = *(const v4u*)(P + m * PROJ_LD + 1536 + c); }
#pragma unroll
    for (int u = 0; u < 2; ++u) { const size_t m = (size_t)(m0 + u * NGW);
      float f[8], bb[8], oo[8]; unpack8(wf[u], f); unpack8(wb[u], bb); unpack8(wo[u], oo);
      float s = 0.f;
#pragma unroll
      for (int j = 0; j < 8; ++j) { f[j] += bb[j]; s += f[j] * f[j]; }
      s += __shfl_xor(s, 1); s += __shfl_xor(s, 2); s += __shfl_xor(s, 4); s += __shfl_xor(s, 8);
      const float r = rsqrtf(s * (1.f / 128.f) + 1e-6f);
#pragma unroll
      for (int j = 0; j < 8; ++j) f[j] = f[j] * r * gg[j] * sigmoidf_(oo[j]);
      *(v4u*)(Y + m * 1024 + c) = pack8(f); }
  }
  { const bf16* PO = (const bf16*)(ws + WS_PO); const float* PML = (const float*)(ws + WS_PML); const float* ga = (const float*)a.in[I_GHA];
    constexpr float C = 0.10206207261596575f * 1.4426950408889634f; const int hh = F.lane >> 3;
    float g8[8];
#pragma unroll
    for (int j = 0; j < 8; ++j) g8[j] = ga[c + j];
    for (int m = gw; m < MTOK; m += NGW) {
      float pa[8], pb[8]; unpack8(*(const v4u*)(PO + (size_t)m * 512 + c), pa); unpack8(*(const v4u*)(PO + ((size_t)MTOK + m) * 512 + c), pb);
      const float m0 = PML[(size_t)m * 16 + hh * 2], l0 = PML[(size_t)m * 16 + hh * 2 + 1], m1 = PML[((size_t)MTOK + m) * 16 + hh * 2], l1 = PML[((size_t)MTOK + m) * 16 + hh * 2 + 1];
      const float M = fmaxf(m0, m1), e0 = __builtin_amdgcn_exp2f((m0 - M) * C), e1 = __builtin_amdgcn_exp2f((m1 - M) * C); const float rl = 1.f / (l0 * e0 + l1 * e1);
      float f[8];
#pragma unroll
      for (int j = 0; j < 8; ++j) f[j] = pa[j] * e0 + pb[j] * e1;
      float s = 0.f;
#pragma unroll
      for (int j = 0; j < 8; ++j) { f[j] *= rl; s += f[j] * f[j]; }
      s += __shfl_xor(s, 1); s += __shfl_xor(s, 2); s += __shfl_xor(s, 4);
      const float r = rsqrtf(s * (1.f / 64.f) + 1e-6f);
#pragma unroll
      for (int j = 0; j < 8; ++j) f[j] = f[j] * r * g8[j];
      *(v4u*)(Y + (size_t)m * 1024 + 512 + c) = pack8(f); } }
}
template <int MODE> struct EpiResid { static constexpr bool TWO_PASS = false; const float* basef; const bf16* baseb; float* out; bf16* outb; float* ss;
  __device__ __forceinline__ void row8(const pg8::Unit& u, int rloc, int cloc, const float (&a0)[8], const float (&a1)[8], int fq) const {
    const int row = u.pm * 256 + rloc; const size_t off = (size_t)row * 1024 + u.pn * 256 + cloc;
    float v0[8], v1[8];
    if constexpr (MODE == 0) {
      const f32x4 b0 = *(const f32x4*)(basef + off), b1 = *(const f32x4*)(basef + off + 4), b2 = *(const f32x4*)(basef + off + 128), b3 = *(const f32x4*)(basef + off + 132);
#pragma unroll
      for (int i = 0; i < 4; ++i) { v0[i] = a0[i] + b0[i]; v0[4 + i] = a0[4 + i] + b1[i]; v1[i] = a1[i] + b2[i]; v1[4 + i] = a1[4 + i] + b3[i]; }
      *(v4u*)(outb + off) = pack8(v0); *(v4u*)(outb + off + 128) = pack8(v1);
    } else {
      float r0[8], r1[8]; unpack8(*(const v4u*)(baseb + off), r0); unpack8(*(const v4u*)(baseb + off + 128), r1);
#pragma unroll
      for (int i = 0; i < 8; ++i) { v0[i] = a0[i] + r0[i]; v1[i] = a1[i] + r1[i]; }
      *(v4u*)(outb + off) = pack8(v0); *(v4u*)(outb + off + 128) = pack8(v1);
      if (out) { *(f32x4*)(out + off) = (f32x4){v0[0], v0[1], v0[2], v0[3]}; *(f32x4*)(out + off + 4) = (f32x4){v0[4], v0[5], v0[6], v0[7]};
        *(f32x4*)(out + off + 128) = (f32x4){v1[0], v1[1], v1[2], v1[3]}; *(f32x4*)(out + off + 132) = (f32x4){v1[4], v1[5], v1[6], v1[7]}; }
    }
    float s = sumsq8(v0) + sumsq8(v1); s += __shfl_xor(s, 16); s += __shfl_xor(s, 32); if (fq == 0) unsafeAtomicAdd(ss + row, s); } };
struct EpiScale { static constexpr bool TWO_PASS = false; bf16* O; const float* ss;
  __device__ __forceinline__ void row8(const pg8::Unit& u, int rloc, int cloc, const float (&a0)[8], const float (&a1)[8], int fq) const {
    const int row = u.pm * 256 + rloc; const float r = rsqrtf(ss[row] * (1.f / 1024.f) + 1e-6f); float v0[8], v1[8];
#pragma unroll
    for (int i = 0; i < 8; ++i) { v0[i] = a0[i] * r; v1[i] = a1[i] * r; }
    bf16* p = O + (size_t)row * 1024 + u.pn * 256 + cloc; *(v4u*)p = pack8(v0); *(v4u*)(p + 128) = pack8(v1); } };
struct EpiSoftmax { static constexpr bool TWO_PASS = true; bf16* O; float scale; LAS float* xch;
  __device__ __forceinline__ void pass1(const pg8::Unit& u, int rloc, int wc, float (&v0)[8], float (&v1)[8], int fq) const {
    float mx = -3.0e38f;
#pragma unroll
    for (int i = 0; i < 8; ++i) { v0[i] *= scale; v1[i] *= scale; mx = fmaxf(mx, fmaxf(v0[i], v1[i])); }
    mx = fmaxf(mx, __shfl_xor(mx, 16)); mx = fmaxf(mx, __shfl_xor(mx, 32));
    float l = 0.f;
#pragma unroll
    for (int i = 0; i < 8; ++i) { v0[i] = __expf(v0[i] - mx); v1[i] = __expf(v1[i] - mx); l += v0[i] + v1[i]; }
    l += __shfl_xor(l, 16); l += __shfl_xor(l, 32);
    if (fq == 0) { xch[(rloc * 4 + wc) * 2] = mx; xch[(rloc * 4 + wc) * 2 + 1] = l; } }
  __device__ __forceinline__ void row8(const pg8::Unit& u, int rloc, int cloc, const float (&a0)[8], const float (&a1)[8], int fq) const {
    const int wc = cloc >> 5; float m[4], l[4]; float M = -3.0e38f;
#pragma unroll
    for (int w = 0; w < 4; ++w) { m[w] = xch[(rloc * 4 + w) * 2]; l[w] = xch[(rloc * 4 + w) * 2 + 1]; M = fmaxf(M, m[w]); }
    float L = 0.f, mine = 0.f;
#pragma unroll
    for (int w = 0; w < 4; ++w) { const float e = __expf(m[w] - M); L += l[w] * e; if (w == wc) mine = e; }
    const float f = mine / L; float v0[8], v1[8];
#pragma unroll
    for (int i = 0; i < 8; ++i) { v0[i] = a0[i] * f; v1[i] = a1[i] * f; }
    bf16* p = O + (size_t)(u.pm * 256 + rloc) * 1024 + u.pn * 256 + cloc; *(v4u*)p = pack8(v0); *(v4u*)(p + 128) = pack8(v1); } };
struct MemOrder { int G, c, kind;
  __device__ bool next(int i, pg8::Unit& u) const { const int L = i * G + c; if (L >= 256) return false;
    const int bh = L >> 4, t = L & 15, b = bh >> 2, h = bh & 3;
    u.pm = b * 16 + t; u.pn = h; u.g = 0; u.ibase = 0; u.aoff = ((long)(b * SEQ + t * 256)) * 1024 + (kind == 2 ? 0 : h * 256);
    u.boff = kind == 0 ? ((long)(b * NMEM)) * 1024 + h * 256 : kind == 1 ? ((long)(h * 256)) * 1024 + b * NMEM : ((long)(h * 256)) * 1024; return true; } };
constexpr size_t WS_WRG = WS_DEC + 65536;
constexpr size_t WS_ROWSEL = WS_SEL, WS_GSEL = WS_SEL + 131072, WS_INV = 31 * MiB, WS_YE = 160 * MiB;
typedef float f32x4m __attribute__((ext_vector_type(4)));
__device__ __forceinline__ void p10_router(Frame& F, const Args& a) {
  unsigned char* ws = F.ws; const bf16* X2 = (const bf16*)(ws + WS_X2); const float* ss2 = (const float*)(ws + CTL_SS2); float* AFF = (float*)(ws + WS_AFF); const float* WRG = (const float*)(ws + WS_WRG);
  const int gw = F.vcu * NWAVES + F.wave, NGW = F.G * NWAVES, r = F.lane & 15, kq = F.lane >> 4;
  LAS float* wl = (LAS float*)F.lds;
  for (int i = F.tid; i < 4096; i += NTHR) ((LAS f32x4*)wl)[i] = ((const f32x4*)WRG)[i];
  __syncthreads();
  for (int it = gw; it < MTOK / 16; it += NGW) { const int m0 = it * 16;
    const bf16* xp = X2 + (size_t)(m0 + r) * 1024 + 4 * kq; const LAS float* wp = wl + (4 * kq) * 16 + r;
    f32x4m acc0 = {0.f, 0.f, 0.f, 0.f}, acc1 = {0.f, 0.f, 0.f, 0.f};
#pragma unroll 1
    for (int hf = 0; hf < 2; ++hf) {
      f32x4 xv[32];
#pragma unroll
      for (int j = 0; j < 32; ++j) {
#if X2MODE >= 1 && X2MODE != 3
        xv[j] = *(const f32x4*)((const float*)(ws + WS_X2F) + (size_t)(m0 + r) * 1024 + 4 * kq + 16 * (32 * hf + j));
#else
        const v2u w = *(const v2u*)(xp + 16 * (32 * hf + j)); xv[j] = (f32x4){bflo(w.x), bfhi(w.x), bflo(w.y), bfhi(w.y)};
#endif
      }
#pragma unroll
      for (int j = 0; j < 32; j += 2) { const LAS float* w0 = wp + (16 * (32 * hf + j)) * 16; const LAS float* w1 = w0 + 256;
        acc0 = __builtin_amdgcn_mfma_f32_16x16x4f32(xv[j].x, w0[0], acc0, 0, 0, 0); acc1 = __builtin_amdgcn_mfma_f32_16x16x4f32(xv[j + 1].x, w1[0], acc1, 0, 0, 0);
        acc0 = __builtin_amdgcn_mfma_f32_16x16x4f32(xv[j].y, w0[16], acc0, 0, 0, 0); acc1 = __builtin_amdgcn_mfma_f32_16x16x4f32(xv[j + 1].y, w1[16], acc1, 0, 0, 0);
        acc0 = __builtin_amdgcn_mfma_f32_16x16x4f32(xv[j].z, w0[32], acc0, 0, 0, 0); acc1 = __builtin_amdgcn_mfma_f32_16x16x4f32(xv[j + 1].z, w1[32], acc1, 0, 0, 0);
        acc0 = __builtin_amdgcn_mfma_f32_16x16x4f32(xv[j].w, w0[48], acc0, 0, 0, 0); acc1 = __builtin_amdgcn_mfma_f32_16x16x4f32(xv[j + 1].w, w1[48], acc1, 0, 0, 0); }
    }
#pragma unroll
    for (int i = 0; i < 4; ++i) { const int row = m0 + 4 * kq + i; const float lg = (acc0[i] + acc1[i]) * rsqrtf(ss2[row] * (1.f / 1024.f) + 1e-6f);
      float mx = lg; mx = fmaxf(mx, __shfl_xor(mx, 1)); mx = fmaxf(mx, __shfl_xor(mx, 2)); mx = fmaxf(mx, __shfl_xor(mx, 4)); mx = fmaxf(mx, __shfl_xor(mx, 8));
      const float ex = __expf(lg - mx); float l = ex; l += __shfl_xor(l, 1); l += __shfl_xor(l, 2); l += __shfl_xor(l, 4); l += __shfl_xor(l, 8);
      AFF[(size_t)row * 16 + r] = ex / l; }
  }
  __syncthreads();
}
__device__ __forceinline__ void p11_topk(Frame& F, char* lds) {
  unsigned char* ws = F.ws; const float* AFF = (const float*)(ws + WS_AFF); int* ROWSEL = (int*)(ws + WS_ROWSEL); float* GSEL = (float*)(ws + WS_GSEL); int* INV = (int*)(ws + WS_INV);
  unsigned* hist = (unsigned*)lds; unsigned* ctl = hist + 256; unsigned* wsum = hist + 320;
  const int tid = F.tid, lane = F.lane, wid = F.wave;
  for (int it = (int)blockIdx.x; it < BATCH * NEXP; it += F.G) { const int b = it >> 4, e = it & 15;
    unsigned key[8];
#pragma unroll
    for (int j = 0; j < 8; ++j) key[j] = __float_as_uint(AFF[((size_t)b * SEQ + 8 * tid + j) * 16 + e]);
    unsigned prefix = 0u, mask = 0u, need = CAP;
    for (int shift = 24; shift >= 0; shift -= 8) {
      if (tid < 256) hist[tid] = 0u;
      __syncthreads();
#pragma unroll
      for (int j = 0; j < 8; ++j) if ((key[j] & mask) == prefix) atomicAdd(&hist[(key[j] >> shift) & 255u], 1u);
      __syncthreads();
      if (tid == 0) { unsigned above = 0u; int d = 255; for (; d > 0; --d) { const unsigned c = hist[d]; if (above + c >= need) break; above += c; } ctl[0] = (unsigned)d; ctl[1] = need - above; }
      __syncthreads();
      prefix |= ctl[0] << shift; mask |= 255u << shift; need = ctl[1];
      __syncthreads();
    }
    unsigned ngt = 0u, neq = 0u;
#pragma unroll
    for (int j = 0; j < 8; ++j) { ngt += key[j] > prefix ? 1u : 0u; neq += key[j] == prefix ? 1u : 0u; }
    unsigned sgt = ngt, seq_ = neq;
#pragma unroll
    for (int o = 1; o < 64; o <<= 1) { const unsigned y0 = __shfl_up(sgt, o), y1 = __shfl_up(seq_, o); if (lane >= o) { sgt += y0; seq_ += y1; } }
    if (lane == 63) { wsum[wid] = sgt; wsum[8 + wid] = seq_; }
    __syncthreads();
    unsigned bgt = 0u, beq = 0u, tgt = 0u;
#pragma unroll
    for (int w = 0; w < 8; ++w) { const unsigned g = wsum[w], q = wsum[8 + w]; if (w < wid) { bgt += g; beq += q; } tgt += g; }
    unsigned pgt = bgt + sgt - ngt, peq = beq + seq_ - neq;
#pragma unroll
    for (int j = 0; j < 8; ++j) { const int t = 8 * tid + j; int slot = -1;
      if (key[j] > prefix) slot = (int)pgt++; else if (key[j] == prefix) { if (peq < need) slot = (int)(tgt + peq); ++peq; }
      INV[((size_t)b * SEQ + t) * 16 + e] = slot;
      if (slot >= 0) { ROWSEL[e * 2048 + b * 512 + slot] = b * SEQ + t; GSEL[e * 2048 + b * 512 + slot] = __uint_as_float(key[j]); } }
    __syncthreads();
  }
}
#ifndef GU_ORDER
#define GU_ORDER 1
#endif
#ifndef DN_ORDER
#define DN_ORDER 1
#endif
struct MoeGUOrder { int G, c;
  __device__ bool next(int i, pg8::Unit& u) const { const int L = i * G + c; if (L >= 2048) return false;
#if GU_ORDER == 0
    const int e = L >> 7, r = L & 127, pn = r >> 3, mt = r & 7;
#elif GU_ORDER == 1
    const int e = L >> 7, r = L & 127, mt = r >> 4, pn = r & 15;
#else
    const int x = c & 7, j = c >> 3, e = (i >> 2) * 8 + x, r = (i & 3) * 32 + j, mt = r >> 4, pn = r & 15;
#endif
    u.g = e; u.pm = mt; u.pn = pn; u.ibase = e * 2048 + mt * 256; u.aoff = MOE_FP8 ? ((long)e * 2048 + mt * 256) * 512 : 0; u.boff = ((long)e * 4096 + pn * 256) * (MOE_FP8 ? 512 : 1024); return true; } };
struct MoeDownOrder { int G, c;
  __device__ bool next(int i, pg8::Unit& u) const { const int L = i * G + c; if (L >= 512) return false;
#if DN_ORDER == 0
    const int e = L >> 5, r = L & 31, pn = r >> 3, mt = r & 7;
#else
    const int x = c & 7, j = c >> 3, e = i * 8 + x, pn = j >> 3, mt = j & 7;
#endif
    u.g = e; u.pm = mt; u.pn = pn; u.ibase = e * 2048 + mt * 256; u.aoff = ((long)e * 2048 + mt * 256) * (MOE_FP8_DOWN ? 1024 : 2048); u.boff = ((long)e * 1024 + pn * 256) * (MOE_FP8_DOWN ? 1024 : 2048); return true; } };
struct EpiGU { static constexpr bool TWO_PASS = false; bf16* H; const float* ss2; const int* rowsel;
  __device__ __forceinline__ void row8(const pg8::Unit& u, int rloc, int cloc, const float (&a0)[8], const float (&a1)[8], int fq) const {
    const int tok = rowsel[u.ibase + rloc]; const float r = rsqrtf(ss2[tok] * (1.f / 1024.f) + 1e-6f); float h[8];
#pragma unroll
    for (int i = 0; i < 8; ++i) { const float g = a0[i] * r, up = a1[i] * r; h[i] = g * sigmoidf_(g) * up; if (FP8EMU) h[i] = q8(h[i], 8.f); }
#if MOE_FP8_DOWN
    *(v2u*)((unsigned char*)H + ((size_t)u.g * 2048 + u.pm * 256 + rloc) * 2048 + u.pn * 128 + cloc) = pack8_fp8(h, 8.f); } };
#else
    *(v4u*)(H + ((size_t)u.g * 2048 + u.pm * 256 + rloc) * 2048 + u.pn * 128 + cloc) = pack8(h); } };
#endif
struct EpiGU8 { static constexpr bool TWO_PASS = false; unsigned char* H8; const float* ss2; const int* rowsel;
  __device__ __forceinline__ void row8(const pg8::Unit& u, int rloc, int cloc, const float (&a0)[8], const float (&a1)[8], int fq) const {
    float h[8];
#pragma unroll
    for (int i = 0; i < 8; ++i) { const float g = a0[i], up = a1[i]; h[i] = g * sigmoidf_(g) * up; }
#if MOE_FP8_DOWN
    *(v2u*)(H8 + ((size_t)u.g * 2048 + u.pm * 256 + rloc) * 2048 + u.pn * 128 + cloc) = pack8_fp8(h, 8.f); } };
#else
    *(v4u*)((bf16*)H8 + ((size_t)u.g * 2048 + u.pm * 256 + rloc) * 2048 + u.pn * 128 + cloc) = pack8(h); } };
#endif
struct EpiYE { static constexpr bool TWO_PASS = false; bf16* Yp; const float* gsel;
  __device__ __forceinline__ void row8(const pg8::Unit& u, int rloc, int cloc, const float (&a0)[8], const float (&a1)[8], int fq) const {
    const float gv = gsel[u.ibase + rloc]; float v0[8], v1[8];
#pragma unroll
    for (int i = 0; i < 8; ++i) { v0[i] = a0[i] * gv; v1[i] = a1[i] * gv; }
    bf16* p = Yp + ((size_t)u.g * 2048 + u.pm * 256 + rloc) * 1024 + u.pn * 256 + cloc; *(v4u*)p = pack8(v0); *(v4u*)(p + 128) = pack8(v1); } };
__device__ __forceinline__ void p14_final(Frame& F, const Args& a) {
  unsigned char* ws = F.ws; const bf16* X2 = (const bf16*)(ws + WS_X2); const int* INV = (const int*)(ws + WS_INV); const bf16* YE = (const bf16*)(ws + WS_YE);
  const float* gfin = (const float*)a.in[I_GFIN]; float* out = a.out;
  const int gw = F.vcu * NWAVES + F.wave, NGW = F.G * NWAVES;
  f32x4 g[4];
#pragma unroll
  for (int j = 0; j < 4; ++j) g[j] = *(const f32x4*)(gfin + 256 * j + 4 * F.lane);
  for (int m0 = gw; m0 < MTOK; m0 += 2 * NGW) {
    f32x4 v[2][4]; int inv[2];
#pragma unroll
    for (int u = 0; u < 2; ++u) { const int m = m0 + u * NGW;
#pragma unroll
      for (int j = 0; j < 4; ++j) {
#if X2MODE >= 2
        v[u][j] = *(const f32x4*)((const float*)(ws + WS_X2F) + (size_t)m * 1024 + 256 * j + 4 * F.lane);
#else
        const v2u w = *(const v2u*)(X2 + (size_t)m * 1024 + 256 * j + 4 * F.lane); v[u][j] = (f32x4){bflo(w.x), bfhi(w.x), bflo(w.y), bfhi(w.y)};
#endif
      }
      inv[u] = F.lane < 16 ? INV[(size_t)m * 16 + F.lane] : -1; }
#pragma unroll
    for (int u = 0; u < 2; ++u) { const int m = m0 + u * NGW, b = m >> 12;
      unsigned long long sel = __ballot(inv[u] >= 0);
      while (sel) { const int e = __builtin_ctzll(sel); sel &= sel - 1; const int slot = __shfl(inv[u], e);
        const bf16* yr = YE + ((size_t)e * 2048 + b * 512 + slot) * 1024 + 4 * F.lane;
#pragma unroll
        for (int j = 0; j < 4; ++j) { const v2u w = *(const v2u*)(yr + 256 * j); v[u][j].x += bflo(w.x); v[u][j].y += bfhi(w.x); v[u][j].z += bflo(w.y); v[u][j].w += bfhi(w.y); } }
      float s = 0.f;
#pragma unroll
      for (int j = 0; j < 4; ++j) s += (v[u][j].x * v[u][j].x + v[u][j].y * v[u][j].y) + (v[u][j].z * v[u][j].z + v[u][j].w * v[u][j].w);
      const float r = rsqrtf(wave_sum(s) * (1.f / 1024.f) + 1e-6f);
#pragma unroll
      for (int j = 0; j < 4; ++j) *(f32x4*)(out + (size_t)m * 1024 + 256 * j + 4 * F.lane) = v[u][j] * r * g[j]; }
  }
}
__global__ void __launch_bounds__(NTHR, 2) mk(Args a) {
  extern __shared__ __attribute__((aligned(16))) unsigned char lds_raw[];
  Frame F;
  F.lds = (LAS unsigned char*)lds_raw; F.MISC = (volatile LAS unsigned*)(F.lds + LDSCTL_OFF + 320);
  F.tid = threadIdx.x; F.lane = F.tid & 63; F.wave = __builtin_amdgcn_readfirstlane(F.tid >> 6);
  F.G = gridDim.x; { const int bx = blockIdx.x; F.vcu = (F.G % 8 == 0) ? (bx % 8) * (F.G / 8) + bx / 8 : bx; }
  F.ws = a.ws; F.ctl = (gu32*)(a.ws + WS_CTL);
  unsigned char* ws = a.ws;
  for (int u = F.tid; u < (LDS_BYTES - LDSCTL_OFF) / 4; u += NTHR) ((LAS unsigned*)(F.lds + LDSCTL_OFF))[u] = 0u;
  __syncthreads();
  XcdBarrier bar = xcd_barrier_post((unsigned*)(F.ctl + CW_BAR), F.MISC + 8);
  const int lo = a.ph_lo, hi = a.ph_hi;
#define IN(k) (lo <= (k) && (k) < hi)
#define BOTH(k) (IN(k) && IN((k) + 1))
#define GRID_BAR() xcd_barrier(bar)
  float* ssq = (float*)(ws + CTL_SSQ); float* sskv = (float*)(ws + CTL_SSKV);

#ifndef REP_MASK
#define REP_MASK 0
#endif
#define NREP(k) ((((REP_MASK) >> (k)) & 1) ? 2 : 1)
#define PH_BEGIN(k) if (IN(k)) { for (int rep_ = 0; rep_ < NREP(k); ++rep_) { const bool dry = rep_ + 1 < NREP(k); (void)dry;
#define PH_END(k) if (dry) GRID_BAR(); } if (BOTH(k)) GRID_BAR(); }
  float* dummy = (float*)(ws + WS_DUMMY);
  float* ss1 = (float*)(ws + CTL_SS1); float* ss2 = (float*)(ws + CTL_SS2);
#ifndef FILLMODE
#define FILLMODE 2
#endif
  PH_BEGIN(0) p0_prologue(F, a, true, FILLMODE == 0); PH_END(0)
  PH_BEGIN(1)
    { pg8::Gemm g{(const bf16*)(ws + WS_XN), (const bf16*)(ws + WS_WIN), 1024, 1024, 1024, nullptr, 127, 127}; pg8::StaticOrder S; S.init(MTOK, PROJ_LD, F.G, (int)blockIdx.x, 1024, 1024);
      EpiProj E{(bf16*)(ws + WS_PROJ), dry ? dummy : ssq, dry ? dummy + 16384 : sskv};
      pg8::gemm_phase<EpiProj, pg8::StaticOrder, false>(F.lds, g, S, E); }
    { pg8::Gemm g{(const bf16*)(ws + WS_MEMN), (const bf16*)(ws + WS_WMK), 1024, 1024, 1024, nullptr, 127, 127}; pg8::StaticOrder S; S.init(1024, 1024, F.G, (int)((blockIdx.x + 128u) % (unsigned)F.G), 1024, 1024);
      EpiStore E{(bf16*)(ws + WS_KMEM), 1024};
      pg8::gemm_phase<EpiStore, pg8::StaticOrder, false>(F.lds, g, S, E); }
    { pg8::Gemm g{(const bf16*)(ws + WS_WMV), (const bf16*)(ws + WS_MEMN), 1024, 1024, 1024, nullptr, 127, 127}; pg8::StaticOrder S; S.init(1024, 1024, F.G, (int)((blockIdx.x + 112u) % (unsigned)F.G), 1024, 1024);
      EpiStore E{(bf16*)(ws + WS_VMEMT), 1024};
      pg8::gemm_phase<EpiStore, pg8::StaticOrder, false>(F.lds, g, S, E); }
  PH_END(1)
  PH_BEGIN(2) p2_elementwise(F, a); PH_END(2)
  PH_BEGIN(3) p3_mixers(F, a, (char*)lds_raw, bar.x, ssq, sskv, dry ? 64 * 16 : 0); PH_END(3)
  PH_BEGIN(4) p4_combine(F, a); PH_END(4)
  PH_BEGIN(5)
    pg8::Gemm g{(const bf16*)(ws + WS_Y), (const bf16*)(ws + WS_WOUT), 1024, 1024, 1024, nullptr, 127, 127}; pg8::StaticOrder S; S.init(MTOK, 1024, F.G, (int)blockIdx.x, 1024, 1024);
    EpiResid<0> E{(const float*)a.in[I_X], nullptr, nullptr, (bf16*)(ws + WS_X1B), dry ? dummy : ss1};
    pg8::gemm_phase<EpiResid<0>, pg8::StaticOrder, false>(F.lds, g, S, E);
  PH_END(5)
  PH_BEGIN(6)
    { pg8::Gemm g{(const bf16*)(ws + WS_X1B), (const bf16*)(ws + WS_WMQ), 1024, 1024, 1024, nullptr, 127, 127}; MemOrder S{F.G, (int)blockIdx.x, 2};
      EpiScale E{(bf16*)(ws + WS_QMEM), ss1};
      pg8::gemm_phase<EpiScale, MemOrder, false>(F.lds, g, S, E); }
    if (F.tid == 0) __builtin_amdgcn_fence(__ATOMIC_ACQUIRE, "agent");
    asm volatile("s_waitcnt vmcnt(0)" ::: "memory"); __syncthreads();
    { pg8::Gemm g{(const bf16*)(ws + WS_QMEM), (const bf16*)(ws + WS_KMEM), 1024, 1024, 256, nullptr, 127, 127}; MemOrder S{F.G, (int)blockIdx.x, 0};
      EpiSoftmax E{(bf16*)(ws + WS_P), 0.0625f, (LAS float*)(F.lds + LDSCTL_OFF + 1024)};
      pg8::gemm_phase<EpiSoftmax, MemOrder, false>(F.lds, g, S, E); }
    if (F.tid == 0) __builtin_amdgcn_fence(__ATOMIC_ACQUIRE, "agent");
    asm volatile("s_waitcnt vmcnt(0)" ::: "memory"); __syncthreads();
    { pg8::Gemm g{(const bf16*)(ws + WS_P), (const bf16*)(ws + WS_VMEMT), 1024, 1024, 256, nullptr, 127, 127}; MemOrder S{F.G, (int)blockIdx.x, 1};
      EpiStore E{(bf16*)(ws + WS_MO), 1024};
      pg8::gemm_phase<EpiStore, MemOrder, false>(F.lds, g, S, E); }
  PH_END(6)
  PH_BEGIN(9)
    pg8::Gemm g{(const bf16*)(ws + WS_MO), (const bf16*)(ws + WS_WMO), 1024, 1024, 1024, nullptr, 127, 127}; pg8::StaticOrder S; S.init(MTOK, 1024, F.G, (int)blockIdx.x, 1024, 1024);
    EpiResid<1> E{nullptr, (const bf16*)(ws + WS_X1B), X2MODE >= 1 ? (float*)(ws + WS_X2F) : nullptr, (bf16*)(ws + WS_X2), dry ? dummy : ss2};
    pg8::gemm_phase<EpiResid<1>, pg8::StaticOrder, false>(F.lds, g, S, E);
  PH_END(9)
  PH_BEGIN(10) p10_router(F, a); PH_END(10)
  PH_BEGIN(11) p11_topk(F, (char*)lds_raw);
    if (!dry && FILLMODE != 0) conv_fill(F, a, 1 << 30);
  PH_END(11)
  PH_BEGIN(12)
#if MOE_FP8
    {
      const int gw = F.vcu * NWAVES + F.wave, NGW = F.G * NWAVES; const int* rs = (const int*)(ws + WS_ROWSEL);
      for (int r0 = gw; r0 < NEXP * 2048; r0 += 4 * NGW) {
        int tok[4]; float rn[4]; v4u qa[4], qb[4];
#pragma unroll
        for (int u = 0; u < 4; ++u) { const int r = r0 + u * NGW; tok[u] = r < NEXP * 2048 ? rs[r] : 0; }
#pragma unroll
        for (int u = 0; u < 4; ++u) { const bf16* xr = (const bf16*)(ws + WS_X2) + (size_t)tok[u] * 1024 + F.lane * 16; rn[u] = ss2[tok[u]]; qa[u] = *(const v4u*)xr; qb[u] = *(const v4u*)(xr + 8); }
#pragma unroll
        for (int u = 0; u < 4; ++u) { const int r = r0 + u * NGW; const float s = rsqrtf(rn[u] * (1.f / 1024.f) + 1e-6f);
          float lo[8], hi[8]; unpack8(qa[u], lo); unpack8(qb[u], hi);
#pragma unroll
          for (int j = 0; j < 8; ++j) { lo[j] *= s; hi[j] *= s; }
          const v2u a8 = pack8_fp8(lo, 1.f), b8 = pack8_fp8(hi, 1.f); v4u o; o.x = a8.x; o.y = a8.y; o.z = b8.x; o.w = b8.y;
          if (r < NEXP * 2048) *(v4u*)(ws + WS_XG + (size_t)r * 1024 + F.lane * 16) = o; } }
      GRID_BAR(); }
    pg8::Gemm g{(const bf16*)(ws + WS_XG), (const bf16*)(ws + WS_WEGU8), 512, 512, 512, nullptr, 127, 121}; MoeGUOrder S{F.G, (int)blockIdx.x};
    EpiGU8 E{(unsigned char*)(ws + WS_HID8), ss2, (const int*)(ws + WS_ROWSEL)};
    pg8::gemm_phase<EpiGU8, MoeGUOrder, false, 1>(F.lds, g, S, E);
#else
    pg8::Gemm g{(const bf16*)(ws + WS_X2B), (const bf16*)(ws + WS_WEGU), 1024, 1024, 1024, (const int*)(ws + WS_ROWSEL), 127, 127}; MoeGUOrder S{F.G, (int)blockIdx.x};
    EpiGU E{(bf16*)(ws + WS_HID), ss2, (const int*)(ws + WS_ROWSEL)};
    pg8::gemm_phase<EpiGU, MoeGUOrder, true>(F.lds, g, S, E);
#endif
  PH_END(12)
  PH_BEGIN(13)
#if MOE_FP8_DOWN
    pg8::Gemm g{(const bf16*)(ws + WS_HID8), (const bf16*)(ws + WS_WED8), 1024, 1024, 1024, nullptr, 124, 121}; MoeDownOrder S{F.G, (int)blockIdx.x};
    EpiYE E{(bf16*)(ws + WS_YE), (const float*)(ws + WS_GSEL)};
    pg8::gemm_phase<EpiYE, MoeDownOrder, false, 1>(F.lds, g, S, E);
#else
    pg8::Gemm g{(const bf16*)(ws + WS_HID), (const bf16*)(ws + WS_WED), 2048, 2048, 2048, nullptr, 127, 127}; MoeDownOrder S{F.G, (int)blockIdx.x};
    EpiYE E{(bf16*)(ws + WS_YE), (const float*)(ws + WS_GSEL)};
    pg8::gemm_phase<EpiYE, MoeDownOrder, false>(F.lds, g, S, E);
#endif
  PH_END(13)
  PH_BEGIN(14) p14_final(F, a); PH_END(14)
#undef IN
#undef BOTH
#undef GRID_BAR
}

__global__ __launch_bounds__(256) void adapt_b2f(const bf16* src, long lds_, long scol, float* dst, long ldd, long dcol, long rows, long ncols) {
  const long i = blockIdx.x * 256L + threadIdx.x; if (i >= rows * ncols) return;
  const long r = i / ncols, c = i % ncols; dst[r * ldd + dcol + c] = bf2f(src[r * lds_ + scol + c]);
}
static void adapt(hipStream_t s, const void* src, long lds_, long scol, float* dst, long ldd, long dcol, long rows, long ncols) {
  hipLaunchKernelGGL(adapt_b2f, dim3((unsigned)((rows * ncols + 255) / 256)), dim3(256), 0, s, (const bf16*)src, lds_, scol, dst, ldd, dcol, rows, ncols);
}

static int mk_grid() {
  static int grid = 0;
  if (grid == 0) {
    int dev = 0, cus = 0, per_cu = 0;
    (void)hipGetDevice(&dev); (void)hipDeviceGetAttribute(&cus, hipDeviceAttributeMultiprocessorCount, dev);
    (void)hipFuncSetAttribute((const void*)mk, hipFuncAttributeMaxDynamicSharedMemorySize, LDS_BYTES);
    (void)hipOccupancyMaxActiveBlocksPerMultiprocessor(&per_cu, (const void*)mk, NTHR, LDS_BYTES);
    (void)hipGetLastError();
    grid = cus > 0 ? cus : 256;
  }
  return grid;
}
static void mk_launch(hipStream_t s, void* const* d_in, void* d_out, void* d_ws, int lo, int hi, int flags) {
  Args a; memset(&a, 0, sizeof(a));
  for (int i = 0; i < 26; ++i) a.in[i] = d_in[i];
  a.out = (float*)d_out; a.ws = (unsigned char*)d_ws; a.ph_lo = lo; a.ph_hi = hi; a.flags = flags; a.pad = 0;
  (void)hipMemsetAsync((char*)d_ws + WS_CTL + CW_BAR * 4, 0, XCD_BAR_WORDS * 4, s);
  hipLaunchKernelGGL(mk, dim3(mk_grid()), dim3(NTHR), LDS_BYTES, s, a);
}

extern "C" void kernel_launch(void* const* d_in, const int* in_sizes, int n_in, void* d_out, int out_size, void* d_ws, size_t ws_size, hipStream_t s) {
  (void)hipMemsetAsync((char*)d_ws + WS_CTL, 0, CTL_ZERO_BYTES, s);
  mk_launch(s, d_in, d_out, d_ws, 0, 15, 1);
}
```

```cpp
#include <hip/hip_runtime.h>
#include <cstdint>
#include <cstdio>
#include <cstring>

constexpr int BATCH = 4, SEQ = 4096, DM = 1024, MTOK = BATCH * SEQ;
constexpr int D_IN = 2480;
constexpr int OFF_QM = 0, OFF_KM = 512, OFF_VM = 1024, OFF_OM = 1536, OFF_G = 2048, OFF_CQ = 2064, OFF_CKV = 2320, OFF_KR = 2448;
constexpr int NEXP = 16, CAP = 512, DFF = 2048, NMEM = 256;
constexpr size_t MiB = 1u << 20;
enum { I_X = 0, I_MEM, I_POS, I_GMIX, I_WIN, I_BG, I_CONV, I_GQA, I_WQB, I_GKVA, I_WKVB, I_GHM, I_GHA, I_WOUT, I_GMX, I_GMKV, I_WMQ, I_WMK, I_WMV, I_WMO, I_GFFN, I_WR, I_WEG, I_WEU, I_WED, I_GFIN };
#define GAS __attribute__((address_space(1)))
#define LAS __attribute__((address_space(3)))
typedef unsigned short bf16;
typedef unsigned v4u __attribute__((ext_vector_type(4)));
typedef unsigned v2u __attribute__((ext_vector_type(2)));
typedef float f32x4 __attribute__((ext_vector_type(4)));
typedef float f32x16 __attribute__((ext_vector_type(16)));
typedef short bf16x8 __attribute__((ext_vector_type(8)));
typedef short s16x4 __attribute__((ext_vector_type(4)));
typedef GAS unsigned gu32;
#define RLX_AGENT __ATOMIC_RELAXED, __HIP_MEMORY_SCOPE_AGENT
#define LDS_WAIT() asm volatile("s_waitcnt lgkmcnt(0)" ::: "memory")
#define VM_WAIT() asm volatile("s_waitcnt vmcnt(0)" ::: "memory")
constexpr int NWAVES = 8, NTHR = 512;
__device__ __forceinline__ unsigned f2bf(float f) { unsigned u = __builtin_bit_cast(unsigned, f); return (u + 0x7fffu + ((u >> 16) & 1u)) >> 16; }
__device__ __forceinline__ unsigned pk2(float lo, float hi) { return f2bf(lo) | (f2bf(hi) << 16); }
__device__ __forceinline__ float bf2f(unsigned short h) { return __builtin_bit_cast(float, (unsigned)h << 16); }
__device__ __forceinline__ float bflo(unsigned w) { return __builtin_bit_cast(float, w << 16); }
__device__ __forceinline__ float bfhi(unsigned w) { return __builtin_bit_cast(float, w & 0xffff0000u); }
typedef float f32x2_t __attribute__((ext_vector_type(2))); typedef __bf16 bf16x2_t __attribute__((ext_vector_type(2)));
__device__ __forceinline__ unsigned cvt_pk_bf16(float lo, float hi) { f32x2_t v = {lo, hi}; bf16x2_t b = __builtin_convertvector(v, bf16x2_t); return __builtin_bit_cast(unsigned, b); }
__device__ __forceinline__ v2u pack8_fp8(const float (&v)[8], float sc) { float c[8];
#pragma unroll
  for (int i = 0; i < 8; ++i) c[i] = __builtin_amdgcn_fmed3f(v[i] * sc, -448.f, 448.f);
  int a = 0, b = 0; a = __builtin_amdgcn_cvt_pk_fp8_f32(c[0], c[1], a, false); a = __builtin_amdgcn_cvt_pk_fp8_f32(c[2], c[3], a, true);
  b = __builtin_amdgcn_cvt_pk_fp8_f32(c[4], c[5], b, false); b = __builtin_amdgcn_cvt_pk_fp8_f32(c[6], c[7], b, true); v2u r; r.x = (unsigned)a; r.y = (unsigned)b; return r; }
__device__ __forceinline__ float q8(float x, float sc) { const int p = __builtin_amdgcn_cvt_pk_fp8_f32(x * sc, 0.f, 0, false); return __builtin_amdgcn_cvt_f32_fp8(p, 0) * (1.f / sc); }
__device__ __forceinline__ float wave_sum(float v) {
#pragma unroll
  for (int o = 1; o < 64; o <<= 1) v += __shfl_xor(v, o);
  return v;
}
__device__ __forceinline__ float sigmoidf_(float x) { return 1.f / (1.f + __expf(-x)); }

#define XB_TMO      128
#define XB_XCNT(j)  (256  + 64 * (j))
#define XB_XSUB(j)  (1280 + 64 * (j))
#define XB_XGEN(j)  (2304 + 64 * (j))
#define XB_TOP      3328
#define XB_TOPGEN   3392
#define XCD_BAR_WORDS 3456
#define XB_SPIN_CAP (1u << 22)
__device__ __forceinline__ unsigned xb_ld(unsigned* p)              { return __hip_atomic_load(p, __ATOMIC_RELAXED, __HIP_MEMORY_SCOPE_AGENT); }
__device__ __forceinline__ unsigned xb_add(unsigned* p, unsigned v) { return __hip_atomic_fetch_add(p, v, __ATOMIC_RELAXED, __HIP_MEMORY_SCOPE_AGENT); }
__device__ __forceinline__ unsigned xb_xcc_id() { return (unsigned)__builtin_amdgcn_s_getreg((3 << 11) | 20) & 0xFu; }
#define XB_SPIN(cond, bar) do { unsigned _sp = 0; while (cond) { __builtin_amdgcn_s_sleep(1); \
    if ((++_sp & 255u) == 0u) { if (xb_ld(&(bar)[XB_TMO])) break; if (_sp > XB_SPIN_CAP) { atomicAdd(&(bar)[XB_TMO], 1u); break; } } } } while (0)
struct XcdBarrier { unsigned* bar; unsigned x; volatile LAS unsigned* st; };
__device__ __forceinline__ XcdBarrier xcd_barrier_post(unsigned* bar, volatile LAS unsigned* st) {
  XcdBarrier b; b.bar = bar; b.x = xb_xcc_id(); b.st = st;
  if (threadIdx.x == 0) (void)xb_add(&bar[XB_XCNT(b.x)], 1u);
  return b;
}
__device__ __forceinline__ void xcd_barrier_complete(unsigned* bar, unsigned x, unsigned& nloc, unsigned& nx) {
  const unsigned G = gridDim.x * gridDim.y * gridDim.z;
  unsigned sum, cnt, mine, sp = 0u;
  for (;;) {
    sum = 0u; cnt = 0u; mine = 0u;
#pragma unroll
    for (unsigned j = 0; j < 16; ++j) { const unsigned c = xb_ld(&bar[XB_XCNT(j)]); sum += c; cnt += (c > 0u) ? 1u : 0u; mine = (j == x) ? c : mine; }
    if (sum == G) break;
    __builtin_amdgcn_s_sleep(1);
    if ((++sp & 255u) == 0u) { if (xb_ld(&bar[XB_TMO])) break; if (sp > XB_SPIN_CAP) { atomicAdd(&bar[XB_TMO], 1u); break; } }
  }
  nloc = mine > 0u ? mine : 1u; nx = cnt > 0u ? cnt : 1u;
}
__device__ __forceinline__ void xcd_barrier(const XcdBarrier& b) {
  asm volatile("s_waitcnt vmcnt(0)" ::: "memory");
  __syncthreads();
  if (threadIdx.x == 0) {
    unsigned* bar = b.bar;
    __builtin_amdgcn_s_waitcnt(0);
    unsigned nloc = b.st[0], nx = b.st[1];
    if (nloc == 0u) { xcd_barrier_complete(bar, b.x, nloc, nx); b.st[0] = nloc; b.st[1] = nx; }
    const unsigned old = xb_add(&bar[XB_XSUB(b.x)], 1u);
    const unsigned gen = old / nloc;
    if (old + 1u == (gen + 1u) * nloc) {
      __builtin_amdgcn_fence(__ATOMIC_RELEASE, "agent");
      asm volatile("s_waitcnt vmcnt(0)" ::: "memory");
      const unsigned og = xb_add(&bar[XB_TOP], 1u);
      const unsigned tg = og / nx;
      if (og + 1u == (tg + 1u) * nx) xb_add(&bar[XB_TOPGEN], 1u);
      else XB_SPIN(xb_ld(&bar[XB_TOPGEN]) == tg, bar);
      __builtin_amdgcn_fence(__ATOMIC_ACQUIRE, "agent");
      xb_add(&bar[XB_XGEN(b.x)], 1u);
      asm volatile("s_waitcnt vmcnt(0)" ::: "memory");
    } else {
      XB_SPIN(xb_ld(&bar[XB_XGEN(b.x)]) == gen, bar);
      __builtin_amdgcn_fence(__ATOMIC_ACQUIRE, "agent");
      asm volatile("s_waitcnt vmcnt(0)" ::: "memory");
    }
  }
  __syncthreads();
}

namespace pg8 {
constexpr int BM = 256, BK = 64, HALF = 128, HTB = HALF * BK * 2, STAGE_BYTES = 8 * HTB, NXCD = 8, WGM = 8;
__host__ __device__ __forceinline__ int lds_byte(int r, int c) { const int st = (r >> 4) * 2 + (c >> 5), rr = r & 15, cc = c & 31, ob = rr * 64 + cc * 2; return st * 1024 + (ob ^ (((ob >> 9) & 1) << 5)); }
__host__ __device__ __forceinline__ void stage_rc(int b, int& R, int& C) { const int st = b / 1024, sb = b % 1024, swz = sb ^ (((sb >> 9) & 1) << 5); R = (st >> 1) * 16 + swz / 64; C = (st & 1) * 32 + (swz % 64) / 2; }
__host__ __device__ __forceinline__ int perm32(int rho) { const int n = rho >> 4, i = rho & 15; return 8 * (i >> 2) + 4 * n + (i & 3); }

struct Unit { long aoff, boff; int pm, pn, g, ibase; };
struct Gemm { const bf16* A; const bf16* Bt; int lda, ldb, K; const int* gidx; int sa, sb; };
typedef int v8i_t __attribute__((ext_vector_type(8))); typedef int v4i_t __attribute__((ext_vector_type(4)));
__device__ __forceinline__ v8i_t cat8(bf16x8 lo, bf16x8 hi) { const v4i_t a = __builtin_bit_cast(v4i_t, lo), b = __builtin_bit_cast(v4i_t, hi); return __builtin_shufflevector(a, b, 0, 1, 2, 3, 4, 5, 6, 7); }

struct StaticOrder {
  int nM, nN, nwg, G, c, lda, ldb;
  __device__ void init(int M, int N, int G_, int c_, int lda_, int ldb_) { nM = M / BM; nN = N / BM; nwg = nM * nN; G = G_; c = c_; lda = lda_; ldb = ldb_; }
  __device__ bool next(int i, Unit& u) const {
    const long L = (long)i * G + c; if (L >= nwg) return false;
    int wgid = (int)L; { const int q = nwg / NXCD, r = nwg % NXCD, xcd = wgid % NXCD, off = wgid / NXCD; wgid = (xcd < r ? xcd * (q + 1) : r * (q + 1) + (xcd - r) * q) + off; }
    const int nig = WGM * nN, gid = wgid / nig, fm = gid * WGM, gsz = (nM - fm) < WGM ? (nM - fm) : WGM;
    u.pm = fm + ((wgid % nig) % gsz); u.pn = (wgid % nig) / gsz; u.g = 0; u.ibase = 0;
    u.aoff = (long)u.pm * BM * lda; u.boff = (long)u.pn * BM * ldb; return true;
  }
};

template <class Epi, class Sched, bool GATHER, int FP8 = 0>
__device__ __forceinline__ void gemm_phase(LAS unsigned char* lds, const Gemm g, const Sched& S, const Epi& E) {
  int tid = threadIdx.x; asm volatile("" : "+v"(tid));
  const int wid = __builtin_amdgcn_readfirstlane(tid >> 6), lane = tid & 63, wr = wid >> 2, wc = wid & 3, fr = lane & 15, fq = lane >> 4;
  const int K = g.K, nt = K / BK;
  int Rs[2], Cs[2]; unsigned voffB[2];
#pragma unroll
  for (int i = 0; i < 2; ++i) { int R, C; stage_rc(tid * 16 + i * 8192, R, C); Rs[i] = R; Cs[i] = C; const int Rb = (R & ~31) + perm32(R & 31); voffB[i] = (unsigned)(Rb * g.ldb + C) * 2u; }
  const size_t kstep = (size_t)(BK * 2);
  const size_t hstepB = (size_t)HALF * g.ldb * 2;
  const unsigned ldsw = (unsigned)wid * 1024u;
  const int aoff_l = lds_byte(wr * 64 + fr, FP8 ? fq * 16 : fq * 8), boff_l = lds_byte(wc * 32 + fr, FP8 ? fq * 16 : fq * 8);
  constexpr int aoff_k = FP8 ? 16 : 1024, boff_k = FP8 ? 16 : 1024;
#define PG8_SA(b, h) (((b) * 2 + (h)) * HTB)
#define PG8_SB(b, h) ((4 + (b) * 2 + (h)) * HTB)
#define PG8_STAGE(bufoff, gbase, voff) do { _Pragma("unroll") for (int _i = 0; _i < 2; ++_i) \
        __builtin_amdgcn_global_load_lds((const unsigned*)((const char*)(gbase) + (voff)[_i]), (LAS unsigned*)(lds + (bufoff) + ldsw + _i * 8192), 16, 0, 0); } while (0)
#define PG8_LDA(dst, b, h) do { _Pragma("unroll") for (int m = 0; m < 4; ++m) { if constexpr (FP8) { const v4i_t lo_ = *(const LAS v4i_t*)(lds + PG8_SA(b, h) + aoff_l + m * 2048), hi_ = *(const LAS v4i_t*)(lds + PG8_SA(b, h) + aoff_l + m * 2048 + aoff_k); dst##8[m] = __builtin_shufflevector(lo_, hi_, 0, 1, 2, 3, 4, 5, 6, 7); } \
        else { _Pragma("unroll") for (int k = 0; k < 2; ++k) dst[m][k] = *(const LAS bf16x8*)(lds + PG8_SA(b, h) + aoff_l + m * 2048 + k * aoff_k); } } } while (0)
#define PG8_LDB(dst, b, h) do { _Pragma("unroll") for (int n = 0; n < 2; ++n) { if constexpr (FP8) { const v4i_t lo_ = *(const LAS v4i_t*)(lds + PG8_SB(b, h) + boff_l + n * 2048), hi_ = *(const LAS v4i_t*)(lds + PG8_SB(b, h) + boff_l + n * 2048 + boff_k); dst##8[n] = __builtin_shufflevector(lo_, hi_, 0, 1, 2, 3, 4, 5, 6, 7); } \
        else { _Pragma("unroll") for (int k = 0; k < 2; ++k) dst[n][k] = *(const LAS bf16x8*)(lds + PG8_SB(b, h) + boff_l + n * 2048 + k * boff_k); } } } while (0)
#define PG8_MMA(ai, bj, At, Bt) do { __builtin_amdgcn_s_setprio(1); _Pragma("unroll") for (int m = 0; m < 4; ++m) _Pragma("unroll") for (int n = 0; n < 2; ++n) { \
        if constexpr (FP8) asm volatile("v_mfma_scale_f32_16x16x128_f8f6f4 %0, %1, %2, %0, %3, %4 op_sel_hi:[0,0,0]" : "+v"(acc[ai][bj][m][n]) : "v"(Bt##8[n]), "v"(At##8[m]), "v"(vsb), "v"(vsa)); \
        else { _Pragma("unroll") for (int k = 0; k < 2; ++k) acc[ai][bj][m][n] = __builtin_amdgcn_mfma_f32_16x16x32_bf16(Bt[n][k], At[m][k], acc[ai][bj][m][n], 0, 0, 0); } } \
        __builtin_amdgcn_s_setprio(0); } while (0)
#define PG8_WAIT_V(n) asm volatile("s_waitcnt vmcnt(" #n ")" ::: "memory")
#define PG8_WAIT_L(n) asm volatile("s_waitcnt lgkmcnt(" #n ")" ::: "memory")
#define PG8_BAR __builtin_amdgcn_s_barrier()
#define PG8_SCHED __builtin_amdgcn_sched_barrier(0)
  Unit cur, nxt; int ui = 0;
  if (!S.next(0, cur)) return;
  unsigned vA[2][2], nvA[2][2];
  auto load_va = [&](const Unit& u, unsigned (&v)[2][2]) {
#pragma unroll
    for (int h = 0; h < 2; ++h)
#pragma unroll
      for (int i = 0; i < 2; ++i) {
        if constexpr (GATHER) v[h][i] = (unsigned)((long)g.gidx[u.ibase + h * HALF + Rs[i]] * g.lda + Cs[i]) * 2u;
        else v[h][i] = (unsigned)((h * HALF + Rs[i]) * g.lda + Cs[i]) * 2u;
      }
  };
  load_va(cur, vA);
  f32x4 acc[2][2][4][2];
#pragma unroll
  for (int a = 0; a < 2; ++a)
#pragma unroll
    for (int b = 0; b < 2; ++b)
#pragma unroll
      for (int m = 0; m < 4; ++m)
#pragma unroll
        for (int n = 0; n < 2; ++n) acc[a][b][m][n] = (f32x4){0.f, 0.f, 0.f, 0.f};
  int vsa = g.sa, vsb = g.sb; (void)vsa; (void)vsb;
  bf16x8 At[4][2], B0[2][2], B1[2][2]; v8i_t At8[4], B08[2], B18[2];
  const char* cA = (const char*)g.A + (GATHER ? 0 : cur.aoff * 2); const char* cB = (const char*)g.Bt + cur.boff * 2;
  PG8_STAGE(PG8_SB(0, 0), cB, voffB); PG8_STAGE(PG8_SB(0, 1), cB + hstepB, voffB); PG8_STAGE(PG8_SA(0, 0), cA, vA[0]); PG8_STAGE(PG8_SA(0, 1), cA, vA[1]);
  if (wr == 1) PG8_BAR;
  PG8_WAIT_V(2); PG8_BAR;
  PG8_STAGE(PG8_SB(1, 0), cB + kstep, voffB); PG8_STAGE(PG8_SA(1, 0), cA + kstep, vA[0]); PG8_STAGE(PG8_SB(1, 1), cB + hstepB + kstep, voffB);
  PG8_WAIT_V(6); PG8_BAR;
  for (;;) {
    const bool has_next = S.next(ui + 1, nxt);
    const char* nA = has_next ? (const char*)g.A + (GATHER ? 0 : nxt.aoff * 2) : cA; const char* nB = has_next ? (const char*)g.Bt + nxt.boff * 2 : cB;
    if constexpr (GATHER) { if (has_next) load_va(nxt, nvA); else {
#pragma unroll
      for (int h = 0; h < 2; ++h)
#pragma unroll
        for (int i = 0; i < 2; ++i) nvA[h][i] = vA[h][i]; } }
#pragma unroll 1
    for (int t = 0; t < nt; t += 2) {
      const bool last = (t == nt - 2);
      const char* a1 = cA + (size_t)(t + 1) * kstep;
      const char* a2 = last ? nA : cA + (size_t)(t + 2) * kstep; const char* b2 = last ? nB : cB + (size_t)(t + 2) * kstep;
      const char* a3 = a2 + kstep; const char* b3 = b2 + kstep;
      unsigned w0[2], w1[2];
      if constexpr (GATHER) { w0[0] = last ? nvA[0][0] : vA[0][0]; w0[1] = last ? nvA[0][1] : vA[0][1]; w1[0] = last ? nvA[1][0] : vA[1][0]; w1[1] = last ? nvA[1][1] : vA[1][1]; }
      else { w0[0] = vA[0][0]; w0[1] = vA[0][1]; w1[0] = vA[1][0]; w1[1] = vA[1][1]; }
      PG8_LDB(B0, 0, 0); PG8_LDB(B1, 0, 1); PG8_SCHED; PG8_LDA(At, 0, 0); PG8_STAGE(PG8_SA(1, 1), a1, vA[1]);
      PG8_WAIT_V(8); PG8_WAIT_L(0); PG8_BAR; PG8_MMA(0, 0, At, B0); PG8_MMA(0, 1, At, B1); PG8_BAR; PG8_SCHED;
      PG8_LDA(At, 0, 1); PG8_STAGE(PG8_SB(0, 0), b2, voffB); PG8_STAGE(PG8_SB(0, 1), b2 + hstepB, voffB); PG8_STAGE(PG8_SA(0, 0), a2, w0);
      PG8_WAIT_V(8); PG8_WAIT_L(0); PG8_BAR; PG8_MMA(1, 0, At, B0); PG8_MMA(1, 1, At, B1); PG8_BAR; PG8_SCHED;
      PG8_LDB(B0, 1, 0); PG8_LDB(B1, 1, 1); PG8_SCHED; PG8_LDA(At, 1, 0); PG8_STAGE(PG8_SA(0, 1), a2, w1);
      PG8_WAIT_V(8); PG8_WAIT_L(0); PG8_BAR; PG8_MMA(0, 0, At, B0); PG8_MMA(0, 1, At, B1); PG8_BAR; PG8_SCHED;
      PG8_LDA(At, 1, 1); PG8_STAGE(PG8_SB(1, 0), b3, voffB); PG8_STAGE(PG8_SB(1, 1), b3 + hstepB, voffB); PG8_STAGE(PG8_SA(1, 0), a3, w0);
      PG8_WAIT_V(8); PG8_WAIT_L(0); PG8_BAR; PG8_MMA(1, 0, At, B0); PG8_MMA(1, 1, At, B1); PG8_BAR; PG8_SCHED;
    }
    if constexpr (FP8) { asm volatile("s_nop 15\n\ts_nop 15" ::: "memory"); __builtin_amdgcn_sched_barrier(0); }
    if (wr == 0) PG8_BAR;
    int fr_o = fr, fq_o = fq; asm volatile("" : "+v"(fr_o), "+v"(fq_o));
    if constexpr (Epi::TWO_PASS) {
#pragma unroll
      for (int ai = 0; ai < 2; ++ai)
#pragma unroll
        for (int m = 0; m < 4; ++m) {
          float v0[8], v1[8];
#pragma unroll
          for (int n = 0; n < 2; ++n)
#pragma unroll
            for (int j = 0; j < 4; ++j) { v0[n * 4 + j] = acc[ai][0][m][n][j]; v1[n * 4 + j] = acc[ai][1][m][n][j]; }
          E.pass1(cur, ai * HALF + wr * 64 + m * 16 + fr_o, wc, v0, v1, fq_o);
#pragma unroll
          for (int n = 0; n < 2; ++n)
#pragma unroll
            for (int j = 0; j < 4; ++j) { acc[ai][0][m][n][j] = v0[n * 4 + j]; acc[ai][1][m][n][j] = v1[n * 4 + j]; }
        }
      asm volatile("s_waitcnt lgkmcnt(0)" ::: "memory"); PG8_BAR; asm volatile("" ::: "memory");
    }
    {
#pragma unroll
      for (int ai = 0; ai < 2; ++ai)
#pragma unroll
        for (int m = 0; m < 4; ++m) {
          float v0[8], v1[8];
#pragma unroll
          for (int n = 0; n < 2; ++n)
#pragma unroll
            for (int j = 0; j < 4; ++j) { v0[n * 4 + j] = acc[ai][0][m][n][j]; v1[n * 4 + j] = acc[ai][1][m][n][j]; }
          E.row8(cur, ai * HALF + wr * 64 + m * 16 + fr_o, wc * 32 + 8 * fq_o, v0, v1, fq_o);
          asm volatile("" ::: "memory");
        }
    }
    if (!has_next) break;
#pragma unroll
    for (int a = 0; a < 2; ++a)
#pragma unroll
      for (int b = 0; b < 2; ++b)
#pragma unroll
        for (int m = 0; m < 4; ++m)
#pragma unroll
          for (int n = 0; n < 2; ++n) acc[a][b][m][n] = (f32x4){0.f, 0.f, 0.f, 0.f};
    cur = nxt; cA = nA; cB = nB; ++ui;
    if constexpr (GATHER) {
#pragma unroll
      for (int h = 0; h < 2; ++h)
#pragma unroll
        for (int i = 0; i < 2; ++i) vA[h][i] = nvA[h][i]; }
    if (wr == 1) PG8_BAR;
  }
  PG8_WAIT_V(0);
  PG8_BAR;
#undef PG8_SA
#undef PG8_SB
#undef PG8_STAGE
#undef PG8_LDA
#undef PG8_LDB
#undef PG8_MMA
#undef PG8_WAIT_V
#undef PG8_WAIT_L
#undef PG8_BAR
#undef PG8_SCHED
}
}
constexpr size_t WS_CTL = 0, CTL_ZERO_BYTES = 1 * MiB;
constexpr int CW_TMO = 0, CW_BAR = 4096, CW_Q = 8192;
constexpr size_t CTL_SSQ = 256 * 1024, CTL_SSKV = CTL_SSQ + 65536, CTL_SS1 = CTL_SSKV + 65536, CTL_SS2 = CTL_SS1 + 65536;
constexpr size_t WS_WIN = 1 * MiB, WS_WQB = 6 * MiB, WS_WKVB = 6 * MiB + 512 * 1024, WS_WOUT = 7 * MiB, WS_WMQ = 9 * MiB, WS_WMK = 11 * MiB, WS_WMV = 13 * MiB, WS_WMO = 15 * MiB;
constexpr size_t WS_ROPE = 17 * MiB, WS_MEMN = 19 * MiB, WS_KMEM = 21 * MiB, WS_VMEMT = 23 * MiB, WS_GSC = 25 * MiB, WS_DEC = 28 * MiB, WS_AFF = 29 * MiB, WS_SEL = 30 * MiB;
constexpr size_t WS_PROJ = 32 * MiB, WS_XN = 112 * MiB, WS_QC = 112 * MiB, WS_KC = 128 * MiB, WS_QM = 144 * MiB, WS_KM = 168 * MiB, WS_VM = 192 * MiB, WS_HF = 208 * MiB, WS_HB = 224 * MiB, WS_Y = 240 * MiB;
constexpr size_t WS_X1 = 112 * MiB, WS_X1B = 176 * MiB, WS_QMEM = 208 * MiB, WS_P = 240 * MiB, WS_MO = 112 * MiB, WS_X2 = 208 * MiB, WS_X2B = 208 * MiB, WS_HID = 32 * MiB;
constexpr size_t WS_DUMMY = 304 * MiB;
#ifndef X2MODE
#define X2MODE 2
#endif
constexpr size_t WS_X2F = 256 * MiB;
constexpr size_t WS_WEGU = 320 * MiB, WS_WED = 448 * MiB, WS_END = 512 * MiB;
constexpr int PROJ_LD = 2560;
constexpr int PC_CQ = 2048, PC_CKV = 2304, PC_KR = 2432, PC_G = 2464;
constexpr int RING_BYTES = 131072, LDSCTL_OFF = 133120, LDS_BYTES = 147456;

struct Args { const void* in[26]; float* out; unsigned char* ws; int ph_lo, ph_hi, flags, pad; };

struct Frame {
  LAS unsigned char* lds; volatile LAS unsigned* MISC; gu32* ctl; unsigned char* ws;
  int tid, lane, wave, vcu, G;
};

__device__ __forceinline__ void p0_tr(const float* W, int ldw, int k0, int kvalid, int scol0, int ncols, const float* gs, bf16* WT, int ldt, int drow0, LAS float* scr, int lane, bool doq = false) {
  const int c4 = (lane & 15) * 4, kr = lane >> 4;
  f32x4 v[16];
#pragma unroll
  for (int i = 0; i < 16; ++i) { const int kk = 4 * i + kr; v[i] = (f32x4){0.f, 0.f, 0.f, 0.f};
    if (c4 < ncols && k0 + kk < kvalid) { v[i] = *(const f32x4*)(W + (size_t)(k0 + kk) * ldw + scol0 + c4); if (gs) v[i] = v[i] * gs[k0 + kk];
      if (doq) { v[i].x = q8(v[i].x, 64.f); v[i].y = q8(v[i].y, 64.f); v[i].z = q8(v[i].z, 64.f); v[i].w = q8(v[i].w, 64.f); } } }
#pragma unroll
  for (int i = 0; i < 16; ++i) { const int kk = 4 * i + kr; LAS float* d = scr + kk * 65 + c4; d[0] = v[i].x; d[1] = v[i].y; d[2] = v[i].z; d[3] = v[i].w; }
  LDS_WAIT(); asm volatile("" ::: "memory");
  const int c = lane & 7;
#pragma unroll
  for (int j = 0; j < 8; ++j) { const int n = (lane >> 3) + 8 * j; const LAS float* s = scr + (8 * c) * 65 + n;
    v4u o; o.x = pk2(s[0 * 65], s[1 * 65]); o.y = pk2(s[2 * 65], s[3 * 65]); o.z = pk2(s[4 * 65], s[5 * 65]); o.w = pk2(s[6 * 65], s[7 * 65]);
    *(GAS v4u*)(WT + (size_t)(drow0 + n) * ldt + k0 + 8 * c) = o; }
  LDS_WAIT(); asm volatile("" ::: "memory");
}
struct ConvDesc { const float* W; const float* gs; unsigned char* WT8; int ldw, k0, scol0, ldt, drow0; };
__device__ __forceinline__ void p0_tr8_load(const ConvDesc& d, f32x4 (&v)[16], int lane) {
  const int c4 = (lane & 15) * 4, kr = lane >> 4;
#pragma unroll
  for (int i = 0; i < 16; ++i) { const int kk = 4 * i + kr; v[i] = *(const f32x4*)(d.W + (size_t)(d.k0 + kk) * d.ldw + d.scol0 + c4); }
}
__device__ __forceinline__ void p0_tr8_finish(const ConvDesc& d, f32x4 (&v)[16], float sc, LAS float* scr, int lane) {
  const int c4 = (lane & 15) * 4, kr = lane >> 4;
#pragma unroll
  for (int i = 0; i < 16; ++i) { const int kk = 4 * i + kr; f32x4 x = v[i]; if (d.gs) x = x * d.gs[d.k0 + kk]; LAS float* p = scr + kk * 65 + c4; p[0] = x.x; p[1] = x.y; p[2] = x.z; p[3] = x.w; }
  LDS_WAIT(); asm volatile("" ::: "memory");
  const int c = lane & 7;
#pragma unroll
  for (int j = 0; j < 8; ++j) { const int n = (lane >> 3) + 8 * j; const LAS float* s = scr + (8 * c) * 65 + n;
    float f[8];
#pragma unroll
    for (int q = 0; q < 8; ++q) f[q] = s[q * 65];
    *(GAS v2u*)(d.WT8 + (size_t)(d.drow0 + n) * d.ldt + d.k0 + 8 * c) = pack8_fp8(f, sc); }
  LDS_WAIT(); asm volatile("" ::: "memory");
}
__device__ __forceinline__ void p0_tr32(const float* W, int ldw, int k0, int scol0, int ncols, const float* gs, bf16* WT, int ldt, int drow0, LAS float* scr, int lane) {
#pragma unroll 8
  for (int i = 0; i < 32; ++i) { const int kk = 2 * i + (lane >> 5), c = lane & 31; float v = 0.f;
    if (c < ncols) { v = W[(size_t)(k0 + kk) * ldw + scol0 + c]; if (gs) v *= gs[k0 + kk]; }
    scr[kk * 65 + c] = v; }
  LDS_WAIT(); asm volatile("" ::: "memory");
  const int c = lane & 7;
#pragma unroll
  for (int j = 0; j < 4; ++j) { const int n = (lane >> 3) + 8 * j; const LAS float* s = scr + (8 * c) * 65 + n;
    v4u o; o.x = pk2(s[0 * 65], s[1 * 65]); o.y = pk2(s[2 * 65], s[3 * 65]); o.z = pk2(s[4 * 65], s[5 * 65]); o.w = pk2(s[6 * 65], s[7 * 65]);
    *(GAS v4u*)(WT + (size_t)(drow0 + n) * ldt + k0 + 8 * c) = o; }
  LDS_WAIT(); asm volatile("" ::: "memory");
}
__device__ __forceinline__ void rms_row_to_bf16(const float* xrow, bf16* orow, int lane) {
  const GAS f32x4* xr = (const GAS f32x4*)xrow + lane;
  f32x4 v[4]; float s = 0.f;
#pragma unroll
  for (int j = 0; j < 4; ++j) { v[j] = xr[64 * j]; s += (v[j].x * v[j].x + v[j].y * v[j].y) + (v[j].z * v[j].z + v[j].w * v[j].w); }
  const float rstd = rsqrtf(wave_sum(s) * (1.f / 1024.f) + 1e-6f);
  GAS unsigned long long* o8 = (GAS unsigned long long*)orow + lane;
#pragma unroll
  for (int j = 0; j < 4; ++j) o8[64 * j] = (unsigned long long)pk2(v[j].x * rstd, v[j].y * rstd) | ((unsigned long long)pk2(v[j].z * rstd, v[j].w * rstd) << 32);
}

#ifndef FP8EMU
#define FP8EMU 0
#endif
#ifndef MOE_FP8
#define MOE_FP8 1
#endif
#ifndef CONV_NT
#define CONV_NT 0
#endif
#ifndef MOE_FP8_DOWN
#define MOE_FP8_DOWN MOE_FP8
#endif
constexpr size_t WS_PO = 384 * MiB, WS_PML = 272 * MiB;
constexpr size_t WS_XG = 96 * MiB;
constexpr size_t WS_X2Q = 208 * MiB, WS_WEGU8 = 320 * MiB, WS_WED8 = 448 * MiB, WS_HID8 = 32 * MiB;
constexpr int CW_RDY = 8192 + 64 * 44;
constexpr int CW_CONV = 8192 + 64 * 40, CW_MDONE = 8192 + 64 * 41, CW_TDONE = 8192 + 64 * 42;
constexpr int CONV_IGU = 16 * 64, CONV_ID = 32 * 16, CONV_ITEMS = NEXP * (CONV_IGU + CONV_ID), CONV_CHUNKS = CONV_ITEMS / 8;
__device__ __forceinline__ ConvDesc conv_desc(Frame& F, const Args& a, int it) {
  auto I = [&](int i) { return (const float*)a.in[i]; };
  unsigned char* ws = F.ws; ConvDesc d;
  const int e = it / (CONV_IGU + CONV_ID); int r = it % (CONV_IGU + CONV_ID);
  if (r < CONV_IGU) { const int kb = r / 64, nb = r % 64, p = nb >> 2, j0 = (nb & 3) * 64; const bool up = j0 >= 128;
    d.W = (up ? I(I_WEU) : I(I_WEG)) + (size_t)e * 1024 * 2048; d.ldw = 2048; d.k0 = 64 * kb; d.scol0 = 128 * p + (up ? j0 - 128 : j0); d.gs = I(I_GFFN); d.WT8 = ws + WS_WEGU8 + (size_t)e * 4096 * 1024; d.ldt = 1024; d.drow0 = 64 * nb; }
  else { r -= CONV_IGU; const int kb = r / 16, nb = r % 16;
    d.W = I(I_WED) + (size_t)e * 2048 * 1024; d.ldw = 1024; d.k0 = 64 * kb; d.scol0 = 64 * nb; d.gs = nullptr; d.WT8 = ws + WS_WED8 + (size_t)e * 1024 * 2048; d.ldt = 2048; d.drow0 = 64 * nb; }
  return d;
}
__device__ __forceinline__ void conv_fill(Frame& F, const Args& a, int maxpairs) {
  static_assert(MOE_FP8 && MOE_FP8_DOWN, "the conversion filler writes fp8 expert weights");
  volatile LAS int* slot = (volatile LAS int*)(F.lds + LDSCTL_OFF + 16);
  LAS float* scr = (LAS float*)(F.lds + F.wave * 16640);
  for (int n = 0; n < maxpairs; ++n) {
    if (F.tid == 0) { int got = -1;
      if (__hip_atomic_load(F.ctl + CW_CONV, RLX_AGENT) < (unsigned)CONV_CHUNKS) { const unsigned c = __hip_atomic_fetch_add(F.ctl + CW_CONV, 2u, RLX_AGENT); if (c < (unsigned)CONV_CHUNKS) got = (int)c; }
      *slot = got; }
    __syncthreads();
    const int c = __builtin_amdgcn_readfirstlane(*slot);
    __syncthreads();
    if (c < 0) break;
    const ConvDesc d0 = conv_desc(F, a, c * 8 + F.wave), d1 = conv_desc(F, a, (c + 1) * 8 + F.wave);
    f32x4 v0[16], v1[16];
    p0_tr8_load(d0, v0, F.lane); p0_tr8_load(d1, v1, F.lane);
    p0_tr8_finish(d0, v0, 64.f, scr, F.lane); p0_tr8_finish(d1, v1, 64.f, scr, F.lane);
  }
}
__device__ __forceinline__ void p0_prologue(Frame& F, const Args& a, bool do_dense, bool do_experts) {
  LAS float* scr = (LAS float*)(F.lds + F.wave * 16640);
  const int gw = F.vcu * NWAVES + F.wave, NGW = F.G * NWAVES;
  auto I = [&](int i) { return (const float*)a.in[i]; };
  unsigned char* ws = F.ws;
  if (do_dense) {
    constexpr int I_WIN_ = 16 * 40, I_WQB_ = 4 * 12, I_WKVB_ = 4 * 16, I_SQ = 16 * 16;
    constexpr int NIT = I_WIN_ + I_WQB_ + I_WKVB_ + 5 * I_SQ;
    for (int it = gw; it < NIT; it += NGW) {
      int r = it;
      if (r < I_WIN_) { const int kb = r / 40, nb = r % 40; int sc, nc = 64;
        if (nb < 32) sc = 64 * nb; else if (nb < 36) sc = OFF_CQ + 64 * (nb - 32); else if (nb < 38) sc = OFF_CKV + 64 * (nb - 36); else if (nb == 38) { sc = OFF_KR; nc = 32; } else { sc = 0; nc = 0; }
        p0_tr(I(I_WIN), D_IN, 64 * kb, 1024, sc, nc, I(I_GMIX), (bf16*)(ws + WS_WIN), 1024, 64 * nb, scr, F.lane);
        if (nb == 38) p0_tr32(I(I_WIN), D_IN, 64 * kb, OFF_G, 16, I(I_GMIX), (bf16*)(ws + WS_WIN), 1024, PC_G, scr, F.lane);
        continue; } r -= I_WIN_;
      if (r < I_WQB_) { const int kb = r / 12, nb = r % 12; p0_tr(I(I_WQB), 768, 64 * kb, 256, 64 * nb, 64, I(I_GQA), (bf16*)(ws + WS_WQB), 256, 64 * nb, scr, F.lane); continue; } r -= I_WQB_;
      if (r < I_WKVB_) { const int kb = r / 16, nb = r % 16; const int h = nb & 7; const int sc = h * 128 + (nb >= 8 ? 64 : 0);
        p0_tr(I(I_WKVB), 1024, 64 * kb, 128, sc, 64, I(I_GKVA), (bf16*)(ws + WS_WKVB), 256, 64 * nb, scr, F.lane); continue; } r -= I_WKVB_;
      const int which = r / I_SQ; r %= I_SQ; const int kb = r / 16, nb = r % 16;
      const float* src = which == 0 ? I(I_WOUT) : which == 1 ? I(I_WMQ) : which == 2 ? I(I_WMK) : which == 3 ? I(I_WMV) : I(I_WMO);
      const float* gs = which == 1 ? I(I_GMX) : (which == 2 || which == 3) ? I(I_GMKV) : nullptr;
      bf16* dst = (bf16*)(ws + (which == 0 ? WS_WOUT : which == 1 ? WS_WMQ : which == 2 ? WS_WMK : which == 3 ? WS_WMV : WS_WMO));
      p0_tr(src, 1024, 64 * kb, 1024, 64 * nb, 64, gs, dst, 1024, 64 * nb, scr, F.lane);
    }
    for (int m0 = gw; m0 < MTOK; m0 += 4 * NGW) {
      f32x4 v[4][4];
#pragma unroll
      for (int u = 0; u < 4; ++u) { const GAS f32x4* xr = (const GAS f32x4*)(I(I_X) + (size_t)(m0 + u * NGW) * 1024) + F.lane;
#pragma unroll
        for (int j = 0; j < 4; ++j) v[u][j] = __builtin_nontemporal_load(xr + 64 * j); }
#pragma unroll
      for (int u = 0; u < 4; ++u) { float s = 0.f;
#pragma unroll
        for (int j = 0; j < 4; ++j) s += (v[u][j].x * v[u][j].x + v[u][j].y * v[u][j].y) + (v[u][j].z * v[u][j].z + v[u][j].w * v[u][j].w);
        const float rstd = rsqrtf(wave_sum(s) * (1.f / 1024.f) + 1e-6f);
        GAS unsigned long long* o8 = (GAS unsigned long long*)((bf16*)(ws + WS_XN) + (size_t)(m0 + u * NGW) * 1024) + F.lane;
#pragma unroll
        for (int j = 0; j < 4; ++j) o8[64 * j] = (unsigned long long)pk2(v[u][j].x * rstd, v[u][j].y * rstd) | ((unsigned long long)pk2(v[u][j].z * rstd, v[u][j].w * rstd) << 32); } }
    for (int m = gw; m < BATCH * NMEM; m += NGW) rms_row_to_bf16(I(I_MEM) + (size_t)m * 1024, (bf16*)(ws + WS_MEMN) + (size_t)m * 1024, F.lane);
    { const float* wr = I(I_WR); const float* gf = I(I_GFFN); float* wrg = (float*)(ws + WS_DEC + 65536);
      for (int i = (F.vcu * NTHR + F.tid); i < 1024 * 16; i += F.G * NTHR) wrg[i] = wr[i] * gf[i >> 4]; }
    { const int* pos = (const int*)a.in[I_POS]; float* rt = (float*)(ws + WS_ROPE);
      for (int i = (F.vcu * NTHR + F.tid); i < MTOK * 16; i += F.G * NTHR) { const int m = i >> 4, j = i & 15; const float inv = powf(10000.f, -(float)j / 16.f); const float ang = (float)pos[m] * inv;
        rt[m * 32 + j] = cosf(ang); rt[m * 32 + 16 + j] = sinf(ang); } }
  }
  if (do_experts) conv_fill(F, a, 1 << 30);
}

__device__ __forceinline__ v4u pack8(const float (&v)[8]) { v4u w; w.x = cvt_pk_bf16(v[0], v[1]); w.y = cvt_pk_bf16(v[2], v[3]); w.z = cvt_pk_bf16(v[4], v[5]); w.w = cvt_pk_bf16(v[6], v[7]); return w; }
__device__ __forceinline__ float sumsq8(const float (&v)[8]) { float s = 0.f;
#pragma unroll
  for (int i = 0; i < 8; ++i) s += v[i] * v[i];
  return s; }
struct EpiStore { static constexpr bool TWO_PASS = false; bf16* O; int ldc;
  __device__ __forceinline__ void row8(const pg8::Unit& u, int rloc, int cloc, const float (&v0)[8], const float (&v1)[8], int fq) const {
    bf16* p = O + (size_t)(u.pm * 256 + rloc) * ldc + u.pn * 256 + cloc; *(v4u*)p = pack8(v0); *(v4u*)(p + 128) = pack8(v1); } };
struct EpiProj { static constexpr bool TWO_PASS = false; bf16* P; float* ssq; float* sskv;
  __device__ __forceinline__ void row8(const pg8::Unit& u, int rloc, int cloc, const float (&v0)[8], const float (&v1)[8], int fq) const {
    const int row = u.pm * 256 + rloc; bf16* p = P + (size_t)row * PROJ_LD + u.pn * 256 + cloc; *(v4u*)p = pack8(v0); *(v4u*)(p + 128) = pack8(v1);
    if (u.pn == 8) { float s = sumsq8(v0) + sumsq8(v1); s += __shfl_xor(s, 16); s += __shfl_xor(s, 32); if (fq == 0) unsafeAtomicAdd(ssq + row, s); }
    if (u.pn == 9) { float s = sumsq8(v0); s += __shfl_xor(s, 16); s += __shfl_xor(s, 32); if (fq == 0) unsafeAtomicAdd(sskv + row, s); } } };
struct EpiQ { static constexpr bool TWO_PASS = false; bf16* Q; const float* ssq; const float* rope;
  __device__ __forceinline__ void rope8(float (&v)[8], int row, int fq) const {
    float pv[8];
#pragma unroll
    for (int i = 0; i < 8; ++i) pv[i] = __shfl_xor(v[i], 32);
    const float* cs = rope + (size_t)row * 32 + 8 * (fq & 1);
#pragma unroll
    for (int i = 0; i < 8; ++i) { const float c = cs[i], s = cs[16 + i]; v[i] = (fq < 2) ? (v[i] * c - pv[i] * s) : (v[i] * c + pv[i] * s); }
  }
  __device__ __forceinline__ void row8(const pg8::Unit& u, int rloc, int cloc, const float (&a0)[8], const float (&a1)[8], int fq) const {
    const int row = u.pm * 256 + rloc; const float r = rsqrtf(ssq[row] * (1.f / 256.f) + 1e-6f);
    float v0[8], v1[8];
#pragma unroll
    for (int i = 0; i < 8; ++i) { v0[i] = a0[i] * r; v1[i] = a1[i] * r; }
    const int g0 = u.pn * 8 + (cloc >> 5), g1 = g0 + 4;
    if (g0 % 3 == 2) rope8(v0, row, fq);
    if (g1 % 3 == 2) rope8(v1, row, fq);
    bf16* p = Q + (size_t)row * 768 + u.pn * 256 + cloc; *(v4u*)p = pack8(v0); *(v4u*)(p + 128) = pack8(v1); } };
struct EpiKV { static constexpr bool TWO_PASS = false; bf16* KMp; bf16* VMp; const float* sskv;
  __device__ __forceinline__ void put(int row, int c, const float (&v)[8], float r) const {
    float w[8];
#pragma unroll
    for (int i = 0; i < 8; ++i) w[i] = v[i] * r;
    if (c < 512) *(v4u*)(KMp + (size_t)row * 768 + (c >> 6) * 96 + (c & 63)) = pack8(w); else *(v4u*)(VMp + (size_t)row * 512 + (c - 512)) = pack8(w); }
  __device__ __forceinline__ void row8(const pg8::Unit& u, int rloc, int cloc, const float (&a0)[8], const float (&a1)[8], int fq) const {
    const int row = u.pm * 256 + rloc; const float r = rsqrtf(sskv[row] * (1.f / 128.f) + 1e-6f);
    put(row, u.pn * 256 + cloc, a0, r); put(row, u.pn * 256 + 128 + cloc, a1, r); } };

__device__ __forceinline__ void unpack8(v4u w, float (&f)[8]) { f[0] = bflo(w.x); f[1] = bfhi(w.x); f[2] = bflo(w.y); f[3] = bfhi(w.y); f[4] = bflo(w.z); f[5] = bfhi(w.z); f[6] = bflo(w.w); f[7] = bfhi(w.w); }
__device__ __forceinline__ float log_sigmoid(float x) { return fminf(x, 0.f) - log1pf(__expf(-fabsf(x))); }

__device__ __forceinline__ void p2_elementwise(Frame& F, const Args& a) {
  unsigned char* ws = F.ws;
  const bf16* P = (const bf16*)(ws + WS_PROJ);
  { const float* cw = (const float*)a.in[I_CONV]; bf16* QC = (bf16*)(ws + WS_QC); bf16* KC = (bf16*)(ws + WS_KC);
    const int gi = F.vcu * NTHR + F.tid, c = (gi & 127) * 8, mstep = (F.G * NTHR) >> 7; float w0[8], w1[8], w2[8];
#pragma unroll
    for (int j = 0; j < 8; ++j) { w0[j] = cw[c + j]; w1[j] = cw[1024 + c + j]; w2[j] = cw[2048 + c + j]; }
    for (int m0 = gi >> 7; m0 < MTOK; m0 += 2 * mstep) {
      v4u r0[2], r1[2], r2[2];
#pragma unroll
      for (int u = 0; u < 2; ++u) { const int m = m0 + u * mstep, t = m & (SEQ - 1); const bf16* pr = P + (size_t)m * PROJ_LD + c;
        r1[u] = *(const v4u*)pr; r0[u] = t > 0 ? *(const v4u*)(pr - PROJ_LD) : (v4u){0u, 0u, 0u, 0u}; r2[u] = t < SEQ - 1 ? *(const v4u*)(pr + PROJ_LD) : (v4u){0u, 0u, 0u, 0u}; }
#pragma unroll
      for (int u = 0; u < 2; ++u) { const int m = m0 + u * mstep; float x0[8], x1[8], x2[8], o[8]; unpack8(r0[u], x0); unpack8(r1[u], x1); unpack8(r2[u], x2);
#pragma unroll
        for (int j = 0; j < 8; ++j) { float v = x0[j] * w0[j] + x1[j] * w1[j] + x2[j] * w2[j]; v = v * sigmoidf_(v); o[j] = (c < 512) ? v : v * 0.08838834764831845f; }
        if (c < 512) *(v4u*)(QC + (size_t)m * 512 + c) = pack8(o); else *(v4u*)(KC + (size_t)m * 512 + c - 512) = pack8(o); } } }
  { const float* rope = (const float*)(ws + WS_ROPE); bf16* KMp = (bf16*)(ws + WS_KM);
    for (int i = F.vcu * NTHR + F.tid; i < MTOK * 16; i += F.G * NTHR) { const int m = i >> 4, j = i & 15;
      const float t1 = bf2f(P[(size_t)m * PROJ_LD + PC_KR + j]), t2 = bf2f(P[(size_t)m * PROJ_LD + PC_KR + 16 + j]); const float c = rope[m * 32 + j], s = rope[m * 32 + 16 + j];
      const bf16 o1 = (bf16)f2bf(t1 * c - t2 * s), o2 = (bf16)f2bf(t2 * c + t1 * s);
#pragma unroll
      for (int h = 0; h < 8; ++h) { KMp[(size_t)m * 768 + h * 96 + 64 + j] = o1; KMp[(size_t)m * 768 + h * 96 + 80 + j] = o2; } } }
  { const float* bg = (const float*)a.in[I_BG]; float* GSC = (float*)(ws + WS_GSC); float* DEC = (float*)(ws + WS_DEC);
    const int gw = F.vcu * NWAVES + F.wave, NGW = F.G * NWAVES;
    for (int it = gw; it < 32 * 64; it += NGW) { const int seq = it >> 6, c = it & 63, dir = seq & 1, h = (seq >> 1) & 3, b = seq >> 3;
      const int p = c * 64 + F.lane, t = dir ? (SEQ - 1 - p) : p; const size_t row = (size_t)b * SEQ + t;
      const int gi = (dir ? 8 : 0) + h, gf = (dir ? 12 : 4) + h;
      const float li = bf2f(P[row * PROJ_LD + PC_G + gi]) + bg[gi]; const float lf = log_sigmoid(bf2f(P[row * PROJ_LD + PC_G + gf]) + bg[gf]);
      float bs = lf;
#pragma unroll
      for (int o = 1; o < 64; o <<= 1) { const float y = __shfl_up(bs, o); if (F.lane >= o) bs += y; }
      const float av = li - bs; float pm = av;
#pragma unroll
      for (int o = 1; o < 64; o <<= 1) { const float y = __shfl_up(pm, o); if (F.lane >= o) pm = fmaxf(pm, y); }
      float* gs = GSC + (size_t)seq * 3 * SEQ; gs[p] = bs; gs[SEQ + p] = av; gs[2 * SEQ + p] = pm;
      if (F.lane == 63) { DEC[seq * 128 + c] = bs; DEC[seq * 128 + 64 + c] = pm; } } }
}
namespace mla {
constexpr int DQK = 96, DV = 64, NW = 8, QBLK = 32, KVBLK = 64, LDQ = 768, LDK = 768, LDV = 512, LDO = 1024;
constexpr float SCALE = 0.10206207261596575f;
constexpr float THR = 8.f;
constexpr int SHM_V = 16384, SHM_K = 16384, SHM_ATTN = 2 * SHM_V + 2 * SHM_K + NW * 64 * 4;
#define KSWZ(row, colB) ((row) * 256 + ((colB) ^ (((row) & 7) << 4)))
#define SBAR() __builtin_amdgcn_sched_barrier(0)
__device__ __forceinline__ int crow(int r, int hi) { return (r & 3) + 8 * (r >> 2) + 4 * hi; }
__device__ __forceinline__ void partialSM(f32x16& p0, f32x16& p1, float& m_reg, float& mn, float& alpha) {
  constexpr float C = SCALE * 1.4426950408889634f;
  float pmax = p0[0];
#pragma unroll
  for (int r = 1; r < 16; ++r) pmax = fmaxf(pmax, p0[r]);
#pragma unroll
  for (int r = 0; r < 16; ++r) pmax = fmaxf(pmax, p1[r]);
  { auto rr = __builtin_amdgcn_permlane32_swap(__float_as_uint(pmax), __float_as_uint(pmax), false, false);
    pmax = fmaxf(__uint_as_float(rr[0]), __uint_as_float(rr[1])); }
  if (__builtin_expect(__all(pmax - m_reg <= THR / SCALE), 1)) { mn = m_reg; alpha = 1.f; }
  else { mn = fmaxf(m_reg, pmax); alpha = __builtin_amdgcn_exp2f((m_reg - mn) * C); m_reg = mn; }
  const float mnC = -mn * C;
#pragma unroll
  for (int r = 0; r < 16; ++r) p0[r] = fmaf(p0[r], C, mnC);
#pragma unroll
  for (int r = 0; r < 16; ++r) p1[r] = fmaf(p1[r], C, mnC);
#pragma unroll
  for (int r = 0; r < 16; ++r) p0[r] = __builtin_amdgcn_exp2f(p0[r]);
}
__device__ __forceinline__ void finishSM(f32x16& p0, f32x16& p1, float alpha, float& l_reg, bf16x8& pa0, bf16x8& pa1, bf16x8& pa2, bf16x8& pa3) {
#pragma unroll
  for (int r = 0; r < 16; ++r) p1[r] = __builtin_amdgcn_exp2f(p1[r]);
  float ps = 0;
#pragma unroll
  for (int r = 0; r < 16; ++r) ps += p0[r];
#pragma unroll
  for (int r = 0; r < 16; ++r) ps += p1[r];
  { auto rr = __builtin_amdgcn_permlane32_swap(__float_as_uint(ps), __float_as_uint(ps), false, false);
    ps = __uint_as_float(rr[0]) + __uint_as_float(rr[1]); }
  l_reg = l_reg * alpha + ps;
#define PK4(P, BASE, OUT) do { unsigned a0 = cvt_pk_bf16(P[BASE + 0], P[BASE + 1]), a1 = cvt_pk_bf16(P[BASE + 2], P[BASE + 3]);   \
    unsigned b0 = cvt_pk_bf16(P[BASE + 4], P[BASE + 5]), b1 = cvt_pk_bf16(P[BASE + 6], P[BASE + 7]);                              \
    auto r0 = __builtin_amdgcn_permlane32_swap(a0, b0, false, false); auto r1 = __builtin_amdgcn_permlane32_swap(a1, b1, false, false); \
    v4u w = {r0[0], r1[0], r0[1], r1[1]}; OUT = __builtin_bit_cast(bf16x8, w); } while (0)
  PK4(p0, 0, pa0); PK4(p0, 8, pa1); PK4(p1, 0, pa2); PK4(p1, 8, pa3);
#undef PK4
}
__device__ __forceinline__ void qkt(f32x16& p0, f32x16& p1, const char* Ks, const bf16x8* qr, int r32, int hi) {
  p0 = f32x16{}; p1 = f32x16{};
#pragma unroll
  for (int d0 = 0; d0 < DQK / 16; ++d0) { const int cb = (d0 * 16 + hi * 8) * 2;
    const bf16x8 b0 = *reinterpret_cast<const bf16x8*>(Ks + KSWZ(r32, cb));
    const bf16x8 b1 = *reinterpret_cast<const bf16x8*>(Ks + KSWZ(32 + r32, cb));
    p0 = __builtin_amdgcn_mfma_f32_32x32x16_bf16(b0, qr[d0], p0, 0, 0, 0);
    p1 = __builtin_amdgcn_mfma_f32_32x32x16_bf16(b1, qr[d0], p1, 0, 0, 0); }
}
__device__ __forceinline__ int v_st(int k, int c) { const int kk = (k & ~0xC) | ((k & 4) << 1) | ((k & 8) >> 1); return ((kk >> 3) * 4 + (c >> 5)) * 512 + ((kk & 7) * 32 + (c & 31)) * 2; }
__device__ __forceinline__ int v_rd_base(int lane) { return ((lane & 3) << 3) | (((lane >> 2) & 3) << 6) | (((lane >> 4) & 1) << 5) | (((lane >> 5) & 1) << 8); }
constexpr int v_rd_off(int d0, int ks, int half) { return d0 * 512 + ks * 4096 + half * 2048; }
template <int OFF> __device__ __forceinline__ s16x4 tr_read(int vb) {
  s16x4 r; asm volatile("ds_read_b64_tr_b16 %0, %1 offset:%2" : "=&v"(r) : "v"(vb), "i"(OFF) : "memory"); return r;
}
template <int D0> __device__ __forceinline__ void pv_one(f32x16& od, int vb, bf16x8 pa0, bf16x8 pa1, bf16x8 pa2, bf16x8 pa3) {
  const s16x4 l0 = tr_read<v_rd_off(D0, 0, 0)>(vb), h0 = tr_read<v_rd_off(D0, 0, 1)>(vb), l1 = tr_read<v_rd_off(D0, 1, 0)>(vb), h1 = tr_read<v_rd_off(D0, 1, 1)>(vb);
  const s16x4 l2 = tr_read<v_rd_off(D0, 2, 0)>(vb), h2 = tr_read<v_rd_off(D0, 2, 1)>(vb), l3 = tr_read<v_rd_off(D0, 3, 0)>(vb), h3 = tr_read<v_rd_off(D0, 3, 1)>(vb);
  asm volatile("s_waitcnt lgkmcnt(0)" ::: "memory"); SBAR();
#define PK(L, H) (bf16x8){L[0], L[1], L[2], L[3], H[0], H[1], H[2], H[3]}
  od = __builtin_amdgcn_mfma_f32_32x32x16_bf16(pa0, PK(l0, h0), od, 0, 0, 0);
  od = __builtin_amdgcn_mfma_f32_32x32x16_bf16(pa1, PK(l1, h1), od, 0, 0, 0);
  od = __builtin_amdgcn_mfma_f32_32x32x16_bf16(pa2, PK(l2, h2), od, 0, 0, 0);
  od = __builtin_amdgcn_mfma_f32_32x32x16_bf16(pa3, PK(l3, h3), od, 0, 0, 0);
#undef PK
}
__device__ __forceinline__ void pv_d0(f32x16* o, int vb, bf16x8 pa0, bf16x8 pa1, bf16x8 pa2, bf16x8 pa3) {
  pv_one<0>(o[0], vb, pa0, pa1, pa2, pa3); pv_one<1>(o[1], vb, pa0, pa1, pa2, pa3);
}
constexpr int LDP = 8 * 64, LDML = 8 * 2;
__device__ __forceinline__ void attn_unit(const bf16* __restrict__ Qb, const bf16* __restrict__ Kh, const bf16* __restrict__ Vh, bf16* __restrict__ Op, float* __restrict__ MLp, int seq, char* lds) {
  int tid = threadIdx.x; asm volatile("" : "+v"(tid));
  const int wid = tid >> 6, lane = tid & 63, r32 = lane & 31, hi = lane >> 5;
  char* V_lds = lds; char* K_lds = lds + 2 * SHM_V;
  float* wsf = (float*)(lds + 2 * SHM_V + 2 * SHM_K) + wid * 64; float* li_l = wsf; float* al_l = wsf + 32;
  float m_reg = -1e30f, l_reg = 0; f32x16 o[2] = {}; bf16x8 qr[DQK / 16];
  const bf16* Qw = Qb + (long)(wid * QBLK + r32) * LDQ + hi * 8;
#pragma unroll
  for (int d0 = 0; d0 < DQK / 16; ++d0) qr[d0] = *reinterpret_cast<const bf16x8*>(Qw + d0 * 16);
  const int sr = tid >> 4, sc = (tid & 15) * 8, vst0 = v_st(sr, sc & 63), vst1 = v_st(32 + sr, sc & 63);
  const bool doK = sc < DQK, doV = sc < DV;
  const int vb0 = (int)(uintptr_t)V_lds + v_rd_base(lane);
  struct { bf16x8 vs0, vs1, ks0, ks1; } sr_[2];
#define SLOAD(i, k0) do { if (doV) { sr_[i].vs0 = *reinterpret_cast<const bf16x8*>(&Vh[(long)((k0) + sr) * LDV + sc]); sr_[i].vs1 = *reinterpret_cast<const bf16x8*>(&Vh[(long)((k0) + 32 + sr) * LDV + sc]); } \
    if (doK) { sr_[i].ks0 = *reinterpret_cast<const bf16x8*>(&Kh[(long)((k0) + sr) * LDK + sc]); sr_[i].ks1 = *reinterpret_cast<const bf16x8*>(&Kh[(long)((k0) + 32 + sr) * LDK + sc]); } } while (0)
#define SWRITE(b, i) do { if (doV) { *(bf16x8*)(V_lds + (b) * SHM_V + vst0) = sr_[i].vs0; *(bf16x8*)(V_lds + (b) * SHM_V + vst1) = sr_[i].vs1; } \
    if (doK) { const int kc = sc * 2; *(bf16x8*)(K_lds + (b) * SHM_K + KSWZ(sr, kc)) = sr_[i].ks0; *(bf16x8*)(K_lds + (b) * SHM_K + KSWZ(32 + sr, kc)) = sr_[i].ks1; } } while (0)
#define SWAIT() asm volatile("s_waitcnt vmcnt(4)" ::: "memory")
#define RESC(a) do { if (__any((a) < 1.f)) { if (hi == 0) al_l[r32] = (a); asm volatile("s_waitcnt lgkmcnt(0)" ::: "memory"); \
    _Pragma("unroll") for (int d = 0; d < 2; ++d) _Pragma("unroll") for (int r = 0; r < 16; ++r) o[d][r] *= al_l[crow(r, hi)]; } } while (0)
  f32x16 pA0, pA1, pB0, pB1; float mnA, mnB, alA, alB; bf16x8 pa0, pa1, pa2, pa3; const int NT = seq / KVBLK;
  constexpr int SE = 0, SO = 1;
  SLOAD(SE, 0); asm volatile("s_waitcnt vmcnt(0)" ::: "memory"); SWRITE(0, SE); __syncthreads();
  qkt(pA0, pA1, K_lds, qr, r32, hi); partialSM(pA0, pA1, m_reg, mnA, alA);
  SLOAD(SO, KVBLK); if (2 < NT) SLOAD(SE, 2 * KVBLK);
  SWAIT(); SWRITE(1, SO); __syncthreads();
  for (int j = 1; j + 1 < NT; j += 2) {
    SBAR(); qkt(pB0, pB1, K_lds + SHM_K, qr, r32, hi);
    finishSM(pA0, pA1, alA, l_reg, pa0, pa1, pa2, pa3); SBAR();
    SLOAD(SO, (j + 2) * KVBLK); SBAR();
    pv_d0(o, vb0, pa0, pa1, pa2, pa3); partialSM(pB0, pB1, m_reg, mnB, alB);
    __syncthreads(); SWAIT(); SWRITE(0, SE);
    RESC(alB); __syncthreads();
    SBAR(); qkt(pA0, pA1, K_lds, qr, r32, hi);
    finishSM(pB0, pB1, alB, l_reg, pa0, pa1, pa2, pa3); SBAR();
    if (j + 3 < NT) SLOAD(SE, (j + 3) * KVBLK); SBAR();
    pv_d0(o, vb0 + SHM_V, pa0, pa1, pa2, pa3); partialSM(pA0, pA1, m_reg, mnA, alA);
    __syncthreads(); SWAIT(); SWRITE(1, SO);
    RESC(alA); __syncthreads();
  }
  SBAR(); qkt(pB0, pB1, K_lds + SHM_K, qr, r32, hi);
  finishSM(pA0, pA1, alA, l_reg, pa0, pa1, pa2, pa3); SBAR();
  pv_d0(o, vb0, pa0, pa1, pa2, pa3); partialSM(pB0, pB1, m_reg, mnB, alB);
  __syncthreads(); RESC(alB);
  finishSM(pB0, pB1, alB, l_reg, pa0, pa1, pa2, pa3); SBAR();
  pv_d0(o, vb0 + SHM_V, pa0, pa1, pa2, pa3);
  __syncthreads();
  { float* st = (float*)lds + wid * (32 * 68);
#pragma unroll
    for (int r = 0; r < 16; ++r) { const int orow = crow(r, hi); st[orow * 68 + r32] = o[0][r]; st[orow * 68 + 32 + r32] = o[1][r]; }
    asm volatile("s_waitcnt lgkmcnt(0)" ::: "memory");
    bf16* op = Op + (long)(wid * QBLK + r32) * LDP + hi * 32;
#pragma unroll
    for (int j = 0; j < 4; ++j) { const f32x4 x0 = *(const f32x4*)(st + r32 * 68 + hi * 32 + 8 * j), x1 = *(const f32x4*)(st + r32 * 68 + hi * 32 + 8 * j + 4);
      const float w[8] = {x0.x, x0.y, x0.z, x0.w, x1.x, x1.y, x1.z, x1.w}; *(v4u*)(op + 8 * j) = pack8(w); }
    if (hi == 0) { float* mp = MLp + (long)(wid * QBLK + r32) * LDML; mp[0] = m_reg; mp[1] = l_reg; } }
  __syncthreads();
#undef SLOAD
#undef SWRITE
#undef SWAIT
#undef RESC
}
#undef KSWZ
#undef SBAR
}

__device__ __forceinline__ int queue_pull(Frame& F, gu32* heads, int nq, int nper, int myq) {
  volatile LAS int* slot = (volatile LAS int*)(F.lds + LDSCTL_OFF);
  if (F.tid == 0) { int got = -1;
    for (int k = 0; k < nq; ++k) { const int q = (myq + k) % nq;
      if (__hip_atomic_load(heads + 64 * q, RLX_AGENT) >= (unsigned)nper) continue;
      const unsigned i = __hip_atomic_fetch_add(heads + 64 * q, 1u, RLX_AGENT);
      if (i < (unsigned)nper) { got = q * nper + (int)i; break; } }
    *slot = got; }
  __syncthreads();
  const int r = __builtin_amdgcn_readfirstlane(*slot);
  __syncthreads();
  return r;
}
__device__ __forceinline__ void p3_attention(Frame& F, const Args& a, char* lds_generic, unsigned xcc, int qoff) {
  unsigned char* ws = F.ws;
  const bf16* QMp = (const bf16*)(ws + WS_QM); const bf16* KMp = (const bf16*)(ws + WS_KM); const bf16* VMp = (const bf16*)(ws + WS_VM); bf16* PO = (bf16*)(ws + WS_PO); float* PML = (float*)(ws + WS_PML);
#ifndef WAIT_MODE
#define WAIT_MODE 1
#endif
  bool waited = false; (void)waited;
  for (;;) {
    const int u = queue_pull(F, F.ctl + CW_Q + qoff, 8, 128, (int)(xcc & 7u));
    if (u < 0) break;
    const int bh = u >> 5, qb = (u >> 1) & 15, kh = u & 1, b = bh >> 3, h = bh & 7;
#if WAIT_MODE == 0
    if (F.tid == 0) { unsigned sp = 0;
      while (__hip_atomic_load(F.ctl + CW_RDY + 64 * b, RLX_AGENT) < 112u) { __builtin_amdgcn_s_sleep(2); if (++sp > (1u << 24)) break; }
      __builtin_amdgcn_fence(__ATOMIC_ACQUIRE, "agent"); }
    asm volatile("s_waitcnt vmcnt(0)" ::: "memory"); __syncthreads();
#else
    if (!waited) { waited = true;
      if (F.tid == 0) { unsigned sp = 0;
        for (int bb = 0; bb < 4; ++bb) while (__hip_atomic_load(F.ctl + CW_RDY + 64 * bb, RLX_AGENT) < 112u) { __builtin_amdgcn_s_sleep(2); if (++sp > (1u << 24)) break; }
        __builtin_amdgcn_fence(__ATOMIC_ACQUIRE, "agent"); }
      asm volatile("s_waitcnt vmcnt(0)" ::: "memory"); __syncthreads(); }
#endif
    const size_t row0 = (size_t)b * SEQ + qb * 256, key0 = (size_t)b * SEQ + kh * (SEQ / 2);
    mla::attn_unit(QMp + row0 * 768 + h * 96, KMp + key0 * 768 + h * 96, VMp + key0 * 512 + h * 64,
                   PO + ((size_t)kh * MTOK + row0) * 512 + h * 64, PML + ((size_t)kh * MTOK + row0) * 16 + h * 2, SEQ / 2, lds_generic);
  }
}
namespace mls {
using mla::crow; using mla::v_st; using mla::v_rd_base;
#define KSWZ(row, colB) ((row) * 256 + ((colB) ^ (((row) & 7) << 4)))
constexpr int OFF_QS = 0, OFF_KS = 16384, OFF_KP = 32768, OFF_VV = 49152, OFF_CT = 65536, OFF_SC = 98304, OFF_NB = 99328, OFF_NP = 100352, OFF_CH = 104448, OFF_WS = 105472;
template <int OFF> __device__ __forceinline__ s16x4 trr(int vb) { s16x4 r; asm volatile("ds_read_b64_tr_b16 %0, %1 offset:%2" : "=&v"(r) : "v"(vb), "i"(OFF) : "memory"); return r; }
#define PKF(L, H) (bf16x8){L[0], L[1], L[2], L[3], H[0], H[1], H[2], H[3]}
__device__ __forceinline__ void vfrags(int img, int d0, int lane, bf16x8 (&f)[4]) {
  const int vb = img + v_rd_base(lane) + d0 * 512;
  const s16x4 l0 = trr<0>(vb), h0 = trr<2048>(vb), l1 = trr<4096>(vb), h1 = trr<4096 + 2048>(vb), l2 = trr<8192>(vb), h2 = trr<8192 + 2048>(vb), l3 = trr<12288>(vb), h3 = trr<12288 + 2048>(vb);
  asm volatile("s_waitcnt lgkmcnt(0)" ::: "memory"); __builtin_amdgcn_sched_barrier(0);
  f[0] = PKF(l0, h0); f[1] = PKF(l1, h1); f[2] = PKF(l2, h2); f[3] = PKF(l3, h3);
}
__device__ __forceinline__ void pack_p(const f32x16& p0, const f32x16& p1, bf16x8& pa0, bf16x8& pa1, bf16x8& pa2, bf16x8& pa3) {
#define PK4(P, BASE, OUT) do { unsigned a0 = cvt_pk_bf16(P[BASE + 0], P[BASE + 1]), a1 = cvt_pk_bf16(P[BASE + 2], P[BASE + 3]);   \
    unsigned b0 = cvt_pk_bf16(P[BASE + 4], P[BASE + 5]), b1 = cvt_pk_bf16(P[BASE + 6], P[BASE + 7]);                              \
    auto r0 = __builtin_amdgcn_permlane32_swap(a0, b0, false, false); auto r1 = __builtin_amdgcn_permlane32_swap(a1, b1, false, false); \
    v4u w = {r0[0], r1[0], r0[1], r1[1]}; OUT = __builtin_bit_cast(bf16x8, w); } while (0)
  PK4(p0, 0, pa0); PK4(p0, 8, pa1); PK4(p1, 0, pa2); PK4(p1, 8, pa3);
#undef PK4
}
__device__ __forceinline__ float swap_add(float v) { auto rr = __builtin_amdgcn_permlane32_swap(__float_as_uint(v), __float_as_uint(v), false, false); return __uint_as_float(rr[0]) + __uint_as_float(rr[1]); }

__device__ __forceinline__ void mlstm_seq(int seq, unsigned char* ws, char* lds) {
  int tid = threadIdx.x; asm volatile("" : "+v"(tid));
  const int wid = __builtin_amdgcn_readfirstlane(tid >> 6), lane = tid & 63, r32 = lane & 31, hi = lane >> 5, rb = wid >> 2, cb = wid & 3;
  const int dir = seq & 1, h = (seq >> 1) & 3, b = seq >> 3;
  const bf16* QC = (const bf16*)(ws + WS_QC); const bf16* KC = (const bf16*)(ws + WS_KC); const bf16* P = (const bf16*)(ws + WS_PROJ);
  const float* gs = (const float*)(ws + WS_GSC) + (size_t)seq * 3 * SEQ; const float* dec = (const float*)(ws + WS_DEC) + seq * 128;
  bf16* H = (bf16*)(ws + (dir ? WS_HB : WS_HF));
  float* sc_alpha = (float*)(lds + OFF_SC); float* sc_a = sc_alpha + 64; float* sc_iw = sc_alpha + 128; float* sc_en = sc_alpha + 192;
  float* nbuf = (float*)(lds + OFF_NB); float* npart = (float*)(lds + OFF_NP);
  float* ch_mprev = (float*)(lds + OFF_CH); float* ch_mnew = ch_mprev + 64; float* ch_dec = ch_mprev + 128; float* ch_g = ch_mprev + 192;
  float* wsf = (float*)(lds + OFF_WS) + wid * 32;
  const int ldsb = (int)(uintptr_t)lds;
  if (tid < 64) {
    if (tid == 0) { float m = 0.f; for (int c = 0; c < 64; ++c) { const float g = dec[c], wm = dec[64 + c]; const float mn = fmaxf(g + m, g + wm); ch_mprev[c] = m; ch_mnew[c] = mn; ch_dec[c] = __expf(g + m - mn); ch_g[c] = g; m = mn; } } }
  for (int i = tid; i < 32768 / 16; i += NTHR) ((v4u*)(lds + OFF_CT))[i] = (v4u){0u, 0u, 0u, 0u};
  if (tid < 128) nbuf[tid] = 0.f;
  f32x16 cacc[3]; cacc[0] = f32x16{}; cacc[1] = f32x16{}; cacc[2] = f32x16{};
  const int nown = rb ? 1 : 3;
  __syncthreads();
  const int sr = tid >> 4, sc = (tid & 15) * 8;
  v4u gq0, gq1, gk0, gk1, gv0, gv1; float ga0, ga1, sb = 0.f, sa = 0.f, spm = 0.f;
#define ROWOF(p) ((size_t)b * SEQ + (dir ? (SEQ - 1 - (p)) : (p)))
#define LOADC(c) do { const int p0_ = 64 * (c) + sr, p1_ = p0_ + 32; const size_t r0_ = ROWOF(p0_), r1_ = ROWOF(p1_); \
    gq0 = *(const v4u*)(QC + r0_ * 512 + h * 128 + sc); gq1 = *(const v4u*)(QC + r1_ * 512 + h * 128 + sc); \
    gk0 = *(const v4u*)(KC + r0_ * 512 + h * 128 + sc); gk1 = *(const v4u*)(KC + r1_ * 512 + h * 128 + sc); \
    gv0 = *(const v4u*)(P + r0_ * PROJ_LD + 1024 + h * 128 + sc); gv1 = *(const v4u*)(P + r1_ * PROJ_LD + 1024 + h * 128 + sc); \
    ga0 = gs[SEQ + p0_]; ga1 = gs[SEQ + p1_]; \
    if (tid < 64) { sb = gs[64 * (c) + tid]; sa = gs[SEQ + 64 * (c) + tid]; spm = gs[2 * SEQ + 64 * (c) + tid]; } } while (0)
#define WRITEC(c) do { \
    *(v4u*)(lds + OFF_QS + KSWZ(sr, sc * 2)) = gq0; *(v4u*)(lds + OFF_QS + KSWZ(32 + sr, sc * 2)) = gq1; \
    *(v4u*)(lds + OFF_KS + KSWZ(sr, sc * 2)) = gk0; *(v4u*)(lds + OFF_KS + KSWZ(32 + sr, sc * 2)) = gk1; \
    *(v4u*)(lds + OFF_VV + v_st(sr, sc)) = gv0; *(v4u*)(lds + OFF_VV + v_st(32 + sr, sc)) = gv1; \
    { const float gc_ = ch_g[c], mn_ = ch_mnew[c]; const float w0_ = __expf(gc_ + ga0 - mn_), w1_ = __expf(gc_ + ga1 - mn_); float f0_[8], f1_[8], cs_[8]; unpack8(gk0, f0_); unpack8(gk1, f1_); \
      _Pragma("unroll") for (int j = 0; j < 8; ++j) { f0_[j] *= w0_; f1_[j] *= w1_; cs_[j] = f0_[j] + f1_[j]; } \
      *(v4u*)(lds + OFF_KP + v_st(sr, sc)) = pack8(f0_); *(v4u*)(lds + OFF_KP + v_st(32 + sr, sc)) = pack8(f1_); \
      _Pragma("unroll") for (int j = 0; j < 8; ++j) { cs_[j] += __shfl_xor(cs_[j], 16); cs_[j] += __shfl_xor(cs_[j], 32); } \
      if ((lane >> 4) == 0) { _Pragma("unroll") for (int j = 0; j < 8; ++j) npart[wid * 128 + sc + j] = cs_[j]; } } \
    if (tid < 64) { const float m_ = ch_mprev[c]; const float mt_ = fmaxf(sb + m_, sb + spm); sc_alpha[tid] = sb - mt_; sc_a[tid] = sa; sc_iw[tid] = __expf(sb + m_ - mt_); sc_en[tid] = __expf(-mt_); } } while (0)
  LOADC(0); WRITEC(0);
  __syncthreads();
  for (int c = 0; c < 64; ++c) {
    if (c + 1 < 64) LOADC(c + 1);
    const float* nb = nbuf + (c & 1) * 128;
    if (tid < 128) { float s = 0.f;
#pragma unroll
      for (int w = 0; w < 8; ++w) s += npart[w * 128 + tid];
      nbuf[((c + 1) & 1) * 128 + tid] = ch_dec[c] * nb[tid] + s; }
    bf16x8 qr[8];
#pragma unroll
    for (int d0 = 0; d0 < 8; ++d0) qr[d0] = *(const bf16x8*)(lds + OFF_QS + KSWZ(32 * rb + r32, (16 * d0 + 8 * hi) * 2));
    f32x16 p0 = f32x16{}, p1 = f32x16{};
#pragma unroll
    for (int d0 = 0; d0 < 8; ++d0) { const bf16x8 k0 = *(const bf16x8*)(lds + OFF_KS + KSWZ(r32, (16 * d0 + 8 * hi) * 2)); p0 = __builtin_amdgcn_mfma_f32_32x32x16_bf16(k0, qr[d0], p0, 0, 0, 0); }
    if (rb == 1) {
#pragma unroll
      for (int d0 = 0; d0 < 8; ++d0) { const bf16x8 k1 = *(const bf16x8*)(lds + OFF_KS + KSWZ(32 + r32, (16 * d0 + 8 * hi) * 2)); p1 = __builtin_amdgcn_mfma_f32_32x32x16_bf16(k1, qr[d0], p1, 0, 0, 0); }
    }
    const float al = sc_alpha[32 * rb + r32];
    if (rb == 0) {
#pragma unroll
      for (int r = 0; r < 16; ++r) { const int sl = crow(r, hi); p0[r] = (sl <= r32) ? __expf(al + sc_a[sl]) * p0[r] : 0.f; }
    } else {
#pragma unroll
      for (int r = 0; r < 16; ++r) { const int sl = crow(r, hi); p0[r] = __expf(al + sc_a[sl]) * p0[r]; p1[r] = (sl <= r32) ? __expf(al + sc_a[32 + sl]) * p1[r] : 0.f; }
    }
    float ps = 0.f;
#pragma unroll
    for (int r = 0; r < 16; ++r) ps += p0[r] + p1[r];
    ps = swap_add(ps);
    bf16x8 pa0, pa1, pa2, pa3; pack_p(p0, p1, pa0, pa1, pa2, pa3);
    float qn = 0.f;
#pragma unroll
    for (int d0 = 0; d0 < 8; ++d0) { const f32x4 n0 = *(const f32x4*)(nb + 16 * d0 + 8 * hi), n1 = *(const f32x4*)(nb + 16 * d0 + 8 * hi + 4); const v4u qw = __builtin_bit_cast(v4u, qr[d0]);
      qn += bflo(qw.x) * n0.x + bfhi(qw.x) * n0.y + bflo(qw.y) * n0.z + bfhi(qw.y) * n0.w + bflo(qw.z) * n1.x + bfhi(qw.z) * n1.y + bflo(qw.w) * n1.z + bfhi(qw.w) * n1.w; }
    qn = swap_add(qn);
    { const float iwt = sc_iw[32 * rb + r32]; const float den = iwt * qn + ps; const float rd = 1.f / fmaxf(fabsf(den), sc_en[32 * rb + r32]); if (hi == 0) wsf[r32] = rd; }
    f32x16 o = f32x16{};
#pragma unroll
    for (int d0 = 0; d0 < 8; ++d0) { const bf16x8 cf = *(const bf16x8*)(lds + OFF_CT + KSWZ(32 * cb + r32, (16 * d0 + 8 * hi) * 2)); o = __builtin_amdgcn_mfma_f32_32x32x16_bf16(qr[d0], cf, o, 0, 0, 0); }
#pragma unroll
    for (int r = 0; r < 16; ++r) o[r] *= sc_iw[32 * rb + crow(r, hi)];
    bf16x8 vf[4]; vfrags(ldsb + OFF_VV, cb, lane, vf);
    o = __builtin_amdgcn_mfma_f32_32x32x16_bf16(pa0, vf[0], o, 0, 0, 0); o = __builtin_amdgcn_mfma_f32_32x32x16_bf16(pa1, vf[1], o, 0, 0, 0);
    if (rb == 1) { o = __builtin_amdgcn_mfma_f32_32x32x16_bf16(pa2, vf[2], o, 0, 0, 0); o = __builtin_amdgcn_mfma_f32_32x32x16_bf16(pa3, vf[3], o, 0, 0, 0); }
    asm volatile("s_waitcnt lgkmcnt(0)" ::: "memory");
#pragma unroll
    for (int r = 0; r < 16; ++r) { const int tl = crow(r, hi); const int p = 64 * c + 32 * rb + tl; H[ROWOF(p) * 512 + h * 128 + 32 * cb + r32] = (bf16)f2bf(o[r] * wsf[tl]); }
    { const float dc = ch_dec[c];
#pragma unroll
      for (int i = 0; i < 3; ++i) if (i < nown) { const int db = rb ? 3 : i; bf16x8 kf[4]; vfrags(ldsb + OFF_KP, db, lane, kf);
#pragma unroll
        for (int r = 0; r < 16; ++r) cacc[i][r] *= dc;
#pragma unroll
        for (int ks = 0; ks < 4; ++ks) cacc[i] = __builtin_amdgcn_mfma_f32_32x32x16_bf16(kf[ks], vf[ks], cacc[i], 0, 0, 0); } }
    __syncthreads();
#pragma unroll
    for (int i = 0; i < 3; ++i) if (i < nown) {
#pragma unroll
      for (int g = 0; g < 4; ++g) { const int d = 32 * (rb ? 3 : i) + 8 * g + 4 * hi, e = 32 * cb + r32;
        v2u w; w.x = cvt_pk_bf16(cacc[i][4 * g], cacc[i][4 * g + 1]); w.y = cvt_pk_bf16(cacc[i][4 * g + 2], cacc[i][4 * g + 3]);
        *(v2u*)(lds + OFF_CT + KSWZ(e, d * 2)) = w; } }
    if (c + 1 < 64) WRITEC(c + 1);
    __syncthreads();
  }
#undef ROWOF
#undef LOADC
#undef WRITEC
}
#undef KSWZ
#undef PKF
}

struct ListOrder { int n, L0, L1, nN, lda, ldb;
  __device__ bool next(int i, pg8::Unit& u) const { if (i >= n) return false; const int L = i ? L1 : L0; u.pm = L / nN; u.pn = L % nN; u.g = 0; u.ibase = 0;
    u.aoff = (long)u.pm * 256 * lda; u.boff = (long)u.pn * 256 * ldb; return true; } };
__device__ __forceinline__ void publish_units(Frame& F, const ListOrder& S) {
  if (F.tid == 0) { __builtin_amdgcn_fence(__ATOMIC_RELEASE, "agent"); asm volatile("s_waitcnt vmcnt(0)" ::: "memory");
    for (int i = 0; i < S.n; ++i) { const int L = i ? S.L1 : S.L0; __hip_atomic_fetch_add(F.ctl + CW_RDY + 64 * ((L / S.nN) >> 4), 1u, RLX_AGENT); } }
}
#ifndef P3_FILL_CHUNKS
#define P3_FILL_CHUNKS 3
#endif
__device__ __forceinline__ void p3_mixers(Frame& F, const Args& a, char* lds_generic, unsigned xcc, float* ssq, float* sskv, int qoff) {
  unsigned char* ws = F.ws; const int bx = (int)blockIdx.x;
#ifndef MLSTM_REPS
#define MLSTM_REPS 1
#endif
  if (bx < 32) { for (int rp = 0; rp < MLSTM_REPS; ++rp) { mls::mlstm_seq(bx, F.ws, lds_generic); __syncthreads(); } }
  else { const int c = bx - 32;
    { ListOrder S{c < 192 ? 1 : 0, c, 0, 3, PROJ_LD, 256};
      pg8::Gemm g{(const bf16*)(ws + WS_PROJ) + PC_CQ, (const bf16*)(ws + WS_WQB), PROJ_LD, 256, 256, nullptr, 127, 127};
      EpiQ E{(bf16*)(ws + WS_QM), ssq, (const float*)(ws + WS_ROPE)};
      pg8::gemm_phase<EpiQ, ListOrder, false>(F.lds, g, S, E); publish_units(F, S); }
    { ListOrder S{c >= 192 ? 2 : 1, c >= 192 ? c - 192 : c + 32, c + 32, 4, PROJ_LD, 256};
      pg8::Gemm g{(const bf16*)(ws + WS_PROJ) + PC_CKV, (const bf16*)(ws + WS_WKVB), PROJ_LD, 256, 256, nullptr, 127, 127};
      EpiKV E{(bf16*)(ws + WS_KM), (bf16*)(ws + WS_VM), sskv};
      pg8::gemm_phase<EpiKV, ListOrder, false>(F.lds, g, S, E); publish_units(F, S); }
  }
  p3_attention(F, a, lds_generic, xcc, qoff);
  if (bx >= 32 && !qoff) conv_fill(F, a, P3_FILL_CHUNKS);
}
__device__ __forceinline__ void p4_combine(Frame& F, const Args& a) {
  unsigned char* ws = F.ws; const bf16* HF = (const bf16*)(ws + WS_HF); const bf16* HB = (const bf16*)(ws + WS_HB); const bf16* P = (const bf16*)(ws + WS_PROJ); bf16* Y = (bf16*)(ws + WS_Y);
  const float* g = (const float*)a.in[I_GHM];
  const int gw = F.vcu * NWAVES + F.wave, NGW = F.G * NWAVES, c = F.lane * 8;
  float gg[8];
#pragma unroll
  for (int j = 0; j < 8; ++j) gg[j] = g[c + j];
  for (int m0 = gw; m0 < MTOK; m0 += 2 * NGW) {
    v4u wf[2], wb[2], wo[2];
#pragma unroll
    for (int u = 0; u < 2; ++u) { const size_t m = (size_t)(m0 + u * NGW); wf[u] = *(const v4u*)(HF + m * 512 + c); wb[u] = *(const v4u*)(HB + m * 512 + c); wo[u] = *(const v4u*)(P + m * PROJ_LD + 1536 + c); }
#pragma unroll
    for (int u = 0; u < 2; ++u) { const size_t m = (size_t)(m0 + u * NGW);
      float f[8], bb[8], oo[8]; unpack8(wf[u], f); unpack8(wb[u], bb); unpack8(wo[u], oo);
      float s = 0.f;
#pragma unroll
      for (int j = 0; j < 8; ++j) { f[j] += bb[j]; s += f[j] * f[j]; }
      s += __shfl_xor(s, 1); s += __shfl_xor(s, 2); s += __shfl_xor(s, 4); s += __shfl_xor(s, 8);
      const float r = rsqrtf(s * (1.f / 128.f) + 1e-6f);
#pragma unroll
      for (int j = 0; j < 8; ++j) f[j] = f[j] * r * gg[j] * sigmoidf_(oo[j]);
      *(v4u*)(Y + m * 1024 + c) = pack8(f); }
  }
  { const bf16* PO = (const bf16*)(ws + WS_PO); const float* PML = (const float*)(ws + WS_PML); const float* ga = (const float*)a.in[I_GHA];
    constexpr float C = 0.10206207261596575f * 1.4426950408889634f; const int hh = F.lane >> 3;
    float g8[8];
#pragma unroll
    for (int j = 0; j < 8; ++j) g8[j] = ga[c + j];
    for (int m = gw; m < MTOK; m += NGW) {
      float pa[8], pb[8]; unpack8(*(const v4u*)(PO + (size_t)m * 512 + c), pa); unpack8(*(const v4u*)(PO + ((size_t)MTOK + m) * 512 + c), pb);
      const float m0 = PML[(size_t)m * 16 + hh * 2], l0 = PML[(size_t)m * 16 + hh * 2 + 1], m1 = PML[((size_t)MTOK + m) * 16 + hh * 2], l1 = PML[((size_t)MTOK + m) * 16 + hh * 2 + 1];
      const float M = fmaxf(m0, m1), e0 = __builtin_amdgcn_exp2f((m0 - M) * C), e1 = __builtin_amdgcn_exp2f((m1 - M) * C); const float rl = 1.f / (l0 * e0 + l1 * e1);
      float f[8];
#pragma unroll
      for (int j = 0; j < 8; ++j) f[j] = pa[j] * e0 + pb[j] * e1;
      float s = 0.f;
#pragma unroll
      for (int j = 0; j < 8; ++j) { f[j] *= rl; s += f[j] * f[j]; }
      s += __shfl_xor(s, 1); s += __shfl_xor(s, 2); s += __shfl_xor(s, 4);
      const float r = rsqrtf(s * (1.f / 64.f) + 1e-6f);
#pragma unroll
      for (int j = 0; j < 8; ++j) f[j] = f[j] * r * g8[j];
      *(v4u*)(Y + (size_t)m * 1024 + 512 + c) = pack8(f); } }
}
template <int MODE> struct EpiResid { static constexpr bool TWO_PASS = false; const float* basef; const bf16* baseb; float* out; bf16* outb; float* ss;
  __device__ __forceinline__ void row8(const pg8::Unit& u, int rloc, int cloc, const float (&a0)[8], const float (&a1)[8], int fq) const {
    const int row = u.pm * 256 + rloc; const size_t off = (size_t)row * 1024 + u.pn * 256 + cloc;
    float v0[8], v1[8];
    if constexpr (MODE == 0) {
      const f32x4 b0 = *(const f32x4*)(basef + off), b1 = *(const f32x4*)(basef + off + 4), b2 = *(const f32x4*)(basef + off + 128), b3 = *(const f32x4*)(basef + off + 132);
#pragma unroll
      for (int i = 0; i < 4; ++i) { v0[i] = a0[i] + b0[i]; v0[4 + i] = a0[4 + i] + b1[i]; v1[i] = a1[i] + b2[i]; v1[4 + i] = a1[4 + i] + b3[i]; }
      *(v4u*)(outb + off) = pack8(v0); *(v4u*)(outb + off + 128) = pack8(v1);
    } else {
      float r0[8], r1[8]; unpack8(*(const v4u*)(baseb + off), r0); unpack8(*(const v4u*)(baseb + off + 128), r1);
#pragma unroll
      for (int i = 0; i < 8; ++i) { v0[i] = a0[i] + r0[i]; v1[i] = a1[i] + r1[i]; }
      *(v4u*)(outb + off) = pack8(v0); *(v4u*)(outb + off + 128) = pack8(v1);
      if (out) { *(f32x4*)(out + off) = (f32x4){v0[0], v0[1], v0[2], v0[3]}; *(f32x4*)(out + off + 4) = (f32x4){v0[4], v0[5], v0[6], v0[7]};
        *(f32x4*)(out + off + 128) = (f32x4){v1[0], v1[1], v1[2], v1[3]}; *(f32x4*)(out + off + 132) = (f32x4){v1[4], v1[5], v1[6], v1[7]}; }
    }
    float s = sumsq8(v0) + sumsq8(v1); s += __shfl_xor(s, 16); s += __shfl_xor(s, 32); if (fq == 0) unsafeAtomicAdd(ss + row, s); } };
struct EpiScale { static constexpr bool TWO_PASS = false; bf16* O; const float* ss;
  __device__ __forceinline__ void row8(const pg8::Unit& u, int rloc, int cloc, const float (&a0)[8], const float (&a1)[8], int fq) const {
    const int row = u.pm * 256 + rloc; const float r = rsqrtf(ss[row] * (1.f / 1024.f) + 1e-6f); float v0[8], v1[8];
#pragma unroll
    for (int i = 0; i < 8; ++i) { v0[i] = a0[i] * r; v1[i] = a1[i] * r; }
    bf16* p = O + (size_t)row * 1024 + u.pn * 256 + cloc; *(v4u*)p = pack8(v0); *(v4u*)(p + 128) = pack8(v1); } };
struct EpiSoftmax { static constexpr bool TWO_PASS = true; bf16* O; float scale; LAS float* xch;
  __device__ __forceinline__ void pass1(const pg8::Unit& u, int rloc, int wc, float (&v0)[8], float (&v1)[8], int fq) const {
    float mx = -3.0e38f;
#pragma unroll
    for (int i = 0; i < 8; ++i) { v0[i] *= scale; v1[i] *= scale; mx = fmaxf(mx, fmaxf(v0[i], v1[i])); }
    mx = fmaxf(mx, __shfl_xor(mx, 16)); mx = fmaxf(mx, __shfl_xor(mx, 32));
    float l = 0.f;
#pragma unroll
    for (int i = 0; i < 8; ++i) { v0[i] = __expf(v0[i] - mx); v1[i] = __expf(v1[i] - mx); l += v0[i] + v1[i]; }
    l += __shfl_xor(l, 16); l += __shfl_xor(l, 32);
    if (fq == 0) { xch[(rloc * 4 + wc) * 2] = mx; xch[(rloc * 4 + wc) * 2 + 1] = l; } }
  __device__ __forceinline__ void row8(const pg8::Unit& u, int rloc, int cloc, const float (&a0)[8], const float (&a1)[8], int fq) const {
    const int wc = cloc >> 5; float m[4], l[4]; float M = -3.0e38f;
#pragma unroll
    for (int w = 0; w < 4; ++w) { m[w] = xch[(rloc * 4 + w) * 2]; l[w] = xch[(rloc * 4 + w) * 2 + 1]; M = fmaxf(M, m[w]); }
    float L = 0.f, mine = 0.f;
#pragma unroll
    for (int w = 0; w < 4; ++w) { const float e = __expf(m[w] - M); L += l[w] * e; if (w == wc) mine = e; }
    const float f = mine / L; float v0[8], v1[8];
#pragma unroll
    for (int i = 0; i < 8; ++i) { v0[i] = a0[i] * f; v1[i] = a1[i] * f; }
    bf16* p = O + (size_t)(u.pm * 256 + rloc) * 1024 + u.pn * 256 + cloc; *(v4u*)p = pack8(v0); *(v4u*)(p + 128) = pack8(v1); } };
struct MemOrder { int G, c, kind;
  __device__ bool next(int i, pg8::Unit& u) const { const int L = i * G + c; if (L >= 256) return false;
    const int bh = L >> 4, t = L & 15, b = bh >> 2, h = bh & 3;
    u.pm = b * 16 + t; u.pn = h; u.g = 0; u.ibase = 0; u.aoff = ((long)(b * SEQ + t * 256)) * 1024 + (kind == 2 ? 0 : h * 256);
    u.boff = kind == 0 ? ((long)(b * NMEM)) * 1024 + h * 256 : kind == 1 ? ((long)(h * 256)) * 1024 + b * NMEM : ((long)(h * 256)) * 1024; return true; } };
constexpr size_t WS_WRG = WS_DEC + 65536;
constexpr size_t WS_ROWSEL = WS_SEL, WS_GSEL = WS_SEL + 131072, WS_INV = 31 * MiB, WS_YE = 160 * MiB;
typedef float f32x4m __attribute__((ext_vector_type(4)));
__device__ __forceinline__ void p10_router(Frame& F, const Args& a) {
  unsigned char* ws = F.ws; const bf16* X2 = (const bf16*)(ws + WS_X2); const float* ss2 = (const float*)(ws + CTL_SS2); float* AFF = (float*)(ws + WS_AFF); const float* WRG = (const float*)(ws + WS_WRG);
  const int gw = F.vcu * NWAVES + F.wave, NGW = F.G * NWAVES, r = F.lane & 15, kq = F.lane >> 4;
  LAS float* wl = (LAS float*)F.lds;
  for (int i = F.tid; i < 4096; i += NTHR) ((LAS f32x4*)wl)[i] = ((const f32x4*)WRG)[i];
  __syncthreads();
  for (int it = gw; it < MTOK / 16; it += NGW) { const int m0 = it * 16;
    const bf16* xp = X2 + (size_t)(m0 + r) * 1024 + 4 * kq; const LAS float* wp = wl + (4 * kq) * 16 + r;
    f32x4m acc0 = {0.f, 0.f, 0.f, 0.f}, acc1 = {0.f, 0.f, 0.f, 0.f};
#pragma unroll 1
    for (int hf = 0; hf < 2; ++hf) {
      f32x4 xv[32];
#pragma unroll
      for (int j = 0; j < 32; ++j) {
#if X2MODE >= 1 && X2MODE != 3
        xv[j] = *(const f32x4*)((const float*)(ws + WS_X2F) + (size_t)(m0 + r) * 1024 + 4 * kq + 16 * (32 * hf + j));
#else
        const v2u w = *(const v2u*)(xp + 16 * (32 * hf + j)); xv[j] = (f32x4){bflo(w.x), bfhi(w.x), bflo(w.y), bfhi(w.y)};
#endif
      }
#pragma unroll
      for (int j = 0; j < 32; j += 2) { const LAS float* w0 = wp + (16 * (32 * hf + j)) * 16; const LAS float* w1 = w0 + 256;
        acc0 = __builtin_amdgcn_mfma_f32_16x16x4f32(xv[j].x, w0[0], acc0, 0, 0, 0); acc1 = __builtin_amdgcn_mfma_f32_16x16x4f32(xv[j + 1].x, w1[0], acc1, 0, 0, 0);
        acc0 = __builtin_amdgcn_mfma_f32_16x16x4f32(xv[j].y, w0[16], acc0, 0, 0, 0); acc1 = __builtin_amdgcn_mfma_f32_16x16x4f32(xv[j + 1].y, w1[16], acc1, 0, 0, 0);
        acc0 = __builtin_amdgcn_mfma_f32_16x16x4f32(xv[j].z, w0[32], acc0, 0, 0, 0); acc1 = __builtin_amdgcn_mfma_f32_16x16x4f32(xv[j + 1].z, w1[32], acc1, 0, 0, 0);
        acc0 = __builtin_amdgcn_mfma_f32_16x16x4f32(xv[j].w, w0[48], acc0, 0, 0, 0); acc1 = __builtin_amdgcn_mfma_f32_16x16x4f32(xv[j + 1].w, w1[48], acc1, 0, 0, 0); }
    }
#pragma unroll
    for (int i = 0; i < 4; ++i) { const int row = m0 + 4 * kq + i; const float lg = (acc0[i] + acc1[i]) * rsqrtf(ss2[row] * (1.f / 1024.f) + 1e-6f);
      float mx = lg; mx = fmaxf(mx, __shfl_xor(mx, 1)); mx = fmaxf(mx, __shfl_xor(mx, 2)); mx = fmaxf(mx, __shfl_xor(mx, 4)); mx = fmaxf(mx, __shfl_xor(mx, 8));
      const float ex = __expf(lg - mx); float l = ex; l += __shfl_xor(l, 1); l += __shfl_xor(l, 2); l += __shfl_xor(l, 4); l += __shfl_xor(l, 8);
      AFF[(size_t)row * 16 + r] = ex / l; }
  }
  __syncthreads();
}
__device__ __forceinline__ void p11_topk(Frame& F, char* lds) {
  unsigned char* ws = F.ws; const float* AFF = (const float*)(ws + WS_AFF); int* ROWSEL = (int*)(ws + WS_ROWSEL); float* GSEL = (float*)(ws + WS_GSEL); int* INV = (int*)(ws + WS_INV);
  unsigned* hist = (unsigned*)lds; unsigned* ctl = hist + 256; unsigned* wsum = hist + 320;
  const int tid = F.tid, lane = F.lane, wid = F.wave;
  for (int it = (int)blockIdx.x; it < BATCH * NEXP; it += F.G) { const int b = it >> 4, e = it & 15;
    unsigned key[8];
#pragma unroll
    for (int j = 0; j < 8; ++j) key[j] = __float_as_uint(AFF[((size_t)b * SEQ + 8 * tid + j) * 16 + e]);
    unsigned prefix = 0u, mask = 0u, need = CAP;
    for (int shift = 24; shift >= 0; shift -= 8) {
      if (tid < 256) hist[tid] = 0u;
      __syncthreads();
#pragma unroll
      for (int j = 0; j < 8; ++j) if ((key[j] & mask) == prefix) atomicAdd(&hist[(key[j] >> shift) & 255u], 1u);
      __syncthreads();
      if (tid == 0) { unsigned above = 0u; int d = 255; for (; d > 0; --d) { const unsigned c = hist[d]; if (above + c >= need) break; above += c; } ctl[0] = (unsigned)d; ctl[1] = need - above; }
      __syncthreads();
      prefix |= ctl[0] << shift; mask |= 255u << shift; need = ctl[1];
      __syncthreads();
    }
    unsigned ngt = 0u, neq = 0u;
#pragma unroll
    for (int j = 0; j < 8; ++j) { ngt += key[j] > prefix ? 1u : 0u; neq += key[j] == prefix ? 1u : 0u; }
    unsigned sgt = ngt, seq_ = neq;
#pragma unroll
    for (int o = 1; o < 64; o <<= 1) { const unsigned y0 = __shfl_up(sgt, o), y1 = __shfl_up(seq_, o); if (lane >= o) { sgt += y0; seq_ += y1; } }
    if (lane == 63) { wsum[wid] = sgt; wsum[8 + wid] = seq_; }
    __syncthreads();
    unsigned bgt = 0u, beq = 0u, tgt = 0u;
#pragma unroll
    for (int w = 0; w < 8; ++w) { const unsigned g = wsum[w], q = wsum[8 + w]; if (w < wid) { bgt += g; beq += q; } tgt += g; }
    unsigned pgt = bgt + sgt - ngt, peq = beq + seq_ - neq;
#pragma unroll
    for (int j = 0; j < 8; ++j) { const int t = 8 * tid + j; int slot = -1;
      if (key[j] > prefix) slot = (int)pgt++; else if (key[j] == prefix) { if (peq < need) slot = (int)(tgt + peq); ++peq; }
      INV[((size_t)b * SEQ + t) * 16 + e] = slot;
      if (slot >= 0) { ROWSEL[e * 2048 + b * 512 + slot] = b * SEQ + t; GSEL[e * 2048 + b * 512 + slot] = __uint_as_float(key[j]); } }
    __syncthreads();
  }
}
#ifndef GU_ORDER
#define GU_ORDER 1
#endif
#ifndef DN_ORDER
#define DN_ORDER 1
#endif
struct MoeGUOrder { int G, c;
  __device__ bool next(int i, pg8::Unit& u) const { const int L = i * G + c; if (L >= 2048) return false;
#if GU_ORDER == 0
    const int e = L >> 7, r = L & 127, pn = r >> 3, mt = r & 7;
#elif GU_ORDER == 1
    const int e = L >> 7, r = L & 127, mt = r >> 4, pn = r & 15;
#else
    const int x = c & 7, j = c >> 3, e = (i >> 2) * 8 + x, r = (i & 3) * 32 + j, mt = r >> 4, pn = r & 15;
#endif
    u.g = e; u.pm = mt; u.pn = pn; u.ibase = e * 2048 + mt * 256; u.aoff = MOE_FP8 ? ((long)e * 2048 + mt * 256) * 512 : 0; u.boff = ((long)e * 4096 + pn * 256) * (MOE_FP8 ? 512 : 1024); return true; } };
struct MoeDownOrder { int G, c;
  __device__ bool next(int i, pg8::Unit& u) const { const int L = i * G + c; if (L >= 512) return false;
#if DN_ORDER == 0
    const int e = L >> 5, r = L & 31, pn = r >> 3, mt = r & 7;
#else
    const int x = c & 7, j = c >> 3, e = i * 8 + x, pn = j >> 3, mt = j & 7;
#endif
    u.g = e; u.pm = mt; u.pn = pn; u.ibase = e * 2048 + mt * 256; u.aoff = ((long)e * 2048 + mt * 256) * (MOE_FP8_DOWN ? 1024 : 2048); u.boff = ((long)e * 1024 + pn * 256) * (MOE_FP8_DOWN ? 1024 : 2048); return true; } };
struct EpiGU { static constexpr bool TWO_PASS = false; bf16* H; const float* ss2; const int* rowsel;
  __device__ __forceinline__ void row8(const pg8::Unit& u, int rloc, int cloc, const float (&a0)[8], const float (&a1)[8], int fq) const {
    const int tok = rowsel[u.ibase + rloc]; const float r = rsqrtf(ss2[tok] * (1.f / 1024.f) + 1e-6f); float h[8];
#pragma unroll
    for (int i = 0; i < 8; ++i) { const float g = a0[i] * r, up = a1[i] * r; h[i] = g * sigmoidf_(g) * up; if (FP8EMU) h[i] = q8(h[i], 8.f); }
#if MOE_FP8_DOWN
    *(v2u*)((unsigned char*)H + ((size_t)u.g * 2048 + u.pm * 256 + rloc) * 2048 + u.pn * 128 + cloc) = pack8_fp8(h, 8.f); } };
#else
    *(v4u*)(H + ((size_t)u.g * 2048 + u.pm * 256 + rloc) * 2048 + u.pn * 128 + cloc) = pack8(h); } };
#endif
struct EpiGU8 { static constexpr bool TWO_PASS = false; unsigned char* H8; const float* ss2; const int* rowsel;
  __device__ __forceinline__ void row8(const pg8::Unit& u, int rloc, int cloc, const float (&a0)[8], const float (&a1)[8], int fq) const {
    float h[8];
#pragma unroll
    for (int i = 0; i < 8; ++i) { const float g = a0[i], up = a1[i]; h[i] = g * sigmoidf_(g) * up; }
#if MOE_FP8_DOWN
    *(v2u*)(H8 + ((size_t)u.g * 2048 + u.pm * 256 + rloc) * 2048 + u.pn * 128 + cloc) = pack8_fp8(h, 8.f); } };
#else
    *(v4u*)((bf16*)H8 + ((size_t)u.g * 2048 + u.pm * 256 + rloc) * 2048 + u.pn * 128 + cloc) = pack8(h); } };
#endif
struct EpiYE { static constexpr bool TWO_PASS = false; bf16* Yp; const float* gsel;
  __device__ __forceinline__ void row8(const pg8::Unit& u, int rloc, int cloc, const float (&a0)[8], const float (&a1)[8], int fq) const {
    const float gv = gsel[u.ibase + rloc]; float v0[8], v1[8];
#pragma unroll
    for (int i = 0; i < 8; ++i) { v0[i] = a0[i] * gv; v1[i] = a1[i] * gv; }
    bf16* p = Yp + ((size_t)u.g * 2048 + u.pm * 256 + rloc) * 1024 + u.pn * 256 + cloc; *(v4u*)p = pack8(v0); *(v4u*)(p + 128) = pack8(v1); } };
__device__ __forceinline__ void p14_final(Frame& F, const Args& a) {
  unsigned char* ws = F.ws; const bf16* X2 = (const bf16*)(ws + WS_X2); const int* INV = (const int*)(ws + WS_INV); const bf16* YE = (const bf16*)(ws + WS_YE);
  const float* gfin = (const float*)a.in[I_GFIN]; float* out = a.out;
  const int gw = F.vcu * NWAVES + F.wave, NGW = F.G * NWAVES;
  f32x4 g[4];
#pragma unroll
  for (int j = 0; j < 4; ++j) g[j] = *(const f32x4*)(gfin + 256 * j + 4 * F.lane);
  for (int m0 = gw; m0 < MTOK; m0 += 2 * NGW) {
    f32x4 v[2][4]; int inv[2];
#pragma unroll
    for (int u = 0; u < 2; ++u) { const int m = m0 + u * NGW;
#pragma unroll
      for (int j = 0; j < 4; ++j) {
#if X2MODE >= 2
        v[u][j] = *(const f32x4*)((const float*)(ws + WS_X2F) + (size_t)m * 1024 + 256 * j + 4 * F.lane);
#else
        const v2u w = *(const v2u*)(X2 + (size_t)m * 1024 + 256 * j + 4 * F.lane); v[u][j] = (f32x4){bflo(w.x), bfhi(w.x), bflo(w.y), bfhi(w.y)};
#endif
      }
      inv[u] = F.lane < 16 ? INV[(size_t)m * 16 + F.lane] : -1; }
#pragma unroll
    for (int u = 0; u < 2; ++u) { const int m = m0 + u * NGW, b = m >> 12;
      unsigned long long sel = __ballot(inv[u] >= 0);
      while (sel) { const int e = __builtin_ctzll(sel); sel &= sel - 1; const int slot = __shfl(inv[u], e);
        const bf16* yr = YE + ((size_t)e * 2048 + b * 512 + slot) * 1024 + 4 * F.lane;
#pragma unroll
        for (int j = 0; j < 4; ++j) { const v2u w = *(const v2u*)(yr + 256 * j); v[u][j].x += bflo(w.x); v[u][j].y += bfhi(w.x); v[u][j].z += bflo(w.y); v[u][j].w += bfhi(w.y); } }
      float s = 0.f;
#pragma unroll
      for (int j = 0; j < 4; ++j) s += (v[u][j].x * v[u][j].x + v[u][j].y * v[u][j].y) + (v[u][j].z * v[u][j].z + v[u][j].w * v[u][j].w);
      const float r = rsqrtf(wave_sum(s) * (1.f / 1024.f) + 1e-6f);
#pragma unroll
      for (int j = 0; j < 4; ++j) *(f32x4*)(out + (size_t)m * 1024 + 256 * j + 4 * F.lane) = v[u][j] * r * g[j]; }
  }
}
__global__ void __launch_bounds__(NTHR, 2) mk(Args a) {
  extern __shared__ __attribute__((aligned(16))) unsigned char lds_raw[];
  Frame F;
  F.lds = (LAS unsigned char*)lds_raw; F.MISC = (volatile LAS unsigned*)(F.lds + LDSCTL_OFF + 320);
  F.tid = threadIdx.x; F.lane = F.tid & 63; F.wave = __builtin_amdgcn_readfirstlane(F.tid >> 6);
  F.G = gridDim.x; { const int bx = blockIdx.x; F.vcu = (F.G % 8 == 0) ? (bx % 8) * (F.G / 8) + bx / 8 : bx; }
  F.ws = a.ws; F.ctl = (gu32*)(a.ws + WS_CTL);
  unsigned char* ws = a.ws;
  for (int u = F.tid; u < (LDS_BYTES - LDSCTL_OFF) / 4; u += NTHR) ((LAS unsigned*)(F.lds + LDSCTL_OFF))[u] = 0u;
  __syncthreads();
  XcdBarrier bar = xcd_barrier_post((unsigned*)(F.ctl + CW_BAR), F.MISC + 8);
  const int lo = a.ph_lo, hi = a.ph_hi;
#define IN(k) (lo <= (k) && (k) < hi)
#define BOTH(k) (IN(k) && IN((k) + 1))
#define GRID_BAR() xcd_barrier(bar)
  float* ssq = (float*)(ws + CTL_SSQ); float* sskv = (float*)(ws + CTL_SSKV);

#ifndef REP_MASK
#define REP_MASK 0
#endif
#define NREP(k) ((((REP_MASK) >> (k)) & 1) ? 2 : 1)
#define PH_BEGIN(k) if (IN(k)) { for (int rep_ = 0; rep_ < NREP(k); ++rep_) { const bool dry = rep_ + 1 < NREP(k); (void)dry;
#define PH_END(k) if (dry) GRID_BAR(); } if (BOTH(k)) GRID_BAR(); }
  float* dummy = (float*)(ws + WS_DUMMY);
  float* ss1 = (float*)(ws + CTL_SS1); float* ss2 = (float*)(ws + CTL_SS2);
#ifndef FILLMODE
#define FILLMODE 2
#endif
  PH_BEGIN(0) p0_prologue(F, a, true, FILLMODE == 0); PH_END(0)
  PH_BEGIN(1)
    { pg8::Gemm g{(const bf16*)(ws + WS_XN), (const bf16*)(ws + WS_WIN), 1024, 1024, 1024, nullptr, 127, 127}; pg8::StaticOrder S; S.init(MTOK, PROJ_LD, F.G, (int)blockIdx.x, 1024, 1024);
      EpiProj E{(bf16*)(ws + WS_PROJ), dry ? dummy : ssq, dry ? dummy + 16384 : sskv};
      pg8::gemm_phase<EpiProj, pg8::StaticOrder, false>(F.lds, g, S, E); }
    { pg8::Gemm g{(const bf16*)(ws + WS_MEMN), (const bf16*)(ws + WS_WMK), 1024, 1024, 1024, nullptr, 127, 127}; pg8::StaticOrder S; S.init(1024, 1024, F.G, (int)((blockIdx.x + 128u) % (unsigned)F.G), 1024, 1024);
      EpiStore E{(bf16*)(ws + WS_KMEM), 1024};
      pg8::gemm_phase<EpiStore, pg8::StaticOrder, false>(F.lds, g, S, E); }
    { pg8::Gemm g{(const bf16*)(ws + WS_WMV), (const bf16*)(ws + WS_MEMN), 1024, 1024, 1024, nullptr, 127, 127}; pg8::StaticOrder S; S.init(1024, 1024, F.G, (int)((blockIdx.x + 112u) % (unsigned)F.G), 1024, 1024);
      EpiStore E{(bf16*)(ws + WS_VMEMT), 1024};
      pg8::gemm_phase<EpiStore, pg8::StaticOrder, false>(F.lds, g, S, E); }
  PH_END(1)
  PH_BEGIN(2) p2_elementwise(F, a); PH_END(2)
  PH_BEGIN(3) p3_mixers(F, a, (char*)lds_raw, bar.x, ssq, sskv, dry ? 64 * 16 : 0); PH_END(3)
  PH_BEGIN(4) p4_combine(F, a); PH_END(4)
  PH_BEGIN(5)
    pg8::Gemm g{(const bf16*)(ws + WS_Y), (const bf16*)(ws + WS_WOUT), 1024, 1024, 1024, nullptr, 127, 127}; pg8::StaticOrder S; S.init(MTOK, 1024, F.G, (int)blockIdx.x, 1024, 1024);
    EpiResid<0> E{(const float*)a.in[I_X], nullptr, nullptr, (bf16*)(ws + WS_X1B), dry ? dummy : ss1};
    pg8::gemm_phase<EpiResid<0>, pg8::StaticOrder, false>(F.lds, g, S, E);
  PH_END(5)
  PH_BEGIN(6)
    { pg8::Gemm g{(const bf16*)(ws + WS_X1B), (const bf16*)(ws + WS_WMQ), 1024, 1024, 1024, nullptr, 127, 127}; MemOrder S{F.G, (int)blockIdx.x, 2};
      EpiScale E{(bf16*)(ws + WS_QMEM), ss1};
      pg8::gemm_phase<EpiScale, MemOrder, false>(F.lds, g, S, E); }
    if (F.tid == 0) __builtin_amdgcn_fence(__ATOMIC_ACQUIRE, "agent");
    asm volatile("s_waitcnt vmcnt(0)" ::: "memory"); __syncthreads();
    { pg8::Gemm g{(const bf16*)(ws + WS_QMEM), (const bf16*)(ws + WS_KMEM), 1024, 1024, 256, nullptr, 127, 127}; MemOrder S{F.G, (int)blockIdx.x, 0};
      EpiSoftmax E{(bf16*)(ws + WS_P), 0.0625f, (LAS float*)(F.lds + LDSCTL_OFF + 1024)};
      pg8::gemm_phase<EpiSoftmax, MemOrder, false>(F.lds, g, S, E); }
    if (F.tid == 0) __builtin_amdgcn_fence(__ATOMIC_ACQUIRE, "agent");
    asm volatile("s_waitcnt vmcnt(0)" ::: "memory"); __syncthreads();
    { pg8::Gemm g{(const bf16*)(ws + WS_P), (const bf16*)(ws + WS_VMEMT), 1024, 1024, 256, nullptr, 127, 127}; MemOrder S{F.G, (int)blockIdx.x, 1};
      EpiStore E{(bf16*)(ws + WS_MO), 1024};
      pg8::gemm_phase<EpiStore, MemOrder, false>(F.lds, g, S, E); }
  PH_END(6)
  PH_BEGIN(9)
    pg8::Gemm g{(const bf16*)(ws + WS_MO), (const bf16*)(ws + WS_WMO), 1024, 1024, 1024, nullptr, 127, 127}; pg8::StaticOrder S; S.init(MTOK, 1024, F.G, (int)blockIdx.x, 1024, 1024);
    EpiResid<1> E{nullptr, (const bf16*)(ws + WS_X1B), X2MODE >= 1 ? (float*)(ws + WS_X2F) : nullptr, (bf16*)(ws + WS_X2), dry ? dummy : ss2};
    pg8::gemm_phase<EpiResid<1>, pg8::StaticOrder, false>(F.lds, g, S, E);
  PH_END(9)
  PH_BEGIN(10) p10_router(F, a); PH_END(10)
  PH_BEGIN(11) p11_topk(F, (char*)lds_raw);
    if (!dry && FILLMODE != 0) conv_fill(F, a, 1 << 30);
  PH_END(11)
  PH_BEGIN(12)
#if MOE_FP8
    {
      const int gw = F.vcu * NWAVES + F.wave, NGW = F.G * NWAVES; const int* rs = (const int*)(ws + WS_ROWSEL);
      for (int r0 = gw; r0 < NEXP * 2048; r0 += 4 * NGW) {
        int tok[4]; float rn[4]; v4u qa[4], qb[4];
#pragma unroll
        for (int u = 0; u < 4; ++u) { const int r = r0 + u * NGW; tok[u] = r < NEXP * 2048 ? rs[r] : 0; }
#pragma unroll
        for (int u = 0; u < 4; ++u) { const bf16* xr = (const bf16*)(ws + WS_X2) + (size_t)tok[u] * 1024 + F.lane * 16; rn[u] = ss2[tok[u]]; qa[u] = *(const v4u*)xr; qb[u] = *(const v4u*)(xr + 8); }
#pragma unroll
        for (int u = 0; u < 4; ++u) { const int r = r0 + u * NGW; const float s = rsqrtf(rn[u] * (1.f / 1024.f) + 1e-6f);
          float lo[8], hi[8]; unpack8(qa[u], lo); unpack8(qb[u], hi);
#pragma unroll
          for (int j = 0; j < 8; ++j) { lo[j] *= s; hi[j] *= s; }
          const v2u a8 = pack8_fp8(lo, 1.f), b8 = pack8_fp8(hi, 1.f); v4u o; o.x = a8.x; o.y = a8.y; o.z = b8.x; o.w = b8.y;
          if (r < NEXP * 2048) *(v4u*)(ws + WS_XG + (size_t)r * 1024 + F.lane * 16) = o; } }
      GRID_BAR(); }
    pg8::Gemm g{(const bf16*)(ws + WS_XG), (const bf16*)(ws + WS_WEGU8), 512, 512, 512, nullptr, 127, 121}; MoeGUOrder S{F.G, (int)blockIdx.x};
    EpiGU8 E{(unsigned char*)(ws + WS_HID8), ss2, (const int*)(ws + WS_ROWSEL)};
    pg8::gemm_phase<EpiGU8, MoeGUOrder, false, 1>(F.lds, g, S, E);
#else
    pg8::Gemm g{(const bf16*)(ws + WS_X2B), (const bf16*)(ws + WS_WEGU), 1024, 1024, 1024, (const int*)(ws + WS_ROWSEL), 127, 127}; MoeGUOrder S{F.G, (int)blockIdx.x};
    EpiGU E{(bf16*)(ws + WS_HID), ss2, (const int*)(ws + WS_ROWSEL)};
    pg8::gemm_phase<EpiGU, MoeGUOrder, true>(F.lds, g, S, E);
#endif
  PH_END(12)
  PH_BEGIN(13)
#if MOE_FP8_DOWN
    pg8::Gemm g{(const bf16*)(ws + WS_HID8), (const bf16*)(ws + WS_WED8), 1024, 1024, 1024, nullptr, 124, 121}; MoeDownOrder S{F.G, (int)blockIdx.x};
    EpiYE E{(bf16*)(ws + WS_YE), (const float*)(ws + WS_GSEL)};
    pg8::gemm_phase<EpiYE, MoeDownOrder, false, 1>(F.lds, g, S, E);
#else
    pg8::Gemm g{(const bf16*)(ws + WS_HID), (const bf16*)(ws + WS_WED), 2048, 2048, 2048, nullptr, 127, 127}; MoeDownOrder S{F.G, (int)blockIdx.x};
    EpiYE E{(bf16*)(ws + WS_YE), (const float*)(ws + WS_GSEL)};
    pg8::gemm_phase<EpiYE, MoeDownOrder, false>(F.lds, g, S, E);
#endif
  PH_END(13)
  PH_BEGIN(14) p14_final(F, a); PH_END(14)
#undef IN
#undef BOTH
#undef GRID_BAR
}

__global__ __launch_bounds__(256) void adapt_b2f(const bf16* src, long lds_, long scol, float* dst, long ldd, long dcol, long rows, long ncols) {
  const long i = blockIdx.x * 256L + threadIdx.x; if (i >= rows * ncols) return;
  const long r = i / ncols, c = i % ncols; dst[r * ldd + dcol + c] = bf2f(src[r * lds_ + scol + c]);
}
static void adapt(hipStream_t s, const void* src, long lds_, long scol, float* dst, long ldd, long dcol, long rows, long ncols) {
  hipLaunchKernelGGL(adapt_b2f, dim3((unsigned)((rows * ncols + 255) / 256)), dim3(256), 0, s, (const bf16*)src, lds_, scol, dst, ldd, dcol, rows, ncols);
}

static int mk_grid() {
  static int grid = 0;
  if (grid == 0) {
    int dev = 0, cus = 0, per_cu = 0;
    (void)hipGetDevice(&dev); (void)hipDeviceGetAttribute(&cus, hipDeviceAttributeMultiprocessorCount, dev);
    (void)hipFuncSetAttribute((const void*)mk, hipFuncAttributeMaxDynamicSharedMemorySize, LDS_BYTES);
    (void)hipOccupancyMaxActiveBlocksPerMultiprocessor(&per_cu, (const void*)mk, NTHR, LDS_BYTES);
    (void)hipGetLastError();
    grid = cus > 0 ? cus : 256;
  }
  return grid;
}
static void mk_launch(hipStream_t s, void* const* d_in, void* d_out, void* d_ws, int lo, int hi, int flags) {
  Args a; memset(&a, 0, sizeof(a));
  for (int i = 0; i < 26; ++i) a.in[i] = d_in[i];
  a.out = (float*)d_out; a.ws = (unsigned char*)d_ws; a.ph_lo = lo; a.ph_hi = hi; a.flags = flags; a.pad = 0;
  (void)hipMemsetAsync((char*)d_ws + WS_CTL + CW_BAR * 4, 0, XCD_BAR_WORDS * 4, s);
  hipLaunchKernelGGL(mk, dim3(mk_grid()), dim3(NTHR), LDS_BYTES, s, a);
}

extern "C" void kernel_launch(void* const* d_in, const int* in_sizes, int n_in, void* d_out, int out_size, void* d_ws, size_t ws_size, hipStream_t s) {
  (void)hipMemsetAsync((char*)d_ws + WS_CTL, 0, CTL_ZERO_BYTES, s);
  mk_launch(s, d_in, d_out, d_ws, 0, 15, 1);
}
```

```cpp
#include <hip/hip_runtime.h>
#include <cstdint>
#include <cstdio>
#include <cstring>

constexpr int BATCH = 4, SEQ = 4096, DM = 1024, MTOK = BATCH * SEQ;
constexpr int D_IN = 2480;
constexpr int OFF_QM = 0, OFF_KM = 512, OFF_VM = 1024, OFF_OM = 1536, OFF_G = 2048, OFF_CQ = 2064, OFF_CKV = 2320, OFF_KR = 2448;
constexpr int NEXP = 16, CAP = 512, DFF = 2048, NMEM = 256;
constexpr size_t MiB = 1u << 20;
enum { I_X = 0, I_MEM, I_POS, I_GMIX, I_WIN, I_BG, I_CONV, I_GQA, I_WQB, I_GKVA, I_WKVB, I_GHM, I_GHA, I_WOUT, I_GMX, I_GMKV, I_WMQ, I_WMK, I_WMV, I_WMO, I_GFFN, I_WR, I_WEG, I_WEU, I_WED, I_GFIN };
#define GAS __attribute__((address_space(1)))
#define LAS __attribute__((address_space(3)))
typedef unsigned short bf16;
typedef unsigned v4u __attribute__((ext_vector_type(4)));
typedef unsigned v2u __attribute__((ext_vector_type(2)));
typedef float f32x4 __attribute__((ext_vector_type(4)));
typedef float f32x16 __attribute__((ext_vector_type(16)));
typedef short bf16x8 __attribute__((ext_vector_type(8)));
typedef short s16x4 __attribute__((ext_vector_type(4)));
typedef GAS unsigned gu32;
#define RLX_AGENT __ATOMIC_RELAXED, __HIP_MEMORY_SCOPE_AGENT
#define LDS_WAIT() asm volatile("s_waitcnt lgkmcnt(0)" ::: "memory")
#define VM_WAIT() asm volatile("s_waitcnt vmcnt(0)" ::: "memory")
constexpr int NWAVES = 8, NTHR = 512;
__device__ __forceinline__ unsigned f2bf(float f) { unsigned u = __builtin_bit_cast(unsigned, f); return (u + 0x7fffu + ((u >> 16) & 1u)) >> 16; }
__device__ __forceinline__ unsigned pk2(float lo, float hi) { return f2bf(lo) | (f2bf(hi) << 16); }
__device__ __forceinline__ float bf2f(unsigned short h) { return __builtin_bit_cast(float, (unsigned)h << 16); }
__device__ __forceinline__ float bflo(unsigned w) { return __builtin_bit_cast(float, w << 16); }
__device__ __forceinline__ float bfhi(unsigned w) { return __builtin_bit_cast(float, w & 0xffff0000u); }
typedef float f32x2_t __attribute__((ext_vector_type(2))); typedef __bf16 bf16x2_t __attribute__((ext_vector_type(2)));
__device__ __forceinline__ unsigned cvt_pk_bf16(float lo, float hi) { f32x2_t v = {lo, hi}; bf16x2_t b = __builtin_convertvector(v, bf16x2_t); return __builtin_bit_cast(unsigned, b); }
__device__ __forceinline__ v2u pack8_fp8(const float (&v)[8], float sc) { float c[8];
#pragma unroll
  for (int i = 0; i < 8; ++i) c[i] = __builtin_amdgcn_fmed3f(v[i] * sc, -448.f, 448.f);
  int a = 0, b = 0; a = __builtin_amdgcn_cvt_pk_fp8_f32(c[0], c[1], a, false); a = __builtin_amdgcn_cvt_pk_fp8_f32(c[2], c[3], a, true);
  b = __builtin_amdgcn_cvt_pk_fp8_f32(c[4], c[5], b, false); b = __builtin_amdgcn_cvt_pk_fp8_f32(c[6], c[7], b, true); v2u r; r.x = (unsigned)a; r.y = (unsigned)b; return r; }
__device__ __forceinline__ float q8(float x, float sc) { const int p = __builtin_amdgcn_cvt_pk_fp8_f32(x * sc, 0.f, 0, false); return __builtin_amdgcn_cvt_f32_fp8(p, 0) * (1.f / sc); }
__device__ __forceinline__ float wave_sum(float v) {
#pragma unroll
  for (int o = 1; o < 64; o <<= 1) v += __shfl_xor(v, o);
  return v;
}
__device__ __forceinline__ float sigmoidf_(float x) { return 1.f / (1.f + __expf(-x)); }

#define XB_TMO      128
#define XB_XCNT(j)  (256  + 64 * (j))
#define XB_XSUB(j)  (1280 + 64 * (j))
#define XB_XGEN(j)  (2304 + 64 * (j))
#define XB_TOP      3328
#define XB_TOPGEN   3392
#define XCD_BAR_WORDS 3456
#define XB_SPIN_CAP (1u << 22)
__device__ __forceinline__ unsigned xb_ld(unsigned* p)              { return __hip_atomic_load(p, __ATOMIC_RELAXED, __HIP_MEMORY_SCOPE_AGENT); }
__device__ __forceinline__ unsigned xb_add(unsigned* p, unsigned v) { return __hip_atomic_fetch_add(p, v, __ATOMIC_RELAXED, __HIP_MEMORY_SCOPE_AGENT); }
__device__ __forceinline__ unsigned xb_xcc_id() { return (unsigned)__builtin_amdgcn_s_getreg((3 << 11) | 20) & 0xFu; }
#define XB_SPIN(cond, bar) do { unsigned _sp = 0; while (cond) { __builtin_amdgcn_s_sleep(1); \
    if ((++_sp & 255u) == 0u) { if (xb_ld(&(bar)[XB_TMO])) break; if (_sp > XB_SPIN_CAP) { atomicAdd(&(bar)[XB_TMO], 1u); break; } } } } while (0)
struct XcdBarrier { unsigned* bar; unsigned x; volatile LAS unsigned* st; };
__device__ __forceinline__ XcdBarrier xcd_barrier_post(unsigned* bar, volatile LAS unsigned* st) {
  XcdBarrier b; b.bar = bar; b.x = xb_xcc_id(); b.st = st;
  if (threadIdx.x == 0) (void)xb_add(&bar[XB_XCNT(b.x)], 1u);
  return b;
}
__device__ __forceinline__ void xcd_barrier_complete(unsigned* bar, unsigned x, unsigned& nloc, unsigned& nx) {
  const unsigned G = gridDim.x * gridDim.y * gridDim.z;
  unsigned sum, cnt, mine, sp = 0u;
  for (;;) {
    sum = 0u; cnt = 0u; mine = 0u;
#pragma unroll
    for (unsigned j = 0; j < 16; ++j) { const unsigned c = xb_ld(&bar[XB_XCNT(j)]); sum += c; cnt += (c > 0u) ? 1u : 0u; mine = (j == x) ? c : mine; }
    if (sum == G) break;
    __builtin_amdgcn_s_sleep(1);
    if ((++sp & 255u) == 0u) { if (xb_ld(&bar[XB_TMO])) break; if (sp > XB_SPIN_CAP) { atomicAdd(&bar[XB_TMO], 1u); break; } }
  }
  nloc = mine > 0u ? mine : 1u; nx = cnt > 0u ? cnt : 1u;
}
__device__ __forceinline__ void xcd_barrier(const XcdBarrier& b) {
  asm volatile("s_waitcnt vmcnt(0)" ::: "memory");
  __syncthreads();
  if (threadIdx.x == 0) {
    unsigned* bar = b.bar;
    __builtin_amdgcn_s_waitcnt(0);
    unsigned nloc = b.st[0], nx = b.st[1];
    if (nloc == 0u) { xcd_barrier_complete(bar, b.x, nloc, nx); b.st[0] = nloc; b.st[1] = nx; }
    const unsigned old = xb_add(&bar[XB_XSUB(b.x)], 1u);
    const unsigned gen = old / nloc;
    if (old + 1u == (gen + 1u) * nloc) {
      __builtin_amdgcn_fence(__ATOMIC_RELEASE, "agent");
      asm volatile("s_waitcnt vmcnt(0)" ::: "memory");
      const unsigned og = xb_add(&bar[XB_TOP], 1u);
      const unsigned tg = og / nx;
      if (og + 1u == (tg + 1u) * nx) xb_add(&bar[XB_TOPGEN], 1u);
      else XB_SPIN(xb_ld(&bar[XB_TOPGEN]) == tg, bar);
      __builtin_amdgcn_fence(__ATOMIC_ACQUIRE, "agent");
      xb_add(&bar[XB_XGEN(b.x)], 1u);
      asm volatile("s_waitcnt vmcnt(0)" ::: "memory");
    } else {
      XB_SPIN(xb_ld(&bar[XB_XGEN(b.x)]) == gen, bar);
      __builtin_amdgcn_fence(__ATOMIC_ACQUIRE, "agent");
      asm volatile("s_waitcnt vmcnt(0)" ::: "memory");
    }
  }
  __syncthreads();
}

namespace pg8 {
constexpr int BM = 256, BK = 64, HALF = 128, HTB = HALF * BK * 2, STAGE_BYTES = 8 * HTB, NXCD = 8, WGM = 8;
__host__ __device__ __forceinline__ int lds_byte(int r, int c) { const int st = (r >> 4) * 2 + (c >> 5), rr = r & 15, cc = c & 31, ob = rr * 64 + cc * 2; return st * 1024 + (ob ^ (((ob >> 9) & 1) << 5)); }
__host__ __device__ __forceinline__ void stage_rc(int b, int& R, int& C) { const int st = b / 1024, sb = b % 1024, swz = sb ^ (((sb >> 9) & 1) << 5); R = (st >> 1) * 16 + swz / 64; C = (st & 1) * 32 + (swz % 64) / 2; }
__host__ __device__ __forceinline__ int perm32(int rho) { const int n = rho >> 4, i = rho & 15; return 8 * (i >> 2) + 4 * n + (i & 3); }

struct Unit { long aoff, boff; int pm, pn, g, ibase; };
struct Gemm { const bf16* A; const bf16* Bt; int lda, ldb, K; const int* gidx; int sa, sb; };
typedef int v8i_t __attribute__((ext_vector_type(8))); typedef int v4i_t __attribute__((ext_vector_type(4)));
__device__ __forceinline__ v8i_t cat8(bf16x8 lo, bf16x8 hi) { const v4i_t a = __builtin_bit_cast(v4i_t, lo), b = __builtin_bit_cast(v4i_t, hi); return __builtin_shufflevector(a, b, 0, 1, 2, 3, 4, 5, 6, 7); }

struct StaticOrder {
  int nM, nN, nwg, G, c, lda, ldb;
  __device__ void init(int M, int N, int G_, int c_, int lda_, int ldb_) { nM = M / BM; nN = N / BM; nwg = nM * nN; G = G_; c = c_; lda = lda_; ldb = ldb_; }
  __device__ bool next(int i, Unit& u) const {
    const long L = (long)i * G + c; if (L >= nwg) return false;
    int wgid = (int)L; { const int q = nwg / NXCD, r = nwg % NXCD, xcd = wgid % NXCD, off = wgid / NXCD; wgid = (xcd < r ? xcd * (q + 1) : r * (q + 1) + (xcd - r) * q) + off; }
    const int nig = WGM * nN, gid = wgid / nig, fm = gid * WGM, gsz = (nM - fm) < WGM ? (nM - fm) : WGM;
    u.pm = fm + ((wgid % nig) % gsz); u.pn = (wgid % nig) / gsz; u.g = 0; u.ibase = 0;
    u.aoff = (long)u.pm * BM * lda; u.boff = (long)u.pn * BM * ldb; return true;
  }
};

template <class Epi, class Sched, bool GATHER, int FP8 = 0>
__device__ __forceinline__ void gemm_phase(LAS unsigned char* lds, const Gemm g, const Sched& S, const Epi& E) {
  int tid = threadIdx.x; asm volatile("" : "+v"(tid));
  const int wid = __builtin_amdgcn_readfirstlane(tid >> 6), lane = tid & 63, wr = wid >> 2, wc = wid & 3, fr = lane & 15, fq = lane >> 4;
  const int K = g.K, nt = K / BK;
  int Rs[2], Cs[2]; unsigned voffB[2];
#pragma unroll
  for (int i = 0; i < 2; ++i) { int R, C; stage_rc(tid * 16 + i * 8192, R, C); Rs[i] = R; Cs[i] = C; const int Rb = (R & ~31) + perm32(R & 31); voffB[i] = (unsigned)(Rb * g.ldb + C) * 2u; }
  const size_t kstep = (size_t)(BK * 2);
  const size_t hstepB = (size_t)HALF * g.ldb * 2;
  const unsigned ldsw = (unsigned)wid * 1024u;
  const int aoff_l = lds_byte(wr * 64 + fr, FP8 ? fq * 16 : fq * 8), boff_l = lds_byte(wc * 32 + fr, FP8 ? fq * 16 : fq * 8);
  constexpr int aoff_k = FP8 ? 16 : 1024, boff_k = FP8 ? 16 : 1024;
#define PG8_SA(b, h) (((b) * 2 + (h)) * HTB)
#define PG8_SB(b, h) ((4 + (b) * 2 + (h)) * HTB)
#define PG8_STAGE(bufoff, gbase, voff) do { _Pragma("unroll") for (int _i = 0; _i < 2; ++_i) \
        __builtin_amdgcn_global_load_lds((const unsigned*)((const char*)(gbase) + (voff)[_i]), (LAS unsigned*)(lds + (bufoff) + ldsw + _i * 8192), 16, 0, 0); } while (0)
#define PG8_LDA(dst, b, h) do { _Pragma("unroll") for (int m = 0; m < 4; ++m) { if constexpr (FP8) { const v4i_t lo_ = *(const LAS v4i_t*)(lds + PG8_SA(b, h) + aoff_l + m * 2048), hi_ = *(const LAS v4i_t*)(lds + PG8_SA(b, h) + aoff_l + m * 2048 + aoff_k); dst##8[m] = __builtin_shufflevector(lo_, hi_, 0, 1, 2, 3, 4, 5, 6, 7); } \
        else { _Pragma("unroll") for (int k = 0; k < 2; ++k) dst[m][k] = *(const LAS bf16x8*)(lds + PG8_SA(b, h) + aoff_l + m * 2048 + k * aoff_k); } } } while (0)
#define PG8_LDB(dst, b, h) do { _Pragma("unroll") for (int n = 0; n < 2; ++n) { if constexpr (FP8) { const v4i_t lo_ = *(const LAS v4i_t*)(lds + PG8_SB(b, h) + boff_l + n * 2048), hi_ = *(const LAS v4i_t*)(lds + PG8_SB(b, h) + boff_l + n * 2048 + boff_k); dst##8[n] = __builtin_shufflevector(lo_, hi_, 0, 1, 2, 3, 4, 5, 6, 7); } \
        else { _Pragma("unroll") for (int k = 0; k < 2; ++k) dst[n][k] = *(const LAS bf16x8*)(lds + PG8_SB(b, h) + boff_l + n * 2048 + k * boff_k); } } } while (0)
#define PG8_MMA(ai, bj, At, Bt) do { __builtin_amdgcn_s_setprio(1); _Pragma("unroll") for (int m = 0; m < 4; ++m) _Pragma("unroll") for (int n = 0; n < 2; ++n) { \
        if constexpr (FP8) asm volatile("v_mfma_scale_f32_16x16x128_f8f6f4 %0, %1, %2, %0, %3, %4 op_sel_hi:[0,0,0]" : "+v"(acc[ai][bj][m][n]) : "v"(Bt##8[n]), "v"(At##8[m]), "v"(vsb), "v"(vsa)); \
        else { _Pragma("unroll") for (int k = 0; k < 2; ++k) acc[ai][bj][m][n] = __builtin_amdgcn_mfma_f32_16x16x32_bf16(Bt[n][k], At[m][k], acc[ai][bj][m][n], 0, 0, 0); } } \
        __builtin_amdgcn_s_setprio(0); } while (0)
#define PG8_WAIT_V(n) asm volatile("s_waitcnt vmcnt(" #n ")" ::: "memory")
#define PG8_WAIT_L(n) asm volatile("s_waitcnt lgkmcnt(" #n ")" ::: "memory")
#define PG8_BAR __builtin_amdgcn_s_barrier()
#define PG8_SCHED __builtin_amdgcn_sched_barrier(0)
  Unit cur, nxt; int ui = 0;
  if (!S.next(0, cur)) return;
  unsigned vA[2][2], nvA[2][2];
  auto load_va = [&](const Unit& u, unsigned (&v)[2][2]) {
#pragma unroll
    for (int h = 0; h < 2; ++h)
#pragma unroll
      for (int i = 0; i < 2; ++i) {
        if constexpr (GATHER) v[h][i] = (unsigned)((long)g.gidx[u.ibase + h * HALF + Rs[i]] * g.lda + Cs[i]) * 2u;
        else v[h][i] = (unsigned)((h * HALF + Rs[i]) * g.lda + Cs[i]) * 2u;
      }
  };
  load_va(cur, vA);
  f32x4 acc[2][2][4][2];
#pragma unroll
  for (int a = 0; a < 2; ++a)
#pragma unroll
    for (int b = 0; b < 2; ++b)
#pragma unroll
      for (int m = 0; m < 4; ++m)
#pragma unroll
        for (int n = 0; n < 2; ++n) acc[a][b][m][n] = (f32x4){0.f, 0.f, 0.f, 0.f};
  int vsa = g.sa, vsb = g.sb; (void)vsa; (void)vsb;
  bf16x8 At[4][2], B0[2][2], B1[2][2]; v8i_t At8[4], B08[2], B18[2];
  const char* cA = (const char*)g.A + (GATHER ? 0 : cur.aoff * 2); const char* cB = (const char*)g.Bt + cur.boff * 2;
  PG8_STAGE(PG8_SB(0, 0), cB, voffB); PG8_STAGE(PG8_SB(0, 1), cB + hstepB, voffB); PG8_STAGE(PG8_SA(0, 0), cA, vA[0]); PG8_STAGE(PG8_SA(0, 1), cA, vA[1]);
  if (wr == 1) PG8_BAR;
  PG8_WAIT_V(2); PG8_BAR;
  PG8_STAGE(PG8_SB(1, 0), cB + kstep, voffB); PG8_STAGE(PG8_SA(1, 0), cA + kstep, vA[0]); PG8_STAGE(PG8_SB(1, 1), cB + hstepB + kstep, voffB);
  PG8_WAIT_V(6); PG8_BAR;
  for (;;) {
    const bool has_next = S.next(ui + 1, nxt);
    const char* nA = has_next ? (const char*)g.A + (GATHER ? 0 : nxt.aoff * 2) : cA; const char* nB = has_next ? (const char*)g.Bt + nxt.boff * 2 : cB;
    if constexpr (GATHER) { if (has_next) load_va(nxt, nvA); else {
#pragma unroll
      for (int h = 0; h < 2; ++h)
#pragma unroll
        for (int i = 0; i < 2; ++i) nvA[h][i] = vA[h][i]; } }
#pragma unroll 1
    for (int t = 0; t < nt; t += 2) {
      const bool last = (t == nt - 2);
      const char* a1 = cA + (size_t)(t + 1) * kstep;
      const char* a2 = last ? nA : cA + (size_t)(t + 2) * kstep; const char* b2 = last ? nB : cB + (size_t)(t + 2) * kstep;
      const char* a3 = a2 + kstep; const char* b3 = b2 + kstep;
      unsigned w0[2], w1[2];
      if constexpr (GATHER) { w0[0] = last ? nvA[0][0] : vA[0][0]; w0[1] = last ? nvA[0][1] : vA[0][1]; w1[0] = last ? nvA[1][0] : vA[1][0]; w1[1] = last ? nvA[1][1] : vA[1][1]; }
      else { w0[0] = vA[0][0]; w0[1] = vA[0][1]; w1[0] = vA[1][0]; w1[1] = vA[1][1]; }
      PG8_LDB(B0, 0, 0); PG8_LDB(B1, 0, 1); PG8_SCHED; PG8_LDA(At, 0, 0); PG8_STAGE(PG8_SA(1, 1), a1, vA[1]);
      PG8_WAIT_V(8); PG8_WAIT_L(0); PG8_BAR; PG8_MMA(0, 0, At, B0); PG8_MMA(0, 1, At, B1); PG8_BAR; PG8_SCHED;
      PG8_LDA(At, 0, 1); PG8_STAGE(PG8_SB(0, 0), b2, voffB); PG8_STAGE(PG8_SB(0, 1), b2 + hstepB, voffB); PG8_STAGE(PG8_SA(0, 0), a2, w0);
      PG8_WAIT_V(8); PG8_WAIT_L(0); PG8_BAR; PG8_MMA(1, 0, At, B0); PG8_MMA(1, 1, At, B1); PG8_BAR; PG8_SCHED;
      PG8_LDB(B0, 1, 0); PG8_LDB(B1, 1, 1); PG8_SCHED; PG8_LDA(At, 1, 0); PG8_STAGE(PG8_SA(0, 1), a2, w1);
      PG8_WAIT_V(8); PG8_WAIT_L(0); PG8_BAR; PG8_MMA(0, 0, At, B0); PG8_MMA(0, 1, At, B1); PG8_BAR; PG8_SCHED;
      PG8_LDA(At, 1, 1); PG8_STAGE(PG8_SB(1, 0), b3, voffB); PG8_STAGE(PG8_SB(1, 1), b3 + hstepB, voffB); PG8_STAGE(PG8_SA(1, 0), a3, w0);
      PG8_WAIT_V(8); PG8_WAIT_L(0); PG8_BAR; PG8_MMA(1, 0, At, B0); PG8_MMA(1, 1, At, B1); PG8_BAR; PG8_SCHED;
    }
    if constexpr (FP8) { asm volatile("s_nop 15\n\ts_nop 15" ::: "memory"); __builtin_amdgcn_sched_barrier(0); }
    if (wr == 0) PG8_BAR;
    int fr_o = fr, fq_o = fq; asm volatile("" : "+v"(fr_o), "+v"(fq_o));
    if constexpr (Epi::TWO_PASS) {
#pragma unroll
      for (int ai = 0; ai < 2; ++ai)
#pragma unroll
        for (int m = 0; m < 4; ++m) {
          float v0[8], v1[8];
#pragma unroll
          for (int n = 0; n < 2; ++n)
#pragma unroll
            for (int j = 0; j < 4; ++j) { v0[n * 4 + j] = acc[ai][0][m][n][j]; v1[n * 4 + j] = acc[ai][1][m][n][j]; }
          E.pass1(cur, ai * HALF + wr * 64 + m * 16 + fr_o, wc, v0, v1, fq_o);
#pragma unroll
          for (int n = 0; n < 2; ++n)
#pragma unroll
            for (int j = 0; j < 4; ++j) { acc[ai][0][m][n][j] = v0[n * 4 + j]; acc[ai][1][m][n][j] = v1[n * 4 + j]; }
        }
      asm volatile("s_waitcnt lgkmcnt(0)" ::: "memory"); PG8_BAR; asm volatile("" ::: "memory");
    }
    {
#pragma unroll
      for (int ai = 0; ai < 2; ++ai)
#pragma unroll
        for (int m = 0; m < 4; ++m) {
          float v0[8], v1[8];
#pragma unroll
          for (int n = 0; n < 2; ++n)
#pragma unroll
            for (int j = 0; j < 4; ++j) { v0[n * 4 + j] = acc[ai][0][m][n][j]; v1[n * 4 + j] = acc[ai][1][m][n][j]; }
          E.row8(cur, ai * HALF + wr * 64 + m * 16 + fr_o, wc * 32 + 8 * fq_o, v0, v1, fq_o);
          asm volatile("" ::: "memory");
        }
    }
    if (!has_next) break;
#pragma unroll
    for (int a = 0; a < 2; ++a)
#pragma unroll
      for (int b = 0; b < 2; ++b)
#pragma unroll
        for (int m = 0; m < 4; ++m)
#pragma unroll
          for (int n = 0; n < 2; ++n) acc[a][b][m][n] = (f32x4){0.f, 0.f, 0.f, 0.f};
    cur = nxt; cA = nA; cB = nB; ++ui;
    if constexpr (GATHER) {
#pragma unroll
      for (int h = 0; h < 2; ++h)
#pragma unroll
        for (int i = 0; i < 2; ++i) vA[h][i] = nvA[h][i]; }
    if (wr == 1) PG8_BAR;
  }
  PG8_WAIT_V(0);
  PG8_BAR;
#undef PG8_SA
#undef PG8_SB
#undef PG8_STAGE
#undef PG8_LDA
#undef PG8_LDB
#undef PG8_MMA
#undef PG8_WAIT_V
#undef PG8_WAIT_L
#undef PG8_BAR
#undef PG8_SCHED
}
}
constexpr size_t WS_CTL = 0, CTL_ZERO_BYTES = 1 * MiB;
constexpr int CW_TMO = 0, CW_BAR = 4096, CW_Q = 8192;
constexpr size_t CTL_SSQ = 256 * 1024, CTL_SSKV = CTL_SSQ + 65536, CTL_SS1 = CTL_SSKV + 65536, CTL_SS2 = CTL_SS1 + 65536;
constexpr size_t WS_WIN = 1 * MiB, WS_WQB = 6 * MiB, WS_WKVB = 6 * MiB + 512 * 1024, WS_WOUT = 7 * MiB, WS_WMQ = 9 * MiB, WS_WMK = 11 * MiB, WS_WMV = 13 * MiB, WS_WMO = 15 * MiB;
constexpr size_t WS_ROPE = 17 * MiB, WS_MEMN = 19 * MiB, WS_KMEM = 21 * MiB, WS_VMEMT = 23 * MiB, WS_GSC = 25 * MiB, WS_DEC = 28 * MiB, WS_AFF = 29 * MiB, WS_SEL = 30 * MiB;
constexpr size_t WS_PROJ = 32 * MiB, WS_XN = 112 * MiB, WS_QC = 112 * MiB, WS_KC = 128 * MiB, WS_QM = 144 * MiB, WS_KM = 168 * MiB, WS_VM = 192 * MiB, WS_HF = 208 * MiB, WS_HB = 224 * MiB, WS_Y = 240 * MiB;
constexpr size_t WS_X1 = 112 * MiB, WS_X1B = 176 * MiB, WS_QMEM = 208 * MiB, WS_P = 240 * MiB, WS_MO = 112 * MiB, WS_X2 = 208 * MiB, WS_X2B = 208 * MiB, WS_HID = 32 * MiB;
constexpr size_t WS_DUMMY = 304 * MiB;
#ifndef X2MODE
#define X2MODE 2
#endif
constexpr size_t WS_X2F = 256 * MiB;
constexpr size_t WS_WEGU = 320 * MiB, WS_WED = 448 * MiB, WS_END = 512 * MiB;
constexpr int PROJ_LD = 2560;
constexpr int PC_CQ = 2048, PC_CKV = 2304, PC_KR = 2432, PC_G = 2464;
constexpr int RING_BYTES = 131072, LDSCTL_OFF = 133120, LDS_BYTES = 147456;

struct Args { const void* in[26]; float* out; unsigned char* ws; int ph_lo, ph_hi, flags, pad; };

struct Frame {
  LAS unsigned char* lds; volatile LAS unsigned* MISC; gu32* ctl; unsigned char* ws;
  int tid, lane, wave, vcu, G;
};

__device__ __forceinline__ void p0_tr(const float* W, int ldw, int k0, int kvalid, int scol0, int ncols, const float* gs, bf16* WT, int ldt, int drow0, LAS float* scr, int lane, bool doq = false) {
  const int c4 = (lane & 15) * 4, kr = lane >> 4;
  f32x4 v[16];
#pragma unroll
  for (int i = 0; i < 16; ++i) { const int kk = 4 * i + kr; v[i] = (f32x4){0.f, 0.f, 0.f, 0.f};
    if (c4 < ncols && k0 + kk < kvalid) { v[i] = *(const f32x4*)(W + (size_t)(k0 + kk) * ldw + scol0 + c4); if (gs) v[i] = v[i] * gs[k0 + kk];
      if (doq) { v[i].x = q8(v[i].x, 64.f); v[i].y = q8(v[i].y, 64.f); v[i].z = q8(v[i].z, 64.f); v[i].w = q8(v[i].w, 64.f); } } }
#pragma unroll
  for (int i = 0; i < 16; ++i) { const int kk = 4 * i + kr; LAS float* d = scr + kk * 65 + c4; d[0] = v[i].x; d[1] = v[i].y; d[2] = v[i].z; d[3] = v[i].w; }
  LDS_WAIT(); asm volatile("" ::: "memory");
  const int c = lane & 7;
#pragma unroll
  for (int j = 0; j < 8; ++j) { const int n = (lane >> 3) + 8 * j; const LAS float* s = scr + (8 * c) * 65 + n;
    v4u o; o.x = pk2(s[0 * 65], s[1 * 65]); o.y = pk2(s[2 * 65], s[3 * 65]); o.z = pk2(s[4 * 65], s[5 * 65]); o.w = pk2(s[6 * 65], s[7 * 65]);
    *(GAS v4u*)(WT + (size_t)(drow0 + n) * ldt + k0 + 8 * c) = o; }
  LDS_WAIT(); asm volatile("" ::: "memory");
}
struct ConvDesc { const float* W; const float* gs; unsigned char* WT8; int ldw, k0, scol0, ldt, drow0; };
__device__ __forceinline__ void p0_tr8_load(const ConvDesc& d, f32x4 (&v)[16], int lane) {
  const int c4 = (lane & 15) * 4, kr = lane >> 4;
#pragma unroll
  for (int i = 0; i < 16; ++i) { const int kk = 4 * i + kr; v[i] = *(const f32x4*)(d.W + (size_t)(d.k0 + kk) * d.ldw + d.scol0 + c4); }
}
__device__ __forceinline__ void p0_tr8_finish(const ConvDesc& d, f32x4 (&v)[16], float sc, LAS float* scr, int lane) {
  const int c4 = (lane & 15) * 4, kr = lane >> 4;
#pragma unroll
  for (int i = 0; i < 16; ++i) { const int kk = 4 * i + kr; f32x4 x = v[i]; if (d.gs) x = x * d.gs[d.k0 + kk]; LAS float* p = scr + kk * 65 + c4; p[0] = x.x; p[1] = x.y; p[2] = x.z; p[3] = x.w; }
  LDS_WAIT(); asm volatile("" ::: "memory");
  const int c = lane & 7;
#pragma unroll
  for (int j = 0; j < 8; ++j) { const int n = (lane >> 3) + 8 * j; const LAS float* s = scr + (8 * c) * 65 + n;
    float f[8];
#pragma unroll
    for (int q = 0; q < 8; ++q) f[q] = s[q * 65];
    *(GAS v2u*)(d.WT8 + (size_t)(d.drow0 + n) * d.ldt + d.k0 + 8 * c) = pack8_fp8(f, sc); }
  LDS_WAIT(); asm volatile("" ::: "memory");
}
__device__ __forceinline__ void p0_tr32(const float* W, int ldw, int k0, int scol0, int ncols, const float* gs, bf16* WT, int ldt, int drow0, LAS float* scr, int lane) {
#pragma unroll 8
  for (int i = 0; i < 32; ++i) { const int kk = 2 * i + (lane >> 5), c = lane & 31; float v = 0.f;
    if (c < ncols) { v = W[(size_t)(k0 + kk) * ldw + scol0 + c]; if (gs) v *= gs[k0 + kk]; }
    scr[kk * 65 + c] = v; }
  LDS_WAIT(); asm volatile("" ::: "memory");
  const int c = lane & 7;
#pragma unroll
  for (int j = 0; j < 4; ++j) { const int n = (lane >> 3) + 8 * j; const LAS float* s = scr + (8 * c) * 65 + n;
    v4u o; o.x = pk2(s[0 * 65], s[1 * 65]); o.y = pk2(s[2 * 65], s[3 * 65]); o.z = pk2(s[4 * 65], s[5 * 65]); o.w = pk2(s[6 * 65], s[7 * 65]);
    *(GAS v4u*)(WT + (size_t)(drow0 + n) * ldt + k0 + 8 * c) = o; }
  LDS_WAIT(); asm volatile("" ::: "memory");
}
__device__ __forceinline__ void rms_row_to_bf16(const float* xrow, bf16* orow, int lane) {
  const GAS f32x4* xr = (const GAS f32x4*)xrow + lane;
  f32x4 v[4]; float s = 0.f;
#pragma unroll
  for (int j = 0; j < 4; ++j) { v[j] = xr[64 * j]; s += (v[j].x * v[j].x + v[j].y * v[j].y) + (v[j].z * v[j].z + v[j].w * v[j].w); }
  const float rstd = rsqrtf(wave_sum(s) * (1.f / 1024.f) + 1e-6f);
  GAS unsigned long long* o8 = (GAS unsigned long long*)orow + lane;
#pragma unroll
  for (int j = 0; j < 4; ++j) o8[64 * j] = (unsigned long long)pk2(v[j].x * rstd, v[j].y * rstd) | ((unsigned long long)pk2(v[j].z * rstd, v[j].w * rstd) << 32);
}

#ifndef FP8EMU
#define FP8EMU 0
#endif
#ifndef MOE_FP8
#define MOE_FP8 1
#endif
#ifndef CONV_NT
#define CONV_NT 0
#endif
#ifndef MOE_FP8_DOWN
#define MOE_FP8_DOWN MOE_FP8
#endif
constexpr size_t WS_PO = 384 * MiB, WS_PML = 272 * MiB;
constexpr size_t WS_XG = 96 * MiB;
constexpr size_t WS_X2Q = 208 * MiB, WS_WEGU8 = 320 * MiB, WS_WED8 = 448 * MiB, WS_HID8 = 32 * MiB;
constexpr int CW_RDY = 8192 + 64 * 44;
constexpr int CW_CONV = 8192 + 64 * 40, CW_MDONE = 8192 + 64 * 41, CW_TDONE = 8192 + 64 * 42;
constexpr int CONV_IGU = 16 * 64, CONV_ID = 32 * 16, CONV_ITEMS = NEXP * (CONV_IGU + CONV_ID), CONV_CHUNKS = CONV_ITEMS / 8;
__device__ __forceinline__ ConvDesc conv_desc(Frame& F, const Args& a, int it) {
  auto I = [&](int i) { return (const float*)a.in[i]; };
  unsigned char* ws = F.ws; ConvDesc d;
  const int e = it / (CONV_IGU + CONV_ID); int r = it % (CONV_IGU + CONV_ID);
  if (r < CONV_IGU) { const int kb = r / 64, nb = r % 64, p = nb >> 2, j0 = (nb & 3) * 64; const bool up = j0 >= 128;
    d.W = (up ? I(I_WEU) : I(I_WEG)) + (size_t)e * 1024 * 2048; d.ldw = 2048; d.k0 = 64 * kb; d.scol0 = 128 * p + (up ? j0 - 128 : j0); d.gs = I(I_GFFN); d.WT8 = ws + WS_WEGU8 + (size_t)e * 4096 * 1024; d.ldt = 1024; d.drow0 = 64 * nb; }
  else { r -= CONV_IGU; const int kb = r / 16, nb = r % 16;
    d.W = I(I_WED) + (size_t)e * 2048 * 1024; d.ldw = 1024; d.k0 = 64 * kb; d.scol0 = 64 * nb; d.gs = nullptr; d.WT8 = ws + WS_WED8 + (size_t)e * 1024 * 2048; d.ldt = 2048; d.drow0 = 64 * nb; }
  return d;
}
__device__ __forceinline__ void conv_fill(Frame& F, const Args& a, int maxpairs) {
  static_assert(MOE_FP8 && MOE_FP8_DOWN, "the conversion filler writes fp8 expert weights");
  volatile LAS int* slot = (volatile LAS int*)(F.lds + LDSCTL_OFF + 16);
  LAS float* scr = (LAS float*)(F.lds + F.wave * 16640);
  for (int n = 0; n < maxpairs; ++n) {
    if (F.tid == 0) { int got = -1;
      if (__hip_atomic_load(F.ctl + CW_CONV, RLX_AGENT) < (unsigned)CONV_CHUNKS) { const unsigned c = __hip_atomic_fetch_add(F.ctl + CW_CONV, 2u, RLX_AGENT); if (c < (unsigned)CONV_CHUNKS) got = (int)c; }
      *slot = got; }
    __syncthreads();
    const int c = __builtin_amdgcn_readfirstlane(*slot);
    __syncthreads();
    if (c < 0) break;
    const ConvDesc d0 = conv_desc(F, a, c * 8 + F.wave), d1 = conv_desc(F, a, (c + 1) * 8 + F.wave);
    f32x4 v0[16], v1[16];
    p0_tr8_load(d0, v0, F.lane); p0_tr8_load(d1, v1, F.lane);
    p0_tr8_finish(d0, v0, 64.f, scr, F.lane); p0_tr8_finish(d1, v1, 64.f, scr, F.lane);
  }
}
__device__ __forceinline__ void p0_prologue(Frame& F, const Args& a, bool do_dense, bool do_experts) {
  LAS float* scr = (LAS float*)(F.lds + F.wave * 16640);
  const int gw = F.vcu * NWAVES + F.wave, NGW = F.G * NWAVES;
  auto I = [&](int i) { return (const float*)a.in[i]; };
  unsigned char* ws = F.ws;
  if (do_dense) {
    constexpr int I_WIN_ = 16 * 40, I_WQB_ = 4 * 12, I_WKVB_ = 4 * 16, I_SQ = 16 * 16;
    constexpr int NIT = I_WIN_ + I_WQB_ + I_WKVB_ + 5 * I_SQ;
    for (int it = gw; it < NIT; it += NGW) {
      int r = it;
      if (r < I_WIN_) { const int kb = r / 40, nb = r % 40; int sc, nc = 64;
        if (nb < 32) sc = 64 * nb; else if (nb < 36) sc = OFF_CQ + 64 * (nb - 32); else if (nb < 38) sc = OFF_CKV + 64 * (nb - 36); else if (nb == 38) { sc = OFF_KR; nc = 32; } else { sc = 0; nc = 0; }
        p0_tr(I(I_WIN), D_IN, 64 * kb, 1024, sc, nc, I(I_GMIX), (bf16*)(ws + WS_WIN), 1024, 64 * nb, scr, F.lane);
        if (nb == 38) p0_tr32(I(I_WIN), D_IN, 64 * kb, OFF_G, 16, I(I_GMIX), (bf16*)(ws + WS_WIN), 1024, PC_G, scr, F.lane);
        continue; } r -= I_WIN_;
      if (r < I_WQB_) { const int kb = r / 12, nb = r % 12; p0_tr(I(I_WQB), 768, 64 * kb, 256, 64 * nb, 64, I(I_GQA), (bf16*)(ws + WS_WQB), 256, 64 * nb, scr, F.lane); continue; } r -= I_WQB_;
      if (r < I_WKVB_) { const int kb = r / 16, nb = r % 16; const int h = nb & 7; const int sc = h * 128 + (nb >= 8 ? 64 : 0);
        p0_tr(I(I_WKVB), 1024, 64 * kb, 128, sc, 64, I(I_GKVA), (bf16*)(ws + WS_WKVB), 256, 64 * nb, scr, F.lane); continue; } r -= I_WKVB_;
      const int which = r / I_SQ; r %= I_SQ; const int kb = r / 16, nb = r % 16;
      const float* src = which == 0 ? I(I_WOUT) : which == 1 ? I(I_WMQ) : which == 2 ? I(I_WMK) : which == 3 ? I(I_WMV) : I(I_WMO);
      const float* gs = which == 1 ? I(I_GMX) : (which == 2 || which == 3) ? I(I_GMKV) : nullptr;
      bf16* dst = (bf16*)(ws + (which == 0 ? WS_WOUT : which == 1 ? WS_WMQ : which == 2 ? WS_WMK : which == 3 ? WS_WMV : WS_WMO));
      p0_tr(src, 1024, 64 * kb, 1024, 64 * nb, 64, gs, dst, 1024, 64 * nb, scr, F.lane);
    }
    for (int m0 = gw; m0 < MTOK; m0 += 4 * NGW) {
      f32x4 v[4][4];
#pragma unroll
      for (int u = 0; u < 4; ++u) { const GAS f32x4* xr = (const GAS f32x4*)(I(I_X) + (size_t)(m0 + u * NGW) * 1024) + F.lane;
#pragma unroll
        for (int j = 0; j < 4; ++j) v[u][j] = __builtin_nontemporal_load(xr + 64 * j); }
#pragma unroll
      for (int u = 0; u < 4; ++u) { float s = 0.f;
#pragma unroll
        for (int j = 0; j < 4; ++j) s += (v[u][j].x * v[u][j].x + v[u][j].y * v[u][j].y) + (v[u][j].z * v[u][j].z + v[u][j].w * v[u][j].w);
        const float rstd = rsqrtf(wave_sum(s) * (1.f / 1024.f) + 1e-6f);
        GAS unsigned long long* o8 = (GAS unsigned long long*)((bf16*)(ws + WS_XN) + (size_t)(m0 + u * NGW) * 1024) + F.lane;
#pragma unroll
        for (int j = 0; j < 4; ++j) o8[64 * j] = (unsigned long long)pk2(v[u][j].x * rstd, v[u][j].y * rstd) | ((unsigned long long)pk2(v[u][j].z * rstd, v[u][j].w * rstd) << 32); } }
    for (int m = gw; m < BATCH * NMEM; m += NGW) rms_row_to_bf16(I(I_MEM) + (size_t)m * 1024, (bf16*)(ws + WS_MEMN) + (size_t)m * 1024, F.lane);
    { const float* wr = I(I_WR); const float* gf = I(I_GFFN); float* wrg = (float*)(ws + WS_DEC + 65536);
      for (int i = (F.vcu * NTHR + F.tid); i < 1024 * 16; i += F.G * NTHR) wrg[i] = wr[i] * gf[i >> 4]; }
    { const int* pos = (const int*)a.in[I_POS]; float* rt = (float*)(ws + WS_ROPE);
      for (int i = (F.vcu * NTHR + F.tid); i < MTOK * 16; i += F.G * NTHR) { const int m = i >> 4, j = i & 15; const float inv = powf(10000.f, -(float)j / 16.f); const float ang = (float)pos[m] * inv;
        rt[m * 32 + j] = cosf(ang); rt[m * 32 + 16 + j] = sinf(ang); } }
  }
  if (do_experts) conv_fill(F, a, 1 << 30);
}

__device__ __forceinline__ v4u pack8(const float (&v)[8]) { v4u w; w.x = cvt_pk_bf16(v[0], v[1]); w.y = cvt_pk_bf16(v[2], v[3]); w.z = cvt_pk_bf16(v[4], v[5]); w.w = cvt_pk_bf16(v[6], v[7]); return w; }
__device__ __forceinline__ float sumsq8(const float (&v)[8]) { float s = 0.f;
#pragma unroll
  for (int i = 0; i < 8; ++i) s += v[i] * v[i];
  return s; }
struct EpiStore { static constexpr bool TWO_PASS = false; bf16* O; int ldc;
  __device__ __forceinline__ void row8(const pg8::Unit& u, int rloc, int cloc, const float (&v0)[8], const float (&v1)[8], int fq) const {
    bf16* p = O + (size_t)(u.pm * 256 + rloc) * ldc + u.pn * 256 + cloc; *(v4u*)p = pack8(v0); *(v4u*)(p + 128) = pack8(v1); } };
struct EpiProj { static constexpr bool TWO_PASS = false; bf16* P; float* ssq; float* sskv;
  __device__ __forceinline__ void row8(const pg8::Unit& u, int rloc, int cloc, const float (&v0)[8], const float (&v1)[8], int fq) const {
    const int row = u.pm * 256 + rloc; bf16* p = P + (size_t)row * PROJ_LD + u.pn * 256 + cloc; *(v4u*)p = pack8(v0); *(v4u*)(p + 128) = pack8(v1);
    if (u.pn == 8) { float s = sumsq8(v0) + sumsq8(v1); s += __shfl_xor(s, 16); s += __shfl_xor(s, 32); if (fq == 0) unsafeAtomicAdd(ssq + row, s); }
    if (u.pn == 9) { float s = sumsq8(v0); s += __shfl_xor(s, 16); s += __shfl_xor(s, 32); if (fq == 0) unsafeAtomicAdd(sskv + row, s); } } };
struct EpiQ { static constexpr bool TWO_PASS = false; bf16* Q; const float* ssq; const float* rope;
  __device__ __forceinline__ void rope8(float (&v)[8], int row, int fq) const {
    float pv[8];
#pragma unroll
    for (int i = 0; i < 8; ++i) pv[i] = __shfl_xor(v[i], 32);
    const float* cs = rope + (size_t)row * 32 + 8 * (fq & 1);
#pragma unroll
    for (int i = 0; i < 8; ++i) { const float c = cs[i], s = cs[16 + i]; v[i] = (fq < 2) ? (v[i] * c - pv[i] * s) : (v[i] * c + pv[i] * s); }
  }
  __device__ __forceinline__ void row8(const pg8::Unit& u, int rloc, int cloc, const float (&a0)[8], const float (&a1)[8], int fq) const {
    const int row = u.pm * 256 + rloc; const float r = rsqrtf(ssq[row] * (1.f / 256.f) + 1e-6f);
    float v0[8], v1[8];
#pragma unroll
    for (int i = 0; i < 8; ++i) { v0[i] = a0[i] * r; v1[i] = a1[i] * r; }
    const int g0 = u.pn * 8 + (cloc >> 5), g1 = g0 + 4;
    if (g0 % 3 == 2) rope8(v0, row, fq);
    if (g1 % 3 == 2) rope8(v1, row, fq);
    bf16* p = Q + (size_t)row * 768 + u.pn * 256 + cloc; *(v4u*)p = pack8(v0); *(v4u*)(p + 128) = pack8(v1); } };
struct EpiKV { static constexpr bool TWO_PASS = false; bf16* KMp; bf16* VMp; const float* sskv;
  __device__ __forceinline__ void put(int row, int c, const float (&v)[8], float r) const {
    float w[8];
#pragma unroll
    for (int i = 0; i < 8; ++i) w[i] = v[i] * r;
    if (c < 512) *(v4u*)(KMp + (size_t)row * 768 + (c >> 6) * 96 + (c & 63)) = pack8(w); else *(v4u*)(VMp + (size_t)row * 512 + (c - 512)) = pack8(w); }
  __device__ __forceinline__ void row8(const pg8::Unit& u, int rloc, int cloc, const float (&a0)[8], const float (&a1)[8], int fq) const {
    const int row = u.pm * 256 + rloc; const float r = rsqrtf(sskv[row] * (1.f / 128.f) + 1e-6f);
    put(row, u.pn * 256 + cloc, a0, r); put(row, u.pn * 256 + 128 + cloc, a1, r); } };

__device__ __forceinline__ void unpack8(v4u w, float (&f)[8]) { f[0] = bflo(w.x); f[1] = bfhi(w.x); f[2] = bflo(w.y); f[3] = bfhi(w.y); f[4] = bflo(w.z); f[5] = bfhi(w.z); f[6] = bflo(w.w); f[7] = bfhi(w.w); }
__device__ __forceinline__ float log_sigmoid(float x) { return fminf(x, 0.f) - log1pf(__expf(-fabsf(x))); }

__device__ __forceinline__ void p2_elementwise(Frame& F, const Args& a) {
  unsigned char* ws = F.ws;
  const bf16* P = (const bf16*)(ws + WS_PROJ);
  { const float* cw = (const float*)a.in[I_CONV]; bf16* QC = (bf16*)(ws + WS_QC); bf16* KC = (bf16*)(ws + WS_KC);
    const int gi = F.vcu * NTHR + F.tid, c = (gi & 127) * 8, mstep = (F.G * NTHR) >> 7; float w0[8], w1[8], w2[8];
#pragma unroll
    for (int j = 0; j < 8; ++j) { w0[j] = cw[c + j]; w1[j] = cw[1024 + c + j]; w2[j] = cw[2048 + c + j]; }
    for (int m0 = gi >> 7; m0 < MTOK; m0 += 2 * mstep) {
      v4u r0[2], r1[2], r2[2];
#pragma unroll
      for (int u = 0; u < 2; ++u) { const int m = m0 + u * mstep, t = m & (SEQ - 1); const bf16* pr = P + (size_t)m * PROJ_LD + c;
        r1[u] = *(const v4u*)pr; r0[u] = t > 0 ? *(const v4u*)(pr - PROJ_LD) : (v4u){0u, 0u, 0u, 0u}; r2[u] = t < SEQ - 1 ? *(const v4u*)(pr + PROJ_LD) : (v4u){0u, 0u, 0u, 0u}; }
#pragma unroll
      for (int u = 0; u < 2; ++u) { const int m = m0 + u * mstep; float x0[8], x1[8], x2[8], o[8]; unpack8(r0[u], x0); unpack8(r1[u], x1); unpack8(r2[u], x2);
#pragma unroll
        for (int j = 0; j < 8; ++j) { float v = x0[j] * w0[j] + x1[j] * w1[j] + x2[j] * w2[j]; v = v * sigmoidf_(v); o[j] = (c < 512) ? v : v * 0.08838834764831845f; }
        if (c < 512) *(v4u*)(QC + (size_t)m * 512 + c) = pack8(o); else *(v4u*)(KC + (size_t)m * 512 + c - 512) = pack8(o); } } }
  { const float* rope = (const float*)(ws + WS_ROPE); bf16* KMp = (bf16*)(ws + WS_KM);
    for (int i = F.vcu * NTHR + F.tid; i < MTOK * 16; i += F.G * NTHR) { const int m = i >> 4, j = i & 15;
      const float t1 = bf2f(P[(size_t)m * PROJ_LD + PC_KR + j]), t2 = bf2f(P[(size_t)m * PROJ_LD + PC_KR + 16 + j]); const float c = rope[m * 32 + j], s = rope[m * 32 + 16 + j];
      const bf16 o1 = (bf16)f2bf(t1 * c - t2 * s), o2 = (bf16)f2bf(t2 * c + t1 * s);
#pragma unroll
      for (int h = 0; h < 8; ++h) { KMp[(size_t)m * 768 + h * 96 + 64 + j] = o1; KMp[(size_t)m * 768 + h * 96 + 80 + j] = o2; } } }
  { const float* bg = (const float*)a.in[I_BG]; float* GSC = (float*)(ws + WS_GSC); float* DEC = (float*)(ws + WS_DEC);
    const int gw = F.vcu * NWAVES + F.wave, NGW = F.G * NWAVES;
    for (int it = gw; it < 32 * 64; it += NGW) { const int seq = it >> 6, c = it & 63, dir = seq & 1, h = (seq >> 1) & 3, b = seq >> 3;
      const int p = c * 64 + F.lane, t = dir ? (SEQ - 1 - p) : p; const size_t row = (size_t)b * SEQ + t;
      const int gi = (dir ? 8 : 0) + h, gf = (dir ? 12 : 4) + h;
      const float li = bf2f(P[row * PROJ_LD + PC_G + gi]) + bg[gi]; const float lf = log_sigmoid(bf2f(P[row * PROJ_LD + PC_G + gf]) + bg[gf]);
      float bs = lf;
#pragma unroll
      for (int o = 1; o < 64; o <<= 1) { const float y = __shfl_up(bs, o); if (F.lane >= o) bs += y; }
      const float av = li - bs; float pm = av;
#pragma unroll
      for (int o = 1; o < 64; o <<= 1) { const float y = __shfl_up(pm, o); if (F.lane >= o) pm = fmaxf(pm, y); }
      float* gs = GSC + (size_t)seq * 3 * SEQ; gs[p] = bs; gs[SEQ + p] = av; gs[2 * SEQ + p] = pm;
      if (F.lane == 63) { DEC[seq * 128 + c] = bs; DEC[seq * 128 + 64 + c] = pm; } } }
}
namespace mla {
constexpr int DQK = 96, DV = 64, NW = 8, QBLK = 32, KVBLK = 64, LDQ = 768, LDK = 768, LDV = 512, LDO = 1024;
constexpr float SCALE = 0.10206207261596575f;
constexpr float THR = 8.f;
constexpr int SHM_V = 16384, SHM_K = 16384, SHM_ATTN = 2 * SHM_V + 2 * SHM_K + NW * 64 * 4;
#define KSWZ(row, colB) ((row) * 256 + ((colB) ^ (((row) & 7) << 4)))
#define SBAR() __builtin_amdgcn_sched_barrier(0)
__device__ __forceinline__ int crow(int r, int hi) { return (r & 3) + 8 * (r >> 2) + 4 * hi; }
__device__ __forceinline__ void partialSM(f32x16& p0, f32x16& p1, float& m_reg, float& mn, float& alpha) {
  constexpr float C = SCALE * 1.4426950408889634f;
  float pmax = p0[0];
#pragma unroll
  for (int r = 1; r < 16; ++r) pmax = fmaxf(pmax, p0[r]);
#pragma unroll
  for (int r = 0; r < 16; ++r) pmax = fmaxf(pmax, p1[r]);
  { auto rr = __builtin_amdgcn_permlane32_swap(__float_as_uint(pmax), __float_as_uint(pmax), false, false);
    pmax = fmaxf(__uint_as_float(rr[0]), __uint_as_float(rr[1])); }
  if (__builtin_expect(__all(pmax - m_reg <= THR / SCALE), 1)) { mn = m_reg; alpha = 1.f; }
  else { mn = fmaxf(m_reg, pmax); alpha = __builtin_amdgcn_exp2f((m_reg - mn) * C); m_reg = mn; }
  const float mnC = -mn * C;
#pragma unroll
  for (int r = 0; r < 16; ++r) p0[r] = fmaf(p0[r], C, mnC);
#pragma unroll
  for (int r = 0; r < 16; ++r) p1[r] = fmaf(p1[r], C, mnC);
#pragma unroll
  for (int r = 0; r < 16; ++r) p0[r] = __builtin_amdgcn_exp2f(p0[r]);
}
__device__ __forceinline__ void finishSM(f32x16& p0, f32x16& p1, float alpha, float& l_reg, bf16x8& pa0, bf16x8& pa1, bf16x8& pa2, bf16x8& pa3) {
#pragma unroll
  for (int r = 0; r < 16; ++r) p1[r] = __builtin_amdgcn_exp2f(p1[r]);
  float ps = 0;
#pragma unroll
  for (int r = 0; r < 16; ++r) ps += p0[r];
#pragma unroll
  for (int r = 0; r < 16; ++r) ps += p1[r];
  { auto rr = __builtin_amdgcn_permlane32_swap(__float_as_uint(ps), __float_as_uint(ps), false, false);
    ps = __uint_as_float(rr[0]) + __uint_as_float(rr[1]); }
  l_reg = l_reg * alpha + ps;
#define PK4(P, BASE, OUT) do { unsigned a0 = cvt_pk_bf16(P[BASE + 0], P[BASE + 1]), a1 = cvt_pk_bf16(P[BASE + 2], P[BASE + 3]);   \
    unsigned b0 = cvt_pk_bf16(P[BASE + 4], P[BASE + 5]), b1 = cvt_pk_bf16(P[BASE + 6], P[BASE + 7]);                              \
    auto r0 = __builtin_amdgcn_permlane32_swap(a0, b0, false, false); auto r1 = __builtin_amdgcn_permlane32_swap(a1, b1, false, false); \
    v4u w = {r0[0], r1[0], r0[1], r1[1]}; OUT = __builtin_bit_cast(bf16x8, w); } while (0)
  PK4(p0, 0, pa0); PK4(p0, 8, pa1); PK4(p1, 0, pa2); PK4(p1, 8, pa3);
#undef PK4
}
__device__ __forceinline__ void qkt(f32x16& p0, f32x16& p1, const char* Ks, const bf16x8* qr, int r32, int hi) {
  p0 = f32x16{}; p1 = f32x16{};
#pragma unroll
  for (int d0 = 0; d0 < DQK / 16; ++d0) { const int cb = (d0 * 16 + hi * 8) * 2;
    const bf16x8 b0 = *reinterpret_cast<const bf16x8*>(Ks + KSWZ(r32, cb));
    const bf16x8 b1 = *reinterpret_cast<const bf16x8*>(Ks + KSWZ(32 + r32, cb));
    p0 = __builtin_amdgcn_mfma_f32_32x32x16_bf16(b0, qr[d0], p0, 0, 0, 0);
    p1 = __builtin_amdgcn_mfma_f32_32x32x16_bf16(b1, qr[d0], p1, 0, 0, 0); }
}
__device__ __forceinline__ int v_st(int k, int c) { const int kk = (k & ~0xC) | ((k & 4) << 1) | ((k & 8) >> 1); return ((kk >> 3) * 4 + (c >> 5)) * 512 + ((kk & 7) * 32 + (c & 31)) * 2; }
__device__ __forceinline__ int v_rd_base(int lane) { return ((lane & 3) << 3) | (((lane >> 2) & 3) << 6) | (((lane >> 4) & 1) << 5) | (((lane >> 5) & 1) << 8); }
constexpr int v_rd_off(int d0, int ks, int half) { return d0 * 512 + ks * 4096 + half * 2048; }
template <int OFF> __device__ __forceinline__ s16x4 tr_read(int vb) {
  s16x4 r; asm volatile("ds_read_b64_tr_b16 %0, %1 offset:%2" : "=&v"(r) : "v"(vb), "i"(OFF) : "memory"); return r;
}
template <int D0> __device__ __forceinline__ void pv_one(f32x16& od, int vb, bf16x8 pa0, bf16x8 pa1, bf16x8 pa2, bf16x8 pa3) {
  const s16x4 l0 = tr_read<v_rd_off(D0, 0, 0)>(vb), h0 = tr_read<v_rd_off(D0, 0, 1)>(vb), l1 = tr_read<v_rd_off(D0, 1, 0)>(vb), h1 = tr_read<v_rd_off(D0, 1, 1)>(vb);
  const s16x4 l2 = tr_read<v_rd_off(D0, 2, 0)>(vb), h2 = tr_read<v_rd_off(D0, 2, 1)>(vb), l3 = tr_read<v_rd_off(D0, 3, 0)>(vb), h3 = tr_read<v_rd_off(D0, 3, 1)>(vb);
  asm volatile("s_waitcnt lgkmcnt(0)" ::: "memory"); SBAR();
#define PK(L, H) (bf16x8){L[0], L[1], L[2], L[3], H[0], H[1], H[2], H[3]}
  od = __builtin_amdgcn_mfma_f32_32x32x16_bf16(pa0, PK(l0, h0), od, 0, 0, 0);
  od = __builtin_amdgcn_mfma_f32_32x32x16_bf16(pa1, PK(l1, h1), od, 0, 0, 0);
  od = __builtin_amdgcn_mfma_f32_32x32x16_bf16(pa2, PK(l2, h2), od, 0, 0, 0);
  od = __builtin_amdgcn_mfma_f32_32x32x16_bf16(pa3, PK(l3, h3), od, 0, 0, 0);
#undef PK
}
__device__ __forceinline__ void pv_d0(f32x16* o, int vb, bf16x8 pa0, bf16x8 pa1, bf16x8 pa2, bf16x8 pa3) {
  pv_one<0>(o[0], vb, pa0, pa1, pa2, pa3); pv_one<1>(o[1], vb, pa0, pa1, pa2, pa3);
}
constexpr int LDP = 8 * 64, LDML = 8 * 2;
__device__ __forceinline__ void attn_unit(const bf16* __restrict__ Qb, const bf16* __restrict__ Kh, const bf16* __restrict__ Vh, bf16* __restrict__ Op, float* __restrict__ MLp, int seq, char* lds) {
  int tid = threadIdx.x; asm volatile("" : "+v"(tid));
  const int wid = tid >> 6, lane = tid & 63, r32 = lane & 31, hi = lane >> 5;
  char* V_lds = lds; char* K_lds = lds + 2 * SHM_V;
  float* wsf = (float*)(lds + 2 * SHM_V + 2 * SHM_K) + wid * 64; float* li_l = wsf; float* al_l = wsf + 32;
  float m_reg = -1e30f, l_reg = 0; f32x16 o[2] = {}; bf16x8 qr[DQK / 16];
  const bf16* Qw = Qb + (long)(wid * QBLK + r32) * LDQ + hi * 8;
#pragma unroll
  for (int d0 = 0; d0 < DQK / 16; ++d0) qr[d0] = *reinterpret_cast<const bf16x8*>(Qw + d0 * 16);
  const int sr = tid >> 4, sc = (tid & 15) * 8, vst0 = v_st(sr, sc & 63), vst1 = v_st(32 + sr, sc & 63);
  const bool doK = sc < DQK, doV = sc < DV;
  const int vb0 = (int)(uintptr_t)V_lds + v_rd_base(lane);
  struct { bf16x8 vs0, vs1, ks0, ks1; } sr_[2];
#define SLOAD(i, k0) do { if (doV) { sr_[i].vs0 = *reinterpret_cast<const bf16x8*>(&Vh[(long)((k0) + sr) * LDV + sc]); sr_[i].vs1 = *reinterpret_cast<const bf16x8*>(&Vh[(long)((k0) + 32 + sr) * LDV + sc]); } \
    if (doK) { sr_[i].ks0 = *reinterpret_cast<const bf16x8*>(&Kh[(long)((k0) + sr) * LDK + sc]); sr_[i].ks1 = *reinterpret_cast<const bf16x8*>(&Kh[(long)((k0) + 32 + sr) * LDK + sc]); } } while (0)
#define SWRITE(b, i) do { if (doV) { *(bf16x8*)(V_lds + (b) * SHM_V + vst0) = sr_[i].vs0; *(bf16x8*)(V_lds + (b) * SHM_V + vst1) = sr_[i].vs1; } \
    if (doK) { const int kc = sc * 2; *(bf16x8*)(K_lds + (b) * SHM_K + KSWZ(sr, kc)) = sr_[i].ks0; *(bf16x8*)(K_lds + (b) * SHM_K + KSWZ(32 + sr, kc)) = sr_[i].ks1; } } while (0)
#define SWAIT() asm volatile("s_waitcnt vmcnt(4)" ::: "memory")
#define RESC(a) do { if (__any((a) < 1.f)) { if (hi == 0) al_l[r32] = (a); asm volatile("s_waitcnt lgkmcnt(0)" ::: "memory"); \
    _Pragma("unroll") for (int d = 0; d < 2; ++d) _Pragma("unroll") for (int r = 0; r < 16; ++r) o[d][r] *= al_l[crow(r, hi)]; } } while (0)
  f32x16 pA0, pA1, pB0, pB1; float mnA, mnB, alA, alB; bf16x8 pa0, pa1, pa2, pa3; const int NT = seq / KVBLK;
  constexpr int SE = 0, SO = 1;
  SLOAD(SE, 0); asm volatile("s_waitcnt vmcnt(0)" ::: "memory"); SWRITE(0, SE); __syncthreads();
  qkt(pA0, pA1, K_lds, qr, r32, hi); partialSM(pA0, pA1, m_reg, mnA, alA);
  SLOAD(SO, KVBLK); if (2 < NT) SLOAD(SE, 2 * KVBLK);
  SWAIT(); SWRITE(1, SO); __syncthreads();
  for (int j = 1; j + 1 < NT; j += 2) {
    SBAR(); qkt(pB0, pB1, K_lds + SHM_K, qr, r32, hi);
    finishSM(pA0, pA1, alA, l_reg, pa0, pa1, pa2, pa3); SBAR();
    SLOAD(SO, (j + 2) * KVBLK); SBAR();
    pv_d0(o, vb0, pa0, pa1, pa2, pa3); partialSM(pB0, pB1, m_reg, mnB, alB);
    __syncthreads(); SWAIT(); SWRITE(0, SE);
    RESC(alB); __syncthreads();
    SBAR(); qkt(pA0, pA1, K_lds, qr, r32, hi);
    finishSM(pB0, pB1, alB, l_reg, pa0, pa1, pa2, pa3); SBAR();
    if (j + 3 < NT) SLOAD(SE, (j + 3) * KVBLK); SBAR();
    pv_d0(o, vb0 + SHM_V, pa0, pa1, pa2, pa3); partialSM(pA0, pA1, m_reg, mnA, alA);
    __syncthreads(); SWAIT(); SWRITE(1, SO);
    RESC(alA); __syncthreads();
  }
  SBAR(); qkt(pB0, pB1, K_lds + SHM_K, qr, r32, hi);
  finishSM(pA0, pA1, alA, l_reg, pa0, pa1, pa2, pa3); SBAR();
  pv_d0(o, vb0, pa0, pa1, pa2, pa3); partialSM(pB0, pB1, m_reg, mnB, alB);
  __syncthreads(); RESC(alB);
  finishSM(pB0, pB1, alB, l_reg, pa0, pa1, pa2, pa3); SBAR();
  pv_d0(o, vb0 + SHM_V, pa0, pa1, pa2, pa3);
  __syncthreads();
  { float* st = (float*)lds + wid * (32 * 68);
#pragma unroll
    for (int r = 0; r < 16; ++r) { const int orow = crow(r, hi); st[orow * 68 + r32] = o[0][r]; st[orow * 68 + 32 + r32] = o[1][r]; }
    asm volatile("s_waitcnt lgkmcnt(0)" ::: "memory");
    bf16* op = Op + (long)(wid * QBLK + r32) * LDP + hi * 32;
#pragma unroll
    for (int j = 0; j < 4; ++j) { const f32x4 x0 = *(const f32x4*)(st + r32 * 68 + hi * 32 + 8 * j), x1 = *(const f32x4*)(st + r32 * 68 + hi * 32 + 8 * j + 4);
      const float w[8] = {x0.x, x0.y, x0.z, x0.w, x1.x, x1.y, x1.z, x1.w}; *(v4u*)(op + 8 * j) = pack8(w); }
    if (hi == 0) { float* mp = MLp + (long)(wid * QBLK + r32) * LDML; mp[0] = m_reg; mp[1] = l_reg; } }
  __syncthreads();
#undef SLOAD
#undef SWRITE
#undef SWAIT
#undef RESC
}
#undef KSWZ
#undef SBAR
}

__device__ __forceinline__ int queue_pull(Frame& F, gu32* heads, int nq, int nper, int myq) {
  volatile LAS int* slot = (volatile LAS int*)(F.lds + LDSCTL_OFF);
  if (F.tid == 0) { int got = -1;
    for (int k = 0; k < nq; ++k) { const int q = (myq + k) % nq;
      if (__hip_atomic_load(heads + 64 * q, RLX_AGENT) >= (unsigned)nper) continue;
      const unsigned i = __hip_atomic_fetch_add(heads + 64 * q, 1u, RLX_AGENT);
      if (i < (unsigned)nper) { got = q * nper + (int)i; break; } }
    *slot = got; }
  __syncthreads();
  const int r = __builtin_amdgcn_readfirstlane(*slot);
  __syncthreads();
  return r;
}
__device__ __forceinline__ void p3_attention(Frame& F, const Args& a, char* lds_generic, unsigned xcc, int qoff) {
  unsigned char* ws = F.ws;
  const bf16* QMp = (const bf16*)(ws + WS_QM); const bf16* KMp = (const bf16*)(ws + WS_KM); const bf16* VMp = (const bf16*)(ws + WS_VM); bf16* PO = (bf16*)(ws + WS_PO); float* PML = (float*)(ws + WS_PML);
#ifndef WAIT_MODE
#define WAIT_MODE 1
#endif
  bool waited = false; (void)waited;
  for (;;) {
    const int u = queue_pull(F, F.ctl + CW_Q + qoff, 8, 128, (int)(xcc & 7u));
    if (u < 0) break;
    const int bh = u >> 5, qb = (u >> 1) & 15, kh = u & 1, b = bh >> 3, h = bh & 7;
#if WAIT_MODE == 0
    if (F.tid == 0) { unsigned sp = 0;
      while (__hip_atomic_load(F.ctl + CW_RDY + 64 * b, RLX_AGENT) < 112u) { __builtin_amdgcn_s_sleep(2); if (++sp > (1u << 24)) break; }
      __builtin_amdgcn_fence(__ATOMIC_ACQUIRE, "agent"); }
    asm volatile("s_waitcnt vmcnt(0)" ::: "memory"); __syncthreads();
#else
    if (!waited) { waited = true;
      if (F.tid == 0) { unsigned sp = 0;
        for (int bb = 0; bb < 4; ++bb) while (__hip_atomic_load(F.ctl + CW_RDY + 64 * bb, RLX_AGENT) < 112u) { __builtin_amdgcn_s_sleep(2); if (++sp > (1u << 24)) break; }
        __builtin_amdgcn_fence(__ATOMIC_ACQUIRE, "agent"); }
      asm volatile("s_waitcnt vmcnt(0)" ::: "memory"); __syncthreads(); }
#endif
    const size_t row0 = (size_t)b * SEQ + qb * 256, key0 = (size_t)b * SEQ + kh * (SEQ / 2);
    mla::attn_unit(QMp + row0 * 768 + h * 96, KMp + key0 * 768 + h * 96, VMp + key0 * 512 + h * 64,
                   PO + ((size_t)kh * MTOK + row0) * 512 + h * 64, PML + ((size_t)kh * MTOK + row0) * 16 + h * 2, SEQ / 2, lds_generic);
  }
}
namespace mls {
using mla::crow; using mla::v_st; using mla::v_rd_base;
#define KSWZ(row, colB) ((row) * 256 + ((colB) ^ (((row) & 7) << 4)))
constexpr int OFF_QS = 0, OFF_KS = 16384, OFF_KP = 32768, OFF_VV = 49152, OFF_CT = 65536, OFF_SC = 98304, OFF_NB = 99328, OFF_NP = 100352, OFF_CH = 104448, OFF_WS = 105472;
template <int OFF> __device__ __forceinline__ s16x4 trr(int vb) { s16x4 r; asm volatile("ds_read_b64_tr_b16 %0, %1 offset:%2" : "=&v"(r) : "v"(vb), "i"(OFF) : "memory"); return r; }
#define PKF(L, H) (bf16x8){L[0], L[1], L[2], L[3], H[0], H[1], H[2], H[3]}
__device__ __forceinline__ void vfrags(int img, int d0, int lane, bf16x8 (&f)[4]) {
  const int vb = img + v_rd_base(lane) + d0 * 512;
  const s16x4 l0 = trr<0>(vb), h0 = trr<2048>(vb), l1 = trr<4096>(vb), h1 = trr<4096 + 2048>(vb), l2 = trr<8192>(vb), h2 = trr<8192 + 2048>(vb), l3 = trr<12288>(vb), h3 = trr<12288 + 2048>(vb);
  asm volatile("s_waitcnt lgkmcnt(0)" ::: "memory"); __builtin_amdgcn_sched_barrier(0);
  f[0] = PKF(l0, h0); f[1] = PKF(l1, h1); f[2] = PKF(l2, h2); f[3] = PKF(l3, h3);
}
__device__ __forceinline__ void pack_p(const f32x16& p0, const f32x16& p1, bf16x8& pa0, bf16x8& pa1, bf16x8& pa2, bf16x8& pa3) {
#define PK4(P, BASE, OUT) do { unsigned a0 = cvt_pk_bf16(P[BASE + 0], P[BASE + 1]), a1 = cvt_pk_bf16(P[BASE + 2], P[BASE + 3]);   \
    unsigned b0 = cvt_pk_bf16(P[BASE + 4], P[BASE + 5]), b1 = cvt_pk_bf16(P[BASE + 6], P[BASE + 7]);                              \
    auto r0 = __builtin_amdgcn_permlane32_swap(a0, b0, false, false); auto r1 = __builtin_amdgcn_permlane32_swap(a1, b1, false, false); \
    v4u w = {r0[0], r1[0], r0[1], r1[1]}; OUT = __builtin_bit_cast(bf16x8, w); } while (0)
  PK4(p0, 0, pa0); PK4(p0, 8, pa1); PK4(p1, 0, pa2); PK4(p1, 8, pa3);
#undef PK4
}
__device__ __forceinline__ float swap_add(float v) { auto rr = __builtin_amdgcn_permlane32_swap(__float_as_uint(v), __float_as_uint(v), false, false); return __uint_as_float(rr[0]) + __uint_as_float(rr[1]); }

__device__ __forceinline__ void mlstm_seq(int seq, unsigned char* ws, char* lds) {
  int tid = threadIdx.x; asm volatile("" : "+v"(tid));
  const int wid = __builtin_amdgcn_readfirstlane(tid >> 6), lane = tid & 63, r32 = lane & 31, hi = lane >> 5, rb = wid >> 2, cb = wid & 3;
  const int dir = seq & 1, h = (seq >> 1) & 3, b = seq >> 3;
  const bf16* QC = (const bf16*)(ws + WS_QC); const bf16* KC = (const bf16*)(ws + WS_KC); const bf16* P = (const bf16*)(ws + WS_PROJ);
  const float* gs = (const float*)(ws + WS_GSC) + (size_t)seq * 3 * SEQ; const float* dec = (const float*)(ws + WS_DEC) + seq * 128;
  bf16* H = (bf16*)(ws + (dir ? WS_HB : WS_HF));
  float* sc_alpha = (float*)(lds + OFF_SC); float* sc_a = sc_alpha + 64; float* sc_iw = sc_alpha + 128; float* sc_en = sc_alpha + 192;
  float* nbuf = (float*)(lds + OFF_NB); float* npart = (float*)(lds + OFF_NP);
  float* ch_mprev = (float*)(lds + OFF_CH); float* ch_mnew = ch_mprev + 64; float* ch_dec = ch_mprev + 128; float* ch_g = ch_mprev + 192;
  float* wsf = (float*)(lds + OFF_WS) + wid * 32;
  const int ldsb = (int)(uintptr_t)lds;
  if (tid < 64) {
    if (tid == 0) { float m = 0.f; for (int c = 0; c < 64; ++c) { const float g = dec[c], wm = dec[64 + c]; const float mn = fmaxf(g + m, g + wm); ch_mprev[c] = m; ch_mnew[c] = mn; ch_dec[c] = __expf(g + m - mn); ch_g[c] = g; m = mn; } } }
  for (int i = tid; i < 32768 / 16; i += NTHR) ((v4u*)(lds + OFF_CT))[i] = (v4u){0u, 0u, 0u, 0u};
  if (tid < 128) nbuf[tid] = 0.f;
  f32x16 cacc[3]; cacc[0] = f32x16{}; cacc[1] = f32x16{}; cacc[2] = f32x16{};
  const int nown = rb ? 1 : 3;
  __syncthreads();
  const int sr = tid >> 4, sc = (tid & 15) * 8;
  v4u gq0, gq1, gk0, gk1, gv0, gv1; float ga0, ga1, sb = 0.f, sa = 0.f, spm = 0.f;
#define ROWOF(p) ((size_t)b * SEQ + (dir ? (SEQ - 1 - (p)) : (p)))
#define LOADC(c) do { const int p0_ = 64 * (c) + sr, p1_ = p0_ + 32; const size_t r0_ = ROWOF(p0_), r1_ = ROWOF(p1_); \
    gq0 = *(const v4u*)(QC + r0_ * 512 + h * 128 + sc); gq1 = *(const v4u*)(QC + r1_ * 512 + h * 128 + sc); \
    gk0 = *(const v4u*)(KC + r0_ * 512 + h * 128 + sc); gk1 = *(const v4u*)(KC + r1_ * 512 + h * 128 + sc); \
    gv0 = *(const v4u*)(P + r0_ * PROJ_LD + 1024 + h * 128 + sc); gv1 = *(const v4u*)(P + r1_ * PROJ_LD + 1024 + h * 128 + sc); \
    ga0 = gs[SEQ + p0_]; ga1 = gs[SEQ + p1_]; \
    if (tid < 64) { sb = gs[64 * (c) + tid]; sa = gs[SEQ + 64 * (c) + tid]; spm = gs[2 * SEQ + 64 * (c) + tid]; } } while (0)
#define WRITEC(c) do { \
    *(v4u*)(lds + OFF_QS + KSWZ(sr, sc * 2)) = gq0; *(v4u*)(lds + OFF_QS + KSWZ(32 + sr, sc * 2)) = gq1; \
    *(v4u*)(lds + OFF_KS + KSWZ(sr, sc * 2)) = gk0; *(v4u*)(lds + OFF_KS + KSWZ(32 + sr, sc * 2)) = gk1; \
    *(v4u*)(lds + OFF_VV + v_st(sr, sc)) = gv0; *(v4u*)(lds + OFF_VV + v_st(32 + sr, sc)) = gv1; \
    { const float gc_ = ch_g[c], mn_ = ch_mnew[c]; const float w0_ = __expf(gc_ + ga0 - mn_), w1_ = __expf(gc_ + ga1 - mn_); float f0_[8], f1_[8], cs_[8]; unpack8(gk0, f0_); unpack8(gk1, f1_); \
      _Pragma("unroll") for (int j = 0; j < 8; ++j) { f0_[j] *= w0_; f1_[j] *= w1_; cs_[j] = f0_[j] + f1_[j]; } \
      *(v4u*)(lds + OFF_KP + v_st(sr, sc)) = pack8(f0_); *(v4u*)(lds + OFF_KP + v_st(32 + sr, sc)) = pack8(f1_); \
      _Pragma("unroll") for (int j = 0; j < 8; ++j) { cs_[j] += __shfl_xor(cs_[j], 16); cs_[j] += __shfl_xor(cs_[j], 32); } \
      if ((lane >> 4) == 0) { _Pragma("unroll") for (int j = 0; j < 8; ++j) npart[wid * 128 + sc + j] = cs_[j]; } } \
    if (tid < 64) { const float m_ = ch_mprev[c]; const float mt_ = fmaxf(sb + m_, sb + spm); sc_alpha[tid] = sb - mt_; sc_a[tid] = sa; sc_iw[tid] = __expf(sb + m_ - mt_); sc_en[tid] = __expf(-mt_); } } while (0)
  LOADC(0); WRITEC(0);
  __syncthreads();
  for (int c = 0; c < 64; ++c) {
    if (c + 1 < 64) LOADC(c + 1);
    const float* nb = nbuf + (c & 1) * 128;
    if (tid < 128) { float s = 0.f;
#pragma unroll
      for (int w = 0; w < 8; ++w) s += npart[w * 128 + tid];
      nbuf[((c + 1) & 1) * 128 + tid] = ch_dec[c] * nb[tid] + s; }
    bf16x8 qr[8];
#pragma unroll
    for (int d0 = 0; d0 < 8; ++d0) qr[d0] = *(const bf16x8*)(lds + OFF_QS + KSWZ(32 * rb + r32, (16 * d0 + 8 * hi) * 2));
    f32x16 p0 = f32x16{}, p1 = f32x16{};
#pragma unroll
    for (int d0 = 0; d0 < 8; ++d0) { const bf16x8 k0 = *(const bf16x8*)(lds + OFF_KS + KSWZ(r32, (16 * d0 + 8 * hi) * 2)); p0 = __builtin_amdgcn_mfma_f32_32x32x16_bf16(k0, qr[d0], p0, 0, 0, 0); }
    if (rb == 1) {
#pragma unroll
      for (int d0 = 0; d0 < 8; ++d0) { const bf16x8 k1 = *(const bf16x8*)(lds + OFF_KS + KSWZ(32 + r32, (16 * d0 + 8 * hi) * 2)); p1 = __builtin_amdgcn_mfma_f32_32x32x16_bf16(k1, qr[d0], p1, 0, 0, 0); }
    }
    const float al = sc_alpha[32 * rb + r32];
    if (rb == 0) {
#pragma unroll
      for (int r = 0; r < 16; ++r) { const int sl = crow(r, hi); p0[r] = (sl <= r32) ? __expf(al + sc_a[sl]) * p0[r] : 0.f; }
    } else {
#pragma unroll
      for (int r = 0; r < 16; ++r) { const int sl = crow(r, hi); p0[r] = __expf(al + sc_a[sl]) * p0[r]; p1[r] = (sl <= r32) ? __expf(al + sc_a[32 + sl]) * p1[r] : 0.f; }
    }
    float ps = 0.f;
#pragma unroll
    for (int r = 0; r < 16; ++r) ps += p0[r] + p1[r];
    ps = swap_add(ps);
    bf16x8 pa0, pa1, pa2, pa3; pack_p(p0, p1, pa0, pa1, pa2, pa3);
    float qn = 0.f;
#pragma unroll
    for (int d0 = 0; d0 < 8; ++d0) { const f32x4 n0 = *(const f32x4*)(nb + 16 * d0 + 8 * hi), n1 = *(const f32x4*)(nb + 16 * d0 + 8 * hi + 4); const v4u qw = __builtin_bit_cast(v4u, qr[d0]);
      qn += bflo(qw.x) * n0.x + bfhi(qw.x) * n0.y + bflo(qw.y) * n0.z + bfhi(qw.y) * n0.w + bflo(qw.z) * n1.x + bfhi(qw.z) * n1.y + bflo(qw.w) * n1.z + bfhi(qw.w) * n1.w; }
    qn = swap_add(qn);
    { const float iwt = sc_iw[32 * rb + r32]; const float den = iwt * qn + ps; const float rd = 1.f / fmaxf(fabsf(den), sc_en[32 * rb + r32]); if (hi == 0) wsf[r32] = rd; }
    f32x16 o = f32x16{};
#pragma unroll
    for (int d0 = 0; d0 < 8; ++d0) { const bf16x8 cf = *(const bf16x8*)(lds + OFF_CT + KSWZ(32 * cb + r32, (16 * d0 + 8 * hi) * 2)); o = __builtin_amdgcn_mfma_f32_32x32x16_bf16(qr[d0], cf, o, 0, 0, 0); }
#pragma unroll
    for (int r = 0; r < 16; ++r) o[r] *= sc_iw[32 * rb + crow(r, hi)];
    bf16x8 vf[4]; vfrags(ldsb + OFF_VV, cb, lane, vf);
    o = __builtin_amdgcn_mfma_f32_32x32x16_bf16(pa0, vf[0], o, 0, 0, 0); o = __builtin_amdgcn_mfma_f32_32x32x16_bf16(pa1, vf[1], o, 0, 0, 0);
    if (rb == 1) { o = __builtin_amdgcn_mfma_f32_32x32x16_bf16(pa2, vf[2], o, 0, 0, 0); o = __builtin_amdgcn_mfma_f32_32x32x16_bf16(pa3, vf[3], o, 0, 0, 0); }
    asm volatile("s_waitcnt lgkmcnt(0)" ::: "memory");
#pragma unroll
    for (int r = 0; r < 16; ++r) { const int tl = crow(r, hi); const int p = 64 * c + 32 * rb + tl; H[ROWOF(p) * 512 + h * 128 + 32 * cb + r32] = (bf16)f2bf(o[r] * wsf[tl]); }
    { const float dc = ch_dec[c];
#pragma unroll
      for (int i = 0; i < 3; ++i) if (i < nown) { const int db = rb ? 3 : i; bf16x8 kf[4]; vfrags(ldsb + OFF_KP, db, lane, kf);
#pragma unroll
        for (int r = 0; r < 16; ++r) cacc[i][r] *= dc;
#pragma unroll
        for (int ks = 0; ks < 4; ++ks) cacc[i] = __builtin_amdgcn_mfma_f32_32x32x16_bf16(kf[ks], vf[ks], cacc[i], 0, 0, 0); } }
    __syncthreads();
#pragma unroll
    for (int i = 0; i < 3; ++i) if (i < nown) {
#pragma unroll
      for (int g = 0; g < 4; ++g) { const int d = 32 * (rb ? 3 : i) + 8 * g + 4 * hi, e = 32 * cb + r32;
        v2u w; w.x = cvt_pk_bf16(cacc[i][4 * g], cacc[i][4 * g + 1]); w.y = cvt_pk_bf16(cacc[i][4 * g + 2], cacc[i][4 * g + 3]);
        *(v2u*)(lds + OFF_CT + KSWZ(e, d * 2)) = w; } }
    if (c + 1 < 64) WRITEC(c + 1);
    __syncthreads();
  }
#undef ROWOF
#undef LOADC
#undef WRITEC
}
#undef KSWZ
#undef PKF
}

struct ListOrder { int n, L0, L1, nN, lda, ldb;
  __device__ bool next(int i, pg8::Unit& u) const { if (i >= n) return false; const int L = i ? L1 : L0; u.pm = L / nN; u.pn = L % nN; u.g = 0; u.ibase = 0;
    u.aoff = (long)u.pm * 256 * lda; u.boff = (long)u.pn * 256 * ldb; return true; } };
__device__ __forceinline__ void publish_units(Frame& F, const ListOrder& S) {
  if (F.tid == 0) { __builtin_amdgcn_fence(__ATOMIC_RELEASE, "agent"); asm volatile("s_waitcnt vmcnt(0)" ::: "memory");
    for (int i = 0; i < S.n; ++i) { const int L = i ? S.L1 : S.L0; __hip_atomic_fetch_add(F.ctl + CW_RDY + 64 * ((L / S.nN) >> 4), 1u, RLX_AGENT); } }
}
#ifndef P3_FILL_CHUNKS
#define P3_FILL_CHUNKS 3
#endif
__device__ __forceinline__ void p3_mixers(Frame& F, const Args& a, char* lds_generic, unsigned xcc, float* ssq, float* sskv, int qoff) {
  unsigned char* ws = F.ws; const int bx = (int)blockIdx.x;
#ifndef MLSTM_REPS
#define MLSTM_REPS 1
#endif
  if (bx < 32) { for (int rp = 0; rp < MLSTM_REPS; ++rp) { mls::mlstm_seq(bx, F.ws, lds_generic); __syncthreads(); } }
  else { const int c = bx - 32;
    { ListOrder S{c < 192 ? 1 : 0, c, 0, 3, PROJ_LD, 256};
      pg8::Gemm g{(const bf16*)(ws + WS_PROJ) + PC_CQ, (const bf16*)(ws + WS_WQB), PROJ_LD, 256, 256, nullptr, 127, 127};
      EpiQ E{(bf16*)(ws + WS_QM), ssq, (const float*)(ws + WS_ROPE)};
      pg8::gemm_phase<EpiQ, ListOrder, false>(F.lds, g, S, E); publish_units(F, S); }
    { ListOrder S{c >= 192 ? 2 : 1, c >= 192 ? c - 192 : c + 32, c + 32, 4, PROJ_LD, 256};
      pg8::Gemm g{(const bf16*)(ws + WS_PROJ) + PC_CKV, (const bf16*)(ws + WS_WKVB), PROJ_LD, 256, 256, nullptr, 127, 127};
      EpiKV E{(bf16*)(ws + WS_KM), (bf16*)(ws + WS_VM), sskv};
      pg8::gemm_phase<EpiKV, ListOrder, false>(F.lds, g, S, E); publish_units(F, S); }
  }
  p3_attention(F, a, lds_generic, xcc, qoff);
  if (bx >= 32 && !qoff) conv_fill(F, a, P3_FILL_CHUNKS);
}
__device__ __forceinline__ void p4_combine(Frame& F, const Args& a) {
  unsigned char* ws = F.ws; const bf16* HF = (const bf16*)(ws + WS_HF); const bf16* HB = (const bf16*)(ws + WS_HB); const bf16* P = (const bf16*)(ws + WS_PROJ); bf16* Y = (bf16*)(ws + WS_Y);
  const float* g = (const float*)a.in[I_GHM];
  const int gw = F.vcu * NWAVES + F.wave, NGW = F.G * NWAVES, c = F.lane * 8;
  float gg[8];
#pragma unroll
  for (int j = 0; j < 8; ++j) gg[j] = g[c + j];
  for (int m0 = gw; m0 < MTOK; m0 += 2 * NGW) {
    v4u wf[2], wb[2], wo[2];
#pragma unroll
    for (int u = 0; u < 2; ++u) { const size_t m = (size_t)(m0 + u * NGW); wf[u] = *(const v4u*)(HF + m * 512 + c); wb[u] = *(const v4u*)(HB + m * 512 + c); wo[u] = *(const v4u*)(P + m * PROJ_LD + 1536 + c); }
#pragma unroll
    for (int u = 0; u < 2; ++u) { const size_t m = (size_t)(m0 + u * NGW);
      float f[8], bb[8], oo[8]; unpack8(wf[u], f); unpack8(wb[u], bb); unpack8(wo[u], oo);
      float s = 0.f;
#pragma unroll
      for (int j = 0; j < 8; ++j) { f[j] += bb[j]; s += f[j] * f[j]; }
      s += __shfl_xor(s, 1); s += __shfl_xor(s, 2); s += __shfl_xor(s, 4); s += __shfl_xor(s, 8);
      const float r = rsqrtf(s * (1.f / 128.f) + 1e-6f);
#pragma unroll
      for (int j = 0; j < 8; ++j) f[j] = f[j] * r * gg[j] * sigmoidf_(oo[j]);
      *(v4u*)(Y + m * 1024 + c) = pack8(f); }
  }
  { const bf16* PO = (const bf16*)(ws + WS_PO); const float* PML = (const float*)(ws + WS_PML); const float* ga = (const float*)a.in[I_GHA];
    constexpr float C = 0.10206207261596575f * 1.4426950408889634f; const int hh = F.lane >> 3;
    float g8[8];
#pragma unroll
    for (int j = 0; j < 8; ++j) g8[j] = ga[c + j];
    for (int m = gw; m < MTOK; m += NGW) {
      float pa[8], pb[8]; unpack8(*(const v4u*)(PO + (size_t)m * 512 + c), pa); unpack8(*(const v4u*)(PO + ((size_t)MTOK + m) * 512 + c), pb);
      const float m0 = PML[(size_t)m * 16 + hh * 2], l0 = PML[(size_t)m * 16 + hh * 2 + 1], m1 = PML[((size_t)MTOK + m) * 16 + hh * 2], l1 = PML[((size_t)MTOK + m) * 16 + hh * 2 + 1];
      const float M = fmaxf(m0, m1), e0 = __builtin_amdgcn_exp2f((m0 - M) * C), e1 = __builtin_amdgcn_exp2f((m1 - M) * C); const float rl = 1.f / (l0 * e0 + l1 * e1);
      float f[8];
#pragma unroll
      for (int j = 0; j < 8; ++j) f[j] = pa[j] * e0 + pb[j] * e1;
      float s = 0.f;
#pragma unroll
      for (int j = 0; j < 8; ++j) { f[j] *= rl; s += f[j] * f[j]; }
      s += __shfl_xor(s, 1); s += __shfl_xor(s, 2); s += __shfl_xor(s, 4);
      const float r = rsqrtf(s * (1.f / 64.f) + 1e-6f);
#pragma unroll
      for (int j = 0; j < 8; ++j) f[j] = f[j] * r * g8[j];
      *(v4u*)(Y + (size_t)m * 1024 + 512 + c) = pack8(f); } }
}
template <int MODE> struct EpiResid { static constexpr bool TWO_PASS = false; const float* basef; const bf16* baseb; float* out; bf16* outb; float* ss;
  __device__ __forceinline__ void row8(const pg8::Unit& u, int rloc, int cloc, const float (&a0)[8], const float (&a1)[8], int fq) const {
    const int row = u.pm * 256 + rloc; const size_t off = (size_t)row * 1024 + u.pn * 256 + cloc;
    float v0[8], v1[8];
    if constexpr (MODE == 0) {
      const f32x4 b0 = *(const f32x4*)(basef + off), b1 = *(const f32x4*)(basef + off + 4), b2 = *(const f32x4*)(basef + off + 128), b3 = *(const f32x4*)(basef + off + 132);
#pragma unroll
      for (int i = 0; i < 4; ++i) { v0[i] = a0[i] + b0[i]; v0[4 + i] = a0[4 + i] + b1[i]; v1[i] = a1[i] + b2[i]; v1[4 + i] = a1[4 + i] + b3[i]; }
      *(v4u*)(outb + off) = pack8(v0); *(v4u*)(outb + off + 128) = pack8(v1);
    } else {
      float r0[8], r1[8]; unpack8(*(const v4u*)(baseb + off), r0); unpack8(*(const v4u*)(baseb + off + 128), r1);
#pragma unroll
      for (int i = 0; i < 8; ++i) { v0[i] = a0[i] + r0[i]; v1[i] = a1[i] + r1[i]; }
      *(v4u*)(outb + off) = pack8(v0); *(v4u*)(outb + off + 128) = pack8(v1);
      if (out) { *(f32x4*)(out + off) = (f32x4){v0[0], v0[1], v0[2], v0[3]}; *(f32x4*)(out + off + 4) = (f32x4){v0[4], v0[5], v0[6], v0[7]};
        *(f32x4*)(out + off + 128) = (f32x4){v1[0], v1[1], v1[2], v1[3]}; *(f32x4*)(out + off + 132) = (f32x4){v1[4], v1[5], v1[6], v1[7]}; }
    }
    float s = sumsq8(v0) + sumsq8(v1); s += __shfl_xor(s, 16); s += __shfl_xor(s, 32); if (fq == 0) unsafeAtomicAdd(ss + row, s); } };
struct EpiScale { static constexpr bool TWO_PASS = false; bf16* O; const float* ss;
  __device__ __forceinline__ void row8(const pg8::Unit& u, int rloc, int cloc, const float (&a0)[8], const float (&a1)[8], int fq) const {
    const int row = u.pm * 256 + rloc; const float r = rsqrtf(ss[row] * (1.f / 1024.f) + 1e-6f); float v0[8], v1[8];
#pragma unroll
    for (int i = 0; i < 8; ++i) { v0[i] = a0[i] * r; v1[i] = a1[i] * r; }
    bf16* p = O + (size_t)row * 1024 + u.pn * 256 + cloc; *(v4u*)p = pack8(v0); *(v4u*)(p + 128) = pack8(v1); } };
struct EpiSoftmax { static constexpr bool TWO_PASS = true; bf16* O; float scale; LAS float* xch;
  __device__ __forceinline__ void pass1(const pg8::Unit& u, int rloc, int wc, float (&v0)[8], float (&v1)[8], int fq) const {
    float mx = -3.0e38f;
#pragma unroll
    for (int i = 0; i < 8; ++i) { v0[i] *= scale; v1[i] *= scale; mx = fmaxf(mx, fmaxf(v0[i], v1[i])); }
    mx = fmaxf(mx, __shfl_xor(mx, 16)); mx = fmaxf(mx, __shfl_xor(mx, 32));
    float l = 0.f;
#pragma unroll
    for (int i = 0; i < 8; ++i) { v0[i] = __expf(v0[i] - mx); v1[i] = __expf(v1[i] - mx); l += v0[i] + v1[i]; }
    l += __shfl_xor(l, 16); l += __shfl_xor(l, 32);
    if (fq == 0) { xch[(rloc * 4 + wc) * 2] = mx; xch[(rloc * 4 + wc) * 2 + 1] = l; } }
  __device__ __forceinline__ void row8(const pg8::Unit& u, int rloc, int cloc, const float (&a0)[8], const float (&a1)[8], int fq) const {
    const int wc = cloc >> 5; float m[4], l[4]; float M = -3.0e38f;
#pragma unroll
    for (int w = 0; w < 4; ++w) { m[w] = xch[(rloc * 4 + w) * 2]; l[w] = xch[(rloc * 4 + w) * 2 + 1]; M = fmaxf(M, m[w]); }
    float L = 0.f, mine = 0.f;
#pragma unroll
    for (int w = 0; w < 4; ++w) { const float e = __expf(m[w] - M); L += l[w] * e; if (w == wc) mine = e; }
    const float f = mine / L; float v0[8], v1[8];
#pragma unroll
    for (int i = 0; i < 8; ++i) { v0[i] = a0[i] * f; v1[i] = a1[i] * f; }
    bf16* p = O + (size_t)(u.pm * 256 + rloc) * 1024 + u.pn * 256 + cloc; *(v4u*)p = pack8(v0); *(v4u*)(p + 128) = pack8(v1); } };
struct MemOrder { int G, c, kind;
  __device__ bool next(int i, pg8::Unit& u) const { const int L = i * G + c; if (L >= 256) return false;
    const int bh = L >> 4, t = L & 15, b = bh >> 2, h = bh & 3;
    u.pm = b * 16 + t; u.pn = h; u.g = 0; u.ibase = 0; u.aoff = ((long)(b * SEQ + t * 256)) * 1024 + (kind == 2 ? 0 : h * 256);
    u.boff = kind == 0 ? ((long)(b * NMEM)) * 1024 + h * 256 : kind == 1 ? ((long)(h * 256)) * 1024 + b * NMEM : ((long)(h * 256)) * 1024; return true; } };
constexpr size_t WS_WRG = WS_DEC + 65536;
constexpr size_t WS_ROWSEL = WS_SEL, WS_GSEL = WS_SEL + 131072, WS_INV = 31 * MiB, WS_YE = 160 * MiB;
typedef float f32x4m __attribute__((ext_vector_type(4)));
__device__ __forceinline__ void p10_router(Frame& F, const Args& a) {
  unsigned char* ws = F.ws; const bf16* X2 = (const bf16*)(ws + WS_X2); const float* ss2 = (const float*)(ws + CTL_SS2); float* AFF = (float*)(ws + WS_AFF); const float* WRG = (const float*)(ws + WS_WRG);
  const int gw = F.vcu * NWAVES + F.wave, NGW = F.G * NWAVES, r = F.lane & 15, kq = F.lane >> 4;
  LAS float* wl = (LAS float*)F.lds;
  for (int i = F.tid; i < 4096; i += NTHR) ((LAS f32x4*)wl)[i] = ((const f32x4*)WRG)[i];
  __syncthreads();
  for (int it = gw; it < MTOK / 16; it += NGW) { const int m0 = it * 16;
    const bf16* xp = X2 + (size_t)(m0 + r) * 1024 + 4 * kq; const LAS float* wp = wl + (4 * kq) * 16 + r;
    f32x4m acc0 = {0.f, 0.f, 0.f, 0.f}, acc1 = {0.f, 0.f, 0.f, 0.f};
#pragma unroll 1
    for (int hf = 0; hf < 2; ++hf) {
      f32x4 xv[32];
#pragma unroll
      for (int j = 0; j < 32; ++j) {
#if X2MODE >= 1 && X2MODE != 3
        xv[j] = *(const f32x4*)((const float*)(ws + WS_X2F) + (size_t)(m0 + r) * 1024 + 4 * kq + 16 * (32 * hf + j));
#else
        const v2u w = *(const v2u*)(xp + 16 * (32 * hf + j)); xv[j] = (f32x4){bflo(w.x), bfhi(w.x), bflo(w.y), bfhi(w.y)};
#endif
      }
#pragma unroll
      for (int j = 0; j < 32; j += 2) { const LAS float* w0 = wp + (16 * (32 * hf + j)) * 16; const LAS float* w1 = w0 + 256;
        acc0 = __builtin_amdgcn_mfma_f32_16x16x4f32(xv[j].x, w0[0], acc0, 0, 0, 0); acc1 = __builtin_amdgcn_mfma_f32_16x16x4f32(xv[j + 1].x, w1[0], acc1, 0, 0, 0);
        acc0 = __builtin_amdgcn_mfma_f32_16x16x4f32(xv[j].y, w0[16], acc0, 0, 0, 0); acc1 = __builtin_amdgcn_mfma_f32_16x16x4f32(xv[j + 1].y, w1[16], acc1, 0, 0, 0);
        acc0 = __builtin_amdgcn_mfma_f32_16x16x4f32(xv[j].z, w0[32], acc0, 0, 0, 0); acc1 = __builtin_amdgcn_mfma_f32_16x16x4f32(xv[j + 1].z, w1[32], acc1, 0, 0, 0);
        acc0 = __builtin_amdgcn_mfma_f32_16x16x4f32(xv[j].w, w0[48], acc0, 0, 0, 0); acc1 = __builtin_amdgcn_mfma_f32_16x16x4f32(xv[j + 1].w, w1[48], acc1, 0, 0, 0); }
    }
#pragma unroll
    for (int i = 0; i < 4; ++i) { const int row = m0 + 4 * kq + i; const float lg = (acc0[i] + acc1[i]) * rsqrtf(ss2[row] * (1.f / 1024.f) + 1e-6f);
      float mx = lg; mx = fmaxf(mx, __shfl_xor(mx, 1)); mx = fmaxf(mx, __shfl_xor(mx, 2)); mx = fmaxf(mx, __shfl_xor(mx, 4)); mx = fmaxf(mx, __shfl_xor(mx, 8));
      const float ex = __expf(lg - mx); float l = ex; l += __shfl_xor(l, 1); l += __shfl_xor(l, 2); l += __shfl_xor(l, 4); l += __shfl_xor(l, 8);
      AFF[(size_t)row * 16 + r] = ex / l; }
  }
  __syncthreads();
}
__device__ __forceinline__ void p11_topk(Frame& F, char* lds) {
  unsigned char* ws = F.ws; const float* AFF = (const float*)(ws + WS_AFF); int* ROWSEL = (int*)(ws + WS_ROWSEL); float* GSEL = (float*)(ws + WS_GSEL); int* INV = (int*)(ws + WS_INV);
  unsigned* hist = (unsigned*)lds; unsigned* ctl = hist + 256; unsigned* wsum = hist + 320;
  const int tid = F.tid, lane = F.lane, wid = F.wave;
  for (int it = (int)blockIdx.x; it < BATCH * NEXP; it += F.G) { const int b = it >> 4, e = it & 15;
    unsigned key[8];
#pragma unroll
    for (int j = 0; j < 8; ++j) key[j] = __float_as_uint(AFF[((size_t)b * SEQ + 8 * tid + j) * 16 + e]);
    unsigned prefix = 0u, mask = 0u, need = CAP;
    for (int shift = 24; shift >= 0; shift -= 8) {
      if (tid < 256) hist[tid] = 0u;
      __syncthreads();
#pragma unroll
      for (int j = 0; j < 8; ++j) if ((key[j] & mask) == prefix) atomicAdd(&hist[(key[j] >> shift) & 255u], 1u);
      __syncthreads();
      if (tid == 0) { unsigned above = 0u; int d = 255; for (; d > 0; --d) { const unsigned c = hist[d]; if (above + c >= need) break; above += c; } ctl[0] = (unsigned)d; ctl[1] = need - above; }
      __syncthreads();
      prefix |= ctl[0] << shift; mask |= 255u << shift; need = ctl[1];
      __syncthreads();
    }
    unsigned ngt = 0u, neq = 0u;
#pragma unroll
    for (int j = 0; j < 8; ++j) { ngt += key[j] > prefix ? 1u : 0u; neq += key[j] == prefix ? 1u : 0u; }
    unsigned sgt = ngt, seq_ = neq;
#pragma unroll
    for (int o = 1; o < 64; o <<= 1) { const unsigned y0 = __shfl_up(sgt, o), y1 = __shfl_up(seq_, o); if (lane >= o) { sgt += y0; seq_ += y1; } }
    if (lane == 63) { wsum[wid] = sgt; wsum[8 + wid] = seq_; }
    __syncthreads();
    unsigned bgt = 0u, beq = 0u, tgt = 0u;
#pragma unroll
    for (int w = 0; w < 8; ++w) { const unsigned g = wsum[w], q = wsum[8 + w]; if (w < wid) { bgt += g; beq += q; } tgt += g; }
    unsigned pgt = bgt + sgt - ngt, peq = beq + seq_ - neq;
#pragma unroll
    for (int j = 0; j < 8; ++j) { const int t = 8 * tid + j; int slot = -1;
      if (key[j] > prefix) slot = (int)pgt++; else if (key[j] == prefix) { if (peq < need) slot = (int)(tgt + peq); ++peq; }
      INV[((size_t)b * SEQ + t) * 16 + e] = slot;
      if (slot >= 0) { ROWSEL[e * 2048 + b * 512 + slot] = b * SEQ + t; GSEL[e * 2048 + b * 512 + slot] = __uint_as_float(key[j]); } }
    __syncthreads();
  }
}
#ifndef GU_ORDER
#define GU_ORDER 1
#endif
#ifndef DN_ORDER
#define DN_ORDER 1
#endif
struct MoeGUOrder { int G, c;
  __device__ bool next(int i, pg8::Unit& u) const { const int L = i * G + c; if (L >= 2048) return false;
#if GU_ORDER == 0
    const int e = L >> 7, r = L & 127, pn = r >> 3, mt = r & 7;
#elif GU_ORDER == 1
    const int e = L >> 7, r = L & 127, mt = r >> 4, pn = r & 15;
#else
    const int x = c & 7, j = c >> 3, e = (i >> 2) * 8 + x, r = (i & 3) * 32 + j, mt = r >> 4, pn = r & 15;
#endif
    u.g = e; u.pm = mt; u.pn = pn; u.ibase = e * 2048 + mt * 256; u.aoff = MOE_FP8 ? ((long)e * 2048 + mt * 256) * 512 : 0; u.boff = ((long)e * 4096 + pn * 256) * (MOE_FP8 ? 512 : 1024); return true; } };
struct MoeDownOrder { int G, c;
  __device__ bool next(int i, pg8::Unit& u) const { const int L = i * G + c; if (L >= 512) return false;
#if DN_ORDER == 0
    const int e = L >> 5, r = L & 31, pn = r >> 3, mt = r & 7;
#else
    const int x = c & 7, j = c >> 3, e = i * 8 + x, pn = j >> 3, mt = j & 7;
#endif
    u.g = e; u.pm = mt; u.pn = pn; u.ibase = e * 2048 + mt * 256; u.aoff = ((long)e * 2048 + mt * 256) * (MOE_FP8_DOWN ? 1024 : 2048); u.boff = ((long)e * 1024 + pn * 256) * (MOE_FP8_DOWN ? 1024 : 2048); return true; } };
struct EpiGU { static constexpr bool TWO_PASS = false; bf16* H; const float* ss2; const int* rowsel;
  __device__ __forceinline__ void row8(const pg8::Unit& u, int rloc, int cloc, const float (&a0)[8], const float (&a1)[8], int fq) const {
    const int tok = rowsel[u.ibase + rloc]; const float r = rsqrtf(ss2[tok] * (1.f / 1024.f) + 1e-6f); float h[8];
#pragma unroll
    for (int i = 0; i < 8; ++i) { const float g = a0[i] * r, up = a1[i] * r; h[i] = g * sigmoidf_(g) * up; if (FP8EMU) h[i] = q8(h[i], 8.f); }
#if MOE_FP8_DOWN
    *(v2u*)((unsigned char*)H + ((size_t)u.g * 2048 + u.pm * 256 + rloc) * 2048 + u.pn * 128 + cloc) = pack8_fp8(h, 8.f); } };
#else
    *(v4u*)(H + ((size_t)u.g * 2048 + u.pm * 256 + rloc) * 2048 + u.pn * 128 + cloc) = pack8(h); } };
#endif
struct EpiGU8 { static constexpr bool TWO_PASS = false; unsigned char* H8; const float* ss2; const int* rowsel;
  __device__ __forceinline__ void row8(const pg8::Unit& u, int rloc, int cloc, const float (&a0)[8], const float (&a1)[8], int fq) const {
    float h[8];
#pragma unroll
    for (int i = 0; i < 8; ++i) { const float g = a0[i], up = a1[i]; h[i] = g * sigmoidf_(g) * up; }
#if MOE_FP8_DOWN
    *(v2u*)(H8 + ((size_t)u.g * 2048 + u.pm * 256 + rloc) * 2048 + u.pn * 128 + cloc) = pack8_fp8(h, 8.f); } };
#else
    *(v4u*)((bf16*)H8 + ((size_t)u.g * 2048 + u.pm * 256 + rloc) * 2048 + u.pn * 128 + cloc) = pack8(h); } };
#endif
struct EpiYE { static constexpr bool TWO_PASS = false; bf16* Yp; const float* gsel;
  __device__ __forceinline__ void row8(const pg8::Unit& u, int rloc, int cloc, const float (&a0)[8], const float (&a1)[8], int fq) const {
    const float gv = gsel[u.ibase + rloc]; float v0[8], v1[8];
#pragma unroll
    for (int i = 0; i < 8; ++i) { v0[i] = a0[i] * gv; v1[i] = a1[i] * gv; }
    bf16* p = Yp + ((size_t)u.g * 2048 + u.pm * 256 + rloc) * 1024 + u.pn * 256 + cloc; *(v4u*)p = pack8(v0); *(v4u*)(p + 128) = pack8(v1); } };
__device__ __forceinline__ void p14_final(Frame& F, const Args& a) {
  unsigned char* ws = F.ws; const bf16* X2 = (const bf16*)(ws + WS_X2); const int* INV = (const int*)(ws + WS_INV); const bf16* YE = (const bf16*)(ws + WS_YE);
  const float* gfin = (const float*)a.in[I_GFIN]; float* out = a.out;
  const int gw = F.vcu * NWAVES + F.wave, NGW = F.G * NWAVES;
  f32x4 g[4];
#pragma unroll
  for (int j = 0; j < 4; ++j) g[j] = *(const f32x4*)(gfin + 256 * j + 4 * F.lane);
  for (int m0 = gw; m0 < MTOK; m0 += 2 * NGW) {
    f32x4 v[2][4]; int inv[2];
#pragma unroll
    for (int u = 0; u < 2; ++u) { const int m = m0 + u * NGW;
#pragma unroll
      for (int j = 0; j < 4; ++j) {
#if X2MODE >= 2
        v[u][j] = *(const f32x4*)((const float*)(ws + WS_X2F) + (size_t)m * 1024 + 256 * j + 4 * F.lane);
#else
        const v2u w = *(const v2u*)(X2 + (size_t)m * 1024 + 256 * j + 4 * F.lane); v[u][j] = (f32x4){bflo(w.x), bfhi(w.x), bflo(w.y), bfhi(w.y)};
#endif
      }
      inv[u] = F.lane < 16 ? INV[(size_t)m * 16 + F.lane] : -1; }
#pragma unroll
    for (int u = 0; u < 2; ++u) { const int m = m0 + u * NGW, b = m >> 12;
      unsigned long long sel = __ballot(inv[u] >= 0);
      while (sel) { const int e = __builtin_ctzll(sel); sel &= sel - 1; const int slot = __shfl(inv[u], e);
        const bf16* yr = YE + ((size_t)e * 2048 + b * 512 + slot) * 1024 + 4 * F.lane;
#pragma unroll
        for (int j = 0; j < 4; ++j) { const v2u w = *(const v2u*)(yr + 256 * j); v[u][j].x += bflo(w.x); v[u][j].y += bfhi(w.x); v[u][j].z += bflo(w.y); v[u][j].w += bfhi(w.y); } }
      float s = 0.f;
#pragma unroll
      for (int j = 0; j < 4; ++j) s += (v[u][j].x * v[u][j].x + v[u][j].y * v[u][j].y) + (v[u][j].z * v[u][j].z + v[u][j].w * v[u][j].w);
      const float r = rsqrtf(wave_sum(s) * (1.f / 1024.f) + 1e-6f);
#pragma unroll
      for (int j = 0; j < 4; ++j) *(f32x4*)(out + (size_t)m * 1024 + 256 * j + 4 * F.lane) = v[u][j] * r * g[j]; }
  }
}
__global__ void __launch_bounds__(NTHR, 2) mk(Args a) {
  extern __shared__ __attribute__((aligned(16))) unsigned char lds_raw[];
  Frame F;
  F.lds = (LAS unsigned char*)lds_raw; F.MISC = (volatile LAS unsigned*)(F.lds + LDSCTL_OFF + 320);
  F.tid = threadIdx.x; F.lane = F.tid & 63; F.wave = __builtin_amdgcn_readfirstlane(F.tid >> 6);
  F.G = gridDim.x; { const int bx = blockIdx.x; F.vcu = (F.G % 8 == 0) ? (bx % 8) * (F.G / 8) + bx / 8 : bx; }
  F.ws = a.ws; F.ctl = (gu32*)(a.ws + WS_CTL);
  unsigned char* ws = a.ws;
  for (int u = F.tid; u < (LDS_BYTES - LDSCTL_OFF) / 4; u += NTHR) ((LAS unsigned*)(F.lds + LDSCTL_OFF))[u] = 0u;
  __syncthreads();
  XcdBarrier bar = xcd_barrier_post((unsigned*)(F.ctl + CW_BAR), F.MISC + 8);
  const int lo = a.ph_lo, hi = a.ph_hi;
#define IN(k) (lo <= (k) && (k) < hi)
#define BOTH(k) (IN(k) && IN((k) + 1))
#define GRID_BAR() xcd_barrier(bar)
  float* ssq = (float*)(ws + CTL_SSQ); float* sskv = (float*)(ws + CTL_SSKV);

#ifndef REP_MASK
#define REP_MASK 0
#endif
#define NREP(k) ((((REP_MASK) >> (k)) & 1) ? 2 : 1)
#define PH_BEGIN(k) if (IN(k)) { for (int rep_ = 0; rep_ < NREP(k); ++rep_) { const bool dry = rep_ + 1 < NREP(k); (void)dry;
#define PH_END(k) if (dry) GRID_BAR(); } if (BOTH(k)) GRID_BAR(); }
  float* dummy = (float*)(ws + WS_DUMMY);
  float* ss1 = (float*)(ws + CTL_SS1); float* ss2 = (float*)(ws + CTL_SS2);
#ifndef FILLMODE
#define FILLMODE 2
#endif
  PH_BEGIN(0) p0_prologue(F, a, true, FILLMODE == 0); PH_END(0)
  PH_BEGIN(1)
    { pg8::Gemm g{(const bf16*)(ws + WS_XN), (const bf16*)(ws + WS_WIN), 1024, 1024, 1024, nullptr, 127, 127}; pg8::StaticOrder S; S.init(MTOK, PROJ_LD, F.G, (int)blockIdx.x, 1024, 1024);
      EpiProj E{(bf16*)(ws + WS_PROJ), dry ? dummy : ssq, dry ? dummy + 16384 : sskv};
      pg8::gemm_phase<EpiProj, pg8::StaticOrder, false>(F.lds, g, S, E); }
    { pg8::Gemm g{(const bf16*)(ws + WS_MEMN), (const bf16*)(ws + WS_WMK), 1024, 1024, 1024, nullptr, 127, 127}; pg8::StaticOrder S; S.init(1024, 1024, F.G, (int)((blockIdx.x + 128u) % (unsigned)F.G), 1024, 1024);
      EpiStore E{(bf16*)(ws + WS_KMEM), 1024};
      pg8::gemm_phase<EpiStore, pg8::StaticOrder, false>(F.lds, g, S, E); }
    { pg8::Gemm g{(const bf16*)(ws + WS_WMV), (const bf16*)(ws + WS_MEMN), 1024, 1024, 1024, nullptr, 127, 127}; pg8::StaticOrder S; S.init(1024, 1024, F.G, (int)((blockIdx.x + 112u) % (unsigned)F.G), 1024, 1024);
      EpiStore E{(bf16*)(ws + WS_VMEMT), 1024};
      pg8::gemm_phase<EpiStore, pg8::StaticOrder, false>(F.lds, g, S, E); }
#ifndef P1_FILL
#define P1_FILL 1
#endif
    if (!dry && blockIdx.x >= 160u) conv_fill(F, a, P1_FILL);
  PH_END(1)
  PH_BEGIN(2) p2_elementwise(F, a); PH_END(2)
  PH_BEGIN(3) p3_mixers(F, a, (char*)lds_raw, bar.x, ssq, sskv, dry ? 64 * 16 : 0); PH_END(3)
  PH_BEGIN(4) p4_combine(F, a); PH_END(4)
  PH_BEGIN(5)
    pg8::Gemm g{(const bf16*)(ws + WS_Y), (const bf16*)(ws + WS_WOUT), 1024, 1024, 1024, nullptr, 127, 127}; pg8::StaticOrder S; S.init(MTOK, 1024, F.G, (int)blockIdx.x, 1024, 1024);
    EpiResid<0> E{(const float*)a.in[I_X], nullptr, nullptr, (bf16*)(ws + WS_X1B), dry ? dummy : ss1};
    pg8::gemm_phase<EpiResid<0>, pg8::StaticOrder, false>(F.lds, g, S, E);
  PH_END(5)
  PH_BEGIN(6)
    { pg8::Gemm g{(const bf16*)(ws + WS_X1B), (const bf16*)(ws + WS_WMQ), 1024, 1024, 1024, nullptr, 127, 127}; MemOrder S{F.G, (int)blockIdx.x, 2};
      EpiScale E{(bf16*)(ws + WS_QMEM), ss1};
      pg8::gemm_phase<EpiScale, MemOrder, false>(F.lds, g, S, E); }
    if (F.tid == 0) __builtin_amdgcn_fence(__ATOMIC_ACQUIRE, "agent");
    asm volatile("s_waitcnt vmcnt(0)" ::: "memory"); __syncthreads();
    { pg8::Gemm g{(const bf16*)(ws + WS_QMEM), (const bf16*)(ws + WS_KMEM), 1024, 1024, 256, nullptr, 127, 127}; MemOrder S{F.G, (int)blockIdx.x, 0};
      EpiSoftmax E{(bf16*)(ws + WS_P), 0.0625f, (LAS float*)(F.lds + LDSCTL_OFF + 1024)};
      pg8::gemm_phase<EpiSoftmax, MemOrder, false>(F.lds, g, S, E); }
    if (F.tid == 0) __builtin_amdgcn_fence(__ATOMIC_ACQUIRE, "agent");
    asm volatile("s_waitcnt vmcnt(0)" ::: "memory"); __syncthreads();
    { pg8::Gemm g{(const bf16*)(ws + WS_P), (const bf16*)(ws + WS_VMEMT), 1024, 1024, 256, nullptr, 127, 127}; MemOrder S{F.G, (int)blockIdx.x, 1};
      EpiStore E{(bf16*)(ws + WS_MO), 1024};
      pg8::gemm_phase<EpiStore, MemOrder, false>(F.lds, g, S, E); }
  PH_END(6)
  PH_BEGIN(9)
    pg8::Gemm g{(const bf16*)(ws + WS_MO), (const bf16*)(ws + WS_WMO), 1024, 1024, 1024, nullptr, 127, 127}; pg8::StaticOrder S; S.init(MTOK, 1024, F.G, (int)blockIdx.x, 1024, 1024);
    EpiResid<1> E{nullptr, (const bf16*)(ws + WS_X1B), X2MODE >= 1 ? (float*)(ws + WS_X2F) : nullptr, (bf16*)(ws + WS_X2), dry ? dummy : ss2};
    pg8::gemm_phase<EpiResid<1>, pg8::StaticOrder, false>(F.lds, g, S, E);
  PH_END(9)
  PH_BEGIN(10) p10_router(F, a); PH_END(10)
  PH_BEGIN(11) p11_topk(F, (char*)lds_raw);
    if (!dry && FILLMODE != 0) conv_fill(F, a, 1 << 30);
  PH_END(11)
  PH_BEGIN(12)
#if MOE_FP8
    {
      const int gw = F.vcu * NWAVES + F.wave, NGW = F.G * NWAVES; const int* rs = (const int*)(ws + WS_ROWSEL);
      for (int r0 = gw; r0 < NEXP * 2048; r0 += 4 * NGW) {
        int tok[4]; float rn[4]; v4u qa[4], qb[4];
#pragma unroll
        for (int u = 0; u < 4; ++u) { const int r = r0 + u * NGW; tok[u] = r < NEXP * 2048 ? rs[r] : 0; }
#pragma unroll
        for (int u = 0; u < 4; ++u) { const bf16* xr = (const bf16*)(ws + WS_X2) + (size_t)tok[u] * 1024 + F.lane * 16; rn[u] = ss2[tok[u]]; qa[u] = *(const v4u*)xr; qb[u] = *(const v4u*)(xr + 8); }
#pragma unroll
        for (int u = 0; u < 4; ++u) { const int r = r0 + u * NGW; const float s = rsqrtf(rn[u] * (1.f / 1024.f) + 1e-6f);
          float lo[8], hi[8]; unpack8(qa[u], lo); unpack8(qb[u], hi);
#pragma unroll
          for (int j = 0; j < 8; ++j) { lo[j] *= s; hi[j] *= s; }
          const v2u a8 = pack8_fp8(lo, 1.f), b8 = pack8_fp8(hi, 1.f); v4u o; o.x = a8.x; o.y = a8.y; o.z = b8.x; o.w = b8.y;
          if (r < NEXP * 2048) *(v4u*)(ws + WS_XG + (size_t)r * 1024 + F.lane * 16) = o; } }
      GRID_BAR(); }
    pg8::Gemm g{(const bf16*)(ws + WS_XG), (const bf16*)(ws + WS_WEGU8), 512, 512, 512, nullptr, 127, 121}; MoeGUOrder S{F.G, (int)blockIdx.x};
    EpiGU8 E{(unsigned char*)(ws + WS_HID8), ss2, (const int*)(ws + WS_ROWSEL)};
    pg8::gemm_phase<EpiGU8, MoeGUOrder, false, 1>(F.lds, g, S, E);
#else
    pg8::Gemm g{(const bf16*)(ws + WS_X2B), (const bf16*)(ws + WS_WEGU), 1024, 1024, 1024, (const int*)(ws + WS_ROWSEL), 127, 127}; MoeGUOrder S{F.G, (int)blockIdx.x};
    EpiGU E{(bf16*)(ws + WS_HID), ss2, (const int*)(ws + WS_ROWSEL)};
    pg8::gemm_phase<EpiGU, MoeGUOrder, true>(F.lds, g, S, E);
#endif
  PH_END(12)
  PH_BEGIN(13)
#if MOE_FP8_DOWN
    pg8::Gemm g{(const bf16*)(ws + WS_HID8), (const bf16*)(ws + WS_WED8), 1024, 1024, 1024, nullptr, 124, 121}; MoeDownOrder S{F.G, (int)blockIdx.x};
    EpiYE E{(bf16*)(ws + WS_YE), (const float*)(ws + WS_GSEL)};
    pg8::gemm_phase<EpiYE, MoeDownOrder, false, 1>(F.lds, g, S, E);
#else
    pg8::Gemm g{(const bf16*)(ws + WS_HID), (const bf16*)(ws + WS_WED), 2048, 2048, 2048, nullptr, 127, 127}; MoeDownOrder S{F.G, (int)blockIdx.x};
    EpiYE E{(bf16*)(ws + WS_YE), (const float*)(ws + WS_GSEL)};
    pg8::gemm_phase<EpiYE, MoeDownOrder, false>(F.lds, g, S, E);
#endif
  PH_END(13)
  PH_BEGIN(14) p14_final(F, a); PH_END(14)
#undef IN
#undef BOTH
#undef GRID_BAR
}

__global__ __launch_bounds__(256) void adapt_b2f(const bf16* src, long lds_, long scol, float* dst, long ldd, long dcol, long rows, long ncols) {
  const long i = blockIdx.x * 256L + threadIdx.x; if (i >= rows * ncols) return;
  const long r = i / ncols, c = i % ncols; dst[r * ldd + dcol + c] = bf2f(src[r * lds_ + scol + c]);
}
static void adapt(hipStream_t s, const void* src, long lds_, long scol, float* dst, long ldd, long dcol, long rows, long ncols) {
  hipLaunchKernelGGL(adapt_b2f, dim3((unsigned)((rows * ncols + 255) / 256)), dim3(256), 0, s, (const bf16*)src, lds_, scol, dst, ldd, dcol, rows, ncols);
}

static int mk_grid() {
  static int grid = 0;
  if (grid == 0) {
    int dev = 0, cus = 0, per_cu = 0;
    (void)hipGetDevice(&dev); (void)hipDeviceGetAttribute(&cus, hipDeviceAttributeMultiprocessorCount, dev);
    (void)hipFuncSetAttribute((const void*)mk, hipFuncAttributeMaxDynamicSharedMemorySize, LDS_BYTES);
    (void)hipOccupancyMaxActiveBlocksPerMultiprocessor(&per_cu, (const void*)mk, NTHR, LDS_BYTES);
    (void)hipGetLastError();
    grid = cus > 0 ? cus : 256;
  }
  return grid;
}
static void mk_launch(hipStream_t s, void* const* d_in, void* d_out, void* d_ws, int lo, int hi, int flags) {
  Args a; memset(&a, 0, sizeof(a));
  for (int i = 0; i < 26; ++i) a.in[i] = d_in[i];
  a.out = (float*)d_out; a.ws = (unsigned char*)d_ws; a.ph_lo = lo; a.ph_hi = hi; a.flags = flags; a.pad = 0;
  (void)hipMemsetAsync((char*)d_ws + WS_CTL + CW_BAR * 4, 0, XCD_BAR_WORDS * 4, s);
  hipLaunchKernelGGL(mk, dim3(mk_grid()), dim3(NTHR), LDS_BYTES, s, a);
}

extern "C" void kernel_launch(void* const* d_in, const int* in_sizes, int n_in, void* d_out, int out_size, void* d_ws, size_t ws_size, hipStream_t s) {
  (void)hipMemsetAsync((char*)d_ws + WS_CTL, 0, CTL_ZERO_BYTES, s);
  mk_launch(s, d_in, d_out, d_ws, 0, 15, 1);
}
```

```cpp
#include <hip/hip_runtime.h>
#include <cstdint>
#include <cstdio>
#include <cstring>

constexpr int BATCH = 4, SEQ = 4096, DM = 1024, MTOK = BATCH * SEQ;
constexpr int D_IN = 2480;
constexpr int OFF_QM = 0, OFF_KM = 512, OFF_VM = 1024, OFF_OM = 1536, OFF_G = 2048, OFF_CQ = 2064, OFF_CKV = 2320, OFF_KR = 2448;
constexpr int NEXP = 16, CAP = 512, DFF = 2048, NMEM = 256;
constexpr size_t MiB = 1u << 20;
enum { I_X = 0, I_MEM, I_POS, I_GMIX, I_WIN, I_BG, I_CONV, I_GQA, I_WQB, I_GKVA, I_WKVB, I_GHM, I_GHA, I_WOUT, I_GMX, I_GMKV, I_WMQ, I_WMK, I_WMV, I_WMO, I_GFFN, I_WR, I_WEG, I_WEU, I_WED, I_GFIN };
#define GAS __attribute__((address_space(1)))
#define LAS __attribute__((address_space(3)))
typedef unsigned short bf16;
typedef unsigned v4u __attribute__((ext_vector_type(4)));
typedef unsigned v2u __attribute__((ext_vector_type(2)));
typedef float f32x4 __attribute__((ext_vector_type(4)));
typedef float f32x16 __attribute__((ext_vector_type(16)));
typedef short bf16x8 __attribute__((ext_vector_type(8)));
typedef short s16x4 __attribute__((ext_vector_type(4)));
typedef GAS unsigned gu32;
#define RLX_AGENT __ATOMIC_RELAXED, __HIP_MEMORY_SCOPE_AGENT
#define LDS_WAIT() asm volatile("s_waitcnt lgkmcnt(0)" ::: "memory")
#define VM_WAIT() asm volatile("s_waitcnt vmcnt(0)" ::: "memory")
constexpr int NWAVES = 8, NTHR = 512;
__device__ __forceinline__ unsigned f2bf(float f) { unsigned u = __builtin_bit_cast(unsigned, f); return (u + 0x7fffu + ((u >> 16) & 1u)) >> 16; }
__device__ __forceinline__ unsigned pk2(float lo, float hi) { return f2bf(lo) | (f2bf(hi) << 16); }
__device__ __forceinline__ float bf2f(unsigned short h) { return __builtin_bit_cast(float, (unsigned)h << 16); }
__device__ __forceinline__ float bflo(unsigned w) { return __builtin_bit_cast(float, w << 16); }
__device__ __forceinline__ float bfhi(unsigned w) { return __builtin_bit_cast(float, w & 0xffff0000u); }
typedef float f32x2_t __attribute__((ext_vector_type(2))); typedef __bf16 bf16x2_t __attribute__((ext_vector_type(2)));
__device__ __forceinline__ unsigned cvt_pk_bf16(float lo, float hi) { f32x2_t v = {lo, hi}; bf16x2_t b = __builtin_convertvector(v, bf16x2_t); return __builtin_bit_cast(unsigned, b); }
__device__ __forceinline__ v2u pack8_fp8(const float (&v)[8], float sc) { float c[8];
#pragma unroll
  for (int i = 0; i < 8; ++i) c[i] = __builtin_amdgcn_fmed3f(v[i] * sc, -448.f, 448.f);
  int a = 0, b = 0; a = __builtin_amdgcn_cvt_pk_fp8_f32(c[0], c[1], a, false); a = __builtin_amdgcn_cvt_pk_fp8_f32(c[2], c[3], a, true);
  b = __builtin_amdgcn_cvt_pk_fp8_f32(c[4], c[5], b, false); b = __builtin_amdgcn_cvt_pk_fp8_f32(c[6], c[7], b, true); v2u r; r.x = (unsigned)a; r.y = (unsigned)b; return r; }
__device__ __forceinline__ float q8(float x, float sc) { const int p = __builtin_amdgcn_cvt_pk_fp8_f32(x * sc, 0.f, 0, false); return __builtin_amdgcn_cvt_f32_fp8(p, 0) * (1.f / sc); }
__device__ __forceinline__ float wave_sum(float v) {
#pragma unroll
  for (int o = 1; o < 64; o <<= 1) v += __shfl_xor(v, o);
  return v;
}
__device__ __forceinline__ float sigmoidf_(float x) { return 1.f / (1.f + __expf(-x)); }

#define XB_TMO      128
#define XB_XCNT(j)  (256  + 64 * (j))
#define XB_XSUB(j)  (1280 + 64 * (j))
#define XB_XGEN(j)  (2304 + 64 * (j))
#define XB_TOP      3328
#define XB_TOPGEN   3392
#define XCD_BAR_WORDS 3456
#define XB_SPIN_CAP (1u << 22)
__device__ __forceinline__ unsigned xb_ld(unsigned* p)              { return __hip_atomic_load(p, __ATOMIC_RELAXED, __HIP_MEMORY_SCOPE_AGENT); }
__device__ __forceinline__ unsigned xb_add(unsigned* p, unsigned v) { return __hip_atomic_fetch_add(p, v, __ATOMIC_RELAXED, __HIP_MEMORY_SCOPE_AGENT); }
__device__ __forceinline__ unsigned xb_xcc_id() { return (unsigned)__builtin_amdgcn_s_getreg((3 << 11) | 20) & 0xFu; }
#define XB_SPIN(cond, bar) do { unsigned _sp = 0; while (cond) { __builtin_amdgcn_s_sleep(1); \
    if ((++_sp & 255u) == 0u) { if (xb_ld(&(bar)[XB_TMO])) break; if (_sp > XB_SPIN_CAP) { atomicAdd(&(bar)[XB_TMO], 1u); break; } } } } while (0)
struct XcdBarrier { unsigned* bar; unsigned x; volatile LAS unsigned* st; };
__device__ __forceinline__ XcdBarrier xcd_barrier_post(unsigned* bar, volatile LAS unsigned* st) {
  XcdBarrier b; b.bar = bar; b.x = xb_xcc_id(); b.st = st;
  if (threadIdx.x == 0) (void)xb_add(&bar[XB_XCNT(b.x)], 1u);
  return b;
}
__device__ __forceinline__ void xcd_barrier_complete(unsigned* bar, unsigned x, unsigned& nloc, unsigned& nx) {
  const unsigned G = gridDim.x * gridDim.y * gridDim.z;
  unsigned sum, cnt, mine, sp = 0u;
  for (;;) {
    sum = 0u; cnt = 0u; mine = 0u;
#pragma unroll
    for (unsigned j = 0; j < 16; ++j) { const unsigned c = xb_ld(&bar[XB_XCNT(j)]); sum += c; cnt += (c > 0u) ? 1u : 0u; mine = (j == x) ? c : mine; }
    if (sum == G) break;
    __builtin_amdgcn_s_sleep(1);
    if ((++sp & 255u) == 0u) { if (xb_ld(&bar[XB_TMO])) break; if (sp > XB_SPIN_CAP) { atomicAdd(&bar[XB_TMO], 1u); break; } }
  }
  nloc = mine > 0u ? mine : 1u; nx = cnt > 0u ? cnt : 1u;
}
__device__ __forceinline__ void xcd_barrier(const XcdBarrier& b) {
  asm volatile("s_waitcnt vmcnt(0)" ::: "memory");
  __syncthreads();
  if (threadIdx.x == 0) {
    unsigned* bar = b.bar;
    __builtin_amdgcn_s_waitcnt(0);
    unsigned nloc = b.st[0], nx = b.st[1];
    if (nloc == 0u) { xcd_barrier_complete(bar, b.x, nloc, nx); b.st[0] = nloc; b.st[1] = nx; }
    const unsigned old = xb_add(&bar[XB_XSUB(b.x)], 1u);
    const unsigned gen = old / nloc;
    if (old + 1u == (gen + 1u) * nloc) {
      __builtin_amdgcn_fence(__ATOMIC_RELEASE, "agent");
      asm volatile("s_waitcnt vmcnt(0)" ::: "memory");
      const unsigned og = xb_add(&bar[XB_TOP], 1u);
      const unsigned tg = og / nx;
      if (og + 1u == (tg + 1u) * nx) xb_add(&bar[XB_TOPGEN], 1u);
      else XB_SPIN(xb_ld(&bar[XB_TOPGEN]) == tg, bar);
      __builtin_amdgcn_fence(__ATOMIC_ACQUIRE, "agent");
      xb_add(&bar[XB_XGEN(b.x)], 1u);
      asm volatile("s_waitcnt vmcnt(0)" ::: "memory");
    } else {
      XB_SPIN(xb_ld(&bar[XB_XGEN(b.x)]) == gen, bar);
      __builtin_amdgcn_fence(__ATOMIC_ACQUIRE, "agent");
      asm volatile("s_waitcnt vmcnt(0)" ::: "memory");
    }
  }
  __syncthreads();
}

namespace pg8 {
constexpr int BM = 256, BK = 64, HALF = 128, HTB = HALF * BK * 2, STAGE_BYTES = 8 * HTB, NXCD = 8, WGM = 8;
__host__ __device__ __forceinline__ int lds_byte(int r, int c) { const int st = (r >> 4) * 2 + (c >> 5), rr = r & 15, cc = c & 31, ob = rr * 64 + cc * 2; return st * 1024 + (ob ^ (((ob >> 9) & 1) << 5)); }
__host__ __device__ __forceinline__ void stage_rc(int b, int& R, int& C) { const int st = b / 1024, sb = b % 1024, swz = sb ^ (((sb >> 9) & 1) << 5); R = (st >> 1) * 16 + swz / 64; C = (st & 1) * 32 + (swz % 64) / 2; }
__host__ __device__ __forceinline__ int perm32(int rho) { const int n = rho >> 4, i = rho & 15; return 8 * (i >> 2) + 4 * n + (i & 3); }

struct Unit { long aoff, boff; int pm, pn, g, ibase; };
struct Gemm { const bf16* A; const bf16* Bt; int lda, ldb, K; const int* gidx; int sa, sb; };
typedef int v8i_t __attribute__((ext_vector_type(8))); typedef int v4i_t __attribute__((ext_vector_type(4)));
__device__ __forceinline__ v8i_t cat8(bf16x8 lo, bf16x8 hi) { const v4i_t a = __builtin_bit_cast(v4i_t, lo), b = __builtin_bit_cast(v4i_t, hi); return __builtin_shufflevector(a, b, 0, 1, 2, 3, 4, 5, 6, 7); }

struct StaticOrder {
  int nM, nN, nwg, G, c, lda, ldb;
  __device__ void init(int M, int N, int G_, int c_, int lda_, int ldb_) { nM = M / BM; nN = N / BM; nwg = nM * nN; G = G_; c = c_; lda = lda_; ldb = ldb_; }
  __device__ bool next(int i, Unit& u) const {
    const long L = (long)i * G + c; if (L >= nwg) return false;
    int wgid = (int)L; { const int q = nwg / NXCD, r = nwg % NXCD, xcd = wgid % NXCD, off = wgid / NXCD; wgid = (xcd < r ? xcd * (q + 1) : r * (q + 1) + (xcd - r) * q) + off; }
    const int nig = WGM * nN, gid = wgid / nig, fm = gid * WGM, gsz = (nM - fm) < WGM ? (nM - fm) : WGM;
    u.pm = fm + ((wgid % nig) % gsz); u.pn = (wgid % nig) / gsz; u.g = 0; u.ibase = 0;
    u.aoff = (long)u.pm * BM * lda; u.boff = (long)u.pn * BM * ldb; return true;
  }
};

template <class Epi, class Sched, bool GATHER, int FP8 = 0>
__device__ __forceinline__ void gemm_phase(LAS unsigned char* lds, const Gemm g, const Sched& S, const Epi& E) {
  int tid = threadIdx.x; asm volatile("" : "+v"(tid));
  const int wid = __builtin_amdgcn_readfirstlane(tid >> 6), lane = tid & 63, wr = wid >> 2, wc = wid & 3, fr = lane & 15, fq = lane >> 4;
  const int K = g.K, nt = K / BK;
  int Rs[2], Cs[2]; unsigned voffB[2];
#pragma unroll
  for (int i = 0; i < 2; ++i) { int R, C; stage_rc(tid * 16 + i * 8192, R, C); Rs[i] = R; Cs[i] = C; const int Rb = (R & ~31) + perm32(R & 31); voffB[i] = (unsigned)(Rb * g.ldb + C) * 2u; }
  const size_t kstep = (size_t)(BK * 2);
  const size_t hstepB = (size_t)HALF * g.ldb * 2;
  const unsigned ldsw = (unsigned)wid * 1024u;
  const int aoff_l = lds_byte(wr * 64 + fr, fq * 8), boff_l = lds_byte(wc * 32 + fr, fq * 8);
  constexpr int aoff_k = 1024, boff_k = 1024;
#define PG8_SA(b, h) (((b) * 2 + (h)) * HTB)
#define PG8_SB(b, h) ((4 + (b) * 2 + (h)) * HTB)
#define PG8_STAGE(bufoff, gbase, voff) do { _Pragma("unroll") for (int _i = 0; _i < 2; ++_i) \
        __builtin_amdgcn_global_load_lds((const unsigned*)((const char*)(gbase) + (voff)[_i]), (LAS unsigned*)(lds + (bufoff) + ldsw + _i * 8192), 16, 0, 0); } while (0)
#define PG8_LDA(dst, b, h) do { _Pragma("unroll") for (int m = 0; m < 4; ++m) { if constexpr (FP8) { const v4i_t lo_ = *(const LAS v4i_t*)(lds + PG8_SA(b, h) + aoff_l + m * 2048), hi_ = *(const LAS v4i_t*)(lds + PG8_SA(b, h) + aoff_l + m * 2048 + aoff_k); dst##8[m] = __builtin_shufflevector(lo_, hi_, 0, 1, 2, 3, 4, 5, 6, 7); } \
        else { _Pragma("unroll") for (int k = 0; k < 2; ++k) dst[m][k] = *(const LAS bf16x8*)(lds + PG8_SA(b, h) + aoff_l + m * 2048 + k * aoff_k); } } } while (0)
#define PG8_LDB(dst, b, h) do { _Pragma("unroll") for (int n = 0; n < 2; ++n) { if constexpr (FP8) { const v4i_t lo_ = *(const LAS v4i_t*)(lds + PG8_SB(b, h) + boff_l + n * 2048), hi_ = *(const LAS v4i_t*)(lds + PG8_SB(b, h) + boff_l + n * 2048 + boff_k); dst##8[n] = __builtin_shufflevector(lo_, hi_, 0, 1, 2, 3, 4, 5, 6, 7); } \
        else { _Pragma("unroll") for (int k = 0; k < 2; ++k) dst[n][k] = *(const LAS bf16x8*)(lds + PG8_SB(b, h) + boff_l + n * 2048 + k * boff_k); } } } while (0)
#define PG8_MMA(ai, bj, At, Bt) do { __builtin_amdgcn_s_setprio(1); _Pragma("unroll") for (int m = 0; m < 4; ++m) _Pragma("unroll") for (int n = 0; n < 2; ++n) { \
        if constexpr (FP8) asm volatile("v_mfma_scale_f32_16x16x128_f8f6f4 %0, %1, %2, %0, %3, %4 op_sel_hi:[0,0,0]" : "+v"(acc[ai][bj][m][n]) : "v"(Bt##8[n]), "v"(At##8[m]), "v"(vsb), "v"(vsa)); \
        else { _Pragma("unroll") for (int k = 0; k < 2; ++k) acc[ai][bj][m][n] = __builtin_amdgcn_mfma_f32_16x16x32_bf16(Bt[n][k], At[m][k], acc[ai][bj][m][n], 0, 0, 0); } } \
        __builtin_amdgcn_s_setprio(0); } while (0)
#define PG8_WAIT_V(n) asm volatile("s_waitcnt vmcnt(" #n ")" ::: "memory")
#define PG8_WAIT_L(n) asm volatile("s_waitcnt lgkmcnt(" #n ")" ::: "memory")
#define PG8_BAR __builtin_amdgcn_s_barrier()
#define PG8_SCHED __builtin_amdgcn_sched_barrier(0)
  Unit cur, nxt; int ui = 0;
  if (!S.next(0, cur)) return;
  unsigned vA[2][2], nvA[2][2];
  auto load_va = [&](const Unit& u, unsigned (&v)[2][2]) {
#pragma unroll
    for (int h = 0; h < 2; ++h)
#pragma unroll
      for (int i = 0; i < 2; ++i) {
        if constexpr (GATHER) v[h][i] = (unsigned)((long)g.gidx[u.ibase + h * HALF + Rs[i]] * g.lda + Cs[i]) * 2u;
        else v[h][i] = (unsigned)((h * HALF + Rs[i]) * g.lda + Cs[i]) * 2u;
      }
  };
  load_va(cur, vA);
  f32x4 acc[2][2][4][2];
#pragma unroll
  for (int a = 0; a < 2; ++a)
#pragma unroll
    for (int b = 0; b < 2; ++b)
#pragma unroll
      for (int m = 0; m < 4; ++m)
#pragma unroll
        for (int n = 0; n < 2; ++n) acc[a][b][m][n] = (f32x4){0.f, 0.f, 0.f, 0.f};
  int vsa = g.sa, vsb = g.sb; (void)vsa; (void)vsb;
  bf16x8 At[4][2], B0[2][2], B1[2][2]; v8i_t At8[4], B08[2], B18[2];
  const char* cA = (const char*)g.A + (GATHER ? 0 : cur.aoff * 2); const char* cB = (const char*)g.Bt + cur.boff * 2;
  PG8_STAGE(PG8_SB(0, 0), cB, voffB); PG8_STAGE(PG8_SB(0, 1), cB + hstepB, voffB); PG8_STAGE(PG8_SA(0, 0), cA, vA[0]); PG8_STAGE(PG8_SA(0, 1), cA, vA[1]);
  if (wr == 1) PG8_BAR;
  PG8_WAIT_V(2); PG8_BAR;
  PG8_STAGE(PG8_SB(1, 0), cB + kstep, voffB); PG8_STAGE(PG8_SA(1, 0), cA + kstep, vA[0]); PG8_STAGE(PG8_SB(1, 1), cB + hstepB + kstep, voffB);
  PG8_WAIT_V(6); PG8_BAR;
  for (;;) {
    const bool has_next = S.next(ui + 1, nxt);
    const char* nA = has_next ? (const char*)g.A + (GATHER ? 0 : nxt.aoff * 2) : cA; const char* nB = has_next ? (const char*)g.Bt + nxt.boff * 2 : cB;
    if constexpr (GATHER) { if (has_next) load_va(nxt, nvA); else {
#pragma unroll
      for (int h = 0; h < 2; ++h)
#pragma unroll
        for (int i = 0; i < 2; ++i) nvA[h][i] = vA[h][i]; } }
#pragma unroll 1
    for (int t = 0; t < nt; t += 2) {
      const bool last = (t == nt - 2);
      const char* a1 = cA + (size_t)(t + 1) * kstep;
      const char* a2 = last ? nA : cA + (size_t)(t + 2) * kstep; const char* b2 = last ? nB : cB + (size_t)(t + 2) * kstep;
      const char* a3 = a2 + kstep; const char* b3 = b2 + kstep;
      unsigned w0[2], w1[2];
      if constexpr (GATHER) { w0[0] = last ? nvA[0][0] : vA[0][0]; w0[1] = last ? nvA[0][1] : vA[0][1]; w1[0] = last ? nvA[1][0] : vA[1][0]; w1[1] = last ? nvA[1][1] : vA[1][1]; }
      else { w0[0] = vA[0][0]; w0[1] = vA[0][1]; w1[0] = vA[1][0]; w1[1] = vA[1][1]; }
      PG8_LDB(B0, 0, 0); PG8_LDB(B1, 0, 1); PG8_SCHED; PG8_LDA(At, 0, 0); PG8_STAGE(PG8_SA(1, 1), a1, vA[1]);
      PG8_WAIT_V(8); PG8_WAIT_L(0); PG8_BAR; PG8_MMA(0, 0, At, B0); PG8_MMA(0, 1, At, B1); PG8_BAR; PG8_SCHED;
      PG8_LDA(At, 0, 1); PG8_STAGE(PG8_SB(0, 0), b2, voffB); PG8_STAGE(PG8_SB(0, 1), b2 + hstepB, voffB); PG8_STAGE(PG8_SA(0, 0), a2, w0);
      PG8_WAIT_V(8); PG8_WAIT_L(0); PG8_BAR; PG8_MMA(1, 0, At, B0); PG8_MMA(1, 1, At, B1); PG8_BAR; PG8_SCHED;
      PG8_LDB(B0, 1, 0); PG8_LDB(B1, 1, 1); PG8_SCHED; PG8_LDA(At, 1, 0); PG8_STAGE(PG8_SA(0, 1), a2, w1);
      PG8_WAIT_V(8); PG8_WAIT_L(0); PG8_BAR; PG8_MMA(0, 0, At, B0); PG8_MMA(0, 1, At, B1); PG8_BAR; PG8_SCHED;
      PG8_LDA(At, 1, 1); PG8_STAGE(PG8_SB(1, 0), b3, voffB); PG8_STAGE(PG8_SB(1, 1), b3 + hstepB, voffB); PG8_STAGE(PG8_SA(1, 0), a3, w0);
      PG8_WAIT_V(8); PG8_WAIT_L(0); PG8_BAR; PG8_MMA(1, 0, At, B0); PG8_MMA(1, 1, At, B1); PG8_BAR; PG8_SCHED;
    }
    if constexpr (FP8) { asm volatile("s_nop 15\n\ts_nop 15" ::: "memory"); __builtin_amdgcn_sched_barrier(0); }
    if (wr == 0) PG8_BAR;
    int fr_o = fr, fq_o = fq; asm volatile("" : "+v"(fr_o), "+v"(fq_o));
    if constexpr (Epi::TWO_PASS) {
#pragma unroll
      for (int ai = 0; ai < 2; ++ai)
#pragma unroll
        for (int m = 0; m < 4; ++m) {
          float v0[8], v1[8];
#pragma unroll
          for (int n = 0; n < 2; ++n)
#pragma unroll
            for (int j = 0; j < 4; ++j) { v0[n * 4 + j] = acc[ai][0][m][n][j]; v1[n * 4 + j] = acc[ai][1][m][n][j]; }
          E.pass1(cur, ai * HALF + wr * 64 + m * 16 + fr_o, wc, v0, v1, fq_o);
#pragma unroll
          for (int n = 0; n < 2; ++n)
#pragma unroll
            for (int j = 0; j < 4; ++j) { acc[ai][0][m][n][j] = v0[n * 4 + j]; acc[ai][1][m][n][j] = v1[n * 4 + j]; }
        }
      asm volatile("s_waitcnt lgkmcnt(0)" ::: "memory"); PG8_BAR; asm volatile("" ::: "memory");
    }
    {
#pragma unroll
      for (int ai = 0; ai < 2; ++ai)
#pragma unroll
        for (int m = 0; m < 4; ++m) {
          float v0[8], v1[8];
#pragma unroll
          for (int n = 0; n < 2; ++n)
#pragma unroll
            for (int j = 0; j < 4; ++j) { v0[n * 4 + j] = acc[ai][0][m][n][j]; v1[n * 4 + j] = acc[ai][1][m][n][j]; }
          E.row8(cur, ai * HALF + wr * 64 + m * 16 + fr_o, wc * 32 + 8 * fq_o, v0, v1, fq_o);
          asm volatile("" ::: "memory");
        }
    }
    if (!has_next) break;
#pragma unroll
    for (int a = 0; a < 2; ++a)
#pragma unroll
      for (int b = 0; b < 2; ++b)
#pragma unroll
        for (int m = 0; m < 4; ++m)
#pragma unroll
          for (int n = 0; n < 2; ++n) acc[a][b][m][n] = (f32x4){0.f, 0.f, 0.f, 0.f};
    cur = nxt; cA = nA; cB = nB; ++ui;
    if constexpr (GATHER) {
#pragma unroll
      for (int h = 0; h < 2; ++h)
#pragma unroll
        for (int i = 0; i < 2; ++i) vA[h][i] = nvA[h][i]; }
    if (wr == 1) PG8_BAR;
  }
  PG8_WAIT_V(0);
  PG8_BAR;
#undef PG8_SA
#undef PG8_SB
#undef PG8_STAGE
#undef PG8_LDA
#undef PG8_LDB
#undef PG8_MMA
#undef PG8_WAIT_V
#undef PG8_WAIT_L
#undef PG8_BAR
#undef PG8_SCHED
}
}
constexpr size_t WS_CTL = 0, CTL_ZERO_BYTES = 1 * MiB;
constexpr int CW_TMO = 0, CW_BAR = 4096, CW_Q = 8192;
constexpr size_t CTL_SSQ = 256 * 1024, CTL_SSKV = CTL_SSQ + 65536, CTL_SS1 = CTL_SSKV + 65536, CTL_SS2 = CTL_SS1 + 65536;
constexpr size_t WS_WIN = 1 * MiB, WS_WQB = 6 * MiB, WS_WKVB = 6 * MiB + 512 * 1024, WS_WOUT = 7 * MiB, WS_WMQ = 9 * MiB, WS_WMK = 11 * MiB, WS_WMV = 13 * MiB, WS_WMO = 15 * MiB;
constexpr size_t WS_ROPE = 17 * MiB, WS_MEMN = 19 * MiB, WS_KMEM = 21 * MiB, WS_VMEMT = 23 * MiB, WS_GSC = 25 * MiB, WS_DEC = 28 * MiB, WS_AFF = 29 * MiB, WS_SEL = 30 * MiB;
constexpr size_t WS_PROJ = 32 * MiB, WS_XN = 112 * MiB, WS_QC = 112 * MiB, WS_KC = 128 * MiB, WS_QM = 144 * MiB, WS_KM = 168 * MiB, WS_VM = 192 * MiB, WS_HF = 208 * MiB, WS_HB = 224 * MiB, WS_Y = 240 * MiB;
constexpr size_t WS_X1 = 112 * MiB, WS_X1B = 176 * MiB, WS_QMEM = 208 * MiB, WS_P = 240 * MiB, WS_MO = 112 * MiB, WS_X2 = 208 * MiB, WS_X2B = 208 * MiB, WS_HID = 32 * MiB;
constexpr size_t WS_DUMMY = 304 * MiB;
#ifndef X2MODE
#define X2MODE 2
#endif
constexpr size_t WS_X2F = 256 * MiB;
constexpr size_t WS_WEGU = 320 * MiB, WS_WED = 448 * MiB, WS_END = 512 * MiB;
constexpr int PROJ_LD = 2560;
constexpr int PC_CQ = 2048, PC_CKV = 2304, PC_KR = 2432, PC_G = 2464;
constexpr int RING_BYTES = 131072, LDSCTL_OFF = 133120, LDS_BYTES = 147456;

struct Args { const void* in[26]; float* out; unsigned char* ws; int ph_lo, ph_hi, flags, pad; };

struct Frame {
  LAS unsigned char* lds; volatile LAS unsigned* MISC; gu32* ctl; unsigned char* ws;
  int tid, lane, wave, vcu, G;
};

__device__ __forceinline__ void p0_tr(const float* W, int ldw, int k0, int kvalid, int scol0, int ncols, const float* gs, bf16* WT, int ldt, int drow0, LAS float* scr, int lane, bool doq = false) {
  const int c4 = (lane & 15) * 4, kr = lane >> 4;
  f32x4 v[16];
#pragma unroll
  for (int i = 0; i < 16; ++i) { const int kk = 4 * i + kr; v[i] = (f32x4){0.f, 0.f, 0.f, 0.f};
    if (c4 < ncols && k0 + kk < kvalid) { v[i] = *(const f32x4*)(W + (size_t)(k0 + kk) * ldw + scol0 + c4); if (gs) v[i] = v[i] * gs[k0 + kk];
      if (doq) { v[i].x = q8(v[i].x, 64.f); v[i].y = q8(v[i].y, 64.f); v[i].z = q8(v[i].z, 64.f); v[i].w = q8(v[i].w, 64.f); } } }
#pragma unroll
  for (int i = 0; i < 16; ++i) { const int kk = 4 * i + kr; LAS float* d = scr + kk * 65 + c4; d[0] = v[i].x; d[1] = v[i].y; d[2] = v[i].z; d[3] = v[i].w; }
  LDS_WAIT(); asm volatile("" ::: "memory");
  const int c = lane & 7;
#pragma unroll
  for (int j = 0; j < 8; ++j) { const int n = (lane >> 3) + 8 * j; const LAS float* s = scr + (8 * c) * 65 + n;
    v4u o; o.x = pk2(s[0 * 65], s[1 * 65]); o.y = pk2(s[2 * 65], s[3 * 65]); o.z = pk2(s[4 * 65], s[5 * 65]); o.w = pk2(s[6 * 65], s[7 * 65]);
    *(GAS v4u*)(WT + (size_t)(drow0 + n) * ldt + k0 + 8 * c) = o; }
  LDS_WAIT(); asm volatile("" ::: "memory");
}
struct ConvDesc { const float* W; const float* gs; unsigned char* WT8; int ldw, k0, scol0, ldt, drow0; };
__device__ __forceinline__ void p0_tr8_load(const ConvDesc& d, f32x4 (&v)[16], int lane) {
  const int c4 = (lane & 15) * 4, kr = lane >> 4;
#pragma unroll
  for (int i = 0; i < 16; ++i) { const int kk = 4 * i + kr; v[i] = *(const f32x4*)(d.W + (size_t)(d.k0 + kk) * d.ldw + d.scol0 + c4); }
}
__device__ __forceinline__ void p0_tr8_finish(const ConvDesc& d, f32x4 (&v)[16], float sc, LAS float* scr, int lane) {
  const int c4 = (lane & 15) * 4, kr = lane >> 4;
#pragma unroll
  for (int i = 0; i < 16; ++i) { const int kk = 4 * i + kr; f32x4 x = v[i]; if (d.gs) x = x * d.gs[d.k0 + kk]; LAS float* p = scr + kk * 65 + c4; p[0] = x.x; p[1] = x.y; p[2] = x.z; p[3] = x.w; }
  LDS_WAIT(); asm volatile("" ::: "memory");
  const int c = lane & 7;
#pragma unroll
  for (int j = 0; j < 8; ++j) { const int n = (lane >> 3) + 8 * j; const LAS float* s = scr + (8 * c) * 65 + n;
    float f[8];
#pragma unroll
    for (int q = 0; q < 8; ++q) f[q] = s[q * 65];
    *(GAS v2u*)(d.WT8 + (size_t)(d.drow0 + n) * d.ldt + d.k0 + 8 * c) = pack8_fp8(f, sc); }
  LDS_WAIT(); asm volatile("" ::: "memory");
}
__device__ __forceinline__ void p0_tr32(const float* W, int ldw, int k0, int scol0, int ncols, const float* gs, bf16* WT, int ldt, int drow0, LAS float* scr, int lane) {
#pragma unroll 8
  for (int i = 0; i < 32; ++i) { const int kk = 2 * i + (lane >> 5), c = lane & 31; float v = 0.f;
    if (c < ncols) { v = W[(size_t)(k0 + kk) * ldw + scol0 + c]; if (gs) v *= gs[k0 + kk]; }
    scr[kk * 65 + c] = v; }
  LDS_WAIT(); asm volatile("" ::: "memory");
  const int c = lane & 7;
#pragma unroll
  for (int j = 0; j < 4; ++j) { const int n = (lane >> 3) + 8 * j; const LAS float* s = scr + (8 * c) * 65 + n;
    v4u o; o.x = pk2(s[0 * 65], s[1 * 65]); o.y = pk2(s[2 * 65], s[3 * 65]); o.z = pk2(s[4 * 65], s[5 * 65]); o.w = pk2(s[6 * 65], s[7 * 65]);
    *(GAS v4u*)(WT + (size_t)(drow0 + n) * ldt + k0 + 8 * c) = o; }
  LDS_WAIT(); asm volatile("" ::: "memory");
}
__device__ __forceinline__ void rms_row_to_bf16(const float* xrow, bf16* orow, int lane) {
  const GAS f32x4* xr = (const GAS f32x4*)xrow + lane;
  f32x4 v[4]; float s = 0.f;
#pragma unroll
  for (int j = 0; j < 4; ++j) { v[j] = xr[64 * j]; s += (v[j].x * v[j].x + v[j].y * v[j].y) + (v[j].z * v[j].z + v[j].w * v[j].w); }
  const float rstd = rsqrtf(wave_sum(s) * (1.f / 1024.f) + 1e-6f);
  GAS unsigned long long* o8 = (GAS unsigned long long*)orow + lane;
#pragma unroll
  for (int j = 0; j < 4; ++j) o8[64 * j] = (unsigned long long)pk2(v[j].x * rstd, v[j].y * rstd) | ((unsigned long long)pk2(v[j].z * rstd, v[j].w * rstd) << 32);
}

#ifndef FP8EMU
#define FP8EMU 0
#endif
#ifndef MOE_FP8
#define MOE_FP8 1
#endif
#ifndef CONV_NT
#define CONV_NT 0
#endif
#ifndef MOE_FP8_DOWN
#define MOE_FP8_DOWN MOE_FP8
#endif
constexpr size_t WS_PO = 384 * MiB, WS_PML = 272 * MiB;
constexpr size_t WS_XG = 96 * MiB;
constexpr size_t WS_X2Q = 208 * MiB, WS_WEGU8 = 320 * MiB, WS_WED8 = 448 * MiB, WS_HID8 = 32 * MiB;
constexpr int CW_RDY = 8192 + 64 * 44;
constexpr int CW_CONV = 8192 + 64 * 40, CW_MDONE = 8192 + 64 * 41, CW_TDONE = 8192 + 64 * 42;
constexpr int CONV_IGU = 16 * 64, CONV_ID = 32 * 16, CONV_ITEMS = NEXP * (CONV_IGU + CONV_ID), CONV_CHUNKS = CONV_ITEMS / 8;
__device__ __forceinline__ ConvDesc conv_desc(Frame& F, const Args& a, int it) {
  auto I = [&](int i) { return (const float*)a.in[i]; };
  unsigned char* ws = F.ws; ConvDesc d;
  const int e = it / (CONV_IGU + CONV_ID); int r = it % (CONV_IGU + CONV_ID);
  if (r < CONV_IGU) { const int kb = r / 64, nb = r % 64, p = nb >> 2, j0 = (nb & 3) * 64; const bool up = j0 >= 128;
    d.W = (up ? I(I_WEU) : I(I_WEG)) + (size_t)e * 1024 * 2048; d.ldw = 2048; d.k0 = 64 * kb; d.scol0 = 128 * p + (up ? j0 - 128 : j0); d.gs = I(I_GFFN); d.WT8 = ws + WS_WEGU8 + (size_t)e * 4096 * 1024; d.ldt = 1024; d.drow0 = 64 * nb; }
  else { r -= CONV_IGU; const int kb = r / 16, nb = r % 16;
    d.W = I(I_WED) + (size_t)e * 2048 * 1024; d.ldw = 1024; d.k0 = 64 * kb; d.scol0 = 64 * nb; d.gs = nullptr; d.WT8 = ws + WS_WED8 + (size_t)e * 1024 * 2048; d.ldt = 2048; d.drow0 = 64 * nb; }
  return d;
}
__device__ __forceinline__ void conv_fill(Frame& F, const Args& a, int maxpairs) {
  static_assert(MOE_FP8 && MOE_FP8_DOWN, "the conversion filler writes fp8 expert weights");
  volatile LAS int* slot = (volatile LAS int*)(F.lds + LDSCTL_OFF + 16);
  LAS float* scr = (LAS float*)(F.lds + F.wave * 16640);
  for (int n = 0; n < maxpairs; ++n) {
    if (F.tid == 0) { int got = -1;
      if (__hip_atomic_load(F.ctl + CW_CONV, RLX_AGENT) < (unsigned)CONV_CHUNKS) { const unsigned c = __hip_atomic_fetch_add(F.ctl + CW_CONV, 2u, RLX_AGENT); if (c < (unsigned)CONV_CHUNKS) got = (int)c; }
      *slot = got; }
    __syncthreads();
    const int c = __builtin_amdgcn_readfirstlane(*slot);
    __syncthreads();
    if (c < 0) break;
    const ConvDesc d0 = conv_desc(F, a, c * 8 + F.wave), d1 = conv_desc(F, a, (c + 1) * 8 + F.wave);
    f32x4 v0[16], v1[16];
    p0_tr8_load(d0, v0, F.lane); p0_tr8_load(d1, v1, F.lane);
    p0_tr8_finish(d0, v0, 64.f, scr, F.lane); p0_tr8_finish(d1, v1, 64.f, scr, F.lane);
  }
}
__device__ __forceinline__ void p0_prologue(Frame& F, const Args& a, bool do_dense, bool do_experts) {
  LAS float* scr = (LAS float*)(F.lds + F.wave * 16640);
  const int gw = F.vcu * NWAVES + F.wave, NGW = F.G * NWAVES;
  auto I = [&](int i) { return (const float*)a.in[i]; };
  unsigned char* ws = F.ws;
  if (do_dense) {
    constexpr int I_WIN_ = 16 * 40, I_WQB_ = 4 * 12, I_WKVB_ = 4 * 16, I_SQ = 16 * 16;
    constexpr int NIT = I_WIN_ + I_WQB_ + I_WKVB_ + 5 * I_SQ;
    for (int it = gw; it < NIT; it += NGW) {
      int r = it;
      if (r < I_WIN_) { const int kb = r / 40, nb = r % 40; int sc, nc = 64;
        if (nb < 32) sc = 64 * nb; else if (nb < 36) sc = OFF_CQ + 64 * (nb - 32); else if (nb < 38) sc = OFF_CKV + 64 * (nb - 36); else if (nb == 38) { sc = OFF_KR; nc = 32; } else { sc = 0; nc = 0; }
        p0_tr(I(I_WIN), D_IN, 64 * kb, 1024, sc, nc, I(I_GMIX), (bf16*)(ws + WS_WIN), 1024, 64 * nb, scr, F.lane);
        if (nb == 38) p0_tr32(I(I_WIN), D_IN, 64 * kb, OFF_G, 16, I(I_GMIX), (bf16*)(ws + WS_WIN), 1024, PC_G, scr, F.lane);
        continue; } r -= I_WIN_;
      if (r < I_WQB_) { const int kb = r / 12, nb = r % 12; p0_tr(I(I_WQB), 768, 64 * kb, 256, 64 * nb, 64, I(I_GQA), (bf16*)(ws + WS_WQB), 256, 64 * nb, scr, F.lane); continue; } r -= I_WQB_;
      if (r < I_WKVB_) { const int kb = r / 16, nb = r % 16; const int h = nb & 7; const int sc = h * 128 + (nb >= 8 ? 64 : 0);
        p0_tr(I(I_WKVB), 1024, 64 * kb, 128, sc, 64, I(I_GKVA), (bf16*)(ws + WS_WKVB), 256, 64 * nb, scr, F.lane); continue; } r -= I_WKVB_;
      const int which = r / I_SQ; r %= I_SQ; const int kb = r / 16, nb = r % 16;
      const float* src = which == 0 ? I(I_WOUT) : which == 1 ? I(I_WMQ) : which == 2 ? I(I_WMK) : which == 3 ? I(I_WMV) : I(I_WMO);
      const float* gs = which == 1 ? I(I_GMX) : (which == 2 || which == 3) ? I(I_GMKV) : nullptr;
      bf16* dst = (bf16*)(ws + (which == 0 ? WS_WOUT : which == 1 ? WS_WMQ : which == 2 ? WS_WMK : which == 3 ? WS_WMV : WS_WMO));
      p0_tr(src, 1024, 64 * kb, 1024, 64 * nb, 64, gs, dst, 1024, 64 * nb, scr, F.lane);
    }
    for (int m0 = gw; m0 < MTOK; m0 += 4 * NGW) {
      f32x4 v[4][4];
#pragma unroll
      for (int u = 0; u < 4; ++u) { const GAS f32x4* xr = (const GAS f32x4*)(I(I_X) + (size_t)(m0 + u * NGW) * 1024) + F.lane;
#pragma unroll
        for (int j = 0; j < 4; ++j) v[u][j] = __builtin_nontemporal_load(xr + 64 * j); }
#pragma unroll
      for (int u = 0; u < 4; ++u) { float s = 0.f;
#pragma unroll
        for (int j = 0; j < 4; ++j) s += (v[u][j].x * v[u][j].x + v[u][j].y * v[u][j].y) + (v[u][j].z * v[u][j].z + v[u][j].w * v[u][j].w);
        const float rstd = rsqrtf(wave_sum(s) * (1.f / 1024.f) + 1e-6f);
        GAS unsigned long long* o8 = (GAS unsigned long long*)((bf16*)(ws + WS_XN) + (size_t)(m0 + u * NGW) * 1024) + F.lane;
#pragma unroll
        for (int j = 0; j < 4; ++j) o8[64 * j] = (unsigned long long)pk2(v[u][j].x * rstd, v[u][j].y * rstd) | ((unsigned long long)pk2(v[u][j].z * rstd, v[u][j].w * rstd) << 32); } }
    for (int m = gw; m < BATCH * NMEM; m += NGW) rms_row_to_bf16(I(I_MEM) + (size_t)m * 1024, (bf16*)(ws + WS_MEMN) + (size_t)m * 1024, F.lane);
    { const float* wr = I(I_WR); const float* gf = I(I_GFFN); float* wrg = (float*)(ws + WS_DEC + 65536);
      for (int i = (F.vcu * NTHR + F.tid); i < 1024 * 16; i += F.G * NTHR) wrg[i] = wr[i] * gf[i >> 4]; }
    { const int* pos = (const int*)a.in[I_POS]; float* rt = (float*)(ws + WS_ROPE);
      for (int i = (F.vcu * NTHR + F.tid); i < MTOK * 16; i += F.G * NTHR) { const int m = i >> 4, j = i & 15; const float inv = powf(10000.f, -(float)j / 16.f); const float ang = (float)pos[m] * inv;
        rt[m * 32 + j] = cosf(ang); rt[m * 32 + 16 + j] = sinf(ang); } }
  }
  if (do_experts) conv_fill(F, a, 1 << 30);
}

__device__ __forceinline__ v4u pack8(const float (&v)[8]) { v4u w; w.x = cvt_pk_bf16(v[0], v[1]); w.y = cvt_pk_bf16(v[2], v[3]); w.z = cvt_pk_bf16(v[4], v[5]); w.w = cvt_pk_bf16(v[6], v[7]); return w; }
__device__ __forceinline__ float sumsq8(const float (&v)[8]) { float s = 0.f;
#pragma unroll
  for (int i = 0; i < 8; ++i) s += v[i] * v[i];
  return s; }
struct EpiStore { static constexpr bool TWO_PASS = false; bf16* O; int ldc;
  __device__ __forceinline__ void row8(const pg8::Unit& u, int rloc, int cloc, const float (&v0)[8], const float (&v1)[8], int fq) const {
    bf16* p = O + (size_t)(u.pm * 256 + rloc) * ldc + u.pn * 256 + cloc; *(v4u*)p = pack8(v0); *(v4u*)(p + 128) = pack8(v1); } };
struct EpiProj { static constexpr bool TWO_PASS = false; bf16* P; float* ssq; float* sskv;
  __device__ __forceinline__ void row8(const pg8::Unit& u, int rloc, int cloc, const float (&v0)[8], const float (&v1)[8], int fq) const {
    const int row = u.pm * 256 + rloc; bf16* p = P + (size_t)row * PROJ_LD + u.pn * 256 + cloc; *(v4u*)p = pack8(v0); *(v4u*)(p + 128) = pack8(v1);
    if (u.pn == 8) { float s = sumsq8(v0) + sumsq8(v1); s += __shfl_xor(s, 16); s += __shfl_xor(s, 32); if (fq == 0) unsafeAtomicAdd(ssq + row, s); }
    if (u.pn == 9) { float s = sumsq8(v0); s += __shfl_xor(s, 16); s += __shfl_xor(s, 32); if (fq == 0) unsafeAtomicAdd(sskv + row, s); } } };
struct EpiQ { static constexpr bool TWO_PASS = false; bf16* Q; const float* ssq; const float* rope;
  __device__ __forceinline__ void rope8(float (&v)[8], int row, int fq) const {
    float pv[8];
#pragma unroll
    for (int i = 0; i < 8; ++i) pv[i] = __shfl_xor(v[i], 32);
    const float* cs = rope + (size_t)row * 32 + 8 * (fq & 1);
#pragma unroll
    for (int i = 0; i < 8; ++i) { const float c = cs[i], s = cs[16 + i]; v[i] = (fq < 2) ? (v[i] * c - pv[i] * s) : (v[i] * c + pv[i] * s); }
  }
  __device__ __forceinline__ void row8(const pg8::Unit& u, int rloc, int cloc, const float (&a0)[8], const float (&a1)[8], int fq) const {
    const int row = u.pm * 256 + rloc; const float r = rsqrtf(ssq[row] * (1.f / 256.f) + 1e-6f);
    float v0[8], v1[8];
#pragma unroll
    for (int i = 0; i < 8; ++i) { v0[i] = a0[i] * r; v1[i] = a1[i] * r; }
    const int g0 = u.pn * 8 + (cloc >> 5), g1 = g0 + 4;
    if (g0 % 3 == 2) rope8(v0, row, fq);
    if (g1 % 3 == 2) rope8(v1, row, fq);
    bf16* p = Q + (size_t)row * 768 + u.pn * 256 + cloc; *(v4u*)p = pack8(v0); *(v4u*)(p + 128) = pack8(v1); } };
struct EpiKV { static constexpr bool TWO_PASS = false; bf16* KMp; bf16* VMp; const float* sskv;
  __device__ __forceinline__ void put(int row, int c, const float (&v)[8], float r) const {
    float w[8];
#pragma unroll
    for (int i = 0; i < 8; ++i) w[i] = v[i] * r;
    if (c < 512) *(v4u*)(KMp + (size_t)row * 768 + (c >> 6) * 96 + (c & 63)) = pack8(w); else *(v4u*)(VMp + (size_t)row * 512 + (c - 512)) = pack8(w); }
  __device__ __forceinline__ void row8(const pg8::Unit& u, int rloc, int cloc, const float (&a0)[8], const float (&a1)[8], int fq) const {
    const int row = u.pm * 256 + rloc; const float r = rsqrtf(sskv[row] * (1.f / 128.f) + 1e-6f);
    put(row, u.pn * 256 + cloc, a0, r); put(row, u.pn * 256 + 128 + cloc, a1, r); } };

__device__ __forceinline__ void unpack8(v4u w, float (&f)[8]) { f[0] = bflo(w.x); f[1] = bfhi(w.x); f[2] = bflo(w.y); f[3] = bfhi(w.y); f[4] = bflo(w.z); f[5] = bfhi(w.z); f[6] = bflo(w.w); f[7] = bfhi(w.w); }
__device__ __forceinline__ float log_sigmoid(float x) { return fminf(x, 0.f) - log1pf(__expf(-fabsf(x))); }

__device__ __forceinline__ void p2_elementwise(Frame& F, const Args& a) {
  unsigned char* ws = F.ws;
  const bf16* P = (const bf16*)(ws + WS_PROJ);
  { const float* cw = (const float*)a.in[I_CONV]; bf16* QC = (bf16*)(ws + WS_QC); bf16* KC = (bf16*)(ws + WS_KC);
    const int gi = F.vcu * NTHR + F.tid, c = (gi & 127) * 8, mstep = (F.G * NTHR) >> 7; float w0[8], w1[8], w2[8];
#pragma unroll
    for (int j = 0; j < 8; ++j) { w0[j] = cw[c + j]; w1[j] = cw[1024 + c + j]; w2[j] = cw[2048 + c + j]; }
    for (int m0 = gi >> 7; m0 < MTOK; m0 += 2 * mstep) {
      v4u r0[2], r1[2], r2[2];
#pragma unroll
      for (int u = 0; u < 2; ++u) { const int m = m0 + u * mstep, t = m & (SEQ - 1); const bf16* pr = P + (size_t)m * PROJ_LD + c;
        r1[u] = *(const v4u*)pr; r0[u] = t > 0 ? *(const v4u*)(pr - PROJ_LD) : (v4u){0u, 0u, 0u, 0u}; r2[u] = t < SEQ - 1 ? *(const v4u*)(pr + PROJ_LD) : (v4u){0u, 0u, 0u, 0u}; }
#pragma unroll
      for (int u = 0; u < 2; ++u) { const int m = m0 + u * mstep; float x0[8], x1[8], x2[8], o[8]; unpack8(r0[u], x0); unpack8(r1[u], x1); unpack8(r2[u], x2);
#pragma unroll
        for (int j = 0; j < 8; ++j) { float v = x0[j] * w0[j] + x1[j] * w1[j] + x2[j] * w2[j]; v = v * sigmoidf_(v); o[j] = (c < 512) ? v : v * 0.08838834764831845f; }
        if (c < 512) *(v4u*)(QC + (size_t)m * 512 + c) = pack8(o); else *(v4u*)(KC + (size_t)m * 512 + c - 512) = pack8(o); } } }
  { const float* rope = (const float*)(ws + WS_ROPE); bf16* KMp = (bf16*)(ws + WS_KM);
    for (int i = F.vcu * NTHR + F.tid; i < MTOK * 16; i += F.G * NTHR) { const int m = i >> 4, j = i & 15;
      const float t1 = bf2f(P[(size_t)m * PROJ_LD + PC_KR + j]), t2 = bf2f(P[(size_t)m * PROJ_LD + PC_KR + 16 + j]); const float c = rope[m * 32 + j], s = rope[m * 32 + 16 + j];
      const bf16 o1 = (bf16)f2bf(t1 * c - t2 * s), o2 = (bf16)f2bf(t2 * c + t1 * s);
#pragma unroll
      for (int h = 0; h < 8; ++h) { KMp[(size_t)m * 768 + h * 96 + 64 + j] = o1; KMp[(size_t)m * 768 + h * 96 + 80 + j] = o2; } } }
  { const float* bg = (const float*)a.in[I_BG]; float* GSC = (float*)(ws + WS_GSC); float* DEC = (float*)(ws + WS_DEC);
    const int gw = F.vcu * NWAVES + F.wave, NGW = F.G * NWAVES;
    for (int it = gw; it < 32 * 64; it += NGW) { const int seq = it >> 6, c = it & 63, dir = seq & 1, h = (seq >> 1) & 3, b = seq >> 3;
      const int p = c * 64 + F.lane, t = dir ? (SEQ - 1 - p) : p; const size_t row = (size_t)b * SEQ + t;
      const int gi = (dir ? 8 : 0) + h, gf = (dir ? 12 : 4) + h;
      const float li = bf2f(P[row * PROJ_LD + PC_G + gi]) + bg[gi]; const float lf = log_sigmoid(bf2f(P[row * PROJ_LD + PC_G + gf]) + bg[gf]);
      float bs = lf;
#pragma unroll
      for (int o = 1; o < 64; o <<= 1) { const float y = __shfl_up(bs, o); if (F.lane >= o) bs += y; }
      const float av = li - bs; float pm = av;
#pragma unroll
      for (int o = 1; o < 64; o <<= 1) { const float y = __shfl_up(pm, o); if (F.lane >= o) pm = fmaxf(pm, y); }
      float* gs = GSC + (size_t)seq * 3 * SEQ; gs[p] = bs; gs[SEQ + p] = av; gs[2 * SEQ + p] = pm;
      if (F.lane == 63) { DEC[seq * 128 + c] = bs; DEC[seq * 128 + 64 + c] = pm; } } }
}
namespace mla {
constexpr int DQK = 96, DV = 64, NW = 8, QBLK = 32, KVBLK = 64, LDQ = 768, LDK = 768, LDV = 512, LDO = 1024;
constexpr float SCALE = 0.10206207261596575f;
constexpr float THR = 8.f;
constexpr int SHM_V = 16384, SHM_K = 16384, SHM_ATTN = 2 * SHM_V + 2 * SHM_K + NW * 64 * 4;
#define KSWZ(row, colB) ((row) * 256 + ((colB) ^ (((row) & 7) << 4)))
#define SBAR() __builtin_amdgcn_sched_barrier(0)
__device__ __forceinline__ int crow(int r, int hi) { return (r & 3) + 8 * (r >> 2) + 4 * hi; }
__device__ __forceinline__ void partialSM(f32x16& p0, f32x16& p1, float& m_reg, float& mn, float& alpha) {
  constexpr float C = SCALE * 1.4426950408889634f;
  float pmax = p0[0];
#pragma unroll
  for (int r = 1; r < 16; ++r) pmax = fmaxf(pmax, p0[r]);
#pragma unroll
  for (int r = 0; r < 16; ++r) pmax = fmaxf(pmax, p1[r]);
  { auto rr = __builtin_amdgcn_permlane32_swap(__float_as_uint(pmax), __float_as_uint(pmax), false, false);
    pmax = fmaxf(__uint_as_float(rr[0]), __uint_as_float(rr[1])); }
  if (__builtin_expect(__all(pmax - m_reg <= THR / SCALE), 1)) { mn = m_reg; alpha = 1.f; }
  else { mn = fmaxf(m_reg, pmax); alpha = __builtin_amdgcn_exp2f((m_reg - mn) * C); m_reg = mn; }
  const float mnC = -mn * C;
#pragma unroll
  for (int r = 0; r < 16; ++r) p0[r] = fmaf(p0[r], C, mnC);
#pragma unroll
  for (int r = 0; r < 16; ++r) p1[r] = fmaf(p1[r], C, mnC);
#pragma unroll
  for (int r = 0; r < 16; ++r) p0[r] = __builtin_amdgcn_exp2f(p0[r]);
}
__device__ __forceinline__ void finishSM(f32x16& p0, f32x16& p1, float alpha, float& l_reg, bf16x8& pa0, bf16x8& pa1, bf16x8& pa2, bf16x8& pa3) {
#pragma unroll
  for (int r = 0; r < 16; ++r) p1[r] = __builtin_amdgcn_exp2f(p1[r]);
  float ps = 0;
#pragma unroll
  for (int r = 0; r < 16; ++r) ps += p0[r];
#pragma unroll
  for (int r = 0; r < 16; ++r) ps += p1[r];
  { auto rr = __builtin_amdgcn_permlane32_swap(__float_as_uint(ps), __float_as_uint(ps), false, false);
    ps = __uint_as_float(rr[0]) + __uint_as_float(rr[1]); }
  l_reg = l_reg * alpha + ps;
#define PK4(P, BASE, OUT) do { unsigned a0 = cvt_pk_bf16(P[BASE + 0], P[BASE + 1]), a1 = cvt_pk_bf16(P[BASE + 2], P[BASE + 3]);   \
    unsigned b0 = cvt_pk_bf16(P[BASE + 4], P[BASE + 5]), b1 = cvt_pk_bf16(P[BASE + 6], P[BASE + 7]);                              \
    auto r0 = __builtin_amdgcn_permlane32_swap(a0, b0, false, false); auto r1 = __builtin_amdgcn_permlane32_swap(a1, b1, false, false); \
    v4u w = {r0[0], r1[0], r0[1], r1[1]}; OUT = __builtin_bit_cast(bf16x8, w); } while (0)
  PK4(p0, 0, pa0); PK4(p0, 8, pa1); PK4(p1, 0, pa2); PK4(p1, 8, pa3);
#undef PK4
}
__device__ __forceinline__ void qkt(f32x16& p0, f32x16& p1, const char* Ks, const bf16x8* qr, int r32, int hi) {
  p0 = f32x16{}; p1 = f32x16{};
#pragma unroll
  for (int d0 = 0; d0 < DQK / 16; ++d0) { const int cb = (d0 * 16 + hi * 8) * 2;
    const bf16x8 b0 = *reinterpret_cast<const bf16x8*>(Ks + KSWZ(r32, cb));
    const bf16x8 b1 = *reinterpret_cast<const bf16x8*>(Ks + KSWZ(32 + r32, cb));
    p0 = __builtin_amdgcn_mfma_f32_32x32x16_bf16(b0, qr[d0], p0, 0, 0, 0);
    p1 = __builtin_amdgcn_mfma_f32_32x32x16_bf16(b1, qr[d0], p1, 0, 0, 0); }
}
__device__ __forceinline__ int v_st(int k, int c) { const int kk = (k & ~0xC) | ((k & 4) << 1) | ((k & 8) >> 1); return ((kk >> 3) * 4 + (c >> 5)) * 512 + ((kk & 7) * 32 + (c & 31)) * 2; }
__device__ __forceinline__ int v_rd_base(int lane) { return ((lane & 3) << 3) | (((lane >> 2) & 3) << 6) | (((lane >> 4) & 1) << 5) | (((lane >> 5) & 1) << 8); }
constexpr int v_rd_off(int d0, int ks, int half) { return d0 * 512 + ks * 4096 + half * 2048; }
template <int OFF> __device__ __forceinline__ s16x4 tr_read(int vb) {
  s16x4 r; asm volatile("ds_read_b64_tr_b16 %0, %1 offset:%2" : "=&v"(r) : "v"(vb), "i"(OFF) : "memory"); return r;
}
template <int D0> __device__ __forceinline__ void pv_one(f32x16& od, int vb, bf16x8 pa0, bf16x8 pa1, bf16x8 pa2, bf16x8 pa3) {
  const s16x4 l0 = tr_read<v_rd_off(D0, 0, 0)>(vb), h0 = tr_read<v_rd_off(D0, 0, 1)>(vb), l1 = tr_read<v_rd_off(D0, 1, 0)>(vb), h1 = tr_read<v_rd_off(D0, 1, 1)>(vb);
  const s16x4 l2 = tr_read<v_rd_off(D0, 2, 0)>(vb), h2 = tr_read<v_rd_off(D0, 2, 1)>(vb), l3 = tr_read<v_rd_off(D0, 3, 0)>(vb), h3 = tr_read<v_rd_off(D0, 3, 1)>(vb);
  asm volatile("s_waitcnt lgkmcnt(0)" ::: "memory"); SBAR();
#define PK(L, H) (bf16x8){L[0], L[1], L[2], L[3], H[0], H[1], H[2], H[3]}
  od = __builtin_amdgcn_mfma_f32_32x32x16_bf16(pa0, PK(l0, h0), od, 0, 0, 0);
  od = __builtin_amdgcn_mfma_f32_32x32x16_bf16(pa1, PK(l1, h1), od, 0, 0, 0);
  od = __builtin_amdgcn_mfma_f32_32x32x16_bf16(pa2, PK(l2, h2), od, 0, 0, 0);
  od = __builtin_amdgcn_mfma_f32_32x32x16_bf16(pa3, PK(l3, h3), od, 0, 0, 0);
#undef PK
}
__device__ __forceinline__ void pv_d0(f32x16* o, int vb, bf16x8 pa0, bf16x8 pa1, bf16x8 pa2, bf16x8 pa3) {
  pv_one<0>(o[0], vb, pa0, pa1, pa2, pa3); pv_one<1>(o[1], vb, pa0, pa1, pa2, pa3);
}
constexpr int LDP = 8 * 64, LDML = 8 * 2;
__device__ __forceinline__ void attn_unit(const bf16* __restrict__ Qb, const bf16* __restrict__ Kh, const bf16* __restrict__ Vh, bf16* __restrict__ Op, float* __restrict__ MLp, int seq, char* lds) {
  int tid = threadIdx.x; asm volatile("" : "+v"(tid));
  const int wid = tid >> 6, lane = tid & 63, r32 = lane & 31, hi = lane >> 5;
  char* V_lds = lds; char* K_lds = lds + 2 * SHM_V;
  float* wsf = (float*)(lds + 2 * SHM_V + 2 * SHM_K) + wid * 64; float* li_l = wsf; float* al_l = wsf + 32;
  float m_reg = -1e30f, l_reg = 0; f32x16 o[2] = {}; bf16x8 qr[DQK / 16];
  const bf16* Qw = Qb + (long)(wid * QBLK + r32) * LDQ + hi * 8;
#pragma unroll
  for (int d0 = 0; d0 < DQK / 16; ++d0) qr[d0] = *reinterpret_cast<const bf16x8*>(Qw + d0 * 16);
  const int sr = tid >> 4, sc = (tid & 15) * 8, vst0 = v_st(sr, sc & 63), vst1 = v_st(32 + sr, sc & 63);
  const bool doK = sc < DQK, doV = sc < DV;
  const int vb0 = (int)(uintptr_t)V_lds + v_rd_base(lane);
  struct { bf16x8 vs0, vs1, ks0, ks1; } sr_[2];
#define SLOAD(i, k0) do { if (doV) { sr_[i].vs0 = *reinterpret_cast<const bf16x8*>(&Vh[(long)((k0) + sr) * LDV + sc]); sr_[i].vs1 = *reinterpret_cast<const bf16x8*>(&Vh[(long)((k0) + 32 + sr) * LDV + sc]); } \
    if (doK) { sr_[i].ks0 = *reinterpret_cast<const bf16x8*>(&Kh[(long)((k0) + sr) * LDK + sc]); sr_[i].ks1 = *reinterpret_cast<const bf16x8*>(&Kh[(long)((k0) + 32 + sr) * LDK + sc]); } } while (0)
#define SWRITE(b, i) do { if (doV) { *(bf16x8*)(V_lds + (b) * SHM_V + vst0) = sr_[i].vs0; *(bf16x8*)(V_lds + (b) * SHM_V + vst1) = sr_[i].vs1; } \
    if (doK) { const int kc = sc * 2; *(bf16x8*)(K_lds + (b) * SHM_K + KSWZ(sr, kc)) = sr_[i].ks0; *(bf16x8*)(K_lds + (b) * SHM_K + KSWZ(32 + sr, kc)) = sr_[i].ks1; } } while (0)
#define SWAIT() asm volatile("s_waitcnt vmcnt(4)" ::: "memory")
#define RESC(a) do { if (__any((a) < 1.f)) { if (hi == 0) al_l[r32] = (a); asm volatile("s_waitcnt lgkmcnt(0)" ::: "memory"); \
    _Pragma("unroll") for (int d = 0; d < 2; ++d) _Pragma("unroll") for (int r = 0; r < 16; ++r) o[d][r] *= al_l[crow(r, hi)]; } } while (0)
  f32x16 pA0, pA1, pB0, pB1; float mnA, mnB, alA, alB; bf16x8 pa0, pa1, pa2, pa3; const int NT = seq / KVBLK;
  constexpr int SE = 0, SO = 1;
  SLOAD(SE, 0); asm volatile("s_waitcnt vmcnt(0)" ::: "memory"); SWRITE(0, SE); __syncthreads();
  qkt(pA0, pA1, K_lds, qr, r32, hi); partialSM(pA0, pA1, m_reg, mnA, alA);
  SLOAD(SO, KVBLK); if (2 < NT) SLOAD(SE, 2 * KVBLK);
  SWAIT(); SWRITE(1, SO); __syncthreads();
  for (int j = 1; j + 1 < NT; j += 2) {
    SBAR(); qkt(pB0, pB1, K_lds + SHM_K, qr, r32, hi);
    finishSM(pA0, pA1, alA, l_reg, pa0, pa1, pa2, pa3); SBAR();
    SLOAD(SO, (j + 2) * KVBLK); SBAR();
    pv_d0(o, vb0, pa0, pa1, pa2, pa3); partialSM(pB0, pB1, m_reg, mnB, alB);
    __syncthreads(); SWAIT(); SWRITE(0, SE);
    RESC(alB); __syncthreads();
    SBAR(); qkt(pA0, pA1, K_lds, qr, r32, hi);
    finishSM(pB0, pB1, alB, l_reg, pa0, pa1, pa2, pa3); SBAR();
    if (j + 3 < NT) SLOAD(SE, (j + 3) * KVBLK); SBAR();
    pv_d0(o, vb0 + SHM_V, pa0, pa1, pa2, pa3); partialSM(pA0, pA1, m_reg, mnA, alA);
    __syncthreads(); SWAIT(); SWRITE(1, SO);
    RESC(alA); __syncthreads();
  }
  SBAR(); qkt(pB0, pB1, K_lds + SHM_K, qr, r32, hi);
  finishSM(pA0, pA1, alA, l_reg, pa0, pa1, pa2, pa3); SBAR();
  pv_d0(o, vb0, pa0, pa1, pa2, pa3); partialSM(pB0, pB1, m_reg, mnB, alB);
  __syncthreads(); RESC(alB);
  finishSM(pB0, pB1, alB, l_reg, pa0, pa1, pa2, pa3); SBAR();
  pv_d0(o, vb0 + SHM_V, pa0, pa1, pa2, pa3);
  __syncthreads();
  { float* st = (float*)lds + wid * (32 * 68);
#pragma unroll
    for (int r = 0; r < 16; ++r) { const int orow = crow(r, hi); st[orow * 68 + r32] = o[0][r]; st[orow * 68 + 32 + r32] = o[1][r]; }
    asm volatile("s_waitcnt lgkmcnt(0)" ::: "memory");
    bf16* op = Op + (long)(wid * QBLK + r32) * LDP + hi * 32;
#pragma unroll
    for (int j = 0; j < 4; ++j) { const f32x4 x0 = *(const f32x4*)(st + r32 * 68 + hi * 32 + 8 * j), x1 = *(const f32x4*)(st + r32 * 68 + hi * 32 + 8 * j + 4);
      const float w[8] = {x0.x, x0.y, x0.z, x0.w, x1.x, x1.y, x1.z, x1.w}; *(v4u*)(op + 8 * j) = pack8(w); }
    if (hi == 0) { float* mp = MLp + (long)(wid * QBLK + r32) * LDML; mp[0] = m_reg; mp[1] = l_reg; } }
  __syncthreads();
#undef SLOAD
#undef SWRITE
#undef SWAIT
#undef RESC
}
#undef KSWZ
#undef SBAR
}

__device__ __forceinline__ int queue_pull(Frame& F, gu32* heads, int nq, int nper, int myq) {
  volatile LAS int* slot = (volatile LAS int*)(F.lds + LDSCTL_OFF);
  if (F.tid == 0) { int got = -1;
    for (int k = 0; k < nq; ++k) { const int q = (myq + k) % nq;
      if (__hip_atomic_load(heads + 64 * q, RLX_AGENT) >= (unsigned)nper) continue;
      const unsigned i = __hip_atomic_fetch_add(heads + 64 * q, 1u, RLX_AGENT);
      if (i < (unsigned)nper) { got = q * nper + (int)i; break; } }
    *slot = got; }
  __syncthreads();
  const int r = __builtin_amdgcn_readfirstlane(*slot);
  __syncthreads();
  return r;
}
__device__ __forceinline__ void p3_attention(Frame& F, const Args& a, char* lds_generic, unsigned xcc, int qoff) {
  unsigned char* ws = F.ws;
  const bf16* QMp = (const bf16*)(ws + WS_QM); const bf16* KMp = (const bf16*)(ws + WS_KM); const bf16* VMp = (const bf16*)(ws + WS_VM); bf16* PO = (bf16*)(ws + WS_PO); float* PML = (float*)(ws + WS_PML);
#ifndef WAIT_MODE
#define WAIT_MODE 1
#endif
  bool waited = false; (void)waited;
  for (;;) {
    const int u = queue_pull(F, F.ctl + CW_Q + qoff, 8, 128, (int)(xcc & 7u));
    if (u < 0) break;
    const int bh = u >> 5, qb = (u >> 1) & 15, kh = u & 1, b = bh >> 3, h = bh & 7;
#if WAIT_MODE == 0
    if (F.tid == 0) { unsigned sp = 0;
      while (__hip_atomic_load(F.ctl + CW_RDY + 64 * b, RLX_AGENT) < 112u) { __builtin_amdgcn_s_sleep(2); if (++sp > (1u << 24)) break; }
      __builtin_amdgcn_fence(__ATOMIC_ACQUIRE, "agent"); }
    asm volatile("s_waitcnt vmcnt(0)" ::: "memory"); __syncthreads();
#else
    if (!waited) { waited = true;
      if (F.tid == 0) { unsigned sp = 0;
        for (int bb = 0; bb < 4; ++bb) while (__hip_atomic_load(F.ctl + CW_RDY + 64 * bb, RLX_AGENT) < 112u) { __builtin_amdgcn_s_sleep(2); if (++sp > (1u << 24)) break; }
        __builtin_amdgcn_fence(__ATOMIC_ACQUIRE, "agent"); }
      asm volatile("s_waitcnt vmcnt(0)" ::: "memory"); __syncthreads(); }
#endif
    const size_t row0 = (size_t)b * SEQ + qb * 256, key0 = (size_t)b * SEQ + kh * (SEQ / 2);
    mla::attn_unit(QMp + row0 * 768 + h * 96, KMp + key0 * 768 + h * 96, VMp + key0 * 512 + h * 64,
                   PO + ((size_t)kh * MTOK + row0) * 512 + h * 64, PML + ((size_t)kh * MTOK + row0) * 16 + h * 2, SEQ / 2, lds_generic);
  }
}
namespace mls {
using mla::crow; using mla::v_st; using mla::v_rd_base;
#define KSWZ(row, colB) ((row) * 256 + ((colB) ^ (((row) & 7) << 4)))
constexpr int OFF_QS = 0, OFF_KS = 16384, OFF_KP = 32768, OFF_VV = 49152, OFF_CT = 65536, OFF_SC = 98304, OFF_NB = 99328, OFF_NP = 100352, OFF_CH = 104448, OFF_WS = 105472;
template <int OFF> __device__ __forceinline__ s16x4 trr(int vb) { s16x4 r; asm volatile("ds_read_b64_tr_b16 %0, %1 offset:%2" : "=&v"(r) : "v"(vb), "i"(OFF) : "memory"); return r; }
#define PKF(L, H) (bf16x8){L[0], L[1], L[2], L[3], H[0], H[1], H[2], H[3]}
__device__ __forceinline__ void vfrags(int img, int d0, int lane, bf16x8 (&f)[4]) {
  const int vb = img + v_rd_base(lane) + d0 * 512;
  const s16x4 l0 = trr<0>(vb), h0 = trr<2048>(vb), l1 = trr<4096>(vb), h1 = trr<4096 + 2048>(vb), l2 = trr<8192>(vb), h2 = trr<8192 + 2048>(vb), l3 = trr<12288>(vb), h3 = trr<12288 + 2048>(vb);
  asm volatile("s_waitcnt lgkmcnt(0)" ::: "memory"); __builtin_amdgcn_sched_barrier(0);
  f[0] = PKF(l0, h0); f[1] = PKF(l1, h1); f[2] = PKF(l2, h2); f[3] = PKF(l3, h3);
}
__device__ __forceinline__ void pack_p(const f32x16& p0, const f32x16& p1, bf16x8& pa0, bf16x8& pa1, bf16x8& pa2, bf16x8& pa3) {
#define PK4(P, BASE, OUT) do { unsigned a0 = cvt_pk_bf16(P[BASE + 0], P[BASE + 1]), a1 = cvt_pk_bf16(P[BASE + 2], P[BASE + 3]);   \
    unsigned b0 = cvt_pk_bf16(P[BASE + 4], P[BASE + 5]), b1 = cvt_pk_bf16(P[BASE + 6], P[BASE + 7]);                              \
    auto r0 = __builtin_amdgcn_permlane32_swap(a0, b0, false, false); auto r1 = __builtin_amdgcn_permlane32_swap(a1, b1, false, false); \
    v4u w = {r0[0], r1[0], r0[1], r1[1]}; OUT = __builtin_bit_cast(bf16x8, w); } while (0)
  PK4(p0, 0, pa0); PK4(p0, 8, pa1); PK4(p1, 0, pa2); PK4(p1, 8, pa3);
#undef PK4
}
__device__ __forceinline__ float swap_add(float v) { auto rr = __builtin_amdgcn_permlane32_swap(__float_as_uint(v), __float_as_uint(v), false, false); return __uint_as_float(rr[0]) + __uint_as_float(rr[1]); }

__device__ __forceinline__ void mlstm_seq(int seq, unsigned char* ws, char* lds) {
  int tid = threadIdx.x; asm volatile("" : "+v"(tid));
  const int wid = __builtin_amdgcn_readfirstlane(tid >> 6), lane = tid & 63, r32 = lane & 31, hi = lane >> 5, rb = wid >> 2, cb = wid & 3;
  const int dir = seq & 1, h = (seq >> 1) & 3, b = seq >> 3;
  const bf16* QC = (const bf16*)(ws + WS_QC); const bf16* KC = (const bf16*)(ws + WS_KC); const bf16* P = (const bf16*)(ws + WS_PROJ);
  const float* gs = (const float*)(ws + WS_GSC) + (size_t)seq * 3 * SEQ; const float* dec = (const float*)(ws + WS_DEC) + seq * 128;
  bf16* H = (bf16*)(ws + (dir ? WS_HB : WS_HF));
  float* sc_alpha = (float*)(lds + OFF_SC); float* sc_a = sc_alpha + 64; float* sc_iw = sc_alpha + 128; float* sc_en = sc_alpha + 192;
  float* nbuf = (float*)(lds + OFF_NB); float* npart = (float*)(lds + OFF_NP);
  float* ch_mprev = (float*)(lds + OFF_CH); float* ch_mnew = ch_mprev + 64; float* ch_dec = ch_mprev + 128; float* ch_g = ch_mprev + 192;
  float* wsf = (float*)(lds + OFF_WS) + wid * 32;
  const int ldsb = (int)(uintptr_t)lds;
  if (tid < 64) {
    if (tid == 0) { float m = 0.f; for (int c = 0; c < 64; ++c) { const float g = dec[c], wm = dec[64 + c]; const float mn = fmaxf(g + m, g + wm); ch_mprev[c] = m; ch_mnew[c] = mn; ch_dec[c] = __expf(g + m - mn); ch_g[c] = g; m = mn; } } }
  for (int i = tid; i < 32768 / 16; i += NTHR) ((v4u*)(lds + OFF_CT))[i] = (v4u){0u, 0u, 0u, 0u};
  if (tid < 128) nbuf[tid] = 0.f;
  f32x16 cacc[3]; cacc[0] = f32x16{}; cacc[1] = f32x16{}; cacc[2] = f32x16{};
  const int nown = rb ? 1 : 3;
  __syncthreads();
  const int sr = tid >> 4, sc = (tid & 15) * 8;
  v4u gq0, gq1, gk0, gk1, gv0, gv1; float ga0, ga1, sb = 0.f, sa = 0.f, spm = 0.f;
#define ROWOF(p) ((size_t)b * SEQ + (dir ? (SEQ - 1 - (p)) : (p)))
#define LOADC(c) do { const int p0_ = 64 * (c) + sr, p1_ = p0_ + 32; const size_t r0_ = ROWOF(p0_), r1_ = ROWOF(p1_); \
    gq0 = *(const v4u*)(QC + r0_ * 512 + h * 128 + sc); gq1 = *(const v4u*)(QC + r1_ * 512 + h * 128 + sc); \
    gk0 = *(const v4u*)(KC + r0_ * 512 + h * 128 + sc); gk1 = *(const v4u*)(KC + r1_ * 512 + h * 128 + sc); \
    gv0 = *(const v4u*)(P + r0_ * PROJ_LD + 1024 + h * 128 + sc); gv1 = *(const v4u*)(P + r1_ * PROJ_LD + 1024 + h * 128 + sc); \
    ga0 = gs[SEQ + p0_]; ga1 = gs[SEQ + p1_]; \
    if (tid < 64) { sb = gs[64 * (c) + tid]; sa = gs[SEQ + 64 * (c) + tid]; spm = gs[2 * SEQ + 64 * (c) + tid]; } } while (0)
#define WRITEC(c) do { \
    *(v4u*)(lds + OFF_QS + KSWZ(sr, sc * 2)) = gq0; *(v4u*)(lds + OFF_QS + KSWZ(32 + sr, sc * 2)) = gq1; \
    *(v4u*)(lds + OFF_KS + KSWZ(sr, sc * 2)) = gk0; *(v4u*)(lds + OFF_KS + KSWZ(32 + sr, sc * 2)) = gk1; \
    *(v4u*)(lds + OFF_VV + v_st(sr, sc)) = gv0; *(v4u*)(lds + OFF_VV + v_st(32 + sr, sc)) = gv1; \
    { const float gc_ = ch_g[c], mn_ = ch_mnew[c]; const float w0_ = __expf(gc_ + ga0 - mn_), w1_ = __expf(gc_ + ga1 - mn_); float f0_[8], f1_[8], cs_[8]; unpack8(gk0, f0_); unpack8(gk1, f1_); \
      _Pragma("unroll") for (int j = 0; j < 8; ++j) { f0_[j] *= w0_; f1_[j] *= w1_; cs_[j] = f0_[j] + f1_[j]; } \
      *(v4u*)(lds + OFF_KP + v_st(sr, sc)) = pack8(f0_); *(v4u*)(lds + OFF_KP + v_st(32 + sr, sc)) = pack8(f1_); \
      _Pragma("unroll") for (int j = 0; j < 8; ++j) { cs_[j] += __shfl_xor(cs_[j], 16); cs_[j] += __shfl_xor(cs_[j], 32); } \
      if ((lane >> 4) == 0) { _Pragma("unroll") for (int j = 0; j < 8; ++j) npart[wid * 128 + sc + j] = cs_[j]; } } \
    if (tid < 64) { const float m_ = ch_mprev[c]; const float mt_ = fmaxf(sb + m_, sb + spm); sc_alpha[tid] = sb - mt_; sc_a[tid] = sa; sc_iw[tid] = __expf(sb + m_ - mt_); sc_en[tid] = __expf(-mt_); } } while (0)
  LOADC(0); WRITEC(0);
  __syncthreads();
  for (int c = 0; c < 64; ++c) {
    if (c + 1 < 64) LOADC(c + 1);
    const float* nb = nbuf + (c & 1) * 128;
    if (tid < 128) { float s = 0.f;
#pragma unroll
      for (int w = 0; w < 8; ++w) s += npart[w * 128 + tid];
      nbuf[((c + 1) & 1) * 128 + tid] = ch_dec[c] * nb[tid] + s; }
    bf16x8 qr[8];
#pragma unroll
    for (int d0 = 0; d0 < 8; ++d0) qr[d0] = *(const bf16x8*)(lds + OFF_QS + KSWZ(32 * rb + r32, (16 * d0 + 8 * hi) * 2));
    f32x16 p0 = f32x16{}, p1 = f32x16{};
#pragma unroll
    for (int d0 = 0; d0 < 8; ++d0) { const bf16x8 k0 = *(const bf16x8*)(lds + OFF_KS + KSWZ(r32, (16 * d0 + 8 * hi) * 2)); p0 = __builtin_amdgcn_mfma_f32_32x32x16_bf16(k0, qr[d0], p0, 0, 0, 0); }
    if (rb == 1) {
#pragma unroll
      for (int d0 = 0; d0 < 8; ++d0) { const bf16x8 k1 = *(const bf16x8*)(lds + OFF_KS + KSWZ(32 + r32, (16 * d0 + 8 * hi) * 2)); p1 = __builtin_amdgcn_mfma_f32_32x32x16_bf16(k1, qr[d0], p1, 0, 0, 0); }
    }
    const float al = sc_alpha[32 * rb + r32];
    if (rb == 0) {
#pragma unroll
      for (int r = 0; r < 16; ++r) { const int sl = crow(r, hi); p0[r] = (sl <= r32) ? __expf(al + sc_a[sl]) * p0[r] : 0.f; }
    } else {
#pragma unroll
      for (int r = 0; r < 16; ++r) { const int sl = crow(r, hi); p0[r] = __expf(al + sc_a[sl]) * p0[r]; p1[r] = (sl <= r32) ? __expf(al + sc_a[32 + sl]) * p1[r] : 0.f; }
    }
    float ps = 0.f;
#pragma unroll
    for (int r = 0; r < 16; ++r) ps += p0[r] + p1[r];
    ps = swap_add(ps);
    bf16x8 pa0, pa1, pa2, pa3; pack_p(p0, p1, pa0, pa1, pa2, pa3);
    float qn = 0.f;
#pragma unroll
    for (int d0 = 0; d0 < 8; ++d0) { const f32x4 n0 = *(const f32x4*)(nb + 16 * d0 + 8 * hi), n1 = *(const f32x4*)(nb + 16 * d0 + 8 * hi + 4); const v4u qw = __builtin_bit_cast(v4u, qr[d0]);
      qn += bflo(qw.x) * n0.x + bfhi(qw.x) * n0.y + bflo(qw.y) * n0.z + bfhi(qw.y) * n0.w + bflo(qw.z) * n1.x + bfhi(qw.z) * n1.y + bflo(qw.w) * n1.z + bfhi(qw.w) * n1.w; }
    qn = swap_add(qn);
    { const float iwt = sc_iw[32 * rb + r32]; const float den = iwt * qn + ps; const float rd = 1.f / fmaxf(fabsf(den), sc_en[32 * rb + r32]); if (hi == 0) wsf[r32] = rd; }
    f32x16 o = f32x16{};
#pragma unroll
    for (int d0 = 0; d0 < 8; ++d0) { const bf16x8 cf = *(const bf16x8*)(lds + OFF_CT + KSWZ(32 * cb + r32, (16 * d0 + 8 * hi) * 2)); o = __builtin_amdgcn_mfma_f32_32x32x16_bf16(qr[d0], cf, o, 0, 0, 0); }
#pragma unroll
    for (int r = 0; r < 16; ++r) o[r] *= sc_iw[32 * rb + crow(r, hi)];
    bf16x8 vf[4]; vfrags(ldsb + OFF_VV, cb, lane, vf);
    o = __builtin_amdgcn_mfma_f32_32x32x16_bf16(pa0, vf[0], o, 0, 0, 0); o = __builtin_amdgcn_mfma_f32_32x32x16_bf16(pa1, vf[1], o, 0, 0, 0);
    if (rb == 1) { o = __builtin_amdgcn_mfma_f32_32x32x16_bf16(pa2, vf[2], o, 0, 0, 0); o = __builtin_amdgcn_mfma_f32_32x32x16_bf16(pa3, vf[3], o, 0, 0, 0); }
    asm volatile("s_waitcnt lgkmcnt(0)" ::: "memory");
#pragma unroll
    for (int r = 0; r < 16; ++r) { const int tl = crow(r, hi); const int p = 64 * c + 32 * rb + tl; H[ROWOF(p) * 512 + h * 128 + 32 * cb + r32] = (bf16)f2bf(o[r] * wsf[tl]); }
    { const float dc = ch_dec[c];
#pragma unroll
      for (int i = 0; i < 3; ++i) if (i < nown) { const int db = rb ? 3 : i; bf16x8 kf[4]; vfrags(ldsb + OFF_KP, db, lane, kf);
#pragma unroll
        for (int r = 0; r < 16; ++r) cacc[i][r] *= dc;
#pragma unroll
        for (int ks = 0; ks < 4; ++ks) cacc[i] = __builtin_amdgcn_mfma_f32_32x32x16_bf16(kf[ks], vf[ks], cacc[i], 0, 0, 0); } }
    __syncthreads();
#pragma unroll
    for (int i = 0; i < 3; ++i) if (i < nown) {
#pragma unroll
      for (int g = 0; g < 4; ++g) { const int d = 32 * (rb ? 3 : i) + 8 * g + 4 * hi, e = 32 * cb + r32;
        v2u w; w.x = cvt_pk_bf16(cacc[i][4 * g], cacc[i][4 * g + 1]); w.y = cvt_pk_bf16(cacc[i][4 * g + 2], cacc[i][4 * g + 3]);
        *(v2u*)(lds + OFF_CT + KSWZ(e, d * 2)) = w; } }
    if (c + 1 < 64) WRITEC(c + 1);
    __syncthreads();
  }
#undef ROWOF
#undef LOADC
#undef WRITEC
}
#undef KSWZ
#undef PKF
}

struct ListOrder { int n, L0, L1, nN, lda, ldb;
  __device__ bool next(int i, pg8::Unit& u) const { if (i >= n) return false; const int L = i ? L1 : L0; u.pm = L / nN; u.pn = L % nN; u.g = 0; u.ibase = 0;
    u.aoff = (long)u.pm * 256 * lda; u.boff = (long)u.pn * 256 * ldb; return true; } };
__device__ __forceinline__ void publish_units(Frame& F, const ListOrder& S) {
  if (F.tid == 0) { __builtin_amdgcn_fence(__ATOMIC_RELEASE, "agent"); asm volatile("s_waitcnt vmcnt(0)" ::: "memory");
    for (int i = 0; i < S.n; ++i) { const int L = i ? S.L1 : S.L0; __hip_atomic_fetch_add(F.ctl + CW_RDY + 64 * ((L / S.nN) >> 4), 1u, RLX_AGENT); } }
}
#ifndef P3_FILL_CHUNKS
#define P3_FILL_CHUNKS 3
#endif
__device__ __forceinline__ void p3_mixers(Frame& F, const Args& a, char* lds_generic, unsigned xcc, float* ssq, float* sskv, int qoff) {
  unsigned char* ws = F.ws; const int bx = (int)blockIdx.x;
#ifndef MLSTM_REPS
#define MLSTM_REPS 1
#endif
  if (bx < 32) { for (int rp = 0; rp < MLSTM_REPS; ++rp) { mls::mlstm_seq(bx, F.ws, lds_generic); __syncthreads(); } }
  else { const int c = bx - 32;
    { ListOrder S{c < 192 ? 1 : 0, c, 0, 3, PROJ_LD, 256};
      pg8::Gemm g{(const bf16*)(ws + WS_PROJ) + PC_CQ, (const bf16*)(ws + WS_WQB), PROJ_LD, 256, 256, nullptr, 127, 127};
      EpiQ E{(bf16*)(ws + WS_QM), ssq, (const float*)(ws + WS_ROPE)};
      pg8::gemm_phase<EpiQ, ListOrder, false>(F.lds, g, S, E); publish_units(F, S); }
    { ListOrder S{c >= 192 ? 2 : 1, c >= 192 ? c - 192 : c + 32, c + 32, 4, PROJ_LD, 256};
      pg8::Gemm g{(const bf16*)(ws + WS_PROJ) + PC_CKV, (const bf16*)(ws + WS_WKVB), PROJ_LD, 256, 256, nullptr, 127, 127};
      EpiKV E{(bf16*)(ws + WS_KM), (bf16*)(ws + WS_VM), sskv};
      pg8::gemm_phase<EpiKV, ListOrder, false>(F.lds, g, S, E); publish_units(F, S); }
  }
  p3_attention(F, a, lds_generic, xcc, qoff);
  if (bx >= 32 && !qoff) conv_fill(F, a, P3_FILL_CHUNKS);
}
__device__ __forceinline__ void p4_combine(Frame& F, const Args& a) {
  unsigned char* ws = F.ws; const bf16* HF = (const bf16*)(ws + WS_HF); const bf16* HB = (const bf16*)(ws + WS_HB); const bf16* P = (const bf16*)(ws + WS_PROJ); bf16* Y = (bf16*)(ws + WS_Y);
  const float* g = (const float*)a.in[I_GHM];
  const int gw = F.vcu * NWAVES + F.wave, NGW = F.G * NWAVES, c = F.lane * 8;
  float gg[8];
#pragma unroll
  for (int j = 0; j < 8; ++j) gg[j] = g[c + j];
  for (int m0 = gw; m0 < MTOK; m0 += 2 * NGW) {
    v4u wf[2], wb[2], wo[2];
#pragma unroll
    for (int u = 0; u < 2; ++u) { const size_t m = (size_t)(m0 + u * NGW); wf[u] = *(const v4u*)(HF + m * 512 + c); wb[u] = *(const v4u*)(HB + m * 512 + c); wo[u] = *(const v4u*)(P + m * PROJ_LD + 1536 + c); }
#pragma unroll
    for (int u = 0; u < 2; ++u) { const size_t m = (size_t)(m0 + u * NGW);
      float f[8], bb[8], oo[8]; unpack8(wf[u], f); unpack8(wb[u], bb); unpack8(wo[u], oo);
      float s = 0.f;
#pragma unroll
      for (int j = 0; j < 8; ++j) { f[j] += bb[j]; s += f[j] * f[j]; }
      s += __shfl_xor(s, 1); s += __shfl_xor(s, 2); s += __shfl_xor(s, 4); s += __shfl_xor(s, 8);
      const float r = rsqrtf(s * (1.f / 128.f) + 1e-6f);
#pragma unroll
      for (int j = 0; j < 8; ++j) f[j] = f[j] * r * gg[j] * sigmoidf_(oo[j]);
      *(v4u*)(Y + m * 1024 + c) = pack8(f); }
  }
  { const bf16* PO = (const bf16*)(ws + WS_PO); const float* PML = (const float*)(ws + WS_PML); const float* ga = (const float*)a.in[I_GHA];
    constexpr float C = 0.10206207261596575f * 1.4426950408889634f; const int hh = F.lane >> 3;
    float g8[8];
#pragma unroll
    for (int j = 0; j < 8; ++j) g8[j] = ga[c + j];
    for (int m = gw; m < MTOK; m += NGW) {
      float pa[8], pb[8]; unpack8(*(const v4u*)(PO + (size_t)m * 512 + c), pa); unpack8(*(const v4u*)(PO + ((size_t)MTOK + m) * 512 + c), pb);
      const float m0 = PML[(size_t)m * 16 + hh * 2], l0 = PML[(size_t)m * 16 + hh * 2 + 1], m1 = PML[((size_t)MTOK + m) * 16 + hh * 2], l1 = PML[((size_t)MTOK + m) * 16 + hh * 2 + 1];
      const float M = fmaxf(m0, m1), e0 = __builtin_amdgcn_exp2f((m0 - M) * C), e1 = __builtin_amdgcn_exp2f((m1 - M) * C); const float rl = 1.f / (l0 * e0 + l1 * e1);
      float f[8];
#pragma unroll
      for (int j = 0; j < 8; ++j) f[j] = pa[j] * e0 + pb[j] * e1;
      float s = 0.f;
#pragma unroll
      for (int j = 0; j < 8; ++j) { f[j] *= rl; s += f[j] * f[j]; }
      s += __shfl_xor(s, 1); s += __shfl_xor(s, 2); s += __shfl_xor(s, 4);
      const float r = rsqrtf(s * (1.f / 64.f) + 1e-6f);
#pragma unroll
      for (int j = 0; j < 8; ++j) f[j] = f[j] * r * g8[j];
      *(v4u*)(Y + (size_t)m * 1024 + 512 + c) = pack8(f); } }
}
template <int MODE> struct EpiResid { static constexpr bool TWO_PASS = false; const float* basef; const bf16* baseb; float* out; bf16* outb; float* ss;
  __device__ __forceinline__ void row8(const pg8::Unit& u, int rloc, int cloc, const float (&a0)[8], const float (&a1)[8], int fq) const {
    const int row = u.pm * 256 + rloc; const size_t off = (size_t)row * 1024 + u.pn * 256 + cloc;
    float v0[8], v1[8];
    if constexpr (MODE == 0) {
      const f32x4 b0 = *(const f32x4*)(basef + off), b1 = *(const f32x4*)(basef + off + 4), b2 = *(const f32x4*)(basef + off + 128), b3 = *(const f32x4*)(basef + off + 132);
#pragma unroll
      for (int i = 0; i < 4; ++i) { v0[i] = a0[i] + b0[i]; v0[4 + i] = a0[4 + i] + b1[i]; v1[i] = a1[i] + b2[i]; v1[4 + i] = a1[4 + i] + b3[i]; }
      *(v4u*)(outb + off) = pack8(v0); *(v4u*)(outb + off + 128) = pack8(v1);
    } else {
      float r0[8], r1[8]; unpack8(*(const v4u*)(baseb + off), r0); unpack8(*(const v4u*)(baseb + off + 128), r1);
#pragma unroll
      for (int i = 0; i < 8; ++i) { v0[i] = a0[i] + r0[i]; v1[i] = a1[i] + r1[i]; }
      *(v4u*)(outb + off) = pack8(v0); *(v4u*)(outb + off + 128) = pack8(v1);
      if (out) { *(f32x4*)(out + off) = (f32x4){v0[0], v0[1], v0[2], v0[3]}; *(f32x4*)(out + off + 4) = (f32x4){v0[4], v0[5], v0[6], v0[7]};
        *(f32x4*)(out + off + 128) = (f32x4){v1[0], v1[1], v1[2], v1[3]}; *(f32x4*)(out + off + 132) = (f32x4){v1[4], v1[5], v1[6], v1[7]}; }
    }
    float s = sumsq8(v0) + sumsq8(v1); s += __shfl_xor(s, 16); s += __shfl_xor(s, 32); if (fq == 0) unsafeAtomicAdd(ss + row, s); } };
struct EpiScale { static constexpr bool TWO_PASS = false; bf16* O; const float* ss;
  __device__ __forceinline__ void row8(const pg8::Unit& u, int rloc, int cloc, const float (&a0)[8], const float (&a1)[8], int fq) const {
    const int row = u.pm * 256 + rloc; const float r = rsqrtf(ss[row] * (1.f / 1024.f) + 1e-6f); float v0[8], v1[8];
#pragma unroll
    for (int i = 0; i < 8; ++i) { v0[i] = a0[i] * r; v1[i] = a1[i] * r; }
    bf16* p = O + (size_t)row * 1024 + u.pn * 256 + cloc; *(v4u*)p = pack8(v0); *(v4u*)(p + 128) = pack8(v1); } };
struct EpiSoftmax { static constexpr bool TWO_PASS = true; bf16* O; float scale; LAS float* xch;
  __device__ __forceinline__ void pass1(const pg8::Unit& u, int rloc, int wc, float (&v0)[8], float (&v1)[8], int fq) const {
    float mx = -3.0e38f;
#pragma unroll
    for (int i = 0; i < 8; ++i) { v0[i] *= scale; v1[i] *= scale; mx = fmaxf(mx, fmaxf(v0[i], v1[i])); }
    mx = fmaxf(mx, __shfl_xor(mx, 16)); mx = fmaxf(mx, __shfl_xor(mx, 32));
    float l = 0.f;
#pragma unroll
    for (int i = 0; i < 8; ++i) { v0[i] = __expf(v0[i] - mx); v1[i] = __expf(v1[i] - mx); l += v0[i] + v1[i]; }
    l += __shfl_xor(l, 16); l += __shfl_xor(l, 32);
    if (fq == 0) { xch[(rloc * 4 + wc) * 2] = mx; xch[(rloc * 4 + wc) * 2 + 1] = l; } }
  __device__ __forceinline__ void row8(const pg8::Unit& u, int rloc, int cloc, const float (&a0)[8], const float (&a1)[8], int fq) const {
    const int wc = cloc >> 5; float m[4], l[4]; float M = -3.0e38f;
#pragma unroll
    for (int w = 0; w < 4; ++w) { m[w] = xch[(rloc * 4 + w) * 2]; l[w] = xch[(rloc * 4 + w) * 2 + 1]; M = fmaxf(M, m[w]); }
    float L = 0.f, mine = 0.f;
#pragma unroll
    for (int w = 0; w < 4; ++w) { const float e = __expf(m[w] - M); L += l[w] * e; if (w == wc) mine = e; }
    const float f = mine / L; float v0[8], v1[8];
#pragma unroll
    for (int i = 0; i < 8; ++i) { v0[i] = a0[i] * f; v1[i] = a1[i] * f; }
    bf16* p = O + (size_t)(u.pm * 256 + rloc) * 1024 + u.pn * 256 + cloc; *(v4u*)p = pack8(v0); *(v4u*)(p + 128) = pack8(v1); } };
struct MemOrder { int G, c, kind;
  __device__ bool next(int i, pg8::Unit& u) const { const int L = i * G + c; if (L >= 256) return false;
    const int bh = L >> 4, t = L & 15, b = bh >> 2, h = bh & 3;
    u.pm = b * 16 + t; u.pn = h; u.g = 0; u.ibase = 0; u.aoff = ((long)(b * SEQ + t * 256)) * 1024 + (kind == 2 ? 0 : h * 256);
    u.boff = kind == 0 ? ((long)(b * NMEM)) * 1024 + h * 256 : kind == 1 ? ((long)(h * 256)) * 1024 + b * NMEM : ((long)(h * 256)) * 1024; return true; } };
constexpr size_t WS_WRG = WS_DEC + 65536;
constexpr size_t WS_ROWSEL = WS_SEL, WS_GSEL = WS_SEL + 131072, WS_INV = 31 * MiB, WS_YE = 160 * MiB;
typedef float f32x4m __attribute__((ext_vector_type(4)));
__device__ __forceinline__ void p10_router(Frame& F, const Args& a) {
  unsigned char* ws = F.ws; const bf16* X2 = (const bf16*)(ws + WS_X2); const float* ss2 = (const float*)(ws + CTL_SS2); float* AFF = (float*)(ws + WS_AFF); const float* WRG = (const float*)(ws + WS_WRG);
  const int gw = F.vcu * NWAVES + F.wave, NGW = F.G * NWAVES, r = F.lane & 15, kq = F.lane >> 4;
  LAS float* wl = (LAS float*)F.lds;
  for (int i = F.tid; i < 4096; i += NTHR) ((LAS f32x4*)wl)[i] = ((const f32x4*)WRG)[i];
  __syncthreads();
  for (int it = gw; it < MTOK / 16; it += NGW) { const int m0 = it * 16;
    const bf16* xp = X2 + (size_t)(m0 + r) * 1024 + 4 * kq; const LAS float* wp = wl + (4 * kq) * 16 + r;
    f32x4m acc0 = {0.f, 0.f, 0.f, 0.f}, acc1 = {0.f, 0.f, 0.f, 0.f};
#pragma unroll 1
    for (int hf = 0; hf < 2; ++hf) {
      f32x4 xv[32];
#pragma unroll
      for (int j = 0; j < 32; ++j) {
#if X2MODE >= 1 && X2MODE != 3
        xv[j] = *(const f32x4*)((const float*)(ws + WS_X2F) + (size_t)(m0 + r) * 1024 + 4 * kq + 16 * (32 * hf + j));
#else
        const v2u w = *(const v2u*)(xp + 16 * (32 * hf + j)); xv[j] = (f32x4){bflo(w.x), bfhi(w.x), bflo(w.y), bfhi(w.y)};
#endif
      }
#pragma unroll
      for (int j = 0; j < 32; j += 2) { const LAS float* w0 = wp + (16 * (32 * hf + j)) * 16; const LAS float* w1 = w0 + 256;
        acc0 = __builtin_amdgcn_mfma_f32_16x16x4f32(xv[j].x, w0[0], acc0, 0, 0, 0); acc1 = __builtin_amdgcn_mfma_f32_16x16x4f32(xv[j + 1].x, w1[0], acc1, 0, 0, 0);
        acc0 = __builtin_amdgcn_mfma_f32_16x16x4f32(xv[j].y, w0[16], acc0, 0, 0, 0); acc1 = __builtin_amdgcn_mfma_f32_16x16x4f32(xv[j + 1].y, w1[16], acc1, 0, 0, 0);
        acc0 = __builtin_amdgcn_mfma_f32_16x16x4f32(xv[j].z, w0[32], acc0, 0, 0, 0); acc1 = __builtin_amdgcn_mfma_f32_16x16x4f32(xv[j + 1].z, w1[32], acc1, 0, 0, 0);
        acc0 = __builtin_amdgcn_mfma_f32_16x16x4f32(xv[j].w, w0[48], acc0, 0, 0, 0); acc1 = __builtin_amdgcn_mfma_f32_16x16x4f32(xv[j + 1].w, w1[48], acc1, 0, 0, 0); }
    }
#pragma unroll
    for (int i = 0; i < 4; ++i) { const int row = m0 + 4 * kq + i; const float lg = (acc0[i] + acc1[i]) * rsqrtf(ss2[row] * (1.f / 1024.f) + 1e-6f);
      float mx = lg; mx = fmaxf(mx, __shfl_xor(mx, 1)); mx = fmaxf(mx, __shfl_xor(mx, 2)); mx = fmaxf(mx, __shfl_xor(mx, 4)); mx = fmaxf(mx, __shfl_xor(mx, 8));
      const float ex = __expf(lg - mx); float l = ex; l += __shfl_xor(l, 1); l += __shfl_xor(l, 2); l += __shfl_xor(l, 4); l += __shfl_xor(l, 8);
      AFF[(size_t)row * 16 + r] = ex / l; }
  }
  __syncthreads();
}
__device__ __forceinline__ void p11_topk(Frame& F, char* lds) {
  unsigned char* ws = F.ws; const float* AFF = (const float*)(ws + WS_AFF); int* ROWSEL = (int*)(ws + WS_ROWSEL); float* GSEL = (float*)(ws + WS_GSEL); int* INV = (int*)(ws + WS_INV);
  unsigned* hist = (unsigned*)lds; unsigned* ctl = hist + 256; unsigned* wsum = hist + 320;
  const int tid = F.tid, lane = F.lane, wid = F.wave;
  for (int it = (int)blockIdx.x; it < BATCH * NEXP; it += F.G) { const int b = it >> 4, e = it & 15;
    unsigned key[8];
#pragma unroll
    for (int j = 0; j < 8; ++j) key[j] = __float_as_uint(AFF[((size_t)b * SEQ + 8 * tid + j) * 16 + e]);
    unsigned prefix = 0u, mask = 0u, need = CAP;
    for (int shift = 24; shift >= 0; shift -= 8) {
      if (tid < 256) hist[tid] = 0u;
      __syncthreads();
#pragma unroll
      for (int j = 0; j < 8; ++j) if ((key[j] & mask) == prefix) atomicAdd(&hist[(key[j] >> shift) & 255u], 1u);
      __syncthreads();
      if (tid == 0) { unsigned above = 0u; int d = 255; for (; d > 0; --d) { const unsigned c = hist[d]; if (above + c >= need) break; above += c; } ctl[0] = (unsigned)d; ctl[1] = need - above; }
      __syncthreads();
      prefix |= ctl[0] << shift; mask |= 255u << shift; need = ctl[1];
      __syncthreads();
    }
    unsigned ngt = 0u, neq = 0u;
#pragma unroll
    for (int j = 0; j < 8; ++j) { ngt += key[j] > prefix ? 1u : 0u; neq += key[j] == prefix ? 1u : 0u; }
    unsigned sgt = ngt, seq_ = neq;
#pragma unroll
    for (int o = 1; o < 64; o <<= 1) { const unsigned y0 = __shfl_up(sgt, o), y1 = __shfl_up(seq_, o); if (lane >= o) { sgt += y0; seq_ += y1; } }
    if (lane == 63) { wsum[wid] = sgt; wsum[8 + wid] = seq_; }
    __syncthreads();
    unsigned bgt = 0u, beq = 0u, tgt = 0u;
#pragma unroll
    for (int w = 0; w < 8; ++w) { const unsigned g = wsum[w], q = wsum[8 + w]; if (w < wid) { bgt += g; beq += q; } tgt += g; }
    unsigned pgt = bgt + sgt - ngt, peq = beq + seq_ - neq;
#pragma unroll
    for (int j = 0; j < 8; ++j) { const int t = 8 * tid + j; int slot = -1;
      if (key[j] > prefix) slot = (int)pgt++; else if (key[j] == prefix) { if (peq < need) slot = (int)(tgt + peq); ++peq; }
      INV[((size_t)b * SEQ + t) * 16 + e] = slot;
      if (slot >= 0) { ROWSEL[e * 2048 + b * 512 + slot] = b * SEQ + t; GSEL[e * 2048 + b * 512 + slot] = __uint_as_float(key[j]); } }
    __syncthreads();
  }
}
#ifndef GU_ORDER
#define GU_ORDER 1
#endif
#ifndef DN_ORDER
#define DN_ORDER 1
#endif
struct MoeGUOrder { int G, c;
  __device__ bool next(int i, pg8::Unit& u) const { const int L = i * G + c; if (L >= 2048) return false;
#if GU_ORDER == 0
    const int e = L >> 7, r = L & 127, pn = r >> 3, mt = r & 7;
#elif GU_ORDER == 1
    const int e = L >> 7, r = L & 127, mt = r >> 4, pn = r & 15;
#else
    const int x = c & 7, j = c >> 3, e = (i >> 2) * 8 + x, r = (i & 3) * 32 + j, mt = r >> 4, pn = r & 15;
#endif
    u.g = e; u.pm = mt; u.pn = pn; u.ibase = e * 2048 + mt * 256; u.aoff = MOE_FP8 ? ((long)e * 2048 + mt * 256) * 512 : 0; u.boff = ((long)e * 4096 + pn * 256) * (MOE_FP8 ? 512 : 1024); return true; } };
struct MoeDownOrder { int G, c;
  __device__ bool next(int i, pg8::Unit& u) const { const int L = i * G + c; if (L >= 512) return false;
#if DN_ORDER == 0
    const int e = L >> 5, r = L & 31, pn = r >> 3, mt = r & 7;
#else
    const int x = c & 7, j = c >> 3, e = i * 8 + x, pn = j >> 3, mt = j & 7;
#endif
    u.g = e; u.pm = mt; u.pn = pn; u.ibase = e * 2048 + mt * 256; u.aoff = ((long)e * 2048 + mt * 256) * (MOE_FP8_DOWN ? 1024 : 2048); u.boff = ((long)e * 1024 + pn * 256) * (MOE_FP8_DOWN ? 1024 : 2048); return true; } };
struct EpiGU { static constexpr bool TWO_PASS = false; bf16* H; const float* ss2; const int* rowsel;
  __device__ __forceinline__ void row8(const pg8::Unit& u, int rloc, int cloc, const float (&a0)[8], const float (&a1)[8], int fq) const {
    const int tok = rowsel[u.ibase + rloc]; const float r = rsqrtf(ss2[tok] * (1.f / 1024.f) + 1e-6f); float h[8];
#pragma unroll
    for (int i = 0; i < 8; ++i) { const float g = a0[i] * r, up = a1[i] * r; h[i] = g * sigmoidf_(g) * up; if (FP8EMU) h[i] = q8(h[i], 8.f); }
#if MOE_FP8_DOWN
    *(v2u*)((unsigned char*)H + ((size_t)u.g * 2048 + u.pm * 256 + rloc) * 2048 + u.pn * 128 + cloc) = pack8_fp8(h, 8.f); } };
#else
    *(v4u*)(H + ((size_t)u.g * 2048 + u.pm * 256 + rloc) * 2048 + u.pn * 128 + cloc) = pack8(h); } };
#endif
struct EpiGU8 { static constexpr bool TWO_PASS = false; unsigned char* H8; const float* ss2; const int* rowsel;
  __device__ __forceinline__ void row8(const pg8::Unit& u, int rloc, int cloc, const float (&a0)[8], const float (&a1)[8], int fq) const {
    float h[8];
#pragma unroll
    for (int i = 0; i < 8; ++i) { const float g = a0[i], up = a1[i]; h[i] = g * sigmoidf_(g) * up; }
#if MOE_FP8_DOWN
    *(v2u*)(H8 + ((size_t)u.g * 2048 + u.pm * 256 + rloc) * 2048 + u.pn * 128 + cloc) = pack8_fp8(h, 8.f); } };
#else
    *(v4u*)((bf16*)H8 + ((size_t)u.g * 2048 + u.pm * 256 + rloc) * 2048 + u.pn * 128 + cloc) = pack8(h); } };
#endif
struct EpiYE { static constexpr bool TWO_PASS = false; bf16* Yp; const float* gsel;
  __device__ __forceinline__ void row8(const pg8::Unit& u, int rloc, int cloc, const float (&a0)[8], const float (&a1)[8], int fq) const {
    const float gv = gsel[u.ibase + rloc]; float v0[8], v1[8];
#pragma unroll
    for (int i = 0; i < 8; ++i) { v0[i] = a0[i] * gv; v1[i] = a1[i] * gv; }
    bf16* p = Yp + ((size_t)u.g * 2048 + u.pm * 256 + rloc) * 1024 + u.pn * 256 + cloc; *(v4u*)p = pack8(v0); *(v4u*)(p + 128) = pack8(v1); } };
__device__ __forceinline__ void p14_final(Frame& F, const Args& a) {
  unsigned char* ws = F.ws; const bf16* X2 = (const bf16*)(ws + WS_X2); const int* INV = (const int*)(ws + WS_INV); const bf16* YE = (const bf16*)(ws + WS_YE);
  const float* gfin = (const float*)a.in[I_GFIN]; float* out = a.out;
  const int gw = F.vcu * NWAVES + F.wave, NGW = F.G * NWAVES;
  f32x4 g[4];
#pragma unroll
  for (int j = 0; j < 4; ++j) g[j] = *(const f32x4*)(gfin + 256 * j + 4 * F.lane);
  for (int m0 = gw; m0 < MTOK; m0 += 2 * NGW) {
    f32x4 v[2][4]; int inv[2];
#pragma unroll
    for (int u = 0; u < 2; ++u) { const int m = m0 + u * NGW;
#pragma unroll
      for (int j = 0; j < 4; ++j) {
#if X2MODE >= 2
        v[u][j] = *(const f32x4*)((const float*)(ws + WS_X2F) + (size_t)m * 1024 + 256 * j + 4 * F.lane);
#else
        const v2u w = *(const v2u*)(X2 + (size_t)m * 1024 + 256 * j + 4 * F.lane); v[u][j] = (f32x4){bflo(w.x), bfhi(w.x), bflo(w.y), bfhi(w.y)};
#endif
      }
      inv[u] = F.lane < 16 ? INV[(size_t)m * 16 + F.lane] : -1; }
#pragma unroll
    for (int u = 0; u < 2; ++u) { const int m = m0 + u * NGW, b = m >> 12;
      unsigned long long sel = __ballot(inv[u] >= 0);
      while (sel) { const int e = __builtin_ctzll(sel); sel &= sel - 1; const int slot = __shfl(inv[u], e);
        const bf16* yr = YE + ((size_t)e * 2048 + b * 512 + slot) * 1024 + 4 * F.lane;
#pragma unroll
        for (int j = 0; j < 4; ++j) { const v2u w = *(const v2u*)(yr + 256 * j); v[u][j].x += bflo(w.x); v[u][j].y += bfhi(w.x); v[u][j].z += bflo(w.y); v[u][j].w += bfhi(w.y); } }
      float s = 0.f;
#pragma unroll
      for (int j = 0; j < 4; ++j) s += (v[u][j].x * v[u][j].x + v[u][j].y * v[u][j].y) + (v[u][j].z * v[u][j].z + v[u][j].w * v[u][j].w);
      const float r = rsqrtf(wave_sum(s) * (1.f / 1024.f) + 1e-6f);
#pragma unroll
      for (int j = 0; j < 4; ++j) *(f32x4*)(out + (size_t)m * 1024 + 256 * j + 4 * F.lane) = v[u][j] * r * g[j]; }
  }
}
__global__ void __launch_bounds__(NTHR, 2) mk(Args a) {
  extern __shared__ __attribute__((aligned(16))) unsigned char lds_raw[];
  Frame F;
  F.lds = (LAS unsigned char*)lds_raw; F.MISC = (volatile LAS unsigned*)(F.lds + LDSCTL_OFF + 320);
  F.tid = threadIdx.x; F.lane = F.tid & 63; F.wave = __builtin_amdgcn_readfirstlane(F.tid >> 6);
  F.G = gridDim.x; { const int bx = blockIdx.x; F.vcu = (F.G % 8 == 0) ? (bx % 8) * (F.G / 8) + bx / 8 : bx; }
  F.ws = a.ws; F.ctl = (gu32*)(a.ws + WS_CTL);
  unsigned char* ws = a.ws;
  for (int u = F.tid; u < (LDS_BYTES - LDSCTL_OFF) / 4; u += NTHR) ((LAS unsigned*)(F.lds + LDSCTL_OFF))[u] = 0u;
  __syncthreads();
  XcdBarrier bar = xcd_barrier_post((unsigned*)(F.ctl + CW_BAR), F.MISC + 8);
  const int lo = a.ph_lo, hi = a.ph_hi;
#define IN(k) (lo <= (k) && (k) < hi)
#define BOTH(k) (IN(k) && IN((k) + 1))
#define GRID_BAR() xcd_barrier(bar)
  float* ssq = (float*)(ws + CTL_SSQ); float* sskv = (float*)(ws + CTL_SSKV);

#ifndef REP_MASK
#define REP_MASK 0
#endif
#define NREP(k) ((((REP_MASK) >> (k)) & 1) ? 2 : 1)
#define PH_BEGIN(k) if (IN(k)) { for (int rep_ = 0; rep_ < NREP(k); ++rep_) { const bool dry = rep_ + 1 < NREP(k); (void)dry;
#define PH_END(k) if (dry) GRID_BAR(); } if (BOTH(k)) GRID_BAR(); }
  float* dummy = (float*)(ws + WS_DUMMY);
  float* ss1 = (float*)(ws + CTL_SS1); float* ss2 = (float*)(ws + CTL_SS2);
#ifndef FILLMODE
#define FILLMODE 2
#endif
  PH_BEGIN(0) p0_prologue(F, a, true, FILLMODE == 0); PH_END(0)
  PH_BEGIN(1)
    { pg8::Gemm g{(const bf16*)(ws + WS_XN), (const bf16*)(ws + WS_WIN), 1024, 1024, 1024, nullptr, 127, 127}; pg8::StaticOrder S; S.init(MTOK, PROJ_LD, F.G, (int)blockIdx.x, 1024, 1024);
      EpiProj E{(bf16*)(ws + WS_PROJ), dry ? dummy : ssq, dry ? dummy + 16384 : sskv};
      pg8::gemm_phase<EpiProj, pg8::StaticOrder, false>(F.lds, g, S, E); }
    { pg8::Gemm g{(const bf16*)(ws + WS_MEMN), (const bf16*)(ws + WS_WMK), 1024, 1024, 1024, nullptr, 127, 127}; pg8::StaticOrder S; S.init(1024, 1024, F.G, (int)((blockIdx.x + 128u) % (unsigned)F.G), 1024, 1024);
      EpiStore E{(bf16*)(ws + WS_KMEM), 1024};
      pg8::gemm_phase<EpiStore, pg8::StaticOrder, false>(F.lds, g, S, E); }
    { pg8::Gemm g{(const bf16*)(ws + WS_WMV), (const bf16*)(ws + WS_MEMN), 1024, 1024, 1024, nullptr, 127, 127}; pg8::StaticOrder S; S.init(1024, 1024, F.G, (int)((blockIdx.x + 112u) % (unsigned)F.G), 1024, 1024);
      EpiStore E{(bf16*)(ws + WS_VMEMT), 1024};
      pg8::gemm_phase<EpiStore, pg8::StaticOrder, false>(F.lds, g, S, E); }
#ifndef P1_FILL
#define P1_FILL 1
#endif
    if (!dry && blockIdx.x >= 160u) conv_fill(F, a, P1_FILL);
  PH_END(1)
  PH_BEGIN(2) p2_elementwise(F, a); PH_END(2)
  PH_BEGIN(3) p3_mixers(F, a, (char*)lds_raw, bar.x, ssq, sskv, dry ? 64 * 16 : 0); PH_END(3)
  PH_BEGIN(4) p4_combine(F, a); PH_END(4)
  PH_BEGIN(5)
    pg8::Gemm g{(const bf16*)(ws + WS_Y), (const bf16*)(ws + WS_WOUT), 1024, 1024, 1024, nullptr, 127, 127}; pg8::StaticOrder S; S.init(MTOK, 1024, F.G, (int)blockIdx.x, 1024, 1024);
    EpiResid<0> E{(const float*)a.in[I_X], nullptr, nullptr, (bf16*)(ws + WS_X1B), dry ? dummy : ss1};
    pg8::gemm_phase<EpiResid<0>, pg8::StaticOrder, false>(F.lds, g, S, E);
  PH_END(5)
  PH_BEGIN(6)
    { pg8::Gemm g{(const bf16*)(ws + WS_X1B), (const bf16*)(ws + WS_WMQ), 1024, 1024, 1024, nullptr, 127, 127}; MemOrder S{F.G, (int)blockIdx.x, 2};
      EpiScale E{(bf16*)(ws + WS_QMEM), ss1};
      pg8::gemm_phase<EpiScale, MemOrder, false>(F.lds, g, S, E); }
    if (F.tid == 0) __builtin_amdgcn_fence(__ATOMIC_ACQUIRE, "agent");
    asm volatile("s_waitcnt vmcnt(0)" ::: "memory"); __syncthreads();
    { pg8::Gemm g{(const bf16*)(ws + WS_QMEM), (const bf16*)(ws + WS_KMEM), 1024, 1024, 256, nullptr, 127, 127}; MemOrder S{F.G, (int)blockIdx.x, 0};
      EpiSoftmax E{(bf16*)(ws + WS_P), 0.0625f, (LAS float*)(F.lds + LDSCTL_OFF + 1024)};
      pg8::gemm_phase<EpiSoftmax, MemOrder, false>(F.lds, g, S, E); }
    if (F.tid == 0) __builtin_amdgcn_fence(__ATOMIC_ACQUIRE, "agent");
    asm volatile("s_waitcnt vmcnt(0)" ::: "memory"); __syncthreads();
    { pg8::Gemm g{(const bf16*)(ws + WS_P), (const bf16*)(ws + WS_VMEMT), 1024, 1024, 256, nullptr, 127, 127}; MemOrder S{F.G, (int)blockIdx.x, 1};
      EpiStore E{(bf16*)(ws + WS_MO), 1024};
      pg8::gemm_phase<EpiStore, MemOrder, false>(F.lds, g, S, E); }
  PH_END(6)
  PH_BEGIN(9)
    pg8::Gemm g{(const bf16*)(ws + WS_MO), (const bf16*)(ws + WS_WMO), 1024, 1024, 1024, nullptr, 127, 127}; pg8::StaticOrder S; S.init(MTOK, 1024, F.G, (int)blockIdx.x, 1024, 1024);
    EpiResid<1> E{nullptr, (const bf16*)(ws + WS_X1B), X2MODE >= 1 ? (float*)(ws + WS_X2F) : nullptr, (bf16*)(ws + WS_X2), dry ? dummy : ss2};
    pg8::gemm_phase<EpiResid<1>, pg8::StaticOrder, false>(F.lds, g, S, E);
  PH_END(9)
  PH_BEGIN(10) p10_router(F, a); PH_END(10)
  PH_BEGIN(11) p11_topk(F, (char*)lds_raw);
    if (!dry && FILLMODE != 0) conv_fill(F, a, 1 << 30);
  PH_END(11)
  PH_BEGIN(12)
#if MOE_FP8
    {
      const int gw = F.vcu * NWAVES + F.wave, NGW = F.G * NWAVES; const int* rs = (const int*)(ws + WS_ROWSEL);
      for (int r0 = gw; r0 < NEXP * 2048; r0 += 4 * NGW) {
        int tok[4]; float rn[4]; v4u qa[4], qb[4];
#pragma unroll
        for (int u = 0; u < 4; ++u) { const int r = r0 + u * NGW; tok[u] = r < NEXP * 2048 ? rs[r] : 0; }
#pragma unroll
        for (int u = 0; u < 4; ++u) { const bf16* xr = (const bf16*)(ws + WS_X2) + (size_t)tok[u] * 1024 + F.lane * 16; rn[u] = ss2[tok[u]]; qa[u] = *(const v4u*)xr; qb[u] = *(const v4u*)(xr + 8); }
#pragma unroll
        for (int u = 0; u < 4; ++u) { const int r = r0 + u * NGW; const float s = rsqrtf(rn[u] * (1.f / 1024.f) + 1e-6f);
          float lo[8], hi[8]; unpack8(qa[u], lo); unpack8(qb[u], hi);
#pragma unroll
          for (int j = 0; j < 8; ++j) { lo[j] *= s; hi[j] *= s; }
          const v2u a8 = pack8_fp8(lo, 1.f), b8 = pack8_fp8(hi, 1.f); v4u o; o.x = a8.x; o.y = a8.y; o.z = b8.x; o.w = b8.y;
          if (r < NEXP * 2048) *(v4u*)(ws + WS_XG + (size_t)r * 1024 + F.lane * 16) = o; } }
      GRID_BAR(); }
    pg8::Gemm g{(const bf16*)(ws + WS_XG), (const bf16*)(ws + WS_WEGU8), 512, 512, 512, nullptr, 127, 121}; MoeGUOrder S{F.G, (int)blockIdx.x};
    EpiGU8 E{(unsigned char*)(ws + WS_HID8), ss2, (const int*)(ws + WS_ROWSEL)};
    pg8::gemm_phase<EpiGU8, MoeGUOrder, false, 1>(F.lds, g, S, E);
#else
    pg8::Gemm g{(const bf16*)(ws + WS_X2B), (const bf16*)(ws + WS_WEGU), 1024, 1024, 1024, (const int*)(ws + WS_ROWSEL), 127, 127}; MoeGUOrder S{F.G, (int)blockIdx.x};
    EpiGU E{(bf16*)(ws + WS_HID), ss2, (const int*)(ws + WS_ROWSEL)};
    pg8::gemm_phase<EpiGU, MoeGUOrder, true>(F.lds, g, S, E);
#endif
  PH_END(12)
  PH_BEGIN(13)
#if MOE_FP8_DOWN
    pg8::Gemm g{(const bf16*)(ws + WS_HID8), (const bf16*)(ws + WS_WED8), 1024, 1024, 1024, nullptr, 124, 121}; MoeDownOrder S{F.G, (int)blockIdx.x};
    EpiYE E{(bf16*)(ws + WS_YE), (const float*)(ws + WS_GSEL)};
    pg8::gemm_phase<EpiYE, MoeDownOrder, false, 1>(F.lds, g, S, E);
#else
    pg8::Gemm g{(const bf16*)(ws + WS_HID), (const bf16*)(ws + WS_WED), 2048, 2048, 2048, nullptr, 127, 127}; MoeDownOrder S{F.G, (int)blockIdx.x};
    EpiYE E{(bf16*)(ws + WS_YE), (const float*)(ws + WS_GSEL)};
    pg8::gemm_phase<EpiYE, MoeDownOrder, false>(F.lds, g, S, E);
#endif
  PH_END(13)
  PH_BEGIN(14) p14_final(F, a); PH_END(14)
#undef IN
#undef BOTH
#undef GRID_BAR
}

__global__ __launch_bounds__(256) void adapt_b2f(const bf16* src, long lds_, long scol, float* dst, long ldd, long dcol, long rows, long ncols) {
  const long i = blockIdx.x * 256L + threadIdx.x; if (i >= rows * ncols) return;
  const long r = i / ncols, c = i % ncols; dst[r * ldd + dcol + c] = bf2f(src[r * lds_ + scol + c]);
}
static void adapt(hipStream_t s, const void* src, long lds_, long scol, float* dst, long ldd, long dcol, long rows, long ncols) {
  hipLaunchKernelGGL(adapt_b2f, dim3((unsigned)((rows * ncols + 255) / 256)), dim3(256), 0, s, (const bf16*)src, lds_, scol, dst, ldd, dcol, rows, ncols);
}

static int mk_grid() {
  static int grid = 0;
  if (grid == 0) {
    int dev = 0, cus = 0, per_cu = 0;
    (void)hipGetDevice(&dev); (void)hipDeviceGetAttribute(&cus, hipDeviceAttributeMultiprocessorCount, dev);
    (void)hipFuncSetAttribute((const void*)mk, hipFuncAttributeMaxDynamicSharedMemorySize, LDS_BYTES);
    (void)hipOccupancyMaxActiveBlocksPerMultiprocessor(&per_cu, (const void*)mk, NTHR, LDS_BYTES);
    (void)hipGetLastError();
    grid = cus > 0 ? cus : 256;
  }
  return grid;
}
static void mk_launch(hipStream_t s, void* const* d_in, void* d_out, void* d_ws, int lo, int hi, int flags) {
  Args a; memset(&a, 0, sizeof(a));
  for (int i = 0; i < 26; ++i) a.in[i] = d_in[i];
  a.out = (float*)d_out; a.ws = (unsigned char*)d_ws; a.ph_lo = lo; a.ph_hi = hi; a.flags = flags; a.pad = 0;
  (void)hipMemsetAsync((char*)d_ws + WS_CTL + CW_BAR * 4, 0, XCD_BAR_WORDS * 4, s);
  hipLaunchKernelGGL(mk, dim3(mk_grid()), dim3(NTHR), LDS_BYTES, s, a);
}

extern "C" void kernel_launch(void* const* d_in, const int* in_sizes, int n_in, void* d_out, int out_size, void* d_ws, size_t ws_size, hipStream_t s) {
  (void)hipMemsetAsync((char*)d_ws + WS_CTL, 0, CTL_ZERO_BYTES, s);
  mk_launch(s, d_in, d_out, d_ws, 0, 15, 1);
}
```

```cpp
#include <hip/hip_runtime.h>
#include <cstdint>
#include <cstdio>
#include <cstring>

constexpr int BATCH = 4, SEQ = 4096, DM = 1024, MTOK = BATCH * SEQ;
constexpr int D_IN = 2480;
constexpr int OFF_QM = 0, OFF_KM = 512, OFF_VM = 1024, OFF_OM = 1536, OFF_G = 2048, OFF_CQ = 2064, OFF_CKV = 2320, OFF_KR = 2448;
constexpr int NEXP = 16, CAP = 512, DFF = 2048, NMEM = 256;
constexpr size_t MiB = 1u << 20;
enum { I_X = 0, I_MEM, I_POS, I_GMIX, I_WIN, I_BG, I_CONV, I_GQA, I_WQB, I_GKVA, I_WKVB, I_GHM, I_GHA, I_WOUT, I_GMX, I_GMKV, I_WMQ, I_WMK, I_WMV, I_WMO, I_GFFN, I_WR, I_WEG, I_WEU, I_WED, I_GFIN };
#define GAS __attribute__((address_space(1)))
#define LAS __attribute__((address_space(3)))
typedef unsigned short bf16;
typedef unsigned v4u __attribute__((ext_vector_type(4)));
typedef unsigned v2u __attribute__((ext_vector_type(2)));
typedef float f32x4 __attribute__((ext_vector_type(4)));
typedef float f32x16 __attribute__((ext_vector_type(16)));
typedef short bf16x8 __attribute__((ext_vector_type(8)));
typedef short s16x4 __attribute__((ext_vector_type(4)));
typedef GAS unsigned gu32;
#define RLX_AGENT __ATOMIC_RELAXED, __HIP_MEMORY_SCOPE_AGENT
#define LDS_WAIT() asm volatile("s_waitcnt lgkmcnt(0)" ::: "memory")
#define VM_WAIT() asm volatile("s_waitcnt vmcnt(0)" ::: "memory")
constexpr int NWAVES = 8, NTHR = 512;
struct SsAcc { unsigned long long* p;
  __device__ __forceinline__ float operator[](int i) const { return (float)(long long)p[i] * (1.f / 1048576.f); }
  __device__ __forceinline__ void add(int i, float s) const { (void)__hip_atomic_fetch_add(p + i, (unsigned long long)__float2ll_rn(s * 1048576.f), __ATOMIC_RELAXED, __HIP_MEMORY_SCOPE_AGENT); }
  __device__ __forceinline__ SsAcc operator+(int o) const { return SsAcc{p + o}; } };
__device__ __forceinline__ unsigned f2bf(float f) { unsigned u = __builtin_bit_cast(unsigned, f); return (u + 0x7fffu + ((u >> 16) & 1u)) >> 16; }
__device__ __forceinline__ float bf2f(unsigned short h) { return __builtin_bit_cast(float, (unsigned)h << 16); }
__device__ __forceinline__ float bflo(unsigned w) { return __builtin_bit_cast(float, w << 16); }
__device__ __forceinline__ float bfhi(unsigned w) { return __builtin_bit_cast(float, w & 0xffff0000u); }
typedef float f32x2_t __attribute__((ext_vector_type(2))); typedef __bf16 bf16x2_t __attribute__((ext_vector_type(2)));
__device__ __forceinline__ unsigned cvt_pk_bf16(float lo, float hi) { f32x2_t v = {lo, hi}; bf16x2_t b = __builtin_convertvector(v, bf16x2_t); return __builtin_bit_cast(unsigned, b); }
__device__ __forceinline__ unsigned pk2(float lo, float hi) { return cvt_pk_bf16(lo, hi); }
__device__ __forceinline__ v2u pack8_fp8(const float (&v)[8], float sc) { float c[8];
#pragma unroll
  for (int i = 0; i < 8; ++i) c[i] = __builtin_amdgcn_fmed3f(v[i] * sc, -448.f, 448.f);
  int a = 0, b = 0; a = __builtin_amdgcn_cvt_pk_fp8_f32(c[0], c[1], a, false); a = __builtin_amdgcn_cvt_pk_fp8_f32(c[2], c[3], a, true);
  b = __builtin_amdgcn_cvt_pk_fp8_f32(c[4], c[5], b, false); b = __builtin_amdgcn_cvt_pk_fp8_f32(c[6], c[7], b, true); v2u r; r.x = (unsigned)a; r.y = (unsigned)b; return r; }
__device__ __forceinline__ float q8(float x, float sc) { const int p = __builtin_amdgcn_cvt_pk_fp8_f32(x * sc, 0.f, 0, false); return __builtin_amdgcn_cvt_f32_fp8(p, 0) * (1.f / sc); }
__device__ __forceinline__ float wave_sum(float v) {
#pragma unroll
  for (int o = 1; o < 64; o <<= 1) v += __shfl_xor(v, o);
  return v;
}
__device__ __forceinline__ float sigmoidf_(float x) { return __builtin_amdgcn_rcpf(1.f + __expf(-x)); }

#define XB_TMO      128
#define XB_XCNT(j)  (256  + 64 * (j))
#define XB_XSUB(j)  (1280 + 64 * (j))
#define XB_XGEN(j)  (2304 + 64 * (j))
#define XB_TOP      3328
#define XB_TOPGEN   3392
#define XCD_BAR_WORDS 3456
#define XB_SPIN_CAP (1u << 22)
__device__ __forceinline__ unsigned xb_ld(unsigned* p)              { return __hip_atomic_load(p, __ATOMIC_RELAXED, __HIP_MEMORY_SCOPE_AGENT); }
__device__ __forceinline__ unsigned xb_add(unsigned* p, unsigned v) { return __hip_atomic_fetch_add(p, v, __ATOMIC_RELAXED, __HIP_MEMORY_SCOPE_AGENT); }
__device__ __forceinline__ unsigned xb_xcc_id() { return (unsigned)__builtin_amdgcn_s_getreg((3 << 11) | 20) & 0xFu; }
#define XB_SPIN(cond, bar) do { unsigned _sp = 0; while (cond) { __builtin_amdgcn_s_sleep(1); \
    if ((++_sp & 255u) == 0u) { if (xb_ld(&(bar)[XB_TMO])) break; if (_sp > XB_SPIN_CAP) { atomicAdd(&(bar)[XB_TMO], 1u); break; } } } } while (0)
struct XcdBarrier { unsigned* bar; unsigned x; volatile LAS unsigned* st; };
__device__ __forceinline__ XcdBarrier xcd_barrier_post(unsigned* bar, volatile LAS unsigned* st) {
  XcdBarrier b; b.bar = bar; b.x = xb_xcc_id(); b.st = st;
  if (threadIdx.x == 0) (void)xb_add(&bar[XB_XCNT(b.x)], 1u);
  return b;
}
__device__ __forceinline__ void xcd_barrier_complete(unsigned* bar, unsigned x, unsigned& nloc, unsigned& nx) {
  const unsigned G = gridDim.x * gridDim.y * gridDim.z;
  unsigned sum, cnt, mine, sp = 0u;
  for (;;) {
    sum = 0u; cnt = 0u; mine = 0u;
#pragma unroll
    for (unsigned j = 0; j < 16; ++j) { const unsigned c = xb_ld(&bar[XB_XCNT(j)]); sum += c; cnt += (c > 0u) ? 1u : 0u; mine = (j == x) ? c : mine; }
    if (sum == G) break;
    __builtin_amdgcn_s_sleep(1);
    if ((++sp & 255u) == 0u) { if (xb_ld(&bar[XB_TMO])) break; if (sp > XB_SPIN_CAP) { atomicAdd(&bar[XB_TMO], 1u); break; } }
  }
  nloc = mine > 0u ? mine : 1u; nx = cnt > 0u ? cnt : 1u;
}
__device__ __forceinline__ void xcd_barrier(const XcdBarrier& b) {
  asm volatile("s_waitcnt vmcnt(0)" ::: "memory");
  __syncthreads();
  if (threadIdx.x == 0) {
    unsigned* bar = b.bar;
    __builtin_amdgcn_s_waitcnt(0);
    unsigned nloc = b.st[0], nx = b.st[1];
    if (nloc == 0u) { xcd_barrier_complete(bar, b.x, nloc, nx); b.st[0] = nloc; b.st[1] = nx; }
    const unsigned old = xb_add(&bar[XB_XSUB(b.x)], 1u);
    const unsigned gen = old / nloc;
    if (old + 1u == (gen + 1u) * nloc) {
      __builtin_amdgcn_fence(__ATOMIC_RELEASE, "agent");
      asm volatile("s_waitcnt vmcnt(0)" ::: "memory");
      const unsigned og = xb_add(&bar[XB_TOP], 1u);
      const unsigned tg = og / nx;
      if (og + 1u == (tg + 1u) * nx) xb_add(&bar[XB_TOPGEN], 1u);
      else XB_SPIN(xb_ld(&bar[XB_TOPGEN]) == tg, bar);
      __builtin_amdgcn_fence(__ATOMIC_ACQUIRE, "agent");
      xb_add(&bar[XB_XGEN(b.x)], 1u);
      asm volatile("s_waitcnt vmcnt(0)" ::: "memory");
    } else {
      XB_SPIN(xb_ld(&bar[XB_XGEN(b.x)]) == gen, bar);
      __builtin_amdgcn_fence(__ATOMIC_ACQUIRE, "agent");
      asm volatile("s_waitcnt vmcnt(0)" ::: "memory");
    }
  }
  __syncthreads();
}

namespace pg8 {
constexpr int BM = 256, BK = 64, HALF = 128, HTB = HALF * BK * 2, STAGE_BYTES = 8 * HTB, NXCD = 8, WGM = 8;
__host__ __device__ __forceinline__ int lds_byte(int r, int c) { const int st = (r >> 4) * 2 + (c >> 5), rr = r & 15, cc = c & 31, ob = rr * 64 + cc * 2; return st * 1024 + (ob ^ (((ob >> 9) & 1) << 5)); }
__host__ __device__ __forceinline__ void stage_rc(int b, int& R, int& C) { const int st = b / 1024, sb = b % 1024, swz = sb ^ (((sb >> 9) & 1) << 5); R = (st >> 1) * 16 + swz / 64; C = (st & 1) * 32 + (swz % 64) / 2; }
__host__ __device__ __forceinline__ int perm32(int rho) { const int n = rho >> 4, i = rho & 15; return 8 * (i >> 2) + 4 * n + (i & 3); }

struct Unit { long aoff, boff; int pm, pn, g, ibase; };
struct Gemm { const bf16* A; const bf16* Bt; int lda, ldb, K; const int* gidx; int sa, sb; };
typedef int v8i_t __attribute__((ext_vector_type(8))); typedef int v4i_t __attribute__((ext_vector_type(4)));
__device__ __forceinline__ v8i_t cat8(bf16x8 lo, bf16x8 hi) { const v4i_t a = __builtin_bit_cast(v4i_t, lo), b = __builtin_bit_cast(v4i_t, hi); return __builtin_shufflevector(a, b, 0, 1, 2, 3, 4, 5, 6, 7); }

struct StaticOrder {
  int nM, nN, nwg, G, c, lda, ldb;
  __device__ void init(int M, int N, int G_, int c_, int lda_, int ldb_) { nM = M / BM; nN = N / BM; nwg = nM * nN; G = G_; c = c_; lda = lda_; ldb = ldb_; }
  __device__ bool next(int i, Unit& u) const {
    const long L = (long)i * G + c; if (L >= nwg) return false;
    int wgid = (int)L; { const int q = nwg / NXCD, r = nwg % NXCD, xcd = wgid % NXCD, off = wgid / NXCD; wgid = (xcd < r ? xcd * (q + 1) : r * (q + 1) + (xcd - r) * q) + off; }
    const int nig = WGM * nN, gid = wgid / nig, fm = gid * WGM, gsz = (nM - fm) < WGM ? (nM - fm) : WGM;
    u.pm = fm + ((wgid % nig) % gsz); u.pn = (wgid % nig) / gsz; u.g = 0; u.ibase = 0;
    u.aoff = (long)u.pm * BM * lda; u.boff = (long)u.pn * BM * ldb; return true;
  }
};

template <class Epi, class Sched, bool GATHER, int FP8 = 0>
__device__ __forceinline__ void gemm_phase(LAS unsigned char* lds, const Gemm g, const Sched& S, const Epi& E) {
  int tid = threadIdx.x; asm volatile("" : "+v"(tid));
  const int wid = __builtin_amdgcn_readfirstlane(tid >> 6), lane = tid & 63, wr = wid >> 2, wc = wid & 3, fr = lane & 15, fq = lane >> 4;
  const int K = g.K, nt = K / BK;
  int Rs[2], Cs[2]; unsigned voffB[2];
#pragma unroll
  for (int i = 0; i < 2; ++i) { int R, C; stage_rc(tid * 16 + i * 8192, R, C); Rs[i] = R; Cs[i] = C; const int Rb = (R & ~31) + perm32(R & 31); voffB[i] = (unsigned)(Rb * g.ldb + C) * 2u; }
  const size_t kstep = (size_t)(BK * 2);
  const size_t hstepB = (size_t)HALF * g.ldb * 2;
  const unsigned ldsw = (unsigned)wid * 1024u;
  const int aoff_l = lds_byte(wr * 64 + fr, fq * 8), boff_l = lds_byte(wc * 32 + fr, fq * 8);
  constexpr int aoff_k = 1024, boff_k = 1024;
#define PG8_SA(b, h) (((b) * 2 + (h)) * HTB)
#define PG8_SB(b, h) ((4 + (b) * 2 + (h)) * HTB)
#define PG8_STAGE(bufoff, gbase, voff) do { _Pragma("unroll") for (int _i = 0; _i < 2; ++_i) \
        __builtin_amdgcn_global_load_lds((const unsigned*)((const char*)(gbase) + (voff)[_i]), (LAS unsigned*)(lds + (bufoff) + ldsw + _i * 8192), 16, 0, 0); } while (0)
#define PG8_LDA(dst, b, h) do { _Pragma("unroll") for (int m = 0; m < 4; ++m) { if constexpr (FP8) { const v4i_t lo_ = *(const LAS v4i_t*)(lds + PG8_SA(b, h) + aoff_l + m * 2048), hi_ = *(const LAS v4i_t*)(lds + PG8_SA(b, h) + aoff_l + m * 2048 + aoff_k); dst##8[m] = __builtin_shufflevector(lo_, hi_, 0, 1, 2, 3, 4, 5, 6, 7); } \
        else { _Pragma("unroll") for (int k = 0; k < 2; ++k) dst[m][k] = *(const LAS bf16x8*)(lds + PG8_SA(b, h) + aoff_l + m * 2048 + k * aoff_k); } } } while (0)
#define PG8_LDB(dst, b, h) do { _Pragma("unroll") for (int n = 0; n < 2; ++n) { if constexpr (FP8) { const v4i_t lo_ = *(const LAS v4i_t*)(lds + PG8_SB(b, h) + boff_l + n * 2048), hi_ = *(const LAS v4i_t*)(lds + PG8_SB(b, h) + boff_l + n * 2048 + boff_k); dst##8[n] = __builtin_shufflevector(lo_, hi_, 0, 1, 2, 3, 4, 5, 6, 7); } \
        else { _Pragma("unroll") for (int k = 0; k < 2; ++k) dst[n][k] = *(const LAS bf16x8*)(lds + PG8_SB(b, h) + boff_l + n * 2048 + k * boff_k); } } } while (0)
#define PG8_MMA(ai, bj, At, Bt) do { __builtin_amdgcn_s_setprio(1); _Pragma("unroll") for (int m = 0; m < 4; ++m) _Pragma("unroll") for (int n = 0; n < 2; ++n) { \
        if constexpr (FP8) asm volatile("v_mfma_scale_f32_16x16x128_f8f6f4 %0, %1, %2, %0, %3, %4 op_sel_hi:[0,0,0]" : "+v"(acc[ai][bj][m][n]) : "v"(Bt##8[n]), "v"(At##8[m]), "v"(vsb), "v"(vsa)); \
        else { _Pragma("unroll") for (int k = 0; k < 2; ++k) acc[ai][bj][m][n] = __builtin_amdgcn_mfma_f32_16x16x32_bf16(Bt[n][k], At[m][k], acc[ai][bj][m][n], 0, 0, 0); } } \
        __builtin_amdgcn_s_setprio(0); } while (0)
#define PG8_WAIT_V(n) asm volatile("s_waitcnt vmcnt(" #n ")" ::: "memory")
#define PG8_WAIT_L(n) asm volatile("s_waitcnt lgkmcnt(" #n ")" ::: "memory")
#define PG8_BAR __builtin_amdgcn_s_barrier()
#define PG8_SCHED __builtin_amdgcn_sched_barrier(0)
  Unit cur, nxt; int ui = 0;
  if (!S.next(0, cur)) return;
  unsigned vA[2][2], nvA[2][2];
  auto load_va = [&](const Unit& u, unsigned (&v)[2][2]) {
#pragma unroll
    for (int h = 0; h < 2; ++h)
#pragma unroll
      for (int i = 0; i < 2; ++i) {
        if constexpr (GATHER) v[h][i] = (unsigned)((long)g.gidx[u.ibase + h * HALF + Rs[i]] * g.lda + Cs[i]) * 2u;
        else v[h][i] = (unsigned)((h * HALF + Rs[i]) * g.lda + Cs[i]) * 2u;
      }
  };
  load_va(cur, vA);
  f32x4 acc[2][2][4][2];
#pragma unroll
  for (int a = 0; a < 2; ++a)
#pragma unroll
    for (int b = 0; b < 2; ++b)
#pragma unroll
      for (int m = 0; m < 4; ++m)
#pragma unroll
        for (int n = 0; n < 2; ++n) acc[a][b][m][n] = (f32x4){0.f, 0.f, 0.f, 0.f};
  int vsa = g.sa, vsb = g.sb; (void)vsa; (void)vsb;
  bf16x8 At[4][2], B0[2][2], B1[2][2]; v8i_t At8[4], B08[2], B18[2];
  const char* cA = (const char*)g.A + (GATHER ? 0 : cur.aoff * 2); const char* cB = (const char*)g.Bt + cur.boff * 2;
  PG8_STAGE(PG8_SB(0, 0), cB, voffB); PG8_STAGE(PG8_SB(0, 1), cB + hstepB, voffB); PG8_STAGE(PG8_SA(0, 0), cA, vA[0]); PG8_STAGE(PG8_SA(0, 1), cA, vA[1]);
  if (wr == 1) PG8_BAR;
  PG8_WAIT_V(2); PG8_BAR;
  PG8_STAGE(PG8_SB(1, 0), cB + kstep, voffB); PG8_STAGE(PG8_SA(1, 0), cA + kstep, vA[0]); PG8_STAGE(PG8_SB(1, 1), cB + hstepB + kstep, voffB);
  PG8_WAIT_V(6); PG8_BAR;
  for (;;) {
    const bool has_next = S.next(ui + 1, nxt);
    const char* nA = has_next ? (const char*)g.A + (GATHER ? 0 : nxt.aoff * 2) : cA; const char* nB = has_next ? (const char*)g.Bt + nxt.boff * 2 : cB;
    if constexpr (GATHER) { if (has_next) load_va(nxt, nvA); else {
#pragma unroll
      for (int h = 0; h < 2; ++h)
#pragma unroll
        for (int i = 0; i < 2; ++i) nvA[h][i] = vA[h][i]; } }
#pragma unroll 1
    for (int t = 0; t < nt; t += 2) {
      const bool last = (t == nt - 2);
      const char* a1 = cA + (size_t)(t + 1) * kstep;
      const char* a2 = last ? nA : cA + (size_t)(t + 2) * kstep; const char* b2 = last ? nB : cB + (size_t)(t + 2) * kstep;
      const char* a3 = a2 + kstep; const char* b3 = b2 + kstep;
      unsigned w0[2], w1[2];
      if constexpr (GATHER) { w0[0] = last ? nvA[0][0] : vA[0][0]; w0[1] = last ? nvA[0][1] : vA[0][1]; w1[0] = last ? nvA[1][0] : vA[1][0]; w1[1] = last ? nvA[1][1] : vA[1][1]; }
      else { w0[0] = vA[0][0]; w0[1] = vA[0][1]; w1[0] = vA[1][0]; w1[1] = vA[1][1]; }
      PG8_LDB(B0, 0, 0); PG8_LDB(B1, 0, 1); PG8_SCHED; PG8_LDA(At, 0, 0); PG8_STAGE(PG8_SA(1, 1), a1, vA[1]);
      PG8_WAIT_V(8); PG8_WAIT_L(0); PG8_BAR; PG8_MMA(0, 0, At, B0); PG8_MMA(0, 1, At, B1); PG8_BAR; PG8_SCHED;
      PG8_LDA(At, 0, 1); PG8_STAGE(PG8_SB(0, 0), b2, voffB); PG8_STAGE(PG8_SB(0, 1), b2 + hstepB, voffB); PG8_STAGE(PG8_SA(0, 0), a2, w0);
      PG8_WAIT_V(8); PG8_WAIT_L(0); PG8_BAR; PG8_MMA(1, 0, At, B0); PG8_MMA(1, 1, At, B1); PG8_BAR; PG8_SCHED;
      PG8_LDB(B0, 1, 0); PG8_LDB(B1, 1, 1); PG8_SCHED; PG8_LDA(At, 1, 0); PG8_STAGE(PG8_SA(0, 1), a2, w1);
      PG8_WAIT_V(8); PG8_WAIT_L(0); PG8_BAR; PG8_MMA(0, 0, At, B0); PG8_MMA(0, 1, At, B1); PG8_BAR; PG8_SCHED;
      PG8_LDA(At, 1, 1); PG8_STAGE(PG8_SB(1, 0), b3, voffB); PG8_STAGE(PG8_SB(1, 1), b3 + hstepB, voffB); PG8_STAGE(PG8_SA(1, 0), a3, w0);
      PG8_WAIT_V(8); PG8_WAIT_L(0); PG8_BAR; PG8_MMA(1, 0, At, B0); PG8_MMA(1, 1, At, B1); PG8_BAR; PG8_SCHED;
    }
    if constexpr (FP8) { asm volatile("s_nop 15\n\ts_nop 15" ::: "memory"); __builtin_amdgcn_sched_barrier(0); }
    if (wr == 0) PG8_BAR;
    int fr_o = fr, fq_o = fq; asm volatile("" : "+v"(fr_o), "+v"(fq_o));
    if constexpr (Epi::TWO_PASS) {
#pragma unroll
      for (int ai = 0; ai < 2; ++ai)
#pragma unroll
        for (int m = 0; m < 4; ++m) {
          float v0[8], v1[8];
#pragma unroll
          for (int n = 0; n < 2; ++n)
#pragma unroll
            for (int j = 0; j < 4; ++j) { v0[n * 4 + j] = acc[ai][0][m][n][j]; v1[n * 4 + j] = acc[ai][1][m][n][j]; }
          E.pass1(cur, ai * HALF + wr * 64 + m * 16 + fr_o, wc, v0, v1, fq_o);
#pragma unroll
          for (int n = 0; n < 2; ++n)
#pragma unroll
            for (int j = 0; j < 4; ++j) { acc[ai][0][m][n][j] = v0[n * 4 + j]; acc[ai][1][m][n][j] = v1[n * 4 + j]; }
        }
      asm volatile("s_waitcnt lgkmcnt(0)" ::: "memory"); PG8_BAR; asm volatile("" ::: "memory");
    }
    {
#pragma unroll
      for (int ai = 0; ai < 2; ++ai)
#pragma unroll
        for (int m = 0; m < 4; ++m) {
          float v0[8], v1[8];
#pragma unroll
          for (int n = 0; n < 2; ++n)
#pragma unroll
            for (int j = 0; j < 4; ++j) { v0[n * 4 + j] = acc[ai][0][m][n][j]; v1[n * 4 + j] = acc[ai][1][m][n][j]; }
          E.row8(cur, ai * HALF + wr * 64 + m * 16 + fr_o, wc * 32 + 8 * fq_o, v0, v1, fq_o);
          asm volatile("" ::: "memory");
        }
    }
    if (!has_next) break;
#pragma unroll
    for (int a = 0; a < 2; ++a)
#pragma unroll
      for (int b = 0; b < 2; ++b)
#pragma unroll
        for (int m = 0; m < 4; ++m)
#pragma unroll
          for (int n = 0; n < 2; ++n) acc[a][b][m][n] = (f32x4){0.f, 0.f, 0.f, 0.f};
    cur = nxt; cA = nA; cB = nB; ++ui;
    if constexpr (GATHER) {
#pragma unroll
      for (int h = 0; h < 2; ++h)
#pragma unroll
        for (int i = 0; i < 2; ++i) vA[h][i] = nvA[h][i]; }
    if (wr == 1) PG8_BAR;
  }
  PG8_WAIT_V(0);
  PG8_BAR;
#undef PG8_SA
#undef PG8_SB
#undef PG8_STAGE
#undef PG8_LDA
#undef PG8_LDB
#undef PG8_MMA
#undef PG8_WAIT_V
#undef PG8_WAIT_L
#undef PG8_BAR
#undef PG8_SCHED
}
}
constexpr size_t WS_CTL = 0, CTL_ZERO_BYTES = 768 * 1024;
constexpr int CW_TMO = 0, CW_BAR = 4096, CW_Q = 8192;
constexpr size_t CTL_SSQ = 256 * 1024, CTL_SSKV = CTL_SSQ + 131072, CTL_SS1 = CTL_SSKV + 131072, CTL_SS2 = CTL_SS1 + 131072;
constexpr size_t WS_WIN = 1 * MiB, WS_WQB = 6 * MiB, WS_WKVB = 6 * MiB + 512 * 1024, WS_WOUT = 7 * MiB, WS_WMQ = 9 * MiB, WS_WMK = 11 * MiB, WS_WMV = 13 * MiB, WS_WMO = 15 * MiB;
constexpr size_t WS_ROPE = 17 * MiB, WS_MEMN = 19 * MiB, WS_KMEM = 21 * MiB, WS_VMEMT = 23 * MiB, WS_GSC = 25 * MiB, WS_DEC = 28 * MiB, WS_AFF = 29 * MiB, WS_SEL = 30 * MiB;
constexpr size_t WS_PROJ = 32 * MiB, WS_XN = 112 * MiB, WS_QC = 112 * MiB, WS_KC = 128 * MiB, WS_QM = 144 * MiB, WS_KM = 168 * MiB, WS_VM = 192 * MiB, WS_HF = 208 * MiB, WS_HB = 224 * MiB, WS_Y = 240 * MiB;
#ifndef X2MODE
#define X2MODE 4
#endif
constexpr size_t WS_X1 = 112 * MiB, WS_X1B = 176 * MiB, WS_QMEM = 208 * MiB, WS_P = 240 * MiB, WS_MO = 112 * MiB, WS_X2 = (X2MODE == 4 ? 384 : 208) * MiB, WS_X2B = 208 * MiB, WS_HID = 32 * MiB;
constexpr size_t WS_DUMMY = 304 * MiB;
constexpr size_t WS_X2F = 256 * MiB;
constexpr size_t WS_WEGU = 320 * MiB, WS_WED = 448 * MiB, WS_END = 512 * MiB;
constexpr int PROJ_LD = 2560;
constexpr int PC_CQ = 2048, PC_CKV = 2304, PC_KR = 2432, PC_G = 2464;
constexpr int RING_BYTES = 131072, LDSCTL_OFF = 133120, LDS_BYTES = 147456;

struct Args { const void* in[26]; float* out; unsigned char* ws; int ph_lo, ph_hi, flags, pad; };

struct Frame {
  LAS unsigned char* lds; volatile LAS unsigned* MISC; gu32* ctl; unsigned char* ws;
  int tid, lane, wave, vcu, G;
};

__device__ __forceinline__ void p0_tr(const float* W, int ldw, int k0, int kvalid, int scol0, int ncols, const float* gs, bf16* WT, int ldt, int drow0, LAS float* scr, int lane, bool doq = false) {
  const int c4 = (lane & 15) * 4, kr = lane >> 4;
  f32x4 v[16];
#pragma unroll
  for (int i = 0; i < 16; ++i) { const int kk = 4 * i + kr; v[i] = (f32x4){0.f, 0.f, 0.f, 0.f};
    if (c4 < ncols && k0 + kk < kvalid) { v[i] = *(const f32x4*)(W + (size_t)(k0 + kk) * ldw + scol0 + c4); if (gs) v[i] = v[i] * gs[k0 + kk];
      if (doq) { v[i].x = q8(v[i].x, 64.f); v[i].y = q8(v[i].y, 64.f); v[i].z = q8(v[i].z, 64.f); v[i].w = q8(v[i].w, 64.f); } } }
#pragma unroll
  for (int i = 0; i < 16; ++i) { const int kk = 4 * i + kr; LAS float* d = scr + kk * 65 + c4; d[0] = v[i].x; d[1] = v[i].y; d[2] = v[i].z; d[3] = v[i].w; }
  LDS_WAIT(); asm volatile("" ::: "memory");
  const int c = lane & 7;
#pragma unroll
  for (int j = 0; j < 8; ++j) { const int n = (lane >> 3) + 8 * j; const LAS float* s = scr + (8 * c) * 65 + n;
    v4u o; o.x = pk2(s[0 * 65], s[1 * 65]); o.y = pk2(s[2 * 65], s[3 * 65]); o.z = pk2(s[4 * 65], s[5 * 65]); o.w = pk2(s[6 * 65], s[7 * 65]);
    *(GAS v4u*)(WT + (size_t)(drow0 + n) * ldt + k0 + 8 * c) = o; }
  LDS_WAIT(); asm volatile("" ::: "memory");
}
struct ConvDesc { const float* W; const float* gs; unsigned char* WT8; int ldw, k0, scol0, ldt, drow0; float sc; };
__device__ __forceinline__ void p0_tr8_load(const ConvDesc& d, f32x4 (&v)[16], int lane) {
  const int c4 = (lane & 15) * 4, kr = lane >> 4;
#pragma unroll
  for (int i = 0; i < 16; ++i) { const int kk = 16 * kr + i; v[i] = *(const f32x4*)(d.W + (size_t)(d.k0 + kk) * d.ldw + d.scol0 + c4); }
}
__device__ __forceinline__ void p0_tr8_finish(const ConvDesc& d, f32x4 (&v)[16], float sc, LAS float* scr, int lane) {
  (void)scr; const int c4 = (lane & 15) * 4, kr = lane >> 4;
  if (d.gs) {
#pragma unroll
    for (int i = 0; i < 16; ++i) v[i] = v[i] * d.gs[d.k0 + 16 * kr + i]; }
#pragma unroll
  for (int j = 0; j < 4; ++j) { float f0[8], f1[8];
#pragma unroll
    for (int q = 0; q < 8; ++q) { f0[q] = v[q][j]; f1[q] = v[8 + q][j]; }
    const v2u a8 = pack8_fp8(f0, sc), b8 = pack8_fp8(f1, sc); v4u o; o.x = a8.x; o.y = a8.y; o.z = b8.x; o.w = b8.y;
    *(GAS v4u*)(d.WT8 + (size_t)(d.drow0 + c4 + j) * d.ldt + d.k0 + 16 * kr) = o; }
}
__device__ __forceinline__ void p0_tr32(const float* W, int ldw, int k0, int scol0, int ncols, const float* gs, bf16* WT, int ldt, int drow0, LAS float* scr, int lane) {
#pragma unroll 8
  for (int i = 0; i < 32; ++i) { const int kk = 2 * i + (lane >> 5), c = lane & 31; float v = 0.f;
    if (c < ncols) { v = W[(size_t)(k0 + kk) * ldw + scol0 + c]; if (gs) v *= gs[k0 + kk]; }
    scr[kk * 65 + c] = v; }
  LDS_WAIT(); asm volatile("" ::: "memory");
  const int c = lane & 7;
#pragma unroll
  for (int j = 0; j < 4; ++j) { const int n = (lane >> 3) + 8 * j; const LAS float* s = scr + (8 * c) * 65 + n;
    v4u o; o.x = pk2(s[0 * 65], s[1 * 65]); o.y = pk2(s[2 * 65], s[3 * 65]); o.z = pk2(s[4 * 65], s[5 * 65]); o.w = pk2(s[6 * 65], s[7 * 65]);
    *(GAS v4u*)(WT + (size_t)(drow0 + n) * ldt + k0 + 8 * c) = o; }
  LDS_WAIT(); asm volatile("" ::: "memory");
}
__device__ __forceinline__ void rms_row_to_bf16(const float* xrow, bf16* orow, int lane) {
  const GAS f32x4* xr = (const GAS f32x4*)xrow + lane;
  f32x4 v[4]; float s = 0.f;
#pragma unroll
  for (int j = 0; j < 4; ++j) { v[j] = xr[64 * j]; s += (v[j].x * v[j].x + v[j].y * v[j].y) + (v[j].z * v[j].z + v[j].w * v[j].w); }
  const float rstd = rsqrtf(wave_sum(s) * (1.f / 1024.f) + 1e-6f);
  GAS unsigned long long* o8 = (GAS unsigned long long*)orow + lane;
#pragma unroll
  for (int j = 0; j < 4; ++j) o8[64 * j] = (unsigned long long)pk2(v[j].x * rstd, v[j].y * rstd) | ((unsigned long long)pk2(v[j].z * rstd, v[j].w * rstd) << 32);
}

#ifndef FP8EMU
#define FP8EMU 0
#endif
#ifndef MOE_FP8
#define MOE_FP8 1
#endif
#ifndef CONV_NT
#define CONV_NT 0
#endif
#ifndef MEMATTN_FUSED
#define MEMATTN_FUSED 1
#endif
#ifndef UPGEMM_IN_P2
#define UPGEMM_IN_P2 1
#endif
#ifndef ATTN_BODY
#define ATTN_BODY 2
#endif
#ifndef MOE_GATHER_GEMM
#define MOE_GATHER_GEMM 1
#endif
#ifndef MOE_FP8_DOWN
#define MOE_FP8_DOWN MOE_FP8
#endif
constexpr size_t WS_PO = 384 * MiB, WS_PML = 272 * MiB;
constexpr size_t WS_XG = 96 * MiB;
constexpr size_t WS_X2Q = 208 * MiB, WS_WEGU8 = 320 * MiB, WS_WED8 = 448 * MiB, WS_HID8 = 32 * MiB;
constexpr int CW_RDY = 8192 + 64 * 44;
constexpr int CW_CONV = 8192 + 64 * 40, CW_MDONE = 8192 + 64 * 41, CW_TDONE = 8192 + 64 * 42;
constexpr int CONV_IGU = 16 * 64, CONV_ID = 32 * 16, CONV_ITEMS = NEXP * (CONV_IGU + CONV_ID), CONV_CHUNKS = CONV_ITEMS / 8;
__device__ __forceinline__ ConvDesc conv_desc(Frame& F, const Args& a, int it) {
  auto I = [&](int i) { return (const float*)a.in[i]; };
  unsigned char* ws = F.ws; ConvDesc d;
  const int e = it / (CONV_IGU + CONV_ID); int r = it % (CONV_IGU + CONV_ID);
  d.sc = 64.f;
  if (r < CONV_IGU) { const int kb = r / 64, nb = r % 64, p = nb >> 2, j0 = (nb & 3) * 64; const bool up = j0 >= 128; if (up) d.sc = 512.f;
    d.W = (up ? I(I_WEU) : I(I_WEG)) + (size_t)e * 1024 * 2048; d.ldw = 2048; d.k0 = 64 * kb; d.scol0 = 128 * p + (up ? j0 - 128 : j0); d.gs = I(I_GFFN); d.WT8 = ws + WS_WEGU8 + (size_t)e * 4096 * 1024; d.ldt = 1024; d.drow0 = 64 * nb; }
  else { r -= CONV_IGU; const int kb = r / 16, nb = r % 16;
    d.W = I(I_WED) + (size_t)e * 2048 * 1024; d.ldw = 1024; d.k0 = 64 * kb; d.scol0 = 64 * nb; d.gs = nullptr; d.WT8 = ws + WS_WED8 + (size_t)e * 1024 * 2048; d.ldt = 2048; d.drow0 = 64 * nb; }
  return d;
}
__device__ __forceinline__ void conv_fill(Frame& F, const Args& a, int maxpairs, unsigned limit = (unsigned)CONV_CHUNKS) {
  static_assert(MOE_FP8 && MOE_FP8_DOWN, "the conversion filler writes fp8 expert weights");
  volatile LAS int* slot = (volatile LAS int*)(F.lds + LDSCTL_OFF + 16);
  LAS float* scr = (LAS float*)(F.lds + F.wave * 16640);
  for (int n = 0; n < maxpairs; ++n) {
    if (F.tid == 0) { int got = -1;
      if (__hip_atomic_load(F.ctl + CW_CONV, RLX_AGENT) < limit) { const unsigned c = __hip_atomic_fetch_add(F.ctl + CW_CONV, 2u, RLX_AGENT); if (c < (unsigned)CONV_CHUNKS) got = (int)c; }
      *slot = got; }
    __syncthreads();
    const int c = __builtin_amdgcn_readfirstlane(*slot);
    __syncthreads();
    if (c < 0) break;
    const ConvDesc d0 = conv_desc(F, a, c * 8 + F.wave), d1 = conv_desc(F, a, (c + 1) * 8 + F.wave);
    f32x4 v0[16], v1[16];
    p0_tr8_load(d0, v0, F.lane); p0_tr8_load(d1, v1, F.lane);
    p0_tr8_finish(d0, v0, d0.sc, scr, F.lane); p0_tr8_finish(d1, v1, d1.sc, scr, F.lane);
  }
}
__device__ __forceinline__ void p0_prologue(Frame& F, const Args& a, bool do_dense, bool do_experts) {
  LAS float* scr = (LAS float*)(F.lds + F.wave * 16640);
  const int gw = F.vcu * NWAVES + F.wave, NGW = F.G * NWAVES;
  auto I = [&](int i) { return (const float*)a.in[i]; };
  unsigned char* ws = F.ws;
  if (do_dense) {
    constexpr int I_WIN_ = 16 * 40, I_WQB_ = 4 * 12, I_WKVB_ = 4 * 16, I_SQ = 16 * 16;
    constexpr int NIT = I_WIN_ + I_WQB_ + I_WKVB_ + 5 * I_SQ;
    for (int it = gw; it < NIT; it += NGW) {
      int r = it;
      if (r < I_WIN_) { const int kb = r / 40, nb = r % 40; int sc, nc = 64;
        if (nb < 32) sc = 64 * nb; else if (nb < 36) sc = OFF_CQ + 64 * (nb - 32); else if (nb < 38) sc = OFF_CKV + 64 * (nb - 36); else if (nb == 38) { sc = OFF_KR; nc = 32; } else { sc = 0; nc = 0; }
        p0_tr(I(I_WIN), D_IN, 64 * kb, 1024, sc, nc, I(I_GMIX), (bf16*)(ws + WS_WIN), 1024, 64 * nb, scr, F.lane);
        if (nb == 38) p0_tr32(I(I_WIN), D_IN, 64 * kb, OFF_G, 16, I(I_GMIX), (bf16*)(ws + WS_WIN), 1024, PC_G, scr, F.lane);
        continue; } r -= I_WIN_;
      if (r < I_WQB_) { const int kb = r / 12, nb = r % 12; p0_tr(I(I_WQB), 768, 64 * kb, 256, 64 * nb, 64, I(I_GQA), (bf16*)(ws + WS_WQB), 256, 64 * nb, scr, F.lane); continue; } r -= I_WQB_;
      if (r < I_WKVB_) { const int kb = r / 16, nb = r % 16; const int h = nb & 7; const int sc = h * 128 + (nb >= 8 ? 64 : 0);
        p0_tr(I(I_WKVB), 1024, 64 * kb, 128, sc, 64, I(I_GKVA), (bf16*)(ws + WS_WKVB), 256, 64 * nb, scr, F.lane); continue; } r -= I_WKVB_;
      const int which = r / I_SQ; r %= I_SQ; const int kb = r / 16, nb = r % 16;
      const float* src = which == 0 ? I(I_WOUT) : which == 1 ? I(I_WMQ) : which == 2 ? I(I_WMK) : which == 3 ? I(I_WMV) : I(I_WMO);
      const float* gs = which == 1 ? I(I_GMX) : (which == 2 || which == 3) ? I(I_GMKV) : nullptr;
      bf16* dst = (bf16*)(ws + (which == 0 ? WS_WOUT : which == 1 ? WS_WMQ : which == 2 ? WS_WMK : which == 3 ? WS_WMV : WS_WMO));
      p0_tr(src, 1024, 64 * kb, 1024, 64 * nb, 64, gs, dst, 1024, 64 * nb, scr, F.lane);
    }
    for (int m0 = gw; m0 < MTOK; m0 += 4 * NGW) {
      f32x4 v[4][4];
#pragma unroll
      for (int u = 0; u < 4; ++u) { const GAS f32x4* xr = (const GAS f32x4*)(I(I_X) + (size_t)(m0 + u * NGW) * 1024) + F.lane;
#pragma unroll
        for (int j = 0; j < 4; ++j) v[u][j] = __builtin_nontemporal_load(xr + 64 * j); }
#pragma unroll
      for (int u = 0; u < 4; ++u) { float s = 0.f;
#pragma unroll
        for (int j = 0; j < 4; ++j) s += (v[u][j].x * v[u][j].x + v[u][j].y * v[u][j].y) + (v[u][j].z * v[u][j].z + v[u][j].w * v[u][j].w);
        const float rstd = rsqrtf(wave_sum(s) * (1.f / 1024.f) + 1e-6f);
        GAS unsigned long long* o8 = (GAS unsigned long long*)((bf16*)(ws + WS_XN) + (size_t)(m0 + u * NGW) * 1024) + F.lane;
#pragma unroll
        for (int j = 0; j < 4; ++j) o8[64 * j] = (unsigned long long)pk2(v[u][j].x * rstd, v[u][j].y * rstd) | ((unsigned long long)pk2(v[u][j].z * rstd, v[u][j].w * rstd) << 32); } }
    for (int m = gw; m < BATCH * NMEM; m += NGW) rms_row_to_bf16(I(I_MEM) + (size_t)m * 1024, (bf16*)(ws + WS_MEMN) + (size_t)m * 1024, F.lane);
    { const float* wr = I(I_WR); const float* gf = I(I_GFFN); float* wrg = (float*)(ws + WS_DEC + 65536);
      for (int i = (F.vcu * NTHR + F.tid); i < 1024 * 16; i += F.G * NTHR) wrg[i] = wr[i] * gf[i >> 4]; }
    { const int* pos = (const int*)a.in[I_POS]; float* rt = (float*)(ws + WS_ROPE);
      for (int i = (F.vcu * NTHR + F.tid); i < MTOK * 16; i += F.G * NTHR) { const int m = i >> 4, j = i & 15; const float inv = powf(10000.f, -(float)j / 16.f); const float ang = (float)pos[m] * inv;
        rt[m * 32 + j] = cosf(ang); rt[m * 32 + 16 + j] = sinf(ang); } }
  }
  if (do_experts) conv_fill(F, a, 1 << 30);
}

__device__ __forceinline__ v4u pack8(const float (&v)[8]) { v4u w; w.x = cvt_pk_bf16(v[0], v[1]); w.y = cvt_pk_bf16(v[2], v[3]); w.z = cvt_pk_bf16(v[4], v[5]); w.w = cvt_pk_bf16(v[6], v[7]); return w; }
__device__ __forceinline__ float sumsq8(const float (&v)[8]) { float s = 0.f;
#pragma unroll
  for (int i = 0; i < 8; ++i) s += v[i] * v[i];
  return s; }
struct EpiStore { static constexpr bool TWO_PASS = false; bf16* O; int ldc;
  __device__ __forceinline__ void row8(const pg8::Unit& u, int rloc, int cloc, const float (&v0)[8], const float (&v1)[8], int fq) const {
    bf16* p = O + (size_t)(u.pm * 256 + rloc) * ldc + u.pn * 256 + cloc; *(v4u*)p = pack8(v0); *(v4u*)(p + 128) = pack8(v1); } };
struct EpiProj { static constexpr bool TWO_PASS = false; bf16* P; SsAcc ssq; SsAcc sskv;
  __device__ __forceinline__ void row8(const pg8::Unit& u, int rloc, int cloc, const float (&v0)[8], const float (&v1)[8], int fq) const {
    const int row = u.pm * 256 + rloc; bf16* p = P + (size_t)row * PROJ_LD + u.pn * 256 + cloc; *(v4u*)p = pack8(v0); *(v4u*)(p + 128) = pack8(v1);
    if (u.pn == 8) { float s = sumsq8(v0) + sumsq8(v1); s += __shfl_xor(s, 16); s += __shfl_xor(s, 32); if (fq == 0) ssq.add(row, s); }
    if (u.pn == 9) { float s = sumsq8(v0); s += __shfl_xor(s, 16); s += __shfl_xor(s, 32); if (fq == 0) sskv.add(row, s); } } };
struct EpiQ { static constexpr bool TWO_PASS = false; bf16* Q; SsAcc ssq; const float* rope;
  __device__ __forceinline__ void rope8(float (&v)[8], int row, int fq) const {
    float pv[8];
#pragma unroll
    for (int i = 0; i < 8; ++i) pv[i] = __shfl_xor(v[i], 32);
    const float* cs = rope + (size_t)row * 32 + 8 * (fq & 1);
#pragma unroll
    for (int i = 0; i < 8; ++i) { const float c = cs[i], s = cs[16 + i]; v[i] = (fq < 2) ? (v[i] * c - pv[i] * s) : (v[i] * c + pv[i] * s); }
  }
  __device__ __forceinline__ void row8(const pg8::Unit& u, int rloc, int cloc, const float (&a0)[8], const float (&a1)[8], int fq) const {
    const int row = u.pm * 256 + rloc; const float r = rsqrtf(ssq[row] * (1.f / 256.f) + 1e-6f) * (ATTN_BODY == 2 ? 0.10206207261596575f * 1.4426950408889634f : 1.f);
    float v0[8], v1[8];
#pragma unroll
    for (int i = 0; i < 8; ++i) { v0[i] = a0[i] * r; v1[i] = a1[i] * r; }
    const int g0 = u.pn * 8 + (cloc >> 5), g1 = g0 + 4;
    if (g0 % 3 == 2) rope8(v0, row, fq);
    if (g1 % 3 == 2) rope8(v1, row, fq);
    bf16* p = Q + (size_t)row * 768 + u.pn * 256 + cloc; *(v4u*)p = pack8(v0); *(v4u*)(p + 128) = pack8(v1); } };
struct EpiKV { static constexpr bool TWO_PASS = false; bf16* KMp; bf16* VMp; SsAcc sskv;
  __device__ __forceinline__ void put(int row, int c, const float (&v)[8], float r) const {
    float w[8];
#pragma unroll
    for (int i = 0; i < 8; ++i) w[i] = v[i] * r;
    if (c < 512) *(v4u*)(KMp + (size_t)row * 768 + (c >> 6) * 96 + (c & 63)) = pack8(w); else *(v4u*)(VMp + (size_t)row * 512 + (c - 512)) = pack8(w); }
  __device__ __forceinline__ void row8(const pg8::Unit& u, int rloc, int cloc, const float (&a0)[8], const float (&a1)[8], int fq) const {
    const int row = u.pm * 256 + rloc; const float r = rsqrtf(sskv[row] * (1.f / 128.f) + 1e-6f);
    put(row, u.pn * 256 + cloc, a0, r); put(row, u.pn * 256 + 128 + cloc, a1, r); } };

__device__ __forceinline__ void unpack8(v4u w, float (&f)[8]) { f[0] = bflo(w.x); f[1] = bfhi(w.x); f[2] = bflo(w.y); f[3] = bfhi(w.y); f[4] = bflo(w.z); f[5] = bfhi(w.z); f[6] = bflo(w.w); f[7] = bfhi(w.w); }
__device__ __forceinline__ float log_sigmoid(float x) { return fminf(x, 0.f) - log1pf(__expf(-fabsf(x))); }

__device__ __forceinline__ void p2_elementwise(Frame& F, const Args& a) {
  unsigned char* ws = F.ws;
  const bf16* P = (const bf16*)(ws + WS_PROJ);
  { const float* cw = (const float*)a.in[I_CONV]; bf16* QC = (bf16*)(ws + WS_QC); bf16* KC = (bf16*)(ws + WS_KC);
    const int gi = F.vcu * NTHR + F.tid, c = (gi & 127) * 8, mstep = (F.G * NTHR) >> 7; float w0[8], w1[8], w2[8];
#pragma unroll
    for (int j = 0; j < 8; ++j) { w0[j] = cw[c + j]; w1[j] = cw[1024 + c + j]; w2[j] = cw[2048 + c + j]; }
    for (int m0 = gi >> 7; m0 < MTOK; m0 += 2 * mstep) {
      v4u r0[2], r1[2], r2[2];
#pragma unroll
      for (int u = 0; u < 2; ++u) { const int m = m0 + u * mstep, t = m & (SEQ - 1); const bf16* pr = P + (size_t)m * PROJ_LD + c;
        r1[u] = *(const v4u*)pr; r0[u] = t > 0 ? *(const v4u*)(pr - PROJ_LD) : (v4u){0u, 0u, 0u, 0u}; r2[u] = t < SEQ - 1 ? *(const v4u*)(pr + PROJ_LD) : (v4u){0u, 0u, 0u, 0u}; }
#pragma unroll
      for (int u = 0; u < 2; ++u) { const int m = m0 + u * mstep; float x0[8], x1[8], x2[8], o[8]; unpack8(r0[u], x0); unpack8(r1[u], x1); unpack8(r2[u], x2);
#pragma unroll
        for (int j = 0; j < 8; ++j) { float v = x0[j] * w0[j] + x1[j] * w1[j] + x2[j] * w2[j]; v = v * sigmoidf_(v); o[j] = (c < 512) ? v : v * 0.08838834764831845f; }
        if (c < 512) *(v4u*)(QC + (size_t)m * 512 + c) = pack8(o); else *(v4u*)(KC + (size_t)m * 512 + c - 512) = pack8(o); } } }
  { const float* rope = (const float*)(ws + WS_ROPE); bf16* KMp = (bf16*)(ws + WS_KM);
    for (int i = F.vcu * NTHR + F.tid; i < MTOK * 16; i += F.G * NTHR) { const int m = i >> 4, j = i & 15;
      const float t1 = bf2f(P[(size_t)m * PROJ_LD + PC_KR + j]), t2 = bf2f(P[(size_t)m * PROJ_LD + PC_KR + 16 + j]); const float c = rope[m * 32 + j], s = rope[m * 32 + 16 + j];
      const bf16 o1 = (bf16)f2bf(t1 * c - t2 * s), o2 = (bf16)f2bf(t2 * c + t1 * s);
#pragma unroll
      for (int h = 0; h < 8; ++h) { KMp[(size_t)m * 768 + h * 96 + 64 + j] = o1; KMp[(size_t)m * 768 + h * 96 + 80 + j] = o2; } } }
  { const float* bg = (const float*)a.in[I_BG]; float* GSC = (float*)(ws + WS_GSC); float* DEC = (float*)(ws + WS_DEC);
    const int gw = F.vcu * NWAVES + F.wave, NGW = F.G * NWAVES;
    for (int it = gw; it < 32 * 64; it += NGW) { const int seq = it >> 6, c = it & 63, dir = seq & 1, h = (seq >> 1) & 3, b = seq >> 3;
      const int p = c * 64 + F.lane, t = dir ? (SEQ - 1 - p) : p; const size_t row = (size_t)b * SEQ + t;
      const int gi = (dir ? 8 : 0) + h, gf = (dir ? 12 : 4) + h;
      const float li = bf2f(P[row * PROJ_LD + PC_G + gi]) + bg[gi]; const float lf = log_sigmoid(bf2f(P[row * PROJ_LD + PC_G + gf]) + bg[gf]);
      float bs = lf;
#pragma unroll
      for (int o = 1; o < 64; o <<= 1) { const float y = __shfl_up(bs, o); if (F.lane >= o) bs += y; }
      const float av = li - bs; float pm = av;
#pragma unroll
      for (int o = 1; o < 64; o <<= 1) { const float y = __shfl_up(pm, o); if (F.lane >= o) pm = fmaxf(pm, y); }
      float* gs = GSC + (size_t)seq * 3 * SEQ; gs[p] = bs; gs[SEQ + p] = av; gs[2 * SEQ + p] = pm;
      if (F.lane == 63) { DEC[seq * 128 + c] = bs; DEC[seq * 128 + 64 + c] = pm; } } }
}
#ifndef ATTN_BODY
#define ATTN_BODY 2
#endif
namespace mla {
constexpr int DQK = 96, DV = 64, NW = 8, QBLK = 32, KVBLK = 64, LDQ = 768, LDK = 768, LDV = 512, LDO = 1024;
constexpr float SCALE = 0.10206207261596575f;
constexpr float THR = 8.f;
constexpr int SHM_V = 16384, SHM_K = 16384, SHM_ATTN = 2 * SHM_V + 2 * SHM_K + NW * 64 * 4;
#define KSWZ(row, colB) ((row) * 256 + ((colB) ^ (((row) & 7) << 4)))
#define SBAR() __builtin_amdgcn_sched_barrier(0)
__device__ __forceinline__ int crow(int r, int hi) { return (r & 3) + 8 * (r >> 2) + 4 * hi; }
__device__ __forceinline__ void partialSM(f32x16& p0, f32x16& p1, float& m_reg, float& mn, float& alpha) {
  constexpr float C = SCALE * 1.4426950408889634f;
  float pmax = p0[0];
#pragma unroll
  for (int r = 1; r < 16; ++r) pmax = fmaxf(pmax, p0[r]);
#pragma unroll
  for (int r = 0; r < 16; ++r) pmax = fmaxf(pmax, p1[r]);
  { auto rr = __builtin_amdgcn_permlane32_swap(__float_as_uint(pmax), __float_as_uint(pmax), false, false);
    pmax = fmaxf(__uint_as_float(rr[0]), __uint_as_float(rr[1])); }
  if (__builtin_expect(__all(pmax - m_reg <= THR / SCALE), 1)) { mn = m_reg; alpha = 1.f; }
  else { mn = fmaxf(m_reg, pmax); alpha = __builtin_amdgcn_exp2f((m_reg - mn) * C); m_reg = mn; }
  const float mnC = -mn * C;
#pragma unroll
  for (int r = 0; r < 16; ++r) p0[r] = fmaf(p0[r], C, mnC);
#pragma unroll
  for (int r = 0; r < 16; ++r) p1[r] = fmaf(p1[r], C, mnC);
#pragma unroll
  for (int r = 0; r < 16; ++r) p0[r] = __builtin_amdgcn_exp2f(p0[r]);
}
__device__ __forceinline__ void finishSM(f32x16& p0, f32x16& p1, float alpha, float& l_reg, bf16x8& pa0, bf16x8& pa1, bf16x8& pa2, bf16x8& pa3) {
#pragma unroll
  for (int r = 0; r < 16; ++r) p1[r] = __builtin_amdgcn_exp2f(p1[r]);
  float ps = 0;
#pragma unroll
  for (int r = 0; r < 16; ++r) ps += p0[r];
#pragma unroll
  for (int r = 0; r < 16; ++r) ps += p1[r];
  { auto rr = __builtin_amdgcn_permlane32_swap(__float_as_uint(ps), __float_as_uint(ps), false, false);
    ps = __uint_as_float(rr[0]) + __uint_as_float(rr[1]); }
  l_reg = l_reg * alpha + ps;
#define PK4(P, BASE, OUT) do { unsigned a0 = cvt_pk_bf16(P[BASE + 0], P[BASE + 1]), a1 = cvt_pk_bf16(P[BASE + 2], P[BASE + 3]);   \
    unsigned b0 = cvt_pk_bf16(P[BASE + 4], P[BASE + 5]), b1 = cvt_pk_bf16(P[BASE + 6], P[BASE + 7]);                              \
    auto r0 = __builtin_amdgcn_permlane32_swap(a0, b0, false, false); auto r1 = __builtin_amdgcn_permlane32_swap(a1, b1, false, false); \
    v4u w = {r0[0], r1[0], r0[1], r1[1]}; OUT = __builtin_bit_cast(bf16x8, w); } while (0)
  PK4(p0, 0, pa0); PK4(p0, 8, pa1); PK4(p1, 0, pa2); PK4(p1, 8, pa3);
#undef PK4
}
__device__ __forceinline__ void qkt(f32x16& p0, f32x16& p1, const char* Ks, const bf16x8* qr, int r32, int hi) {
  p0 = f32x16{}; p1 = f32x16{};
#pragma unroll
  for (int d0 = 0; d0 < DQK / 16; ++d0) { const int cb = (d0 * 16 + hi * 8) * 2;
    const bf16x8 b0 = *reinterpret_cast<const bf16x8*>(Ks + KSWZ(r32, cb));
    const bf16x8 b1 = *reinterpret_cast<const bf16x8*>(Ks + KSWZ(32 + r32, cb));
    p0 = __builtin_amdgcn_mfma_f32_32x32x16_bf16(b0, qr[d0], p0, 0, 0, 0);
    p1 = __builtin_amdgcn_mfma_f32_32x32x16_bf16(b1, qr[d0], p1, 0, 0, 0); }
}
__device__ __forceinline__ int v_st(int k, int c) { const int kk = (k & ~0xC) | ((k & 4) << 1) | ((k & 8) >> 1); return ((kk >> 3) * 4 + (c >> 5)) * 512 + ((kk & 7) * 32 + (c & 31)) * 2; }
__device__ __forceinline__ int v_rd_base(int lane) { return ((lane & 3) << 3) | (((lane >> 2) & 3) << 6) | (((lane >> 4) & 1) << 5) | (((lane >> 5) & 1) << 8); }
constexpr int v_rd_off(int d0, int ks, int half) { return d0 * 512 + ks * 4096 + half * 2048; }
template <int OFF> __device__ __forceinline__ s16x4 tr_read(int vb) {
  s16x4 r; asm volatile("ds_read_b64_tr_b16 %0, %1 offset:%2" : "=&v"(r) : "v"(vb), "i"(OFF) : "memory"); return r;
}
template <int D0> __device__ __forceinline__ void pv_one(f32x16& od, int vb, bf16x8 pa0, bf16x8 pa1, bf16x8 pa2, bf16x8 pa3) {
  const s16x4 l0 = tr_read<v_rd_off(D0, 0, 0)>(vb), h0 = tr_read<v_rd_off(D0, 0, 1)>(vb), l1 = tr_read<v_rd_off(D0, 1, 0)>(vb), h1 = tr_read<v_rd_off(D0, 1, 1)>(vb);
  const s16x4 l2 = tr_read<v_rd_off(D0, 2, 0)>(vb), h2 = tr_read<v_rd_off(D0, 2, 1)>(vb), l3 = tr_read<v_rd_off(D0, 3, 0)>(vb), h3 = tr_read<v_rd_off(D0, 3, 1)>(vb);
  asm volatile("s_waitcnt lgkmcnt(0)" ::: "memory"); SBAR();
#define PK(L, H) (bf16x8){L[0], L[1], L[2], L[3], H[0], H[1], H[2], H[3]}
  od = __builtin_amdgcn_mfma_f32_32x32x16_bf16(pa0, PK(l0, h0), od, 0, 0, 0);
  od = __builtin_amdgcn_mfma_f32_32x32x16_bf16(pa1, PK(l1, h1), od, 0, 0, 0);
  od = __builtin_amdgcn_mfma_f32_32x32x16_bf16(pa2, PK(l2, h2), od, 0, 0, 0);
  od = __builtin_amdgcn_mfma_f32_32x32x16_bf16(pa3, PK(l3, h3), od, 0, 0, 0);
#undef PK
}
__device__ __forceinline__ void pv_d0(f32x16* o, int vb, bf16x8 pa0, bf16x8 pa1, bf16x8 pa2, bf16x8 pa3) {
  pv_one<0>(o[0], vb, pa0, pa1, pa2, pa3); pv_one<1>(o[1], vb, pa0, pa1, pa2, pa3);
}
constexpr int LDP = 8 * 64, LDML = 8 * 2;
__device__ __forceinline__ void attn_unit(const bf16* __restrict__ Qb, const bf16* __restrict__ Kh, const bf16* __restrict__ Vh, bf16* __restrict__ Op, float* __restrict__ MLp, int seq, char* lds) {
  int tid = threadIdx.x; asm volatile("" : "+v"(tid));
  const int wid = tid >> 6, lane = tid & 63, r32 = lane & 31, hi = lane >> 5;
  char* V_lds = lds; char* K_lds = lds + 2 * SHM_V;
  float* wsf = (float*)(lds + 2 * SHM_V + 2 * SHM_K) + wid * 64; float* li_l = wsf; float* al_l = wsf + 32;
  float m_reg = -1e30f, l_reg = 0; f32x16 o[2] = {}; bf16x8 qr[DQK / 16];
  const bf16* Qw = Qb + (long)(wid * QBLK + r32) * LDQ + hi * 8;
#pragma unroll
  for (int d0 = 0; d0 < DQK / 16; ++d0) qr[d0] = *reinterpret_cast<const bf16x8*>(Qw + d0 * 16);
  const int sr = tid >> 4, sc = (tid & 15) * 8, vst0 = v_st(sr, sc & 63), vst1 = v_st(32 + sr, sc & 63);
  const bool doK = sc < DQK, doV = sc < DV;
  const int vb0 = (int)(uintptr_t)V_lds + v_rd_base(lane);
  struct { bf16x8 vs0, vs1, ks0, ks1; } sr_[2];
#define SLOAD(i, k0) do { if (doV) { sr_[i].vs0 = *reinterpret_cast<const bf16x8*>(&Vh[(long)((k0) + sr) * LDV + sc]); sr_[i].vs1 = *reinterpret_cast<const bf16x8*>(&Vh[(long)((k0) + 32 + sr) * LDV + sc]); } \
    if (doK) { sr_[i].ks0 = *reinterpret_cast<const bf16x8*>(&Kh[(long)((k0) + sr) * LDK + sc]); sr_[i].ks1 = *reinterpret_cast<const bf16x8*>(&Kh[(long)((k0) + 32 + sr) * LDK + sc]); } } while (0)
#define SWRITE(b, i) do { if (doV) { *(bf16x8*)(V_lds + (b) * SHM_V + vst0) = sr_[i].vs0; *(bf16x8*)(V_lds + (b) * SHM_V + vst1) = sr_[i].vs1; } \
    if (doK) { const int kc = sc * 2; *(bf16x8*)(K_lds + (b) * SHM_K + KSWZ(sr, kc)) = sr_[i].ks0; *(bf16x8*)(K_lds + (b) * SHM_K + KSWZ(32 + sr, kc)) = sr_[i].ks1; } } while (0)
#define SWAIT() asm volatile("s_waitcnt vmcnt(4)" ::: "memory")
#define RESC(a) do { if (__any((a) < 1.f)) { if (hi == 0) al_l[r32] = (a); asm volatile("s_waitcnt lgkmcnt(0)" ::: "memory"); \
    _Pragma("unroll") for (int d = 0; d < 2; ++d) _Pragma("unroll") for (int r = 0; r < 16; ++r) o[d][r] *= al_l[crow(r, hi)]; } } while (0)
  f32x16 pA0, pA1, pB0, pB1; float mnA, mnB, alA, alB; bf16x8 pa0, pa1, pa2, pa3; const int NT = seq / KVBLK;
  constexpr int SE = 0, SO = 1;
  SLOAD(SE, 0); asm volatile("s_waitcnt vmcnt(0)" ::: "memory"); SWRITE(0, SE); __syncthreads();
  qkt(pA0, pA1, K_lds, qr, r32, hi); partialSM(pA0, pA1, m_reg, mnA, alA);
  SLOAD(SO, KVBLK); if (2 < NT) SLOAD(SE, 2 * KVBLK);
  SWAIT(); SWRITE(1, SO); __syncthreads();
  for (int j = 1; j + 1 < NT; j += 2) {
    SBAR(); qkt(pB0, pB1, K_lds + SHM_K, qr, r32, hi);
    finishSM(pA0, pA1, alA, l_reg, pa0, pa1, pa2, pa3); SBAR();
    SLOAD(SO, (j + 2) * KVBLK); SBAR();
    pv_d0(o, vb0, pa0, pa1, pa2, pa3); partialSM(pB0, pB1, m_reg, mnB, alB);
    __syncthreads(); SWAIT(); SWRITE(0, SE);
    RESC(alB); __syncthreads();
    SBAR(); qkt(pA0, pA1, K_lds, qr, r32, hi);
    finishSM(pB0, pB1, alB, l_reg, pa0, pa1, pa2, pa3); SBAR();
    if (j + 3 < NT) SLOAD(SE, (j + 3) * KVBLK); SBAR();
    pv_d0(o, vb0 + SHM_V, pa0, pa1, pa2, pa3); partialSM(pA0, pA1, m_reg, mnA, alA);
    __syncthreads(); SWAIT(); SWRITE(1, SO);
    RESC(alA); __syncthreads();
  }
  SBAR(); qkt(pB0, pB1, K_lds + SHM_K, qr, r32, hi);
  finishSM(pA0, pA1, alA, l_reg, pa0, pa1, pa2, pa3); SBAR();
  pv_d0(o, vb0, pa0, pa1, pa2, pa3); partialSM(pB0, pB1, m_reg, mnB, alB);
  __syncthreads(); RESC(alB);
  finishSM(pB0, pB1, alB, l_reg, pa0, pa1, pa2, pa3); SBAR();
  pv_d0(o, vb0 + SHM_V, pa0, pa1, pa2, pa3);
  __syncthreads();
  { float* st = (float*)lds + wid * (32 * 68);
#pragma unroll
    for (int r = 0; r < 16; ++r) { const int orow = crow(r, hi); st[orow * 68 + r32] = o[0][r]; st[orow * 68 + 32 + r32] = o[1][r]; }
    asm volatile("s_waitcnt lgkmcnt(0)" ::: "memory");
    bf16* op = Op + (long)(wid * QBLK + r32) * LDP + hi * 32;
#pragma unroll
    for (int j = 0; j < 4; ++j) { const f32x4 x0 = *(const f32x4*)(st + r32 * 68 + hi * 32 + 8 * j), x1 = *(const f32x4*)(st + r32 * 68 + hi * 32 + 8 * j + 4);
      const float w[8] = {x0.x, x0.y, x0.z, x0.w, x1.x, x1.y, x1.z, x1.w}; *(v4u*)(op + 8 * j) = pack8(w); }
    if (hi == 0) { float* mp = MLp + (long)(wid * QBLK + r32) * LDML; mp[0] = m_reg; mp[1] = l_reg; } }
  __syncthreads();
#undef SLOAD
#undef SWRITE
#undef SWAIT
#undef RESC
}
#undef KSWZ
#undef SBAR
}


namespace mla2 {
constexpr int NW = 8, QBLK = 32, KVBLK = 64, LDQ = 768, LDK = 768, LDV = 512, NT = (SEQ / 2) / KVBLK;
constexpr float C2 = 0.10206207261596575f * 1.4426950408889634f;
constexpr float THR2 = 8.f;
constexpr int KSLOT = 12288, VSLOT = 8192, LDS_K = 0, LDS_V = 4 * KSLOT, LDS_WS = LDS_V + 3 * VSLOT, LDS_OST = LDS_WS + NW * 256, LDS_END = LDS_OST + NW * 4096;
static_assert(LDS_END <= LDSCTL_OFF, "attention LDS overlaps the control area");
#define SBAR() __builtin_amdgcn_sched_barrier(0)
#define PIN(x) asm volatile("" : "+v"(x))
#define MFMA(a, b, c) __builtin_amdgcn_mfma_f32_32x32x16_bf16(a, b, c, 0, 0, 0)
__device__ __forceinline__ int crow(int r, int hi) { return (r & 3) + 8 * (r >> 2) + 4 * hi; }
__device__ __forceinline__ void glds16(const void* g, unsigned lds_base) {
  unsigned sv; asm volatile("s_mov_b32 %0, m0\n\ts_mov_b32 m0, %2\n\ts_nop 0\n\tglobal_load_lds_dwordx4 %1, off\n\ts_mov_b32 m0, %0" : "=&s"(sv) : "v"(g), "s"(lds_base) : "memory"); }
typedef __attribute__((address_space(3))) const char* lds_cptr;
typedef short v4i16_t __attribute__((ext_vector_type(4)));
__device__ __forceinline__ void kload2(bf16x8* kf, lds_cptr kp, int d0) { kf[2 * d0] = *(const LAS bf16x8*)(kp + d0 * 2048); kf[2 * d0 + 1] = *(const LAS bf16x8*)(kp + d0 * 2048 + 512); }
__device__ __forceinline__ s16x4 vtr(lds_cptr p) { return __builtin_bit_cast(s16x4, __builtin_amdgcn_ds_read_tr16_b64_v4i16((LAS v4i16_t*)p)); }
#define MX3(a, b, c) __builtin_fmaxf(__builtin_fmaxf((a), (b)), (c))
__device__ __forceinline__ float rowmax(const f32x16& p0, const f32x16& p1) {
  float a = MX3(p0[0], p0[1], p1[0]), b = MX3(p0[2], p0[3], p1[1]); a = MX3(a, p1[2], p1[3]);
#pragma unroll
  for (int r = 4; r < 16; r += 4) { a = MX3(a, p0[r], p0[r + 1]); b = MX3(b, p0[r + 2], p0[r + 3]); a = MX3(a, p1[r], p1[r + 1]); b = MX3(b, p1[r + 2], p1[r + 3]); }
  float m = __builtin_fmaxf(a, b); auto rr = __builtin_amdgcn_permlane32_swap(__float_as_uint(m), __float_as_uint(m), false, false);
  return __builtin_fmaxf(__uint_as_float(rr[0]), __uint_as_float(rr[1])); }
constexpr int LDP = 8 * 64, LDML = 8 * 2;
__device__ __forceinline__ void attn_unit(const bf16* Qb, const bf16* __restrict__ Kh, const bf16* __restrict__ Vh, bf16* Op, float* MLp, char* lds) {
  int tid = threadIdx.x; asm volatile("" : "+v"(tid));
  const int lane = tid & 63, r32 = lane & 31, hi = lane >> 5; const int wid = __builtin_amdgcn_readfirstlane(tid >> 6);
  const bool kxw = wid < 4;
  const bf16* Qw = Qb + (long)(wid * QBLK) * LDQ;
  const unsigned lds0 = (unsigned)(uintptr_t)lds; float* wsf = (float*)(lds + LDS_WS) + wid * 64;
  const bf16* ksrc = Kh + (long)lane * LDK + wid * 8;
  const bf16* vsrc = Vh + (long)(16 * (wid & 3) + (lane >> 2)) * LDV + (wid >> 2) * 32 + (lane & 3) * 8;
  const unsigned kdst = lds0 + LDS_K + wid * 1024, vdst = lds0 + LDS_V + wid * 1024;
#define DMA_K(t, slot) do { glds16(ksrc + (long)(t) * KVBLK * LDK, (unsigned)__builtin_amdgcn_readfirstlane(kdst + (slot))); \
    if (kxw) glds16(ksrc + (long)(t) * KVBLK * LDK + 64, (unsigned)__builtin_amdgcn_readfirstlane(kdst + 8192 + (slot))); } while (0)
#define DMA_V(t, slot) glds16(vsrc + (long)(t) * KVBLK * LDV, (unsigned)__builtin_amdgcn_readfirstlane(vdst + (slot)))
#define WAIT_BAR_(N) asm volatile("s_waitcnt vmcnt(" #N ") lgkmcnt(0)\n\ts_barrier" ::: "memory")
#define WAIT_BAR2() do { if (kxw) WAIT_BAR_(3); else WAIT_BAR_(2); } while (0)
  const lds_cptr vp0 = (lds_cptr)lds + LDS_V + ((lane >> 4) & 1) * 32 + (lane & 3) * 8 + (4 * hi + ((lane & 15) >> 2)) * 64;
  const lds_cptr kp0 = (lds_cptr)lds + LDS_K + hi * 1024 + r32 * 16;
  DMA_K(0, 0); DMA_V(0, 0); DMA_K(1, KSLOT);
  bf16x8 qr[6];
#pragma unroll
  for (int d0 = 0; d0 < 6; ++d0) qr[d0] = *reinterpret_cast<const bf16x8*>(&Qw[(long)r32 * LDQ + d0 * 16 + hi * 8]);
  float mhat = 0.f, l_reg = 0.f; f32x16 o[2]; o[0] = f32x16{}; o[1] = f32x16{};
  f32x16 zero16 = f32x16{};
  f32x16 negm = f32x16{}; asm volatile("" : "+v"(negm));
  bool resc = false;
  f32x16 pA0, pA1, pB0, pB1; bf16x8 kf[8], kx[4]; s16x4 vlo[8], vhi[8]; v4u pw0, pw1, pw2, pw3;
  int sl_prev = 0, sl_cur = 0, sl_next = VSLOT;
  int ks0 = 0, ks1 = KSLOT, ks2 = 2 * KSLOT, ks3 = 3 * KSLOT;
#define ROT() do { sl_prev = sl_cur; sl_cur = sl_next; sl_next = (sl_next == 2 * VSLOT) ? 0 : sl_next + VSLOT; const int k_ = ks0; ks0 = ks1; ks1 = ks2; ks2 = ks3; ks3 = k_; } while (0)
#define EX(v) __builtin_amdgcn_exp2f(v)
#define RESC() do { if (resc) { _Pragma("unroll") for (int d_ = 0; d_ < 2; ++d_) _Pragma("unroll") for (int r = 0; r < 16; ++r) o[d_][r] *= wsf[crow(r, hi)]; } } while (0)
  DMA_K(2, 2 * KSLOT);
  if (kxw) WAIT_BAR_(2); else WAIT_BAR_(1);
  _Pragma("unroll") for (int d0 = 0; d0 < 4; ++d0) kload2(kf, kp0, d0);
  _Pragma("unroll") for (int d0 = 0; d0 < 2; ++d0) kload2(kx, kp0 + 8192, d0);
  pA0 = MFMA(kf[0], qr[0], zero16); pA1 = MFMA(kf[1], qr[0], zero16); pA0 = MFMA(kf[2], qr[1], pA0); pA1 = MFMA(kf[3], qr[1], pA1);
  pA0 = MFMA(kf[4], qr[2], pA0); pA1 = MFMA(kf[5], qr[2], pA1); pA0 = MFMA(kf[6], qr[3], pA0); pA1 = MFMA(kf[7], qr[3], pA1);
  pA0 = MFMA(kx[0], qr[4], pA0); pA1 = MFMA(kx[1], qr[4], pA1); pA0 = MFMA(kx[2], qr[5], pA0); pA1 = MFMA(kx[3], qr[5], pA1);
  { const float rm = rowmax(pA0, pA1); mhat = rm;
#pragma unroll
    for (int r = 0; r < 16; ++r) { pA0[r] = EX(pA0[r] - rm); pA1[r] = EX(pA1[r] - rm); }
#pragma unroll
    for (int r = 0; r < 16; ++r) negm[r] = -mhat;
    asm volatile("" : "+v"(negm)); }
  WAIT_BAR_(0);
  DMA_K(3, 3 * KSLOT); DMA_V(1, VSLOT); ROT();
  _Pragma("unroll") for (int d0 = 0; d0 < 4; ++d0) kload2(kf, kp0 + ks0, d0);
#define PKW(P, i) cvt_pk_bf16(P[i], P[i + 1])
#define PAF(k) __builtin_bit_cast(bf16x8, pw##k)
#define VFR(i) (bf16x8){vlo[i][0], vlo[i][1], vlo[i][2], vlo[i][3], vhi[i][0], vhi[i][1], vhi[i][2], vhi[i][3]}
#define VRD(i) do { vlo[i] = vtr(vp_ + (((i) >> 2) * 4096 + ((i) & 3) * 1024)); vhi[i] = vtr(vp_ + (((i) >> 2) * 4096 + ((i) & 3) * 1024 + 512)); } while (0)
#define KRD(G, d0) do { if (G) { kload2(kf, kp0 + ks1, d0); SBAR(); } } while (0)
#define GAP3(MF, a0, a1, a2, W0, PW) do { MF; sacc += a0; sacc += a1; sacc += a2; W0; PIN(PW); PIN(sacc); SBAR(); } while (0)
#define GAP2(MF, a0, a1, W0, W1, PW) do { MF; sacc += a0; sacc += a1; W0; W1; PIN(PW); PIN(sacc); SBAR(); } while (0)
#define GAP1(MF, a0, a1, W0, PW) do { MF; sacc += a0; sacc += a1; W0; PIN(PW); PIN(sacc); SBAR(); } while (0)
#define GAPB(MF, X, i) do { MF; X[i] = EX(X[i]); X[i + 1] = EX(X[i + 1]); X[i + 2] = EX(X[i + 2]); X[i + 3] = EX(X[i + 3]); PIN(X); SBAR(); } while (0)
#define STEP(C0, C1, P0, P1, t, GK, GV, GL) do { SBAR(); \
    const lds_cptr vp_ = vp0 + sl_prev; const lds_cptr kxp_ = kp0 + ks0 + 8192; \
    kload2(kx, kxp_, 0); VRD(0); SBAR(); float sacc = P0[0] + P0[1]; \
                               GAP3(C0 = MFMA(kf[0], qr[0], negm), P0[2], P0[3], P0[4],    pw0[0] = PKW(P0, 0), pw0); \
    kload2(kx, kxp_, 1); VRD(4); SBAR(); GAP3(C1 = MFMA(kf[1], qr[0], negm), P0[5], P0[6], P0[7],    pw0[1] = PKW(P0, 2), pw0); \
    VRD(1); SBAR(); GAP3(C0 = MFMA(kf[2], qr[1], C0), P0[8], P0[9], P0[10],   pw0[2] = PKW(P0, 4), pw0); \
    VRD(5); SBAR(); GAP3(C1 = MFMA(kf[3], qr[1], C1), P0[11], P0[12], P0[13], pw0[3] = PKW(P0, 6), pw0); \
    VRD(2); SBAR(); GAP3(C0 = MFMA(kf[4], qr[2], C0), P0[14], P0[15], P1[0],  pw1[0] = PKW(P0, 8), pw1); \
    VRD(6); SBAR(); GAP3(C1 = MFMA(kf[5], qr[2], C1), P1[1], P1[2], P1[3],    pw1[1] = PKW(P0, 10), pw1); \
    VRD(3); SBAR(); GAP2(C0 = MFMA(kf[6], qr[3], C0), P1[4], P1[5],   pw1[2] = PKW(P0, 12), pw1[3] = PKW(P0, 14), pw1); \
    VRD(7); SBAR(); GAP2(C1 = MFMA(kf[7], qr[3], C1), P1[6], P1[7],   pw2[0] = PKW(P1, 0),  pw2[1] = PKW(P1, 2),  pw2); \
                    GAP2(C0 = MFMA(kx[0], qr[4], C0), P1[8], P1[9],   pw2[2] = PKW(P1, 4),  pw2[3] = PKW(P1, 6),  pw2); \
                    GAP2(C1 = MFMA(kx[1], qr[4], C1), P1[10], P1[11], pw3[0] = PKW(P1, 8),  pw3[1] = PKW(P1, 10), pw3); \
                    GAP1(C0 = MFMA(kx[2], qr[5], C0), P1[12], P1[13], pw3[2] = PKW(P1, 12), pw3); \
                    GAP1(C1 = MFMA(kx[3], qr[5], C1), P1[14], P1[15], pw3[3] = PKW(P1, 14), pw3); \
    l_reg += sacc; \
    if (GK) DMA_K((t) + 3, ks3); if (GV) DMA_V((t) + 1, sl_next); \
    { const float rm = rowmax(C0, C1); resc = false;              \
      if (__builtin_expect(__any(rm > THR2), 0)) { const float dl = __builtin_fmaxf(rm, 0.f); mhat += dl; \
          _Pragma("unroll") for (int r = 0; r < 16; ++r) { C0[r] -= dl; C1[r] -= dl; } \
          _Pragma("unroll") for (int r = 0; r < 16; ++r) negm[r] = -mhat; \
          asm volatile("" : "+v"(negm)); \
          const float f = __builtin_amdgcn_exp2f(-dl); l_reg *= f; if (hi == 0) wsf[r32] = f; resc = true; } } \
    SBAR(); \
    GAPB(o[0] = MFMA(PAF(0), VFR(0), o[0]), C0, 0);              GAPB(o[1] = MFMA(PAF(0), VFR(4), o[1]), C0, 4); \
    KRD(GL, 0); GAPB(o[0] = MFMA(PAF(1), VFR(1), o[0]), C0, 8);  KRD(GL, 1); GAPB(o[1] = MFMA(PAF(1), VFR(5), o[1]), C0, 12); \
    KRD(GL, 2); GAPB(o[0] = MFMA(PAF(2), VFR(2), o[0]), C1, 0);  KRD(GL, 3); GAPB(o[1] = MFMA(PAF(2), VFR(6), o[1]), C1, 4); \
    GAPB(o[0] = MFMA(PAF(3), VFR(3), o[0]), C1, 8);              GAPB(o[1] = MFMA(PAF(3), VFR(7), o[1]), C1, 12); \
    } while (0)
  int t = 1;
#pragma unroll 1
  for (; t + 5 < NT; t += 2) {
    STEP(pB0, pB1, pA0, pA1, t, true, true, true);     WAIT_BAR2(); RESC(); ROT();
    STEP(pA0, pA1, pB0, pB1, t + 1, true, true, true); WAIT_BAR2(); RESC(); ROT();
  }
#define ENDW(tt) do { if ((tt) + 3 < NT) { WAIT_BAR2(); } else if ((tt) + 2 < NT) { WAIT_BAR_(1); } else { WAIT_BAR_(0); } } while (0)
#pragma unroll 1
  for (; t + 1 < NT; t += 2) {
    STEP(pB0, pB1, pA0, pA1, t, (t + 3 < NT), (t + 1 < NT), (t + 1 < NT));         ENDW(t);     RESC(); ROT();
    STEP(pA0, pA1, pB0, pB1, t + 1, (t + 4 < NT), (t + 2 < NT), (t + 2 < NT));     ENDW(t + 1); RESC(); ROT();
  }
  STEP(pB0, pB1, pA0, pA1, NT - 1, false, false, false); RESC();
  { float sacc = pB0[0] + pB0[1];
#pragma unroll
    for (int r = 2; r < 16; ++r) sacc += pB0[r];
#pragma unroll
    for (int r = 0; r < 16; ++r) sacc += pB1[r];
    l_reg += sacc;
    pw0 = (v4u){PKW(pB0, 0), PKW(pB0, 2), PKW(pB0, 4), PKW(pB0, 6)}; pw1 = (v4u){PKW(pB0, 8), PKW(pB0, 10), PKW(pB0, 12), PKW(pB0, 14)};
    pw2 = (v4u){PKW(pB1, 0), PKW(pB1, 2), PKW(pB1, 4), PKW(pB1, 6)}; pw3 = (v4u){PKW(pB1, 8), PKW(pB1, 10), PKW(pB1, 12), PKW(pB1, 14)};
    const lds_cptr vp_ = vp0 + sl_cur; _Pragma("unroll") for (int i = 0; i < 8; ++i) VRD(i);
    o[0] = MFMA(PAF(0), VFR(0), o[0]); o[1] = MFMA(PAF(0), VFR(4), o[1]); o[0] = MFMA(PAF(1), VFR(1), o[0]); o[1] = MFMA(PAF(1), VFR(5), o[1]);
    o[0] = MFMA(PAF(2), VFR(2), o[0]); o[1] = MFMA(PAF(2), VFR(6), o[1]); o[0] = MFMA(PAF(3), VFR(3), o[0]); o[1] = MFMA(PAF(3), VFR(7), o[1]); }
  { auto rr = __builtin_amdgcn_permlane32_swap(__float_as_uint(l_reg), __float_as_uint(l_reg), false, false); l_reg = __uint_as_float(rr[0]) + __uint_as_float(rr[1]); }
  if (hi == 0) { float* mp = MLp + (long)(wid * QBLK + r32) * LDML; mp[0] = mhat; mp[1] = l_reg; }
  bf16* Ow = Op + (long)(wid * QBLK) * LDP; bf16* stg = (bf16*)(lds + LDS_OST) + wid * 2048;
#pragma unroll
  for (int r = 0; r < 16; ++r) { const int orow = crow(r, hi);
#pragma unroll
    for (int d0 = 0; d0 < 2; ++d0) stg[orow * 64 + d0 * 32 + r32] = (bf16)f2bf(o[d0][r]); }
  asm volatile("s_waitcnt lgkmcnt(0)" ::: "memory");
#pragma unroll
  for (int i = 0; i < 4; ++i) { const int row = i * 8 + (lane >> 3), ch = lane & 7; *(v4u*)(Ow + (long)row * LDP + ch * 8) = *(const v4u*)(stg + row * 64 + ch * 8); }
  asm volatile("s_waitcnt lgkmcnt(0)\n\ts_barrier" ::: "memory");
#undef DMA_K
#undef DMA_V
#undef WAIT_BAR_
#undef WAIT_BAR2
#undef ROT
#undef EX
#undef RESC
#undef PKW
#undef PAF
#undef VFR
#undef VRD
#undef KRD
#undef ENDW
#undef GAP3
#undef GAP2
#undef GAP1
#undef GAPB
#undef STEP
}
#undef SBAR
#undef PIN
#undef MFMA
#undef MX3
}

__device__ __forceinline__ int queue_pull(Frame& F, gu32* heads, int nq, int nper, int myq) {
  volatile LAS int* slot = (volatile LAS int*)(F.lds + LDSCTL_OFF);
  if (F.tid == 0) { int got = -1;
    for (int k = 0; k < nq; ++k) { const int q = (myq + k) % nq;
      if (__hip_atomic_load(heads + 64 * q, RLX_AGENT) >= (unsigned)nper) continue;
      const unsigned i = __hip_atomic_fetch_add(heads + 64 * q, 1u, RLX_AGENT);
      if (i < (unsigned)nper) { got = q * nper + (int)i; break; } }
    *slot = got; }
  __syncthreads();
  const int r = __builtin_amdgcn_readfirstlane(*slot);
  __syncthreads();
  return r;
}
__device__ __forceinline__ void p3_attention(Frame& F, const Args& a, char* lds_generic, unsigned xcc, int qoff) {
  unsigned char* ws = F.ws;
  const bf16* QMp = (const bf16*)(ws + WS_QM); const bf16* KMp = (const bf16*)(ws + WS_KM); const bf16* VMp = (const bf16*)(ws + WS_VM); bf16* PO = (bf16*)(ws + WS_PO); float* PML = (float*)(ws + WS_PML);
#ifndef WAIT_MODE
#define WAIT_MODE 1
#endif
  bool waited = false; (void)waited;
  for (;;) {
    const int u = queue_pull(F, F.ctl + CW_Q + qoff, 8, 128, (int)(xcc & 7u));
    if (u < 0) break;
    const int bh = u >> 5, qb = (u >> 1) & 15, kh = u & 1, b = bh >> 3, h = bh & 7;
#if UPGEMM_IN_P2
    (void)waited;
#elif WAIT_MODE == 0
    if (F.tid == 0) { unsigned sp = 0;
      while (__hip_atomic_load(F.ctl + CW_RDY + 64 * b, RLX_AGENT) < 112u) { __builtin_amdgcn_s_sleep(2); if (++sp > (1u << 24)) break; }
      __builtin_amdgcn_fence(__ATOMIC_ACQUIRE, "agent"); }
    asm volatile("s_waitcnt vmcnt(0)" ::: "memory"); __syncthreads();
#else
    if (!waited) { waited = true;
      if (F.tid == 0) { unsigned sp = 0;
        for (int bb = 0; bb < 4; ++bb) while (__hip_atomic_load(F.ctl + CW_RDY + 64 * bb, RLX_AGENT) < 112u) { __builtin_amdgcn_s_sleep(2); if (++sp > (1u << 24)) break; }
        __builtin_amdgcn_fence(__ATOMIC_ACQUIRE, "agent"); }
      asm volatile("s_waitcnt vmcnt(0)" ::: "memory"); __syncthreads(); }
#endif
    const size_t row0 = (size_t)b * SEQ + qb * 256, key0 = (size_t)b * SEQ + kh * (SEQ / 2);
#ifndef ATT_REP
#define ATT_REP 1
#endif
#pragma unroll 1
    for (int rp = 0; rp < ATT_REP; ++rp)
#if ATTN_BODY == 2
    mla2::attn_unit(QMp + row0 * 768 + h * 96, KMp + key0 * 768 + h * 96, VMp + key0 * 512 + h * 64,
                    PO + ((size_t)kh * MTOK + row0) * 512 + h * 64, PML + ((size_t)kh * MTOK + row0) * 16 + h * 2, lds_generic);
#else
    mla::attn_unit(QMp + row0 * 768 + h * 96, KMp + key0 * 768 + h * 96, VMp + key0 * 512 + h * 64,
                   PO + ((size_t)kh * MTOK + row0) * 512 + h * 64, PML + ((size_t)kh * MTOK + row0) * 16 + h * 2, SEQ / 2, lds_generic);
#endif
  }
}
#ifndef MLSTM_BODY
#define MLSTM_BODY 2
#endif
#if MLSTM_BODY == 2
#define MLSTM_FN mlstm_seq2
#else
#define MLSTM_FN mlstm_seq
#endif
namespace mls {
using mla::crow; using mla::v_st; using mla::v_rd_base;
#define KSWZ(row, colB) ((row) * 256 + ((colB) ^ (((row) & 7) << 4)))
constexpr int OFF_QS = 0, OFF_KS = 16384, OFF_KP = 32768, OFF_VV = 49152, OFF_CT = 65536, OFF_SC = 98304, OFF_NB = 99328, OFF_NP = 100352, OFF_CH = 104448, OFF_WS = 105472, OFF_NT = 108544;
template <int OFF> __device__ __forceinline__ s16x4 trr(int vb) { s16x4 r; asm volatile("ds_read_b64_tr_b16 %0, %1 offset:%2" : "=&v"(r) : "v"(vb), "i"(OFF) : "memory"); return r; }
#define PKF(L, H) (bf16x8){L[0], L[1], L[2], L[3], H[0], H[1], H[2], H[3]}
__device__ __forceinline__ void vfrags(const char* lds, int off, int d0, int lane, bf16x8 (&f)[4]) {
  const mla2::lds_cptr vb = (mla2::lds_cptr)lds + off + v_rd_base(lane) + d0 * 512;
  const s16x4 l0 = mla2::vtr(vb), h0 = mla2::vtr(vb + 2048), l1 = mla2::vtr(vb + 4096), h1 = mla2::vtr(vb + 4096 + 2048), l2 = mla2::vtr(vb + 8192), h2 = mla2::vtr(vb + 8192 + 2048), l3 = mla2::vtr(vb + 12288), h3 = mla2::vtr(vb + 12288 + 2048);
  f[0] = PKF(l0, h0); f[1] = PKF(l1, h1); f[2] = PKF(l2, h2); f[3] = PKF(l3, h3);
}
__device__ __forceinline__ void pack_p(const f32x16& p0, const f32x16& p1, bf16x8& pa0, bf16x8& pa1, bf16x8& pa2, bf16x8& pa3) {
#define PK4(P, BASE, OUT) do { unsigned a0 = cvt_pk_bf16(P[BASE + 0], P[BASE + 1]), a1 = cvt_pk_bf16(P[BASE + 2], P[BASE + 3]);   \
    unsigned b0 = cvt_pk_bf16(P[BASE + 4], P[BASE + 5]), b1 = cvt_pk_bf16(P[BASE + 6], P[BASE + 7]);                              \
    auto r0 = __builtin_amdgcn_permlane32_swap(a0, b0, false, false); auto r1 = __builtin_amdgcn_permlane32_swap(a1, b1, false, false); \
    v4u w = {r0[0], r1[0], r0[1], r1[1]}; OUT = __builtin_bit_cast(bf16x8, w); } while (0)
  PK4(p0, 0, pa0); PK4(p0, 8, pa1); PK4(p1, 0, pa2); PK4(p1, 8, pa3);
#undef PK4
}
__device__ __forceinline__ float swap16_add(float v) { auto rr = __builtin_amdgcn_permlane16_swap(__float_as_uint(v), __float_as_uint(v), false, false); return __uint_as_float(rr[0]) + __uint_as_float(rr[1]); }
__device__ __forceinline__ float swap_add(float v) { auto rr = __builtin_amdgcn_permlane32_swap(__float_as_uint(v), __float_as_uint(v), false, false); return __uint_as_float(rr[0]) + __uint_as_float(rr[1]); }

template <int DIR> __device__ __forceinline__ void mlstm_seq(int seq, unsigned char* ws, char* lds) {
  int tid = threadIdx.x; asm volatile("" : "+v"(tid));
  const int wid = __builtin_amdgcn_readfirstlane(tid >> 6), lane = tid & 63, r32 = lane & 31, hi = lane >> 5, rb = wid >> 2, cb = wid & 3;
  constexpr int dir = DIR; const int h = (seq >> 1) & 3, b = seq >> 3;
  const bf16* QC = (const bf16*)(ws + WS_QC); const bf16* KC = (const bf16*)(ws + WS_KC); const bf16* P = (const bf16*)(ws + WS_PROJ);
  const float* gs = (const float*)(ws + WS_GSC) + (size_t)seq * 3 * SEQ; const float* dec = (const float*)(ws + WS_DEC) + seq * 128;
  bf16* H = (bf16*)(ws + (dir ? WS_HB : WS_HF));
  float* sc_alpha = (float*)(lds + OFF_SC); float* sc_a = sc_alpha + 64; float* sc_iw = sc_alpha + 128; float* sc_en = sc_alpha + 192;
  float* nbuf = (float*)(lds + OFF_NB); float* npart = (float*)(lds + OFF_NP);
  float* ch_mprev = (float*)(lds + OFF_CH); float* ch_mnew = ch_mprev + 64; float* ch_dec = ch_mprev + 128; float* ch_g = ch_mprev + 192;
  float* wsf = (float*)(lds + OFF_WS) + wid * 32;
  const int ldsb = (int)(uintptr_t)lds; (void)ldsb;
  if (tid < 64) {
    if (tid == 0) { float m = 0.f; for (int c = 0; c < 64; ++c) { const float g = dec[c], wm = dec[64 + c]; const float mn = fmaxf(g + m, g + wm); ch_mprev[c] = m; ch_mnew[c] = mn; ch_dec[c] = __expf(g + m - mn); ch_g[c] = g; m = mn; } } }
  for (int i = tid; i < 32768 / 16; i += NTHR) ((v4u*)(lds + OFF_CT))[i] = (v4u){0u, 0u, 0u, 0u};
  if (tid < 128) nbuf[tid] = 0.f;
  for (int i = tid; i < 16384 / 16; i += NTHR) ((v4u*)(lds + OFF_NT))[i] = (v4u){0u, 0u, 0u, 0u};
  f32x16 cacc[3]; cacc[0] = f32x16{}; cacc[1] = f32x16{}; cacc[2] = f32x16{};
  const int nown = rb ? 1 : 3;
  __syncthreads();
  const int sr = tid >> 4, sc = (tid & 15) * 8;
  v4u gq0, gq1, gk0, gk1, gv0, gv1; float ga0, ga1, sb = 0.f, sa = 0.f, spm = 0.f;
#define ROWOF(p) ((size_t)b * SEQ + (dir ? (SEQ - 1 - (p)) : (p)))
  constexpr long CSTEP = dir ? -64 : 64, RSTEP = dir ? -32 : 32;
  bf16* Hl = H + ROWOF(32 * rb + 4 * hi) * 512 + h * 128 + 32 * cb + r32;
  const bf16* qp = QC + ROWOF(sr) * 512 + h * 128 + sc; const bf16* kp = KC + ROWOF(sr) * 512 + h * 128 + sc; const bf16* vp = P + ROWOF(sr) * PROJ_LD + 1024 + h * 128 + sc;
#define LOADC(c) do { const long co_ = (long)(c) * CSTEP; \
    gq0 = *(const v4u*)(qp + co_ * 512); gq1 = *(const v4u*)(qp + (co_ + RSTEP) * 512); \
    gk0 = *(const v4u*)(kp + co_ * 512); gk1 = *(const v4u*)(kp + (co_ + RSTEP) * 512); \
    gv0 = *(const v4u*)(vp + co_ * PROJ_LD); gv1 = *(const v4u*)(vp + (co_ + RSTEP) * PROJ_LD); \
    ga0 = gs[SEQ + 64 * (c) + sr]; ga1 = gs[SEQ + 64 * (c) + 32 + sr]; \
    if (tid < 64) { sb = gs[64 * (c) + tid]; sa = gs[SEQ + 64 * (c) + tid]; spm = gs[2 * SEQ + 64 * (c) + tid]; } } while (0)
#define WRITEC(c) do { \
    *(v4u*)(lds + OFF_QS + KSWZ(sr, sc * 2)) = gq0; *(v4u*)(lds + OFF_QS + KSWZ(32 + sr, sc * 2)) = gq1; \
    *(v4u*)(lds + OFF_KS + KSWZ(sr, sc * 2)) = gk0; *(v4u*)(lds + OFF_KS + KSWZ(32 + sr, sc * 2)) = gk1; \
    *(v4u*)(lds + OFF_VV + v_st(sr, sc)) = gv0; *(v4u*)(lds + OFF_VV + v_st(32 + sr, sc)) = gv1; \
    { const float gc_ = ch_g[c], mn_ = ch_mnew[c]; const float w0_ = __expf(gc_ + ga0 - mn_), w1_ = __expf(gc_ + ga1 - mn_); float f0_[8], f1_[8], cs_[8]; unpack8(gk0, f0_); unpack8(gk1, f1_); \
      _Pragma("unroll") for (int j = 0; j < 8; ++j) { f0_[j] *= w0_; f1_[j] *= w1_; cs_[j] = f0_[j] + f1_[j]; } \
      *(v4u*)(lds + OFF_KP + v_st(sr, sc)) = pack8(f0_); *(v4u*)(lds + OFF_KP + v_st(32 + sr, sc)) = pack8(f1_); \
      _Pragma("unroll") for (int j = 0; j < 8; ++j) cs_[j] = swap_add(swap16_add(cs_[j])); \
      if ((lane >> 4) == 0) { _Pragma("unroll") for (int j = 0; j < 8; ++j) npart[wid * 128 + sc + j] = cs_[j]; } } \
    if (tid < 64) { const float m_ = ch_mprev[c]; const float mt_ = fmaxf(sb + m_, sb + spm); sc_alpha[tid] = (sb - mt_) * 1.4426950408889634f; sc_a[tid] = sa * 1.4426950408889634f; sc_iw[tid] = __expf(sb + m_ - mt_); sc_en[tid] = __expf(-mt_); } } while (0)
  LOADC(0); WRITEC(0);
  __syncthreads();
  for (int c = 0; c < 64; ++c) {
    if (c + 1 < 64) LOADC(c + 1);
    const float* nb = nbuf + (c & 1) * 128;
    if (tid < 128) { float s = 0.f;
#pragma unroll
      for (int w = 0; w < 8; ++w) s += npart[w * 128 + tid];
      const float nv = ch_dec[c] * nb[tid] + s; nbuf[((c + 1) & 1) * 128 + tid] = nv;
      const unsigned hb = f2bf(nv), lb = f2bf(nv - __uint_as_float(hb << 16)); char* nt = lds + OFF_NT + ((c + 1) & 1) * 8192;
      *(unsigned short*)(nt + KSWZ(0, tid * 2)) = (unsigned short)hb; *(unsigned short*)(nt + KSWZ(1, tid * 2)) = (unsigned short)lb; }
    bf16x8 qr[8];
#pragma unroll
    for (int d0 = 0; d0 < 8; ++d0) qr[d0] = *(const bf16x8*)(lds + OFF_QS + KSWZ(32 * rb + r32, (16 * d0 + 8 * hi) * 2));
    f32x16 p0 = f32x16{}, p1 = f32x16{};
#pragma unroll
    for (int d0 = 0; d0 < 8; ++d0) { const bf16x8 k0 = *(const bf16x8*)(lds + OFF_KS + KSWZ(r32, (16 * d0 + 8 * hi) * 2)); p0 = __builtin_amdgcn_mfma_f32_32x32x16_bf16(k0, qr[d0], p0, 0, 0, 0); }
    if (rb == 1) {
#pragma unroll
      for (int d0 = 0; d0 < 8; ++d0) { const bf16x8 k1 = *(const bf16x8*)(lds + OFF_KS + KSWZ(32 + r32, (16 * d0 + 8 * hi) * 2)); p1 = __builtin_amdgcn_mfma_f32_32x32x16_bf16(k1, qr[d0], p1, 0, 0, 0); }
    }
    const float al = sc_alpha[32 * rb + r32];
    f32x4 a4[4];
#pragma unroll
    for (int g = 0; g < 4; ++g) a4[g] = *(const f32x4*)(sc_a + 8 * g + 4 * hi);
    if (rb == 0) {
#pragma unroll
      for (int r = 0; r < 16; ++r) { const int sl = crow(r, hi); p0[r] = (sl <= r32) ? __builtin_amdgcn_exp2f(al + a4[r >> 2][r & 3]) * p0[r] : 0.f; }
    } else {
      f32x4 b4[4];
#pragma unroll
      for (int g = 0; g < 4; ++g) b4[g] = *(const f32x4*)(sc_a + 32 + 8 * g + 4 * hi);
#pragma unroll
      for (int r = 0; r < 16; ++r) { const int sl = crow(r, hi); p0[r] = __builtin_amdgcn_exp2f(al + a4[r >> 2][r & 3]) * p0[r]; p1[r] = (sl <= r32) ? __builtin_amdgcn_exp2f(al + b4[r >> 2][r & 3]) * p1[r] : 0.f; }
    }
    float ps = 0.f;
#pragma unroll
    for (int r = 0; r < 16; ++r) ps += p0[r] + p1[r];
    ps = swap_add(ps);
    bf16x8 pa0, pa1, pa2, pa3; pack_p(p0, p1, pa0, pa1, pa2, pa3);
    float qn;
    { f32x16 pn = f32x16{}; const char* nt = lds + OFF_NT + (c & 1) * 8192;
#pragma unroll
      for (int d0 = 0; d0 < 8; ++d0) { const bf16x8 nf = *(const bf16x8*)(nt + KSWZ(r32, (16 * d0 + 8 * hi) * 2)); pn = __builtin_amdgcn_mfma_f32_32x32x16_bf16(nf, qr[d0], pn, 0, 0, 0); }
      qn = pn[0] + pn[1]; }
    { const float iwt = sc_iw[32 * rb + r32]; const float den = iwt * qn + ps; const float rd = 1.f / fmaxf(fabsf(den), sc_en[32 * rb + r32]); if (hi == 0) wsf[r32] = rd; }
    f32x16 o = f32x16{};
#pragma unroll
    for (int d0 = 0; d0 < 8; ++d0) { const bf16x8 cf = *(const bf16x8*)(lds + OFF_CT + KSWZ(32 * cb + r32, (16 * d0 + 8 * hi) * 2)); o = __builtin_amdgcn_mfma_f32_32x32x16_bf16(qr[d0], cf, o, 0, 0, 0); }
#pragma unroll
    for (int g = 0; g < 4; ++g) { const f32x4 w4 = *(const f32x4*)(sc_iw + 32 * rb + 8 * g + 4 * hi);
#pragma unroll
      for (int j = 0; j < 4; ++j) o[4 * g + j] *= w4[j]; }
    bf16x8 vf[4]; vfrags(lds, OFF_VV, cb, lane, vf);
    o = __builtin_amdgcn_mfma_f32_32x32x16_bf16(pa0, vf[0], o, 0, 0, 0); o = __builtin_amdgcn_mfma_f32_32x32x16_bf16(pa1, vf[1], o, 0, 0, 0);
    if (rb == 1) { o = __builtin_amdgcn_mfma_f32_32x32x16_bf16(pa2, vf[2], o, 0, 0, 0); o = __builtin_amdgcn_mfma_f32_32x32x16_bf16(pa3, vf[3], o, 0, 0, 0); }
    asm volatile("s_waitcnt lgkmcnt(0)" ::: "memory");
    { bf16* Hc = Hl + (long)c * (CSTEP * 512);
#pragma unroll
      for (int g = 0; g < 4; ++g) { const f32x4 rd4 = *(const f32x4*)(wsf + 8 * g + 4 * hi); bf16* Hg = Hc + (dir ? -8 * g : 8 * g) * 512;
        const unsigned w0 = cvt_pk_bf16(o[4 * g] * rd4[0], o[4 * g + 1] * rd4[1]), w1 = cvt_pk_bf16(o[4 * g + 2] * rd4[2], o[4 * g + 3] * rd4[3]);
        Hg[0] = (bf16)(w0 & 0xffffu); Hg[dir ? -512 : 512] = (bf16)(w0 >> 16); Hg[dir ? -1024 : 1024] = (bf16)(w1 & 0xffffu); Hg[dir ? -1536 : 1536] = (bf16)(w1 >> 16); } }
    { const float dc = ch_dec[c];
#pragma unroll
      for (int i = 0; i < 3; ++i) if (i < nown) { const int db = rb ? 3 : i; bf16x8 kf[4]; vfrags(lds, OFF_KP, db, lane, kf);
#pragma unroll
        for (int r = 0; r < 16; ++r) cacc[i][r] *= dc;
#pragma unroll
        for (int ks = 0; ks < 4; ++ks) cacc[i] = __builtin_amdgcn_mfma_f32_32x32x16_bf16(kf[ks], vf[ks], cacc[i], 0, 0, 0); } }
    __syncthreads();
#pragma unroll
    for (int i = 0; i < 3; ++i) if (i < nown) {
#pragma unroll
      for (int g = 0; g < 4; ++g) { const int d = 32 * (rb ? 3 : i) + 8 * g + 4 * hi, e = 32 * cb + r32;
        v2u w; w.x = cvt_pk_bf16(cacc[i][4 * g], cacc[i][4 * g + 1]); w.y = cvt_pk_bf16(cacc[i][4 * g + 2], cacc[i][4 * g + 3]);
        *(v2u*)(lds + OFF_CT + KSWZ(e, d * 2)) = w; } }
    if (c + 1 < 64) WRITEC(c + 1);
    __syncthreads();
  }
#undef ROWOF
#undef LOADC
#undef WRITEC
}
template <int DIR> __device__ __forceinline__ void mlstm_seq2(int seq, unsigned char* ws, char* lds) {
  int tid = threadIdx.x; asm volatile("" : "+v"(tid));
  const int wid = __builtin_amdgcn_readfirstlane(tid >> 6), lane = tid & 63, r32 = lane & 31, hi = lane >> 5, rb = wid & 1, cb = wid >> 1;
  const bool swave = cb == 0;
  constexpr int dir = DIR; const int h = (seq >> 1) & 3, b = seq >> 3;
  const bf16* QC = (const bf16*)(ws + WS_QC); const bf16* KC = (const bf16*)(ws + WS_KC); const bf16* P = (const bf16*)(ws + WS_PROJ);
  const float* gs = (const float*)(ws + WS_GSC) + (size_t)seq * 3 * SEQ; const float* dec = (const float*)(ws + WS_DEC) + seq * 128;
  bf16* H = (bf16*)(ws + (dir ? WS_HB : WS_HF));
  float* sc_alpha = (float*)(lds + OFF_SC); float* sc_a = sc_alpha + 64; float* sc_iw = sc_alpha + 128; float* sc_en = sc_alpha + 192;
  float* nbuf = (float*)(lds + OFF_NB); float* npart = (float*)(lds + OFF_NP);
  float* ch_mprev = (float*)(lds + OFF_CH); float* ch_mnew = ch_mprev + 64; float* ch_dec = ch_mprev + 128; float* ch_g = ch_mprev + 192;
  float* rdbuf = (float*)(lds + OFF_WS);
  char* pbuf = lds + OFF_NT + 16384;
  if (tid == 0) { float m = 0.f; for (int c = 0; c < 64; ++c) { const float g = dec[c], wm = dec[64 + c]; const float mn = fmaxf(g + m, g + wm); ch_mprev[c] = m; ch_mnew[c] = mn; ch_dec[c] = __expf(g + m - mn); ch_g[c] = g; m = mn; } }
  for (int i = tid; i < 32768 / 16; i += NTHR) ((v4u*)(lds + OFF_CT))[i] = (v4u){0u, 0u, 0u, 0u};
  if (tid < 128) nbuf[tid] = 0.f;
  for (int i = tid; i < 16384 / 16; i += NTHR) ((v4u*)(lds + OFF_NT))[i] = (v4u){0u, 0u, 0u, 0u};
  const int n_own = swave ? 0 : 2, n_ext = (cb == 1 || cb == 3) ? 1 : 0; constexpr int eb_ext = 0;
  const int db_own0 = 2 * rb, db_ext0 = (cb == 1 ? 0 : 2) + rb;
  f32x16 cacc[3]; cacc[0] = f32x16{}; cacc[1] = f32x16{}; cacc[2] = f32x16{};
  __syncthreads();
  const int sr = tid >> 4, sc = (tid & 15) * 8;
  v4u gq0, gq1, gk0, gk1, gv0, gv1; float ga0, ga1, sb = 0.f, sa = 0.f, spm = 0.f;
#define ROWOF(p) ((size_t)b * SEQ + (dir ? (SEQ - 1 - (p)) : (p)))
  constexpr long CSTEP = dir ? -64 : 64, RSTEP = dir ? -32 : 32;
  bf16* Hl = H + ROWOF(32 * rb + 4 * hi) * 512 + h * 128 + 32 * cb + r32;
  const bf16* qp = QC + ROWOF(sr) * 512 + h * 128 + sc; const bf16* kp = KC + ROWOF(sr) * 512 + h * 128 + sc; const bf16* vp = P + ROWOF(sr) * PROJ_LD + 1024 + h * 128 + sc;
#define LOADC(c) do { const long co_ = (long)(c) * CSTEP; \
    gq0 = *(const v4u*)(qp + co_ * 512); gq1 = *(const v4u*)(qp + (co_ + RSTEP) * 512); \
    gk0 = *(const v4u*)(kp + co_ * 512); gk1 = *(const v4u*)(kp + (co_ + RSTEP) * 512); \
    gv0 = *(const v4u*)(vp + co_ * PROJ_LD); gv1 = *(const v4u*)(vp + (co_ + RSTEP) * PROJ_LD); \
    ga0 = gs[SEQ + 64 * (c) + sr]; ga1 = gs[SEQ + 64 * (c) + 32 + sr]; \
    if (wid == 5) { sb = gs[64 * (c) + lane]; sa = gs[SEQ + 64 * (c) + lane]; spm = gs[2 * SEQ + 64 * (c) + lane]; } } while (0)
#define WRITEC(c) do { \
    *(v4u*)(lds + OFF_QS + KSWZ(sr, sc * 2)) = gq0; *(v4u*)(lds + OFF_QS + KSWZ(32 + sr, sc * 2)) = gq1; \
    *(v4u*)(lds + OFF_KS + KSWZ(sr, sc * 2)) = gk0; *(v4u*)(lds + OFF_KS + KSWZ(32 + sr, sc * 2)) = gk1; \
    *(v4u*)(lds + OFF_VV + v_st(sr, sc)) = gv0; *(v4u*)(lds + OFF_VV + v_st(32 + sr, sc)) = gv1; \
    { const float gc_ = ch_g[c], mn_ = ch_mnew[c]; const float w0_ = __expf(gc_ + ga0 - mn_), w1_ = __expf(gc_ + ga1 - mn_); float f0_[8], f1_[8], cs_[8]; unpack8(gk0, f0_); unpack8(gk1, f1_); \
      _Pragma("unroll") for (int j = 0; j < 8; ++j) { f0_[j] *= w0_; f1_[j] *= w1_; cs_[j] = f0_[j] + f1_[j]; } \
      *(v4u*)(lds + OFF_KP + v_st(sr, sc)) = pack8(f0_); *(v4u*)(lds + OFF_KP + v_st(32 + sr, sc)) = pack8(f1_); \
      _Pragma("unroll") for (int j = 0; j < 8; ++j) cs_[j] = swap_add(swap16_add(cs_[j])); \
      if ((lane >> 4) == 0) { _Pragma("unroll") for (int j = 0; j < 8; ++j) npart[wid * 128 + sc + j] = cs_[j]; } } \
    if (wid == 5) { const float m_ = ch_mprev[c]; const float mt_ = fmaxf(sb + m_, sb + spm); sc_alpha[lane] = (sb - mt_) * 1.4426950408889634f; sc_a[lane] = sa * 1.4426950408889634f; sc_iw[lane] = __expf(sb + m_ - mt_); sc_en[lane] = __expf(-mt_); } } while (0)
  LOADC(0); WRITEC(0);
  __syncthreads();
  for (int c = 0; c < 64; ++c) {
    if (c + 1 < 64) LOADC(c + 1);
    const float* nb = nbuf + (c & 1) * 128;
    if (wid == 4 || wid == 5) { const int t = tid - 256; float s = 0.f;
#pragma unroll
      for (int w = 0; w < 8; ++w) s += npart[w * 128 + t];
      const float nv = ch_dec[c] * nb[t] + s; nbuf[((c + 1) & 1) * 128 + t] = nv;
      const unsigned hb = f2bf(nv), lb = f2bf(nv - __uint_as_float(hb << 16)); char* nt = lds + OFF_NT + ((c + 1) & 1) * 8192;
      *(unsigned short*)(nt + KSWZ(0, t * 2)) = (unsigned short)hb; *(unsigned short*)(nt + KSWZ(1, t * 2)) = (unsigned short)lb; }
    bf16x8 qr[8];
#pragma unroll
    for (int d0 = 0; d0 < 8; ++d0) qr[d0] = *(const bf16x8*)(lds + OFF_QS + KSWZ(32 * rb + r32, (16 * d0 + 8 * hi) * 2));
    if (swave) {
      float qn;
      { f32x16 pn = f32x16{}; const char* nt = lds + OFF_NT + (c & 1) * 8192;
#pragma unroll
        for (int d0 = 0; d0 < 8; ++d0) { const bf16x8 nf = *(const bf16x8*)(nt + KSWZ(r32, (16 * d0 + 8 * hi) * 2)); pn = __builtin_amdgcn_mfma_f32_32x32x16_bf16(nf, qr[d0], pn, 0, 0, 0); }
        qn = pn[0] + pn[1]; }
      asm volatile("" : "+v"(qn));
      const float al = sc_alpha[32 * rb + r32];
      f32x16 p0 = f32x16{}, p1 = f32x16{};
#pragma unroll
      for (int d0 = 0; d0 < 8; ++d0) { const bf16x8 k0 = *(const bf16x8*)(lds + OFF_KS + KSWZ(r32, (16 * d0 + 8 * hi) * 2)); p0 = __builtin_amdgcn_mfma_f32_32x32x16_bf16(k0, qr[d0], p0, 0, 0, 0); }
      if (rb == 1) {
#pragma unroll
        for (int d0 = 0; d0 < 8; ++d0) { const bf16x8 k1 = *(const bf16x8*)(lds + OFF_KS + KSWZ(32 + r32, (16 * d0 + 8 * hi) * 2)); p1 = __builtin_amdgcn_mfma_f32_32x32x16_bf16(k1, qr[d0], p1, 0, 0, 0); }
      }
      { f32x4 a4[4];
#pragma unroll
        for (int g = 0; g < 4; ++g) a4[g] = *(const f32x4*)(sc_a + 8 * g + 4 * hi);
        if (rb == 0) {
#pragma unroll
          for (int r = 0; r < 16; ++r) { const int sl = crow(r, hi); p0[r] = (sl <= r32) ? __builtin_amdgcn_exp2f(al + a4[r >> 2][r & 3]) * p0[r] : 0.f; }
        } else {
#pragma unroll
          for (int r = 0; r < 16; ++r) p0[r] = __builtin_amdgcn_exp2f(al + a4[r >> 2][r & 3]) * p0[r];
        } }
      if (rb == 1) { f32x4 b4[4];
#pragma unroll
        for (int g = 0; g < 4; ++g) b4[g] = *(const f32x4*)(sc_a + 32 + 8 * g + 4 * hi);
#pragma unroll
        for (int r = 0; r < 16; ++r) { const int sl = crow(r, hi); p1[r] = (sl <= r32) ? __builtin_amdgcn_exp2f(al + b4[r >> 2][r & 3]) * p1[r] : 0.f; } }
      float ps = 0.f;
#pragma unroll
      for (int r = 0; r < 16; ++r) ps += p0[r] + p1[r];
      ps = swap_add(ps);
      bf16x8 pa0, pa1, pa2, pa3; pack_p(p0, p1, pa0, pa1, pa2, pa3);
      { char* pw = pbuf + rb * 4096 + lane * 16; *(bf16x8*)(pw) = pa0; *(bf16x8*)(pw + 1024) = pa1; *(bf16x8*)(pw + 2048) = pa2; *(bf16x8*)(pw + 3072) = pa3; }
      { const float iwt = sc_iw[32 * rb + r32]; const float den = iwt * qn + ps; const float rd = 1.f / fmaxf(fabsf(den), sc_en[32 * rb + r32]); if (hi == 0) rdbuf[32 * rb + r32] = rd; }
    }
    f32x16 o = f32x16{};
#pragma unroll
    for (int d0 = 0; d0 < 8; ++d0) { const bf16x8 cf = *(const bf16x8*)(lds + OFF_CT + KSWZ(32 * cb + r32, (16 * d0 + 8 * hi) * 2)); o = __builtin_amdgcn_mfma_f32_32x32x16_bf16(qr[d0], cf, o, 0, 0, 0); }
#pragma unroll
    for (int g = 0; g < 4; ++g) { const f32x4 w4 = *(const f32x4*)(sc_iw + 32 * rb + 8 * g + 4 * hi);
#pragma unroll
      for (int j = 0; j < 4; ++j) o[4 * g + j] *= w4[j]; }
    bf16x8 vf[4]; vfrags(lds, OFF_VV, cb, lane, vf);
    { const float dc = ch_dec[c];
#pragma unroll
      for (int i = 0; i < 2; ++i) if (i < n_own) { bf16x8 kf[4]; vfrags(lds, OFF_KP, db_own0 + i, lane, kf);
#pragma unroll
        for (int r = 0; r < 16; ++r) cacc[i][r] *= dc;
#pragma unroll
        for (int ks = 0; ks < 4; ++ks) cacc[i] = __builtin_amdgcn_mfma_f32_32x32x16_bf16(kf[ks], vf[ks], cacc[i], 0, 0, 0); }
      if (n_ext > 0) { bf16x8 vx[4]; vfrags(lds, OFF_VV, eb_ext, lane, vx); bf16x8 kf[4]; vfrags(lds, OFF_KP, db_ext0, lane, kf);
#pragma unroll
        for (int r = 0; r < 16; ++r) cacc[2][r] *= dc;
#pragma unroll
        for (int ks = 0; ks < 4; ++ks) cacc[2] = __builtin_amdgcn_mfma_f32_32x32x16_bf16(kf[ks], vx[ks], cacc[2], 0, 0, 0); } }
    __syncthreads();
    { const char* pw = pbuf + rb * 4096 + lane * 16; const bf16x8 pa0 = *(const bf16x8*)(pw), pa1 = *(const bf16x8*)(pw + 1024);
      o = __builtin_amdgcn_mfma_f32_32x32x16_bf16(pa0, vf[0], o, 0, 0, 0); o = __builtin_amdgcn_mfma_f32_32x32x16_bf16(pa1, vf[1], o, 0, 0, 0);
      if (rb == 1) { const bf16x8 pa2 = *(const bf16x8*)(pw + 2048), pa3 = *(const bf16x8*)(pw + 3072);
        o = __builtin_amdgcn_mfma_f32_32x32x16_bf16(pa2, vf[2], o, 0, 0, 0); o = __builtin_amdgcn_mfma_f32_32x32x16_bf16(pa3, vf[3], o, 0, 0, 0); } }
    { bf16* Hc = Hl + (long)c * (CSTEP * 512);
#pragma unroll
      for (int g = 0; g < 4; ++g) { const f32x4 rd4 = *(const f32x4*)(rdbuf + 32 * rb + 8 * g + 4 * hi); bf16* Hg = Hc + (dir ? -8 * g : 8 * g) * 512;
        const unsigned w0 = cvt_pk_bf16(o[4 * g] * rd4[0], o[4 * g + 1] * rd4[1]), w1 = cvt_pk_bf16(o[4 * g + 2] * rd4[2], o[4 * g + 3] * rd4[3]);
        Hg[0] = (bf16)(w0 & 0xffffu); Hg[dir ? -512 : 512] = (bf16)(w0 >> 16); Hg[dir ? -1024 : 1024] = (bf16)(w1 & 0xffffu); Hg[dir ? -1536 : 1536] = (bf16)(w1 >> 16); } }
#pragma unroll
    for (int i = 0; i < 3; ++i) if (i < 2 ? (i < n_own) : (n_ext > 0)) { const int db = i < 2 ? db_own0 + i : db_ext0, eb = i < 2 ? cb : eb_ext;
#pragma unroll
      for (int g = 0; g < 4; ++g) { const int d = 32 * db + 8 * g + 4 * hi, e = 32 * eb + r32;
        v2u w; w.x = cvt_pk_bf16(cacc[i][4 * g], cacc[i][4 * g + 1]); w.y = cvt_pk_bf16(cacc[i][4 * g + 2], cacc[i][4 * g + 3]);
        *(v2u*)(lds + OFF_CT + KSWZ(e, d * 2)) = w; } }
    if (c + 1 < 64) WRITEC(c + 1);
    __syncthreads();
  }
#undef ROWOF
#undef LOADC
#undef WRITEC
}
#undef KSWZ
#undef PKF
}

struct ListOrder { int n, L0, L1, nN, lda, ldb;
  __device__ bool next(int i, pg8::Unit& u) const { if (i >= n) return false; const int L = i ? L1 : L0; u.pm = L / nN; u.pn = L % nN; u.g = 0; u.ibase = 0;
    u.aoff = (long)u.pm * 256 * lda; u.boff = (long)u.pn * 256 * ldb; return true; } };
__device__ __forceinline__ void publish_units(Frame& F, const ListOrder& S) {
  if (F.tid == 0) { __builtin_amdgcn_fence(__ATOMIC_RELEASE, "agent"); asm volatile("s_waitcnt vmcnt(0)" ::: "memory");
    for (int i = 0; i < S.n; ++i) { const int L = i ? S.L1 : S.L0; __hip_atomic_fetch_add(F.ctl + CW_RDY + 64 * ((L / S.nN) >> 4), 1u, RLX_AGENT); } }
}
#ifndef P3_DYNAMIC_FILL
#define P3_DYNAMIC_FILL 1
#endif
#ifndef P3_FILL_CHUNKS
#define P3_FILL_CHUNKS 6
#endif
__device__ __forceinline__ void p2_upgemms(Frame& F, SsAcc ssq, SsAcc sskv) {
  unsigned char* ws = F.ws;
  for (int base = 0; base < 448; base += F.G) { const int L = base + (int)blockIdx.x;
    { ListOrder S{L < 192 ? 1 : 0, L, 0, 3, PROJ_LD, 256};
      pg8::Gemm g{(const bf16*)(ws + WS_PROJ) + PC_CQ, (const bf16*)(ws + WS_WQB), PROJ_LD, 256, 256, nullptr, 127, 127};
      EpiQ E{(bf16*)(ws + WS_QM), ssq, (const float*)(ws + WS_ROPE)};
      pg8::gemm_phase<EpiQ, ListOrder, false>(F.lds, g, S, E); }
    { ListOrder S{(L >= 192 && L < 448) ? 1 : 0, L - 192, 0, 4, PROJ_LD, 256};
      pg8::Gemm g{(const bf16*)(ws + WS_PROJ) + PC_CKV, (const bf16*)(ws + WS_WKVB), PROJ_LD, 256, 128, nullptr, 127, 127};
      EpiKV E{(bf16*)(ws + WS_KM), (bf16*)(ws + WS_VM), sskv};
      pg8::gemm_phase<EpiKV, ListOrder, false>(F.lds, g, S, E); } }
}
__device__ __forceinline__ void p3_mixers(Frame& F, const Args& a, char* lds_generic, unsigned xcc, SsAcc ssq, SsAcc sskv, int qoff) {
  unsigned char* ws = F.ws; const int bx = (int)blockIdx.x;
#ifndef MLSTM_REPS
#define MLSTM_REPS 1
#endif
  if (bx < 32) { for (int rp = 0; rp < MLSTM_REPS; ++rp) { if (bx & 1) mls::MLSTM_FN<1>(bx, F.ws, lds_generic); else mls::MLSTM_FN<0>(bx, F.ws, lds_generic); __syncthreads(); } }
#if !UPGEMM_IN_P2
  else { const int c = bx - 32;
    { ListOrder S{c < 192 ? 1 : 0, c, 0, 3, PROJ_LD, 256};
      pg8::Gemm g{(const bf16*)(ws + WS_PROJ) + PC_CQ, (const bf16*)(ws + WS_WQB), PROJ_LD, 256, 256, nullptr, 127, 127};
      EpiQ E{(bf16*)(ws + WS_QM), ssq, (const float*)(ws + WS_ROPE)};
      pg8::gemm_phase<EpiQ, ListOrder, false>(F.lds, g, S, E); publish_units(F, S); }
    { ListOrder S{c >= 192 ? 2 : 1, c >= 192 ? c - 192 : c + 32, c + 32, 4, PROJ_LD, 256};
      pg8::Gemm g{(const bf16*)(ws + WS_PROJ) + PC_CKV, (const bf16*)(ws + WS_WKVB), PROJ_LD, 256, 256, nullptr, 127, 127};
      EpiKV E{(bf16*)(ws + WS_KM), (bf16*)(ws + WS_VM), sskv};
      pg8::gemm_phase<EpiKV, ListOrder, false>(F.lds, g, S, E); publish_units(F, S); }
  }
#endif
  p3_attention(F, a, lds_generic, xcc, qoff);
#ifndef P3_CONV_LIMIT
#define P3_CONV_LIMIT 3072
#endif
#if P3_DYNAMIC_FILL
  if (!qoff) conv_fill(F, a, 1 << 30, P3_CONV_LIMIT);
#else
  if (bx >= 32 && !qoff) conv_fill(F, a, P3_FILL_CHUNKS);
#endif
}
__device__ __forceinline__ void p4_combine(Frame& F, const Args& a) {
  unsigned char* ws = F.ws; const bf16* HF = (const bf16*)(ws + WS_HF); const bf16* HB = (const bf16*)(ws + WS_HB); const bf16* P = (const bf16*)(ws + WS_PROJ); bf16* Y = (bf16*)(ws + WS_Y);
  const float* g = (const float*)a.in[I_GHM];
  const int gw = F.vcu * NWAVES + F.wave, NGW = F.G * NWAVES, c = F.lane * 8;
  float gg[8];
#pragma unroll
  for (int j = 0; j < 8; ++j) gg[j] = g[c + j];
  for (int m0 = gw; m0 < MTOK; m0 += 2 * NGW) {
    v4u wf[2], wb[2], wo[2];
#pragma unroll
    for (int u = 0; u < 2; ++u) { const size_t m = (size_t)(m0 + u * NGW); wf[u] = *(const v4u*)(HF + m * 512 + c); wb[u] = *(const v4u*)(HB + m * 512 + c); wo[u] = *(const v4u*)(P + m * PROJ_LD + 1536 + c); }
#pragma unroll
    for (int u = 0; u < 2; ++u) { const size_t m = (size_t)(m0 + u * NGW);
      float f[8], bb[8], oo[8]; unpack8(wf[u], f); unpack8(wb[u], bb); unpack8(wo[u], oo);
      float s = 0.f;
#pragma unroll
      for (int j = 0; j < 8; ++j) { f[j] += bb[j]; s += f[j] * f[j]; }
      s += __shfl_xor(s, 1); s += __shfl_xor(s, 2); s += __shfl_xor(s, 4); s += __shfl_xor(s, 8);
      const float r = rsqrtf(s * (1.f / 128.f) + 1e-6f);
#pragma unroll
      for (int j = 0; j < 8; ++j) f[j] = f[j] * r * gg[j] * sigmoidf_(oo[j]);
      *(v4u*)(Y + m * 1024 + c) = pack8(f); }
  }
  { const bf16* PO = (const bf16*)(ws + WS_PO); const float* PML = (const float*)(ws + WS_PML); const float* ga = (const float*)a.in[I_GHA];
    constexpr float C = 0.10206207261596575f * 1.4426950408889634f; const int hh = F.lane >> 3;
    float g8[8];
#pragma unroll
    for (int j = 0; j < 8; ++j) g8[j] = ga[c + j];
    for (int m = gw; m < MTOK; m += NGW) {
      float pa[8], pb[8]; unpack8(*(const v4u*)(PO + (size_t)m * 512 + c), pa); unpack8(*(const v4u*)(PO + ((size_t)MTOK + m) * 512 + c), pb);
      const float m0 = PML[(size_t)m * 16 + hh * 2], l0 = PML[(size_t)m * 16 + hh * 2 + 1], m1 = PML[((size_t)MTOK + m) * 16 + hh * 2], l1 = PML[((size_t)MTOK + m) * 16 + hh * 2 + 1];
      const float M = fmaxf(m0, m1), e0 = __builtin_amdgcn_exp2f((m0 - M) * (ATTN_BODY == 2 ? 1.f : C)), e1 = __builtin_amdgcn_exp2f((m1 - M) * (ATTN_BODY == 2 ? 1.f : C)); const float rl = 1.f / (l0 * e0 + l1 * e1);
      float f[8];
#pragma unroll
      for (int j = 0; j < 8; ++j) f[j] = pa[j] * e0 + pb[j] * e1;
      float s = 0.f;
#pragma unroll
      for (int j = 0; j < 8; ++j) { f[j] *= rl; s += f[j] * f[j]; }
      s += __shfl_xor(s, 1); s += __shfl_xor(s, 2); s += __shfl_xor(s, 4);
      const float r = rsqrtf(s * (1.f / 64.f) + 1e-6f);
#pragma unroll
      for (int j = 0; j < 8; ++j) f[j] = f[j] * r * g8[j];
      *(v4u*)(Y + (size_t)m * 1024 + 512 + c) = pack8(f); } }
}
template <int MODE> struct EpiResid { static constexpr bool TWO_PASS = false; const float* basef; const bf16* baseb; float* out; bf16* outb; SsAcc ss;
  __device__ __forceinline__ void row8(const pg8::Unit& u, int rloc, int cloc, const float (&a0)[8], const float (&a1)[8], int fq) const {
    const int row = u.pm * 256 + rloc; const size_t off = (size_t)row * 1024 + u.pn * 256 + cloc;
    float v0[8], v1[8];
    if constexpr (MODE == 0) {
      const f32x4 b0 = *(const f32x4*)(basef + off), b1 = *(const f32x4*)(basef + off + 4), b2 = *(const f32x4*)(basef + off + 128), b3 = *(const f32x4*)(basef + off + 132);
#pragma unroll
      for (int i = 0; i < 4; ++i) { v0[i] = a0[i] + b0[i]; v0[4 + i] = a0[4 + i] + b1[i]; v1[i] = a1[i] + b2[i]; v1[4 + i] = a1[4 + i] + b3[i]; }
      *(v4u*)(outb + off) = pack8(v0); *(v4u*)(outb + off + 128) = pack8(v1);
    } else {
      float r0[8], r1[8]; unpack8(*(const v4u*)(baseb + off), r0); unpack8(*(const v4u*)(baseb + off + 128), r1);
#pragma unroll
      for (int i = 0; i < 8; ++i) { v0[i] = a0[i] + r0[i]; v1[i] = a1[i] + r1[i]; }
      *(v4u*)(outb + off) = pack8(v0); *(v4u*)(outb + off + 128) = pack8(v1);
      if (out) { *(f32x4*)(out + off) = (f32x4){v0[0], v0[1], v0[2], v0[3]}; *(f32x4*)(out + off + 4) = (f32x4){v0[4], v0[5], v0[6], v0[7]};
        *(f32x4*)(out + off + 128) = (f32x4){v1[0], v1[1], v1[2], v1[3]}; *(f32x4*)(out + off + 132) = (f32x4){v1[4], v1[5], v1[6], v1[7]}; }
    }
    float s = sumsq8(v0) + sumsq8(v1); s += __shfl_xor(s, 16); s += __shfl_xor(s, 32); if (fq == 0) ss.add(row, s); } };
struct EpiScale { static constexpr bool TWO_PASS = false; bf16* O; SsAcc ss;
  __device__ __forceinline__ void row8(const pg8::Unit& u, int rloc, int cloc, const float (&a0)[8], const float (&a1)[8], int fq) const {
    const int row = u.pm * 256 + rloc; const float r = rsqrtf(ss[row] * (1.f / 1024.f) + 1e-6f); float v0[8], v1[8];
#pragma unroll
    for (int i = 0; i < 8; ++i) { v0[i] = a0[i] * r; v1[i] = a1[i] * r; }
    bf16* p = O + (size_t)row * 1024 + u.pn * 256 + cloc; *(v4u*)p = pack8(v0); *(v4u*)(p + 128) = pack8(v1); } };
struct EpiSoftmax { static constexpr bool TWO_PASS = true; bf16* O; float scale; LAS float* xch;
  __device__ __forceinline__ void pass1(const pg8::Unit& u, int rloc, int wc, float (&v0)[8], float (&v1)[8], int fq) const {
    float mx = -3.0e38f;
#pragma unroll
    for (int i = 0; i < 8; ++i) { v0[i] *= scale; v1[i] *= scale; mx = fmaxf(mx, fmaxf(v0[i], v1[i])); }
    mx = fmaxf(mx, __shfl_xor(mx, 16)); mx = fmaxf(mx, __shfl_xor(mx, 32));
    float l = 0.f;
#pragma unroll
    for (int i = 0; i < 8; ++i) { v0[i] = __expf(v0[i] - mx); v1[i] = __expf(v1[i] - mx); l += v0[i] + v1[i]; }
    l += __shfl_xor(l, 16); l += __shfl_xor(l, 32);
    if (fq == 0) { xch[(rloc * 4 + wc) * 2] = mx; xch[(rloc * 4 + wc) * 2 + 1] = l; } }
  __device__ __forceinline__ void row8(const pg8::Unit& u, int rloc, int cloc, const float (&a0)[8], const float (&a1)[8], int fq) const {
    const int wc = cloc >> 5; float m[4], l[4]; float M = -3.0e38f;
#pragma unroll
    for (int w = 0; w < 4; ++w) { m[w] = xch[(rloc * 4 + w) * 2]; l[w] = xch[(rloc * 4 + w) * 2 + 1]; M = fmaxf(M, m[w]); }
    float L = 0.f, mine = 0.f;
#pragma unroll
    for (int w = 0; w < 4; ++w) { const float e = __expf(m[w] - M); L += l[w] * e; if (w == wc) mine = e; }
    const float f = mine / L; float v0[8], v1[8];
#pragma unroll
    for (int i = 0; i < 8; ++i) { v0[i] = a0[i] * f; v1[i] = a1[i] * f; }
    bf16* p = O + (size_t)(u.pm * 256 + rloc) * 1024 + u.pn * 256 + cloc; *(v4u*)p = pack8(v0); *(v4u*)(p + 128) = pack8(v1); } };

namespace mem2 {
#define MSWZ(row, colB) ((row) * 512 + ((colB) ^ (((row) & 15) << 4)))
__device__ __forceinline__ void stage_image(char* lds, const bf16* src, int tid_in) {
  int tid = tid_in; asm volatile("" : "+v"(tid));
  const bf16* sp = src + (size_t)(tid >> 5) * 1024 + (tid & 31) * 8; const int row0 = tid >> 5, pc = tid & 31;
  v4u t[16];
#pragma unroll
  for (int p = 0; p < 16; ++p) t[p] = *(const v4u*)(sp + (size_t)p * 16 * 1024);
#pragma unroll
  for (int p = 0; p < 16; ++p) { const int row = p * 16 + row0; *(v4u*)(lds + MSWZ(row, pc * 16)) = t[p]; }
}
__device__ __forceinline__ void memattn_unit(const bf16* Q, const bf16* K, const bf16* VT, bf16* O, char* lds) {
  int tid = threadIdx.x; asm volatile("" : "+v"(tid));
  const int wid = __builtin_amdgcn_readfirstlane(tid >> 6), lane = tid & 63, r32 = lane & 31, hi = lane >> 5;
#define MFENCE() asm volatile("" ::: "memory")
  stage_image(lds, K, tid);
  MFENCE();
  const bf16* Qw = Q + (size_t)(wid * 32 + r32) * 1024 + hi * 8;
  bf16x8 qa[4], qb[4];
#pragma unroll
  for (int d = 0; d < 4; ++d) qa[d] = *(const bf16x8*)(Qw + d * 16);
  __syncthreads();
  f32x16 p[8];
#pragma unroll
  for (int n = 0; n < 8; ++n) p[n] = f32x16{};
#define QK_GROUP(QC, QN, G) do { \
    if ((G) < 3) { _Pragma("unroll") for (int d = 0; d < 4; ++d) QN[d] = *(const bf16x8*)(Qw + (4 * ((G) + 1) + d) * 16); } \
    _Pragma("unroll") for (int d = 0; d < 4; ++d) { MFENCE(); \
      _Pragma("unroll") for (int n = 0; n < 8; ++n) { const bf16x8 kf = *(const bf16x8*)(lds + MSWZ(32 * n + r32, (16 * (4 * (G) + d) + 8 * hi) * 2)); p[n] = __builtin_amdgcn_mfma_f32_32x32x16_bf16(kf, QC[d], p[n], 0, 0, 0); } } } while (0)
  QK_GROUP(qa, qb, 0); QK_GROUP(qb, qa, 1); QK_GROUP(qa, qb, 2); QK_GROUP(qb, qa, 3);
#undef QK_GROUP
  MFENCE();
  float mx = p[0][0];
#pragma unroll
  for (int n = 0; n < 8; ++n)
#pragma unroll
    for (int r = 0; r < 16; ++r) mx = fmaxf(mx, p[n][r]);
  { auto rr = __builtin_amdgcn_permlane32_swap(__float_as_uint(mx), __float_as_uint(mx), false, false); mx = fmaxf(__uint_as_float(rr[0]), __uint_as_float(rr[1])); }
  constexpr float C = 0.0625f * 1.4426950408889634f; const float nm = -mx * C; float l = 0.f;
#pragma unroll
  for (int n = 0; n < 8; ++n)
#pragma unroll
    for (int r = 0; r < 16; ++r) { p[n][r] = __builtin_amdgcn_exp2f(__builtin_fmaf(p[n][r], C, nm)); l += p[n][r]; }
  l = mls::swap_add(l); const float rl = __builtin_amdgcn_rcpf(l);
  bf16x8 pa[16];
#pragma unroll
  for (int k = 0; k < 4; ++k) {
#pragma unroll
    for (int r = 0; r < 16; ++r) { p[2 * k][r] *= rl; p[2 * k + 1][r] *= rl; }
    mls::pack_p(p[2 * k], p[2 * k + 1], pa[4 * k], pa[4 * k + 1], pa[4 * k + 2], pa[4 * k + 3]); }
  __syncthreads();
  stage_image(lds, VT, tid);
  __syncthreads();
  unsigned pkA[4][8];
  { f32x16 o[4];
#pragma unroll
    for (int dt = 0; dt < 4; ++dt) o[dt] = f32x16{};
#pragma unroll
    for (int ks = 0; ks < 16; ++ks) { MFENCE();
#pragma unroll
      for (int dt = 0; dt < 4; ++dt) { const bf16x8 vf = *(const bf16x8*)(lds + MSWZ(32 * dt + r32, (16 * ks + 8 * hi) * 2)); o[dt] = __builtin_amdgcn_mfma_f32_32x32x16_bf16(pa[ks], vf, o[dt], 0, 0, 0); } }
    MFENCE();
#pragma unroll
    for (int dt = 0; dt < 4; ++dt)
#pragma unroll
      for (int j = 0; j < 8; ++j) pkA[dt][j] = cvt_pk_bf16(o[dt][2 * j], o[dt][2 * j + 1]); }
  f32x16 o[4];
#pragma unroll
  for (int dt = 0; dt < 4; ++dt) o[dt] = f32x16{};
#pragma unroll
  for (int ks = 0; ks < 16; ++ks) { MFENCE();
#pragma unroll
    for (int dt = 0; dt < 4; ++dt) { const bf16x8 vf = *(const bf16x8*)(lds + MSWZ(32 * (4 + dt) + r32, (16 * ks + 8 * hi) * 2)); o[dt] = __builtin_amdgcn_mfma_f32_32x32x16_bf16(pa[ks], vf, o[dt], 0, 0, 0); } }
  MFENCE();
  __syncthreads();
  { unsigned short* stg = (unsigned short*)(lds + wid * 16384);
#pragma unroll
    for (int dt = 0; dt < 4; ++dt)
#pragma unroll
      for (int j = 0; j < 8; ++j) { stg[mla::crow(2 * j, hi) * 256 + 32 * dt + r32] = (unsigned short)(pkA[dt][j] & 0xffffu); stg[mla::crow(2 * j + 1, hi) * 256 + 32 * dt + r32] = (unsigned short)(pkA[dt][j] >> 16); }
#pragma unroll
    for (int dt = 0; dt < 4; ++dt)
#pragma unroll
      for (int r = 0; r < 16; ++r) stg[mla::crow(r, hi) * 256 + 32 * (4 + dt) + r32] = (unsigned short)f2bf(o[dt][r]);
    asm volatile("s_waitcnt lgkmcnt(0)" ::: "memory");
#pragma unroll
    for (int i = 0; i < 16; ++i) { const int row = i * 2 + hi, pc = r32; *(v4u*)(O + (size_t)(wid * 32 + row) * 1024 + pc * 8) = *(const v4u*)(stg + row * 256 + pc * 8); } }
  __syncthreads();
#undef MFENCE
}
#undef MSWZ
}
struct MemOrder { int G, c, kind;
  __device__ bool next(int i, pg8::Unit& u) const { const int L = i * G + c; if (L >= 256) return false;
    const int bh = L >> 4, t = L & 15, b = bh >> 2, h = bh & 3;
    u.pm = b * 16 + t; u.pn = h; u.g = 0; u.ibase = 0; u.aoff = ((long)(b * SEQ + t * 256)) * 1024 + (kind == 2 ? 0 : h * 256);
    u.boff = kind == 0 ? ((long)(b * NMEM)) * 1024 + h * 256 : kind == 1 ? ((long)(h * 256)) * 1024 + b * NMEM : ((long)(h * 256)) * 1024; return true; } };
constexpr size_t WS_WRG = WS_DEC + 65536;
constexpr size_t WS_ROWSEL = WS_SEL, WS_GSEL = WS_SEL + 131072, WS_INV = 31 * MiB, WS_YE = 160 * MiB;
typedef float f32x4m __attribute__((ext_vector_type(4)));
__device__ __forceinline__ void p10_router(Frame& F, const Args& a) {
  unsigned char* ws = F.ws; const bf16* X2 = (const bf16*)(ws + WS_X2); const SsAcc ss2{(unsigned long long*)(ws + CTL_SS2)}; float* AFF = (float*)(ws + WS_AFF); const float* WRG = (const float*)(ws + WS_WRG);
  const int r = F.lane & 15, kq = F.lane >> 4;
  LAS float* wl = (LAS float*)F.lds;
  for (int i = F.tid; i < 4096; i += NTHR) ((LAS f32x4*)wl)[i] = ((const f32x4*)WRG)[i];
  __syncthreads();
  LAS f32x4* xch = (LAS f32x4*)(F.lds + 65536);
  for (int it0 = F.vcu * 4; it0 < MTOK / 16; it0 += F.G * 4) { const int it = it0 + (F.wave & 3), hf = F.wave >> 2, m0 = it * 16;
    const bf16* xp = X2 + (size_t)(m0 + r) * 1024 + 4 * kq; const LAS float* wp = wl + (4 * kq) * 16 + r; (void)xp;
    f32x4m acc0 = {0.f, 0.f, 0.f, 0.f}, acc1 = {0.f, 0.f, 0.f, 0.f};
    { f32x4 xv[32];
#pragma unroll
      for (int j = 0; j < 32; ++j) {
#if X2MODE >= 1 && X2MODE != 3 && X2MODE != 4
        xv[j] = *(const f32x4*)((const float*)(ws + WS_X2F) + (size_t)(m0 + r) * 1024 + 4 * kq + 16 * (32 * hf + j));
#else
        const v2u w = *(const v2u*)(xp + 16 * (32 * hf + j)); xv[j] = (f32x4){bflo(w.x), bfhi(w.x), bflo(w.y), bfhi(w.y)};
#endif
      }
#pragma unroll
      for (int j = 0; j < 32; j += 2) { const LAS float* w0 = wp + (16 * (32 * hf + j)) * 16; const LAS float* w1 = w0 + 256;
        acc0 = __builtin_amdgcn_mfma_f32_16x16x4f32(xv[j].x, w0[0], acc0, 0, 0, 0); acc1 = __builtin_amdgcn_mfma_f32_16x16x4f32(xv[j + 1].x, w1[0], acc1, 0, 0, 0);
        acc0 = __builtin_amdgcn_mfma_f32_16x16x4f32(xv[j].y, w0[16], acc0, 0, 0, 0); acc1 = __builtin_amdgcn_mfma_f32_16x16x4f32(xv[j + 1].y, w1[16], acc1, 0, 0, 0);
        acc0 = __builtin_amdgcn_mfma_f32_16x16x4f32(xv[j].z, w0[32], acc0, 0, 0, 0); acc1 = __builtin_amdgcn_mfma_f32_16x16x4f32(xv[j + 1].z, w1[32], acc1, 0, 0, 0);
        acc0 = __builtin_amdgcn_mfma_f32_16x16x4f32(xv[j].w, w0[48], acc0, 0, 0, 0); acc1 = __builtin_amdgcn_mfma_f32_16x16x4f32(xv[j + 1].w, w1[48], acc1, 0, 0, 0); }
    }
    f32x4 part = {acc0[0] + acc1[0], acc0[1] + acc1[1], acc0[2] + acc1[2], acc0[3] + acc1[3]};
    if (hf == 1) xch[(F.wave & 3) * 64 + F.lane] = part;
    __syncthreads();
    if (hf == 0) { const f32x4 oth = xch[(F.wave & 3) * 64 + F.lane];
#pragma unroll
      for (int i = 0; i < 4; ++i) { const int row = m0 + 4 * kq + i; const float lg = (part[i] + oth[i]) * rsqrtf(ss2[row] * (1.f / 1024.f) + 1e-6f);
        float mx = lg; mx = fmaxf(mx, __shfl_xor(mx, 1)); mx = fmaxf(mx, __shfl_xor(mx, 2)); mx = fmaxf(mx, __shfl_xor(mx, 4)); mx = fmaxf(mx, __shfl_xor(mx, 8));
        const float ex = __expf(lg - mx); float l = ex; l += __shfl_xor(l, 1); l += __shfl_xor(l, 2); l += __shfl_xor(l, 4); l += __shfl_xor(l, 8);
        AFF[((size_t)(row >> 12) * 16 + r) * SEQ + (row & (SEQ - 1))] = ex / l; } }
    __syncthreads();
  }
  __syncthreads();
}
__device__ __forceinline__ void p11_topk(Frame& F, char* lds) {
  unsigned char* ws = F.ws; const float* AFF = (const float*)(ws + WS_AFF); int* ROWSEL = (int*)(ws + WS_ROWSEL); float* GSEL = (float*)(ws + WS_GSEL); int* INV = (int*)(ws + WS_INV);
  unsigned* hist = (unsigned*)lds; unsigned* ctl = hist + 256; unsigned* wsum = hist + 320;
  const int tid = F.tid, lane = F.lane, wid = F.wave;
  for (int it = (int)blockIdx.x; it < BATCH * NEXP; it += F.G) { const int b = it >> 4, e = it & 15;
    unsigned key[8];
#pragma unroll
    for (int j = 0; j < 8; ++j) key[j] = __float_as_uint(AFF[((size_t)b * 16 + e) * SEQ + 8 * tid + j]);
    unsigned prefix = 0u, mask = 0u, need = CAP;
    for (int shift = 24; shift >= 0; shift -= 8) {
      if (tid < 256) hist[tid] = 0u;
      __syncthreads();
#pragma unroll
      for (int j = 0; j < 8; ++j) {
        if (shift == 24) {
          const unsigned d = (key[j] >> shift) & 255u; bool act = (key[j] & mask) == prefix;
          for (;;) { const unsigned long long am = __ballot(act); if (am == 0ull) break;
            const int lead = __builtin_ctzll(am); const unsigned dl = (unsigned)__shfl((int)d, lead);
            const unsigned long long mm = __ballot(act && d == dl);
            if (lane == lead) atomicAdd(&hist[dl], (unsigned)__popcll(mm));
            if (d == dl) act = false; }
        } else if ((key[j] & mask) == prefix) atomicAdd(&hist[(key[j] >> shift) & 255u], 1u); }
      __syncthreads();
      { unsigned cnt = 0u, inc = 0u;
        if (tid < 256) { cnt = hist[255 - tid]; inc = cnt;
#pragma unroll
          for (int o = 1; o < 64; o <<= 1) { const unsigned y = __shfl_up(inc, o); if (lane >= o) inc += y; }
          if (lane == 63) wsum[16 + wid] = inc; }
        __syncthreads();
        if (tid < 256) { for (int w = 0; w < wid; ++w) inc += wsum[16 + w];
          if (inc >= need && inc - cnt < need) { ctl[0] = (unsigned)(255 - tid); ctl[1] = need - (inc - cnt); } } }
      __syncthreads();
      prefix |= ctl[0] << shift; mask |= 255u << shift; need = ctl[1];
      __syncthreads();
    }
    unsigned ngt = 0u, neq = 0u;
#pragma unroll
    for (int j = 0; j < 8; ++j) { ngt += key[j] > prefix ? 1u : 0u; neq += key[j] == prefix ? 1u : 0u; }
    unsigned sgt = ngt, seq_ = neq;
#pragma unroll
    for (int o = 1; o < 64; o <<= 1) { const unsigned y0 = __shfl_up(sgt, o), y1 = __shfl_up(seq_, o); if (lane >= o) { sgt += y0; seq_ += y1; } }
    if (lane == 63) { wsum[wid] = sgt; wsum[8 + wid] = seq_; }
    __syncthreads();
    unsigned bgt = 0u, beq = 0u, tgt = 0u;
#pragma unroll
    for (int w = 0; w < 8; ++w) { const unsigned g = wsum[w], q = wsum[8 + w]; if (w < wid) { bgt += g; beq += q; } tgt += g; }
    unsigned pgt = bgt + sgt - ngt, peq = beq + seq_ - neq;
#pragma unroll
    for (int j = 0; j < 8; ++j) { const int t = 8 * tid + j; int slot = -1;
      if (key[j] > prefix) slot = (int)pgt++; else if (key[j] == prefix) { if (peq < need) slot = (int)(tgt + peq); ++peq; }
      INV[((size_t)b * SEQ + t) * 16 + e] = slot;
      if (slot >= 0) { ROWSEL[e * 2048 + b * 512 + slot] = b * SEQ + t; GSEL[e * 2048 + b * 512 + slot] = __uint_as_float(key[j]); } }
    __syncthreads();
  }
}
#ifndef GU_ORDER
#define GU_ORDER 3
#endif
#ifndef DN_ORDER
#define DN_ORDER 1
#endif
struct MoeGUOrder { int G, c;
  __device__ bool next(int i, pg8::Unit& u) const { const int L = i * G + c; if (L >= 2048) return false;
#if GU_ORDER == 0
    const int e = L >> 7, r = L & 127, pn = r >> 3, mt = r & 7;
#elif GU_ORDER == 1
    const int e = L >> 7, r = L & 127, mt = r >> 4, pn = r & 15;
#elif GU_ORDER == 2
    const int x = c & 7, j = c >> 3, e = (i >> 2) * 8 + x, r = (i & 3) * 32 + j, mt = r >> 4, pn = r & 15;
#else
    int e, mt, pn;
    if (G == 256) { const int x = c & 7, j = c >> 3; e = (i >> 2) * 8 + x; mt = j & 7; pn = (i & 3) * 4 + (j >> 3); }
    else { e = L >> 7; const int r = L & 127; mt = r >> 4; pn = r & 15; }
#endif
    u.g = e; u.pm = mt; u.pn = pn; u.ibase = e * 2048 + mt * 256; u.aoff = MOE_FP8 ? ((long)e * 2048 + mt * 256) * 512 : 0; u.boff = ((long)e * 4096 + pn * 256) * (MOE_FP8 ? 512 : 1024); return true; } };
struct MoeDownOrder { int G, c;
  __device__ bool next(int i, pg8::Unit& u) const { const int L = i * G + c; if (L >= 512) return false;
#if DN_ORDER == 0
    const int e = L >> 5, r = L & 31, pn = r >> 3, mt = r & 7;
#else
    int e, pn, mt;
    if (G == 256) { const int x = c & 7, j = c >> 3; e = i * 8 + x; pn = j >> 3; mt = j & 7; }
    else { e = L >> 5; const int r = L & 31; pn = r >> 3; mt = r & 7; }
#endif
    u.g = e; u.pm = mt; u.pn = pn; u.ibase = e * 2048 + mt * 256; u.aoff = ((long)e * 2048 + mt * 256) * (MOE_FP8_DOWN ? 1024 : 2048); u.boff = ((long)e * 1024 + pn * 256) * (MOE_FP8_DOWN ? 1024 : 2048); return true; } };
struct EpiGU { static constexpr bool TWO_PASS = false; bf16* H; SsAcc ss2; const int* rowsel;
  __device__ __forceinline__ void row8(const pg8::Unit& u, int rloc, int cloc, const float (&a0)[8], const float (&a1)[8], int fq) const {
    const int tok = rowsel[u.ibase + rloc]; const float r = rsqrtf(ss2[tok] * (1.f / 1024.f) + 1e-6f); float h[8];
#pragma unroll
    for (int i = 0; i < 8; ++i) { const float g = a0[i] * r, up = a1[i] * r; h[i] = g * sigmoidf_(g) * up; if (FP8EMU) h[i] = q8(h[i], 8.f); }
#if MOE_FP8_DOWN
    *(v2u*)((unsigned char*)H + ((size_t)u.g * 2048 + u.pm * 256 + rloc) * 2048 + u.pn * 128 + cloc) = pack8_fp8(h, 8.f); } };
#else
    *(v4u*)(H + ((size_t)u.g * 2048 + u.pm * 256 + rloc) * 2048 + u.pn * 128 + cloc) = pack8(h); } };
#endif
struct EpiNull { static constexpr bool TWO_PASS = false; float* d;
  __device__ __forceinline__ void row8(const pg8::Unit& u, int rloc, int cloc, const float (&a0)[8], const float (&a1)[8], int fq) const {
    float s = 0.f;
#pragma unroll
    for (int i = 0; i < 8; ++i) s += a0[i] + a1[i];
    if (s == 1.2345e30f) d[rloc] = s; } };
struct EpiGU8 { static constexpr bool TWO_PASS = false; unsigned char* H8; SsAcc ss2; const int* rowsel;
  __device__ __forceinline__ void row8(const pg8::Unit& u, int rloc, int cloc, const float (&a0)[8], const float (&a1)[8], int fq) const {
    float h[8];
#pragma unroll
    for (int i = 0; i < 8; ++i) { const float g = a0[i], up = a1[i]; h[i] = g * sigmoidf_(g) * up; }
#if MOE_FP8_DOWN
    *(v2u*)(H8 + ((size_t)u.g * 2048 + u.pm * 256 + rloc) * 2048 + u.pn * 128 + cloc) = pack8_fp8(h, 1.f); } };
#else
    *(v4u*)((bf16*)H8 + ((size_t)u.g * 2048 + u.pm * 256 + rloc) * 2048 + u.pn * 128 + cloc) = pack8(h); } };
#endif
struct EpiYE { static constexpr bool TWO_PASS = false; bf16* Yp; const float* gsel;
  __device__ __forceinline__ void row8(const pg8::Unit& u, int rloc, int cloc, const float (&a0)[8], const float (&a1)[8], int fq) const {
    const float gv = gsel[u.ibase + rloc]; float v0[8], v1[8];
#pragma unroll
    for (int i = 0; i < 8; ++i) { v0[i] = a0[i] * gv; v1[i] = a1[i] * gv; }
    bf16* p = Yp + ((size_t)u.g * 2048 + u.pm * 256 + rloc) * 1024 + u.pn * 256 + cloc; *(v4u*)p = pack8(v0); *(v4u*)(p + 128) = pack8(v1); } };
__device__ __forceinline__ void p14_final(Frame& F, const Args& a) {
  unsigned char* ws = F.ws; const bf16* X2 = (const bf16*)(ws + WS_X2); const int* INV = (const int*)(ws + WS_INV); const bf16* YE = (const bf16*)(ws + WS_YE);
  const float* gfin = (const float*)a.in[I_GFIN]; float* out = a.out;
  const int gw = F.vcu * NWAVES + F.wave, NGW = F.G * NWAVES;
  f32x4 g[4];
#pragma unroll
  for (int j = 0; j < 4; ++j) g[j] = *(const f32x4*)(gfin + 256 * j + 4 * F.lane);
  for (int m0 = gw; m0 < MTOK; m0 += 2 * NGW) {
    f32x4 v[2][4]; int inv[2];
#pragma unroll
    for (int u = 0; u < 2; ++u) { const int m = m0 + u * NGW;
#pragma unroll
      for (int j = 0; j < 4; ++j) {
#if X2MODE >= 2 && X2MODE != 4
        v[u][j] = *(const f32x4*)((const float*)(ws + WS_X2F) + (size_t)m * 1024 + 256 * j + 4 * F.lane);
#else
        const v2u w = *(const v2u*)(X2 + (size_t)m * 1024 + 256 * j + 4 * F.lane); v[u][j] = (f32x4){bflo(w.x), bfhi(w.x), bflo(w.y), bfhi(w.y)};
#endif
      }
      inv[u] = F.lane < 16 ? INV[(size_t)m * 16 + F.lane] : -1; }
#pragma unroll
    for (int u = 0; u < 2; ++u) { const int m = m0 + u * NGW, b = m >> 12;
      unsigned long long sel = __ballot(inv[u] >= 0);
      while (sel) { const int e = __builtin_ctzll(sel); sel &= sel - 1; const int slot = __shfl(inv[u], e);
        const bf16* yr = YE + ((size_t)e * 2048 + b * 512 + slot) * 1024 + 4 * F.lane;
#pragma unroll
        for (int j = 0; j < 4; ++j) { const v2u w = *(const v2u*)(yr + 256 * j); v[u][j].x += bflo(w.x); v[u][j].y += bfhi(w.x); v[u][j].z += bflo(w.y); v[u][j].w += bfhi(w.y); } }
      float s = 0.f;
#pragma unroll
      for (int j = 0; j < 4; ++j) s += (v[u][j].x * v[u][j].x + v[u][j].y * v[u][j].y) + (v[u][j].z * v[u][j].z + v[u][j].w * v[u][j].w);
      const float r = rsqrtf(wave_sum(s) * (1.f / 1024.f) + 1e-6f);
#pragma unroll
      for (int j = 0; j < 4; ++j) *(f32x4*)(out + (size_t)m * 1024 + 256 * j + 4 * F.lane) = v[u][j] * r * g[j]; }
  }
}
__global__ void __launch_bounds__(NTHR, 2) mk(Args a) {
  extern __shared__ __attribute__((aligned(16))) unsigned char lds_raw[];
  Frame F;
  F.lds = (LAS unsigned char*)lds_raw; F.MISC = (volatile LAS unsigned*)(F.lds + LDSCTL_OFF + 320);
  F.tid = threadIdx.x; F.lane = F.tid & 63; F.wave = __builtin_amdgcn_readfirstlane(F.tid >> 6);
  F.G = gridDim.x; { const int bx = blockIdx.x; F.vcu = (F.G % 8 == 0) ? (bx % 8) * (F.G / 8) + bx / 8 : bx; }
  F.ws = a.ws; F.ctl = (gu32*)(a.ws + WS_CTL);
  unsigned char* ws = a.ws;
  for (int u = F.tid; u < (LDS_BYTES - LDSCTL_OFF) / 4; u += NTHR) ((LAS unsigned*)(F.lds + LDSCTL_OFF))[u] = 0u;
  __syncthreads();
  XcdBarrier bar = xcd_barrier_post((unsigned*)(F.ctl + CW_BAR), F.MISC + 8);
  const int lo = a.ph_lo, hi = a.ph_hi;
#define IN(k) (lo <= (k) && (k) < hi)
#define BOTH(k) (IN(k) && IN((k) + 1))
#define GRID_BAR() xcd_barrier(bar)
  const SsAcc ssq{(unsigned long long*)(ws + CTL_SSQ)}, sskv{(unsigned long long*)(ws + CTL_SSKV)};

#ifndef REP_MASK
#define REP_MASK 0
#endif
#define NREP(k) ((((REP_MASK) >> (k)) & 1) ? 2 : 1)
#define PH_BEGIN(k) if (IN(k)) { for (int rep_ = 0; rep_ < NREP(k); ++rep_) { const bool dry = rep_ + 1 < NREP(k); (void)dry;
#define PH_END(k) if (dry) GRID_BAR(); } if (BOTH(k)) GRID_BAR(); }
  float* dummy = (float*)(ws + WS_DUMMY);
  const SsAcc ss1{(unsigned long long*)(ws + CTL_SS1)}, ss2{(unsigned long long*)(ws + CTL_SS2)}, ssdummy{(unsigned long long*)(ws + WS_DUMMY)};
#ifndef FILLMODE
#define FILLMODE 2
#endif
  PH_BEGIN(0) p0_prologue(F, a, true, FILLMODE == 0); PH_END(0)
  PH_BEGIN(1)
#ifndef P1_DED_PAIRS
#define P1_DED_PAIRS 5
#endif
    const bool p1split = (F.G == 256); const int g1 = p1split ? 224 : F.G, bx1 = (int)blockIdx.x;
    if (!p1split || bx1 < 224) {
    { pg8::Gemm g{(const bf16*)(ws + WS_XN), (const bf16*)(ws + WS_WIN), 1024, 1024, 1024, nullptr, 127, 127}; pg8::StaticOrder S; S.init(MTOK, PROJ_LD, g1, bx1, 1024, 1024);
      EpiProj E{(bf16*)(ws + WS_PROJ), dry ? ssdummy : ssq, dry ? ssdummy + 16384 : sskv};
      pg8::gemm_phase<EpiProj, pg8::StaticOrder, false>(F.lds, g, S, E); }
    { pg8::Gemm g{(const bf16*)(ws + WS_MEMN), (const bf16*)(ws + WS_WMK), 1024, 1024, 1024, nullptr, 127, 127}; pg8::StaticOrder S;
      S.init(1024, 1024, 1 << 20, p1split ? ((bx1 >= 192 && bx1 < 208) ? bx1 - 192 : (1 << 20)) : (int)((blockIdx.x + 128u) % (unsigned)F.G), 1024, 1024);
      if (!p1split) S.G = F.G;
      EpiStore E{(bf16*)(ws + WS_KMEM), 1024};
      pg8::gemm_phase<EpiStore, pg8::StaticOrder, false>(F.lds, g, S, E); }
    { pg8::Gemm g{(const bf16*)(ws + WS_WMV), (const bf16*)(ws + WS_MEMN), 1024, 1024, 1024, nullptr, 127, 127}; pg8::StaticOrder S;
      S.init(1024, 1024, 1 << 20, p1split ? ((bx1 >= 208 && bx1 < 224) ? bx1 - 208 : (1 << 20)) : (int)((blockIdx.x + 112u) % (unsigned)F.G), 1024, 1024);
      if (!p1split) S.G = F.G;
      EpiStore E{(bf16*)(ws + WS_VMEMT), 1024};
      pg8::gemm_phase<EpiStore, pg8::StaticOrder, false>(F.lds, g, S, E); }
    } else if (!dry) conv_fill(F, a, P1_DED_PAIRS);
  PH_END(1)
  PH_BEGIN(2) p2_elementwise(F, a);
#if UPGEMM_IN_P2
    p2_upgemms(F, ssq, sskv);
#endif
  PH_END(2)
  PH_BEGIN(3) p3_mixers(F, a, (char*)lds_raw, bar.x, ssq, sskv, dry ? 64 * 16 : 0); PH_END(3)
  PH_BEGIN(4) p4_combine(F, a); PH_END(4)
  PH_BEGIN(5)
    pg8::Gemm g{(const bf16*)(ws + WS_Y), (const bf16*)(ws + WS_WOUT), 1024, 1024, 1024, nullptr, 127, 127}; pg8::StaticOrder S; S.init(MTOK, 1024, F.G, (int)blockIdx.x, 1024, 1024);
    EpiResid<0> E{(const float*)a.in[I_X], nullptr, nullptr, (bf16*)(ws + WS_X1B), dry ? ssdummy : ss1};
    pg8::gemm_phase<EpiResid<0>, pg8::StaticOrder, false>(F.lds, g, S, E);
  PH_END(5)
  PH_BEGIN(6)
    { pg8::Gemm g{(const bf16*)(ws + WS_X1B), (const bf16*)(ws + WS_WMQ), 1024, 1024, 1024, nullptr, 127, 127}; MemOrder S{F.G, (int)blockIdx.x, 2};
      EpiScale E{(bf16*)(ws + WS_QMEM), ss1};
      pg8::gemm_phase<EpiScale, MemOrder, false>(F.lds, g, S, E); }
    if (F.tid == 0) __builtin_amdgcn_fence(__ATOMIC_ACQUIRE, "agent");
    asm volatile("s_waitcnt vmcnt(0)" ::: "memory"); __syncthreads();
#if MEMATTN_FUSED
    for (int L = (int)blockIdx.x; L < 256; L += F.G) { const int bh = L >> 4, t = L & 15, b = bh >> 2, h = bh & 3; const size_t row0 = (size_t)b * SEQ + t * 256;
      mem2::memattn_unit((const bf16*)(ws + WS_QMEM) + row0 * 1024 + h * 256, (const bf16*)(ws + WS_KMEM) + (size_t)(b * NMEM) * 1024 + h * 256,
                         (const bf16*)(ws + WS_VMEMT) + (size_t)(h * 256) * 1024 + b * NMEM, (bf16*)(ws + WS_MO) + row0 * 1024 + h * 256, (char*)lds_raw); }
#else
    { pg8::Gemm g{(const bf16*)(ws + WS_QMEM), (const bf16*)(ws + WS_KMEM), 1024, 1024, 256, nullptr, 127, 127}; MemOrder S{F.G, (int)blockIdx.x, 0};
      EpiSoftmax E{(bf16*)(ws + WS_P), 0.0625f, (LAS float*)(F.lds + LDSCTL_OFF + 1024)};
      pg8::gemm_phase<EpiSoftmax, MemOrder, false>(F.lds, g, S, E); }
    if (F.tid == 0) __builtin_amdgcn_fence(__ATOMIC_ACQUIRE, "agent");
    asm volatile("s_waitcnt vmcnt(0)" ::: "memory"); __syncthreads();
    { pg8::Gemm g{(const bf16*)(ws + WS_P), (const bf16*)(ws + WS_VMEMT), 1024, 1024, 256, nullptr, 127, 127}; MemOrder S{F.G, (int)blockIdx.x, 1};
      EpiStore E{(bf16*)(ws + WS_MO), 1024};
      pg8::gemm_phase<EpiStore, MemOrder, false>(F.lds, g, S, E); }
#endif
  PH_END(6)
  PH_BEGIN(9)
    pg8::Gemm g{(const bf16*)(ws + WS_MO), (const bf16*)(ws + WS_WMO), 1024, 1024, 1024, nullptr, 127, 127}; pg8::StaticOrder S; S.init(MTOK, 1024, F.G, (int)blockIdx.x, 1024, 1024);
    EpiResid<1> E{nullptr, (const bf16*)(ws + WS_X1B), (X2MODE >= 1 && X2MODE != 4) ? (float*)(ws + WS_X2F) : nullptr, (bf16*)(ws + WS_X2), dry ? ssdummy : ss2};
    pg8::gemm_phase<EpiResid<1>, pg8::StaticOrder, false>(F.lds, g, S, E);
  PH_END(9)
  PH_BEGIN(10) p10_router(F, a); PH_END(10)
  PH_BEGIN(11) p11_topk(F, (char*)lds_raw);
#if MOE_GATHER_GEMM
    if (blockIdx.x >= 64u || F.G < 128) {
      const int nw = (F.G >= 128 ? F.G - 64 : F.G) * NWAVES, gw = (F.G >= 128 ? (int)blockIdx.x - 64 : (int)blockIdx.x) * NWAVES + F.wave;
      for (int r0 = gw; r0 < MTOK; r0 += 4 * nw) {
        float rn[4]; v4u qa[4], qb[4];
#pragma unroll
        for (int u = 0; u < 4; ++u) { const int r = min(r0 + u * nw, MTOK - 1); const bf16* xr = (const bf16*)(ws + WS_X2) + (size_t)r * 1024 + F.lane * 16; rn[u] = ss2[r]; qa[u] = *(const v4u*)xr; qb[u] = *(const v4u*)(xr + 8); }
#pragma unroll
        for (int u = 0; u < 4; ++u) { const int r = r0 + u * nw; const float s = rsqrtf(rn[u] * (1.f / 1024.f) + 1e-6f);
          float lo[8], hi[8]; unpack8(qa[u], lo); unpack8(qb[u], hi);
#pragma unroll
          for (int j = 0; j < 8; ++j) { lo[j] *= s; hi[j] *= s; }
          const v2u a8 = pack8_fp8(lo, 1.f), b8 = pack8_fp8(hi, 1.f); v4u o; o.x = a8.x; o.y = a8.y; o.z = b8.x; o.w = b8.y;
          if (r < MTOK) *(v4u*)(ws + WS_XG + (size_t)r * 1024 + F.lane * 16) = o; } } }
#endif
    if (!dry && FILLMODE != 0) conv_fill(F, a, 1 << 30);
  PH_END(11)
  PH_BEGIN(12)
#if MOE_FP8 && MOE_GATHER_GEMM
    pg8::Gemm g{(const bf16*)(ws + WS_XG), (const bf16*)(ws + WS_WEGU8), 512, 512, 512, (const int*)(ws + WS_ROWSEL), 127, 121}; MoeGUOrder S{F.G, (int)blockIdx.x};
    EpiGU8 E{(unsigned char*)(ws + WS_HID8), ss2, (const int*)(ws + WS_ROWSEL)};
    pg8::gemm_phase<EpiGU8, MoeGUOrder, true, 1>(F.lds, g, S, E);
#elif MOE_FP8
    {
      const int gw = F.vcu * NWAVES + F.wave, NGW = F.G * NWAVES; const int* rs = (const int*)(ws + WS_ROWSEL);
      for (int r0 = gw; r0 < NEXP * 2048; r0 += 4 * NGW) {
        int tok[4]; float rn[4]; v4u qa[4], qb[4];
#pragma unroll
        for (int u = 0; u < 4; ++u) { const int r = r0 + u * NGW; tok[u] = r < NEXP * 2048 ? rs[r] : 0; }
#pragma unroll
        for (int u = 0; u < 4; ++u) { const bf16* xr = (const bf16*)(ws + WS_X2) + (size_t)tok[u] * 1024 + F.lane * 16; rn[u] = ss2[tok[u]]; qa[u] = *(const v4u*)xr; qb[u] = *(const v4u*)(xr + 8); }
#pragma unroll
        for (int u = 0; u < 4; ++u) { const int r = r0 + u * NGW; const float s = rsqrtf(rn[u] * (1.f / 1024.f) + 1e-6f);
          float lo[8], hi[8]; unpack8(qa[u], lo); unpack8(qb[u], hi);
#pragma unroll
          for (int j = 0; j < 8; ++j) { lo[j] *= s; hi[j] *= s; }
          const v2u a8 = pack8_fp8(lo, 1.f), b8 = pack8_fp8(hi, 1.f); v4u o; o.x = a8.x; o.y = a8.y; o.z = b8.x; o.w = b8.y;
          if (r < NEXP * 2048) *(v4u*)(ws + WS_XG + (size_t)r * 1024 + F.lane * 16) = o; } }
      GRID_BAR(); }
    pg8::Gemm g{(const bf16*)(ws + WS_XG), (const bf16*)(ws + WS_WEGU8), 512, 512, 512, nullptr, 127, 121}; MoeGUOrder S{F.G, (int)blockIdx.x};
    EpiGU8 E{(unsigned char*)(ws + WS_HID8), ss2, (const int*)(ws + WS_ROWSEL)};
#ifdef DRYNULL12
    if (dry) { EpiNull EN{dummy}; pg8::gemm_phase<EpiNull, MoeGUOrder, false, 1>(F.lds, g, S, EN); } else
#endif
    pg8::gemm_phase<EpiGU8, MoeGUOrder, false, 1>(F.lds, g, S, E);
#else
    pg8::Gemm g{(const bf16*)(ws + WS_X2B), (const bf16*)(ws + WS_WEGU), 1024, 1024, 1024, (const int*)(ws + WS_ROWSEL), 127, 127}; MoeGUOrder S{F.G, (int)blockIdx.x};
    EpiGU E{(bf16*)(ws + WS_HID), ss2, (const int*)(ws + WS_ROWSEL)};
    pg8::gemm_phase<EpiGU, MoeGUOrder, true>(F.lds, g, S, E);
#endif
  PH_END(12)
  PH_BEGIN(13)
#if MOE_FP8_DOWN
#ifndef DRYK13
#define DRYK13 1024
#endif
    pg8::Gemm g{(const bf16*)(ws + WS_HID8), (const bf16*)(ws + WS_WED8), 1024, 1024, dry ? DRYK13 : 1024, nullptr, 124, 121}; MoeDownOrder S{F.G, (int)blockIdx.x};
    EpiYE E{(bf16*)(ws + WS_YE), (const float*)(ws + WS_GSEL)};
    pg8::gemm_phase<EpiYE, MoeDownOrder, false, 1>(F.lds, g, S, E);
#else
    pg8::Gemm g{(const bf16*)(ws + WS_HID), (const bf16*)(ws + WS_WED), 2048, 2048, 2048, nullptr, 127, 127}; MoeDownOrder S{F.G, (int)blockIdx.x};
    EpiYE E{(bf16*)(ws + WS_YE), (const float*)(ws + WS_GSEL)};
    pg8::gemm_phase<EpiYE, MoeDownOrder, false>(F.lds, g, S, E);
#endif
  PH_END(13)
  PH_BEGIN(14) p14_final(F, a); PH_END(14)
#undef IN
#undef BOTH
#undef GRID_BAR
}

static int mk_grid() {
  static int grid = 0;
  if (grid == 0) {
    int dev = 0, cus = 0, per_cu = 0;
    (void)hipGetDevice(&dev); (void)hipDeviceGetAttribute(&cus, hipDeviceAttributeMultiprocessorCount, dev);
    (void)hipFuncSetAttribute((const void*)mk, hipFuncAttributeMaxDynamicSharedMemorySize, LDS_BYTES);
    (void)hipOccupancyMaxActiveBlocksPerMultiprocessor(&per_cu, (const void*)mk, NTHR, LDS_BYTES);
    (void)hipGetLastError();
    grid = cus > 0 ? cus : 256;
  }
  return grid;
}
static void mk_launch(hipStream_t s, void* const* d_in, void* d_out, void* d_ws, int lo, int hi, int flags) {
  Args a; memset(&a, 0, sizeof(a));
  for (int i = 0; i < 26; ++i) a.in[i] = d_in[i];
  a.out = (float*)d_out; a.ws = (unsigned char*)d_ws; a.ph_lo = lo; a.ph_hi = hi; a.flags = flags; a.pad = 0;
  hipLaunchKernelGGL(mk, dim3(mk_grid()), dim3(NTHR), LDS_BYTES, s, a);
}

extern "C" void kernel_launch(void* const* d_in, const int* in_sizes, int n_in, void* d_out, int out_size, void* d_ws, size_t ws_size, hipStream_t s) {
  (void)hipMemsetAsync((char*)d_ws + WS_CTL, 0, CTL_ZERO_BYTES, s);
  mk_launch(s, d_in, d_out, d_ws, 0, 15, 1);
}
```
